# Optimizing an MI355X kernel written in HIP

```python
import math
import jax, jax.numpy as jnp
from jax import lax
import numpy as np

D_MODEL = 1024
BATCH = 8
SEQ = 8192
DEPTH = 1

CHUNK = 64
EPS = 1e-6
MIX_WIDTH = D_MODEL
POOL_WIDTH = MIX_WIDTH // 2
POOL_WINDOWS = (2, 4, 8, 16)
N_POOL_GROUPS = len(POOL_WINDOWS)
POOL_GROUP = POOL_WIDTH // N_POOL_GROUPS
ATTN_WIDTH = MIX_WIDTH - POOL_WIDTH
HEAD_DIM = 64
N_HEADS = ATTN_WIDTH // HEAD_DIM
IDX_HEADS = 8
IDX_DIM = 64
TOPK_MAX = 256
Q_BLOCK = 128
PEER_HEADS = 8
PEER_KEYS = 128
PEER_EXPERTS = PEER_KEYS * PEER_KEYS
PEER_QDIM = 256
PEER_TOPK = 16
PEER_BLOCK = 128
NEG = -1e30

IN_SIZES = (POOL_WIDTH, ATTN_WIDTH, ATTN_WIDTH, ATTN_WIDTH, IDX_HEADS * IDX_DIM, IDX_DIM, IDX_HEADS)
IN_WIDTH = sum(IN_SIZES)
IN_SPLITS = tuple(int(s) for s in np.cumsum(IN_SIZES)[:-1])

kernel_name = "hymba_pool_dsa_peer_block"


def rms_norm(x, g):
    xf = x.astype(jnp.float32)
    y = xf * lax.rsqrt(jnp.mean(xf * xf, axis=-1, keepdims=True) + EPS)
    return (y * g.astype(jnp.float32)).astype(x.dtype)


def alibi_slopes(n_heads):
    h = jnp.arange(1, n_heads + 1, dtype=jnp.float32)
    return jnp.exp2(-8.0 * h / n_heads)


def pool_mixer(u, pool_w, pool_scale, pool_out_g):
    B, S, _ = u.shape
    uf = u.astype(jnp.float32)
    cs = jnp.cumsum(uf, axis=1)
    t = jnp.arange(S)
    parts = []
    for gi, win in enumerate(POOL_WINDOWS):
        lo, hi = gi * POOL_GROUP, (gi + 1) * POOL_GROUP
        cg = cs[..., lo:hi]
        prev = jnp.pad(cg, ((0, 0), (win, 0), (0, 0)))[:, :S]
        cnt = jnp.minimum(t + 1, win).astype(jnp.float32)[None, :, None]
        parts.append((cg - prev) / cnt - uf[..., lo:hi])
    pooled = jnp.stack(parts, axis=2).astype(u.dtype)
    mixed = jnp.einsum('bsgc,gcd->bsgd', pooled, pool_w).reshape(B, S, POOL_WIDTH)
    return rms_norm(mixed * pool_scale, pool_out_g)


def sparse_attention(q, k, v, qi, ki, wi, slopes):
    B, S = q.shape[0], q.shape[1]
    topk = min(TOPK_MAX, S // 4)
    s_chunk = jnp.arange(S) // CHUNK
    scale = HEAD_DIM ** -0.5

    def block(j):
        start = j * Q_BLOCK
        qb = lax.dynamic_slice_in_dim(q, start, Q_BLOCK, axis=1)
        qib = lax.dynamic_slice_in_dim(qi, start, Q_BLOCK, axis=1)
        wib = lax.dynamic_slice_in_dim(wi, start, Q_BLOCK, axis=1)
        t = start + jnp.arange(Q_BLOCK)
        t_chunk = t // CHUNK
        dots = jnp.einsum('bqhd,bsd->bqhs', qib, ki).astype(jnp.float32) * (IDX_DIM ** -0.5)
        score = jnp.einsum('bqh,bqhs->bqs', wib.astype(jnp.float32), jax.nn.relu(dots))
        admissible = s_chunk[None, :] <= t_chunk[:, None]
        score = jnp.where(admissible[None], score, NEG)
        _, sel = lax.top_k(score, topk)
        valid = (sel // CHUNK) <= t_chunk[None, :, None]
        kg = jax.vmap(lambda kb, ib: kb[ib])(k, sel)
        vg = jax.vmap(lambda vb, ib: vb[ib])(v, sel)
        logits = jnp.einsum('bqhd,bqkhd->bqhk', qb, kg).astype(jnp.float32) * scale
        dist = jnp.abs(t[None, :, None] - sel).astype(jnp.float32)
        logits = logits - slopes[None, None, :, None] * dist[:, :, None, :]
        logits = jnp.where(valid[:, :, None, :], logits, NEG)
        p = jax.nn.softmax(logits, axis=-1).astype(v.dtype)
        return jnp.einsum('bqhk,bqkhd->bqhd', p, vg)

    outs = lax.map(block, jnp.arange(S // Q_BLOCK))
    return jnp.swapaxes(outs, 0, 1).reshape(B, S, N_HEADS, HEAD_DIM)


def peer_ffn(h, wq, sub_keys, u_tab, v_tab):
    B, S, D = h.shape
    hb = h.reshape((B * S) // PEER_BLOCK, PEER_BLOCK, D)
    half = PEER_QDIM // 2

    def block(xb):
        q = (xb @ wq).reshape(PEER_BLOCK, PEER_HEADS, 2, half)
        s = jnp.einsum('thpd,hpnd->thpn', q, sub_keys).astype(jnp.float32)
        s1, i1 = lax.top_k(s[:, :, 0], PEER_TOPK)
        s2, i2 = lax.top_k(s[:, :, 1], PEER_TOPK)
        cand = (s1[..., :, None] + s2[..., None, :]).reshape(PEER_BLOCK, PEER_HEADS, PEER_TOPK * PEER_TOPK)
        cand_id = (i1[..., :, None] * PEER_KEYS + i2[..., None, :]).reshape(PEER_BLOCK, PEER_HEADS, PEER_TOPK * PEER_TOPK)
        top_s, pos = lax.top_k(cand, PEER_TOPK)
        eid = jnp.take_along_axis(cand_id, pos, axis=-1)
        g = jax.nn.softmax(top_s, axis=-1)
        ug = u_tab[eid]
        a = jax.nn.gelu(jnp.einsum('td,thkd->thk', xb, ug).astype(jnp.float32), approximate=False)
        vg = v_tab[eid]
        return jnp.einsum('thk,thkd->td', (g * a).astype(xb.dtype), vg)

    return lax.map(block, hb).reshape(B, S, D)


def setup_inputs(seed: int = 0) -> dict:
    key = jax.random.key(seed)
    ks = jax.random.split(key, 18)
    f32 = jnp.float32
    L = DEPTH
    D = D_MODEL

    def nrm(k, shape, std):
        return std * jax.random.normal(k, shape, f32)

    def gain(k, shape):
        return 1.0 + 0.1 * jax.random.normal(k, shape, f32)

    return {
        "x": jax.random.normal(ks[0], (BATCH, SEQ, D), f32),
        "c": jax.random.normal(ks[1], (BATCH, D), f32),
        "ada_w": nrm(ks[2], (L, D, 6 * D), 0.5 * D ** -0.5),
        "ada_b": nrm(ks[3], (L, 6 * D), 0.02),
        "norm1_g": gain(ks[4], (L, D)),
        "w_in": nrm(ks[5], (L, D, IN_WIDTH), D ** -0.5),
        "pool_w": nrm(ks[6], (L, N_POOL_GROUPS, POOL_GROUP, POOL_GROUP), POOL_GROUP ** -0.5),
        "pool_scale": gain(ks[7], (L, POOL_WIDTH)),
        "pool_out_g": gain(ks[8], (L, POOL_WIDTH)),
        "q_norm_g": gain(ks[9], (L, HEAD_DIM)),
        "k_norm_g": gain(ks[10], (L, HEAD_DIM)),
        "attn_out_g": gain(ks[11], (L, N_HEADS, HEAD_DIM)),
        "w_out": nrm(ks[12], (L, MIX_WIDTH, D), MIX_WIDTH ** -0.5),
        "norm2_g": gain(ks[13], (L, D)),
        "peer_wq": nrm(ks[14], (L, D, PEER_HEADS * PEER_QDIM), D ** -0.5),
        "peer_subkeys": nrm(ks[15], (L, PEER_HEADS, 2, PEER_KEYS, PEER_QDIM // 2), (PEER_QDIM // 2) ** -0.5),
        "peer_u": nrm(ks[16], (L, PEER_EXPERTS, D), D ** -0.5),
        "peer_v": nrm(ks[17], (L, PEER_EXPERTS, D), PEER_HEADS ** -0.5),
    }


def reference(x, c, ada_w, ada_b, norm1_g, w_in, pool_w, pool_scale, pool_out_g,
              q_norm_g, k_norm_g, attn_out_g, w_out, norm2_g, peer_wq, peer_subkeys,
              peer_u, peer_v):
    B, S, D = x.shape
    slopes = alibi_slopes(N_HEADS)
    cond = jax.nn.silu(c)
    for l in range(DEPTH):
        mod = (cond @ ada_w[l] + ada_b[l])[:, None, :]
        sh1, sc1, g1, sh2, sc2, g2 = jnp.split(mod, 6, axis=-1)

        h = rms_norm(x, norm1_g[l]) * (1 + sc1) + sh1
        proj = h @ w_in[l]
        u, q, k, v, qi, ki, wi = jnp.split(proj, IN_SPLITS, axis=-1)
        pool_out = pool_mixer(u, pool_w[l], pool_scale[l], pool_out_g[l])
        q = rms_norm(q.reshape(B, S, N_HEADS, HEAD_DIM), q_norm_g[l])
        k = rms_norm(k.reshape(B, S, N_HEADS, HEAD_DIM), k_norm_g[l])
        v = v.reshape(B, S, N_HEADS, HEAD_DIM)
        qi = qi.reshape(B, S, IDX_HEADS, IDX_DIM)
        wi = wi * (IDX_HEADS ** -0.5)
        attn = sparse_attention(q, k, v, qi, ki, wi, slopes)
        attn_out = rms_norm(attn, attn_out_g[l]).reshape(B, S, ATTN_WIDTH)
        mixed = jnp.concatenate([pool_out, attn_out], axis=-1) @ w_out[l]
        x = x + g1 * mixed

        h2 = rms_norm(x, norm2_g[l]) * (1 + sc2) + sh2
        x = x + g2 * peer_ffn(h2, peer_wq[l], peer_subkeys[l], peer_u[l], peer_v[l])
    return x
```

```cpp
#include <hip/hip_runtime.h>
#include <hip/hip_cooperative_groups.h>
#include <cstdio>
#include <cstdint>
namespace cg = cooperative_groups;

#ifndef MK_MULTI
#define MK_MULTI 0
#endif

typedef _Float16 f16;
typedef _Float16 f16x8 __attribute__((ext_vector_type(8)));
typedef _Float16 f16x4 __attribute__((ext_vector_type(4)));
typedef float f32x4 __attribute__((ext_vector_type(4)));
typedef unsigned long long u64;
typedef unsigned short u16;

constexpr int NB = 8, NS = 8192, ND = 1024, NT = NB * NS;
constexpr int INW = 2632;
constexpr int NMAIN = 2304;
constexpr float EPS = 1e-6f;
constexpr int NTHR = 512, NWAVE = 8;

constexpr size_t MiB = 1u << 20;
constexpr size_t WS_CTL = 0;
constexpr size_t WS_MOD = 1 * MiB;
constexpr size_t WS_WIN = 2 * MiB;
constexpr size_t WS_WVT = 7 * MiB;
constexpr size_t WS_WOUT = 8 * MiB;
constexpr size_t WS_WQ = 10 * MiB;
constexpr size_t WS_SK = 14 * MiB;
constexpr size_t WS_PW = 14 * MiB + 512 * 1024;
constexpr size_t WS_UT = 16 * MiB;
constexpr size_t WS_VP = 48 * MiB;
constexpr size_t WS_H = 80 * MiB;
constexpr size_t WS_U = 208 * MiB;
constexpr size_t WS_Q = 272 * MiB;
constexpr size_t WS_K = 336 * MiB;
constexpr size_t WS_VT = 400 * MiB;
constexpr size_t WS_PQ = 208 * MiB;
constexpr size_t WS_QI = 464 * MiB;
constexpr size_t WS_KI = 528 * MiB;
constexpr size_t WS_WI = 536 * MiB;
constexpr size_t WS_MASK = 544 * MiB;
constexpr size_t WS_EID = 608 * MiB;
constexpr size_t WS_GW = 624 * MiB;
constexpr size_t WS_END = 656 * MiB;

constexpr int LDS_BYTES = 155648;
constexpr float PEER_USCALE = 256.f, PEER_VSCALE = 16.f;

struct Args { const float* in[18]; float* out; unsigned char* ws; int ph_lo, ph_hi; };

__host__ __device__ __forceinline__ int pos2log(int p) { return 64 * ((p >> 5) & 3) + 32 * (p >> 7) + 8 * ((p >> 2) & 3) + 4 * ((p >> 4) & 1) + (p & 3); }
__device__ __forceinline__ int maincol(int L) { if (L < 1536) return L; if (L < 2120) return L + 512; return -1; }

__device__ __forceinline__ float wave_sum(float v) {
#pragma unroll
    for (int o = 1; o < 64; o <<= 1) v += __shfl_xor(v, o);
    return v;
}
__device__ __forceinline__ float wave_max(float v) {
#pragma unroll
    for (int o = 1; o < 64; o <<= 1) v = fmaxf(v, __shfl_xor(v, o));
    return v;
}

__device__ void ph0_prologue(const Args& a, int bid, int nb, unsigned char* lds) {
    int tid = threadIdx.x; asm volatile("" : "+v"(tid));
    const float* c = a.in[1]; const float* ada_w = a.in[2]; const float* ada_b = a.in[3];
    float* sil = (float*)lds;
    for (int i = tid; i < NB * ND; i += NTHR) { const float v = c[i]; sil[i] = v / (1.f + __expf(-v)); }
    __syncthreads();
    float* mod = (float*)(a.ws + WS_MOD);
    const int gt = bid * NTHR + tid, ngt = nb * NTHR;
    for (int o = gt; o < NB * 6144; o += ngt) {
        const int b = o / 6144, j = o % 6144;
        float acc = ada_b[j];
        const float* sb = sil + b * ND;
        for (int k = 0; k < ND; ++k) acc += sb[k] * ada_w[(size_t)k * 6144 + j];
        mod[o] = acc;
    }
    const float* w_in = a.in[5]; const float* pool_w = a.in[6]; const float* w_out = a.in[12];
    const float* wq = a.in[14]; const float* sk = a.in[15]; const float* pu = a.in[16]; const float* pv = a.in[17];
    f16* WIN = (f16*)(a.ws + WS_WIN); f16* WVT = (f16*)(a.ws + WS_WVT); f16* WOUT = (f16*)(a.ws + WS_WOUT); f16* WQ = (f16*)(a.ws + WS_WQ);
    f16* SK = (f16*)(a.ws + WS_SK); f16* PW = (f16*)(a.ws + WS_PW); unsigned char* UT = a.ws + WS_UT; unsigned char* VP = a.ws + WS_VP;
    {
        __syncthreads();
        const int lane = tid & 63, wv_ = tid >> 6;
        float* scr = (float*)lds + wv_ * (64 * 33);
        constexpr int I_IN = 16 * (NMAIN / 32), I_VT = 16 * 16, I_OUT = 16 * 32, I_WQ = 16 * 64, I_ALL = I_IN + I_VT + I_OUT + I_WQ;
        for (int it = bid * NWAVE + wv_; it < I_ALL; it += nb * NWAVE) {
            int rr = it, kind = 0;
            if (rr >= I_IN) { rr -= I_IN; kind = 1; if (rr >= I_VT) { rr -= I_VT; kind = 2; if (rr >= I_OUT) { rr -= I_OUT; kind = 3; } } }
            const int npb = kind == 0 ? NMAIN / 32 : kind == 1 ? 16 : kind == 2 ? 32 : 64;
            const int k0 = (rr / npb) * 64, p0 = (rr % npb) * 32, p = p0 + (lane & 31);
            const float* W = kind <= 1 ? w_in : kind == 2 ? w_out : wq; const int ldw = kind <= 1 ? INW : kind == 2 ? 1024 : 2048;
            int col;
            if (kind == 0) col = maincol((p & ~255) + pos2log(p & 255)); else if (kind == 1) col = 1536 + p; else col = (p & ~255) + pos2log(p & 255);
#pragma unroll 8
            for (int i = 0; i < 32; ++i) { const int kk = 2 * i + (lane >> 5); scr[kk * 33 + (lane & 31)] = col >= 0 ? W[(size_t)(k0 + kk) * ldw + col] : 0.f; }
            f16* WT = kind == 0 ? WIN : kind == 1 ? WVT : kind == 2 ? WOUT : WQ;
            const int c8 = lane & 7;
#pragma unroll
            for (int j = 0; j < 4; ++j) { const int n = (lane >> 3) + 8 * j; const float* sp = scr + (8 * c8) * 33 + n;
                *(f16x8*)(WT + (size_t)(p0 + n) * ND + k0 + 8 * c8) = (f16x8){(f16)sp[0], (f16)sp[33], (f16)sp[66], (f16)sp[99], (f16)sp[132], (f16)sp[165], (f16)sp[198], (f16)sp[231]}; }
        }
    }
    for (int i = gt; i < 8 * 2 * 128 * 128; i += ngt) SK[i] = (f16)sk[i];
    for (int i = gt; i < 4 * 128 * 128; i += ngt) { const int g = i >> 14, cc = (i >> 7) & 127, d = i & 127; PW[(g * 128 + d) * 128 + cc] = (f16)pool_w[i]; }
    for (int i = gt; i < 16384 * 1024 / 4; i += ngt) { const f32x4 u = ((const f32x4*)pu)[i] * PEER_USCALE, v = ((const f32x4*)pv)[i] * PEER_VSCALE;
        int pu8 = __builtin_amdgcn_cvt_pk_bf8_f32(u.x, u.y, 0, false); pu8 = __builtin_amdgcn_cvt_pk_bf8_f32(u.z, u.w, pu8, true);
        int pv8 = __builtin_amdgcn_cvt_pk_bf8_f32(v.x, v.y, 0, false); pv8 = __builtin_amdgcn_cvt_pk_bf8_f32(v.z, v.w, pv8, true);
        ((int*)UT)[i] = pu8; ((int*)VP)[i] = pv8; }
}

__device__ void row_norm_mod(const float* src, const float* g, const float* mod, int sh_off, int sc_off, f16* dst, int bid, int nb) {
    int tid_ = threadIdx.x; asm volatile("" : "+v"(tid_)); const int lane = tid_ & 63, wave = tid_ >> 6;
    for (int row = bid * NWAVE + wave; row < NT; row += nb * NWAVE) {
        const int b = row / NS;
        const f32x4* xr = (const f32x4*)(src + (size_t)row * ND) + lane;
        f32x4 v[4]; float s = 0.f;
#pragma unroll
        for (int j = 0; j < 4; ++j) { v[j] = xr[64 * j]; s += v[j].x * v[j].x + v[j].y * v[j].y + v[j].z * v[j].z + v[j].w * v[j].w; }
        const float rstd = rsqrtf(wave_sum(s) * (1.f / ND) + EPS);
#pragma unroll
        for (int j = 0; j < 4; ++j) {
            const int col = lane * 4 + 256 * j;
            const f32x4 gg = *(const f32x4*)(g + col), sc = *(const f32x4*)(mod + b * 6144 + sc_off + col), sh = *(const f32x4*)(mod + b * 6144 + sh_off + col);
            f16x4 o;
            o.x = (f16)(v[j].x * rstd * gg.x * (1.f + sc.x) + sh.x); o.y = (f16)(v[j].y * rstd * gg.y * (1.f + sc.y) + sh.y);
            o.z = (f16)(v[j].z * rstd * gg.z * (1.f + sc.z) + sh.z); o.w = (f16)(v[j].w * rstd * gg.w * (1.f + sc.w) + sh.w);
            *(f16x4*)(dst + (size_t)row * ND + col) = o;
        }
    }
}


namespace pg8 {
#define PG8_LAS __attribute__((address_space(3)))
constexpr int BM = 256, BK = 64, HALF = 128, HTB = HALF * BK * 2, STAGE_BYTES = 8 * HTB, NXCD = 8, WGM = 8;
__host__ __device__ __forceinline__ int lds_byte(int r, int c) { const int st = (r >> 4) * 2 + (c >> 5), rr = r & 15, cc = c & 31, ob = rr * 64 + cc * 2; return st * 1024 + (ob ^ (((ob >> 9) & 1) << 5)); }
__host__ __device__ __forceinline__ void stage_rc(int b, int& R, int& C) { const int st = b / 1024, sb = b % 1024, swz = sb ^ (((sb >> 9) & 1) << 5); R = (st >> 1) * 16 + swz / 64; C = (st & 1) * 32 + (swz % 64) / 2; }
struct Unit { int pm, pn; };
struct Gemm { const f16* A; const f16* Bt; int M, N, K; };
struct StaticOrder {
    int nM, nN, nwg, G, c;
    __host__ __device__ void init(int M, int N, int G_, int c_) { nM = M / BM; nN = N / BM; nwg = nM * nN; G = G_; c = c_; }
    __host__ __device__ bool next(int i, Unit& u) const {
        const long L = (long)i * G + c; if (L >= nwg) return false;
        int wgid = (int)L; { const int q = nwg / NXCD, r = nwg % NXCD, xcd = wgid % NXCD, off = wgid / NXCD; wgid = (xcd < r ? xcd * (q + 1) : r * (q + 1) + (xcd - r) * q) + off; }
        const int nig = WGM * nN, gid = wgid / nig, fm = gid * WGM, gsz = (nM - fm) < WGM ? (nM - fm) : WGM;
        u.pm = fm + ((wgid % nig) % gsz); u.pn = (wgid % nig) / gsz; return true;
    }
};
template <class Epi>
__device__ __forceinline__ void gemm_phase(PG8_LAS unsigned char* lds, const Gemm g, const StaticOrder& S, const Epi& E) {
    int tid = threadIdx.x; asm volatile("" : "+v"(tid));
    const int wid = __builtin_amdgcn_readfirstlane(tid >> 6), lane = tid & 63, wr = wid >> 2, wc = wid & 3, fr = lane & 15, fq = lane >> 4;
    const int K = g.K, nt = K / BK;
    unsigned voffA[2];
#pragma unroll
    for (int i = 0; i < 2; ++i) { int R, C; stage_rc(tid * 16 + i * 8192, R, C); voffA[i] = (unsigned)(R * K + C) * 2u; }
    const size_t kstep = (size_t)(BK * 2);
    const size_t hstep = (size_t)HALF * K * 2;
    const size_t tstep = 2 * hstep;
    const unsigned ldsw = (unsigned)wid * 1024u;
    const int aoff = lds_byte(wr * 64 + fr, fq * 8), boff = lds_byte(wc * 32 + fr, fq * 8);
#define PG8_SA(b, h) (((b) * 2 + (h)) * HTB)
#define PG8_SB(b, h) ((4 + (b) * 2 + (h)) * HTB)
#define PG8_STAGE(bufoff, gbase, voff) do { _Pragma("unroll") for (int _i = 0; _i < 2; ++_i) \
        __builtin_amdgcn_global_load_lds((const unsigned*)((const char*)(gbase) + (voff)[_i]), (PG8_LAS unsigned*)(lds + (bufoff) + ldsw + _i * 8192), 16, 0, 0); } while (0)
#define PG8_LDA(dst, b, h) do { _Pragma("unroll") for (int m = 0; m < 4; ++m) _Pragma("unroll") for (int k = 0; k < 2; ++k) dst[m][k] = *(const PG8_LAS f16x8*)(lds + PG8_SA(b, h) + aoff + m * 2048 + k * 1024); } while (0)
#define PG8_LDB(dst, b, h) do { _Pragma("unroll") for (int n = 0; n < 2; ++n) _Pragma("unroll") for (int k = 0; k < 2; ++k) dst[n][k] = *(const PG8_LAS f16x8*)(lds + PG8_SB(b, h) + boff + n * 2048 + k * 1024); } while (0)
#define PG8_MMA(ai, bj, At, Bt) do { __builtin_amdgcn_s_setprio(1); _Pragma("unroll") for (int m = 0; m < 4; ++m) _Pragma("unroll") for (int n = 0; n < 2; ++n) _Pragma("unroll") for (int k = 0; k < 2; ++k) \
        acc[ai][bj][m][n] = __builtin_amdgcn_mfma_f32_16x16x32_f16(Bt[n][k], At[m][k], acc[ai][bj][m][n], 0, 0, 0); __builtin_amdgcn_s_setprio(0); } while (0)
#define PG8_WAIT_V(n) asm volatile("s_waitcnt vmcnt(" #n ")" ::: "memory")
#define PG8_WAIT_L(n) asm volatile("s_waitcnt lgkmcnt(" #n ")" ::: "memory")
#define PG8_BAR __builtin_amdgcn_s_barrier()
#define PG8_SCHED __builtin_amdgcn_sched_barrier(0)
    Unit cur, nxt; int ui = 0;
    if (!S.next(0, cur)) return;
    f32x4 acc[2][2][4][2];
#pragma unroll
    for (int a = 0; a < 2; ++a)
#pragma unroll
        for (int b = 0; b < 2; ++b)
#pragma unroll
            for (int m = 0; m < 4; ++m)
#pragma unroll
                for (int n = 0; n < 2; ++n) acc[a][b][m][n] = (f32x4){0.f, 0.f, 0.f, 0.f};
    f16x8 At[4][2], B0[2][2], B1[2][2];
    const char* cA = (const char*)g.A + (size_t)cur.pm * tstep; const char* cB = (const char*)g.Bt + (size_t)cur.pn * tstep;
    PG8_STAGE(PG8_SB(0, 0), cB, voffA); PG8_STAGE(PG8_SB(0, 1), cB + hstep, voffA); PG8_STAGE(PG8_SA(0, 0), cA, voffA); PG8_STAGE(PG8_SA(0, 1), cA + hstep, voffA);
    if (wr == 1) PG8_BAR;
    PG8_WAIT_V(2); PG8_BAR;
    PG8_STAGE(PG8_SB(1, 0), cB + kstep, voffA); PG8_STAGE(PG8_SA(1, 0), cA + kstep, voffA); PG8_STAGE(PG8_SB(1, 1), cB + hstep + kstep, voffA);
    PG8_WAIT_V(6); PG8_BAR;
    for (;;) {
        const bool has_next = S.next(ui + 1, nxt);
        const char* nA = has_next ? (const char*)g.A + (size_t)nxt.pm * tstep : cA; const char* nB = has_next ? (const char*)g.Bt + (size_t)nxt.pn * tstep : cB;
        for (int t = 0; t < nt; t += 2) {
            const bool last = (t == nt - 2);
            const char* a1 = cA + (size_t)(t + 1) * kstep;
            const char* a2 = last ? nA : cA + (size_t)(t + 2) * kstep; const char* b2 = last ? nB : cB + (size_t)(t + 2) * kstep;
            const char* a3 = a2 + kstep; const char* b3 = b2 + kstep;
            PG8_LDB(B0, 0, 0); PG8_LDB(B1, 0, 1); PG8_SCHED; PG8_LDA(At, 0, 0); PG8_STAGE(PG8_SA(1, 1), a1 + hstep, voffA);
            PG8_WAIT_V(8); PG8_WAIT_L(0); PG8_BAR; PG8_MMA(0, 0, At, B0); PG8_MMA(0, 1, At, B1); PG8_BAR; PG8_SCHED;
            PG8_LDA(At, 0, 1); PG8_STAGE(PG8_SB(0, 0), b2, voffA); PG8_STAGE(PG8_SB(0, 1), b2 + hstep, voffA); PG8_STAGE(PG8_SA(0, 0), a2, voffA);
            PG8_WAIT_V(8); PG8_WAIT_L(0); PG8_BAR; PG8_MMA(1, 0, At, B0); PG8_MMA(1, 1, At, B1); PG8_BAR; PG8_SCHED;
            PG8_LDB(B0, 1, 0); PG8_LDB(B1, 1, 1); PG8_SCHED; PG8_LDA(At, 1, 0); PG8_STAGE(PG8_SA(0, 1), a2 + hstep, voffA);
            PG8_WAIT_V(8); PG8_WAIT_L(0); PG8_BAR; PG8_MMA(0, 0, At, B0); PG8_MMA(0, 1, At, B1); PG8_BAR; PG8_SCHED;
            PG8_LDA(At, 1, 1); PG8_STAGE(PG8_SB(1, 0), b3, voffA); PG8_STAGE(PG8_SB(1, 1), b3 + hstep, voffA); PG8_STAGE(PG8_SA(1, 0), a3, voffA);
            PG8_WAIT_V(8); PG8_WAIT_L(0); PG8_BAR; PG8_MMA(1, 0, At, B0); PG8_MMA(1, 1, At, B1); PG8_BAR; PG8_SCHED;
        }
        if (wr == 0) PG8_BAR;
        E(acc, cur, wr, wc, fr, fq);
        if (!has_next) break;
#pragma unroll
        for (int a = 0; a < 2; ++a)
#pragma unroll
            for (int b = 0; b < 2; ++b)
#pragma unroll
                for (int m = 0; m < 4; ++m)
#pragma unroll
                    for (int n = 0; n < 2; ++n) acc[a][b][m][n] = (f32x4){0.f, 0.f, 0.f, 0.f};
        cur = nxt; cA = nA; cB = nB; ++ui;
        if (wr == 1) PG8_BAR;
    }
    PG8_WAIT_V(0);
    PG8_BAR;
#undef PG8_SA
#undef PG8_SB
#undef PG8_STAGE
#undef PG8_LDA
#undef PG8_LDB
#undef PG8_MMA
#undef PG8_WAIT_V
#undef PG8_WAIT_L
#undef PG8_BAR
#undef PG8_SCHED
}

typedef f32x4 Acc[2][2][4][2];
struct EpiMain {
    unsigned char* ws; const float *qg, *kg;
    __device__ __forceinline__ void operator()(const Acc& acc, const Unit& u, int wr, int wc, int fr, int fq) const {
        const int row0 = u.pm * BM + wr * 64 + fr, pn = u.pn;
        if (pn == 8) {
            if (wc == 0) {
#pragma unroll
                for (int ai = 0; ai < 2; ++ai)
#pragma unroll
                    for (int m = 0; m < 4; ++m) { const size_t row = row0 + ai * HALF + m * 16;
#pragma unroll
                        for (int bj = 0; bj < 2; ++bj) { const f32x4 v0 = acc[ai][bj][m][0], v1 = acc[ai][bj][m][1];
                            *(f16x8*)((f16*)(ws + WS_KI) + (((row >> 5) * 8 + 4 * bj + fq) * 32 + (row & 31)) * 8) = (f16x8){(f16)v0[0], (f16)v0[1], (f16)v0[2], (f16)v0[3], (f16)v1[0], (f16)v1[1], (f16)v1[2], (f16)v1[3]}; } }
            } else if (wc == 1 && fq == 0) {
#pragma unroll
                for (int ai = 0; ai < 2; ++ai)
#pragma unroll
                    for (int m = 0; m < 4; ++m) { const size_t row = row0 + ai * HALF + m * 16;
                        *(f32x4*)((float*)(ws + WS_WI) + row * 8) = acc[ai][0][m][0] * 0.35355339059327373f; *(f32x4*)((float*)(ws + WS_WI) + row * 8 + 4) = acc[ai][0][m][1] * 0.35355339059327373f; }
            }
            return;
        }
        const int kind = pn >> 1;
        f16* base = (f16*)(ws + (kind == 0 ? WS_U : kind == 1 ? WS_Q : kind == 2 ? WS_K : WS_QI));
        const int col0 = (pn & 1) * 256 + 64 * wc + 8 * fq;
        if (kind == 1 || kind == 2) {
            const float* gp = (kind == 1 ? qg : kg) + 8 * fq;
#pragma unroll
            for (int ai = 0; ai < 2; ++ai)
#pragma unroll
                for (int m = 0; m < 4; ++m) { const size_t row = row0 + ai * HALF + m * 16;
                    float ss = 0.f;
#pragma unroll
                    for (int bj = 0; bj < 2; ++bj)
#pragma unroll
                        for (int n = 0; n < 2; ++n) { const f32x4 v = acc[ai][bj][m][n]; ss += v[0] * v[0] + v[1] * v[1] + v[2] * v[2] + v[3] * v[3]; }
                    ss += __shfl_xor(ss, 16); ss += __shfl_xor(ss, 32);
                    const float rstd = rsqrtf(ss * (1.f / 64.f) + EPS);
#pragma unroll
                    for (int bj = 0; bj < 2; ++bj) { const f32x4 v0 = acc[ai][bj][m][0] * rstd * *(const f32x4*)(gp + 32 * bj), v1 = acc[ai][bj][m][1] * rstd * *(const f32x4*)(gp + 32 * bj + 4);
                        *(f16x8*)(base + row * 512 + col0 + 32 * bj) = (f16x8){(f16)v0[0], (f16)v0[1], (f16)v0[2], (f16)v0[3], (f16)v1[0], (f16)v1[1], (f16)v1[2], (f16)v1[3]}; }
                    asm volatile("" ::: "memory"); }
        } else {
#pragma unroll
            for (int ai = 0; ai < 2; ++ai)
#pragma unroll
                for (int m = 0; m < 4; ++m) { const size_t row = row0 + ai * HALF + m * 16;
#pragma unroll
                    for (int bj = 0; bj < 2; ++bj) { const f32x4 v0 = acc[ai][bj][m][0], v1 = acc[ai][bj][m][1];
                        *(f16x8*)(base + row * 512 + col0 + 32 * bj) = (f16x8){(f16)v0[0], (f16)v0[1], (f16)v0[2], (f16)v0[3], (f16)v1[0], (f16)v1[1], (f16)v1[2], (f16)v1[3]}; } }
        }
    }
};
struct EpiVT {
    f16* VT;
    __device__ __forceinline__ void operator()(const Acc& acc, const Unit& u, int wr, int wc, int fr, int fq) const {
        const int row0 = u.pm * BM + wr * 64 + fr, col0 = u.pn * BM + 32 * wc + 4 * fq;
#pragma unroll
        for (int ai = 0; ai < 2; ++ai)
#pragma unroll
            for (int m = 0; m < 4; ++m) { const size_t row = row0 + ai * HALF + m * 16;
#pragma unroll
                for (int bj = 0; bj < 2; ++bj)
#pragma unroll
                    for (int n = 0; n < 2; ++n) { const f32x4 v = acc[ai][bj][m][n];
                        *(f16x4*)(VT + row * NT + col0 + 128 * bj + 16 * n) = (f16x4){(f16)v[0], (f16)v[1], (f16)v[2], (f16)v[3]}; } }
    }
};
struct EpiOut {
    const float* x; const float* mod; float* out;
    __device__ __forceinline__ void operator()(const Acc& acc, const Unit& u, int wr, int wc, int fr, int fq) const {
        const int row0 = u.pm * BM + wr * 64 + fr, col0 = u.pn * BM + 64 * wc + 8 * fq;
        const float* g1 = mod + ((u.pm * BM) / NS) * 6144 + 2048 + col0;
        f32x4 g4[2][2];
#pragma unroll
        for (int bj = 0; bj < 2; ++bj)
#pragma unroll
            for (int n = 0; n < 2; ++n) g4[bj][n] = *(const f32x4*)(g1 + 32 * bj + 4 * n);
#pragma unroll
        for (int ai = 0; ai < 2; ++ai)
#pragma unroll
            for (int m = 0; m < 4; ++m) { const size_t off = (size_t)(row0 + ai * HALF + m * 16) * ND + col0;
#pragma unroll
                for (int bj = 0; bj < 2; ++bj)
#pragma unroll
                    for (int n = 0; n < 2; ++n) { const f32x4 xv = *(const f32x4*)(x + off + 32 * bj + 4 * n);
                        *(f32x4*)(out + off + 32 * bj + 4 * n) = xv + g4[bj][n] * acc[ai][bj][m][n]; } }
    }
};
struct EpiPQ {
    f16* PQ;
    __device__ __forceinline__ void operator()(const Acc& acc, const Unit& u, int wr, int wc, int fr, int fq) const {
        const int row0 = u.pm * BM + wr * 64 + fr, col0 = u.pn * BM + 64 * wc + 8 * fq;
#pragma unroll
        for (int ai = 0; ai < 2; ++ai)
#pragma unroll
            for (int m = 0; m < 4; ++m) { const size_t row = row0 + ai * HALF + m * 16;
#pragma unroll
                for (int bj = 0; bj < 2; ++bj) { const f32x4 v0 = acc[ai][bj][m][0], v1 = acc[ai][bj][m][1];
                    *(f16x8*)(PQ + row * 2048 + col0 + 32 * bj) = (f16x8){(f16)v0[0], (f16)v0[1], (f16)v0[2], (f16)v0[3], (f16)v1[0], (f16)v1[1], (f16)v1[2], (f16)v1[3]}; } }
    }
};
}

__device__ __forceinline__ void ph2_inproj(const Args& a, int bid, int nb, unsigned char* lds) {
    const f16* H = (const f16*)(a.ws + WS_H); const f16* WIN = (const f16*)(a.ws + WS_WIN); const f16* WVT = (const f16*)(a.ws + WS_WVT);
    PG8_LAS unsigned char* l3 = (PG8_LAS unsigned char*)lds;
    { pg8::Gemm g{H, WIN, NT, NMAIN, ND}; pg8::StaticOrder S; S.init(NT, NMAIN, nb, bid);
      pg8::EpiMain E{a.ws, a.in[9], a.in[10]};
      pg8::gemm_phase(l3, g, S, E); }
    { pg8::Gemm g{WVT, H, 512, NT, ND}; pg8::StaticOrder S; S.init(512, NT, nb, bid);
      pg8::EpiVT E{(f16*)(a.ws + WS_VT)};
      pg8::gemm_phase(l3, g, S, E); }
}


constexpr int PPITCH = 1040;
__device__ __forceinline__ void ph3_pool_fast(const Args& a, int bid, int nb, unsigned char* lds) {
    int tid = threadIdx.x; asm volatile("" : "+v"(tid));
    const int lane = tid & 63, wave = __builtin_amdgcn_readfirstlane(tid >> 6), fr = lane & 15, fq = lane >> 4;
    const f16* U = (const f16*)(a.ws + WS_U); const f16* PW = (const f16*)(a.ws + WS_PW); f16* MIX = (f16*)(a.ws + WS_H);
    const float* pscale = a.in[7]; const float* pg = a.in[8];
    float* red = (float*)(lds + 32 * PPITCH);
    typedef _Float16 h2 __attribute__((ext_vector_type(2)));
    for (int item = bid; item < NT / 32; item += nb) {
        const int t0 = item * 32;
        __syncthreads();
        {
            const int cg8 = tid & 63, tq = tid >> 6, gch = cg8 >> 4, win = 2 << gch;
            const int tb = t0 + 4 * tq, tl0 = tb % NS;
            const f16* up = U + (size_t)(tb - tl0) * 512 + 8 * cg8;
            float sm[8];
#pragma unroll
            for (int j = 0; j < 8; ++j) sm[j] = 0.f;
            f16x8 hist_[15];
#pragma unroll
            for (int q = 0; q < 15; ++q) { const int rr = tl0 - 15 + q; hist_[q] = (q >= 16 - win && rr >= 0) ? *(const f16x8*)(up + (size_t)rr * 512) : (f16x8){0, 0, 0, 0, 0, 0, 0, 0}; }
            f16x8 cur_[4];
#pragma unroll
            for (int k = 0; k < 4; ++k) cur_[k] = *(const f16x8*)(up + (size_t)(tl0 + k) * 512);
#pragma unroll
            for (int q = 0; q < 15; ++q)
#pragma unroll
                for (int j = 0; j < 8; ++j) sm[j] += (float)hist_[q][j];
#pragma unroll
            for (int k = 0; k < 4; ++k) {
                const int tl = tl0 + k;
                const float ic = 1.f / (float)((tl + 1 < win) ? tl + 1 : win);
                f16x8 o;
#pragma unroll
                for (int j = 0; j < 8; ++j) { sm[j] += (float)cur_[k][j]; o[j] = (f16)(sm[j] * ic - (float)cur_[k][j]); }
                *(f16x8*)(lds + (4 * tq + k) * PPITCH + 16 * cg8) = o;
                if (k < 3) {
#pragma unroll
                    for (int j = 0; j < 8; ++j) {
                        float dv;
                        const int q = 16 - win + k;
                        dv = 0.f;
#pragma unroll
                        for (int qq = 0; qq < 15; ++qq) if (qq == q) dv = (float)hist_[qq][j];
#pragma unroll
                        for (int kk = 0; kk < 3; ++kk) if (q == 15 + kk) dv = (float)cur_[kk][j];
                        sm[j] -= dv;
                    }
                }
            }
        }
        __syncthreads();
        const int g = wave >> 1, th = wave & 1;
        f32x4 acc[8];
#pragma unroll
        for (int nt = 0; nt < 8; ++nt) acc[nt] = (f32x4){0.f, 0.f, 0.f, 0.f};
#pragma unroll
        for (int ks = 0; ks < 4; ++ks) {
            const f16x8 bf = *(const f16x8*)(lds + (16 * th + fr) * PPITCH + (g * 128 + 32 * ks + 8 * fq) * 2);
#pragma unroll
            for (int nt = 0; nt < 8; ++nt) { const f16x8 af = *(const f16x8*)(PW + (size_t)(g * 128 + 16 * nt + fr) * 128 + 32 * ks + 8 * fq);
                acc[nt] = __builtin_amdgcn_mfma_f32_16x16x32_f16(af, bf, acc[nt], 0, 0, 0); }
        }
        float ss = 0.f;
#pragma unroll
        for (int nt = 0; nt < 8; ++nt) { const f32x4 sc = *(const f32x4*)(pscale + g * 128 + 16 * nt + 4 * fq); acc[nt] = acc[nt] * sc;
            ss += acc[nt][0] * acc[nt][0] + acc[nt][1] * acc[nt][1] + acc[nt][2] * acc[nt][2] + acc[nt][3] * acc[nt][3]; }
        ss += __shfl_xor(ss, 16); ss += __shfl_xor(ss, 32);
        if (fq == 0) red[(16 * th + fr) * 4 + g] = ss;
        __syncthreads();
        const f32x4 r4 = *(const f32x4*)(red + (16 * th + fr) * 4);
        const float rstd = rsqrtf((r4[0] + r4[1] + r4[2] + r4[3]) * (1.f / 512.f) + EPS);
        const size_t orow = (size_t)(t0 + 16 * th + fr) * ND + g * 128 + 4 * fq;
#pragma unroll
        for (int nt = 0; nt < 8; ++nt) { const f32x4 gg = *(const f32x4*)(pg + g * 128 + 16 * nt + 4 * fq); const f32x4 v = acc[nt] * rstd * gg;
            *(f16x4*)(MIX + orow + 16 * nt) = (f16x4){(f16)v[0], (f16)v[1], (f16)v[2], (f16)v[3]}; }
    }
    __syncthreads();
}


typedef float f32x16 __attribute__((ext_vector_type(16)));
typedef float f32x2 __attribute__((ext_vector_type(2)));
typedef unsigned u32x4 __attribute__((ext_vector_type(4)));

constexpr int IDX_KPITCH = 16384 + 16;
constexpr int IDX_HPITCH = 516;
template <int NBL>
__device__ __forceinline__ int wave_pick(const unsigned (&cc)[NBL], unsigned target, int lane, unsigned& rem_out) {
    unsigned tot = 0u;
#pragma unroll
    for (int j = 0; j < NBL; ++j) tot += cc[j];
    unsigned S = tot;
#pragma unroll
    for (int o = 1; o < 64; o <<= 1) { const unsigned v = __shfl_down(S, o); if (lane + o < 64) S += v; }
    const unsigned above = S - tot;
    const bool hit = (above < target) && (S >= target);
    const u64 bal = __ballot(hit);
    const int L = bal ? __builtin_ctzll(bal) : 0;
    int bin = 0; unsigned rem = target;
    { unsigned run = above; bool done = false;
#pragma unroll
      for (int j = NBL - 1; j >= 0; --j) { if (!done) { if (run + cc[j] >= target) { bin = NBL * lane + j; rem = target - run; done = true; } else run += cc[j]; } } }
    bin = __shfl(bin, L); rem_out = __shfl(rem, L);
    return bin;
}
template <int MODE>
__device__ __forceinline__ void ph3_index_fast(const Args& a, int bid, int nb, unsigned char* lds) {
    int tid = threadIdx.x; asm volatile("" : "+v"(tid));
    const int lane = tid & 63, wave = __builtin_amdgcn_readfirstlane(tid >> 6), r = lane & 31, hh = lane >> 5;
    const f16* QI = (const f16*)(a.ws + WS_QI); const f16* KI = (const f16*)(a.ws + WS_KI); const float* WI = (const float*)(a.ws + WS_WI);
    u64* MASK = (u64*)(a.ws + WS_MASK);
    unsigned* hist = (unsigned*)(lds + 8 * IDX_KPITCH);
    f16x8 af[2][4]; f32x2 wv2[2][8];
#define IDX_LOAD_FRAGS(t0_) do { \
        _Pragma("unroll") for (int rt = 0; rt < 2; ++rt) { \
            const int ql = 4 * rt + 2 * ((r >> 2) & 1) + (r >> 4), hd = (r & 3) + 4 * ((r >> 3) & 1); \
            _Pragma("unroll") for (int ks = 0; ks < 4; ++ks) af[rt][ks] = *(const f16x8*)(QI + (size_t)((t0_) + ql) * 512 + hd * 64 + 16 * ks + 8 * hh); \
            _Pragma("unroll") for (int qq = 0; qq < 2; ++qq) { const float* wp = WI + (size_t)((t0_) + 4 * rt + 2 * hh + qq) * 8; const f32x4 w0 = *(const f32x4*)wp * 0.125f, w1 = *(const f32x4*)(wp + 4) * 0.125f; \
                wv2[rt][4 * qq + 0] = (f32x2){w0[0], w0[1]}; wv2[rt][4 * qq + 1] = (f32x2){w0[2], w0[3]}; wv2[rt][4 * qq + 2] = (f32x2){w1[0], w1[1]}; wv2[rt][4 * qq + 3] = (f32x2){w1[2], w1[3]}; } \
        } } while (0)
    for (int round = 0; round * nb < 256; ++round) {
        const int p = round * nb + ((round & 1) ? (nb - 1 - bid) : bid);
        if (p < 256) { const int tg = p >> 3, b_ = p & 7, t0l = tg * 8, ch_ = t0l >> 6, t0_ = b_ * NS + t0l;
            if (tid < 8 * (ch_ + 1)) { const int q = tid / (ch_ + 1), w = tid % (ch_ + 1); MASK[(size_t)(t0_ + q) * 128 + w] = ~0ull; } }
    }
#define IDX_P(round_) ((round_) * nb + (((round_) & 1) ? (nb - 1 - bid) : bid))
    int round = 0;
    while (round * nb < 8192 && !(IDX_P(round) >= 256 && IDX_P(round) < 8192)) ++round;
    if (round * nb < 8192) { const int p0 = IDX_P(round); IDX_LOAD_FRAGS((p0 & 7) * NS + (p0 >> 3) * 8); }
    for (; round * nb < 8192; ) {
        const int p = IDX_P(round);
        int rnext = round + 1;
        while (rnext * nb < 8192 && !(IDX_P(rnext) >= 256 && IDX_P(rnext) < 8192)) ++rnext;
        const bool has_next = rnext * nb < 8192;
        const int pn = has_next ? IDX_P(rnext) : p;
        const int tg = p >> 3, b = p & 7, t0l = tg * 8, ch = t0l >> 6, nadm = 64 * (ch + 1), t0 = b * NS + t0l;
        const int t0n = (pn & 7) * NS + (pn >> 3) * 8;
        round = has_next ? rnext : 8192;
        __syncthreads();
#pragma unroll
        for (int i = 0; i < 9; ++i) if (tid + i * NTHR < 8 * IDX_HPITCH) hist[tid + i * NTHR] = 0u;
        __syncthreads();
        const int nkb = nadm >> 5;
        const f16* kbase = KI + ((size_t)(b * (NS / 32)) * 8 + hh) * 256 + r * 8;
#define IDX_LOADB(dst, kb_) do { _Pragma("unroll") for (int ks = 0; ks < 4; ++ks) dst[ks] = *(const f16x8*)(kbase + ((size_t)(kb_) * 8 + 2 * ks) * 256); } while (0)
#define IDX_BLOCK(bfrag, kb_) do { \
            f32x16 acc[2]; \
            _Pragma("unroll") for (int rt = 0; rt < 2; ++rt) { acc[rt] = (f32x16){0.f, 0.f, 0.f, 0.f, 0.f, 0.f, 0.f, 0.f, 0.f, 0.f, 0.f, 0.f, 0.f, 0.f, 0.f, 0.f}; \
                _Pragma("unroll") for (int ks = 0; ks < 4; ++ks) acc[rt] = __builtin_amdgcn_mfma_f32_32x32x16_f16(af[rt][ks], bfrag[ks], acc[rt], 0, 0, 0); } \
            _Pragma("unroll") for (int rt = 0; rt < 2; ++rt) \
                _Pragma("unroll") for (int qq = 0; qq < 2; ++qq) { \
                    f32x2 t2 = (f32x2){0.f, 0.f}; \
                    _Pragma("unroll") for (int hp = 0; hp < 4; ++hp) { const f32x2 r2 = (f32x2){__int_as_float(max(__float_as_int(acc[rt][8 * qq + 2 * hp]), 0)), __int_as_float(max(__float_as_int(acc[rt][8 * qq + 2 * hp + 1]), 0))}; \
                        t2 = __builtin_elementwise_fma(wv2[rt][4 * qq + hp], r2, t2); } \
                    const float sc = t2[0] + t2[1]; \
                    const f16 sh = (f16)sc; const unsigned bits = (unsigned)__builtin_bit_cast(unsigned short, sh); \
                    const unsigned key = (bits & 0x8000u) ? (~bits & 0xFFFFu) : (bits | 0x8000u); \
                    const int q = 4 * rt + 2 * hh + qq; \
                    if (MODE != 2) *(u16*)(lds + q * IDX_KPITCH + ((kb_) * 32 + r) * 2) = (u16)key; \
                    if (MODE != 2 && MODE != 4) atomicAdd(&hist[q * IDX_HPITCH + (key >> 7)], (key & 64u) ? 0x10000u : 1u); \
                    if (MODE == 2) sink += key; \
                } } while (0)
        f16x8 bf0[4], bf1[4], bf2[4]; unsigned sink = 0u;
        if (wave >= 4) __builtin_amdgcn_s_sleep(5);
        if (wave < nkb) IDX_LOADB(bf0, wave);
        if (wave + 8 < nkb) IDX_LOADB(bf1, wave + 8);
        if (wave + 16 < nkb) IDX_LOADB(bf2, wave + 16);
        if (MODE != 3) for (int kb = wave; kb < nkb; kb += 24) {
            IDX_BLOCK(bf0, kb);
            if (kb + 24 < nkb) IDX_LOADB(bf0, kb + 24);
            if (kb + 8 < nkb) { IDX_BLOCK(bf1, kb + 8); if (kb + 32 < nkb) IDX_LOADB(bf1, kb + 32); }
            if (kb + 16 < nkb) { IDX_BLOCK(bf2, kb + 16); if (kb + 40 < nkb) IDX_LOADB(bf2, kb + 40); }
        }
#undef IDX_LOADB
#undef IDX_BLOCK
        if (MODE == 2 && sink == 0xdeadbeefu) hist[tid] = sink;
        IDX_LOAD_FRAGS(t0n);
        __syncthreads();
        if (MODE != 1) {
            unsigned* hw = hist + wave * IDX_HPITCH;
            const unsigned char* krow = lds + wave * IDX_KPITCH;
            unsigned rem1 = 0u, rem2 = 0u;
            int b1;
            {   const u32x4 d0 = *(const u32x4*)(hw + 8 * lane), d1 = *(const u32x4*)(hw + 8 * lane + 4);
                const unsigned dd[8] = {d0.x, d0.y, d0.z, d0.w, d1.x, d1.y, d1.z, d1.w};
                unsigned cc[16];
#pragma unroll
                for (int j = 0; j < 8; ++j) { cc[2 * j] = dd[j] & 0xFFFFu; cc[2 * j + 1] = dd[j] >> 16; }
                b1 = wave_pick<16>(cc, 256u, lane, rem1); }
            hw[lane] = 0u;
            const int nit = (nadm + 511) >> 9;
            for (int it = 0; it < nit; ++it) {
                const int idx = (it * 64 + lane) * 8;
                if (idx < nadm) { const u32x4 k4 = *(const u32x4*)(krow + idx * 2);
                    const unsigned kk[4] = {k4.x, k4.y, k4.z, k4.w};
                    unsigned hit = 0u;
#pragma unroll
                    for (int j = 0; j < 4; ++j) { hit |= (((kk[j] & 0xFFFFu) >> 6) == (unsigned)b1 ? 1u : 0u) << (2 * j); hit |= ((kk[j] >> 22) == (unsigned)b1 ? 1u : 0u) << (2 * j + 1); }
                    if (hit) {
#pragma unroll
                        for (int j = 0; j < 4; ++j) { const unsigned k0 = kk[j] & 0xFFFFu, k1 = kk[j] >> 16;
                            if (hit & (1u << (2 * j))) atomicAdd(&hw[k0 & 63u], 1u);
                            if (hit & (2u << (2 * j))) atomicAdd(&hw[k1 & 63u], 1u); }
                    } }
            }
            int b2;
            { const unsigned c1[1] = {hw[lane]}; b2 = wave_pick<1>(c1, rem1, lane, rem2); }
            const unsigned tau = ((unsigned)b1 << 6) | (unsigned)b2;
            const size_t mrow = (size_t)(t0 + wave) * 128;
            for (int it = 0; it < nit; ++it) {
                const int idx = (it * 64 + lane) * 8;
                unsigned byte = 0u;
                if (idx < nadm) { const u32x4 k4 = *(const u32x4*)(krow + idx * 2);
                    const unsigned kk[4] = {k4.x, k4.y, k4.z, k4.w};
#pragma unroll
                    for (int j = 0; j < 4; ++j) { byte |= ((kk[j] & 0xFFFFu) >= tau ? 1u : 0u) << (2 * j); byte |= ((kk[j] >> 16) >= tau ? 1u : 0u) << (2 * j + 1); } }
                unsigned lo = (lane & 4) ? 0u : (byte << (8 * (lane & 3))), hi = (lane & 4) ? (byte << (8 * (lane & 3))) : 0u;
                lo |= __shfl_xor(lo, 1); hi |= __shfl_xor(hi, 1); lo |= __shfl_xor(lo, 2); hi |= __shfl_xor(hi, 2); lo |= __shfl_xor(lo, 4); hi |= __shfl_xor(hi, 4);
                if ((lane & 7) == 0 && idx < nadm) MASK[mrow + it * 8 + (lane >> 3)] = ((u64)hi << 32) | lo;
            }
        }
    }
    __syncthreads();
}

constexpr int ATP = 144;
constexpr int ATT_QWORD = 3584 + 32 * 64;
template <int AMODE>
__device__ __forceinline__ void ph4_attn_fast(const Args& a, int bid, int nb, unsigned char* lds) {
    int tid = threadIdx.x; asm volatile("" : "+v"(tid));
    const int lane = tid & 63, wave = __builtin_amdgcn_readfirstlane(tid >> 6), r = lane & 31, hh = lane >> 5;
    const f16* Q = (const f16*)(a.ws + WS_Q); const f16* Kk = (const f16*)(a.ws + WS_K); const f16* VT = (const f16*)(a.ws + WS_VT);
    const u64* MASK = (const u64*)(a.ws + WS_MASK); f16* MIX = (f16*)(a.ws + WS_H); const float* og = a.in[11];
    unsigned char* Kl = lds; unsigned char* Vl = lds + 2 * 64 * ATP;
    const float LOG2E = 1.4426950408889634f, OFF = 8192.f;
    const int pir = 16 * (r >> 4) + 8 * ((r >> 2) & 1) + 4 * ((r >> 3) & 1) + (r & 3);
    const int srow = tid >> 3, schk = tid & 7;
    unsigned* aq = (unsigned*)(a.ws + WS_CTL) + ATT_QWORD;
    volatile unsigned* ucell = (volatile unsigned*)(lds + 6 * 64 * ATP);
    volatile unsigned* dflag = ucell + 8;
    const float kmax = __int_as_float(__builtin_amdgcn_readfirstlane(__float_as_int(1.01f * 8.f * wave_max(fabsf(a.in[10][lane])))));
    int upar = 0;
    for (;;) {
        if (tid == 0) ucell[upar] = __hip_atomic_fetch_add(aq, 1u, __ATOMIC_RELAXED, __HIP_MEMORY_SCOPE_AGENT);
        if (tid < 8) dflag[tid] = 0u;
        __syncthreads();
        const unsigned u = ucell[upar]; upar ^= 1;
        if (u >= 2048u) break;
        const int h = 7 - (int)(u >> 8), qb = 31 - (int)((u & 255u) >> 3), b = (int)(u & 7u);
        const int q0l = qb * 256, tq = q0l + 32 * wave + r, cw = 4 * qb + (wave >> 1), top = 4 * qb + 3;
        const size_t t = (size_t)b * NS + tq;
        const float slope = exp2f(-(float)(h + 1)) * LOG2E;
        f16x8 qf[4];
#pragma unroll
        for (int ks = 0; ks < 4; ++ks) { const f16x8 qv = *(const f16x8*)(Q + t * 512 + h * 64 + 16 * ks + 8 * hh);
#pragma unroll
            for (int j = 0; j < 8; ++j) qf[ks][j] = (f16)((float)qv[j] * (0.125f * LOG2E)); }
        float qss = 0.f;
#pragma unroll
        for (int ks = 0; ks < 4; ++ks)
#pragma unroll
            for (int j = 0; j < 8; ++j) qss += (float)qf[ks][j] * (float)qf[ks][j];
        qss += __shfl_xor(qss, 32);
        const float Sb = __int_as_float(__builtin_amdgcn_readfirstlane(__float_as_int(wave_max(sqrtf(qss)) * kmax)));
        const float rowc = OFF + slope * (float)(tq - q0l);
        float m = 1000.f, l = 0.f;
        f32x16 O[2];
#pragma unroll
        for (int dt = 0; dt < 2; ++dt) O[dt] = (f32x16){0.f, 0.f, 0.f, 0.f, 0.f, 0.f, 0.f, 0.f, 0.f, 0.f, 0.f, 0.f, 0.f, 0.f, 0.f, 0.f};
        const f16* kg = Kk + ((size_t)b * NS + srow) * 512 + h * 64 + schk * 8;
        const f16* vg = VT + (size_t)(h * 64 + srow) * NT + (size_t)b * NS + schk * 8;
        f16x8 kr0, kr1, vr0, vr1; u64 mw0 = 0ull, mw1 = 0ull;
#define ATT_LOAD(kr, vr, mwv, jj) do { if ((jj) >= 0) { kr = *(const f16x8*)(kg + (size_t)(jj) * 64 * 512); vr = *(const f16x8*)(vg + (jj) * 64); mwv = ((jj) <= cw) ? MASK[t * 128 + (jj)] : 0ull; } } while (0)
        ATT_LOAD(kr0, vr0, mw0, top); ATT_LOAD(kr1, vr1, mw1, top - 1);
        int buf = 0; bool wdone = false, stop = false;
        auto step = [&](f16x8& kreg, f16x8& vreg, u64& mwr, const int j) {
            *(f16x8*)(Kl + buf * 64 * ATP + srow * ATP + schk * 16) = kreg;
            *(f16x8*)(Vl + buf * 64 * ATP + srow * ATP + schk * 16) = vreg;
            const u64 mw = mwr;
            asm volatile("s_waitcnt lgkmcnt(0)" ::: "memory"); __builtin_amdgcn_s_barrier(); asm volatile("" ::: "memory");
            {
                const unsigned jp = (unsigned)(j + 1);
                if ((dflag[0] > jp) & (dflag[1] > jp) & (dflag[2] > jp) & (dflag[3] > jp) & (dflag[4] > jp) & (dflag[5] > jp) & (dflag[6] > jp) & (dflag[7] > jp)) { stop = true; return; }
            }
            ATT_LOAD(kreg, vreg, mwr, j - 2);
            if (!wdone && j < cw) { const float lmax = Sb + OFF + slope * (float)(64 * j + 63 - q0l); if (__all(lmax - m < -28.f)) { wdone = true; if (lane == 0) dflag[wave] = (unsigned)(j + 1); } }
            if (j <= cw && !wdone) {
                const unsigned char* kb_ = Kl + buf * 64 * ATP + pir * ATP + 16 * hh;
                f16x8 fr8[8];
#pragma unroll
                for (int kt = 0; kt < 2; ++kt)
#pragma unroll
                    for (int ks = 0; ks < 4; ++ks) fr8[kt * 4 + ks] = *(const f16x8*)(kb_ + kt * 32 * ATP + ks * 32);
                f32x16 sa[2];
                if (j == cw) {
#pragma unroll
                    for (int kt = 0; kt < 2; ++kt)
#pragma unroll
                        for (int rg = 0; rg < 16; ++rg) { const float x = (float)(64 * j + 32 * kt + 16 * (rg >> 3) + 8 * hh + (rg & 7) - tq); sa[kt][rg] = rowc - slope * fabsf(x); }
                } else {
                    const float base = OFF + slope * (float)(64 * j + 8 * hh - q0l);
#pragma unroll
                    for (int kt = 0; kt < 2; ++kt)
#pragma unroll
                        for (int rg = 0; rg < 16; ++rg) sa[kt][rg] = __builtin_fmaf(slope, (float)(32 * kt + 16 * (rg >> 3) + (rg & 7)), base);
                }
                __builtin_amdgcn_sched_barrier(0);
                __builtin_amdgcn_s_setprio(1);
#pragma unroll
                for (int kt = 0; kt < 2; ++kt)
#pragma unroll
                    for (int ks = 0; ks < 4; ++ks) sa[kt] = __builtin_amdgcn_mfma_f32_32x32x16_f16(fr8[kt * 4 + ks], qf[ks], sa[kt], 0, 0, 0);
                __builtin_amdgcn_s_setprio(0);
                __builtin_amdgcn_sched_barrier(0);
                const unsigned char* vb_ = Vl + buf * 64 * ATP + r * ATP + 16 * hh;
#pragma unroll
                for (int dt = 0; dt < 2; ++dt)
#pragma unroll
                    for (int kt = 0; kt < 2; ++kt)
#pragma unroll
                        for (int s2 = 0; s2 < 2; ++s2) fr8[dt * 4 + kt * 2 + s2] = *(const f16x8*)(vb_ + dt * 32 * ATP + kt * 64 + s2 * 32);
                __builtin_amdgcn_sched_barrier(0);
                float rm = 0.f;
#pragma unroll
                for (int kt = 0; kt < 2; ++kt) { const unsigned w32 = (unsigned)(kt ? (mw >> 32) : mw) >> (8 * hh);
#pragma unroll
                    for (int rg = 0; rg < 16; ++rg) { const int tm = __builtin_amdgcn_sbfe((int)w32, 16 * (rg >> 3) + (rg & 7), 1);
                        const float L = __int_as_float(__float_as_int(sa[kt][rg]) & tm); sa[kt][rg] = L; rm = fmaxf(rm, L); } }
                rm = fmaxf(rm, __shfl_xor(rm, 32));
                const float mn = fmaxf(m, rm);
                if (__any(mn > m)) { const float al = __builtin_amdgcn_exp2f(m - mn); l *= al;
#pragma unroll
                    for (int dt = 0; dt < 2; ++dt)
#pragma unroll
                        for (int rg = 0; rg < 16; ++rg) O[dt][rg] *= al; }
                m = mn;
                f16x8 pf[2][2];
                float l0 = 0.f, l1 = 0.f;
#pragma unroll
                for (int kt = 0; kt < 2; ++kt)
#pragma unroll
                    for (int rg = 0; rg < 16; ++rg) { const float pp = __builtin_amdgcn_exp2f(sa[kt][rg] - m); if (rg & 1) l1 += pp; else l0 += pp; pf[kt][rg >> 3][rg & 7] = (f16)pp; }
                l += l0 + l1;
                __builtin_amdgcn_sched_barrier(0);
                __builtin_amdgcn_s_setprio(1);
#pragma unroll
                for (int dt = 0; dt < 2; ++dt)
#pragma unroll
                    for (int kt = 0; kt < 2; ++kt)
#pragma unroll
                        for (int s2 = 0; s2 < 2; ++s2) O[dt] = __builtin_amdgcn_mfma_f32_32x32x16_f16(fr8[dt * 4 + kt * 2 + s2], pf[kt][s2], O[dt], 0, 0, 0);
                __builtin_amdgcn_s_setprio(0);
            }
            buf ^= 1;
        };
        for (int j = top; j >= 0; j -= 2) {
            step(kr0, vr0, mw0, j); if (stop) break;
            if (j - 1 >= 0) { step(kr1, vr1, mw1, j - 1); if (stop) break; }
        }
#undef ATT_LOAD
        l += __shfl_xor(l, 32);
        const float inv = 1.f / l;
        float ss = 0.f;
#pragma unroll
        for (int dt = 0; dt < 2; ++dt)
#pragma unroll
            for (int rg = 0; rg < 16; ++rg) { O[dt][rg] *= inv; ss += O[dt][rg] * O[dt][rg]; }
        ss += __shfl_xor(ss, 32);
        const float rstd = rsqrtf(ss * (1.f / 64.f) + EPS);
#pragma unroll
        for (int dt = 0; dt < 2; ++dt)
#pragma unroll
            for (int g4 = 0; g4 < 4; ++g4) { const int d = 32 * dt + 8 * g4 + 4 * hh; const f32x4 gg = *(const f32x4*)(og + h * 64 + d);
                f16x4 o4; o4.x = (f16)(O[dt][4 * g4 + 0] * rstd * gg.x); o4.y = (f16)(O[dt][4 * g4 + 1] * rstd * gg.y); o4.z = (f16)(O[dt][4 * g4 + 2] * rstd * gg.z); o4.w = (f16)(O[dt][4 * g4 + 3] * rstd * gg.w);
                *(f16x4*)(MIX + t * ND + 512 + h * 64 + d) = o4; }
        __syncthreads();
    }
}

__device__ __forceinline__ void ph5_outproj(const Args& a, int bid, int nb, unsigned char* lds) {
    pg8::Gemm g{(const f16*)(a.ws + WS_H), (const f16*)(a.ws + WS_WOUT), NT, 1024, ND}; pg8::StaticOrder S; S.init(NT, 1024, nb, bid);
    pg8::EpiOut E{a.in[0], (const float*)(a.ws + WS_MOD), a.out};
    pg8::gemm_phase((PG8_LAS unsigned char*)lds, g, S, E);
}

__device__ __forceinline__ void ph7_peerq(const Args& a, int bid, int nb, unsigned char* lds) {
    pg8::Gemm g{(const f16*)(a.ws + WS_H), (const f16*)(a.ws + WS_WQ), NT, 2048, ND}; pg8::StaticOrder S; S.init(NT, 2048, nb, bid);
    pg8::EpiPQ E{(f16*)(a.ws + WS_PQ)};
    pg8::gemm_phase((PG8_LAS unsigned char*)lds, g, S, E);
}


__device__ __forceinline__ unsigned f2skey(float f) { const unsigned u = __float_as_uint(f); return (u & 0x80000000u) ? ~u : (u | 0x80000000u); }
__device__ __forceinline__ float skey2f(unsigned k) { return __uint_as_float((k & 0x80000000u) ? (k & 0x7FFFFFFFu) : ~k); }
#define CE_(a_, b_) do { const unsigned t__ = max(a_, b_); b_ = min(a_, b_); a_ = t__; } while (0)
#define SORT16_DESC(v) do { CE_(v[0], v[1]); CE_(v[2], v[3]); CE_(v[0], v[2]); CE_(v[1], v[3]); CE_(v[1], v[2]); CE_(v[4], v[5]); CE_(v[6], v[7]); CE_(v[4], v[6]); CE_(v[5], v[7]); CE_(v[5], v[6]); CE_(v[0], v[4]); CE_(v[2], v[6]); CE_(v[2], v[4]); CE_(v[1], v[5]); CE_(v[3], v[7]); CE_(v[3], v[5]); CE_(v[1], v[2]); CE_(v[3], v[4]); CE_(v[5], v[6]); CE_(v[8], v[9]); CE_(v[10], v[11]); CE_(v[8], v[10]); CE_(v[9], v[11]); CE_(v[9], v[10]); CE_(v[12], v[13]); CE_(v[14], v[15]); CE_(v[12], v[14]); CE_(v[13], v[15]); CE_(v[13], v[14]); CE_(v[8], v[12]); CE_(v[10], v[14]); CE_(v[10], v[12]); CE_(v[9], v[13]); CE_(v[11], v[15]); CE_(v[11], v[13]); CE_(v[9], v[10]); CE_(v[11], v[12]); CE_(v[13], v[14]); CE_(v[0], v[8]); CE_(v[4], v[12]); CE_(v[4], v[8]); CE_(v[2], v[10]); CE_(v[6], v[14]); CE_(v[6], v[10]); CE_(v[2], v[4]); CE_(v[6], v[8]); CE_(v[10], v[12]); CE_(v[1], v[9]); CE_(v[5], v[13]); CE_(v[5], v[9]); CE_(v[3], v[11]); CE_(v[7], v[15]); CE_(v[7], v[11]); CE_(v[3], v[5]); CE_(v[7], v[9]); CE_(v[11], v[13]); CE_(v[1], v[2]); CE_(v[3], v[4]); CE_(v[5], v[6]); CE_(v[7], v[8]); CE_(v[9], v[10]); CE_(v[11], v[12]); CE_(v[13], v[14]); } while (0)
#define BITONIC16_DESC(v) do { CE_(v[0], v[8]); CE_(v[1], v[9]); CE_(v[2], v[10]); CE_(v[3], v[11]); CE_(v[4], v[12]); CE_(v[5], v[13]); CE_(v[6], v[14]); CE_(v[7], v[15]); CE_(v[0], v[4]); CE_(v[1], v[5]); CE_(v[2], v[6]); CE_(v[3], v[7]); CE_(v[8], v[12]); CE_(v[9], v[13]); CE_(v[10], v[14]); CE_(v[11], v[15]); CE_(v[0], v[2]); CE_(v[1], v[3]); CE_(v[4], v[6]); CE_(v[5], v[7]); CE_(v[8], v[10]); CE_(v[9], v[11]); CE_(v[12], v[14]); CE_(v[13], v[15]); CE_(v[0], v[1]); CE_(v[2], v[3]); CE_(v[4], v[5]); CE_(v[6], v[7]); CE_(v[8], v[9]); CE_(v[10], v[11]); CE_(v[12], v[13]); CE_(v[14], v[15]); } while (0)
#define MERGE16_DESC(dst, other) do { unsigned c__[16]; _Pragma("unroll") for (int i__ = 0; i__ < 16; ++i__) c__[i__] = max(dst[i__], other[15 - i__]); BITONIC16_DESC(c__); _Pragma("unroll") for (int i__ = 0; i__ < 16; ++i__) dst[i__] = c__[i__]; } while (0)
#define TOP16_INSERT(v, x_) do { unsigned x__ = (x_); _Pragma("unroll") for (int k_ = 0; k_ < 16; ++k_) { const unsigned t__ = max(v[k_], x__); x__ = min(v[k_], x__); v[k_] = t__; } } while (0)
__device__ __forceinline__ void ph8_peersel_fast(const Args& a, int bid, int nb, unsigned char* lds) {
    int tid = threadIdx.x; asm volatile("" : "+v"(tid));
    const int lane = tid & 63, wave = __builtin_amdgcn_readfirstlane(tid >> 6), r = lane & 31, hh = lane >> 5;
    const f16* PQ = (const f16*)(a.ws + WS_PQ); const f16* SK = (const f16*)(a.ws + WS_SK);
    u16* EID = (u16*)(a.ws + WS_EID); float* GW = (float*)(a.ws + WS_GW);
    unsigned char* wl = lds + wave * 2048 + lane * 32;
    for (int item = bid * NWAVE + wave; item < (NT / 32) * 8; item += nb * NWAVE) {
        const int tt = item >> 3, h = item & 7, t0 = tt * 32;
        unsigned top[2][16];
#pragma unroll
        for (int p = 0; p < 2; ++p) {
            f16x8 bq[8];
#pragma unroll
            for (int ks = 0; ks < 8; ++ks) bq[ks] = *(const f16x8*)(PQ + (size_t)(t0 + r) * 2048 + h * 256 + p * 128 + 16 * ks + 8 * hh);
#pragma unroll
            for (int k = 0; k < 16; ++k) top[p][k] = 0u;
            const f16* skb = SK + (size_t)((h * 2 + p) * 128 + r) * 128 + 8 * hh;
            f16x8 afa[8], afb[8];
#pragma unroll
            for (int ks = 0; ks < 8; ++ks) afa[ks] = *(const f16x8*)(skb + 16 * ks);
#define P8_TILE(AF, nt_) do { f32x16 acc = (f32x16){0.f, 0.f, 0.f, 0.f, 0.f, 0.f, 0.f, 0.f, 0.f, 0.f, 0.f, 0.f, 0.f, 0.f, 0.f, 0.f}; \
                _Pragma("unroll") for (int ks = 0; ks < 8; ++ks) acc = __builtin_amdgcn_mfma_f32_32x32x16_f16(AF[ks], bq[ks], acc, 0, 0, 0); \
                const unsigned nb0 = 32 * (nt_) + 4 * hh; \
                unsigned ky[16]; \
                _Pragma("unroll") for (int rg = 0; rg < 16; ++rg) { const unsigned n = nb0 + (rg & 3) + 8 * (rg >> 2); ky[rg] = (f2skey(acc[rg]) & ~127u) | n; } \
                SORT16_DESC(ky); MERGE16_DESC(top[p], ky); } while (0)
#pragma unroll 1
            for (int np = 0; np < 2; ++np) {
#pragma unroll
                for (int ks = 0; ks < 8; ++ks) afb[ks] = *(const f16x8*)(skb + (size_t)(2 * np + 1) * 32 * 128 + 16 * ks);
                P8_TILE(afa, 2 * np);
                const int nn = (np == 0) ? 2 : 3;
#pragma unroll
                for (int ks = 0; ks < 8; ++ks) afa[ks] = *(const f16x8*)(skb + (size_t)nn * 32 * 128 + 16 * ks);
                P8_TILE(afb, 2 * np + 1);
            }
#undef P8_TILE
            unsigned oth[16];
#pragma unroll
            for (int k = 0; k < 16; ++k) oth[k] = __shfl_xor(top[p][k], 32);
            MERGE16_DESC(top[p], oth);
            asm volatile("" ::: "memory");
        }
#pragma unroll
        for (int k = 0; k < 16; k += 4) {
            *(unsigned*)(wl + k) = (top[0][k] & 127u) | ((top[0][k + 1] & 127u) << 8) | ((top[0][k + 2] & 127u) << 16) | ((top[0][k + 3] & 127u) << 24);
            *(unsigned*)(wl + 16 + k) = (top[1][k] & 127u) | ((top[1][k + 1] & 127u) << 8) | ((top[1][k + 2] & 127u) << 16) | ((top[1][k + 3] & 127u) << 24);
        }
        float fa[16], fb[16];
#pragma unroll
        for (int k = 0; k < 16; ++k) { fa[k] = skey2f(top[0][k] & ~127u); fb[k] = skey2f(top[1][k] & ~127u); }
        unsigned cg[4][16];
        cg[0][0] = (f2skey(fa[0] + fb[0]) & ~255u) | 0u;
        cg[0][1] = (f2skey(fa[0] + fb[1]) & ~255u) | 1u;
        cg[0][2] = (f2skey(fa[0] + fb[2]) & ~255u) | 2u;
        cg[0][3] = (f2skey(fa[0] + fb[3]) & ~255u) | 3u;
        cg[0][4] = (f2skey(fa[0] + fb[4]) & ~255u) | 4u;
        cg[0][5] = (f2skey(fa[0] + fb[5]) & ~255u) | 5u;
        cg[0][6] = (f2skey(fa[0] + fb[6]) & ~255u) | 6u;
        cg[0][7] = (f2skey(fa[0] + fb[7]) & ~255u) | 7u;
        cg[0][8] = (f2skey(fa[0] + fb[8]) & ~255u) | 8u;
        cg[0][9] = (f2skey(fa[0] + fb[9]) & ~255u) | 9u;
        cg[0][10] = (f2skey(fa[0] + fb[10]) & ~255u) | 10u;
        cg[0][11] = (f2skey(fa[0] + fb[11]) & ~255u) | 11u;
        cg[0][12] = (f2skey(fa[0] + fb[12]) & ~255u) | 12u;
        cg[0][13] = (f2skey(fa[0] + fb[13]) & ~255u) | 13u;
        cg[0][14] = (f2skey(fa[0] + fb[14]) & ~255u) | 14u;
        cg[0][15] = (f2skey(fa[0] + fb[15]) & ~255u) | 15u;
        cg[1][0] = (f2skey(fa[1] + fb[0]) & ~255u) | 16u;
        cg[1][1] = (f2skey(fa[1] + fb[1]) & ~255u) | 17u;
        cg[1][2] = (f2skey(fa[1] + fb[2]) & ~255u) | 18u;
        cg[1][3] = (f2skey(fa[1] + fb[3]) & ~255u) | 19u;
        cg[1][4] = (f2skey(fa[1] + fb[4]) & ~255u) | 20u;
        cg[1][5] = (f2skey(fa[1] + fb[5]) & ~255u) | 21u;
        cg[1][6] = (f2skey(fa[1] + fb[6]) & ~255u) | 22u;
        cg[1][7] = (f2skey(fa[1] + fb[7]) & ~255u) | 23u;
        cg[1][8] = (f2skey(fa[2] + fb[0]) & ~255u) | 32u;
        cg[1][9] = (f2skey(fa[2] + fb[1]) & ~255u) | 33u;
        cg[1][10] = (f2skey(fa[2] + fb[2]) & ~255u) | 34u;
        cg[1][11] = (f2skey(fa[2] + fb[3]) & ~255u) | 35u;
        cg[1][12] = (f2skey(fa[2] + fb[4]) & ~255u) | 36u;
        cg[1][13] = (f2skey(fa[3] + fb[0]) & ~255u) | 48u;
        cg[1][14] = (f2skey(fa[3] + fb[1]) & ~255u) | 49u;
        cg[1][15] = (f2skey(fa[3] + fb[2]) & ~255u) | 50u;
        cg[2][0] = (f2skey(fa[3] + fb[3]) & ~255u) | 51u;
        cg[2][1] = (f2skey(fa[4] + fb[0]) & ~255u) | 64u;
        cg[2][2] = (f2skey(fa[4] + fb[1]) & ~255u) | 65u;
        cg[2][3] = (f2skey(fa[4] + fb[2]) & ~255u) | 66u;
        cg[2][4] = (f2skey(fa[5] + fb[0]) & ~255u) | 80u;
        cg[2][5] = (f2skey(fa[5] + fb[1]) & ~255u) | 81u;
        cg[2][6] = (f2skey(fa[6] + fb[0]) & ~255u) | 96u;
        cg[2][7] = (f2skey(fa[6] + fb[1]) & ~255u) | 97u;
        cg[2][8] = (f2skey(fa[7] + fb[0]) & ~255u) | 112u;
        cg[2][9] = (f2skey(fa[7] + fb[1]) & ~255u) | 113u;
        cg[2][10] = (f2skey(fa[8] + fb[0]) & ~255u) | 128u;
        cg[2][11] = (f2skey(fa[9] + fb[0]) & ~255u) | 144u;
        cg[2][12] = (f2skey(fa[10] + fb[0]) & ~255u) | 160u;
        cg[2][13] = (f2skey(fa[11] + fb[0]) & ~255u) | 176u;
        cg[2][14] = (f2skey(fa[12] + fb[0]) & ~255u) | 192u;
        cg[2][15] = (f2skey(fa[13] + fb[0]) & ~255u) | 208u;
        cg[3][0] = (f2skey(fa[14] + fb[0]) & ~255u) | 224u;
        cg[3][1] = (f2skey(fa[15] + fb[0]) & ~255u) | 240u;
        cg[3][2] = 0u;
        cg[3][3] = 0u;
        cg[3][4] = 0u;
        cg[3][5] = 0u;
        cg[3][6] = 0u;
        cg[3][7] = 0u;
        cg[3][8] = 0u;
        cg[3][9] = 0u;
        cg[3][10] = 0u;
        cg[3][11] = 0u;
        cg[3][12] = 0u;
        cg[3][13] = 0u;
        cg[3][14] = 0u;
        cg[3][15] = 0u;
        SORT16_DESC(cg[0]); SORT16_DESC(cg[1]); SORT16_DESC(cg[2]); SORT16_DESC(cg[3]);
        MERGE16_DESC(cg[0], cg[1]); MERGE16_DESC(cg[2], cg[3]); MERGE16_DESC(cg[0], cg[2]);
        unsigned ct[16];
#pragma unroll
        for (int k = 0; k < 16; ++k) ct[k] = cg[0][k];
        float sc[16]; float den = 0.f; const float s0 = skey2f(ct[0] & ~255u);
#pragma unroll
        for (int k = 0; k < 16; ++k) { sc[k] = __expf(skey2f(ct[k] & ~255u) - s0); den += sc[k]; }
        const float inv = 1.f / den;
        if (hh == 0) {
            u16 ev[16];
#pragma unroll
            for (int k = 0; k < 16; ++k) { const unsigned ij = ct[k] & 255u; const unsigned i1 = wl[ij >> 4], i2 = wl[16 + (ij & 15u)]; ev[k] = (u16)(i1 * 128u + i2); }
            const size_t o = (size_t)(t0 + r) * 128 + h * 16;
#pragma unroll
            for (int k = 0; k < 16; k += 8) {
                *(u32x4*)(EID + o + k) = (u32x4){(unsigned)ev[k] | ((unsigned)ev[k + 1] << 16), (unsigned)ev[k + 2] | ((unsigned)ev[k + 3] << 16), (unsigned)ev[k + 4] | ((unsigned)ev[k + 5] << 16), (unsigned)ev[k + 6] | ((unsigned)ev[k + 7] << 16)};
            }
#pragma unroll
            for (int k = 0; k < 16; k += 4) *(f32x4*)(GW + o + k) = (f32x4){sc[k] * inv, sc[k + 1] * inv, sc[k + 2] * inv, sc[k + 3] * inv};
        }
    }
}

typedef _Float16 f16x2 __attribute__((ext_vector_type(2)));
__device__ __forceinline__ float gelu_erf(float d) { return 0.5f * d * (1.f + erff(d * 0.70710678118654752f)); }
constexpr int PQ_WORD0 = 3584, PQ_CHUNK = 64, PQ_NCHUNK = NT / PQ_CHUNK;
constexpr size_t WS_PART = 208 * MiB;
__device__ __forceinline__ unsigned xcc_id_() { return (unsigned)__builtin_amdgcn_s_getreg((3 << 11) | 20) & 7u; }
template <int VPHASE>
__device__ __forceinline__ void ph9_sliced(const Args& a, unsigned char* lds) {
    int tid_ = threadIdx.x; asm volatile("" : "+v"(tid_)); const int lane = tid_ & 63, wave = __builtin_amdgcn_readfirstlane(tid_ >> 6);
    const int g8 = lane >> 3, c16 = lane & 7;
    const f16* H2 = (const f16*)(a.ws + WS_H); const unsigned char* TAB = a.ws + (VPHASE ? WS_VP : WS_UT);
    const u16* EID = (const u16*)(a.ws + WS_EID); const float* GW = (const float*)(a.ws + WS_GW); float* PART = (float*)(a.ws + WS_PART);
    const float* mod = (const float*)(a.ws + WS_MOD); float* out = a.out;
    unsigned* qw = (unsigned*)(a.ws + WS_CTL) + PQ_WORD0 + (VPHASE ? 8 * 64 : 0);
    volatile unsigned* cslot = (volatile unsigned*)lds;
    const bool b5 = (lane & 32) != 0, b4 = (lane & 16) != 0, b3 = (lane & 8) != 0, b2 = (lane & 4) != 0, b1 = (lane & 2) != 0, b0 = (lane & 1) != 0;
    const unsigned x0 = xcc_id_();
    int par = 0;
    for (int k = 0; k < 8; ++k) {
        const unsigned sl = (x0 + (unsigned)k) & 7u;
        unsigned cur = 0u;
        if (tid_ == 0) cur = __hip_atomic_fetch_add(qw + 64 * sl, 1u, __ATOMIC_RELAXED, __HIP_MEMORY_SCOPE_AGENT);
        for (;;) {
            if (tid_ == 0) cslot[par] = cur;
            __syncthreads();
            const unsigned c = cslot[par]; par ^= 1;
            if (c >= (unsigned)PQ_NCHUNK) break;
            if (tid_ == 0) cur = __hip_atomic_fetch_add(qw + 64 * sl, 1u, __ATOMIC_RELAXED, __HIP_MEMORY_SCOPE_AGENT);
            const int tb = (int)c * PQ_CHUNK + wave * (PQ_CHUNK / NWAVE);
            const unsigned char* tsl = TAB + 128 * sl + 16 * c16;
#pragma unroll 1
            for (int i8 = 0; i8 < PQ_CHUNK / NWAVE; ++i8) {
                const int t = tb + i8;
                const u32x4 e0 = *(const u32x4*)(EID + (size_t)t * 128 + 16 * g8), e1 = *(const u32x4*)(EID + (size_t)t * 128 + 16 * g8 + 8);
                const unsigned ew[8] = {e0.x, e0.y, e0.z, e0.w, e1.x, e1.y, e1.z, e1.w};
                u32x4 r8[16];
#pragma unroll
                for (int i = 0; i < 16; ++i) { const unsigned eid = (i & 1) ? (ew[i >> 1] >> 16) : (ew[i >> 1] & 0xFFFFu); r8[i] = *(const u32x4*)(tsl + (size_t)eid * ND); }
                if (!VPHASE) {
                    const u32x4 hq0 = *(const u32x4*)(H2 + (size_t)t * ND + 128 * sl + 16 * c16), hq1 = *(const u32x4*)(H2 + (size_t)t * ND + 128 * sl + 16 * c16 + 8);
                    const unsigned hp[8] = {hq0.x, hq0.y, hq0.z, hq0.w, hq1.x, hq1.y, hq1.z, hq1.w};
                    float p[16];
#pragma unroll
                    for (int i = 0; i < 16; ++i) { float d = 0.f;
#pragma unroll
                        for (int j = 0; j < 4; ++j) { const unsigned lo = __builtin_amdgcn_perm(r8[i][j], r8[i][j], 0x010C000Cu), hi = __builtin_amdgcn_perm(r8[i][j], r8[i][j], 0x030C020Cu);
                            d = __builtin_amdgcn_fdot2(__builtin_bit_cast(f16x2, hp[2 * j]), __builtin_bit_cast(f16x2, lo), d, false);
                            d = __builtin_amdgcn_fdot2(__builtin_bit_cast(f16x2, hp[2 * j + 1]), __builtin_bit_cast(f16x2, hi), d, false); }
                        p[i] = d; }
                    float q8[8], q4[4], r2[2];
#pragma unroll
                    for (int ii = 0; ii < 8; ++ii) { const float keep = b2 ? p[8 + ii] : p[ii], send = b2 ? p[ii] : p[8 + ii]; q8[ii] = keep + __shfl_xor(send, 4); }
#pragma unroll
                    for (int ii = 0; ii < 4; ++ii) { const float keep = b1 ? q8[4 + ii] : q8[ii], send = b1 ? q8[ii] : q8[4 + ii]; q4[ii] = keep + __shfl_xor(send, 2); }
#pragma unroll
                    for (int ii = 0; ii < 2; ++ii) { const float keep = b0 ? q4[2 + ii] : q4[ii], send = b0 ? q4[ii] : q4[2 + ii]; r2[ii] = keep + __shfl_xor(send, 1); }
                    *(f32x2*)(PART + ((size_t)sl * NT + t) * 128 + 16 * g8 + 2 * c16) = (f32x2){r2[0], r2[1]};
                } else {
                    const float* wp = GW + (size_t)t * 128 + 16 * g8;
                    const f32x4 wq0 = *(const f32x4*)wp, wq1 = *(const f32x4*)(wp + 4), wq2 = *(const f32x4*)(wp + 8), wq3 = *(const f32x4*)(wp + 12);
                    const float wv[16] = {wq0[0], wq0[1], wq0[2], wq0[3], wq1[0], wq1[1], wq1[2], wq1[3], wq2[0], wq2[1], wq2[2], wq2[3], wq3[0], wq3[1], wq3[2], wq3[3]};
                    f16x2 acc2[8];
#pragma unroll
                    for (int j = 0; j < 8; ++j) acc2[j] = (f16x2){(f16)0.f, (f16)0.f};
#pragma unroll
                    for (int i = 0; i < 16; ++i) { const f16x2 w2 = (f16x2){(f16)wv[i], (f16)wv[i]};
#pragma unroll
                        for (int j = 0; j < 4; ++j) { const unsigned lo = __builtin_amdgcn_perm(r8[i][j], r8[i][j], 0x010C000Cu), hi = __builtin_amdgcn_perm(r8[i][j], r8[i][j], 0x030C020Cu);
                            acc2[2 * j] = __builtin_elementwise_fma(w2, __builtin_bit_cast(f16x2, lo), acc2[2 * j]);
                            acc2[2 * j + 1] = __builtin_elementwise_fma(w2, __builtin_bit_cast(f16x2, hi), acc2[2 * j + 1]); } }
                    float acc[16];
#pragma unroll
                    for (int j = 0; j < 8; ++j) { acc[2 * j] = (float)acc2[j][0]; acc[2 * j + 1] = (float)acc2[j][1]; }
                    float q8[8], q4[4], r2[2];
#pragma unroll
                    for (int ii = 0; ii < 8; ++ii) { const float keep = b5 ? acc[8 + ii] : acc[ii], send = b5 ? acc[ii] : acc[8 + ii]; q8[ii] = keep + __shfl_xor(send, 32); }
#pragma unroll
                    for (int ii = 0; ii < 4; ++ii) { const float keep = b4 ? q8[4 + ii] : q8[ii], send = b4 ? q8[ii] : q8[4 + ii]; q4[ii] = keep + __shfl_xor(send, 16); }
#pragma unroll
                    for (int ii = 0; ii < 2; ++ii) { const float keep = b3 ? q4[2 + ii] : q4[ii], send = b3 ? q4[ii] : q4[2 + ii]; r2[ii] = keep + __shfl_xor(send, 8); }
                    const int ch = 128 * sl + 16 * c16 + 2 * g8;
                    float* op = out + (size_t)t * ND + ch; const float* g2 = mod + (t / NS) * 6144 + 5120 + ch;
                    const f32x2 o2 = *(const f32x2*)op, gg = *(const f32x2*)g2;
                    *(f32x2*)op = o2 + gg * ((f32x2){r2[0], r2[1]} * (1.f / PEER_VSCALE));
                }
            }
        }
    }
}
__device__ __forceinline__ void ph9b_combine(const Args& a, int bid, int nb) {
    int tid_ = threadIdx.x; asm volatile("" : "+v"(tid_));
    float* GW = (float*)(a.ws + WS_GW); const float* PART = (const float*)(a.ws + WS_PART);
    for (size_t i = (size_t)bid * NTHR + tid_; i < (size_t)NT * 128 / 4; i += (size_t)nb * NTHR) {
        f32x4 sum = ((const f32x4*)PART)[i];
#pragma unroll
        for (int sidx = 1; sidx < 8; ++sidx) sum += ((const f32x4*)(PART + (size_t)sidx * NT * 128))[i];
        const f32x4 g = ((const f32x4*)GW)[i];
        f32x4 w;
#pragma unroll
        for (int j = 0; j < 4; ++j) w[j] = g[j] * gelu_erf(sum[j] * (1.f / PEER_USCALE));
        ((f32x4*)GW)[i] = w;
    }
}

#define LAS __attribute__((address_space(3)))
#define XB_TMO      128
#define XB_XCNT(j)  (256  + 64 * (j))
#define XB_XSUB(j)  (1280 + 64 * (j))
#define XB_XGEN(j)  (2304 + 64 * (j))
#define XB_TOP      3328
#define XB_TOPGEN   3392
#define XCD_BAR_WORDS 3456
#define XB_SPIN_CAP (1u << 18)
__device__ __forceinline__ unsigned xb_ld(unsigned* p)              { return __hip_atomic_load(p, __ATOMIC_RELAXED, __HIP_MEMORY_SCOPE_AGENT); }
__device__ __forceinline__ unsigned xb_add(unsigned* p, unsigned v) { return __hip_atomic_fetch_add(p, v, __ATOMIC_RELAXED, __HIP_MEMORY_SCOPE_AGENT); }
__device__ __forceinline__ unsigned xb_xcc_id() { return (unsigned)__builtin_amdgcn_s_getreg((3 << 11) | 20) & 0xFu; }
#define XB_SPIN(cond, bar) do { unsigned _sp = 0; while (cond) { __builtin_amdgcn_s_sleep(1); \
    if ((++_sp & 255u) == 0u) { if (xb_ld(&(bar)[XB_TMO])) break; if (_sp > XB_SPIN_CAP) { atomicAdd(&(bar)[XB_TMO], 1u); break; } } } } while (0)
struct XcdBarrier { unsigned* bar; unsigned x; volatile LAS unsigned* st; };
__device__ __forceinline__ XcdBarrier xcd_barrier_post(unsigned* bar, volatile LAS unsigned* st) {
    XcdBarrier b; b.bar = bar; b.x = xb_xcc_id(); b.st = st;
    if (threadIdx.x == 0) (void)xb_add(&bar[XB_XCNT(b.x)], 1u);
    return b;
}
__device__ __forceinline__ void xcd_barrier_complete(unsigned* bar, unsigned x, unsigned& nloc, unsigned& nx) {
    const unsigned G = gridDim.x * gridDim.y * gridDim.z;
    unsigned sum, cnt, mine, sp = 0u;
    for (;;) {
        sum = 0u; cnt = 0u; mine = 0u;
#pragma unroll
        for (unsigned j = 0; j < 16; ++j) { const unsigned c = xb_ld(&bar[XB_XCNT(j)]); sum += c; cnt += (c > 0u) ? 1u : 0u; mine = (j == x) ? c : mine; }
        if (sum == G) break;
        __builtin_amdgcn_s_sleep(1);
        if ((++sp & 255u) == 0u) { if (xb_ld(&bar[XB_TMO])) break; if (sp > XB_SPIN_CAP) { atomicAdd(&bar[XB_TMO], 1u); break; } }
    }
    nloc = mine > 0u ? mine : 1u; nx = cnt > 0u ? cnt : 1u;
}
__device__ __forceinline__ void xcd_barrier(const XcdBarrier& b) {
    asm volatile("s_waitcnt vmcnt(0)" ::: "memory");
    __syncthreads();
    if (threadIdx.x == 0) {
        unsigned* bar = b.bar;
        __builtin_amdgcn_s_waitcnt(0);
        unsigned nloc = b.st[0], nx = b.st[1];
        if (nloc == 0u) { xcd_barrier_complete(bar, b.x, nloc, nx); b.st[0] = nloc; b.st[1] = nx; }
        const unsigned old = xb_add(&bar[XB_XSUB(b.x)], 1u);
        const unsigned gen = old / nloc;
        if (old + 1u == (gen + 1u) * nloc) {
            __builtin_amdgcn_fence(__ATOMIC_RELEASE, "agent");
            asm volatile("s_waitcnt vmcnt(0)" ::: "memory");
            const unsigned og = xb_add(&bar[XB_TOP], 1u);
            const unsigned tg = og / nx;
            if (og + 1u == (tg + 1u) * nx) xb_add(&bar[XB_TOPGEN], 1u);
            else XB_SPIN(xb_ld(&bar[XB_TOPGEN]) == tg, bar);
            __builtin_amdgcn_fence(__ATOMIC_ACQUIRE, "agent");
            xb_add(&bar[XB_XGEN(b.x)], 1u);
            asm volatile("s_waitcnt vmcnt(0)" ::: "memory");
        } else {
            XB_SPIN(xb_ld(&bar[XB_XGEN(b.x)]) == gen, bar);
            __builtin_amdgcn_fence(__ATOMIC_ACQUIRE, "agent");
            asm volatile("s_waitcnt vmcnt(0)" ::: "memory");
        }
    }
    __syncthreads();
}

constexpr int N_PHASES = 12;
__global__ void __launch_bounds__(NTHR, 2) mk_fwd(Args a) {
    extern __shared__ __attribute__((aligned(16))) unsigned char lds[];
    cg::grid_group grid = cg::this_grid();
    const int bid = blockIdx.x, nb = gridDim.x;
    const int lo = a.ph_lo, hi = a.ph_hi;
    volatile LAS unsigned* bst = (volatile LAS unsigned*)((LAS unsigned char*)lds + (LDS_BYTES - 16));
    if (threadIdx.x < 4) bst[threadIdx.x] = 0u;
    __syncthreads();
    XcdBarrier xbar = xcd_barrier_post((unsigned*)(a.ws + WS_CTL), bst);
#ifndef PROBE_PH
#define PROBE_PH -1
#endif
#define SEAM(k) do { if ((k) == 0) grid.sync(); else xcd_barrier(xbar); } while (0)
#define PHASE(k, body) if (lo <= (k) && (k) < hi) { for (int rep_ = 0; rep_ < ((k) == PROBE_PH ? 2 : 1); ++rep_) { body; if ((k) + 1 < hi || rep_ == 0 && (k) == PROBE_PH) SEAM(k); } }
    PHASE(0, ph0_prologue(a, bid, nb, lds))
    PHASE(1, row_norm_mod(a.in[0], a.in[4], (const float*)(a.ws + WS_MOD), 0, 1024, (f16*)(a.ws + WS_H), bid, nb))
    PHASE(2, ph2_inproj(a, bid, nb, lds))
    PHASE(3, ph3_pool_fast(a, bid, nb, lds); if (PROBE_PH == 30) ph3_pool_fast(a, bid, nb, lds); if (PROBE_PH == 31) ph3_index_fast<0>(a, bid, nb, lds); if (PROBE_PH == 32) ph3_index_fast<1>(a, bid, nb, lds); if (PROBE_PH == 33) ph3_index_fast<2>(a, bid, nb, lds); if (PROBE_PH == 34) ph3_index_fast<3>(a, bid, nb, lds); if (PROBE_PH == 35) ph3_index_fast<4>(a, bid, nb, lds); ph3_index_fast<0>(a, bid, nb, lds))
    PHASE(4, if (PROBE_PH == 41) ph4_attn_fast<1>(a, bid, nb, lds); if (PROBE_PH == 42) ph4_attn_fast<2>(a, bid, nb, lds); if (PROBE_PH == 43) ph4_attn_fast<3>(a, bid, nb, lds); if (PROBE_PH == 40) ph4_attn_fast<0>(a, bid, nb, lds); ph4_attn_fast<0>(a, bid, nb, lds))
    PHASE(5, ph5_outproj(a, bid, nb, lds))
    PHASE(6, row_norm_mod(a.out, a.in[13], (const float*)(a.ws + WS_MOD), 3072, 4096, (f16*)(a.ws + WS_H), bid, nb))
    PHASE(7, ph7_peerq(a, bid, nb, lds))
    PHASE(8, ph8_peersel_fast(a, bid, nb, lds))
    PHASE(9, ph9_sliced<0>(a, lds))
    PHASE(10, ph9b_combine(a, bid, nb))
    PHASE(11, ph9_sliced<1>(a, lds))
#undef PHASE
}

extern "C" void kernel_launch(void* const* d_in, const int* in_sizes, int n_in, void* d_out, int out_size, void* d_ws, size_t ws_size, hipStream_t stream) {
    static int grid = 0;
    if (grid == 0) {
        if (n_in != 18 || out_size != NT * ND || ws_size < WS_END) { fprintf(stderr, "kernel_launch: unexpected shapes (n_in %d out %d ws %zu)\n", n_in, out_size, ws_size); grid = -1; return; }
        int dev = 0, cus = 0, per_cu = 0;
        hipGetDevice(&dev); hipDeviceGetAttribute(&cus, hipDeviceAttributeMultiprocessorCount, dev);
        hipFuncSetAttribute((const void*)mk_fwd, hipFuncAttributeMaxDynamicSharedMemorySize, LDS_BYTES);
        hipOccupancyMaxActiveBlocksPerMultiprocessor(&per_cu, (const void*)mk_fwd, NTHR, LDS_BYTES);
        if (per_cu < 1) { fprintf(stderr, "kernel_launch: occupancy query says %d blocks/CU\n", per_cu); per_cu = 1; }
        grid = cus * 1;
        (void)hipGetLastError();
    }
    if (grid < 0) return;
    if (hipMemsetAsync((char*)d_ws + WS_CTL, 0, 32768, stream) != hipSuccess) { fprintf(stderr, "kernel_launch: memset of the barrier words failed\n"); return; }
    Args a{};
    for (int i = 0; i < 18; ++i) a.in[i] = (const float*)d_in[i];
    a.out = (float*)d_out; a.ws = (unsigned char*)d_ws;
#if MK_MULTI
    for (int ph = 0; ph < N_PHASES; ++ph) { a.ph_lo = ph; a.ph_hi = ph + 1; hipLaunchKernelGGL(mk_fwd, dim3(grid), dim3(NTHR), LDS_BYTES, stream, a); }
#else
    a.ph_lo = 0; a.ph_hi = N_PHASES;
    void* args[] = {&a};
    hipError_t e = hipLaunchCooperativeKernel((const void*)mk_fwd, dim3(grid), dim3(NTHR), args, LDS_BYTES, stream);
    if (e != hipSuccess) fprintf(stderr, "cooperative launch failed: %s (grid %d)\n", hipGetErrorString(e), grid);
#endif
}
```

```cpp
#include <hip/hip_runtime.h>
#include <hip/hip_cooperative_groups.h>
#include <cstdio>
#include <cstdint>
namespace cg = cooperative_groups;

#ifndef MK_MULTI
#define MK_MULTI 0
#endif

typedef _Float16 f16;
typedef _Float16 f16x8 __attribute__((ext_vector_type(8)));
typedef _Float16 f16x4 __attribute__((ext_vector_type(4)));
typedef float f32x4 __attribute__((ext_vector_type(4)));
typedef unsigned long long u64;
typedef unsigned short u16;

constexpr int NB = 8, NS = 8192, ND = 1024, NT = NB * NS;
constexpr int INW = 2632;
constexpr int NMAIN = 2304;
constexpr float EPS = 1e-6f;
constexpr int NTHR = 512, NWAVE = 8;

constexpr size_t MiB = 1u << 20;
constexpr size_t WS_CTL = 0;
constexpr size_t WS_MOD = 1 * MiB;
constexpr size_t WS_WIN = 2 * MiB;
constexpr size_t WS_WVT = 7 * MiB;
constexpr size_t WS_WOUT = 8 * MiB;
constexpr size_t WS_WQ = 10 * MiB;
constexpr size_t WS_SK = 14 * MiB;
constexpr size_t WS_PW = 14 * MiB + 512 * 1024;
constexpr size_t WS_UT = 16 * MiB;
constexpr size_t WS_VP = 48 * MiB;
constexpr size_t WS_H = 80 * MiB;
constexpr size_t WS_U = 208 * MiB;
constexpr size_t WS_Q = 272 * MiB;
constexpr size_t WS_K = 336 * MiB;
constexpr size_t WS_VT = 400 * MiB;
constexpr size_t WS_PQ = 208 * MiB;
constexpr size_t WS_QI = 464 * MiB;
constexpr size_t WS_KI = 528 * MiB;
constexpr size_t WS_WI = 536 * MiB;
constexpr size_t WS_MASK = 544 * MiB;
constexpr size_t WS_EID = 608 * MiB;
constexpr size_t WS_GW = 624 * MiB;
constexpr size_t WS_END = 656 * MiB;

constexpr int LDS_BYTES = 155648;
constexpr float PEER_USCALE = 256.f, PEER_VSCALE = 16.f;

struct Args { const float* in[18]; float* out; unsigned char* ws; int ph_lo, ph_hi; };

__host__ __device__ __forceinline__ int pos2log(int p) { return 64 * ((p >> 5) & 3) + 32 * (p >> 7) + 8 * ((p >> 2) & 3) + 4 * ((p >> 4) & 1) + (p & 3); }
__device__ __forceinline__ int maincol(int L) { if (L < 1536) return L; if (L < 2120) return L + 512; return -1; }

__device__ __forceinline__ float wave_sum(float v) {
#pragma unroll
    for (int o = 1; o < 64; o <<= 1) v += __shfl_xor(v, o);
    return v;
}
__device__ __forceinline__ float wave_max(float v) {
#pragma unroll
    for (int o = 1; o < 64; o <<= 1) v = fmaxf(v, __shfl_xor(v, o));
    return v;
}

__device__ void ph0_prologue(const Args& a, int bid, int nb, unsigned char* lds) {
    int tid = threadIdx.x; asm volatile("" : "+v"(tid));
    const float* c = a.in[1]; const float* ada_w = a.in[2]; const float* ada_b = a.in[3];
    float* sil = (float*)lds;
    for (int i = tid; i < NB * ND; i += NTHR) { const float v = c[i]; sil[i] = v / (1.f + __expf(-v)); }
    __syncthreads();
    float* mod = (float*)(a.ws + WS_MOD);
    const int gt = bid * NTHR + tid, ngt = nb * NTHR;
    for (int o = gt; o < NB * 6144; o += ngt) {
        const int b = o / 6144, j = o % 6144;
        float acc = ada_b[j];
        const float* sb = sil + b * ND;
        for (int k = 0; k < ND; ++k) acc += sb[k] * ada_w[(size_t)k * 6144 + j];
        mod[o] = acc;
    }
    const float* w_in = a.in[5]; const float* pool_w = a.in[6]; const float* w_out = a.in[12];
    const float* wq = a.in[14]; const float* sk = a.in[15]; const float* pu = a.in[16]; const float* pv = a.in[17];
    f16* WIN = (f16*)(a.ws + WS_WIN); f16* WVT = (f16*)(a.ws + WS_WVT); f16* WOUT = (f16*)(a.ws + WS_WOUT); f16* WQ = (f16*)(a.ws + WS_WQ);
    f16* SK = (f16*)(a.ws + WS_SK); f16* PW = (f16*)(a.ws + WS_PW); unsigned char* UT = a.ws + WS_UT; unsigned char* VP = a.ws + WS_VP;
    {
        __syncthreads();
        const int lane = tid & 63, wv_ = tid >> 6;
        float* scr = (float*)lds + wv_ * (64 * 33);
        constexpr int I_IN = 16 * (NMAIN / 32), I_VT = 16 * 16, I_OUT = 16 * 32, I_WQ = 16 * 64, I_ALL = I_IN + I_VT + I_OUT + I_WQ;
        for (int it = bid * NWAVE + wv_; it < I_ALL; it += nb * NWAVE) {
            int rr = it, kind = 0;
            if (rr >= I_IN) { rr -= I_IN; kind = 1; if (rr >= I_VT) { rr -= I_VT; kind = 2; if (rr >= I_OUT) { rr -= I_OUT; kind = 3; } } }
            const int npb = kind == 0 ? NMAIN / 32 : kind == 1 ? 16 : kind == 2 ? 32 : 64;
            const int k0 = (rr / npb) * 64, p0 = (rr % npb) * 32, p = p0 + (lane & 31);
            const float* W = kind <= 1 ? w_in : kind == 2 ? w_out : wq; const int ldw = kind <= 1 ? INW : kind == 2 ? 1024 : 2048;
            int col;
            if (kind == 0) col = maincol((p & ~255) + pos2log(p & 255)); else if (kind == 1) col = 1536 + p; else col = (p & ~255) + pos2log(p & 255);
#pragma unroll 8
            for (int i = 0; i < 32; ++i) { const int kk = 2 * i + (lane >> 5); scr[kk * 33 + (lane & 31)] = col >= 0 ? W[(size_t)(k0 + kk) * ldw + col] : 0.f; }
            f16* WT = kind == 0 ? WIN : kind == 1 ? WVT : kind == 2 ? WOUT : WQ;
            const int c8 = lane & 7;
#pragma unroll
            for (int j = 0; j < 4; ++j) { const int n = (lane >> 3) + 8 * j; const float* sp = scr + (8 * c8) * 33 + n;
                *(f16x8*)(WT + (size_t)(p0 + n) * ND + k0 + 8 * c8) = (f16x8){(f16)sp[0], (f16)sp[33], (f16)sp[66], (f16)sp[99], (f16)sp[132], (f16)sp[165], (f16)sp[198], (f16)sp[231]}; }
        }
    }
    for (int i = gt; i < 8 * 2 * 128 * 128; i += ngt) { const int hp = i >> 14, n = (i >> 7) & 127, d = i & 127;
        SK[((((hp * 4 + (n >> 5)) * 8 + (d >> 4)) * 2 + ((d >> 3) & 1)) * 32 + (n & 31)) * 8 + (d & 7)] = (f16)sk[i]; }
    for (int i = gt; i < 4 * 128 * 128; i += ngt) { const int g = i >> 14, cc = (i >> 7) & 127, d = i & 127;
        PW[(((((g * 8 + (d >> 4)) * 4 + (cc >> 5)) * 4 + ((cc >> 3) & 3)) * 16 + (d & 15)) << 3) + (cc & 7)] = (f16)pool_w[i]; }
    for (int i = gt; i < 16384 * 1024 / 4; i += ngt) { const f32x4 u = ((const f32x4*)pu)[i] * PEER_USCALE, v = ((const f32x4*)pv)[i] * PEER_VSCALE;
        int pu8 = __builtin_amdgcn_cvt_pk_bf8_f32(u.x, u.y, 0, false); pu8 = __builtin_amdgcn_cvt_pk_bf8_f32(u.z, u.w, pu8, true);
        int pv8 = __builtin_amdgcn_cvt_pk_bf8_f32(v.x, v.y, 0, false); pv8 = __builtin_amdgcn_cvt_pk_bf8_f32(v.z, v.w, pv8, true);
        ((int*)UT)[i] = pu8; ((int*)VP)[i] = pv8; }
}

__device__ void row_norm_mod(const float* src, const float* g, const float* mod, int sh_off, int sc_off, f16* dst, int bid, int nb) {
    int tid_ = threadIdx.x; asm volatile("" : "+v"(tid_)); const int lane = tid_ & 63, wave = tid_ >> 6;
    for (int row = bid * NWAVE + wave; row < NT; row += nb * NWAVE) {
        const int b = row / NS;
        const f32x4* xr = (const f32x4*)(src + (size_t)row * ND) + lane;
        f32x4 v[4]; float s = 0.f;
#pragma unroll
        for (int j = 0; j < 4; ++j) { v[j] = xr[64 * j]; s += v[j].x * v[j].x + v[j].y * v[j].y + v[j].z * v[j].z + v[j].w * v[j].w; }
        const float rstd = rsqrtf(wave_sum(s) * (1.f / ND) + EPS);
#pragma unroll
        for (int j = 0; j < 4; ++j) {
            const int col = lane * 4 + 256 * j;
            const f32x4 gg = *(const f32x4*)(g + col), sc = *(const f32x4*)(mod + b * 6144 + sc_off + col), sh = *(const f32x4*)(mod + b * 6144 + sh_off + col);
            f16x4 o;
            o.x = (f16)(v[j].x * rstd * gg.x * (1.f + sc.x) + sh.x); o.y = (f16)(v[j].y * rstd * gg.y * (1.f + sc.y) + sh.y);
            o.z = (f16)(v[j].z * rstd * gg.z * (1.f + sc.z) + sh.z); o.w = (f16)(v[j].w * rstd * gg.w * (1.f + sc.w) + sh.w);
            *(f16x4*)(dst + (size_t)row * ND + col) = o;
        }
    }
}


namespace pg8 {
#define PG8_LAS __attribute__((address_space(3)))
constexpr int BM = 256, BK = 64, HALF = 128, HTB = HALF * BK * 2, STAGE_BYTES = 8 * HTB, NXCD = 8, WGM = 8;
__host__ __device__ __forceinline__ int lds_byte(int r, int c) { const int st = (r >> 4) * 2 + (c >> 5), rr = r & 15, cc = c & 31, ob = rr * 64 + cc * 2; return st * 1024 + (ob ^ (((ob >> 9) & 1) << 5)); }
__host__ __device__ __forceinline__ void stage_rc(int b, int& R, int& C) { const int st = b / 1024, sb = b % 1024, swz = sb ^ (((sb >> 9) & 1) << 5); R = (st >> 1) * 16 + swz / 64; C = (st & 1) * 32 + (swz % 64) / 2; }
struct Unit { int pm, pn; };
struct Gemm { const f16* A; const f16* Bt; int M, N, K; };
struct StaticOrder {
    int nM, nN, nwg, G, c;
    __host__ __device__ void init(int M, int N, int G_, int c_) { nM = M / BM; nN = N / BM; nwg = nM * nN; G = G_; c = c_; }
    __host__ __device__ bool next(int i, Unit& u) const {
        const long L = (long)i * G + c; if (L >= nwg) return false;
        int wgid = (int)L; { const int q = nwg / NXCD, r = nwg % NXCD, xcd = wgid % NXCD, off = wgid / NXCD; wgid = (xcd < r ? xcd * (q + 1) : r * (q + 1) + (xcd - r) * q) + off; }
        const int nig = WGM * nN, gid = wgid / nig, fm = gid * WGM, gsz = (nM - fm) < WGM ? (nM - fm) : WGM;
        u.pm = fm + ((wgid % nig) % gsz); u.pn = (wgid % nig) / gsz; return true;
    }
};
template <class Epi>
__device__ __forceinline__ void gemm_phase(PG8_LAS unsigned char* lds, const Gemm g, const StaticOrder& S, const Epi& E) {
    int tid = threadIdx.x; asm volatile("" : "+v"(tid));
    const int wid = __builtin_amdgcn_readfirstlane(tid >> 6), lane = tid & 63, wr = wid >> 2, wc = wid & 3, fr = lane & 15, fq = lane >> 4;
    const int K = g.K, nt = K / BK;
    unsigned voffA[2];
#pragma unroll
    for (int i = 0; i < 2; ++i) { int R, C; stage_rc(tid * 16 + i * 8192, R, C); voffA[i] = (unsigned)(R * K + C) * 2u; }
    const size_t kstep = (size_t)(BK * 2);
    const size_t hstep = (size_t)HALF * K * 2;
    const size_t tstep = 2 * hstep;
    const unsigned ldsw = (unsigned)wid * 1024u;
    const int aoff = lds_byte(wr * 64 + fr, fq * 8), boff = lds_byte(wc * 32 + fr, fq * 8);
#define PG8_SA(b, h) (((b) * 2 + (h)) * HTB)
#define PG8_SB(b, h) ((4 + (b) * 2 + (h)) * HTB)
#define PG8_STAGE(bufoff, gbase, voff) do { _Pragma("unroll") for (int _i = 0; _i < 2; ++_i) \
        __builtin_amdgcn_global_load_lds((const unsigned*)((const char*)(gbase) + (voff)[_i]), (PG8_LAS unsigned*)(lds + (bufoff) + ldsw + _i * 8192), 16, 0, 0); } while (0)
#define PG8_LDA(dst, b, h) do { _Pragma("unroll") for (int m = 0; m < 4; ++m) _Pragma("unroll") for (int k = 0; k < 2; ++k) dst[m][k] = *(const PG8_LAS f16x8*)(lds + PG8_SA(b, h) + aoff + m * 2048 + k * 1024); } while (0)
#define PG8_LDB(dst, b, h) do { _Pragma("unroll") for (int n = 0; n < 2; ++n) _Pragma("unroll") for (int k = 0; k < 2; ++k) dst[n][k] = *(const PG8_LAS f16x8*)(lds + PG8_SB(b, h) + boff + n * 2048 + k * 1024); } while (0)
#define PG8_MMA(ai, bj, At, Bt) do { __builtin_amdgcn_s_setprio(1); _Pragma("unroll") for (int m = 0; m < 4; ++m) _Pragma("unroll") for (int n = 0; n < 2; ++n) _Pragma("unroll") for (int k = 0; k < 2; ++k) \
        acc[ai][bj][m][n] = __builtin_amdgcn_mfma_f32_16x16x32_f16(Bt[n][k], At[m][k], acc[ai][bj][m][n], 0, 0, 0); __builtin_amdgcn_s_setprio(0); } while (0)
#define PG8_WAIT_V(n) asm volatile("s_waitcnt vmcnt(" #n ")" ::: "memory")
#define PG8_WAIT_L(n) asm volatile("s_waitcnt lgkmcnt(" #n ")" ::: "memory")
#define PG8_BAR __builtin_amdgcn_s_barrier()
#define PG8_SCHED __builtin_amdgcn_sched_barrier(0)
    Unit cur, nxt; int ui = 0;
    if (!S.next(0, cur)) return;
    f32x4 acc[2][2][4][2];
#pragma unroll
    for (int a = 0; a < 2; ++a)
#pragma unroll
        for (int b = 0; b < 2; ++b)
#pragma unroll
            for (int m = 0; m < 4; ++m)
#pragma unroll
                for (int n = 0; n < 2; ++n) acc[a][b][m][n] = (f32x4){0.f, 0.f, 0.f, 0.f};
    f16x8 At[4][2], B0[2][2], B1[2][2];
    const char* cA = (const char*)g.A + (size_t)cur.pm * tstep; const char* cB = (const char*)g.Bt + (size_t)cur.pn * tstep;
    PG8_STAGE(PG8_SB(0, 0), cB, voffA); PG8_STAGE(PG8_SB(0, 1), cB + hstep, voffA); PG8_STAGE(PG8_SA(0, 0), cA, voffA); PG8_STAGE(PG8_SA(0, 1), cA + hstep, voffA);
    if (wr == 1) PG8_BAR;
    PG8_WAIT_V(2); PG8_BAR;
    PG8_STAGE(PG8_SB(1, 0), cB + kstep, voffA); PG8_STAGE(PG8_SA(1, 0), cA + kstep, voffA); PG8_STAGE(PG8_SB(1, 1), cB + hstep + kstep, voffA);
    PG8_WAIT_V(6); PG8_BAR;
    for (;;) {
        const bool has_next = S.next(ui + 1, nxt);
        const char* nA = has_next ? (const char*)g.A + (size_t)nxt.pm * tstep : cA; const char* nB = has_next ? (const char*)g.Bt + (size_t)nxt.pn * tstep : cB;
        for (int t = 0; t < nt; t += 2) {
            const bool last = (t == nt - 2);
            const char* a1 = cA + (size_t)(t + 1) * kstep;
            const char* a2 = last ? nA : cA + (size_t)(t + 2) * kstep; const char* b2 = last ? nB : cB + (size_t)(t + 2) * kstep;
            const char* a3 = a2 + kstep; const char* b3 = b2 + kstep;
            PG8_LDB(B0, 0, 0); PG8_LDB(B1, 0, 1); PG8_SCHED; PG8_LDA(At, 0, 0); PG8_STAGE(PG8_SA(1, 1), a1 + hstep, voffA);
            PG8_WAIT_V(8); PG8_WAIT_L(0); PG8_BAR; PG8_MMA(0, 0, At, B0); PG8_MMA(0, 1, At, B1); PG8_BAR; PG8_SCHED;
            PG8_LDA(At, 0, 1); PG8_STAGE(PG8_SB(0, 0), b2, voffA); PG8_STAGE(PG8_SB(0, 1), b2 + hstep, voffA); PG8_STAGE(PG8_SA(0, 0), a2, voffA);
            PG8_WAIT_V(8); PG8_WAIT_L(0); PG8_BAR; PG8_MMA(1, 0, At, B0); PG8_MMA(1, 1, At, B1); PG8_BAR; PG8_SCHED;
            PG8_LDB(B0, 1, 0); PG8_LDB(B1, 1, 1); PG8_SCHED; PG8_LDA(At, 1, 0); PG8_STAGE(PG8_SA(0, 1), a2 + hstep, voffA);
            PG8_WAIT_V(8); PG8_WAIT_L(0); PG8_BAR; PG8_MMA(0, 0, At, B0); PG8_MMA(0, 1, At, B1); PG8_BAR; PG8_SCHED;
            PG8_LDA(At, 1, 1); PG8_STAGE(PG8_SB(1, 0), b3, voffA); PG8_STAGE(PG8_SB(1, 1), b3 + hstep, voffA); PG8_STAGE(PG8_SA(1, 0), a3, voffA);
            PG8_WAIT_V(8); PG8_WAIT_L(0); PG8_BAR; PG8_MMA(1, 0, At, B0); PG8_MMA(1, 1, At, B1); PG8_BAR; PG8_SCHED;
        }
        if (wr == 0) PG8_BAR;
        E(acc, cur, wr, wc, fr, fq);
        if (!has_next) break;
#pragma unroll
        for (int a = 0; a < 2; ++a)
#pragma unroll
            for (int b = 0; b < 2; ++b)
#pragma unroll
                for (int m = 0; m < 4; ++m)
#pragma unroll
                    for (int n = 0; n < 2; ++n) acc[a][b][m][n] = (f32x4){0.f, 0.f, 0.f, 0.f};
        cur = nxt; cA = nA; cB = nB; ++ui;
        if (wr == 1) PG8_BAR;
    }
    PG8_WAIT_V(0);
    PG8_BAR;
#undef PG8_SA
#undef PG8_SB
#undef PG8_STAGE
#undef PG8_LDA
#undef PG8_LDB
#undef PG8_MMA
#undef PG8_WAIT_V
#undef PG8_WAIT_L
#undef PG8_BAR
#undef PG8_SCHED
}

typedef f32x4 Acc[2][2][4][2];
struct EpiMain {
    unsigned char* ws; const float *qg, *kg;
    __device__ __forceinline__ void operator()(const Acc& acc, const Unit& u, int wr, int wc, int fr, int fq) const {
        const int row0 = u.pm * BM + wr * 64 + fr, pn = u.pn;
        if (pn == 8) {
            if (wc == 0) {
#pragma unroll
                for (int ai = 0; ai < 2; ++ai)
#pragma unroll
                    for (int m = 0; m < 4; ++m) { const size_t row = row0 + ai * HALF + m * 16;
#pragma unroll
                        for (int bj = 0; bj < 2; ++bj) { const f32x4 v0 = acc[ai][bj][m][0], v1 = acc[ai][bj][m][1];
                            *(f16x8*)((f16*)(ws + WS_KI) + (((row >> 5) * 8 + 4 * bj + fq) * 32 + (row & 31)) * 8) = (f16x8){(f16)v0[0], (f16)v0[1], (f16)v0[2], (f16)v0[3], (f16)v1[0], (f16)v1[1], (f16)v1[2], (f16)v1[3]}; } }
            } else if (wc == 1 && fq == 0) {
#pragma unroll
                for (int ai = 0; ai < 2; ++ai)
#pragma unroll
                    for (int m = 0; m < 4; ++m) { const size_t row = row0 + ai * HALF + m * 16;
                        *(f32x4*)((float*)(ws + WS_WI) + row * 8) = acc[ai][0][m][0] * 0.35355339059327373f; *(f32x4*)((float*)(ws + WS_WI) + row * 8 + 4) = acc[ai][0][m][1] * 0.35355339059327373f; }
            }
            return;
        }
        const int kind = pn >> 1;
        f16* base = (f16*)(ws + (kind == 0 ? WS_U : kind == 1 ? WS_Q : kind == 2 ? WS_K : WS_QI));
        const int col0 = (pn & 1) * 256 + 64 * wc + 8 * fq;
        if (kind == 1 || kind == 2) {
            const float* gp = (kind == 1 ? qg : kg) + 8 * fq;
#pragma unroll
            for (int ai = 0; ai < 2; ++ai)
#pragma unroll
                for (int m = 0; m < 4; ++m) { const size_t row = row0 + ai * HALF + m * 16;
                    float ss = 0.f;
#pragma unroll
                    for (int bj = 0; bj < 2; ++bj)
#pragma unroll
                        for (int n = 0; n < 2; ++n) { const f32x4 v = acc[ai][bj][m][n]; ss += v[0] * v[0] + v[1] * v[1] + v[2] * v[2] + v[3] * v[3]; }
                    ss += __shfl_xor(ss, 16); ss += __shfl_xor(ss, 32);
                    const float rstd = rsqrtf(ss * (1.f / 64.f) + EPS);
#pragma unroll
                    for (int bj = 0; bj < 2; ++bj) { const f32x4 v0 = acc[ai][bj][m][0] * rstd * *(const f32x4*)(gp + 32 * bj), v1 = acc[ai][bj][m][1] * rstd * *(const f32x4*)(gp + 32 * bj + 4);
                        *(f16x8*)(base + row * 512 + col0 + 32 * bj) = (f16x8){(f16)v0[0], (f16)v0[1], (f16)v0[2], (f16)v0[3], (f16)v1[0], (f16)v1[1], (f16)v1[2], (f16)v1[3]}; }
                    asm volatile("" ::: "memory"); }
        } else if (kind == 3) {
            const int hd = (pn & 1) * 4 + wc;
#pragma unroll
            for (int ai = 0; ai < 2; ++ai)
#pragma unroll
                for (int m = 0; m < 4; ++m) { const size_t row = row0 + ai * HALF + m * 16; const int ql = (int)(row & 7);
                    const int rr = (hd & 3) | (((ql >> 1) & 1) << 2) | ((hd >> 2) << 3) | ((ql & 1) << 4);
#pragma unroll
                    for (int bj = 0; bj < 2; ++bj) { const f32x4 v0 = acc[ai][bj][m][0], v1 = acc[ai][bj][m][1]; const int chunk = fq + 4 * bj;
                        *(f16x8*)(base + ((((((row >> 3) * 2 + (ql >> 2)) * 4 + (chunk >> 1)) * 2 + (chunk & 1)) * 32 + rr) << 3)) = (f16x8){(f16)v0[0], (f16)v0[1], (f16)v0[2], (f16)v0[3], (f16)v1[0], (f16)v1[1], (f16)v1[2], (f16)v1[3]}; } }
        } else {
#pragma unroll
            for (int ai = 0; ai < 2; ++ai)
#pragma unroll
                for (int m = 0; m < 4; ++m) { const size_t row = row0 + ai * HALF + m * 16;
#pragma unroll
                    for (int bj = 0; bj < 2; ++bj) { const f32x4 v0 = acc[ai][bj][m][0], v1 = acc[ai][bj][m][1];
                        *(f16x8*)(base + row * 512 + col0 + 32 * bj) = (f16x8){(f16)v0[0], (f16)v0[1], (f16)v0[2], (f16)v0[3], (f16)v1[0], (f16)v1[1], (f16)v1[2], (f16)v1[3]}; } }
        }
    }
};
struct EpiVT {
    f16* VT;
    __device__ __forceinline__ void operator()(const Acc& acc, const Unit& u, int wr, int wc, int fr, int fq) const {
        const int row0 = u.pm * BM + wr * 64 + fr, col0 = u.pn * BM + 32 * wc + 4 * fq;
#pragma unroll
        for (int ai = 0; ai < 2; ++ai)
#pragma unroll
            for (int m = 0; m < 4; ++m) { const size_t row = row0 + ai * HALF + m * 16;
#pragma unroll
                for (int bj = 0; bj < 2; ++bj)
#pragma unroll
                    for (int n = 0; n < 2; ++n) { const f32x4 v = acc[ai][bj][m][n];
                        *(f16x4*)(VT + row * NT + col0 + 128 * bj + 16 * n) = (f16x4){(f16)v[0], (f16)v[1], (f16)v[2], (f16)v[3]}; } }
    }
};
struct EpiOut {
    const float* x; const float* mod; float* out;
    __device__ __forceinline__ void operator()(const Acc& acc, const Unit& u, int wr, int wc, int fr, int fq) const {
        const int row0 = u.pm * BM + wr * 64 + fr, col0 = u.pn * BM + 64 * wc + 8 * fq;
        const float* g1 = mod + ((u.pm * BM) / NS) * 6144 + 2048 + col0;
        f32x4 g4[2][2];
#pragma unroll
        for (int bj = 0; bj < 2; ++bj)
#pragma unroll
            for (int n = 0; n < 2; ++n) g4[bj][n] = *(const f32x4*)(g1 + 32 * bj + 4 * n);
#pragma unroll
        for (int ai = 0; ai < 2; ++ai)
#pragma unroll
            for (int m = 0; m < 4; ++m) { const size_t off = (size_t)(row0 + ai * HALF + m * 16) * ND + col0;
#pragma unroll
                for (int bj = 0; bj < 2; ++bj)
#pragma unroll
                    for (int n = 0; n < 2; ++n) { const f32x4 xv = *(const f32x4*)(x + off + 32 * bj + 4 * n);
                        *(f32x4*)(out + off + 32 * bj + 4 * n) = xv + g4[bj][n] * acc[ai][bj][m][n]; } }
    }
};
struct EpiPQ {
    f16* PQ;
    __device__ __forceinline__ void operator()(const Acc& acc, const Unit& u, int wr, int wc, int fr, int fq) const {
        const int row0 = u.pm * BM + wr * 64 + fr, col0 = u.pn * BM + 64 * wc + 8 * fq;
#pragma unroll
        for (int ai = 0; ai < 2; ++ai)
#pragma unroll
            for (int m = 0; m < 4; ++m) { const size_t row = row0 + ai * HALF + m * 16;
#pragma unroll
                for (int bj = 0; bj < 2; ++bj) { const f32x4 v0 = acc[ai][bj][m][0], v1 = acc[ai][bj][m][1];
                    *(f16x8*)(PQ + ((((row >> 5) * 256 + ((col0 + 32 * bj) >> 3)) * 32 + (row & 31)) << 3)) = (f16x8){(f16)v0[0], (f16)v0[1], (f16)v0[2], (f16)v0[3], (f16)v1[0], (f16)v1[1], (f16)v1[2], (f16)v1[3]}; } }
    }
};
}

__device__ __forceinline__ void ph2_inproj(const Args& a, int bid, int nb, unsigned char* lds) {
    const f16* H = (const f16*)(a.ws + WS_H); const f16* WIN = (const f16*)(a.ws + WS_WIN); const f16* WVT = (const f16*)(a.ws + WS_WVT);
    PG8_LAS unsigned char* l3 = (PG8_LAS unsigned char*)lds;
    { pg8::Gemm g{H, WIN, NT, NMAIN, ND}; pg8::StaticOrder S; S.init(NT, NMAIN, nb, bid);
      pg8::EpiMain E{a.ws, a.in[9], a.in[10]};
      pg8::gemm_phase(l3, g, S, E); }
    { pg8::Gemm g{WVT, H, 512, NT, ND}; pg8::StaticOrder S; S.init(512, NT, nb, bid);
      pg8::EpiVT E{(f16*)(a.ws + WS_VT)};
      pg8::gemm_phase(l3, g, S, E); }
}


constexpr int PPITCH = 1040;
__device__ __forceinline__ void ph3_pool_fast(const Args& a, int bid, int nb, unsigned char* lds) {
    int tid = threadIdx.x; asm volatile("" : "+v"(tid));
    const int lane = tid & 63, wave = __builtin_amdgcn_readfirstlane(tid >> 6), fr = lane & 15, fq = lane >> 4;
    const f16* U = (const f16*)(a.ws + WS_U); const f16* PW = (const f16*)(a.ws + WS_PW); f16* MIX = (f16*)(a.ws + WS_H);
    const float* pscale = a.in[7]; const float* pg = a.in[8];
    float* red = (float*)(lds + 32 * PPITCH);
    typedef _Float16 h2 __attribute__((ext_vector_type(2)));
    for (int item = bid; item < NT / 32; item += nb) {
        const int t0 = item * 32;
        __syncthreads();
        {
            const int cg8 = tid & 63, tq = tid >> 6, gch = cg8 >> 4, win = 2 << gch;
            const int tb = t0 + 4 * tq, tl0 = tb % NS;
            const f16* up = U + (size_t)(tb - tl0) * 512 + 8 * cg8;
            float sm[8];
#pragma unroll
            for (int j = 0; j < 8; ++j) sm[j] = 0.f;
            f16x8 hist_[15];
#pragma unroll
            for (int q = 0; q < 15; ++q) { const int rr = tl0 - 15 + q; hist_[q] = (q >= 16 - win && rr >= 0) ? *(const f16x8*)(up + (size_t)rr * 512) : (f16x8){0, 0, 0, 0, 0, 0, 0, 0}; }
            f16x8 cur_[4];
#pragma unroll
            for (int k = 0; k < 4; ++k) cur_[k] = *(const f16x8*)(up + (size_t)(tl0 + k) * 512);
#pragma unroll
            for (int q = 0; q < 15; ++q)
#pragma unroll
                for (int j = 0; j < 8; ++j) sm[j] += (float)hist_[q][j];
#pragma unroll
            for (int k = 0; k < 4; ++k) {
                const int tl = tl0 + k;
                const float ic = 1.f / (float)((tl + 1 < win) ? tl + 1 : win);
                f16x8 o;
#pragma unroll
                for (int j = 0; j < 8; ++j) { sm[j] += (float)cur_[k][j]; o[j] = (f16)(sm[j] * ic - (float)cur_[k][j]); }
                *(f16x8*)(lds + (4 * tq + k) * PPITCH + 16 * cg8) = o;
                if (k < 3) {
#pragma unroll
                    for (int j = 0; j < 8; ++j) {
                        float dv;
                        const int q = 16 - win + k;
                        dv = 0.f;
#pragma unroll
                        for (int qq = 0; qq < 15; ++qq) if (qq == q) dv = (float)hist_[qq][j];
#pragma unroll
                        for (int kk = 0; kk < 3; ++kk) if (q == 15 + kk) dv = (float)cur_[kk][j];
                        sm[j] -= dv;
                    }
                }
            }
        }
        __syncthreads();
        const int g = wave >> 1, th = wave & 1;
        f32x4 acc[8];
#pragma unroll
        for (int nt = 0; nt < 8; ++nt) acc[nt] = (f32x4){0.f, 0.f, 0.f, 0.f};
#pragma unroll
        for (int ks = 0; ks < 4; ++ks) {
            const f16x8 bf = *(const f16x8*)(lds + (16 * th + fr) * PPITCH + (g * 128 + 32 * ks + 8 * fq) * 2);
#pragma unroll
            for (int nt = 0; nt < 8; ++nt) { const f16x8 af = *(const f16x8*)(PW + (((((g * 8 + nt) * 4 + ks) * 4 + fq) * 16 + fr) << 3));
                acc[nt] = __builtin_amdgcn_mfma_f32_16x16x32_f16(af, bf, acc[nt], 0, 0, 0); }
        }
        float ss = 0.f;
#pragma unroll
        for (int nt = 0; nt < 8; ++nt) { const f32x4 sc = *(const f32x4*)(pscale + g * 128 + 16 * nt + 4 * fq); acc[nt] = acc[nt] * sc;
            ss += acc[nt][0] * acc[nt][0] + acc[nt][1] * acc[nt][1] + acc[nt][2] * acc[nt][2] + acc[nt][3] * acc[nt][3]; }
        ss += __shfl_xor(ss, 16); ss += __shfl_xor(ss, 32);
        if (fq == 0) red[(16 * th + fr) * 4 + g] = ss;
        __syncthreads();
        const f32x4 r4 = *(const f32x4*)(red + (16 * th + fr) * 4);
        const float rstd = rsqrtf((r4[0] + r4[1] + r4[2] + r4[3]) * (1.f / 512.f) + EPS);
        const size_t orow = (size_t)(t0 + 16 * th + fr) * ND + g * 128 + 4 * fq;
#pragma unroll
        for (int nt = 0; nt < 8; ++nt) { const f32x4 gg = *(const f32x4*)(pg + g * 128 + 16 * nt + 4 * fq); const f32x4 v = acc[nt] * rstd * gg;
            *(f16x4*)(MIX + orow + 16 * nt) = (f16x4){(f16)v[0], (f16)v[1], (f16)v[2], (f16)v[3]}; }
    }
    __syncthreads();
}


typedef float f32x16 __attribute__((ext_vector_type(16)));
typedef float f32x2 __attribute__((ext_vector_type(2)));
typedef unsigned u32x4 __attribute__((ext_vector_type(4)));

constexpr int IDX_KPITCH = 16384 + 16;
constexpr int IDX_HPITCH = 516;
template <int NBL>
__device__ __forceinline__ int wave_pick(const unsigned (&cc)[NBL], unsigned target, int lane, unsigned& rem_out) {
    unsigned tot = 0u;
#pragma unroll
    for (int j = 0; j < NBL; ++j) tot += cc[j];
    unsigned S = tot;
#pragma unroll
    for (int o = 1; o < 64; o <<= 1) { const unsigned v = __shfl_down(S, o); if (lane + o < 64) S += v; }
    const unsigned above = S - tot;
    const bool hit = (above < target) && (S >= target);
    const u64 bal = __ballot(hit);
    const int L = bal ? __builtin_ctzll(bal) : 0;
    int bin = 0; unsigned rem = target;
    { unsigned run = above; bool done = false;
#pragma unroll
      for (int j = NBL - 1; j >= 0; --j) { if (!done) { if (run + cc[j] >= target) { bin = NBL * lane + j; rem = target - run; done = true; } else run += cc[j]; } } }
    bin = __shfl(bin, L); rem_out = __shfl(rem, L);
    return bin;
}
template <int MODE>
__device__ __forceinline__ void ph3_index_fast(const Args& a, int bid, int nb, unsigned char* lds) {
    int tid = threadIdx.x; asm volatile("" : "+v"(tid));
    const int lane = tid & 63, wave = __builtin_amdgcn_readfirstlane(tid >> 6), r = lane & 31, hh = lane >> 5;
    const f16* QI = (const f16*)(a.ws + WS_QI); const f16* KI = (const f16*)(a.ws + WS_KI); const float* WI = (const float*)(a.ws + WS_WI);
    u64* MASK = (u64*)(a.ws + WS_MASK);
    unsigned* hist = (unsigned*)(lds + 8 * IDX_KPITCH);
    f16x8 af[2][4]; f32x2 wv2[2][8];
#define IDX_LOAD_FRAGS(t0_) do { \
        _Pragma("unroll") for (int rt = 0; rt < 2; ++rt) { \
            _Pragma("unroll") for (int ks = 0; ks < 4; ++ks) af[rt][ks] = *(const f16x8*)(QI + ((((((size_t)((t0_) >> 3) * 2 + rt) * 4 + ks) * 2 + hh) * 32 + r) << 3)); \
            _Pragma("unroll") for (int qq = 0; qq < 2; ++qq) { const float* wp = WI + (size_t)((t0_) + 4 * rt + 2 * hh + qq) * 8; const f32x4 w0 = *(const f32x4*)wp * 0.125f, w1 = *(const f32x4*)(wp + 4) * 0.125f; \
                wv2[rt][4 * qq + 0] = (f32x2){w0[0], w0[1]}; wv2[rt][4 * qq + 1] = (f32x2){w0[2], w0[3]}; wv2[rt][4 * qq + 2] = (f32x2){w1[0], w1[1]}; wv2[rt][4 * qq + 3] = (f32x2){w1[2], w1[3]}; } \
        } } while (0)
    for (int round = 0; round * nb < 256; ++round) {
        const int p = round * nb + ((round & 1) ? (nb - 1 - bid) : bid);
        if (p < 256) { const int tg = p >> 3, b_ = p & 7, t0l = tg * 8, ch_ = t0l >> 6, t0_ = b_ * NS + t0l;
            if (tid < 8 * (ch_ + 1)) { const int q = tid / (ch_ + 1), w = tid % (ch_ + 1); MASK[((size_t)b_ * 128 + w) * NS + t0l + q] = ~0ull; } }
    }
#define IDX_P(round_) ((round_) * nb + (((round_) & 1) ? (nb - 1 - bid) : bid))
    int round = 0;
    while (round * nb < 8192 && !(IDX_P(round) >= 256 && IDX_P(round) < 8192)) ++round;
    if (round * nb < 8192) { const int p0 = IDX_P(round); IDX_LOAD_FRAGS((p0 & 7) * NS + (p0 >> 3) * 8); }
    for (; round * nb < 8192; ) {
        const int p = IDX_P(round);
        int rnext = round + 1;
        while (rnext * nb < 8192 && !(IDX_P(rnext) >= 256 && IDX_P(rnext) < 8192)) ++rnext;
        const bool has_next = rnext * nb < 8192;
        const int pn = has_next ? IDX_P(rnext) : p;
        const int tg = p >> 3, b = p & 7, t0l = tg * 8, ch = t0l >> 6, nadm = 64 * (ch + 1), t0 = b * NS + t0l;
        const int t0n = (pn & 7) * NS + (pn >> 3) * 8;
        round = has_next ? rnext : 8192;
        __syncthreads();
#pragma unroll
        for (int i = 0; i < 9; ++i) if (tid + i * NTHR < 8 * IDX_HPITCH) hist[tid + i * NTHR] = 0u;
        __syncthreads();
        const int nkb = nadm >> 5;
        const f16* kbase = KI + ((size_t)(b * (NS / 32)) * 8 + hh) * 256 + r * 8;
#define IDX_LOADB(dst, kb_) do { _Pragma("unroll") for (int ks = 0; ks < 4; ++ks) dst[ks] = *(const f16x8*)(kbase + ((size_t)(kb_) * 8 + 2 * ks) * 256); } while (0)
#define IDX_BLOCK(bfrag, kb_) do { \
            f32x16 acc[2]; \
            _Pragma("unroll") for (int rt = 0; rt < 2; ++rt) { acc[rt] = (f32x16){0.f, 0.f, 0.f, 0.f, 0.f, 0.f, 0.f, 0.f, 0.f, 0.f, 0.f, 0.f, 0.f, 0.f, 0.f, 0.f}; \
                _Pragma("unroll") for (int ks = 0; ks < 4; ++ks) acc[rt] = __builtin_amdgcn_mfma_f32_32x32x16_f16(af[rt][ks], bfrag[ks], acc[rt], 0, 0, 0); } \
            _Pragma("unroll") for (int rt = 0; rt < 2; ++rt) \
                _Pragma("unroll") for (int qq = 0; qq < 2; ++qq) { \
                    f32x2 t2 = (f32x2){0.f, 0.f}; \
                    _Pragma("unroll") for (int hp = 0; hp < 4; ++hp) { const f32x2 r2 = (f32x2){__int_as_float(max(__float_as_int(acc[rt][8 * qq + 2 * hp]), 0)), __int_as_float(max(__float_as_int(acc[rt][8 * qq + 2 * hp + 1]), 0))}; \
                        t2 = __builtin_elementwise_fma(wv2[rt][4 * qq + hp], r2, t2); } \
                    const float sc = t2[0] + t2[1]; \
                    const f16 sh = (f16)sc; const unsigned bits = (unsigned)__builtin_bit_cast(unsigned short, sh); \
                    const unsigned key = (bits & 0x8000u) ? (~bits & 0xFFFFu) : (bits | 0x8000u); \
                    const int q = 4 * rt + 2 * hh + qq; \
                    if (MODE != 2) *(u16*)(lds + q * IDX_KPITCH + ((kb_) * 32 + r) * 2) = (u16)key; \
                    if (MODE != 2 && MODE != 4) atomicAdd(&hist[q * IDX_HPITCH + (key >> 7)], (key & 64u) ? 0x10000u : 1u); \
                    if (MODE == 2) sink += key; \
                } } while (0)
        f16x8 bf0[4], bf1[4], bf2[4]; unsigned sink = 0u;
        if (wave >= 4) __builtin_amdgcn_s_sleep(5);
        if (wave < nkb) IDX_LOADB(bf0, wave);
        if (wave + 8 < nkb) IDX_LOADB(bf1, wave + 8);
        if (wave + 16 < nkb) IDX_LOADB(bf2, wave + 16);
        if (MODE != 3) for (int kb = wave; kb < nkb; kb += 24) {
            IDX_BLOCK(bf0, kb);
            if (kb + 24 < nkb) IDX_LOADB(bf0, kb + 24);
            if (kb + 8 < nkb) { IDX_BLOCK(bf1, kb + 8); if (kb + 32 < nkb) IDX_LOADB(bf1, kb + 32); }
            if (kb + 16 < nkb) { IDX_BLOCK(bf2, kb + 16); if (kb + 40 < nkb) IDX_LOADB(bf2, kb + 40); }
        }
#undef IDX_LOADB
#undef IDX_BLOCK
        if (MODE == 2 && sink == 0xdeadbeefu) hist[tid] = sink;
        IDX_LOAD_FRAGS(t0n);
        __syncthreads();
        if (MODE != 1) {
            unsigned* hw = hist + wave * IDX_HPITCH;
            const unsigned char* krow = lds + wave * IDX_KPITCH;
            unsigned rem1 = 0u, rem2 = 0u;
            int b1;
            {   const u32x4 d0 = *(const u32x4*)(hw + 8 * lane), d1 = *(const u32x4*)(hw + 8 * lane + 4);
                const unsigned dd[8] = {d0.x, d0.y, d0.z, d0.w, d1.x, d1.y, d1.z, d1.w};
                unsigned cc[16];
#pragma unroll
                for (int j = 0; j < 8; ++j) { cc[2 * j] = dd[j] & 0xFFFFu; cc[2 * j + 1] = dd[j] >> 16; }
                b1 = wave_pick<16>(cc, 256u, lane, rem1); }
            hw[lane] = 0u;
            const int nit = (nadm + 511) >> 9;
            for (int it = 0; it < nit; ++it) {
                const int idx = (it * 64 + lane) * 8;
                if (idx < nadm) { const u32x4 k4 = *(const u32x4*)(krow + idx * 2);
                    const unsigned kk[4] = {k4.x, k4.y, k4.z, k4.w};
                    unsigned hit = 0u;
#pragma unroll
                    for (int j = 0; j < 4; ++j) { hit |= (((kk[j] & 0xFFFFu) >> 6) == (unsigned)b1 ? 1u : 0u) << (2 * j); hit |= ((kk[j] >> 22) == (unsigned)b1 ? 1u : 0u) << (2 * j + 1); }
                    if (hit) {
#pragma unroll
                        for (int j = 0; j < 4; ++j) { const unsigned k0 = kk[j] & 0xFFFFu, k1 = kk[j] >> 16;
                            if (hit & (1u << (2 * j))) atomicAdd(&hw[k0 & 63u], 1u);
                            if (hit & (2u << (2 * j))) atomicAdd(&hw[k1 & 63u], 1u); }
                    } }
            }
            int b2;
            { const unsigned c1[1] = {hw[lane]}; b2 = wave_pick<1>(c1, rem1, lane, rem2); }
            const unsigned tau = ((unsigned)b1 << 6) | (unsigned)b2;
            const size_t mrow = (size_t)(t0 + wave) * 128;
            for (int it = 0; it < nit; ++it) {
                const int idx = (it * 64 + lane) * 8;
                unsigned byte = 0u;
                if (idx < nadm) { const u32x4 k4 = *(const u32x4*)(krow + idx * 2);
                    const unsigned kk[4] = {k4.x, k4.y, k4.z, k4.w};
#pragma unroll
                    for (int j = 0; j < 4; ++j) { byte |= ((kk[j] & 0xFFFFu) >= tau ? 1u : 0u) << (2 * j); byte |= ((kk[j] >> 16) >= tau ? 1u : 0u) << (2 * j + 1); } }
                unsigned lo = (lane & 4) ? 0u : (byte << (8 * (lane & 3))), hi = (lane & 4) ? (byte << (8 * (lane & 3))) : 0u;
                lo |= __shfl_xor(lo, 1); hi |= __shfl_xor(hi, 1); lo |= __shfl_xor(lo, 2); hi |= __shfl_xor(hi, 2); lo |= __shfl_xor(lo, 4); hi |= __shfl_xor(hi, 4);
                if ((lane & 7) == 0 && idx < nadm) { hw[64 + 2 * (it * 8 + (lane >> 3))] = lo; hw[64 + 2 * (it * 8 + (lane >> 3)) + 1] = hi; }
            }
        }
        __syncthreads();
        if (MODE != 1) { const int w = tid >> 2, qp = tid & 3;
            if (w <= ch) { const unsigned* ha = hist + (2 * qp) * IDX_HPITCH + 64 + 2 * w; const unsigned* hb = ha + IDX_HPITCH;
                *(u32x4*)(MASK + ((size_t)b * 128 + w) * NS + t0l + 2 * qp) = (u32x4){ha[0], ha[1], hb[0], hb[1]}; } }
    }
    __syncthreads();
}

constexpr int ATP = 144;
constexpr int ATT_QWORD = 3584 + 32 * 64;
template <int AMODE>
__device__ __forceinline__ void ph4_attn_fast(const Args& a, int bid, int nb, unsigned char* lds) {
    int tid = threadIdx.x; asm volatile("" : "+v"(tid));
    const int lane = tid & 63, wave = __builtin_amdgcn_readfirstlane(tid >> 6), r = lane & 31, hh = lane >> 5;
    const f16* Q = (const f16*)(a.ws + WS_Q); const f16* Kk = (const f16*)(a.ws + WS_K); const f16* VT = (const f16*)(a.ws + WS_VT);
    const u64* MASK = (const u64*)(a.ws + WS_MASK); f16* MIX = (f16*)(a.ws + WS_H); const float* og = a.in[11];
    unsigned char* Kl = lds; unsigned char* Vl = lds + 2 * 64 * ATP;
    const float LOG2E = 1.4426950408889634f, OFF = 8192.f;
    const int pir = 16 * (r >> 4) + 8 * ((r >> 2) & 1) + 4 * ((r >> 3) & 1) + (r & 3);
    const int srow = tid >> 3, schk = tid & 7;
    unsigned* aq = (unsigned*)(a.ws + WS_CTL) + ATT_QWORD;
    volatile unsigned* ucell = (volatile unsigned*)(lds + 6 * 64 * ATP);
    volatile unsigned* dflag = ucell + 8;
    const float kmax = __int_as_float(__builtin_amdgcn_readfirstlane(__float_as_int(1.01f * 8.f * wave_max(fabsf(a.in[10][lane])))));
    int upar = 0;
    for (;;) {
        if (tid == 0) ucell[upar] = __hip_atomic_fetch_add(aq, 1u, __ATOMIC_RELAXED, __HIP_MEMORY_SCOPE_AGENT);
        if (tid < 8) dflag[tid] = 0u;
        __syncthreads();
        const unsigned u = ucell[upar]; upar ^= 1;
        if (u >= 2048u) break;
        const int h = 7 - (int)(u >> 8), qb = 31 - (int)((u & 255u) >> 3), b = (int)(u & 7u);
        const int q0l = qb * 256, tq = q0l + 32 * wave + r, cw = 4 * qb + (wave >> 1), top = 4 * qb + 3;
        const size_t t = (size_t)b * NS + tq;
        const float slope = exp2f(-(float)(h + 1)) * LOG2E;
        f16x8 qf[4];
#pragma unroll
        for (int ks = 0; ks < 4; ++ks) { const f16x8 qv = *(const f16x8*)(Q + t * 512 + h * 64 + 16 * ks + 8 * hh);
#pragma unroll
            for (int j = 0; j < 8; ++j) qf[ks][j] = (f16)((float)qv[j] * (0.125f * LOG2E)); }
        float qss = 0.f;
#pragma unroll
        for (int ks = 0; ks < 4; ++ks)
#pragma unroll
            for (int j = 0; j < 8; ++j) qss += (float)qf[ks][j] * (float)qf[ks][j];
        qss += __shfl_xor(qss, 32);
        const float Sb = __int_as_float(__builtin_amdgcn_readfirstlane(__float_as_int(wave_max(sqrtf(qss)) * kmax)));
        const float rowc = OFF + slope * (float)(tq - q0l);
        float m = 1000.f, l = 0.f;
        f32x16 O[2];
#pragma unroll
        for (int dt = 0; dt < 2; ++dt) O[dt] = (f32x16){0.f, 0.f, 0.f, 0.f, 0.f, 0.f, 0.f, 0.f, 0.f, 0.f, 0.f, 0.f, 0.f, 0.f, 0.f, 0.f};
        const f16* kg = Kk + ((size_t)b * NS + srow) * 512 + h * 64 + schk * 8;
        const f16* vg = VT + (size_t)(h * 64 + srow) * NT + (size_t)b * NS + schk * 8;
        f16x8 kr0, kr1, vr0, vr1; u64 mw0 = 0ull, mw1 = 0ull;
#define ATT_LOAD(kr, vr, mwv, jj) do { if ((jj) >= 0) { kr = *(const f16x8*)(kg + (size_t)(jj) * 64 * 512); vr = *(const f16x8*)(vg + (jj) * 64); mwv = ((jj) <= cw) ? MASK[((size_t)b * 128 + (jj)) * NS + tq] : 0ull; } } while (0)
        ATT_LOAD(kr0, vr0, mw0, top); ATT_LOAD(kr1, vr1, mw1, top - 1);
        int buf = 0; bool wdone = false, stop = false;
        auto step = [&](f16x8& kreg, f16x8& vreg, u64& mwr, const int j) {
            *(f16x8*)(Kl + buf * 64 * ATP + srow * ATP + schk * 16) = kreg;
            *(f16x8*)(Vl + buf * 64 * ATP + srow * ATP + schk * 16) = vreg;
            const u64 mw = mwr;
            asm volatile("s_waitcnt lgkmcnt(0)" ::: "memory"); __builtin_amdgcn_s_barrier(); asm volatile("" ::: "memory");
            {
                const unsigned jp = (unsigned)(j + 1);
                if ((dflag[0] > jp) & (dflag[1] > jp) & (dflag[2] > jp) & (dflag[3] > jp) & (dflag[4] > jp) & (dflag[5] > jp) & (dflag[6] > jp) & (dflag[7] > jp)) { stop = true; return; }
            }
            ATT_LOAD(kreg, vreg, mwr, j - 2);
            if (!wdone && j < cw) { const float lmax = Sb + OFF + slope * (float)(64 * j + 63 - q0l); if (__all(lmax - m < -28.f)) { wdone = true; if (lane == 0) dflag[wave] = (unsigned)(j + 1); } }
            if (j <= cw && !wdone) {
                const unsigned char* kb_ = Kl + buf * 64 * ATP + pir * ATP + 16 * hh;
                f16x8 fr8[8];
#pragma unroll
                for (int kt = 0; kt < 2; ++kt)
#pragma unroll
                    for (int ks = 0; ks < 4; ++ks) fr8[kt * 4 + ks] = *(const f16x8*)(kb_ + kt * 32 * ATP + ks * 32);
                f32x16 sa[2];
                if (j == cw) {
#pragma unroll
                    for (int kt = 0; kt < 2; ++kt)
#pragma unroll
                        for (int rg = 0; rg < 16; ++rg) { const float x = (float)(64 * j + 32 * kt + 16 * (rg >> 3) + 8 * hh + (rg & 7) - tq); sa[kt][rg] = rowc - slope * fabsf(x); }
                } else {
                    const float base = OFF + slope * (float)(64 * j + 8 * hh - q0l);
#pragma unroll
                    for (int kt = 0; kt < 2; ++kt)
#pragma unroll
                        for (int rg = 0; rg < 16; ++rg) sa[kt][rg] = __builtin_fmaf(slope, (float)(32 * kt + 16 * (rg >> 3) + (rg & 7)), base);
                }
                __builtin_amdgcn_sched_barrier(0);
                __builtin_amdgcn_s_setprio(1);
#pragma unroll
                for (int kt = 0; kt < 2; ++kt)
#pragma unroll
                    for (int ks = 0; ks < 4; ++ks) sa[kt] = __builtin_amdgcn_mfma_f32_32x32x16_f16(fr8[kt * 4 + ks], qf[ks], sa[kt], 0, 0, 0);
                __builtin_amdgcn_s_setprio(0);
                __builtin_amdgcn_sched_barrier(0);
                const unsigned char* vb_ = Vl + buf * 64 * ATP + r * ATP + 16 * hh;
#pragma unroll
                for (int dt = 0; dt < 2; ++dt)
#pragma unroll
                    for (int kt = 0; kt < 2; ++kt)
#pragma unroll
                        for (int s2 = 0; s2 < 2; ++s2) fr8[dt * 4 + kt * 2 + s2] = *(const f16x8*)(vb_ + dt * 32 * ATP + kt * 64 + s2 * 32);
                __builtin_amdgcn_sched_barrier(0);
                float rm = 0.f;
#pragma unroll
                for (int kt = 0; kt < 2; ++kt) { const unsigned w32 = (unsigned)(kt ? (mw >> 32) : mw) >> (8 * hh);
#pragma unroll
                    for (int rg = 0; rg < 16; ++rg) { const int tm = __builtin_amdgcn_sbfe((int)w32, 16 * (rg >> 3) + (rg & 7), 1);
                        const float L = __int_as_float(__float_as_int(sa[kt][rg]) & tm); sa[kt][rg] = L; rm = fmaxf(rm, L); } }
                rm = fmaxf(rm, __shfl_xor(rm, 32));
                const float mn = fmaxf(m, rm);
                if (__any(mn > m)) { const float al = __builtin_amdgcn_exp2f(m - mn); l *= al;
#pragma unroll
                    for (int dt = 0; dt < 2; ++dt)
#pragma unroll
                        for (int rg = 0; rg < 16; ++rg) O[dt][rg] *= al; }
                m = mn;
                f16x8 pf[2][2];
                float l0 = 0.f, l1 = 0.f;
#pragma unroll
                for (int kt = 0; kt < 2; ++kt)
#pragma unroll
                    for (int rg = 0; rg < 16; ++rg) { const float pp = __builtin_amdgcn_exp2f(sa[kt][rg] - m); if (rg & 1) l1 += pp; else l0 += pp; pf[kt][rg >> 3][rg & 7] = (f16)pp; }
                l += l0 + l1;
                __builtin_amdgcn_sched_barrier(0);
                __builtin_amdgcn_s_setprio(1);
#pragma unroll
                for (int dt = 0; dt < 2; ++dt)
#pragma unroll
                    for (int kt = 0; kt < 2; ++kt)
#pragma unroll
                        for (int s2 = 0; s2 < 2; ++s2) O[dt] = __builtin_amdgcn_mfma_f32_32x32x16_f16(fr8[dt * 4 + kt * 2 + s2], pf[kt][s2], O[dt], 0, 0, 0);
                __builtin_amdgcn_s_setprio(0);
            }
            buf ^= 1;
        };
        for (int j = top; j >= 0; j -= 2) {
            step(kr0, vr0, mw0, j); if (stop) break;
            if (j - 1 >= 0) { step(kr1, vr1, mw1, j - 1); if (stop) break; }
        }
#undef ATT_LOAD
        l += __shfl_xor(l, 32);
        const float inv = 1.f / l;
        float ss = 0.f;
#pragma unroll
        for (int dt = 0; dt < 2; ++dt)
#pragma unroll
            for (int rg = 0; rg < 16; ++rg) { O[dt][rg] *= inv; ss += O[dt][rg] * O[dt][rg]; }
        ss += __shfl_xor(ss, 32);
        const float rstd = rsqrtf(ss * (1.f / 64.f) + EPS);
#pragma unroll
        for (int dt = 0; dt < 2; ++dt)
#pragma unroll
            for (int g4 = 0; g4 < 4; ++g4) { const int d = 32 * dt + 8 * g4 + 4 * hh; const f32x4 gg = *(const f32x4*)(og + h * 64 + d);
                f16x4 o4; o4.x = (f16)(O[dt][4 * g4 + 0] * rstd * gg.x); o4.y = (f16)(O[dt][4 * g4 + 1] * rstd * gg.y); o4.z = (f16)(O[dt][4 * g4 + 2] * rstd * gg.z); o4.w = (f16)(O[dt][4 * g4 + 3] * rstd * gg.w);
                *(f16x4*)(MIX + t * ND + 512 + h * 64 + d) = o4; }
        __syncthreads();
    }
}

__device__ __forceinline__ void ph5_outproj(const Args& a, int bid, int nb, unsigned char* lds) {
    pg8::Gemm g{(const f16*)(a.ws + WS_H), (const f16*)(a.ws + WS_WOUT), NT, 1024, ND}; pg8::StaticOrder S; S.init(NT, 1024, nb, bid);
    pg8::EpiOut E{a.in[0], (const float*)(a.ws + WS_MOD), a.out};
    pg8::gemm_phase((PG8_LAS unsigned char*)lds, g, S, E);
}

__device__ __forceinline__ void ph7_peerq(const Args& a, int bid, int nb, unsigned char* lds) {
    pg8::Gemm g{(const f16*)(a.ws + WS_H), (const f16*)(a.ws + WS_WQ), NT, 2048, ND}; pg8::StaticOrder S; S.init(NT, 2048, nb, bid);
    pg8::EpiPQ E{(f16*)(a.ws + WS_PQ)};
    pg8::gemm_phase((PG8_LAS unsigned char*)lds, g, S, E);
}


__device__ __forceinline__ unsigned f2skey(float f) { const unsigned u = __float_as_uint(f); return (u & 0x80000000u) ? ~u : (u | 0x80000000u); }
__device__ __forceinline__ float skey2f(unsigned k) { return __uint_as_float((k & 0x80000000u) ? (k & 0x7FFFFFFFu) : ~k); }
#define CE_(a_, b_) do { const unsigned t__ = max(a_, b_); b_ = min(a_, b_); a_ = t__; } while (0)
#define SORT16_DESC(v) do { CE_(v[0], v[1]); CE_(v[2], v[3]); CE_(v[0], v[2]); CE_(v[1], v[3]); CE_(v[1], v[2]); CE_(v[4], v[5]); CE_(v[6], v[7]); CE_(v[4], v[6]); CE_(v[5], v[7]); CE_(v[5], v[6]); CE_(v[0], v[4]); CE_(v[2], v[6]); CE_(v[2], v[4]); CE_(v[1], v[5]); CE_(v[3], v[7]); CE_(v[3], v[5]); CE_(v[1], v[2]); CE_(v[3], v[4]); CE_(v[5], v[6]); CE_(v[8], v[9]); CE_(v[10], v[11]); CE_(v[8], v[10]); CE_(v[9], v[11]); CE_(v[9], v[10]); CE_(v[12], v[13]); CE_(v[14], v[15]); CE_(v[12], v[14]); CE_(v[13], v[15]); CE_(v[13], v[14]); CE_(v[8], v[12]); CE_(v[10], v[14]); CE_(v[10], v[12]); CE_(v[9], v[13]); CE_(v[11], v[15]); CE_(v[11], v[13]); CE_(v[9], v[10]); CE_(v[11], v[12]); CE_(v[13], v[14]); CE_(v[0], v[8]); CE_(v[4], v[12]); CE_(v[4], v[8]); CE_(v[2], v[10]); CE_(v[6], v[14]); CE_(v[6], v[10]); CE_(v[2], v[4]); CE_(v[6], v[8]); CE_(v[10], v[12]); CE_(v[1], v[9]); CE_(v[5], v[13]); CE_(v[5], v[9]); CE_(v[3], v[11]); CE_(v[7], v[15]); CE_(v[7], v[11]); CE_(v[3], v[5]); CE_(v[7], v[9]); CE_(v[11], v[13]); CE_(v[1], v[2]); CE_(v[3], v[4]); CE_(v[5], v[6]); CE_(v[7], v[8]); CE_(v[9], v[10]); CE_(v[11], v[12]); CE_(v[13], v[14]); } while (0)
#define BITONIC16_DESC(v) do { CE_(v[0], v[8]); CE_(v[1], v[9]); CE_(v[2], v[10]); CE_(v[3], v[11]); CE_(v[4], v[12]); CE_(v[5], v[13]); CE_(v[6], v[14]); CE_(v[7], v[15]); CE_(v[0], v[4]); CE_(v[1], v[5]); CE_(v[2], v[6]); CE_(v[3], v[7]); CE_(v[8], v[12]); CE_(v[9], v[13]); CE_(v[10], v[14]); CE_(v[11], v[15]); CE_(v[0], v[2]); CE_(v[1], v[3]); CE_(v[4], v[6]); CE_(v[5], v[7]); CE_(v[8], v[10]); CE_(v[9], v[11]); CE_(v[12], v[14]); CE_(v[13], v[15]); CE_(v[0], v[1]); CE_(v[2], v[3]); CE_(v[4], v[5]); CE_(v[6], v[7]); CE_(v[8], v[9]); CE_(v[10], v[11]); CE_(v[12], v[13]); CE_(v[14], v[15]); } while (0)
#define MERGE16_DESC(dst, other) do { unsigned c__[16]; _Pragma("unroll") for (int i__ = 0; i__ < 16; ++i__) c__[i__] = max(dst[i__], other[15 - i__]); BITONIC16_DESC(c__); _Pragma("unroll") for (int i__ = 0; i__ < 16; ++i__) dst[i__] = c__[i__]; } while (0)
#define TOP16_INSERT(v, x_) do { unsigned x__ = (x_); _Pragma("unroll") for (int k_ = 0; k_ < 16; ++k_) { const unsigned t__ = max(v[k_], x__); x__ = min(v[k_], x__); v[k_] = t__; } } while (0)
__device__ __forceinline__ void ph8_peersel_fast(const Args& a, int bid, int nb, unsigned char* lds) {
    int tid = threadIdx.x; asm volatile("" : "+v"(tid));
    const int lane = tid & 63, wave = __builtin_amdgcn_readfirstlane(tid >> 6), r = lane & 31, hh = lane >> 5;
    const f16* PQ = (const f16*)(a.ws + WS_PQ); const f16* SK = (const f16*)(a.ws + WS_SK);
    u16* EID = (u16*)(a.ws + WS_EID); float* GW = (float*)(a.ws + WS_GW);
    unsigned char* wl = lds + wave * 2048 + lane * 32;
    for (int item = bid * NWAVE + wave; item < (NT / 32) * 8; item += nb * NWAVE) {
        const int tt = item >> 3, h = item & 7, t0 = tt * 32;
        unsigned top[2][16];
#pragma unroll
        for (int p = 0; p < 2; ++p) {
            f16x8 bq[8];
#pragma unroll
            for (int ks = 0; ks < 8; ++ks) bq[ks] = *(const f16x8*)(PQ + ((((size_t)tt * 256 + h * 32 + p * 16 + 2 * ks + hh) * 32 + r) << 3));
#pragma unroll
            for (int k = 0; k < 16; ++k) top[p][k] = 0u;
            const f16* skb = SK + (size_t)(h * 2 + p) * 16384 + hh * 256 + r * 8;
            f16x8 afa[8], afb[8];
#pragma unroll
            for (int ks = 0; ks < 8; ++ks) afa[ks] = *(const f16x8*)(skb + ks * 512);
#define P8_TILE(AF, nt_) do { f32x16 acc = (f32x16){0.f, 0.f, 0.f, 0.f, 0.f, 0.f, 0.f, 0.f, 0.f, 0.f, 0.f, 0.f, 0.f, 0.f, 0.f, 0.f}; \
                _Pragma("unroll") for (int ks = 0; ks < 8; ++ks) acc = __builtin_amdgcn_mfma_f32_32x32x16_f16(AF[ks], bq[ks], acc, 0, 0, 0); \
                const unsigned nb0 = 32 * (nt_) + 4 * hh; \
                unsigned ky[16]; \
                _Pragma("unroll") for (int rg = 0; rg < 16; ++rg) { const unsigned n = nb0 + (rg & 3) + 8 * (rg >> 2); ky[rg] = (f2skey(acc[rg]) & ~127u) | n; } \
                SORT16_DESC(ky); MERGE16_DESC(top[p], ky); } while (0)
#pragma unroll 1
            for (int np = 0; np < 2; ++np) {
#pragma unroll
                for (int ks = 0; ks < 8; ++ks) afb[ks] = *(const f16x8*)(skb + ((2 * np + 1) * 8 + ks) * 512);
                P8_TILE(afa, 2 * np);
                const int nn = (np == 0) ? 2 : 3;
#pragma unroll
                for (int ks = 0; ks < 8; ++ks) afa[ks] = *(const f16x8*)(skb + (nn * 8 + ks) * 512);
                P8_TILE(afb, 2 * np + 1);
            }
#undef P8_TILE
            unsigned oth[16];
#pragma unroll
            for (int k = 0; k < 16; ++k) oth[k] = __shfl_xor(top[p][k], 32);
            MERGE16_DESC(top[p], oth);
            asm volatile("" ::: "memory");
        }
#pragma unroll
        for (int k = 0; k < 16; k += 4) {
            *(unsigned*)(wl + k) = (top[0][k] & 127u) | ((top[0][k + 1] & 127u) << 8) | ((top[0][k + 2] & 127u) << 16) | ((top[0][k + 3] & 127u) << 24);
            *(unsigned*)(wl + 16 + k) = (top[1][k] & 127u) | ((top[1][k + 1] & 127u) << 8) | ((top[1][k + 2] & 127u) << 16) | ((top[1][k + 3] & 127u) << 24);
        }
        float fa[16], fb[16];
#pragma unroll
        for (int k = 0; k < 16; ++k) { fa[k] = skey2f(top[0][k] & ~127u); fb[k] = skey2f(top[1][k] & ~127u); }
        unsigned cg[4][16];
        cg[0][0] = (f2skey(fa[0] + fb[0]) & ~255u) | 0u;
        cg[0][1] = (f2skey(fa[0] + fb[1]) & ~255u) | 1u;
        cg[0][2] = (f2skey(fa[0] + fb[2]) & ~255u) | 2u;
        cg[0][3] = (f2skey(fa[0] + fb[3]) & ~255u) | 3u;
        cg[0][4] = (f2skey(fa[0] + fb[4]) & ~255u) | 4u;
        cg[0][5] = (f2skey(fa[0] + fb[5]) & ~255u) | 5u;
        cg[0][6] = (f2skey(fa[0] + fb[6]) & ~255u) | 6u;
        cg[0][7] = (f2skey(fa[0] + fb[7]) & ~255u) | 7u;
        cg[0][8] = (f2skey(fa[0] + fb[8]) & ~255u) | 8u;
        cg[0][9] = (f2skey(fa[0] + fb[9]) & ~255u) | 9u;
        cg[0][10] = (f2skey(fa[0] + fb[10]) & ~255u) | 10u;
        cg[0][11] = (f2skey(fa[0] + fb[11]) & ~255u) | 11u;
        cg[0][12] = (f2skey(fa[0] + fb[12]) & ~255u) | 12u;
        cg[0][13] = (f2skey(fa[0] + fb[13]) & ~255u) | 13u;
        cg[0][14] = (f2skey(fa[0] + fb[14]) & ~255u) | 14u;
        cg[0][15] = (f2skey(fa[0] + fb[15]) & ~255u) | 15u;
        cg[1][0] = (f2skey(fa[1] + fb[0]) & ~255u) | 16u;
        cg[1][1] = (f2skey(fa[1] + fb[1]) & ~255u) | 17u;
        cg[1][2] = (f2skey(fa[1] + fb[2]) & ~255u) | 18u;
        cg[1][3] = (f2skey(fa[1] + fb[3]) & ~255u) | 19u;
        cg[1][4] = (f2skey(fa[1] + fb[4]) & ~255u) | 20u;
        cg[1][5] = (f2skey(fa[1] + fb[5]) & ~255u) | 21u;
        cg[1][6] = (f2skey(fa[1] + fb[6]) & ~255u) | 22u;
        cg[1][7] = (f2skey(fa[1] + fb[7]) & ~255u) | 23u;
        cg[1][8] = (f2skey(fa[2] + fb[0]) & ~255u) | 32u;
        cg[1][9] = (f2skey(fa[2] + fb[1]) & ~255u) | 33u;
        cg[1][10] = (f2skey(fa[2] + fb[2]) & ~255u) | 34u;
        cg[1][11] = (f2skey(fa[2] + fb[3]) & ~255u) | 35u;
        cg[1][12] = (f2skey(fa[2] + fb[4]) & ~255u) | 36u;
        cg[1][13] = (f2skey(fa[3] + fb[0]) & ~255u) | 48u;
        cg[1][14] = (f2skey(fa[3] + fb[1]) & ~255u) | 49u;
        cg[1][15] = (f2skey(fa[3] + fb[2]) & ~255u) | 50u;
        cg[2][0] = (f2skey(fa[3] + fb[3]) & ~255u) | 51u;
        cg[2][1] = (f2skey(fa[4] + fb[0]) & ~255u) | 64u;
        cg[2][2] = (f2skey(fa[4] + fb[1]) & ~255u) | 65u;
        cg[2][3] = (f2skey(fa[4] + fb[2]) & ~255u) | 66u;
        cg[2][4] = (f2skey(fa[5] + fb[0]) & ~255u) | 80u;
        cg[2][5] = (f2skey(fa[5] + fb[1]) & ~255u) | 81u;
        cg[2][6] = (f2skey(fa[6] + fb[0]) & ~255u) | 96u;
        cg[2][7] = (f2skey(fa[6] + fb[1]) & ~255u) | 97u;
        cg[2][8] = (f2skey(fa[7] + fb[0]) & ~255u) | 112u;
        cg[2][9] = (f2skey(fa[7] + fb[1]) & ~255u) | 113u;
        cg[2][10] = (f2skey(fa[8] + fb[0]) & ~255u) | 128u;
        cg[2][11] = (f2skey(fa[9] + fb[0]) & ~255u) | 144u;
        cg[2][12] = (f2skey(fa[10] + fb[0]) & ~255u) | 160u;
        cg[2][13] = (f2skey(fa[11] + fb[0]) & ~255u) | 176u;
        cg[2][14] = (f2skey(fa[12] + fb[0]) & ~255u) | 192u;
        cg[2][15] = (f2skey(fa[13] + fb[0]) & ~255u) | 208u;
        cg[3][0] = (f2skey(fa[14] + fb[0]) & ~255u) | 224u;
        cg[3][1] = (f2skey(fa[15] + fb[0]) & ~255u) | 240u;
        cg[3][2] = 0u;
        cg[3][3] = 0u;
        cg[3][4] = 0u;
        cg[3][5] = 0u;
        cg[3][6] = 0u;
        cg[3][7] = 0u;
        cg[3][8] = 0u;
        cg[3][9] = 0u;
        cg[3][10] = 0u;
        cg[3][11] = 0u;
        cg[3][12] = 0u;
        cg[3][13] = 0u;
        cg[3][14] = 0u;
        cg[3][15] = 0u;
        SORT16_DESC(cg[0]); SORT16_DESC(cg[1]); SORT16_DESC(cg[2]); SORT16_DESC(cg[3]);
        MERGE16_DESC(cg[0], cg[1]); MERGE16_DESC(cg[2], cg[3]); MERGE16_DESC(cg[0], cg[2]);
        unsigned ct[16];
#pragma unroll
        for (int k = 0; k < 16; ++k) ct[k] = cg[0][k];
        float sc[16]; float den = 0.f; const float s0 = skey2f(ct[0] & ~255u);
#pragma unroll
        for (int k = 0; k < 16; ++k) { sc[k] = __expf(skey2f(ct[k] & ~255u) - s0); den += sc[k]; }
        const float inv = 1.f / den;
        if (hh == 0) {
            u16 ev[16];
#pragma unroll
            for (int k = 0; k < 16; ++k) { const unsigned ij = ct[k] & 255u; const unsigned i1 = wl[ij >> 4], i2 = wl[16 + (ij & 15u)]; ev[k] = (u16)(i1 * 128u + i2); }
            const size_t o = (size_t)(t0 + r) * 128 + h * 16;
#pragma unroll
            for (int k = 0; k < 16; k += 8) {
                *(u32x4*)(EID + o + k) = (u32x4){(unsigned)ev[k] | ((unsigned)ev[k + 1] << 16), (unsigned)ev[k + 2] | ((unsigned)ev[k + 3] << 16), (unsigned)ev[k + 4] | ((unsigned)ev[k + 5] << 16), (unsigned)ev[k + 6] | ((unsigned)ev[k + 7] << 16)};
            }
#pragma unroll
            for (int k = 0; k < 16; k += 4) *(f32x4*)(GW + o + k) = (f32x4){sc[k] * inv, sc[k + 1] * inv, sc[k + 2] * inv, sc[k + 3] * inv};
        }
    }
}

typedef _Float16 f16x2 __attribute__((ext_vector_type(2)));
__device__ __forceinline__ float gelu_erf(float d) { return 0.5f * d * (1.f + erff(d * 0.70710678118654752f)); }
constexpr int PQ_WORD0 = 3584, PQ_CHUNK = 64, PQ_NCHUNK = NT / PQ_CHUNK;
constexpr size_t WS_PART = 208 * MiB;
__device__ __forceinline__ unsigned xcc_id_() { return (unsigned)__builtin_amdgcn_s_getreg((3 << 11) | 20) & 7u; }
template <int VPHASE>
__device__ __forceinline__ void ph9_sliced(const Args& a, unsigned char* lds) {
    int tid_ = threadIdx.x; asm volatile("" : "+v"(tid_)); const int lane = tid_ & 63, wave = __builtin_amdgcn_readfirstlane(tid_ >> 6);
    const int g8 = lane >> 3, c16 = lane & 7;
    const f16* H2 = (const f16*)(a.ws + WS_H); const unsigned char* TAB = a.ws + (VPHASE ? WS_VP : WS_UT);
    const u16* EID = (const u16*)(a.ws + WS_EID); const float* GW = (const float*)(a.ws + WS_GW); float* PART = (float*)(a.ws + WS_PART);
    const float* mod = (const float*)(a.ws + WS_MOD); float* out = a.out;
    unsigned* qw = (unsigned*)(a.ws + WS_CTL) + PQ_WORD0 + (VPHASE ? 8 * 64 : 0);
    volatile unsigned* cslot = (volatile unsigned*)lds;
    const bool b5 = (lane & 32) != 0, b4 = (lane & 16) != 0, b3 = (lane & 8) != 0, b2 = (lane & 4) != 0, b1 = (lane & 2) != 0, b0 = (lane & 1) != 0;
    const unsigned x0 = xcc_id_();
    int par = 0;
    for (int k = 0; k < 8; ++k) {
        const unsigned sl = (x0 + (unsigned)k) & 7u;
        unsigned cur = 0u;
        if (tid_ == 0) cur = __hip_atomic_fetch_add(qw + 64 * sl, 1u, __ATOMIC_RELAXED, __HIP_MEMORY_SCOPE_AGENT);
        for (;;) {
            if (tid_ == 0) cslot[par] = cur;
            __syncthreads();
            const unsigned c = cslot[par]; par ^= 1;
            if (c >= (unsigned)PQ_NCHUNK) break;
            if (tid_ == 0) cur = __hip_atomic_fetch_add(qw + 64 * sl, 1u, __ATOMIC_RELAXED, __HIP_MEMORY_SCOPE_AGENT);
            const int tb = (int)c * PQ_CHUNK + wave * (PQ_CHUNK / NWAVE);
            const unsigned char* tsl = TAB + 128 * sl + 16 * c16;
#pragma unroll 1
            for (int i8 = 0; i8 < PQ_CHUNK / NWAVE; ++i8) {
                const int t = tb + i8;
                const u32x4 e0 = *(const u32x4*)(EID + (size_t)t * 128 + 16 * g8), e1 = *(const u32x4*)(EID + (size_t)t * 128 + 16 * g8 + 8);
                const unsigned ew[8] = {e0.x, e0.y, e0.z, e0.w, e1.x, e1.y, e1.z, e1.w};
                u32x4 r8[16];
#pragma unroll
                for (int i = 0; i < 16; ++i) { const unsigned eid = (i & 1) ? (ew[i >> 1] >> 16) : (ew[i >> 1] & 0xFFFFu); r8[i] = *(const u32x4*)(tsl + (size_t)eid * ND); }
                if (!VPHASE) {
                    const u32x4 hq0 = *(const u32x4*)(H2 + (size_t)t * ND + 128 * sl + 16 * c16), hq1 = *(const u32x4*)(H2 + (size_t)t * ND + 128 * sl + 16 * c16 + 8);
                    const unsigned hp[8] = {hq0.x, hq0.y, hq0.z, hq0.w, hq1.x, hq1.y, hq1.z, hq1.w};
                    float p[16];
#pragma unroll
                    for (int i = 0; i < 16; ++i) { float d = 0.f;
#pragma unroll
                        for (int j = 0; j < 4; ++j) { const unsigned lo = __builtin_amdgcn_perm(r8[i][j], r8[i][j], 0x010C000Cu), hi = __builtin_amdgcn_perm(r8[i][j], r8[i][j], 0x030C020Cu);
                            d = __builtin_amdgcn_fdot2(__builtin_bit_cast(f16x2, hp[2 * j]), __builtin_bit_cast(f16x2, lo), d, false);
                            d = __builtin_amdgcn_fdot2(__builtin_bit_cast(f16x2, hp[2 * j + 1]), __builtin_bit_cast(f16x2, hi), d, false); }
                        p[i] = d; }
                    float q8[8], q4[4], r2[2];
#pragma unroll
                    for (int ii = 0; ii < 8; ++ii) { const float keep = b2 ? p[8 + ii] : p[ii], send = b2 ? p[ii] : p[8 + ii]; q8[ii] = keep + __shfl_xor(send, 4); }
#pragma unroll
                    for (int ii = 0; ii < 4; ++ii) { const float keep = b1 ? q8[4 + ii] : q8[ii], send = b1 ? q8[ii] : q8[4 + ii]; q4[ii] = keep + __shfl_xor(send, 2); }
#pragma unroll
                    for (int ii = 0; ii < 2; ++ii) { const float keep = b0 ? q4[2 + ii] : q4[ii], send = b0 ? q4[ii] : q4[2 + ii]; r2[ii] = keep + __shfl_xor(send, 1); }
                    *(f32x2*)(PART + ((size_t)sl * NT + t) * 128 + 16 * g8 + 2 * c16) = (f32x2){r2[0], r2[1]};
                } else {
                    const float* wp = GW + (size_t)t * 128 + 16 * g8;
                    const f32x4 wq0 = *(const f32x4*)wp, wq1 = *(const f32x4*)(wp + 4), wq2 = *(const f32x4*)(wp + 8), wq3 = *(const f32x4*)(wp + 12);
                    const float wv[16] = {wq0[0], wq0[1], wq0[2], wq0[3], wq1[0], wq1[1], wq1[2], wq1[3], wq2[0], wq2[1], wq2[2], wq2[3], wq3[0], wq3[1], wq3[2], wq3[3]};
                    f16x2 acc2[8];
#pragma unroll
                    for (int j = 0; j < 8; ++j) acc2[j] = (f16x2){(f16)0.f, (f16)0.f};
#pragma unroll
                    for (int i = 0; i < 16; ++i) { const f16x2 w2 = (f16x2){(f16)wv[i], (f16)wv[i]};
#pragma unroll
                        for (int j = 0; j < 4; ++j) { const unsigned lo = __builtin_amdgcn_perm(r8[i][j], r8[i][j], 0x010C000Cu), hi = __builtin_amdgcn_perm(r8[i][j], r8[i][j], 0x030C020Cu);
                            acc2[2 * j] = __builtin_elementwise_fma(w2, __builtin_bit_cast(f16x2, lo), acc2[2 * j]);
                            acc2[2 * j + 1] = __builtin_elementwise_fma(w2, __builtin_bit_cast(f16x2, hi), acc2[2 * j + 1]); } }
                    float acc[16];
#pragma unroll
                    for (int j = 0; j < 8; ++j) { acc[2 * j] = (float)acc2[j][0]; acc[2 * j + 1] = (float)acc2[j][1]; }
                    float q8[8], q4[4], r2[2];
#pragma unroll
                    for (int ii = 0; ii < 8; ++ii) { const float keep = b5 ? acc[8 + ii] : acc[ii], send = b5 ? acc[ii] : acc[8 + ii]; q8[ii] = keep + __shfl_xor(send, 32); }
#pragma unroll
                    for (int ii = 0; ii < 4; ++ii) { const float keep = b4 ? q8[4 + ii] : q8[ii], send = b4 ? q8[ii] : q8[4 + ii]; q4[ii] = keep + __shfl_xor(send, 16); }
#pragma unroll
                    for (int ii = 0; ii < 2; ++ii) { const float keep = b3 ? q4[2 + ii] : q4[ii], send = b3 ? q4[ii] : q4[2 + ii]; r2[ii] = keep + __shfl_xor(send, 8); }
                    const int ch = 128 * sl + 16 * c16 + 2 * g8;
                    float* op = out + (size_t)t * ND + ch; const float* g2 = mod + (t / NS) * 6144 + 5120 + ch;
                    const f32x2 o2 = *(const f32x2*)op, gg = *(const f32x2*)g2;
                    *(f32x2*)op = o2 + gg * ((f32x2){r2[0], r2[1]} * (1.f / PEER_VSCALE));
                }
            }
        }
    }
}
__device__ __forceinline__ void ph9b_combine(const Args& a, int bid, int nb) {
    int tid_ = threadIdx.x; asm volatile("" : "+v"(tid_));
    float* GW = (float*)(a.ws + WS_GW); const float* PART = (const float*)(a.ws + WS_PART);
    for (size_t i = (size_t)bid * NTHR + tid_; i < (size_t)NT * 128 / 4; i += (size_t)nb * NTHR) {
        f32x4 sum = ((const f32x4*)PART)[i];
#pragma unroll
        for (int sidx = 1; sidx < 8; ++sidx) sum += ((const f32x4*)(PART + (size_t)sidx * NT * 128))[i];
        const f32x4 g = ((const f32x4*)GW)[i];
        f32x4 w;
#pragma unroll
        for (int j = 0; j < 4; ++j) w[j] = g[j] * gelu_erf(sum[j] * (1.f / PEER_USCALE));
        ((f32x4*)GW)[i] = w;
    }
}

#define LAS __attribute__((address_space(3)))
#define XB_TMO      128
#define XB_XCNT(j)  (256  + 64 * (j))
#define XB_XSUB(j)  (1280 + 64 * (j))
#define XB_XGEN(j)  (2304 + 64 * (j))
#define XB_TOP      3328
#define XB_TOPGEN   3392
#define XCD_BAR_WORDS 3456
#define XB_SPIN_CAP (1u << 18)
__device__ __forceinline__ unsigned xb_ld(unsigned* p)              { return __hip_atomic_load(p, __ATOMIC_RELAXED, __HIP_MEMORY_SCOPE_AGENT); }
__device__ __forceinline__ unsigned xb_add(unsigned* p, unsigned v) { return __hip_atomic_fetch_add(p, v, __ATOMIC_RELAXED, __HIP_MEMORY_SCOPE_AGENT); }
__device__ __forceinline__ unsigned xb_xcc_id() { return (unsigned)__builtin_amdgcn_s_getreg((3 << 11) | 20) & 0xFu; }
#define XB_SPIN(cond, bar) do { unsigned _sp = 0; while (cond) { __builtin_amdgcn_s_sleep(1); \
    if ((++_sp & 255u) == 0u) { if (xb_ld(&(bar)[XB_TMO])) break; if (_sp > XB_SPIN_CAP) { atomicAdd(&(bar)[XB_TMO], 1u); break; } } } } while (0)
struct XcdBarrier { unsigned* bar; unsigned x; volatile LAS unsigned* st; };
__device__ __forceinline__ XcdBarrier xcd_barrier_post(unsigned* bar, volatile LAS unsigned* st) {
    XcdBarrier b; b.bar = bar; b.x = xb_xcc_id(); b.st = st;
    if (threadIdx.x == 0) (void)xb_add(&bar[XB_XCNT(b.x)], 1u);
    return b;
}
__device__ __forceinline__ void xcd_barrier_complete(unsigned* bar, unsigned x, unsigned& nloc, unsigned& nx) {
    const unsigned G = gridDim.x * gridDim.y * gridDim.z;
    unsigned sum, cnt, mine, sp = 0u;
    for (;;) {
        sum = 0u; cnt = 0u; mine = 0u;
#pragma unroll
        for (unsigned j = 0; j < 16; ++j) { const unsigned c = xb_ld(&bar[XB_XCNT(j)]); sum += c; cnt += (c > 0u) ? 1u : 0u; mine = (j == x) ? c : mine; }
        if (sum == G) break;
        __builtin_amdgcn_s_sleep(1);
        if ((++sp & 255u) == 0u) { if (xb_ld(&bar[XB_TMO])) break; if (sp > XB_SPIN_CAP) { atomicAdd(&bar[XB_TMO], 1u); break; } }
    }
    nloc = mine > 0u ? mine : 1u; nx = cnt > 0u ? cnt : 1u;
}
__device__ __forceinline__ void xcd_barrier(const XcdBarrier& b) {
    asm volatile("s_waitcnt vmcnt(0)" ::: "memory");
    __syncthreads();
    if (threadIdx.x == 0) {
        unsigned* bar = b.bar;
        __builtin_amdgcn_s_waitcnt(0);
        unsigned nloc = b.st[0], nx = b.st[1];
        if (nloc == 0u) { xcd_barrier_complete(bar, b.x, nloc, nx); b.st[0] = nloc; b.st[1] = nx; }
        const unsigned old = xb_add(&bar[XB_XSUB(b.x)], 1u);
        const unsigned gen = old / nloc;
        if (old + 1u == (gen + 1u) * nloc) {
            __builtin_amdgcn_fence(__ATOMIC_RELEASE, "agent");
            asm volatile("s_waitcnt vmcnt(0)" ::: "memory");
            const unsigned og = xb_add(&bar[XB_TOP], 1u);
            const unsigned tg = og / nx;
            if (og + 1u == (tg + 1u) * nx) xb_add(&bar[XB_TOPGEN], 1u);
            else XB_SPIN(xb_ld(&bar[XB_TOPGEN]) == tg, bar);
            __builtin_amdgcn_fence(__ATOMIC_ACQUIRE, "agent");
            xb_add(&bar[XB_XGEN(b.x)], 1u);
            asm volatile("s_waitcnt vmcnt(0)" ::: "memory");
        } else {
            XB_SPIN(xb_ld(&bar[XB_XGEN(b.x)]) == gen, bar);
            __builtin_amdgcn_fence(__ATOMIC_ACQUIRE, "agent");
            asm volatile("s_waitcnt vmcnt(0)" ::: "memory");
        }
    }
    __syncthreads();
}

constexpr int N_PHASES = 12;
__global__ void __launch_bounds__(NTHR, 2) mk_fwd(Args a) {
    extern __shared__ __attribute__((aligned(16))) unsigned char lds[];
    cg::grid_group grid = cg::this_grid();
    const int bid = blockIdx.x, nb = gridDim.x;
    const int lo = a.ph_lo, hi = a.ph_hi;
    volatile LAS unsigned* bst = (volatile LAS unsigned*)((LAS unsigned char*)lds + (LDS_BYTES - 16));
    if (threadIdx.x < 4) bst[threadIdx.x] = 0u;
    __syncthreads();
    XcdBarrier xbar = xcd_barrier_post((unsigned*)(a.ws + WS_CTL), bst);
#ifndef PROBE_PH
#define PROBE_PH -1
#endif
#define SEAM(k) do { if ((k) == 0) grid.sync(); else xcd_barrier(xbar); } while (0)
#define PHASE(k, body) if (lo <= (k) && (k) < hi) { for (int rep_ = 0; rep_ < ((k) == PROBE_PH ? 2 : 1); ++rep_) { body; if ((k) + 1 < hi || rep_ == 0 && (k) == PROBE_PH) SEAM(k); } }
    PHASE(0, ph0_prologue(a, bid, nb, lds))
    PHASE(1, row_norm_mod(a.in[0], a.in[4], (const float*)(a.ws + WS_MOD), 0, 1024, (f16*)(a.ws + WS_H), bid, nb))
    PHASE(2, ph2_inproj(a, bid, nb, lds))
    PHASE(3, ph3_pool_fast(a, bid, nb, lds); if (PROBE_PH == 30) ph3_pool_fast(a, bid, nb, lds); if (PROBE_PH == 31) ph3_index_fast<0>(a, bid, nb, lds); if (PROBE_PH == 32) ph3_index_fast<1>(a, bid, nb, lds); if (PROBE_PH == 33) ph3_index_fast<2>(a, bid, nb, lds); if (PROBE_PH == 34) ph3_index_fast<3>(a, bid, nb, lds); if (PROBE_PH == 35) ph3_index_fast<4>(a, bid, nb, lds); ph3_index_fast<0>(a, bid, nb, lds))
    PHASE(4, if (PROBE_PH == 41) ph4_attn_fast<1>(a, bid, nb, lds); if (PROBE_PH == 42) ph4_attn_fast<2>(a, bid, nb, lds); if (PROBE_PH == 43) ph4_attn_fast<3>(a, bid, nb, lds); if (PROBE_PH == 40) ph4_attn_fast<0>(a, bid, nb, lds); ph4_attn_fast<0>(a, bid, nb, lds))
    PHASE(5, ph5_outproj(a, bid, nb, lds))
    PHASE(6, row_norm_mod(a.out, a.in[13], (const float*)(a.ws + WS_MOD), 3072, 4096, (f16*)(a.ws + WS_H), bid, nb))
    PHASE(7, ph7_peerq(a, bid, nb, lds))
    PHASE(8, ph8_peersel_fast(a, bid, nb, lds))
    PHASE(9, ph9_sliced<0>(a, lds))
    PHASE(10, ph9b_combine(a, bid, nb))
    PHASE(11, ph9_sliced<1>(a, lds))
#undef PHASE
}

extern "C" void kernel_launch(void* const* d_in, const int* in_sizes, int n_in, void* d_out, int out_size, void* d_ws, size_t ws_size, hipStream_t stream) {
    static int grid = 0;
    if (grid == 0) {
        if (n_in != 18 || out_size != NT * ND || ws_size < WS_END) { fprintf(stderr, "kernel_launch: unexpected shapes (n_in %d out %d ws %zu)\n", n_in, out_size, ws_size); grid = -1; return; }
        int dev = 0, cus = 0, per_cu = 0;
        hipGetDevice(&dev); hipDeviceGetAttribute(&cus, hipDeviceAttributeMultiprocessorCount, dev);
        hipFuncSetAttribute((const void*)mk_fwd, hipFuncAttributeMaxDynamicSharedMemorySize, LDS_BYTES);
        hipOccupancyMaxActiveBlocksPerMultiprocessor(&per_cu, (const void*)mk_fwd, NTHR, LDS_BYTES);
        if (per_cu < 1) { fprintf(stderr, "kernel_launch: occupancy query says %d blocks/CU\n", per_cu); per_cu = 1; }
        grid = cus * 1;
        (void)hipGetLastError();
    }
    if (grid < 0) return;
    if (hipMemsetAsync((char*)d_ws + WS_CTL, 0, 32768, stream) != hipSuccess) { fprintf(stderr, "kernel_launch: memset of the barrier words failed\n"); return; }
    Args a{};
    for (int i = 0; i < 18; ++i) a.in[i] = (const float*)d_in[i];
    a.out = (float*)d_out; a.ws = (unsigned char*)d_ws;
#if MK_MULTI
    for (int ph = 0; ph < N_PHASES; ++ph) { a.ph_lo = ph; a.ph_hi = ph + 1; hipLaunchKernelGGL(mk_fwd, dim3(grid), dim3(NTHR), LDS_BYTES, stream, a); }
#else
    a.ph_lo = 0; a.ph_hi = N_PHASES;
    void* args[] = {&a};
    hipError_t e = hipLaunchCooperativeKernel((const void*)mk_fwd, dim3(grid), dim3(NTHR), args, LDS_BYTES, stream);
    if (e != hipSuccess) fprintf(stderr, "cooperative launch failed: %s (grid %d)\n", hipGetErrorString(e), grid);
#endif
}
```

```cpp
#include <hip/hip_runtime.h>
#include <hip/hip_cooperative_groups.h>
#include <cstdio>
#include <cstdint>
namespace cg = cooperative_groups;

#ifndef MK_MULTI
#define MK_MULTI 0
#endif

typedef _Float16 f16;
typedef _Float16 f16x8 __attribute__((ext_vector_type(8)));
typedef _Float16 f16x4 __attribute__((ext_vector_type(4)));
typedef float f32x4 __attribute__((ext_vector_type(4)));
typedef unsigned long long u64;
typedef unsigned short u16;

constexpr int NB = 8, NS = 8192, ND = 1024, NT = NB * NS;
constexpr int INW = 2632;
constexpr int NMAIN = 2304;
constexpr float EPS = 1e-6f;
constexpr int NTHR = 512, NWAVE = 8;

constexpr size_t MiB = 1u << 20;
constexpr size_t WS_CTL = 0;
constexpr size_t WS_MOD = 1 * MiB;
constexpr size_t WS_WIN = 2 * MiB;
constexpr size_t WS_WVT = 7 * MiB;
constexpr size_t WS_WOUT = 8 * MiB;
constexpr size_t WS_WQ = 10 * MiB;
constexpr size_t WS_SK = 14 * MiB;
constexpr size_t WS_PW = 14 * MiB + 512 * 1024;
constexpr size_t WS_UT = 16 * MiB;
constexpr size_t WS_VP = 48 * MiB;
constexpr size_t WS_H = 80 * MiB;
constexpr size_t WS_U = 208 * MiB;
constexpr size_t WS_Q = 272 * MiB;
constexpr size_t WS_K = 336 * MiB;
constexpr size_t WS_VT = 400 * MiB;
constexpr size_t WS_PQ = 208 * MiB;
constexpr size_t WS_QI = 464 * MiB;
constexpr size_t WS_KI = 528 * MiB;
constexpr size_t WS_WI = 536 * MiB;
constexpr size_t WS_MASK = 544 * MiB;
constexpr size_t WS_EID = 608 * MiB;
constexpr size_t WS_GW = 624 * MiB;
constexpr size_t WS_END = 656 * MiB;

constexpr int LDS_BYTES = 155648;
constexpr float PEER_USCALE = 256.f, PEER_VSCALE = 16.f;

struct Args { const float* in[18]; float* out; unsigned char* ws; int ph_lo, ph_hi; };

__host__ __device__ __forceinline__ int pos2log(int p) { return 64 * ((p >> 5) & 3) + 32 * (p >> 7) + 8 * ((p >> 2) & 3) + 4 * ((p >> 4) & 1) + (p & 3); }
__device__ __forceinline__ int maincol(int L) { if (L < 1536) return L; if (L < 2120) return L + 512; return -1; }

__device__ __forceinline__ float wave_sum(float v) {
#pragma unroll
    for (int o = 1; o < 64; o <<= 1) v += __shfl_xor(v, o);
    return v;
}
__device__ __forceinline__ float wave_max(float v) {
#pragma unroll
    for (int o = 1; o < 64; o <<= 1) v = fmaxf(v, __shfl_xor(v, o));
    return v;
}

__device__ void ph0_prologue(const Args& a, int bid, int nb, unsigned char* lds) {
    int tid = threadIdx.x; asm volatile("" : "+v"(tid));
    const float* c = a.in[1]; const float* ada_w = a.in[2]; const float* ada_b = a.in[3];
    float* sil = (float*)lds;
    for (int i = tid; i < NB * ND; i += NTHR) { const float v = c[i]; sil[i] = v / (1.f + __expf(-v)); }
    __syncthreads();
    float* mod = (float*)(a.ws + WS_MOD);
    const int gt = bid * NTHR + tid, ngt = nb * NTHR;
    for (int o = gt; o < NB * 6144; o += ngt) {
        const int b = o / 6144, j = o % 6144;
        float acc = ada_b[j];
        const float* sb = sil + b * ND;
        for (int k = 0; k < ND; ++k) acc += sb[k] * ada_w[(size_t)k * 6144 + j];
        mod[o] = acc;
    }
    const float* w_in = a.in[5]; const float* pool_w = a.in[6]; const float* w_out = a.in[12];
    const float* wq = a.in[14]; const float* sk = a.in[15]; const float* pu = a.in[16]; const float* pv = a.in[17];
    f16* WIN = (f16*)(a.ws + WS_WIN); f16* WVT = (f16*)(a.ws + WS_WVT); f16* WOUT = (f16*)(a.ws + WS_WOUT); f16* WQ = (f16*)(a.ws + WS_WQ);
    f16* SK = (f16*)(a.ws + WS_SK); f16* PW = (f16*)(a.ws + WS_PW); unsigned char* UT = a.ws + WS_UT; unsigned char* VP = a.ws + WS_VP;
    {
        __syncthreads();
        const int lane = tid & 63, wv_ = tid >> 6;
        float* scr = (float*)lds + wv_ * (64 * 33);
        constexpr int I_IN = 16 * (NMAIN / 32), I_VT = 16 * 16, I_OUT = 16 * 32, I_WQ = 16 * 64, I_ALL = I_IN + I_VT + I_OUT + I_WQ;
        for (int it = bid * NWAVE + wv_; it < I_ALL; it += nb * NWAVE) {
            int rr = it, kind = 0;
            if (rr >= I_IN) { rr -= I_IN; kind = 1; if (rr >= I_VT) { rr -= I_VT; kind = 2; if (rr >= I_OUT) { rr -= I_OUT; kind = 3; } } }
            const int npb = kind == 0 ? NMAIN / 32 : kind == 1 ? 16 : kind == 2 ? 32 : 64;
            const int k0 = (rr / npb) * 64, p0 = (rr % npb) * 32, p = p0 + (lane & 31);
            const float* W = kind <= 1 ? w_in : kind == 2 ? w_out : wq; const int ldw = kind <= 1 ? INW : kind == 2 ? 1024 : 2048;
            int col;
            if (kind == 0) col = maincol((p & ~255) + pos2log(p & 255)); else if (kind == 1) col = 1536 + p; else col = (p & ~255) + pos2log(p & 255);
#pragma unroll 8
            for (int i = 0; i < 32; ++i) { const int kk = 2 * i + (lane >> 5); scr[kk * 33 + (lane & 31)] = col >= 0 ? W[(size_t)(k0 + kk) * ldw + col] : 0.f; }
            f16* WT = kind == 0 ? WIN : kind == 1 ? WVT : kind == 2 ? WOUT : WQ;
            const int c8 = lane & 7;
#pragma unroll
            for (int j = 0; j < 4; ++j) { const int n = (lane >> 3) + 8 * j; const float* sp = scr + (8 * c8) * 33 + n;
                *(f16x8*)(WT + (size_t)(p0 + n) * ND + k0 + 8 * c8) = (f16x8){(f16)sp[0], (f16)sp[33], (f16)sp[66], (f16)sp[99], (f16)sp[132], (f16)sp[165], (f16)sp[198], (f16)sp[231]}; }
        }
    }
    for (int i = gt; i < 8 * 2 * 128 * 128; i += ngt) { const int hp = i >> 14, n = (i >> 7) & 127, d = i & 127;
        SK[((((hp * 4 + (n >> 5)) * 8 + (d >> 4)) * 2 + ((d >> 3) & 1)) * 32 + (n & 31)) * 8 + (d & 7)] = (f16)sk[i]; }
    for (int i = gt; i < 4 * 128 * 128; i += ngt) { const int g = i >> 14, cc = (i >> 7) & 127, d = i & 127;
        PW[(((((g * 8 + (d >> 4)) * 4 + (cc >> 5)) * 4 + ((cc >> 3) & 3)) * 16 + (d & 15)) << 3) + (cc & 7)] = (f16)pool_w[i]; }
    for (int i = gt; i < 16384 * 1024 / 4; i += ngt) { const f32x4 u = ((const f32x4*)pu)[i] * PEER_USCALE, v = ((const f32x4*)pv)[i] * PEER_VSCALE;
        int pu8 = __builtin_amdgcn_cvt_pk_bf8_f32(u.x, u.y, 0, false); pu8 = __builtin_amdgcn_cvt_pk_bf8_f32(u.z, u.w, pu8, true);
        int pv8 = __builtin_amdgcn_cvt_pk_bf8_f32(v.x, v.y, 0, false); pv8 = __builtin_amdgcn_cvt_pk_bf8_f32(v.z, v.w, pv8, true);
        ((int*)UT)[i] = pu8; ((int*)VP)[i] = pv8; }
}

__device__ void row_norm_mod(const float* src, const float* g, const float* mod, int sh_off, int sc_off, f16* dst, int bid, int nb) {
    int tid_ = threadIdx.x; asm volatile("" : "+v"(tid_)); const int lane = tid_ & 63, wave = tid_ >> 6;
    for (int row = bid * NWAVE + wave; row < NT; row += nb * NWAVE) {
        const int b = row / NS;
        const f32x4* xr = (const f32x4*)(src + (size_t)row * ND) + lane;
        f32x4 v[4]; float s = 0.f;
#pragma unroll
        for (int j = 0; j < 4; ++j) { v[j] = xr[64 * j]; s += v[j].x * v[j].x + v[j].y * v[j].y + v[j].z * v[j].z + v[j].w * v[j].w; }
        const float rstd = rsqrtf(wave_sum(s) * (1.f / ND) + EPS);
#pragma unroll
        for (int j = 0; j < 4; ++j) {
            const int col = lane * 4 + 256 * j;
            const f32x4 gg = *(const f32x4*)(g + col), sc = *(const f32x4*)(mod + b * 6144 + sc_off + col), sh = *(const f32x4*)(mod + b * 6144 + sh_off + col);
            f16x4 o;
            o.x = (f16)(v[j].x * rstd * gg.x * (1.f + sc.x) + sh.x); o.y = (f16)(v[j].y * rstd * gg.y * (1.f + sc.y) + sh.y);
            o.z = (f16)(v[j].z * rstd * gg.z * (1.f + sc.z) + sh.z); o.w = (f16)(v[j].w * rstd * gg.w * (1.f + sc.w) + sh.w);
            *(f16x4*)(dst + (size_t)row * ND + col) = o;
        }
    }
}


namespace pg8 {
#define PG8_LAS __attribute__((address_space(3)))
constexpr int BM = 256, BK = 64, HALF = 128, HTB = HALF * BK * 2, STAGE_BYTES = 8 * HTB, NXCD = 8, WGM = 8;
__host__ __device__ __forceinline__ int lds_byte(int r, int c) { const int st = (r >> 4) * 2 + (c >> 5), rr = r & 15, cc = c & 31, ob = rr * 64 + cc * 2; return st * 1024 + (ob ^ (((ob >> 9) & 1) << 5)); }
__host__ __device__ __forceinline__ void stage_rc(int b, int& R, int& C) { const int st = b / 1024, sb = b % 1024, swz = sb ^ (((sb >> 9) & 1) << 5); R = (st >> 1) * 16 + swz / 64; C = (st & 1) * 32 + (swz % 64) / 2; }
struct Unit { int pm, pn; };
struct Gemm { const f16* A; const f16* Bt; int M, N, K; };
struct StaticOrder {
    int nM, nN, nwg, G, c;
    __host__ __device__ void init(int M, int N, int G_, int c_) { nM = M / BM; nN = N / BM; nwg = nM * nN; G = G_; c = c_; }
    __host__ __device__ bool next(int i, Unit& u) const {
        const long L = (long)i * G + c; if (L >= nwg) return false;
        int wgid = (int)L; { const int q = nwg / NXCD, r = nwg % NXCD, xcd = wgid % NXCD, off = wgid / NXCD; wgid = (xcd < r ? xcd * (q + 1) : r * (q + 1) + (xcd - r) * q) + off; }
        const int nig = WGM * nN, gid = wgid / nig, fm = gid * WGM, gsz = (nM - fm) < WGM ? (nM - fm) : WGM;
        u.pm = fm + ((wgid % nig) % gsz); u.pn = (wgid % nig) / gsz; return true;
    }
};
template <class Epi>
__device__ __forceinline__ void gemm_phase(PG8_LAS unsigned char* lds, const Gemm g, const StaticOrder& S, const Epi& E) {
    int tid = threadIdx.x; asm volatile("" : "+v"(tid));
    const int wid = __builtin_amdgcn_readfirstlane(tid >> 6), lane = tid & 63, wr = wid >> 2, wc = wid & 3, fr = lane & 15, fq = lane >> 4;
    const int K = g.K, nt = K / BK;
    unsigned voffA[2];
#pragma unroll
    for (int i = 0; i < 2; ++i) { int R, C; stage_rc(tid * 16 + i * 8192, R, C); voffA[i] = (unsigned)(R * K + C) * 2u; }
    const size_t kstep = (size_t)(BK * 2);
    const size_t hstep = (size_t)HALF * K * 2;
    const size_t tstep = 2 * hstep;
    const unsigned ldsw = (unsigned)wid * 1024u;
    const int aoff = lds_byte(wr * 64 + fr, fq * 8), boff = lds_byte(wc * 32 + fr, fq * 8);
#define PG8_SA(b, h) (((b) * 2 + (h)) * HTB)
#define PG8_SB(b, h) ((4 + (b) * 2 + (h)) * HTB)
#define PG8_STAGE(bufoff, gbase, voff) do { _Pragma("unroll") for (int _i = 0; _i < 2; ++_i) \
        __builtin_amdgcn_global_load_lds((const unsigned*)((const char*)(gbase) + (voff)[_i]), (PG8_LAS unsigned*)(lds + (bufoff) + ldsw + _i * 8192), 16, 0, 0); } while (0)
#define PG8_LDA(dst, b, h) do { _Pragma("unroll") for (int m = 0; m < 4; ++m) _Pragma("unroll") for (int k = 0; k < 2; ++k) dst[m][k] = *(const PG8_LAS f16x8*)(lds + PG8_SA(b, h) + aoff + m * 2048 + k * 1024); } while (0)
#define PG8_LDB(dst, b, h) do { _Pragma("unroll") for (int n = 0; n < 2; ++n) _Pragma("unroll") for (int k = 0; k < 2; ++k) dst[n][k] = *(const PG8_LAS f16x8*)(lds + PG8_SB(b, h) + boff + n * 2048 + k * 1024); } while (0)
#define PG8_MMA(ai, bj, At, Bt) do { __builtin_amdgcn_s_setprio(1); _Pragma("unroll") for (int m = 0; m < 4; ++m) _Pragma("unroll") for (int n = 0; n < 2; ++n) _Pragma("unroll") for (int k = 0; k < 2; ++k) \
        acc[ai][bj][m][n] = __builtin_amdgcn_mfma_f32_16x16x32_f16(Bt[n][k], At[m][k], acc[ai][bj][m][n], 0, 0, 0); __builtin_amdgcn_s_setprio(0); } while (0)
#define PG8_WAIT_V(n) asm volatile("s_waitcnt vmcnt(" #n ")" ::: "memory")
#define PG8_WAIT_L(n) asm volatile("s_waitcnt lgkmcnt(" #n ")" ::: "memory")
#define PG8_BAR __builtin_amdgcn_s_barrier()
#define PG8_SCHED __builtin_amdgcn_sched_barrier(0)
    Unit cur, nxt; int ui = 0;
    if (!S.next(0, cur)) return;
    f32x4 acc[2][2][4][2];
#pragma unroll
    for (int a = 0; a < 2; ++a)
#pragma unroll
        for (int b = 0; b < 2; ++b)
#pragma unroll
            for (int m = 0; m < 4; ++m)
#pragma unroll
                for (int n = 0; n < 2; ++n) acc[a][b][m][n] = (f32x4){0.f, 0.f, 0.f, 0.f};
    f16x8 At[4][2], B0[2][2], B1[2][2];
    const char* cA = (const char*)g.A + (size_t)cur.pm * tstep; const char* cB = (const char*)g.Bt + (size_t)cur.pn * tstep;
    PG8_STAGE(PG8_SB(0, 0), cB, voffA); PG8_STAGE(PG8_SB(0, 1), cB + hstep, voffA); PG8_STAGE(PG8_SA(0, 0), cA, voffA); PG8_STAGE(PG8_SA(0, 1), cA + hstep, voffA);
    if (wr == 1) PG8_BAR;
    PG8_WAIT_V(2); PG8_BAR;
    PG8_STAGE(PG8_SB(1, 0), cB + kstep, voffA); PG8_STAGE(PG8_SA(1, 0), cA + kstep, voffA); PG8_STAGE(PG8_SB(1, 1), cB + hstep + kstep, voffA);
    PG8_WAIT_V(6); PG8_BAR;
    for (;;) {
        const bool has_next = S.next(ui + 1, nxt);
        const char* nA = has_next ? (const char*)g.A + (size_t)nxt.pm * tstep : cA; const char* nB = has_next ? (const char*)g.Bt + (size_t)nxt.pn * tstep : cB;
        for (int t = 0; t < nt; t += 2) {
            const bool last = (t == nt - 2);
            const char* a1 = cA + (size_t)(t + 1) * kstep;
            const char* a2 = last ? nA : cA + (size_t)(t + 2) * kstep; const char* b2 = last ? nB : cB + (size_t)(t + 2) * kstep;
            const char* a3 = a2 + kstep; const char* b3 = b2 + kstep;
            PG8_LDB(B0, 0, 0); PG8_LDB(B1, 0, 1); PG8_SCHED; PG8_LDA(At, 0, 0); PG8_STAGE(PG8_SA(1, 1), a1 + hstep, voffA);
            PG8_WAIT_V(8); PG8_WAIT_L(0); PG8_BAR; PG8_MMA(0, 0, At, B0); PG8_MMA(0, 1, At, B1); PG8_BAR; PG8_SCHED;
            PG8_LDA(At, 0, 1); PG8_STAGE(PG8_SB(0, 0), b2, voffA); PG8_STAGE(PG8_SB(0, 1), b2 + hstep, voffA); PG8_STAGE(PG8_SA(0, 0), a2, voffA);
            PG8_WAIT_V(8); PG8_WAIT_L(0); PG8_BAR; PG8_MMA(1, 0, At, B0); PG8_MMA(1, 1, At, B1); PG8_BAR; PG8_SCHED;
            PG8_LDB(B0, 1, 0); PG8_LDB(B1, 1, 1); PG8_SCHED; PG8_LDA(At, 1, 0); PG8_STAGE(PG8_SA(0, 1), a2 + hstep, voffA);
            PG8_WAIT_V(8); PG8_WAIT_L(0); PG8_BAR; PG8_MMA(0, 0, At, B0); PG8_MMA(0, 1, At, B1); PG8_BAR; PG8_SCHED;
            PG8_LDA(At, 1, 1); PG8_STAGE(PG8_SB(1, 0), b3, voffA); PG8_STAGE(PG8_SB(1, 1), b3 + hstep, voffA); PG8_STAGE(PG8_SA(1, 0), a3, voffA);
            PG8_WAIT_V(8); PG8_WAIT_L(0); PG8_BAR; PG8_MMA(1, 0, At, B0); PG8_MMA(1, 1, At, B1); PG8_BAR; PG8_SCHED;
        }
        if (wr == 0) PG8_BAR;
        E(acc, cur, wr, wc, fr, fq);
        if (!has_next) break;
#pragma unroll
        for (int a = 0; a < 2; ++a)
#pragma unroll
            for (int b = 0; b < 2; ++b)
#pragma unroll
                for (int m = 0; m < 4; ++m)
#pragma unroll
                    for (int n = 0; n < 2; ++n) acc[a][b][m][n] = (f32x4){0.f, 0.f, 0.f, 0.f};
        cur = nxt; cA = nA; cB = nB; ++ui;
        if (wr == 1) PG8_BAR;
    }
    PG8_WAIT_V(0);
    PG8_BAR;
#undef PG8_SA
#undef PG8_SB
#undef PG8_STAGE
#undef PG8_LDA
#undef PG8_LDB
#undef PG8_MMA
#undef PG8_WAIT_V
#undef PG8_WAIT_L
#undef PG8_BAR
#undef PG8_SCHED
}

typedef f32x4 Acc[2][2][4][2];
struct EpiMain {
    unsigned char* ws; const float *qg, *kg;
    __device__ __forceinline__ void operator()(const Acc& acc, const Unit& u, int wr, int wc, int fr, int fq) const {
        const int row0 = u.pm * BM + wr * 64 + fr, pn = u.pn;
        if (pn == 8) {
            if (wc == 0) {
#pragma unroll
                for (int ai = 0; ai < 2; ++ai)
#pragma unroll
                    for (int m = 0; m < 4; ++m) { const size_t row = row0 + ai * HALF + m * 16;
#pragma unroll
                        for (int bj = 0; bj < 2; ++bj) { const f32x4 v0 = acc[ai][bj][m][0], v1 = acc[ai][bj][m][1];
                            *(f16x8*)((f16*)(ws + WS_KI) + (((row >> 5) * 8 + 4 * bj + fq) * 32 + (row & 31)) * 8) = (f16x8){(f16)v0[0], (f16)v0[1], (f16)v0[2], (f16)v0[3], (f16)v1[0], (f16)v1[1], (f16)v1[2], (f16)v1[3]}; } }
            } else if (wc == 1 && fq == 0) {
#pragma unroll
                for (int ai = 0; ai < 2; ++ai)
#pragma unroll
                    for (int m = 0; m < 4; ++m) { const size_t row = row0 + ai * HALF + m * 16;
                        *(f32x4*)((float*)(ws + WS_WI) + row * 8) = acc[ai][0][m][0] * 0.35355339059327373f; *(f32x4*)((float*)(ws + WS_WI) + row * 8 + 4) = acc[ai][0][m][1] * 0.35355339059327373f; }
            }
            return;
        }
        const int kind = pn >> 1;
        f16* base = (f16*)(ws + (kind == 0 ? WS_U : kind == 1 ? WS_Q : kind == 2 ? WS_K : WS_QI));
        const int col0 = (pn & 1) * 256 + 64 * wc + 8 * fq;
        if (kind == 1 || kind == 2) {
            const float* gp = (kind == 1 ? qg : kg) + 8 * fq;
#pragma unroll
            for (int ai = 0; ai < 2; ++ai)
#pragma unroll
                for (int m = 0; m < 4; ++m) { const size_t row = row0 + ai * HALF + m * 16;
                    float ss = 0.f;
#pragma unroll
                    for (int bj = 0; bj < 2; ++bj)
#pragma unroll
                        for (int n = 0; n < 2; ++n) { const f32x4 v = acc[ai][bj][m][n]; ss += v[0] * v[0] + v[1] * v[1] + v[2] * v[2] + v[3] * v[3]; }
                    ss += __shfl_xor(ss, 16); ss += __shfl_xor(ss, 32);
                    const float rstd = rsqrtf(ss * (1.f / 64.f) + EPS);
#pragma unroll
                    for (int bj = 0; bj < 2; ++bj) { const f32x4 v0 = acc[ai][bj][m][0] * rstd * *(const f32x4*)(gp + 32 * bj), v1 = acc[ai][bj][m][1] * rstd * *(const f32x4*)(gp + 32 * bj + 4);
                        *(f16x8*)(base + row * 512 + col0 + 32 * bj) = (f16x8){(f16)v0[0], (f16)v0[1], (f16)v0[2], (f16)v0[3], (f16)v1[0], (f16)v1[1], (f16)v1[2], (f16)v1[3]}; }
                    asm volatile("" ::: "memory"); }
        } else if (kind == 3) {
            const int hd = (pn & 1) * 4 + wc;
#pragma unroll
            for (int ai = 0; ai < 2; ++ai)
#pragma unroll
                for (int m = 0; m < 4; ++m) { const size_t row = row0 + ai * HALF + m * 16; const int ql = (int)(row & 7);
                    const int rr = (hd & 3) | (((ql >> 1) & 1) << 2) | ((hd >> 2) << 3) | ((ql & 1) << 4);
#pragma unroll
                    for (int bj = 0; bj < 2; ++bj) { const f32x4 v0 = acc[ai][bj][m][0], v1 = acc[ai][bj][m][1]; const int chunk = fq + 4 * bj;
                        *(f16x8*)(base + ((((((row >> 3) * 2 + (ql >> 2)) * 4 + (chunk >> 1)) * 2 + (chunk & 1)) * 32 + rr) << 3)) = (f16x8){(f16)v0[0], (f16)v0[1], (f16)v0[2], (f16)v0[3], (f16)v1[0], (f16)v1[1], (f16)v1[2], (f16)v1[3]}; } }
        } else {
#pragma unroll
            for (int ai = 0; ai < 2; ++ai)
#pragma unroll
                for (int m = 0; m < 4; ++m) { const size_t row = row0 + ai * HALF + m * 16;
#pragma unroll
                    for (int bj = 0; bj < 2; ++bj) { const f32x4 v0 = acc[ai][bj][m][0], v1 = acc[ai][bj][m][1];
                        *(f16x8*)(base + row * 512 + col0 + 32 * bj) = (f16x8){(f16)v0[0], (f16)v0[1], (f16)v0[2], (f16)v0[3], (f16)v1[0], (f16)v1[1], (f16)v1[2], (f16)v1[3]}; } }
        }
    }
};
struct EpiVT {
    f16* VT;
    __device__ __forceinline__ void operator()(const Acc& acc, const Unit& u, int wr, int wc, int fr, int fq) const {
        const int row0 = u.pm * BM + wr * 64 + fr, col0 = u.pn * BM + 32 * wc + 4 * fq;
#pragma unroll
        for (int ai = 0; ai < 2; ++ai)
#pragma unroll
            for (int m = 0; m < 4; ++m) { const size_t row = row0 + ai * HALF + m * 16;
#pragma unroll
                for (int bj = 0; bj < 2; ++bj)
#pragma unroll
                    for (int n = 0; n < 2; ++n) { const f32x4 v = acc[ai][bj][m][n];
                        *(f16x4*)(VT + row * NT + col0 + 128 * bj + 16 * n) = (f16x4){(f16)v[0], (f16)v[1], (f16)v[2], (f16)v[3]}; } }
    }
};
struct EpiOut {
    const float* x; const float* mod; float* out;
    __device__ __forceinline__ void operator()(const Acc& acc, const Unit& u, int wr, int wc, int fr, int fq) const {
        const int row0 = u.pm * BM + wr * 64 + fr, col0 = u.pn * BM + 64 * wc + 8 * fq;
        const float* g1 = mod + ((u.pm * BM) / NS) * 6144 + 2048 + col0;
        f32x4 g4[2][2];
#pragma unroll
        for (int bj = 0; bj < 2; ++bj)
#pragma unroll
            for (int n = 0; n < 2; ++n) g4[bj][n] = *(const f32x4*)(g1 + 32 * bj + 4 * n);
#pragma unroll
        for (int ai = 0; ai < 2; ++ai)
#pragma unroll
            for (int m = 0; m < 4; ++m) { const size_t off = (size_t)(row0 + ai * HALF + m * 16) * ND + col0;
#pragma unroll
                for (int bj = 0; bj < 2; ++bj)
#pragma unroll
                    for (int n = 0; n < 2; ++n) { const f32x4 xv = *(const f32x4*)(x + off + 32 * bj + 4 * n);
                        *(f32x4*)(out + off + 32 * bj + 4 * n) = xv + g4[bj][n] * acc[ai][bj][m][n]; } }
    }
};
struct EpiPQ {
    f16* PQ;
    __device__ __forceinline__ void operator()(const Acc& acc, const Unit& u, int wr, int wc, int fr, int fq) const {
        const int row0 = u.pm * BM + wr * 64 + fr, col0 = u.pn * BM + 64 * wc + 8 * fq;
#pragma unroll
        for (int ai = 0; ai < 2; ++ai)
#pragma unroll
            for (int m = 0; m < 4; ++m) { const size_t row = row0 + ai * HALF + m * 16;
#pragma unroll
                for (int bj = 0; bj < 2; ++bj) { const f32x4 v0 = acc[ai][bj][m][0], v1 = acc[ai][bj][m][1];
                    *(f16x8*)(PQ + ((((row >> 5) * 256 + ((col0 + 32 * bj) >> 3)) * 32 + (row & 31)) << 3)) = (f16x8){(f16)v0[0], (f16)v0[1], (f16)v0[2], (f16)v0[3], (f16)v1[0], (f16)v1[1], (f16)v1[2], (f16)v1[3]}; } }
    }
};
}

__device__ __forceinline__ void ph2_inproj(const Args& a, int bid, int nb, unsigned char* lds) {
    const f16* H = (const f16*)(a.ws + WS_H); const f16* WIN = (const f16*)(a.ws + WS_WIN); const f16* WVT = (const f16*)(a.ws + WS_WVT);
    PG8_LAS unsigned char* l3 = (PG8_LAS unsigned char*)lds;
    { pg8::Gemm g{H, WIN, NT, NMAIN, ND}; pg8::StaticOrder S; S.init(NT, NMAIN, nb, bid);
      pg8::EpiMain E{a.ws, a.in[9], a.in[10]};
      pg8::gemm_phase(l3, g, S, E); }
    { pg8::Gemm g{WVT, H, 512, NT, ND}; pg8::StaticOrder S; S.init(512, NT, nb, bid);
      pg8::EpiVT E{(f16*)(a.ws + WS_VT)};
      pg8::gemm_phase(l3, g, S, E); }
}


constexpr int PPITCH = 1040;
__device__ __forceinline__ void ph3_pool_fast(const Args& a, int bid, int nb, unsigned char* lds) {
    int tid = threadIdx.x; asm volatile("" : "+v"(tid));
    const int lane = tid & 63, wave = __builtin_amdgcn_readfirstlane(tid >> 6), fr = lane & 15, fq = lane >> 4;
    const f16* U = (const f16*)(a.ws + WS_U); const f16* PW = (const f16*)(a.ws + WS_PW); f16* MIX = (f16*)(a.ws + WS_H);
    const float* pscale = a.in[7]; const float* pg = a.in[8];
    float* red = (float*)(lds + 32 * PPITCH);
    typedef _Float16 h2 __attribute__((ext_vector_type(2)));
    for (int item = bid; item < NT / 32; item += nb) {
        const int t0 = item * 32;
        __syncthreads();
        {
            const int cg8 = tid & 63, tq = tid >> 6, gch = cg8 >> 4, win = 2 << gch;
            const int tb = t0 + 4 * tq, tl0 = tb % NS;
            const f16* up = U + (size_t)(tb - tl0) * 512 + 8 * cg8;
            float sm[8];
#pragma unroll
            for (int j = 0; j < 8; ++j) sm[j] = 0.f;
            f16x8 hist_[15];
#pragma unroll
            for (int q = 0; q < 15; ++q) { const int rr = tl0 - 15 + q; hist_[q] = (q >= 16 - win && rr >= 0) ? *(const f16x8*)(up + (size_t)rr * 512) : (f16x8){0, 0, 0, 0, 0, 0, 0, 0}; }
            f16x8 cur_[4];
#pragma unroll
            for (int k = 0; k < 4; ++k) cur_[k] = *(const f16x8*)(up + (size_t)(tl0 + k) * 512);
#pragma unroll
            for (int q = 0; q < 15; ++q)
#pragma unroll
                for (int j = 0; j < 8; ++j) sm[j] += (float)hist_[q][j];
#pragma unroll
            for (int k = 0; k < 4; ++k) {
                const int tl = tl0 + k;
                const float ic = 1.f / (float)((tl + 1 < win) ? tl + 1 : win);
                f16x8 o;
#pragma unroll
                for (int j = 0; j < 8; ++j) { sm[j] += (float)cur_[k][j]; o[j] = (f16)(sm[j] * ic - (float)cur_[k][j]); }
                *(f16x8*)(lds + (4 * tq + k) * PPITCH + 16 * cg8) = o;
                if (k < 3) {
#pragma unroll
                    for (int j = 0; j < 8; ++j) {
                        float dv;
                        const int q = 16 - win + k;
                        dv = 0.f;
#pragma unroll
                        for (int qq = 0; qq < 15; ++qq) if (qq == q) dv = (float)hist_[qq][j];
#pragma unroll
                        for (int kk = 0; kk < 3; ++kk) if (q == 15 + kk) dv = (float)cur_[kk][j];
                        sm[j] -= dv;
                    }
                }
            }
        }
        __syncthreads();
        const int g = wave >> 1, th = wave & 1;
        f32x4 acc[8];
#pragma unroll
        for (int nt = 0; nt < 8; ++nt) acc[nt] = (f32x4){0.f, 0.f, 0.f, 0.f};
#pragma unroll
        for (int ks = 0; ks < 4; ++ks) {
            const f16x8 bf = *(const f16x8*)(lds + (16 * th + fr) * PPITCH + (g * 128 + 32 * ks + 8 * fq) * 2);
#pragma unroll
            for (int nt = 0; nt < 8; ++nt) { const f16x8 af = *(const f16x8*)(PW + (((((g * 8 + nt) * 4 + ks) * 4 + fq) * 16 + fr) << 3));
                acc[nt] = __builtin_amdgcn_mfma_f32_16x16x32_f16(af, bf, acc[nt], 0, 0, 0); }
        }
        float ss = 0.f;
#pragma unroll
        for (int nt = 0; nt < 8; ++nt) { const f32x4 sc = *(const f32x4*)(pscale + g * 128 + 16 * nt + 4 * fq); acc[nt] = acc[nt] * sc;
            ss += acc[nt][0] * acc[nt][0] + acc[nt][1] * acc[nt][1] + acc[nt][2] * acc[nt][2] + acc[nt][3] * acc[nt][3]; }
        ss += __shfl_xor(ss, 16); ss += __shfl_xor(ss, 32);
        if (fq == 0) red[(16 * th + fr) * 4 + g] = ss;
        __syncthreads();
        const f32x4 r4 = *(const f32x4*)(red + (16 * th + fr) * 4);
        const float rstd = rsqrtf((r4[0] + r4[1] + r4[2] + r4[3]) * (1.f / 512.f) + EPS);
        const size_t orow = (size_t)(t0 + 16 * th + fr) * ND + g * 128 + 4 * fq;
#pragma unroll
        for (int nt = 0; nt < 8; ++nt) { const f32x4 gg = *(const f32x4*)(pg + g * 128 + 16 * nt + 4 * fq); const f32x4 v = acc[nt] * rstd * gg;
            *(f16x4*)(MIX + orow + 16 * nt) = (f16x4){(f16)v[0], (f16)v[1], (f16)v[2], (f16)v[3]}; }
    }
    __syncthreads();
}


typedef float f32x16 __attribute__((ext_vector_type(16)));
typedef float f32x2 __attribute__((ext_vector_type(2)));
typedef unsigned u32x4 __attribute__((ext_vector_type(4)));

constexpr int IDX_KPITCH = 16384 + 16;
constexpr int IDX_HPITCH = 516;
template <int NBL>
__device__ __forceinline__ int wave_pick(const unsigned (&cc)[NBL], unsigned target, int lane, unsigned& rem_out) {
    unsigned tot = 0u;
#pragma unroll
    for (int j = 0; j < NBL; ++j) tot += cc[j];
    unsigned S = tot;
#pragma unroll
    for (int o = 1; o < 64; o <<= 1) { const unsigned v = __shfl_down(S, o); if (lane + o < 64) S += v; }
    const unsigned above = S - tot;
    const bool hit = (above < target) && (S >= target);
    const u64 bal = __ballot(hit);
    const int L = bal ? __builtin_ctzll(bal) : 0;
    int bin = 0; unsigned rem = target;
    { unsigned run = above; bool done = false;
#pragma unroll
      for (int j = NBL - 1; j >= 0; --j) { if (!done) { if (run + cc[j] >= target) { bin = NBL * lane + j; rem = target - run; done = true; } else run += cc[j]; } } }
    bin = __shfl(bin, L); rem_out = __shfl(rem, L);
    return bin;
}
template <int MODE>
__device__ __forceinline__ void ph3_index_fast(const Args& a, int bid, int nb, unsigned char* lds) {
    int tid = threadIdx.x; asm volatile("" : "+v"(tid));
    const int lane = tid & 63, wave = __builtin_amdgcn_readfirstlane(tid >> 6), r = lane & 31, hh = lane >> 5;
    const f16* QI = (const f16*)(a.ws + WS_QI); const f16* KI = (const f16*)(a.ws + WS_KI); const float* WI = (const float*)(a.ws + WS_WI);
    u64* MASK = (u64*)(a.ws + WS_MASK);
    unsigned* hist = (unsigned*)(lds + 8 * IDX_KPITCH);
    f16x8 af[2][4]; f32x2 wv2[2][8];
#define IDX_LOAD_FRAGS(t0_) do { \
        _Pragma("unroll") for (int rt = 0; rt < 2; ++rt) { \
            _Pragma("unroll") for (int ks = 0; ks < 4; ++ks) af[rt][ks] = *(const f16x8*)(QI + ((((((size_t)((t0_) >> 3) * 2 + rt) * 4 + ks) * 2 + hh) * 32 + r) << 3)); \
            _Pragma("unroll") for (int qq = 0; qq < 2; ++qq) { const float* wp = WI + (size_t)((t0_) + 4 * rt + 2 * hh + qq) * 8; const f32x4 w0 = *(const f32x4*)wp * 0.125f, w1 = *(const f32x4*)(wp + 4) * 0.125f; \
                wv2[rt][4 * qq + 0] = (f32x2){w0[0], w0[1]}; wv2[rt][4 * qq + 1] = (f32x2){w0[2], w0[3]}; wv2[rt][4 * qq + 2] = (f32x2){w1[0], w1[1]}; wv2[rt][4 * qq + 3] = (f32x2){w1[2], w1[3]}; } \
        } } while (0)
    for (int round = 0; round * nb < 256; ++round) {
        const int p = round * nb + ((round & 1) ? (nb - 1 - bid) : bid);
        if (p < 256) { const int tg = p >> 3, b_ = p & 7, t0l = tg * 8, ch_ = t0l >> 6, t0_ = b_ * NS + t0l;
            if (tid < 8 * (ch_ + 1)) { const int q = tid / (ch_ + 1), w = tid % (ch_ + 1); MASK[((size_t)b_ * 128 + w) * NS + t0l + q] = ~0ull; } }
    }
#define IDX_P(round_) ((round_) * nb + (((round_) & 1) ? (nb - 1 - bid) : bid))
    int round = 0;
    while (round * nb < 8192 && !(IDX_P(round) >= 256 && IDX_P(round) < 8192)) ++round;
    if (round * nb < 8192) { const int p0 = IDX_P(round); IDX_LOAD_FRAGS((p0 & 7) * NS + (p0 >> 3) * 8); }
    for (; round * nb < 8192; ) {
        const int p = IDX_P(round);
        int rnext = round + 1;
        while (rnext * nb < 8192 && !(IDX_P(rnext) >= 256 && IDX_P(rnext) < 8192)) ++rnext;
        const bool has_next = rnext * nb < 8192;
        const int pn = has_next ? IDX_P(rnext) : p;
        const int tg = p >> 3, b = p & 7, t0l = tg * 8, ch = t0l >> 6, nadm = 64 * (ch + 1), t0 = b * NS + t0l;
        const int t0n = (pn & 7) * NS + (pn >> 3) * 8;
        round = has_next ? rnext : 8192;
        __syncthreads();
#pragma unroll
        for (int i = 0; i < 9; ++i) if (tid + i * NTHR < 8 * IDX_HPITCH) hist[tid + i * NTHR] = 0u;
        __syncthreads();
        const int nkb = nadm >> 5;
        const f16* kbase = KI + ((size_t)(b * (NS / 32)) * 8 + hh) * 256 + r * 8;
#define IDX_LOADB(dst, kb_) do { _Pragma("unroll") for (int ks = 0; ks < 4; ++ks) dst[ks] = *(const f16x8*)(kbase + ((size_t)(kb_) * 8 + 2 * ks) * 256); } while (0)
#define IDX_BLOCK(bfrag, kb_) do { \
            f32x16 acc[2]; \
            _Pragma("unroll") for (int rt = 0; rt < 2; ++rt) { acc[rt] = (f32x16){0.f, 0.f, 0.f, 0.f, 0.f, 0.f, 0.f, 0.f, 0.f, 0.f, 0.f, 0.f, 0.f, 0.f, 0.f, 0.f}; \
                _Pragma("unroll") for (int ks = 0; ks < 4; ++ks) acc[rt] = __builtin_amdgcn_mfma_f32_32x32x16_f16(af[rt][ks], bfrag[ks], acc[rt], 0, 0, 0); } \
            _Pragma("unroll") for (int rt = 0; rt < 2; ++rt) \
                _Pragma("unroll") for (int qq = 0; qq < 2; ++qq) { \
                    f32x2 t2 = (f32x2){0.f, 0.f}; \
                    _Pragma("unroll") for (int hp = 0; hp < 4; ++hp) { const f32x2 r2 = (f32x2){__int_as_float(max(__float_as_int(acc[rt][8 * qq + 2 * hp]), 0)), __int_as_float(max(__float_as_int(acc[rt][8 * qq + 2 * hp + 1]), 0))}; \
                        t2 = __builtin_elementwise_fma(wv2[rt][4 * qq + hp], r2, t2); } \
                    const float sc = t2[0] + t2[1]; \
                    const f16 sh = (f16)sc; const unsigned bits = (unsigned)__builtin_bit_cast(unsigned short, sh); \
                    const unsigned key = (bits & 0x8000u) ? (~bits & 0xFFFFu) : (bits | 0x8000u); \
                    const int q = 4 * rt + 2 * hh + qq; \
                    if (MODE != 2) *(u16*)(lds + q * IDX_KPITCH + ((kb_) * 32 + r) * 2) = (u16)key; \
                    if (MODE != 2 && MODE != 4) atomicAdd(&hist[q * IDX_HPITCH + (key >> 7)], (key & 64u) ? 0x10000u : 1u); \
                    if (MODE == 2) sink += key; \
                } } while (0)
        f16x8 bf0[4], bf1[4], bf2[4]; unsigned sink = 0u;
        if (wave >= 4) __builtin_amdgcn_s_sleep(5);
        if (wave < nkb) IDX_LOADB(bf0, wave);
        if (wave + 8 < nkb) IDX_LOADB(bf1, wave + 8);
        if (wave + 16 < nkb) IDX_LOADB(bf2, wave + 16);
        if (MODE != 3) for (int kb = wave; kb < nkb; kb += 24) {
            IDX_BLOCK(bf0, kb);
            if (kb + 24 < nkb) IDX_LOADB(bf0, kb + 24);
            if (kb + 8 < nkb) { IDX_BLOCK(bf1, kb + 8); if (kb + 32 < nkb) IDX_LOADB(bf1, kb + 32); }
            if (kb + 16 < nkb) { IDX_BLOCK(bf2, kb + 16); if (kb + 40 < nkb) IDX_LOADB(bf2, kb + 40); }
        }
#undef IDX_LOADB
#undef IDX_BLOCK
        if (MODE == 2 && sink == 0xdeadbeefu) hist[tid] = sink;
        IDX_LOAD_FRAGS(t0n);
        __syncthreads();
        if (MODE != 1) {
            unsigned* hw = hist + wave * IDX_HPITCH;
            const unsigned char* krow = lds + wave * IDX_KPITCH;
            unsigned rem1 = 0u, rem2 = 0u;
            int b1;
            {   const u32x4 d0 = *(const u32x4*)(hw + 8 * lane), d1 = *(const u32x4*)(hw + 8 * lane + 4);
                const unsigned dd[8] = {d0.x, d0.y, d0.z, d0.w, d1.x, d1.y, d1.z, d1.w};
                unsigned cc[16];
#pragma unroll
                for (int j = 0; j < 8; ++j) { cc[2 * j] = dd[j] & 0xFFFFu; cc[2 * j + 1] = dd[j] >> 16; }
                b1 = wave_pick<16>(cc, 256u, lane, rem1); }
            hw[lane] = 0u;
            const int nit = (nadm + 511) >> 9;
            for (int it = 0; it < nit; ++it) {
                const int idx = (it * 64 + lane) * 8;
                if (idx < nadm) { const u32x4 k4 = *(const u32x4*)(krow + idx * 2);
                    const unsigned kk[4] = {k4.x, k4.y, k4.z, k4.w};
                    unsigned hit = 0u;
#pragma unroll
                    for (int j = 0; j < 4; ++j) { hit |= (((kk[j] & 0xFFFFu) >> 6) == (unsigned)b1 ? 1u : 0u) << (2 * j); hit |= ((kk[j] >> 22) == (unsigned)b1 ? 1u : 0u) << (2 * j + 1); }
                    if (hit) {
#pragma unroll
                        for (int j = 0; j < 4; ++j) { const unsigned k0 = kk[j] & 0xFFFFu, k1 = kk[j] >> 16;
                            if (hit & (1u << (2 * j))) atomicAdd(&hw[k0 & 63u], 1u);
                            if (hit & (2u << (2 * j))) atomicAdd(&hw[k1 & 63u], 1u); }
                    } }
            }
            int b2;
            { const unsigned c1[1] = {hw[lane]}; b2 = wave_pick<1>(c1, rem1, lane, rem2); }
            const unsigned tau = ((unsigned)b1 << 6) | (unsigned)b2;
            const size_t mrow = (size_t)(t0 + wave) * 128;
            for (int it = 0; it < nit; ++it) {
                const int idx = (it * 64 + lane) * 8;
                unsigned byte = 0u;
                if (idx < nadm) { const u32x4 k4 = *(const u32x4*)(krow + idx * 2);
                    const unsigned kk[4] = {k4.x, k4.y, k4.z, k4.w};
#pragma unroll
                    for (int j = 0; j < 4; ++j) { byte |= ((kk[j] & 0xFFFFu) >= tau ? 1u : 0u) << (2 * j); byte |= ((kk[j] >> 16) >= tau ? 1u : 0u) << (2 * j + 1); } }
                unsigned lo = (lane & 4) ? 0u : (byte << (8 * (lane & 3))), hi = (lane & 4) ? (byte << (8 * (lane & 3))) : 0u;
                lo |= __shfl_xor(lo, 1); hi |= __shfl_xor(hi, 1); lo |= __shfl_xor(lo, 2); hi |= __shfl_xor(hi, 2); lo |= __shfl_xor(lo, 4); hi |= __shfl_xor(hi, 4);
                if ((lane & 7) == 0 && idx < nadm) { hw[64 + 2 * (it * 8 + (lane >> 3))] = lo; hw[64 + 2 * (it * 8 + (lane >> 3)) + 1] = hi; }
            }
        }
        __syncthreads();
        if (MODE != 1) { const int w = tid >> 2, qp = tid & 3;
            if (w <= ch) { const unsigned* ha = hist + (2 * qp) * IDX_HPITCH + 64 + 2 * w; const unsigned* hb = ha + IDX_HPITCH;
                *(u32x4*)(MASK + ((size_t)b * 128 + w) * NS + t0l + 2 * qp) = (u32x4){ha[0], ha[1], hb[0], hb[1]}; } }
    }
    __syncthreads();
}

constexpr int ATP = 144;
constexpr int ATT_QWORD = 3584 + 32 * 64;
template <int AMODE>
__device__ __forceinline__ void ph4_attn_fast(const Args& a, int bid, int nb, unsigned char* lds) {
    int tid = threadIdx.x; asm volatile("" : "+v"(tid));
    const int lane = tid & 63, wave = __builtin_amdgcn_readfirstlane(tid >> 6), r = lane & 31, hh = lane >> 5;
    const f16* Q = (const f16*)(a.ws + WS_Q); const f16* Kk = (const f16*)(a.ws + WS_K); const f16* VT = (const f16*)(a.ws + WS_VT);
    const u64* MASK = (const u64*)(a.ws + WS_MASK); f16* MIX = (f16*)(a.ws + WS_H); const float* og = a.in[11];
    unsigned char* Kl = lds; unsigned char* Vl = lds + 2 * 64 * ATP;
    const float LOG2E = 1.4426950408889634f, OFF = 8192.f;
    const int pir = 16 * (r >> 4) + 8 * ((r >> 2) & 1) + 4 * ((r >> 3) & 1) + (r & 3);
    const int srow = tid >> 3, schk = tid & 7;
    unsigned* aq = (unsigned*)(a.ws + WS_CTL) + ATT_QWORD;
    volatile unsigned* ucell = (volatile unsigned*)(lds + 6 * 64 * ATP);
    volatile unsigned* dflag = ucell + 8;
    const float kmax = __int_as_float(__builtin_amdgcn_readfirstlane(__float_as_int(1.01f * 8.f * wave_max(fabsf(a.in[10][lane])))));
    int upar = 0;
    for (;;) {
        if (tid == 0) ucell[upar] = __hip_atomic_fetch_add(aq, 1u, __ATOMIC_RELAXED, __HIP_MEMORY_SCOPE_AGENT);
        if (tid < 8) dflag[tid] = 0u;
        __syncthreads();
        const unsigned u = ucell[upar]; upar ^= 1;
        if (u >= 2048u) break;
        const int h = 7 - (int)(u >> 8), qb = 31 - (int)((u & 255u) >> 3), b = (int)(u & 7u);
        const int q0l = qb * 256, tq = q0l + 32 * wave + r, cw = 4 * qb + (wave >> 1), top = 4 * qb + 3;
        const size_t t = (size_t)b * NS + tq;
        const float slope = exp2f(-(float)(h + 1)) * LOG2E;
        f16x8 qf[4];
#pragma unroll
        for (int ks = 0; ks < 4; ++ks) { const f16x8 qv = *(const f16x8*)(Q + t * 512 + h * 64 + 16 * ks + 8 * hh);
#pragma unroll
            for (int j = 0; j < 8; ++j) qf[ks][j] = (f16)((float)qv[j] * (0.125f * LOG2E)); }
        float qss = 0.f;
#pragma unroll
        for (int ks = 0; ks < 4; ++ks)
#pragma unroll
            for (int j = 0; j < 8; ++j) qss += (float)qf[ks][j] * (float)qf[ks][j];
        qss += __shfl_xor(qss, 32);
        const float Sb = __int_as_float(__builtin_amdgcn_readfirstlane(__float_as_int(wave_max(sqrtf(qss)) * kmax)));
        const float rowc = OFF + slope * (float)(tq - q0l);
        float m = 1000.f, l = 0.f;
        f32x16 O[2];
#pragma unroll
        for (int dt = 0; dt < 2; ++dt) O[dt] = (f32x16){0.f, 0.f, 0.f, 0.f, 0.f, 0.f, 0.f, 0.f, 0.f, 0.f, 0.f, 0.f, 0.f, 0.f, 0.f, 0.f};
        const f16* kg = Kk + ((size_t)b * NS + srow) * 512 + h * 64 + schk * 8;
        const f16* vg = VT + (size_t)(h * 64 + srow) * NT + (size_t)b * NS + schk * 8;
        f16x8 kr0, kr1, vr0, vr1; u64 mw0 = 0ull, mw1 = 0ull;
#define ATT_LOAD(kr, vr, mwv, jj) do { if ((jj) >= 0) { kr = *(const f16x8*)(kg + (size_t)(jj) * 64 * 512); vr = *(const f16x8*)(vg + (jj) * 64); mwv = ((jj) <= cw) ? MASK[((size_t)b * 128 + (jj)) * NS + tq] : 0ull; } } while (0)
        ATT_LOAD(kr0, vr0, mw0, top); ATT_LOAD(kr1, vr1, mw1, top - 1);
        int buf = 0; bool wdone = false, stop = false;
        auto step = [&](f16x8& kreg, f16x8& vreg, u64& mwr, const int j) {
            *(f16x8*)(Kl + buf * 64 * ATP + srow * ATP + schk * 16) = kreg;
            *(f16x8*)(Vl + buf * 64 * ATP + srow * ATP + schk * 16) = vreg;
            const u64 mw = mwr;
            asm volatile("s_waitcnt lgkmcnt(0)" ::: "memory"); __builtin_amdgcn_s_barrier(); asm volatile("" ::: "memory");
            {
                const unsigned jp = (unsigned)(j + 1);
                if ((dflag[0] > jp) & (dflag[1] > jp) & (dflag[2] > jp) & (dflag[3] > jp) & (dflag[4] > jp) & (dflag[5] > jp) & (dflag[6] > jp) & (dflag[7] > jp)) { stop = true; return; }
            }
            ATT_LOAD(kreg, vreg, mwr, j - 2);
            if (!wdone && j < cw) { const float lmax = Sb + OFF + slope * (float)(64 * j + 63 - q0l); if (__all(lmax - m < -28.f)) { wdone = true; if (lane == 0) dflag[wave] = (unsigned)(j + 1); } }
            if (j <= cw && !wdone) {
                const unsigned char* kb_ = Kl + buf * 64 * ATP + pir * ATP + 16 * hh;
                f16x8 fr8[8];
#pragma unroll
                for (int kt = 0; kt < 2; ++kt)
#pragma unroll
                    for (int ks = 0; ks < 4; ++ks) fr8[kt * 4 + ks] = *(const f16x8*)(kb_ + kt * 32 * ATP + ks * 32);
                f32x16 sa[2];
                if (j == cw) {
#pragma unroll
                    for (int kt = 0; kt < 2; ++kt)
#pragma unroll
                        for (int rg = 0; rg < 16; ++rg) { const float x = (float)(64 * j + 32 * kt + 16 * (rg >> 3) + 8 * hh + (rg & 7) - tq); sa[kt][rg] = rowc - slope * fabsf(x); }
                } else {
                    const float base = OFF + slope * (float)(64 * j + 8 * hh - q0l);
#pragma unroll
                    for (int kt = 0; kt < 2; ++kt)
#pragma unroll
                        for (int rg = 0; rg < 16; ++rg) sa[kt][rg] = __builtin_fmaf(slope, (float)(32 * kt + 16 * (rg >> 3) + (rg & 7)), base);
                }
                __builtin_amdgcn_sched_barrier(0);
                __builtin_amdgcn_s_setprio(1);
#pragma unroll
                for (int kt = 0; kt < 2; ++kt)
#pragma unroll
                    for (int ks = 0; ks < 4; ++ks) sa[kt] = __builtin_amdgcn_mfma_f32_32x32x16_f16(fr8[kt * 4 + ks], qf[ks], sa[kt], 0, 0, 0);
                __builtin_amdgcn_s_setprio(0);
                __builtin_amdgcn_sched_barrier(0);
                const unsigned char* vb_ = Vl + buf * 64 * ATP + r * ATP + 16 * hh;
#pragma unroll
                for (int dt = 0; dt < 2; ++dt)
#pragma unroll
                    for (int kt = 0; kt < 2; ++kt)
#pragma unroll
                        for (int s2 = 0; s2 < 2; ++s2) fr8[dt * 4 + kt * 2 + s2] = *(const f16x8*)(vb_ + dt * 32 * ATP + kt * 64 + s2 * 32);
                __builtin_amdgcn_sched_barrier(0);
                float rm = 0.f;
#pragma unroll
                for (int kt = 0; kt < 2; ++kt) { const unsigned w32 = (unsigned)(kt ? (mw >> 32) : mw) >> (8 * hh);
#pragma unroll
                    for (int rg = 0; rg < 16; ++rg) { const int tm = __builtin_amdgcn_sbfe((int)w32, 16 * (rg >> 3) + (rg & 7), 1);
                        const float L = __int_as_float(__float_as_int(sa[kt][rg]) & tm); sa[kt][rg] = L; rm = fmaxf(rm, L); } }
                rm = fmaxf(rm, __shfl_xor(rm, 32));
                const float mn = fmaxf(m, rm);
                if (__any(mn > m)) { const float al = __builtin_amdgcn_exp2f(m - mn); l *= al;
#pragma unroll
                    for (int dt = 0; dt < 2; ++dt)
#pragma unroll
                        for (int rg = 0; rg < 16; ++rg) O[dt][rg] *= al; }
                m = mn;
                f16x8 pf[2][2];
                float l0 = 0.f, l1 = 0.f;
#pragma unroll
                for (int kt = 0; kt < 2; ++kt)
#pragma unroll
                    for (int rg = 0; rg < 16; ++rg) { const float pp = __builtin_amdgcn_exp2f(sa[kt][rg] - m); if (rg & 1) l1 += pp; else l0 += pp; pf[kt][rg >> 3][rg & 7] = (f16)pp; }
                l += l0 + l1;
                __builtin_amdgcn_sched_barrier(0);
                __builtin_amdgcn_s_setprio(1);
#pragma unroll
                for (int dt = 0; dt < 2; ++dt)
#pragma unroll
                    for (int kt = 0; kt < 2; ++kt)
#pragma unroll
                        for (int s2 = 0; s2 < 2; ++s2) O[dt] = __builtin_amdgcn_mfma_f32_32x32x16_f16(fr8[dt * 4 + kt * 2 + s2], pf[kt][s2], O[dt], 0, 0, 0);
                __builtin_amdgcn_s_setprio(0);
            }
            buf ^= 1;
        };
        for (int j = top; j >= 0; j -= 2) {
            step(kr0, vr0, mw0, j); if (stop) break;
            if (j - 1 >= 0) { step(kr1, vr1, mw1, j - 1); if (stop) break; }
        }
#undef ATT_LOAD
        l += __shfl_xor(l, 32);
        const float inv = 1.f / l;
        float ss = 0.f;
#pragma unroll
        for (int dt = 0; dt < 2; ++dt)
#pragma unroll
            for (int rg = 0; rg < 16; ++rg) { O[dt][rg] *= inv; ss += O[dt][rg] * O[dt][rg]; }
        ss += __shfl_xor(ss, 32);
        const float rstd = rsqrtf(ss * (1.f / 64.f) + EPS);
#pragma unroll
        for (int dt = 0; dt < 2; ++dt)
#pragma unroll
            for (int g4 = 0; g4 < 4; ++g4) { const int d = 32 * dt + 8 * g4 + 4 * hh; const f32x4 gg = *(const f32x4*)(og + h * 64 + d);
                f16x4 o4; o4.x = (f16)(O[dt][4 * g4 + 0] * rstd * gg.x); o4.y = (f16)(O[dt][4 * g4 + 1] * rstd * gg.y); o4.z = (f16)(O[dt][4 * g4 + 2] * rstd * gg.z); o4.w = (f16)(O[dt][4 * g4 + 3] * rstd * gg.w);
                *(f16x4*)(MIX + t * ND + 512 + h * 64 + d) = o4; }
        __syncthreads();
    }
}

__device__ __forceinline__ void ph5_outproj(const Args& a, int bid, int nb, unsigned char* lds) {
    pg8::Gemm g{(const f16*)(a.ws + WS_H), (const f16*)(a.ws + WS_WOUT), NT, 1024, ND}; pg8::StaticOrder S; S.init(NT, 1024, nb, bid);
    pg8::EpiOut E{a.in[0], (const float*)(a.ws + WS_MOD), a.out};
    pg8::gemm_phase((PG8_LAS unsigned char*)lds, g, S, E);
}

__device__ __forceinline__ void ph7_peerq(const Args& a, int bid, int nb, unsigned char* lds) {
    pg8::Gemm g{(const f16*)(a.ws + WS_H), (const f16*)(a.ws + WS_WQ), NT, 2048, ND}; pg8::StaticOrder S; S.init(NT, 2048, nb, bid);
    pg8::EpiPQ E{(f16*)(a.ws + WS_PQ)};
    pg8::gemm_phase((PG8_LAS unsigned char*)lds, g, S, E);
}


__device__ __forceinline__ unsigned f2skey(float f) { const unsigned u = __float_as_uint(f); return (u & 0x80000000u) ? ~u : (u | 0x80000000u); }
__device__ __forceinline__ float skey2f(unsigned k) { return __uint_as_float((k & 0x80000000u) ? (k & 0x7FFFFFFFu) : ~k); }
#define CE_(a_, b_) do { const unsigned t__ = max(a_, b_); b_ = min(a_, b_); a_ = t__; } while (0)
#define SORT16_DESC(v) do { CE_(v[0], v[1]); CE_(v[2], v[3]); CE_(v[0], v[2]); CE_(v[1], v[3]); CE_(v[1], v[2]); CE_(v[4], v[5]); CE_(v[6], v[7]); CE_(v[4], v[6]); CE_(v[5], v[7]); CE_(v[5], v[6]); CE_(v[0], v[4]); CE_(v[2], v[6]); CE_(v[2], v[4]); CE_(v[1], v[5]); CE_(v[3], v[7]); CE_(v[3], v[5]); CE_(v[1], v[2]); CE_(v[3], v[4]); CE_(v[5], v[6]); CE_(v[8], v[9]); CE_(v[10], v[11]); CE_(v[8], v[10]); CE_(v[9], v[11]); CE_(v[9], v[10]); CE_(v[12], v[13]); CE_(v[14], v[15]); CE_(v[12], v[14]); CE_(v[13], v[15]); CE_(v[13], v[14]); CE_(v[8], v[12]); CE_(v[10], v[14]); CE_(v[10], v[12]); CE_(v[9], v[13]); CE_(v[11], v[15]); CE_(v[11], v[13]); CE_(v[9], v[10]); CE_(v[11], v[12]); CE_(v[13], v[14]); CE_(v[0], v[8]); CE_(v[4], v[12]); CE_(v[4], v[8]); CE_(v[2], v[10]); CE_(v[6], v[14]); CE_(v[6], v[10]); CE_(v[2], v[4]); CE_(v[6], v[8]); CE_(v[10], v[12]); CE_(v[1], v[9]); CE_(v[5], v[13]); CE_(v[5], v[9]); CE_(v[3], v[11]); CE_(v[7], v[15]); CE_(v[7], v[11]); CE_(v[3], v[5]); CE_(v[7], v[9]); CE_(v[11], v[13]); CE_(v[1], v[2]); CE_(v[3], v[4]); CE_(v[5], v[6]); CE_(v[7], v[8]); CE_(v[9], v[10]); CE_(v[11], v[12]); CE_(v[13], v[14]); } while (0)
#define BITONIC16_DESC(v) do { CE_(v[0], v[8]); CE_(v[1], v[9]); CE_(v[2], v[10]); CE_(v[3], v[11]); CE_(v[4], v[12]); CE_(v[5], v[13]); CE_(v[6], v[14]); CE_(v[7], v[15]); CE_(v[0], v[4]); CE_(v[1], v[5]); CE_(v[2], v[6]); CE_(v[3], v[7]); CE_(v[8], v[12]); CE_(v[9], v[13]); CE_(v[10], v[14]); CE_(v[11], v[15]); CE_(v[0], v[2]); CE_(v[1], v[3]); CE_(v[4], v[6]); CE_(v[5], v[7]); CE_(v[8], v[10]); CE_(v[9], v[11]); CE_(v[12], v[14]); CE_(v[13], v[15]); CE_(v[0], v[1]); CE_(v[2], v[3]); CE_(v[4], v[5]); CE_(v[6], v[7]); CE_(v[8], v[9]); CE_(v[10], v[11]); CE_(v[12], v[13]); CE_(v[14], v[15]); } while (0)
#define MERGE16_DESC(dst, other) do { unsigned c__[16]; _Pragma("unroll") for (int i__ = 0; i__ < 16; ++i__) c__[i__] = max(dst[i__], other[15 - i__]); BITONIC16_DESC(c__); _Pragma("unroll") for (int i__ = 0; i__ < 16; ++i__) dst[i__] = c__[i__]; } while (0)
#define TOP16_INSERT(v, x_) do { unsigned x__ = (x_); _Pragma("unroll") for (int k_ = 0; k_ < 16; ++k_) { const unsigned t__ = max(v[k_], x__); x__ = min(v[k_], x__); v[k_] = t__; } } while (0)
__device__ __forceinline__ void ph8_peersel_fast(const Args& a, int bid, int nb, unsigned char* lds) {
    int tid = threadIdx.x; asm volatile("" : "+v"(tid));
    const int lane = tid & 63, wave = __builtin_amdgcn_readfirstlane(tid >> 6), r = lane & 31, hh = lane >> 5;
    const f16* PQ = (const f16*)(a.ws + WS_PQ); const f16* SK = (const f16*)(a.ws + WS_SK);
    u16* EID = (u16*)(a.ws + WS_EID); float* GW = (float*)(a.ws + WS_GW);
    unsigned char* wl = lds + wave * 2048 + lane * 32;
    for (int item = bid * NWAVE + wave; item < (NT / 32) * 8; item += nb * NWAVE) {
        const int tt = item >> 3, h = item & 7, t0 = tt * 32;
        unsigned top[2][16];
#pragma unroll
        for (int p = 0; p < 2; ++p) {
            f16x8 bq[8];
#pragma unroll
            for (int ks = 0; ks < 8; ++ks) bq[ks] = *(const f16x8*)(PQ + ((((size_t)tt * 256 + h * 32 + p * 16 + 2 * ks + hh) * 32 + r) << 3));
#pragma unroll
            for (int k = 0; k < 16; ++k) top[p][k] = 0u;
            const f16* skb = SK + (size_t)(h * 2 + p) * 16384 + hh * 256 + r * 8;
            f16x8 afa[8], afb[8];
#pragma unroll
            for (int ks = 0; ks < 8; ++ks) afa[ks] = *(const f16x8*)(skb + ks * 512);
#define P8_TILE(AF, nt_) do { f32x16 acc = (f32x16){0.f, 0.f, 0.f, 0.f, 0.f, 0.f, 0.f, 0.f, 0.f, 0.f, 0.f, 0.f, 0.f, 0.f, 0.f, 0.f}; \
                _Pragma("unroll") for (int ks = 0; ks < 8; ++ks) acc = __builtin_amdgcn_mfma_f32_32x32x16_f16(AF[ks], bq[ks], acc, 0, 0, 0); \
                const unsigned nb0 = 32 * (nt_) + 4 * hh; \
                unsigned ky[16]; \
                _Pragma("unroll") for (int rg = 0; rg < 16; ++rg) { const unsigned n = nb0 + (rg & 3) + 8 * (rg >> 2); ky[rg] = (f2skey(acc[rg]) & ~127u) | n; } \
                SORT16_DESC(ky); MERGE16_DESC(top[p], ky); } while (0)
#pragma unroll 1
            for (int np = 0; np < 2; ++np) {
#pragma unroll
                for (int ks = 0; ks < 8; ++ks) afb[ks] = *(const f16x8*)(skb + ((2 * np + 1) * 8 + ks) * 512);
                P8_TILE(afa, 2 * np);
                const int nn = (np == 0) ? 2 : 3;
#pragma unroll
                for (int ks = 0; ks < 8; ++ks) afa[ks] = *(const f16x8*)(skb + (nn * 8 + ks) * 512);
                P8_TILE(afb, 2 * np + 1);
            }
#undef P8_TILE
            unsigned oth[16];
#pragma unroll
            for (int k = 0; k < 16; ++k) oth[k] = __shfl_xor(top[p][k], 32);
            MERGE16_DESC(top[p], oth);
            asm volatile("" ::: "memory");
        }
#pragma unroll
        for (int k = 0; k < 16; k += 4) {
            *(unsigned*)(wl + k) = (top[0][k] & 127u) | ((top[0][k + 1] & 127u) << 8) | ((top[0][k + 2] & 127u) << 16) | ((top[0][k + 3] & 127u) << 24);
            *(unsigned*)(wl + 16 + k) = (top[1][k] & 127u) | ((top[1][k + 1] & 127u) << 8) | ((top[1][k + 2] & 127u) << 16) | ((top[1][k + 3] & 127u) << 24);
        }
        float fa[16], fb[16];
#pragma unroll
        for (int k = 0; k < 16; ++k) { fa[k] = skey2f(top[0][k] & ~127u); fb[k] = skey2f(top[1][k] & ~127u); }
        unsigned cg[4][16];
        cg[0][0] = (f2skey(fa[0] + fb[0]) & ~255u) | 0u;
        cg[0][1] = (f2skey(fa[0] + fb[1]) & ~255u) | 1u;
        cg[0][2] = (f2skey(fa[0] + fb[2]) & ~255u) | 2u;
        cg[0][3] = (f2skey(fa[0] + fb[3]) & ~255u) | 3u;
        cg[0][4] = (f2skey(fa[0] + fb[4]) & ~255u) | 4u;
        cg[0][5] = (f2skey(fa[0] + fb[5]) & ~255u) | 5u;
        cg[0][6] = (f2skey(fa[0] + fb[6]) & ~255u) | 6u;
        cg[0][7] = (f2skey(fa[0] + fb[7]) & ~255u) | 7u;
        cg[0][8] = (f2skey(fa[0] + fb[8]) & ~255u) | 8u;
        cg[0][9] = (f2skey(fa[0] + fb[9]) & ~255u) | 9u;
        cg[0][10] = (f2skey(fa[0] + fb[10]) & ~255u) | 10u;
        cg[0][11] = (f2skey(fa[0] + fb[11]) & ~255u) | 11u;
        cg[0][12] = (f2skey(fa[0] + fb[12]) & ~255u) | 12u;
        cg[0][13] = (f2skey(fa[0] + fb[13]) & ~255u) | 13u;
        cg[0][14] = (f2skey(fa[0] + fb[14]) & ~255u) | 14u;
        cg[0][15] = (f2skey(fa[0] + fb[15]) & ~255u) | 15u;
        cg[1][0] = (f2skey(fa[1] + fb[0]) & ~255u) | 16u;
        cg[1][1] = (f2skey(fa[1] + fb[1]) & ~255u) | 17u;
        cg[1][2] = (f2skey(fa[1] + fb[2]) & ~255u) | 18u;
        cg[1][3] = (f2skey(fa[1] + fb[3]) & ~255u) | 19u;
        cg[1][4] = (f2skey(fa[1] + fb[4]) & ~255u) | 20u;
        cg[1][5] = (f2skey(fa[1] + fb[5]) & ~255u) | 21u;
        cg[1][6] = (f2skey(fa[1] + fb[6]) & ~255u) | 22u;
        cg[1][7] = (f2skey(fa[1] + fb[7]) & ~255u) | 23u;
        cg[1][8] = (f2skey(fa[2] + fb[0]) & ~255u) | 32u;
        cg[1][9] = (f2skey(fa[2] + fb[1]) & ~255u) | 33u;
        cg[1][10] = (f2skey(fa[2] + fb[2]) & ~255u) | 34u;
        cg[1][11] = (f2skey(fa[2] + fb[3]) & ~255u) | 35u;
        cg[1][12] = (f2skey(fa[2] + fb[4]) & ~255u) | 36u;
        cg[1][13] = (f2skey(fa[3] + fb[0]) & ~255u) | 48u;
        cg[1][14] = (f2skey(fa[3] + fb[1]) & ~255u) | 49u;
        cg[1][15] = (f2skey(fa[3] + fb[2]) & ~255u) | 50u;
        cg[2][0] = (f2skey(fa[3] + fb[3]) & ~255u) | 51u;
        cg[2][1] = (f2skey(fa[4] + fb[0]) & ~255u) | 64u;
        cg[2][2] = (f2skey(fa[4] + fb[1]) & ~255u) | 65u;
        cg[2][3] = (f2skey(fa[4] + fb[2]) & ~255u) | 66u;
        cg[2][4] = (f2skey(fa[5] + fb[0]) & ~255u) | 80u;
        cg[2][5] = (f2skey(fa[5] + fb[1]) & ~255u) | 81u;
        cg[2][6] = (f2skey(fa[6] + fb[0]) & ~255u) | 96u;
        cg[2][7] = (f2skey(fa[6] + fb[1]) & ~255u) | 97u;
        cg[2][8] = (f2skey(fa[7] + fb[0]) & ~255u) | 112u;
        cg[2][9] = (f2skey(fa[7] + fb[1]) & ~255u) | 113u;
        cg[2][10] = (f2skey(fa[8] + fb[0]) & ~255u) | 128u;
        cg[2][11] = (f2skey(fa[9] + fb[0]) & ~255u) | 144u;
        cg[2][12] = (f2skey(fa[10] + fb[0]) & ~255u) | 160u;
        cg[2][13] = (f2skey(fa[11] + fb[0]) & ~255u) | 176u;
        cg[2][14] = (f2skey(fa[12] + fb[0]) & ~255u) | 192u;
        cg[2][15] = (f2skey(fa[13] + fb[0]) & ~255u) | 208u;
        cg[3][0] = (f2skey(fa[14] + fb[0]) & ~255u) | 224u;
        cg[3][1] = (f2skey(fa[15] + fb[0]) & ~255u) | 240u;
        cg[3][2] = 0u;
        cg[3][3] = 0u;
        cg[3][4] = 0u;
        cg[3][5] = 0u;
        cg[3][6] = 0u;
        cg[3][7] = 0u;
        cg[3][8] = 0u;
        cg[3][9] = 0u;
        cg[3][10] = 0u;
        cg[3][11] = 0u;
        cg[3][12] = 0u;
        cg[3][13] = 0u;
        cg[3][14] = 0u;
        cg[3][15] = 0u;
        SORT16_DESC(cg[0]); SORT16_DESC(cg[1]); SORT16_DESC(cg[2]); SORT16_DESC(cg[3]);
        MERGE16_DESC(cg[0], cg[1]); MERGE16_DESC(cg[2], cg[3]); MERGE16_DESC(cg[0], cg[2]);
        unsigned ct[16];
#pragma unroll
        for (int k = 0; k < 16; ++k) ct[k] = cg[0][k];
        float sc[16]; float den = 0.f; const float s0 = skey2f(ct[0] & ~255u);
#pragma unroll
        for (int k = 0; k < 16; ++k) { sc[k] = __expf(skey2f(ct[k] & ~255u) - s0); den += sc[k]; }
        const float inv = 1.f / den;
        if (hh == 0) {
            u16 ev[16];
#pragma unroll
            for (int k = 0; k < 16; ++k) { const unsigned ij = ct[k] & 255u; const unsigned i1 = wl[ij >> 4], i2 = wl[16 + (ij & 15u)]; ev[k] = (u16)(i1 * 128u + i2); }
            const size_t o = (size_t)(t0 + r) * 128 + h * 16;
#pragma unroll
            for (int k = 0; k < 16; k += 8) {
                *(u32x4*)(EID + o + k) = (u32x4){(unsigned)ev[k] | ((unsigned)ev[k + 1] << 16), (unsigned)ev[k + 2] | ((unsigned)ev[k + 3] << 16), (unsigned)ev[k + 4] | ((unsigned)ev[k + 5] << 16), (unsigned)ev[k + 6] | ((unsigned)ev[k + 7] << 16)};
            }
#pragma unroll
            for (int k = 0; k < 16; k += 4) *(f32x4*)(GW + o + k) = (f32x4){sc[k] * inv, sc[k + 1] * inv, sc[k + 2] * inv, sc[k + 3] * inv};
        }
    }
}

typedef _Float16 f16x2 __attribute__((ext_vector_type(2)));
__device__ __forceinline__ float gelu_erf(float d) { return 0.5f * d * (1.f + erff(d * 0.70710678118654752f)); }
constexpr int PQ_WORD0 = 3584, PQ_CHUNK = 64, PQ_NCHUNK = NT / PQ_CHUNK;
constexpr size_t WS_PART = 208 * MiB;
__device__ __forceinline__ unsigned xcc_id_() { return (unsigned)__builtin_amdgcn_s_getreg((3 << 11) | 20) & 7u; }
template <int VPHASE>
__device__ __forceinline__ void ph9_sliced(const Args& a, unsigned char* lds) {
    int tid_ = threadIdx.x; asm volatile("" : "+v"(tid_)); const int lane = tid_ & 63, wave = __builtin_amdgcn_readfirstlane(tid_ >> 6);
    const int g8 = lane >> 3, c16 = lane & 7;
    const f16* H2 = (const f16*)(a.ws + WS_H); const unsigned char* TAB = a.ws + (VPHASE ? WS_VP : WS_UT);
    const u16* EID = (const u16*)(a.ws + WS_EID); const float* GW = (const float*)(a.ws + WS_GW); float* PART = (float*)(a.ws + WS_PART);
    const float* mod = (const float*)(a.ws + WS_MOD); float* out = a.out;
    unsigned* qw = (unsigned*)(a.ws + WS_CTL) + PQ_WORD0 + (VPHASE ? 8 * 64 : 0);
    volatile unsigned* cslot = (volatile unsigned*)lds;
    const bool b5 = (lane & 32) != 0, b4 = (lane & 16) != 0, b3 = (lane & 8) != 0, b2 = (lane & 4) != 0, b1 = (lane & 2) != 0, b0 = (lane & 1) != 0;
    const unsigned x0 = xcc_id_();
    int par = 0;
    for (int k = 0; k < 8; ++k) {
        const unsigned sl = (x0 + (unsigned)k) & 7u;
        unsigned cur = 0u;
        if (tid_ == 0) cur = __hip_atomic_fetch_add(qw + 64 * sl, 1u, __ATOMIC_RELAXED, __HIP_MEMORY_SCOPE_AGENT);
        for (;;) {
            if (tid_ == 0) cslot[par] = cur;
            __syncthreads();
            const unsigned c = cslot[par]; par ^= 1;
            if (c >= (unsigned)PQ_NCHUNK) break;
            if (tid_ == 0) cur = __hip_atomic_fetch_add(qw + 64 * sl, 1u, __ATOMIC_RELAXED, __HIP_MEMORY_SCOPE_AGENT);
            const int tb = (int)c * PQ_CHUNK + wave * (PQ_CHUNK / NWAVE);
            const unsigned char* tsl = TAB + 128 * sl + 16 * c16;
#pragma unroll 1
            for (int i8 = 0; i8 < PQ_CHUNK / NWAVE; ++i8) {
                const int t = tb + i8;
                const u32x4 e0 = *(const u32x4*)(EID + (size_t)t * 128 + 16 * g8), e1 = *(const u32x4*)(EID + (size_t)t * 128 + 16 * g8 + 8);
                const unsigned ew[8] = {e0.x, e0.y, e0.z, e0.w, e1.x, e1.y, e1.z, e1.w};
                u32x4 r8[16];
#pragma unroll
                for (int i = 0; i < 16; ++i) { const unsigned eid = (i & 1) ? (ew[i >> 1] >> 16) : (ew[i >> 1] & 0xFFFFu); r8[i] = *(const u32x4*)(tsl + (size_t)eid * ND); }
                if (!VPHASE) {
                    const u32x4 hq0 = *(const u32x4*)(H2 + (size_t)t * ND + 128 * sl + 16 * c16), hq1 = *(const u32x4*)(H2 + (size_t)t * ND + 128 * sl + 16 * c16 + 8);
                    const unsigned hp[8] = {hq0.x, hq0.y, hq0.z, hq0.w, hq1.x, hq1.y, hq1.z, hq1.w};
                    float p[16];
#pragma unroll
                    for (int i = 0; i < 16; ++i) { float d = 0.f;
#pragma unroll
                        for (int j = 0; j < 4; ++j) { const unsigned lo = __builtin_amdgcn_perm(r8[i][j], r8[i][j], 0x010C000Cu), hi = __builtin_amdgcn_perm(r8[i][j], r8[i][j], 0x030C020Cu);
                            d = __builtin_amdgcn_fdot2(__builtin_bit_cast(f16x2, hp[2 * j]), __builtin_bit_cast(f16x2, lo), d, false);
                            d = __builtin_amdgcn_fdot2(__builtin_bit_cast(f16x2, hp[2 * j + 1]), __builtin_bit_cast(f16x2, hi), d, false); }
                        p[i] = d; }
                    float q8[8], q4[4], r2[2];
#pragma unroll
                    for (int ii = 0; ii < 8; ++ii) { const float keep = b2 ? p[8 + ii] : p[ii], send = b2 ? p[ii] : p[8 + ii]; q8[ii] = keep + __shfl_xor(send, 4); }
#pragma unroll
                    for (int ii = 0; ii < 4; ++ii) { const float keep = b1 ? q8[4 + ii] : q8[ii], send = b1 ? q8[ii] : q8[4 + ii]; q4[ii] = keep + __shfl_xor(send, 2); }
#pragma unroll
                    for (int ii = 0; ii < 2; ++ii) { const float keep = b0 ? q4[2 + ii] : q4[ii], send = b0 ? q4[ii] : q4[2 + ii]; r2[ii] = keep + __shfl_xor(send, 1); }
                    *(f32x2*)(PART + ((size_t)sl * NT + t) * 128 + 16 * g8 + 2 * c16) = (f32x2){r2[0], r2[1]};
                } else {
                    const float* wp = GW + (size_t)t * 128 + 16 * g8;
                    const f32x4 wq0 = *(const f32x4*)wp, wq1 = *(const f32x4*)(wp + 4), wq2 = *(const f32x4*)(wp + 8), wq3 = *(const f32x4*)(wp + 12);
                    const float wv[16] = {wq0[0], wq0[1], wq0[2], wq0[3], wq1[0], wq1[1], wq1[2], wq1[3], wq2[0], wq2[1], wq2[2], wq2[3], wq3[0], wq3[1], wq3[2], wq3[3]};
                    f16x2 acc2[8];
#pragma unroll
                    for (int j = 0; j < 8; ++j) acc2[j] = (f16x2){(f16)0.f, (f16)0.f};
#pragma unroll
                    for (int i = 0; i < 16; ++i) { const f16x2 w2 = (f16x2){(f16)wv[i], (f16)wv[i]};
#pragma unroll
                        for (int j = 0; j < 4; ++j) { const unsigned lo = __builtin_amdgcn_perm(r8[i][j], r8[i][j], 0x010C000Cu), hi = __builtin_amdgcn_perm(r8[i][j], r8[i][j], 0x030C020Cu);
                            acc2[2 * j] = __builtin_elementwise_fma(w2, __builtin_bit_cast(f16x2, lo), acc2[2 * j]);
                            acc2[2 * j + 1] = __builtin_elementwise_fma(w2, __builtin_bit_cast(f16x2, hi), acc2[2 * j + 1]); } }
                    float acc[16];
#pragma unroll
                    for (int j = 0; j < 8; ++j) { acc[2 * j] = (float)acc2[j][0]; acc[2 * j + 1] = (float)acc2[j][1]; }
                    float q8[8], q4[4], r2[2];
#pragma unroll
                    for (int ii = 0; ii < 8; ++ii) { const float keep = b5 ? acc[8 + ii] : acc[ii], send = b5 ? acc[ii] : acc[8 + ii]; q8[ii] = keep + __shfl_xor(send, 32); }
#pragma unroll
                    for (int ii = 0; ii < 4; ++ii) { const float keep = b4 ? q8[4 + ii] : q8[ii], send = b4 ? q8[ii] : q8[4 + ii]; q4[ii] = keep + __shfl_xor(send, 16); }
#pragma unroll
                    for (int ii = 0; ii < 2; ++ii) { const float keep = b3 ? q4[2 + ii] : q4[ii], send = b3 ? q4[ii] : q4[2 + ii]; r2[ii] = keep + __shfl_xor(send, 8); }
                    const int ch = 128 * sl + 16 * c16 + 2 * g8;
                    float* op = out + (size_t)t * ND + ch; const float* g2 = mod + (t / NS) * 6144 + 5120 + ch;
                    const f32x2 o2 = *(const f32x2*)op, gg = *(const f32x2*)g2;
                    *(f32x2*)op = o2 + gg * ((f32x2){r2[0], r2[1]} * (1.f / PEER_VSCALE));
                }
            }
        }
    }
}
__device__ __forceinline__ void ph9b_combine(const Args& a, int bid, int nb) {
    int tid_ = threadIdx.x; asm volatile("" : "+v"(tid_));
    float* GW = (float*)(a.ws + WS_GW); const float* PART = (const float*)(a.ws + WS_PART);
    for (size_t i = (size_t)bid * NTHR + tid_; i < (size_t)NT * 128 / 4; i += (size_t)nb * NTHR) {
        f32x4 sum = ((const f32x4*)PART)[i];
#pragma unroll
        for (int sidx = 1; sidx < 8; ++sidx) sum += ((const f32x4*)(PART + (size_t)sidx * NT * 128))[i];
        const f32x4 g = ((const f32x4*)GW)[i];
        f32x4 w;
#pragma unroll
        for (int j = 0; j < 4; ++j) w[j] = g[j] * gelu_erf(sum[j] * (1.f / PEER_USCALE));
        ((f32x4*)GW)[i] = w;
    }
}

#define LAS __attribute__((address_space(3)))
#define XB_TMO      128
#define XB_XCNT(j)  (256  + 64 * (j))
#define XB_XSUB(j)  (1280 + 64 * (j))
#define XB_XGEN(j)  (2304 + 64 * (j))
#define XB_TOP      3328
#define XB_TOPGEN   3392
#define XCD_BAR_WORDS 3456
#define XB_SPIN_CAP (1u << 18)
__device__ __forceinline__ unsigned xb_ld(unsigned* p)              { return __hip_atomic_load(p, __ATOMIC_RELAXED, __HIP_MEMORY_SCOPE_AGENT); }
__device__ __forceinline__ unsigned xb_add(unsigned* p, unsigned v) { return __hip_atomic_fetch_add(p, v, __ATOMIC_RELAXED, __HIP_MEMORY_SCOPE_AGENT); }
__device__ __forceinline__ unsigned xb_xcc_id() { return (unsigned)__builtin_amdgcn_s_getreg((3 << 11) | 20) & 0xFu; }
#define XB_SPIN(cond, bar) do { unsigned _sp = 0; while (cond) { __builtin_amdgcn_s_sleep(1); \
    if ((++_sp & 255u) == 0u) { if (xb_ld(&(bar)[XB_TMO])) break; if (_sp > XB_SPIN_CAP) { atomicAdd(&(bar)[XB_TMO], 1u); break; } } } } while (0)
struct XcdBarrier { unsigned* bar; unsigned x; volatile LAS unsigned* st; };
__device__ __forceinline__ XcdBarrier xcd_barrier_post(unsigned* bar, volatile LAS unsigned* st) {
    XcdBarrier b; b.bar = bar; b.x = xb_xcc_id(); b.st = st;
    if (threadIdx.x == 0) (void)xb_add(&bar[XB_XCNT(b.x)], 1u);
    return b;
}
__device__ __forceinline__ void xcd_barrier_complete(unsigned* bar, unsigned x, unsigned& nloc, unsigned& nx) {
    const unsigned G = gridDim.x * gridDim.y * gridDim.z;
    unsigned sum, cnt, mine, sp = 0u;
    for (;;) {
        sum = 0u; cnt = 0u; mine = 0u;
#pragma unroll
        for (unsigned j = 0; j < 16; ++j) { const unsigned c = xb_ld(&bar[XB_XCNT(j)]); sum += c; cnt += (c > 0u) ? 1u : 0u; mine = (j == x) ? c : mine; }
        if (sum == G) break;
        __builtin_amdgcn_s_sleep(1);
        if ((++sp & 255u) == 0u) { if (xb_ld(&bar[XB_TMO])) break; if (sp > XB_SPIN_CAP) { atomicAdd(&bar[XB_TMO], 1u); break; } }
    }
    nloc = mine > 0u ? mine : 1u; nx = cnt > 0u ? cnt : 1u;
}
__device__ __forceinline__ void xcd_barrier(const XcdBarrier& b) {
    asm volatile("s_waitcnt vmcnt(0)" ::: "memory");
    __syncthreads();
    if (threadIdx.x == 0) {
        unsigned* bar = b.bar;
        __builtin_amdgcn_s_waitcnt(0);
        unsigned nloc = b.st[0], nx = b.st[1];
        if (nloc == 0u) { xcd_barrier_complete(bar, b.x, nloc, nx); b.st[0] = nloc; b.st[1] = nx; }
        const unsigned old = xb_add(&bar[XB_XSUB(b.x)], 1u);
        const unsigned gen = old / nloc;
        if (old + 1u == (gen + 1u) * nloc) {
            __builtin_amdgcn_fence(__ATOMIC_RELEASE, "agent");
            asm volatile("s_waitcnt vmcnt(0)" ::: "memory");
            const unsigned og = xb_add(&bar[XB_TOP], 1u);
            const unsigned tg = og / nx;
            if (og + 1u == (tg + 1u) * nx) xb_add(&bar[XB_TOPGEN], 1u);
            else XB_SPIN(xb_ld(&bar[XB_TOPGEN]) == tg, bar);
            __builtin_amdgcn_fence(__ATOMIC_ACQUIRE, "agent");
            xb_add(&bar[XB_XGEN(b.x)], 1u);
            asm volatile("s_waitcnt vmcnt(0)" ::: "memory");
        } else {
            XB_SPIN(xb_ld(&bar[XB_XGEN(b.x)]) == gen, bar);
            __builtin_amdgcn_fence(__ATOMIC_ACQUIRE, "agent");
            asm volatile("s_waitcnt vmcnt(0)" ::: "memory");
        }
    }
    __syncthreads();
}

constexpr int N_PHASES = 12;
__global__ void __launch_bounds__(NTHR, 2) mk_fwd(Args a) {
    extern __shared__ __attribute__((aligned(16))) unsigned char lds[];
    cg::grid_group grid = cg::this_grid();
    const int bid = blockIdx.x, nb = gridDim.x;
    const int lo = a.ph_lo, hi = a.ph_hi;
    volatile LAS unsigned* bst = (volatile LAS unsigned*)((LAS unsigned char*)lds + (LDS_BYTES - 16));
    if (threadIdx.x < 4) bst[threadIdx.x] = 0u;
    __syncthreads();
    XcdBarrier xbar = xcd_barrier_post((unsigned*)(a.ws + WS_CTL), bst);
#define SEAM(k) do { if ((k) == 0) grid.sync(); else xcd_barrier(xbar); } while (0)
#define PHASE(k, body) if (lo <= (k) && (k) < hi) { body; if ((k) + 1 < hi) SEAM(k); }
    PHASE(0, ph0_prologue(a, bid, nb, lds))
    PHASE(1, row_norm_mod(a.in[0], a.in[4], (const float*)(a.ws + WS_MOD), 0, 1024, (f16*)(a.ws + WS_H), bid, nb))
    PHASE(2, ph2_inproj(a, bid, nb, lds))
    PHASE(3, ph3_pool_fast(a, bid, nb, lds); ph3_index_fast<0>(a, bid, nb, lds))
    PHASE(4, ph4_attn_fast<0>(a, bid, nb, lds))
    PHASE(5, ph5_outproj(a, bid, nb, lds))
    PHASE(6, row_norm_mod(a.out, a.in[13], (const float*)(a.ws + WS_MOD), 3072, 4096, (f16*)(a.ws + WS_H), bid, nb))
    PHASE(7, ph7_peerq(a, bid, nb, lds))
    PHASE(8, ph8_peersel_fast(a, bid, nb, lds))
    PHASE(9, ph9_sliced<0>(a, lds))
    PHASE(10, ph9b_combine(a, bid, nb))
    PHASE(11, ph9_sliced<1>(a, lds))
#undef PHASE
}

extern "C" void kernel_launch(void* const* d_in, const int* in_sizes, int n_in, void* d_out, int out_size, void* d_ws, size_t ws_size, hipStream_t stream) {
    static int grid = 0;
    if (grid == 0) {
        if (n_in != 18 || out_size != NT * ND || ws_size < WS_END) { fprintf(stderr, "kernel_launch: unexpected shapes (n_in %d out %d ws %zu)\n", n_in, out_size, ws_size); grid = -1; return; }
        int dev = 0, cus = 0, per_cu = 0;
        hipGetDevice(&dev); hipDeviceGetAttribute(&cus, hipDeviceAttributeMultiprocessorCount, dev);
        hipFuncSetAttribute((const void*)mk_fwd, hipFuncAttributeMaxDynamicSharedMemorySize, LDS_BYTES);
        hipOccupancyMaxActiveBlocksPerMultiprocessor(&per_cu, (const void*)mk_fwd, NTHR, LDS_BYTES);
        if (per_cu < 1) { fprintf(stderr, "kernel_launch: occupancy query says %d blocks/CU\n", per_cu); per_cu = 1; }
        grid = cus * 1;
        (void)hipGetLastError();
    }
    if (grid < 0) return;
    if (hipMemsetAsync((char*)d_ws + WS_CTL, 0, 32768, stream) != hipSuccess) { fprintf(stderr, "kernel_launch: memset of the barrier words failed\n"); return; }
    Args a{};
    for (int i = 0; i < 18; ++i) a.in[i] = (const float*)d_in[i];
    a.out = (float*)d_out; a.ws = (unsigned char*)d_ws;
#if MK_MULTI
    for (int ph = 0; ph < N_PHASES; ++ph) { a.ph_lo = ph; a.ph_hi = ph + 1; hipLaunchKernelGGL(mk_fwd, dim3(grid), dim3(NTHR), LDS_BYTES, stream, a); }
#else
    a.ph_lo = 0; a.ph_hi = N_PHASES;
    void* args[] = {&a};
    hipError_t e = hipLaunchCooperativeKernel((const void*)mk_fwd, dim3(grid), dim3(NTHR), args, LDS_BYTES, stream);
    if (e != hipSuccess) fprintf(stderr, "cooperative launch failed: %s (grid %d)\n", hipGetErrorString(e), grid);
#endif
}
```

```cpp
#include <hip/hip_runtime.h>
#include <hip/hip_cooperative_groups.h>
#include <cstdio>
#include <cstdint>
namespace cg = cooperative_groups;

#ifndef MK_MULTI
#define MK_MULTI 0
#endif

typedef _Float16 f16;
typedef _Float16 f16x8 __attribute__((ext_vector_type(8)));
typedef _Float16 f16x4 __attribute__((ext_vector_type(4)));
typedef float f32x4 __attribute__((ext_vector_type(4)));
typedef unsigned long long u64;
typedef unsigned short u16;

constexpr int NB = 8, NS = 8192, ND = 1024, NT = NB * NS;
constexpr int INW = 2632;
constexpr int NMAIN = 2304;
constexpr float EPS = 1e-6f;
constexpr int NTHR = 512, NWAVE = 8;

constexpr size_t MiB = 1u << 20;
constexpr size_t WS_CTL = 0;
constexpr size_t WS_MOD = 1 * MiB;
constexpr size_t WS_WIN = 2 * MiB;
constexpr size_t WS_WVT = 7 * MiB;
constexpr size_t WS_WOUT = 8 * MiB;
constexpr size_t WS_WQ = 10 * MiB;
constexpr size_t WS_SK = 14 * MiB;
constexpr size_t WS_PW = 14 * MiB + 512 * 1024;
constexpr size_t WS_UT = 16 * MiB;
constexpr size_t WS_VP = 48 * MiB;
constexpr size_t WS_H = 80 * MiB;
constexpr size_t WS_U = 208 * MiB;
constexpr size_t WS_Q = 272 * MiB;
constexpr size_t WS_K = 336 * MiB;
constexpr size_t WS_VT = 400 * MiB;
constexpr size_t WS_PQ = 208 * MiB;
constexpr size_t WS_QI = 464 * MiB;
constexpr size_t WS_KI = 528 * MiB;
constexpr size_t WS_WI = 536 * MiB;
constexpr size_t WS_MASK = 544 * MiB;
constexpr size_t WS_EID = 608 * MiB;
constexpr size_t WS_GW = 624 * MiB;
constexpr size_t WS_END = 656 * MiB;

constexpr int LDS_BYTES = 155648;
constexpr float PEER_USCALE = 256.f, PEER_VSCALE = 16.f;

struct Args { const float* in[18]; float* out; unsigned char* ws; int ph_lo, ph_hi; };

__host__ __device__ __forceinline__ int pos2log(int p) { return 64 * ((p >> 5) & 3) + 32 * (p >> 7) + 8 * ((p >> 2) & 3) + 4 * ((p >> 4) & 1) + (p & 3); }
__device__ __forceinline__ int maincol(int L) { if (L < 1536) return L; if (L < 2120) return L + 512; return -1; }

__device__ __forceinline__ float wave_sum(float v) {
#pragma unroll
    for (int o = 1; o < 64; o <<= 1) v += __shfl_xor(v, o);
    return v;
}
__device__ __forceinline__ float wave_max(float v) {
#pragma unroll
    for (int o = 1; o < 64; o <<= 1) v = fmaxf(v, __shfl_xor(v, o));
    return v;
}

__device__ void ph0_prologue(const Args& a, int bid, int nb, unsigned char* lds) {
    int tid = threadIdx.x; asm volatile("" : "+v"(tid));
    const float* c = a.in[1]; const float* ada_w = a.in[2]; const float* ada_b = a.in[3];
    float* sil = (float*)lds;
    for (int i = tid; i < NB * ND; i += NTHR) { const float v = c[i]; sil[i] = v / (1.f + __expf(-v)); }
    __syncthreads();
    float* mod = (float*)(a.ws + WS_MOD);
    const int gt = bid * NTHR + tid, ngt = nb * NTHR;
    for (int o = gt; o < NB * 6144; o += ngt) {
        const int b = o / 6144, j = o % 6144;
        float acc = ada_b[j];
        const float* sb = sil + b * ND;
        for (int k = 0; k < ND; ++k) acc += sb[k] * ada_w[(size_t)k * 6144 + j];
        mod[o] = acc;
    }
    const float* w_in = a.in[5]; const float* pool_w = a.in[6]; const float* w_out = a.in[12];
    const float* wq = a.in[14]; const float* sk = a.in[15]; const float* pu = a.in[16]; const float* pv = a.in[17];
    f16* WIN = (f16*)(a.ws + WS_WIN); f16* WVT = (f16*)(a.ws + WS_WVT); f16* WOUT = (f16*)(a.ws + WS_WOUT); f16* WQ = (f16*)(a.ws + WS_WQ);
    f16* PW = (f16*)(a.ws + WS_PW); unsigned char* UT = a.ws + WS_UT; unsigned char* VP = a.ws + WS_VP;
    {
        __syncthreads();
        const int lane = tid & 63, wv_ = tid >> 6;
        float* scr = (float*)lds + wv_ * (64 * 33);
        constexpr int I_IN = 16 * (NMAIN / 32), I_VT = 16 * 16, I_OUT = 16 * 32, I_WQ = 16 * 64, I_ALL = I_IN + I_VT + I_OUT + I_WQ;
        for (int it = bid * NWAVE + wv_; it < I_ALL; it += nb * NWAVE) {
            int rr = it, kind = 0;
            if (rr >= I_IN) { rr -= I_IN; kind = 1; if (rr >= I_VT) { rr -= I_VT; kind = 2; if (rr >= I_OUT) { rr -= I_OUT; kind = 3; } } }
            const int npb = kind == 0 ? NMAIN / 32 : kind == 1 ? 16 : kind == 2 ? 32 : 64;
            const int k0 = (rr / npb) * 64, p0 = (rr % npb) * 32, p = p0 + (lane & 31);
            const float* W = kind <= 1 ? w_in : kind == 2 ? w_out : wq; const int ldw = kind <= 1 ? INW : kind == 2 ? 1024 : 2048;
            int col;
            if (kind == 0) col = maincol((p & ~255) + pos2log(p & 255)); else if (kind == 1) col = 1536 + p; else col = (p & ~255) + pos2log(p & 255);
            if (kind == 3) {
                const int hp = col >> 7, nn = col & 127;
                const float* skr = sk + (size_t)(hp * 128 + nn) * 128; const float* wqr = wq + (size_t)(k0 + (lane >> 5)) * 2048 + hp * 128;
                float accw[32];
#pragma unroll
                for (int i = 0; i < 32; ++i) accw[i] = 0.f;
#pragma unroll 1
                for (int dq = 0; dq < 128; dq += 32) {
                    f32x4 sr[8];
#pragma unroll
                    for (int e = 0; e < 8; ++e) sr[e] = *(const f32x4*)(skr + dq + 4 * e);
#pragma unroll
                    for (int i = 0; i < 32; ++i) { const float* wr = wqr + (size_t)(2 * i) * 2048 + dq;
#pragma unroll
                        for (int e = 0; e < 8; ++e) { const f32x4 w4 = *(const f32x4*)(wr + 4 * e); accw[i] += w4[0] * sr[e][0] + w4[1] * sr[e][1] + w4[2] * sr[e][2] + w4[3] * sr[e][3]; } }
                }
#pragma unroll
                for (int i = 0; i < 32; ++i) scr[(2 * i + (lane >> 5)) * 33 + (lane & 31)] = accw[i];
            } else {
#pragma unroll 8
                for (int i = 0; i < 32; ++i) { const int kk = 2 * i + (lane >> 5); scr[kk * 33 + (lane & 31)] = col >= 0 ? W[(size_t)(k0 + kk) * ldw + col] : 0.f; }
            }
            f16* WT = kind == 0 ? WIN : kind == 1 ? WVT : kind == 2 ? WOUT : WQ;
            const int c8 = lane & 7;
#pragma unroll
            for (int j = 0; j < 4; ++j) { const int n = (lane >> 3) + 8 * j; const float* sp = scr + (8 * c8) * 33 + n;
                *(f16x8*)(WT + (size_t)(p0 + n) * ND + k0 + 8 * c8) = (f16x8){(f16)sp[0], (f16)sp[33], (f16)sp[66], (f16)sp[99], (f16)sp[132], (f16)sp[165], (f16)sp[198], (f16)sp[231]}; }
        }
    }
    for (int i = gt; i < 4 * 128 * 128; i += ngt) { const int g = i >> 14, cc = (i >> 7) & 127, d = i & 127;
        PW[(((((g * 8 + (d >> 4)) * 4 + (cc >> 5)) * 4 + ((cc >> 3) & 3)) * 16 + (d & 15)) << 3) + (cc & 7)] = (f16)pool_w[i]; }
    for (int i = gt; i < 16384 * 1024 / 4; i += ngt) { const f32x4 u = ((const f32x4*)pu)[i] * PEER_USCALE, v = ((const f32x4*)pv)[i] * PEER_VSCALE;
        int pu8 = __builtin_amdgcn_cvt_pk_bf8_f32(u.x, u.y, 0, false); pu8 = __builtin_amdgcn_cvt_pk_bf8_f32(u.z, u.w, pu8, true);
        int pv8 = __builtin_amdgcn_cvt_pk_bf8_f32(v.x, v.y, 0, false); pv8 = __builtin_amdgcn_cvt_pk_bf8_f32(v.z, v.w, pv8, true);
        ((int*)UT)[i] = pu8; ((int*)VP)[i] = pv8; }
}

__device__ void row_norm_mod(const float* src, const float* g, const float* mod, int sh_off, int sc_off, f16* dst, int bid, int nb) {
    int tid_ = threadIdx.x; asm volatile("" : "+v"(tid_)); const int lane = tid_ & 63, wave = tid_ >> 6;
    for (int row = bid * NWAVE + wave; row < NT; row += nb * NWAVE) {
        const int b = row / NS;
        const f32x4* xr = (const f32x4*)(src + (size_t)row * ND) + lane;
        f32x4 v[4]; float s = 0.f;
#pragma unroll
        for (int j = 0; j < 4; ++j) { v[j] = xr[64 * j]; s += v[j].x * v[j].x + v[j].y * v[j].y + v[j].z * v[j].z + v[j].w * v[j].w; }
        const float rstd = rsqrtf(wave_sum(s) * (1.f / ND) + EPS);
#pragma unroll
        for (int j = 0; j < 4; ++j) {
            const int col = lane * 4 + 256 * j;
            const f32x4 gg = *(const f32x4*)(g + col), sc = *(const f32x4*)(mod + b * 6144 + sc_off + col), sh = *(const f32x4*)(mod + b * 6144 + sh_off + col);
            f16x4 o;
            o.x = (f16)(v[j].x * rstd * gg.x * (1.f + sc.x) + sh.x); o.y = (f16)(v[j].y * rstd * gg.y * (1.f + sc.y) + sh.y);
            o.z = (f16)(v[j].z * rstd * gg.z * (1.f + sc.z) + sh.z); o.w = (f16)(v[j].w * rstd * gg.w * (1.f + sc.w) + sh.w);
            *(f16x4*)(dst + (size_t)row * ND + col) = o;
        }
    }
}


namespace pg8 {
#define PG8_LAS __attribute__((address_space(3)))
constexpr int BM = 256, BK = 64, HALF = 128, HTB = HALF * BK * 2, STAGE_BYTES = 8 * HTB, NXCD = 8, WGM = 8;
__host__ __device__ __forceinline__ int lds_byte(int r, int c) { const int st = (r >> 4) * 2 + (c >> 5), rr = r & 15, cc = c & 31, ob = rr * 64 + cc * 2; return st * 1024 + (ob ^ (((ob >> 9) & 1) << 5)); }
__host__ __device__ __forceinline__ void stage_rc(int b, int& R, int& C) { const int st = b / 1024, sb = b % 1024, swz = sb ^ (((sb >> 9) & 1) << 5); R = (st >> 1) * 16 + swz / 64; C = (st & 1) * 32 + (swz % 64) / 2; }
struct Unit { int pm, pn; };
struct Gemm { const f16* A; const f16* Bt; int M, N, K; };
struct StaticOrder {
    int nM, nN, nwg, G, c;
    __host__ __device__ void init(int M, int N, int G_, int c_) { nM = M / BM; nN = N / BM; nwg = nM * nN; G = G_; c = c_; }
    __host__ __device__ bool next(int i, Unit& u) const {
        const long L = (long)i * G + c; if (L >= nwg) return false;
        int wgid = (int)L; { const int q = nwg / NXCD, r = nwg % NXCD, xcd = wgid % NXCD, off = wgid / NXCD; wgid = (xcd < r ? xcd * (q + 1) : r * (q + 1) + (xcd - r) * q) + off; }
        const int nig = WGM * nN, gid = wgid / nig, fm = gid * WGM, gsz = (nM - fm) < WGM ? (nM - fm) : WGM;
        u.pm = fm + ((wgid % nig) % gsz); u.pn = (wgid % nig) / gsz; return true;
    }
};
template <class Epi>
__device__ __forceinline__ void gemm_phase(PG8_LAS unsigned char* lds, const Gemm g, const StaticOrder& S, const Epi& E) {
    int tid = threadIdx.x; asm volatile("" : "+v"(tid));
    const int wid = __builtin_amdgcn_readfirstlane(tid >> 6), lane = tid & 63, wr = wid >> 2, wc = wid & 3, fr = lane & 15, fq = lane >> 4;
    const int K = g.K, nt = K / BK;
    unsigned voffA[2];
#pragma unroll
    for (int i = 0; i < 2; ++i) { int R, C; stage_rc(tid * 16 + i * 8192, R, C); voffA[i] = (unsigned)(R * K + C) * 2u; }
    const size_t kstep = (size_t)(BK * 2);
    const size_t hstep = (size_t)HALF * K * 2;
    const size_t tstep = 2 * hstep;
    const unsigned ldsw = (unsigned)wid * 1024u;
    const int aoff = lds_byte(wr * 64 + fr, fq * 8), boff = lds_byte(wc * 32 + fr, fq * 8);
#define PG8_SA(b, h) (((b) * 2 + (h)) * HTB)
#define PG8_SB(b, h) ((4 + (b) * 2 + (h)) * HTB)
#define PG8_STAGE(bufoff, gbase, voff) do { _Pragma("unroll") for (int _i = 0; _i < 2; ++_i) \
        __builtin_amdgcn_global_load_lds((const unsigned*)((const char*)(gbase) + (voff)[_i]), (PG8_LAS unsigned*)(lds + (bufoff) + ldsw + _i * 8192), 16, 0, 0); } while (0)
#define PG8_LDA(dst, b, h) do { _Pragma("unroll") for (int m = 0; m < 4; ++m) _Pragma("unroll") for (int k = 0; k < 2; ++k) dst[m][k] = *(const PG8_LAS f16x8*)(lds + PG8_SA(b, h) + aoff + m * 2048 + k * 1024); } while (0)
#define PG8_LDB(dst, b, h) do { _Pragma("unroll") for (int n = 0; n < 2; ++n) _Pragma("unroll") for (int k = 0; k < 2; ++k) dst[n][k] = *(const PG8_LAS f16x8*)(lds + PG8_SB(b, h) + boff + n * 2048 + k * 1024); } while (0)
#define PG8_MMA(ai, bj, At, Bt) do { __builtin_amdgcn_s_setprio(1); _Pragma("unroll") for (int m = 0; m < 4; ++m) _Pragma("unroll") for (int n = 0; n < 2; ++n) _Pragma("unroll") for (int k = 0; k < 2; ++k) \
        acc[ai][bj][m][n] = __builtin_amdgcn_mfma_f32_16x16x32_f16(Bt[n][k], At[m][k], acc[ai][bj][m][n], 0, 0, 0); __builtin_amdgcn_s_setprio(0); } while (0)
#define PG8_WAIT_V(n) asm volatile("s_waitcnt vmcnt(" #n ")" ::: "memory")
#define PG8_WAIT_L(n) asm volatile("s_waitcnt lgkmcnt(" #n ")" ::: "memory")
#define PG8_BAR __builtin_amdgcn_s_barrier()
#define PG8_SCHED __builtin_amdgcn_sched_barrier(0)
    Unit cur, nxt; int ui = 0;
    if (!S.next(0, cur)) return;
    f32x4 acc[2][2][4][2];
#pragma unroll
    for (int a = 0; a < 2; ++a)
#pragma unroll
        for (int b = 0; b < 2; ++b)
#pragma unroll
            for (int m = 0; m < 4; ++m)
#pragma unroll
                for (int n = 0; n < 2; ++n) acc[a][b][m][n] = (f32x4){0.f, 0.f, 0.f, 0.f};
    f16x8 At[4][2], B0[2][2], B1[2][2];
    const char* cA = (const char*)g.A + (size_t)cur.pm * tstep; const char* cB = (const char*)g.Bt + (size_t)cur.pn * tstep;
    PG8_STAGE(PG8_SB(0, 0), cB, voffA); PG8_STAGE(PG8_SB(0, 1), cB + hstep, voffA); PG8_STAGE(PG8_SA(0, 0), cA, voffA); PG8_STAGE(PG8_SA(0, 1), cA + hstep, voffA);
    if (wr == 1) PG8_BAR;
    PG8_WAIT_V(2); PG8_BAR;
    PG8_STAGE(PG8_SB(1, 0), cB + kstep, voffA); PG8_STAGE(PG8_SA(1, 0), cA + kstep, voffA); PG8_STAGE(PG8_SB(1, 1), cB + hstep + kstep, voffA);
    PG8_WAIT_V(6); PG8_BAR;
    for (;;) {
        const bool has_next = S.next(ui + 1, nxt);
        const char* nA = has_next ? (const char*)g.A + (size_t)nxt.pm * tstep : cA; const char* nB = has_next ? (const char*)g.Bt + (size_t)nxt.pn * tstep : cB;
        for (int t = 0; t < nt; t += 2) {
            const bool last = (t == nt - 2);
            const char* a1 = cA + (size_t)(t + 1) * kstep;
            const char* a2 = last ? nA : cA + (size_t)(t + 2) * kstep; const char* b2 = last ? nB : cB + (size_t)(t + 2) * kstep;
            const char* a3 = a2 + kstep; const char* b3 = b2 + kstep;
            PG8_LDB(B0, 0, 0); PG8_LDB(B1, 0, 1); PG8_SCHED; PG8_LDA(At, 0, 0); PG8_STAGE(PG8_SA(1, 1), a1 + hstep, voffA);
            PG8_WAIT_V(8); PG8_WAIT_L(0); PG8_BAR; PG8_MMA(0, 0, At, B0); PG8_MMA(0, 1, At, B1); PG8_BAR; PG8_SCHED;
            PG8_LDA(At, 0, 1); PG8_STAGE(PG8_SB(0, 0), b2, voffA); PG8_STAGE(PG8_SB(0, 1), b2 + hstep, voffA); PG8_STAGE(PG8_SA(0, 0), a2, voffA);
            PG8_WAIT_V(8); PG8_WAIT_L(0); PG8_BAR; PG8_MMA(1, 0, At, B0); PG8_MMA(1, 1, At, B1); PG8_BAR; PG8_SCHED;
            PG8_LDB(B0, 1, 0); PG8_LDB(B1, 1, 1); PG8_SCHED; PG8_LDA(At, 1, 0); PG8_STAGE(PG8_SA(0, 1), a2 + hstep, voffA);
            PG8_WAIT_V(8); PG8_WAIT_L(0); PG8_BAR; PG8_MMA(0, 0, At, B0); PG8_MMA(0, 1, At, B1); PG8_BAR; PG8_SCHED;
            PG8_LDA(At, 1, 1); PG8_STAGE(PG8_SB(1, 0), b3, voffA); PG8_STAGE(PG8_SB(1, 1), b3 + hstep, voffA); PG8_STAGE(PG8_SA(1, 0), a3, voffA);
            PG8_WAIT_V(8); PG8_WAIT_L(0); PG8_BAR; PG8_MMA(1, 0, At, B0); PG8_MMA(1, 1, At, B1); PG8_BAR; PG8_SCHED;
        }
        if (wr == 0) PG8_BAR;
        E(acc, cur, wr, wc, fr, fq);
        if (!has_next) break;
#pragma unroll
        for (int a = 0; a < 2; ++a)
#pragma unroll
            for (int b = 0; b < 2; ++b)
#pragma unroll
                for (int m = 0; m < 4; ++m)
#pragma unroll
                    for (int n = 0; n < 2; ++n) acc[a][b][m][n] = (f32x4){0.f, 0.f, 0.f, 0.f};
        cur = nxt; cA = nA; cB = nB; ++ui;
        if (wr == 1) PG8_BAR;
    }
    PG8_WAIT_V(0);
    PG8_BAR;
#undef PG8_SA
#undef PG8_SB
#undef PG8_STAGE
#undef PG8_LDA
#undef PG8_LDB
#undef PG8_MMA
#undef PG8_WAIT_V
#undef PG8_WAIT_L
#undef PG8_BAR
#undef PG8_SCHED
}

typedef f32x4 Acc[2][2][4][2];
struct EpiMain {
    unsigned char* ws; const float *qg, *kg;
    __device__ __forceinline__ void operator()(const Acc& acc, const Unit& u, int wr, int wc, int fr, int fq) const {
        const int row0 = u.pm * BM + wr * 64 + fr, pn = u.pn;
        if (pn == 8) {
            if (wc == 0) {
#pragma unroll
                for (int ai = 0; ai < 2; ++ai)
#pragma unroll
                    for (int m = 0; m < 4; ++m) { const size_t row = row0 + ai * HALF + m * 16;
#pragma unroll
                        for (int bj = 0; bj < 2; ++bj) { const f32x4 v0 = acc[ai][bj][m][0], v1 = acc[ai][bj][m][1];
                            *(f16x8*)((f16*)(ws + WS_KI) + (((row >> 5) * 8 + 4 * bj + fq) * 32 + (row & 31)) * 8) = (f16x8){(f16)v0[0], (f16)v0[1], (f16)v0[2], (f16)v0[3], (f16)v1[0], (f16)v1[1], (f16)v1[2], (f16)v1[3]}; } }
            } else if (wc == 1 && fq == 0) {
#pragma unroll
                for (int ai = 0; ai < 2; ++ai)
#pragma unroll
                    for (int m = 0; m < 4; ++m) { const size_t row = row0 + ai * HALF + m * 16;
                        *(f32x4*)((float*)(ws + WS_WI) + row * 8) = acc[ai][0][m][0] * 0.35355339059327373f; *(f32x4*)((float*)(ws + WS_WI) + row * 8 + 4) = acc[ai][0][m][1] * 0.35355339059327373f; }
            }
            return;
        }
        const int kind = pn >> 1;
        f16* base = (f16*)(ws + (kind == 0 ? WS_U : kind == 1 ? WS_Q : kind == 2 ? WS_K : WS_QI));
        const int col0 = (pn & 1) * 256 + 64 * wc + 8 * fq;
        if (kind == 1 || kind == 2) {
            const float* gp = (kind == 1 ? qg : kg) + 8 * fq;
#pragma unroll
            for (int ai = 0; ai < 2; ++ai)
#pragma unroll
                for (int m = 0; m < 4; ++m) { const size_t row = row0 + ai * HALF + m * 16;
                    float ss = 0.f;
#pragma unroll
                    for (int bj = 0; bj < 2; ++bj)
#pragma unroll
                        for (int n = 0; n < 2; ++n) { const f32x4 v = acc[ai][bj][m][n]; ss += v[0] * v[0] + v[1] * v[1] + v[2] * v[2] + v[3] * v[3]; }
                    ss += __shfl_xor(ss, 16); ss += __shfl_xor(ss, 32);
                    const float rstd = rsqrtf(ss * (1.f / 64.f) + EPS);
#pragma unroll
                    for (int bj = 0; bj < 2; ++bj) { const f32x4 v0 = acc[ai][bj][m][0] * rstd * *(const f32x4*)(gp + 32 * bj), v1 = acc[ai][bj][m][1] * rstd * *(const f32x4*)(gp + 32 * bj + 4);
                        *(f16x8*)(base + row * 512 + col0 + 32 * bj) = (f16x8){(f16)v0[0], (f16)v0[1], (f16)v0[2], (f16)v0[3], (f16)v1[0], (f16)v1[1], (f16)v1[2], (f16)v1[3]}; }
                    asm volatile("" ::: "memory"); }
        } else if (kind == 3) {
            const int hd = (pn & 1) * 4 + wc;
#pragma unroll
            for (int ai = 0; ai < 2; ++ai)
#pragma unroll
                for (int m = 0; m < 4; ++m) { const size_t row = row0 + ai * HALF + m * 16; const int ql = (int)(row & 7);
                    const int rr = (hd & 3) | (((ql >> 1) & 1) << 2) | ((hd >> 2) << 3) | ((ql & 1) << 4);
#pragma unroll
                    for (int bj = 0; bj < 2; ++bj) { const f32x4 v0 = acc[ai][bj][m][0], v1 = acc[ai][bj][m][1]; const int chunk = fq + 4 * bj;
                        *(f16x8*)(base + ((((((row >> 3) * 2 + (ql >> 2)) * 4 + (chunk >> 1)) * 2 + (chunk & 1)) * 32 + rr) << 3)) = (f16x8){(f16)v0[0], (f16)v0[1], (f16)v0[2], (f16)v0[3], (f16)v1[0], (f16)v1[1], (f16)v1[2], (f16)v1[3]}; } }
        } else {
#pragma unroll
            for (int ai = 0; ai < 2; ++ai)
#pragma unroll
                for (int m = 0; m < 4; ++m) { const size_t row = row0 + ai * HALF + m * 16;
#pragma unroll
                    for (int bj = 0; bj < 2; ++bj) { const f32x4 v0 = acc[ai][bj][m][0], v1 = acc[ai][bj][m][1];
                        *(f16x8*)(base + row * 512 + col0 + 32 * bj) = (f16x8){(f16)v0[0], (f16)v0[1], (f16)v0[2], (f16)v0[3], (f16)v1[0], (f16)v1[1], (f16)v1[2], (f16)v1[3]}; } }
        }
    }
};
struct EpiVT {
    f16* VT;
    __device__ __forceinline__ void operator()(const Acc& acc, const Unit& u, int wr, int wc, int fr, int fq) const {
        const int row0 = u.pm * BM + wr * 64 + fr, col0 = u.pn * BM + 32 * wc + 4 * fq;
#pragma unroll
        for (int ai = 0; ai < 2; ++ai)
#pragma unroll
            for (int m = 0; m < 4; ++m) { const size_t row = row0 + ai * HALF + m * 16;
#pragma unroll
                for (int bj = 0; bj < 2; ++bj)
#pragma unroll
                    for (int n = 0; n < 2; ++n) { const f32x4 v = acc[ai][bj][m][n];
                        *(f16x4*)(VT + row * NT + col0 + 128 * bj + 16 * n) = (f16x4){(f16)v[0], (f16)v[1], (f16)v[2], (f16)v[3]}; } }
    }
};
struct EpiOut {
    const float* x; const float* mod; float* out;
    __device__ __forceinline__ void operator()(const Acc& acc, const Unit& u, int wr, int wc, int fr, int fq) const {
        const int row0 = u.pm * BM + wr * 64 + fr, col0 = u.pn * BM + 64 * wc + 8 * fq;
        const float* g1 = mod + ((u.pm * BM) / NS) * 6144 + 2048 + col0;
        f32x4 g4[2][2];
#pragma unroll
        for (int bj = 0; bj < 2; ++bj)
#pragma unroll
            for (int n = 0; n < 2; ++n) g4[bj][n] = *(const f32x4*)(g1 + 32 * bj + 4 * n);
#pragma unroll
        for (int ai = 0; ai < 2; ++ai)
#pragma unroll
            for (int m = 0; m < 4; ++m) { const size_t off = (size_t)(row0 + ai * HALF + m * 16) * ND + col0;
#pragma unroll
                for (int bj = 0; bj < 2; ++bj)
#pragma unroll
                    for (int n = 0; n < 2; ++n) { const f32x4 xv = *(const f32x4*)(x + off + 32 * bj + 4 * n);
                        *(f32x4*)(out + off + 32 * bj + 4 * n) = xv + g4[bj][n] * acc[ai][bj][m][n]; } }
    }
};
struct EpiPQ {
    f16* PQ;
    __device__ __forceinline__ void operator()(const Acc& acc, const Unit& u, int wr, int wc, int fr, int fq) const {
        const int row0 = u.pm * BM + wr * 64 + fr, col0 = u.pn * BM + 64 * wc + 8 * fq;
#pragma unroll
        for (int ai = 0; ai < 2; ++ai)
#pragma unroll
            for (int m = 0; m < 4; ++m) { const size_t row = row0 + ai * HALF + m * 16;
#pragma unroll
                for (int bj = 0; bj < 2; ++bj) { const f32x4 v0 = acc[ai][bj][m][0], v1 = acc[ai][bj][m][1];
                    *(f16x8*)(PQ + ((((row >> 5) * 256 + ((col0 + 32 * bj) >> 3)) * 32 + (row & 31)) << 3)) = (f16x8){(f16)v0[0], (f16)v0[1], (f16)v0[2], (f16)v0[3], (f16)v1[0], (f16)v1[1], (f16)v1[2], (f16)v1[3]}; } }
    }
};
}

__device__ __forceinline__ void ph2_inproj(const Args& a, int bid, int nb, unsigned char* lds) {
    const f16* H = (const f16*)(a.ws + WS_H); const f16* WIN = (const f16*)(a.ws + WS_WIN); const f16* WVT = (const f16*)(a.ws + WS_WVT);
    PG8_LAS unsigned char* l3 = (PG8_LAS unsigned char*)lds;
    { pg8::Gemm g{H, WIN, NT, NMAIN, ND}; pg8::StaticOrder S; S.init(NT, NMAIN, nb, bid);
      pg8::EpiMain E{a.ws, a.in[9], a.in[10]};
      pg8::gemm_phase(l3, g, S, E); }
    { pg8::Gemm g{WVT, H, 512, NT, ND}; pg8::StaticOrder S; S.init(512, NT, nb, bid);
      pg8::EpiVT E{(f16*)(a.ws + WS_VT)};
      pg8::gemm_phase(l3, g, S, E); }
}


constexpr int PPITCH = 1040;
__device__ __forceinline__ void ph3_pool_fast(const Args& a, int bid, int nb, unsigned char* lds) {
    int tid = threadIdx.x; asm volatile("" : "+v"(tid));
    const int lane = tid & 63, wave = __builtin_amdgcn_readfirstlane(tid >> 6), fr = lane & 15, fq = lane >> 4;
    const f16* U = (const f16*)(a.ws + WS_U); const f16* PW = (const f16*)(a.ws + WS_PW); f16* MIX = (f16*)(a.ws + WS_H);
    const float* pscale = a.in[7]; const float* pg = a.in[8];
    float* red = (float*)(lds + 32 * PPITCH);
    typedef _Float16 h2 __attribute__((ext_vector_type(2)));
    for (int item = bid; item < NT / 32; item += nb) {
        const int t0 = item * 32;
        __syncthreads();
        {
            const int cg8 = tid & 63, tq = tid >> 6, gch = cg8 >> 4, win = 2 << gch;
            const int tb = t0 + 4 * tq, tl0 = tb % NS;
            const f16* up = U + (size_t)(tb - tl0) * 512 + 8 * cg8;
            float sm[8];
#pragma unroll
            for (int j = 0; j < 8; ++j) sm[j] = 0.f;
            f16x8 hist_[15];
#pragma unroll
            for (int q = 0; q < 15; ++q) { const int rr = tl0 - 15 + q; hist_[q] = (q >= 16 - win && rr >= 0) ? *(const f16x8*)(up + (size_t)rr * 512) : (f16x8){0, 0, 0, 0, 0, 0, 0, 0}; }
            f16x8 cur_[4];
#pragma unroll
            for (int k = 0; k < 4; ++k) cur_[k] = *(const f16x8*)(up + (size_t)(tl0 + k) * 512);
#pragma unroll
            for (int q = 0; q < 15; ++q)
#pragma unroll
                for (int j = 0; j < 8; ++j) sm[j] += (float)hist_[q][j];
#pragma unroll
            for (int k = 0; k < 4; ++k) {
                const int tl = tl0 + k;
                const float ic = 1.f / (float)((tl + 1 < win) ? tl + 1 : win);
                f16x8 o;
#pragma unroll
                for (int j = 0; j < 8; ++j) { sm[j] += (float)cur_[k][j]; o[j] = (f16)(sm[j] * ic - (float)cur_[k][j]); }
                *(f16x8*)(lds + (4 * tq + k) * PPITCH + 16 * cg8) = o;
                if (k < 3) {
#pragma unroll
                    for (int j = 0; j < 8; ++j) {
                        float dv;
                        const int q = 16 - win + k;
                        dv = 0.f;
#pragma unroll
                        for (int qq = 0; qq < 15; ++qq) if (qq == q) dv = (float)hist_[qq][j];
#pragma unroll
                        for (int kk = 0; kk < 3; ++kk) if (q == 15 + kk) dv = (float)cur_[kk][j];
                        sm[j] -= dv;
                    }
                }
            }
        }
        __syncthreads();
        const int g = wave >> 1, th = wave & 1;
        f32x4 acc[8];
#pragma unroll
        for (int nt = 0; nt < 8; ++nt) acc[nt] = (f32x4){0.f, 0.f, 0.f, 0.f};
#pragma unroll
        for (int ks = 0; ks < 4; ++ks) {
            const f16x8 bf = *(const f16x8*)(lds + (16 * th + fr) * PPITCH + (g * 128 + 32 * ks + 8 * fq) * 2);
#pragma unroll
            for (int nt = 0; nt < 8; ++nt) { const f16x8 af = *(const f16x8*)(PW + (((((g * 8 + nt) * 4 + ks) * 4 + fq) * 16 + fr) << 3));
                acc[nt] = __builtin_amdgcn_mfma_f32_16x16x32_f16(af, bf, acc[nt], 0, 0, 0); }
        }
        float ss = 0.f;
#pragma unroll
        for (int nt = 0; nt < 8; ++nt) { const f32x4 sc = *(const f32x4*)(pscale + g * 128 + 16 * nt + 4 * fq); acc[nt] = acc[nt] * sc;
            ss += acc[nt][0] * acc[nt][0] + acc[nt][1] * acc[nt][1] + acc[nt][2] * acc[nt][2] + acc[nt][3] * acc[nt][3]; }
        ss += __shfl_xor(ss, 16); ss += __shfl_xor(ss, 32);
        if (fq == 0) red[(16 * th + fr) * 4 + g] = ss;
        __syncthreads();
        const f32x4 r4 = *(const f32x4*)(red + (16 * th + fr) * 4);
        const float rstd = rsqrtf((r4[0] + r4[1] + r4[2] + r4[3]) * (1.f / 512.f) + EPS);
        const size_t orow = (size_t)(t0 + 16 * th + fr) * ND + g * 128 + 4 * fq;
#pragma unroll
        for (int nt = 0; nt < 8; ++nt) { const f32x4 gg = *(const f32x4*)(pg + g * 128 + 16 * nt + 4 * fq); const f32x4 v = acc[nt] * rstd * gg;
            *(f16x4*)(MIX + orow + 16 * nt) = (f16x4){(f16)v[0], (f16)v[1], (f16)v[2], (f16)v[3]}; }
    }
    __syncthreads();
}


typedef float f32x16 __attribute__((ext_vector_type(16)));
typedef float f32x2 __attribute__((ext_vector_type(2)));
typedef unsigned u32x4 __attribute__((ext_vector_type(4)));

constexpr int IDX_KPITCH = 16384 + 16;
constexpr int IDX_HPITCH = 516;
template <int NBL>
__device__ __forceinline__ int wave_pick(const unsigned (&cc)[NBL], unsigned target, int lane, unsigned& rem_out) {
    unsigned tot = 0u;
#pragma unroll
    for (int j = 0; j < NBL; ++j) tot += cc[j];
    unsigned S = tot;
#pragma unroll
    for (int o = 1; o < 64; o <<= 1) { const unsigned v = __shfl_down(S, o); if (lane + o < 64) S += v; }
    const unsigned above = S - tot;
    const bool hit = (above < target) && (S >= target);
    const u64 bal = __ballot(hit);
    const int L = bal ? __builtin_ctzll(bal) : 0;
    int bin = 0; unsigned rem = target;
    { unsigned run = above; bool done = false;
#pragma unroll
      for (int j = NBL - 1; j >= 0; --j) { if (!done) { if (run + cc[j] >= target) { bin = NBL * lane + j; rem = target - run; done = true; } else run += cc[j]; } } }
    bin = __shfl(bin, L); rem_out = __shfl(rem, L);
    return bin;
}
template <int MODE>
__device__ __forceinline__ void ph3_index_fast(const Args& a, int bid, int nb, unsigned char* lds) {
    int tid = threadIdx.x; asm volatile("" : "+v"(tid));
    const int lane = tid & 63, wave = __builtin_amdgcn_readfirstlane(tid >> 6), r = lane & 31, hh = lane >> 5;
    const f16* QI = (const f16*)(a.ws + WS_QI); const f16* KI = (const f16*)(a.ws + WS_KI); const float* WI = (const float*)(a.ws + WS_WI);
    u64* MASK = (u64*)(a.ws + WS_MASK);
    unsigned* hist = (unsigned*)(lds + 8 * IDX_KPITCH);
    f16x8 af[2][4]; f32x2 wv2[2][8];
#define IDX_LOAD_FRAGS(t0_) do { \
        _Pragma("unroll") for (int rt = 0; rt < 2; ++rt) { \
            _Pragma("unroll") for (int ks = 0; ks < 4; ++ks) af[rt][ks] = *(const f16x8*)(QI + ((((((size_t)((t0_) >> 3) * 2 + rt) * 4 + ks) * 2 + hh) * 32 + r) << 3)); \
            _Pragma("unroll") for (int qq = 0; qq < 2; ++qq) { const float* wp = WI + (size_t)((t0_) + 4 * rt + 2 * hh + qq) * 8; const f32x4 w0 = *(const f32x4*)wp * 0.125f, w1 = *(const f32x4*)(wp + 4) * 0.125f; \
                wv2[rt][4 * qq + 0] = (f32x2){w0[0], w0[1]}; wv2[rt][4 * qq + 1] = (f32x2){w0[2], w0[3]}; wv2[rt][4 * qq + 2] = (f32x2){w1[0], w1[1]}; wv2[rt][4 * qq + 3] = (f32x2){w1[2], w1[3]}; } \
        } } while (0)
    for (int round = 0; round * nb < 256; ++round) {
        const int p = round * nb + ((round & 1) ? (nb - 1 - bid) : bid);
        if (p < 256) { const int tg = p >> 3, b_ = p & 7, t0l = tg * 8, ch_ = t0l >> 6, t0_ = b_ * NS + t0l;
            if (tid < 8 * (ch_ + 1)) { const int q = tid / (ch_ + 1), w = tid % (ch_ + 1); MASK[((size_t)b_ * 128 + w) * NS + t0l + q] = ~0ull; } }
    }
#define IDX_P(round_) ((round_) * nb + (((round_) & 1) ? (nb - 1 - bid) : bid))
    int round = 0;
    while (round * nb < 8192 && !(IDX_P(round) >= 256 && IDX_P(round) < 8192)) ++round;
    if (round * nb < 8192) { const int p0 = IDX_P(round); IDX_LOAD_FRAGS((p0 & 7) * NS + (p0 >> 3) * 8); }
    for (; round * nb < 8192; ) {
        const int p = IDX_P(round);
        int rnext = round + 1;
        while (rnext * nb < 8192 && !(IDX_P(rnext) >= 256 && IDX_P(rnext) < 8192)) ++rnext;
        const bool has_next = rnext * nb < 8192;
        const int pn = has_next ? IDX_P(rnext) : p;
        const int tg = p >> 3, b = p & 7, t0l = tg * 8, ch = t0l >> 6, nadm = 64 * (ch + 1), t0 = b * NS + t0l;
        const int t0n = (pn & 7) * NS + (pn >> 3) * 8;
        round = has_next ? rnext : 8192;
        __syncthreads();
#pragma unroll
        for (int i = 0; i < 9; ++i) if (tid + i * NTHR < 8 * IDX_HPITCH) hist[tid + i * NTHR] = 0u;
        __syncthreads();
        const int nkb = nadm >> 5;
        const f16* kbase = KI + ((size_t)(b * (NS / 32)) * 8 + hh) * 256 + r * 8;
#define IDX_LOADB(dst, kb_) do { _Pragma("unroll") for (int ks = 0; ks < 4; ++ks) dst[ks] = *(const f16x8*)(kbase + ((size_t)(kb_) * 8 + 2 * ks) * 256); } while (0)
#define IDX_BLOCK(bfrag, kb_) do { \
            f32x16 acc[2]; \
            _Pragma("unroll") for (int rt = 0; rt < 2; ++rt) { acc[rt] = (f32x16){0.f, 0.f, 0.f, 0.f, 0.f, 0.f, 0.f, 0.f, 0.f, 0.f, 0.f, 0.f, 0.f, 0.f, 0.f, 0.f}; \
                _Pragma("unroll") for (int ks = 0; ks < 4; ++ks) acc[rt] = __builtin_amdgcn_mfma_f32_32x32x16_f16(af[rt][ks], bfrag[ks], acc[rt], 0, 0, 0); } \
            _Pragma("unroll") for (int rt = 0; rt < 2; ++rt) \
                _Pragma("unroll") for (int qq = 0; qq < 2; ++qq) { \
                    f32x2 t2 = (f32x2){0.f, 0.f}; \
                    _Pragma("unroll") for (int hp = 0; hp < 4; ++hp) { const f32x2 r2 = (f32x2){__int_as_float(max(__float_as_int(acc[rt][8 * qq + 2 * hp]), 0)), __int_as_float(max(__float_as_int(acc[rt][8 * qq + 2 * hp + 1]), 0))}; \
                        t2 = __builtin_elementwise_fma(wv2[rt][4 * qq + hp], r2, t2); } \
                    const float sc = t2[0] + t2[1]; \
                    const f16 sh = (f16)sc; const unsigned bits = (unsigned)__builtin_bit_cast(unsigned short, sh); \
                    const unsigned key = (bits & 0x8000u) ? (~bits & 0xFFFFu) : (bits | 0x8000u); \
                    const int q = 4 * rt + 2 * hh + qq; \
                    if (MODE != 2) *(u16*)(lds + q * IDX_KPITCH + ((kb_) * 32 + r) * 2) = (u16)key; \
                    if (MODE != 2 && MODE != 4) atomicAdd(&hist[q * IDX_HPITCH + (key >> 7)], (key & 64u) ? 0x10000u : 1u); \
                    if (MODE == 2) sink += key; \
                } } while (0)
        f16x8 bf0[4], bf1[4], bf2[4]; unsigned sink = 0u;
        if (wave >= 4) __builtin_amdgcn_s_sleep(5);
        if (wave < nkb) IDX_LOADB(bf0, wave);
        if (wave + 8 < nkb) IDX_LOADB(bf1, wave + 8);
        if (wave + 16 < nkb) IDX_LOADB(bf2, wave + 16);
        if (MODE != 3) for (int kb = wave; kb < nkb; kb += 24) {
            IDX_BLOCK(bf0, kb);
            if (kb + 24 < nkb) IDX_LOADB(bf0, kb + 24);
            if (kb + 8 < nkb) { IDX_BLOCK(bf1, kb + 8); if (kb + 32 < nkb) IDX_LOADB(bf1, kb + 32); }
            if (kb + 16 < nkb) { IDX_BLOCK(bf2, kb + 16); if (kb + 40 < nkb) IDX_LOADB(bf2, kb + 40); }
        }
#undef IDX_LOADB
#undef IDX_BLOCK
        if (MODE == 2 && sink == 0xdeadbeefu) hist[tid] = sink;
        IDX_LOAD_FRAGS(t0n);
        __syncthreads();
        if (MODE != 1) {
            unsigned* hw = hist + wave * IDX_HPITCH;
            const unsigned char* krow = lds + wave * IDX_KPITCH;
            unsigned rem1 = 0u, rem2 = 0u;
            int b1;
            {   const u32x4 d0 = *(const u32x4*)(hw + 8 * lane), d1 = *(const u32x4*)(hw + 8 * lane + 4);
                const unsigned dd[8] = {d0.x, d0.y, d0.z, d0.w, d1.x, d1.y, d1.z, d1.w};
                unsigned cc[16];
#pragma unroll
                for (int j = 0; j < 8; ++j) { cc[2 * j] = dd[j] & 0xFFFFu; cc[2 * j + 1] = dd[j] >> 16; }
                b1 = wave_pick<16>(cc, 256u, lane, rem1); }
            hw[lane] = 0u;
            const int nit = (nadm + 511) >> 9;
            for (int it = 0; it < nit; ++it) {
                const int idx = (it * 64 + lane) * 8;
                if (idx < nadm) { const u32x4 k4 = *(const u32x4*)(krow + idx * 2);
                    const unsigned kk[4] = {k4.x, k4.y, k4.z, k4.w};
                    unsigned hit = 0u;
#pragma unroll
                    for (int j = 0; j < 4; ++j) { hit |= (((kk[j] & 0xFFFFu) >> 6) == (unsigned)b1 ? 1u : 0u) << (2 * j); hit |= ((kk[j] >> 22) == (unsigned)b1 ? 1u : 0u) << (2 * j + 1); }
                    if (hit) {
#pragma unroll
                        for (int j = 0; j < 4; ++j) { const unsigned k0 = kk[j] & 0xFFFFu, k1 = kk[j] >> 16;
                            if (hit & (1u << (2 * j))) atomicAdd(&hw[k0 & 63u], 1u);
                            if (hit & (2u << (2 * j))) atomicAdd(&hw[k1 & 63u], 1u); }
                    } }
            }
            int b2;
            { const unsigned c1[1] = {hw[lane]}; b2 = wave_pick<1>(c1, rem1, lane, rem2); }
            const unsigned tau = ((unsigned)b1 << 6) | (unsigned)b2;
            const size_t mrow = (size_t)(t0 + wave) * 128;
            for (int it = 0; it < nit; ++it) {
                const int idx = (it * 64 + lane) * 8;
                unsigned byte = 0u;
                if (idx < nadm) { const u32x4 k4 = *(const u32x4*)(krow + idx * 2);
                    const unsigned kk[4] = {k4.x, k4.y, k4.z, k4.w};
#pragma unroll
                    for (int j = 0; j < 4; ++j) { byte |= ((kk[j] & 0xFFFFu) >= tau ? 1u : 0u) << (2 * j); byte |= ((kk[j] >> 16) >= tau ? 1u : 0u) << (2 * j + 1); } }
                unsigned lo = (lane & 4) ? 0u : (byte << (8 * (lane & 3))), hi = (lane & 4) ? (byte << (8 * (lane & 3))) : 0u;
                lo |= __shfl_xor(lo, 1); hi |= __shfl_xor(hi, 1); lo |= __shfl_xor(lo, 2); hi |= __shfl_xor(hi, 2); lo |= __shfl_xor(lo, 4); hi |= __shfl_xor(hi, 4);
                if ((lane & 7) == 0 && idx < nadm) { hw[64 + 2 * (it * 8 + (lane >> 3))] = lo; hw[64 + 2 * (it * 8 + (lane >> 3)) + 1] = hi; }
            }
        }
        __syncthreads();
        if (MODE != 1) { const int w = tid >> 2, qp = tid & 3;
            if (w <= ch) { const unsigned* ha = hist + (2 * qp) * IDX_HPITCH + 64 + 2 * w; const unsigned* hb = ha + IDX_HPITCH;
                *(u32x4*)(MASK + ((size_t)b * 128 + w) * NS + t0l + 2 * qp) = (u32x4){ha[0], ha[1], hb[0], hb[1]}; } }
    }
    __syncthreads();
}

constexpr int ATP = 144;
constexpr int ATT_QWORD = 3584 + 32 * 64;
template <int AMODE>
__device__ __forceinline__ void ph4_attn_fast(const Args& a, int bid, int nb, unsigned char* lds) {
    int tid = threadIdx.x; asm volatile("" : "+v"(tid));
    const int lane = tid & 63, wave = __builtin_amdgcn_readfirstlane(tid >> 6), r = lane & 31, hh = lane >> 5;
    const f16* Q = (const f16*)(a.ws + WS_Q); const f16* Kk = (const f16*)(a.ws + WS_K); const f16* VT = (const f16*)(a.ws + WS_VT);
    const u64* MASK = (const u64*)(a.ws + WS_MASK); f16* MIX = (f16*)(a.ws + WS_H); const float* og = a.in[11];
    unsigned char* Kl = lds; unsigned char* Vl = lds + 2 * 64 * ATP;
    const float LOG2E = 1.4426950408889634f, OFF = 8192.f;
    const int pir = 16 * (r >> 4) + 8 * ((r >> 2) & 1) + 4 * ((r >> 3) & 1) + (r & 3);
    const int srow = tid >> 3, schk = tid & 7;
    unsigned* aq = (unsigned*)(a.ws + WS_CTL) + ATT_QWORD;
    volatile unsigned* ucell = (volatile unsigned*)(lds + 6 * 64 * ATP);
    volatile unsigned* dflag = ucell + 8;
    const float kmax = __int_as_float(__builtin_amdgcn_readfirstlane(__float_as_int(1.01f * 8.f * wave_max(fabsf(a.in[10][lane])))));
    int upar = 0;
    for (;;) {
        if (tid == 0) ucell[upar] = __hip_atomic_fetch_add(aq, 1u, __ATOMIC_RELAXED, __HIP_MEMORY_SCOPE_AGENT);
        if (tid < 8) dflag[tid] = 0u;
        __syncthreads();
        const unsigned u = ucell[upar]; upar ^= 1;
        if (u >= 2048u) break;
        const int h = 7 - (int)(u >> 8), qb = 31 - (int)((u & 255u) >> 3), b = (int)(u & 7u);
        const int q0l = qb * 256, tq = q0l + 32 * wave + r, cw = 4 * qb + (wave >> 1), top = 4 * qb + 3;
        const size_t t = (size_t)b * NS + tq;
        const float slope = exp2f(-(float)(h + 1)) * LOG2E;
        f16x8 qf[4];
#pragma unroll
        for (int ks = 0; ks < 4; ++ks) { const f16x8 qv = *(const f16x8*)(Q + t * 512 + h * 64 + 16 * ks + 8 * hh);
#pragma unroll
            for (int j = 0; j < 8; ++j) qf[ks][j] = (f16)((float)qv[j] * (0.125f * LOG2E)); }
        float qss = 0.f;
#pragma unroll
        for (int ks = 0; ks < 4; ++ks)
#pragma unroll
            for (int j = 0; j < 8; ++j) qss += (float)qf[ks][j] * (float)qf[ks][j];
        qss += __shfl_xor(qss, 32);
        const float Sb = __int_as_float(__builtin_amdgcn_readfirstlane(__float_as_int(wave_max(sqrtf(qss)) * kmax)));
        const float rowc = OFF + slope * (float)(tq - q0l);
        float m = 1000.f, l = 0.f;
        f32x16 O[2];
#pragma unroll
        for (int dt = 0; dt < 2; ++dt) O[dt] = (f32x16){0.f, 0.f, 0.f, 0.f, 0.f, 0.f, 0.f, 0.f, 0.f, 0.f, 0.f, 0.f, 0.f, 0.f, 0.f, 0.f};
        const f16* kg = Kk + ((size_t)b * NS + srow) * 512 + h * 64 + schk * 8;
        const f16* vg = VT + (size_t)(h * 64 + srow) * NT + (size_t)b * NS + schk * 8;
        f16x8 kr0, kr1, vr0, vr1; u64 mw0 = 0ull, mw1 = 0ull;
#define ATT_LOAD(kr, vr, mwv, jj) do { if ((jj) >= 0) { kr = *(const f16x8*)(kg + (size_t)(jj) * 64 * 512); vr = *(const f16x8*)(vg + (jj) * 64); mwv = ((jj) <= cw) ? MASK[((size_t)b * 128 + (jj)) * NS + tq] : 0ull; } } while (0)
        ATT_LOAD(kr0, vr0, mw0, top); ATT_LOAD(kr1, vr1, mw1, top - 1);
        int buf = 0; bool wdone = false, stop = false;
        auto step = [&](f16x8& kreg, f16x8& vreg, u64& mwr, const int j) {
            *(f16x8*)(Kl + buf * 64 * ATP + srow * ATP + schk * 16) = kreg;
            *(f16x8*)(Vl + buf * 64 * ATP + srow * ATP + schk * 16) = vreg;
            const u64 mw = mwr;
            asm volatile("s_waitcnt lgkmcnt(0)" ::: "memory"); __builtin_amdgcn_s_barrier(); asm volatile("" ::: "memory");
            {
                const unsigned jp = (unsigned)(j + 1);
                if ((dflag[0] > jp) & (dflag[1] > jp) & (dflag[2] > jp) & (dflag[3] > jp) & (dflag[4] > jp) & (dflag[5] > jp) & (dflag[6] > jp) & (dflag[7] > jp)) { stop = true; return; }
            }
            ATT_LOAD(kreg, vreg, mwr, j - 2);
            if (!wdone && j < cw) { const float lmax = Sb + OFF + slope * (float)(64 * j + 63 - q0l); if (__all(lmax - m < -28.f)) { wdone = true; if (lane == 0) dflag[wave] = (unsigned)(j + 1); } }
            if (j <= cw && !wdone) {
                const unsigned char* kb_ = Kl + buf * 64 * ATP + pir * ATP + 16 * hh;
                f16x8 fr8[8];
#pragma unroll
                for (int kt = 0; kt < 2; ++kt)
#pragma unroll
                    for (int ks = 0; ks < 4; ++ks) fr8[kt * 4 + ks] = *(const f16x8*)(kb_ + kt * 32 * ATP + ks * 32);
                f32x16 sa[2];
                if (j == cw) {
#pragma unroll
                    for (int kt = 0; kt < 2; ++kt)
#pragma unroll
                        for (int rg = 0; rg < 16; ++rg) { const float x = (float)(64 * j + 32 * kt + 16 * (rg >> 3) + 8 * hh + (rg & 7) - tq); sa[kt][rg] = rowc - slope * fabsf(x); }
                } else {
                    const float base = OFF + slope * (float)(64 * j + 8 * hh - q0l);
#pragma unroll
                    for (int kt = 0; kt < 2; ++kt)
#pragma unroll
                        for (int rg = 0; rg < 16; ++rg) sa[kt][rg] = __builtin_fmaf(slope, (float)(32 * kt + 16 * (rg >> 3) + (rg & 7)), base);
                }
                __builtin_amdgcn_sched_barrier(0);
                __builtin_amdgcn_s_setprio(1);
#pragma unroll
                for (int kt = 0; kt < 2; ++kt)
#pragma unroll
                    for (int ks = 0; ks < 4; ++ks) sa[kt] = __builtin_amdgcn_mfma_f32_32x32x16_f16(fr8[kt * 4 + ks], qf[ks], sa[kt], 0, 0, 0);
                __builtin_amdgcn_s_setprio(0);
                __builtin_amdgcn_sched_barrier(0);
                const unsigned char* vb_ = Vl + buf * 64 * ATP + r * ATP + 16 * hh;
#pragma unroll
                for (int dt = 0; dt < 2; ++dt)
#pragma unroll
                    for (int kt = 0; kt < 2; ++kt)
#pragma unroll
                        for (int s2 = 0; s2 < 2; ++s2) fr8[dt * 4 + kt * 2 + s2] = *(const f16x8*)(vb_ + dt * 32 * ATP + kt * 64 + s2 * 32);
                __builtin_amdgcn_sched_barrier(0);
                float rm = 0.f;
#pragma unroll
                for (int kt = 0; kt < 2; ++kt) { const unsigned w32 = (unsigned)(kt ? (mw >> 32) : mw) >> (8 * hh);
#pragma unroll
                    for (int rg = 0; rg < 16; ++rg) { const int tm = __builtin_amdgcn_sbfe((int)w32, 16 * (rg >> 3) + (rg & 7), 1);
                        const float L = __int_as_float(__float_as_int(sa[kt][rg]) & tm); sa[kt][rg] = L; rm = fmaxf(rm, L); } }
                rm = fmaxf(rm, __shfl_xor(rm, 32));
                const float mn = fmaxf(m, rm);
                if (__any(mn > m)) { const float al = __builtin_amdgcn_exp2f(m - mn); l *= al;
#pragma unroll
                    for (int dt = 0; dt < 2; ++dt)
#pragma unroll
                        for (int rg = 0; rg < 16; ++rg) O[dt][rg] *= al; }
                m = mn;
                f16x8 pf[2][2];
                float l0 = 0.f, l1 = 0.f;
#pragma unroll
                for (int kt = 0; kt < 2; ++kt)
#pragma unroll
                    for (int rg = 0; rg < 16; ++rg) { const float pp = __builtin_amdgcn_exp2f(sa[kt][rg] - m); if (rg & 1) l1 += pp; else l0 += pp; pf[kt][rg >> 3][rg & 7] = (f16)pp; }
                l += l0 + l1;
                __builtin_amdgcn_sched_barrier(0);
                __builtin_amdgcn_s_setprio(1);
#pragma unroll
                for (int dt = 0; dt < 2; ++dt)
#pragma unroll
                    for (int kt = 0; kt < 2; ++kt)
#pragma unroll
                        for (int s2 = 0; s2 < 2; ++s2) O[dt] = __builtin_amdgcn_mfma_f32_32x32x16_f16(fr8[dt * 4 + kt * 2 + s2], pf[kt][s2], O[dt], 0, 0, 0);
                __builtin_amdgcn_s_setprio(0);
            }
            buf ^= 1;
        };
        for (int j = top; j >= 0; j -= 2) {
            step(kr0, vr0, mw0, j); if (stop) break;
            if (j - 1 >= 0) { step(kr1, vr1, mw1, j - 1); if (stop) break; }
        }
#undef ATT_LOAD
        l += __shfl_xor(l, 32);
        const float inv = 1.f / l;
        float ss = 0.f;
#pragma unroll
        for (int dt = 0; dt < 2; ++dt)
#pragma unroll
            for (int rg = 0; rg < 16; ++rg) { O[dt][rg] *= inv; ss += O[dt][rg] * O[dt][rg]; }
        ss += __shfl_xor(ss, 32);
        const float rstd = rsqrtf(ss * (1.f / 64.f) + EPS);
#pragma unroll
        for (int dt = 0; dt < 2; ++dt)
#pragma unroll
            for (int g4 = 0; g4 < 4; ++g4) { const int d = 32 * dt + 8 * g4 + 4 * hh; const f32x4 gg = *(const f32x4*)(og + h * 64 + d);
                f16x4 o4; o4.x = (f16)(O[dt][4 * g4 + 0] * rstd * gg.x); o4.y = (f16)(O[dt][4 * g4 + 1] * rstd * gg.y); o4.z = (f16)(O[dt][4 * g4 + 2] * rstd * gg.z); o4.w = (f16)(O[dt][4 * g4 + 3] * rstd * gg.w);
                *(f16x4*)(MIX + t * ND + 512 + h * 64 + d) = o4; }
        __syncthreads();
    }
}

__device__ __forceinline__ void ph5_outproj(const Args& a, int bid, int nb, unsigned char* lds) {
    pg8::Gemm g{(const f16*)(a.ws + WS_H), (const f16*)(a.ws + WS_WOUT), NT, 1024, ND}; pg8::StaticOrder S; S.init(NT, 1024, nb, bid);
    pg8::EpiOut E{a.in[0], (const float*)(a.ws + WS_MOD), a.out};
    pg8::gemm_phase((PG8_LAS unsigned char*)lds, g, S, E);
}

__device__ __forceinline__ void ph7_peerq(const Args& a, int bid, int nb, unsigned char* lds) {
    pg8::Gemm g{(const f16*)(a.ws + WS_H), (const f16*)(a.ws + WS_WQ), NT, 2048, ND}; pg8::StaticOrder S; S.init(NT, 2048, nb, bid);
    pg8::EpiPQ E{(f16*)(a.ws + WS_PQ)};
    pg8::gemm_phase((PG8_LAS unsigned char*)lds, g, S, E);
}


__device__ __forceinline__ unsigned f2skey(float f) { const unsigned u = __float_as_uint(f); return (u & 0x80000000u) ? ~u : (u | 0x80000000u); }
__device__ __forceinline__ float skey2f(unsigned k) { return __uint_as_float((k & 0x80000000u) ? (k & 0x7FFFFFFFu) : ~k); }
#define CE_(a_, b_) do { const unsigned t__ = max(a_, b_); b_ = min(a_, b_); a_ = t__; } while (0)
#define SORT16_DESC(v) do { CE_(v[0], v[1]); CE_(v[2], v[3]); CE_(v[0], v[2]); CE_(v[1], v[3]); CE_(v[1], v[2]); CE_(v[4], v[5]); CE_(v[6], v[7]); CE_(v[4], v[6]); CE_(v[5], v[7]); CE_(v[5], v[6]); CE_(v[0], v[4]); CE_(v[2], v[6]); CE_(v[2], v[4]); CE_(v[1], v[5]); CE_(v[3], v[7]); CE_(v[3], v[5]); CE_(v[1], v[2]); CE_(v[3], v[4]); CE_(v[5], v[6]); CE_(v[8], v[9]); CE_(v[10], v[11]); CE_(v[8], v[10]); CE_(v[9], v[11]); CE_(v[9], v[10]); CE_(v[12], v[13]); CE_(v[14], v[15]); CE_(v[12], v[14]); CE_(v[13], v[15]); CE_(v[13], v[14]); CE_(v[8], v[12]); CE_(v[10], v[14]); CE_(v[10], v[12]); CE_(v[9], v[13]); CE_(v[11], v[15]); CE_(v[11], v[13]); CE_(v[9], v[10]); CE_(v[11], v[12]); CE_(v[13], v[14]); CE_(v[0], v[8]); CE_(v[4], v[12]); CE_(v[4], v[8]); CE_(v[2], v[10]); CE_(v[6], v[14]); CE_(v[6], v[10]); CE_(v[2], v[4]); CE_(v[6], v[8]); CE_(v[10], v[12]); CE_(v[1], v[9]); CE_(v[5], v[13]); CE_(v[5], v[9]); CE_(v[3], v[11]); CE_(v[7], v[15]); CE_(v[7], v[11]); CE_(v[3], v[5]); CE_(v[7], v[9]); CE_(v[11], v[13]); CE_(v[1], v[2]); CE_(v[3], v[4]); CE_(v[5], v[6]); CE_(v[7], v[8]); CE_(v[9], v[10]); CE_(v[11], v[12]); CE_(v[13], v[14]); } while (0)
#define BITONIC16_DESC(v) do { CE_(v[0], v[8]); CE_(v[1], v[9]); CE_(v[2], v[10]); CE_(v[3], v[11]); CE_(v[4], v[12]); CE_(v[5], v[13]); CE_(v[6], v[14]); CE_(v[7], v[15]); CE_(v[0], v[4]); CE_(v[1], v[5]); CE_(v[2], v[6]); CE_(v[3], v[7]); CE_(v[8], v[12]); CE_(v[9], v[13]); CE_(v[10], v[14]); CE_(v[11], v[15]); CE_(v[0], v[2]); CE_(v[1], v[3]); CE_(v[4], v[6]); CE_(v[5], v[7]); CE_(v[8], v[10]); CE_(v[9], v[11]); CE_(v[12], v[14]); CE_(v[13], v[15]); CE_(v[0], v[1]); CE_(v[2], v[3]); CE_(v[4], v[5]); CE_(v[6], v[7]); CE_(v[8], v[9]); CE_(v[10], v[11]); CE_(v[12], v[13]); CE_(v[14], v[15]); } while (0)
#define MERGE16_DESC(dst, other) do { unsigned c__[16]; _Pragma("unroll") for (int i__ = 0; i__ < 16; ++i__) c__[i__] = max(dst[i__], other[15 - i__]); BITONIC16_DESC(c__); _Pragma("unroll") for (int i__ = 0; i__ < 16; ++i__) dst[i__] = c__[i__]; } while (0)
#define TOP16_INSERT(v, x_) do { unsigned x__ = (x_); _Pragma("unroll") for (int k_ = 0; k_ < 16; ++k_) { const unsigned t__ = max(v[k_], x__); x__ = min(v[k_], x__); v[k_] = t__; } } while (0)
__device__ __forceinline__ void ph8_peersel_fast(const Args& a, int bid, int nb, unsigned char* lds) {
    int tid = threadIdx.x; asm volatile("" : "+v"(tid));
    const int lane = tid & 63, wave = __builtin_amdgcn_readfirstlane(tid >> 6), r = lane & 31, hh = lane >> 5;
    const f16* PQ = (const f16*)(a.ws + WS_PQ);
    u16* EID = (u16*)(a.ws + WS_EID); float* GW = (float*)(a.ws + WS_GW);
    unsigned char* wl = lds + wave * 2048 + lane * 32;
    for (int item = bid * NWAVE + wave; item < (NT / 32) * 8; item += nb * NWAVE) {
        const int tt = item >> 3, h = item & 7, t0 = tt * 32;
        unsigned top[2][16];
#pragma unroll
        for (int p = 0; p < 2; ++p) {
            f16x8 sq[8];
#pragma unroll
            for (int c = 0; c < 8; ++c) sq[c] = *(const f16x8*)(PQ + ((((size_t)tt * 256 + h * 32 + p * 16 + 8 * hh + c) * 32 + r) << 3));
#pragma unroll
            for (int k = 0; k < 16; ++k) top[p][k] = 0u;
#pragma unroll
            for (int g = 0; g < 4; ++g) {
                unsigned ky[16];
#pragma unroll
                for (int i = 0; i < 16; ++i) { const unsigned n = 64u * hh + 16u * g + i; ky[i] = (f2skey((float)sq[2 * g + (i >> 3)][i & 7]) & ~127u) | n; }
                SORT16_DESC(ky); MERGE16_DESC(top[p], ky);
            }
            unsigned oth[16];
#pragma unroll
            for (int k = 0; k < 16; ++k) oth[k] = __shfl_xor(top[p][k], 32);
            MERGE16_DESC(top[p], oth);
            asm volatile("" ::: "memory");
        }
#pragma unroll
        for (int k = 0; k < 16; k += 4) {
            *(unsigned*)(wl + k) = (top[0][k] & 127u) | ((top[0][k + 1] & 127u) << 8) | ((top[0][k + 2] & 127u) << 16) | ((top[0][k + 3] & 127u) << 24);
            *(unsigned*)(wl + 16 + k) = (top[1][k] & 127u) | ((top[1][k + 1] & 127u) << 8) | ((top[1][k + 2] & 127u) << 16) | ((top[1][k + 3] & 127u) << 24);
        }
        float fa[16], fb[16];
#pragma unroll
        for (int k = 0; k < 16; ++k) { fa[k] = skey2f(top[0][k] & ~127u); fb[k] = skey2f(top[1][k] & ~127u); }
        unsigned cg[4][16];
        cg[0][0] = (f2skey(fa[0] + fb[0]) & ~255u) | 0u;
        cg[0][1] = (f2skey(fa[0] + fb[1]) & ~255u) | 1u;
        cg[0][2] = (f2skey(fa[0] + fb[2]) & ~255u) | 2u;
        cg[0][3] = (f2skey(fa[0] + fb[3]) & ~255u) | 3u;
        cg[0][4] = (f2skey(fa[0] + fb[4]) & ~255u) | 4u;
        cg[0][5] = (f2skey(fa[0] + fb[5]) & ~255u) | 5u;
        cg[0][6] = (f2skey(fa[0] + fb[6]) & ~255u) | 6u;
        cg[0][7] = (f2skey(fa[0] + fb[7]) & ~255u) | 7u;
        cg[0][8] = (f2skey(fa[0] + fb[8]) & ~255u) | 8u;
        cg[0][9] = (f2skey(fa[0] + fb[9]) & ~255u) | 9u;
        cg[0][10] = (f2skey(fa[0] + fb[10]) & ~255u) | 10u;
        cg[0][11] = (f2skey(fa[0] + fb[11]) & ~255u) | 11u;
        cg[0][12] = (f2skey(fa[0] + fb[12]) & ~255u) | 12u;
        cg[0][13] = (f2skey(fa[0] + fb[13]) & ~255u) | 13u;
        cg[0][14] = (f2skey(fa[0] + fb[14]) & ~255u) | 14u;
        cg[0][15] = (f2skey(fa[0] + fb[15]) & ~255u) | 15u;
        cg[1][0] = (f2skey(fa[1] + fb[0]) & ~255u) | 16u;
        cg[1][1] = (f2skey(fa[1] + fb[1]) & ~255u) | 17u;
        cg[1][2] = (f2skey(fa[1] + fb[2]) & ~255u) | 18u;
        cg[1][3] = (f2skey(fa[1] + fb[3]) & ~255u) | 19u;
        cg[1][4] = (f2skey(fa[1] + fb[4]) & ~255u) | 20u;
        cg[1][5] = (f2skey(fa[1] + fb[5]) & ~255u) | 21u;
        cg[1][6] = (f2skey(fa[1] + fb[6]) & ~255u) | 22u;
        cg[1][7] = (f2skey(fa[1] + fb[7]) & ~255u) | 23u;
        cg[1][8] = (f2skey(fa[2] + fb[0]) & ~255u) | 32u;
        cg[1][9] = (f2skey(fa[2] + fb[1]) & ~255u) | 33u;
        cg[1][10] = (f2skey(fa[2] + fb[2]) & ~255u) | 34u;
        cg[1][11] = (f2skey(fa[2] + fb[3]) & ~255u) | 35u;
        cg[1][12] = (f2skey(fa[2] + fb[4]) & ~255u) | 36u;
        cg[1][13] = (f2skey(fa[3] + fb[0]) & ~255u) | 48u;
        cg[1][14] = (f2skey(fa[3] + fb[1]) & ~255u) | 49u;
        cg[1][15] = (f2skey(fa[3] + fb[2]) & ~255u) | 50u;
        cg[2][0] = (f2skey(fa[3] + fb[3]) & ~255u) | 51u;
        cg[2][1] = (f2skey(fa[4] + fb[0]) & ~255u) | 64u;
        cg[2][2] = (f2skey(fa[4] + fb[1]) & ~255u) | 65u;
        cg[2][3] = (f2skey(fa[4] + fb[2]) & ~255u) | 66u;
        cg[2][4] = (f2skey(fa[5] + fb[0]) & ~255u) | 80u;
        cg[2][5] = (f2skey(fa[5] + fb[1]) & ~255u) | 81u;
        cg[2][6] = (f2skey(fa[6] + fb[0]) & ~255u) | 96u;
        cg[2][7] = (f2skey(fa[6] + fb[1]) & ~255u) | 97u;
        cg[2][8] = (f2skey(fa[7] + fb[0]) & ~255u) | 112u;
        cg[2][9] = (f2skey(fa[7] + fb[1]) & ~255u) | 113u;
        cg[2][10] = (f2skey(fa[8] + fb[0]) & ~255u) | 128u;
        cg[2][11] = (f2skey(fa[9] + fb[0]) & ~255u) | 144u;
        cg[2][12] = (f2skey(fa[10] + fb[0]) & ~255u) | 160u;
        cg[2][13] = (f2skey(fa[11] + fb[0]) & ~255u) | 176u;
        cg[2][14] = (f2skey(fa[12] + fb[0]) & ~255u) | 192u;
        cg[2][15] = (f2skey(fa[13] + fb[0]) & ~255u) | 208u;
        cg[3][0] = (f2skey(fa[14] + fb[0]) & ~255u) | 224u;
        cg[3][1] = (f2skey(fa[15] + fb[0]) & ~255u) | 240u;
        cg[3][2] = 0u;
        cg[3][3] = 0u;
        cg[3][4] = 0u;
        cg[3][5] = 0u;
        cg[3][6] = 0u;
        cg[3][7] = 0u;
        cg[3][8] = 0u;
        cg[3][9] = 0u;
        cg[3][10] = 0u;
        cg[3][11] = 0u;
        cg[3][12] = 0u;
        cg[3][13] = 0u;
        cg[3][14] = 0u;
        cg[3][15] = 0u;
        SORT16_DESC(cg[0]); SORT16_DESC(cg[1]); SORT16_DESC(cg[2]); SORT16_DESC(cg[3]);
        MERGE16_DESC(cg[0], cg[1]); MERGE16_DESC(cg[2], cg[3]); MERGE16_DESC(cg[0], cg[2]);
        unsigned ct[16];
#pragma unroll
        for (int k = 0; k < 16; ++k) ct[k] = cg[0][k];
        float sc[16]; float den = 0.f; const float s0 = skey2f(ct[0] & ~255u);
#pragma unroll
        for (int k = 0; k < 16; ++k) { sc[k] = __expf(skey2f(ct[k] & ~255u) - s0); den += sc[k]; }
        const float inv = 1.f / den;
        if (hh == 0) {
            u16 ev[16];
#pragma unroll
            for (int k = 0; k < 16; ++k) { const unsigned ij = ct[k] & 255u; const unsigned i1 = wl[ij >> 4], i2 = wl[16 + (ij & 15u)]; ev[k] = (u16)(i1 * 128u + i2); }
            const size_t o = (size_t)(t0 + r) * 128 + h * 16;
#pragma unroll
            for (int k = 0; k < 16; k += 8) {
                *(u32x4*)(EID + o + k) = (u32x4){(unsigned)ev[k] | ((unsigned)ev[k + 1] << 16), (unsigned)ev[k + 2] | ((unsigned)ev[k + 3] << 16), (unsigned)ev[k + 4] | ((unsigned)ev[k + 5] << 16), (unsigned)ev[k + 6] | ((unsigned)ev[k + 7] << 16)};
            }
#pragma unroll
            for (int k = 0; k < 16; k += 4) *(f32x4*)(GW + o + k) = (f32x4){sc[k] * inv, sc[k + 1] * inv, sc[k + 2] * inv, sc[k + 3] * inv};
        }
    }
}

typedef _Float16 f16x2 __attribute__((ext_vector_type(2)));
__device__ __forceinline__ float gelu_erf(float d) { return 0.5f * d * (1.f + erff(d * 0.70710678118654752f)); }
constexpr int PQ_WORD0 = 3584, PQ_CHUNK = 64, PQ_NCHUNK = NT / PQ_CHUNK;
constexpr size_t WS_PART = 208 * MiB;
__device__ __forceinline__ unsigned xcc_id_() { return (unsigned)__builtin_amdgcn_s_getreg((3 << 11) | 20) & 7u; }
template <int VPHASE>
__device__ __forceinline__ void ph9_sliced(const Args& a, unsigned char* lds) {
    int tid_ = threadIdx.x; asm volatile("" : "+v"(tid_)); const int lane = tid_ & 63, wave = __builtin_amdgcn_readfirstlane(tid_ >> 6);
    const int g8 = lane >> 3, c16 = lane & 7;
    const f16* H2 = (const f16*)(a.ws + WS_H); const unsigned char* TAB = a.ws + (VPHASE ? WS_VP : WS_UT);
    const u16* EID = (const u16*)(a.ws + WS_EID); const float* GW = (const float*)(a.ws + WS_GW); float* PART = (float*)(a.ws + WS_PART);
    const float* mod = (const float*)(a.ws + WS_MOD); float* out = a.out;
    unsigned* qw = (unsigned*)(a.ws + WS_CTL) + PQ_WORD0 + (VPHASE ? 8 * 64 : 0);
    volatile unsigned* cslot = (volatile unsigned*)lds;
    const bool b5 = (lane & 32) != 0, b4 = (lane & 16) != 0, b3 = (lane & 8) != 0, b2 = (lane & 4) != 0, b1 = (lane & 2) != 0, b0 = (lane & 1) != 0;
    const unsigned x0 = xcc_id_();
    int par = 0;
    for (int k = 0; k < 8; ++k) {
        const unsigned sl = (x0 + (unsigned)k) & 7u;
        unsigned cur = 0u;
        if (tid_ == 0) cur = __hip_atomic_fetch_add(qw + 64 * sl, 1u, __ATOMIC_RELAXED, __HIP_MEMORY_SCOPE_AGENT);
        for (;;) {
            if (tid_ == 0) cslot[par] = cur;
            __syncthreads();
            const unsigned c = cslot[par]; par ^= 1;
            if (c >= (unsigned)PQ_NCHUNK) break;
            if (tid_ == 0) cur = __hip_atomic_fetch_add(qw + 64 * sl, 1u, __ATOMIC_RELAXED, __HIP_MEMORY_SCOPE_AGENT);
            const int tb = (int)c * PQ_CHUNK + wave * (PQ_CHUNK / NWAVE);
            const unsigned char* tsl = TAB + 128 * sl + 16 * c16;
#pragma unroll 1
            for (int i8 = 0; i8 < PQ_CHUNK / NWAVE; ++i8) {
                const int t = tb + i8;
                const u32x4 e0 = *(const u32x4*)(EID + (size_t)t * 128 + 16 * g8), e1 = *(const u32x4*)(EID + (size_t)t * 128 + 16 * g8 + 8);
                const unsigned ew[8] = {e0.x, e0.y, e0.z, e0.w, e1.x, e1.y, e1.z, e1.w};
                u32x4 r8[16];
#pragma unroll
                for (int i = 0; i < 16; ++i) { const unsigned eid = (i & 1) ? (ew[i >> 1] >> 16) : (ew[i >> 1] & 0xFFFFu); r8[i] = *(const u32x4*)(tsl + (size_t)eid * ND); }
                if (!VPHASE) {
                    const u32x4 hq0 = *(const u32x4*)(H2 + (size_t)t * ND + 128 * sl + 16 * c16), hq1 = *(const u32x4*)(H2 + (size_t)t * ND + 128 * sl + 16 * c16 + 8);
                    const unsigned hp[8] = {hq0.x, hq0.y, hq0.z, hq0.w, hq1.x, hq1.y, hq1.z, hq1.w};
                    float p[16];
#pragma unroll
                    for (int i = 0; i < 16; ++i) { float d = 0.f;
#pragma unroll
                        for (int j = 0; j < 4; ++j) { const unsigned lo = __builtin_amdgcn_perm(r8[i][j], r8[i][j], 0x010C000Cu), hi = __builtin_amdgcn_perm(r8[i][j], r8[i][j], 0x030C020Cu);
                            d = __builtin_amdgcn_fdot2(__builtin_bit_cast(f16x2, hp[2 * j]), __builtin_bit_cast(f16x2, lo), d, false);
                            d = __builtin_amdgcn_fdot2(__builtin_bit_cast(f16x2, hp[2 * j + 1]), __builtin_bit_cast(f16x2, hi), d, false); }
                        p[i] = d; }
                    float q8[8], q4[4], r2[2];
#pragma unroll
                    for (int ii = 0; ii < 8; ++ii) { const float keep = b2 ? p[8 + ii] : p[ii], send = b2 ? p[ii] : p[8 + ii]; q8[ii] = keep + __shfl_xor(send, 4); }
#pragma unroll
                    for (int ii = 0; ii < 4; ++ii) { const float keep = b1 ? q8[4 + ii] : q8[ii], send = b1 ? q8[ii] : q8[4 + ii]; q4[ii] = keep + __shfl_xor(send, 2); }
#pragma unroll
                    for (int ii = 0; ii < 2; ++ii) { const float keep = b0 ? q4[2 + ii] : q4[ii], send = b0 ? q4[ii] : q4[2 + ii]; r2[ii] = keep + __shfl_xor(send, 1); }
                    *(f32x2*)(PART + ((size_t)sl * NT + t) * 128 + 16 * g8 + 2 * c16) = (f32x2){r2[0], r2[1]};
                } else {
                    const float* wp = GW + (size_t)t * 128 + 16 * g8;
                    const f32x4 wq0 = *(const f32x4*)wp, wq1 = *(const f32x4*)(wp + 4), wq2 = *(const f32x4*)(wp + 8), wq3 = *(const f32x4*)(wp + 12);
                    const float wv[16] = {wq0[0], wq0[1], wq0[2], wq0[3], wq1[0], wq1[1], wq1[2], wq1[3], wq2[0], wq2[1], wq2[2], wq2[3], wq3[0], wq3[1], wq3[2], wq3[3]};
                    f16x2 acc2[8];
#pragma unroll
                    for (int j = 0; j < 8; ++j) acc2[j] = (f16x2){(f16)0.f, (f16)0.f};
#pragma unroll
                    for (int i = 0; i < 16; ++i) { const f16x2 w2 = (f16x2){(f16)wv[i], (f16)wv[i]};
#pragma unroll
                        for (int j = 0; j < 4; ++j) { const unsigned lo = __builtin_amdgcn_perm(r8[i][j], r8[i][j], 0x010C000Cu), hi = __builtin_amdgcn_perm(r8[i][j], r8[i][j], 0x030C020Cu);
                            acc2[2 * j] = __builtin_elementwise_fma(w2, __builtin_bit_cast(f16x2, lo), acc2[2 * j]);
                            acc2[2 * j + 1] = __builtin_elementwise_fma(w2, __builtin_bit_cast(f16x2, hi), acc2[2 * j + 1]); } }
                    float acc[16];
#pragma unroll
                    for (int j = 0; j < 8; ++j) { acc[2 * j] = (float)acc2[j][0]; acc[2 * j + 1] = (float)acc2[j][1]; }
                    float q8[8], q4[4], r2[2];
#pragma unroll
                    for (int ii = 0; ii < 8; ++ii) { const float keep = b5 ? acc[8 + ii] : acc[ii], send = b5 ? acc[ii] : acc[8 + ii]; q8[ii] = keep + __shfl_xor(send, 32); }
#pragma unroll
                    for (int ii = 0; ii < 4; ++ii) { const float keep = b4 ? q8[4 + ii] : q8[ii], send = b4 ? q8[ii] : q8[4 + ii]; q4[ii] = keep + __shfl_xor(send, 16); }
#pragma unroll
                    for (int ii = 0; ii < 2; ++ii) { const float keep = b3 ? q4[2 + ii] : q4[ii], send = b3 ? q4[ii] : q4[2 + ii]; r2[ii] = keep + __shfl_xor(send, 8); }
                    const int ch = 128 * sl + 16 * c16 + 2 * g8;
                    float* op = out + (size_t)t * ND + ch; const float* g2 = mod + (t / NS) * 6144 + 5120 + ch;
                    const f32x2 o2 = *(const f32x2*)op, gg = *(const f32x2*)g2;
                    *(f32x2*)op = o2 + gg * ((f32x2){r2[0], r2[1]} * (1.f / PEER_VSCALE));
                }
            }
        }
    }
}
__device__ __forceinline__ void ph9b_combine(const Args& a, int bid, int nb) {
    int tid_ = threadIdx.x; asm volatile("" : "+v"(tid_));
    float* GW = (float*)(a.ws + WS_GW); const float* PART = (const float*)(a.ws + WS_PART);
    for (size_t i = (size_t)bid * NTHR + tid_; i < (size_t)NT * 128 / 4; i += (size_t)nb * NTHR) {
        f32x4 sum = ((const f32x4*)PART)[i];
#pragma unroll
        for (int sidx = 1; sidx < 8; ++sidx) sum += ((const f32x4*)(PART + (size_t)sidx * NT * 128))[i];
        const f32x4 g = ((const f32x4*)GW)[i];
        f32x4 w;
#pragma unroll
        for (int j = 0; j < 4; ++j) w[j] = g[j] * gelu_erf(sum[j] * (1.f / PEER_USCALE));
        ((f32x4*)GW)[i] = w;
    }
}

#define LAS __attribute__((address_space(3)))
#define XB_TMO      128
#define XB_XCNT(j)  (256  + 64 * (j))
#define XB_XSUB(j)  (1280 + 64 * (j))
#define XB_XGEN(j)  (2304 + 64 * (j))
#define XB_TOP      3328
#define XB_TOPGEN   3392
#define XCD_BAR_WORDS 3456
#define XB_SPIN_CAP (1u << 18)
__device__ __forceinline__ unsigned xb_ld(unsigned* p)              { return __hip_atomic_load(p, __ATOMIC_RELAXED, __HIP_MEMORY_SCOPE_AGENT); }
__device__ __forceinline__ unsigned xb_add(unsigned* p, unsigned v) { return __hip_atomic_fetch_add(p, v, __ATOMIC_RELAXED, __HIP_MEMORY_SCOPE_AGENT); }
__device__ __forceinline__ unsigned xb_xcc_id() { return (unsigned)__builtin_amdgcn_s_getreg((3 << 11) | 20) & 0xFu; }
#define XB_SPIN(cond, bar) do { unsigned _sp = 0; while (cond) { __builtin_amdgcn_s_sleep(1); \
    if ((++_sp & 255u) == 0u) { if (xb_ld(&(bar)[XB_TMO])) break; if (_sp > XB_SPIN_CAP) { atomicAdd(&(bar)[XB_TMO], 1u); break; } } } } while (0)
struct XcdBarrier { unsigned* bar; unsigned x; volatile LAS unsigned* st; };
__device__ __forceinline__ XcdBarrier xcd_barrier_post(unsigned* bar, volatile LAS unsigned* st) {
    XcdBarrier b; b.bar = bar; b.x = xb_xcc_id(); b.st = st;
    if (threadIdx.x == 0) (void)xb_add(&bar[XB_XCNT(b.x)], 1u);
    return b;
}
__device__ __forceinline__ void xcd_barrier_complete(unsigned* bar, unsigned x, unsigned& nloc, unsigned& nx) {
    const unsigned G = gridDim.x * gridDim.y * gridDim.z;
    unsigned sum, cnt, mine, sp = 0u;
    for (;;) {
        sum = 0u; cnt = 0u; mine = 0u;
#pragma unroll
        for (unsigned j = 0; j < 16; ++j) { const unsigned c = xb_ld(&bar[XB_XCNT(j)]); sum += c; cnt += (c > 0u) ? 1u : 0u; mine = (j == x) ? c : mine; }
        if (sum == G) break;
        __builtin_amdgcn_s_sleep(1);
        if ((++sp & 255u) == 0u) { if (xb_ld(&bar[XB_TMO])) break; if (sp > XB_SPIN_CAP) { atomicAdd(&bar[XB_TMO], 1u); break; } }
    }
    nloc = mine > 0u ? mine : 1u; nx = cnt > 0u ? cnt : 1u;
}
__device__ __forceinline__ void xcd_barrier(const XcdBarrier& b) {
    asm volatile("s_waitcnt vmcnt(0)" ::: "memory");
    __syncthreads();
    if (threadIdx.x == 0) {
        unsigned* bar = b.bar;
        __builtin_amdgcn_s_waitcnt(0);
        unsigned nloc = b.st[0], nx = b.st[1];
        if (nloc == 0u) { xcd_barrier_complete(bar, b.x, nloc, nx); b.st[0] = nloc; b.st[1] = nx; }
        const unsigned old = xb_add(&bar[XB_XSUB(b.x)], 1u);
        const unsigned gen = old / nloc;
        if (old + 1u == (gen + 1u) * nloc) {
            __builtin_amdgcn_fence(__ATOMIC_RELEASE, "agent");
            asm volatile("s_waitcnt vmcnt(0)" ::: "memory");
            const unsigned og = xb_add(&bar[XB_TOP], 1u);
            const unsigned tg = og / nx;
            if (og + 1u == (tg + 1u) * nx) xb_add(&bar[XB_TOPGEN], 1u);
            else XB_SPIN(xb_ld(&bar[XB_TOPGEN]) == tg, bar);
            __builtin_amdgcn_fence(__ATOMIC_ACQUIRE, "agent");
            xb_add(&bar[XB_XGEN(b.x)], 1u);
            asm volatile("s_waitcnt vmcnt(0)" ::: "memory");
        } else {
            XB_SPIN(xb_ld(&bar[XB_XGEN(b.x)]) == gen, bar);
            __builtin_amdgcn_fence(__ATOMIC_ACQUIRE, "agent");
            asm volatile("s_waitcnt vmcnt(0)" ::: "memory");
        }
    }
    __syncthreads();
}

constexpr int N_PHASES = 12;
__global__ void __launch_bounds__(NTHR, 2) mk_fwd(Args a) {
    extern __shared__ __attribute__((aligned(16))) unsigned char lds[];
    cg::grid_group grid = cg::this_grid();
    const int bid = blockIdx.x, nb = gridDim.x;
    const int lo = a.ph_lo, hi = a.ph_hi;
    volatile LAS unsigned* bst = (volatile LAS unsigned*)((LAS unsigned char*)lds + (LDS_BYTES - 16));
    if (threadIdx.x < 4) bst[threadIdx.x] = 0u;
    __syncthreads();
    XcdBarrier xbar = xcd_barrier_post((unsigned*)(a.ws + WS_CTL), bst);
#define SEAM(k) do { if ((k) == 0) grid.sync(); else xcd_barrier(xbar); } while (0)
#define PHASE(k, body) if (lo <= (k) && (k) < hi) { body; if ((k) + 1 < hi) SEAM(k); }
    PHASE(0, ph0_prologue(a, bid, nb, lds))
    PHASE(1, row_norm_mod(a.in[0], a.in[4], (const float*)(a.ws + WS_MOD), 0, 1024, (f16*)(a.ws + WS_H), bid, nb))
    PHASE(2, ph2_inproj(a, bid, nb, lds))
    PHASE(3, ph3_pool_fast(a, bid, nb, lds); ph3_index_fast<0>(a, bid, nb, lds))
    PHASE(4, ph4_attn_fast<0>(a, bid, nb, lds))
    PHASE(5, ph5_outproj(a, bid, nb, lds))
    PHASE(6, row_norm_mod(a.out, a.in[13], (const float*)(a.ws + WS_MOD), 3072, 4096, (f16*)(a.ws + WS_H), bid, nb))
    PHASE(7, ph7_peerq(a, bid, nb, lds))
    PHASE(8, ph8_peersel_fast(a, bid, nb, lds))
    PHASE(9, ph9_sliced<0>(a, lds))
    PHASE(10, ph9b_combine(a, bid, nb))
    PHASE(11, ph9_sliced<1>(a, lds))
#undef PHASE
}

extern "C" void kernel_launch(void* const* d_in, const int* in_sizes, int n_in, void* d_out, int out_size, void* d_ws, size_t ws_size, hipStream_t stream) {
    static int grid = 0;
    if (grid == 0) {
        if (n_in != 18 || out_size != NT * ND || ws_size < WS_END) { fprintf(stderr, "kernel_launch: unexpected shapes (n_in %d out %d ws %zu)\n", n_in, out_size, ws_size); grid = -1; return; }
        int dev = 0, cus = 0, per_cu = 0;
        hipGetDevice(&dev); hipDeviceGetAttribute(&cus, hipDeviceAttributeMultiprocessorCount, dev);
        hipFuncSetAttribute((const void*)mk_fwd, hipFuncAttributeMaxDynamicSharedMemorySize, LDS_BYTES);
        hipOccupancyMaxActiveBlocksPerMultiprocessor(&per_cu, (const void*)mk_fwd, NTHR, LDS_BYTES);
        if (per_cu < 1) { fprintf(stderr, "kernel_launch: occupancy query says %d blocks/CU\n", per_cu); per_cu = 1; }
        grid = cus * 1;
        (void)hipGetLastError();
    }
    if (grid < 0) return;
    if (hipMemsetAsync((char*)d_ws + WS_CTL, 0, 32768, stream) != hipSuccess) { fprintf(stderr, "kernel_launch: memset of the barrier words failed\n"); return; }
    Args a{};
    for (int i = 0; i < 18; ++i) a.in[i] = (const float*)d_in[i];
    a.out = (float*)d_out; a.ws = (unsigned char*)d_ws;
#if MK_MULTI
    for (int ph = 0; ph < N_PHASES; ++ph) { a.ph_lo = ph; a.ph_hi = ph + 1; hipLaunchKernelGGL(mk_fwd, dim3(grid), dim3(NTHR), LDS_BYTES, stream, a); }
#else
    a.ph_lo = 0; a.ph_hi = N_PHASES;
    void* args[] = {&a};
    hipError_t e = hipLaunchCooperativeKernel((const void*)mk_fwd, dim3(grid), dim3(NTHR), args, LDS_BYTES, stream);
    if (e != hipSuccess) fprintf(stderr, "cooperative launch failed: %s (grid %d)\n", hipGetErrorString(e), grid);
#endif
}
```

```cpp
#include <hip/hip_runtime.h>
#include <hip/hip_cooperative_groups.h>
#include <cstdio>
#include <cstdint>
namespace cg = cooperative_groups;

#ifndef MK_MULTI
#define MK_MULTI 0
#endif

typedef _Float16 f16;
typedef _Float16 f16x8 __attribute__((ext_vector_type(8)));
typedef _Float16 f16x4 __attribute__((ext_vector_type(4)));
typedef float f32x4 __attribute__((ext_vector_type(4)));
typedef float f32x16 __attribute__((ext_vector_type(16)));
typedef unsigned long long u64;
typedef unsigned short u16;

constexpr int NB = 8, NS = 8192, ND = 1024, NT = NB * NS;
constexpr int INW = 2632;
constexpr int NMAIN = 2304;
constexpr float EPS = 1e-6f;
constexpr int NTHR = 512, NWAVE = 8;

constexpr size_t MiB = 1u << 20;
constexpr size_t WS_CTL = 0;
constexpr size_t WS_MOD = 1 * MiB;
constexpr size_t WS_WIN = 2 * MiB;
constexpr size_t WS_WVT = 7 * MiB;
constexpr size_t WS_WOUT = 8 * MiB;
constexpr size_t WS_WQ = 10 * MiB;
constexpr size_t WS_SK = 14 * MiB;
constexpr size_t WS_PW = 14 * MiB + 512 * 1024;
constexpr size_t WS_UT = 16 * MiB;
constexpr size_t WS_VP = 48 * MiB;
constexpr size_t WS_H = 80 * MiB;
constexpr size_t WS_U = 208 * MiB;
constexpr size_t WS_Q = 272 * MiB;
constexpr size_t WS_K = 336 * MiB;
constexpr size_t WS_VT = 400 * MiB;
constexpr size_t WS_PQ = 208 * MiB;
constexpr size_t WS_QI = 464 * MiB;
constexpr size_t WS_KI = 528 * MiB;
constexpr size_t WS_WI = 536 * MiB;
constexpr size_t WS_MASK = 544 * MiB;
constexpr size_t WS_EID = 608 * MiB;
constexpr size_t WS_GW = 624 * MiB;
constexpr size_t WS_END = 656 * MiB;

constexpr int LDS_BYTES = 155648;
constexpr float PEER_USCALE = 256.f, PEER_VSCALE = 16.f;

struct Args { const float* in[18]; float* out; unsigned char* ws; int ph_lo, ph_hi; };

__host__ __device__ __forceinline__ int pos2log(int p) { return 64 * ((p >> 5) & 3) + 32 * (p >> 7) + 8 * ((p >> 2) & 3) + 4 * ((p >> 4) & 1) + (p & 3); }
__device__ __forceinline__ int maincol(int L) { if (L < 1536) return L; if (L < 2120) return L + 512; return -1; }

__device__ __forceinline__ float wave_sum(float v) {
#pragma unroll
    for (int o = 1; o < 64; o <<= 1) v += __shfl_xor(v, o);
    return v;
}
__device__ __forceinline__ float wave_max(float v) {
#pragma unroll
    for (int o = 1; o < 64; o <<= 1) v = fmaxf(v, __shfl_xor(v, o));
    return v;
}

__device__ void ph0_prologue(const Args& a, int bid, int nb, unsigned char* lds) {
    int tid = threadIdx.x; asm volatile("" : "+v"(tid));
    const float* c = a.in[1]; const float* ada_w = a.in[2]; const float* ada_b = a.in[3];
    float* sil = (float*)lds;
    for (int i = tid; i < NB * ND; i += NTHR) { const float v = c[i]; sil[i] = v / (1.f + __expf(-v)); }
    __syncthreads();
    float* mod = (float*)(a.ws + WS_MOD);
    const int gt = bid * NTHR + tid, ngt = nb * NTHR;
    for (int o = gt; o < NB * 6144; o += ngt) {
        const int b = o / 6144, j = o % 6144;
        float acc = ada_b[j];
        const float* sb = sil + b * ND;
        for (int k = 0; k < ND; ++k) acc += sb[k] * ada_w[(size_t)k * 6144 + j];
        mod[o] = acc;
    }
    const float* w_in = a.in[5]; const float* pool_w = a.in[6]; const float* w_out = a.in[12];
    const float* wq = a.in[14]; const float* sk = a.in[15]; const float* pu = a.in[16]; const float* pv = a.in[17];
    f16* WIN = (f16*)(a.ws + WS_WIN); f16* WVT = (f16*)(a.ws + WS_WVT); f16* WOUT = (f16*)(a.ws + WS_WOUT); f16* WQ = (f16*)(a.ws + WS_WQ);
 unsigned char* UT = a.ws + WS_UT; unsigned char* VP = a.ws + WS_VP;
    {
        __syncthreads();
        const int lane = tid & 63, wv_ = tid >> 6;
        float* scr = (float*)lds + wv_ * (64 * 33);
        constexpr int I_WQ = 16 * 64, I_Z = 16 * 16, I_INR = 16 * (NMAIN / 32 - 16), I_VT = 16 * 16, I_OUT = 16 * 32, I_ALL = I_WQ + I_Z + I_INR + I_VT + I_OUT;
        for (int it = bid * NWAVE + wv_; it < I_ALL; it += nb * NWAVE) {
            int rr = it, kind = 3, pboff = 0;
            if (rr >= I_WQ) { rr -= I_WQ; kind = 0;
                if (rr >= I_Z) { rr -= I_Z; pboff = 16;
                    if (rr >= I_INR) { rr -= I_INR; kind = 1; pboff = 0; if (rr >= I_VT) { rr -= I_VT; kind = 2; } } } }
            const int npb = kind == 0 ? (pboff ? NMAIN / 32 - 16 : 16) : kind == 1 ? 16 : kind == 2 ? 32 : 64;
            const int k0 = (rr / npb) * 64, p0 = (rr % npb + pboff) * 32, p = p0 + (lane & 31);
            const float* W = kind <= 1 ? w_in : kind == 2 ? w_out : wq; const int ldw = kind <= 1 ? INW : kind == 2 ? 1024 : 2048;
            int col;
            if (kind == 0) col = maincol((p & ~255) + pos2log(p & 255)); else if (kind == 1) col = 1536 + p; else col = (p & ~255) + pos2log(p & 255);
            const bool foldz = (kind == 0 && pboff == 0);
            if (foldz || kind == 3) {
                const int r5 = lane & 31, hh_ = lane >> 5;
                const int blk = __builtin_amdgcn_readfirstlane(col >> 7);
                const int sub = col & 127;
                const float* arow = W + (size_t)(k0 + r5) * ldw + blk * 128 + 8 * hh_;
                f32x16 acc0 = (f32x16){0.f, 0.f, 0.f, 0.f, 0.f, 0.f, 0.f, 0.f, 0.f, 0.f, 0.f, 0.f, 0.f, 0.f, 0.f, 0.f}, acc1 = acc0;
#pragma unroll 2
                for (int ks = 0; ks < 8; ++ks) {
                    const f32x4 a00 = *(const f32x4*)(arow + 16 * ks), a01 = *(const f32x4*)(arow + 16 * ks + 4);
                    const f32x4 a10 = *(const f32x4*)(arow + (size_t)32 * ldw + 16 * ks), a11 = *(const f32x4*)(arow + (size_t)32 * ldw + 16 * ks + 4);
                    f16x8 bfr;
                    if (kind == 3) { const float* br = sk + (size_t)(blk * 128 + sub) * 128 + 16 * ks + 8 * hh_; const f32x4 b0 = *(const f32x4*)br, b1 = *(const f32x4*)(br + 4);
                        bfr = (f16x8){(f16)b0[0], (f16)b0[1], (f16)b0[2], (f16)b0[3], (f16)b1[0], (f16)b1[1], (f16)b1[2], (f16)b1[3]}; }
                    else { const float* br = pool_w + (size_t)blk * 16384 + (size_t)(16 * ks + 8 * hh_) * 128 + sub;
                        bfr = (f16x8){(f16)br[0], (f16)br[128], (f16)br[256], (f16)br[384], (f16)br[512], (f16)br[640], (f16)br[768], (f16)br[896]}; }
                    const f16x8 af0 = (f16x8){(f16)a00[0], (f16)a00[1], (f16)a00[2], (f16)a00[3], (f16)a01[0], (f16)a01[1], (f16)a01[2], (f16)a01[3]};
                    const f16x8 af1 = (f16x8){(f16)a10[0], (f16)a10[1], (f16)a10[2], (f16)a10[3], (f16)a11[0], (f16)a11[1], (f16)a11[2], (f16)a11[3]};
                    acc0 = __builtin_amdgcn_mfma_f32_32x32x16_f16(af0, bfr, acc0, 0, 0, 0);
                    acc1 = __builtin_amdgcn_mfma_f32_32x32x16_f16(af1, bfr, acc1, 0, 0, 0);
                }
#pragma unroll
                for (int rg = 0; rg < 16; ++rg) { const int kk = (rg & 3) + 8 * (rg >> 2) + 4 * hh_; scr[kk * 33 + r5] = acc0[rg]; scr[(32 + kk) * 33 + r5] = acc1[rg]; }
            } else {
#pragma unroll 8
                for (int i = 0; i < 32; ++i) { const int kk = 2 * i + (lane >> 5); scr[kk * 33 + (lane & 31)] = col >= 0 ? W[(size_t)(k0 + kk) * ldw + col] : 0.f; }
            }
            f16* WT = kind == 0 ? WIN : kind == 1 ? WVT : kind == 2 ? WOUT : WQ;
            const int c8 = lane & 7;
#pragma unroll
            for (int j = 0; j < 4; ++j) { const int n = (lane >> 3) + 8 * j; const float* sp = scr + (8 * c8) * 33 + n;
                *(f16x8*)(WT + (size_t)(p0 + n) * ND + k0 + 8 * c8) = (f16x8){(f16)sp[0], (f16)sp[33], (f16)sp[66], (f16)sp[99], (f16)sp[132], (f16)sp[165], (f16)sp[198], (f16)sp[231]}; }
        }
    }
    for (int i = gt; i < 16384 * 1024 / 4; i += ngt) { const f32x4 u = ((const f32x4*)pu)[i] * PEER_USCALE, v = ((const f32x4*)pv)[i] * PEER_VSCALE;
        int pu8 = __builtin_amdgcn_cvt_pk_bf8_f32(u.x, u.y, 0, false); pu8 = __builtin_amdgcn_cvt_pk_bf8_f32(u.z, u.w, pu8, true);
        int pv8 = __builtin_amdgcn_cvt_pk_bf8_f32(v.x, v.y, 0, false); pv8 = __builtin_amdgcn_cvt_pk_bf8_f32(v.z, v.w, pv8, true);
        ((int*)UT)[i] = pu8; ((int*)VP)[i] = pv8; }
}

__device__ void row_norm_mod(const float* src, const float* g, const float* mod, int sh_off, int sc_off, f16* dst, int bid, int nb) {
    int tid_ = threadIdx.x; asm volatile("" : "+v"(tid_)); const int lane = tid_ & 63, wave = tid_ >> 6;
    for (int row = bid * NWAVE + wave; row < NT; row += nb * NWAVE) {
        const int b = row / NS;
        const f32x4* xr = (const f32x4*)(src + (size_t)row * ND) + lane;
        f32x4 v[4]; float s = 0.f;
#pragma unroll
        for (int j = 0; j < 4; ++j) { v[j] = xr[64 * j]; s += v[j].x * v[j].x + v[j].y * v[j].y + v[j].z * v[j].z + v[j].w * v[j].w; }
        const float rstd = rsqrtf(wave_sum(s) * (1.f / ND) + EPS);
#pragma unroll
        for (int j = 0; j < 4; ++j) {
            const int col = lane * 4 + 256 * j;
            const f32x4 gg = *(const f32x4*)(g + col), sc = *(const f32x4*)(mod + b * 6144 + sc_off + col), sh = *(const f32x4*)(mod + b * 6144 + sh_off + col);
            f16x4 o;
            o.x = (f16)(v[j].x * rstd * gg.x * (1.f + sc.x) + sh.x); o.y = (f16)(v[j].y * rstd * gg.y * (1.f + sc.y) + sh.y);
            o.z = (f16)(v[j].z * rstd * gg.z * (1.f + sc.z) + sh.z); o.w = (f16)(v[j].w * rstd * gg.w * (1.f + sc.w) + sh.w);
            *(f16x4*)(dst + (size_t)row * ND + col) = o;
        }
    }
}


namespace pg8 {
#define PG8_LAS __attribute__((address_space(3)))
constexpr int BM = 256, BK = 64, HALF = 128, HTB = HALF * BK * 2, STAGE_BYTES = 8 * HTB, NXCD = 8, WGM = 8;
__host__ __device__ __forceinline__ int lds_byte(int r, int c) { const int st = (r >> 4) * 2 + (c >> 5), rr = r & 15, cc = c & 31, ob = rr * 64 + cc * 2; return st * 1024 + (ob ^ (((ob >> 9) & 1) << 5)); }
__host__ __device__ __forceinline__ void stage_rc(int b, int& R, int& C) { const int st = b / 1024, sb = b % 1024, swz = sb ^ (((sb >> 9) & 1) << 5); R = (st >> 1) * 16 + swz / 64; C = (st & 1) * 32 + (swz % 64) / 2; }
struct Unit { int pm, pn; };
struct Gemm { const f16* A; const f16* Bt; int M, N, K; };
struct StaticOrder {
    int nM, nN, nwg, G, c;
    __host__ __device__ void init(int M, int N, int G_, int c_) { nM = M / BM; nN = N / BM; nwg = nM * nN; G = G_; c = c_; }
    __host__ __device__ bool next(int i, Unit& u) const {
        const long L = (long)i * G + c; if (L >= nwg) return false;
        int wgid = (int)L; { const int q = nwg / NXCD, r = nwg % NXCD, xcd = wgid % NXCD, off = wgid / NXCD; wgid = (xcd < r ? xcd * (q + 1) : r * (q + 1) + (xcd - r) * q) + off; }
        const int nig = WGM * nN, gid = wgid / nig, fm = gid * WGM, gsz = (nM - fm) < WGM ? (nM - fm) : WGM;
        u.pm = fm + ((wgid % nig) % gsz); u.pn = (wgid % nig) / gsz; return true;
    }
};
template <class Epi>
__device__ __forceinline__ void gemm_phase(PG8_LAS unsigned char* lds, const Gemm g, const StaticOrder& S, const Epi& E) {
    int tid = threadIdx.x; asm volatile("" : "+v"(tid));
    const int wid = __builtin_amdgcn_readfirstlane(tid >> 6), lane = tid & 63, wr = wid >> 2, wc = wid & 3, fr = lane & 15, fq = lane >> 4;
    const int K = g.K, nt = K / BK;
    unsigned voffA[2];
#pragma unroll
    for (int i = 0; i < 2; ++i) { int R, C; stage_rc(tid * 16 + i * 8192, R, C); voffA[i] = (unsigned)(R * K + C) * 2u; }
    const size_t kstep = (size_t)(BK * 2);
    const size_t hstep = (size_t)HALF * K * 2;
    const size_t tstep = 2 * hstep;
    const unsigned ldsw = (unsigned)wid * 1024u;
    const int aoff = lds_byte(wr * 64 + fr, fq * 8), boff = lds_byte(wc * 32 + fr, fq * 8);
#define PG8_SA(b, h) (((b) * 2 + (h)) * HTB)
#define PG8_SB(b, h) ((4 + (b) * 2 + (h)) * HTB)
#define PG8_STAGE(bufoff, gbase, voff) do { _Pragma("unroll") for (int _i = 0; _i < 2; ++_i) \
        __builtin_amdgcn_global_load_lds((const unsigned*)((const char*)(gbase) + (voff)[_i]), (PG8_LAS unsigned*)(lds + (bufoff) + ldsw + _i * 8192), 16, 0, 0); } while (0)
#define PG8_LDA(dst, b, h) do { _Pragma("unroll") for (int m = 0; m < 4; ++m) _Pragma("unroll") for (int k = 0; k < 2; ++k) dst[m][k] = *(const PG8_LAS f16x8*)(lds + PG8_SA(b, h) + aoff + m * 2048 + k * 1024); } while (0)
#define PG8_LDB(dst, b, h) do { _Pragma("unroll") for (int n = 0; n < 2; ++n) _Pragma("unroll") for (int k = 0; k < 2; ++k) dst[n][k] = *(const PG8_LAS f16x8*)(lds + PG8_SB(b, h) + boff + n * 2048 + k * 1024); } while (0)
#define PG8_MMA(ai, bj, At, Bt) do { __builtin_amdgcn_s_setprio(1); _Pragma("unroll") for (int m = 0; m < 4; ++m) _Pragma("unroll") for (int n = 0; n < 2; ++n) _Pragma("unroll") for (int k = 0; k < 2; ++k) \
        acc[ai][bj][m][n] = __builtin_amdgcn_mfma_f32_16x16x32_f16(Bt[n][k], At[m][k], acc[ai][bj][m][n], 0, 0, 0); __builtin_amdgcn_s_setprio(0); } while (0)
#define PG8_WAIT_V(n) asm volatile("s_waitcnt vmcnt(" #n ")" ::: "memory")
#define PG8_WAIT_L(n) asm volatile("s_waitcnt lgkmcnt(" #n ")" ::: "memory")
#define PG8_BAR __builtin_amdgcn_s_barrier()
#define PG8_SCHED __builtin_amdgcn_sched_barrier(0)
    Unit cur, nxt; int ui = 0;
    if (!S.next(0, cur)) return;
    f32x4 acc[2][2][4][2];
#pragma unroll
    for (int a = 0; a < 2; ++a)
#pragma unroll
        for (int b = 0; b < 2; ++b)
#pragma unroll
            for (int m = 0; m < 4; ++m)
#pragma unroll
                for (int n = 0; n < 2; ++n) acc[a][b][m][n] = (f32x4){0.f, 0.f, 0.f, 0.f};
    f16x8 At[4][2], B0[2][2], B1[2][2];
    const char* cA = (const char*)g.A + (size_t)cur.pm * tstep; const char* cB = (const char*)g.Bt + (size_t)cur.pn * tstep;
    PG8_STAGE(PG8_SB(0, 0), cB, voffA); PG8_STAGE(PG8_SB(0, 1), cB + hstep, voffA); PG8_STAGE(PG8_SA(0, 0), cA, voffA); PG8_STAGE(PG8_SA(0, 1), cA + hstep, voffA);
    if (wr == 1) PG8_BAR;
    PG8_WAIT_V(2); PG8_BAR;
    PG8_STAGE(PG8_SB(1, 0), cB + kstep, voffA); PG8_STAGE(PG8_SA(1, 0), cA + kstep, voffA); PG8_STAGE(PG8_SB(1, 1), cB + hstep + kstep, voffA);
    PG8_WAIT_V(6); PG8_BAR;
    for (;;) {
        const bool has_next = S.next(ui + 1, nxt);
        const char* nA = has_next ? (const char*)g.A + (size_t)nxt.pm * tstep : cA; const char* nB = has_next ? (const char*)g.Bt + (size_t)nxt.pn * tstep : cB;
        for (int t = 0; t < nt; t += 2) {
            const bool last = (t == nt - 2);
            const char* a1 = cA + (size_t)(t + 1) * kstep;
            const char* a2 = last ? nA : cA + (size_t)(t + 2) * kstep; const char* b2 = last ? nB : cB + (size_t)(t + 2) * kstep;
            const char* a3 = a2 + kstep; const char* b3 = b2 + kstep;
            PG8_LDB(B0, 0, 0); PG8_LDB(B1, 0, 1); PG8_SCHED; PG8_LDA(At, 0, 0); PG8_STAGE(PG8_SA(1, 1), a1 + hstep, voffA);
            PG8_WAIT_V(8); PG8_WAIT_L(0); PG8_BAR; PG8_MMA(0, 0, At, B0); PG8_MMA(0, 1, At, B1); PG8_BAR; PG8_SCHED;
            PG8_LDA(At, 0, 1); PG8_STAGE(PG8_SB(0, 0), b2, voffA); PG8_STAGE(PG8_SB(0, 1), b2 + hstep, voffA); PG8_STAGE(PG8_SA(0, 0), a2, voffA);
            PG8_WAIT_V(8); PG8_WAIT_L(0); PG8_BAR; PG8_MMA(1, 0, At, B0); PG8_MMA(1, 1, At, B1); PG8_BAR; PG8_SCHED;
            PG8_LDB(B0, 1, 0); PG8_LDB(B1, 1, 1); PG8_SCHED; PG8_LDA(At, 1, 0); PG8_STAGE(PG8_SA(0, 1), a2 + hstep, voffA);
            PG8_WAIT_V(8); PG8_WAIT_L(0); PG8_BAR; PG8_MMA(0, 0, At, B0); PG8_MMA(0, 1, At, B1); PG8_BAR; PG8_SCHED;
            PG8_LDA(At, 1, 1); PG8_STAGE(PG8_SB(1, 0), b3, voffA); PG8_STAGE(PG8_SB(1, 1), b3 + hstep, voffA); PG8_STAGE(PG8_SA(1, 0), a3, voffA);
            PG8_WAIT_V(8); PG8_WAIT_L(0); PG8_BAR; PG8_MMA(1, 0, At, B0); PG8_MMA(1, 1, At, B1); PG8_BAR; PG8_SCHED;
        }
        if (wr == 0) PG8_BAR;
        E(acc, cur, wr, wc, fr, fq);
        if (!has_next) break;
#pragma unroll
        for (int a = 0; a < 2; ++a)
#pragma unroll
            for (int b = 0; b < 2; ++b)
#pragma unroll
                for (int m = 0; m < 4; ++m)
#pragma unroll
                    for (int n = 0; n < 2; ++n) acc[a][b][m][n] = (f32x4){0.f, 0.f, 0.f, 0.f};
        cur = nxt; cA = nA; cB = nB; ++ui;
        if (wr == 1) PG8_BAR;
    }
    PG8_WAIT_V(0);
    PG8_BAR;
#undef PG8_SA
#undef PG8_SB
#undef PG8_STAGE
#undef PG8_LDA
#undef PG8_LDB
#undef PG8_MMA
#undef PG8_WAIT_V
#undef PG8_WAIT_L
#undef PG8_BAR
#undef PG8_SCHED
}

typedef f32x4 Acc[2][2][4][2];
struct EpiMain {
    unsigned char* ws; const float *qg, *kg;
    __device__ __forceinline__ void operator()(const Acc& acc, const Unit& u, int wr, int wc, int fr, int fq) const {
        const int row0 = u.pm * BM + wr * 64 + fr, pn = u.pn;
        if (pn == 8) {
            if (wc == 0) {
#pragma unroll
                for (int ai = 0; ai < 2; ++ai)
#pragma unroll
                    for (int m = 0; m < 4; ++m) { const size_t row = row0 + ai * HALF + m * 16;
#pragma unroll
                        for (int bj = 0; bj < 2; ++bj) { const f32x4 v0 = acc[ai][bj][m][0], v1 = acc[ai][bj][m][1];
                            *(f16x8*)((f16*)(ws + WS_KI) + (((row >> 5) * 8 + 4 * bj + fq) * 32 + (row & 31)) * 8) = (f16x8){(f16)v0[0], (f16)v0[1], (f16)v0[2], (f16)v0[3], (f16)v1[0], (f16)v1[1], (f16)v1[2], (f16)v1[3]}; } }
            } else if (wc == 1 && fq == 0) {
#pragma unroll
                for (int ai = 0; ai < 2; ++ai)
#pragma unroll
                    for (int m = 0; m < 4; ++m) { const size_t row = row0 + ai * HALF + m * 16;
                        *(f32x4*)((float*)(ws + WS_WI) + row * 8) = acc[ai][0][m][0] * 0.35355339059327373f; *(f32x4*)((float*)(ws + WS_WI) + row * 8 + 4) = acc[ai][0][m][1] * 0.35355339059327373f; }
            }
            return;
        }
        const int kind = pn >> 1;
        f16* base = (f16*)(ws + (kind == 0 ? WS_U : kind == 1 ? WS_Q : kind == 2 ? WS_K : WS_QI));
        const int col0 = (pn & 1) * 256 + 64 * wc + 8 * fq;
        if (kind == 1 || kind == 2) {
            const float* gp = (kind == 1 ? qg : kg) + 8 * fq;
#pragma unroll
            for (int ai = 0; ai < 2; ++ai)
#pragma unroll
                for (int m = 0; m < 4; ++m) { const size_t row = row0 + ai * HALF + m * 16;
                    float ss = 0.f;
#pragma unroll
                    for (int bj = 0; bj < 2; ++bj)
#pragma unroll
                        for (int n = 0; n < 2; ++n) { const f32x4 v = acc[ai][bj][m][n]; ss += v[0] * v[0] + v[1] * v[1] + v[2] * v[2] + v[3] * v[3]; }
                    ss += __shfl_xor(ss, 16); ss += __shfl_xor(ss, 32);
                    const float rstd = rsqrtf(ss * (1.f / 64.f) + EPS);
#pragma unroll
                    for (int bj = 0; bj < 2; ++bj) { const f32x4 v0 = acc[ai][bj][m][0] * rstd * *(const f32x4*)(gp + 32 * bj), v1 = acc[ai][bj][m][1] * rstd * *(const f32x4*)(gp + 32 * bj + 4);
                        *(f16x8*)(base + row * 512 + col0 + 32 * bj) = (f16x8){(f16)v0[0], (f16)v0[1], (f16)v0[2], (f16)v0[3], (f16)v1[0], (f16)v1[1], (f16)v1[2], (f16)v1[3]}; }
                    asm volatile("" ::: "memory"); }
        } else if (kind == 3) {
            const int hd = (pn & 1) * 4 + wc;
#pragma unroll
            for (int ai = 0; ai < 2; ++ai)
#pragma unroll
                for (int m = 0; m < 4; ++m) { const size_t row = row0 + ai * HALF + m * 16; const int ql = (int)(row & 7);
                    const int rr = (hd & 3) | (((ql >> 1) & 1) << 2) | ((hd >> 2) << 3) | ((ql & 1) << 4);
#pragma unroll
                    for (int bj = 0; bj < 2; ++bj) { const f32x4 v0 = acc[ai][bj][m][0], v1 = acc[ai][bj][m][1]; const int chunk = fq + 4 * bj;
                        *(f16x8*)(base + ((((((row >> 3) * 2 + (ql >> 2)) * 4 + (chunk >> 1)) * 2 + (chunk & 1)) * 32 + rr) << 3)) = (f16x8){(f16)v0[0], (f16)v0[1], (f16)v0[2], (f16)v0[3], (f16)v1[0], (f16)v1[1], (f16)v1[2], (f16)v1[3]}; } }
        } else {
#pragma unroll
            for (int ai = 0; ai < 2; ++ai)
#pragma unroll
                for (int m = 0; m < 4; ++m) { const size_t row = row0 + ai * HALF + m * 16;
#pragma unroll
                    for (int bj = 0; bj < 2; ++bj) { const f32x4 v0 = acc[ai][bj][m][0], v1 = acc[ai][bj][m][1];
                        *(f16x8*)(base + row * 512 + col0 + 32 * bj) = (f16x8){(f16)v0[0], (f16)v0[1], (f16)v0[2], (f16)v0[3], (f16)v1[0], (f16)v1[1], (f16)v1[2], (f16)v1[3]}; } }
        }
    }
};
struct EpiVT {
    f16* VT;
    __device__ __forceinline__ void operator()(const Acc& acc, const Unit& u, int wr, int wc, int fr, int fq) const {
        const int row0 = u.pm * BM + wr * 64 + fr, col0 = u.pn * BM + 32 * wc + 4 * fq;
#pragma unroll
        for (int ai = 0; ai < 2; ++ai)
#pragma unroll
            for (int m = 0; m < 4; ++m) { const size_t row = row0 + ai * HALF + m * 16;
#pragma unroll
                for (int bj = 0; bj < 2; ++bj)
#pragma unroll
                    for (int n = 0; n < 2; ++n) { const f32x4 v = acc[ai][bj][m][n];
                        *(f16x4*)(VT + row * NT + col0 + 128 * bj + 16 * n) = (f16x4){(f16)v[0], (f16)v[1], (f16)v[2], (f16)v[3]}; } }
    }
};
struct EpiOut {
    const float* x; const float* mod; float* out;
    __device__ __forceinline__ void operator()(const Acc& acc, const Unit& u, int wr, int wc, int fr, int fq) const {
        const int row0 = u.pm * BM + wr * 64 + fr, col0 = u.pn * BM + 64 * wc + 8 * fq;
        const float* g1 = mod + ((u.pm * BM) / NS) * 6144 + 2048 + col0;
        f32x4 g4[2][2];
#pragma unroll
        for (int bj = 0; bj < 2; ++bj)
#pragma unroll
            for (int n = 0; n < 2; ++n) g4[bj][n] = *(const f32x4*)(g1 + 32 * bj + 4 * n);
#pragma unroll
        for (int ai = 0; ai < 2; ++ai)
#pragma unroll
            for (int m = 0; m < 4; ++m) { const size_t off = (size_t)(row0 + ai * HALF + m * 16) * ND + col0;
#pragma unroll
                for (int bj = 0; bj < 2; ++bj)
#pragma unroll
                    for (int n = 0; n < 2; ++n) { const f32x4 xv = *(const f32x4*)(x + off + 32 * bj + 4 * n);
                        *(f32x4*)(out + off + 32 * bj + 4 * n) = xv + g4[bj][n] * acc[ai][bj][m][n]; } }
    }
};
struct EpiPQ {
    f16* PQ;
    __device__ __forceinline__ void operator()(const Acc& acc, const Unit& u, int wr, int wc, int fr, int fq) const {
        const int row0 = u.pm * BM + wr * 64 + fr, col0 = u.pn * BM + 64 * wc + 8 * fq;
#pragma unroll
        for (int ai = 0; ai < 2; ++ai)
#pragma unroll
            for (int m = 0; m < 4; ++m) { const size_t row = row0 + ai * HALF + m * 16;
#pragma unroll
                for (int bj = 0; bj < 2; ++bj) { const f32x4 v0 = acc[ai][bj][m][0], v1 = acc[ai][bj][m][1];
                    *(f16x8*)(PQ + ((((row >> 5) * 256 + ((col0 + 32 * bj) >> 3)) * 32 + (row & 31)) << 3)) = (f16x8){(f16)v0[0], (f16)v0[1], (f16)v0[2], (f16)v0[3], (f16)v1[0], (f16)v1[1], (f16)v1[2], (f16)v1[3]}; } }
    }
};
}

__device__ __forceinline__ void ph2_inproj(const Args& a, int bid, int nb, unsigned char* lds) {
    const f16* H = (const f16*)(a.ws + WS_H); const f16* WIN = (const f16*)(a.ws + WS_WIN); const f16* WVT = (const f16*)(a.ws + WS_WVT);
    PG8_LAS unsigned char* l3 = (PG8_LAS unsigned char*)lds;
    { pg8::Gemm g{H, WIN, NT, NMAIN, ND}; pg8::StaticOrder S; S.init(NT, NMAIN, nb, bid);
      pg8::EpiMain E{a.ws, a.in[9], a.in[10]};
      pg8::gemm_phase(l3, g, S, E); }
    { pg8::Gemm g{WVT, H, 512, NT, ND}; pg8::StaticOrder S; S.init(512, NT, nb, bid);
      pg8::EpiVT E{(f16*)(a.ws + WS_VT)};
      pg8::gemm_phase(l3, g, S, E); }
}


constexpr int PPITCH = 1040;
__device__ __forceinline__ void ph3_pool_fast(const Args& a, int bid, int nb, unsigned char* lds) {
    int tid = threadIdx.x; asm volatile("" : "+v"(tid));
    const int cg8 = tid & 63, tq = tid >> 6, gch = cg8 >> 4, win = 2 << gch;
    const f16* Z = (const f16*)(a.ws + WS_U); f16* MIX = (f16*)(a.ws + WS_H);
    const f32x4 ps0 = *(const f32x4*)(a.in[7] + 8 * cg8), ps1 = *(const f32x4*)(a.in[7] + 8 * cg8 + 4), pg0 = *(const f32x4*)(a.in[8] + 8 * cg8), pg1 = *(const f32x4*)(a.in[8] + 8 * cg8 + 4);
    const float psc[8] = {ps0[0], ps0[1], ps0[2], ps0[3], ps1[0], ps1[1], ps1[2], ps1[3]}, pgn[8] = {pg0[0], pg0[1], pg0[2], pg0[3], pg1[0], pg1[1], pg1[2], pg1[3]};
    for (int item = bid; item < NT / 32; item += nb) {
        const int tb = item * 32 + 4 * tq, tl0 = tb % NS;
        const f16* up = Z + (size_t)(tb - tl0) * 512 + 8 * cg8;
        float sm[8];
#pragma unroll
        for (int j = 0; j < 8; ++j) sm[j] = 0.f;
        f16x8 hist_[15];
#pragma unroll
        for (int q = 0; q < 15; ++q) { const int rr = tl0 - 15 + q; hist_[q] = (q >= 16 - win && rr >= 0) ? *(const f16x8*)(up + (size_t)rr * 512) : (f16x8){0, 0, 0, 0, 0, 0, 0, 0}; }
        f16x8 cur_[4];
#pragma unroll
        for (int k = 0; k < 4; ++k) cur_[k] = *(const f16x8*)(up + (size_t)(tl0 + k) * 512);
#pragma unroll
        for (int q = 0; q < 15; ++q)
#pragma unroll
            for (int j = 0; j < 8; ++j) sm[j] += (float)hist_[q][j];
#pragma unroll
        for (int k = 0; k < 4; ++k) {
            const int tl = tl0 + k;
            const float ic = 1.f / (float)((tl + 1 < win) ? tl + 1 : win);
            float v[8]; float ss = 0.f;
#pragma unroll
            for (int j = 0; j < 8; ++j) { sm[j] += (float)cur_[k][j]; v[j] = (sm[j] * ic - (float)cur_[k][j]) * psc[j]; ss += v[j] * v[j]; }
            const float rstd = rsqrtf(wave_sum(ss) * (1.f / 512.f) + EPS);
            f16x8 o;
#pragma unroll
            for (int j = 0; j < 8; ++j) o[j] = (f16)(v[j] * rstd * pgn[j]);
            *(f16x8*)(MIX + (size_t)(tb + k) * ND + 8 * cg8) = o;
            if (k < 3) {
#pragma unroll
                for (int j = 0; j < 8; ++j) {
                    const int q = 16 - win + k;
                    float dv = 0.f;
#pragma unroll
                    for (int qq = 0; qq < 15; ++qq) if (qq == q) dv = (float)hist_[qq][j];
#pragma unroll
                    for (int kk = 0; kk < 3; ++kk) if (q == 15 + kk) dv = (float)cur_[kk][j];
                    sm[j] -= dv;
                }
            }
        }
    }
}


typedef float f32x2 __attribute__((ext_vector_type(2)));
typedef unsigned u32x4 __attribute__((ext_vector_type(4)));

constexpr int IDX_KPITCH = 16384 + 16;
constexpr int IDX_HPITCH = 516;
template <int NBL>
__device__ __forceinline__ int wave_pick(const unsigned (&cc)[NBL], unsigned target, int lane, unsigned& rem_out) {
    unsigned tot = 0u;
#pragma unroll
    for (int j = 0; j < NBL; ++j) tot += cc[j];
    unsigned S = tot;
#pragma unroll
    for (int o = 1; o < 64; o <<= 1) { const unsigned v = __shfl_down(S, o); if (lane + o < 64) S += v; }
    const unsigned above = S - tot;
    const bool hit = (above < target) && (S >= target);
    const u64 bal = __ballot(hit);
    const int L = bal ? __builtin_ctzll(bal) : 0;
    int bin = 0; unsigned rem = target;
    { unsigned run = above; bool done = false;
#pragma unroll
      for (int j = NBL - 1; j >= 0; --j) { if (!done) { if (run + cc[j] >= target) { bin = NBL * lane + j; rem = target - run; done = true; } else run += cc[j]; } } }
    bin = __shfl(bin, L); rem_out = __shfl(rem, L);
    return bin;
}
template <int MODE>
__device__ __forceinline__ void ph3_index_fast(const Args& a, int bid, int nb, unsigned char* lds) {
    int tid = threadIdx.x; asm volatile("" : "+v"(tid));
    const int lane = tid & 63, wave = __builtin_amdgcn_readfirstlane(tid >> 6), r = lane & 31, hh = lane >> 5;
    const f16* QI = (const f16*)(a.ws + WS_QI); const f16* KI = (const f16*)(a.ws + WS_KI); const float* WI = (const float*)(a.ws + WS_WI);
    u64* MASK = (u64*)(a.ws + WS_MASK);
    unsigned* hist = (unsigned*)(lds + 8 * IDX_KPITCH);
    f16x8 af[2][4]; f32x2 wv2[2][8];
#define IDX_LOAD_FRAGS(t0_) do { \
        _Pragma("unroll") for (int rt = 0; rt < 2; ++rt) { \
            _Pragma("unroll") for (int ks = 0; ks < 4; ++ks) af[rt][ks] = *(const f16x8*)(QI + ((((((size_t)((t0_) >> 3) * 2 + rt) * 4 + ks) * 2 + hh) * 32 + r) << 3)); \
            _Pragma("unroll") for (int qq = 0; qq < 2; ++qq) { const float* wp = WI + (size_t)((t0_) + 4 * rt + 2 * hh + qq) * 8; const f32x4 w0 = *(const f32x4*)wp * 0.125f, w1 = *(const f32x4*)(wp + 4) * 0.125f; \
                wv2[rt][4 * qq + 0] = (f32x2){w0[0], w0[1]}; wv2[rt][4 * qq + 1] = (f32x2){w0[2], w0[3]}; wv2[rt][4 * qq + 2] = (f32x2){w1[0], w1[1]}; wv2[rt][4 * qq + 3] = (f32x2){w1[2], w1[3]}; } \
        } } while (0)
    for (int round = 0; round * nb < 256; ++round) {
        const int p = round * nb + ((round & 1) ? (nb - 1 - bid) : bid);
        if (p < 256) { const int tg = p >> 3, b_ = p & 7, t0l = tg * 8, ch_ = t0l >> 6, t0_ = b_ * NS + t0l;
            if (tid < 8 * (ch_ + 1)) { const int q = tid / (ch_ + 1), w = tid % (ch_ + 1); MASK[((size_t)b_ * 128 + w) * NS + t0l + q] = ~0ull; } }
    }
#define IDX_P(round_) ((round_) * nb + (((round_) & 1) ? (nb - 1 - bid) : bid))
    int round = 0;
    while (round * nb < 8192 && !(IDX_P(round) >= 256 && IDX_P(round) < 8192)) ++round;
    if (round * nb < 8192) { const int p0 = IDX_P(round); IDX_LOAD_FRAGS((p0 & 7) * NS + (p0 >> 3) * 8); }
    for (; round * nb < 8192; ) {
        const int p = IDX_P(round);
        int rnext = round + 1;
        while (rnext * nb < 8192 && !(IDX_P(rnext) >= 256 && IDX_P(rnext) < 8192)) ++rnext;
        const bool has_next = rnext * nb < 8192;
        const int pn = has_next ? IDX_P(rnext) : p;
        const int tg = p >> 3, b = p & 7, t0l = tg * 8, ch = t0l >> 6, nadm = 64 * (ch + 1), t0 = b * NS + t0l;
        const int t0n = (pn & 7) * NS + (pn >> 3) * 8;
        round = has_next ? rnext : 8192;
        __syncthreads();
#pragma unroll
        for (int i = 0; i < 9; ++i) if (tid + i * NTHR < 8 * IDX_HPITCH) hist[tid + i * NTHR] = 0u;
        __syncthreads();
        const int nkb = nadm >> 5;
        const f16* kbase = KI + ((size_t)(b * (NS / 32)) * 8 + hh) * 256 + r * 8;
#define IDX_LOADB(dst, kb_) do { _Pragma("unroll") for (int ks = 0; ks < 4; ++ks) dst[ks] = *(const f16x8*)(kbase + ((size_t)(kb_) * 8 + 2 * ks) * 256); } while (0)
#define IDX_BLOCK(bfrag, kb_) do { \
            f32x16 acc[2]; \
            _Pragma("unroll") for (int rt = 0; rt < 2; ++rt) { acc[rt] = (f32x16){0.f, 0.f, 0.f, 0.f, 0.f, 0.f, 0.f, 0.f, 0.f, 0.f, 0.f, 0.f, 0.f, 0.f, 0.f, 0.f}; \
                _Pragma("unroll") for (int ks = 0; ks < 4; ++ks) acc[rt] = __builtin_amdgcn_mfma_f32_32x32x16_f16(af[rt][ks], bfrag[ks], acc[rt], 0, 0, 0); } \
            _Pragma("unroll") for (int rt = 0; rt < 2; ++rt) \
                _Pragma("unroll") for (int qq = 0; qq < 2; ++qq) { \
                    f32x2 t2 = (f32x2){0.f, 0.f}; \
                    _Pragma("unroll") for (int hp = 0; hp < 4; ++hp) { const f32x2 r2 = (f32x2){__int_as_float(max(__float_as_int(acc[rt][8 * qq + 2 * hp]), 0)), __int_as_float(max(__float_as_int(acc[rt][8 * qq + 2 * hp + 1]), 0))}; \
                        t2 = __builtin_elementwise_fma(wv2[rt][4 * qq + hp], r2, t2); } \
                    const float sc = t2[0] + t2[1]; \
                    const f16 sh = (f16)sc; const unsigned bits = (unsigned)__builtin_bit_cast(unsigned short, sh); \
                    const unsigned key = (bits & 0x8000u) ? (~bits & 0xFFFFu) : (bits | 0x8000u); \
                    const int q = 4 * rt + 2 * hh + qq; \
                    if (MODE != 2) *(u16*)(lds + q * IDX_KPITCH + ((kb_) * 32 + r) * 2) = (u16)key; \
                    if (MODE != 2 && MODE != 4) atomicAdd(&hist[q * IDX_HPITCH + (key >> 7)], (key & 64u) ? 0x10000u : 1u); \
                    if (MODE == 2) sink += key; \
                } } while (0)
        f16x8 bf0[4], bf1[4], bf2[4]; unsigned sink = 0u;
        if (wave >= 4) __builtin_amdgcn_s_sleep(5);
        if (wave < nkb) IDX_LOADB(bf0, wave);
        if (wave + 8 < nkb) IDX_LOADB(bf1, wave + 8);
        if (wave + 16 < nkb) IDX_LOADB(bf2, wave + 16);
        if (MODE != 3) for (int kb = wave; kb < nkb; kb += 24) {
            IDX_BLOCK(bf0, kb);
            if (kb + 24 < nkb) IDX_LOADB(bf0, kb + 24);
            if (kb + 8 < nkb) { IDX_BLOCK(bf1, kb + 8); if (kb + 32 < nkb) IDX_LOADB(bf1, kb + 32); }
            if (kb + 16 < nkb) { IDX_BLOCK(bf2, kb + 16); if (kb + 40 < nkb) IDX_LOADB(bf2, kb + 40); }
        }
#undef IDX_LOADB
#undef IDX_BLOCK
        if (MODE == 2 && sink == 0xdeadbeefu) hist[tid] = sink;
        IDX_LOAD_FRAGS(t0n);
        __syncthreads();
        if (MODE != 1) {
            unsigned* hw = hist + wave * IDX_HPITCH;
            const unsigned char* krow = lds + wave * IDX_KPITCH;
            unsigned rem1 = 0u, rem2 = 0u;
            int b1;
            {   const u32x4 d0 = *(const u32x4*)(hw + 8 * lane), d1 = *(const u32x4*)(hw + 8 * lane + 4);
                const unsigned dd[8] = {d0.x, d0.y, d0.z, d0.w, d1.x, d1.y, d1.z, d1.w};
                unsigned cc[16];
#pragma unroll
                for (int j = 0; j < 8; ++j) { cc[2 * j] = dd[j] & 0xFFFFu; cc[2 * j + 1] = dd[j] >> 16; }
                b1 = wave_pick<16>(cc, 256u, lane, rem1); }
            hw[lane] = 0u;
            const int nit = (nadm + 511) >> 9;
            for (int it = 0; it < nit; ++it) {
                const int idx = (it * 64 + lane) * 8;
                if (idx < nadm) { const u32x4 k4 = *(const u32x4*)(krow + idx * 2);
                    const unsigned kk[4] = {k4.x, k4.y, k4.z, k4.w};
                    unsigned hit = 0u;
#pragma unroll
                    for (int j = 0; j < 4; ++j) { hit |= (((kk[j] & 0xFFFFu) >> 6) == (unsigned)b1 ? 1u : 0u) << (2 * j); hit |= ((kk[j] >> 22) == (unsigned)b1 ? 1u : 0u) << (2 * j + 1); }
                    if (hit) {
#pragma unroll
                        for (int j = 0; j < 4; ++j) { const unsigned k0 = kk[j] & 0xFFFFu, k1 = kk[j] >> 16;
                            if (hit & (1u << (2 * j))) atomicAdd(&hw[k0 & 63u], 1u);
                            if (hit & (2u << (2 * j))) atomicAdd(&hw[k1 & 63u], 1u); }
                    } }
            }
            int b2;
            { const unsigned c1[1] = {hw[lane]}; b2 = wave_pick<1>(c1, rem1, lane, rem2); }
            const unsigned tau = ((unsigned)b1 << 6) | (unsigned)b2;
            const size_t mrow = (size_t)(t0 + wave) * 128;
            for (int it = 0; it < nit; ++it) {
                const int idx = (it * 64 + lane) * 8;
                unsigned byte = 0u;
                if (idx < nadm) { const u32x4 k4 = *(const u32x4*)(krow + idx * 2);
                    const unsigned kk[4] = {k4.x, k4.y, k4.z, k4.w};
#pragma unroll
                    for (int j = 0; j < 4; ++j) { byte |= ((kk[j] & 0xFFFFu) >= tau ? 1u : 0u) << (2 * j); byte |= ((kk[j] >> 16) >= tau ? 1u : 0u) << (2 * j + 1); } }
                unsigned lo = (lane & 4) ? 0u : (byte << (8 * (lane & 3))), hi = (lane & 4) ? (byte << (8 * (lane & 3))) : 0u;
                lo |= __shfl_xor(lo, 1); hi |= __shfl_xor(hi, 1); lo |= __shfl_xor(lo, 2); hi |= __shfl_xor(hi, 2); lo |= __shfl_xor(lo, 4); hi |= __shfl_xor(hi, 4);
                if ((lane & 7) == 0 && idx < nadm) { hw[64 + 2 * (it * 8 + (lane >> 3))] = lo; hw[64 + 2 * (it * 8 + (lane >> 3)) + 1] = hi; }
            }
        }
        __syncthreads();
        if (MODE != 1) { const int w = tid >> 2, qp = tid & 3;
            if (w <= ch) { const unsigned* ha = hist + (2 * qp) * IDX_HPITCH + 64 + 2 * w; const unsigned* hb = ha + IDX_HPITCH;
                *(u32x4*)(MASK + ((size_t)b * 128 + w) * NS + t0l + 2 * qp) = (u32x4){ha[0], ha[1], hb[0], hb[1]}; } }
    }
    __syncthreads();
}

constexpr int ATP = 144;
constexpr int ATT_QWORD = 3584 + 32 * 64;
template <int AMODE>
__device__ __forceinline__ void ph4_attn_fast(const Args& a, int bid, int nb, unsigned char* lds) {
    int tid = threadIdx.x; asm volatile("" : "+v"(tid));
    const int lane = tid & 63, wave = __builtin_amdgcn_readfirstlane(tid >> 6), r = lane & 31, hh = lane >> 5;
    const f16* Q = (const f16*)(a.ws + WS_Q); const f16* Kk = (const f16*)(a.ws + WS_K); const f16* VT = (const f16*)(a.ws + WS_VT);
    const u64* MASK = (const u64*)(a.ws + WS_MASK); f16* MIX = (f16*)(a.ws + WS_H); const float* og = a.in[11];
    unsigned char* Kl = lds; unsigned char* Vl = lds + 2 * 64 * ATP;
    const float LOG2E = 1.4426950408889634f, OFF = 8192.f;
    const int pir = 16 * (r >> 4) + 8 * ((r >> 2) & 1) + 4 * ((r >> 3) & 1) + (r & 3);
    const int srow = tid >> 3, schk = tid & 7;
    unsigned* aq = (unsigned*)(a.ws + WS_CTL) + ATT_QWORD;
    volatile unsigned* ucell = (volatile unsigned*)(lds + 6 * 64 * ATP);
    volatile unsigned* dflag = ucell + 8;
    const float kmax = __int_as_float(__builtin_amdgcn_readfirstlane(__float_as_int(1.01f * 8.f * wave_max(fabsf(a.in[10][lane])))));
    int upar = 0;
    for (;;) {
        if (tid == 0) ucell[upar] = __hip_atomic_fetch_add(aq, 1u, __ATOMIC_RELAXED, __HIP_MEMORY_SCOPE_AGENT);
        if (tid < 8) dflag[tid] = 0u;
        __syncthreads();
        const unsigned u = ucell[upar]; upar ^= 1;
        if (u >= 2048u) break;
        const int h = 7 - (int)(u >> 8), qb = 31 - (int)((u & 255u) >> 3), b = (int)(u & 7u);
        const int q0l = qb * 256, tq = q0l + 32 * wave + r, cw = 4 * qb + (wave >> 1), top = 4 * qb + 3;
        const size_t t = (size_t)b * NS + tq;
        const float slope = exp2f(-(float)(h + 1)) * LOG2E;
        f16x8 qf[4];
#pragma unroll
        for (int ks = 0; ks < 4; ++ks) { const f16x8 qv = *(const f16x8*)(Q + t * 512 + h * 64 + 16 * ks + 8 * hh);
#pragma unroll
            for (int j = 0; j < 8; ++j) qf[ks][j] = (f16)((float)qv[j] * (0.125f * LOG2E)); }
        float qss = 0.f;
#pragma unroll
        for (int ks = 0; ks < 4; ++ks)
#pragma unroll
            for (int j = 0; j < 8; ++j) qss += (float)qf[ks][j] * (float)qf[ks][j];
        qss += __shfl_xor(qss, 32);
        const float Sb = __int_as_float(__builtin_amdgcn_readfirstlane(__float_as_int(wave_max(sqrtf(qss)) * kmax)));
        const float rowc = OFF + slope * (float)(tq - q0l);
        float m = 1000.f, l = 0.f;
        f32x16 O[2];
#pragma unroll
        for (int dt = 0; dt < 2; ++dt) O[dt] = (f32x16){0.f, 0.f, 0.f, 0.f, 0.f, 0.f, 0.f, 0.f, 0.f, 0.f, 0.f, 0.f, 0.f, 0.f, 0.f, 0.f};
        const f16* kg = Kk + ((size_t)b * NS + srow) * 512 + h * 64 + schk * 8;
        const f16* vg = VT + (size_t)(h * 64 + srow) * NT + (size_t)b * NS + schk * 8;
        f16x8 kr0, kr1, vr0, vr1; u64 mw0 = 0ull, mw1 = 0ull;
#define ATT_LOAD(kr, vr, mwv, jj) do { if ((jj) >= 0) { kr = *(const f16x8*)(kg + (size_t)(jj) * 64 * 512); vr = *(const f16x8*)(vg + (jj) * 64); mwv = ((jj) <= cw) ? MASK[((size_t)b * 128 + (jj)) * NS + tq] : 0ull; } } while (0)
        ATT_LOAD(kr0, vr0, mw0, top); ATT_LOAD(kr1, vr1, mw1, top - 1);
        int buf = 0; bool wdone = false, stop = false;
        auto step = [&](f16x8& kreg, f16x8& vreg, u64& mwr, const int j) {
            *(f16x8*)(Kl + buf * 64 * ATP + srow * ATP + schk * 16) = kreg;
            *(f16x8*)(Vl + buf * 64 * ATP + srow * ATP + schk * 16) = vreg;
            const u64 mw = mwr;
            asm volatile("s_waitcnt lgkmcnt(0)" ::: "memory"); __builtin_amdgcn_s_barrier(); asm volatile("" ::: "memory");
            {
                const unsigned jp = (unsigned)(j + 1);
                if ((dflag[0] > jp) & (dflag[1] > jp) & (dflag[2] > jp) & (dflag[3] > jp) & (dflag[4] > jp) & (dflag[5] > jp) & (dflag[6] > jp) & (dflag[7] > jp)) { stop = true; return; }
            }
            ATT_LOAD(kreg, vreg, mwr, j - 2);
            if (!wdone && j < cw) { const float lmax = Sb + OFF + slope * (float)(64 * j + 63 - q0l); if (__all(lmax - m < -28.f)) { wdone = true; if (lane == 0) dflag[wave] = (unsigned)(j + 1); } }
            if (j <= cw && !wdone) {
                const unsigned char* kb_ = Kl + buf * 64 * ATP + pir * ATP + 16 * hh;
                f16x8 fr8[8];
#pragma unroll
                for (int kt = 0; kt < 2; ++kt)
#pragma unroll
                    for (int ks = 0; ks < 4; ++ks) fr8[kt * 4 + ks] = *(const f16x8*)(kb_ + kt * 32 * ATP + ks * 32);
                f32x16 sa[2];
                if (j == cw) {
#pragma unroll
                    for (int kt = 0; kt < 2; ++kt)
#pragma unroll
                        for (int rg = 0; rg < 16; ++rg) { const float x = (float)(64 * j + 32 * kt + 16 * (rg >> 3) + 8 * hh + (rg & 7) - tq); sa[kt][rg] = rowc - slope * fabsf(x); }
                } else {
                    const float base = OFF + slope * (float)(64 * j + 8 * hh - q0l);
#pragma unroll
                    for (int kt = 0; kt < 2; ++kt)
#pragma unroll
                        for (int rg = 0; rg < 16; ++rg) sa[kt][rg] = __builtin_fmaf(slope, (float)(32 * kt + 16 * (rg >> 3) + (rg & 7)), base);
                }
                __builtin_amdgcn_sched_barrier(0);
                __builtin_amdgcn_s_setprio(1);
#pragma unroll
                for (int kt = 0; kt < 2; ++kt)
#pragma unroll
                    for (int ks = 0; ks < 4; ++ks) sa[kt] = __builtin_amdgcn_mfma_f32_32x32x16_f16(fr8[kt * 4 + ks], qf[ks], sa[kt], 0, 0, 0);
                __builtin_amdgcn_s_setprio(0);
                __builtin_amdgcn_sched_barrier(0);
                const unsigned char* vb_ = Vl + buf * 64 * ATP + r * ATP + 16 * hh;
#pragma unroll
                for (int dt = 0; dt < 2; ++dt)
#pragma unroll
                    for (int kt = 0; kt < 2; ++kt)
#pragma unroll
                        for (int s2 = 0; s2 < 2; ++s2) fr8[dt * 4 + kt * 2 + s2] = *(const f16x8*)(vb_ + dt * 32 * ATP + kt * 64 + s2 * 32);
                __builtin_amdgcn_sched_barrier(0);
                float rm = 0.f;
#pragma unroll
                for (int kt = 0; kt < 2; ++kt) { const unsigned w32 = (unsigned)(kt ? (mw >> 32) : mw) >> (8 * hh);
#pragma unroll
                    for (int rg = 0; rg < 16; ++rg) { const int tm = __builtin_amdgcn_sbfe((int)w32, 16 * (rg >> 3) + (rg & 7), 1);
                        const float L = __int_as_float(__float_as_int(sa[kt][rg]) & tm); sa[kt][rg] = L; rm = fmaxf(rm, L); } }
                rm = fmaxf(rm, __shfl_xor(rm, 32));
                const float mn = fmaxf(m, rm);
                if (__any(mn > m)) { const float al = __builtin_amdgcn_exp2f(m - mn); l *= al;
#pragma unroll
                    for (int dt = 0; dt < 2; ++dt)
#pragma unroll
                        for (int rg = 0; rg < 16; ++rg) O[dt][rg] *= al; }
                m = mn;
                f16x8 pf[2][2];
                float l0 = 0.f, l1 = 0.f;
#pragma unroll
                for (int kt = 0; kt < 2; ++kt)
#pragma unroll
                    for (int rg = 0; rg < 16; ++rg) { const float pp = __builtin_amdgcn_exp2f(sa[kt][rg] - m); if (rg & 1) l1 += pp; else l0 += pp; pf[kt][rg >> 3][rg & 7] = (f16)pp; }
                l += l0 + l1;
                __builtin_amdgcn_sched_barrier(0);
                __builtin_amdgcn_s_setprio(1);
#pragma unroll
                for (int dt = 0; dt < 2; ++dt)
#pragma unroll
                    for (int kt = 0; kt < 2; ++kt)
#pragma unroll
                        for (int s2 = 0; s2 < 2; ++s2) O[dt] = __builtin_amdgcn_mfma_f32_32x32x16_f16(fr8[dt * 4 + kt * 2 + s2], pf[kt][s2], O[dt], 0, 0, 0);
                __builtin_amdgcn_s_setprio(0);
            }
            buf ^= 1;
        };
        for (int j = top; j >= 0; j -= 2) {
            step(kr0, vr0, mw0, j); if (stop) break;
            if (j - 1 >= 0) { step(kr1, vr1, mw1, j - 1); if (stop) break; }
        }
#undef ATT_LOAD
        l += __shfl_xor(l, 32);
        const float inv = 1.f / l;
        float ss = 0.f;
#pragma unroll
        for (int dt = 0; dt < 2; ++dt)
#pragma unroll
            for (int rg = 0; rg < 16; ++rg) { O[dt][rg] *= inv; ss += O[dt][rg] * O[dt][rg]; }
        ss += __shfl_xor(ss, 32);
        const float rstd = rsqrtf(ss * (1.f / 64.f) + EPS);
#pragma unroll
        for (int dt = 0; dt < 2; ++dt)
#pragma unroll
            for (int g4 = 0; g4 < 4; ++g4) { const int d = 32 * dt + 8 * g4 + 4 * hh; const f32x4 gg = *(const f32x4*)(og + h * 64 + d);
                f16x4 o4; o4.x = (f16)(O[dt][4 * g4 + 0] * rstd * gg.x); o4.y = (f16)(O[dt][4 * g4 + 1] * rstd * gg.y); o4.z = (f16)(O[dt][4 * g4 + 2] * rstd * gg.z); o4.w = (f16)(O[dt][4 * g4 + 3] * rstd * gg.w);
                *(f16x4*)(MIX + t * ND + 512 + h * 64 + d) = o4; }
        __syncthreads();
    }
}

__device__ __forceinline__ void ph5_outproj(const Args& a, int bid, int nb, unsigned char* lds) {
    pg8::Gemm g{(const f16*)(a.ws + WS_H), (const f16*)(a.ws + WS_WOUT), NT, 1024, ND}; pg8::StaticOrder S; S.init(NT, 1024, nb, bid);
    pg8::EpiOut E{a.in[0], (const float*)(a.ws + WS_MOD), a.out};
    pg8::gemm_phase((PG8_LAS unsigned char*)lds, g, S, E);
}

__device__ __forceinline__ void ph7_peerq(const Args& a, int bid, int nb, unsigned char* lds) {
    pg8::Gemm g{(const f16*)(a.ws + WS_H), (const f16*)(a.ws + WS_WQ), NT, 2048, ND}; pg8::StaticOrder S; S.init(NT, 2048, nb, bid);
    pg8::EpiPQ E{(f16*)(a.ws + WS_PQ)};
    pg8::gemm_phase((PG8_LAS unsigned char*)lds, g, S, E);
}


__device__ __forceinline__ unsigned f2skey(float f) { const unsigned u = __float_as_uint(f); return (u & 0x80000000u) ? ~u : (u | 0x80000000u); }
__device__ __forceinline__ float skey2f(unsigned k) { return __uint_as_float((k & 0x80000000u) ? (k & 0x7FFFFFFFu) : ~k); }
#define CE_(a_, b_) do { const unsigned t__ = max(a_, b_); b_ = min(a_, b_); a_ = t__; } while (0)
#define SORT16_DESC(v) do { CE_(v[0], v[1]); CE_(v[2], v[3]); CE_(v[0], v[2]); CE_(v[1], v[3]); CE_(v[1], v[2]); CE_(v[4], v[5]); CE_(v[6], v[7]); CE_(v[4], v[6]); CE_(v[5], v[7]); CE_(v[5], v[6]); CE_(v[0], v[4]); CE_(v[2], v[6]); CE_(v[2], v[4]); CE_(v[1], v[5]); CE_(v[3], v[7]); CE_(v[3], v[5]); CE_(v[1], v[2]); CE_(v[3], v[4]); CE_(v[5], v[6]); CE_(v[8], v[9]); CE_(v[10], v[11]); CE_(v[8], v[10]); CE_(v[9], v[11]); CE_(v[9], v[10]); CE_(v[12], v[13]); CE_(v[14], v[15]); CE_(v[12], v[14]); CE_(v[13], v[15]); CE_(v[13], v[14]); CE_(v[8], v[12]); CE_(v[10], v[14]); CE_(v[10], v[12]); CE_(v[9], v[13]); CE_(v[11], v[15]); CE_(v[11], v[13]); CE_(v[9], v[10]); CE_(v[11], v[12]); CE_(v[13], v[14]); CE_(v[0], v[8]); CE_(v[4], v[12]); CE_(v[4], v[8]); CE_(v[2], v[10]); CE_(v[6], v[14]); CE_(v[6], v[10]); CE_(v[2], v[4]); CE_(v[6], v[8]); CE_(v[10], v[12]); CE_(v[1], v[9]); CE_(v[5], v[13]); CE_(v[5], v[9]); CE_(v[3], v[11]); CE_(v[7], v[15]); CE_(v[7], v[11]); CE_(v[3], v[5]); CE_(v[7], v[9]); CE_(v[11], v[13]); CE_(v[1], v[2]); CE_(v[3], v[4]); CE_(v[5], v[6]); CE_(v[7], v[8]); CE_(v[9], v[10]); CE_(v[11], v[12]); CE_(v[13], v[14]); } while (0)
#define BITONIC16_DESC(v) do { CE_(v[0], v[8]); CE_(v[1], v[9]); CE_(v[2], v[10]); CE_(v[3], v[11]); CE_(v[4], v[12]); CE_(v[5], v[13]); CE_(v[6], v[14]); CE_(v[7], v[15]); CE_(v[0], v[4]); CE_(v[1], v[5]); CE_(v[2], v[6]); CE_(v[3], v[7]); CE_(v[8], v[12]); CE_(v[9], v[13]); CE_(v[10], v[14]); CE_(v[11], v[15]); CE_(v[0], v[2]); CE_(v[1], v[3]); CE_(v[4], v[6]); CE_(v[5], v[7]); CE_(v[8], v[10]); CE_(v[9], v[11]); CE_(v[12], v[14]); CE_(v[13], v[15]); CE_(v[0], v[1]); CE_(v[2], v[3]); CE_(v[4], v[5]); CE_(v[6], v[7]); CE_(v[8], v[9]); CE_(v[10], v[11]); CE_(v[12], v[13]); CE_(v[14], v[15]); } while (0)
#define MERGE16_DESC(dst, other) do { unsigned c__[16]; _Pragma("unroll") for (int i__ = 0; i__ < 16; ++i__) c__[i__] = max(dst[i__], other[15 - i__]); BITONIC16_DESC(c__); _Pragma("unroll") for (int i__ = 0; i__ < 16; ++i__) dst[i__] = c__[i__]; } while (0)
#define TOP16_INSERT(v, x_) do { unsigned x__ = (x_); _Pragma("unroll") for (int k_ = 0; k_ < 16; ++k_) { const unsigned t__ = max(v[k_], x__); x__ = min(v[k_], x__); v[k_] = t__; } } while (0)
__device__ __forceinline__ void ph8_peersel_fast(const Args& a, int bid, int nb, unsigned char* lds) {
    int tid = threadIdx.x; asm volatile("" : "+v"(tid));
    const int lane = tid & 63, wave = __builtin_amdgcn_readfirstlane(tid >> 6), r = lane & 31, hh = lane >> 5;
    const f16* PQ = (const f16*)(a.ws + WS_PQ);
    u16* EID = (u16*)(a.ws + WS_EID); float* GW = (float*)(a.ws + WS_GW);
    unsigned char* wl = lds + wave * 2048 + lane * 32;
    for (int item = bid * NWAVE + wave; item < (NT / 32) * 8; item += nb * NWAVE) {
        const int tt = item >> 3, h = item & 7, t0 = tt * 32;
        unsigned top[2][16];
#pragma unroll
        for (int p = 0; p < 2; ++p) {
            f16x8 sq[8];
#pragma unroll
            for (int c = 0; c < 8; ++c) sq[c] = *(const f16x8*)(PQ + ((((size_t)tt * 256 + h * 32 + p * 16 + 8 * hh + c) * 32 + r) << 3));
#pragma unroll
            for (int k = 0; k < 16; ++k) top[p][k] = 0u;
#pragma unroll
            for (int g = 0; g < 4; ++g) {
                unsigned ky[16];
#pragma unroll
                for (int i = 0; i < 16; ++i) { const unsigned n = 64u * hh + 16u * g + i; ky[i] = (f2skey((float)sq[2 * g + (i >> 3)][i & 7]) & ~127u) | n; }
                SORT16_DESC(ky); MERGE16_DESC(top[p], ky);
            }
            unsigned oth[16];
#pragma unroll
            for (int k = 0; k < 16; ++k) oth[k] = __shfl_xor(top[p][k], 32);
            MERGE16_DESC(top[p], oth);
            asm volatile("" ::: "memory");
        }
#pragma unroll
        for (int k = 0; k < 16; k += 4) {
            *(unsigned*)(wl + k) = (top[0][k] & 127u) | ((top[0][k + 1] & 127u) << 8) | ((top[0][k + 2] & 127u) << 16) | ((top[0][k + 3] & 127u) << 24);
            *(unsigned*)(wl + 16 + k) = (top[1][k] & 127u) | ((top[1][k + 1] & 127u) << 8) | ((top[1][k + 2] & 127u) << 16) | ((top[1][k + 3] & 127u) << 24);
        }
        float fa[16], fb[16];
#pragma unroll
        for (int k = 0; k < 16; ++k) { fa[k] = skey2f(top[0][k] & ~127u); fb[k] = skey2f(top[1][k] & ~127u); }
        unsigned cg[4][16];
        cg[0][0] = (f2skey(fa[0] + fb[0]) & ~255u) | 0u;
        cg[0][1] = (f2skey(fa[0] + fb[1]) & ~255u) | 1u;
        cg[0][2] = (f2skey(fa[0] + fb[2]) & ~255u) | 2u;
        cg[0][3] = (f2skey(fa[0] + fb[3]) & ~255u) | 3u;
        cg[0][4] = (f2skey(fa[0] + fb[4]) & ~255u) | 4u;
        cg[0][5] = (f2skey(fa[0] + fb[5]) & ~255u) | 5u;
        cg[0][6] = (f2skey(fa[0] + fb[6]) & ~255u) | 6u;
        cg[0][7] = (f2skey(fa[0] + fb[7]) & ~255u) | 7u;
        cg[0][8] = (f2skey(fa[0] + fb[8]) & ~255u) | 8u;
        cg[0][9] = (f2skey(fa[0] + fb[9]) & ~255u) | 9u;
        cg[0][10] = (f2skey(fa[0] + fb[10]) & ~255u) | 10u;
        cg[0][11] = (f2skey(fa[0] + fb[11]) & ~255u) | 11u;
        cg[0][12] = (f2skey(fa[0] + fb[12]) & ~255u) | 12u;
        cg[0][13] = (f2skey(fa[0] + fb[13]) & ~255u) | 13u;
        cg[0][14] = (f2skey(fa[0] + fb[14]) & ~255u) | 14u;
        cg[0][15] = (f2skey(fa[0] + fb[15]) & ~255u) | 15u;
        cg[1][0] = (f2skey(fa[1] + fb[0]) & ~255u) | 16u;
        cg[1][1] = (f2skey(fa[1] + fb[1]) & ~255u) | 17u;
        cg[1][2] = (f2skey(fa[1] + fb[2]) & ~255u) | 18u;
        cg[1][3] = (f2skey(fa[1] + fb[3]) & ~255u) | 19u;
        cg[1][4] = (f2skey(fa[1] + fb[4]) & ~255u) | 20u;
        cg[1][5] = (f2skey(fa[1] + fb[5]) & ~255u) | 21u;
        cg[1][6] = (f2skey(fa[1] + fb[6]) & ~255u) | 22u;
        cg[1][7] = (f2skey(fa[1] + fb[7]) & ~255u) | 23u;
        cg[1][8] = (f2skey(fa[2] + fb[0]) & ~255u) | 32u;
        cg[1][9] = (f2skey(fa[2] + fb[1]) & ~255u) | 33u;
        cg[1][10] = (f2skey(fa[2] + fb[2]) & ~255u) | 34u;
        cg[1][11] = (f2skey(fa[2] + fb[3]) & ~255u) | 35u;
        cg[1][12] = (f2skey(fa[2] + fb[4]) & ~255u) | 36u;
        cg[1][13] = (f2skey(fa[3] + fb[0]) & ~255u) | 48u;
        cg[1][14] = (f2skey(fa[3] + fb[1]) & ~255u) | 49u;
        cg[1][15] = (f2skey(fa[3] + fb[2]) & ~255u) | 50u;
        cg[2][0] = (f2skey(fa[3] + fb[3]) & ~255u) | 51u;
        cg[2][1] = (f2skey(fa[4] + fb[0]) & ~255u) | 64u;
        cg[2][2] = (f2skey(fa[4] + fb[1]) & ~255u) | 65u;
        cg[2][3] = (f2skey(fa[4] + fb[2]) & ~255u) | 66u;
        cg[2][4] = (f2skey(fa[5] + fb[0]) & ~255u) | 80u;
        cg[2][5] = (f2skey(fa[5] + fb[1]) & ~255u) | 81u;
        cg[2][6] = (f2skey(fa[6] + fb[0]) & ~255u) | 96u;
        cg[2][7] = (f2skey(fa[6] + fb[1]) & ~255u) | 97u;
        cg[2][8] = (f2skey(fa[7] + fb[0]) & ~255u) | 112u;
        cg[2][9] = (f2skey(fa[7] + fb[1]) & ~255u) | 113u;
        cg[2][10] = (f2skey(fa[8] + fb[0]) & ~255u) | 128u;
        cg[2][11] = (f2skey(fa[9] + fb[0]) & ~255u) | 144u;
        cg[2][12] = (f2skey(fa[10] + fb[0]) & ~255u) | 160u;
        cg[2][13] = (f2skey(fa[11] + fb[0]) & ~255u) | 176u;
        cg[2][14] = (f2skey(fa[12] + fb[0]) & ~255u) | 192u;
        cg[2][15] = (f2skey(fa[13] + fb[0]) & ~255u) | 208u;
        cg[3][0] = (f2skey(fa[14] + fb[0]) & ~255u) | 224u;
        cg[3][1] = (f2skey(fa[15] + fb[0]) & ~255u) | 240u;
        cg[3][2] = 0u;
        cg[3][3] = 0u;
        cg[3][4] = 0u;
        cg[3][5] = 0u;
        cg[3][6] = 0u;
        cg[3][7] = 0u;
        cg[3][8] = 0u;
        cg[3][9] = 0u;
        cg[3][10] = 0u;
        cg[3][11] = 0u;
        cg[3][12] = 0u;
        cg[3][13] = 0u;
        cg[3][14] = 0u;
        cg[3][15] = 0u;
        SORT16_DESC(cg[0]); SORT16_DESC(cg[1]); SORT16_DESC(cg[2]); SORT16_DESC(cg[3]);
        MERGE16_DESC(cg[0], cg[1]); MERGE16_DESC(cg[2], cg[3]); MERGE16_DESC(cg[0], cg[2]);
        unsigned ct[16];
#pragma unroll
        for (int k = 0; k < 16; ++k) ct[k] = cg[0][k];
        float sc[16]; float den = 0.f; const float s0 = skey2f(ct[0] & ~255u);
#pragma unroll
        for (int k = 0; k < 16; ++k) { sc[k] = __expf(skey2f(ct[k] & ~255u) - s0); den += sc[k]; }
        const float inv = 1.f / den;
        if (hh == 0) {
            u16 ev[16];
#pragma unroll
            for (int k = 0; k < 16; ++k) { const unsigned ij = ct[k] & 255u; const unsigned i1 = wl[ij >> 4], i2 = wl[16 + (ij & 15u)]; ev[k] = (u16)(i1 * 128u + i2); }
            const size_t o = (size_t)(t0 + r) * 128 + h * 16;
#pragma unroll
            for (int k = 0; k < 16; k += 8) {
                *(u32x4*)(EID + o + k) = (u32x4){(unsigned)ev[k] | ((unsigned)ev[k + 1] << 16), (unsigned)ev[k + 2] | ((unsigned)ev[k + 3] << 16), (unsigned)ev[k + 4] | ((unsigned)ev[k + 5] << 16), (unsigned)ev[k + 6] | ((unsigned)ev[k + 7] << 16)};
            }
#pragma unroll
            for (int k = 0; k < 16; k += 4) *(f32x4*)(GW + o + k) = (f32x4){sc[k] * inv, sc[k + 1] * inv, sc[k + 2] * inv, sc[k + 3] * inv};
        }
    }
}

typedef _Float16 f16x2 __attribute__((ext_vector_type(2)));
__device__ __forceinline__ float gelu_erf(float d) { return 0.5f * d * (1.f + erff(d * 0.70710678118654752f)); }
constexpr int PQ_WORD0 = 3584, PQ_CHUNK = 64, PQ_NCHUNK = NT / PQ_CHUNK;
constexpr size_t WS_PART = 208 * MiB;
__device__ __forceinline__ unsigned xcc_id_() { return (unsigned)__builtin_amdgcn_s_getreg((3 << 11) | 20) & 7u; }
template <int VPHASE>
__device__ __forceinline__ void ph9_sliced(const Args& a, unsigned char* lds) {
    int tid_ = threadIdx.x; asm volatile("" : "+v"(tid_)); const int lane = tid_ & 63, wave = __builtin_amdgcn_readfirstlane(tid_ >> 6);
    const int g8 = lane >> 3, c16 = lane & 7;
    const f16* H2 = (const f16*)(a.ws + WS_H); const unsigned char* TAB = a.ws + (VPHASE ? WS_VP : WS_UT);
    const u16* EID = (const u16*)(a.ws + WS_EID); const float* GW = (const float*)(a.ws + WS_GW); float* PART = (float*)(a.ws + WS_PART);
    const float* mod = (const float*)(a.ws + WS_MOD); float* out = a.out;
    unsigned* qw = (unsigned*)(a.ws + WS_CTL) + PQ_WORD0 + (VPHASE ? 8 * 64 : 0);
    volatile unsigned* cslot = (volatile unsigned*)lds;
    const bool b5 = (lane & 32) != 0, b4 = (lane & 16) != 0, b3 = (lane & 8) != 0, b2 = (lane & 4) != 0, b1 = (lane & 2) != 0, b0 = (lane & 1) != 0;
    const unsigned x0 = xcc_id_();
    int par = 0;
    for (int k = 0; k < 8; ++k) {
        const unsigned sl = (x0 + (unsigned)k) & 7u;
        unsigned cur = 0u;
        if (tid_ == 0) cur = __hip_atomic_fetch_add(qw + 64 * sl, 1u, __ATOMIC_RELAXED, __HIP_MEMORY_SCOPE_AGENT);
        for (;;) {
            if (tid_ == 0) cslot[par] = cur;
            __syncthreads();
            const unsigned c = cslot[par]; par ^= 1;
            if (c >= (unsigned)PQ_NCHUNK) break;
            if (tid_ == 0) cur = __hip_atomic_fetch_add(qw + 64 * sl, 1u, __ATOMIC_RELAXED, __HIP_MEMORY_SCOPE_AGENT);
            const int tb = (int)c * PQ_CHUNK + wave * (PQ_CHUNK / NWAVE);
            const unsigned char* tsl = TAB + 128 * sl + 16 * c16;
#pragma unroll 1
            for (int i8 = 0; i8 < PQ_CHUNK / NWAVE; ++i8) {
                const int t = tb + i8;
                const u32x4 e0 = *(const u32x4*)(EID + (size_t)t * 128 + 16 * g8), e1 = *(const u32x4*)(EID + (size_t)t * 128 + 16 * g8 + 8);
                const unsigned ew[8] = {e0.x, e0.y, e0.z, e0.w, e1.x, e1.y, e1.z, e1.w};
                u32x4 r8[16];
#pragma unroll
                for (int i = 0; i < 16; ++i) { const unsigned eid = (i & 1) ? (ew[i >> 1] >> 16) : (ew[i >> 1] & 0xFFFFu); r8[i] = *(const u32x4*)(tsl + (size_t)eid * ND); }
                if (!VPHASE) {
                    const u32x4 hq0 = *(const u32x4*)(H2 + (size_t)t * ND + 128 * sl + 16 * c16), hq1 = *(const u32x4*)(H2 + (size_t)t * ND + 128 * sl + 16 * c16 + 8);
                    const unsigned hp[8] = {hq0.x, hq0.y, hq0.z, hq0.w, hq1.x, hq1.y, hq1.z, hq1.w};
                    float p[16];
#pragma unroll
                    for (int i = 0; i < 16; ++i) { float d = 0.f;
#pragma unroll
                        for (int j = 0; j < 4; ++j) { const unsigned lo = __builtin_amdgcn_perm(r8[i][j], r8[i][j], 0x010C000Cu), hi = __builtin_amdgcn_perm(r8[i][j], r8[i][j], 0x030C020Cu);
                            d = __builtin_amdgcn_fdot2(__builtin_bit_cast(f16x2, hp[2 * j]), __builtin_bit_cast(f16x2, lo), d, false);
                            d = __builtin_amdgcn_fdot2(__builtin_bit_cast(f16x2, hp[2 * j + 1]), __builtin_bit_cast(f16x2, hi), d, false); }
                        p[i] = d; }
                    float q8[8], q4[4], r2[2];
#pragma unroll
                    for (int ii = 0; ii < 8; ++ii) { const float keep = b2 ? p[8 + ii] : p[ii], send = b2 ? p[ii] : p[8 + ii]; q8[ii] = keep + __shfl_xor(send, 4); }
#pragma unroll
                    for (int ii = 0; ii < 4; ++ii) { const float keep = b1 ? q8[4 + ii] : q8[ii], send = b1 ? q8[ii] : q8[4 + ii]; q4[ii] = keep + __shfl_xor(send, 2); }
#pragma unroll
                    for (int ii = 0; ii < 2; ++ii) { const float keep = b0 ? q4[2 + ii] : q4[ii], send = b0 ? q4[ii] : q4[2 + ii]; r2[ii] = keep + __shfl_xor(send, 1); }
                    *(f32x2*)(PART + ((size_t)sl * NT + t) * 128 + 16 * g8 + 2 * c16) = (f32x2){r2[0], r2[1]};
                } else {
                    const float* wp = GW + (size_t)t * 128 + 16 * g8;
                    const f32x4 wq0 = *(const f32x4*)wp, wq1 = *(const f32x4*)(wp + 4), wq2 = *(const f32x4*)(wp + 8), wq3 = *(const f32x4*)(wp + 12);
                    const float wv[16] = {wq0[0], wq0[1], wq0[2], wq0[3], wq1[0], wq1[1], wq1[2], wq1[3], wq2[0], wq2[1], wq2[2], wq2[3], wq3[0], wq3[1], wq3[2], wq3[3]};
                    f16x2 acc2[8];
#pragma unroll
                    for (int j = 0; j < 8; ++j) acc2[j] = (f16x2){(f16)0.f, (f16)0.f};
#pragma unroll
                    for (int i = 0; i < 16; ++i) { const f16x2 w2 = (f16x2){(f16)wv[i], (f16)wv[i]};
#pragma unroll
                        for (int j = 0; j < 4; ++j) { const unsigned lo = __builtin_amdgcn_perm(r8[i][j], r8[i][j], 0x010C000Cu), hi = __builtin_amdgcn_perm(r8[i][j], r8[i][j], 0x030C020Cu);
                            acc2[2 * j] = __builtin_elementwise_fma(w2, __builtin_bit_cast(f16x2, lo), acc2[2 * j]);
                            acc2[2 * j + 1] = __builtin_elementwise_fma(w2, __builtin_bit_cast(f16x2, hi), acc2[2 * j + 1]); } }
                    float acc[16];
#pragma unroll
                    for (int j = 0; j < 8; ++j) { acc[2 * j] = (float)acc2[j][0]; acc[2 * j + 1] = (float)acc2[j][1]; }
                    float q8[8], q4[4], r2[2];
#pragma unroll
                    for (int ii = 0; ii < 8; ++ii) { const float keep = b5 ? acc[8 + ii] : acc[ii], send = b5 ? acc[ii] : acc[8 + ii]; q8[ii] = keep + __shfl_xor(send, 32); }
#pragma unroll
                    for (int ii = 0; ii < 4; ++ii) { const float keep = b4 ? q8[4 + ii] : q8[ii], send = b4 ? q8[ii] : q8[4 + ii]; q4[ii] = keep + __shfl_xor(send, 16); }
#pragma unroll
                    for (int ii = 0; ii < 2; ++ii) { const float keep = b3 ? q4[2 + ii] : q4[ii], send = b3 ? q4[ii] : q4[2 + ii]; r2[ii] = keep + __shfl_xor(send, 8); }
                    const int ch = 128 * sl + 16 * c16 + 2 * g8;
                    float* op = out + (size_t)t * ND + ch; const float* g2 = mod + (t / NS) * 6144 + 5120 + ch;
                    const f32x2 o2 = *(const f32x2*)op, gg = *(const f32x2*)g2;
                    *(f32x2*)op = o2 + gg * ((f32x2){r2[0], r2[1]} * (1.f / PEER_VSCALE));
                }
            }
        }
    }
}
__device__ __forceinline__ void ph9b_combine(const Args& a, int bid, int nb) {
    int tid_ = threadIdx.x; asm volatile("" : "+v"(tid_));
    float* GW = (float*)(a.ws + WS_GW); const float* PART = (const float*)(a.ws + WS_PART);
    for (size_t i = (size_t)bid * NTHR + tid_; i < (size_t)NT * 128 / 4; i += (size_t)nb * NTHR) {
        f32x4 sum = ((const f32x4*)PART)[i];
#pragma unroll
        for (int sidx = 1; sidx < 8; ++sidx) sum += ((const f32x4*)(PART + (size_t)sidx * NT * 128))[i];
        const f32x4 g = ((const f32x4*)GW)[i];
        f32x4 w;
#pragma unroll
        for (int j = 0; j < 4; ++j) w[j] = g[j] * gelu_erf(sum[j] * (1.f / PEER_USCALE));
        ((f32x4*)GW)[i] = w;
    }
}

#define LAS __attribute__((address_space(3)))
#define XB_TMO      128
#define XB_XCNT(j)  (256  + 64 * (j))
#define XB_XSUB(j)  (1280 + 64 * (j))
#define XB_XGEN(j)  (2304 + 64 * (j))
#define XB_TOP      3328
#define XB_TOPGEN   3392
#define XCD_BAR_WORDS 3456
#define XB_SPIN_CAP (1u << 18)
__device__ __forceinline__ unsigned xb_ld(unsigned* p)              { return __hip_atomic_load(p, __ATOMIC_RELAXED, __HIP_MEMORY_SCOPE_AGENT); }
__device__ __forceinline__ unsigned xb_add(unsigned* p, unsigned v) { return __hip_atomic_fetch_add(p, v, __ATOMIC_RELAXED, __HIP_MEMORY_SCOPE_AGENT); }
__device__ __forceinline__ unsigned xb_xcc_id() { return (unsigned)__builtin_amdgcn_s_getreg((3 << 11) | 20) & 0xFu; }
#define XB_SPIN(cond, bar) do { unsigned _sp = 0; while (cond) { __builtin_amdgcn_s_sleep(1); \
    if ((++_sp & 255u) == 0u) { if (xb_ld(&(bar)[XB_TMO])) break; if (_sp > XB_SPIN_CAP) { atomicAdd(&(bar)[XB_TMO], 1u); break; } } } } while (0)
struct XcdBarrier { unsigned* bar; unsigned x; volatile LAS unsigned* st; };
__device__ __forceinline__ XcdBarrier xcd_barrier_post(unsigned* bar, volatile LAS unsigned* st) {
    XcdBarrier b; b.bar = bar; b.x = xb_xcc_id(); b.st = st;
    if (threadIdx.x == 0) (void)xb_add(&bar[XB_XCNT(b.x)], 1u);
    return b;
}
__device__ __forceinline__ void xcd_barrier_complete(unsigned* bar, unsigned x, unsigned& nloc, unsigned& nx) {
    const unsigned G = gridDim.x * gridDim.y * gridDim.z;
    unsigned sum, cnt, mine, sp = 0u;
    for (;;) {
        sum = 0u; cnt = 0u; mine = 0u;
#pragma unroll
        for (unsigned j = 0; j < 16; ++j) { const unsigned c = xb_ld(&bar[XB_XCNT(j)]); sum += c; cnt += (c > 0u) ? 1u : 0u; mine = (j == x) ? c : mine; }
        if (sum == G) break;
        __builtin_amdgcn_s_sleep(1);
        if ((++sp & 255u) == 0u) { if (xb_ld(&bar[XB_TMO])) break; if (sp > XB_SPIN_CAP) { atomicAdd(&bar[XB_TMO], 1u); break; } }
    }
    nloc = mine > 0u ? mine : 1u; nx = cnt > 0u ? cnt : 1u;
}
__device__ __forceinline__ void xcd_barrier(const XcdBarrier& b) {
    asm volatile("s_waitcnt vmcnt(0)" ::: "memory");
    __syncthreads();
    if (threadIdx.x == 0) {
        unsigned* bar = b.bar;
        __builtin_amdgcn_s_waitcnt(0);
        unsigned nloc = b.st[0], nx = b.st[1];
        if (nloc == 0u) { xcd_barrier_complete(bar, b.x, nloc, nx); b.st[0] = nloc; b.st[1] = nx; }
        const unsigned old = xb_add(&bar[XB_XSUB(b.x)], 1u);
        const unsigned gen = old / nloc;
        if (old + 1u == (gen + 1u) * nloc) {
            __builtin_amdgcn_fence(__ATOMIC_RELEASE, "agent");
            asm volatile("s_waitcnt vmcnt(0)" ::: "memory");
            const unsigned og = xb_add(&bar[XB_TOP], 1u);
            const unsigned tg = og / nx;
            if (og + 1u == (tg + 1u) * nx) xb_add(&bar[XB_TOPGEN], 1u);
            else XB_SPIN(xb_ld(&bar[XB_TOPGEN]) == tg, bar);
            __builtin_amdgcn_fence(__ATOMIC_ACQUIRE, "agent");
            xb_add(&bar[XB_XGEN(b.x)], 1u);
            asm volatile("s_waitcnt vmcnt(0)" ::: "memory");
        } else {
            XB_SPIN(xb_ld(&bar[XB_XGEN(b.x)]) == gen, bar);
            __builtin_amdgcn_fence(__ATOMIC_ACQUIRE, "agent");
            asm volatile("s_waitcnt vmcnt(0)" ::: "memory");
        }
    }
    __syncthreads();
}

constexpr int N_PHASES = 12;
__global__ void __launch_bounds__(NTHR, 2) mk_fwd(Args a) {
    extern __shared__ __attribute__((aligned(16))) unsigned char lds[];
    cg::grid_group grid = cg::this_grid();
    const int bid = blockIdx.x, nb = gridDim.x;
    const int lo = a.ph_lo, hi = a.ph_hi;
    volatile LAS unsigned* bst = (volatile LAS unsigned*)((LAS unsigned char*)lds + (LDS_BYTES - 16));
    if (threadIdx.x < 4) bst[threadIdx.x] = 0u;
    __syncthreads();
    XcdBarrier xbar = xcd_barrier_post((unsigned*)(a.ws + WS_CTL), bst);
#define SEAM(k) do { if ((k) == 0) grid.sync(); else xcd_barrier(xbar); } while (0)
#define PHASE(k, body) if (lo <= (k) && (k) < hi) { body; if ((k) + 1 < hi) SEAM(k); }
    PHASE(0, ph0_prologue(a, bid, nb, lds))
    PHASE(1, row_norm_mod(a.in[0], a.in[4], (const float*)(a.ws + WS_MOD), 0, 1024, (f16*)(a.ws + WS_H), bid, nb))
    PHASE(2, ph2_inproj(a, bid, nb, lds))
    PHASE(3, ph3_pool_fast(a, bid, nb, lds); ph3_index_fast<0>(a, bid, nb, lds))
    PHASE(4, ph4_attn_fast<0>(a, bid, nb, lds))
    PHASE(5, ph5_outproj(a, bid, nb, lds))
    PHASE(6, row_norm_mod(a.out, a.in[13], (const float*)(a.ws + WS_MOD), 3072, 4096, (f16*)(a.ws + WS_H), bid, nb))
    PHASE(7, ph7_peerq(a, bid, nb, lds))
    PHASE(8, ph8_peersel_fast(a, bid, nb, lds))
    PHASE(9, ph9_sliced<0>(a, lds))
    PHASE(10, ph9b_combine(a, bid, nb))
    PHASE(11, ph9_sliced<1>(a, lds))
#undef PHASE
}

extern "C" void kernel_launch(void* const* d_in, const int* in_sizes, int n_in, void* d_out, int out_size, void* d_ws, size_t ws_size, hipStream_t stream) {
    static int grid = 0;
    if (grid == 0) {
        if (n_in != 18 || out_size != NT * ND || ws_size < WS_END) { fprintf(stderr, "kernel_launch: unexpected shapes (n_in %d out %d ws %zu)\n", n_in, out_size, ws_size); grid = -1; return; }
        int dev = 0, cus = 0, per_cu = 0;
        hipGetDevice(&dev); hipDeviceGetAttribute(&cus, hipDeviceAttributeMultiprocessorCount, dev);
        hipFuncSetAttribute((const void*)mk_fwd, hipFuncAttributeMaxDynamicSharedMemorySize, LDS_BYTES);
        hipOccupancyMaxActiveBlocksPerMultiprocessor(&per_cu, (const void*)mk_fwd, NTHR, LDS_BYTES);
        if (per_cu < 1) { fprintf(stderr, "kernel_launch: occupancy query says %d blocks/CU\n", per_cu); per_cu = 1; }
        grid = cus * 1;
        (void)hipGetLastError();
    }
    if (grid < 0) return;
    if (hipMemsetAsync((char*)d_ws + WS_CTL, 0, 32768, stream) != hipSuccess) { fprintf(stderr, "kernel_launch: memset of the barrier words failed\n"); return; }
    Args a{};
    for (int i = 0; i < 18; ++i) a.in[i] = (const float*)d_in[i];
    a.out = (float*)d_out; a.ws = (unsigned char*)d_ws;
#if MK_MULTI
    for (int ph = 0; ph < N_PHASES; ++ph) { a.ph_lo = ph; a.ph_hi = ph + 1; hipLaunchKernelGGL(mk_fwd, dim3(grid), dim3(NTHR), LDS_BYTES, stream, a); }
#else
    a.ph_lo = 0; a.ph_hi = N_PHASES;
    void* args[] = {&a};
    hipError_t e = hipLaunchCooperativeKernel((const void*)mk_fwd, dim3(grid), dim3(NTHR), args, LDS_BYTES, stream);
    if (e != hipSuccess) fprintf(stderr, "cooperative launch failed: %s (grid %d)\n", hipGetErrorString(e), grid);
#endif
}
```

```cpp
#include <hip/hip_runtime.h>
#include <hip/hip_cooperative_groups.h>
#include <cstdio>
#include <cstdint>
namespace cg = cooperative_groups;

#ifndef MK_MULTI
#define MK_MULTI 0
#endif

typedef _Float16 f16;
typedef _Float16 f16x8 __attribute__((ext_vector_type(8)));
typedef _Float16 f16x4 __attribute__((ext_vector_type(4)));
typedef float f32x4 __attribute__((ext_vector_type(4)));
typedef float f32x16 __attribute__((ext_vector_type(16)));
typedef unsigned long long u64;
typedef unsigned short u16;

constexpr int NB = 8, NS = 8192, ND = 1024, NT = NB * NS;
constexpr int INW = 2632;
constexpr int NMAIN = 2304;
constexpr float EPS = 1e-6f;
constexpr int NTHR = 512, NWAVE = 8;

constexpr size_t MiB = 1u << 20;
constexpr size_t WS_CTL = 0;
constexpr size_t WS_MOD = 1 * MiB;
constexpr size_t WS_WIN = 2 * MiB;
constexpr size_t WS_WVT = 7 * MiB;
constexpr size_t WS_WOUT = 8 * MiB;
constexpr size_t WS_WQ = 10 * MiB;
constexpr size_t WS_SK = 14 * MiB;
constexpr size_t WS_PW = 14 * MiB + 512 * 1024;
constexpr size_t WS_QS = 1 * MiB + 512 * 1024;
constexpr size_t WS_UT = 16 * MiB;
constexpr size_t WS_VP = 48 * MiB;
constexpr size_t WS_H = 80 * MiB;
constexpr size_t WS_U = 208 * MiB;
constexpr size_t WS_Q = 272 * MiB;
constexpr size_t WS_K = 336 * MiB;
constexpr size_t WS_VT = 400 * MiB;
constexpr size_t WS_PQ = 208 * MiB;
constexpr size_t WS_HQ = 464 * MiB;
constexpr size_t WS_HSC = 528 * MiB;
constexpr size_t WS_QI = 464 * MiB;
constexpr size_t WS_KI = 528 * MiB;
constexpr size_t WS_WI = 536 * MiB;
constexpr size_t WS_MASK = 544 * MiB;
constexpr size_t WS_EID = 608 * MiB;
constexpr size_t WS_GW = 624 * MiB;
constexpr size_t WS_END = 656 * MiB;

constexpr int LDS_BYTES = 155648;
constexpr float PEER_QSTEP = 0.3352f;
constexpr float PEER_WSCALE = 16384.f;

struct Args { const float* in[18]; float* out; unsigned char* ws; int ph_lo, ph_hi; };

__host__ __device__ __forceinline__ int pos2log(int p) { return 64 * ((p >> 5) & 3) + 32 * (p >> 7) + 8 * ((p >> 2) & 3) + 4 * ((p >> 4) & 1) + (p & 3); }
__device__ __forceinline__ int maincol(int L) { if (L < 1536) return L; if (L < 2120) return L + 512; return -1; }

__device__ __forceinline__ float wave_sum(float v) {
#pragma unroll
    for (int o = 1; o < 64; o <<= 1) v += __shfl_xor(v, o);
    return v;
}
__device__ __forceinline__ float wave_max(float v) {
#pragma unroll
    for (int o = 1; o < 64; o <<= 1) v = fmaxf(v, __shfl_xor(v, o));
    return v;
}

__device__ void ph0_prologue(const Args& a, int bid, int nb, unsigned char* lds) {
    int tid = threadIdx.x; asm volatile("" : "+v"(tid));
    const float* c = a.in[1]; const float* ada_w = a.in[2]; const float* ada_b = a.in[3];
    float* sil = (float*)lds;
    for (int i = tid; i < NB * ND; i += NTHR) { const float v = c[i]; sil[i] = v / (1.f + __expf(-v)); }
    __syncthreads();
    float* mod = (float*)(a.ws + WS_MOD);
    const int gt = bid * NTHR + tid, ngt = nb * NTHR;
    for (int o = gt; o < NB * 6144; o += ngt) {
        const int b = o / 6144, j = o % 6144;
        float acc = ada_b[j];
        const float* sb = sil + b * ND;
        for (int k = 0; k < ND; ++k) acc += sb[k] * ada_w[(size_t)k * 6144 + j];
        mod[o] = acc;
    }
    const float* w_in = a.in[5]; const float* pool_w = a.in[6]; const float* w_out = a.in[12];
    const float* wq = a.in[14]; const float* sk = a.in[15]; const float* pu = a.in[16]; const float* pv = a.in[17];
    f16* WIN = (f16*)(a.ws + WS_WIN); f16* WVT = (f16*)(a.ws + WS_WVT); f16* WOUT = (f16*)(a.ws + WS_WOUT); f16* WQ = (f16*)(a.ws + WS_WQ);
 unsigned char* UT = a.ws + WS_UT; unsigned char* VP = a.ws + WS_VP;
    {
        __syncthreads();
        const int lane = tid & 63, wv_ = tid >> 6;
        float* scr = (float*)lds + wv_ * (64 * 33);
        constexpr int I_WQ = 16 * 64, I_Z = 16 * 16, I_INR = 16 * (NMAIN / 32 - 16), I_VT = 16 * 16, I_OUT = 16 * 32, I_ALL = I_WQ + I_Z + I_INR + I_VT + I_OUT;
        for (int it = bid * NWAVE + wv_; it < I_ALL; it += nb * NWAVE) {
            int rr = it, kind = 3, pboff = 0;
            if (rr >= I_WQ) { rr -= I_WQ; kind = 0;
                if (rr >= I_Z) { rr -= I_Z; pboff = 16;
                    if (rr >= I_INR) { rr -= I_INR; kind = 1; pboff = 0; if (rr >= I_VT) { rr -= I_VT; kind = 2; } } } }
            const int npb = kind == 0 ? (pboff ? NMAIN / 32 - 16 : 16) : kind == 1 ? 16 : kind == 2 ? 32 : 64;
            const int k0 = (rr / npb) * 64, p0 = (rr % npb + pboff) * 32, p = p0 + (lane & 31);
            const float* W = kind <= 1 ? w_in : kind == 2 ? w_out : wq; const int ldw = kind <= 1 ? INW : kind == 2 ? 1024 : 2048;
            int col;
            if (kind == 0) col = maincol((p & ~255) + pos2log(p & 255)); else if (kind == 1) col = 1536 + p; else col = (p & ~255) + pos2log(p & 255);
            const bool foldz = (kind == 0 && pboff == 0);
            if (foldz || kind == 3) {
                const int r5 = lane & 31, hh_ = lane >> 5;
                const int blk = __builtin_amdgcn_readfirstlane(col >> 7);
                const int sub = col & 127;
                const float* arow = W + (size_t)(k0 + r5) * ldw + blk * 128 + 8 * hh_;
                f32x16 acc0 = (f32x16){0.f, 0.f, 0.f, 0.f, 0.f, 0.f, 0.f, 0.f, 0.f, 0.f, 0.f, 0.f, 0.f, 0.f, 0.f, 0.f}, acc1 = acc0;
#pragma unroll 2
                for (int ks = 0; ks < 8; ++ks) {
                    const f32x4 a00 = *(const f32x4*)(arow + 16 * ks), a01 = *(const f32x4*)(arow + 16 * ks + 4);
                    const f32x4 a10 = *(const f32x4*)(arow + (size_t)32 * ldw + 16 * ks), a11 = *(const f32x4*)(arow + (size_t)32 * ldw + 16 * ks + 4);
                    f16x8 bfr;
                    if (kind == 3) { const float* br = sk + (size_t)(blk * 128 + sub) * 128 + 16 * ks + 8 * hh_; const f32x4 b0 = *(const f32x4*)br, b1 = *(const f32x4*)(br + 4);
                        bfr = (f16x8){(f16)b0[0], (f16)b0[1], (f16)b0[2], (f16)b0[3], (f16)b1[0], (f16)b1[1], (f16)b1[2], (f16)b1[3]}; }
                    else { const float* br = pool_w + (size_t)blk * 16384 + (size_t)(16 * ks + 8 * hh_) * 128 + sub;
                        bfr = (f16x8){(f16)br[0], (f16)br[128], (f16)br[256], (f16)br[384], (f16)br[512], (f16)br[640], (f16)br[768], (f16)br[896]}; }
                    const f16x8 af0 = (f16x8){(f16)a00[0], (f16)a00[1], (f16)a00[2], (f16)a00[3], (f16)a01[0], (f16)a01[1], (f16)a01[2], (f16)a01[3]};
                    const f16x8 af1 = (f16x8){(f16)a10[0], (f16)a10[1], (f16)a10[2], (f16)a10[3], (f16)a11[0], (f16)a11[1], (f16)a11[2], (f16)a11[3]};
                    acc0 = __builtin_amdgcn_mfma_f32_32x32x16_f16(af0, bfr, acc0, 0, 0, 0);
                    acc1 = __builtin_amdgcn_mfma_f32_32x32x16_f16(af1, bfr, acc1, 0, 0, 0);
                }
#pragma unroll
                for (int rg = 0; rg < 16; ++rg) { const int kk = (rg & 3) + 8 * (rg >> 2) + 4 * hh_; scr[kk * 33 + r5] = acc0[rg]; scr[(32 + kk) * 33 + r5] = acc1[rg]; }
            } else {
#pragma unroll 8
                for (int i = 0; i < 32; ++i) { const int kk = 2 * i + (lane >> 5); scr[kk * 33 + (lane & 31)] = col >= 0 ? W[(size_t)(k0 + kk) * ldw + col] : 0.f; }
            }
            f16* WT = kind == 0 ? WIN : kind == 1 ? WVT : kind == 2 ? WOUT : WQ;
            const int c8 = lane & 7;
#pragma unroll
            for (int j = 0; j < 4; ++j) { const int n = (lane >> 3) + 8 * j; const float* sp = scr + (8 * c8) * 33 + n;
                *(f16x8*)(WT + (size_t)(p0 + n) * ND + k0 + 8 * c8) = (f16x8){(f16)sp[0], (f16)sp[33], (f16)sp[66], (f16)sp[99], (f16)sp[132], (f16)sp[165], (f16)sp[198], (f16)sp[231]}; }
        }
    }
    {
        __syncthreads();
        float ssu = 0.f, ssv = 0.f;
        for (int i = tid; i < 64 * 1024 / 4; i += NTHR) { const f32x4 u = ((const f32x4*)pu)[i], v = ((const f32x4*)pv)[i];
            ssu += u.x * u.x + u.y * u.y + u.z * u.z + u.w * u.w; ssv += v.x * v.x + v.y * v.y + v.z * v.z + v.w * v.w; }
        ssu = wave_sum(ssu); ssv = wave_sum(ssv);
        float* red = (float*)lds;
        if ((tid & 63) == 0) { red[tid >> 6] = ssu; red[8 + (tid >> 6)] = ssv; }
        __syncthreads();
        float tu = 0.f, tv = 0.f;
#pragma unroll
        for (int w = 0; w < 8; ++w) { tu += red[w]; tv += red[8 + w]; }
        const float du = PEER_QSTEP * sqrtf(tu * (1.f / 65536.f)), dv = PEER_QSTEP * sqrtf(tv * (1.f / 65536.f));
        if (bid == 0 && tid == 0) { float* qs = (float*)(a.ws + WS_QS); qs[0] = du; qs[1] = dv; }
        const float idu = 1.f / du, idv = 1.f / dv;
        const int lane = tid & 63, wv_ = tid >> 6;
        for (int row = bid * NWAVE + wv_; row < 2 * 16384; row += nb * NWAVE) {
            const bool isv = row >= 16384; const int e = row & 16383;
            const float* src = (isv ? pv : pu) + (size_t)e * ND + 4 * lane; u16* dstq = (u16*)((isv ? VP : UT) + (size_t)e * 512) + lane;
            const float inv = isv ? idv : idu; const int off = isv ? 8 : 0;
#pragma unroll
            for (int j = 0; j < 4; ++j) { const f32x4 x4 = *(const f32x4*)(src + 256 * j); unsigned pk = 0u;
#pragma unroll
                for (int k = 0; k < 4; ++k) { int q = (int)floorf(x4[k] * inv); q = q < -8 ? -8 : q > 7 ? 7 : q; pk |= (unsigned)((q + off) & 15) << (4 * k); }
                dstq[64 * j] = (u16)pk; }
        }
    }
}

__device__ void row_norm_mod(const float* src, const float* g, const float* mod, int sh_off, int sc_off, f16* dst, int bid, int nb) {
    int tid_ = threadIdx.x; asm volatile("" : "+v"(tid_)); const int lane = tid_ & 63, wave = tid_ >> 6;
    for (int row = bid * NWAVE + wave; row < NT; row += nb * NWAVE) {
        const int b = row / NS;
        const f32x4* xr = (const f32x4*)(src + (size_t)row * ND) + lane;
        f32x4 v[4]; float s = 0.f;
#pragma unroll
        for (int j = 0; j < 4; ++j) { v[j] = xr[64 * j]; s += v[j].x * v[j].x + v[j].y * v[j].y + v[j].z * v[j].z + v[j].w * v[j].w; }
        const float rstd = rsqrtf(wave_sum(s) * (1.f / ND) + EPS);
#pragma unroll
        for (int j = 0; j < 4; ++j) {
            const int col = lane * 4 + 256 * j;
            const f32x4 gg = *(const f32x4*)(g + col), sc = *(const f32x4*)(mod + b * 6144 + sc_off + col), sh = *(const f32x4*)(mod + b * 6144 + sh_off + col);
            f16x4 o;
            o.x = (f16)(v[j].x * rstd * gg.x * (1.f + sc.x) + sh.x); o.y = (f16)(v[j].y * rstd * gg.y * (1.f + sc.y) + sh.y);
            o.z = (f16)(v[j].z * rstd * gg.z * (1.f + sc.z) + sh.z); o.w = (f16)(v[j].w * rstd * gg.w * (1.f + sc.w) + sh.w);
            *(f16x4*)(dst + (size_t)row * ND + col) = o;
        }
    }
}


__device__ void row_norm_mod_q(const float* src, const float* g, const float* mod, int sh_off, int sc_off, f16* dst, unsigned* hq, float* hsc, int bid, int nb) {
    int tid_ = threadIdx.x; asm volatile("" : "+v"(tid_)); const int lane = tid_ & 63, wave = tid_ >> 6;
    for (int row = bid * NWAVE + wave; row < NT; row += nb * NWAVE) {
        const int b = row / NS;
        const float* xr = src + (size_t)row * ND + 8 * lane;
        f32x4 v[4]; float s = 0.f;
#pragma unroll
        for (int j = 0; j < 4; ++j) { v[j] = *(const f32x4*)(xr + 512 * (j >> 1) + 4 * (j & 1)); s += v[j].x * v[j].x + v[j].y * v[j].y + v[j].z * v[j].z + v[j].w * v[j].w; }
        const float rstd = rsqrtf(wave_sum(s) * (1.f / ND) + EPS);
        float o[16]; float am = 0.f;
#pragma unroll
        for (int j = 0; j < 4; ++j) {
            const int col = 8 * lane + 512 * (j >> 1) + 4 * (j & 1);
            const f32x4 gg = *(const f32x4*)(g + col), sc = *(const f32x4*)(mod + b * 6144 + sc_off + col), sh = *(const f32x4*)(mod + b * 6144 + sh_off + col);
#pragma unroll
            for (int k = 0; k < 4; ++k) { const float y = v[j][k] * rstd * gg[k] * (1.f + sc[k]) + sh[k]; o[4 * j + k] = y; am = fmaxf(am, fabsf(y)); }
        }
        am = wave_max(am);
        const float inv = am > 0.f ? 119.f / am : 0.f;
#pragma unroll
        for (int j = 0; j < 2; ++j) {
            *(f16x8*)(dst + (size_t)row * ND + 8 * lane + 512 * j) = (f16x8){(f16)o[8 * j], (f16)o[8 * j + 1], (f16)o[8 * j + 2], (f16)o[8 * j + 3], (f16)o[8 * j + 4], (f16)o[8 * j + 5], (f16)o[8 * j + 6], (f16)o[8 * j + 7]};
            unsigned ph = 0u, pl = 0u;
#pragma unroll
            for (int k = 0; k < 8; ++k) { const int q = (int)rintf(o[8 * j + k] * inv); const int l = ((q + 8) & 15) - 8; const int h = (q - l) >> 4;
                ph |= (unsigned)(h & 15) << (4 * k); pl |= (unsigned)(l & 15) << (4 * k); }
            hq[(size_t)row * 256 + lane + 64 * j] = ph; hq[(size_t)row * 256 + 128 + lane + 64 * j] = pl;
        }
        if (lane == 0) hsc[row] = am * (1.f / 119.f);
    }
}

namespace pg8 {
#define PG8_LAS __attribute__((address_space(3)))
constexpr int BM = 256, BK = 64, HALF = 128, HTB = HALF * BK * 2, STAGE_BYTES = 8 * HTB, NXCD = 8, WGM = 8;
__host__ __device__ __forceinline__ int lds_byte(int r, int c) { const int st = (r >> 4) * 2 + (c >> 5), rr = r & 15, cc = c & 31, ob = rr * 64 + cc * 2; return st * 1024 + (ob ^ (((ob >> 9) & 1) << 5)); }
__host__ __device__ __forceinline__ void stage_rc(int b, int& R, int& C) { const int st = b / 1024, sb = b % 1024, swz = sb ^ (((sb >> 9) & 1) << 5); R = (st >> 1) * 16 + swz / 64; C = (st & 1) * 32 + (swz % 64) / 2; }
struct Unit { int pm, pn; };
struct Gemm { const f16* A; const f16* Bt; int M, N, K; };
struct StaticOrder {
    int nM, nN, nwg, G, c;
    __host__ __device__ void init(int M, int N, int G_, int c_) { nM = M / BM; nN = N / BM; nwg = nM * nN; G = G_; c = c_; }
    __host__ __device__ bool next(int i, Unit& u) const {
        const long L = (long)i * G + c; if (L >= nwg) return false;
        int wgid = (int)L; { const int q = nwg / NXCD, r = nwg % NXCD, xcd = wgid % NXCD, off = wgid / NXCD; wgid = (xcd < r ? xcd * (q + 1) : r * (q + 1) + (xcd - r) * q) + off; }
        const int nig = WGM * nN, gid = wgid / nig, fm = gid * WGM, gsz = (nM - fm) < WGM ? (nM - fm) : WGM;
        u.pm = fm + ((wgid % nig) % gsz); u.pn = (wgid % nig) / gsz; return true;
    }
};
template <class Epi>
__device__ __forceinline__ void gemm_phase(PG8_LAS unsigned char* lds, const Gemm g, const StaticOrder& S, const Epi& E) {
    int tid = threadIdx.x; asm volatile("" : "+v"(tid));
    const int wid = __builtin_amdgcn_readfirstlane(tid >> 6), lane = tid & 63, wr = wid >> 2, wc = wid & 3, fr = lane & 15, fq = lane >> 4;
    const int K = g.K, nt = K / BK;
    unsigned voffA[2];
#pragma unroll
    for (int i = 0; i < 2; ++i) { int R, C; stage_rc(tid * 16 + i * 8192, R, C); voffA[i] = (unsigned)(R * K + C) * 2u; }
    const size_t kstep = (size_t)(BK * 2);
    const size_t hstep = (size_t)HALF * K * 2;
    const size_t tstep = 2 * hstep;
    const unsigned ldsw = (unsigned)wid * 1024u;
    const int aoff = lds_byte(wr * 64 + fr, fq * 8), boff = lds_byte(wc * 32 + fr, fq * 8);
#define PG8_SA(b, h) (((b) * 2 + (h)) * HTB)
#define PG8_SB(b, h) ((4 + (b) * 2 + (h)) * HTB)
#define PG8_STAGE(bufoff, gbase, voff) do { _Pragma("unroll") for (int _i = 0; _i < 2; ++_i) \
        __builtin_amdgcn_global_load_lds((const unsigned*)((const char*)(gbase) + (voff)[_i]), (PG8_LAS unsigned*)(lds + (bufoff) + ldsw + _i * 8192), 16, 0, 0); } while (0)
#define PG8_LDA(dst, b, h) do { _Pragma("unroll") for (int m = 0; m < 4; ++m) _Pragma("unroll") for (int k = 0; k < 2; ++k) dst[m][k] = *(const PG8_LAS f16x8*)(lds + PG8_SA(b, h) + aoff + m * 2048 + k * 1024); } while (0)
#define PG8_LDB(dst, b, h) do { _Pragma("unroll") for (int n = 0; n < 2; ++n) _Pragma("unroll") for (int k = 0; k < 2; ++k) dst[n][k] = *(const PG8_LAS f16x8*)(lds + PG8_SB(b, h) + boff + n * 2048 + k * 1024); } while (0)
#define PG8_MMA(ai, bj, At, Bt) do { __builtin_amdgcn_s_setprio(1); _Pragma("unroll") for (int m = 0; m < 4; ++m) _Pragma("unroll") for (int n = 0; n < 2; ++n) _Pragma("unroll") for (int k = 0; k < 2; ++k) \
        acc[ai][bj][m][n] = __builtin_amdgcn_mfma_f32_16x16x32_f16(Bt[n][k], At[m][k], acc[ai][bj][m][n], 0, 0, 0); __builtin_amdgcn_s_setprio(0); } while (0)
#define PG8_WAIT_V(n) asm volatile("s_waitcnt vmcnt(" #n ")" ::: "memory")
#define PG8_WAIT_L(n) asm volatile("s_waitcnt lgkmcnt(" #n ")" ::: "memory")
#define PG8_BAR __builtin_amdgcn_s_barrier()
#define PG8_SCHED __builtin_amdgcn_sched_barrier(0)
    Unit cur, nxt; int ui = 0;
    if (!S.next(0, cur)) return;
    f32x4 acc[2][2][4][2];
#pragma unroll
    for (int a = 0; a < 2; ++a)
#pragma unroll
        for (int b = 0; b < 2; ++b)
#pragma unroll
            for (int m = 0; m < 4; ++m)
#pragma unroll
                for (int n = 0; n < 2; ++n) acc[a][b][m][n] = (f32x4){0.f, 0.f, 0.f, 0.f};
    f16x8 At[4][2], B0[2][2], B1[2][2];
    const char* cA = (const char*)g.A + (size_t)cur.pm * tstep; const char* cB = (const char*)g.Bt + (size_t)cur.pn * tstep;
    PG8_STAGE(PG8_SB(0, 0), cB, voffA); PG8_STAGE(PG8_SB(0, 1), cB + hstep, voffA); PG8_STAGE(PG8_SA(0, 0), cA, voffA); PG8_STAGE(PG8_SA(0, 1), cA + hstep, voffA);
    if (wr == 1) PG8_BAR;
    PG8_WAIT_V(2); PG8_BAR;
    PG8_STAGE(PG8_SB(1, 0), cB + kstep, voffA); PG8_STAGE(PG8_SA(1, 0), cA + kstep, voffA); PG8_STAGE(PG8_SB(1, 1), cB + hstep + kstep, voffA);
    PG8_WAIT_V(6); PG8_BAR;
    for (;;) {
        const bool has_next = S.next(ui + 1, nxt);
        const char* nA = has_next ? (const char*)g.A + (size_t)nxt.pm * tstep : cA; const char* nB = has_next ? (const char*)g.Bt + (size_t)nxt.pn * tstep : cB;
        for (int t = 0; t < nt; t += 2) {
            const bool last = (t == nt - 2);
            const char* a1 = cA + (size_t)(t + 1) * kstep;
            const char* a2 = last ? nA : cA + (size_t)(t + 2) * kstep; const char* b2 = last ? nB : cB + (size_t)(t + 2) * kstep;
            const char* a3 = a2 + kstep; const char* b3 = b2 + kstep;
            PG8_LDB(B0, 0, 0); PG8_LDB(B1, 0, 1); PG8_SCHED; PG8_LDA(At, 0, 0); PG8_STAGE(PG8_SA(1, 1), a1 + hstep, voffA);
            PG8_WAIT_V(8); PG8_WAIT_L(0); PG8_BAR; PG8_MMA(0, 0, At, B0); PG8_MMA(0, 1, At, B1); PG8_BAR; PG8_SCHED;
            PG8_LDA(At, 0, 1); PG8_STAGE(PG8_SB(0, 0), b2, voffA); PG8_STAGE(PG8_SB(0, 1), b2 + hstep, voffA); PG8_STAGE(PG8_SA(0, 0), a2, voffA);
            PG8_WAIT_V(8); PG8_WAIT_L(0); PG8_BAR; PG8_MMA(1, 0, At, B0); PG8_MMA(1, 1, At, B1); PG8_BAR; PG8_SCHED;
            PG8_LDB(B0, 1, 0); PG8_LDB(B1, 1, 1); PG8_SCHED; PG8_LDA(At, 1, 0); PG8_STAGE(PG8_SA(0, 1), a2 + hstep, voffA);
            PG8_WAIT_V(8); PG8_WAIT_L(0); PG8_BAR; PG8_MMA(0, 0, At, B0); PG8_MMA(0, 1, At, B1); PG8_BAR; PG8_SCHED;
            PG8_LDA(At, 1, 1); PG8_STAGE(PG8_SB(1, 0), b3, voffA); PG8_STAGE(PG8_SB(1, 1), b3 + hstep, voffA); PG8_STAGE(PG8_SA(1, 0), a3, voffA);
            PG8_WAIT_V(8); PG8_WAIT_L(0); PG8_BAR; PG8_MMA(1, 0, At, B0); PG8_MMA(1, 1, At, B1); PG8_BAR; PG8_SCHED;
        }
        if (wr == 0) PG8_BAR;
        E(acc, cur, wr, wc, fr, fq);
        if (!has_next) break;
#pragma unroll
        for (int a = 0; a < 2; ++a)
#pragma unroll
            for (int b = 0; b < 2; ++b)
#pragma unroll
                for (int m = 0; m < 4; ++m)
#pragma unroll
                    for (int n = 0; n < 2; ++n) acc[a][b][m][n] = (f32x4){0.f, 0.f, 0.f, 0.f};
        cur = nxt; cA = nA; cB = nB; ++ui;
        if (wr == 1) PG8_BAR;
    }
    PG8_WAIT_V(0);
    PG8_BAR;
#undef PG8_SA
#undef PG8_SB
#undef PG8_STAGE
#undef PG8_LDA
#undef PG8_LDB
#undef PG8_MMA
#undef PG8_WAIT_V
#undef PG8_WAIT_L
#undef PG8_BAR
#undef PG8_SCHED
}

typedef f32x4 Acc[2][2][4][2];
struct EpiMain {
    unsigned char* ws; const float *qg, *kg;
    __device__ __forceinline__ void operator()(const Acc& acc, const Unit& u, int wr, int wc, int fr, int fq) const {
        const int row0 = u.pm * BM + wr * 64 + fr, pn = u.pn;
        if (pn == 8) {
            if (wc == 0) {
#pragma unroll
                for (int ai = 0; ai < 2; ++ai)
#pragma unroll
                    for (int m = 0; m < 4; ++m) { const size_t row = row0 + ai * HALF + m * 16;
#pragma unroll
                        for (int bj = 0; bj < 2; ++bj) { const f32x4 v0 = acc[ai][bj][m][0], v1 = acc[ai][bj][m][1];
                            *(f16x8*)((f16*)(ws + WS_KI) + (((row >> 5) * 8 + 4 * bj + fq) * 32 + (row & 31)) * 8) = (f16x8){(f16)v0[0], (f16)v0[1], (f16)v0[2], (f16)v0[3], (f16)v1[0], (f16)v1[1], (f16)v1[2], (f16)v1[3]}; } }
            } else if (wc == 1 && fq == 0) {
#pragma unroll
                for (int ai = 0; ai < 2; ++ai)
#pragma unroll
                    for (int m = 0; m < 4; ++m) { const size_t row = row0 + ai * HALF + m * 16;
                        *(f32x4*)((float*)(ws + WS_WI) + row * 8) = acc[ai][0][m][0] * 0.35355339059327373f; *(f32x4*)((float*)(ws + WS_WI) + row * 8 + 4) = acc[ai][0][m][1] * 0.35355339059327373f; }
            }
            return;
        }
        const int kind = pn >> 1;
        f16* base = (f16*)(ws + (kind == 0 ? WS_U : kind == 1 ? WS_Q : kind == 2 ? WS_K : WS_QI));
        const int col0 = (pn & 1) * 256 + 64 * wc + 8 * fq;
        if (kind == 1 || kind == 2) {
            const float* gp = (kind == 1 ? qg : kg) + 8 * fq;
#pragma unroll
            for (int ai = 0; ai < 2; ++ai)
#pragma unroll
                for (int m = 0; m < 4; ++m) { const size_t row = row0 + ai * HALF + m * 16;
                    float ss = 0.f;
#pragma unroll
                    for (int bj = 0; bj < 2; ++bj)
#pragma unroll
                        for (int n = 0; n < 2; ++n) { const f32x4 v = acc[ai][bj][m][n]; ss += v[0] * v[0] + v[1] * v[1] + v[2] * v[2] + v[3] * v[3]; }
                    ss += __shfl_xor(ss, 16); ss += __shfl_xor(ss, 32);
                    const float rstd = rsqrtf(ss * (1.f / 64.f) + EPS);
#pragma unroll
                    for (int bj = 0; bj < 2; ++bj) { const f32x4 v0 = acc[ai][bj][m][0] * rstd * *(const f32x4*)(gp + 32 * bj), v1 = acc[ai][bj][m][1] * rstd * *(const f32x4*)(gp + 32 * bj + 4);
                        *(f16x8*)(base + row * 512 + col0 + 32 * bj) = (f16x8){(f16)v0[0], (f16)v0[1], (f16)v0[2], (f16)v0[3], (f16)v1[0], (f16)v1[1], (f16)v1[2], (f16)v1[3]}; }
                    asm volatile("" ::: "memory"); }
        } else if (kind == 3) {
            const int hd = (pn & 1) * 4 + wc;
#pragma unroll
            for (int ai = 0; ai < 2; ++ai)
#pragma unroll
                for (int m = 0; m < 4; ++m) { const size_t row = row0 + ai * HALF + m * 16; const int ql = (int)(row & 7);
                    const int rr = (hd & 3) | (((ql >> 1) & 1) << 2) | ((hd >> 2) << 3) | ((ql & 1) << 4);
#pragma unroll
                    for (int bj = 0; bj < 2; ++bj) { const f32x4 v0 = acc[ai][bj][m][0], v1 = acc[ai][bj][m][1]; const int chunk = fq + 4 * bj;
                        *(f16x8*)(base + ((((((row >> 3) * 2 + (ql >> 2)) * 4 + (chunk >> 1)) * 2 + (chunk & 1)) * 32 + rr) << 3)) = (f16x8){(f16)v0[0], (f16)v0[1], (f16)v0[2], (f16)v0[3], (f16)v1[0], (f16)v1[1], (f16)v1[2], (f16)v1[3]}; } }
        } else {
#pragma unroll
            for (int ai = 0; ai < 2; ++ai)
#pragma unroll
                for (int m = 0; m < 4; ++m) { const size_t row = row0 + ai * HALF + m * 16;
#pragma unroll
                    for (int bj = 0; bj < 2; ++bj) { const f32x4 v0 = acc[ai][bj][m][0], v1 = acc[ai][bj][m][1];
                        *(f16x8*)(base + row * 512 + col0 + 32 * bj) = (f16x8){(f16)v0[0], (f16)v0[1], (f16)v0[2], (f16)v0[3], (f16)v1[0], (f16)v1[1], (f16)v1[2], (f16)v1[3]}; } }
        }
    }
};
struct EpiVT {
    f16* VT;
    __device__ __forceinline__ void operator()(const Acc& acc, const Unit& u, int wr, int wc, int fr, int fq) const {
        const int row0 = u.pm * BM + wr * 64 + fr, col0 = u.pn * BM + 32 * wc + 4 * fq;
#pragma unroll
        for (int ai = 0; ai < 2; ++ai)
#pragma unroll
            for (int m = 0; m < 4; ++m) { const size_t row = row0 + ai * HALF + m * 16;
#pragma unroll
                for (int bj = 0; bj < 2; ++bj)
#pragma unroll
                    for (int n = 0; n < 2; ++n) { const f32x4 v = acc[ai][bj][m][n];
                        *(f16x4*)(VT + row * NT + col0 + 128 * bj + 16 * n) = (f16x4){(f16)v[0], (f16)v[1], (f16)v[2], (f16)v[3]}; } }
    }
};
struct EpiOut {
    const float* x; const float* mod; float* out;
    __device__ __forceinline__ void operator()(const Acc& acc, const Unit& u, int wr, int wc, int fr, int fq) const {
        const int row0 = u.pm * BM + wr * 64 + fr, col0 = u.pn * BM + 64 * wc + 8 * fq;
        const float* g1 = mod + ((u.pm * BM) / NS) * 6144 + 2048 + col0;
        f32x4 g4[2][2];
#pragma unroll
        for (int bj = 0; bj < 2; ++bj)
#pragma unroll
            for (int n = 0; n < 2; ++n) g4[bj][n] = *(const f32x4*)(g1 + 32 * bj + 4 * n);
#pragma unroll
        for (int ai = 0; ai < 2; ++ai)
#pragma unroll
            for (int m = 0; m < 4; ++m) { const size_t off = (size_t)(row0 + ai * HALF + m * 16) * ND + col0;
#pragma unroll
                for (int bj = 0; bj < 2; ++bj)
#pragma unroll
                    for (int n = 0; n < 2; ++n) { const f32x4 xv = *(const f32x4*)(x + off + 32 * bj + 4 * n);
                        *(f32x4*)(out + off + 32 * bj + 4 * n) = xv + g4[bj][n] * acc[ai][bj][m][n]; } }
    }
};
struct EpiPQ {
    f16* PQ;
    __device__ __forceinline__ void operator()(const Acc& acc, const Unit& u, int wr, int wc, int fr, int fq) const {
        const int row0 = u.pm * BM + wr * 64 + fr, col0 = u.pn * BM + 64 * wc + 8 * fq;
#pragma unroll
        for (int ai = 0; ai < 2; ++ai)
#pragma unroll
            for (int m = 0; m < 4; ++m) { const size_t row = row0 + ai * HALF + m * 16;
#pragma unroll
                for (int bj = 0; bj < 2; ++bj) { const f32x4 v0 = acc[ai][bj][m][0], v1 = acc[ai][bj][m][1];
                    *(f16x8*)(PQ + ((((row >> 5) * 256 + ((col0 + 32 * bj) >> 3)) * 32 + (row & 31)) << 3)) = (f16x8){(f16)v0[0], (f16)v0[1], (f16)v0[2], (f16)v0[3], (f16)v1[0], (f16)v1[1], (f16)v1[2], (f16)v1[3]}; } }
    }
};
}

__device__ __forceinline__ void ph2_inproj(const Args& a, int bid, int nb, unsigned char* lds) {
    const f16* H = (const f16*)(a.ws + WS_H); const f16* WIN = (const f16*)(a.ws + WS_WIN); const f16* WVT = (const f16*)(a.ws + WS_WVT);
    PG8_LAS unsigned char* l3 = (PG8_LAS unsigned char*)lds;
    { pg8::Gemm g{H, WIN, NT, NMAIN, ND}; pg8::StaticOrder S; S.init(NT, NMAIN, nb, bid);
      pg8::EpiMain E{a.ws, a.in[9], a.in[10]};
      pg8::gemm_phase(l3, g, S, E); }
    { pg8::Gemm g{WVT, H, 512, NT, ND}; pg8::StaticOrder S; S.init(512, NT, nb, bid);
      pg8::EpiVT E{(f16*)(a.ws + WS_VT)};
      pg8::gemm_phase(l3, g, S, E); }
}


constexpr int PPITCH = 1040;
__device__ __forceinline__ void ph3_pool_fast(const Args& a, int bid, int nb, unsigned char* lds) {
    int tid = threadIdx.x; asm volatile("" : "+v"(tid));
    const int cg8 = tid & 63, tq = tid >> 6, gch = cg8 >> 4, win = 2 << gch;
    const f16* Z = (const f16*)(a.ws + WS_U); f16* MIX = (f16*)(a.ws + WS_H);
    const f32x4 ps0 = *(const f32x4*)(a.in[7] + 8 * cg8), ps1 = *(const f32x4*)(a.in[7] + 8 * cg8 + 4), pg0 = *(const f32x4*)(a.in[8] + 8 * cg8), pg1 = *(const f32x4*)(a.in[8] + 8 * cg8 + 4);
    const float psc[8] = {ps0[0], ps0[1], ps0[2], ps0[3], ps1[0], ps1[1], ps1[2], ps1[3]}, pgn[8] = {pg0[0], pg0[1], pg0[2], pg0[3], pg1[0], pg1[1], pg1[2], pg1[3]};
    for (int item = bid; item < NT / 32; item += nb) {
        const int tb = item * 32 + 4 * tq, tl0 = tb % NS;
        const f16* up = Z + (size_t)(tb - tl0) * 512 + 8 * cg8;
        float sm[8];
#pragma unroll
        for (int j = 0; j < 8; ++j) sm[j] = 0.f;
        f16x8 hist_[15];
#pragma unroll
        for (int q = 0; q < 15; ++q) { const int rr = tl0 - 15 + q; hist_[q] = (q >= 16 - win && rr >= 0) ? *(const f16x8*)(up + (size_t)rr * 512) : (f16x8){0, 0, 0, 0, 0, 0, 0, 0}; }
        f16x8 cur_[4];
#pragma unroll
        for (int k = 0; k < 4; ++k) cur_[k] = *(const f16x8*)(up + (size_t)(tl0 + k) * 512);
#pragma unroll
        for (int q = 0; q < 15; ++q)
#pragma unroll
            for (int j = 0; j < 8; ++j) sm[j] += (float)hist_[q][j];
#pragma unroll
        for (int k = 0; k < 4; ++k) {
            const int tl = tl0 + k;
            const float ic = 1.f / (float)((tl + 1 < win) ? tl + 1 : win);
            float v[8]; float ss = 0.f;
#pragma unroll
            for (int j = 0; j < 8; ++j) { sm[j] += (float)cur_[k][j]; v[j] = (sm[j] * ic - (float)cur_[k][j]) * psc[j]; ss += v[j] * v[j]; }
            const float rstd = rsqrtf(wave_sum(ss) * (1.f / 512.f) + EPS);
            f16x8 o;
#pragma unroll
            for (int j = 0; j < 8; ++j) o[j] = (f16)(v[j] * rstd * pgn[j]);
            *(f16x8*)(MIX + (size_t)(tb + k) * ND + 8 * cg8) = o;
            if (k < 3) {
#pragma unroll
                for (int j = 0; j < 8; ++j) {
                    const int q = 16 - win + k;
                    float dv = 0.f;
#pragma unroll
                    for (int qq = 0; qq < 15; ++qq) if (qq == q) dv = (float)hist_[qq][j];
#pragma unroll
                    for (int kk = 0; kk < 3; ++kk) if (q == 15 + kk) dv = (float)cur_[kk][j];
                    sm[j] -= dv;
                }
            }
        }
    }
}


typedef float f32x2 __attribute__((ext_vector_type(2)));
typedef unsigned u32x4 __attribute__((ext_vector_type(4)));

constexpr int IDX_KPITCH = 16384 + 16;
constexpr int IDX_HPITCH = 516;
template <int NBL>
__device__ __forceinline__ int wave_pick(const unsigned (&cc)[NBL], unsigned target, int lane, unsigned& rem_out) {
    unsigned tot = 0u;
#pragma unroll
    for (int j = 0; j < NBL; ++j) tot += cc[j];
    unsigned S = tot;
#pragma unroll
    for (int o = 1; o < 64; o <<= 1) { const unsigned v = __shfl_down(S, o); if (lane + o < 64) S += v; }
    const unsigned above = S - tot;
    const bool hit = (above < target) && (S >= target);
    const u64 bal = __ballot(hit);
    const int L = bal ? __builtin_ctzll(bal) : 0;
    int bin = 0; unsigned rem = target;
    { unsigned run = above; bool done = false;
#pragma unroll
      for (int j = NBL - 1; j >= 0; --j) { if (!done) { if (run + cc[j] >= target) { bin = NBL * lane + j; rem = target - run; done = true; } else run += cc[j]; } } }
    bin = __shfl(bin, L); rem_out = __shfl(rem, L);
    return bin;
}
template <int MODE>
__device__ __forceinline__ void ph3_index_fast(const Args& a, int bid, int nb, unsigned char* lds) {
    int tid = threadIdx.x; asm volatile("" : "+v"(tid));
    const int lane = tid & 63, wave = __builtin_amdgcn_readfirstlane(tid >> 6), r = lane & 31, hh = lane >> 5;
    const f16* QI = (const f16*)(a.ws + WS_QI); const f16* KI = (const f16*)(a.ws + WS_KI); const float* WI = (const float*)(a.ws + WS_WI);
    u64* MASK = (u64*)(a.ws + WS_MASK);
    unsigned* hist = (unsigned*)(lds + 8 * IDX_KPITCH);
    f16x8 af[2][4]; f32x2 wv2[2][8];
#define IDX_LOAD_FRAGS(t0_) do { \
        _Pragma("unroll") for (int rt = 0; rt < 2; ++rt) { \
            _Pragma("unroll") for (int ks = 0; ks < 4; ++ks) af[rt][ks] = *(const f16x8*)(QI + ((((((size_t)((t0_) >> 3) * 2 + rt) * 4 + ks) * 2 + hh) * 32 + r) << 3)); \
            _Pragma("unroll") for (int qq = 0; qq < 2; ++qq) { const float* wp = WI + (size_t)((t0_) + 4 * rt + 2 * hh + qq) * 8; const f32x4 w0 = *(const f32x4*)wp * 0.125f, w1 = *(const f32x4*)(wp + 4) * 0.125f; \
                wv2[rt][4 * qq + 0] = (f32x2){w0[0], w0[1]}; wv2[rt][4 * qq + 1] = (f32x2){w0[2], w0[3]}; wv2[rt][4 * qq + 2] = (f32x2){w1[0], w1[1]}; wv2[rt][4 * qq + 3] = (f32x2){w1[2], w1[3]}; } \
        } } while (0)
    for (int round = 0; round * nb < 256; ++round) {
        const int p = round * nb + ((round & 1) ? (nb - 1 - bid) : bid);
        if (p < 256) { const int tg = p >> 3, b_ = p & 7, t0l = tg * 8, ch_ = t0l >> 6, t0_ = b_ * NS + t0l;
            if (tid < 8 * (ch_ + 1)) { const int q = tid / (ch_ + 1), w = tid % (ch_ + 1); MASK[((size_t)b_ * 128 + w) * NS + t0l + q] = ~0ull; } }
    }
#define IDX_P(round_) ((round_) * nb + (((round_) & 1) ? (nb - 1 - bid) : bid))
    int round = 0;
    while (round * nb < 8192 && !(IDX_P(round) >= 256 && IDX_P(round) < 8192)) ++round;
    if (round * nb < 8192) { const int p0 = IDX_P(round); IDX_LOAD_FRAGS((p0 & 7) * NS + (p0 >> 3) * 8); }
    for (; round * nb < 8192; ) {
        const int p = IDX_P(round);
        int rnext = round + 1;
        while (rnext * nb < 8192 && !(IDX_P(rnext) >= 256 && IDX_P(rnext) < 8192)) ++rnext;
        const bool has_next = rnext * nb < 8192;
        const int pn = has_next ? IDX_P(rnext) : p;
        const int tg = p >> 3, b = p & 7, t0l = tg * 8, ch = t0l >> 6, nadm = 64 * (ch + 1), t0 = b * NS + t0l;
        const int t0n = (pn & 7) * NS + (pn >> 3) * 8;
        round = has_next ? rnext : 8192;
        __syncthreads();
#pragma unroll
        for (int i = 0; i < 9; ++i) if (tid + i * NTHR < 8 * IDX_HPITCH) hist[tid + i * NTHR] = 0u;
        __syncthreads();
        const int nkb = nadm >> 5;
        const f16* kbase = KI + ((size_t)(b * (NS / 32)) * 8 + hh) * 256 + r * 8;
#define IDX_LOADB(dst, kb_) do { _Pragma("unroll") for (int ks = 0; ks < 4; ++ks) dst[ks] = *(const f16x8*)(kbase + ((size_t)(kb_) * 8 + 2 * ks) * 256); } while (0)
#define IDX_BLOCK(bfrag, kb_) do { \
            f32x16 acc[2]; \
            _Pragma("unroll") for (int rt = 0; rt < 2; ++rt) { acc[rt] = (f32x16){0.f, 0.f, 0.f, 0.f, 0.f, 0.f, 0.f, 0.f, 0.f, 0.f, 0.f, 0.f, 0.f, 0.f, 0.f, 0.f}; \
                _Pragma("unroll") for (int ks = 0; ks < 4; ++ks) acc[rt] = __builtin_amdgcn_mfma_f32_32x32x16_f16(af[rt][ks], bfrag[ks], acc[rt], 0, 0, 0); } \
            _Pragma("unroll") for (int rt = 0; rt < 2; ++rt) \
                _Pragma("unroll") for (int qq = 0; qq < 2; ++qq) { \
                    f32x2 t2 = (f32x2){0.f, 0.f}; \
                    _Pragma("unroll") for (int hp = 0; hp < 4; ++hp) { const f32x2 r2 = (f32x2){__int_as_float(max(__float_as_int(acc[rt][8 * qq + 2 * hp]), 0)), __int_as_float(max(__float_as_int(acc[rt][8 * qq + 2 * hp + 1]), 0))}; \
                        t2 = __builtin_elementwise_fma(wv2[rt][4 * qq + hp], r2, t2); } \
                    const float sc = t2[0] + t2[1]; \
                    const f16 sh = (f16)sc; const unsigned bits = (unsigned)__builtin_bit_cast(unsigned short, sh); \
                    const unsigned key = (bits & 0x8000u) ? (~bits & 0xFFFFu) : (bits | 0x8000u); \
                    const int q = 4 * rt + 2 * hh + qq; \
                    if (MODE != 2) *(u16*)(lds + q * IDX_KPITCH + ((kb_) * 32 + r) * 2) = (u16)key; \
                    if (MODE != 2 && MODE != 4) atomicAdd(&hist[q * IDX_HPITCH + (key >> 7)], (key & 64u) ? 0x10000u : 1u); \
                    if (MODE == 2) sink += key; \
                } } while (0)
        f16x8 bf0[4], bf1[4], bf2[4]; unsigned sink = 0u;
        if (wave >= 4) __builtin_amdgcn_s_sleep(5);
        if (wave < nkb) IDX_LOADB(bf0, wave);
        if (wave + 8 < nkb) IDX_LOADB(bf1, wave + 8);
        if (wave + 16 < nkb) IDX_LOADB(bf2, wave + 16);
        if (MODE != 3) for (int kb = wave; kb < nkb; kb += 24) {
            IDX_BLOCK(bf0, kb);
            if (kb + 24 < nkb) IDX_LOADB(bf0, kb + 24);
            if (kb + 8 < nkb) { IDX_BLOCK(bf1, kb + 8); if (kb + 32 < nkb) IDX_LOADB(bf1, kb + 32); }
            if (kb + 16 < nkb) { IDX_BLOCK(bf2, kb + 16); if (kb + 40 < nkb) IDX_LOADB(bf2, kb + 40); }
        }
#undef IDX_LOADB
#undef IDX_BLOCK
        if (MODE == 2 && sink == 0xdeadbeefu) hist[tid] = sink;
        IDX_LOAD_FRAGS(t0n);
        __syncthreads();
        if (MODE != 1) {
            unsigned* hw = hist + wave * IDX_HPITCH;
            const unsigned char* krow = lds + wave * IDX_KPITCH;
            unsigned rem1 = 0u, rem2 = 0u;
            int b1;
            {   const u32x4 d0 = *(const u32x4*)(hw + 8 * lane), d1 = *(const u32x4*)(hw + 8 * lane + 4);
                const unsigned dd[8] = {d0.x, d0.y, d0.z, d0.w, d1.x, d1.y, d1.z, d1.w};
                unsigned cc[16];
#pragma unroll
                for (int j = 0; j < 8; ++j) { cc[2 * j] = dd[j] & 0xFFFFu; cc[2 * j + 1] = dd[j] >> 16; }
                b1 = wave_pick<16>(cc, 256u, lane, rem1); }
            hw[lane] = 0u;
            const int nit = (nadm + 511) >> 9;
            for (int it = 0; it < nit; ++it) {
                const int idx = (it * 64 + lane) * 8;
                if (idx < nadm) { const u32x4 k4 = *(const u32x4*)(krow + idx * 2);
                    const unsigned kk[4] = {k4.x, k4.y, k4.z, k4.w};
                    unsigned hit = 0u;
#pragma unroll
                    for (int j = 0; j < 4; ++j) { hit |= (((kk[j] & 0xFFFFu) >> 6) == (unsigned)b1 ? 1u : 0u) << (2 * j); hit |= ((kk[j] >> 22) == (unsigned)b1 ? 1u : 0u) << (2 * j + 1); }
                    if (hit) {
#pragma unroll
                        for (int j = 0; j < 4; ++j) { const unsigned k0 = kk[j] & 0xFFFFu, k1 = kk[j] >> 16;
                            if (hit & (1u << (2 * j))) atomicAdd(&hw[k0 & 63u], 1u);
                            if (hit & (2u << (2 * j))) atomicAdd(&hw[k1 & 63u], 1u); }
                    } }
            }
            int b2;
            { const unsigned c1[1] = {hw[lane]}; b2 = wave_pick<1>(c1, rem1, lane, rem2); }
            const unsigned tau = ((unsigned)b1 << 6) | (unsigned)b2;
            const size_t mrow = (size_t)(t0 + wave) * 128;
            for (int it = 0; it < nit; ++it) {
                const int idx = (it * 64 + lane) * 8;
                unsigned byte = 0u;
                if (idx < nadm) { const u32x4 k4 = *(const u32x4*)(krow + idx * 2);
                    const unsigned kk[4] = {k4.x, k4.y, k4.z, k4.w};
#pragma unroll
                    for (int j = 0; j < 4; ++j) { byte |= ((kk[j] & 0xFFFFu) >= tau ? 1u : 0u) << (2 * j); byte |= ((kk[j] >> 16) >= tau ? 1u : 0u) << (2 * j + 1); } }
                unsigned lo = (lane & 4) ? 0u : (byte << (8 * (lane & 3))), hi = (lane & 4) ? (byte << (8 * (lane & 3))) : 0u;
                lo |= __shfl_xor(lo, 1); hi |= __shfl_xor(hi, 1); lo |= __shfl_xor(lo, 2); hi |= __shfl_xor(hi, 2); lo |= __shfl_xor(lo, 4); hi |= __shfl_xor(hi, 4);
                if ((lane & 7) == 0 && idx < nadm) { hw[64 + 2 * (it * 8 + (lane >> 3))] = lo; hw[64 + 2 * (it * 8 + (lane >> 3)) + 1] = hi; }
            }
        }
        __syncthreads();
        if (MODE != 1) { const int w = tid >> 2, qp = tid & 3;
            if (w <= ch) { const unsigned* ha = hist + (2 * qp) * IDX_HPITCH + 64 + 2 * w; const unsigned* hb = ha + IDX_HPITCH;
                *(u32x4*)(MASK + ((size_t)b * 128 + w) * NS + t0l + 2 * qp) = (u32x4){ha[0], ha[1], hb[0], hb[1]}; } }
    }
    __syncthreads();
}

constexpr int ATP = 144;
constexpr int ATT_QWORD = 3584 + 32 * 64;
template <int AMODE>
__device__ __forceinline__ void ph4_attn_fast(const Args& a, int bid, int nb, unsigned char* lds) {
    int tid = threadIdx.x; asm volatile("" : "+v"(tid));
    const int lane = tid & 63, wave = __builtin_amdgcn_readfirstlane(tid >> 6), r = lane & 31, hh = lane >> 5;
    const f16* Q = (const f16*)(a.ws + WS_Q); const f16* Kk = (const f16*)(a.ws + WS_K); const f16* VT = (const f16*)(a.ws + WS_VT);
    const u64* MASK = (const u64*)(a.ws + WS_MASK); f16* MIX = (f16*)(a.ws + WS_H); const float* og = a.in[11];
    unsigned char* Kl = lds; unsigned char* Vl = lds + 2 * 64 * ATP;
    const float LOG2E = 1.4426950408889634f, OFF = 8192.f;
    const int pir = 16 * (r >> 4) + 8 * ((r >> 2) & 1) + 4 * ((r >> 3) & 1) + (r & 3);
    const int srow = tid >> 3, schk = tid & 7;
    unsigned* aq = (unsigned*)(a.ws + WS_CTL) + ATT_QWORD;
    volatile unsigned* ucell = (volatile unsigned*)(lds + 6 * 64 * ATP);
    volatile unsigned* dflag = ucell + 8;
    const float kmax = __int_as_float(__builtin_amdgcn_readfirstlane(__float_as_int(1.01f * 8.f * wave_max(fabsf(a.in[10][lane])))));
    int upar = 0;
    for (;;) {
        if (tid == 0) ucell[upar] = __hip_atomic_fetch_add(aq, 1u, __ATOMIC_RELAXED, __HIP_MEMORY_SCOPE_AGENT);
        if (tid < 8) dflag[tid] = 0u;
        __syncthreads();
        const unsigned u = ucell[upar]; upar ^= 1;
        if (u >= 2048u) break;
        const int h = 7 - (int)(u >> 8), qb = 31 - (int)((u & 255u) >> 3), b = (int)(u & 7u);
        const int q0l = qb * 256, tq = q0l + 32 * wave + r, cw = 4 * qb + (wave >> 1), top = 4 * qb + 3;
        const size_t t = (size_t)b * NS + tq;
        const float slope = exp2f(-(float)(h + 1)) * LOG2E;
        f16x8 qf[4];
#pragma unroll
        for (int ks = 0; ks < 4; ++ks) { const f16x8 qv = *(const f16x8*)(Q + t * 512 + h * 64 + 16 * ks + 8 * hh);
#pragma unroll
            for (int j = 0; j < 8; ++j) qf[ks][j] = (f16)((float)qv[j] * (0.125f * LOG2E)); }
        float qss = 0.f;
#pragma unroll
        for (int ks = 0; ks < 4; ++ks)
#pragma unroll
            for (int j = 0; j < 8; ++j) qss += (float)qf[ks][j] * (float)qf[ks][j];
        qss += __shfl_xor(qss, 32);
        const float Sb = __int_as_float(__builtin_amdgcn_readfirstlane(__float_as_int(wave_max(sqrtf(qss)) * kmax)));
        const float rowc = OFF + slope * (float)(tq - q0l);
        float m = 1000.f, l = 0.f;
        f32x16 O[2];
#pragma unroll
        for (int dt = 0; dt < 2; ++dt) O[dt] = (f32x16){0.f, 0.f, 0.f, 0.f, 0.f, 0.f, 0.f, 0.f, 0.f, 0.f, 0.f, 0.f, 0.f, 0.f, 0.f, 0.f};
        const f16* kg = Kk + ((size_t)b * NS + srow) * 512 + h * 64 + schk * 8;
        const f16* vg = VT + (size_t)(h * 64 + srow) * NT + (size_t)b * NS + schk * 8;
        f16x8 kr0, kr1, vr0, vr1; u64 mw0 = 0ull, mw1 = 0ull;
#define ATT_LOAD(kr, vr, mwv, jj) do { if ((jj) >= 0) { kr = *(const f16x8*)(kg + (size_t)(jj) * 64 * 512); vr = *(const f16x8*)(vg + (jj) * 64); mwv = ((jj) <= cw) ? MASK[((size_t)b * 128 + (jj)) * NS + tq] : 0ull; } } while (0)
        ATT_LOAD(kr0, vr0, mw0, top); ATT_LOAD(kr1, vr1, mw1, top - 1);
        int buf = 0; bool wdone = false, stop = false;
        auto step = [&](f16x8& kreg, f16x8& vreg, u64& mwr, const int j) {
            *(f16x8*)(Kl + buf * 64 * ATP + srow * ATP + schk * 16) = kreg;
            *(f16x8*)(Vl + buf * 64 * ATP + srow * ATP + schk * 16) = vreg;
            const u64 mw = mwr;
            asm volatile("s_waitcnt lgkmcnt(0)" ::: "memory"); __builtin_amdgcn_s_barrier(); asm volatile("" ::: "memory");
            {
                const unsigned jp = (unsigned)(j + 1);
                if ((dflag[0] > jp) & (dflag[1] > jp) & (dflag[2] > jp) & (dflag[3] > jp) & (dflag[4] > jp) & (dflag[5] > jp) & (dflag[6] > jp) & (dflag[7] > jp)) { stop = true; return; }
            }
            ATT_LOAD(kreg, vreg, mwr, j - 2);
            if (!wdone && j < cw) { const float lmax = Sb + OFF + slope * (float)(64 * j + 63 - q0l); if (__all(lmax - m < -28.f)) { wdone = true; if (lane == 0) dflag[wave] = (unsigned)(j + 1); } }
            if (j <= cw && !wdone) {
                const unsigned char* kb_ = Kl + buf * 64 * ATP + pir * ATP + 16 * hh;
                f16x8 fr8[8];
#pragma unroll
                for (int kt = 0; kt < 2; ++kt)
#pragma unroll
                    for (int ks = 0; ks < 4; ++ks) fr8[kt * 4 + ks] = *(const f16x8*)(kb_ + kt * 32 * ATP + ks * 32);
                f32x16 sa[2];
                if (j == cw) {
#pragma unroll
                    for (int kt = 0; kt < 2; ++kt)
#pragma unroll
                        for (int rg = 0; rg < 16; ++rg) { const float x = (float)(64 * j + 32 * kt + 16 * (rg >> 3) + 8 * hh + (rg & 7) - tq); sa[kt][rg] = rowc - slope * fabsf(x); }
                } else {
                    const float base = OFF + slope * (float)(64 * j + 8 * hh - q0l);
#pragma unroll
                    for (int kt = 0; kt < 2; ++kt)
#pragma unroll
                        for (int rg = 0; rg < 16; ++rg) sa[kt][rg] = __builtin_fmaf(slope, (float)(32 * kt + 16 * (rg >> 3) + (rg & 7)), base);
                }
                __builtin_amdgcn_sched_barrier(0);
                __builtin_amdgcn_s_setprio(1);
#pragma unroll
                for (int kt = 0; kt < 2; ++kt)
#pragma unroll
                    for (int ks = 0; ks < 4; ++ks) sa[kt] = __builtin_amdgcn_mfma_f32_32x32x16_f16(fr8[kt * 4 + ks], qf[ks], sa[kt], 0, 0, 0);
                __builtin_amdgcn_s_setprio(0);
                __builtin_amdgcn_sched_barrier(0);
                const unsigned char* vb_ = Vl + buf * 64 * ATP + r * ATP + 16 * hh;
#pragma unroll
                for (int dt = 0; dt < 2; ++dt)
#pragma unroll
                    for (int kt = 0; kt < 2; ++kt)
#pragma unroll
                        for (int s2 = 0; s2 < 2; ++s2) fr8[dt * 4 + kt * 2 + s2] = *(const f16x8*)(vb_ + dt * 32 * ATP + kt * 64 + s2 * 32);
                __builtin_amdgcn_sched_barrier(0);
                float rm = 0.f;
#pragma unroll
                for (int kt = 0; kt < 2; ++kt) { const unsigned w32 = (unsigned)(kt ? (mw >> 32) : mw) >> (8 * hh);
#pragma unroll
                    for (int rg = 0; rg < 16; ++rg) { const int tm = __builtin_amdgcn_sbfe((int)w32, 16 * (rg >> 3) + (rg & 7), 1);
                        const float L = __int_as_float(__float_as_int(sa[kt][rg]) & tm); sa[kt][rg] = L; rm = fmaxf(rm, L); } }
                rm = fmaxf(rm, __shfl_xor(rm, 32));
                const float mn = fmaxf(m, rm);
                if (__any(mn > m)) { const float al = __builtin_amdgcn_exp2f(m - mn); l *= al;
#pragma unroll
                    for (int dt = 0; dt < 2; ++dt)
#pragma unroll
                        for (int rg = 0; rg < 16; ++rg) O[dt][rg] *= al; }
                m = mn;
                f16x8 pf[2][2];
                float l0 = 0.f, l1 = 0.f;
#pragma unroll
                for (int kt = 0; kt < 2; ++kt)
#pragma unroll
                    for (int rg = 0; rg < 16; ++rg) { const float pp = __builtin_amdgcn_exp2f(sa[kt][rg] - m); if (rg & 1) l1 += pp; else l0 += pp; pf[kt][rg >> 3][rg & 7] = (f16)pp; }
                l += l0 + l1;
                __builtin_amdgcn_sched_barrier(0);
                __builtin_amdgcn_s_setprio(1);
#pragma unroll
                for (int dt = 0; dt < 2; ++dt)
#pragma unroll
                    for (int kt = 0; kt < 2; ++kt)
#pragma unroll
                        for (int s2 = 0; s2 < 2; ++s2) O[dt] = __builtin_amdgcn_mfma_f32_32x32x16_f16(fr8[dt * 4 + kt * 2 + s2], pf[kt][s2], O[dt], 0, 0, 0);
                __builtin_amdgcn_s_setprio(0);
            }
            buf ^= 1;
        };
        for (int j = top; j >= 0; j -= 2) {
            step(kr0, vr0, mw0, j); if (stop) break;
            if (j - 1 >= 0) { step(kr1, vr1, mw1, j - 1); if (stop) break; }
        }
#undef ATT_LOAD
        l += __shfl_xor(l, 32);
        const float inv = 1.f / l;
        float ss = 0.f;
#pragma unroll
        for (int dt = 0; dt < 2; ++dt)
#pragma unroll
            for (int rg = 0; rg < 16; ++rg) { O[dt][rg] *= inv; ss += O[dt][rg] * O[dt][rg]; }
        ss += __shfl_xor(ss, 32);
        const float rstd = rsqrtf(ss * (1.f / 64.f) + EPS);
#pragma unroll
        for (int dt = 0; dt < 2; ++dt)
#pragma unroll
            for (int g4 = 0; g4 < 4; ++g4) { const int d = 32 * dt + 8 * g4 + 4 * hh; const f32x4 gg = *(const f32x4*)(og + h * 64 + d);
                f16x4 o4; o4.x = (f16)(O[dt][4 * g4 + 0] * rstd * gg.x); o4.y = (f16)(O[dt][4 * g4 + 1] * rstd * gg.y); o4.z = (f16)(O[dt][4 * g4 + 2] * rstd * gg.z); o4.w = (f16)(O[dt][4 * g4 + 3] * rstd * gg.w);
                *(f16x4*)(MIX + t * ND + 512 + h * 64 + d) = o4; }
        __syncthreads();
    }
}

__device__ __forceinline__ void ph5_outproj(const Args& a, int bid, int nb, unsigned char* lds) {
    pg8::Gemm g{(const f16*)(a.ws + WS_H), (const f16*)(a.ws + WS_WOUT), NT, 1024, ND}; pg8::StaticOrder S; S.init(NT, 1024, nb, bid);
    pg8::EpiOut E{a.in[0], (const float*)(a.ws + WS_MOD), a.out};
    pg8::gemm_phase((PG8_LAS unsigned char*)lds, g, S, E);
}

__device__ __forceinline__ void ph7_peerq(const Args& a, int bid, int nb, unsigned char* lds) {
    pg8::Gemm g{(const f16*)(a.ws + WS_H), (const f16*)(a.ws + WS_WQ), NT, 2048, ND}; pg8::StaticOrder S; S.init(NT, 2048, nb, bid);
    pg8::EpiPQ E{(f16*)(a.ws + WS_PQ)};
    pg8::gemm_phase((PG8_LAS unsigned char*)lds, g, S, E);
}


__device__ __forceinline__ unsigned f2skey(float f) { const unsigned u = __float_as_uint(f); return (u & 0x80000000u) ? ~u : (u | 0x80000000u); }
__device__ __forceinline__ float skey2f(unsigned k) { return __uint_as_float((k & 0x80000000u) ? (k & 0x7FFFFFFFu) : ~k); }
#define CE_(a_, b_) do { const unsigned t__ = max(a_, b_); b_ = min(a_, b_); a_ = t__; } while (0)
#define SORT16_DESC(v) do { CE_(v[0], v[1]); CE_(v[2], v[3]); CE_(v[0], v[2]); CE_(v[1], v[3]); CE_(v[1], v[2]); CE_(v[4], v[5]); CE_(v[6], v[7]); CE_(v[4], v[6]); CE_(v[5], v[7]); CE_(v[5], v[6]); CE_(v[0], v[4]); CE_(v[2], v[6]); CE_(v[2], v[4]); CE_(v[1], v[5]); CE_(v[3], v[7]); CE_(v[3], v[5]); CE_(v[1], v[2]); CE_(v[3], v[4]); CE_(v[5], v[6]); CE_(v[8], v[9]); CE_(v[10], v[11]); CE_(v[8], v[10]); CE_(v[9], v[11]); CE_(v[9], v[10]); CE_(v[12], v[13]); CE_(v[14], v[15]); CE_(v[12], v[14]); CE_(v[13], v[15]); CE_(v[13], v[14]); CE_(v[8], v[12]); CE_(v[10], v[14]); CE_(v[10], v[12]); CE_(v[9], v[13]); CE_(v[11], v[15]); CE_(v[11], v[13]); CE_(v[9], v[10]); CE_(v[11], v[12]); CE_(v[13], v[14]); CE_(v[0], v[8]); CE_(v[4], v[12]); CE_(v[4], v[8]); CE_(v[2], v[10]); CE_(v[6], v[14]); CE_(v[6], v[10]); CE_(v[2], v[4]); CE_(v[6], v[8]); CE_(v[10], v[12]); CE_(v[1], v[9]); CE_(v[5], v[13]); CE_(v[5], v[9]); CE_(v[3], v[11]); CE_(v[7], v[15]); CE_(v[7], v[11]); CE_(v[3], v[5]); CE_(v[7], v[9]); CE_(v[11], v[13]); CE_(v[1], v[2]); CE_(v[3], v[4]); CE_(v[5], v[6]); CE_(v[7], v[8]); CE_(v[9], v[10]); CE_(v[11], v[12]); CE_(v[13], v[14]); } while (0)
#define BITONIC16_DESC(v) do { CE_(v[0], v[8]); CE_(v[1], v[9]); CE_(v[2], v[10]); CE_(v[3], v[11]); CE_(v[4], v[12]); CE_(v[5], v[13]); CE_(v[6], v[14]); CE_(v[7], v[15]); CE_(v[0], v[4]); CE_(v[1], v[5]); CE_(v[2], v[6]); CE_(v[3], v[7]); CE_(v[8], v[12]); CE_(v[9], v[13]); CE_(v[10], v[14]); CE_(v[11], v[15]); CE_(v[0], v[2]); CE_(v[1], v[3]); CE_(v[4], v[6]); CE_(v[5], v[7]); CE_(v[8], v[10]); CE_(v[9], v[11]); CE_(v[12], v[14]); CE_(v[13], v[15]); CE_(v[0], v[1]); CE_(v[2], v[3]); CE_(v[4], v[5]); CE_(v[6], v[7]); CE_(v[8], v[9]); CE_(v[10], v[11]); CE_(v[12], v[13]); CE_(v[14], v[15]); } while (0)
#define MERGE16_DESC(dst, other) do { unsigned c__[16]; _Pragma("unroll") for (int i__ = 0; i__ < 16; ++i__) c__[i__] = max(dst[i__], other[15 - i__]); BITONIC16_DESC(c__); _Pragma("unroll") for (int i__ = 0; i__ < 16; ++i__) dst[i__] = c__[i__]; } while (0)
#define TOP16_INSERT(v, x_) do { unsigned x__ = (x_); _Pragma("unroll") for (int k_ = 0; k_ < 16; ++k_) { const unsigned t__ = max(v[k_], x__); x__ = min(v[k_], x__); v[k_] = t__; } } while (0)
__device__ __forceinline__ void ph8_peersel_fast(const Args& a, int bid, int nb, unsigned char* lds) {
    int tid = threadIdx.x; asm volatile("" : "+v"(tid));
    const int lane = tid & 63, wave = __builtin_amdgcn_readfirstlane(tid >> 6), r = lane & 31, hh = lane >> 5;
    const f16* PQ = (const f16*)(a.ws + WS_PQ);
    u16* EID = (u16*)(a.ws + WS_EID); float* GW = (float*)(a.ws + WS_GW);
    unsigned char* wl = lds + wave * 2048 + lane * 32;
    for (int item = bid * NWAVE + wave; item < (NT / 32) * 8; item += nb * NWAVE) {
        const int tt = item >> 3, h = item & 7, t0 = tt * 32;
        unsigned top[2][16];
#pragma unroll
        for (int p = 0; p < 2; ++p) {
            f16x8 sq[8];
#pragma unroll
            for (int c = 0; c < 8; ++c) sq[c] = *(const f16x8*)(PQ + ((((size_t)tt * 256 + h * 32 + p * 16 + 8 * hh + c) * 32 + r) << 3));
#pragma unroll
            for (int k = 0; k < 16; ++k) top[p][k] = 0u;
#pragma unroll
            for (int g = 0; g < 4; ++g) {
                unsigned ky[16];
#pragma unroll
                for (int i = 0; i < 16; ++i) { const unsigned n = 64u * hh + 16u * g + i; ky[i] = (f2skey((float)sq[2 * g + (i >> 3)][i & 7]) & ~127u) | n; }
                SORT16_DESC(ky); MERGE16_DESC(top[p], ky);
            }
            unsigned oth[16];
#pragma unroll
            for (int k = 0; k < 16; ++k) oth[k] = __shfl_xor(top[p][k], 32);
            MERGE16_DESC(top[p], oth);
            asm volatile("" ::: "memory");
        }
#pragma unroll
        for (int k = 0; k < 16; k += 4) {
            *(unsigned*)(wl + k) = (top[0][k] & 127u) | ((top[0][k + 1] & 127u) << 8) | ((top[0][k + 2] & 127u) << 16) | ((top[0][k + 3] & 127u) << 24);
            *(unsigned*)(wl + 16 + k) = (top[1][k] & 127u) | ((top[1][k + 1] & 127u) << 8) | ((top[1][k + 2] & 127u) << 16) | ((top[1][k + 3] & 127u) << 24);
        }
        float fa[16], fb[16];
#pragma unroll
        for (int k = 0; k < 16; ++k) { fa[k] = skey2f(top[0][k] & ~127u); fb[k] = skey2f(top[1][k] & ~127u); }
        unsigned cg[4][16];
        cg[0][0] = (f2skey(fa[0] + fb[0]) & ~255u) | 0u;
        cg[0][1] = (f2skey(fa[0] + fb[1]) & ~255u) | 1u;
        cg[0][2] = (f2skey(fa[0] + fb[2]) & ~255u) | 2u;
        cg[0][3] = (f2skey(fa[0] + fb[3]) & ~255u) | 3u;
        cg[0][4] = (f2skey(fa[0] + fb[4]) & ~255u) | 4u;
        cg[0][5] = (f2skey(fa[0] + fb[5]) & ~255u) | 5u;
        cg[0][6] = (f2skey(fa[0] + fb[6]) & ~255u) | 6u;
        cg[0][7] = (f2skey(fa[0] + fb[7]) & ~255u) | 7u;
        cg[0][8] = (f2skey(fa[0] + fb[8]) & ~255u) | 8u;
        cg[0][9] = (f2skey(fa[0] + fb[9]) & ~255u) | 9u;
        cg[0][10] = (f2skey(fa[0] + fb[10]) & ~255u) | 10u;
        cg[0][11] = (f2skey(fa[0] + fb[11]) & ~255u) | 11u;
        cg[0][12] = (f2skey(fa[0] + fb[12]) & ~255u) | 12u;
        cg[0][13] = (f2skey(fa[0] + fb[13]) & ~255u) | 13u;
        cg[0][14] = (f2skey(fa[0] + fb[14]) & ~255u) | 14u;
        cg[0][15] = (f2skey(fa[0] + fb[15]) & ~255u) | 15u;
        cg[1][0] = (f2skey(fa[1] + fb[0]) & ~255u) | 16u;
        cg[1][1] = (f2skey(fa[1] + fb[1]) & ~255u) | 17u;
        cg[1][2] = (f2skey(fa[1] + fb[2]) & ~255u) | 18u;
        cg[1][3] = (f2skey(fa[1] + fb[3]) & ~255u) | 19u;
        cg[1][4] = (f2skey(fa[1] + fb[4]) & ~255u) | 20u;
        cg[1][5] = (f2skey(fa[1] + fb[5]) & ~255u) | 21u;
        cg[1][6] = (f2skey(fa[1] + fb[6]) & ~255u) | 22u;
        cg[1][7] = (f2skey(fa[1] + fb[7]) & ~255u) | 23u;
        cg[1][8] = (f2skey(fa[2] + fb[0]) & ~255u) | 32u;
        cg[1][9] = (f2skey(fa[2] + fb[1]) & ~255u) | 33u;
        cg[1][10] = (f2skey(fa[2] + fb[2]) & ~255u) | 34u;
        cg[1][11] = (f2skey(fa[2] + fb[3]) & ~255u) | 35u;
        cg[1][12] = (f2skey(fa[2] + fb[4]) & ~255u) | 36u;
        cg[1][13] = (f2skey(fa[3] + fb[0]) & ~255u) | 48u;
        cg[1][14] = (f2skey(fa[3] + fb[1]) & ~255u) | 49u;
        cg[1][15] = (f2skey(fa[3] + fb[2]) & ~255u) | 50u;
        cg[2][0] = (f2skey(fa[3] + fb[3]) & ~255u) | 51u;
        cg[2][1] = (f2skey(fa[4] + fb[0]) & ~255u) | 64u;
        cg[2][2] = (f2skey(fa[4] + fb[1]) & ~255u) | 65u;
        cg[2][3] = (f2skey(fa[4] + fb[2]) & ~255u) | 66u;
        cg[2][4] = (f2skey(fa[5] + fb[0]) & ~255u) | 80u;
        cg[2][5] = (f2skey(fa[5] + fb[1]) & ~255u) | 81u;
        cg[2][6] = (f2skey(fa[6] + fb[0]) & ~255u) | 96u;
        cg[2][7] = (f2skey(fa[6] + fb[1]) & ~255u) | 97u;
        cg[2][8] = (f2skey(fa[7] + fb[0]) & ~255u) | 112u;
        cg[2][9] = (f2skey(fa[7] + fb[1]) & ~255u) | 113u;
        cg[2][10] = (f2skey(fa[8] + fb[0]) & ~255u) | 128u;
        cg[2][11] = (f2skey(fa[9] + fb[0]) & ~255u) | 144u;
        cg[2][12] = (f2skey(fa[10] + fb[0]) & ~255u) | 160u;
        cg[2][13] = (f2skey(fa[11] + fb[0]) & ~255u) | 176u;
        cg[2][14] = (f2skey(fa[12] + fb[0]) & ~255u) | 192u;
        cg[2][15] = (f2skey(fa[13] + fb[0]) & ~255u) | 208u;
        cg[3][0] = (f2skey(fa[14] + fb[0]) & ~255u) | 224u;
        cg[3][1] = (f2skey(fa[15] + fb[0]) & ~255u) | 240u;
        cg[3][2] = 0u;
        cg[3][3] = 0u;
        cg[3][4] = 0u;
        cg[3][5] = 0u;
        cg[3][6] = 0u;
        cg[3][7] = 0u;
        cg[3][8] = 0u;
        cg[3][9] = 0u;
        cg[3][10] = 0u;
        cg[3][11] = 0u;
        cg[3][12] = 0u;
        cg[3][13] = 0u;
        cg[3][14] = 0u;
        cg[3][15] = 0u;
        SORT16_DESC(cg[0]); SORT16_DESC(cg[1]); SORT16_DESC(cg[2]); SORT16_DESC(cg[3]);
        MERGE16_DESC(cg[0], cg[1]); MERGE16_DESC(cg[2], cg[3]); MERGE16_DESC(cg[0], cg[2]);
        unsigned ct[16];
#pragma unroll
        for (int k = 0; k < 16; ++k) ct[k] = cg[0][k];
        float sc[16]; float den = 0.f; const float s0 = skey2f(ct[0] & ~255u);
#pragma unroll
        for (int k = 0; k < 16; ++k) { sc[k] = __expf(skey2f(ct[k] & ~255u) - s0); den += sc[k]; }
        const float inv = 1.f / den;
        if (hh == 0) {
            u16 ev[16];
#pragma unroll
            for (int k = 0; k < 16; ++k) { const unsigned ij = ct[k] & 255u; const unsigned i1 = wl[ij >> 4], i2 = wl[16 + (ij & 15u)]; ev[k] = (u16)(i1 * 128u + i2); }
            const size_t o = (size_t)(t0 + r) * 128 + h * 16;
#pragma unroll
            for (int k = 0; k < 16; k += 8) {
                *(u32x4*)(EID + o + k) = (u32x4){(unsigned)ev[k] | ((unsigned)ev[k + 1] << 16), (unsigned)ev[k + 2] | ((unsigned)ev[k + 3] << 16), (unsigned)ev[k + 4] | ((unsigned)ev[k + 5] << 16), (unsigned)ev[k + 6] | ((unsigned)ev[k + 7] << 16)};
            }
#pragma unroll
            for (int k = 0; k < 16; k += 4) *(f32x4*)(GW + o + k) = (f32x4){sc[k] * inv, sc[k + 1] * inv, sc[k + 2] * inv, sc[k + 3] * inv};
        }
    }
}

typedef _Float16 f16x2 __attribute__((ext_vector_type(2)));
__device__ __forceinline__ float gelu_erf(float d) { return 0.5f * d * (1.f + erff(d * 0.70710678118654752f)); }
constexpr int PQ_WORD0 = 3584, PQ_CHUNK = 64, PQ_NCHUNK = NT / PQ_CHUNK, PQ_HALF = PQ_NCHUNK / 2;
constexpr size_t WS_PART = 208 * MiB;
__device__ __forceinline__ unsigned xcc_id_() { return (unsigned)__builtin_amdgcn_s_getreg((3 << 11) | 20) & 7u; }
template <int VPHASE>
__device__ __forceinline__ void ph9_sliced(const Args& a, unsigned char* lds) {
    int tid_ = threadIdx.x; asm volatile("" : "+v"(tid_)); const int lane = tid_ & 63, wave = __builtin_amdgcn_readfirstlane(tid_ >> 6);
    const int g8 = lane >> 3, c8 = lane & 7;
    const unsigned char* HQ = a.ws + WS_HQ; const float* HSC = (const float*)(a.ws + WS_HSC); const unsigned char* TAB = a.ws + (VPHASE ? WS_VP : WS_UT);
    const u16* EID = (const u16*)(a.ws + WS_EID); const float* GW = (const float*)(a.ws + WS_GW); float* PART = (float*)(a.ws + WS_PART);
    const float* mod = (const float*)(a.ws + WS_MOD); float* out = a.out;
    unsigned* qw = (unsigned*)(a.ws + WS_CTL) + PQ_WORD0 + (VPHASE ? 8 * 64 : 0);
    volatile unsigned* cslot = (volatile unsigned*)lds;
    const bool b5 = (lane & 32) != 0, b4 = (lane & 16) != 0, b3 = (lane & 8) != 0, b2 = (lane & 4) != 0, b1 = (lane & 2) != 0, b0 = (lane & 1) != 0;
    const unsigned x0 = xcc_id_();
    int par = 0;
    for (int k = 0; k < 8; ++k) {
        const unsigned qi_ = (x0 + (unsigned)k) & 7u, sl = qi_ & 3u, half = qi_ >> 2;
        unsigned cur = 0u;
        if (tid_ == 0) cur = __hip_atomic_fetch_add(qw + 64 * qi_, 1u, __ATOMIC_RELAXED, __HIP_MEMORY_SCOPE_AGENT);
        for (;;) {
            if (tid_ == 0) cslot[par] = cur;
            __syncthreads();
            const unsigned c = cslot[par]; par ^= 1;
            if (c >= (unsigned)PQ_HALF) break;
            if (tid_ == 0) cur = __hip_atomic_fetch_add(qw + 64 * qi_, 1u, __ATOMIC_RELAXED, __HIP_MEMORY_SCOPE_AGENT);
            const int tb = (int)(half * PQ_HALF + c) * PQ_CHUNK + wave * (PQ_CHUNK / NWAVE);
            const unsigned char* tsl = TAB + 128 * sl + 16 * c8;
#pragma unroll 1
            for (int i8 = 0; i8 < PQ_CHUNK / NWAVE; ++i8) {
                const int t = tb + i8;
                const u32x4 e0 = *(const u32x4*)(EID + (size_t)t * 128 + 16 * g8), e1 = *(const u32x4*)(EID + (size_t)t * 128 + 16 * g8 + 8);
                const unsigned ew[8] = {e0.x, e0.y, e0.z, e0.w, e1.x, e1.y, e1.z, e1.w};
                u32x4 r8[16];
#pragma unroll
                for (int i = 0; i < 16; ++i) { const unsigned eid = (i & 1) ? (ew[i >> 1] >> 16) : (ew[i >> 1] & 0xFFFFu); r8[i] = *(const u32x4*)(tsl + (size_t)eid * 512); }
                if (!VPHASE) {
                    const u32x4 hh4 = *(const u32x4*)(HQ + (size_t)t * 1024 + 128 * sl + 16 * c8), hl4 = *(const u32x4*)(HQ + (size_t)t * 1024 + 512 + 128 * sl + 16 * c8);
                    const float hsc = 0.5f * HSC[t];
                    int hs1 = 0, hs0 = 0;
#pragma unroll
                    for (int j = 0; j < 4; ++j) { hs1 = __builtin_amdgcn_sdot8((int)hh4[j], 0x11111111, hs1, false); hs0 = __builtin_amdgcn_sdot8((int)hl4[j], 0x11111111, hs0, false); }
                    const int hsum = 16 * hs1 + hs0;
                    float p[16];
#pragma unroll
                    for (int i = 0; i < 16; ++i) { int d1 = 0, d0 = 0;
#pragma unroll
                        for (int j = 0; j < 4; ++j) { d1 = __builtin_amdgcn_sdot8((int)hh4[j], (int)r8[i][j], d1, false); d0 = __builtin_amdgcn_sdot8((int)hl4[j], (int)r8[i][j], d0, false); }
                        p[i] = (float)(2 * (16 * d1 + d0) + hsum); }
                    float q8[8], q4[4], r2[2];
#pragma unroll
                    for (int ii = 0; ii < 8; ++ii) { const float keep = b2 ? p[8 + ii] : p[ii], send = b2 ? p[ii] : p[8 + ii]; q8[ii] = keep + __shfl_xor(send, 4); }
#pragma unroll
                    for (int ii = 0; ii < 4; ++ii) { const float keep = b1 ? q8[4 + ii] : q8[ii], send = b1 ? q8[ii] : q8[4 + ii]; q4[ii] = keep + __shfl_xor(send, 2); }
#pragma unroll
                    for (int ii = 0; ii < 2; ++ii) { const float keep = b0 ? q4[2 + ii] : q4[ii], send = b0 ? q4[ii] : q4[2 + ii]; r2[ii] = keep + __shfl_xor(send, 1); }
                    *(f32x2*)(PART + ((size_t)sl * NT + t) * 128 + 16 * g8 + 2 * c8) = (f32x2){r2[0] * hsc, r2[1] * hsc};
                } else {
                    const float* wp = GW + (size_t)t * 128 + 16 * g8;
                    const f32x4 wq0 = *(const f32x4*)wp, wq1 = *(const f32x4*)(wp + 4), wq2 = *(const f32x4*)(wp + 8), wq3 = *(const f32x4*)(wp + 12);
                    const float wv[16] = {wq0[0], wq0[1], wq0[2], wq0[3], wq1[0], wq1[1], wq1[2], wq1[3], wq2[0], wq2[1], wq2[2], wq2[3], wq3[0], wq3[1], wq3[2], wq3[3]};
                    float wsum = 0.f;
#pragma unroll
                    for (int i = 0; i < 16; ++i) wsum += wv[i];
                    const f16 off = (f16)(-7.5f * 5.9604644775390625e-08f * wsum);
                    f16x2 acc2[16];
#pragma unroll
                    for (int j = 0; j < 16; ++j) acc2[j] = (f16x2){off, off};
#pragma unroll
                    for (int i = 0; i < 16; ++i) { const f16x2 wa = (f16x2){(f16)wv[i], (f16)wv[i]}; const f16x2 wb = wa * (f16x2){(f16)0.0625f, (f16)0.0625f};
#pragma unroll
                        for (int j = 0; j < 4; ++j) { const unsigned x = r8[i][j], y = x >> 8;
                            acc2[4 * j]     = __builtin_elementwise_fma(wa, __builtin_bit_cast(f16x2, x & 0x000F000Fu), acc2[4 * j]);
                            acc2[4 * j + 1] = __builtin_elementwise_fma(wb, __builtin_bit_cast(f16x2, x & 0x00F000F0u), acc2[4 * j + 1]);
                            acc2[4 * j + 2] = __builtin_elementwise_fma(wa, __builtin_bit_cast(f16x2, y & 0x000F000Fu), acc2[4 * j + 2]);
                            acc2[4 * j + 3] = __builtin_elementwise_fma(wb, __builtin_bit_cast(f16x2, y & 0x00F000F0u), acc2[4 * j + 3]); } }
                    float acc[32];
#pragma unroll
                    for (int j = 0; j < 4; ++j)
#pragma unroll
                        for (int q = 0; q < 4; ++q) { acc[8 * j + q] = (float)acc2[4 * j + q][0]; acc[8 * j + 4 + q] = (float)acc2[4 * j + q][1]; }
                    float q16[16], q8[8], r4[4];
#pragma unroll
                    for (int ii = 0; ii < 16; ++ii) { const float keep = b5 ? acc[16 + ii] : acc[ii], send = b5 ? acc[ii] : acc[16 + ii]; q16[ii] = keep + __shfl_xor(send, 32); }
#pragma unroll
                    for (int ii = 0; ii < 8; ++ii) { const float keep = b4 ? q16[8 + ii] : q16[ii], send = b4 ? q16[ii] : q16[8 + ii]; q8[ii] = keep + __shfl_xor(send, 16); }
#pragma unroll
                    for (int ii = 0; ii < 4; ++ii) { const float keep = b3 ? q8[4 + ii] : q8[ii], send = b3 ? q8[ii] : q8[4 + ii]; r4[ii] = keep + __shfl_xor(send, 8); }
                    const int ch = 256 * sl + 32 * c8 + 4 * g8;
                    float* op = out + (size_t)t * ND + ch; const float* g2 = mod + (t / NS) * 6144 + 5120 + ch;
                    const f32x4 o4 = *(const f32x4*)op, gg = *(const f32x4*)g2;
                    *(f32x4*)op = o4 + gg * ((f32x4){r4[0], r4[1], r4[2], r4[3]} * (16777216.f / PEER_WSCALE));
                }
            }
        }
    }
}
__device__ __forceinline__ void ph9b_combine(const Args& a, int bid, int nb) {
    int tid_ = threadIdx.x; asm volatile("" : "+v"(tid_));
    float* GW = (float*)(a.ws + WS_GW); const float* PART = (const float*)(a.ws + WS_PART);
    const float du = ((const float*)(a.ws + WS_QS))[0], dv = ((const float*)(a.ws + WS_QS))[1] * PEER_WSCALE;
    for (size_t i = (size_t)bid * NTHR + tid_; i < (size_t)NT * 128 / 4; i += (size_t)nb * NTHR) {
        f32x4 sum = ((const f32x4*)PART)[i];
#pragma unroll
        for (int sidx = 1; sidx < 4; ++sidx) sum += ((const f32x4*)(PART + (size_t)sidx * NT * 128))[i];
        const f32x4 g = ((const f32x4*)GW)[i];
        f32x4 w;
#pragma unroll
        for (int j = 0; j < 4; ++j) w[j] = fminf(fmaxf(g[j] * gelu_erf(sum[j] * du) * dv, -60000.f), 60000.f);
        ((f32x4*)GW)[i] = w;
    }
}

#define LAS __attribute__((address_space(3)))
#define XB_TMO      128
#define XB_XCNT(j)  (256  + 64 * (j))
#define XB_XSUB(j)  (1280 + 64 * (j))
#define XB_XGEN(j)  (2304 + 64 * (j))
#define XB_TOP      3328
#define XB_TOPGEN   3392
#define XCD_BAR_WORDS 3456
#define XB_SPIN_CAP (1u << 18)
__device__ __forceinline__ unsigned xb_ld(unsigned* p)              { return __hip_atomic_load(p, __ATOMIC_RELAXED, __HIP_MEMORY_SCOPE_AGENT); }
__device__ __forceinline__ unsigned xb_add(unsigned* p, unsigned v) { return __hip_atomic_fetch_add(p, v, __ATOMIC_RELAXED, __HIP_MEMORY_SCOPE_AGENT); }
__device__ __forceinline__ unsigned xb_xcc_id() { return (unsigned)__builtin_amdgcn_s_getreg((3 << 11) | 20) & 0xFu; }
#define XB_SPIN(cond, bar) do { unsigned _sp = 0; while (cond) { __builtin_amdgcn_s_sleep(1); \
    if ((++_sp & 255u) == 0u) { if (xb_ld(&(bar)[XB_TMO])) break; if (_sp > XB_SPIN_CAP) { atomicAdd(&(bar)[XB_TMO], 1u); break; } } } } while (0)
struct XcdBarrier { unsigned* bar; unsigned x; volatile LAS unsigned* st; };
__device__ __forceinline__ XcdBarrier xcd_barrier_post(unsigned* bar, volatile LAS unsigned* st) {
    XcdBarrier b; b.bar = bar; b.x = xb_xcc_id(); b.st = st;
    if (threadIdx.x == 0) (void)xb_add(&bar[XB_XCNT(b.x)], 1u);
    return b;
}
__device__ __forceinline__ void xcd_barrier_complete(unsigned* bar, unsigned x, unsigned& nloc, unsigned& nx) {
    const unsigned G = gridDim.x * gridDim.y * gridDim.z;
    unsigned sum, cnt, mine, sp = 0u;
    for (;;) {
        sum = 0u; cnt = 0u; mine = 0u;
#pragma unroll
        for (unsigned j = 0; j < 16; ++j) { const unsigned c = xb_ld(&bar[XB_XCNT(j)]); sum += c; cnt += (c > 0u) ? 1u : 0u; mine = (j == x) ? c : mine; }
        if (sum == G) break;
        __builtin_amdgcn_s_sleep(1);
        if ((++sp & 255u) == 0u) { if (xb_ld(&bar[XB_TMO])) break; if (sp > XB_SPIN_CAP) { atomicAdd(&bar[XB_TMO], 1u); break; } }
    }
    nloc = mine > 0u ? mine : 1u; nx = cnt > 0u ? cnt : 1u;
}
__device__ __forceinline__ void xcd_barrier(const XcdBarrier& b) {
    asm volatile("s_waitcnt vmcnt(0)" ::: "memory");
    __syncthreads();
    if (threadIdx.x == 0) {
        unsigned* bar = b.bar;
        __builtin_amdgcn_s_waitcnt(0);
        unsigned nloc = b.st[0], nx = b.st[1];
        if (nloc == 0u) { xcd_barrier_complete(bar, b.x, nloc, nx); b.st[0] = nloc; b.st[1] = nx; }
        const unsigned old = xb_add(&bar[XB_XSUB(b.x)], 1u);
        const unsigned gen = old / nloc;
        if (old + 1u == (gen + 1u) * nloc) {
            __builtin_amdgcn_fence(__ATOMIC_RELEASE, "agent");
            asm volatile("s_waitcnt vmcnt(0)" ::: "memory");
            const unsigned og = xb_add(&bar[XB_TOP], 1u);
            const unsigned tg = og / nx;
            if (og + 1u == (tg + 1u) * nx) xb_add(&bar[XB_TOPGEN], 1u);
            else XB_SPIN(xb_ld(&bar[XB_TOPGEN]) == tg, bar);
            __builtin_amdgcn_fence(__ATOMIC_ACQUIRE, "agent");
            xb_add(&bar[XB_XGEN(b.x)], 1u);
            asm volatile("s_waitcnt vmcnt(0)" ::: "memory");
        } else {
            XB_SPIN(xb_ld(&bar[XB_XGEN(b.x)]) == gen, bar);
            __builtin_amdgcn_fence(__ATOMIC_ACQUIRE, "agent");
            asm volatile("s_waitcnt vmcnt(0)" ::: "memory");
        }
    }
    __syncthreads();
}

constexpr int N_PHASES = 12;
__global__ void __launch_bounds__(NTHR, 2) mk_fwd(Args a) {
    extern __shared__ __attribute__((aligned(16))) unsigned char lds[];
    cg::grid_group grid = cg::this_grid();
    const int bid = blockIdx.x, nb = gridDim.x;
    const int lo = a.ph_lo, hi = a.ph_hi;
    volatile LAS unsigned* bst = (volatile LAS unsigned*)((LAS unsigned char*)lds + (LDS_BYTES - 16));
    if (threadIdx.x < 4) bst[threadIdx.x] = 0u;
    __syncthreads();
    XcdBarrier xbar = xcd_barrier_post((unsigned*)(a.ws + WS_CTL), bst);
#define SEAM(k) do { if ((k) == 0) grid.sync(); else xcd_barrier(xbar); } while (0)
#define PHASE(k, body) if (lo <= (k) && (k) < hi) { body; if ((k) + 1 < hi) SEAM(k); }
    PHASE(0, ph0_prologue(a, bid, nb, lds))
    PHASE(1, row_norm_mod(a.in[0], a.in[4], (const float*)(a.ws + WS_MOD), 0, 1024, (f16*)(a.ws + WS_H), bid, nb))
    PHASE(2, ph2_inproj(a, bid, nb, lds))
    PHASE(3, ph3_pool_fast(a, bid, nb, lds); ph3_index_fast<0>(a, bid, nb, lds))
    PHASE(4, ph4_attn_fast<0>(a, bid, nb, lds))
    PHASE(5, ph5_outproj(a, bid, nb, lds))
    PHASE(6, row_norm_mod_q(a.out, a.in[13], (const float*)(a.ws + WS_MOD), 3072, 4096, (f16*)(a.ws + WS_H), (unsigned*)(a.ws + WS_HQ), (float*)(a.ws + WS_HSC), bid, nb))
    PHASE(7, ph7_peerq(a, bid, nb, lds))
    PHASE(8, ph8_peersel_fast(a, bid, nb, lds))
    PHASE(9, ph9_sliced<0>(a, lds))
    PHASE(10, ph9b_combine(a, bid, nb))
    PHASE(11, ph9_sliced<1>(a, lds))
#undef PHASE
}

extern "C" void kernel_launch(void* const* d_in, const int* in_sizes, int n_in, void* d_out, int out_size, void* d_ws, size_t ws_size, hipStream_t stream) {
    static int grid = 0;
    if (grid == 0) {
        if (n_in != 18 || out_size != NT * ND || ws_size < WS_END) { fprintf(stderr, "kernel_launch: unexpected shapes (n_in %d out %d ws %zu)\n", n_in, out_size, ws_size); grid = -1; return; }
        int dev = 0, cus = 0, per_cu = 0;
        hipGetDevice(&dev); hipDeviceGetAttribute(&cus, hipDeviceAttributeMultiprocessorCount, dev);
        hipFuncSetAttribute((const void*)mk_fwd, hipFuncAttributeMaxDynamicSharedMemorySize, LDS_BYTES);
        hipOccupancyMaxActiveBlocksPerMultiprocessor(&per_cu, (const void*)mk_fwd, NTHR, LDS_BYTES);
        if (per_cu < 1) { fprintf(stderr, "kernel_launch: occupancy query says %d blocks/CU\n", per_cu); per_cu = 1; }
        grid = cus * 1;
        (void)hipGetLastError();
    }
    if (grid < 0) return;
    if (hipMemsetAsync((char*)d_ws + WS_CTL, 0, 32768, stream) != hipSuccess) { fprintf(stderr, "kernel_launch: memset of the barrier words failed\n"); return; }
    Args a{};
    for (int i = 0; i < 18; ++i) a.in[i] = (const float*)d_in[i];
    a.out = (float*)d_out; a.ws = (unsigned char*)d_ws;
#if MK_MULTI
    for (int ph = 0; ph < N_PHASES; ++ph) { a.ph_lo = ph; a.ph_hi = ph + 1; hipLaunchKernelGGL(mk_fwd, dim3(grid), dim3(NTHR), LDS_BYTES, stream, a); }
#else
    a.ph_lo = 0; a.ph_hi = N_PHASES;
    void* args[] = {&a};
    hipError_t e = hipLaunchCooperativeKernel((const void*)mk_fwd, dim3(grid), dim3(NTHR), args, LDS_BYTES, stream);
    if (e != hipSuccess) fprintf(stderr, "cooperative launch failed: %s (grid %d)\n", hipGetErrorString(e), grid);
#endif
}
```

```cpp
#include <hip/hip_runtime.h>
#include <hip/hip_cooperative_groups.h>
#include <cstdio>
#include <cstdint>
namespace cg = cooperative_groups;

#ifndef MK_MULTI
#define MK_MULTI 0
#endif

typedef _Float16 f16;
typedef _Float16 f16x8 __attribute__((ext_vector_type(8)));
typedef _Float16 f16x4 __attribute__((ext_vector_type(4)));
typedef float f32x4 __attribute__((ext_vector_type(4)));
typedef float f32x16 __attribute__((ext_vector_type(16)));
typedef int i32x4 __attribute__((ext_vector_type(4)));
typedef unsigned long long u64;
typedef unsigned short u16;

constexpr int NB = 8, NS = 8192, ND = 1024, NT = NB * NS;
constexpr int INW = 2632;
constexpr int NMAIN = 2304;
constexpr float EPS = 1e-6f;
constexpr int NTHR = 512, NWAVE = 8;

constexpr size_t MiB = 1u << 20;
constexpr size_t WS_CTL = 0;
constexpr size_t WS_MOD = 1 * MiB;
constexpr size_t WS_WIN = 2 * MiB;
constexpr size_t WS_WVT = 7 * MiB;
constexpr size_t WS_WOUT = 8 * MiB;
constexpr size_t WS_WQ = 10 * MiB;
constexpr size_t WS_SK = 14 * MiB;
constexpr size_t WS_PW = 14 * MiB + 512 * 1024;
constexpr size_t WS_QS = 1 * MiB + 512 * 1024;
constexpr size_t WS_UT = 16 * MiB;
constexpr size_t WS_VP = 48 * MiB;
constexpr size_t WS_H = 80 * MiB;
constexpr size_t WS_U = 208 * MiB;
constexpr size_t WS_Q = 272 * MiB;
constexpr size_t WS_K = 336 * MiB;
constexpr size_t WS_VT = 400 * MiB;
constexpr size_t WS_PQ = 208 * MiB;
constexpr size_t WS_WQ8 = 24 * MiB;
constexpr size_t WS_WSC = 26 * MiB;
constexpr size_t WS_HQ = 464 * MiB;
constexpr size_t WS_HSC = 528 * MiB;
constexpr size_t WS_QI = 464 * MiB;
constexpr size_t WS_KI = 528 * MiB;
constexpr size_t WS_WI = 536 * MiB;
constexpr size_t WS_MASK = 544 * MiB;
constexpr size_t WS_EID = 608 * MiB;
constexpr size_t WS_GW = 624 * MiB;
constexpr size_t WS_END = 656 * MiB;

constexpr int LDS_BYTES = 155648;
constexpr float PEER_QSTEP = 0.3352f;
constexpr float PEER_WSCALE = 16384.f;

struct Args { const float* in[18]; float* out; unsigned char* ws; int ph_lo, ph_hi; };

__host__ __device__ __forceinline__ int pos2log(int p) { return 64 * ((p >> 5) & 3) + 32 * (p >> 7) + 8 * ((p >> 2) & 3) + 4 * ((p >> 4) & 1) + (p & 3); }
__device__ __forceinline__ int maincol(int L) { if (L < 1536) return L; if (L < 2120) return L + 512; return -1; }

__device__ __forceinline__ float wave_sum(float v) {
#pragma unroll
    for (int o = 1; o < 64; o <<= 1) v += __shfl_xor(v, o);
    return v;
}
__device__ __forceinline__ float wave_max(float v) {
#pragma unroll
    for (int o = 1; o < 64; o <<= 1) v = fmaxf(v, __shfl_xor(v, o));
    return v;
}

__device__ void ph0_prologue(const Args& a, int bid, int nb, unsigned char* lds) {
    int tid = threadIdx.x; asm volatile("" : "+v"(tid));
    const float* c = a.in[1]; const float* ada_w = a.in[2]; const float* ada_b = a.in[3];
    float* sil = (float*)lds;
    for (int i = tid; i < NB * ND; i += NTHR) { const float v = c[i]; sil[i] = v / (1.f + __expf(-v)); }
    __syncthreads();
    float* mod = (float*)(a.ws + WS_MOD);
    const int gt = bid * NTHR + tid, ngt = nb * NTHR;
    for (int o = gt; o < NB * 6144; o += ngt) {
        const int b = o / 6144, j = o % 6144;
        float acc = ada_b[j];
        const float* sb = sil + b * ND;
        for (int k = 0; k < ND; ++k) acc += sb[k] * ada_w[(size_t)k * 6144 + j];
        mod[o] = acc;
    }
    const float* w_in = a.in[5]; const float* pool_w = a.in[6]; const float* w_out = a.in[12];
    const float* wq = a.in[14]; const float* sk = a.in[15]; const float* pu = a.in[16]; const float* pv = a.in[17];
    f16* WIN = (f16*)(a.ws + WS_WIN); f16* WVT = (f16*)(a.ws + WS_WVT); f16* WOUT = (f16*)(a.ws + WS_WOUT); f16* WQ = (f16*)(a.ws + WS_WQ);
 unsigned char* UT = a.ws + WS_UT; unsigned char* VP = a.ws + WS_VP;
    {
        __syncthreads();
        const int lane = tid & 63, wv_ = tid >> 6;
        float* scr = (float*)lds + wv_ * (64 * 33);
        constexpr int I_WQ = 16 * 64, I_Z = 16 * 16, I_INR = 16 * (NMAIN / 32 - 16), I_VT = 16 * 16, I_OUT = 16 * 32, I_ALL = I_WQ + I_Z + I_INR + I_VT + I_OUT;
        for (int it = bid * NWAVE + wv_; it < I_ALL; it += nb * NWAVE) {
            int rr = it, kind = 3, pboff = 0;
            if (rr >= I_WQ) { rr -= I_WQ; kind = 0;
                if (rr >= I_Z) { rr -= I_Z; pboff = 16;
                    if (rr >= I_INR) { rr -= I_INR; kind = 1; pboff = 0; if (rr >= I_VT) { rr -= I_VT; kind = 2; } } } }
            const int npb = kind == 0 ? (pboff ? NMAIN / 32 - 16 : 16) : kind == 1 ? 16 : kind == 2 ? 32 : 64;
            const int k0 = (rr / npb) * 64, p0 = (rr % npb + pboff) * 32, p = p0 + (lane & 31);
            const float* W = kind <= 1 ? w_in : kind == 2 ? w_out : wq; const int ldw = kind <= 1 ? INW : kind == 2 ? 1024 : 2048;
            int col;
            if (kind == 0) col = maincol((p & ~255) + pos2log(p & 255)); else if (kind == 1) col = 1536 + p; else col = (p & ~255) + pos2log(p & 255);
            const bool foldz = (kind == 0 && pboff == 0);
            if (foldz || kind == 3) {
                const int r5 = lane & 31, hh_ = lane >> 5;
                const int blk = __builtin_amdgcn_readfirstlane(col >> 7);
                const int sub = col & 127;
                const float* arow = W + (size_t)(k0 + r5) * ldw + blk * 128 + 8 * hh_;
                f32x16 acc0 = (f32x16){0.f, 0.f, 0.f, 0.f, 0.f, 0.f, 0.f, 0.f, 0.f, 0.f, 0.f, 0.f, 0.f, 0.f, 0.f, 0.f}, acc1 = acc0;
#pragma unroll 2
                for (int ks = 0; ks < 8; ++ks) {
                    const f32x4 a00 = *(const f32x4*)(arow + 16 * ks), a01 = *(const f32x4*)(arow + 16 * ks + 4);
                    const f32x4 a10 = *(const f32x4*)(arow + (size_t)32 * ldw + 16 * ks), a11 = *(const f32x4*)(arow + (size_t)32 * ldw + 16 * ks + 4);
                    f16x8 bfr;
                    if (kind == 3) { const float* br = sk + (size_t)(blk * 128 + sub) * 128 + 16 * ks + 8 * hh_; const f32x4 b0 = *(const f32x4*)br, b1 = *(const f32x4*)(br + 4);
                        bfr = (f16x8){(f16)b0[0], (f16)b0[1], (f16)b0[2], (f16)b0[3], (f16)b1[0], (f16)b1[1], (f16)b1[2], (f16)b1[3]}; }
                    else { const float* br = pool_w + (size_t)blk * 16384 + (size_t)(16 * ks + 8 * hh_) * 128 + sub;
                        bfr = (f16x8){(f16)br[0], (f16)br[128], (f16)br[256], (f16)br[384], (f16)br[512], (f16)br[640], (f16)br[768], (f16)br[896]}; }
                    const f16x8 af0 = (f16x8){(f16)a00[0], (f16)a00[1], (f16)a00[2], (f16)a00[3], (f16)a01[0], (f16)a01[1], (f16)a01[2], (f16)a01[3]};
                    const f16x8 af1 = (f16x8){(f16)a10[0], (f16)a10[1], (f16)a10[2], (f16)a10[3], (f16)a11[0], (f16)a11[1], (f16)a11[2], (f16)a11[3]};
                    acc0 = __builtin_amdgcn_mfma_f32_32x32x16_f16(af0, bfr, acc0, 0, 0, 0);
                    acc1 = __builtin_amdgcn_mfma_f32_32x32x16_f16(af1, bfr, acc1, 0, 0, 0);
                }
#pragma unroll
                for (int rg = 0; rg < 16; ++rg) { const int kk = (rg & 3) + 8 * (rg >> 2) + 4 * hh_; scr[kk * 33 + r5] = acc0[rg]; scr[(32 + kk) * 33 + r5] = acc1[rg]; }
            } else {
#pragma unroll 8
                for (int i = 0; i < 32; ++i) { const int kk = 2 * i + (lane >> 5); scr[kk * 33 + (lane & 31)] = col >= 0 ? W[(size_t)(k0 + kk) * ldw + col] : 0.f; }
            }
            f16* WT = kind == 0 ? WIN : kind == 1 ? WVT : kind == 2 ? WOUT : WQ;
            const int c8 = lane & 7;
#pragma unroll
            for (int j = 0; j < 4; ++j) { const int n = (lane >> 3) + 8 * j; const float* sp = scr + (8 * c8) * 33 + n;
                *(f16x8*)(WT + (size_t)(p0 + n) * ND + k0 + 8 * c8) = (f16x8){(f16)sp[0], (f16)sp[33], (f16)sp[66], (f16)sp[99], (f16)sp[132], (f16)sp[165], (f16)sp[198], (f16)sp[231]}; }
        }
    }
    {
        __syncthreads();
        float ssu = 0.f, ssv = 0.f;
        for (int i = tid; i < 64 * 1024 / 4; i += NTHR) { const f32x4 u = ((const f32x4*)pu)[i], v = ((const f32x4*)pv)[i];
            ssu += u.x * u.x + u.y * u.y + u.z * u.z + u.w * u.w; ssv += v.x * v.x + v.y * v.y + v.z * v.z + v.w * v.w; }
        ssu = wave_sum(ssu); ssv = wave_sum(ssv);
        float* red = (float*)lds;
        if ((tid & 63) == 0) { red[tid >> 6] = ssu; red[8 + (tid >> 6)] = ssv; }
        __syncthreads();
        float tu = 0.f, tv = 0.f;
#pragma unroll
        for (int w = 0; w < 8; ++w) { tu += red[w]; tv += red[8 + w]; }
        const float du = PEER_QSTEP * sqrtf(tu * (1.f / 65536.f)), dv = PEER_QSTEP * sqrtf(tv * (1.f / 65536.f));
        if (bid == 0 && tid == 0) { float* qs = (float*)(a.ws + WS_QS); qs[0] = du; qs[1] = dv; }
        const float idu = 1.f / du, idv = 1.f / dv;
        const int lane = tid & 63, wv_ = tid >> 6;
        for (int row = bid * NWAVE + wv_; row < 2 * 16384; row += nb * NWAVE) {
            const bool isv = row >= 16384; const int e = row & 16383;
            const float* src = (isv ? pv : pu) + (size_t)e * ND + 4 * lane; u16* dstq = (u16*)((isv ? VP : UT) + (size_t)e * 512) + lane;
            const float inv = isv ? idv : idu;
#pragma unroll
            for (int j = 0; j < 4; ++j) { const f32x4 x4 = *(const f32x4*)(src + 256 * j); unsigned pk = 0u, pb = 0u;
#pragma unroll
                for (int k = 0; k < 4; ++k) { int q = (int)floorf(x4[k] * inv); q = q < -8 ? -8 : q > 7 ? 7 : q; pk |= (unsigned)(q + 8) << (4 * k); pb |= (unsigned)(q + 8) << (8 * k); }
                const unsigned other = __shfl_xor(pb, 1);
                if (isv) dstq[64 * j] = (u16)pk;
                else if (!(lane & 1)) ((unsigned*)(UT + (size_t)e * 512))[(lane >> 1) + 32 * j] = pb | (other << 4); }
        }
    }
}

__device__ void row_norm_mod(const float* src, const float* g, const float* mod, int sh_off, int sc_off, f16* dst, int bid, int nb) {
    int tid_ = threadIdx.x; asm volatile("" : "+v"(tid_)); const int lane = tid_ & 63, wave = tid_ >> 6;
    for (int row = bid * NWAVE + wave; row < NT; row += nb * NWAVE) {
        const int b = row / NS;
        const f32x4* xr = (const f32x4*)(src + (size_t)row * ND) + lane;
        f32x4 v[4]; float s = 0.f;
#pragma unroll
        for (int j = 0; j < 4; ++j) { v[j] = xr[64 * j]; s += v[j].x * v[j].x + v[j].y * v[j].y + v[j].z * v[j].z + v[j].w * v[j].w; }
        const float rstd = rsqrtf(wave_sum(s) * (1.f / ND) + EPS);
#pragma unroll
        for (int j = 0; j < 4; ++j) {
            const int col = lane * 4 + 256 * j;
            const f32x4 gg = *(const f32x4*)(g + col), sc = *(const f32x4*)(mod + b * 6144 + sc_off + col), sh = *(const f32x4*)(mod + b * 6144 + sh_off + col);
            f16x4 o;
            o.x = (f16)(v[j].x * rstd * gg.x * (1.f + sc.x) + sh.x); o.y = (f16)(v[j].y * rstd * gg.y * (1.f + sc.y) + sh.y);
            o.z = (f16)(v[j].z * rstd * gg.z * (1.f + sc.z) + sh.z); o.w = (f16)(v[j].w * rstd * gg.w * (1.f + sc.w) + sh.w);
            *(f16x4*)(dst + (size_t)row * ND + col) = o;
        }
    }
}


__device__ void row_norm_mod_q(const float* src, const float* g, const float* mod, int sh_off, int sc_off, unsigned char* hq, float* hsc, int bid, int nb) {
    int tid_ = threadIdx.x; asm volatile("" : "+v"(tid_)); const int lane = tid_ & 63, wave = tid_ >> 6;
    for (int row = bid * NWAVE + wave; row < NT; row += nb * NWAVE) {
        const int b = row / NS;
        const float* xr = src + (size_t)row * ND + 8 * lane;
        f32x4 v[4]; float s = 0.f;
#pragma unroll
        for (int j = 0; j < 4; ++j) { v[j] = *(const f32x4*)(xr + 512 * (j >> 1) + 4 * (j & 1)); s += v[j].x * v[j].x + v[j].y * v[j].y + v[j].z * v[j].z + v[j].w * v[j].w; }
        const float rstd = rsqrtf(wave_sum(s) * (1.f / ND) + EPS);
        float o[16]; float am = 0.f;
#pragma unroll
        for (int j = 0; j < 4; ++j) {
            const int col = 8 * lane + 512 * (j >> 1) + 4 * (j & 1);
            const f32x4 gg = *(const f32x4*)(g + col), sc = *(const f32x4*)(mod + b * 6144 + sc_off + col), sh = *(const f32x4*)(mod + b * 6144 + sh_off + col);
#pragma unroll
            for (int k = 0; k < 4; ++k) { const float y = v[j][k] * rstd * gg[k] * (1.f + sc[k]) + sh[k]; o[4 * j + k] = y; am = fmaxf(am, fabsf(y)); }
        }
        am = wave_max(am);
        const float inv = am > 0.f ? 119.f / am : 0.f;
#pragma unroll
        for (int j = 0; j < 2; ++j) {
            unsigned p0 = 0u, p1 = 0u;
#pragma unroll
            for (int k = 0; k < 4; ++k) { p0 |= (unsigned)((int)rintf(o[8 * j + k] * inv) & 255) << (8 * k); p1 |= (unsigned)((int)rintf(o[8 * j + 4 + k] * inv) & 255) << (8 * k); }
            *(u64*)(hq + (size_t)row * ND + 8 * lane + 512 * j) = (u64)p0 | ((u64)p1 << 32);
        }
        if (lane == 0) hsc[row] = am * (1.f / 119.f);
    }
}
__device__ void wq_to_int8(const f16* WQ, unsigned char* WQ8, float* WSC, int bid, int nb) {
    int tid_ = threadIdx.x; asm volatile("" : "+v"(tid_)); const int lane = tid_ & 63, wave = tid_ >> 6;
    for (int row = bid * NWAVE + wave; row < 2048; row += nb * NWAVE) {
        const f16x8 a0 = *(const f16x8*)(WQ + (size_t)row * ND + 8 * lane), a1 = *(const f16x8*)(WQ + (size_t)row * ND + 8 * lane + 512);
        float am = 0.f;
#pragma unroll
        for (int k = 0; k < 8; ++k) am = fmaxf(am, fmaxf(fabsf((float)a0[k]), fabsf((float)a1[k])));
        am = wave_max(am);
        const float inv = am > 0.f ? 127.f / am : 0.f;
        unsigned p[4] = {0u, 0u, 0u, 0u};
#pragma unroll
        for (int k = 0; k < 4; ++k) { p[0] |= (unsigned)((int)rintf((float)a0[k] * inv) & 255) << (8 * k); p[1] |= (unsigned)((int)rintf((float)a0[4 + k] * inv) & 255) << (8 * k);
                                      p[2] |= (unsigned)((int)rintf((float)a1[k] * inv) & 255) << (8 * k); p[3] |= (unsigned)((int)rintf((float)a1[4 + k] * inv) & 255) << (8 * k); }
        *(u64*)(WQ8 + (size_t)row * ND + 8 * lane) = (u64)p[0] | ((u64)p[1] << 32);
        *(u64*)(WQ8 + (size_t)row * ND + 8 * lane + 512) = (u64)p[2] | ((u64)p[3] << 32);
        if (lane == 0) WSC[row] = am * (1.f / 127.f);
    }
}

namespace pg8 {
#define PG8_LAS __attribute__((address_space(3)))
constexpr int BM = 256, BK = 64, HALF = 128, HTB = HALF * BK * 2, STAGE_BYTES = 8 * HTB, NXCD = 8, WGM = 8;
__host__ __device__ __forceinline__ int lds_byte(int r, int c) { const int st = (r >> 4) * 2 + (c >> 5), rr = r & 15, cc = c & 31, ob = rr * 64 + cc * 2; return st * 1024 + (ob ^ (((ob >> 9) & 1) << 5)); }
__host__ __device__ __forceinline__ void stage_rc(int b, int& R, int& C) { const int st = b / 1024, sb = b % 1024, swz = sb ^ (((sb >> 9) & 1) << 5); R = (st >> 1) * 16 + swz / 64; C = (st & 1) * 32 + (swz % 64) / 2; }
struct Unit { int pm, pn; };
struct Gemm { const f16* A; const f16* Bt; int M, N, K; };
struct StaticOrder {
    int nM, nN, nwg, G, c;
    __host__ __device__ void init(int M, int N, int G_, int c_) { nM = M / BM; nN = N / BM; nwg = nM * nN; G = G_; c = c_; }
    __host__ __device__ bool next(int i, Unit& u) const {
        const long L = (long)i * G + c; if (L >= nwg) return false;
        int wgid = (int)L; { const int q = nwg / NXCD, r = nwg % NXCD, xcd = wgid % NXCD, off = wgid / NXCD; wgid = (xcd < r ? xcd * (q + 1) : r * (q + 1) + (xcd - r) * q) + off; }
        const int nig = WGM * nN, gid = wgid / nig, fm = gid * WGM, gsz = (nM - fm) < WGM ? (nM - fm) : WGM;
        u.pm = fm + ((wgid % nig) % gsz); u.pn = (wgid % nig) / gsz; return true;
    }
};
template <class Epi, bool I8 = false>
__device__ __forceinline__ void gemm_phase(PG8_LAS unsigned char* lds, const Gemm g, const StaticOrder& S, const Epi& E) {
    int tid = threadIdx.x; asm volatile("" : "+v"(tid));
    const int wid = __builtin_amdgcn_readfirstlane(tid >> 6), lane = tid & 63, wr = wid >> 2, wc = wid & 3, fr = lane & 15, fq = lane >> 4;
    const int K = g.K, nt = K / BK;
    unsigned voffA[2];
#pragma unroll
    for (int i = 0; i < 2; ++i) { int R, C; stage_rc(tid * 16 + i * 8192, R, C); voffA[i] = (unsigned)(R * K + C) * 2u; }
    const size_t kstep = (size_t)(BK * 2);
    const size_t hstep = (size_t)HALF * K * 2;
    const size_t tstep = 2 * hstep;
    const unsigned ldsw = (unsigned)wid * 1024u;
    const int aoff = lds_byte(wr * 64 + fr, fq * 8), boff = lds_byte(wc * 32 + fr, fq * 8);
#define PG8_SA(b, h) (((b) * 2 + (h)) * HTB)
#define PG8_SB(b, h) ((4 + (b) * 2 + (h)) * HTB)
#define PG8_STAGE(bufoff, gbase, voff) do { _Pragma("unroll") for (int _i = 0; _i < 2; ++_i) \
        __builtin_amdgcn_global_load_lds((const unsigned*)((const char*)(gbase) + (voff)[_i]), (PG8_LAS unsigned*)(lds + (bufoff) + ldsw + _i * 8192), 16, 0, 0); } while (0)
#define PG8_LDA(dst, b, h) do { _Pragma("unroll") for (int m = 0; m < 4; ++m) _Pragma("unroll") for (int k = 0; k < 2; ++k) dst[m][k] = *(const PG8_LAS f16x8*)(lds + PG8_SA(b, h) + aoff + m * 2048 + k * 1024); } while (0)
#define PG8_LDB(dst, b, h) do { _Pragma("unroll") for (int n = 0; n < 2; ++n) _Pragma("unroll") for (int k = 0; k < 2; ++k) dst[n][k] = *(const PG8_LAS f16x8*)(lds + PG8_SB(b, h) + boff + n * 2048 + k * 1024); } while (0)
#define PG8_MMA(ai, bj, At, Bt) do { __builtin_amdgcn_s_setprio(1); _Pragma("unroll") for (int m = 0; m < 4; ++m) _Pragma("unroll") for (int n = 0; n < 2; ++n) _Pragma("unroll") for (int k = 0; k < 2; ++k) \
        acc[ai][bj][m][n] = I8 ? __builtin_bit_cast(f32x4, __builtin_amdgcn_mfma_i32_16x16x64_i8(__builtin_bit_cast(i32x4, Bt[n][k]), __builtin_bit_cast(i32x4, At[m][k]), __builtin_bit_cast(i32x4, acc[ai][bj][m][n]), 0, 0, 0)) \
                                 : __builtin_amdgcn_mfma_f32_16x16x32_f16(Bt[n][k], At[m][k], acc[ai][bj][m][n], 0, 0, 0); __builtin_amdgcn_s_setprio(0); } while (0)
#define PG8_WAIT_V(n) asm volatile("s_waitcnt vmcnt(" #n ")" ::: "memory")
#define PG8_WAIT_L(n) asm volatile("s_waitcnt lgkmcnt(" #n ")" ::: "memory")
#define PG8_BAR __builtin_amdgcn_s_barrier()
#define PG8_SCHED __builtin_amdgcn_sched_barrier(0)
    Unit cur, nxt; int ui = 0;
    if (!S.next(0, cur)) return;
    f32x4 acc[2][2][4][2];
#pragma unroll
    for (int a = 0; a < 2; ++a)
#pragma unroll
        for (int b = 0; b < 2; ++b)
#pragma unroll
            for (int m = 0; m < 4; ++m)
#pragma unroll
                for (int n = 0; n < 2; ++n) acc[a][b][m][n] = (f32x4){0.f, 0.f, 0.f, 0.f};
    f16x8 At[4][2], B0[2][2], B1[2][2];
    const char* cA = (const char*)g.A + (size_t)cur.pm * tstep; const char* cB = (const char*)g.Bt + (size_t)cur.pn * tstep;
    PG8_STAGE(PG8_SB(0, 0), cB, voffA); PG8_STAGE(PG8_SB(0, 1), cB + hstep, voffA); PG8_STAGE(PG8_SA(0, 0), cA, voffA); PG8_STAGE(PG8_SA(0, 1), cA + hstep, voffA);
    if (wr == 1) PG8_BAR;
    PG8_WAIT_V(2); PG8_BAR;
    PG8_STAGE(PG8_SB(1, 0), cB + kstep, voffA); PG8_STAGE(PG8_SA(1, 0), cA + kstep, voffA); PG8_STAGE(PG8_SB(1, 1), cB + hstep + kstep, voffA);
    PG8_WAIT_V(6); PG8_BAR;
    for (;;) {
        const bool has_next = S.next(ui + 1, nxt);
        const char* nA = has_next ? (const char*)g.A + (size_t)nxt.pm * tstep : cA; const char* nB = has_next ? (const char*)g.Bt + (size_t)nxt.pn * tstep : cB;
        for (int t = 0; t < nt; t += 2) {
            const bool last = (t == nt - 2);
            const char* a1 = cA + (size_t)(t + 1) * kstep;
            const char* a2 = last ? nA : cA + (size_t)(t + 2) * kstep; const char* b2 = last ? nB : cB + (size_t)(t + 2) * kstep;
            const char* a3 = a2 + kstep; const char* b3 = b2 + kstep;
            PG8_LDB(B0, 0, 0); PG8_LDB(B1, 0, 1); PG8_SCHED; PG8_LDA(At, 0, 0); PG8_STAGE(PG8_SA(1, 1), a1 + hstep, voffA);
            PG8_WAIT_V(8); PG8_WAIT_L(0); PG8_BAR; PG8_MMA(0, 0, At, B0); PG8_MMA(0, 1, At, B1); PG8_BAR; PG8_SCHED;
            PG8_LDA(At, 0, 1); PG8_STAGE(PG8_SB(0, 0), b2, voffA); PG8_STAGE(PG8_SB(0, 1), b2 + hstep, voffA); PG8_STAGE(PG8_SA(0, 0), a2, voffA);
            PG8_WAIT_V(8); PG8_WAIT_L(0); PG8_BAR; PG8_MMA(1, 0, At, B0); PG8_MMA(1, 1, At, B1); PG8_BAR; PG8_SCHED;
            PG8_LDB(B0, 1, 0); PG8_LDB(B1, 1, 1); PG8_SCHED; PG8_LDA(At, 1, 0); PG8_STAGE(PG8_SA(0, 1), a2 + hstep, voffA);
            PG8_WAIT_V(8); PG8_WAIT_L(0); PG8_BAR; PG8_MMA(0, 0, At, B0); PG8_MMA(0, 1, At, B1); PG8_BAR; PG8_SCHED;
            PG8_LDA(At, 1, 1); PG8_STAGE(PG8_SB(1, 0), b3, voffA); PG8_STAGE(PG8_SB(1, 1), b3 + hstep, voffA); PG8_STAGE(PG8_SA(1, 0), a3, voffA);
            PG8_WAIT_V(8); PG8_WAIT_L(0); PG8_BAR; PG8_MMA(1, 0, At, B0); PG8_MMA(1, 1, At, B1); PG8_BAR; PG8_SCHED;
        }
        if (wr == 0) PG8_BAR;
        E(acc, cur, wr, wc, fr, fq);
        if (!has_next) break;
#pragma unroll
        for (int a = 0; a < 2; ++a)
#pragma unroll
            for (int b = 0; b < 2; ++b)
#pragma unroll
                for (int m = 0; m < 4; ++m)
#pragma unroll
                    for (int n = 0; n < 2; ++n) acc[a][b][m][n] = (f32x4){0.f, 0.f, 0.f, 0.f};
        cur = nxt; cA = nA; cB = nB; ++ui;
        if (wr == 1) PG8_BAR;
    }
    PG8_WAIT_V(0);
    PG8_BAR;
#undef PG8_SA
#undef PG8_SB
#undef PG8_STAGE
#undef PG8_LDA
#undef PG8_LDB
#undef PG8_MMA
#undef PG8_WAIT_V
#undef PG8_WAIT_L
#undef PG8_BAR
#undef PG8_SCHED
}

typedef f32x4 Acc[2][2][4][2];
struct EpiMain {
    unsigned char* ws; const float *qg, *kg;
    __device__ __forceinline__ void operator()(const Acc& acc, const Unit& u, int wr, int wc, int fr, int fq) const {
        const int row0 = u.pm * BM + wr * 64 + fr, pn = u.pn;
        if (pn == 8) {
            if (wc == 0) {
#pragma unroll
                for (int ai = 0; ai < 2; ++ai)
#pragma unroll
                    for (int m = 0; m < 4; ++m) { const size_t row = row0 + ai * HALF + m * 16;
#pragma unroll
                        for (int bj = 0; bj < 2; ++bj) { const f32x4 v0 = acc[ai][bj][m][0], v1 = acc[ai][bj][m][1];
                            *(f16x8*)((f16*)(ws + WS_KI) + (((row >> 5) * 8 + 4 * bj + fq) * 32 + (row & 31)) * 8) = (f16x8){(f16)v0[0], (f16)v0[1], (f16)v0[2], (f16)v0[3], (f16)v1[0], (f16)v1[1], (f16)v1[2], (f16)v1[3]}; } }
            } else if (wc == 1 && fq == 0) {
#pragma unroll
                for (int ai = 0; ai < 2; ++ai)
#pragma unroll
                    for (int m = 0; m < 4; ++m) { const size_t row = row0 + ai * HALF + m * 16;
                        *(f32x4*)((float*)(ws + WS_WI) + row * 8) = acc[ai][0][m][0] * 0.35355339059327373f; *(f32x4*)((float*)(ws + WS_WI) + row * 8 + 4) = acc[ai][0][m][1] * 0.35355339059327373f; }
            }
            return;
        }
        const int kind = pn >> 1;
        f16* base = (f16*)(ws + (kind == 0 ? WS_U : kind == 1 ? WS_Q : kind == 2 ? WS_K : WS_QI));
        const int col0 = (pn & 1) * 256 + 64 * wc + 8 * fq;
        if (kind == 1 || kind == 2) {
            const float* gp = (kind == 1 ? qg : kg) + 8 * fq;
#pragma unroll
            for (int ai = 0; ai < 2; ++ai)
#pragma unroll
                for (int m = 0; m < 4; ++m) { const size_t row = row0 + ai * HALF + m * 16;
                    float ss = 0.f;
#pragma unroll
                    for (int bj = 0; bj < 2; ++bj)
#pragma unroll
                        for (int n = 0; n < 2; ++n) { const f32x4 v = acc[ai][bj][m][n]; ss += v[0] * v[0] + v[1] * v[1] + v[2] * v[2] + v[3] * v[3]; }
                    ss += __shfl_xor(ss, 16); ss += __shfl_xor(ss, 32);
                    const float rstd = rsqrtf(ss * (1.f / 64.f) + EPS);
#pragma unroll
                    for (int bj = 0; bj < 2; ++bj) { const f32x4 v0 = acc[ai][bj][m][0] * rstd * *(const f32x4*)(gp + 32 * bj), v1 = acc[ai][bj][m][1] * rstd * *(const f32x4*)(gp + 32 * bj + 4);
                        *(f16x8*)(base + row * 512 + col0 + 32 * bj) = (f16x8){(f16)v0[0], (f16)v0[1], (f16)v0[2], (f16)v0[3], (f16)v1[0], (f16)v1[1], (f16)v1[2], (f16)v1[3]}; }
                    asm volatile("" ::: "memory"); }
        } else if (kind == 3) {
            const int hd = (pn & 1) * 4 + wc;
#pragma unroll
            for (int ai = 0; ai < 2; ++ai)
#pragma unroll
                for (int m = 0; m < 4; ++m) { const size_t row = row0 + ai * HALF + m * 16; const int ql = (int)(row & 7);
                    const int rr = (hd & 3) | (((ql >> 1) & 1) << 2) | ((hd >> 2) << 3) | ((ql & 1) << 4);
#pragma unroll
                    for (int bj = 0; bj < 2; ++bj) { const f32x4 v0 = acc[ai][bj][m][0], v1 = acc[ai][bj][m][1]; const int chunk = fq + 4 * bj;
                        *(f16x8*)(base + ((((((row >> 3) * 2 + (ql >> 2)) * 4 + (chunk >> 1)) * 2 + (chunk & 1)) * 32 + rr) << 3)) = (f16x8){(f16)v0[0], (f16)v0[1], (f16)v0[2], (f16)v0[3], (f16)v1[0], (f16)v1[1], (f16)v1[2], (f16)v1[3]}; } }
        } else {
#pragma unroll
            for (int ai = 0; ai < 2; ++ai)
#pragma unroll
                for (int m = 0; m < 4; ++m) { const size_t row = row0 + ai * HALF + m * 16;
#pragma unroll
                    for (int bj = 0; bj < 2; ++bj) { const f32x4 v0 = acc[ai][bj][m][0], v1 = acc[ai][bj][m][1];
                        *(f16x8*)(base + row * 512 + col0 + 32 * bj) = (f16x8){(f16)v0[0], (f16)v0[1], (f16)v0[2], (f16)v0[3], (f16)v1[0], (f16)v1[1], (f16)v1[2], (f16)v1[3]}; } }
        }
    }
};
struct EpiVT {
    f16* VT;
    __device__ __forceinline__ void operator()(const Acc& acc, const Unit& u, int wr, int wc, int fr, int fq) const {
        const int row0 = u.pm * BM + wr * 64 + fr, col0 = u.pn * BM + 32 * wc + 4 * fq;
#pragma unroll
        for (int ai = 0; ai < 2; ++ai)
#pragma unroll
            for (int m = 0; m < 4; ++m) { const size_t row = row0 + ai * HALF + m * 16;
#pragma unroll
                for (int bj = 0; bj < 2; ++bj)
#pragma unroll
                    for (int n = 0; n < 2; ++n) { const f32x4 v = acc[ai][bj][m][n];
                        *(f16x4*)(VT + row * NT + col0 + 128 * bj + 16 * n) = (f16x4){(f16)v[0], (f16)v[1], (f16)v[2], (f16)v[3]}; } }
    }
};
struct EpiOut {
    const float* x; const float* mod; float* out;
    __device__ __forceinline__ void operator()(const Acc& acc, const Unit& u, int wr, int wc, int fr, int fq) const {
        const int row0 = u.pm * BM + wr * 64 + fr, col0 = u.pn * BM + 64 * wc + 8 * fq;
        const float* g1 = mod + ((u.pm * BM) / NS) * 6144 + 2048 + col0;
        f32x4 g4[2][2];
#pragma unroll
        for (int bj = 0; bj < 2; ++bj)
#pragma unroll
            for (int n = 0; n < 2; ++n) g4[bj][n] = *(const f32x4*)(g1 + 32 * bj + 4 * n);
#pragma unroll
        for (int ai = 0; ai < 2; ++ai)
#pragma unroll
            for (int m = 0; m < 4; ++m) { const size_t off = (size_t)(row0 + ai * HALF + m * 16) * ND + col0;
#pragma unroll
                for (int bj = 0; bj < 2; ++bj)
#pragma unroll
                    for (int n = 0; n < 2; ++n) { const f32x4 xv = *(const f32x4*)(x + off + 32 * bj + 4 * n);
                        *(f32x4*)(out + off + 32 * bj + 4 * n) = xv + g4[bj][n] * acc[ai][bj][m][n]; } }
    }
};
struct EpiPQ {
    f16* PQ; const float* hsc; const float* wsc;
    __device__ __forceinline__ void operator()(const Acc& acc, const Unit& u, int wr, int wc, int fr, int fq) const {
        const int row0 = u.pm * BM + wr * 64 + fr, col0 = u.pn * BM + 64 * wc + 8 * fq;
        f32x4 ws4[2][2];
#pragma unroll
        for (int bj = 0; bj < 2; ++bj)
#pragma unroll
            for (int n = 0; n < 2; ++n) ws4[bj][n] = *(const f32x4*)(wsc + u.pn * BM + 128 * bj + 32 * wc + 16 * n + 4 * fq);
#pragma unroll
        for (int ai = 0; ai < 2; ++ai)
#pragma unroll
            for (int m = 0; m < 4; ++m) { const size_t row = row0 + ai * HALF + m * 16; const float hs = hsc[row];
#pragma unroll
                for (int bj = 0; bj < 2; ++bj) { const i32x4 i0 = __builtin_bit_cast(i32x4, acc[ai][bj][m][0]), i1 = __builtin_bit_cast(i32x4, acc[ai][bj][m][1]);
                    const f32x4 v0 = (f32x4){(float)i0[0], (float)i0[1], (float)i0[2], (float)i0[3]} * ws4[bj][0] * hs, v1 = (f32x4){(float)i1[0], (float)i1[1], (float)i1[2], (float)i1[3]} * ws4[bj][1] * hs;
                    *(f16x8*)(PQ + ((((row >> 5) * 256 + ((col0 + 32 * bj) >> 3)) * 32 + (row & 31)) << 3)) = (f16x8){(f16)v0[0], (f16)v0[1], (f16)v0[2], (f16)v0[3], (f16)v1[0], (f16)v1[1], (f16)v1[2], (f16)v1[3]}; } }
    }
};
}

__device__ __forceinline__ void ph2_inproj(const Args& a, int bid, int nb, unsigned char* lds) {
    const f16* H = (const f16*)(a.ws + WS_H); const f16* WIN = (const f16*)(a.ws + WS_WIN); const f16* WVT = (const f16*)(a.ws + WS_WVT);
    PG8_LAS unsigned char* l3 = (PG8_LAS unsigned char*)lds;
    { pg8::Gemm g{H, WIN, NT, NMAIN, ND}; pg8::StaticOrder S; S.init(NT, NMAIN, nb, bid);
      pg8::EpiMain E{a.ws, a.in[9], a.in[10]};
      pg8::gemm_phase(l3, g, S, E); }
    { pg8::Gemm g{WVT, H, 512, NT, ND}; pg8::StaticOrder S; S.init(512, NT, nb, bid);
      pg8::EpiVT E{(f16*)(a.ws + WS_VT)};
      pg8::gemm_phase(l3, g, S, E); }
}


constexpr int PPITCH = 1040;
__device__ __forceinline__ void ph3_pool_fast(const Args& a, int bid, int nb, unsigned char* lds) {
    int tid = threadIdx.x; asm volatile("" : "+v"(tid));
    const int cg8 = tid & 63, tq = tid >> 6, gch = cg8 >> 4, win = 2 << gch;
    const f16* Z = (const f16*)(a.ws + WS_U); f16* MIX = (f16*)(a.ws + WS_H);
    const f32x4 ps0 = *(const f32x4*)(a.in[7] + 8 * cg8), ps1 = *(const f32x4*)(a.in[7] + 8 * cg8 + 4), pg0 = *(const f32x4*)(a.in[8] + 8 * cg8), pg1 = *(const f32x4*)(a.in[8] + 8 * cg8 + 4);
    const float psc[8] = {ps0[0], ps0[1], ps0[2], ps0[3], ps1[0], ps1[1], ps1[2], ps1[3]}, pgn[8] = {pg0[0], pg0[1], pg0[2], pg0[3], pg1[0], pg1[1], pg1[2], pg1[3]};
    for (int item = bid; item < NT / 32; item += nb) {
        const int tb = item * 32 + 4 * tq, tl0 = tb % NS;
        const f16* up = Z + (size_t)(tb - tl0) * 512 + 8 * cg8;
        float sm[8];
#pragma unroll
        for (int j = 0; j < 8; ++j) sm[j] = 0.f;
        f16x8 hist_[15];
#pragma unroll
        for (int q = 0; q < 15; ++q) { const int rr = tl0 - 15 + q; hist_[q] = (q >= 16 - win && rr >= 0) ? *(const f16x8*)(up + (size_t)rr * 512) : (f16x8){0, 0, 0, 0, 0, 0, 0, 0}; }
        f16x8 cur_[4];
#pragma unroll
        for (int k = 0; k < 4; ++k) cur_[k] = *(const f16x8*)(up + (size_t)(tl0 + k) * 512);
#pragma unroll
        for (int q = 0; q < 15; ++q)
#pragma unroll
            for (int j = 0; j < 8; ++j) sm[j] += (float)hist_[q][j];
#pragma unroll
        for (int k = 0; k < 4; ++k) {
            const int tl = tl0 + k;
            const float ic = 1.f / (float)((tl + 1 < win) ? tl + 1 : win);
            float v[8]; float ss = 0.f;
#pragma unroll
            for (int j = 0; j < 8; ++j) { sm[j] += (float)cur_[k][j]; v[j] = (sm[j] * ic - (float)cur_[k][j]) * psc[j]; ss += v[j] * v[j]; }
            const float rstd = rsqrtf(wave_sum(ss) * (1.f / 512.f) + EPS);
            f16x8 o;
#pragma unroll
            for (int j = 0; j < 8; ++j) o[j] = (f16)(v[j] * rstd * pgn[j]);
            *(f16x8*)(MIX + (size_t)(tb + k) * ND + 8 * cg8) = o;
            if (k < 3) {
#pragma unroll
                for (int j = 0; j < 8; ++j) {
                    const int q = 16 - win + k;
                    float dv = 0.f;
#pragma unroll
                    for (int qq = 0; qq < 15; ++qq) if (qq == q) dv = (float)hist_[qq][j];
#pragma unroll
                    for (int kk = 0; kk < 3; ++kk) if (q == 15 + kk) dv = (float)cur_[kk][j];
                    sm[j] -= dv;
                }
            }
        }
    }
}


typedef float f32x2 __attribute__((ext_vector_type(2)));
typedef unsigned u32x4 __attribute__((ext_vector_type(4)));

constexpr int IDX_KPITCH = 16384 + 16;
constexpr int IDX_HPITCH = 516;
template <int NBL>
__device__ __forceinline__ int wave_pick(const unsigned (&cc)[NBL], unsigned target, int lane, unsigned& rem_out) {
    unsigned tot = 0u;
#pragma unroll
    for (int j = 0; j < NBL; ++j) tot += cc[j];
    unsigned S = tot;
#pragma unroll
    for (int o = 1; o < 64; o <<= 1) { const unsigned v = __shfl_down(S, o); if (lane + o < 64) S += v; }
    const unsigned above = S - tot;
    const bool hit = (above < target) && (S >= target);
    const u64 bal = __ballot(hit);
    const int L = bal ? __builtin_ctzll(bal) : 0;
    int bin = 0; unsigned rem = target;
    { unsigned run = above; bool done = false;
#pragma unroll
      for (int j = NBL - 1; j >= 0; --j) { if (!done) { if (run + cc[j] >= target) { bin = NBL * lane + j; rem = target - run; done = true; } else run += cc[j]; } } }
    bin = __shfl(bin, L); rem_out = __shfl(rem, L);
    return bin;
}
template <int MODE>
__device__ __forceinline__ void ph3_index_fast(const Args& a, int bid, int nb, unsigned char* lds) {
    int tid = threadIdx.x; asm volatile("" : "+v"(tid));
    const int lane = tid & 63, wave = __builtin_amdgcn_readfirstlane(tid >> 6), r = lane & 31, hh = lane >> 5;
    const f16* QI = (const f16*)(a.ws + WS_QI); const f16* KI = (const f16*)(a.ws + WS_KI); const float* WI = (const float*)(a.ws + WS_WI);
    u64* MASK = (u64*)(a.ws + WS_MASK);
    unsigned* hist = (unsigned*)(lds + 8 * IDX_KPITCH);
    f16x8 af[2][4]; f32x2 wv2[2][8];
#define IDX_LOAD_FRAGS(t0_) do { \
        _Pragma("unroll") for (int rt = 0; rt < 2; ++rt) { \
            _Pragma("unroll") for (int ks = 0; ks < 4; ++ks) af[rt][ks] = *(const f16x8*)(QI + ((((((size_t)((t0_) >> 3) * 2 + rt) * 4 + ks) * 2 + hh) * 32 + r) << 3)); \
            _Pragma("unroll") for (int qq = 0; qq < 2; ++qq) { const float* wp = WI + (size_t)((t0_) + 4 * rt + 2 * hh + qq) * 8; const f32x4 w0 = *(const f32x4*)wp * 0.125f, w1 = *(const f32x4*)(wp + 4) * 0.125f; \
                wv2[rt][4 * qq + 0] = (f32x2){w0[0], w0[1]}; wv2[rt][4 * qq + 1] = (f32x2){w0[2], w0[3]}; wv2[rt][4 * qq + 2] = (f32x2){w1[0], w1[1]}; wv2[rt][4 * qq + 3] = (f32x2){w1[2], w1[3]}; } \
        } } while (0)
    for (int round = 0; round * nb < 256; ++round) {
        const int p = round * nb + ((round & 1) ? (nb - 1 - bid) : bid);
        if (p < 256) { const int tg = p >> 3, b_ = p & 7, t0l = tg * 8, ch_ = t0l >> 6, t0_ = b_ * NS + t0l;
            if (tid < 8 * (ch_ + 1)) { const int q = tid / (ch_ + 1), w = tid % (ch_ + 1); MASK[((size_t)b_ * 128 + w) * NS + t0l + q] = ~0ull; } }
    }
#define IDX_P(round_) ((round_) * nb + (((round_) & 1) ? (nb - 1 - bid) : bid))
    int round = 0;
    while (round * nb < 8192 && !(IDX_P(round) >= 256 && IDX_P(round) < 8192)) ++round;
    if (round * nb < 8192) { const int p0 = IDX_P(round); IDX_LOAD_FRAGS((p0 & 7) * NS + (p0 >> 3) * 8); }
    for (; round * nb < 8192; ) {
        const int p = IDX_P(round);
        int rnext = round + 1;
        while (rnext * nb < 8192 && !(IDX_P(rnext) >= 256 && IDX_P(rnext) < 8192)) ++rnext;
        const bool has_next = rnext * nb < 8192;
        const int pn = has_next ? IDX_P(rnext) : p;
        const int tg = p >> 3, b = p & 7, t0l = tg * 8, ch = t0l >> 6, nadm = 64 * (ch + 1), t0 = b * NS + t0l;
        const int t0n = (pn & 7) * NS + (pn >> 3) * 8;
        round = has_next ? rnext : 8192;
        __syncthreads();
#pragma unroll
        for (int i = 0; i < 9; ++i) if (tid + i * NTHR < 8 * IDX_HPITCH) hist[tid + i * NTHR] = 0u;
        __syncthreads();
        const int nkb = nadm >> 5;
        const f16* kbase = KI + ((size_t)(b * (NS / 32)) * 8 + hh) * 256 + r * 8;
#define IDX_LOADB(dst, kb_) do { _Pragma("unroll") for (int ks = 0; ks < 4; ++ks) dst[ks] = *(const f16x8*)(kbase + ((size_t)(kb_) * 8 + 2 * ks) * 256); } while (0)
#define IDX_BLOCK(bfrag, kb_) do { \
            f32x16 acc[2]; \
            _Pragma("unroll") for (int rt = 0; rt < 2; ++rt) { acc[rt] = (f32x16){0.f, 0.f, 0.f, 0.f, 0.f, 0.f, 0.f, 0.f, 0.f, 0.f, 0.f, 0.f, 0.f, 0.f, 0.f, 0.f}; \
                _Pragma("unroll") for (int ks = 0; ks < 4; ++ks) acc[rt] = __builtin_amdgcn_mfma_f32_32x32x16_f16(af[rt][ks], bfrag[ks], acc[rt], 0, 0, 0); } \
            _Pragma("unroll") for (int rt = 0; rt < 2; ++rt) \
                _Pragma("unroll") for (int qq = 0; qq < 2; ++qq) { \
                    f32x2 t2 = (f32x2){0.f, 0.f}; \
                    _Pragma("unroll") for (int hp = 0; hp < 4; ++hp) { const f32x2 r2 = (f32x2){__int_as_float(max(__float_as_int(acc[rt][8 * qq + 2 * hp]), 0)), __int_as_float(max(__float_as_int(acc[rt][8 * qq + 2 * hp + 1]), 0))}; \
                        t2 = __builtin_elementwise_fma(wv2[rt][4 * qq + hp], r2, t2); } \
                    const float sc = t2[0] + t2[1]; \
                    const f16 sh = (f16)sc; const unsigned bits = (unsigned)__builtin_bit_cast(unsigned short, sh); \
                    const unsigned key = (bits & 0x8000u) ? (~bits & 0xFFFFu) : (bits | 0x8000u); \
                    const int q = 4 * rt + 2 * hh + qq; \
                    if (MODE != 2) *(u16*)(lds + q * IDX_KPITCH + ((kb_) * 32 + r) * 2) = (u16)key; \
                    if (MODE != 2 && MODE != 4) atomicAdd(&hist[q * IDX_HPITCH + (key >> 7)], (key & 64u) ? 0x10000u : 1u); \
                    if (MODE == 2) sink += key; \
                } } while (0)
        f16x8 bf0[4], bf1[4], bf2[4]; unsigned sink = 0u;
        if (wave >= 4) __builtin_amdgcn_s_sleep(5);
        if (wave < nkb) IDX_LOADB(bf0, wave);
        if (wave + 8 < nkb) IDX_LOADB(bf1, wave + 8);
        if (wave + 16 < nkb) IDX_LOADB(bf2, wave + 16);
        if (MODE != 3) for (int kb = wave; kb < nkb; kb += 24) {
            IDX_BLOCK(bf0, kb);
            if (kb + 24 < nkb) IDX_LOADB(bf0, kb + 24);
            if (kb + 8 < nkb) { IDX_BLOCK(bf1, kb + 8); if (kb + 32 < nkb) IDX_LOADB(bf1, kb + 32); }
            if (kb + 16 < nkb) { IDX_BLOCK(bf2, kb + 16); if (kb + 40 < nkb) IDX_LOADB(bf2, kb + 40); }
        }
#undef IDX_LOADB
#undef IDX_BLOCK
        if (MODE == 2 && sink == 0xdeadbeefu) hist[tid] = sink;
        IDX_LOAD_FRAGS(t0n);
        __syncthreads();
        if (MODE != 1) {
            unsigned* hw = hist + wave * IDX_HPITCH;
            const unsigned char* krow = lds + wave * IDX_KPITCH;
            unsigned rem1 = 0u, rem2 = 0u;
            int b1;
            {   const u32x4 d0 = *(const u32x4*)(hw + 8 * lane), d1 = *(const u32x4*)(hw + 8 * lane + 4);
                const unsigned dd[8] = {d0.x, d0.y, d0.z, d0.w, d1.x, d1.y, d1.z, d1.w};
                unsigned cc[16];
#pragma unroll
                for (int j = 0; j < 8; ++j) { cc[2 * j] = dd[j] & 0xFFFFu; cc[2 * j + 1] = dd[j] >> 16; }
                b1 = wave_pick<16>(cc, 256u, lane, rem1); }
            hw[lane] = 0u;
            const int nit = (nadm + 511) >> 9;
            for (int it = 0; it < nit; ++it) {
                const int idx = (it * 64 + lane) * 8;
                if (idx < nadm) { const u32x4 k4 = *(const u32x4*)(krow + idx * 2);
                    const unsigned kk[4] = {k4.x, k4.y, k4.z, k4.w};
                    unsigned hit = 0u;
#pragma unroll
                    for (int j = 0; j < 4; ++j) { hit |= (((kk[j] & 0xFFFFu) >> 6) == (unsigned)b1 ? 1u : 0u) << (2 * j); hit |= ((kk[j] >> 22) == (unsigned)b1 ? 1u : 0u) << (2 * j + 1); }
                    if (hit) {
#pragma unroll
                        for (int j = 0; j < 4; ++j) { const unsigned k0 = kk[j] & 0xFFFFu, k1 = kk[j] >> 16;
                            if (hit & (1u << (2 * j))) atomicAdd(&hw[k0 & 63u], 1u);
                            if (hit & (2u << (2 * j))) atomicAdd(&hw[k1 & 63u], 1u); }
                    } }
            }
            int b2;
            { const unsigned c1[1] = {hw[lane]}; b2 = wave_pick<1>(c1, rem1, lane, rem2); }
            const unsigned tau = ((unsigned)b1 << 6) | (unsigned)b2;
            const size_t mrow = (size_t)(t0 + wave) * 128;
            for (int it = 0; it < nit; ++it) {
                const int idx = (it * 64 + lane) * 8;
                unsigned byte = 0u;
                if (idx < nadm) { const u32x4 k4 = *(const u32x4*)(krow + idx * 2);
                    const unsigned kk[4] = {k4.x, k4.y, k4.z, k4.w};
#pragma unroll
                    for (int j = 0; j < 4; ++j) { byte |= ((kk[j] & 0xFFFFu) >= tau ? 1u : 0u) << (2 * j); byte |= ((kk[j] >> 16) >= tau ? 1u : 0u) << (2 * j + 1); } }
                unsigned lo = (lane & 4) ? 0u : (byte << (8 * (lane & 3))), hi = (lane & 4) ? (byte << (8 * (lane & 3))) : 0u;
                lo |= __shfl_xor(lo, 1); hi |= __shfl_xor(hi, 1); lo |= __shfl_xor(lo, 2); hi |= __shfl_xor(hi, 2); lo |= __shfl_xor(lo, 4); hi |= __shfl_xor(hi, 4);
                if ((lane & 7) == 0 && idx < nadm) { hw[64 + 2 * (it * 8 + (lane >> 3))] = lo; hw[64 + 2 * (it * 8 + (lane >> 3)) + 1] = hi; }
            }
        }
        __syncthreads();
        if (MODE != 1) { const int w = tid >> 2, qp = tid & 3;
            if (w <= ch) { const unsigned* ha = hist + (2 * qp) * IDX_HPITCH + 64 + 2 * w; const unsigned* hb = ha + IDX_HPITCH;
                *(u32x4*)(MASK + ((size_t)b * 128 + w) * NS + t0l + 2 * qp) = (u32x4){ha[0], ha[1], hb[0], hb[1]}; } }
    }
    __syncthreads();
}

constexpr int ATP = 144;
constexpr int ATT_QWORD = 3584 + 32 * 64;
template <int AMODE>
__device__ __forceinline__ void ph4_attn_fast(const Args& a, int bid, int nb, unsigned char* lds) {
    int tid = threadIdx.x; asm volatile("" : "+v"(tid));
    const int lane = tid & 63, wave = __builtin_amdgcn_readfirstlane(tid >> 6), r = lane & 31, hh = lane >> 5;
    const f16* Q = (const f16*)(a.ws + WS_Q); const f16* Kk = (const f16*)(a.ws + WS_K); const f16* VT = (const f16*)(a.ws + WS_VT);
    const u64* MASK = (const u64*)(a.ws + WS_MASK); f16* MIX = (f16*)(a.ws + WS_H); const float* og = a.in[11];
    unsigned char* Kl = lds; unsigned char* Vl = lds + 2 * 64 * ATP;
    const float LOG2E = 1.4426950408889634f, OFF = 8192.f;
    const int pir = 16 * (r >> 4) + 8 * ((r >> 2) & 1) + 4 * ((r >> 3) & 1) + (r & 3);
    const int srow = tid >> 3, schk = tid & 7;
    unsigned* aq = (unsigned*)(a.ws + WS_CTL) + ATT_QWORD;
    volatile unsigned* ucell = (volatile unsigned*)(lds + 6 * 64 * ATP);
    volatile unsigned* dflag = ucell + 8;
    const float kmax = __int_as_float(__builtin_amdgcn_readfirstlane(__float_as_int(1.01f * 8.f * wave_max(fabsf(a.in[10][lane])))));
    int upar = 0;
    for (;;) {
        if (tid == 0) ucell[upar] = __hip_atomic_fetch_add(aq, 1u, __ATOMIC_RELAXED, __HIP_MEMORY_SCOPE_AGENT);
        if (tid < 8) dflag[tid] = 0u;
        __syncthreads();
        const unsigned u = ucell[upar]; upar ^= 1;
        if (u >= 2048u) break;
        const int h = 7 - (int)(u >> 8), qb = 31 - (int)((u & 255u) >> 3), b = (int)(u & 7u);
        const int q0l = qb * 256, tq = q0l + 32 * wave + r, cw = 4 * qb + (wave >> 1), top = 4 * qb + 3;
        const size_t t = (size_t)b * NS + tq;
        const float slope = exp2f(-(float)(h + 1)) * LOG2E;
        f16x8 qf[4];
#pragma unroll
        for (int ks = 0; ks < 4; ++ks) { const f16x8 qv = *(const f16x8*)(Q + t * 512 + h * 64 + 16 * ks + 8 * hh);
#pragma unroll
            for (int j = 0; j < 8; ++j) qf[ks][j] = (f16)((float)qv[j] * (0.125f * LOG2E)); }
        float qss = 0.f;
#pragma unroll
        for (int ks = 0; ks < 4; ++ks)
#pragma unroll
            for (int j = 0; j < 8; ++j) qss += (float)qf[ks][j] * (float)qf[ks][j];
        qss += __shfl_xor(qss, 32);
        const float Sb = __int_as_float(__builtin_amdgcn_readfirstlane(__float_as_int(wave_max(sqrtf(qss)) * kmax)));
        const float rowc = OFF + slope * (float)(tq - q0l);
        float m = 1000.f, l = 0.f;
        f32x16 O[2];
#pragma unroll
        for (int dt = 0; dt < 2; ++dt) O[dt] = (f32x16){0.f, 0.f, 0.f, 0.f, 0.f, 0.f, 0.f, 0.f, 0.f, 0.f, 0.f, 0.f, 0.f, 0.f, 0.f, 0.f};
        const f16* kg = Kk + ((size_t)b * NS + srow) * 512 + h * 64 + schk * 8;
        const f16* vg = VT + (size_t)(h * 64 + srow) * NT + (size_t)b * NS + schk * 8;
        f16x8 kr0, kr1, vr0, vr1; u64 mw0 = 0ull, mw1 = 0ull;
#define ATT_LOAD(kr, vr, mwv, jj) do { if ((jj) >= 0) { kr = *(const f16x8*)(kg + (size_t)(jj) * 64 * 512); vr = *(const f16x8*)(vg + (jj) * 64); mwv = ((jj) <= cw) ? MASK[((size_t)b * 128 + (jj)) * NS + tq] : 0ull; } } while (0)
        ATT_LOAD(kr0, vr0, mw0, top); ATT_LOAD(kr1, vr1, mw1, top - 1);
        int buf = 0; bool wdone = false, stop = false;
        auto step = [&](f16x8& kreg, f16x8& vreg, u64& mwr, const int j) {
            *(f16x8*)(Kl + buf * 64 * ATP + srow * ATP + schk * 16) = kreg;
            *(f16x8*)(Vl + buf * 64 * ATP + srow * ATP + schk * 16) = vreg;
            const u64 mw = mwr;
            asm volatile("s_waitcnt lgkmcnt(0)" ::: "memory"); __builtin_amdgcn_s_barrier(); asm volatile("" ::: "memory");
            {
                const unsigned jp = (unsigned)(j + 1);
                if ((dflag[0] > jp) & (dflag[1] > jp) & (dflag[2] > jp) & (dflag[3] > jp) & (dflag[4] > jp) & (dflag[5] > jp) & (dflag[6] > jp) & (dflag[7] > jp)) { stop = true; return; }
            }
            ATT_LOAD(kreg, vreg, mwr, j - 2);
            if (!wdone && j < cw) { const float lmax = Sb + OFF + slope * (float)(64 * j + 63 - q0l); if (__all(lmax - m < -28.f)) { wdone = true; if (lane == 0) dflag[wave] = (unsigned)(j + 1); } }
            if (j <= cw && !wdone) {
                const unsigned char* kb_ = Kl + buf * 64 * ATP + pir * ATP + 16 * hh;
                f16x8 fr8[8];
#pragma unroll
                for (int kt = 0; kt < 2; ++kt)
#pragma unroll
                    for (int ks = 0; ks < 4; ++ks) fr8[kt * 4 + ks] = *(const f16x8*)(kb_ + kt * 32 * ATP + ks * 32);
                f32x16 sa[2];
                if (j == cw) {
#pragma unroll
                    for (int kt = 0; kt < 2; ++kt)
#pragma unroll
                        for (int rg = 0; rg < 16; ++rg) { const float x = (float)(64 * j + 32 * kt + 16 * (rg >> 3) + 8 * hh + (rg & 7) - tq); sa[kt][rg] = rowc - slope * fabsf(x); }
                } else {
                    const float base = OFF + slope * (float)(64 * j + 8 * hh - q0l);
#pragma unroll
                    for (int kt = 0; kt < 2; ++kt)
#pragma unroll
                        for (int rg = 0; rg < 16; ++rg) sa[kt][rg] = __builtin_fmaf(slope, (float)(32 * kt + 16 * (rg >> 3) + (rg & 7)), base);
                }
                __builtin_amdgcn_sched_barrier(0);
                __builtin_amdgcn_s_setprio(1);
#pragma unroll
                for (int kt = 0; kt < 2; ++kt)
#pragma unroll
                    for (int ks = 0; ks < 4; ++ks) sa[kt] = __builtin_amdgcn_mfma_f32_32x32x16_f16(fr8[kt * 4 + ks], qf[ks], sa[kt], 0, 0, 0);
                __builtin_amdgcn_s_setprio(0);
                __builtin_amdgcn_sched_barrier(0);
                const unsigned char* vb_ = Vl + buf * 64 * ATP + r * ATP + 16 * hh;
#pragma unroll
                for (int dt = 0; dt < 2; ++dt)
#pragma unroll
                    for (int kt = 0; kt < 2; ++kt)
#pragma unroll
                        for (int s2 = 0; s2 < 2; ++s2) fr8[dt * 4 + kt * 2 + s2] = *(const f16x8*)(vb_ + dt * 32 * ATP + kt * 64 + s2 * 32);
                __builtin_amdgcn_sched_barrier(0);
                float rm = 0.f;
#pragma unroll
                for (int kt = 0; kt < 2; ++kt) { const unsigned w32 = (unsigned)(kt ? (mw >> 32) : mw) >> (8 * hh);
#pragma unroll
                    for (int rg = 0; rg < 16; ++rg) { const int tm = __builtin_amdgcn_sbfe((int)w32, 16 * (rg >> 3) + (rg & 7), 1);
                        const float L = __int_as_float(__float_as_int(sa[kt][rg]) & tm); sa[kt][rg] = L; rm = fmaxf(rm, L); } }
                rm = fmaxf(rm, __shfl_xor(rm, 32));
                const float mn = fmaxf(m, rm);
                if (__any(mn > m)) { const float al = __builtin_amdgcn_exp2f(m - mn); l *= al;
#pragma unroll
                    for (int dt = 0; dt < 2; ++dt)
#pragma unroll
                        for (int rg = 0; rg < 16; ++rg) O[dt][rg] *= al; }
                m = mn;
                f16x8 pf[2][2];
                float l0 = 0.f, l1 = 0.f;
#pragma unroll
                for (int kt = 0; kt < 2; ++kt)
#pragma unroll
                    for (int rg = 0; rg < 16; ++rg) { const float pp = __builtin_amdgcn_exp2f(sa[kt][rg] - m); if (rg & 1) l1 += pp; else l0 += pp; pf[kt][rg >> 3][rg & 7] = (f16)pp; }
                l += l0 + l1;
                __builtin_amdgcn_sched_barrier(0);
                __builtin_amdgcn_s_setprio(1);
#pragma unroll
                for (int dt = 0; dt < 2; ++dt)
#pragma unroll
                    for (int kt = 0; kt < 2; ++kt)
#pragma unroll
                        for (int s2 = 0; s2 < 2; ++s2) O[dt] = __builtin_amdgcn_mfma_f32_32x32x16_f16(fr8[dt * 4 + kt * 2 + s2], pf[kt][s2], O[dt], 0, 0, 0);
                __builtin_amdgcn_s_setprio(0);
            }
            buf ^= 1;
        };
        for (int j = top; j >= 0; j -= 2) {
            step(kr0, vr0, mw0, j); if (stop) break;
            if (j - 1 >= 0) { step(kr1, vr1, mw1, j - 1); if (stop) break; }
        }
#undef ATT_LOAD
        l += __shfl_xor(l, 32);
        const float inv = 1.f / l;
        float ss = 0.f;
#pragma unroll
        for (int dt = 0; dt < 2; ++dt)
#pragma unroll
            for (int rg = 0; rg < 16; ++rg) { O[dt][rg] *= inv; ss += O[dt][rg] * O[dt][rg]; }
        ss += __shfl_xor(ss, 32);
        const float rstd = rsqrtf(ss * (1.f / 64.f) + EPS);
#pragma unroll
        for (int dt = 0; dt < 2; ++dt)
#pragma unroll
            for (int g4 = 0; g4 < 4; ++g4) { const int d = 32 * dt + 8 * g4 + 4 * hh; const f32x4 gg = *(const f32x4*)(og + h * 64 + d);
                f16x4 o4; o4.x = (f16)(O[dt][4 * g4 + 0] * rstd * gg.x); o4.y = (f16)(O[dt][4 * g4 + 1] * rstd * gg.y); o4.z = (f16)(O[dt][4 * g4 + 2] * rstd * gg.z); o4.w = (f16)(O[dt][4 * g4 + 3] * rstd * gg.w);
                *(f16x4*)(MIX + t * ND + 512 + h * 64 + d) = o4; }
        __syncthreads();
    }
}

__device__ __forceinline__ void ph5_outproj(const Args& a, int bid, int nb, unsigned char* lds) {
    pg8::Gemm g{(const f16*)(a.ws + WS_H), (const f16*)(a.ws + WS_WOUT), NT, 1024, ND}; pg8::StaticOrder S; S.init(NT, 1024, nb, bid);
    pg8::EpiOut E{a.in[0], (const float*)(a.ws + WS_MOD), a.out};
    pg8::gemm_phase((PG8_LAS unsigned char*)lds, g, S, E);
}

__device__ __forceinline__ void ph7_peerq(const Args& a, int bid, int nb, unsigned char* lds) {
    pg8::Gemm g{(const f16*)(a.ws + WS_HQ), (const f16*)(a.ws + WS_WQ8), NT, 2048, ND / 2}; pg8::StaticOrder S; S.init(NT, 2048, nb, bid);
    pg8::EpiPQ E{(f16*)(a.ws + WS_PQ), (const float*)(a.ws + WS_HSC), (const float*)(a.ws + WS_WSC)};
    pg8::gemm_phase<pg8::EpiPQ, true>((PG8_LAS unsigned char*)lds, g, S, E);
}


__device__ __forceinline__ unsigned f2skey(float f) { const unsigned u = __float_as_uint(f); return (u & 0x80000000u) ? ~u : (u | 0x80000000u); }
__device__ __forceinline__ float skey2f(unsigned k) { return __uint_as_float((k & 0x80000000u) ? (k & 0x7FFFFFFFu) : ~k); }
#define CE_(a_, b_) do { const unsigned t__ = max(a_, b_); b_ = min(a_, b_); a_ = t__; } while (0)
#define SORT16_DESC(v) do { CE_(v[0], v[1]); CE_(v[2], v[3]); CE_(v[0], v[2]); CE_(v[1], v[3]); CE_(v[1], v[2]); CE_(v[4], v[5]); CE_(v[6], v[7]); CE_(v[4], v[6]); CE_(v[5], v[7]); CE_(v[5], v[6]); CE_(v[0], v[4]); CE_(v[2], v[6]); CE_(v[2], v[4]); CE_(v[1], v[5]); CE_(v[3], v[7]); CE_(v[3], v[5]); CE_(v[1], v[2]); CE_(v[3], v[4]); CE_(v[5], v[6]); CE_(v[8], v[9]); CE_(v[10], v[11]); CE_(v[8], v[10]); CE_(v[9], v[11]); CE_(v[9], v[10]); CE_(v[12], v[13]); CE_(v[14], v[15]); CE_(v[12], v[14]); CE_(v[13], v[15]); CE_(v[13], v[14]); CE_(v[8], v[12]); CE_(v[10], v[14]); CE_(v[10], v[12]); CE_(v[9], v[13]); CE_(v[11], v[15]); CE_(v[11], v[13]); CE_(v[9], v[10]); CE_(v[11], v[12]); CE_(v[13], v[14]); CE_(v[0], v[8]); CE_(v[4], v[12]); CE_(v[4], v[8]); CE_(v[2], v[10]); CE_(v[6], v[14]); CE_(v[6], v[10]); CE_(v[2], v[4]); CE_(v[6], v[8]); CE_(v[10], v[12]); CE_(v[1], v[9]); CE_(v[5], v[13]); CE_(v[5], v[9]); CE_(v[3], v[11]); CE_(v[7], v[15]); CE_(v[7], v[11]); CE_(v[3], v[5]); CE_(v[7], v[9]); CE_(v[11], v[13]); CE_(v[1], v[2]); CE_(v[3], v[4]); CE_(v[5], v[6]); CE_(v[7], v[8]); CE_(v[9], v[10]); CE_(v[11], v[12]); CE_(v[13], v[14]); } while (0)
#define BITONIC16_DESC(v) do { CE_(v[0], v[8]); CE_(v[1], v[9]); CE_(v[2], v[10]); CE_(v[3], v[11]); CE_(v[4], v[12]); CE_(v[5], v[13]); CE_(v[6], v[14]); CE_(v[7], v[15]); CE_(v[0], v[4]); CE_(v[1], v[5]); CE_(v[2], v[6]); CE_(v[3], v[7]); CE_(v[8], v[12]); CE_(v[9], v[13]); CE_(v[10], v[14]); CE_(v[11], v[15]); CE_(v[0], v[2]); CE_(v[1], v[3]); CE_(v[4], v[6]); CE_(v[5], v[7]); CE_(v[8], v[10]); CE_(v[9], v[11]); CE_(v[12], v[14]); CE_(v[13], v[15]); CE_(v[0], v[1]); CE_(v[2], v[3]); CE_(v[4], v[5]); CE_(v[6], v[7]); CE_(v[8], v[9]); CE_(v[10], v[11]); CE_(v[12], v[13]); CE_(v[14], v[15]); } while (0)
#define MERGE16_DESC(dst, other) do { unsigned c__[16]; _Pragma("unroll") for (int i__ = 0; i__ < 16; ++i__) c__[i__] = max(dst[i__], other[15 - i__]); BITONIC16_DESC(c__); _Pragma("unroll") for (int i__ = 0; i__ < 16; ++i__) dst[i__] = c__[i__]; } while (0)
#define TOP16_INSERT(v, x_) do { unsigned x__ = (x_); _Pragma("unroll") for (int k_ = 0; k_ < 16; ++k_) { const unsigned t__ = max(v[k_], x__); x__ = min(v[k_], x__); v[k_] = t__; } } while (0)
__device__ __forceinline__ void ph8_peersel_fast(const Args& a, int bid, int nb, unsigned char* lds) {
    int tid = threadIdx.x; asm volatile("" : "+v"(tid));
    const int lane = tid & 63, wave = __builtin_amdgcn_readfirstlane(tid >> 6), r = lane & 31, hh = lane >> 5;
    const f16* PQ = (const f16*)(a.ws + WS_PQ);
    u16* EID = (u16*)(a.ws + WS_EID); float* GW = (float*)(a.ws + WS_GW);
    unsigned char* wl = lds + wave * 2048 + lane * 32;
    for (int item = bid * NWAVE + wave; item < (NT / 32) * 8; item += nb * NWAVE) {
        const int tt = item >> 3, h = item & 7, t0 = tt * 32;
        unsigned top[2][16];
#pragma unroll
        for (int p = 0; p < 2; ++p) {
            f16x8 sq[8];
#pragma unroll
            for (int c = 0; c < 8; ++c) sq[c] = *(const f16x8*)(PQ + ((((size_t)tt * 256 + h * 32 + p * 16 + 8 * hh + c) * 32 + r) << 3));
#pragma unroll
            for (int k = 0; k < 16; ++k) top[p][k] = 0u;
#pragma unroll
            for (int g = 0; g < 4; ++g) {
                unsigned ky[16];
#pragma unroll
                for (int i = 0; i < 16; ++i) { const unsigned n = 64u * hh + 16u * g + i; ky[i] = (f2skey((float)sq[2 * g + (i >> 3)][i & 7]) & ~127u) | n; }
                SORT16_DESC(ky); MERGE16_DESC(top[p], ky);
            }
            unsigned oth[16];
#pragma unroll
            for (int k = 0; k < 16; ++k) oth[k] = __shfl_xor(top[p][k], 32);
            MERGE16_DESC(top[p], oth);
            asm volatile("" ::: "memory");
        }
#pragma unroll
        for (int k = 0; k < 16; k += 4) {
            *(unsigned*)(wl + k) = (top[0][k] & 127u) | ((top[0][k + 1] & 127u) << 8) | ((top[0][k + 2] & 127u) << 16) | ((top[0][k + 3] & 127u) << 24);
            *(unsigned*)(wl + 16 + k) = (top[1][k] & 127u) | ((top[1][k + 1] & 127u) << 8) | ((top[1][k + 2] & 127u) << 16) | ((top[1][k + 3] & 127u) << 24);
        }
        float fa[16], fb[16];
#pragma unroll
        for (int k = 0; k < 16; ++k) { fa[k] = skey2f(top[0][k] & ~127u); fb[k] = skey2f(top[1][k] & ~127u); }
        unsigned cg[4][16];
        cg[0][0] = (f2skey(fa[0] + fb[0]) & ~255u) | 0u;
        cg[0][1] = (f2skey(fa[0] + fb[1]) & ~255u) | 1u;
        cg[0][2] = (f2skey(fa[0] + fb[2]) & ~255u) | 2u;
        cg[0][3] = (f2skey(fa[0] + fb[3]) & ~255u) | 3u;
        cg[0][4] = (f2skey(fa[0] + fb[4]) & ~255u) | 4u;
        cg[0][5] = (f2skey(fa[0] + fb[5]) & ~255u) | 5u;
        cg[0][6] = (f2skey(fa[0] + fb[6]) & ~255u) | 6u;
        cg[0][7] = (f2skey(fa[0] + fb[7]) & ~255u) | 7u;
        cg[0][8] = (f2skey(fa[0] + fb[8]) & ~255u) | 8u;
        cg[0][9] = (f2skey(fa[0] + fb[9]) & ~255u) | 9u;
        cg[0][10] = (f2skey(fa[0] + fb[10]) & ~255u) | 10u;
        cg[0][11] = (f2skey(fa[0] + fb[11]) & ~255u) | 11u;
        cg[0][12] = (f2skey(fa[0] + fb[12]) & ~255u) | 12u;
        cg[0][13] = (f2skey(fa[0] + fb[13]) & ~255u) | 13u;
        cg[0][14] = (f2skey(fa[0] + fb[14]) & ~255u) | 14u;
        cg[0][15] = (f2skey(fa[0] + fb[15]) & ~255u) | 15u;
        cg[1][0] = (f2skey(fa[1] + fb[0]) & ~255u) | 16u;
        cg[1][1] = (f2skey(fa[1] + fb[1]) & ~255u) | 17u;
        cg[1][2] = (f2skey(fa[1] + fb[2]) & ~255u) | 18u;
        cg[1][3] = (f2skey(fa[1] + fb[3]) & ~255u) | 19u;
        cg[1][4] = (f2skey(fa[1] + fb[4]) & ~255u) | 20u;
        cg[1][5] = (f2skey(fa[1] + fb[5]) & ~255u) | 21u;
        cg[1][6] = (f2skey(fa[1] + fb[6]) & ~255u) | 22u;
        cg[1][7] = (f2skey(fa[1] + fb[7]) & ~255u) | 23u;
        cg[1][8] = (f2skey(fa[2] + fb[0]) & ~255u) | 32u;
        cg[1][9] = (f2skey(fa[2] + fb[1]) & ~255u) | 33u;
        cg[1][10] = (f2skey(fa[2] + fb[2]) & ~255u) | 34u;
        cg[1][11] = (f2skey(fa[2] + fb[3]) & ~255u) | 35u;
        cg[1][12] = (f2skey(fa[2] + fb[4]) & ~255u) | 36u;
        cg[1][13] = (f2skey(fa[3] + fb[0]) & ~255u) | 48u;
        cg[1][14] = (f2skey(fa[3] + fb[1]) & ~255u) | 49u;
        cg[1][15] = (f2skey(fa[3] + fb[2]) & ~255u) | 50u;
        cg[2][0] = (f2skey(fa[3] + fb[3]) & ~255u) | 51u;
        cg[2][1] = (f2skey(fa[4] + fb[0]) & ~255u) | 64u;
        cg[2][2] = (f2skey(fa[4] + fb[1]) & ~255u) | 65u;
        cg[2][3] = (f2skey(fa[4] + fb[2]) & ~255u) | 66u;
        cg[2][4] = (f2skey(fa[5] + fb[0]) & ~255u) | 80u;
        cg[2][5] = (f2skey(fa[5] + fb[1]) & ~255u) | 81u;
        cg[2][6] = (f2skey(fa[6] + fb[0]) & ~255u) | 96u;
        cg[2][7] = (f2skey(fa[6] + fb[1]) & ~255u) | 97u;
        cg[2][8] = (f2skey(fa[7] + fb[0]) & ~255u) | 112u;
        cg[2][9] = (f2skey(fa[7] + fb[1]) & ~255u) | 113u;
        cg[2][10] = (f2skey(fa[8] + fb[0]) & ~255u) | 128u;
        cg[2][11] = (f2skey(fa[9] + fb[0]) & ~255u) | 144u;
        cg[2][12] = (f2skey(fa[10] + fb[0]) & ~255u) | 160u;
        cg[2][13] = (f2skey(fa[11] + fb[0]) & ~255u) | 176u;
        cg[2][14] = (f2skey(fa[12] + fb[0]) & ~255u) | 192u;
        cg[2][15] = (f2skey(fa[13] + fb[0]) & ~255u) | 208u;
        cg[3][0] = (f2skey(fa[14] + fb[0]) & ~255u) | 224u;
        cg[3][1] = (f2skey(fa[15] + fb[0]) & ~255u) | 240u;
        cg[3][2] = 0u;
        cg[3][3] = 0u;
        cg[3][4] = 0u;
        cg[3][5] = 0u;
        cg[3][6] = 0u;
        cg[3][7] = 0u;
        cg[3][8] = 0u;
        cg[3][9] = 0u;
        cg[3][10] = 0u;
        cg[3][11] = 0u;
        cg[3][12] = 0u;
        cg[3][13] = 0u;
        cg[3][14] = 0u;
        cg[3][15] = 0u;
        SORT16_DESC(cg[0]); SORT16_DESC(cg[1]); SORT16_DESC(cg[2]); SORT16_DESC(cg[3]);
        MERGE16_DESC(cg[0], cg[1]); MERGE16_DESC(cg[2], cg[3]); MERGE16_DESC(cg[0], cg[2]);
        unsigned ct[16];
#pragma unroll
        for (int k = 0; k < 16; ++k) ct[k] = cg[0][k];
        float sc[16]; float den = 0.f; const float s0 = skey2f(ct[0] & ~255u);
#pragma unroll
        for (int k = 0; k < 16; ++k) { sc[k] = __expf(skey2f(ct[k] & ~255u) - s0); den += sc[k]; }
        const float inv = 1.f / den;
        if (hh == 0) {
            u16 ev[16];
#pragma unroll
            for (int k = 0; k < 16; ++k) { const unsigned ij = ct[k] & 255u; const unsigned i1 = wl[ij >> 4], i2 = wl[16 + (ij & 15u)]; ev[k] = (u16)(i1 * 128u + i2); }
            const size_t o = (size_t)(t0 + r) * 128 + h * 16;
#pragma unroll
            for (int k = 0; k < 16; k += 8) {
                *(u32x4*)(EID + o + k) = (u32x4){(unsigned)ev[k] | ((unsigned)ev[k + 1] << 16), (unsigned)ev[k + 2] | ((unsigned)ev[k + 3] << 16), (unsigned)ev[k + 4] | ((unsigned)ev[k + 5] << 16), (unsigned)ev[k + 6] | ((unsigned)ev[k + 7] << 16)};
            }
#pragma unroll
            for (int k = 0; k < 16; k += 4) *(f32x4*)(GW + o + k) = (f32x4){sc[k] * inv, sc[k + 1] * inv, sc[k + 2] * inv, sc[k + 3] * inv};
        }
    }
}

typedef _Float16 f16x2 __attribute__((ext_vector_type(2)));
__device__ __forceinline__ float gelu_erf(float d) { return 0.5f * d * (1.f + erff(d * 0.70710678118654752f)); }
constexpr int PQ_WORD0 = 3584, PQ_CHUNK = 64, PQ_NCHUNK = NT / PQ_CHUNK, PQ_HALF = PQ_NCHUNK / 2;
constexpr size_t WS_PART = 208 * MiB;
__device__ __forceinline__ unsigned xcc_id_() { return (unsigned)__builtin_amdgcn_s_getreg((3 << 11) | 20) & 7u; }
template <int VPHASE>
__device__ __forceinline__ void ph9_sliced(const Args& a, unsigned char* lds) {
    int tid_ = threadIdx.x; asm volatile("" : "+v"(tid_)); const int lane = tid_ & 63, wave = __builtin_amdgcn_readfirstlane(tid_ >> 6);
    const int g8 = lane >> 3, c8 = lane & 7;
    const unsigned char* HQ = a.ws + WS_HQ; const float* HSC = (const float*)(a.ws + WS_HSC); const unsigned char* TAB = a.ws + (VPHASE ? WS_VP : WS_UT);
    const u16* EID = (const u16*)(a.ws + WS_EID); const float* GW = (const float*)(a.ws + WS_GW); float* PART = (float*)(a.ws + WS_PART);
    const float* mod = (const float*)(a.ws + WS_MOD); float* out = a.out;
    unsigned* qw = (unsigned*)(a.ws + WS_CTL) + PQ_WORD0 + (VPHASE ? 8 * 64 : 0);
    volatile unsigned* cslot = (volatile unsigned*)lds;
    const bool b5 = (lane & 32) != 0, b4 = (lane & 16) != 0, b3 = (lane & 8) != 0, b2 = (lane & 4) != 0, b1 = (lane & 2) != 0, b0 = (lane & 1) != 0;
    const unsigned x0 = xcc_id_();
    int par = 0;
    for (int k = 0; k < 8; ++k) {
        const unsigned qi_ = (x0 + (unsigned)k) & 7u, sl = qi_ & 3u, half = qi_ >> 2;
        unsigned cur = 0u;
        if (tid_ == 0) cur = __hip_atomic_fetch_add(qw + 64 * qi_, 1u, __ATOMIC_RELAXED, __HIP_MEMORY_SCOPE_AGENT);
        for (;;) {
            if (tid_ == 0) cslot[par] = cur;
            __syncthreads();
            const unsigned c = cslot[par]; par ^= 1;
            if (c >= (unsigned)PQ_HALF) break;
            if (tid_ == 0) cur = __hip_atomic_fetch_add(qw + 64 * qi_, 1u, __ATOMIC_RELAXED, __HIP_MEMORY_SCOPE_AGENT);
            const int tb = (int)(half * PQ_HALF + c) * PQ_CHUNK + wave * (PQ_CHUNK / NWAVE);
            const unsigned char* tsl = TAB + 128 * sl + 16 * c8;
#pragma unroll 1
            for (int i8 = 0; i8 < PQ_CHUNK / NWAVE; ++i8) {
                const int t = tb + i8;
                const u32x4 e0 = *(const u32x4*)(EID + (size_t)t * 128 + 16 * g8), e1 = *(const u32x4*)(EID + (size_t)t * 128 + 16 * g8 + 8);
                const unsigned ew[8] = {e0.x, e0.y, e0.z, e0.w, e1.x, e1.y, e1.z, e1.w};
                u32x4 r8[16];
#pragma unroll
                for (int i = 0; i < 16; ++i) { const unsigned eid = (i & 1) ? (ew[i >> 1] >> 16) : (ew[i >> 1] & 0xFFFFu); r8[i] = *(const u32x4*)(tsl + (size_t)eid * 512); }
                if (!VPHASE) {
                    const u32x4 h0 = *(const u32x4*)(HQ + (size_t)t * 1024 + 256 * sl + 32 * c8), h1 = *(const u32x4*)(HQ + (size_t)t * 1024 + 256 * sl + 32 * c8 + 16);
                    const int hv[8] = {(int)h0.x, (int)h0.y, (int)h0.z, (int)h0.w, (int)h1.x, (int)h1.y, (int)h1.z, (int)h1.w};
                    const float hsc = 0.5f * HSC[t];
                    int hsum = 0;
#pragma unroll
                    for (int d = 0; d < 8; ++d) hsum = __builtin_amdgcn_sdot4(hv[d], 0x01010101, hsum, false);
                    float p[16];
#pragma unroll
                    for (int i = 0; i < 16; ++i) { int dd = 0;
#pragma unroll
                        for (int j = 0; j < 4; ++j) { const unsigned x = r8[i][j];
                            dd = __builtin_amdgcn_sdot4(hv[2 * j], (int)(x & 0x0F0F0F0Fu), dd, false); dd = __builtin_amdgcn_sdot4(hv[2 * j + 1], (int)((x >> 4) & 0x0F0F0F0Fu), dd, false); }
                        p[i] = (float)(2 * dd - 15 * hsum); }
                    float q8[8], q4[4], r2[2];
#pragma unroll
                    for (int ii = 0; ii < 8; ++ii) { const float keep = b2 ? p[8 + ii] : p[ii], send = b2 ? p[ii] : p[8 + ii]; q8[ii] = keep + __shfl_xor(send, 4); }
#pragma unroll
                    for (int ii = 0; ii < 4; ++ii) { const float keep = b1 ? q8[4 + ii] : q8[ii], send = b1 ? q8[ii] : q8[4 + ii]; q4[ii] = keep + __shfl_xor(send, 2); }
#pragma unroll
                    for (int ii = 0; ii < 2; ++ii) { const float keep = b0 ? q4[2 + ii] : q4[ii], send = b0 ? q4[ii] : q4[2 + ii]; r2[ii] = keep + __shfl_xor(send, 1); }
                    *(f32x2*)(PART + ((size_t)sl * NT + t) * 128 + 16 * g8 + 2 * c8) = (f32x2){r2[0] * hsc, r2[1] * hsc};
                } else {
                    const float* wp = GW + (size_t)t * 128 + 16 * g8;
                    const f32x4 wq0 = *(const f32x4*)wp, wq1 = *(const f32x4*)(wp + 4), wq2 = *(const f32x4*)(wp + 8), wq3 = *(const f32x4*)(wp + 12);
                    const float wv[16] = {wq0[0], wq0[1], wq0[2], wq0[3], wq1[0], wq1[1], wq1[2], wq1[3], wq2[0], wq2[1], wq2[2], wq2[3], wq3[0], wq3[1], wq3[2], wq3[3]};
                    float wsum = 0.f;
#pragma unroll
                    for (int i = 0; i < 16; ++i) wsum += wv[i];
                    const f16 off = (f16)(-7.5f * 5.9604644775390625e-08f * wsum);
                    f16x2 acc2[16];
#pragma unroll
                    for (int j = 0; j < 16; ++j) acc2[j] = (f16x2){off, off};
#pragma unroll
                    for (int i = 0; i < 16; ++i) { const f16x2 wa = (f16x2){(f16)wv[i], (f16)wv[i]}; const f16x2 wb = wa * (f16x2){(f16)0.0625f, (f16)0.0625f};
#pragma unroll
                        for (int j = 0; j < 4; ++j) { const unsigned x = r8[i][j], y = x >> 8;
                            acc2[4 * j]     = __builtin_elementwise_fma(wa, __builtin_bit_cast(f16x2, x & 0x000F000Fu), acc2[4 * j]);
                            acc2[4 * j + 1] = __builtin_elementwise_fma(wb, __builtin_bit_cast(f16x2, x & 0x00F000F0u), acc2[4 * j + 1]);
                            acc2[4 * j + 2] = __builtin_elementwise_fma(wa, __builtin_bit_cast(f16x2, y & 0x000F000Fu), acc2[4 * j + 2]);
                            acc2[4 * j + 3] = __builtin_elementwise_fma(wb, __builtin_bit_cast(f16x2, y & 0x00F000F0u), acc2[4 * j + 3]); } }
                    float acc[32];
#pragma unroll
                    for (int j = 0; j < 4; ++j)
#pragma unroll
                        for (int q = 0; q < 4; ++q) { acc[8 * j + q] = (float)acc2[4 * j + q][0]; acc[8 * j + 4 + q] = (float)acc2[4 * j + q][1]; }
                    float q16[16], q8[8], r4[4];
#pragma unroll
                    for (int ii = 0; ii < 16; ++ii) { const float keep = b5 ? acc[16 + ii] : acc[ii], send = b5 ? acc[ii] : acc[16 + ii]; q16[ii] = keep + __shfl_xor(send, 32); }
#pragma unroll
                    for (int ii = 0; ii < 8; ++ii) { const float keep = b4 ? q16[8 + ii] : q16[ii], send = b4 ? q16[ii] : q16[8 + ii]; q8[ii] = keep + __shfl_xor(send, 16); }
#pragma unroll
                    for (int ii = 0; ii < 4; ++ii) { const float keep = b3 ? q8[4 + ii] : q8[ii], send = b3 ? q8[ii] : q8[4 + ii]; r4[ii] = keep + __shfl_xor(send, 8); }
                    const int ch = 256 * sl + 32 * c8 + 4 * g8;
                    float* op = out + (size_t)t * ND + ch; const float* g2 = mod + (t / NS) * 6144 + 5120 + ch;
                    const f32x4 o4 = *(const f32x4*)op, gg = *(const f32x4*)g2;
                    *(f32x4*)op = o4 + gg * ((f32x4){r4[0], r4[1], r4[2], r4[3]} * (16777216.f / PEER_WSCALE));
                }
            }
        }
    }
}
__device__ __forceinline__ void ph9b_combine(const Args& a, int bid, int nb) {
    int tid_ = threadIdx.x; asm volatile("" : "+v"(tid_));
    float* GW = (float*)(a.ws + WS_GW); const float* PART = (const float*)(a.ws + WS_PART);
    const float du = ((const float*)(a.ws + WS_QS))[0], dv = ((const float*)(a.ws + WS_QS))[1] * PEER_WSCALE;
    for (size_t i = (size_t)bid * NTHR + tid_; i < (size_t)NT * 128 / 4; i += (size_t)nb * NTHR) {
        f32x4 sum = ((const f32x4*)PART)[i];
#pragma unroll
        for (int sidx = 1; sidx < 4; ++sidx) sum += ((const f32x4*)(PART + (size_t)sidx * NT * 128))[i];
        const f32x4 g = ((const f32x4*)GW)[i];
        f32x4 w;
#pragma unroll
        for (int j = 0; j < 4; ++j) w[j] = fminf(fmaxf(g[j] * gelu_erf(sum[j] * du) * dv, -60000.f), 60000.f);
        ((f32x4*)GW)[i] = w;
    }
}

#define LAS __attribute__((address_space(3)))
#define XB_TMO      128
#define XB_XCNT(j)  (256  + 64 * (j))
#define XB_XSUB(j)  (1280 + 64 * (j))
#define XB_XGEN(j)  (2304 + 64 * (j))
#define XB_TOP      3328
#define XB_TOPGEN   3392
#define XCD_BAR_WORDS 3456
#define XB_SPIN_CAP (1u << 18)
__device__ __forceinline__ unsigned xb_ld(unsigned* p)              { return __hip_atomic_load(p, __ATOMIC_RELAXED, __HIP_MEMORY_SCOPE_AGENT); }
__device__ __forceinline__ unsigned xb_add(unsigned* p, unsigned v) { return __hip_atomic_fetch_add(p, v, __ATOMIC_RELAXED, __HIP_MEMORY_SCOPE_AGENT); }
__device__ __forceinline__ unsigned xb_xcc_id() { return (unsigned)__builtin_amdgcn_s_getreg((3 << 11) | 20) & 0xFu; }
#define XB_SPIN(cond, bar) do { unsigned _sp = 0; while (cond) { __builtin_amdgcn_s_sleep(1); \
    if ((++_sp & 255u) == 0u) { if (xb_ld(&(bar)[XB_TMO])) break; if (_sp > XB_SPIN_CAP) { atomicAdd(&(bar)[XB_TMO], 1u); break; } } } } while (0)
struct XcdBarrier { unsigned* bar; unsigned x; volatile LAS unsigned* st; };
__device__ __forceinline__ XcdBarrier xcd_barrier_post(unsigned* bar, volatile LAS unsigned* st) {
    XcdBarrier b; b.bar = bar; b.x = xb_xcc_id(); b.st = st;
    if (threadIdx.x == 0) (void)xb_add(&bar[XB_XCNT(b.x)], 1u);
    return b;
}
__device__ __forceinline__ void xcd_barrier_complete(unsigned* bar, unsigned x, unsigned& nloc, unsigned& nx) {
    const unsigned G = gridDim.x * gridDim.y * gridDim.z;
    unsigned sum, cnt, mine, sp = 0u;
    for (;;) {
        sum = 0u; cnt = 0u; mine = 0u;
#pragma unroll
        for (unsigned j = 0; j < 16; ++j) { const unsigned c = xb_ld(&bar[XB_XCNT(j)]); sum += c; cnt += (c > 0u) ? 1u : 0u; mine = (j == x) ? c : mine; }
        if (sum == G) break;
        __builtin_amdgcn_s_sleep(1);
        if ((++sp & 255u) == 0u) { if (xb_ld(&bar[XB_TMO])) break; if (sp > XB_SPIN_CAP) { atomicAdd(&bar[XB_TMO], 1u); break; } }
    }
    nloc = mine > 0u ? mine : 1u; nx = cnt > 0u ? cnt : 1u;
}
__device__ __forceinline__ void xcd_barrier(const XcdBarrier& b) {
    asm volatile("s_waitcnt vmcnt(0)" ::: "memory");
    __syncthreads();
    if (threadIdx.x == 0) {
        unsigned* bar = b.bar;
        __builtin_amdgcn_s_waitcnt(0);
        unsigned nloc = b.st[0], nx = b.st[1];
        if (nloc == 0u) { xcd_barrier_complete(bar, b.x, nloc, nx); b.st[0] = nloc; b.st[1] = nx; }
        const unsigned old = xb_add(&bar[XB_XSUB(b.x)], 1u);
        const unsigned gen = old / nloc;
        if (old + 1u == (gen + 1u) * nloc) {
            __builtin_amdgcn_fence(__ATOMIC_RELEASE, "agent");
            asm volatile("s_waitcnt vmcnt(0)" ::: "memory");
            const unsigned og = xb_add(&bar[XB_TOP], 1u);
            const unsigned tg = og / nx;
            if (og + 1u == (tg + 1u) * nx) xb_add(&bar[XB_TOPGEN], 1u);
            else XB_SPIN(xb_ld(&bar[XB_TOPGEN]) == tg, bar);
            __builtin_amdgcn_fence(__ATOMIC_ACQUIRE, "agent");
            xb_add(&bar[XB_XGEN(b.x)], 1u);
            asm volatile("s_waitcnt vmcnt(0)" ::: "memory");
        } else {
            XB_SPIN(xb_ld(&bar[XB_XGEN(b.x)]) == gen, bar);
            __builtin_amdgcn_fence(__ATOMIC_ACQUIRE, "agent");
            asm volatile("s_waitcnt vmcnt(0)" ::: "memory");
        }
    }
    __syncthreads();
}

constexpr int N_PHASES = 12;
__global__ void __launch_bounds__(NTHR, 2) mk_fwd(Args a) {
    extern __shared__ __attribute__((aligned(16))) unsigned char lds[];
    cg::grid_group grid = cg::this_grid();
    const int bid = blockIdx.x, nb = gridDim.x;
    const int lo = a.ph_lo, hi = a.ph_hi;
    volatile LAS unsigned* bst = (volatile LAS unsigned*)((LAS unsigned char*)lds + (LDS_BYTES - 16));
    if (threadIdx.x < 4) bst[threadIdx.x] = 0u;
    __syncthreads();
    XcdBarrier xbar = xcd_barrier_post((unsigned*)(a.ws + WS_CTL), bst);
#define SEAM(k) do { if ((k) == 0) grid.sync(); else xcd_barrier(xbar); } while (0)
#define PHASE(k, body) if (lo <= (k) && (k) < hi) { body; if ((k) + 1 < hi) SEAM(k); }
    PHASE(0, ph0_prologue(a, bid, nb, lds))
    PHASE(1, row_norm_mod(a.in[0], a.in[4], (const float*)(a.ws + WS_MOD), 0, 1024, (f16*)(a.ws + WS_H), bid, nb); wq_to_int8((const f16*)(a.ws + WS_WQ), a.ws + WS_WQ8, (float*)(a.ws + WS_WSC), bid, nb))
    PHASE(2, ph2_inproj(a, bid, nb, lds))
    PHASE(3, ph3_pool_fast(a, bid, nb, lds); ph3_index_fast<0>(a, bid, nb, lds))
    PHASE(4, ph4_attn_fast<0>(a, bid, nb, lds))
    PHASE(5, ph5_outproj(a, bid, nb, lds))
    PHASE(6, row_norm_mod_q(a.out, a.in[13], (const float*)(a.ws + WS_MOD), 3072, 4096, a.ws + WS_HQ, (float*)(a.ws + WS_HSC), bid, nb))
    PHASE(7, ph7_peerq(a, bid, nb, lds))
    PHASE(8, ph8_peersel_fast(a, bid, nb, lds))
    PHASE(9, ph9_sliced<0>(a, lds))
    PHASE(10, ph9b_combine(a, bid, nb))
    PHASE(11, ph9_sliced<1>(a, lds))
#undef PHASE
}

extern "C" void kernel_launch(void* const* d_in, const int* in_sizes, int n_in, void* d_out, int out_size, void* d_ws, size_t ws_size, hipStream_t stream) {
    static int grid = 0;
    if (grid == 0) {
        if (n_in != 18 || out_size != NT * ND || ws_size < WS_END) { fprintf(stderr, "kernel_launch: unexpected shapes (n_in %d out %d ws %zu)\n", n_in, out_size, ws_size); grid = -1; return; }
        int dev = 0, cus = 0, per_cu = 0;
        hipGetDevice(&dev); hipDeviceGetAttribute(&cus, hipDeviceAttributeMultiprocessorCount, dev);
        hipFuncSetAttribute((const void*)mk_fwd, hipFuncAttributeMaxDynamicSharedMemorySize, LDS_BYTES);
        hipOccupancyMaxActiveBlocksPerMultiprocessor(&per_cu, (const void*)mk_fwd, NTHR, LDS_BYTES);
        if (per_cu < 1) { fprintf(stderr, "kernel_launch: occupancy query says %d blocks/CU\n", per_cu); per_cu = 1; }
        grid = cus * 1;
        (void)hipGetLastError();
    }
    if (grid < 0) return;
    if (hipMemsetAsync((char*)d_ws + WS_CTL, 0, 32768, stream) != hipSuccess) { fprintf(stderr, "kernel_launch: memset of the barrier words failed\n"); return; }
    Args a{};
    for (int i = 0; i < 18; ++i) a.in[i] = (const float*)d_in[i];
    a.out = (float*)d_out; a.ws = (unsigned char*)d_ws;
#if MK_MULTI
    for (int ph = 0; ph < N_PHASES; ++ph) { a.ph_lo = ph; a.ph_hi = ph + 1; hipLaunchKernelGGL(mk_fwd, dim3(grid), dim3(NTHR), LDS_BYTES, stream, a); }
#else
    a.ph_lo = 0; a.ph_hi = N_PHASES;
    void* args[] = {&a};
    hipError_t e = hipLaunchCooperativeKernel((const void*)mk_fwd, dim3(grid), dim3(NTHR), args, LDS_BYTES, stream);
    if (e != hipSuccess) fprintf(stderr, "cooperative launch failed: %s (grid %d)\n", hipGetErrorString(e), grid);
#endif
}
```

```cpp
#include <hip/hip_runtime.h>
#include <hip/hip_cooperative_groups.h>
#include <cstdio>
#include <cstdint>
namespace cg = cooperative_groups;

#ifndef MK_MULTI
#define MK_MULTI 0
#endif

typedef _Float16 f16;
typedef _Float16 f16x8 __attribute__((ext_vector_type(8)));
typedef _Float16 f16x4 __attribute__((ext_vector_type(4)));
typedef float f32x4 __attribute__((ext_vector_type(4)));
typedef float f32x16 __attribute__((ext_vector_type(16)));
typedef int i32x4 __attribute__((ext_vector_type(4)));
typedef unsigned long long u64;
typedef unsigned short u16;

constexpr int NB = 8, NS = 8192, ND = 1024, NT = NB * NS;
constexpr int INW = 2632;
constexpr int NMAIN = 2304;
constexpr float EPS = 1e-6f;
constexpr int NTHR = 512, NWAVE = 8;

constexpr size_t MiB = 1u << 20;
constexpr size_t WS_CTL = 0;
constexpr size_t WS_MOD = 1 * MiB;
constexpr size_t WS_WIN = 2 * MiB;
constexpr size_t WS_WVT = 7 * MiB;
constexpr size_t WS_WOUT = 8 * MiB;
constexpr size_t WS_WQ = 10 * MiB;
constexpr size_t WS_SK = 14 * MiB;
constexpr size_t WS_PW = 14 * MiB + 512 * 1024;
constexpr size_t WS_QS = 1 * MiB + 512 * 1024;
constexpr size_t WS_UT = 16 * MiB;
constexpr size_t WS_VP = 48 * MiB;
constexpr size_t WS_H = 80 * MiB;
constexpr size_t WS_U = 208 * MiB;
constexpr size_t WS_Q = 272 * MiB;
constexpr size_t WS_K = 336 * MiB;
constexpr size_t WS_VT = 400 * MiB;
constexpr size_t WS_PQ = 208 * MiB;
constexpr size_t WS_WQ8 = 24 * MiB;
constexpr size_t WS_WSC = 26 * MiB;
constexpr size_t WS_HQ = 464 * MiB;
constexpr size_t WS_HSC = 528 * MiB;
constexpr size_t WS_QI = 464 * MiB;
constexpr size_t WS_KI = 528 * MiB;
constexpr size_t WS_WI = 536 * MiB;
constexpr size_t WS_MASK = 544 * MiB;
constexpr size_t WS_EID = 608 * MiB;
constexpr size_t WS_GW = 624 * MiB;
constexpr size_t WS_X1 = 656 * MiB;
constexpr size_t WS_END = 784 * MiB;

constexpr int LDS_BYTES = 155648;
constexpr float PEER_QSTEP = 0.3352f;
constexpr float PEER_WSCALE = 16384.f;

struct Args { const float* in[18]; float* out; unsigned char* ws; int ph_lo, ph_hi; };

__host__ __device__ __forceinline__ int pos2log(int p) { return 64 * ((p >> 5) & 3) + 32 * (p >> 7) + 8 * ((p >> 2) & 3) + 4 * ((p >> 4) & 1) + (p & 3); }
__device__ __forceinline__ int maincol(int L) { if (L < 1536) return L; if (L < 2120) return L + 512; return -1; }

__device__ __forceinline__ float wave_sum(float v) {
#pragma unroll
    for (int o = 1; o < 64; o <<= 1) v += __shfl_xor(v, o);
    return v;
}
__device__ __forceinline__ float wave_max(float v) {
#pragma unroll
    for (int o = 1; o < 64; o <<= 1) v = fmaxf(v, __shfl_xor(v, o));
    return v;
}

__device__ void ph0_prologue(const Args& a, int bid, int nb, unsigned char* lds) {
    int tid = threadIdx.x; asm volatile("" : "+v"(tid));
    const float* c = a.in[1]; const float* ada_w = a.in[2]; const float* ada_b = a.in[3];
    float* sil = (float*)lds;
    for (int i = tid; i < NB * ND; i += NTHR) { const float v = c[i]; sil[i] = v / (1.f + __expf(-v)); }
    __syncthreads();
    float* mod = (float*)(a.ws + WS_MOD);
    const int gt = bid * NTHR + tid, ngt = nb * NTHR;
    for (int o = gt; o < NB * 6144; o += ngt) {
        const int b = o / 6144, j = o % 6144;
        float acc = ada_b[j];
        const float* sb = sil + b * ND;
        for (int k = 0; k < ND; ++k) acc += sb[k] * ada_w[(size_t)k * 6144 + j];
        mod[o] = acc;
    }
    const float* w_in = a.in[5]; const float* pool_w = a.in[6]; const float* w_out = a.in[12];
    const float* wq = a.in[14]; const float* sk = a.in[15]; const float* pu = a.in[16]; const float* pv = a.in[17];
    f16* WIN = (f16*)(a.ws + WS_WIN); f16* WVT = (f16*)(a.ws + WS_WVT); f16* WOUT = (f16*)(a.ws + WS_WOUT); f16* WQ = (f16*)(a.ws + WS_WQ);
 unsigned char* UT = a.ws + WS_UT; unsigned char* VP = a.ws + WS_VP;
    {
        __syncthreads();
        const int lane = tid & 63, wv_ = tid >> 6;
        float* scr = (float*)lds + wv_ * (64 * 33);
        constexpr int I_WQ = 16 * 64, I_Z = 16 * 16, I_INR = 16 * (NMAIN / 32 - 16), I_VT = 16 * 16, I_OUT = 16 * 32, I_ALL = I_WQ + I_Z + I_INR + I_VT + I_OUT;
        for (int it = bid * NWAVE + wv_; it < I_ALL; it += nb * NWAVE) {
            int rr = it, kind = 3, pboff = 0;
            if (rr >= I_WQ) { rr -= I_WQ; kind = 0;
                if (rr >= I_Z) { rr -= I_Z; pboff = 16;
                    if (rr >= I_INR) { rr -= I_INR; kind = 1; pboff = 0; if (rr >= I_VT) { rr -= I_VT; kind = 2; } } } }
            const int npb = kind == 0 ? (pboff ? NMAIN / 32 - 16 : 16) : kind == 1 ? 16 : kind == 2 ? 32 : 64;
            const int k0 = (rr / npb) * 64, p0 = (rr % npb + pboff) * 32, p = p0 + (lane & 31);
            const float* W = kind <= 1 ? w_in : kind == 2 ? w_out : wq; const int ldw = kind <= 1 ? INW : kind == 2 ? 1024 : 2048;
            int col;
            if (kind == 0) col = maincol((p & ~255) + pos2log(p & 255)); else if (kind == 1) col = 1536 + p; else col = (p & ~255) + pos2log(p & 255);
            const bool foldz = (kind == 0 && pboff == 0);
            if (foldz || kind == 3) {
                const int r5 = lane & 31, hh_ = lane >> 5;
                const int blk = __builtin_amdgcn_readfirstlane(col >> 7);
                const int sub = col & 127;
                const float* arow = W + (size_t)(k0 + r5) * ldw + blk * 128 + 8 * hh_;
                f32x16 acc0 = (f32x16){0.f, 0.f, 0.f, 0.f, 0.f, 0.f, 0.f, 0.f, 0.f, 0.f, 0.f, 0.f, 0.f, 0.f, 0.f, 0.f}, acc1 = acc0;
#pragma unroll 2
                for (int ks = 0; ks < 8; ++ks) {
                    const f32x4 a00 = *(const f32x4*)(arow + 16 * ks), a01 = *(const f32x4*)(arow + 16 * ks + 4);
                    const f32x4 a10 = *(const f32x4*)(arow + (size_t)32 * ldw + 16 * ks), a11 = *(const f32x4*)(arow + (size_t)32 * ldw + 16 * ks + 4);
                    f16x8 bfr;
                    if (kind == 3) { const float* br = sk + (size_t)(blk * 128 + sub) * 128 + 16 * ks + 8 * hh_; const f32x4 b0 = *(const f32x4*)br, b1 = *(const f32x4*)(br + 4);
                        bfr = (f16x8){(f16)b0[0], (f16)b0[1], (f16)b0[2], (f16)b0[3], (f16)b1[0], (f16)b1[1], (f16)b1[2], (f16)b1[3]}; }
                    else { const float* br = pool_w + (size_t)blk * 16384 + (size_t)(16 * ks + 8 * hh_) * 128 + sub;
                        bfr = (f16x8){(f16)br[0], (f16)br[128], (f16)br[256], (f16)br[384], (f16)br[512], (f16)br[640], (f16)br[768], (f16)br[896]}; }
                    const f16x8 af0 = (f16x8){(f16)a00[0], (f16)a00[1], (f16)a00[2], (f16)a00[3], (f16)a01[0], (f16)a01[1], (f16)a01[2], (f16)a01[3]};
                    const f16x8 af1 = (f16x8){(f16)a10[0], (f16)a10[1], (f16)a10[2], (f16)a10[3], (f16)a11[0], (f16)a11[1], (f16)a11[2], (f16)a11[3]};
                    acc0 = __builtin_amdgcn_mfma_f32_32x32x16_f16(af0, bfr, acc0, 0, 0, 0);
                    acc1 = __builtin_amdgcn_mfma_f32_32x32x16_f16(af1, bfr, acc1, 0, 0, 0);
                }
#pragma unroll
                for (int rg = 0; rg < 16; ++rg) { const int kk = (rg & 3) + 8 * (rg >> 2) + 4 * hh_; scr[kk * 33 + r5] = acc0[rg]; scr[(32 + kk) * 33 + r5] = acc1[rg]; }
            } else {
#pragma unroll 8
                for (int i = 0; i < 32; ++i) { const int kk = 2 * i + (lane >> 5); scr[kk * 33 + (lane & 31)] = col >= 0 ? W[(size_t)(k0 + kk) * ldw + col] : 0.f; }
            }
            f16* WT = kind == 0 ? WIN : kind == 1 ? WVT : kind == 2 ? WOUT : WQ;
            const int c8 = lane & 7;
#pragma unroll
            for (int j = 0; j < 4; ++j) { const int n = (lane >> 3) + 8 * j; const float* sp = scr + (8 * c8) * 33 + n;
                *(f16x8*)(WT + (size_t)(p0 + n) * ND + k0 + 8 * c8) = (f16x8){(f16)sp[0], (f16)sp[33], (f16)sp[66], (f16)sp[99], (f16)sp[132], (f16)sp[165], (f16)sp[198], (f16)sp[231]}; }
        }
    }
    {
        __syncthreads();
        float ssu = 0.f, ssv = 0.f;
        for (int i = tid; i < 64 * 1024 / 4; i += NTHR) { const f32x4 u = ((const f32x4*)pu)[i], v = ((const f32x4*)pv)[i];
            ssu += u.x * u.x + u.y * u.y + u.z * u.z + u.w * u.w; ssv += v.x * v.x + v.y * v.y + v.z * v.z + v.w * v.w; }
        ssu = wave_sum(ssu); ssv = wave_sum(ssv);
        float* red = (float*)lds;
        if ((tid & 63) == 0) { red[tid >> 6] = ssu; red[8 + (tid >> 6)] = ssv; }
        __syncthreads();
        float tu = 0.f, tv = 0.f;
#pragma unroll
        for (int w = 0; w < 8; ++w) { tu += red[w]; tv += red[8 + w]; }
        const float du = PEER_QSTEP * sqrtf(tu * (1.f / 65536.f)), dv = PEER_QSTEP * sqrtf(tv * (1.f / 65536.f));
        if (bid == 0 && tid == 0) { float* qs = (float*)(a.ws + WS_QS); qs[0] = du; qs[1] = dv; }
        const float idu = 1.f / du, idv = 1.f / dv;
        const int lane = tid & 63, wv_ = tid >> 6;
        for (int row = bid * NWAVE + wv_; row < 2 * 16384; row += nb * NWAVE) {
            const bool isv = row >= 16384; const int e = row & 16383;
            const float* src = (isv ? pv : pu) + (size_t)e * ND + 4 * lane; u16* dstq = (u16*)((isv ? VP : UT) + (size_t)e * 512) + lane;
            const float inv = isv ? idv : idu;
#pragma unroll
            for (int j = 0; j < 4; ++j) { const f32x4 x4 = *(const f32x4*)(src + 256 * j); unsigned pk = 0u, pb = 0u;
#pragma unroll
                for (int k = 0; k < 4; ++k) { int q = (int)floorf(x4[k] * inv); q = q < -8 ? -8 : q > 7 ? 7 : q; pk |= (unsigned)(q + 8) << (4 * k); pb |= (unsigned)(q + 8) << (8 * k); }
                const unsigned other = __shfl_xor(pb, 1);
                if (isv) dstq[64 * j] = (u16)pk;
                else if (!(lane & 1)) ((unsigned*)(UT + (size_t)e * 512))[(lane >> 1) + 32 * j] = pb | (other << 4); }
        }
    }
}

__device__ void row_norm_mod(const float* src, const float* g, const float* mod, int sh_off, int sc_off, f16* dst, int bid, int nb) {
    int tid_ = threadIdx.x; asm volatile("" : "+v"(tid_)); const int lane = tid_ & 63, wave = tid_ >> 6;
    for (int row = bid * NWAVE + wave; row < NT; row += nb * NWAVE) {
        const int b = row / NS;
        const f32x4* xr = (const f32x4*)(src + (size_t)row * ND) + lane;
        f32x4 v[4]; float s = 0.f;
#pragma unroll
        for (int j = 0; j < 4; ++j) { v[j] = xr[64 * j]; s += v[j].x * v[j].x + v[j].y * v[j].y + v[j].z * v[j].z + v[j].w * v[j].w; }
        const float rstd = rsqrtf(wave_sum(s) * (1.f / ND) + EPS);
#pragma unroll
        for (int j = 0; j < 4; ++j) {
            const int col = lane * 4 + 256 * j;
            const f32x4 gg = *(const f32x4*)(g + col), sc = *(const f32x4*)(mod + b * 6144 + sc_off + col), sh = *(const f32x4*)(mod + b * 6144 + sh_off + col);
            f16x4 o;
            o.x = (f16)(v[j].x * rstd * gg.x * (1.f + sc.x) + sh.x); o.y = (f16)(v[j].y * rstd * gg.y * (1.f + sc.y) + sh.y);
            o.z = (f16)(v[j].z * rstd * gg.z * (1.f + sc.z) + sh.z); o.w = (f16)(v[j].w * rstd * gg.w * (1.f + sc.w) + sh.w);
            *(f16x4*)(dst + (size_t)row * ND + col) = o;
        }
    }
}


__device__ void row_norm_mod_q(const f16* src, const float* g, const float* mod, int sh_off, int sc_off, unsigned char* hq, float* hsc, int bid, int nb) {
    int tid_ = threadIdx.x; asm volatile("" : "+v"(tid_)); const int lane = tid_ & 63, wave = tid_ >> 6;
    for (int row = bid * NWAVE + wave; row < NT; row += nb * NWAVE) {
        const int b = row / NS;
        const f16* xr = src + (size_t)row * ND + 8 * lane;
        f32x4 v[4]; float s = 0.f;
#pragma unroll
        for (int j = 0; j < 2; ++j) { const f16x8 h8 = *(const f16x8*)(xr + 512 * j);
            v[2 * j] = (f32x4){(float)h8[0], (float)h8[1], (float)h8[2], (float)h8[3]}; v[2 * j + 1] = (f32x4){(float)h8[4], (float)h8[5], (float)h8[6], (float)h8[7]}; }
#pragma unroll
        for (int j = 0; j < 4; ++j) s += v[j].x * v[j].x + v[j].y * v[j].y + v[j].z * v[j].z + v[j].w * v[j].w;
        const float rstd = rsqrtf(wave_sum(s) * (1.f / ND) + EPS);
        float o[16]; float am = 0.f;
#pragma unroll
        for (int j = 0; j < 4; ++j) {
            const int col = 8 * lane + 512 * (j >> 1) + 4 * (j & 1);
            const f32x4 gg = *(const f32x4*)(g + col), sc = *(const f32x4*)(mod + b * 6144 + sc_off + col), sh = *(const f32x4*)(mod + b * 6144 + sh_off + col);
#pragma unroll
            for (int k = 0; k < 4; ++k) { const float y = v[j][k] * rstd * gg[k] * (1.f + sc[k]) + sh[k]; o[4 * j + k] = y; am = fmaxf(am, fabsf(y)); }
        }
        am = wave_max(am);
        const float inv = am > 0.f ? 119.f / am : 0.f;
#pragma unroll
        for (int j = 0; j < 2; ++j) {
            unsigned p0 = 0u, p1 = 0u;
#pragma unroll
            for (int k = 0; k < 4; ++k) { p0 |= (unsigned)((int)rintf(o[8 * j + k] * inv) & 255) << (8 * k); p1 |= (unsigned)((int)rintf(o[8 * j + 4 + k] * inv) & 255) << (8 * k); }
            *(u64*)(hq + (size_t)row * ND + 8 * lane + 512 * j) = (u64)p0 | ((u64)p1 << 32);
        }
        if (lane == 0) hsc[row] = am * (1.f / 119.f);
    }
}
__device__ void wq_to_int8(const f16* WQ, unsigned char* WQ8, float* WSC, int bid, int nb) {
    int tid_ = threadIdx.x; asm volatile("" : "+v"(tid_)); const int lane = tid_ & 63, wave = tid_ >> 6;
    for (int row = bid * NWAVE + wave; row < 2048; row += nb * NWAVE) {
        const f16x8 a0 = *(const f16x8*)(WQ + (size_t)row * ND + 8 * lane), a1 = *(const f16x8*)(WQ + (size_t)row * ND + 8 * lane + 512);
        float am = 0.f;
#pragma unroll
        for (int k = 0; k < 8; ++k) am = fmaxf(am, fmaxf(fabsf((float)a0[k]), fabsf((float)a1[k])));
        am = wave_max(am);
        const float inv = am > 0.f ? 127.f / am : 0.f;
        unsigned p[4] = {0u, 0u, 0u, 0u};
#pragma unroll
        for (int k = 0; k < 4; ++k) { p[0] |= (unsigned)((int)rintf((float)a0[k] * inv) & 255) << (8 * k); p[1] |= (unsigned)((int)rintf((float)a0[4 + k] * inv) & 255) << (8 * k);
                                      p[2] |= (unsigned)((int)rintf((float)a1[k] * inv) & 255) << (8 * k); p[3] |= (unsigned)((int)rintf((float)a1[4 + k] * inv) & 255) << (8 * k); }
        *(u64*)(WQ8 + (size_t)row * ND + 8 * lane) = (u64)p[0] | ((u64)p[1] << 32);
        *(u64*)(WQ8 + (size_t)row * ND + 8 * lane + 512) = (u64)p[2] | ((u64)p[3] << 32);
        if (lane == 0) WSC[row] = am * (1.f / 127.f);
    }
}

namespace pg8 {
#define PG8_LAS __attribute__((address_space(3)))
constexpr int BM = 256, BK = 64, HALF = 128, HTB = HALF * BK * 2, STAGE_BYTES = 8 * HTB, NXCD = 8, WGM = 8;
__host__ __device__ __forceinline__ int lds_byte(int r, int c) { const int st = (r >> 4) * 2 + (c >> 5), rr = r & 15, cc = c & 31, ob = rr * 64 + cc * 2; return st * 1024 + (ob ^ (((ob >> 9) & 1) << 5)); }
__host__ __device__ __forceinline__ void stage_rc(int b, int& R, int& C) { const int st = b / 1024, sb = b % 1024, swz = sb ^ (((sb >> 9) & 1) << 5); R = (st >> 1) * 16 + swz / 64; C = (st & 1) * 32 + (swz % 64) / 2; }
struct Unit { int pm, pn; };
struct Gemm { const f16* A; const f16* Bt; int M, N, K; };
struct StaticOrder {
    int nM, nN, nwg, G, c;
    __host__ __device__ void init(int M, int N, int G_, int c_) { nM = M / BM; nN = N / BM; nwg = nM * nN; G = G_; c = c_; }
    __host__ __device__ bool next(int i, Unit& u) const {
        const long L = (long)i * G + c; if (L >= nwg) return false;
        int wgid = (int)L; { const int q = nwg / NXCD, r = nwg % NXCD, xcd = wgid % NXCD, off = wgid / NXCD; wgid = (xcd < r ? xcd * (q + 1) : r * (q + 1) + (xcd - r) * q) + off; }
        const int nig = WGM * nN, gid = wgid / nig, fm = gid * WGM, gsz = (nM - fm) < WGM ? (nM - fm) : WGM;
        u.pm = fm + ((wgid % nig) % gsz); u.pn = (wgid % nig) / gsz; return true;
    }
};
template <class Epi, bool I8 = false>
__device__ __forceinline__ void gemm_phase(PG8_LAS unsigned char* lds, const Gemm g, const StaticOrder& S, const Epi& E) {
    int tid = threadIdx.x; asm volatile("" : "+v"(tid));
    const int wid = __builtin_amdgcn_readfirstlane(tid >> 6), lane = tid & 63, wr = wid >> 2, wc = wid & 3, fr = lane & 15, fq = lane >> 4;
    const int K = g.K, nt = K / BK;
    unsigned voffA[2];
#pragma unroll
    for (int i = 0; i < 2; ++i) { int R, C; stage_rc(tid * 16 + i * 8192, R, C); voffA[i] = (unsigned)(R * K + C) * 2u; }
    const size_t kstep = (size_t)(BK * 2);
    const size_t hstep = (size_t)HALF * K * 2;
    const size_t tstep = 2 * hstep;
    const unsigned ldsw = (unsigned)wid * 1024u;
    const int aoff = lds_byte(wr * 64 + fr, fq * 8), boff = lds_byte(wc * 32 + fr, fq * 8);
#define PG8_SA(b, h) (((b) * 2 + (h)) * HTB)
#define PG8_SB(b, h) ((4 + (b) * 2 + (h)) * HTB)
#define PG8_STAGE(bufoff, gbase, voff) do { _Pragma("unroll") for (int _i = 0; _i < 2; ++_i) \
        __builtin_amdgcn_global_load_lds((const unsigned*)((const char*)(gbase) + (voff)[_i]), (PG8_LAS unsigned*)(lds + (bufoff) + ldsw + _i * 8192), 16, 0, 0); } while (0)
#define PG8_LDA(dst, b, h) do { _Pragma("unroll") for (int m = 0; m < 4; ++m) _Pragma("unroll") for (int k = 0; k < 2; ++k) dst[m][k] = *(const PG8_LAS f16x8*)(lds + PG8_SA(b, h) + aoff + m * 2048 + k * 1024); } while (0)
#define PG8_LDB(dst, b, h) do { _Pragma("unroll") for (int n = 0; n < 2; ++n) _Pragma("unroll") for (int k = 0; k < 2; ++k) dst[n][k] = *(const PG8_LAS f16x8*)(lds + PG8_SB(b, h) + boff + n * 2048 + k * 1024); } while (0)
#define PG8_MMA(ai, bj, At, Bt) do { __builtin_amdgcn_s_setprio(1); _Pragma("unroll") for (int m = 0; m < 4; ++m) _Pragma("unroll") for (int n = 0; n < 2; ++n) _Pragma("unroll") for (int k = 0; k < 2; ++k) \
        acc[ai][bj][m][n] = I8 ? __builtin_bit_cast(f32x4, __builtin_amdgcn_mfma_i32_16x16x64_i8(__builtin_bit_cast(i32x4, Bt[n][k]), __builtin_bit_cast(i32x4, At[m][k]), __builtin_bit_cast(i32x4, acc[ai][bj][m][n]), 0, 0, 0)) \
                                 : __builtin_amdgcn_mfma_f32_16x16x32_f16(Bt[n][k], At[m][k], acc[ai][bj][m][n], 0, 0, 0); __builtin_amdgcn_s_setprio(0); } while (0)
#define PG8_WAIT_V(n) asm volatile("s_waitcnt vmcnt(" #n ")" ::: "memory")
#define PG8_WAIT_L(n) asm volatile("s_waitcnt lgkmcnt(" #n ")" ::: "memory")
#define PG8_BAR __builtin_amdgcn_s_barrier()
#define PG8_SCHED __builtin_amdgcn_sched_barrier(0)
    Unit cur, nxt; int ui = 0;
    if (!S.next(0, cur)) return;
    f32x4 acc[2][2][4][2];
#pragma unroll
    for (int a = 0; a < 2; ++a)
#pragma unroll
        for (int b = 0; b < 2; ++b)
#pragma unroll
            for (int m = 0; m < 4; ++m)
#pragma unroll
                for (int n = 0; n < 2; ++n) acc[a][b][m][n] = (f32x4){0.f, 0.f, 0.f, 0.f};
    f16x8 At[4][2], B0[2][2], B1[2][2];
    const char* cA = (const char*)g.A + (size_t)cur.pm * tstep; const char* cB = (const char*)g.Bt + (size_t)cur.pn * tstep;
    PG8_STAGE(PG8_SB(0, 0), cB, voffA); PG8_STAGE(PG8_SB(0, 1), cB + hstep, voffA); PG8_STAGE(PG8_SA(0, 0), cA, voffA); PG8_STAGE(PG8_SA(0, 1), cA + hstep, voffA);
    if (wr == 1) PG8_BAR;
    PG8_WAIT_V(2); PG8_BAR;
    PG8_STAGE(PG8_SB(1, 0), cB + kstep, voffA); PG8_STAGE(PG8_SA(1, 0), cA + kstep, voffA); PG8_STAGE(PG8_SB(1, 1), cB + hstep + kstep, voffA);
    PG8_WAIT_V(6); PG8_BAR;
    for (;;) {
        const bool has_next = S.next(ui + 1, nxt);
        const char* nA = has_next ? (const char*)g.A + (size_t)nxt.pm * tstep : cA; const char* nB = has_next ? (const char*)g.Bt + (size_t)nxt.pn * tstep : cB;
        for (int t = 0; t < nt; t += 2) {
            const bool last = (t == nt - 2);
            const char* a1 = cA + (size_t)(t + 1) * kstep;
            const char* a2 = last ? nA : cA + (size_t)(t + 2) * kstep; const char* b2 = last ? nB : cB + (size_t)(t + 2) * kstep;
            const char* a3 = a2 + kstep; const char* b3 = b2 + kstep;
            PG8_LDB(B0, 0, 0); PG8_LDB(B1, 0, 1); PG8_SCHED; PG8_LDA(At, 0, 0); PG8_STAGE(PG8_SA(1, 1), a1 + hstep, voffA);
            PG8_WAIT_V(8); PG8_WAIT_L(0); PG8_BAR; PG8_MMA(0, 0, At, B0); PG8_MMA(0, 1, At, B1); PG8_BAR; PG8_SCHED;
            PG8_LDA(At, 0, 1); PG8_STAGE(PG8_SB(0, 0), b2, voffA); PG8_STAGE(PG8_SB(0, 1), b2 + hstep, voffA); PG8_STAGE(PG8_SA(0, 0), a2, voffA);
            PG8_WAIT_V(8); PG8_WAIT_L(0); PG8_BAR; PG8_MMA(1, 0, At, B0); PG8_MMA(1, 1, At, B1); PG8_BAR; PG8_SCHED;
            PG8_LDB(B0, 1, 0); PG8_LDB(B1, 1, 1); PG8_SCHED; PG8_LDA(At, 1, 0); PG8_STAGE(PG8_SA(0, 1), a2 + hstep, voffA);
            PG8_WAIT_V(8); PG8_WAIT_L(0); PG8_BAR; PG8_MMA(0, 0, At, B0); PG8_MMA(0, 1, At, B1); PG8_BAR; PG8_SCHED;
            PG8_LDA(At, 1, 1); PG8_STAGE(PG8_SB(1, 0), b3, voffA); PG8_STAGE(PG8_SB(1, 1), b3 + hstep, voffA); PG8_STAGE(PG8_SA(1, 0), a3, voffA);
            PG8_WAIT_V(8); PG8_WAIT_L(0); PG8_BAR; PG8_MMA(1, 0, At, B0); PG8_MMA(1, 1, At, B1); PG8_BAR; PG8_SCHED;
        }
        if (wr == 0) PG8_BAR;
        E(acc, cur, wr, wc, fr, fq);
        if (!has_next) break;
#pragma unroll
        for (int a = 0; a < 2; ++a)
#pragma unroll
            for (int b = 0; b < 2; ++b)
#pragma unroll
                for (int m = 0; m < 4; ++m)
#pragma unroll
                    for (int n = 0; n < 2; ++n) acc[a][b][m][n] = (f32x4){0.f, 0.f, 0.f, 0.f};
        cur = nxt; cA = nA; cB = nB; ++ui;
        if (wr == 1) PG8_BAR;
    }
    PG8_WAIT_V(0);
    PG8_BAR;
#undef PG8_SA
#undef PG8_SB
#undef PG8_STAGE
#undef PG8_LDA
#undef PG8_LDB
#undef PG8_MMA
#undef PG8_WAIT_V
#undef PG8_WAIT_L
#undef PG8_BAR
#undef PG8_SCHED
}

typedef f32x4 Acc[2][2][4][2];
struct EpiMain {
    unsigned char* ws; const float *qg, *kg;
    __device__ __forceinline__ void operator()(const Acc& acc, const Unit& u, int wr, int wc, int fr, int fq) const {
        const int row0 = u.pm * BM + wr * 64 + fr, pn = u.pn;
        if (pn == 8) {
            if (wc == 0) {
#pragma unroll
                for (int ai = 0; ai < 2; ++ai)
#pragma unroll
                    for (int m = 0; m < 4; ++m) { const size_t row = row0 + ai * HALF + m * 16;
#pragma unroll
                        for (int bj = 0; bj < 2; ++bj) { const f32x4 v0 = acc[ai][bj][m][0], v1 = acc[ai][bj][m][1];
                            *(f16x8*)((f16*)(ws + WS_KI) + (((row >> 5) * 8 + 4 * bj + fq) * 32 + (row & 31)) * 8) = (f16x8){(f16)v0[0], (f16)v0[1], (f16)v0[2], (f16)v0[3], (f16)v1[0], (f16)v1[1], (f16)v1[2], (f16)v1[3]}; } }
            } else if (wc == 1 && fq == 0) {
#pragma unroll
                for (int ai = 0; ai < 2; ++ai)
#pragma unroll
                    for (int m = 0; m < 4; ++m) { const size_t row = row0 + ai * HALF + m * 16;
                        *(f32x4*)((float*)(ws + WS_WI) + row * 8) = acc[ai][0][m][0] * 0.35355339059327373f; *(f32x4*)((float*)(ws + WS_WI) + row * 8 + 4) = acc[ai][0][m][1] * 0.35355339059327373f; }
            }
            return;
        }
        const int kind = pn >> 1;
        f16* base = (f16*)(ws + (kind == 0 ? WS_U : kind == 1 ? WS_Q : kind == 2 ? WS_K : WS_QI));
        const int col0 = (pn & 1) * 256 + 64 * wc + 8 * fq;
        if (kind == 1 || kind == 2) {
            const float* gp = (kind == 1 ? qg : kg) + 8 * fq;
#pragma unroll
            for (int ai = 0; ai < 2; ++ai)
#pragma unroll
                for (int m = 0; m < 4; ++m) { const size_t row = row0 + ai * HALF + m * 16;
                    float ss = 0.f;
#pragma unroll
                    for (int bj = 0; bj < 2; ++bj)
#pragma unroll
                        for (int n = 0; n < 2; ++n) { const f32x4 v = acc[ai][bj][m][n]; ss += v[0] * v[0] + v[1] * v[1] + v[2] * v[2] + v[3] * v[3]; }
                    ss += __shfl_xor(ss, 16); ss += __shfl_xor(ss, 32);
                    const float rstd = rsqrtf(ss * (1.f / 64.f) + EPS);
#pragma unroll
                    for (int bj = 0; bj < 2; ++bj) { const f32x4 v0 = acc[ai][bj][m][0] * rstd * *(const f32x4*)(gp + 32 * bj), v1 = acc[ai][bj][m][1] * rstd * *(const f32x4*)(gp + 32 * bj + 4);
                        *(f16x8*)(base + row * 512 + col0 + 32 * bj) = (f16x8){(f16)v0[0], (f16)v0[1], (f16)v0[2], (f16)v0[3], (f16)v1[0], (f16)v1[1], (f16)v1[2], (f16)v1[3]}; }
                    asm volatile("" ::: "memory"); }
        } else if (kind == 3) {
            const int hd = (pn & 1) * 4 + wc;
#pragma unroll
            for (int ai = 0; ai < 2; ++ai)
#pragma unroll
                for (int m = 0; m < 4; ++m) { const size_t row = row0 + ai * HALF + m * 16; const int ql = (int)(row & 7);
                    const int rr = (hd & 3) | (((ql >> 1) & 1) << 2) | ((hd >> 2) << 3) | ((ql & 1) << 4);
#pragma unroll
                    for (int bj = 0; bj < 2; ++bj) { const f32x4 v0 = acc[ai][bj][m][0], v1 = acc[ai][bj][m][1]; const int chunk = fq + 4 * bj;
                        *(f16x8*)(base + ((((((row >> 3) * 2 + (ql >> 2)) * 4 + (chunk >> 1)) * 2 + (chunk & 1)) * 32 + rr) << 3)) = (f16x8){(f16)v0[0], (f16)v0[1], (f16)v0[2], (f16)v0[3], (f16)v1[0], (f16)v1[1], (f16)v1[2], (f16)v1[3]}; } }
        } else {
#pragma unroll
            for (int ai = 0; ai < 2; ++ai)
#pragma unroll
                for (int m = 0; m < 4; ++m) { const size_t row = row0 + ai * HALF + m * 16;
#pragma unroll
                    for (int bj = 0; bj < 2; ++bj) { const f32x4 v0 = acc[ai][bj][m][0], v1 = acc[ai][bj][m][1];
                        *(f16x8*)(base + row * 512 + col0 + 32 * bj) = (f16x8){(f16)v0[0], (f16)v0[1], (f16)v0[2], (f16)v0[3], (f16)v1[0], (f16)v1[1], (f16)v1[2], (f16)v1[3]}; } }
        }
    }
};
struct EpiVT {
    f16* VT;
    __device__ __forceinline__ void operator()(const Acc& acc, const Unit& u, int wr, int wc, int fr, int fq) const {
        const int row0 = u.pm * BM + wr * 64 + fr, col0 = u.pn * BM + 32 * wc + 4 * fq;
#pragma unroll
        for (int ai = 0; ai < 2; ++ai)
#pragma unroll
            for (int m = 0; m < 4; ++m) { const size_t row = row0 + ai * HALF + m * 16;
#pragma unroll
                for (int bj = 0; bj < 2; ++bj)
#pragma unroll
                    for (int n = 0; n < 2; ++n) { const f32x4 v = acc[ai][bj][m][n];
                        *(f16x4*)(VT + row * NT + col0 + 128 * bj + 16 * n) = (f16x4){(f16)v[0], (f16)v[1], (f16)v[2], (f16)v[3]}; } }
    }
};
struct EpiOut {
    const float* x; const float* mod; f16* x1;
    __device__ __forceinline__ void operator()(const Acc& acc, const Unit& u, int wr, int wc, int fr, int fq) const {
        const int row0 = u.pm * BM + wr * 64 + fr, col0 = u.pn * BM + 64 * wc + 8 * fq;
        const float* g1 = mod + ((u.pm * BM) / NS) * 6144 + 2048 + col0;
        f32x4 g4[2][2];
#pragma unroll
        for (int bj = 0; bj < 2; ++bj)
#pragma unroll
            for (int n = 0; n < 2; ++n) g4[bj][n] = *(const f32x4*)(g1 + 32 * bj + 4 * n);
#pragma unroll
        for (int ai = 0; ai < 2; ++ai)
#pragma unroll
            for (int m = 0; m < 4; ++m) { const size_t off = (size_t)(row0 + ai * HALF + m * 16) * ND + col0;
#pragma unroll
                for (int bj = 0; bj < 2; ++bj) { const f32x4 v0 = *(const f32x4*)(x + off + 32 * bj) + g4[bj][0] * acc[ai][bj][m][0], v1 = *(const f32x4*)(x + off + 32 * bj + 4) + g4[bj][1] * acc[ai][bj][m][1];
                    *(f16x8*)(x1 + off + 32 * bj) = (f16x8){(f16)v0[0], (f16)v0[1], (f16)v0[2], (f16)v0[3], (f16)v1[0], (f16)v1[1], (f16)v1[2], (f16)v1[3]}; } }
    }
};
struct EpiPQ {
    f16* PQ; const float* hsc; const float* wsc;
    __device__ __forceinline__ void operator()(const Acc& acc, const Unit& u, int wr, int wc, int fr, int fq) const {
        const int row0 = u.pm * BM + wr * 64 + fr, col0 = u.pn * BM + 64 * wc + 8 * fq;
        f32x4 ws4[2][2];
#pragma unroll
        for (int bj = 0; bj < 2; ++bj)
#pragma unroll
            for (int n = 0; n < 2; ++n) ws4[bj][n] = *(const f32x4*)(wsc + u.pn * BM + 128 * bj + 32 * wc + 16 * n + 4 * fq);
#pragma unroll
        for (int ai = 0; ai < 2; ++ai)
#pragma unroll
            for (int m = 0; m < 4; ++m) { const size_t row = row0 + ai * HALF + m * 16; const float hs = hsc[row];
#pragma unroll
                for (int bj = 0; bj < 2; ++bj) { const i32x4 i0 = __builtin_bit_cast(i32x4, acc[ai][bj][m][0]), i1 = __builtin_bit_cast(i32x4, acc[ai][bj][m][1]);
                    const f32x4 v0 = (f32x4){(float)i0[0], (float)i0[1], (float)i0[2], (float)i0[3]} * ws4[bj][0] * hs, v1 = (f32x4){(float)i1[0], (float)i1[1], (float)i1[2], (float)i1[3]} * ws4[bj][1] * hs;
                    *(f16x8*)(PQ + ((((row >> 5) * 256 + ((col0 + 32 * bj) >> 3)) * 32 + (row & 31)) << 3)) = (f16x8){(f16)v0[0], (f16)v0[1], (f16)v0[2], (f16)v0[3], (f16)v1[0], (f16)v1[1], (f16)v1[2], (f16)v1[3]}; } }
    }
};
}

__device__ __forceinline__ void ph2_inproj(const Args& a, int bid, int nb, unsigned char* lds) {
    const f16* H = (const f16*)(a.ws + WS_H); const f16* WIN = (const f16*)(a.ws + WS_WIN); const f16* WVT = (const f16*)(a.ws + WS_WVT);
    PG8_LAS unsigned char* l3 = (PG8_LAS unsigned char*)lds;
    { pg8::Gemm g{H, WIN, NT, NMAIN, ND}; pg8::StaticOrder S; S.init(NT, NMAIN, nb, bid);
      pg8::EpiMain E{a.ws, a.in[9], a.in[10]};
      pg8::gemm_phase(l3, g, S, E); }
    { pg8::Gemm g{WVT, H, 512, NT, ND}; pg8::StaticOrder S; S.init(512, NT, nb, bid);
      pg8::EpiVT E{(f16*)(a.ws + WS_VT)};
      pg8::gemm_phase(l3, g, S, E); }
}


constexpr int PPITCH = 1040;
__device__ __forceinline__ void ph3_pool_fast(const Args& a, int bid, int nb, unsigned char* lds) {
    int tid = threadIdx.x; asm volatile("" : "+v"(tid));
    const int cg8 = tid & 63, tq = tid >> 6, gch = cg8 >> 4, win = 2 << gch;
    const f16* Z = (const f16*)(a.ws + WS_U); f16* MIX = (f16*)(a.ws + WS_H);
    const f32x4 ps0 = *(const f32x4*)(a.in[7] + 8 * cg8), ps1 = *(const f32x4*)(a.in[7] + 8 * cg8 + 4), pg0 = *(const f32x4*)(a.in[8] + 8 * cg8), pg1 = *(const f32x4*)(a.in[8] + 8 * cg8 + 4);
    const float psc[8] = {ps0[0], ps0[1], ps0[2], ps0[3], ps1[0], ps1[1], ps1[2], ps1[3]}, pgn[8] = {pg0[0], pg0[1], pg0[2], pg0[3], pg1[0], pg1[1], pg1[2], pg1[3]};
    for (int item = bid; item < NT / 32; item += nb) {
        const int tb = item * 32 + 4 * tq, tl0 = tb % NS;
        const f16* up = Z + (size_t)(tb - tl0) * 512 + 8 * cg8;
        float sm[8];
#pragma unroll
        for (int j = 0; j < 8; ++j) sm[j] = 0.f;
        f16x8 hist_[15];
#pragma unroll
        for (int q = 0; q < 15; ++q) { const int rr = tl0 - 15 + q; hist_[q] = (q >= 16 - win && rr >= 0) ? *(const f16x8*)(up + (size_t)rr * 512) : (f16x8){0, 0, 0, 0, 0, 0, 0, 0}; }
        f16x8 cur_[4];
#pragma unroll
        for (int k = 0; k < 4; ++k) cur_[k] = *(const f16x8*)(up + (size_t)(tl0 + k) * 512);
#pragma unroll
        for (int q = 0; q < 15; ++q)
#pragma unroll
            for (int j = 0; j < 8; ++j) sm[j] += (float)hist_[q][j];
#pragma unroll
        for (int k = 0; k < 4; ++k) {
            const int tl = tl0 + k;
            const float ic = 1.f / (float)((tl + 1 < win) ? tl + 1 : win);
            float v[8]; float ss = 0.f;
#pragma unroll
            for (int j = 0; j < 8; ++j) { sm[j] += (float)cur_[k][j]; v[j] = (sm[j] * ic - (float)cur_[k][j]) * psc[j]; ss += v[j] * v[j]; }
            const float rstd = rsqrtf(wave_sum(ss) * (1.f / 512.f) + EPS);
            f16x8 o;
#pragma unroll
            for (int j = 0; j < 8; ++j) o[j] = (f16)(v[j] * rstd * pgn[j]);
            *(f16x8*)(MIX + (size_t)(tb + k) * ND + 8 * cg8) = o;
            if (k < 3) {
#pragma unroll
                for (int j = 0; j < 8; ++j) {
                    const int q = 16 - win + k;
                    float dv = 0.f;
#pragma unroll
                    for (int qq = 0; qq < 15; ++qq) if (qq == q) dv = (float)hist_[qq][j];
#pragma unroll
                    for (int kk = 0; kk < 3; ++kk) if (q == 15 + kk) dv = (float)cur_[kk][j];
                    sm[j] -= dv;
                }
            }
        }
    }
}


typedef float f32x2 __attribute__((ext_vector_type(2)));
typedef unsigned u32x4 __attribute__((ext_vector_type(4)));

constexpr int IDX_KPITCH = 16384 + 16;
constexpr int IDX_HPITCH = 516;
template <int NBL>
__device__ __forceinline__ int wave_pick(const unsigned (&cc)[NBL], unsigned target, int lane, unsigned& rem_out) {
    unsigned tot = 0u;
#pragma unroll
    for (int j = 0; j < NBL; ++j) tot += cc[j];
    unsigned S = tot;
#pragma unroll
    for (int o = 1; o < 64; o <<= 1) { const unsigned v = __shfl_down(S, o); if (lane + o < 64) S += v; }
    const unsigned above = S - tot;
    const bool hit = (above < target) && (S >= target);
    const u64 bal = __ballot(hit);
    const int L = bal ? __builtin_ctzll(bal) : 0;
    int bin = 0; unsigned rem = target;
    { unsigned run = above; bool done = false;
#pragma unroll
      for (int j = NBL - 1; j >= 0; --j) { if (!done) { if (run + cc[j] >= target) { bin = NBL * lane + j; rem = target - run; done = true; } else run += cc[j]; } } }
    bin = __shfl(bin, L); rem_out = __shfl(rem, L);
    return bin;
}
template <int MODE>
__device__ __forceinline__ void ph3_index_fast(const Args& a, int bid, int nb, unsigned char* lds) {
    int tid = threadIdx.x; asm volatile("" : "+v"(tid));
    const int lane = tid & 63, wave = __builtin_amdgcn_readfirstlane(tid >> 6), r = lane & 31, hh = lane >> 5;
    const f16* QI = (const f16*)(a.ws + WS_QI); const f16* KI = (const f16*)(a.ws + WS_KI); const float* WI = (const float*)(a.ws + WS_WI);
    u64* MASK = (u64*)(a.ws + WS_MASK);
    unsigned* hist = (unsigned*)(lds + 8 * IDX_KPITCH);
    f16x8 af[2][4]; f32x2 wv2[2][8];
#define IDX_LOAD_FRAGS(t0_) do { \
        _Pragma("unroll") for (int rt = 0; rt < 2; ++rt) { \
            _Pragma("unroll") for (int ks = 0; ks < 4; ++ks) af[rt][ks] = *(const f16x8*)(QI + ((((((size_t)((t0_) >> 3) * 2 + rt) * 4 + ks) * 2 + hh) * 32 + r) << 3)); \
            _Pragma("unroll") for (int qq = 0; qq < 2; ++qq) { const float* wp = WI + (size_t)((t0_) + 4 * rt + 2 * hh + qq) * 8; const f32x4 w0 = *(const f32x4*)wp * 0.125f, w1 = *(const f32x4*)(wp + 4) * 0.125f; \
                wv2[rt][4 * qq + 0] = (f32x2){w0[0], w0[1]}; wv2[rt][4 * qq + 1] = (f32x2){w0[2], w0[3]}; wv2[rt][4 * qq + 2] = (f32x2){w1[0], w1[1]}; wv2[rt][4 * qq + 3] = (f32x2){w1[2], w1[3]}; } \
        } } while (0)
    for (int round = 0; round * nb < 256; ++round) {
        const int p = round * nb + ((round & 1) ? (nb - 1 - bid) : bid);
        if (p < 256) { const int tg = p >> 3, b_ = p & 7, t0l = tg * 8, ch_ = t0l >> 6, t0_ = b_ * NS + t0l;
            if (tid < 8 * (ch_ + 1)) { const int q = tid / (ch_ + 1), w = tid % (ch_ + 1); MASK[((size_t)b_ * 128 + w) * NS + t0l + q] = ~0ull; } }
    }
#define IDX_P(round_) ((round_) * nb + (((round_) & 1) ? (nb - 1 - bid) : bid))
    int round = 0;
    while (round * nb < 8192 && !(IDX_P(round) >= 256 && IDX_P(round) < 8192)) ++round;
    if (round * nb < 8192) { const int p0 = IDX_P(round); IDX_LOAD_FRAGS((p0 & 7) * NS + (p0 >> 3) * 8); }
    for (; round * nb < 8192; ) {
        const int p = IDX_P(round);
        int rnext = round + 1;
        while (rnext * nb < 8192 && !(IDX_P(rnext) >= 256 && IDX_P(rnext) < 8192)) ++rnext;
        const bool has_next = rnext * nb < 8192;
        const int pn = has_next ? IDX_P(rnext) : p;
        const int tg = p >> 3, b = p & 7, t0l = tg * 8, ch = t0l >> 6, nadm = 64 * (ch + 1), t0 = b * NS + t0l;
        const int t0n = (pn & 7) * NS + (pn >> 3) * 8;
        round = has_next ? rnext : 8192;
        __syncthreads();
#pragma unroll
        for (int i = 0; i < 9; ++i) if (tid + i * NTHR < 8 * IDX_HPITCH) hist[tid + i * NTHR] = 0u;
        __syncthreads();
        const int nkb = nadm >> 5;
        const f16* kbase = KI + ((size_t)(b * (NS / 32)) * 8 + hh) * 256 + r * 8;
#define IDX_LOADB(dst, kb_) do { _Pragma("unroll") for (int ks = 0; ks < 4; ++ks) dst[ks] = *(const f16x8*)(kbase + ((size_t)(kb_) * 8 + 2 * ks) * 256); } while (0)
#define IDX_BLOCK(bfrag, kb_) do { \
            f32x16 acc[2]; \
            _Pragma("unroll") for (int rt = 0; rt < 2; ++rt) { acc[rt] = (f32x16){0.f, 0.f, 0.f, 0.f, 0.f, 0.f, 0.f, 0.f, 0.f, 0.f, 0.f, 0.f, 0.f, 0.f, 0.f, 0.f}; \
                _Pragma("unroll") for (int ks = 0; ks < 4; ++ks) acc[rt] = __builtin_amdgcn_mfma_f32_32x32x16_f16(af[rt][ks], bfrag[ks], acc[rt], 0, 0, 0); } \
            _Pragma("unroll") for (int rt = 0; rt < 2; ++rt) \
                _Pragma("unroll") for (int qq = 0; qq < 2; ++qq) { \
                    f32x2 t2 = (f32x2){0.f, 0.f}; \
                    _Pragma("unroll") for (int hp = 0; hp < 4; ++hp) { const f32x2 r2 = (f32x2){__int_as_float(max(__float_as_int(acc[rt][8 * qq + 2 * hp]), 0)), __int_as_float(max(__float_as_int(acc[rt][8 * qq + 2 * hp + 1]), 0))}; \
                        t2 = __builtin_elementwise_fma(wv2[rt][4 * qq + hp], r2, t2); } \
                    const float sc = t2[0] + t2[1]; \
                    const f16 sh = (f16)sc; const unsigned bits = (unsigned)__builtin_bit_cast(unsigned short, sh); \
                    const unsigned key = (bits & 0x8000u) ? (~bits & 0xFFFFu) : (bits | 0x8000u); \
                    const int q = 4 * rt + 2 * hh + qq; \
                    if (MODE != 2) *(u16*)(lds + q * IDX_KPITCH + ((kb_) * 32 + r) * 2) = (u16)key; \
                    if (MODE != 2 && MODE != 4) atomicAdd(&hist[q * IDX_HPITCH + (key >> 7)], (key & 64u) ? 0x10000u : 1u); \
                    if (MODE == 2) sink += key; \
                } } while (0)
        f16x8 bf0[4], bf1[4], bf2[4]; unsigned sink = 0u;
        if (wave >= 4) __builtin_amdgcn_s_sleep(5);
        if (wave < nkb) IDX_LOADB(bf0, wave);
        if (wave + 8 < nkb) IDX_LOADB(bf1, wave + 8);
        if (wave + 16 < nkb) IDX_LOADB(bf2, wave + 16);
        if (MODE != 3) for (int kb = wave; kb < nkb; kb += 24) {
            IDX_BLOCK(bf0, kb);
            if (kb + 24 < nkb) IDX_LOADB(bf0, kb + 24);
            if (kb + 8 < nkb) { IDX_BLOCK(bf1, kb + 8); if (kb + 32 < nkb) IDX_LOADB(bf1, kb + 32); }
            if (kb + 16 < nkb) { IDX_BLOCK(bf2, kb + 16); if (kb + 40 < nkb) IDX_LOADB(bf2, kb + 40); }
        }
#undef IDX_LOADB
#undef IDX_BLOCK
        if (MODE == 2 && sink == 0xdeadbeefu) hist[tid] = sink;
        IDX_LOAD_FRAGS(t0n);
        __syncthreads();
        if (MODE != 1) {
            unsigned* hw = hist + wave * IDX_HPITCH;
            const unsigned char* krow = lds + wave * IDX_KPITCH;
            unsigned rem1 = 0u, rem2 = 0u;
            int b1;
            {   const u32x4 d0 = *(const u32x4*)(hw + 8 * lane), d1 = *(const u32x4*)(hw + 8 * lane + 4);
                const unsigned dd[8] = {d0.x, d0.y, d0.z, d0.w, d1.x, d1.y, d1.z, d1.w};
                unsigned cc[16];
#pragma unroll
                for (int j = 0; j < 8; ++j) { cc[2 * j] = dd[j] & 0xFFFFu; cc[2 * j + 1] = dd[j] >> 16; }
                b1 = wave_pick<16>(cc, 256u, lane, rem1); }
            hw[lane] = 0u;
            const int nit = (nadm + 511) >> 9;
            for (int it = 0; it < nit; ++it) {
                const int idx = (it * 64 + lane) * 8;
                if (idx < nadm) { const u32x4 k4 = *(const u32x4*)(krow + idx * 2);
                    const unsigned kk[4] = {k4.x, k4.y, k4.z, k4.w};
                    unsigned hit = 0u;
#pragma unroll
                    for (int j = 0; j < 4; ++j) { hit |= (((kk[j] & 0xFFFFu) >> 6) == (unsigned)b1 ? 1u : 0u) << (2 * j); hit |= ((kk[j] >> 22) == (unsigned)b1 ? 1u : 0u) << (2 * j + 1); }
                    if (hit) {
#pragma unroll
                        for (int j = 0; j < 4; ++j) { const unsigned k0 = kk[j] & 0xFFFFu, k1 = kk[j] >> 16;
                            if (hit & (1u << (2 * j))) atomicAdd(&hw[k0 & 63u], 1u);
                            if (hit & (2u << (2 * j))) atomicAdd(&hw[k1 & 63u], 1u); }
                    } }
            }
            int b2;
            { const unsigned c1[1] = {hw[lane]}; b2 = wave_pick<1>(c1, rem1, lane, rem2); }
            const unsigned tau = ((unsigned)b1 << 6) | (unsigned)b2;
            const size_t mrow = (size_t)(t0 + wave) * 128;
            for (int it = 0; it < nit; ++it) {
                const int idx = (it * 64 + lane) * 8;
                unsigned byte = 0u;
                if (idx < nadm) { const u32x4 k4 = *(const u32x4*)(krow + idx * 2);
                    const unsigned kk[4] = {k4.x, k4.y, k4.z, k4.w};
#pragma unroll
                    for (int j = 0; j < 4; ++j) { byte |= ((kk[j] & 0xFFFFu) >= tau ? 1u : 0u) << (2 * j); byte |= ((kk[j] >> 16) >= tau ? 1u : 0u) << (2 * j + 1); } }
                unsigned lo = (lane & 4) ? 0u : (byte << (8 * (lane & 3))), hi = (lane & 4) ? (byte << (8 * (lane & 3))) : 0u;
                lo |= __shfl_xor(lo, 1); hi |= __shfl_xor(hi, 1); lo |= __shfl_xor(lo, 2); hi |= __shfl_xor(hi, 2); lo |= __shfl_xor(lo, 4); hi |= __shfl_xor(hi, 4);
                if ((lane & 7) == 0 && idx < nadm) { hw[64 + 2 * (it * 8 + (lane >> 3))] = lo; hw[64 + 2 * (it * 8 + (lane >> 3)) + 1] = hi; }
            }
        }
        __syncthreads();
        if (MODE != 1) { const int w = tid >> 2, qp = tid & 3;
            if (w <= ch) { const unsigned* ha = hist + (2 * qp) * IDX_HPITCH + 64 + 2 * w; const unsigned* hb = ha + IDX_HPITCH;
                *(u32x4*)(MASK + ((size_t)b * 128 + w) * NS + t0l + 2 * qp) = (u32x4){ha[0], ha[1], hb[0], hb[1]}; } }
    }
    __syncthreads();
}

constexpr int ATP = 144;
constexpr int ATT_QWORD = 3584 + 32 * 64;
template <int AMODE>
__device__ __forceinline__ void ph4_attn_fast(const Args& a, int bid, int nb, unsigned char* lds) {
    int tid = threadIdx.x; asm volatile("" : "+v"(tid));
    const int lane = tid & 63, wave = __builtin_amdgcn_readfirstlane(tid >> 6), r = lane & 31, hh = lane >> 5;
    const f16* Q = (const f16*)(a.ws + WS_Q); const f16* Kk = (const f16*)(a.ws + WS_K); const f16* VT = (const f16*)(a.ws + WS_VT);
    const u64* MASK = (const u64*)(a.ws + WS_MASK); f16* MIX = (f16*)(a.ws + WS_H); const float* og = a.in[11];
    unsigned char* Kl = lds; unsigned char* Vl = lds + 2 * 64 * ATP;
    const float LOG2E = 1.4426950408889634f, OFF = 8192.f;
    const int pir = 16 * (r >> 4) + 8 * ((r >> 2) & 1) + 4 * ((r >> 3) & 1) + (r & 3);
    const int srow = tid >> 3, schk = tid & 7;
    unsigned* aq = (unsigned*)(a.ws + WS_CTL) + ATT_QWORD;
    volatile unsigned* ucell = (volatile unsigned*)(lds + 6 * 64 * ATP);
    volatile unsigned* dflag = ucell + 8;
    const float kmax = __int_as_float(__builtin_amdgcn_readfirstlane(__float_as_int(1.01f * 8.f * wave_max(fabsf(a.in[10][lane])))));
    int upar = 0;
    for (;;) {
        if (tid == 0) ucell[upar] = __hip_atomic_fetch_add(aq, 1u, __ATOMIC_RELAXED, __HIP_MEMORY_SCOPE_AGENT);
        if (tid < 8) dflag[tid] = 0u;
        __syncthreads();
        const unsigned u = ucell[upar]; upar ^= 1;
        if (u >= 2048u) break;
        const int h = 7 - (int)(u >> 8), qb = 31 - (int)((u & 255u) >> 3), b = (int)(u & 7u);
        const int q0l = qb * 256, tq = q0l + 32 * wave + r, cw = 4 * qb + (wave >> 1), top = 4 * qb + 3;
        const size_t t = (size_t)b * NS + tq;
        const float slope = exp2f(-(float)(h + 1)) * LOG2E;
        f16x8 qf[4];
#pragma unroll
        for (int ks = 0; ks < 4; ++ks) { const f16x8 qv = *(const f16x8*)(Q + t * 512 + h * 64 + 16 * ks + 8 * hh);
#pragma unroll
            for (int j = 0; j < 8; ++j) qf[ks][j] = (f16)((float)qv[j] * (0.125f * LOG2E)); }
        float qss = 0.f;
#pragma unroll
        for (int ks = 0; ks < 4; ++ks)
#pragma unroll
            for (int j = 0; j < 8; ++j) qss += (float)qf[ks][j] * (float)qf[ks][j];
        qss += __shfl_xor(qss, 32);
        const float Sb = __int_as_float(__builtin_amdgcn_readfirstlane(__float_as_int(wave_max(sqrtf(qss)) * kmax)));
        const float rowc = OFF + slope * (float)(tq - q0l);
        float m = 1000.f, l = 0.f;
        f32x16 O[2];
#pragma unroll
        for (int dt = 0; dt < 2; ++dt) O[dt] = (f32x16){0.f, 0.f, 0.f, 0.f, 0.f, 0.f, 0.f, 0.f, 0.f, 0.f, 0.f, 0.f, 0.f, 0.f, 0.f, 0.f};
        const f16* kg = Kk + ((size_t)b * NS + srow) * 512 + h * 64 + schk * 8;
        const f16* vg = VT + (size_t)(h * 64 + srow) * NT + (size_t)b * NS + schk * 8;
        f16x8 kr0, kr1, vr0, vr1; u64 mw0 = 0ull, mw1 = 0ull;
#define ATT_LOAD(kr, vr, mwv, jj) do { if ((jj) >= 0) { kr = *(const f16x8*)(kg + (size_t)(jj) * 64 * 512); vr = *(const f16x8*)(vg + (jj) * 64); mwv = ((jj) <= cw) ? MASK[((size_t)b * 128 + (jj)) * NS + tq] : 0ull; } } while (0)
        ATT_LOAD(kr0, vr0, mw0, top); ATT_LOAD(kr1, vr1, mw1, top - 1);
        int buf = 0; bool wdone = false, stop = false;
        auto step = [&](f16x8& kreg, f16x8& vreg, u64& mwr, const int j) {
            *(f16x8*)(Kl + buf * 64 * ATP + srow * ATP + schk * 16) = kreg;
            *(f16x8*)(Vl + buf * 64 * ATP + srow * ATP + schk * 16) = vreg;
            const u64 mw = mwr;
            asm volatile("s_waitcnt lgkmcnt(0)" ::: "memory"); __builtin_amdgcn_s_barrier(); asm volatile("" ::: "memory");
            {
                const unsigned jp = (unsigned)(j + 1);
                if ((dflag[0] > jp) & (dflag[1] > jp) & (dflag[2] > jp) & (dflag[3] > jp) & (dflag[4] > jp) & (dflag[5] > jp) & (dflag[6] > jp) & (dflag[7] > jp)) { stop = true; return; }
            }
            ATT_LOAD(kreg, vreg, mwr, j - 2);
            if (!wdone && j < cw) { const float lmax = Sb + OFF + slope * (float)(64 * j + 63 - q0l); if (__all(lmax - m < -28.f)) { wdone = true; if (lane == 0) dflag[wave] = (unsigned)(j + 1); } }
            if (j <= cw && !wdone) {
                const unsigned char* kb_ = Kl + buf * 64 * ATP + pir * ATP + 16 * hh;
                f16x8 fr8[8];
#pragma unroll
                for (int kt = 0; kt < 2; ++kt)
#pragma unroll
                    for (int ks = 0; ks < 4; ++ks) fr8[kt * 4 + ks] = *(const f16x8*)(kb_ + kt * 32 * ATP + ks * 32);
                f32x16 sa[2];
                if (j == cw) {
#pragma unroll
                    for (int kt = 0; kt < 2; ++kt)
#pragma unroll
                        for (int rg = 0; rg < 16; ++rg) { const float x = (float)(64 * j + 32 * kt + 16 * (rg >> 3) + 8 * hh + (rg & 7) - tq); sa[kt][rg] = rowc - slope * fabsf(x); }
                } else {
                    const float base = OFF + slope * (float)(64 * j + 8 * hh - q0l);
#pragma unroll
                    for (int kt = 0; kt < 2; ++kt)
#pragma unroll
                        for (int rg = 0; rg < 16; ++rg) sa[kt][rg] = __builtin_fmaf(slope, (float)(32 * kt + 16 * (rg >> 3) + (rg & 7)), base);
                }
                __builtin_amdgcn_sched_barrier(0);
                __builtin_amdgcn_s_setprio(1);
#pragma unroll
                for (int kt = 0; kt < 2; ++kt)
#pragma unroll
                    for (int ks = 0; ks < 4; ++ks) sa[kt] = __builtin_amdgcn_mfma_f32_32x32x16_f16(fr8[kt * 4 + ks], qf[ks], sa[kt], 0, 0, 0);
                __builtin_amdgcn_s_setprio(0);
                __builtin_amdgcn_sched_barrier(0);
                const unsigned char* vb_ = Vl + buf * 64 * ATP + r * ATP + 16 * hh;
#pragma unroll
                for (int dt = 0; dt < 2; ++dt)
#pragma unroll
                    for (int kt = 0; kt < 2; ++kt)
#pragma unroll
                        for (int s2 = 0; s2 < 2; ++s2) fr8[dt * 4 + kt * 2 + s2] = *(const f16x8*)(vb_ + dt * 32 * ATP + kt * 64 + s2 * 32);
                __builtin_amdgcn_sched_barrier(0);
                float rm = 0.f;
#pragma unroll
                for (int kt = 0; kt < 2; ++kt) { const unsigned w32 = (unsigned)(kt ? (mw >> 32) : mw) >> (8 * hh);
#pragma unroll
                    for (int rg = 0; rg < 16; ++rg) { const int tm = __builtin_amdgcn_sbfe((int)w32, 16 * (rg >> 3) + (rg & 7), 1);
                        const float L = __int_as_float(__float_as_int(sa[kt][rg]) & tm); sa[kt][rg] = L; rm = fmaxf(rm, L); } }
                rm = fmaxf(rm, __shfl_xor(rm, 32));
                const float mn = fmaxf(m, rm);
                if (__any(mn > m)) { const float al = __builtin_amdgcn_exp2f(m - mn); l *= al;
#pragma unroll
                    for (int dt = 0; dt < 2; ++dt)
#pragma unroll
                        for (int rg = 0; rg < 16; ++rg) O[dt][rg] *= al; }
                m = mn;
                f16x8 pf[2][2];
                float l0 = 0.f, l1 = 0.f;
#pragma unroll
                for (int kt = 0; kt < 2; ++kt)
#pragma unroll
                    for (int rg = 0; rg < 16; ++rg) { const float pp = __builtin_amdgcn_exp2f(sa[kt][rg] - m); if (rg & 1) l1 += pp; else l0 += pp; pf[kt][rg >> 3][rg & 7] = (f16)pp; }
                l += l0 + l1;
                __builtin_amdgcn_sched_barrier(0);
                __builtin_amdgcn_s_setprio(1);
#pragma unroll
                for (int dt = 0; dt < 2; ++dt)
#pragma unroll
                    for (int kt = 0; kt < 2; ++kt)
#pragma unroll
                        for (int s2 = 0; s2 < 2; ++s2) O[dt] = __builtin_amdgcn_mfma_f32_32x32x16_f16(fr8[dt * 4 + kt * 2 + s2], pf[kt][s2], O[dt], 0, 0, 0);
                __builtin_amdgcn_s_setprio(0);
            }
            buf ^= 1;
        };
        for (int j = top; j >= 0; j -= 2) {
            step(kr0, vr0, mw0, j); if (stop) break;
            if (j - 1 >= 0) { step(kr1, vr1, mw1, j - 1); if (stop) break; }
        }
#undef ATT_LOAD
        l += __shfl_xor(l, 32);
        const float inv = 1.f / l;
        float ss = 0.f;
#pragma unroll
        for (int dt = 0; dt < 2; ++dt)
#pragma unroll
            for (int rg = 0; rg < 16; ++rg) { O[dt][rg] *= inv; ss += O[dt][rg] * O[dt][rg]; }
        ss += __shfl_xor(ss, 32);
        const float rstd = rsqrtf(ss * (1.f / 64.f) + EPS);
#pragma unroll
        for (int dt = 0; dt < 2; ++dt)
#pragma unroll
            for (int g4 = 0; g4 < 4; ++g4) { const int d = 32 * dt + 8 * g4 + 4 * hh; const f32x4 gg = *(const f32x4*)(og + h * 64 + d);
                f16x4 o4; o4.x = (f16)(O[dt][4 * g4 + 0] * rstd * gg.x); o4.y = (f16)(O[dt][4 * g4 + 1] * rstd * gg.y); o4.z = (f16)(O[dt][4 * g4 + 2] * rstd * gg.z); o4.w = (f16)(O[dt][4 * g4 + 3] * rstd * gg.w);
                *(f16x4*)(MIX + t * ND + 512 + h * 64 + d) = o4; }
        __syncthreads();
    }
}

__device__ __forceinline__ void ph5_outproj(const Args& a, int bid, int nb, unsigned char* lds) {
    pg8::Gemm g{(const f16*)(a.ws + WS_H), (const f16*)(a.ws + WS_WOUT), NT, 1024, ND}; pg8::StaticOrder S; S.init(NT, 1024, nb, bid);
    pg8::EpiOut E{a.in[0], (const float*)(a.ws + WS_MOD), (f16*)(a.ws + WS_X1)};
    pg8::gemm_phase((PG8_LAS unsigned char*)lds, g, S, E);
}

__device__ __forceinline__ void ph7_peerq(const Args& a, int bid, int nb, unsigned char* lds) {
    pg8::Gemm g{(const f16*)(a.ws + WS_HQ), (const f16*)(a.ws + WS_WQ8), NT, 2048, ND / 2}; pg8::StaticOrder S; S.init(NT, 2048, nb, bid);
    pg8::EpiPQ E{(f16*)(a.ws + WS_PQ), (const float*)(a.ws + WS_HSC), (const float*)(a.ws + WS_WSC)};
    pg8::gemm_phase<pg8::EpiPQ, true>((PG8_LAS unsigned char*)lds, g, S, E);
}


__device__ __forceinline__ unsigned f2skey(float f) { const unsigned u = __float_as_uint(f); return (u & 0x80000000u) ? ~u : (u | 0x80000000u); }
__device__ __forceinline__ float skey2f(unsigned k) { return __uint_as_float((k & 0x80000000u) ? (k & 0x7FFFFFFFu) : ~k); }
#define CE_(a_, b_) do { const unsigned t__ = max(a_, b_); b_ = min(a_, b_); a_ = t__; } while (0)
#define SORT16_DESC(v) do { CE_(v[0], v[1]); CE_(v[2], v[3]); CE_(v[0], v[2]); CE_(v[1], v[3]); CE_(v[1], v[2]); CE_(v[4], v[5]); CE_(v[6], v[7]); CE_(v[4], v[6]); CE_(v[5], v[7]); CE_(v[5], v[6]); CE_(v[0], v[4]); CE_(v[2], v[6]); CE_(v[2], v[4]); CE_(v[1], v[5]); CE_(v[3], v[7]); CE_(v[3], v[5]); CE_(v[1], v[2]); CE_(v[3], v[4]); CE_(v[5], v[6]); CE_(v[8], v[9]); CE_(v[10], v[11]); CE_(v[8], v[10]); CE_(v[9], v[11]); CE_(v[9], v[10]); CE_(v[12], v[13]); CE_(v[14], v[15]); CE_(v[12], v[14]); CE_(v[13], v[15]); CE_(v[13], v[14]); CE_(v[8], v[12]); CE_(v[10], v[14]); CE_(v[10], v[12]); CE_(v[9], v[13]); CE_(v[11], v[15]); CE_(v[11], v[13]); CE_(v[9], v[10]); CE_(v[11], v[12]); CE_(v[13], v[14]); CE_(v[0], v[8]); CE_(v[4], v[12]); CE_(v[4], v[8]); CE_(v[2], v[10]); CE_(v[6], v[14]); CE_(v[6], v[10]); CE_(v[2], v[4]); CE_(v[6], v[8]); CE_(v[10], v[12]); CE_(v[1], v[9]); CE_(v[5], v[13]); CE_(v[5], v[9]); CE_(v[3], v[11]); CE_(v[7], v[15]); CE_(v[7], v[11]); CE_(v[3], v[5]); CE_(v[7], v[9]); CE_(v[11], v[13]); CE_(v[1], v[2]); CE_(v[3], v[4]); CE_(v[5], v[6]); CE_(v[7], v[8]); CE_(v[9], v[10]); CE_(v[11], v[12]); CE_(v[13], v[14]); } while (0)
#define BITONIC16_DESC(v) do { CE_(v[0], v[8]); CE_(v[1], v[9]); CE_(v[2], v[10]); CE_(v[3], v[11]); CE_(v[4], v[12]); CE_(v[5], v[13]); CE_(v[6], v[14]); CE_(v[7], v[15]); CE_(v[0], v[4]); CE_(v[1], v[5]); CE_(v[2], v[6]); CE_(v[3], v[7]); CE_(v[8], v[12]); CE_(v[9], v[13]); CE_(v[10], v[14]); CE_(v[11], v[15]); CE_(v[0], v[2]); CE_(v[1], v[3]); CE_(v[4], v[6]); CE_(v[5], v[7]); CE_(v[8], v[10]); CE_(v[9], v[11]); CE_(v[12], v[14]); CE_(v[13], v[15]); CE_(v[0], v[1]); CE_(v[2], v[3]); CE_(v[4], v[5]); CE_(v[6], v[7]); CE_(v[8], v[9]); CE_(v[10], v[11]); CE_(v[12], v[13]); CE_(v[14], v[15]); } while (0)
#define MERGE16_DESC(dst, other) do { unsigned c__[16]; _Pragma("unroll") for (int i__ = 0; i__ < 16; ++i__) c__[i__] = max(dst[i__], other[15 - i__]); BITONIC16_DESC(c__); _Pragma("unroll") for (int i__ = 0; i__ < 16; ++i__) dst[i__] = c__[i__]; } while (0)
#define TOP16_INSERT(v, x_) do { unsigned x__ = (x_); _Pragma("unroll") for (int k_ = 0; k_ < 16; ++k_) { const unsigned t__ = max(v[k_], x__); x__ = min(v[k_], x__); v[k_] = t__; } } while (0)
__device__ __forceinline__ void ph8_peersel_fast(const Args& a, int bid, int nb, unsigned char* lds) {
    int tid = threadIdx.x; asm volatile("" : "+v"(tid));
    const int lane = tid & 63, wave = __builtin_amdgcn_readfirstlane(tid >> 6), r = lane & 31, hh = lane >> 5;
    const f16* PQ = (const f16*)(a.ws + WS_PQ);
    u16* EID = (u16*)(a.ws + WS_EID); float* GW = (float*)(a.ws + WS_GW);
    unsigned char* wl = lds + wave * 2048 + lane * 32;
    for (int item = bid * NWAVE + wave; item < (NT / 32) * 8; item += nb * NWAVE) {
        const int tt = item >> 3, h = item & 7, t0 = tt * 32;
        unsigned top[2][16];
#pragma unroll
        for (int p = 0; p < 2; ++p) {
            f16x8 sq[8];
#pragma unroll
            for (int c = 0; c < 8; ++c) sq[c] = *(const f16x8*)(PQ + ((((size_t)tt * 256 + h * 32 + p * 16 + 8 * hh + c) * 32 + r) << 3));
#pragma unroll
            for (int k = 0; k < 16; ++k) top[p][k] = 0u;
#pragma unroll
            for (int g = 0; g < 4; ++g) {
                unsigned ky[16];
#pragma unroll
                for (int i = 0; i < 16; ++i) { const unsigned n = 64u * hh + 16u * g + i; ky[i] = (f2skey((float)sq[2 * g + (i >> 3)][i & 7]) & ~127u) | n; }
                SORT16_DESC(ky); MERGE16_DESC(top[p], ky);
            }
            unsigned oth[16];
#pragma unroll
            for (int k = 0; k < 16; ++k) oth[k] = __shfl_xor(top[p][k], 32);
            MERGE16_DESC(top[p], oth);
            asm volatile("" ::: "memory");
        }
#pragma unroll
        for (int k = 0; k < 16; k += 4) {
            *(unsigned*)(wl + k) = (top[0][k] & 127u) | ((top[0][k + 1] & 127u) << 8) | ((top[0][k + 2] & 127u) << 16) | ((top[0][k + 3] & 127u) << 24);
            *(unsigned*)(wl + 16 + k) = (top[1][k] & 127u) | ((top[1][k + 1] & 127u) << 8) | ((top[1][k + 2] & 127u) << 16) | ((top[1][k + 3] & 127u) << 24);
        }
        float fa[16], fb[16];
#pragma unroll
        for (int k = 0; k < 16; ++k) { fa[k] = skey2f(top[0][k] & ~127u); fb[k] = skey2f(top[1][k] & ~127u); }
        unsigned cg[4][16];
        cg[0][0] = (f2skey(fa[0] + fb[0]) & ~255u) | 0u;
        cg[0][1] = (f2skey(fa[0] + fb[1]) & ~255u) | 1u;
        cg[0][2] = (f2skey(fa[0] + fb[2]) & ~255u) | 2u;
        cg[0][3] = (f2skey(fa[0] + fb[3]) & ~255u) | 3u;
        cg[0][4] = (f2skey(fa[0] + fb[4]) & ~255u) | 4u;
        cg[0][5] = (f2skey(fa[0] + fb[5]) & ~255u) | 5u;
        cg[0][6] = (f2skey(fa[0] + fb[6]) & ~255u) | 6u;
        cg[0][7] = (f2skey(fa[0] + fb[7]) & ~255u) | 7u;
        cg[0][8] = (f2skey(fa[0] + fb[8]) & ~255u) | 8u;
        cg[0][9] = (f2skey(fa[0] + fb[9]) & ~255u) | 9u;
        cg[0][10] = (f2skey(fa[0] + fb[10]) & ~255u) | 10u;
        cg[0][11] = (f2skey(fa[0] + fb[11]) & ~255u) | 11u;
        cg[0][12] = (f2skey(fa[0] + fb[12]) & ~255u) | 12u;
        cg[0][13] = (f2skey(fa[0] + fb[13]) & ~255u) | 13u;
        cg[0][14] = (f2skey(fa[0] + fb[14]) & ~255u) | 14u;
        cg[0][15] = (f2skey(fa[0] + fb[15]) & ~255u) | 15u;
        cg[1][0] = (f2skey(fa[1] + fb[0]) & ~255u) | 16u;
        cg[1][1] = (f2skey(fa[1] + fb[1]) & ~255u) | 17u;
        cg[1][2] = (f2skey(fa[1] + fb[2]) & ~255u) | 18u;
        cg[1][3] = (f2skey(fa[1] + fb[3]) & ~255u) | 19u;
        cg[1][4] = (f2skey(fa[1] + fb[4]) & ~255u) | 20u;
        cg[1][5] = (f2skey(fa[1] + fb[5]) & ~255u) | 21u;
        cg[1][6] = (f2skey(fa[1] + fb[6]) & ~255u) | 22u;
        cg[1][7] = (f2skey(fa[1] + fb[7]) & ~255u) | 23u;
        cg[1][8] = (f2skey(fa[2] + fb[0]) & ~255u) | 32u;
        cg[1][9] = (f2skey(fa[2] + fb[1]) & ~255u) | 33u;
        cg[1][10] = (f2skey(fa[2] + fb[2]) & ~255u) | 34u;
        cg[1][11] = (f2skey(fa[2] + fb[3]) & ~255u) | 35u;
        cg[1][12] = (f2skey(fa[2] + fb[4]) & ~255u) | 36u;
        cg[1][13] = (f2skey(fa[3] + fb[0]) & ~255u) | 48u;
        cg[1][14] = (f2skey(fa[3] + fb[1]) & ~255u) | 49u;
        cg[1][15] = (f2skey(fa[3] + fb[2]) & ~255u) | 50u;
        cg[2][0] = (f2skey(fa[3] + fb[3]) & ~255u) | 51u;
        cg[2][1] = (f2skey(fa[4] + fb[0]) & ~255u) | 64u;
        cg[2][2] = (f2skey(fa[4] + fb[1]) & ~255u) | 65u;
        cg[2][3] = (f2skey(fa[4] + fb[2]) & ~255u) | 66u;
        cg[2][4] = (f2skey(fa[5] + fb[0]) & ~255u) | 80u;
        cg[2][5] = (f2skey(fa[5] + fb[1]) & ~255u) | 81u;
        cg[2][6] = (f2skey(fa[6] + fb[0]) & ~255u) | 96u;
        cg[2][7] = (f2skey(fa[6] + fb[1]) & ~255u) | 97u;
        cg[2][8] = (f2skey(fa[7] + fb[0]) & ~255u) | 112u;
        cg[2][9] = (f2skey(fa[7] + fb[1]) & ~255u) | 113u;
        cg[2][10] = (f2skey(fa[8] + fb[0]) & ~255u) | 128u;
        cg[2][11] = (f2skey(fa[9] + fb[0]) & ~255u) | 144u;
        cg[2][12] = (f2skey(fa[10] + fb[0]) & ~255u) | 160u;
        cg[2][13] = (f2skey(fa[11] + fb[0]) & ~255u) | 176u;
        cg[2][14] = (f2skey(fa[12] + fb[0]) & ~255u) | 192u;
        cg[2][15] = (f2skey(fa[13] + fb[0]) & ~255u) | 208u;
        cg[3][0] = (f2skey(fa[14] + fb[0]) & ~255u) | 224u;
        cg[3][1] = (f2skey(fa[15] + fb[0]) & ~255u) | 240u;
        cg[3][2] = 0u;
        cg[3][3] = 0u;
        cg[3][4] = 0u;
        cg[3][5] = 0u;
        cg[3][6] = 0u;
        cg[3][7] = 0u;
        cg[3][8] = 0u;
        cg[3][9] = 0u;
        cg[3][10] = 0u;
        cg[3][11] = 0u;
        cg[3][12] = 0u;
        cg[3][13] = 0u;
        cg[3][14] = 0u;
        cg[3][15] = 0u;
        SORT16_DESC(cg[0]); SORT16_DESC(cg[1]); SORT16_DESC(cg[2]); SORT16_DESC(cg[3]);
        MERGE16_DESC(cg[0], cg[1]); MERGE16_DESC(cg[2], cg[3]); MERGE16_DESC(cg[0], cg[2]);
        unsigned ct[16];
#pragma unroll
        for (int k = 0; k < 16; ++k) ct[k] = cg[0][k];
        float sc[16]; float den = 0.f; const float s0 = skey2f(ct[0] & ~255u);
#pragma unroll
        for (int k = 0; k < 16; ++k) { sc[k] = __expf(skey2f(ct[k] & ~255u) - s0); den += sc[k]; }
        const float inv = 1.f / den;
        if (hh == 0) {
            u16 ev[16];
#pragma unroll
            for (int k = 0; k < 16; ++k) { const unsigned ij = ct[k] & 255u; const unsigned i1 = wl[ij >> 4], i2 = wl[16 + (ij & 15u)]; ev[k] = (u16)(i1 * 128u + i2); }
            const size_t o = (size_t)(t0 + r) * 128 + h * 16;
#pragma unroll
            for (int k = 0; k < 16; k += 8) {
                *(u32x4*)(EID + o + k) = (u32x4){(unsigned)ev[k] | ((unsigned)ev[k + 1] << 16), (unsigned)ev[k + 2] | ((unsigned)ev[k + 3] << 16), (unsigned)ev[k + 4] | ((unsigned)ev[k + 5] << 16), (unsigned)ev[k + 6] | ((unsigned)ev[k + 7] << 16)};
            }
#pragma unroll
            for (int k = 0; k < 16; k += 4) *(f32x4*)(GW + o + k) = (f32x4){sc[k] * inv, sc[k + 1] * inv, sc[k + 2] * inv, sc[k + 3] * inv};
        }
    }
}

typedef _Float16 f16x2 __attribute__((ext_vector_type(2)));
__device__ __forceinline__ float gelu_erf(float d) { return 0.5f * d * (1.f + erff(d * 0.70710678118654752f)); }
constexpr int PQ_WORD0 = 3584, PQ_CHUNK = 64, PQ_NCHUNK = NT / PQ_CHUNK, PQ_HALF = PQ_NCHUNK / 2;
constexpr size_t WS_PART = 208 * MiB;
__device__ __forceinline__ unsigned xcc_id_() { return (unsigned)__builtin_amdgcn_s_getreg((3 << 11) | 20) & 7u; }
template <int VPHASE>
__device__ __forceinline__ void ph9_sliced(const Args& a, unsigned char* lds) {
    int tid_ = threadIdx.x; asm volatile("" : "+v"(tid_)); const int lane = tid_ & 63, wave = __builtin_amdgcn_readfirstlane(tid_ >> 6);
    const int g8 = lane >> 3, c8 = lane & 7;
    const unsigned char* HQ = a.ws + WS_HQ; const float* HSC = (const float*)(a.ws + WS_HSC); const unsigned char* TAB = a.ws + (VPHASE ? WS_VP : WS_UT);
    const u16* EID = (const u16*)(a.ws + WS_EID); const float* GW = (const float*)(a.ws + WS_GW); float* PART = (float*)(a.ws + WS_PART);
    const float* mod = (const float*)(a.ws + WS_MOD); float* out = a.out; const f16* X1 = (const f16*)(a.ws + WS_X1);
    unsigned* qw = (unsigned*)(a.ws + WS_CTL) + PQ_WORD0 + (VPHASE ? 8 * 64 : 0);
    volatile unsigned* cslot = (volatile unsigned*)lds;
    const bool b5 = (lane & 32) != 0, b4 = (lane & 16) != 0, b3 = (lane & 8) != 0, b2 = (lane & 4) != 0, b1 = (lane & 2) != 0, b0 = (lane & 1) != 0;
    const unsigned x0 = xcc_id_();
    int par = 0;
    for (int k = 0; k < 8; ++k) {
        const unsigned qi_ = (x0 + (unsigned)k) & 7u, sl = qi_ & 3u, half = qi_ >> 2;
        unsigned cur = 0u;
        if (tid_ == 0) cur = __hip_atomic_fetch_add(qw + 64 * qi_, 1u, __ATOMIC_RELAXED, __HIP_MEMORY_SCOPE_AGENT);
        for (;;) {
            if (tid_ == 0) cslot[par] = cur;
            __syncthreads();
            const unsigned c = cslot[par]; par ^= 1;
            if (c >= (unsigned)PQ_HALF) break;
            if (tid_ == 0) cur = __hip_atomic_fetch_add(qw + 64 * qi_, 1u, __ATOMIC_RELAXED, __HIP_MEMORY_SCOPE_AGENT);
            const int tb = (int)(half * PQ_HALF + c) * PQ_CHUNK + wave * (PQ_CHUNK / NWAVE);
            const unsigned char* tsl = TAB + 128 * sl + 16 * c8;
#pragma unroll 1
            for (int i8 = 0; i8 < PQ_CHUNK / NWAVE; ++i8) {
                const int t = tb + i8;
                const u32x4 e0 = *(const u32x4*)(EID + (size_t)t * 128 + 16 * g8), e1 = *(const u32x4*)(EID + (size_t)t * 128 + 16 * g8 + 8);
                const unsigned ew[8] = {e0.x, e0.y, e0.z, e0.w, e1.x, e1.y, e1.z, e1.w};
                u32x4 r8[16];
#pragma unroll
                for (int i = 0; i < 16; ++i) { const unsigned eid = (i & 1) ? (ew[i >> 1] >> 16) : (ew[i >> 1] & 0xFFFFu); r8[i] = *(const u32x4*)(tsl + (size_t)eid * 512); }
                if (!VPHASE) {
                    const u32x4 h0 = *(const u32x4*)(HQ + (size_t)t * 1024 + 256 * sl + 32 * c8), h1 = *(const u32x4*)(HQ + (size_t)t * 1024 + 256 * sl + 32 * c8 + 16);
                    const int hv[8] = {(int)h0.x, (int)h0.y, (int)h0.z, (int)h0.w, (int)h1.x, (int)h1.y, (int)h1.z, (int)h1.w};
                    const float hsc = 0.5f * HSC[t];
                    int hsum = 0;
#pragma unroll
                    for (int d = 0; d < 8; ++d) hsum = __builtin_amdgcn_sdot4(hv[d], 0x01010101, hsum, false);
                    float p[16];
#pragma unroll
                    for (int i = 0; i < 16; ++i) { int dd = 0;
#pragma unroll
                        for (int j = 0; j < 4; ++j) { const unsigned x = r8[i][j];
                            dd = __builtin_amdgcn_sdot4(hv[2 * j], (int)(x & 0x0F0F0F0Fu), dd, false); dd = __builtin_amdgcn_sdot4(hv[2 * j + 1], (int)((x >> 4) & 0x0F0F0F0Fu), dd, false); }
                        p[i] = (float)(2 * dd - 15 * hsum); }
                    float q8[8], q4[4], r2[2];
#pragma unroll
                    for (int ii = 0; ii < 8; ++ii) { const float keep = b2 ? p[8 + ii] : p[ii], send = b2 ? p[ii] : p[8 + ii]; q8[ii] = keep + __shfl_xor(send, 4); }
#pragma unroll
                    for (int ii = 0; ii < 4; ++ii) { const float keep = b1 ? q8[4 + ii] : q8[ii], send = b1 ? q8[ii] : q8[4 + ii]; q4[ii] = keep + __shfl_xor(send, 2); }
#pragma unroll
                    for (int ii = 0; ii < 2; ++ii) { const float keep = b0 ? q4[2 + ii] : q4[ii], send = b0 ? q4[ii] : q4[2 + ii]; r2[ii] = keep + __shfl_xor(send, 1); }
                    *(f32x2*)(PART + ((size_t)sl * NT + t) * 128 + 16 * g8 + 2 * c8) = (f32x2){r2[0] * hsc, r2[1] * hsc};
                } else {
                    const float* wp = GW + (size_t)t * 128 + 16 * g8;
                    const f32x4 wq0 = *(const f32x4*)wp, wq1 = *(const f32x4*)(wp + 4), wq2 = *(const f32x4*)(wp + 8), wq3 = *(const f32x4*)(wp + 12);
                    const float wv[16] = {wq0[0], wq0[1], wq0[2], wq0[3], wq1[0], wq1[1], wq1[2], wq1[3], wq2[0], wq2[1], wq2[2], wq2[3], wq3[0], wq3[1], wq3[2], wq3[3]};
                    float wsum = 0.f;
#pragma unroll
                    for (int i = 0; i < 16; ++i) wsum += wv[i];
                    const f16 off = (f16)(-7.5f * 5.9604644775390625e-08f * wsum);
                    f16x2 acc2[16];
#pragma unroll
                    for (int j = 0; j < 16; ++j) acc2[j] = (f16x2){off, off};
#pragma unroll
                    for (int i = 0; i < 16; ++i) { const f16x2 wa = (f16x2){(f16)wv[i], (f16)wv[i]}; const f16x2 wb = wa * (f16x2){(f16)0.0625f, (f16)0.0625f};
#pragma unroll
                        for (int j = 0; j < 4; ++j) { const unsigned x = r8[i][j], y = x >> 8;
                            acc2[4 * j]     = __builtin_elementwise_fma(wa, __builtin_bit_cast(f16x2, x & 0x000F000Fu), acc2[4 * j]);
                            acc2[4 * j + 1] = __builtin_elementwise_fma(wb, __builtin_bit_cast(f16x2, x & 0x00F000F0u), acc2[4 * j + 1]);
                            acc2[4 * j + 2] = __builtin_elementwise_fma(wa, __builtin_bit_cast(f16x2, y & 0x000F000Fu), acc2[4 * j + 2]);
                            acc2[4 * j + 3] = __builtin_elementwise_fma(wb, __builtin_bit_cast(f16x2, y & 0x00F000F0u), acc2[4 * j + 3]); } }
                    float acc[32];
#pragma unroll
                    for (int j = 0; j < 4; ++j)
#pragma unroll
                        for (int q = 0; q < 4; ++q) { acc[8 * j + q] = (float)acc2[4 * j + q][0]; acc[8 * j + 4 + q] = (float)acc2[4 * j + q][1]; }
                    float q16[16], q8[8], r4[4];
#pragma unroll
                    for (int ii = 0; ii < 16; ++ii) { const float keep = b5 ? acc[16 + ii] : acc[ii], send = b5 ? acc[ii] : acc[16 + ii]; q16[ii] = keep + __shfl_xor(send, 32); }
#pragma unroll
                    for (int ii = 0; ii < 8; ++ii) { const float keep = b4 ? q16[8 + ii] : q16[ii], send = b4 ? q16[ii] : q16[8 + ii]; q8[ii] = keep + __shfl_xor(send, 16); }
#pragma unroll
                    for (int ii = 0; ii < 4; ++ii) { const float keep = b3 ? q8[4 + ii] : q8[ii], send = b3 ? q8[ii] : q8[4 + ii]; r4[ii] = keep + __shfl_xor(send, 8); }
                    const int ch = 256 * sl + 32 * c8 + 4 * g8;
                    float* op = out + (size_t)t * ND + ch; const float* g2 = mod + (t / NS) * 6144 + 5120 + ch;
                    const f16x4 x4 = *(const f16x4*)(X1 + (size_t)t * ND + ch); const f32x4 gg = *(const f32x4*)g2;
                    *(f32x4*)op = (f32x4){(float)x4[0], (float)x4[1], (float)x4[2], (float)x4[3]} + gg * ((f32x4){r4[0], r4[1], r4[2], r4[3]} * (16777216.f / PEER_WSCALE));
                }
            }
        }
    }
}
__device__ __forceinline__ void ph9b_combine(const Args& a, int bid, int nb) {
    int tid_ = threadIdx.x; asm volatile("" : "+v"(tid_));
    float* GW = (float*)(a.ws + WS_GW); const float* PART = (const float*)(a.ws + WS_PART);
    const float du = ((const float*)(a.ws + WS_QS))[0], dv = ((const float*)(a.ws + WS_QS))[1] * PEER_WSCALE;
    for (size_t i = (size_t)bid * NTHR + tid_; i < (size_t)NT * 128 / 4; i += (size_t)nb * NTHR) {
        f32x4 sum = ((const f32x4*)PART)[i];
#pragma unroll
        for (int sidx = 1; sidx < 4; ++sidx) sum += ((const f32x4*)(PART + (size_t)sidx * NT * 128))[i];
        const f32x4 g = ((const f32x4*)GW)[i];
        f32x4 w;
#pragma unroll
        for (int j = 0; j < 4; ++j) w[j] = fminf(fmaxf(g[j] * gelu_erf(sum[j] * du) * dv, -60000.f), 60000.f);
        ((f32x4*)GW)[i] = w;
    }
}

#define LAS __attribute__((address_space(3)))
#define XB_TMO      128
#define XB_XCNT(j)  (256  + 64 * (j))
#define XB_XSUB(j)  (1280 + 64 * (j))
#define XB_XGEN(j)  (2304 + 64 * (j))
#define XB_TOP      3328
#define XB_TOPGEN   3392
#define XCD_BAR_WORDS 3456
#define XB_SPIN_CAP (1u << 18)
__device__ __forceinline__ unsigned xb_ld(unsigned* p)              { return __hip_atomic_load(p, __ATOMIC_RELAXED, __HIP_MEMORY_SCOPE_AGENT); }
__device__ __forceinline__ unsigned xb_add(unsigned* p, unsigned v) { return __hip_atomic_fetch_add(p, v, __ATOMIC_RELAXED, __HIP_MEMORY_SCOPE_AGENT); }
__device__ __forceinline__ unsigned xb_xcc_id() { return (unsigned)__builtin_amdgcn_s_getreg((3 << 11) | 20) & 0xFu; }
#define XB_SPIN(cond, bar) do { unsigned _sp = 0; while (cond) { __builtin_amdgcn_s_sleep(1); \
    if ((++_sp & 255u) == 0u) { if (xb_ld(&(bar)[XB_TMO])) break; if (_sp > XB_SPIN_CAP) { atomicAdd(&(bar)[XB_TMO], 1u); break; } } } } while (0)
struct XcdBarrier { unsigned* bar; unsigned x; volatile LAS unsigned* st; };
__device__ __forceinline__ XcdBarrier xcd_barrier_post(unsigned* bar, volatile LAS unsigned* st) {
    XcdBarrier b; b.bar = bar; b.x = xb_xcc_id(); b.st = st;
    if (threadIdx.x == 0) (void)xb_add(&bar[XB_XCNT(b.x)], 1u);
    return b;
}
__device__ __forceinline__ void xcd_barrier_complete(unsigned* bar, unsigned x, unsigned& nloc, unsigned& nx) {
    const unsigned G = gridDim.x * gridDim.y * gridDim.z;
    unsigned sum, cnt, mine, sp = 0u;
    for (;;) {
        sum = 0u; cnt = 0u; mine = 0u;
#pragma unroll
        for (unsigned j = 0; j < 16; ++j) { const unsigned c = xb_ld(&bar[XB_XCNT(j)]); sum += c; cnt += (c > 0u) ? 1u : 0u; mine = (j == x) ? c : mine; }
        if (sum == G) break;
        __builtin_amdgcn_s_sleep(1);
        if ((++sp & 255u) == 0u) { if (xb_ld(&bar[XB_TMO])) break; if (sp > XB_SPIN_CAP) { atomicAdd(&bar[XB_TMO], 1u); break; } }
    }
    nloc = mine > 0u ? mine : 1u; nx = cnt > 0u ? cnt : 1u;
}
__device__ __forceinline__ void xcd_barrier(const XcdBarrier& b) {
    asm volatile("s_waitcnt vmcnt(0)" ::: "memory");
    __syncthreads();
    if (threadIdx.x == 0) {
        unsigned* bar = b.bar;
        __builtin_amdgcn_s_waitcnt(0);
        unsigned nloc = b.st[0], nx = b.st[1];
        if (nloc == 0u) { xcd_barrier_complete(bar, b.x, nloc, nx); b.st[0] = nloc; b.st[1] = nx; }
        const unsigned old = xb_add(&bar[XB_XSUB(b.x)], 1u);
        const unsigned gen = old / nloc;
        if (old + 1u == (gen + 1u) * nloc) {
            __builtin_amdgcn_fence(__ATOMIC_RELEASE, "agent");
            asm volatile("s_waitcnt vmcnt(0)" ::: "memory");
            const unsigned og = xb_add(&bar[XB_TOP], 1u);
            const unsigned tg = og / nx;
            if (og + 1u == (tg + 1u) * nx) xb_add(&bar[XB_TOPGEN], 1u);
            else XB_SPIN(xb_ld(&bar[XB_TOPGEN]) == tg, bar);
            __builtin_amdgcn_fence(__ATOMIC_ACQUIRE, "agent");
            xb_add(&bar[XB_XGEN(b.x)], 1u);
            asm volatile("s_waitcnt vmcnt(0)" ::: "memory");
        } else {
            XB_SPIN(xb_ld(&bar[XB_XGEN(b.x)]) == gen, bar);
            __builtin_amdgcn_fence(__ATOMIC_ACQUIRE, "agent");
            asm volatile("s_waitcnt vmcnt(0)" ::: "memory");
        }
    }
    __syncthreads();
}

constexpr int N_PHASES = 12;
__global__ void __launch_bounds__(NTHR, 2) mk_fwd(Args a) {
    extern __shared__ __attribute__((aligned(16))) unsigned char lds[];
    cg::grid_group grid = cg::this_grid();
    const int bid = blockIdx.x, nb = gridDim.x;
    const int lo = a.ph_lo, hi = a.ph_hi;
    volatile LAS unsigned* bst = (volatile LAS unsigned*)((LAS unsigned char*)lds + (LDS_BYTES - 16));
    if (threadIdx.x < 4) bst[threadIdx.x] = 0u;
    __syncthreads();
    XcdBarrier xbar = xcd_barrier_post((unsigned*)(a.ws + WS_CTL), bst);
#define SEAM(k) do { if ((k) == 0) grid.sync(); else xcd_barrier(xbar); } while (0)
#define PHASE(k, body) if (lo <= (k) && (k) < hi) { body; if ((k) + 1 < hi) SEAM(k); }
    PHASE(0, ph0_prologue(a, bid, nb, lds))
    PHASE(1, row_norm_mod(a.in[0], a.in[4], (const float*)(a.ws + WS_MOD), 0, 1024, (f16*)(a.ws + WS_H), bid, nb); wq_to_int8((const f16*)(a.ws + WS_WQ), a.ws + WS_WQ8, (float*)(a.ws + WS_WSC), bid, nb))
    PHASE(2, ph2_inproj(a, bid, nb, lds))
    PHASE(3, ph3_pool_fast(a, bid, nb, lds); ph3_index_fast<0>(a, bid, nb, lds))
    PHASE(4, ph4_attn_fast<0>(a, bid, nb, lds))
    PHASE(5, ph5_outproj(a, bid, nb, lds))
    PHASE(6, row_norm_mod_q((const f16*)(a.ws + WS_X1), a.in[13], (const float*)(a.ws + WS_MOD), 3072, 4096, a.ws + WS_HQ, (float*)(a.ws + WS_HSC), bid, nb))
    PHASE(7, ph7_peerq(a, bid, nb, lds))
    PHASE(8, ph8_peersel_fast(a, bid, nb, lds))
    PHASE(9, ph9_sliced<0>(a, lds))
    PHASE(10, ph9b_combine(a, bid, nb))
    PHASE(11, ph9_sliced<1>(a, lds))
#undef PHASE
}

extern "C" void kernel_launch(void* const* d_in, const int* in_sizes, int n_in, void* d_out, int out_size, void* d_ws, size_t ws_size, hipStream_t stream) {
    static int grid = 0;
    if (grid == 0) {
        if (n_in != 18 || out_size != NT * ND || ws_size < WS_END) { fprintf(stderr, "kernel_launch: unexpected shapes (n_in %d out %d ws %zu)\n", n_in, out_size, ws_size); grid = -1; return; }
        int dev = 0, cus = 0, per_cu = 0;
        hipGetDevice(&dev); hipDeviceGetAttribute(&cus, hipDeviceAttributeMultiprocessorCount, dev);
        hipFuncSetAttribute((const void*)mk_fwd, hipFuncAttributeMaxDynamicSharedMemorySize, LDS_BYTES);
        hipOccupancyMaxActiveBlocksPerMultiprocessor(&per_cu, (const void*)mk_fwd, NTHR, LDS_BYTES);
        if (per_cu < 1) { fprintf(stderr, "kernel_launch: occupancy query says %d blocks/CU\n", per_cu); per_cu = 1; }
        grid = cus * 1;
        (void)hipGetLastError();
    }
    if (grid < 0) return;
    if (hipMemsetAsync((char*)d_ws + WS_CTL, 0, 32768, stream) != hipSuccess) { fprintf(stderr, "kernel_launch: memset of the barrier words failed\n"); return; }
    Args a{};
    for (int i = 0; i < 18; ++i) a.in[i] = (const float*)d_in[i];
    a.out = (float*)d_out; a.ws = (unsigned char*)d_ws;
#if MK_MULTI
    for (int ph = 0; ph < N_PHASES; ++ph) { a.ph_lo = ph; a.ph_hi = ph + 1; hipLaunchKernelGGL(mk_fwd, dim3(grid), dim3(NTHR), LDS_BYTES, stream, a); }
#else
    a.ph_lo = 0; a.ph_hi = N_PHASES;
    void* args[] = {&a};
    hipError_t e = hipLaunchCooperativeKernel((const void*)mk_fwd, dim3(grid), dim3(NTHR), args, LDS_BYTES, stream);
    if (e != hipSuccess) fprintf(stderr, "cooperative launch failed: %s (grid %d)\n", hipGetErrorString(e), grid);
#endif
}
```

```cpp
#include <hip/hip_runtime.h>
#include <hip/hip_cooperative_groups.h>
#include <cstdio>
#include <cstdint>
namespace cg = cooperative_groups;

#ifndef MK_MULTI
#define MK_MULTI 0
#endif

typedef _Float16 f16;
typedef _Float16 f16x8 __attribute__((ext_vector_type(8)));
typedef _Float16 f16x4 __attribute__((ext_vector_type(4)));
typedef float f32x4 __attribute__((ext_vector_type(4)));
typedef float f32x16 __attribute__((ext_vector_type(16)));
typedef int i32x4 __attribute__((ext_vector_type(4)));
typedef unsigned long long u64;
typedef unsigned short u16;

constexpr int NB = 8, NS = 8192, ND = 1024, NT = NB * NS;
constexpr int INW = 2632;
constexpr int NMAIN = 2304;
constexpr float EPS = 1e-6f;
constexpr int NTHR = 512, NWAVE = 8;

constexpr size_t MiB = 1u << 20;
constexpr size_t WS_CTL = 0;
constexpr size_t WS_MOD = 1 * MiB;
constexpr size_t WS_WIN = 2 * MiB;
constexpr size_t WS_WVT = 7 * MiB;
constexpr size_t WS_WOUT = 8 * MiB;
constexpr size_t WS_WQ = 10 * MiB;
constexpr size_t WS_SK = 14 * MiB;
constexpr size_t WS_PW = 14 * MiB + 512 * 1024;
constexpr size_t WS_QS = 1 * MiB + 512 * 1024;
constexpr size_t WS_UT = 16 * MiB;
constexpr size_t WS_VP = 48 * MiB;
constexpr size_t WS_H = 80 * MiB;
constexpr size_t WS_U = 208 * MiB;
constexpr size_t WS_Q = 272 * MiB;
constexpr size_t WS_K = 336 * MiB;
constexpr size_t WS_VT = 400 * MiB;
constexpr size_t WS_PQ = 208 * MiB;
constexpr size_t WS_WQ8 = 24 * MiB;
constexpr size_t WS_WSC = 26 * MiB;
constexpr size_t WS_HQ = 464 * MiB;
constexpr size_t WS_HP = 784 * MiB;
constexpr size_t WS_WSUM = 536 * MiB;
constexpr size_t WS_HSC = 528 * MiB;
constexpr size_t WS_QI = 464 * MiB;
constexpr size_t WS_KI = 528 * MiB;
constexpr size_t WS_WI = 536 * MiB;
constexpr size_t WS_MASK = 544 * MiB;
constexpr size_t WS_EID = 608 * MiB;
constexpr size_t WS_GW = 624 * MiB;
constexpr size_t WS_X1 = 656 * MiB;
constexpr size_t WS_END = 848 * MiB;

constexpr int LDS_BYTES = 155648;
constexpr float PEER_QSTEP = 0.3352f;
constexpr float PEER_WSCALE = 16384.f;

struct Args { const float* in[18]; float* out; unsigned char* ws; int ph_lo, ph_hi; };

__host__ __device__ __forceinline__ int pos2log(int p) { return 64 * ((p >> 5) & 3) + 32 * (p >> 7) + 8 * ((p >> 2) & 3) + 4 * ((p >> 4) & 1) + (p & 3); }
__device__ __forceinline__ int maincol(int L) { if (L < 1536) return L; if (L < 2120) return L + 512; return -1; }

__device__ __forceinline__ float wave_sum(float v) {
#pragma unroll
    for (int o = 1; o < 64; o <<= 1) v += __shfl_xor(v, o);
    return v;
}
__device__ __forceinline__ float wave_max(float v) {
#pragma unroll
    for (int o = 1; o < 64; o <<= 1) v = fmaxf(v, __shfl_xor(v, o));
    return v;
}

__device__ void ph0_prologue(const Args& a, int bid, int nb, unsigned char* lds) {
    int tid = threadIdx.x; asm volatile("" : "+v"(tid));
    const float* c = a.in[1]; const float* ada_w = a.in[2]; const float* ada_b = a.in[3];
    float* sil = (float*)lds;
    for (int i = tid; i < NB * ND; i += NTHR) { const float v = c[i]; sil[i] = v / (1.f + __expf(-v)); }
    __syncthreads();
    float* mod = (float*)(a.ws + WS_MOD);
    const int gt = bid * NTHR + tid, ngt = nb * NTHR;
    for (int o = gt; o < NB * 6144; o += ngt) {
        const int b = o / 6144, j = o % 6144;
        float acc = ada_b[j];
        const float* sb = sil + b * ND;
        for (int k = 0; k < ND; ++k) acc += sb[k] * ada_w[(size_t)k * 6144 + j];
        mod[o] = acc;
    }
    const float* w_in = a.in[5]; const float* pool_w = a.in[6]; const float* w_out = a.in[12];
    const float* wq = a.in[14]; const float* sk = a.in[15]; const float* pu = a.in[16]; const float* pv = a.in[17];
    f16* WIN = (f16*)(a.ws + WS_WIN); f16* WVT = (f16*)(a.ws + WS_WVT); f16* WOUT = (f16*)(a.ws + WS_WOUT); f16* WQ = (f16*)(a.ws + WS_WQ);
 unsigned char* UT = a.ws + WS_UT; unsigned char* VP = a.ws + WS_VP;
    {
        __syncthreads();
        const int lane = tid & 63, wv_ = tid >> 6;
        float* scr = (float*)lds + wv_ * (64 * 33);
        constexpr int I_WQ = 16 * 64, I_Z = 16 * 16, I_INR = 16 * (NMAIN / 32 - 16), I_VT = 16 * 16, I_OUT = 16 * 32, I_ALL = I_WQ + I_Z + I_INR + I_VT + I_OUT;
        for (int it = bid * NWAVE + wv_; it < I_ALL; it += nb * NWAVE) {
            int rr = it, kind = 3, pboff = 0;
            if (rr >= I_WQ) { rr -= I_WQ; kind = 0;
                if (rr >= I_Z) { rr -= I_Z; pboff = 16;
                    if (rr >= I_INR) { rr -= I_INR; kind = 1; pboff = 0; if (rr >= I_VT) { rr -= I_VT; kind = 2; } } } }
            const int npb = kind == 0 ? (pboff ? NMAIN / 32 - 16 : 16) : kind == 1 ? 16 : kind == 2 ? 32 : 64;
            const int k0 = (rr / npb) * 64, p0 = (rr % npb + pboff) * 32, p = p0 + (lane & 31);
            const float* W = kind <= 1 ? w_in : kind == 2 ? w_out : wq; const int ldw = kind <= 1 ? INW : kind == 2 ? 1024 : 2048;
            int col;
            if (kind == 0) col = maincol((p & ~255) + pos2log(p & 255)); else if (kind == 1) col = 1536 + p; else col = (p & ~255) + pos2log(p & 255);
            const bool foldz = (kind == 0 && pboff == 0);
            if (foldz || kind == 3) {
                const int r5 = lane & 31, hh_ = lane >> 5;
                const int blk = __builtin_amdgcn_readfirstlane(col >> 7);
                const int sub = col & 127;
                const float* arow = W + (size_t)(k0 + r5) * ldw + blk * 128 + 8 * hh_;
                f32x16 acc0 = (f32x16){0.f, 0.f, 0.f, 0.f, 0.f, 0.f, 0.f, 0.f, 0.f, 0.f, 0.f, 0.f, 0.f, 0.f, 0.f, 0.f}, acc1 = acc0;
#pragma unroll 2
                for (int ks = 0; ks < 8; ++ks) {
                    const f32x4 a00 = *(const f32x4*)(arow + 16 * ks), a01 = *(const f32x4*)(arow + 16 * ks + 4);
                    const f32x4 a10 = *(const f32x4*)(arow + (size_t)32 * ldw + 16 * ks), a11 = *(const f32x4*)(arow + (size_t)32 * ldw + 16 * ks + 4);
                    f16x8 bfr;
                    if (kind == 3) { const float* br = sk + (size_t)(blk * 128 + sub) * 128 + 16 * ks + 8 * hh_; const f32x4 b0 = *(const f32x4*)br, b1 = *(const f32x4*)(br + 4);
                        bfr = (f16x8){(f16)b0[0], (f16)b0[1], (f16)b0[2], (f16)b0[3], (f16)b1[0], (f16)b1[1], (f16)b1[2], (f16)b1[3]}; }
                    else { const float* br = pool_w + (size_t)blk * 16384 + (size_t)(16 * ks + 8 * hh_) * 128 + sub;
                        bfr = (f16x8){(f16)br[0], (f16)br[128], (f16)br[256], (f16)br[384], (f16)br[512], (f16)br[640], (f16)br[768], (f16)br[896]}; }
                    const f16x8 af0 = (f16x8){(f16)a00[0], (f16)a00[1], (f16)a00[2], (f16)a00[3], (f16)a01[0], (f16)a01[1], (f16)a01[2], (f16)a01[3]};
                    const f16x8 af1 = (f16x8){(f16)a10[0], (f16)a10[1], (f16)a10[2], (f16)a10[3], (f16)a11[0], (f16)a11[1], (f16)a11[2], (f16)a11[3]};
                    acc0 = __builtin_amdgcn_mfma_f32_32x32x16_f16(af0, bfr, acc0, 0, 0, 0);
                    acc1 = __builtin_amdgcn_mfma_f32_32x32x16_f16(af1, bfr, acc1, 0, 0, 0);
                }
#pragma unroll
                for (int rg = 0; rg < 16; ++rg) { const int kk = (rg & 3) + 8 * (rg >> 2) + 4 * hh_; scr[kk * 33 + r5] = acc0[rg]; scr[(32 + kk) * 33 + r5] = acc1[rg]; }
            } else {
#pragma unroll 8
                for (int i = 0; i < 32; ++i) { const int kk = 2 * i + (lane >> 5); scr[kk * 33 + (lane & 31)] = col >= 0 ? W[(size_t)(k0 + kk) * ldw + col] : 0.f; }
            }
            f16* WT = kind == 0 ? WIN : kind == 1 ? WVT : kind == 2 ? WOUT : WQ;
            const int c8 = lane & 7;
#pragma unroll
            for (int j = 0; j < 4; ++j) { const int n = (lane >> 3) + 8 * j; const float* sp = scr + (8 * c8) * 33 + n;
                *(f16x8*)(WT + (size_t)(p0 + n) * ND + k0 + 8 * c8) = (f16x8){(f16)sp[0], (f16)sp[33], (f16)sp[66], (f16)sp[99], (f16)sp[132], (f16)sp[165], (f16)sp[198], (f16)sp[231]}; }
        }
    }
    {
        __syncthreads();
        float ssu = 0.f, ssv = 0.f;
        for (int i = tid; i < 64 * 1024 / 4; i += NTHR) { const f32x4 u = ((const f32x4*)pu)[i], v = ((const f32x4*)pv)[i];
            ssu += u.x * u.x + u.y * u.y + u.z * u.z + u.w * u.w; ssv += v.x * v.x + v.y * v.y + v.z * v.z + v.w * v.w; }
        ssu = wave_sum(ssu); ssv = wave_sum(ssv);
        float* red = (float*)lds;
        if ((tid & 63) == 0) { red[tid >> 6] = ssu; red[8 + (tid >> 6)] = ssv; }
        __syncthreads();
        float tu = 0.f, tv = 0.f;
#pragma unroll
        for (int w = 0; w < 8; ++w) { tu += red[w]; tv += red[8 + w]; }
        const float du = PEER_QSTEP * sqrtf(tu * (1.f / 65536.f)), dv = PEER_QSTEP * sqrtf(tv * (1.f / 65536.f));
        if (bid == 0 && tid == 0) { float* qs = (float*)(a.ws + WS_QS); qs[0] = du; qs[1] = dv; }
        const float idu = 1.f / du, idv = 1.f / dv;
        const int lane = tid & 63, wv_ = tid >> 6;
        for (int row = bid * NWAVE + wv_; row < 2 * 16384; row += nb * NWAVE) {
            const bool isv = row >= 16384; const int e = row & 16383;
            const float* src = (isv ? pv : pu) + (size_t)e * ND + 4 * lane; u16* dstq = (u16*)((isv ? VP : UT) + (size_t)e * 512) + lane;
            const float inv = isv ? idv : idu; const int off = isv ? 8 : 0;
#pragma unroll
            for (int j = 0; j < 4; ++j) { const f32x4 x4 = *(const f32x4*)(src + 256 * j); unsigned pk = 0u;
#pragma unroll
                for (int k = 0; k < 4; ++k) { int q = (int)floorf(x4[k] * inv); q = q < -8 ? -8 : q > 7 ? 7 : q; pk |= (unsigned)((q + off) & 15) << (4 * k); }
                dstq[64 * j] = (u16)pk; }
        }
    }
}

__device__ void row_norm_mod(const float* src, const float* g, const float* mod, int sh_off, int sc_off, f16* dst, int bid, int nb) {
    int tid_ = threadIdx.x; asm volatile("" : "+v"(tid_)); const int lane = tid_ & 63, wave = tid_ >> 6;
    for (int row = bid * NWAVE + wave; row < NT; row += nb * NWAVE) {
        const int b = row / NS;
        const f32x4* xr = (const f32x4*)(src + (size_t)row * ND) + lane;
        f32x4 v[4]; float s = 0.f;
#pragma unroll
        for (int j = 0; j < 4; ++j) { v[j] = xr[64 * j]; s += v[j].x * v[j].x + v[j].y * v[j].y + v[j].z * v[j].z + v[j].w * v[j].w; }
        const float rstd = rsqrtf(wave_sum(s) * (1.f / ND) + EPS);
#pragma unroll
        for (int j = 0; j < 4; ++j) {
            const int col = lane * 4 + 256 * j;
            const f32x4 gg = *(const f32x4*)(g + col), sc = *(const f32x4*)(mod + b * 6144 + sc_off + col), sh = *(const f32x4*)(mod + b * 6144 + sh_off + col);
            f16x4 o;
            o.x = (f16)(v[j].x * rstd * gg.x * (1.f + sc.x) + sh.x); o.y = (f16)(v[j].y * rstd * gg.y * (1.f + sc.y) + sh.y);
            o.z = (f16)(v[j].z * rstd * gg.z * (1.f + sc.z) + sh.z); o.w = (f16)(v[j].w * rstd * gg.w * (1.f + sc.w) + sh.w);
            *(f16x4*)(dst + (size_t)row * ND + col) = o;
        }
    }
}


__device__ void row_norm_mod_q(const f16* src, const float* g, const float* mod, int sh_off, int sc_off, unsigned char* hq, unsigned* hp, float* hsc, int bid, int nb) {
    int tid_ = threadIdx.x; asm volatile("" : "+v"(tid_)); const int lane = tid_ & 63, wave = tid_ >> 6;
    for (int row = bid * NWAVE + wave; row < NT; row += nb * NWAVE) {
        const int b = row / NS;
        const f16* xr = src + (size_t)row * ND + 8 * lane;
        f32x4 v[4]; float s = 0.f;
#pragma unroll
        for (int j = 0; j < 2; ++j) { const f16x8 h8 = *(const f16x8*)(xr + 512 * j);
            v[2 * j] = (f32x4){(float)h8[0], (float)h8[1], (float)h8[2], (float)h8[3]}; v[2 * j + 1] = (f32x4){(float)h8[4], (float)h8[5], (float)h8[6], (float)h8[7]}; }
#pragma unroll
        for (int j = 0; j < 4; ++j) s += v[j].x * v[j].x + v[j].y * v[j].y + v[j].z * v[j].z + v[j].w * v[j].w;
        const float rstd = rsqrtf(wave_sum(s) * (1.f / ND) + EPS);
        float o[16]; float am = 0.f;
#pragma unroll
        for (int j = 0; j < 4; ++j) {
            const int col = 8 * lane + 512 * (j >> 1) + 4 * (j & 1);
            const f32x4 gg = *(const f32x4*)(g + col), sc = *(const f32x4*)(mod + b * 6144 + sc_off + col), sh = *(const f32x4*)(mod + b * 6144 + sh_off + col);
#pragma unroll
            for (int k = 0; k < 4; ++k) { const float y = v[j][k] * rstd * gg[k] * (1.f + sc[k]) + sh[k]; o[4 * j + k] = y; am = fmaxf(am, fabsf(y)); }
        }
        am = wave_max(am);
        const float inv = am > 0.f ? 119.f / am : 0.f;
#pragma unroll
        for (int j = 0; j < 2; ++j) {
            unsigned p0 = 0u, p1 = 0u;
#pragma unroll
            for (int k = 0; k < 4; ++k) { p0 |= (unsigned)((int)rintf(o[8 * j + k] * inv) & 255) << (8 * k); p1 |= (unsigned)((int)rintf(o[8 * j + 4 + k] * inv) & 255) << (8 * k); }
            *(u64*)(hq + (size_t)row * ND + 8 * lane + 512 * j) = (u64)p0 | ((u64)p1 << 32);
            unsigned ph = 0u, pl = 0u;
#pragma unroll
            for (int k = 0; k < 8; ++k) { const int q = (int)rintf(o[8 * j + k] * inv); const int l = ((q + 8) & 15) - 8; const int h = (q - l) >> 4;
                ph |= (unsigned)(h & 15) << (4 * k); pl |= (unsigned)(l & 15) << (4 * k); }
            hp[(size_t)row * 256 + lane + 64 * j] = ph; hp[(size_t)row * 256 + 128 + lane + 64 * j] = pl;
        }
        if (lane == 0) hsc[row] = am * (1.f / 119.f);
    }
}
__device__ void wq_to_int8(const f16* WQ, unsigned char* WQ8, float* WSC, int bid, int nb) {
    int tid_ = threadIdx.x; asm volatile("" : "+v"(tid_)); const int lane = tid_ & 63, wave = tid_ >> 6;
    for (int row = bid * NWAVE + wave; row < 2048; row += nb * NWAVE) {
        const f16x8 a0 = *(const f16x8*)(WQ + (size_t)row * ND + 8 * lane), a1 = *(const f16x8*)(WQ + (size_t)row * ND + 8 * lane + 512);
        float am = 0.f;
#pragma unroll
        for (int k = 0; k < 8; ++k) am = fmaxf(am, fmaxf(fabsf((float)a0[k]), fabsf((float)a1[k])));
        am = wave_max(am);
        const float inv = am > 0.f ? 127.f / am : 0.f;
        unsigned p[4] = {0u, 0u, 0u, 0u};
#pragma unroll
        for (int k = 0; k < 4; ++k) { p[0] |= (unsigned)((int)rintf((float)a0[k] * inv) & 255) << (8 * k); p[1] |= (unsigned)((int)rintf((float)a0[4 + k] * inv) & 255) << (8 * k);
                                      p[2] |= (unsigned)((int)rintf((float)a1[k] * inv) & 255) << (8 * k); p[3] |= (unsigned)((int)rintf((float)a1[4 + k] * inv) & 255) << (8 * k); }
        *(u64*)(WQ8 + (size_t)row * ND + 8 * lane) = (u64)p[0] | ((u64)p[1] << 32);
        *(u64*)(WQ8 + (size_t)row * ND + 8 * lane + 512) = (u64)p[2] | ((u64)p[3] << 32);
        if (lane == 0) WSC[row] = am * (1.f / 127.f);
    }
}

namespace pg8 {
#define PG8_LAS __attribute__((address_space(3)))
constexpr int BM = 256, BK = 64, HALF = 128, HTB = HALF * BK * 2, STAGE_BYTES = 8 * HTB, NXCD = 8, WGM = 8;
__host__ __device__ __forceinline__ int lds_byte(int r, int c) { const int st = (r >> 4) * 2 + (c >> 5), rr = r & 15, cc = c & 31, ob = rr * 64 + cc * 2; return st * 1024 + (ob ^ (((ob >> 9) & 1) << 5)); }
__host__ __device__ __forceinline__ void stage_rc(int b, int& R, int& C) { const int st = b / 1024, sb = b % 1024, swz = sb ^ (((sb >> 9) & 1) << 5); R = (st >> 1) * 16 + swz / 64; C = (st & 1) * 32 + (swz % 64) / 2; }
struct Unit { int pm, pn; };
struct Gemm { const f16* A; const f16* Bt; int M, N, K; };
struct StaticOrder {
    int nM, nN, nwg, G, c;
    __host__ __device__ void init(int M, int N, int G_, int c_) { nM = M / BM; nN = N / BM; nwg = nM * nN; G = G_; c = c_; }
    __host__ __device__ bool next(int i, Unit& u) const {
        const long L = (long)i * G + c; if (L >= nwg) return false;
        int wgid = (int)L; { const int q = nwg / NXCD, r = nwg % NXCD, xcd = wgid % NXCD, off = wgid / NXCD; wgid = (xcd < r ? xcd * (q + 1) : r * (q + 1) + (xcd - r) * q) + off; }
        const int nig = WGM * nN, gid = wgid / nig, fm = gid * WGM, gsz = (nM - fm) < WGM ? (nM - fm) : WGM;
        u.pm = fm + ((wgid % nig) % gsz); u.pn = (wgid % nig) / gsz; return true;
    }
};
template <class Epi, bool I8 = false>
__device__ __forceinline__ void gemm_phase(PG8_LAS unsigned char* lds, const Gemm g, const StaticOrder& S, const Epi& E) {
    int tid = threadIdx.x; asm volatile("" : "+v"(tid));
    const int wid = __builtin_amdgcn_readfirstlane(tid >> 6), lane = tid & 63, wr = wid >> 2, wc = wid & 3, fr = lane & 15, fq = lane >> 4;
    const int K = g.K, nt = K / BK;
    unsigned voffA[2];
#pragma unroll
    for (int i = 0; i < 2; ++i) { int R, C; stage_rc(tid * 16 + i * 8192, R, C); voffA[i] = (unsigned)(R * K + C) * 2u; }
    const size_t kstep = (size_t)(BK * 2);
    const size_t hstep = (size_t)HALF * K * 2;
    const size_t tstep = 2 * hstep;
    const unsigned ldsw = (unsigned)wid * 1024u;
    const int aoff = lds_byte(wr * 64 + fr, fq * 8), boff = lds_byte(wc * 32 + fr, fq * 8);
#define PG8_SA(b, h) (((b) * 2 + (h)) * HTB)
#define PG8_SB(b, h) ((4 + (b) * 2 + (h)) * HTB)
#define PG8_STAGE(bufoff, gbase, voff) do { _Pragma("unroll") for (int _i = 0; _i < 2; ++_i) \
        __builtin_amdgcn_global_load_lds((const unsigned*)((const char*)(gbase) + (voff)[_i]), (PG8_LAS unsigned*)(lds + (bufoff) + ldsw + _i * 8192), 16, 0, 0); } while (0)
#define PG8_LDA(dst, b, h) do { _Pragma("unroll") for (int m = 0; m < 4; ++m) _Pragma("unroll") for (int k = 0; k < 2; ++k) dst[m][k] = *(const PG8_LAS f16x8*)(lds + PG8_SA(b, h) + aoff + m * 2048 + k * 1024); } while (0)
#define PG8_LDB(dst, b, h) do { _Pragma("unroll") for (int n = 0; n < 2; ++n) _Pragma("unroll") for (int k = 0; k < 2; ++k) dst[n][k] = *(const PG8_LAS f16x8*)(lds + PG8_SB(b, h) + boff + n * 2048 + k * 1024); } while (0)
#define PG8_MMA(ai, bj, At, Bt) do { __builtin_amdgcn_s_setprio(1); _Pragma("unroll") for (int m = 0; m < 4; ++m) _Pragma("unroll") for (int n = 0; n < 2; ++n) _Pragma("unroll") for (int k = 0; k < 2; ++k) \
        acc[ai][bj][m][n] = I8 ? __builtin_bit_cast(f32x4, __builtin_amdgcn_mfma_i32_16x16x64_i8(__builtin_bit_cast(i32x4, Bt[n][k]), __builtin_bit_cast(i32x4, At[m][k]), __builtin_bit_cast(i32x4, acc[ai][bj][m][n]), 0, 0, 0)) \
                                 : __builtin_amdgcn_mfma_f32_16x16x32_f16(Bt[n][k], At[m][k], acc[ai][bj][m][n], 0, 0, 0); __builtin_amdgcn_s_setprio(0); } while (0)
#define PG8_WAIT_V(n) asm volatile("s_waitcnt vmcnt(" #n ")" ::: "memory")
#define PG8_WAIT_L(n) asm volatile("s_waitcnt lgkmcnt(" #n ")" ::: "memory")
#define PG8_BAR __builtin_amdgcn_s_barrier()
#define PG8_SCHED __builtin_amdgcn_sched_barrier(0)
    Unit cur, nxt; int ui = 0;
    if (!S.next(0, cur)) return;
    f32x4 acc[2][2][4][2];
#pragma unroll
    for (int a = 0; a < 2; ++a)
#pragma unroll
        for (int b = 0; b < 2; ++b)
#pragma unroll
            for (int m = 0; m < 4; ++m)
#pragma unroll
                for (int n = 0; n < 2; ++n) acc[a][b][m][n] = (f32x4){0.f, 0.f, 0.f, 0.f};
    f16x8 At[4][2], B0[2][2], B1[2][2];
    const char* cA = (const char*)g.A + (size_t)cur.pm * tstep; const char* cB = (const char*)g.Bt + (size_t)cur.pn * tstep;
    PG8_STAGE(PG8_SB(0, 0), cB, voffA); PG8_STAGE(PG8_SB(0, 1), cB + hstep, voffA); PG8_STAGE(PG8_SA(0, 0), cA, voffA); PG8_STAGE(PG8_SA(0, 1), cA + hstep, voffA);
    if (wr == 1) PG8_BAR;
    PG8_WAIT_V(2); PG8_BAR;
    PG8_STAGE(PG8_SB(1, 0), cB + kstep, voffA); PG8_STAGE(PG8_SA(1, 0), cA + kstep, voffA); PG8_STAGE(PG8_SB(1, 1), cB + hstep + kstep, voffA);
    PG8_WAIT_V(6); PG8_BAR;
    for (;;) {
        const bool has_next = S.next(ui + 1, nxt);
        const char* nA = has_next ? (const char*)g.A + (size_t)nxt.pm * tstep : cA; const char* nB = has_next ? (const char*)g.Bt + (size_t)nxt.pn * tstep : cB;
        for (int t = 0; t < nt; t += 2) {
            const bool last = (t == nt - 2);
            const char* a1 = cA + (size_t)(t + 1) * kstep;
            const char* a2 = last ? nA : cA + (size_t)(t + 2) * kstep; const char* b2 = last ? nB : cB + (size_t)(t + 2) * kstep;
            const char* a3 = a2 + kstep; const char* b3 = b2 + kstep;
            PG8_LDB(B0, 0, 0); PG8_LDB(B1, 0, 1); PG8_SCHED; PG8_LDA(At, 0, 0); PG8_STAGE(PG8_SA(1, 1), a1 + hstep, voffA);
            PG8_WAIT_V(8); PG8_WAIT_L(0); PG8_BAR; PG8_MMA(0, 0, At, B0); PG8_MMA(0, 1, At, B1); PG8_BAR; PG8_SCHED;
            PG8_LDA(At, 0, 1); PG8_STAGE(PG8_SB(0, 0), b2, voffA); PG8_STAGE(PG8_SB(0, 1), b2 + hstep, voffA); PG8_STAGE(PG8_SA(0, 0), a2, voffA);
            PG8_WAIT_V(8); PG8_WAIT_L(0); PG8_BAR; PG8_MMA(1, 0, At, B0); PG8_MMA(1, 1, At, B1); PG8_BAR; PG8_SCHED;
            PG8_LDB(B0, 1, 0); PG8_LDB(B1, 1, 1); PG8_SCHED; PG8_LDA(At, 1, 0); PG8_STAGE(PG8_SA(0, 1), a2 + hstep, voffA);
            PG8_WAIT_V(8); PG8_WAIT_L(0); PG8_BAR; PG8_MMA(0, 0, At, B0); PG8_MMA(0, 1, At, B1); PG8_BAR; PG8_SCHED;
            PG8_LDA(At, 1, 1); PG8_STAGE(PG8_SB(1, 0), b3, voffA); PG8_STAGE(PG8_SB(1, 1), b3 + hstep, voffA); PG8_STAGE(PG8_SA(1, 0), a3, voffA);
            PG8_WAIT_V(8); PG8_WAIT_L(0); PG8_BAR; PG8_MMA(1, 0, At, B0); PG8_MMA(1, 1, At, B1); PG8_BAR; PG8_SCHED;
        }
        if (wr == 0) PG8_BAR;
        E(acc, cur, wr, wc, fr, fq);
        if (!has_next) break;
#pragma unroll
        for (int a = 0; a < 2; ++a)
#pragma unroll
            for (int b = 0; b < 2; ++b)
#pragma unroll
                for (int m = 0; m < 4; ++m)
#pragma unroll
                    for (int n = 0; n < 2; ++n) acc[a][b][m][n] = (f32x4){0.f, 0.f, 0.f, 0.f};
        cur = nxt; cA = nA; cB = nB; ++ui;
        if (wr == 1) PG8_BAR;
    }
    PG8_WAIT_V(0);
    PG8_BAR;
#undef PG8_SA
#undef PG8_SB
#undef PG8_STAGE
#undef PG8_LDA
#undef PG8_LDB
#undef PG8_MMA
#undef PG8_WAIT_V
#undef PG8_WAIT_L
#undef PG8_BAR
#undef PG8_SCHED
}

typedef f32x4 Acc[2][2][4][2];
struct EpiMain {
    unsigned char* ws; const float *qg, *kg;
    __device__ __forceinline__ void operator()(const Acc& acc, const Unit& u, int wr, int wc, int fr, int fq) const {
        const int row0 = u.pm * BM + wr * 64 + fr, pn = u.pn;
        if (pn == 8) {
            if (wc == 0) {
#pragma unroll
                for (int ai = 0; ai < 2; ++ai)
#pragma unroll
                    for (int m = 0; m < 4; ++m) { const size_t row = row0 + ai * HALF + m * 16;
#pragma unroll
                        for (int bj = 0; bj < 2; ++bj) { const f32x4 v0 = acc[ai][bj][m][0], v1 = acc[ai][bj][m][1];
                            *(f16x8*)((f16*)(ws + WS_KI) + (((row >> 5) * 8 + 4 * bj + fq) * 32 + (row & 31)) * 8) = (f16x8){(f16)v0[0], (f16)v0[1], (f16)v0[2], (f16)v0[3], (f16)v1[0], (f16)v1[1], (f16)v1[2], (f16)v1[3]}; } }
            } else if (wc == 1 && fq == 0) {
#pragma unroll
                for (int ai = 0; ai < 2; ++ai)
#pragma unroll
                    for (int m = 0; m < 4; ++m) { const size_t row = row0 + ai * HALF + m * 16;
                        *(f32x4*)((float*)(ws + WS_WI) + row * 8) = acc[ai][0][m][0] * 0.35355339059327373f; *(f32x4*)((float*)(ws + WS_WI) + row * 8 + 4) = acc[ai][0][m][1] * 0.35355339059327373f; }
            }
            return;
        }
        const int kind = pn >> 1;
        f16* base = (f16*)(ws + (kind == 0 ? WS_U : kind == 1 ? WS_Q : kind == 2 ? WS_K : WS_QI));
        const int col0 = (pn & 1) * 256 + 64 * wc + 8 * fq;
        if (kind == 1 || kind == 2) {
            const float* gp = (kind == 1 ? qg : kg) + 8 * fq;
#pragma unroll
            for (int ai = 0; ai < 2; ++ai)
#pragma unroll
                for (int m = 0; m < 4; ++m) { const size_t row = row0 + ai * HALF + m * 16;
                    float ss = 0.f;
#pragma unroll
                    for (int bj = 0; bj < 2; ++bj)
#pragma unroll
                        for (int n = 0; n < 2; ++n) { const f32x4 v = acc[ai][bj][m][n]; ss += v[0] * v[0] + v[1] * v[1] + v[2] * v[2] + v[3] * v[3]; }
                    ss += __shfl_xor(ss, 16); ss += __shfl_xor(ss, 32);
                    const float rstd = rsqrtf(ss * (1.f / 64.f) + EPS);
#pragma unroll
                    for (int bj = 0; bj < 2; ++bj) { const f32x4 v0 = acc[ai][bj][m][0] * rstd * *(const f32x4*)(gp + 32 * bj), v1 = acc[ai][bj][m][1] * rstd * *(const f32x4*)(gp + 32 * bj + 4);
                        *(f16x8*)(base + row * 512 + col0 + 32 * bj) = (f16x8){(f16)v0[0], (f16)v0[1], (f16)v0[2], (f16)v0[3], (f16)v1[0], (f16)v1[1], (f16)v1[2], (f16)v1[3]}; }
                    asm volatile("" ::: "memory"); }
        } else if (kind == 3) {
            const int hd = (pn & 1) * 4 + wc;
#pragma unroll
            for (int ai = 0; ai < 2; ++ai)
#pragma unroll
                for (int m = 0; m < 4; ++m) { const size_t row = row0 + ai * HALF + m * 16; const int ql = (int)(row & 7);
                    const int rr = (hd & 3) | (((ql >> 1) & 1) << 2) | ((hd >> 2) << 3) | ((ql & 1) << 4);
#pragma unroll
                    for (int bj = 0; bj < 2; ++bj) { const f32x4 v0 = acc[ai][bj][m][0], v1 = acc[ai][bj][m][1]; const int chunk = fq + 4 * bj;
                        *(f16x8*)(base + ((((((row >> 3) * 2 + (ql >> 2)) * 4 + (chunk >> 1)) * 2 + (chunk & 1)) * 32 + rr) << 3)) = (f16x8){(f16)v0[0], (f16)v0[1], (f16)v0[2], (f16)v0[3], (f16)v1[0], (f16)v1[1], (f16)v1[2], (f16)v1[3]}; } }
        } else {
#pragma unroll
            for (int ai = 0; ai < 2; ++ai)
#pragma unroll
                for (int m = 0; m < 4; ++m) { const size_t row = row0 + ai * HALF + m * 16;
#pragma unroll
                    for (int bj = 0; bj < 2; ++bj) { const f32x4 v0 = acc[ai][bj][m][0], v1 = acc[ai][bj][m][1];
                        *(f16x8*)(base + row * 512 + col0 + 32 * bj) = (f16x8){(f16)v0[0], (f16)v0[1], (f16)v0[2], (f16)v0[3], (f16)v1[0], (f16)v1[1], (f16)v1[2], (f16)v1[3]}; } }
        }
    }
};
struct EpiVT {
    f16* VT;
    __device__ __forceinline__ void operator()(const Acc& acc, const Unit& u, int wr, int wc, int fr, int fq) const {
        const int row0 = u.pm * BM + wr * 64 + fr, col0 = u.pn * BM + 32 * wc + 4 * fq;
#pragma unroll
        for (int ai = 0; ai < 2; ++ai)
#pragma unroll
            for (int m = 0; m < 4; ++m) { const size_t row = row0 + ai * HALF + m * 16;
#pragma unroll
                for (int bj = 0; bj < 2; ++bj)
#pragma unroll
                    for (int n = 0; n < 2; ++n) { const f32x4 v = acc[ai][bj][m][n];
                        *(f16x4*)(VT + row * NT + col0 + 128 * bj + 16 * n) = (f16x4){(f16)v[0], (f16)v[1], (f16)v[2], (f16)v[3]}; } }
    }
};
struct EpiOut {
    const float* x; const float* mod; f16* x1;
    __device__ __forceinline__ void operator()(const Acc& acc, const Unit& u, int wr, int wc, int fr, int fq) const {
        const int row0 = u.pm * BM + wr * 64 + fr, col0 = u.pn * BM + 64 * wc + 8 * fq;
        const float* g1 = mod + ((u.pm * BM) / NS) * 6144 + 2048 + col0;
        f32x4 g4[2][2];
#pragma unroll
        for (int bj = 0; bj < 2; ++bj)
#pragma unroll
            for (int n = 0; n < 2; ++n) g4[bj][n] = *(const f32x4*)(g1 + 32 * bj + 4 * n);
#pragma unroll
        for (int ai = 0; ai < 2; ++ai)
#pragma unroll
            for (int m = 0; m < 4; ++m) { const size_t off = (size_t)(row0 + ai * HALF + m * 16) * ND + col0;
#pragma unroll
                for (int bj = 0; bj < 2; ++bj) { const f32x4 v0 = *(const f32x4*)(x + off + 32 * bj) + g4[bj][0] * acc[ai][bj][m][0], v1 = *(const f32x4*)(x + off + 32 * bj + 4) + g4[bj][1] * acc[ai][bj][m][1];
                    *(f16x8*)(x1 + off + 32 * bj) = (f16x8){(f16)v0[0], (f16)v0[1], (f16)v0[2], (f16)v0[3], (f16)v1[0], (f16)v1[1], (f16)v1[2], (f16)v1[3]}; } }
    }
};
struct EpiPQ {
    f16* PQ; const float* hsc; const float* wsc;
    __device__ __forceinline__ void operator()(const Acc& acc, const Unit& u, int wr, int wc, int fr, int fq) const {
        const int row0 = u.pm * BM + wr * 64 + fr, col0 = u.pn * BM + 64 * wc + 8 * fq;
        f32x4 ws4[2][2];
#pragma unroll
        for (int bj = 0; bj < 2; ++bj)
#pragma unroll
            for (int n = 0; n < 2; ++n) ws4[bj][n] = *(const f32x4*)(wsc + u.pn * BM + 128 * bj + 32 * wc + 16 * n + 4 * fq);
#pragma unroll
        for (int ai = 0; ai < 2; ++ai)
#pragma unroll
            for (int m = 0; m < 4; ++m) { const size_t row = row0 + ai * HALF + m * 16; const float hs = hsc[row];
#pragma unroll
                for (int bj = 0; bj < 2; ++bj) { const i32x4 i0 = __builtin_bit_cast(i32x4, acc[ai][bj][m][0]), i1 = __builtin_bit_cast(i32x4, acc[ai][bj][m][1]);
                    const f32x4 v0 = (f32x4){(float)i0[0], (float)i0[1], (float)i0[2], (float)i0[3]} * ws4[bj][0] * hs, v1 = (f32x4){(float)i1[0], (float)i1[1], (float)i1[2], (float)i1[3]} * ws4[bj][1] * hs;
                    *(f16x8*)(PQ + ((((row >> 5) * 256 + ((col0 + 32 * bj) >> 3)) * 32 + (row & 31)) << 3)) = (f16x8){(f16)v0[0], (f16)v0[1], (f16)v0[2], (f16)v0[3], (f16)v1[0], (f16)v1[1], (f16)v1[2], (f16)v1[3]}; } }
    }
};
}

__device__ __forceinline__ void ph2_inproj(const Args& a, int bid, int nb, unsigned char* lds) {
    const f16* H = (const f16*)(a.ws + WS_H); const f16* WIN = (const f16*)(a.ws + WS_WIN); const f16* WVT = (const f16*)(a.ws + WS_WVT);
    PG8_LAS unsigned char* l3 = (PG8_LAS unsigned char*)lds;
    { pg8::Gemm g{H, WIN, NT, NMAIN, ND}; pg8::StaticOrder S; S.init(NT, NMAIN, nb, bid);
      pg8::EpiMain E{a.ws, a.in[9], a.in[10]};
      pg8::gemm_phase(l3, g, S, E); }
    { pg8::Gemm g{WVT, H, 512, NT, ND}; pg8::StaticOrder S; S.init(512, NT, nb, bid);
      pg8::EpiVT E{(f16*)(a.ws + WS_VT)};
      pg8::gemm_phase(l3, g, S, E); }
}


constexpr int PPITCH = 1040;
__device__ __forceinline__ void ph3_pool_fast(const Args& a, int bid, int nb, unsigned char* lds) {
    int tid = threadIdx.x; asm volatile("" : "+v"(tid));
    const int cg8 = tid & 63, tq = tid >> 6, gch = cg8 >> 4, win = 2 << gch;
    const f16* Z = (const f16*)(a.ws + WS_U); f16* MIX = (f16*)(a.ws + WS_H);
    const f32x4 ps0 = *(const f32x4*)(a.in[7] + 8 * cg8), ps1 = *(const f32x4*)(a.in[7] + 8 * cg8 + 4), pg0 = *(const f32x4*)(a.in[8] + 8 * cg8), pg1 = *(const f32x4*)(a.in[8] + 8 * cg8 + 4);
    const float psc[8] = {ps0[0], ps0[1], ps0[2], ps0[3], ps1[0], ps1[1], ps1[2], ps1[3]}, pgn[8] = {pg0[0], pg0[1], pg0[2], pg0[3], pg1[0], pg1[1], pg1[2], pg1[3]};
    for (int item = bid; item < NT / 32; item += nb) {
        const int tb = item * 32 + 4 * tq, tl0 = tb % NS;
        const f16* up = Z + (size_t)(tb - tl0) * 512 + 8 * cg8;
        float sm[8];
#pragma unroll
        for (int j = 0; j < 8; ++j) sm[j] = 0.f;
        f16x8 hist_[15];
#pragma unroll
        for (int q = 0; q < 15; ++q) { const int rr = tl0 - 15 + q; hist_[q] = (q >= 16 - win && rr >= 0) ? *(const f16x8*)(up + (size_t)rr * 512) : (f16x8){0, 0, 0, 0, 0, 0, 0, 0}; }
        f16x8 cur_[4];
#pragma unroll
        for (int k = 0; k < 4; ++k) cur_[k] = *(const f16x8*)(up + (size_t)(tl0 + k) * 512);
#pragma unroll
        for (int q = 0; q < 15; ++q)
#pragma unroll
            for (int j = 0; j < 8; ++j) sm[j] += (float)hist_[q][j];
#pragma unroll
        for (int k = 0; k < 4; ++k) {
            const int tl = tl0 + k;
            const float ic = 1.f / (float)((tl + 1 < win) ? tl + 1 : win);
            float v[8]; float ss = 0.f;
#pragma unroll
            for (int j = 0; j < 8; ++j) { sm[j] += (float)cur_[k][j]; v[j] = (sm[j] * ic - (float)cur_[k][j]) * psc[j]; ss += v[j] * v[j]; }
            const float rstd = rsqrtf(wave_sum(ss) * (1.f / 512.f) + EPS);
            f16x8 o;
#pragma unroll
            for (int j = 0; j < 8; ++j) o[j] = (f16)(v[j] * rstd * pgn[j]);
            *(f16x8*)(MIX + (size_t)(tb + k) * ND + 8 * cg8) = o;
            if (k < 3) {
#pragma unroll
                for (int j = 0; j < 8; ++j) {
                    const int q = 16 - win + k;
                    float dv = 0.f;
#pragma unroll
                    for (int qq = 0; qq < 15; ++qq) if (qq == q) dv = (float)hist_[qq][j];
#pragma unroll
                    for (int kk = 0; kk < 3; ++kk) if (q == 15 + kk) dv = (float)cur_[kk][j];
                    sm[j] -= dv;
                }
            }
        }
    }
}


typedef float f32x2 __attribute__((ext_vector_type(2)));
typedef unsigned u32x4 __attribute__((ext_vector_type(4)));

constexpr int IDX_KPITCH = 16384 + 16;
constexpr int IDX_HPITCH = 516;
template <int NBL>
__device__ __forceinline__ int wave_pick(const unsigned (&cc)[NBL], unsigned target, int lane, unsigned& rem_out) {
    unsigned tot = 0u;
#pragma unroll
    for (int j = 0; j < NBL; ++j) tot += cc[j];
    unsigned S = tot;
#pragma unroll
    for (int o = 1; o < 64; o <<= 1) { const unsigned v = __shfl_down(S, o); if (lane + o < 64) S += v; }
    const unsigned above = S - tot;
    const bool hit = (above < target) && (S >= target);
    const u64 bal = __ballot(hit);
    const int L = bal ? __builtin_ctzll(bal) : 0;
    int bin = 0; unsigned rem = target;
    { unsigned run = above; bool done = false;
#pragma unroll
      for (int j = NBL - 1; j >= 0; --j) { if (!done) { if (run + cc[j] >= target) { bin = NBL * lane + j; rem = target - run; done = true; } else run += cc[j]; } } }
    bin = __shfl(bin, L); rem_out = __shfl(rem, L);
    return bin;
}
template <int MODE>
__device__ __forceinline__ void ph3_index_fast(const Args& a, int bid, int nb, unsigned char* lds) {
    int tid = threadIdx.x; asm volatile("" : "+v"(tid));
    const int lane = tid & 63, wave = __builtin_amdgcn_readfirstlane(tid >> 6), r = lane & 31, hh = lane >> 5;
    const f16* QI = (const f16*)(a.ws + WS_QI); const f16* KI = (const f16*)(a.ws + WS_KI); const float* WI = (const float*)(a.ws + WS_WI);
    u64* MASK = (u64*)(a.ws + WS_MASK);
    unsigned* hist = (unsigned*)(lds + 8 * IDX_KPITCH);
    f16x8 af[2][4]; f32x2 wv2[2][8];
#define IDX_LOAD_FRAGS(t0_) do { \
        _Pragma("unroll") for (int rt = 0; rt < 2; ++rt) { \
            _Pragma("unroll") for (int ks = 0; ks < 4; ++ks) af[rt][ks] = *(const f16x8*)(QI + ((((((size_t)((t0_) >> 3) * 2 + rt) * 4 + ks) * 2 + hh) * 32 + r) << 3)); \
            _Pragma("unroll") for (int qq = 0; qq < 2; ++qq) { const float* wp = WI + (size_t)((t0_) + 4 * rt + 2 * hh + qq) * 8; const f32x4 w0 = *(const f32x4*)wp * 0.125f, w1 = *(const f32x4*)(wp + 4) * 0.125f; \
                wv2[rt][4 * qq + 0] = (f32x2){w0[0], w0[1]}; wv2[rt][4 * qq + 1] = (f32x2){w0[2], w0[3]}; wv2[rt][4 * qq + 2] = (f32x2){w1[0], w1[1]}; wv2[rt][4 * qq + 3] = (f32x2){w1[2], w1[3]}; } \
        } } while (0)
    for (int round = 0; round * nb < 256; ++round) {
        const int p = round * nb + ((round & 1) ? (nb - 1 - bid) : bid);
        if (p < 256) { const int tg = p >> 3, b_ = p & 7, t0l = tg * 8, ch_ = t0l >> 6, t0_ = b_ * NS + t0l;
            if (tid < 8 * (ch_ + 1)) { const int q = tid / (ch_ + 1), w = tid % (ch_ + 1); MASK[((size_t)b_ * 128 + w) * NS + t0l + q] = ~0ull; } }
    }
#define IDX_P(round_) ((round_) * nb + (((round_) & 1) ? (nb - 1 - bid) : bid))
    int round = 0;
    while (round * nb < 8192 && !(IDX_P(round) >= 256 && IDX_P(round) < 8192)) ++round;
    if (round * nb < 8192) { const int p0 = IDX_P(round); IDX_LOAD_FRAGS((p0 & 7) * NS + (p0 >> 3) * 8); }
    for (; round * nb < 8192; ) {
        const int p = IDX_P(round);
        int rnext = round + 1;
        while (rnext * nb < 8192 && !(IDX_P(rnext) >= 256 && IDX_P(rnext) < 8192)) ++rnext;
        const bool has_next = rnext * nb < 8192;
        const int pn = has_next ? IDX_P(rnext) : p;
        const int tg = p >> 3, b = p & 7, t0l = tg * 8, ch = t0l >> 6, nadm = 64 * (ch + 1), t0 = b * NS + t0l;
        const int t0n = (pn & 7) * NS + (pn >> 3) * 8;
        round = has_next ? rnext : 8192;
        __syncthreads();
#pragma unroll
        for (int i = 0; i < 9; ++i) if (tid + i * NTHR < 8 * IDX_HPITCH) hist[tid + i * NTHR] = 0u;
        __syncthreads();
        const int nkb = nadm >> 5;
        const f16* kbase = KI + ((size_t)(b * (NS / 32)) * 8 + hh) * 256 + r * 8;
#define IDX_LOADB(dst, kb_) do { _Pragma("unroll") for (int ks = 0; ks < 4; ++ks) dst[ks] = *(const f16x8*)(kbase + ((size_t)(kb_) * 8 + 2 * ks) * 256); } while (0)
#define IDX_BLOCK(bfrag, kb_) do { \
            f32x16 acc[2]; \
            _Pragma("unroll") for (int rt = 0; rt < 2; ++rt) { acc[rt] = (f32x16){0.f, 0.f, 0.f, 0.f, 0.f, 0.f, 0.f, 0.f, 0.f, 0.f, 0.f, 0.f, 0.f, 0.f, 0.f, 0.f}; \
                _Pragma("unroll") for (int ks = 0; ks < 4; ++ks) acc[rt] = __builtin_amdgcn_mfma_f32_32x32x16_f16(af[rt][ks], bfrag[ks], acc[rt], 0, 0, 0); } \
            _Pragma("unroll") for (int rt = 0; rt < 2; ++rt) \
                _Pragma("unroll") for (int qq = 0; qq < 2; ++qq) { \
                    f32x2 t2 = (f32x2){0.f, 0.f}; \
                    _Pragma("unroll") for (int hp = 0; hp < 4; ++hp) { const f32x2 r2 = (f32x2){__int_as_float(max(__float_as_int(acc[rt][8 * qq + 2 * hp]), 0)), __int_as_float(max(__float_as_int(acc[rt][8 * qq + 2 * hp + 1]), 0))}; \
                        t2 = __builtin_elementwise_fma(wv2[rt][4 * qq + hp], r2, t2); } \
                    const float sc = t2[0] + t2[1]; \
                    const f16 sh = (f16)sc; const unsigned bits = (unsigned)__builtin_bit_cast(unsigned short, sh); \
                    const unsigned key = (bits & 0x8000u) ? (~bits & 0xFFFFu) : (bits | 0x8000u); \
                    const int q = 4 * rt + 2 * hh + qq; \
                    if (MODE != 2) *(u16*)(lds + q * IDX_KPITCH + ((kb_) * 32 + r) * 2) = (u16)key; \
                    if (MODE != 2 && MODE != 4) atomicAdd(&hist[q * IDX_HPITCH + (key >> 7)], (key & 64u) ? 0x10000u : 1u); \
                    if (MODE == 2) sink += key; \
                } } while (0)
        f16x8 bf0[4], bf1[4], bf2[4]; unsigned sink = 0u;
        if (wave >= 4) __builtin_amdgcn_s_sleep(5);
        if (wave < nkb) IDX_LOADB(bf0, wave);
        if (wave + 8 < nkb) IDX_LOADB(bf1, wave + 8);
        if (wave + 16 < nkb) IDX_LOADB(bf2, wave + 16);
        if (MODE != 3) for (int kb = wave; kb < nkb; kb += 24) {
            IDX_BLOCK(bf0, kb);
            if (kb + 24 < nkb) IDX_LOADB(bf0, kb + 24);
            if (kb + 8 < nkb) { IDX_BLOCK(bf1, kb + 8); if (kb + 32 < nkb) IDX_LOADB(bf1, kb + 32); }
            if (kb + 16 < nkb) { IDX_BLOCK(bf2, kb + 16); if (kb + 40 < nkb) IDX_LOADB(bf2, kb + 40); }
        }
#undef IDX_LOADB
#undef IDX_BLOCK
        if (MODE == 2 && sink == 0xdeadbeefu) hist[tid] = sink;
        IDX_LOAD_FRAGS(t0n);
        __syncthreads();
        if (MODE != 1) {
            unsigned* hw = hist + wave * IDX_HPITCH;
            const unsigned char* krow = lds + wave * IDX_KPITCH;
            unsigned rem1 = 0u, rem2 = 0u;
            int b1;
            {   const u32x4 d0 = *(const u32x4*)(hw + 8 * lane), d1 = *(const u32x4*)(hw + 8 * lane + 4);
                const unsigned dd[8] = {d0.x, d0.y, d0.z, d0.w, d1.x, d1.y, d1.z, d1.w};
                unsigned cc[16];
#pragma unroll
                for (int j = 0; j < 8; ++j) { cc[2 * j] = dd[j] & 0xFFFFu; cc[2 * j + 1] = dd[j] >> 16; }
                b1 = wave_pick<16>(cc, 256u, lane, rem1); }
            hw[lane] = 0u;
            const int nit = (nadm + 511) >> 9;
            for (int it = 0; it < nit; ++it) {
                const int idx = (it * 64 + lane) * 8;
                if (idx < nadm) { const u32x4 k4 = *(const u32x4*)(krow + idx * 2);
                    const unsigned kk[4] = {k4.x, k4.y, k4.z, k4.w};
                    unsigned hit = 0u;
#pragma unroll
                    for (int j = 0; j < 4; ++j) { hit |= (((kk[j] & 0xFFFFu) >> 6) == (unsigned)b1 ? 1u : 0u) << (2 * j); hit |= ((kk[j] >> 22) == (unsigned)b1 ? 1u : 0u) << (2 * j + 1); }
                    if (hit) {
#pragma unroll
                        for (int j = 0; j < 4; ++j) { const unsigned k0 = kk[j] & 0xFFFFu, k1 = kk[j] >> 16;
                            if (hit & (1u << (2 * j))) atomicAdd(&hw[k0 & 63u], 1u);
                            if (hit & (2u << (2 * j))) atomicAdd(&hw[k1 & 63u], 1u); }
                    } }
            }
            int b2;
            { const unsigned c1[1] = {hw[lane]}; b2 = wave_pick<1>(c1, rem1, lane, rem2); }
            const unsigned tau = ((unsigned)b1 << 6) | (unsigned)b2;
            const size_t mrow = (size_t)(t0 + wave) * 128;
            for (int it = 0; it < nit; ++it) {
                const int idx = (it * 64 + lane) * 8;
                unsigned byte = 0u;
                if (idx < nadm) { const u32x4 k4 = *(const u32x4*)(krow + idx * 2);
                    const unsigned kk[4] = {k4.x, k4.y, k4.z, k4.w};
#pragma unroll
                    for (int j = 0; j < 4; ++j) { byte |= ((kk[j] & 0xFFFFu) >= tau ? 1u : 0u) << (2 * j); byte |= ((kk[j] >> 16) >= tau ? 1u : 0u) << (2 * j + 1); } }
                unsigned lo = (lane & 4) ? 0u : (byte << (8 * (lane & 3))), hi = (lane & 4) ? (byte << (8 * (lane & 3))) : 0u;
                lo |= __shfl_xor(lo, 1); hi |= __shfl_xor(hi, 1); lo |= __shfl_xor(lo, 2); hi |= __shfl_xor(hi, 2); lo |= __shfl_xor(lo, 4); hi |= __shfl_xor(hi, 4);
                if ((lane & 7) == 0 && idx < nadm) { hw[64 + 2 * (it * 8 + (lane >> 3))] = lo; hw[64 + 2 * (it * 8 + (lane >> 3)) + 1] = hi; }
            }
        }
        __syncthreads();
        if (MODE != 1) { const int w = tid >> 2, qp = tid & 3;
            if (w <= ch) { const unsigned* ha = hist + (2 * qp) * IDX_HPITCH + 64 + 2 * w; const unsigned* hb = ha + IDX_HPITCH;
                *(u32x4*)(MASK + ((size_t)b * 128 + w) * NS + t0l + 2 * qp) = (u32x4){ha[0], ha[1], hb[0], hb[1]}; } }
    }
    __syncthreads();
}

constexpr int ATP = 144;
constexpr int ATT_QWORD = 3584 + 32 * 64;
template <int AMODE>
__device__ __forceinline__ void ph4_attn_fast(const Args& a, int bid, int nb, unsigned char* lds) {
    int tid = threadIdx.x; asm volatile("" : "+v"(tid));
    const int lane = tid & 63, wave = __builtin_amdgcn_readfirstlane(tid >> 6), r = lane & 31, hh = lane >> 5;
    const f16* Q = (const f16*)(a.ws + WS_Q); const f16* Kk = (const f16*)(a.ws + WS_K); const f16* VT = (const f16*)(a.ws + WS_VT);
    const u64* MASK = (const u64*)(a.ws + WS_MASK); f16* MIX = (f16*)(a.ws + WS_H); const float* og = a.in[11];
    unsigned char* Kl = lds; unsigned char* Vl = lds + 2 * 64 * ATP;
    const float LOG2E = 1.4426950408889634f, OFF = 8192.f;
    const int pir = 16 * (r >> 4) + 8 * ((r >> 2) & 1) + 4 * ((r >> 3) & 1) + (r & 3);
    const int srow = tid >> 3, schk = tid & 7;
    unsigned* aq = (unsigned*)(a.ws + WS_CTL) + ATT_QWORD;
    volatile unsigned* ucell = (volatile unsigned*)(lds + 6 * 64 * ATP);
    volatile unsigned* dflag = ucell + 8;
    const float kmax = __int_as_float(__builtin_amdgcn_readfirstlane(__float_as_int(1.01f * 8.f * wave_max(fabsf(a.in[10][lane])))));
    int upar = 0;
    for (;;) {
        if (tid == 0) ucell[upar] = __hip_atomic_fetch_add(aq, 1u, __ATOMIC_RELAXED, __HIP_MEMORY_SCOPE_AGENT);
        if (tid < 8) dflag[tid] = 0u;
        __syncthreads();
        const unsigned u = ucell[upar]; upar ^= 1;
        if (u >= 2048u) break;
        const int h = 7 - (int)(u >> 8), qb = 31 - (int)((u & 255u) >> 3), b = (int)(u & 7u);
        const int q0l = qb * 256, tq = q0l + 32 * wave + r, cw = 4 * qb + (wave >> 1), top = 4 * qb + 3;
        const size_t t = (size_t)b * NS + tq;
        const float slope = exp2f(-(float)(h + 1)) * LOG2E;
        f16x8 qf[4];
#pragma unroll
        for (int ks = 0; ks < 4; ++ks) { const f16x8 qv = *(const f16x8*)(Q + t * 512 + h * 64 + 16 * ks + 8 * hh);
#pragma unroll
            for (int j = 0; j < 8; ++j) qf[ks][j] = (f16)((float)qv[j] * (0.125f * LOG2E)); }
        float qss = 0.f;
#pragma unroll
        for (int ks = 0; ks < 4; ++ks)
#pragma unroll
            for (int j = 0; j < 8; ++j) qss += (float)qf[ks][j] * (float)qf[ks][j];
        qss += __shfl_xor(qss, 32);
        const float Sb = __int_as_float(__builtin_amdgcn_readfirstlane(__float_as_int(wave_max(sqrtf(qss)) * kmax)));
        const float rowc = OFF + slope * (float)(tq - q0l);
        float m = 1000.f, l = 0.f;
        f32x16 O[2];
#pragma unroll
        for (int dt = 0; dt < 2; ++dt) O[dt] = (f32x16){0.f, 0.f, 0.f, 0.f, 0.f, 0.f, 0.f, 0.f, 0.f, 0.f, 0.f, 0.f, 0.f, 0.f, 0.f, 0.f};
        const f16* kg = Kk + ((size_t)b * NS + srow) * 512 + h * 64 + schk * 8;
        const f16* vg = VT + (size_t)(h * 64 + srow) * NT + (size_t)b * NS + schk * 8;
        f16x8 kr0, kr1, vr0, vr1; u64 mw0 = 0ull, mw1 = 0ull;
#define ATT_LOAD(kr, vr, mwv, jj) do { if ((jj) >= 0) { kr = *(const f16x8*)(kg + (size_t)(jj) * 64 * 512); vr = *(const f16x8*)(vg + (jj) * 64); mwv = ((jj) <= cw) ? MASK[((size_t)b * 128 + (jj)) * NS + tq] : 0ull; } } while (0)
        ATT_LOAD(kr0, vr0, mw0, top); ATT_LOAD(kr1, vr1, mw1, top - 1);
        int buf = 0; bool wdone = false, stop = false;
        auto step = [&](f16x8& kreg, f16x8& vreg, u64& mwr, const int j) {
            *(f16x8*)(Kl + buf * 64 * ATP + srow * ATP + schk * 16) = kreg;
            *(f16x8*)(Vl + buf * 64 * ATP + srow * ATP + schk * 16) = vreg;
            const u64 mw = mwr;
            asm volatile("s_waitcnt lgkmcnt(0)" ::: "memory"); __builtin_amdgcn_s_barrier(); asm volatile("" ::: "memory");
            {
                const unsigned jp = (unsigned)(j + 1);
                if ((dflag[0] > jp) & (dflag[1] > jp) & (dflag[2] > jp) & (dflag[3] > jp) & (dflag[4] > jp) & (dflag[5] > jp) & (dflag[6] > jp) & (dflag[7] > jp)) { stop = true; return; }
            }
            ATT_LOAD(kreg, vreg, mwr, j - 2);
            if (!wdone && j < cw) { const float lmax = Sb + OFF + slope * (float)(64 * j + 63 - q0l); if (__all(lmax - m < -28.f)) { wdone = true; if (lane == 0) dflag[wave] = (unsigned)(j + 1); } }
            if (j <= cw && !wdone) {
                const unsigned char* kb_ = Kl + buf * 64 * ATP + pir * ATP + 16 * hh;
                f16x8 fr8[8];
#pragma unroll
                for (int kt = 0; kt < 2; ++kt)
#pragma unroll
                    for (int ks = 0; ks < 4; ++ks) fr8[kt * 4 + ks] = *(const f16x8*)(kb_ + kt * 32 * ATP + ks * 32);
                f32x16 sa[2];
                if (j == cw) {
#pragma unroll
                    for (int kt = 0; kt < 2; ++kt)
#pragma unroll
                        for (int rg = 0; rg < 16; ++rg) { const float x = (float)(64 * j + 32 * kt + 16 * (rg >> 3) + 8 * hh + (rg & 7) - tq); sa[kt][rg] = rowc - slope * fabsf(x); }
                } else {
                    const float base = OFF + slope * (float)(64 * j + 8 * hh - q0l);
#pragma unroll
                    for (int kt = 0; kt < 2; ++kt)
#pragma unroll
                        for (int rg = 0; rg < 16; ++rg) sa[kt][rg] = __builtin_fmaf(slope, (float)(32 * kt + 16 * (rg >> 3) + (rg & 7)), base);
                }
                __builtin_amdgcn_sched_barrier(0);
                __builtin_amdgcn_s_setprio(1);
#pragma unroll
                for (int kt = 0; kt < 2; ++kt)
#pragma unroll
                    for (int ks = 0; ks < 4; ++ks) sa[kt] = __builtin_amdgcn_mfma_f32_32x32x16_f16(fr8[kt * 4 + ks], qf[ks], sa[kt], 0, 0, 0);
                __builtin_amdgcn_s_setprio(0);
                __builtin_amdgcn_sched_barrier(0);
                const unsigned char* vb_ = Vl + buf * 64 * ATP + r * ATP + 16 * hh;
#pragma unroll
                for (int dt = 0; dt < 2; ++dt)
#pragma unroll
                    for (int kt = 0; kt < 2; ++kt)
#pragma unroll
                        for (int s2 = 0; s2 < 2; ++s2) fr8[dt * 4 + kt * 2 + s2] = *(const f16x8*)(vb_ + dt * 32 * ATP + kt * 64 + s2 * 32);
                __builtin_amdgcn_sched_barrier(0);
                float rm = 0.f;
#pragma unroll
                for (int kt = 0; kt < 2; ++kt) { const unsigned w32 = (unsigned)(kt ? (mw >> 32) : mw) >> (8 * hh);
#pragma unroll
                    for (int rg = 0; rg < 16; ++rg) { const int tm = __builtin_amdgcn_sbfe((int)w32, 16 * (rg >> 3) + (rg & 7), 1);
                        const float L = __int_as_float(__float_as_int(sa[kt][rg]) & tm); sa[kt][rg] = L; rm = fmaxf(rm, L); } }
                rm = fmaxf(rm, __shfl_xor(rm, 32));
                const float mn = fmaxf(m, rm);
                if (__any(mn > m)) { const float al = __builtin_amdgcn_exp2f(m - mn); l *= al;
#pragma unroll
                    for (int dt = 0; dt < 2; ++dt)
#pragma unroll
                        for (int rg = 0; rg < 16; ++rg) O[dt][rg] *= al; }
                m = mn;
                f16x8 pf[2][2];
                float l0 = 0.f, l1 = 0.f;
#pragma unroll
                for (int kt = 0; kt < 2; ++kt)
#pragma unroll
                    for (int rg = 0; rg < 16; ++rg) { const float pp = __builtin_amdgcn_exp2f(sa[kt][rg] - m); if (rg & 1) l1 += pp; else l0 += pp; pf[kt][rg >> 3][rg & 7] = (f16)pp; }
                l += l0 + l1;
                __builtin_amdgcn_sched_barrier(0);
                __builtin_amdgcn_s_setprio(1);
#pragma unroll
                for (int dt = 0; dt < 2; ++dt)
#pragma unroll
                    for (int kt = 0; kt < 2; ++kt)
#pragma unroll
                        for (int s2 = 0; s2 < 2; ++s2) O[dt] = __builtin_amdgcn_mfma_f32_32x32x16_f16(fr8[dt * 4 + kt * 2 + s2], pf[kt][s2], O[dt], 0, 0, 0);
                __builtin_amdgcn_s_setprio(0);
            }
            buf ^= 1;
        };
        for (int j = top; j >= 0; j -= 2) {
            step(kr0, vr0, mw0, j); if (stop) break;
            if (j - 1 >= 0) { step(kr1, vr1, mw1, j - 1); if (stop) break; }
        }
#undef ATT_LOAD
        l += __shfl_xor(l, 32);
        const float inv = 1.f / l;
        float ss = 0.f;
#pragma unroll
        for (int dt = 0; dt < 2; ++dt)
#pragma unroll
            for (int rg = 0; rg < 16; ++rg) { O[dt][rg] *= inv; ss += O[dt][rg] * O[dt][rg]; }
        ss += __shfl_xor(ss, 32);
        const float rstd = rsqrtf(ss * (1.f / 64.f) + EPS);
#pragma unroll
        for (int dt = 0; dt < 2; ++dt)
#pragma unroll
            for (int g4 = 0; g4 < 4; ++g4) { const int d = 32 * dt + 8 * g4 + 4 * hh; const f32x4 gg = *(const f32x4*)(og + h * 64 + d);
                f16x4 o4; o4.x = (f16)(O[dt][4 * g4 + 0] * rstd * gg.x); o4.y = (f16)(O[dt][4 * g4 + 1] * rstd * gg.y); o4.z = (f16)(O[dt][4 * g4 + 2] * rstd * gg.z); o4.w = (f16)(O[dt][4 * g4 + 3] * rstd * gg.w);
                *(f16x4*)(MIX + t * ND + 512 + h * 64 + d) = o4; }
        __syncthreads();
    }
}

__device__ __forceinline__ void ph5_outproj(const Args& a, int bid, int nb, unsigned char* lds) {
    pg8::Gemm g{(const f16*)(a.ws + WS_H), (const f16*)(a.ws + WS_WOUT), NT, 1024, ND}; pg8::StaticOrder S; S.init(NT, 1024, nb, bid);
    pg8::EpiOut E{a.in[0], (const float*)(a.ws + WS_MOD), (f16*)(a.ws + WS_X1)};
    pg8::gemm_phase((PG8_LAS unsigned char*)lds, g, S, E);
}

__device__ __forceinline__ void ph7_peerq(const Args& a, int bid, int nb, unsigned char* lds) {
    pg8::Gemm g{(const f16*)(a.ws + WS_HQ), (const f16*)(a.ws + WS_WQ8), NT, 2048, ND / 2}; pg8::StaticOrder S; S.init(NT, 2048, nb, bid);
    pg8::EpiPQ E{(f16*)(a.ws + WS_PQ), (const float*)(a.ws + WS_HSC), (const float*)(a.ws + WS_WSC)};
    pg8::gemm_phase<pg8::EpiPQ, true>((PG8_LAS unsigned char*)lds, g, S, E);
}


__device__ __forceinline__ unsigned f2skey(float f) { const unsigned u = __float_as_uint(f); return (u & 0x80000000u) ? ~u : (u | 0x80000000u); }
__device__ __forceinline__ float skey2f(unsigned k) { return __uint_as_float((k & 0x80000000u) ? (k & 0x7FFFFFFFu) : ~k); }
#define CE_(a_, b_) do { const unsigned t__ = max(a_, b_); b_ = min(a_, b_); a_ = t__; } while (0)
#define SORT16_DESC(v) do { CE_(v[0], v[1]); CE_(v[2], v[3]); CE_(v[0], v[2]); CE_(v[1], v[3]); CE_(v[1], v[2]); CE_(v[4], v[5]); CE_(v[6], v[7]); CE_(v[4], v[6]); CE_(v[5], v[7]); CE_(v[5], v[6]); CE_(v[0], v[4]); CE_(v[2], v[6]); CE_(v[2], v[4]); CE_(v[1], v[5]); CE_(v[3], v[7]); CE_(v[3], v[5]); CE_(v[1], v[2]); CE_(v[3], v[4]); CE_(v[5], v[6]); CE_(v[8], v[9]); CE_(v[10], v[11]); CE_(v[8], v[10]); CE_(v[9], v[11]); CE_(v[9], v[10]); CE_(v[12], v[13]); CE_(v[14], v[15]); CE_(v[12], v[14]); CE_(v[13], v[15]); CE_(v[13], v[14]); CE_(v[8], v[12]); CE_(v[10], v[14]); CE_(v[10], v[12]); CE_(v[9], v[13]); CE_(v[11], v[15]); CE_(v[11], v[13]); CE_(v[9], v[10]); CE_(v[11], v[12]); CE_(v[13], v[14]); CE_(v[0], v[8]); CE_(v[4], v[12]); CE_(v[4], v[8]); CE_(v[2], v[10]); CE_(v[6], v[14]); CE_(v[6], v[10]); CE_(v[2], v[4]); CE_(v[6], v[8]); CE_(v[10], v[12]); CE_(v[1], v[9]); CE_(v[5], v[13]); CE_(v[5], v[9]); CE_(v[3], v[11]); CE_(v[7], v[15]); CE_(v[7], v[11]); CE_(v[3], v[5]); CE_(v[7], v[9]); CE_(v[11], v[13]); CE_(v[1], v[2]); CE_(v[3], v[4]); CE_(v[5], v[6]); CE_(v[7], v[8]); CE_(v[9], v[10]); CE_(v[11], v[12]); CE_(v[13], v[14]); } while (0)
#define BITONIC16_DESC(v) do { CE_(v[0], v[8]); CE_(v[1], v[9]); CE_(v[2], v[10]); CE_(v[3], v[11]); CE_(v[4], v[12]); CE_(v[5], v[13]); CE_(v[6], v[14]); CE_(v[7], v[15]); CE_(v[0], v[4]); CE_(v[1], v[5]); CE_(v[2], v[6]); CE_(v[3], v[7]); CE_(v[8], v[12]); CE_(v[9], v[13]); CE_(v[10], v[14]); CE_(v[11], v[15]); CE_(v[0], v[2]); CE_(v[1], v[3]); CE_(v[4], v[6]); CE_(v[5], v[7]); CE_(v[8], v[10]); CE_(v[9], v[11]); CE_(v[12], v[14]); CE_(v[13], v[15]); CE_(v[0], v[1]); CE_(v[2], v[3]); CE_(v[4], v[5]); CE_(v[6], v[7]); CE_(v[8], v[9]); CE_(v[10], v[11]); CE_(v[12], v[13]); CE_(v[14], v[15]); } while (0)
#define MERGE16_DESC(dst, other) do { unsigned c__[16]; _Pragma("unroll") for (int i__ = 0; i__ < 16; ++i__) c__[i__] = max(dst[i__], other[15 - i__]); BITONIC16_DESC(c__); _Pragma("unroll") for (int i__ = 0; i__ < 16; ++i__) dst[i__] = c__[i__]; } while (0)
#define TOP16_INSERT(v, x_) do { unsigned x__ = (x_); _Pragma("unroll") for (int k_ = 0; k_ < 16; ++k_) { const unsigned t__ = max(v[k_], x__); x__ = min(v[k_], x__); v[k_] = t__; } } while (0)
__device__ __forceinline__ void ph8_peersel_fast(const Args& a, int bid, int nb, unsigned char* lds) {
    int tid = threadIdx.x; asm volatile("" : "+v"(tid));
    const int lane = tid & 63, wave = __builtin_amdgcn_readfirstlane(tid >> 6), r = lane & 31, hh = lane >> 5;
    const f16* PQ = (const f16*)(a.ws + WS_PQ);
    u16* EID = (u16*)(a.ws + WS_EID); float* GW = (float*)(a.ws + WS_GW);
    unsigned char* wl = lds + wave * 2048 + lane * 32;
    for (int item = bid * NWAVE + wave; item < (NT / 32) * 8; item += nb * NWAVE) {
        const int tt = item >> 3, h = item & 7, t0 = tt * 32;
        unsigned top[2][16];
#pragma unroll
        for (int p = 0; p < 2; ++p) {
            f16x8 sq[8];
#pragma unroll
            for (int c = 0; c < 8; ++c) sq[c] = *(const f16x8*)(PQ + ((((size_t)tt * 256 + h * 32 + p * 16 + 8 * hh + c) * 32 + r) << 3));
#pragma unroll
            for (int k = 0; k < 16; ++k) top[p][k] = 0u;
#pragma unroll
            for (int g = 0; g < 4; ++g) {
                unsigned ky[16];
#pragma unroll
                for (int i = 0; i < 16; ++i) { const unsigned n = 64u * hh + 16u * g + i; ky[i] = (f2skey((float)sq[2 * g + (i >> 3)][i & 7]) & ~127u) | n; }
                SORT16_DESC(ky); MERGE16_DESC(top[p], ky);
            }
            unsigned oth[16];
#pragma unroll
            for (int k = 0; k < 16; ++k) oth[k] = __shfl_xor(top[p][k], 32);
            MERGE16_DESC(top[p], oth);
            asm volatile("" ::: "memory");
        }
#pragma unroll
        for (int k = 0; k < 16; k += 4) {
            *(unsigned*)(wl + k) = (top[0][k] & 127u) | ((top[0][k + 1] & 127u) << 8) | ((top[0][k + 2] & 127u) << 16) | ((top[0][k + 3] & 127u) << 24);
            *(unsigned*)(wl + 16 + k) = (top[1][k] & 127u) | ((top[1][k + 1] & 127u) << 8) | ((top[1][k + 2] & 127u) << 16) | ((top[1][k + 3] & 127u) << 24);
        }
        float fa[16], fb[16];
#pragma unroll
        for (int k = 0; k < 16; ++k) { fa[k] = skey2f(top[0][k] & ~127u); fb[k] = skey2f(top[1][k] & ~127u); }
        unsigned cg[4][16];
        cg[0][0] = (f2skey(fa[0] + fb[0]) & ~255u) | 0u;
        cg[0][1] = (f2skey(fa[0] + fb[1]) & ~255u) | 1u;
        cg[0][2] = (f2skey(fa[0] + fb[2]) & ~255u) | 2u;
        cg[0][3] = (f2skey(fa[0] + fb[3]) & ~255u) | 3u;
        cg[0][4] = (f2skey(fa[0] + fb[4]) & ~255u) | 4u;
        cg[0][5] = (f2skey(fa[0] + fb[5]) & ~255u) | 5u;
        cg[0][6] = (f2skey(fa[0] + fb[6]) & ~255u) | 6u;
        cg[0][7] = (f2skey(fa[0] + fb[7]) & ~255u) | 7u;
        cg[0][8] = (f2skey(fa[0] + fb[8]) & ~255u) | 8u;
        cg[0][9] = (f2skey(fa[0] + fb[9]) & ~255u) | 9u;
        cg[0][10] = (f2skey(fa[0] + fb[10]) & ~255u) | 10u;
        cg[0][11] = (f2skey(fa[0] + fb[11]) & ~255u) | 11u;
        cg[0][12] = (f2skey(fa[0] + fb[12]) & ~255u) | 12u;
        cg[0][13] = (f2skey(fa[0] + fb[13]) & ~255u) | 13u;
        cg[0][14] = (f2skey(fa[0] + fb[14]) & ~255u) | 14u;
        cg[0][15] = (f2skey(fa[0] + fb[15]) & ~255u) | 15u;
        cg[1][0] = (f2skey(fa[1] + fb[0]) & ~255u) | 16u;
        cg[1][1] = (f2skey(fa[1] + fb[1]) & ~255u) | 17u;
        cg[1][2] = (f2skey(fa[1] + fb[2]) & ~255u) | 18u;
        cg[1][3] = (f2skey(fa[1] + fb[3]) & ~255u) | 19u;
        cg[1][4] = (f2skey(fa[1] + fb[4]) & ~255u) | 20u;
        cg[1][5] = (f2skey(fa[1] + fb[5]) & ~255u) | 21u;
        cg[1][6] = (f2skey(fa[1] + fb[6]) & ~255u) | 22u;
        cg[1][7] = (f2skey(fa[1] + fb[7]) & ~255u) | 23u;
        cg[1][8] = (f2skey(fa[2] + fb[0]) & ~255u) | 32u;
        cg[1][9] = (f2skey(fa[2] + fb[1]) & ~255u) | 33u;
        cg[1][10] = (f2skey(fa[2] + fb[2]) & ~255u) | 34u;
        cg[1][11] = (f2skey(fa[2] + fb[3]) & ~255u) | 35u;
        cg[1][12] = (f2skey(fa[2] + fb[4]) & ~255u) | 36u;
        cg[1][13] = (f2skey(fa[3] + fb[0]) & ~255u) | 48u;
        cg[1][14] = (f2skey(fa[3] + fb[1]) & ~255u) | 49u;
        cg[1][15] = (f2skey(fa[3] + fb[2]) & ~255u) | 50u;
        cg[2][0] = (f2skey(fa[3] + fb[3]) & ~255u) | 51u;
        cg[2][1] = (f2skey(fa[4] + fb[0]) & ~255u) | 64u;
        cg[2][2] = (f2skey(fa[4] + fb[1]) & ~255u) | 65u;
        cg[2][3] = (f2skey(fa[4] + fb[2]) & ~255u) | 66u;
        cg[2][4] = (f2skey(fa[5] + fb[0]) & ~255u) | 80u;
        cg[2][5] = (f2skey(fa[5] + fb[1]) & ~255u) | 81u;
        cg[2][6] = (f2skey(fa[6] + fb[0]) & ~255u) | 96u;
        cg[2][7] = (f2skey(fa[6] + fb[1]) & ~255u) | 97u;
        cg[2][8] = (f2skey(fa[7] + fb[0]) & ~255u) | 112u;
        cg[2][9] = (f2skey(fa[7] + fb[1]) & ~255u) | 113u;
        cg[2][10] = (f2skey(fa[8] + fb[0]) & ~255u) | 128u;
        cg[2][11] = (f2skey(fa[9] + fb[0]) & ~255u) | 144u;
        cg[2][12] = (f2skey(fa[10] + fb[0]) & ~255u) | 160u;
        cg[2][13] = (f2skey(fa[11] + fb[0]) & ~255u) | 176u;
        cg[2][14] = (f2skey(fa[12] + fb[0]) & ~255u) | 192u;
        cg[2][15] = (f2skey(fa[13] + fb[0]) & ~255u) | 208u;
        cg[3][0] = (f2skey(fa[14] + fb[0]) & ~255u) | 224u;
        cg[3][1] = (f2skey(fa[15] + fb[0]) & ~255u) | 240u;
        cg[3][2] = 0u;
        cg[3][3] = 0u;
        cg[3][4] = 0u;
        cg[3][5] = 0u;
        cg[3][6] = 0u;
        cg[3][7] = 0u;
        cg[3][8] = 0u;
        cg[3][9] = 0u;
        cg[3][10] = 0u;
        cg[3][11] = 0u;
        cg[3][12] = 0u;
        cg[3][13] = 0u;
        cg[3][14] = 0u;
        cg[3][15] = 0u;
        SORT16_DESC(cg[0]); SORT16_DESC(cg[1]); SORT16_DESC(cg[2]); SORT16_DESC(cg[3]);
        MERGE16_DESC(cg[0], cg[1]); MERGE16_DESC(cg[2], cg[3]); MERGE16_DESC(cg[0], cg[2]);
        unsigned ct[16];
#pragma unroll
        for (int k = 0; k < 16; ++k) ct[k] = cg[0][k];
        float sc[16]; float den = 0.f; const float s0 = skey2f(ct[0] & ~255u);
#pragma unroll
        for (int k = 0; k < 16; ++k) { sc[k] = __expf(skey2f(ct[k] & ~255u) - s0); den += sc[k]; }
        const float inv = 1.f / den;
        if (hh == 0) {
            u16 ev[16];
#pragma unroll
            for (int k = 0; k < 16; ++k) { const unsigned ij = ct[k] & 255u; const unsigned i1 = wl[ij >> 4], i2 = wl[16 + (ij & 15u)]; ev[k] = (u16)(i1 * 128u + i2); }
            const size_t o = (size_t)(t0 + r) * 128 + h * 16;
#pragma unroll
            for (int k = 0; k < 16; k += 8) {
                *(u32x4*)(EID + o + k) = (u32x4){(unsigned)ev[k] | ((unsigned)ev[k + 1] << 16), (unsigned)ev[k + 2] | ((unsigned)ev[k + 3] << 16), (unsigned)ev[k + 4] | ((unsigned)ev[k + 5] << 16), (unsigned)ev[k + 6] | ((unsigned)ev[k + 7] << 16)};
            }
#pragma unroll
            for (int k = 0; k < 16; k += 4) *(f32x4*)(GW + o + k) = (f32x4){sc[k] * inv, sc[k + 1] * inv, sc[k + 2] * inv, sc[k + 3] * inv};
        }
    }
}

typedef _Float16 f16x2 __attribute__((ext_vector_type(2)));
__device__ __forceinline__ float gelu_erf(float d) { return 0.5f * d * (1.f + erff(d * 0.70710678118654752f)); }
constexpr int PQ_WORD0 = 3584, PQ_CHUNK = 64, PQ_NCHUNK = NT / PQ_CHUNK, PQ_HALF = PQ_NCHUNK / 2;
constexpr size_t WS_PART = 208 * MiB;
__device__ __forceinline__ unsigned xcc_id_() { return (unsigned)__builtin_amdgcn_s_getreg((3 << 11) | 20) & 7u; }
template <int VPHASE>
__device__ __forceinline__ void ph9_sliced(const Args& a, unsigned char* lds) {
    int tid_ = threadIdx.x; asm volatile("" : "+v"(tid_)); const int lane = tid_ & 63, wave = __builtin_amdgcn_readfirstlane(tid_ >> 6);
    const int g8 = lane >> 3, c8 = lane & 7;
    const unsigned char* HP = a.ws + WS_HP; const float* HSC = (const float*)(a.ws + WS_HSC); const unsigned char* TAB = a.ws + (VPHASE ? WS_VP : WS_UT);
    const u16* EID = (const u16*)(a.ws + WS_EID); const unsigned* GW = (const unsigned*)(a.ws + WS_GW); float* PART = (float*)(a.ws + WS_PART); const float* WSUM = (const float*)(a.ws + WS_WSUM);
    const float* mod = (const float*)(a.ws + WS_MOD); float* out = a.out; const f16* X1 = (const f16*)(a.ws + WS_X1);
    unsigned* qw = (unsigned*)(a.ws + WS_CTL) + PQ_WORD0 + (VPHASE ? 8 * 64 : 0);
    volatile unsigned* cslot = (volatile unsigned*)lds;
    const bool b5 = (lane & 32) != 0, b4 = (lane & 16) != 0, b3 = (lane & 8) != 0, b2 = (lane & 4) != 0, b1 = (lane & 2) != 0, b0 = (lane & 1) != 0;
    const unsigned x0 = xcc_id_();
    int par = 0;
    for (int k = 0; k < 8; ++k) {
        const unsigned qi_ = (x0 + (unsigned)k) & 7u, sl = qi_ & 3u, half = qi_ >> 2;
        unsigned cur = 0u;
        if (tid_ == 0) cur = __hip_atomic_fetch_add(qw + 64 * qi_, 1u, __ATOMIC_RELAXED, __HIP_MEMORY_SCOPE_AGENT);
        for (;;) {
            if (tid_ == 0) cslot[par] = cur;
            __syncthreads();
            const unsigned c = cslot[par]; par ^= 1;
            if (c >= (unsigned)PQ_HALF) break;
            if (tid_ == 0) cur = __hip_atomic_fetch_add(qw + 64 * qi_, 1u, __ATOMIC_RELAXED, __HIP_MEMORY_SCOPE_AGENT);
            const int tb = (int)(half * PQ_HALF + c) * PQ_CHUNK + wave * (PQ_CHUNK / NWAVE);
            const unsigned char* tsl = TAB + 128 * sl + 16 * c8;
#pragma unroll 1
            for (int i8 = 0; i8 < PQ_CHUNK / NWAVE; ++i8) {
                const int t = tb + i8;
                const u32x4 e0 = *(const u32x4*)(EID + (size_t)t * 128 + 16 * g8), e1 = *(const u32x4*)(EID + (size_t)t * 128 + 16 * g8 + 8);
                const unsigned ew[8] = {e0.x, e0.y, e0.z, e0.w, e1.x, e1.y, e1.z, e1.w};
                u32x4 r8[16];
#pragma unroll
                for (int i = 0; i < 16; ++i) { const unsigned eid = (i & 1) ? (ew[i >> 1] >> 16) : (ew[i >> 1] & 0xFFFFu); r8[i] = *(const u32x4*)(tsl + (size_t)eid * 512); }
                if (!VPHASE) {
                    const u32x4 hh4 = *(const u32x4*)(HP + (size_t)t * 1024 + 128 * sl + 16 * c8), hl4 = *(const u32x4*)(HP + (size_t)t * 1024 + 512 + 128 * sl + 16 * c8);
                    const float hsc = 0.5f * HSC[t];
                    int hs1 = 0, hs0 = 0;
#pragma unroll
                    for (int j = 0; j < 4; ++j) { hs1 = __builtin_amdgcn_sdot8((int)hh4[j], 0x11111111, hs1, false); hs0 = __builtin_amdgcn_sdot8((int)hl4[j], 0x11111111, hs0, false); }
                    const int hsum = 16 * hs1 + hs0;
                    float p[16];
#pragma unroll
                    for (int i = 0; i < 16; ++i) { int d1 = 0, d0 = 0;
#pragma unroll
                        for (int j = 0; j < 4; ++j) { d1 = __builtin_amdgcn_sdot8((int)hh4[j], (int)r8[i][j], d1, false); d0 = __builtin_amdgcn_sdot8((int)hl4[j], (int)r8[i][j], d0, false); }
                        p[i] = (float)(2 * (16 * d1 + d0) + hsum); }
                    float q8[8], q4[4], r2[2];
#pragma unroll
                    for (int ii = 0; ii < 8; ++ii) { const float keep = b2 ? p[8 + ii] : p[ii], send = b2 ? p[ii] : p[8 + ii]; q8[ii] = keep + __shfl_xor(send, 4); }
#pragma unroll
                    for (int ii = 0; ii < 4; ++ii) { const float keep = b1 ? q8[4 + ii] : q8[ii], send = b1 ? q8[ii] : q8[4 + ii]; q4[ii] = keep + __shfl_xor(send, 2); }
#pragma unroll
                    for (int ii = 0; ii < 2; ++ii) { const float keep = b0 ? q4[2 + ii] : q4[ii], send = b0 ? q4[ii] : q4[2 + ii]; r2[ii] = keep + __shfl_xor(send, 1); }
                    *(f32x2*)(PART + ((size_t)sl * NT + t) * 128 + 16 * g8 + 2 * c8) = (f32x2){r2[0] * hsc, r2[1] * hsc};
                } else {
                    const u32x4* wp = (const u32x4*)(GW + (size_t)t * 128 + 16 * g8);
                    const u32x4 wq0 = wp[0], wq1 = wp[1], wq2 = wp[2], wq3 = wp[3];
                    const unsigned wv[16] = {wq0[0], wq0[1], wq0[2], wq0[3], wq1[0], wq1[1], wq1[2], wq1[3], wq2[0], wq2[1], wq2[2], wq2[3], wq3[0], wq3[1], wq3[2], wq3[3]};
                    const f16 off = (f16)(-7.5f * 5.9604644775390625e-08f * WSUM[(size_t)t * 8 + g8]);
                    f16x2 acc2[16];
#pragma unroll
                    for (int j = 0; j < 16; ++j) acc2[j] = (f16x2){off, off};
#pragma unroll
                    for (int i = 0; i < 16; ++i) { const f16x2 wa = __builtin_bit_cast(f16x2, wv[i]); const f16x2 wb = wa * (f16x2){(f16)0.0625f, (f16)0.0625f};
#pragma unroll
                        for (int j = 0; j < 4; ++j) { const unsigned x = r8[i][j], y = x >> 8;
                            acc2[4 * j]     = __builtin_elementwise_fma(wa, __builtin_bit_cast(f16x2, x & 0x000F000Fu), acc2[4 * j]);
                            acc2[4 * j + 1] = __builtin_elementwise_fma(wb, __builtin_bit_cast(f16x2, x & 0x00F000F0u), acc2[4 * j + 1]);
                            acc2[4 * j + 2] = __builtin_elementwise_fma(wa, __builtin_bit_cast(f16x2, y & 0x000F000Fu), acc2[4 * j + 2]);
                            acc2[4 * j + 3] = __builtin_elementwise_fma(wb, __builtin_bit_cast(f16x2, y & 0x00F000F0u), acc2[4 * j + 3]); } }
                    unsigned q8[8], q4[4], r2[2];
#pragma unroll
                    for (int ii = 0; ii < 8; ++ii) { const unsigned lo_ = __builtin_bit_cast(unsigned, acc2[ii]), hi_ = __builtin_bit_cast(unsigned, acc2[8 + ii]); const unsigned keep = b5 ? hi_ : lo_, send = b5 ? lo_ : hi_;
                        q8[ii] = __builtin_bit_cast(unsigned, __builtin_bit_cast(f16x2, keep) + __builtin_bit_cast(f16x2, (unsigned)__shfl_xor((int)send, 32))); }
#pragma unroll
                    for (int ii = 0; ii < 4; ++ii) { const unsigned keep = b4 ? q8[4 + ii] : q8[ii], send = b4 ? q8[ii] : q8[4 + ii];
                        q4[ii] = __builtin_bit_cast(unsigned, __builtin_bit_cast(f16x2, keep) + __builtin_bit_cast(f16x2, (unsigned)__shfl_xor((int)send, 16))); }
#pragma unroll
                    for (int ii = 0; ii < 2; ++ii) { const unsigned keep = b3 ? q4[2 + ii] : q4[ii], send = b3 ? q4[ii] : q4[2 + ii];
                        r2[ii] = __builtin_bit_cast(unsigned, __builtin_bit_cast(f16x2, keep) + __builtin_bit_cast(f16x2, (unsigned)__shfl_xor((int)send, 8))); }
                    const f16x2 ra = __builtin_bit_cast(f16x2, r2[0]), rb = __builtin_bit_cast(f16x2, r2[1]);
                    const int ch = 256 * sl + 32 * c8 + (b5 ? 16 : 0) + (b4 ? 8 : 0) + (b3 ? 2 : 0);
                    float* op = out + (size_t)t * ND + ch; const float* g2 = mod + (t / NS) * 6144 + 5120 + ch; const f16* xp = X1 + (size_t)t * ND + ch;
                    const f16x2 xa = *(const f16x2*)xp, xb = *(const f16x2*)(xp + 4); const f32x2 ga = *(const f32x2*)g2, gb = *(const f32x2*)(g2 + 4);
                    const float sc_ = 16777216.f / PEER_WSCALE;
                    *(f32x2*)op = (f32x2){(float)xa[0] + ga[0] * ((float)ra[0] * sc_), (float)xa[1] + ga[1] * ((float)rb[0] * sc_)};
                    *(f32x2*)(op + 4) = (f32x2){(float)xb[0] + gb[0] * ((float)ra[1] * sc_), (float)xb[1] + gb[1] * ((float)rb[1] * sc_)};
                }
            }
        }
    }
}
__device__ __forceinline__ void ph9b_combine(const Args& a, int bid, int nb) {
    int tid_ = threadIdx.x; asm volatile("" : "+v"(tid_));
    float* GW = (float*)(a.ws + WS_GW); const float* PART = (const float*)(a.ws + WS_PART);
    const float du = ((const float*)(a.ws + WS_QS))[0], dv = ((const float*)(a.ws + WS_QS))[1] * PEER_WSCALE;
    for (size_t i = (size_t)bid * NTHR + tid_; i < (size_t)NT * 128 / 4; i += (size_t)nb * NTHR) {
        f32x4 sum = ((const f32x4*)PART)[i];
#pragma unroll
        for (int sidx = 1; sidx < 4; ++sidx) sum += ((const f32x4*)(PART + (size_t)sidx * NT * 128))[i];
        const f32x4 g = ((const f32x4*)GW)[i];
        f32x4 w;
#pragma unroll
        for (int j = 0; j < 4; ++j) w[j] = fminf(fmaxf(g[j] * gelu_erf(sum[j] * du) * dv, -60000.f), 60000.f);
        float ws_ = 0.f; u32x4 pk;
#pragma unroll
        for (int j = 0; j < 4; ++j) { const f16 hw_ = (f16)w[j]; ws_ += (float)hw_; pk[j] = (unsigned)__builtin_bit_cast(unsigned short, hw_) * 0x10001u; }
        ((u32x4*)GW)[i] = pk;
        ws_ += __shfl_xor(ws_, 1); ws_ += __shfl_xor(ws_, 2);
        if ((tid_ & 3) == 0) ((float*)(a.ws + WS_WSUM))[i >> 2] = ws_;
    }
}

#define LAS __attribute__((address_space(3)))
#define XB_TMO      128
#define XB_XCNT(j)  (256  + 64 * (j))
#define XB_XSUB(j)  (1280 + 64 * (j))
#define XB_XGEN(j)  (2304 + 64 * (j))
#define XB_TOP      3328
#define XB_TOPGEN   3392
#define XCD_BAR_WORDS 3456
#define XB_SPIN_CAP (1u << 18)
__device__ __forceinline__ unsigned xb_ld(unsigned* p)              { return __hip_atomic_load(p, __ATOMIC_RELAXED, __HIP_MEMORY_SCOPE_AGENT); }
__device__ __forceinline__ unsigned xb_add(unsigned* p, unsigned v) { return __hip_atomic_fetch_add(p, v, __ATOMIC_RELAXED, __HIP_MEMORY_SCOPE_AGENT); }
__device__ __forceinline__ unsigned xb_xcc_id() { return (unsigned)__builtin_amdgcn_s_getreg((3 << 11) | 20) & 0xFu; }
#define XB_SPIN(cond, bar) do { unsigned _sp = 0; while (cond) { __builtin_amdgcn_s_sleep(1); \
    if ((++_sp & 255u) == 0u) { if (xb_ld(&(bar)[XB_TMO])) break; if (_sp > XB_SPIN_CAP) { atomicAdd(&(bar)[XB_TMO], 1u); break; } } } } while (0)
struct XcdBarrier { unsigned* bar; unsigned x; volatile LAS unsigned* st; };
__device__ __forceinline__ XcdBarrier xcd_barrier_post(unsigned* bar, volatile LAS unsigned* st) {
    XcdBarrier b; b.bar = bar; b.x = xb_xcc_id(); b.st = st;
    if (threadIdx.x == 0) (void)xb_add(&bar[XB_XCNT(b.x)], 1u);
    return b;
}
__device__ __forceinline__ void xcd_barrier_complete(unsigned* bar, unsigned x, unsigned& nloc, unsigned& nx) {
    const unsigned G = gridDim.x * gridDim.y * gridDim.z;
    unsigned sum, cnt, mine, sp = 0u;
    for (;;) {
        sum = 0u; cnt = 0u; mine = 0u;
#pragma unroll
        for (unsigned j = 0; j < 16; ++j) { const unsigned c = xb_ld(&bar[XB_XCNT(j)]); sum += c; cnt += (c > 0u) ? 1u : 0u; mine = (j == x) ? c : mine; }
        if (sum == G) break;
        __builtin_amdgcn_s_sleep(1);
        if ((++sp & 255u) == 0u) { if (xb_ld(&bar[XB_TMO])) break; if (sp > XB_SPIN_CAP) { atomicAdd(&bar[XB_TMO], 1u); break; } }
    }
    nloc = mine > 0u ? mine : 1u; nx = cnt > 0u ? cnt : 1u;
}
__device__ __forceinline__ void xcd_barrier(const XcdBarrier& b) {
    asm volatile("s_waitcnt vmcnt(0)" ::: "memory");
    __syncthreads();
    if (threadIdx.x == 0) {
        unsigned* bar = b.bar;
        __builtin_amdgcn_s_waitcnt(0);
        unsigned nloc = b.st[0], nx = b.st[1];
        if (nloc == 0u) { xcd_barrier_complete(bar, b.x, nloc, nx); b.st[0] = nloc; b.st[1] = nx; }
        const unsigned old = xb_add(&bar[XB_XSUB(b.x)], 1u);
        const unsigned gen = old / nloc;
        if (old + 1u == (gen + 1u) * nloc) {
            __builtin_amdgcn_fence(__ATOMIC_RELEASE, "agent");
            asm volatile("s_waitcnt vmcnt(0)" ::: "memory");
            const unsigned og = xb_add(&bar[XB_TOP], 1u);
            const unsigned tg = og / nx;
            if (og + 1u == (tg + 1u) * nx) xb_add(&bar[XB_TOPGEN], 1u);
            else XB_SPIN(xb_ld(&bar[XB_TOPGEN]) == tg, bar);
            __builtin_amdgcn_fence(__ATOMIC_ACQUIRE, "agent");
            xb_add(&bar[XB_XGEN(b.x)], 1u);
            asm volatile("s_waitcnt vmcnt(0)" ::: "memory");
        } else {
            XB_SPIN(xb_ld(&bar[XB_XGEN(b.x)]) == gen, bar);
            __builtin_amdgcn_fence(__ATOMIC_ACQUIRE, "agent");
            asm volatile("s_waitcnt vmcnt(0)" ::: "memory");
        }
    }
    __syncthreads();
}

constexpr int N_PHASES = 12;
__global__ void __launch_bounds__(NTHR, 2) mk_fwd(Args a) {
    extern __shared__ __attribute__((aligned(16))) unsigned char lds[];
    cg::grid_group grid = cg::this_grid();
    const int bid = blockIdx.x, nb = gridDim.x;
    const int lo = a.ph_lo, hi = a.ph_hi;
    volatile LAS unsigned* bst = (volatile LAS unsigned*)((LAS unsigned char*)lds + (LDS_BYTES - 16));
    if (threadIdx.x < 4) bst[threadIdx.x] = 0u;
    __syncthreads();
    XcdBarrier xbar = xcd_barrier_post((unsigned*)(a.ws + WS_CTL), bst);
#define SEAM(k) do { if ((k) == 0) grid.sync(); else xcd_barrier(xbar); } while (0)
#define PHASE(k, body) if (lo <= (k) && (k) < hi) { body; if ((k) + 1 < hi) SEAM(k); }
    PHASE(0, ph0_prologue(a, bid, nb, lds))
    PHASE(1, row_norm_mod(a.in[0], a.in[4], (const float*)(a.ws + WS_MOD), 0, 1024, (f16*)(a.ws + WS_H), bid, nb); wq_to_int8((const f16*)(a.ws + WS_WQ), a.ws + WS_WQ8, (float*)(a.ws + WS_WSC), bid, nb))
    PHASE(2, ph2_inproj(a, bid, nb, lds))
    PHASE(3, ph3_pool_fast(a, bid, nb, lds); ph3_index_fast<0>(a, bid, nb, lds))
    PHASE(4, ph4_attn_fast<0>(a, bid, nb, lds))
    PHASE(5, ph5_outproj(a, bid, nb, lds))
    PHASE(6, row_norm_mod_q((const f16*)(a.ws + WS_X1), a.in[13], (const float*)(a.ws + WS_MOD), 3072, 4096, a.ws + WS_HQ, (unsigned*)(a.ws + WS_HP), (float*)(a.ws + WS_HSC), bid, nb))
    PHASE(7, ph7_peerq(a, bid, nb, lds))
    PHASE(8, ph8_peersel_fast(a, bid, nb, lds))
    PHASE(9, ph9_sliced<0>(a, lds))
    PHASE(10, ph9b_combine(a, bid, nb))
    PHASE(11, ph9_sliced<1>(a, lds))
#undef PHASE
}

extern "C" void kernel_launch(void* const* d_in, const int* in_sizes, int n_in, void* d_out, int out_size, void* d_ws, size_t ws_size, hipStream_t stream) {
    static int grid = 0;
    if (grid == 0) {
        if (n_in != 18 || out_size != NT * ND || ws_size < WS_END) { fprintf(stderr, "kernel_launch: unexpected shapes (n_in %d out %d ws %zu)\n", n_in, out_size, ws_size); grid = -1; return; }
        int dev = 0, cus = 0, per_cu = 0;
        hipGetDevice(&dev); hipDeviceGetAttribute(&cus, hipDeviceAttributeMultiprocessorCount, dev);
        hipFuncSetAttribute((const void*)mk_fwd, hipFuncAttributeMaxDynamicSharedMemorySize, LDS_BYTES);
        hipOccupancyMaxActiveBlocksPerMultiprocessor(&per_cu, (const void*)mk_fwd, NTHR, LDS_BYTES);
        if (per_cu < 1) { fprintf(stderr, "kernel_launch: occupancy query says %d blocks/CU\n", per_cu); per_cu = 1; }
        grid = cus * 1;
        (void)hipGetLastError();
    }
    if (grid < 0) return;
    if (hipMemsetAsync((char*)d_ws + WS_CTL, 0, 32768, stream) != hipSuccess) { fprintf(stderr, "kernel_launch: memset of the barrier words failed\n"); return; }
    Args a{};
    for (int i = 0; i < 18; ++i) a.in[i] = (const float*)d_in[i];
    a.out = (float*)d_out; a.ws = (unsigned char*)d_ws;
#if MK_MULTI
    for (int ph = 0; ph < N_PHASES; ++ph) { a.ph_lo = ph; a.ph_hi = ph + 1; hipLaunchKernelGGL(mk_fwd, dim3(grid), dim3(NTHR), LDS_BYTES, stream, a); }
#else
    a.ph_lo = 0; a.ph_hi = N_PHASES;
    void* args[] = {&a};
    hipError_t e = hipLaunchCooperativeKernel((const void*)mk_fwd, dim3(grid), dim3(NTHR), args, LDS_BYTES, stream);
    if (e != hipSuccess) fprintf(stderr, "cooperative launch failed: %s (grid %d)\n", hipGetErrorString(e), grid);
#endif
}
```

```cpp
#include <hip/hip_runtime.h>
#include <hip/hip_cooperative_groups.h>
#include <cstdio>
#include <cstdint>
namespace cg = cooperative_groups;

#ifndef MK_MULTI
#define MK_MULTI 0
#endif

typedef _Float16 f16;
typedef _Float16 f16x8 __attribute__((ext_vector_type(8)));
typedef _Float16 f16x4 __attribute__((ext_vector_type(4)));
typedef float f32x4 __attribute__((ext_vector_type(4)));
typedef float f32x16 __attribute__((ext_vector_type(16)));
typedef int i32x4 __attribute__((ext_vector_type(4)));
typedef unsigned long long u64;
typedef unsigned short u16;

constexpr int NB = 8, NS = 8192, ND = 1024, NT = NB * NS;
constexpr int INW = 2632;
constexpr int NMAIN = 2304;
constexpr float EPS = 1e-6f;
constexpr int NTHR = 512, NWAVE = 8;

constexpr size_t MiB = 1u << 20;
constexpr size_t WS_CTL = 0;
constexpr size_t WS_MOD = 1 * MiB;
constexpr size_t WS_WIN = 2 * MiB;
constexpr size_t WS_WVT = 7 * MiB;
constexpr size_t WS_WOUT = 8 * MiB;
constexpr size_t WS_WQ = 10 * MiB;
constexpr size_t WS_SK = 14 * MiB;
constexpr size_t WS_PW = 14 * MiB + 512 * 1024;
constexpr size_t WS_QS = 1 * MiB + 512 * 1024;
constexpr size_t WS_UT = 16 * MiB;
constexpr size_t WS_VP = 48 * MiB;
constexpr size_t WS_H = 80 * MiB;
constexpr size_t WS_U = 208 * MiB;
constexpr size_t WS_Q = 272 * MiB;
constexpr size_t WS_K = 336 * MiB;
constexpr size_t WS_VT = 400 * MiB;
constexpr size_t WS_PQ = 208 * MiB;
constexpr size_t WS_WQ8 = 24 * MiB;
constexpr size_t WS_WSC = 26 * MiB;
constexpr size_t WS_HQ = 464 * MiB;
constexpr size_t WS_HP = 784 * MiB;
constexpr size_t WS_WSUM = 536 * MiB;
constexpr size_t WS_HSC = 528 * MiB;
constexpr size_t WS_QI = 464 * MiB;
constexpr size_t WS_KI = 528 * MiB;
constexpr size_t WS_WI = 536 * MiB;
constexpr size_t WS_MASK = 544 * MiB;
constexpr size_t WS_EID = 608 * MiB;
constexpr size_t WS_GW = 624 * MiB;
constexpr size_t WS_X1 = 656 * MiB;
constexpr size_t WS_END = 848 * MiB;

constexpr int LDS_BYTES = 155648;
constexpr float PEER_QSTEP = 0.3352f;
constexpr float PEER_WSCALE = 16384.f;

struct Args { const float* in[18]; float* out; unsigned char* ws; int ph_lo, ph_hi; };

__host__ __device__ __forceinline__ int pos2log(int p) { return 64 * ((p >> 5) & 3) + 32 * (p >> 7) + 8 * ((p >> 2) & 3) + 4 * ((p >> 4) & 1) + (p & 3); }
__device__ __forceinline__ int maincol(int L) { if (L < 1536) return L; if (L < 2120) return L + 512; return -1; }

__device__ __forceinline__ float wave_sum(float v) {
#pragma unroll
    for (int o = 1; o < 64; o <<= 1) v += __shfl_xor(v, o);
    return v;
}
__device__ __forceinline__ float wave_max(float v) {
#pragma unroll
    for (int o = 1; o < 64; o <<= 1) v = fmaxf(v, __shfl_xor(v, o));
    return v;
}

__device__ void ph0_prologue(const Args& a, int bid, int nb, unsigned char* lds) {
    int tid = threadIdx.x; asm volatile("" : "+v"(tid));
    const float* c = a.in[1]; const float* ada_w = a.in[2]; const float* ada_b = a.in[3];
    float* sil = (float*)lds;
    for (int i = tid; i < NB * ND; i += NTHR) { const float v = c[i]; sil[i] = v / (1.f + __expf(-v)); }
    __syncthreads();
    float* mod = (float*)(a.ws + WS_MOD);
    const int gt = bid * NTHR + tid, ngt = nb * NTHR;
    for (int o = gt; o < NB * 6144; o += ngt) {
        const int b = o / 6144, j = o % 6144;
        float acc = ada_b[j];
        const float* sb = sil + b * ND;
        for (int k = 0; k < ND; ++k) acc += sb[k] * ada_w[(size_t)k * 6144 + j];
        mod[o] = acc;
    }
    const float* w_in = a.in[5]; const float* pool_w = a.in[6]; const float* w_out = a.in[12];
    const float* wq = a.in[14]; const float* sk = a.in[15]; const float* pu = a.in[16]; const float* pv = a.in[17];
    f16* WIN = (f16*)(a.ws + WS_WIN); f16* WVT = (f16*)(a.ws + WS_WVT); f16* WOUT = (f16*)(a.ws + WS_WOUT); f16* WQ = (f16*)(a.ws + WS_WQ);
 unsigned char* UT = a.ws + WS_UT; unsigned char* VP = a.ws + WS_VP;
    {
        __syncthreads();
        const int lane = tid & 63, wv_ = tid >> 6;
        float* scr = (float*)lds + wv_ * (64 * 33);
        constexpr int I_WQ = 16 * 64, I_Z = 16 * 16, I_INR = 16 * (NMAIN / 32 - 16), I_VT = 16 * 16, I_OUT = 16 * 32, I_ALL = I_WQ + I_Z + I_INR + I_VT + I_OUT;
        for (int it = bid * NWAVE + wv_; it < I_ALL; it += nb * NWAVE) {
            int rr = it, kind = 3, pboff = 0;
            if (rr >= I_WQ) { rr -= I_WQ; kind = 0;
                if (rr >= I_Z) { rr -= I_Z; pboff = 16;
                    if (rr >= I_INR) { rr -= I_INR; kind = 1; pboff = 0; if (rr >= I_VT) { rr -= I_VT; kind = 2; } } } }
            const int npb = kind == 0 ? (pboff ? NMAIN / 32 - 16 : 16) : kind == 1 ? 16 : kind == 2 ? 32 : 64;
            const int k0 = (rr / npb) * 64, p0 = (rr % npb + pboff) * 32, p = p0 + (lane & 31);
            const float* W = kind <= 1 ? w_in : kind == 2 ? w_out : wq; const int ldw = kind <= 1 ? INW : kind == 2 ? 1024 : 2048;
            int col;
            if (kind == 0) col = maincol((p & ~255) + pos2log(p & 255)); else if (kind == 1) col = 1536 + p; else col = (p & ~255) + pos2log(p & 255);
            const bool foldz = (kind == 0 && pboff == 0);
            if (foldz || kind == 3) {
                const int r5 = lane & 31, hh_ = lane >> 5;
                const int blk = __builtin_amdgcn_readfirstlane(col >> 7);
                const int sub = col & 127;
                const float* arow = W + (size_t)(k0 + r5) * ldw + blk * 128 + 8 * hh_;
                f32x16 acc0 = (f32x16){0.f, 0.f, 0.f, 0.f, 0.f, 0.f, 0.f, 0.f, 0.f, 0.f, 0.f, 0.f, 0.f, 0.f, 0.f, 0.f}, acc1 = acc0;
#pragma unroll 2
                for (int ks = 0; ks < 8; ++ks) {
                    const f32x4 a00 = *(const f32x4*)(arow + 16 * ks), a01 = *(const f32x4*)(arow + 16 * ks + 4);
                    const f32x4 a10 = *(const f32x4*)(arow + (size_t)32 * ldw + 16 * ks), a11 = *(const f32x4*)(arow + (size_t)32 * ldw + 16 * ks + 4);
                    f16x8 bfr;
                    if (kind == 3) { const float* br = sk + (size_t)(blk * 128 + sub) * 128 + 16 * ks + 8 * hh_; const f32x4 b0 = *(const f32x4*)br, b1 = *(const f32x4*)(br + 4);
                        bfr = (f16x8){(f16)b0[0], (f16)b0[1], (f16)b0[2], (f16)b0[3], (f16)b1[0], (f16)b1[1], (f16)b1[2], (f16)b1[3]}; }
                    else { const float* br = pool_w + (size_t)blk * 16384 + (size_t)(16 * ks + 8 * hh_) * 128 + sub;
                        bfr = (f16x8){(f16)br[0], (f16)br[128], (f16)br[256], (f16)br[384], (f16)br[512], (f16)br[640], (f16)br[768], (f16)br[896]}; }
                    const f16x8 af0 = (f16x8){(f16)a00[0], (f16)a00[1], (f16)a00[2], (f16)a00[3], (f16)a01[0], (f16)a01[1], (f16)a01[2], (f16)a01[3]};
                    const f16x8 af1 = (f16x8){(f16)a10[0], (f16)a10[1], (f16)a10[2], (f16)a10[3], (f16)a11[0], (f16)a11[1], (f16)a11[2], (f16)a11[3]};
                    acc0 = __builtin_amdgcn_mfma_f32_32x32x16_f16(af0, bfr, acc0, 0, 0, 0);
                    acc1 = __builtin_amdgcn_mfma_f32_32x32x16_f16(af1, bfr, acc1, 0, 0, 0);
                }
#pragma unroll
                for (int rg = 0; rg < 16; ++rg) { const int kk = (rg & 3) + 8 * (rg >> 2) + 4 * hh_; scr[kk * 33 + r5] = acc0[rg]; scr[(32 + kk) * 33 + r5] = acc1[rg]; }
            } else {
#pragma unroll 8
                for (int i = 0; i < 32; ++i) { const int kk = 2 * i + (lane >> 5); scr[kk * 33 + (lane & 31)] = col >= 0 ? W[(size_t)(k0 + kk) * ldw + col] : 0.f; }
            }
            f16* WT = kind == 0 ? WIN : kind == 1 ? WVT : kind == 2 ? WOUT : WQ;
            const int c8 = lane & 7;
#pragma unroll
            for (int j = 0; j < 4; ++j) { const int n = (lane >> 3) + 8 * j; const float* sp = scr + (8 * c8) * 33 + n;
                *(f16x8*)(WT + (size_t)(p0 + n) * ND + k0 + 8 * c8) = (f16x8){(f16)sp[0], (f16)sp[33], (f16)sp[66], (f16)sp[99], (f16)sp[132], (f16)sp[165], (f16)sp[198], (f16)sp[231]}; }
        }
    }
    {
        __syncthreads();
        float ssu = 0.f, ssv = 0.f;
        for (int i = tid; i < 64 * 1024 / 4; i += NTHR) { const f32x4 u = ((const f32x4*)pu)[i], v = ((const f32x4*)pv)[i];
            ssu += u.x * u.x + u.y * u.y + u.z * u.z + u.w * u.w; ssv += v.x * v.x + v.y * v.y + v.z * v.z + v.w * v.w; }
        ssu = wave_sum(ssu); ssv = wave_sum(ssv);
        float* red = (float*)lds;
        if ((tid & 63) == 0) { red[tid >> 6] = ssu; red[8 + (tid >> 6)] = ssv; }
        __syncthreads();
        float tu = 0.f, tv = 0.f;
#pragma unroll
        for (int w = 0; w < 8; ++w) { tu += red[w]; tv += red[8 + w]; }
        const float du = PEER_QSTEP * sqrtf(tu * (1.f / 65536.f)), dv = PEER_QSTEP * sqrtf(tv * (1.f / 65536.f));
        if (bid == 0 && tid == 0) { float* qs = (float*)(a.ws + WS_QS); qs[0] = du; qs[1] = dv; }
        const float idu = 1.f / du, idv = 1.f / dv;
        const int lane = tid & 63, wv_ = tid >> 6;
        for (int row = bid * NWAVE + wv_; row < 2 * 16384; row += nb * NWAVE) {
            const bool isv = row >= 16384; const int e = row & 16383;
            const float* src = (isv ? pv : pu) + (size_t)e * ND + 4 * lane; u16* dstq = (u16*)((isv ? VP : UT) + (size_t)e * 512) + lane;
            const float inv = isv ? idv : idu; const int off = isv ? 8 : 0;
#pragma unroll
            for (int j = 0; j < 4; ++j) { const f32x4 x4 = *(const f32x4*)(src + 256 * j); unsigned pk = 0u;
#pragma unroll
                for (int k = 0; k < 4; ++k) { int q = (int)floorf(x4[k] * inv); q = q < -8 ? -8 : q > 7 ? 7 : q; pk |= (unsigned)((q + off) & 15) << (4 * k); }
                dstq[64 * j] = (u16)pk; }
        }
    }
}

__device__ void row_norm_mod(const float* src, const float* g, const float* mod, int sh_off, int sc_off, f16* dst, int bid, int nb) {
    int tid_ = threadIdx.x; asm volatile("" : "+v"(tid_)); const int lane = tid_ & 63, wave = tid_ >> 6;
    const int rstep = nb * NWAVE, r0 = bid * NWAVE + wave;
    const bool fast = (NS % rstep) == 0 && ((NS / rstep) % 2) == 0;
    if (fast) {
        for (int b = 0; b < NB; ++b) {
            f32x4 gs[4], sh[4];
#pragma unroll
            for (int j = 0; j < 4; ++j) { const int col = lane * 4 + 256 * j; const f32x4 gg = *(const f32x4*)(g + col), sc = *(const f32x4*)(mod + b * 6144 + sc_off + col);
                sh[j] = *(const f32x4*)(mod + b * 6144 + sh_off + col); gs[j] = gg * (1.f + sc); }
            for (int row = b * NS + r0; row < (b + 1) * NS; row += 2 * rstep) {
                const f32x4* xa = (const f32x4*)(src + (size_t)row * ND) + lane; const f32x4* xb = (const f32x4*)(src + (size_t)(row + rstep) * ND) + lane;
                f32x4 va[4], vb[4]; float sa = 0.f, sb = 0.f;
#pragma unroll
                for (int j = 0; j < 4; ++j) { va[j] = xa[64 * j]; vb[j] = xb[64 * j]; }
#pragma unroll
                for (int j = 0; j < 4; ++j) { sa += va[j].x * va[j].x + va[j].y * va[j].y + va[j].z * va[j].z + va[j].w * va[j].w; sb += vb[j].x * vb[j].x + vb[j].y * vb[j].y + vb[j].z * vb[j].z + vb[j].w * vb[j].w; }
                const float ra = rsqrtf(wave_sum(sa) * (1.f / ND) + EPS), rb = rsqrtf(wave_sum(sb) * (1.f / ND) + EPS);
#pragma unroll
                for (int j = 0; j < 4; ++j) { const int col = lane * 4 + 256 * j; const f32x4 oa = va[j] * ra * gs[j] + sh[j], ob = vb[j] * rb * gs[j] + sh[j];
                    *(f16x4*)(dst + (size_t)row * ND + col) = (f16x4){(f16)oa.x, (f16)oa.y, (f16)oa.z, (f16)oa.w};
                    *(f16x4*)(dst + (size_t)(row + rstep) * ND + col) = (f16x4){(f16)ob.x, (f16)ob.y, (f16)ob.z, (f16)ob.w}; }
            }
        }
        return;
    }
    for (int row = r0; row < NT; row += rstep) {
        const int b = row / NS;
        const f32x4* xr = (const f32x4*)(src + (size_t)row * ND) + lane;
        f32x4 v[4]; float s = 0.f;
#pragma unroll
        for (int j = 0; j < 4; ++j) { v[j] = xr[64 * j]; s += v[j].x * v[j].x + v[j].y * v[j].y + v[j].z * v[j].z + v[j].w * v[j].w; }
        const float rstd = rsqrtf(wave_sum(s) * (1.f / ND) + EPS);
#pragma unroll
        for (int j = 0; j < 4; ++j) {
            const int col = lane * 4 + 256 * j;
            const f32x4 gg = *(const f32x4*)(g + col), sc = *(const f32x4*)(mod + b * 6144 + sc_off + col), sh = *(const f32x4*)(mod + b * 6144 + sh_off + col);
            f16x4 o;
            o.x = (f16)(v[j].x * rstd * gg.x * (1.f + sc.x) + sh.x); o.y = (f16)(v[j].y * rstd * gg.y * (1.f + sc.y) + sh.y);
            o.z = (f16)(v[j].z * rstd * gg.z * (1.f + sc.z) + sh.z); o.w = (f16)(v[j].w * rstd * gg.w * (1.f + sc.w) + sh.w);
            *(f16x4*)(dst + (size_t)row * ND + col) = o;
        }
    }
}
__device__ void row_norm_mod_q(const f16* src, const float* g, const float* mod, int sh_off, int sc_off, unsigned char* hq, unsigned* hp, float* hsc, int bid, int nb) {
    int tid_ = threadIdx.x; asm volatile("" : "+v"(tid_)); const int lane = tid_ & 63, wave = tid_ >> 6;
    const int rstep = nb * NWAVE, r0 = bid * NWAVE + wave;
    const bool hoist = (NS % rstep) == 0 && ((NS / rstep) % 2) == 0;
    const int nouter = hoist ? NB : 1, ninner = hoist ? NS : NT;
    for (int bo = 0; bo < nouter; ++bo) {
        f32x4 gs[4], sh[4];
        if (hoist) {
#pragma unroll
            for (int j = 0; j < 4; ++j) { const int col = 8 * lane + 512 * (j >> 1) + 4 * (j & 1); const f32x4 gg = *(const f32x4*)(g + col), sc = *(const f32x4*)(mod + bo * 6144 + sc_off + col);
                sh[j] = *(const f32x4*)(mod + bo * 6144 + sh_off + col); gs[j] = gg * (1.f + sc); }
        }
        for (int rowa = bo * ninner + r0; rowa < (bo + 1) * ninner; rowa += 2 * rstep) {
            const int rowb = rowa + rstep < NT ? rowa + rstep : rowa;
            f16x8 hx[2][2];
#pragma unroll
            for (int j = 0; j < 2; ++j) { hx[0][j] = *(const f16x8*)(src + (size_t)rowa * ND + 8 * lane + 512 * j); hx[1][j] = *(const f16x8*)(src + (size_t)rowb * ND + 8 * lane + 512 * j); }
#pragma unroll
            for (int rr = 0; rr < 2; ++rr) {
                const int row = rr ? rowb : rowa; const int b = row / NS;
                if (!hoist) {
#pragma unroll
                    for (int j = 0; j < 4; ++j) { const int col = 8 * lane + 512 * (j >> 1) + 4 * (j & 1); const f32x4 gg = *(const f32x4*)(g + col), sc = *(const f32x4*)(mod + b * 6144 + sc_off + col);
                        sh[j] = *(const f32x4*)(mod + b * 6144 + sh_off + col); gs[j] = gg * (1.f + sc); }
                }
                f32x4 v[4]; float s = 0.f;
#pragma unroll
                for (int j = 0; j < 2; ++j) { const f16x8 h8 = hx[rr][j];
                    v[2 * j] = (f32x4){(float)h8[0], (float)h8[1], (float)h8[2], (float)h8[3]}; v[2 * j + 1] = (f32x4){(float)h8[4], (float)h8[5], (float)h8[6], (float)h8[7]}; }
#pragma unroll
                for (int j = 0; j < 4; ++j) s += v[j].x * v[j].x + v[j].y * v[j].y + v[j].z * v[j].z + v[j].w * v[j].w;
                const float rstd = rsqrtf(wave_sum(s) * (1.f / ND) + EPS);
                float o[16]; float am = 0.f;
#pragma unroll
                for (int j = 0; j < 4; ++j)
#pragma unroll
                    for (int k = 0; k < 4; ++k) { const float y = v[j][k] * rstd * gs[j][k] + sh[j][k]; o[4 * j + k] = y; am = fmaxf(am, fabsf(y)); }
                am = wave_max(am);
                const float inv = am > 0.f ? 119.f / am : 0.f;
#pragma unroll
                for (int j = 0; j < 2; ++j) {
                    unsigned p0 = 0u, p1 = 0u, ph = 0u, pl = 0u;
#pragma unroll
                    for (int k = 0; k < 8; ++k) { const int q = (int)rintf(o[8 * j + k] * inv); const int l = ((q + 8) & 15) - 8; const int h = (q - l) >> 4;
                        if (k < 4) p0 |= (unsigned)(q & 255) << (8 * k); else p1 |= (unsigned)(q & 255) << (8 * (k - 4));
                        ph |= (unsigned)(h & 15) << (4 * k); pl |= (unsigned)(l & 15) << (4 * k); }
                    *(u64*)(hq + (size_t)row * ND + 8 * lane + 512 * j) = (u64)p0 | ((u64)p1 << 32);
                    hp[(size_t)row * 256 + lane + 64 * j] = ph; hp[(size_t)row * 256 + 128 + lane + 64 * j] = pl;
                }
                if (lane == 0) hsc[row] = am * (1.f / 119.f);
            }
        }
    }
}
__device__ void wq_to_int8(const f16* WQ, unsigned char* WQ8, float* WSC, int bid, int nb) {
    int tid_ = threadIdx.x; asm volatile("" : "+v"(tid_)); const int lane = tid_ & 63, wave = tid_ >> 6;
    for (int row = bid * NWAVE + wave; row < 2048; row += nb * NWAVE) {
        const f16x8 a0 = *(const f16x8*)(WQ + (size_t)row * ND + 8 * lane), a1 = *(const f16x8*)(WQ + (size_t)row * ND + 8 * lane + 512);
        float am = 0.f;
#pragma unroll
        for (int k = 0; k < 8; ++k) am = fmaxf(am, fmaxf(fabsf((float)a0[k]), fabsf((float)a1[k])));
        am = wave_max(am);
        const float inv = am > 0.f ? 127.f / am : 0.f;
        unsigned p[4] = {0u, 0u, 0u, 0u};
#pragma unroll
        for (int k = 0; k < 4; ++k) { p[0] |= (unsigned)((int)rintf((float)a0[k] * inv) & 255) << (8 * k); p[1] |= (unsigned)((int)rintf((float)a0[4 + k] * inv) & 255) << (8 * k);
                                      p[2] |= (unsigned)((int)rintf((float)a1[k] * inv) & 255) << (8 * k); p[3] |= (unsigned)((int)rintf((float)a1[4 + k] * inv) & 255) << (8 * k); }
        *(u64*)(WQ8 + (size_t)row * ND + 8 * lane) = (u64)p[0] | ((u64)p[1] << 32);
        *(u64*)(WQ8 + (size_t)row * ND + 8 * lane + 512) = (u64)p[2] | ((u64)p[3] << 32);
        if (lane == 0) WSC[row] = am * (1.f / 127.f);
    }
}

namespace pg8 {
#define PG8_LAS __attribute__((address_space(3)))
constexpr int BM = 256, BK = 64, HALF = 128, HTB = HALF * BK * 2, STAGE_BYTES = 8 * HTB, NXCD = 8, WGM = 8;
__host__ __device__ __forceinline__ int lds_byte(int r, int c) { const int st = (r >> 4) * 2 + (c >> 5), rr = r & 15, cc = c & 31, ob = rr * 64 + cc * 2; return st * 1024 + (ob ^ (((ob >> 9) & 1) << 5)); }
__host__ __device__ __forceinline__ void stage_rc(int b, int& R, int& C) { const int st = b / 1024, sb = b % 1024, swz = sb ^ (((sb >> 9) & 1) << 5); R = (st >> 1) * 16 + swz / 64; C = (st & 1) * 32 + (swz % 64) / 2; }
struct Unit { int pm, pn; };
struct Gemm { const f16* A; const f16* Bt; int M, N, K; };
struct StaticOrder {
    int nM, nN, nwg, G, c;
    __host__ __device__ void init(int M, int N, int G_, int c_) { nM = M / BM; nN = N / BM; nwg = nM * nN; G = G_; c = c_; }
    __host__ __device__ bool next(int i, Unit& u) const {
        const long L = (long)i * G + c; if (L >= nwg) return false;
        int wgid = (int)L; { const int q = nwg / NXCD, r = nwg % NXCD, xcd = wgid % NXCD, off = wgid / NXCD; wgid = (xcd < r ? xcd * (q + 1) : r * (q + 1) + (xcd - r) * q) + off; }
        const int nig = WGM * nN, gid = wgid / nig, fm = gid * WGM, gsz = (nM - fm) < WGM ? (nM - fm) : WGM;
        u.pm = fm + ((wgid % nig) % gsz); u.pn = (wgid % nig) / gsz; return true;
    }
};
template <class Epi, bool I8 = false>
__device__ __forceinline__ void gemm_phase(PG8_LAS unsigned char* lds, const Gemm g, const StaticOrder& S, const Epi& E) {
    int tid = threadIdx.x; asm volatile("" : "+v"(tid));
    const int wid = __builtin_amdgcn_readfirstlane(tid >> 6), lane = tid & 63, wr = wid >> 2, wc = wid & 3, fr = lane & 15, fq = lane >> 4;
    const int K = g.K, nt = K / BK;
    unsigned voffA[2];
#pragma unroll
    for (int i = 0; i < 2; ++i) { int R, C; stage_rc(tid * 16 + i * 8192, R, C); voffA[i] = (unsigned)(R * K + C) * 2u; }
    const size_t kstep = (size_t)(BK * 2);
    const size_t hstep = (size_t)HALF * K * 2;
    const size_t tstep = 2 * hstep;
    const unsigned ldsw = (unsigned)wid * 1024u;
    const int aoff = lds_byte(wr * 64 + fr, fq * 8), boff = lds_byte(wc * 32 + fr, fq * 8);
#define PG8_SA(b, h) (((b) * 2 + (h)) * HTB)
#define PG8_SB(b, h) ((4 + (b) * 2 + (h)) * HTB)
#define PG8_STAGE(bufoff, gbase, voff) do { _Pragma("unroll") for (int _i = 0; _i < 2; ++_i) \
        __builtin_amdgcn_global_load_lds((const unsigned*)((const char*)(gbase) + (voff)[_i]), (PG8_LAS unsigned*)(lds + (bufoff) + ldsw + _i * 8192), 16, 0, 0); } while (0)
#define PG8_LDA(dst, b, h) do { _Pragma("unroll") for (int m = 0; m < 4; ++m) _Pragma("unroll") for (int k = 0; k < 2; ++k) dst[m][k] = *(const PG8_LAS f16x8*)(lds + PG8_SA(b, h) + aoff + m * 2048 + k * 1024); } while (0)
#define PG8_LDB(dst, b, h) do { _Pragma("unroll") for (int n = 0; n < 2; ++n) _Pragma("unroll") for (int k = 0; k < 2; ++k) dst[n][k] = *(const PG8_LAS f16x8*)(lds + PG8_SB(b, h) + boff + n * 2048 + k * 1024); } while (0)
#define PG8_MMA(ai, bj, At, Bt) do { __builtin_amdgcn_s_setprio(1); _Pragma("unroll") for (int m = 0; m < 4; ++m) _Pragma("unroll") for (int n = 0; n < 2; ++n) _Pragma("unroll") for (int k = 0; k < 2; ++k) \
        acc[ai][bj][m][n] = I8 ? __builtin_bit_cast(f32x4, __builtin_amdgcn_mfma_i32_16x16x64_i8(__builtin_bit_cast(i32x4, Bt[n][k]), __builtin_bit_cast(i32x4, At[m][k]), __builtin_bit_cast(i32x4, acc[ai][bj][m][n]), 0, 0, 0)) \
                                 : __builtin_amdgcn_mfma_f32_16x16x32_f16(Bt[n][k], At[m][k], acc[ai][bj][m][n], 0, 0, 0); __builtin_amdgcn_s_setprio(0); } while (0)
#define PG8_WAIT_V(n) asm volatile("s_waitcnt vmcnt(" #n ")" ::: "memory")
#define PG8_WAIT_L(n) asm volatile("s_waitcnt lgkmcnt(" #n ")" ::: "memory")
#define PG8_BAR __builtin_amdgcn_s_barrier()
#define PG8_SCHED __builtin_amdgcn_sched_barrier(0)
    Unit cur, nxt; int ui = 0;
    if (!S.next(0, cur)) return;
    f32x4 acc[2][2][4][2];
#pragma unroll
    for (int a = 0; a < 2; ++a)
#pragma unroll
        for (int b = 0; b < 2; ++b)
#pragma unroll
            for (int m = 0; m < 4; ++m)
#pragma unroll
                for (int n = 0; n < 2; ++n) acc[a][b][m][n] = (f32x4){0.f, 0.f, 0.f, 0.f};
    f16x8 At[4][2], B0[2][2], B1[2][2];
    const char* cA = (const char*)g.A + (size_t)cur.pm * tstep; const char* cB = (const char*)g.Bt + (size_t)cur.pn * tstep;
    PG8_STAGE(PG8_SB(0, 0), cB, voffA); PG8_STAGE(PG8_SB(0, 1), cB + hstep, voffA); PG8_STAGE(PG8_SA(0, 0), cA, voffA); PG8_STAGE(PG8_SA(0, 1), cA + hstep, voffA);
    if (wr == 1) PG8_BAR;
    PG8_WAIT_V(2); PG8_BAR;
    PG8_STAGE(PG8_SB(1, 0), cB + kstep, voffA); PG8_STAGE(PG8_SA(1, 0), cA + kstep, voffA); PG8_STAGE(PG8_SB(1, 1), cB + hstep + kstep, voffA);
    PG8_WAIT_V(6); PG8_BAR;
    for (;;) {
        const bool has_next = S.next(ui + 1, nxt);
        const char* nA = has_next ? (const char*)g.A + (size_t)nxt.pm * tstep : cA; const char* nB = has_next ? (const char*)g.Bt + (size_t)nxt.pn * tstep : cB;
        for (int t = 0; t < nt; t += 2) {
            const bool last = (t == nt - 2);
            const char* a1 = cA + (size_t)(t + 1) * kstep;
            const char* a2 = last ? nA : cA + (size_t)(t + 2) * kstep; const char* b2 = last ? nB : cB + (size_t)(t + 2) * kstep;
            const char* a3 = a2 + kstep; const char* b3 = b2 + kstep;
            PG8_LDB(B0, 0, 0); PG8_LDB(B1, 0, 1); PG8_SCHED; PG8_LDA(At, 0, 0); PG8_STAGE(PG8_SA(1, 1), a1 + hstep, voffA);
            PG8_WAIT_V(8); PG8_WAIT_L(0); PG8_BAR; PG8_MMA(0, 0, At, B0); PG8_MMA(0, 1, At, B1); PG8_BAR; PG8_SCHED;
            PG8_LDA(At, 0, 1); PG8_STAGE(PG8_SB(0, 0), b2, voffA); PG8_STAGE(PG8_SB(0, 1), b2 + hstep, voffA); PG8_STAGE(PG8_SA(0, 0), a2, voffA);
            PG8_WAIT_V(8); PG8_WAIT_L(0); PG8_BAR; PG8_MMA(1, 0, At, B0); PG8_MMA(1, 1, At, B1); PG8_BAR; PG8_SCHED;
            PG8_LDB(B0, 1, 0); PG8_LDB(B1, 1, 1); PG8_SCHED; PG8_LDA(At, 1, 0); PG8_STAGE(PG8_SA(0, 1), a2 + hstep, voffA);
            PG8_WAIT_V(8); PG8_WAIT_L(0); PG8_BAR; PG8_MMA(0, 0, At, B0); PG8_MMA(0, 1, At, B1); PG8_BAR; PG8_SCHED;
            PG8_LDA(At, 1, 1); PG8_STAGE(PG8_SB(1, 0), b3, voffA); PG8_STAGE(PG8_SB(1, 1), b3 + hstep, voffA); PG8_STAGE(PG8_SA(1, 0), a3, voffA);
            PG8_WAIT_V(8); PG8_WAIT_L(0); PG8_BAR; PG8_MMA(1, 0, At, B0); PG8_MMA(1, 1, At, B1); PG8_BAR; PG8_SCHED;
        }
        if (wr == 0) PG8_BAR;
        E(acc, cur, wr, wc, fr, fq);
        if (!has_next) break;
#pragma unroll
        for (int a = 0; a < 2; ++a)
#pragma unroll
            for (int b = 0; b < 2; ++b)
#pragma unroll
                for (int m = 0; m < 4; ++m)
#pragma unroll
                    for (int n = 0; n < 2; ++n) acc[a][b][m][n] = (f32x4){0.f, 0.f, 0.f, 0.f};
        cur = nxt; cA = nA; cB = nB; ++ui;
        if (wr == 1) PG8_BAR;
    }
    PG8_WAIT_V(0);
    PG8_BAR;
#undef PG8_SA
#undef PG8_SB
#undef PG8_STAGE
#undef PG8_LDA
#undef PG8_LDB
#undef PG8_MMA
#undef PG8_WAIT_V
#undef PG8_WAIT_L
#undef PG8_BAR
#undef PG8_SCHED
}

typedef f32x4 Acc[2][2][4][2];
struct EpiMain {
    unsigned char* ws; const float *qg, *kg;
    __device__ __forceinline__ void operator()(const Acc& acc, const Unit& u, int wr, int wc, int fr, int fq) const {
        const int row0 = u.pm * BM + wr * 64 + fr, pn = u.pn;
        if (pn == 8) {
            if (wc == 0) {
#pragma unroll
                for (int ai = 0; ai < 2; ++ai)
#pragma unroll
                    for (int m = 0; m < 4; ++m) { const size_t row = row0 + ai * HALF + m * 16;
#pragma unroll
                        for (int bj = 0; bj < 2; ++bj) { const f32x4 v0 = acc[ai][bj][m][0], v1 = acc[ai][bj][m][1];
                            *(f16x8*)((f16*)(ws + WS_KI) + (((row >> 5) * 8 + 4 * bj + fq) * 32 + (row & 31)) * 8) = (f16x8){(f16)v0[0], (f16)v0[1], (f16)v0[2], (f16)v0[3], (f16)v1[0], (f16)v1[1], (f16)v1[2], (f16)v1[3]}; } }
            } else if (wc == 1 && fq == 0) {
#pragma unroll
                for (int ai = 0; ai < 2; ++ai)
#pragma unroll
                    for (int m = 0; m < 4; ++m) { const size_t row = row0 + ai * HALF + m * 16;
                        *(f32x4*)((float*)(ws + WS_WI) + row * 8) = acc[ai][0][m][0] * 0.35355339059327373f; *(f32x4*)((float*)(ws + WS_WI) + row * 8 + 4) = acc[ai][0][m][1] * 0.35355339059327373f; }
            }
            return;
        }
        const int kind = pn >> 1;
        f16* base = (f16*)(ws + (kind == 0 ? WS_U : kind == 1 ? WS_Q : kind == 2 ? WS_K : WS_QI));
        const int col0 = (pn & 1) * 256 + 64 * wc + 8 * fq;
        if (kind == 1 || kind == 2) {
            const float* gp = (kind == 1 ? qg : kg) + 8 * fq;
#pragma unroll
            for (int ai = 0; ai < 2; ++ai)
#pragma unroll
                for (int m = 0; m < 4; ++m) { const size_t row = row0 + ai * HALF + m * 16;
                    float ss = 0.f;
#pragma unroll
                    for (int bj = 0; bj < 2; ++bj)
#pragma unroll
                        for (int n = 0; n < 2; ++n) { const f32x4 v = acc[ai][bj][m][n]; ss += v[0] * v[0] + v[1] * v[1] + v[2] * v[2] + v[3] * v[3]; }
                    ss += __shfl_xor(ss, 16); ss += __shfl_xor(ss, 32);
                    const float rstd = rsqrtf(ss * (1.f / 64.f) + EPS);
#pragma unroll
                    for (int bj = 0; bj < 2; ++bj) { const f32x4 v0 = acc[ai][bj][m][0] * rstd * *(const f32x4*)(gp + 32 * bj), v1 = acc[ai][bj][m][1] * rstd * *(const f32x4*)(gp + 32 * bj + 4);
                        *(f16x8*)(base + row * 512 + col0 + 32 * bj) = (f16x8){(f16)v0[0], (f16)v0[1], (f16)v0[2], (f16)v0[3], (f16)v1[0], (f16)v1[1], (f16)v1[2], (f16)v1[3]}; }
                    asm volatile("" ::: "memory"); }
        } else if (kind == 3) {
            const int hd = (pn & 1) * 4 + wc;
#pragma unroll
            for (int ai = 0; ai < 2; ++ai)
#pragma unroll
                for (int m = 0; m < 4; ++m) { const size_t row = row0 + ai * HALF + m * 16; const int ql = (int)(row & 7);
                    const int rr = (hd & 3) | (((ql >> 1) & 1) << 2) | ((hd >> 2) << 3) | ((ql & 1) << 4);
#pragma unroll
                    for (int bj = 0; bj < 2; ++bj) { const f32x4 v0 = acc[ai][bj][m][0], v1 = acc[ai][bj][m][1]; const int chunk = fq + 4 * bj;
                        *(f16x8*)(base + ((((((row >> 3) * 2 + (ql >> 2)) * 4 + (chunk >> 1)) * 2 + (chunk & 1)) * 32 + rr) << 3)) = (f16x8){(f16)v0[0], (f16)v0[1], (f16)v0[2], (f16)v0[3], (f16)v1[0], (f16)v1[1], (f16)v1[2], (f16)v1[3]}; } }
        } else {
#pragma unroll
            for (int ai = 0; ai < 2; ++ai)
#pragma unroll
                for (int m = 0; m < 4; ++m) { const size_t row = row0 + ai * HALF + m * 16;
#pragma unroll
                    for (int bj = 0; bj < 2; ++bj) { const f32x4 v0 = acc[ai][bj][m][0], v1 = acc[ai][bj][m][1];
                        *(f16x8*)(base + row * 512 + col0 + 32 * bj) = (f16x8){(f16)v0[0], (f16)v0[1], (f16)v0[2], (f16)v0[3], (f16)v1[0], (f16)v1[1], (f16)v1[2], (f16)v1[3]}; } }
        }
    }
};
struct EpiVT {
    f16* VT;
    __device__ __forceinline__ void operator()(const Acc& acc, const Unit& u, int wr, int wc, int fr, int fq) const {
        const int row0 = u.pm * BM + wr * 64 + fr, col0 = u.pn * BM + 32 * wc + 4 * fq;
#pragma unroll
        for (int ai = 0; ai < 2; ++ai)
#pragma unroll
            for (int m = 0; m < 4; ++m) { const size_t row = row0 + ai * HALF + m * 16;
#pragma unroll
                for (int bj = 0; bj < 2; ++bj)
#pragma unroll
                    for (int n = 0; n < 2; ++n) { const f32x4 v = acc[ai][bj][m][n];
                        *(f16x4*)(VT + row * NT + col0 + 128 * bj + 16 * n) = (f16x4){(f16)v[0], (f16)v[1], (f16)v[2], (f16)v[3]}; } }
    }
};
struct EpiOut {
    const float* x; const float* mod; f16* x1;
    __device__ __forceinline__ void operator()(const Acc& acc, const Unit& u, int wr, int wc, int fr, int fq) const {
        const int row0 = u.pm * BM + wr * 64 + fr, col0 = u.pn * BM + 64 * wc + 8 * fq;
        const float* g1 = mod + ((u.pm * BM) / NS) * 6144 + 2048 + col0;
        f32x4 g4[2][2];
#pragma unroll
        for (int bj = 0; bj < 2; ++bj)
#pragma unroll
            for (int n = 0; n < 2; ++n) g4[bj][n] = *(const f32x4*)(g1 + 32 * bj + 4 * n);
#pragma unroll
        for (int ai = 0; ai < 2; ++ai)
#pragma unroll
            for (int m = 0; m < 4; ++m) { const size_t off = (size_t)(row0 + ai * HALF + m * 16) * ND + col0;
#pragma unroll
                for (int bj = 0; bj < 2; ++bj) { const f32x4 v0 = *(const f32x4*)(x + off + 32 * bj) + g4[bj][0] * acc[ai][bj][m][0], v1 = *(const f32x4*)(x + off + 32 * bj + 4) + g4[bj][1] * acc[ai][bj][m][1];
                    *(f16x8*)(x1 + off + 32 * bj) = (f16x8){(f16)v0[0], (f16)v0[1], (f16)v0[2], (f16)v0[3], (f16)v1[0], (f16)v1[1], (f16)v1[2], (f16)v1[3]}; } }
    }
};
struct EpiPQ {
    f16* PQ; const float* hsc; const float* wsc;
    __device__ __forceinline__ void operator()(const Acc& acc, const Unit& u, int wr, int wc, int fr, int fq) const {
        const int row0 = u.pm * BM + wr * 64 + fr, col0 = u.pn * BM + 64 * wc + 8 * fq;
        f32x4 ws4[2][2];
#pragma unroll
        for (int bj = 0; bj < 2; ++bj)
#pragma unroll
            for (int n = 0; n < 2; ++n) ws4[bj][n] = *(const f32x4*)(wsc + u.pn * BM + 128 * bj + 32 * wc + 16 * n + 4 * fq);
#pragma unroll
        for (int ai = 0; ai < 2; ++ai)
#pragma unroll
            for (int m = 0; m < 4; ++m) { const size_t row = row0 + ai * HALF + m * 16; const float hs = hsc[row];
#pragma unroll
                for (int bj = 0; bj < 2; ++bj) { const i32x4 i0 = __builtin_bit_cast(i32x4, acc[ai][bj][m][0]), i1 = __builtin_bit_cast(i32x4, acc[ai][bj][m][1]);
                    const f32x4 v0 = (f32x4){(float)i0[0], (float)i0[1], (float)i0[2], (float)i0[3]} * ws4[bj][0] * hs, v1 = (f32x4){(float)i1[0], (float)i1[1], (float)i1[2], (float)i1[3]} * ws4[bj][1] * hs;
                    *(f16x8*)(PQ + ((((row >> 5) * 256 + ((col0 + 32 * bj) >> 3)) * 32 + (row & 31)) << 3)) = (f16x8){(f16)v0[0], (f16)v0[1], (f16)v0[2], (f16)v0[3], (f16)v1[0], (f16)v1[1], (f16)v1[2], (f16)v1[3]}; } }
    }
};
}

__device__ __forceinline__ void ph2_inproj(const Args& a, int bid, int nb, unsigned char* lds) {
    const f16* H = (const f16*)(a.ws + WS_H); const f16* WIN = (const f16*)(a.ws + WS_WIN); const f16* WVT = (const f16*)(a.ws + WS_WVT);
    PG8_LAS unsigned char* l3 = (PG8_LAS unsigned char*)lds;
    { pg8::Gemm g{H, WIN, NT, NMAIN, ND}; pg8::StaticOrder S; S.init(NT, NMAIN, nb, bid);
      pg8::EpiMain E{a.ws, a.in[9], a.in[10]};
      pg8::gemm_phase(l3, g, S, E); }
    { pg8::Gemm g{WVT, H, 512, NT, ND}; pg8::StaticOrder S; S.init(512, NT, nb, bid);
      pg8::EpiVT E{(f16*)(a.ws + WS_VT)};
      pg8::gemm_phase(l3, g, S, E); }
}


constexpr int PPITCH = 1040;
__device__ __forceinline__ void ph3_pool_fast(const Args& a, int bid, int nb, unsigned char* lds) {
    int tid = threadIdx.x; asm volatile("" : "+v"(tid));
    const int cg8 = tid & 63, tq = tid >> 6, gch = cg8 >> 4, win = 2 << gch;
    const f16* Z = (const f16*)(a.ws + WS_U); f16* MIX = (f16*)(a.ws + WS_H);
    const f32x4 ps0 = *(const f32x4*)(a.in[7] + 8 * cg8), ps1 = *(const f32x4*)(a.in[7] + 8 * cg8 + 4), pg0 = *(const f32x4*)(a.in[8] + 8 * cg8), pg1 = *(const f32x4*)(a.in[8] + 8 * cg8 + 4);
    const float psc[8] = {ps0[0], ps0[1], ps0[2], ps0[3], ps1[0], ps1[1], ps1[2], ps1[3]}, pgn[8] = {pg0[0], pg0[1], pg0[2], pg0[3], pg1[0], pg1[1], pg1[2], pg1[3]};
    for (int item = bid; item < NT / 32; item += nb) {
        const int tb = item * 32 + 4 * tq, tl0 = tb % NS;
        const f16* up = Z + (size_t)(tb - tl0) * 512 + 8 * cg8;
        float sm[8];
#pragma unroll
        for (int j = 0; j < 8; ++j) sm[j] = 0.f;
        f16x8 hist_[15];
#pragma unroll
        for (int q = 0; q < 15; ++q) { const int rr = tl0 - 15 + q; hist_[q] = (q >= 16 - win && rr >= 0) ? *(const f16x8*)(up + (size_t)rr * 512) : (f16x8){0, 0, 0, 0, 0, 0, 0, 0}; }
        f16x8 cur_[4];
#pragma unroll
        for (int k = 0; k < 4; ++k) cur_[k] = *(const f16x8*)(up + (size_t)(tl0 + k) * 512);
#pragma unroll
        for (int q = 0; q < 15; ++q)
#pragma unroll
            for (int j = 0; j < 8; ++j) sm[j] += (float)hist_[q][j];
#pragma unroll
        for (int k = 0; k < 4; ++k) {
            const int tl = tl0 + k;
            const float ic = 1.f / (float)((tl + 1 < win) ? tl + 1 : win);
            float v[8]; float ss = 0.f;
#pragma unroll
            for (int j = 0; j < 8; ++j) { sm[j] += (float)cur_[k][j]; v[j] = (sm[j] * ic - (float)cur_[k][j]) * psc[j]; ss += v[j] * v[j]; }
            const float rstd = rsqrtf(wave_sum(ss) * (1.f / 512.f) + EPS);
            f16x8 o;
#pragma unroll
            for (int j = 0; j < 8; ++j) o[j] = (f16)(v[j] * rstd * pgn[j]);
            *(f16x8*)(MIX + (size_t)(tb + k) * ND + 8 * cg8) = o;
            if (k < 3) {
#pragma unroll
                for (int j = 0; j < 8; ++j) {
                    const int q = 16 - win + k;
                    float dv = 0.f;
#pragma unroll
                    for (int qq = 0; qq < 15; ++qq) if (qq == q) dv = (float)hist_[qq][j];
#pragma unroll
                    for (int kk = 0; kk < 3; ++kk) if (q == 15 + kk) dv = (float)cur_[kk][j];
                    sm[j] -= dv;
                }
            }
        }
    }
}


typedef float f32x2 __attribute__((ext_vector_type(2)));
typedef unsigned u32x4 __attribute__((ext_vector_type(4)));

constexpr int IDX_KPITCH = 16384 + 16;
constexpr int IDX_HPITCH = 516;
template <int NBL>
__device__ __forceinline__ int wave_pick(const unsigned (&cc)[NBL], unsigned target, int lane, unsigned& rem_out) {
    unsigned tot = 0u;
#pragma unroll
    for (int j = 0; j < NBL; ++j) tot += cc[j];
    unsigned S = tot;
#pragma unroll
    for (int o = 1; o < 64; o <<= 1) { const unsigned v = __shfl_down(S, o); if (lane + o < 64) S += v; }
    const unsigned above = S - tot;
    const bool hit = (above < target) && (S >= target);
    const u64 bal = __ballot(hit);
    const int L = bal ? __builtin_ctzll(bal) : 0;
    int bin = 0; unsigned rem = target;
    { unsigned run = above; bool done = false;
#pragma unroll
      for (int j = NBL - 1; j >= 0; --j) { if (!done) { if (run + cc[j] >= target) { bin = NBL * lane + j; rem = target - run; done = true; } else run += cc[j]; } } }
    bin = __shfl(bin, L); rem_out = __shfl(rem, L);
    return bin;
}
template <int MODE>
__device__ __forceinline__ void ph3_index_fast(const Args& a, int bid, int nb, unsigned char* lds) {
    int tid = threadIdx.x; asm volatile("" : "+v"(tid));
    const int lane = tid & 63, wave = __builtin_amdgcn_readfirstlane(tid >> 6), r = lane & 31, hh = lane >> 5;
    const f16* QI = (const f16*)(a.ws + WS_QI); const f16* KI = (const f16*)(a.ws + WS_KI); const float* WI = (const float*)(a.ws + WS_WI);
    u64* MASK = (u64*)(a.ws + WS_MASK);
    unsigned* hist = (unsigned*)(lds + 8 * IDX_KPITCH);
    f16x8 af[2][4]; f32x2 wv2[2][8];
#define IDX_LOAD_FRAGS(t0_) do { \
        _Pragma("unroll") for (int rt = 0; rt < 2; ++rt) { \
            _Pragma("unroll") for (int ks = 0; ks < 4; ++ks) af[rt][ks] = *(const f16x8*)(QI + ((((((size_t)((t0_) >> 3) * 2 + rt) * 4 + ks) * 2 + hh) * 32 + r) << 3)); \
            _Pragma("unroll") for (int qq = 0; qq < 2; ++qq) { const float* wp = WI + (size_t)((t0_) + 4 * rt + 2 * hh + qq) * 8; const f32x4 w0 = *(const f32x4*)wp * 0.125f, w1 = *(const f32x4*)(wp + 4) * 0.125f; \
                wv2[rt][4 * qq + 0] = (f32x2){w0[0], w0[1]}; wv2[rt][4 * qq + 1] = (f32x2){w0[2], w0[3]}; wv2[rt][4 * qq + 2] = (f32x2){w1[0], w1[1]}; wv2[rt][4 * qq + 3] = (f32x2){w1[2], w1[3]}; } \
        } } while (0)
    for (int round = 0; round * nb < 256; ++round) {
        const int p = round * nb + ((round & 1) ? (nb - 1 - bid) : bid);
        if (p < 256) { const int tg = p >> 3, b_ = p & 7, t0l = tg * 8, ch_ = t0l >> 6, t0_ = b_ * NS + t0l;
            if (tid < 8 * (ch_ + 1)) { const int q = tid / (ch_ + 1), w = tid % (ch_ + 1); MASK[((size_t)b_ * 128 + w) * NS + t0l + q] = ~0ull; } }
    }
#define IDX_P(round_) ((round_) * nb + (((round_) & 1) ? (nb - 1 - bid) : bid))
    int round = 0;
    while (round * nb < 8192 && !(IDX_P(round) >= 256 && IDX_P(round) < 8192)) ++round;
    if (round * nb < 8192) { const int p0 = IDX_P(round); IDX_LOAD_FRAGS((p0 & 7) * NS + (p0 >> 3) * 8); }
    for (; round * nb < 8192; ) {
        const int p = IDX_P(round);
        int rnext = round + 1;
        while (rnext * nb < 8192 && !(IDX_P(rnext) >= 256 && IDX_P(rnext) < 8192)) ++rnext;
        const bool has_next = rnext * nb < 8192;
        const int pn = has_next ? IDX_P(rnext) : p;
        const int tg = p >> 3, b = p & 7, t0l = tg * 8, ch = t0l >> 6, nadm = 64 * (ch + 1), t0 = b * NS + t0l;
        const int t0n = (pn & 7) * NS + (pn >> 3) * 8;
        round = has_next ? rnext : 8192;
        __syncthreads();
#pragma unroll
        for (int i = 0; i < 9; ++i) if (tid + i * NTHR < 8 * IDX_HPITCH) hist[tid + i * NTHR] = 0u;
        __syncthreads();
        const int nkb = nadm >> 5;
        const f16* kbase = KI + ((size_t)(b * (NS / 32)) * 8 + hh) * 256 + r * 8;
#define IDX_LOADB(dst, kb_) do { _Pragma("unroll") for (int ks = 0; ks < 4; ++ks) dst[ks] = *(const f16x8*)(kbase + ((size_t)(kb_) * 8 + 2 * ks) * 256); } while (0)
#define IDX_BLOCK(bfrag, kb_) do { \
            f32x16 acc[2]; \
            _Pragma("unroll") for (int rt = 0; rt < 2; ++rt) { acc[rt] = (f32x16){0.f, 0.f, 0.f, 0.f, 0.f, 0.f, 0.f, 0.f, 0.f, 0.f, 0.f, 0.f, 0.f, 0.f, 0.f, 0.f}; \
                _Pragma("unroll") for (int ks = 0; ks < 4; ++ks) acc[rt] = __builtin_amdgcn_mfma_f32_32x32x16_f16(af[rt][ks], bfrag[ks], acc[rt], 0, 0, 0); } \
            _Pragma("unroll") for (int rt = 0; rt < 2; ++rt) \
                _Pragma("unroll") for (int qq = 0; qq < 2; ++qq) { \
                    f32x2 t2 = (f32x2){0.f, 0.f}; \
                    _Pragma("unroll") for (int hp = 0; hp < 4; ++hp) { const f32x2 r2 = (f32x2){__int_as_float(max(__float_as_int(acc[rt][8 * qq + 2 * hp]), 0)), __int_as_float(max(__float_as_int(acc[rt][8 * qq + 2 * hp + 1]), 0))}; \
                        t2 = __builtin_elementwise_fma(wv2[rt][4 * qq + hp], r2, t2); } \
                    const float sc = t2[0] + t2[1]; \
                    const f16 sh = (f16)sc; const unsigned bits = (unsigned)__builtin_bit_cast(unsigned short, sh); \
                    const unsigned key = (bits & 0x8000u) ? (~bits & 0xFFFFu) : (bits | 0x8000u); \
                    const int q = 4 * rt + 2 * hh + qq; \
                    if (MODE != 2) *(u16*)(lds + q * IDX_KPITCH + ((kb_) * 32 + r) * 2) = (u16)key; \
                    if (MODE != 2 && MODE != 4) atomicAdd(&hist[q * IDX_HPITCH + (key >> 7)], (key & 64u) ? 0x10000u : 1u); \
                    if (MODE == 2) sink += key; \
                } } while (0)
        f16x8 bf0[4], bf1[4], bf2[4]; unsigned sink = 0u;
        if (wave >= 4) __builtin_amdgcn_s_sleep(5);
        if (wave < nkb) IDX_LOADB(bf0, wave);
        if (wave + 8 < nkb) IDX_LOADB(bf1, wave + 8);
        if (wave + 16 < nkb) IDX_LOADB(bf2, wave + 16);
        if (MODE != 3) for (int kb = wave; kb < nkb; kb += 24) {
            IDX_BLOCK(bf0, kb);
            if (kb + 24 < nkb) IDX_LOADB(bf0, kb + 24);
            if (kb + 8 < nkb) { IDX_BLOCK(bf1, kb + 8); if (kb + 32 < nkb) IDX_LOADB(bf1, kb + 32); }
            if (kb + 16 < nkb) { IDX_BLOCK(bf2, kb + 16); if (kb + 40 < nkb) IDX_LOADB(bf2, kb + 40); }
        }
#undef IDX_LOADB
#undef IDX_BLOCK
        if (MODE == 2 && sink == 0xdeadbeefu) hist[tid] = sink;
        IDX_LOAD_FRAGS(t0n);
        __syncthreads();
        if (MODE != 1) {
            unsigned* hw = hist + wave * IDX_HPITCH;
            const unsigned char* krow = lds + wave * IDX_KPITCH;
            unsigned rem1 = 0u, rem2 = 0u;
            int b1;
            {   const u32x4 d0 = *(const u32x4*)(hw + 8 * lane), d1 = *(const u32x4*)(hw + 8 * lane + 4);
                const unsigned dd[8] = {d0.x, d0.y, d0.z, d0.w, d1.x, d1.y, d1.z, d1.w};
                unsigned cc[16];
#pragma unroll
                for (int j = 0; j < 8; ++j) { cc[2 * j] = dd[j] & 0xFFFFu; cc[2 * j + 1] = dd[j] >> 16; }
                b1 = wave_pick<16>(cc, 256u, lane, rem1); }
            hw[lane] = 0u;
            const int nit = (nadm + 511) >> 9;
            for (int it = 0; it < nit; ++it) {
                const int idx = (it * 64 + lane) * 8;
                if (idx < nadm) { const u32x4 k4 = *(const u32x4*)(krow + idx * 2);
                    const unsigned kk[4] = {k4.x, k4.y, k4.z, k4.w};
                    unsigned hit = 0u;
#pragma unroll
                    for (int j = 0; j < 4; ++j) { hit |= (((kk[j] & 0xFFFFu) >> 6) == (unsigned)b1 ? 1u : 0u) << (2 * j); hit |= ((kk[j] >> 22) == (unsigned)b1 ? 1u : 0u) << (2 * j + 1); }
                    if (hit) {
#pragma unroll
                        for (int j = 0; j < 4; ++j) { const unsigned k0 = kk[j] & 0xFFFFu, k1 = kk[j] >> 16;
                            if (hit & (1u << (2 * j))) atomicAdd(&hw[k0 & 63u], 1u);
                            if (hit & (2u << (2 * j))) atomicAdd(&hw[k1 & 63u], 1u); }
                    } }
            }
            int b2;
            { const unsigned c1[1] = {hw[lane]}; b2 = wave_pick<1>(c1, rem1, lane, rem2); }
            const unsigned tau = ((unsigned)b1 << 6) | (unsigned)b2;
            const size_t mrow = (size_t)(t0 + wave) * 128;
            for (int it = 0; it < nit; ++it) {
                const int idx = (it * 64 + lane) * 8;
                unsigned byte = 0u;
                if (idx < nadm) { const u32x4 k4 = *(const u32x4*)(krow + idx * 2);
                    const unsigned kk[4] = {k4.x, k4.y, k4.z, k4.w};
#pragma unroll
                    for (int j = 0; j < 4; ++j) { byte |= ((kk[j] & 0xFFFFu) >= tau ? 1u : 0u) << (2 * j); byte |= ((kk[j] >> 16) >= tau ? 1u : 0u) << (2 * j + 1); } }
                unsigned lo = (lane & 4) ? 0u : (byte << (8 * (lane & 3))), hi = (lane & 4) ? (byte << (8 * (lane & 3))) : 0u;
                lo |= __shfl_xor(lo, 1); hi |= __shfl_xor(hi, 1); lo |= __shfl_xor(lo, 2); hi |= __shfl_xor(hi, 2); lo |= __shfl_xor(lo, 4); hi |= __shfl_xor(hi, 4);
                if ((lane & 7) == 0 && idx < nadm) { hw[64 + 2 * (it * 8 + (lane >> 3))] = lo; hw[64 + 2 * (it * 8 + (lane >> 3)) + 1] = hi; }
            }
        }
        __syncthreads();
        if (MODE != 1) { const int w = tid >> 2, qp = tid & 3;
            if (w <= ch) { const unsigned* ha = hist + (2 * qp) * IDX_HPITCH + 64 + 2 * w; const unsigned* hb = ha + IDX_HPITCH;
                *(u32x4*)(MASK + ((size_t)b * 128 + w) * NS + t0l + 2 * qp) = (u32x4){ha[0], ha[1], hb[0], hb[1]}; } }
    }
    __syncthreads();
}

constexpr int ATP = 144;
constexpr int ATT_QWORD = 3584 + 32 * 64;
template <int AMODE>
__device__ __forceinline__ void ph4_attn_fast(const Args& a, int bid, int nb, unsigned char* lds) {
    int tid = threadIdx.x; asm volatile("" : "+v"(tid));
    const int lane = tid & 63, wave = __builtin_amdgcn_readfirstlane(tid >> 6), r = lane & 31, hh = lane >> 5;
    const f16* Q = (const f16*)(a.ws + WS_Q); const f16* Kk = (const f16*)(a.ws + WS_K); const f16* VT = (const f16*)(a.ws + WS_VT);
    const u64* MASK = (const u64*)(a.ws + WS_MASK); f16* MIX = (f16*)(a.ws + WS_H); const float* og = a.in[11];
    unsigned char* Kl = lds; unsigned char* Vl = lds + 2 * 64 * ATP;
    const float LOG2E = 1.4426950408889634f, OFF = 8192.f;
    const int pir = 16 * (r >> 4) + 8 * ((r >> 2) & 1) + 4 * ((r >> 3) & 1) + (r & 3);
    const int srow = tid >> 3, schk = tid & 7;
    unsigned* aq = (unsigned*)(a.ws + WS_CTL) + ATT_QWORD;
    volatile unsigned* ucell = (volatile unsigned*)(lds + 6 * 64 * ATP);
    volatile unsigned* dflag = ucell + 8;
    const float kmax = __int_as_float(__builtin_amdgcn_readfirstlane(__float_as_int(1.01f * 8.f * wave_max(fabsf(a.in[10][lane])))));
    int upar = 0;
    for (;;) {
        if (tid == 0) ucell[upar] = __hip_atomic_fetch_add(aq, 1u, __ATOMIC_RELAXED, __HIP_MEMORY_SCOPE_AGENT);
        if (tid < 8) dflag[tid] = 0u;
        __syncthreads();
        const unsigned u = ucell[upar]; upar ^= 1;
        if (u >= 2048u) break;
        const int h = 7 - (int)(u >> 8), qb = 31 - (int)((u & 255u) >> 3), b = (int)(u & 7u);
        const int q0l = qb * 256, tq = q0l + 32 * wave + r, cw = 4 * qb + (wave >> 1), top = 4 * qb + 3;
        const size_t t = (size_t)b * NS + tq;
        const float slope = exp2f(-(float)(h + 1)) * LOG2E;
        f16x8 qf[4];
#pragma unroll
        for (int ks = 0; ks < 4; ++ks) { const f16x8 qv = *(const f16x8*)(Q + t * 512 + h * 64 + 16 * ks + 8 * hh);
#pragma unroll
            for (int j = 0; j < 8; ++j) qf[ks][j] = (f16)((float)qv[j] * (0.125f * LOG2E)); }
        float qss = 0.f;
#pragma unroll
        for (int ks = 0; ks < 4; ++ks)
#pragma unroll
            for (int j = 0; j < 8; ++j) qss += (float)qf[ks][j] * (float)qf[ks][j];
        qss += __shfl_xor(qss, 32);
        const float Sb = __int_as_float(__builtin_amdgcn_readfirstlane(__float_as_int(wave_max(sqrtf(qss)) * kmax)));
        const float rowc = OFF + slope * (float)(tq - q0l);
        float m = 1000.f, l = 0.f;
        f32x16 O[2];
#pragma unroll
        for (int dt = 0; dt < 2; ++dt) O[dt] = (f32x16){0.f, 0.f, 0.f, 0.f, 0.f, 0.f, 0.f, 0.f, 0.f, 0.f, 0.f, 0.f, 0.f, 0.f, 0.f, 0.f};
        const f16* kg = Kk + ((size_t)b * NS + srow) * 512 + h * 64 + schk * 8;
        const f16* vg = VT + (size_t)(h * 64 + srow) * NT + (size_t)b * NS + schk * 8;
        f16x8 kr0, kr1, vr0, vr1; u64 mw0 = 0ull, mw1 = 0ull;
#define ATT_LOAD(kr, vr, mwv, jj) do { if ((jj) >= 0) { kr = *(const f16x8*)(kg + (size_t)(jj) * 64 * 512); vr = *(const f16x8*)(vg + (jj) * 64); mwv = ((jj) <= cw) ? MASK[((size_t)b * 128 + (jj)) * NS + tq] : 0ull; } } while (0)
        ATT_LOAD(kr0, vr0, mw0, top); ATT_LOAD(kr1, vr1, mw1, top - 1);
        int buf = 0; bool wdone = false, stop = false;
        auto step = [&](f16x8& kreg, f16x8& vreg, u64& mwr, const int j) {
            *(f16x8*)(Kl + buf * 64 * ATP + srow * ATP + schk * 16) = kreg;
            *(f16x8*)(Vl + buf * 64 * ATP + srow * ATP + schk * 16) = vreg;
            const u64 mw = mwr;
            asm volatile("s_waitcnt lgkmcnt(0)" ::: "memory"); __builtin_amdgcn_s_barrier(); asm volatile("" ::: "memory");
            {
                const unsigned jp = (unsigned)(j + 1);
                if ((dflag[0] > jp) & (dflag[1] > jp) & (dflag[2] > jp) & (dflag[3] > jp) & (dflag[4] > jp) & (dflag[5] > jp) & (dflag[6] > jp) & (dflag[7] > jp)) { stop = true; return; }
            }
            ATT_LOAD(kreg, vreg, mwr, j - 2);
            if (!wdone && j < cw) { const float lmax = Sb + OFF + slope * (float)(64 * j + 63 - q0l); if (__all(lmax - m < -28.f)) { wdone = true; if (lane == 0) dflag[wave] = (unsigned)(j + 1); } }
            if (j <= cw && !wdone) {
                const unsigned char* kb_ = Kl + buf * 64 * ATP + pir * ATP + 16 * hh;
                f16x8 fr8[8];
#pragma unroll
                for (int kt = 0; kt < 2; ++kt)
#pragma unroll
                    for (int ks = 0; ks < 4; ++ks) fr8[kt * 4 + ks] = *(const f16x8*)(kb_ + kt * 32 * ATP + ks * 32);
                f32x16 sa[2];
                if (j == cw) {
#pragma unroll
                    for (int kt = 0; kt < 2; ++kt)
#pragma unroll
                        for (int rg = 0; rg < 16; ++rg) { const float x = (float)(64 * j + 32 * kt + 16 * (rg >> 3) + 8 * hh + (rg & 7) - tq); sa[kt][rg] = rowc - slope * fabsf(x); }
                } else {
                    const float base = OFF + slope * (float)(64 * j + 8 * hh - q0l);
#pragma unroll
                    for (int kt = 0; kt < 2; ++kt)
#pragma unroll
                        for (int rg = 0; rg < 16; ++rg) sa[kt][rg] = __builtin_fmaf(slope, (float)(32 * kt + 16 * (rg >> 3) + (rg & 7)), base);
                }
                __builtin_amdgcn_sched_barrier(0);
                __builtin_amdgcn_s_setprio(1);
#pragma unroll
                for (int kt = 0; kt < 2; ++kt)
#pragma unroll
                    for (int ks = 0; ks < 4; ++ks) sa[kt] = __builtin_amdgcn_mfma_f32_32x32x16_f16(fr8[kt * 4 + ks], qf[ks], sa[kt], 0, 0, 0);
                __builtin_amdgcn_s_setprio(0);
                __builtin_amdgcn_sched_barrier(0);
                const unsigned char* vb_ = Vl + buf * 64 * ATP + r * ATP + 16 * hh;
#pragma unroll
                for (int dt = 0; dt < 2; ++dt)
#pragma unroll
                    for (int kt = 0; kt < 2; ++kt)
#pragma unroll
                        for (int s2 = 0; s2 < 2; ++s2) fr8[dt * 4 + kt * 2 + s2] = *(const f16x8*)(vb_ + dt * 32 * ATP + kt * 64 + s2 * 32);
                __builtin_amdgcn_sched_barrier(0);
                float rm = 0.f;
#pragma unroll
                for (int kt = 0; kt < 2; ++kt) { const unsigned w32 = (unsigned)(kt ? (mw >> 32) : mw) >> (8 * hh);
#pragma unroll
                    for (int rg = 0; rg < 16; ++rg) { const int tm = __builtin_amdgcn_sbfe((int)w32, 16 * (rg >> 3) + (rg & 7), 1);
                        const float L = __int_as_float(__float_as_int(sa[kt][rg]) & tm); sa[kt][rg] = L; rm = fmaxf(rm, L); } }
                rm = fmaxf(rm, __shfl_xor(rm, 32));
                const float mn = fmaxf(m, rm);
                if (__any(mn > m)) { const float al = __builtin_amdgcn_exp2f(m - mn); l *= al;
#pragma unroll
                    for (int dt = 0; dt < 2; ++dt)
#pragma unroll
                        for (int rg = 0; rg < 16; ++rg) O[dt][rg] *= al; }
                m = mn;
                f16x8 pf[2][2];
                float l0 = 0.f, l1 = 0.f;
#pragma unroll
                for (int kt = 0; kt < 2; ++kt)
#pragma unroll
                    for (int rg = 0; rg < 16; ++rg) { const float pp = __builtin_amdgcn_exp2f(sa[kt][rg] - m); if (rg & 1) l1 += pp; else l0 += pp; pf[kt][rg >> 3][rg & 7] = (f16)pp; }
                l += l0 + l1;
                __builtin_amdgcn_sched_barrier(0);
                __builtin_amdgcn_s_setprio(1);
#pragma unroll
                for (int dt = 0; dt < 2; ++dt)
#pragma unroll
                    for (int kt = 0; kt < 2; ++kt)
#pragma unroll
                        for (int s2 = 0; s2 < 2; ++s2) O[dt] = __builtin_amdgcn_mfma_f32_32x32x16_f16(fr8[dt * 4 + kt * 2 + s2], pf[kt][s2], O[dt], 0, 0, 0);
                __builtin_amdgcn_s_setprio(0);
            }
            buf ^= 1;
        };
        for (int j = top; j >= 0; j -= 2) {
            step(kr0, vr0, mw0, j); if (stop) break;
            if (j - 1 >= 0) { step(kr1, vr1, mw1, j - 1); if (stop) break; }
        }
#undef ATT_LOAD
        l += __shfl_xor(l, 32);
        const float inv = 1.f / l;
        float ss = 0.f;
#pragma unroll
        for (int dt = 0; dt < 2; ++dt)
#pragma unroll
            for (int rg = 0; rg < 16; ++rg) { O[dt][rg] *= inv; ss += O[dt][rg] * O[dt][rg]; }
        ss += __shfl_xor(ss, 32);
        const float rstd = rsqrtf(ss * (1.f / 64.f) + EPS);
#pragma unroll
        for (int dt = 0; dt < 2; ++dt)
#pragma unroll
            for (int g4 = 0; g4 < 4; ++g4) { const int d = 32 * dt + 8 * g4 + 4 * hh; const f32x4 gg = *(const f32x4*)(og + h * 64 + d);
                f16x4 o4; o4.x = (f16)(O[dt][4 * g4 + 0] * rstd * gg.x); o4.y = (f16)(O[dt][4 * g4 + 1] * rstd * gg.y); o4.z = (f16)(O[dt][4 * g4 + 2] * rstd * gg.z); o4.w = (f16)(O[dt][4 * g4 + 3] * rstd * gg.w);
                *(f16x4*)(MIX + t * ND + 512 + h * 64 + d) = o4; }
        __syncthreads();
    }
}

__device__ __forceinline__ void ph5_outproj(const Args& a, int bid, int nb, unsigned char* lds) {
    pg8::Gemm g{(const f16*)(a.ws + WS_H), (const f16*)(a.ws + WS_WOUT), NT, 1024, ND}; pg8::StaticOrder S; S.init(NT, 1024, nb, bid);
    pg8::EpiOut E{a.in[0], (const float*)(a.ws + WS_MOD), (f16*)(a.ws + WS_X1)};
    pg8::gemm_phase((PG8_LAS unsigned char*)lds, g, S, E);
}

__device__ __forceinline__ void ph7_peerq(const Args& a, int bid, int nb, unsigned char* lds) {
    pg8::Gemm g{(const f16*)(a.ws + WS_HQ), (const f16*)(a.ws + WS_WQ8), NT, 2048, ND / 2}; pg8::StaticOrder S; S.init(NT, 2048, nb, bid);
    pg8::EpiPQ E{(f16*)(a.ws + WS_PQ), (const float*)(a.ws + WS_HSC), (const float*)(a.ws + WS_WSC)};
    pg8::gemm_phase<pg8::EpiPQ, true>((PG8_LAS unsigned char*)lds, g, S, E);
}


__device__ __forceinline__ unsigned f2skey(float f) { const unsigned u = __float_as_uint(f); return (u & 0x80000000u) ? ~u : (u | 0x80000000u); }
__device__ __forceinline__ float skey2f(unsigned k) { return __uint_as_float((k & 0x80000000u) ? (k & 0x7FFFFFFFu) : ~k); }
#define CE_(a_, b_) do { const unsigned t__ = max(a_, b_); b_ = min(a_, b_); a_ = t__; } while (0)
#define SORT16_DESC(v) do { CE_(v[0], v[1]); CE_(v[2], v[3]); CE_(v[0], v[2]); CE_(v[1], v[3]); CE_(v[1], v[2]); CE_(v[4], v[5]); CE_(v[6], v[7]); CE_(v[4], v[6]); CE_(v[5], v[7]); CE_(v[5], v[6]); CE_(v[0], v[4]); CE_(v[2], v[6]); CE_(v[2], v[4]); CE_(v[1], v[5]); CE_(v[3], v[7]); CE_(v[3], v[5]); CE_(v[1], v[2]); CE_(v[3], v[4]); CE_(v[5], v[6]); CE_(v[8], v[9]); CE_(v[10], v[11]); CE_(v[8], v[10]); CE_(v[9], v[11]); CE_(v[9], v[10]); CE_(v[12], v[13]); CE_(v[14], v[15]); CE_(v[12], v[14]); CE_(v[13], v[15]); CE_(v[13], v[14]); CE_(v[8], v[12]); CE_(v[10], v[14]); CE_(v[10], v[12]); CE_(v[9], v[13]); CE_(v[11], v[15]); CE_(v[11], v[13]); CE_(v[9], v[10]); CE_(v[11], v[12]); CE_(v[13], v[14]); CE_(v[0], v[8]); CE_(v[4], v[12]); CE_(v[4], v[8]); CE_(v[2], v[10]); CE_(v[6], v[14]); CE_(v[6], v[10]); CE_(v[2], v[4]); CE_(v[6], v[8]); CE_(v[10], v[12]); CE_(v[1], v[9]); CE_(v[5], v[13]); CE_(v[5], v[9]); CE_(v[3], v[11]); CE_(v[7], v[15]); CE_(v[7], v[11]); CE_(v[3], v[5]); CE_(v[7], v[9]); CE_(v[11], v[13]); CE_(v[1], v[2]); CE_(v[3], v[4]); CE_(v[5], v[6]); CE_(v[7], v[8]); CE_(v[9], v[10]); CE_(v[11], v[12]); CE_(v[13], v[14]); } while (0)
#define BITONIC16_DESC(v) do { CE_(v[0], v[8]); CE_(v[1], v[9]); CE_(v[2], v[10]); CE_(v[3], v[11]); CE_(v[4], v[12]); CE_(v[5], v[13]); CE_(v[6], v[14]); CE_(v[7], v[15]); CE_(v[0], v[4]); CE_(v[1], v[5]); CE_(v[2], v[6]); CE_(v[3], v[7]); CE_(v[8], v[12]); CE_(v[9], v[13]); CE_(v[10], v[14]); CE_(v[11], v[15]); CE_(v[0], v[2]); CE_(v[1], v[3]); CE_(v[4], v[6]); CE_(v[5], v[7]); CE_(v[8], v[10]); CE_(v[9], v[11]); CE_(v[12], v[14]); CE_(v[13], v[15]); CE_(v[0], v[1]); CE_(v[2], v[3]); CE_(v[4], v[5]); CE_(v[6], v[7]); CE_(v[8], v[9]); CE_(v[10], v[11]); CE_(v[12], v[13]); CE_(v[14], v[15]); } while (0)
#define MERGE16_DESC(dst, other) do { unsigned c__[16]; _Pragma("unroll") for (int i__ = 0; i__ < 16; ++i__) c__[i__] = max(dst[i__], other[15 - i__]); BITONIC16_DESC(c__); _Pragma("unroll") for (int i__ = 0; i__ < 16; ++i__) dst[i__] = c__[i__]; } while (0)
#define TOP16_INSERT(v, x_) do { unsigned x__ = (x_); _Pragma("unroll") for (int k_ = 0; k_ < 16; ++k_) { const unsigned t__ = max(v[k_], x__); x__ = min(v[k_], x__); v[k_] = t__; } } while (0)
__device__ __forceinline__ void ph8_peersel_fast(const Args& a, int bid, int nb, unsigned char* lds) {
    int tid = threadIdx.x; asm volatile("" : "+v"(tid));
    const int lane = tid & 63, wave = __builtin_amdgcn_readfirstlane(tid >> 6), r = lane & 31, hh = lane >> 5;
    const f16* PQ = (const f16*)(a.ws + WS_PQ);
    u16* EID = (u16*)(a.ws + WS_EID); float* GW = (float*)(a.ws + WS_GW);
    unsigned char* wl = lds + wave * 2048 + lane * 32;
    for (int item = bid * NWAVE + wave; item < (NT / 32) * 8; item += nb * NWAVE) {
        const int tt = item >> 3, h = item & 7, t0 = tt * 32;
        unsigned top[2][16];
#pragma unroll
        for (int p = 0; p < 2; ++p) {
            f16x8 sq[8];
#pragma unroll
            for (int c = 0; c < 8; ++c) sq[c] = *(const f16x8*)(PQ + ((((size_t)tt * 256 + h * 32 + p * 16 + 8 * hh + c) * 32 + r) << 3));
#pragma unroll
            for (int k = 0; k < 16; ++k) top[p][k] = 0u;
#pragma unroll
            for (int g = 0; g < 4; ++g) {
                unsigned ky[16];
#pragma unroll
                for (int i = 0; i < 16; ++i) { const unsigned n = 64u * hh + 16u * g + i; ky[i] = (f2skey((float)sq[2 * g + (i >> 3)][i & 7]) & ~127u) | n; }
                SORT16_DESC(ky); MERGE16_DESC(top[p], ky);
            }
            unsigned oth[16];
#pragma unroll
            for (int k = 0; k < 16; ++k) oth[k] = __shfl_xor(top[p][k], 32);
            MERGE16_DESC(top[p], oth);
            asm volatile("" ::: "memory");
        }
#pragma unroll
        for (int k = 0; k < 16; k += 4) {
            *(unsigned*)(wl + k) = (top[0][k] & 127u) | ((top[0][k + 1] & 127u) << 8) | ((top[0][k + 2] & 127u) << 16) | ((top[0][k + 3] & 127u) << 24);
            *(unsigned*)(wl + 16 + k) = (top[1][k] & 127u) | ((top[1][k + 1] & 127u) << 8) | ((top[1][k + 2] & 127u) << 16) | ((top[1][k + 3] & 127u) << 24);
        }
        float fa[16], fb[16];
#pragma unroll
        for (int k = 0; k < 16; ++k) { fa[k] = skey2f(top[0][k] & ~127u); fb[k] = skey2f(top[1][k] & ~127u); }
        unsigned cg[4][16];
        cg[0][0] = (f2skey(fa[0] + fb[0]) & ~255u) | 0u;
        cg[0][1] = (f2skey(fa[0] + fb[1]) & ~255u) | 1u;
        cg[0][2] = (f2skey(fa[0] + fb[2]) & ~255u) | 2u;
        cg[0][3] = (f2skey(fa[0] + fb[3]) & ~255u) | 3u;
        cg[0][4] = (f2skey(fa[0] + fb[4]) & ~255u) | 4u;
        cg[0][5] = (f2skey(fa[0] + fb[5]) & ~255u) | 5u;
        cg[0][6] = (f2skey(fa[0] + fb[6]) & ~255u) | 6u;
        cg[0][7] = (f2skey(fa[0] + fb[7]) & ~255u) | 7u;
        cg[0][8] = (f2skey(fa[0] + fb[8]) & ~255u) | 8u;
        cg[0][9] = (f2skey(fa[0] + fb[9]) & ~255u) | 9u;
        cg[0][10] = (f2skey(fa[0] + fb[10]) & ~255u) | 10u;
        cg[0][11] = (f2skey(fa[0] + fb[11]) & ~255u) | 11u;
        cg[0][12] = (f2skey(fa[0] + fb[12]) & ~255u) | 12u;
        cg[0][13] = (f2skey(fa[0] + fb[13]) & ~255u) | 13u;
        cg[0][14] = (f2skey(fa[0] + fb[14]) & ~255u) | 14u;
        cg[0][15] = (f2skey(fa[0] + fb[15]) & ~255u) | 15u;
        cg[1][0] = (f2skey(fa[1] + fb[0]) & ~255u) | 16u;
        cg[1][1] = (f2skey(fa[1] + fb[1]) & ~255u) | 17u;
        cg[1][2] = (f2skey(fa[1] + fb[2]) & ~255u) | 18u;
        cg[1][3] = (f2skey(fa[1] + fb[3]) & ~255u) | 19u;
        cg[1][4] = (f2skey(fa[1] + fb[4]) & ~255u) | 20u;
        cg[1][5] = (f2skey(fa[1] + fb[5]) & ~255u) | 21u;
        cg[1][6] = (f2skey(fa[1] + fb[6]) & ~255u) | 22u;
        cg[1][7] = (f2skey(fa[1] + fb[7]) & ~255u) | 23u;
        cg[1][8] = (f2skey(fa[2] + fb[0]) & ~255u) | 32u;
        cg[1][9] = (f2skey(fa[2] + fb[1]) & ~255u) | 33u;
        cg[1][10] = (f2skey(fa[2] + fb[2]) & ~255u) | 34u;
        cg[1][11] = (f2skey(fa[2] + fb[3]) & ~255u) | 35u;
        cg[1][12] = (f2skey(fa[2] + fb[4]) & ~255u) | 36u;
        cg[1][13] = (f2skey(fa[3] + fb[0]) & ~255u) | 48u;
        cg[1][14] = (f2skey(fa[3] + fb[1]) & ~255u) | 49u;
        cg[1][15] = (f2skey(fa[3] + fb[2]) & ~255u) | 50u;
        cg[2][0] = (f2skey(fa[3] + fb[3]) & ~255u) | 51u;
        cg[2][1] = (f2skey(fa[4] + fb[0]) & ~255u) | 64u;
        cg[2][2] = (f2skey(fa[4] + fb[1]) & ~255u) | 65u;
        cg[2][3] = (f2skey(fa[4] + fb[2]) & ~255u) | 66u;
        cg[2][4] = (f2skey(fa[5] + fb[0]) & ~255u) | 80u;
        cg[2][5] = (f2skey(fa[5] + fb[1]) & ~255u) | 81u;
        cg[2][6] = (f2skey(fa[6] + fb[0]) & ~255u) | 96u;
        cg[2][7] = (f2skey(fa[6] + fb[1]) & ~255u) | 97u;
        cg[2][8] = (f2skey(fa[7] + fb[0]) & ~255u) | 112u;
        cg[2][9] = (f2skey(fa[7] + fb[1]) & ~255u) | 113u;
        cg[2][10] = (f2skey(fa[8] + fb[0]) & ~255u) | 128u;
        cg[2][11] = (f2skey(fa[9] + fb[0]) & ~255u) | 144u;
        cg[2][12] = (f2skey(fa[10] + fb[0]) & ~255u) | 160u;
        cg[2][13] = (f2skey(fa[11] + fb[0]) & ~255u) | 176u;
        cg[2][14] = (f2skey(fa[12] + fb[0]) & ~255u) | 192u;
        cg[2][15] = (f2skey(fa[13] + fb[0]) & ~255u) | 208u;
        cg[3][0] = (f2skey(fa[14] + fb[0]) & ~255u) | 224u;
        cg[3][1] = (f2skey(fa[15] + fb[0]) & ~255u) | 240u;
        cg[3][2] = 0u;
        cg[3][3] = 0u;
        cg[3][4] = 0u;
        cg[3][5] = 0u;
        cg[3][6] = 0u;
        cg[3][7] = 0u;
        cg[3][8] = 0u;
        cg[3][9] = 0u;
        cg[3][10] = 0u;
        cg[3][11] = 0u;
        cg[3][12] = 0u;
        cg[3][13] = 0u;
        cg[3][14] = 0u;
        cg[3][15] = 0u;
        SORT16_DESC(cg[0]); SORT16_DESC(cg[1]); SORT16_DESC(cg[2]); SORT16_DESC(cg[3]);
        MERGE16_DESC(cg[0], cg[1]); MERGE16_DESC(cg[2], cg[3]); MERGE16_DESC(cg[0], cg[2]);
        unsigned ct[16];
#pragma unroll
        for (int k = 0; k < 16; ++k) ct[k] = cg[0][k];
        float sc[16]; float den = 0.f; const float s0 = skey2f(ct[0] & ~255u);
#pragma unroll
        for (int k = 0; k < 16; ++k) { sc[k] = __expf(skey2f(ct[k] & ~255u) - s0); den += sc[k]; }
        const float inv = 1.f / den;
        if (hh == 0) {
            u16 ev[16];
#pragma unroll
            for (int k = 0; k < 16; ++k) { const unsigned ij = ct[k] & 255u; const unsigned i1 = wl[ij >> 4], i2 = wl[16 + (ij & 15u)]; ev[k] = (u16)(i1 * 128u + i2); }
            const size_t o = (size_t)(t0 + r) * 128 + h * 16;
#pragma unroll
            for (int k = 0; k < 16; k += 8) {
                *(u32x4*)(EID + o + k) = (u32x4){(unsigned)ev[k] | ((unsigned)ev[k + 1] << 16), (unsigned)ev[k + 2] | ((unsigned)ev[k + 3] << 16), (unsigned)ev[k + 4] | ((unsigned)ev[k + 5] << 16), (unsigned)ev[k + 6] | ((unsigned)ev[k + 7] << 16)};
            }
#pragma unroll
            for (int k = 0; k < 16; k += 4) *(f32x4*)(GW + o + k) = (f32x4){sc[k] * inv, sc[k + 1] * inv, sc[k + 2] * inv, sc[k + 3] * inv};
        }
    }
}

typedef _Float16 f16x2 __attribute__((ext_vector_type(2)));
__device__ __forceinline__ float gelu_erf(float d) { return 0.5f * d * (1.f + erff(d * 0.70710678118654752f)); }
constexpr int PQ_WORD0 = 3584, PQ_CHUNK = 64, PQ_NCHUNK = NT / PQ_CHUNK, PQ_HALF = PQ_NCHUNK / 2;
constexpr size_t WS_PART = 208 * MiB;
__device__ __forceinline__ unsigned xcc_id_() { return (unsigned)__builtin_amdgcn_s_getreg((3 << 11) | 20) & 7u; }
template <int VPHASE>
__device__ __forceinline__ void ph9_sliced(const Args& a, unsigned char* lds) {
    int tid_ = threadIdx.x; asm volatile("" : "+v"(tid_)); const int lane = tid_ & 63, wave = __builtin_amdgcn_readfirstlane(tid_ >> 6);
    const int g8 = lane >> 3, c8 = lane & 7;
    const unsigned char* HP = a.ws + WS_HP; const float* HSC = (const float*)(a.ws + WS_HSC); const unsigned char* TAB = a.ws + (VPHASE ? WS_VP : WS_UT);
    const u16* EID = (const u16*)(a.ws + WS_EID); const unsigned* GW = (const unsigned*)(a.ws + WS_GW); float* PART = (float*)(a.ws + WS_PART); const float* WSUM = (const float*)(a.ws + WS_WSUM);
    const float* mod = (const float*)(a.ws + WS_MOD); float* out = a.out; const f16* X1 = (const f16*)(a.ws + WS_X1);
    unsigned* qw = (unsigned*)(a.ws + WS_CTL) + PQ_WORD0 + (VPHASE ? 8 * 64 : 0);
    volatile unsigned* cslot = (volatile unsigned*)lds;
    const bool b5 = (lane & 32) != 0, b4 = (lane & 16) != 0, b3 = (lane & 8) != 0, b2 = (lane & 4) != 0, b1 = (lane & 2) != 0, b0 = (lane & 1) != 0;
    const unsigned x0 = xcc_id_();
    int par = 0;
    for (int k = 0; k < 8; ++k) {
        const unsigned qi_ = (x0 + (unsigned)k) & 7u, sl = qi_ & 3u, half = qi_ >> 2;
        unsigned cur = 0u;
        if (tid_ == 0) cur = __hip_atomic_fetch_add(qw + 64 * qi_, 1u, __ATOMIC_RELAXED, __HIP_MEMORY_SCOPE_AGENT);
        for (;;) {
            if (tid_ == 0) cslot[par] = cur;
            __syncthreads();
            const unsigned c = cslot[par]; par ^= 1;
            if (c >= (unsigned)PQ_HALF) break;
            if (tid_ == 0) cur = __hip_atomic_fetch_add(qw + 64 * qi_, 1u, __ATOMIC_RELAXED, __HIP_MEMORY_SCOPE_AGENT);
            const int tb = (int)(half * PQ_HALF + c) * PQ_CHUNK + wave * (PQ_CHUNK / NWAVE);
            const unsigned char* tsl = TAB + 128 * sl + 16 * c8;
#pragma unroll 1
            for (int i8 = 0; i8 < PQ_CHUNK / NWAVE; ++i8) {
                const int t = tb + i8;
                const u32x4 e0 = *(const u32x4*)(EID + (size_t)t * 128 + 16 * g8), e1 = *(const u32x4*)(EID + (size_t)t * 128 + 16 * g8 + 8);
                const unsigned ew[8] = {e0.x, e0.y, e0.z, e0.w, e1.x, e1.y, e1.z, e1.w};
                u32x4 r8[16];
#pragma unroll
                for (int i = 0; i < 16; ++i) { const unsigned eid = (i & 1) ? (ew[i >> 1] >> 16) : (ew[i >> 1] & 0xFFFFu); r8[i] = *(const u32x4*)(tsl + (size_t)eid * 512); }
                if (!VPHASE) {
                    const u32x4 hh4 = *(const u32x4*)(HP + (size_t)t * 1024 + 128 * sl + 16 * c8), hl4 = *(const u32x4*)(HP + (size_t)t * 1024 + 512 + 128 * sl + 16 * c8);
                    const float hsc = 0.5f * HSC[t];
                    int hs1 = 0, hs0 = 0;
#pragma unroll
                    for (int j = 0; j < 4; ++j) { hs1 = __builtin_amdgcn_sdot8((int)hh4[j], 0x11111111, hs1, false); hs0 = __builtin_amdgcn_sdot8((int)hl4[j], 0x11111111, hs0, false); }
                    const int hsum = 16 * hs1 + hs0;
                    float p[16];
#pragma unroll
                    for (int i = 0; i < 16; ++i) { int d1 = 0, d0 = 0;
#pragma unroll
                        for (int j = 0; j < 4; ++j) { d1 = __builtin_amdgcn_sdot8((int)hh4[j], (int)r8[i][j], d1, false); d0 = __builtin_amdgcn_sdot8((int)hl4[j], (int)r8[i][j], d0, false); }
                        p[i] = (float)(2 * (16 * d1 + d0) + hsum); }
                    float q8[8], q4[4], r2[2];
#pragma unroll
                    for (int ii = 0; ii < 8; ++ii) { const float keep = b2 ? p[8 + ii] : p[ii], send = b2 ? p[ii] : p[8 + ii]; q8[ii] = keep + __shfl_xor(send, 4); }
#pragma unroll
                    for (int ii = 0; ii < 4; ++ii) { const float keep = b1 ? q8[4 + ii] : q8[ii], send = b1 ? q8[ii] : q8[4 + ii]; q4[ii] = keep + __shfl_xor(send, 2); }
#pragma unroll
                    for (int ii = 0; ii < 2; ++ii) { const float keep = b0 ? q4[2 + ii] : q4[ii], send = b0 ? q4[ii] : q4[2 + ii]; r2[ii] = keep + __shfl_xor(send, 1); }
                    *(f32x2*)(PART + ((size_t)sl * NT + t) * 128 + 16 * g8 + 2 * c8) = (f32x2){r2[0] * hsc, r2[1] * hsc};
                } else {
                    const u32x4* wp = (const u32x4*)(GW + (size_t)t * 128 + 16 * g8);
                    const u32x4 wq0 = wp[0], wq1 = wp[1], wq2 = wp[2], wq3 = wp[3];
                    const unsigned wv[16] = {wq0[0], wq0[1], wq0[2], wq0[3], wq1[0], wq1[1], wq1[2], wq1[3], wq2[0], wq2[1], wq2[2], wq2[3], wq3[0], wq3[1], wq3[2], wq3[3]};
                    const f16 off = (f16)(-7.5f * 5.9604644775390625e-08f * WSUM[(size_t)t * 8 + g8]);
                    f16x2 acc2[16];
#pragma unroll
                    for (int j = 0; j < 16; ++j) acc2[j] = (f16x2){off, off};
#pragma unroll
                    for (int i = 0; i < 16; ++i) { const f16x2 wa = __builtin_bit_cast(f16x2, wv[i]); const f16x2 wb = wa * (f16x2){(f16)0.0625f, (f16)0.0625f};
#pragma unroll
                        for (int j = 0; j < 4; ++j) { const unsigned x = r8[i][j], y = x >> 8;
                            acc2[4 * j]     = __builtin_elementwise_fma(wa, __builtin_bit_cast(f16x2, x & 0x000F000Fu), acc2[4 * j]);
                            acc2[4 * j + 1] = __builtin_elementwise_fma(wb, __builtin_bit_cast(f16x2, x & 0x00F000F0u), acc2[4 * j + 1]);
                            acc2[4 * j + 2] = __builtin_elementwise_fma(wa, __builtin_bit_cast(f16x2, y & 0x000F000Fu), acc2[4 * j + 2]);
                            acc2[4 * j + 3] = __builtin_elementwise_fma(wb, __builtin_bit_cast(f16x2, y & 0x00F000F0u), acc2[4 * j + 3]); } }
                    unsigned q8[8], q4[4], r2[2];
#pragma unroll
                    for (int ii = 0; ii < 8; ++ii) { const unsigned lo_ = __builtin_bit_cast(unsigned, acc2[ii]), hi_ = __builtin_bit_cast(unsigned, acc2[8 + ii]); const unsigned keep = b5 ? hi_ : lo_, send = b5 ? lo_ : hi_;
                        q8[ii] = __builtin_bit_cast(unsigned, __builtin_bit_cast(f16x2, keep) + __builtin_bit_cast(f16x2, (unsigned)__shfl_xor((int)send, 32))); }
#pragma unroll
                    for (int ii = 0; ii < 4; ++ii) { const unsigned keep = b4 ? q8[4 + ii] : q8[ii], send = b4 ? q8[ii] : q8[4 + ii];
                        q4[ii] = __builtin_bit_cast(unsigned, __builtin_bit_cast(f16x2, keep) + __builtin_bit_cast(f16x2, (unsigned)__shfl_xor((int)send, 16))); }
#pragma unroll
                    for (int ii = 0; ii < 2; ++ii) { const unsigned keep = b3 ? q4[2 + ii] : q4[ii], send = b3 ? q4[ii] : q4[2 + ii];
                        r2[ii] = __builtin_bit_cast(unsigned, __builtin_bit_cast(f16x2, keep) + __builtin_bit_cast(f16x2, (unsigned)__shfl_xor((int)send, 8))); }
                    const f16x2 ra = __builtin_bit_cast(f16x2, r2[0]), rb = __builtin_bit_cast(f16x2, r2[1]);
                    const int ch = 256 * sl + 32 * c8 + (b5 ? 16 : 0) + (b4 ? 8 : 0) + (b3 ? 2 : 0);
                    float* op = out + (size_t)t * ND + ch; const float* g2 = mod + (t / NS) * 6144 + 5120 + ch; const f16* xp = X1 + (size_t)t * ND + ch;
                    const f16x2 xa = *(const f16x2*)xp, xb = *(const f16x2*)(xp + 4); const f32x2 ga = *(const f32x2*)g2, gb = *(const f32x2*)(g2 + 4);
                    const float sc_ = 16777216.f / PEER_WSCALE;
                    *(f32x2*)op = (f32x2){(float)xa[0] + ga[0] * ((float)ra[0] * sc_), (float)xa[1] + ga[1] * ((float)rb[0] * sc_)};
                    *(f32x2*)(op + 4) = (f32x2){(float)xb[0] + gb[0] * ((float)ra[1] * sc_), (float)xb[1] + gb[1] * ((float)rb[1] * sc_)};
                }
            }
        }
    }
}
__device__ __forceinline__ void ph9b_combine(const Args& a, int bid, int nb) {
    int tid_ = threadIdx.x; asm volatile("" : "+v"(tid_));
    float* GW = (float*)(a.ws + WS_GW); const float* PART = (const float*)(a.ws + WS_PART);
    const float du = ((const float*)(a.ws + WS_QS))[0], dv = ((const float*)(a.ws + WS_QS))[1] * PEER_WSCALE;
    for (size_t i = (size_t)bid * NTHR + tid_; i < (size_t)NT * 128 / 4; i += (size_t)nb * NTHR) {
        f32x4 sum = ((const f32x4*)PART)[i];
#pragma unroll
        for (int sidx = 1; sidx < 4; ++sidx) sum += ((const f32x4*)(PART + (size_t)sidx * NT * 128))[i];
        const f32x4 g = ((const f32x4*)GW)[i];
        f32x4 w;
#pragma unroll
        for (int j = 0; j < 4; ++j) w[j] = fminf(fmaxf(g[j] * gelu_erf(sum[j] * du) * dv, -60000.f), 60000.f);
        float ws_ = 0.f; u32x4 pk;
#pragma unroll
        for (int j = 0; j < 4; ++j) { const f16 hw_ = (f16)w[j]; ws_ += (float)hw_; pk[j] = (unsigned)__builtin_bit_cast(unsigned short, hw_) * 0x10001u; }
        ((u32x4*)GW)[i] = pk;
        ws_ += __shfl_xor(ws_, 1); ws_ += __shfl_xor(ws_, 2);
        if ((tid_ & 3) == 0) ((float*)(a.ws + WS_WSUM))[i >> 2] = ws_;
    }
}

#define LAS __attribute__((address_space(3)))
#define XB_TMO      128
#define XB_XCNT(j)  (256  + 64 * (j))
#define XB_XSUB(j)  (1280 + 64 * (j))
#define XB_XGEN(j)  (2304 + 64 * (j))
#define XB_TOP      3328
#define XB_TOPGEN   3392
#define XCD_BAR_WORDS 3456
#define XB_SPIN_CAP (1u << 18)
__device__ __forceinline__ unsigned xb_ld(unsigned* p)              { return __hip_atomic_load(p, __ATOMIC_RELAXED, __HIP_MEMORY_SCOPE_AGENT); }
__device__ __forceinline__ unsigned xb_add(unsigned* p, unsigned v) { return __hip_atomic_fetch_add(p, v, __ATOMIC_RELAXED, __HIP_MEMORY_SCOPE_AGENT); }
__device__ __forceinline__ unsigned xb_xcc_id() { return (unsigned)__builtin_amdgcn_s_getreg((3 << 11) | 20) & 0xFu; }
#define XB_SPIN(cond, bar) do { unsigned _sp = 0; while (cond) { __builtin_amdgcn_s_sleep(1); \
    if ((++_sp & 255u) == 0u) { if (xb_ld(&(bar)[XB_TMO])) break; if (_sp > XB_SPIN_CAP) { atomicAdd(&(bar)[XB_TMO], 1u); break; } } } } while (0)
struct XcdBarrier { unsigned* bar; unsigned x; volatile LAS unsigned* st; };
__device__ __forceinline__ XcdBarrier xcd_barrier_post(unsigned* bar, volatile LAS unsigned* st) {
    XcdBarrier b; b.bar = bar; b.x = xb_xcc_id(); b.st = st;
    if (threadIdx.x == 0) (void)xb_add(&bar[XB_XCNT(b.x)], 1u);
    return b;
}
__device__ __forceinline__ void xcd_barrier_complete(unsigned* bar, unsigned x, unsigned& nloc, unsigned& nx) {
    const unsigned G = gridDim.x * gridDim.y * gridDim.z;
    unsigned sum, cnt, mine, sp = 0u;
    for (;;) {
        sum = 0u; cnt = 0u; mine = 0u;
#pragma unroll
        for (unsigned j = 0; j < 16; ++j) { const unsigned c = xb_ld(&bar[XB_XCNT(j)]); sum += c; cnt += (c > 0u) ? 1u : 0u; mine = (j == x) ? c : mine; }
        if (sum == G) break;
        __builtin_amdgcn_s_sleep(1);
        if ((++sp & 255u) == 0u) { if (xb_ld(&bar[XB_TMO])) break; if (sp > XB_SPIN_CAP) { atomicAdd(&bar[XB_TMO], 1u); break; } }
    }
    nloc = mine > 0u ? mine : 1u; nx = cnt > 0u ? cnt : 1u;
}
__device__ __forceinline__ void xcd_barrier(const XcdBarrier& b) {
    asm volatile("s_waitcnt vmcnt(0)" ::: "memory");
    __syncthreads();
    if (threadIdx.x == 0) {
        unsigned* bar = b.bar;
        __builtin_amdgcn_s_waitcnt(0);
        unsigned nloc = b.st[0], nx = b.st[1];
        if (nloc == 0u) { xcd_barrier_complete(bar, b.x, nloc, nx); b.st[0] = nloc; b.st[1] = nx; }
        const unsigned old = xb_add(&bar[XB_XSUB(b.x)], 1u);
        const unsigned gen = old / nloc;
        if (old + 1u == (gen + 1u) * nloc) {
            __builtin_amdgcn_fence(__ATOMIC_RELEASE, "agent");
            asm volatile("s_waitcnt vmcnt(0)" ::: "memory");
            const unsigned og = xb_add(&bar[XB_TOP], 1u);
            const unsigned tg = og / nx;
            if (og + 1u == (tg + 1u) * nx) xb_add(&bar[XB_TOPGEN], 1u);
            else XB_SPIN(xb_ld(&bar[XB_TOPGEN]) == tg, bar);
            __builtin_amdgcn_fence(__ATOMIC_ACQUIRE, "agent");
            xb_add(&bar[XB_XGEN(b.x)], 1u);
            asm volatile("s_waitcnt vmcnt(0)" ::: "memory");
        } else {
            XB_SPIN(xb_ld(&bar[XB_XGEN(b.x)]) == gen, bar);
            __builtin_amdgcn_fence(__ATOMIC_ACQUIRE, "agent");
            asm volatile("s_waitcnt vmcnt(0)" ::: "memory");
        }
    }
    __syncthreads();
}

constexpr int N_PHASES = 12;
__global__ void __launch_bounds__(NTHR, 2) mk_fwd(Args a) {
    extern __shared__ __attribute__((aligned(16))) unsigned char lds[];
    cg::grid_group grid = cg::this_grid();
    const int bid = blockIdx.x, nb = gridDim.x;
    const int lo = a.ph_lo, hi = a.ph_hi;
    volatile LAS unsigned* bst = (volatile LAS unsigned*)((LAS unsigned char*)lds + (LDS_BYTES - 16));
    if (threadIdx.x < 4) bst[threadIdx.x] = 0u;
    __syncthreads();
    XcdBarrier xbar = xcd_barrier_post((unsigned*)(a.ws + WS_CTL), bst);
#define SEAM(k) do { if ((k) == 0) grid.sync(); else xcd_barrier(xbar); } while (0)
#define PHASE(k, body) if (lo <= (k) && (k) < hi) { body; if ((k) + 1 < hi) SEAM(k); }
    PHASE(0, ph0_prologue(a, bid, nb, lds))
    PHASE(1, row_norm_mod(a.in[0], a.in[4], (const float*)(a.ws + WS_MOD), 0, 1024, (f16*)(a.ws + WS_H), bid, nb); wq_to_int8((const f16*)(a.ws + WS_WQ), a.ws + WS_WQ8, (float*)(a.ws + WS_WSC), bid, nb))
    PHASE(2, ph2_inproj(a, bid, nb, lds))
    PHASE(3, ph3_pool_fast(a, bid, nb, lds); ph3_index_fast<0>(a, bid, nb, lds))
    PHASE(4, ph4_attn_fast<0>(a, bid, nb, lds))
    PHASE(5, ph5_outproj(a, bid, nb, lds))
    PHASE(6, row_norm_mod_q((const f16*)(a.ws + WS_X1), a.in[13], (const float*)(a.ws + WS_MOD), 3072, 4096, a.ws + WS_HQ, (unsigned*)(a.ws + WS_HP), (float*)(a.ws + WS_HSC), bid, nb))
    PHASE(7, ph7_peerq(a, bid, nb, lds))
    PHASE(8, ph8_peersel_fast(a, bid, nb, lds))
    PHASE(9, ph9_sliced<0>(a, lds))
    PHASE(10, ph9b_combine(a, bid, nb))
    PHASE(11, ph9_sliced<1>(a, lds))
#undef PHASE
}

extern "C" void kernel_launch(void* const* d_in, const int* in_sizes, int n_in, void* d_out, int out_size, void* d_ws, size_t ws_size, hipStream_t stream) {
    static int grid = 0;
    if (grid == 0) {
        if (n_in != 18 || out_size != NT * ND || ws_size < WS_END) { fprintf(stderr, "kernel_launch: unexpected shapes (n_in %d out %d ws %zu)\n", n_in, out_size, ws_size); grid = -1; return; }
        int dev = 0, cus = 0, per_cu = 0;
        hipGetDevice(&dev); hipDeviceGetAttribute(&cus, hipDeviceAttributeMultiprocessorCount, dev);
        hipFuncSetAttribute((const void*)mk_fwd, hipFuncAttributeMaxDynamicSharedMemorySize, LDS_BYTES);
        hipOccupancyMaxActiveBlocksPerMultiprocessor(&per_cu, (const void*)mk_fwd, NTHR, LDS_BYTES);
        if (per_cu < 1) { fprintf(stderr, "kernel_launch: occupancy query says %d blocks/CU\n", per_cu); per_cu = 1; }
        grid = cus * 1;
        (void)hipGetLastError();
    }
    if (grid < 0) return;
    if (hipMemsetAsync((char*)d_ws + WS_CTL, 0, 32768, stream) != hipSuccess) { fprintf(stderr, "kernel_launch: memset of the barrier words failed\n"); return; }
    Args a{};
    for (int i = 0; i < 18; ++i) a.in[i] = (const float*)d_in[i];
    a.out = (float*)d_out; a.ws = (unsigned char*)d_ws;
#if MK_MULTI
    for (int ph = 0; ph < N_PHASES; ++ph) { a.ph_lo = ph; a.ph_hi = ph + 1; hipLaunchKernelGGL(mk_fwd, dim3(grid), dim3(NTHR), LDS_BYTES, stream, a); }
#else
    a.ph_lo = 0; a.ph_hi = N_PHASES;
    void* args[] = {&a};
    hipError_t e = hipLaunchCooperativeKernel((const void*)mk_fwd, dim3(grid), dim3(NTHR), args, LDS_BYTES, stream);
    if (e != hipSuccess) fprintf(stderr, "cooperative launch failed: %s (grid %d)\n", hipGetErrorString(e), grid);
#endif
}
```

```cpp
#include <hip/hip_runtime.h>
#include <hip/hip_cooperative_groups.h>
#include <cstdio>
#include <cstdint>
namespace cg = cooperative_groups;

#ifndef MK_MULTI
#define MK_MULTI 0
#endif

typedef _Float16 f16;
typedef _Float16 f16x8 __attribute__((ext_vector_type(8)));
typedef _Float16 f16x4 __attribute__((ext_vector_type(4)));
typedef float f32x4 __attribute__((ext_vector_type(4)));
typedef float f32x16 __attribute__((ext_vector_type(16)));
typedef int i32x4 __attribute__((ext_vector_type(4)));
typedef unsigned long long u64;
typedef unsigned short u16;

constexpr int NB = 8, NS = 8192, ND = 1024, NT = NB * NS;
constexpr int INW = 2632;
constexpr int NMAIN = 2304;
constexpr float EPS = 1e-6f;
constexpr int NTHR = 512, NWAVE = 8;

constexpr size_t MiB = 1u << 20;
constexpr size_t WS_CTL = 0;
constexpr size_t WS_MOD = 1 * MiB;
constexpr size_t WS_WIN = 2 * MiB;
constexpr size_t WS_WVT = 7 * MiB;
constexpr size_t WS_WOUT = 8 * MiB;
constexpr size_t WS_WQ = 10 * MiB;
constexpr size_t WS_SK = 14 * MiB;
constexpr size_t WS_PW = 14 * MiB + 512 * 1024;
constexpr size_t WS_QS = 1 * MiB + 512 * 1024;
constexpr size_t WS_UT = 16 * MiB;
constexpr size_t WS_VP = 48 * MiB;
constexpr size_t WS_H = 80 * MiB;
constexpr size_t WS_U = 208 * MiB;
constexpr size_t WS_Q = 272 * MiB;
constexpr size_t WS_K = 336 * MiB;
constexpr size_t WS_VT = 400 * MiB;
constexpr size_t WS_PQ = 208 * MiB;
constexpr size_t WS_WQ8 = 24 * MiB;
constexpr size_t WS_WSC = 26 * MiB;
constexpr size_t WS_HQ = 464 * MiB;
constexpr size_t WS_HP = 784 * MiB;
constexpr size_t WS_WSUM = 536 * MiB;
constexpr size_t WS_HSC = 528 * MiB;
constexpr size_t WS_QI = 464 * MiB;
constexpr size_t WS_KI = 528 * MiB;
constexpr size_t WS_WI = 536 * MiB;
constexpr size_t WS_MASK = 544 * MiB;
constexpr size_t WS_EID = 608 * MiB;
constexpr size_t WS_GW = 624 * MiB;
constexpr size_t WS_X1 = 656 * MiB;
constexpr size_t WS_END = 848 * MiB;

constexpr int LDS_BYTES = 155648;
constexpr float PEER_QSTEP = 0.3352f;
constexpr float PEER_WSCALE = 16384.f;

struct Args { const float* in[18]; float* out; unsigned char* ws; int ph_lo, ph_hi; };

__host__ __device__ __forceinline__ int pos2log(int p) { return 64 * ((p >> 5) & 3) + 32 * (p >> 7) + 8 * ((p >> 2) & 3) + 4 * ((p >> 4) & 1) + (p & 3); }
__device__ __forceinline__ int maincol(int L) { if (L < 1536) return L; if (L < 2120) return L + 512; return -1; }

__device__ __forceinline__ float wave_sum(float v) {
#pragma unroll
    for (int o = 1; o < 64; o <<= 1) v += __shfl_xor(v, o);
    return v;
}
__device__ __forceinline__ float wave_max(float v) {
#pragma unroll
    for (int o = 1; o < 64; o <<= 1) v = fmaxf(v, __shfl_xor(v, o));
    return v;
}

__device__ void ph0_prologue(const Args& a, int bid, int nb, unsigned char* lds) {
    int tid = threadIdx.x; asm volatile("" : "+v"(tid));
    const float* c = a.in[1]; const float* ada_w = a.in[2]; const float* ada_b = a.in[3];
    float* sil = (float*)lds;
    for (int i = tid; i < NB * ND; i += NTHR) { const float v = c[i]; sil[i] = v / (1.f + __expf(-v)); }
    __syncthreads();
    float* mod = (float*)(a.ws + WS_MOD);
    const int gt = bid * NTHR + tid, ngt = nb * NTHR;
    for (int o = gt; o < NB * 6144; o += ngt) {
        const int b = o / 6144, j = o % 6144;
        float acc = ada_b[j];
        const float* sb = sil + b * ND;
        for (int k = 0; k < ND; ++k) acc += sb[k] * ada_w[(size_t)k * 6144 + j];
        mod[o] = acc;
    }
    const float* w_in = a.in[5]; const float* pool_w = a.in[6]; const float* w_out = a.in[12];
    const float* wq = a.in[14]; const float* sk = a.in[15]; const float* pu = a.in[16]; const float* pv = a.in[17];
    f16* WIN = (f16*)(a.ws + WS_WIN); f16* WVT = (f16*)(a.ws + WS_WVT); f16* WOUT = (f16*)(a.ws + WS_WOUT); f16* WQ = (f16*)(a.ws + WS_WQ);
 unsigned char* UT = a.ws + WS_UT; unsigned char* VP = a.ws + WS_VP;
    {
        __syncthreads();
        const int lane = tid & 63, wv_ = tid >> 6;
        float* scr = (float*)lds + wv_ * (64 * 33);
        constexpr int I_WQ = 16 * 64, I_Z = 16 * 16, I_INR = 16 * (NMAIN / 32 - 16), I_VT = 16 * 16, I_OUT = 16 * 32, I_ALL = I_WQ + I_Z + I_INR + I_VT + I_OUT;
        for (int it = bid * NWAVE + wv_; it < I_ALL; it += nb * NWAVE) {
            int rr = it, kind = 3, pboff = 0;
            if (rr >= I_WQ) { rr -= I_WQ; kind = 0;
                if (rr >= I_Z) { rr -= I_Z; pboff = 16;
                    if (rr >= I_INR) { rr -= I_INR; kind = 1; pboff = 0; if (rr >= I_VT) { rr -= I_VT; kind = 2; } } } }
            const int npb = kind == 0 ? (pboff ? NMAIN / 32 - 16 : 16) : kind == 1 ? 16 : kind == 2 ? 32 : 64;
            const int k0 = (rr / npb) * 64, p0 = (rr % npb + pboff) * 32, p = p0 + (lane & 31);
            const float* W = kind <= 1 ? w_in : kind == 2 ? w_out : wq; const int ldw = kind <= 1 ? INW : kind == 2 ? 1024 : 2048;
            int col;
            if (kind == 0) col = maincol((p & ~255) + pos2log(p & 255)); else if (kind == 1) col = 1536 + p; else col = (p & ~255) + pos2log(p & 255);
            const bool foldz = (kind == 0 && pboff == 0);
            if (foldz || kind == 3) {
                const int r5 = lane & 31, hh_ = lane >> 5;
                const int blk = __builtin_amdgcn_readfirstlane(col >> 7);
                const int sub = col & 127;
                const float* arow = W + (size_t)(k0 + r5) * ldw + blk * 128 + 8 * hh_;
                f32x16 acc0 = (f32x16){0.f, 0.f, 0.f, 0.f, 0.f, 0.f, 0.f, 0.f, 0.f, 0.f, 0.f, 0.f, 0.f, 0.f, 0.f, 0.f}, acc1 = acc0;
#pragma unroll 2
                for (int ks = 0; ks < 8; ++ks) {
                    const f32x4 a00 = *(const f32x4*)(arow + 16 * ks), a01 = *(const f32x4*)(arow + 16 * ks + 4);
                    const f32x4 a10 = *(const f32x4*)(arow + (size_t)32 * ldw + 16 * ks), a11 = *(const f32x4*)(arow + (size_t)32 * ldw + 16 * ks + 4);
                    f16x8 bfr;
                    if (kind == 3) { const float* br = sk + (size_t)(blk * 128 + sub) * 128 + 16 * ks + 8 * hh_; const f32x4 b0 = *(const f32x4*)br, b1 = *(const f32x4*)(br + 4);
                        bfr = (f16x8){(f16)b0[0], (f16)b0[1], (f16)b0[2], (f16)b0[3], (f16)b1[0], (f16)b1[1], (f16)b1[2], (f16)b1[3]}; }
                    else { const float* br = pool_w + (size_t)blk * 16384 + (size_t)(16 * ks + 8 * hh_) * 128 + sub;
                        bfr = (f16x8){(f16)br[0], (f16)br[128], (f16)br[256], (f16)br[384], (f16)br[512], (f16)br[640], (f16)br[768], (f16)br[896]}; }
                    const f16x8 af0 = (f16x8){(f16)a00[0], (f16)a00[1], (f16)a00[2], (f16)a00[3], (f16)a01[0], (f16)a01[1], (f16)a01[2], (f16)a01[3]};
                    const f16x8 af1 = (f16x8){(f16)a10[0], (f16)a10[1], (f16)a10[2], (f16)a10[3], (f16)a11[0], (f16)a11[1], (f16)a11[2], (f16)a11[3]};
                    acc0 = __builtin_amdgcn_mfma_f32_32x32x16_f16(af0, bfr, acc0, 0, 0, 0);
                    acc1 = __builtin_amdgcn_mfma_f32_32x32x16_f16(af1, bfr, acc1, 0, 0, 0);
                }
#pragma unroll
                for (int rg = 0; rg < 16; ++rg) { const int kk = (rg & 3) + 8 * (rg >> 2) + 4 * hh_; scr[kk * 33 + r5] = acc0[rg]; scr[(32 + kk) * 33 + r5] = acc1[rg]; }
            } else {
#pragma unroll 8
                for (int i = 0; i < 32; ++i) { const int kk = 2 * i + (lane >> 5); scr[kk * 33 + (lane & 31)] = col >= 0 ? W[(size_t)(k0 + kk) * ldw + col] : 0.f; }
            }
            f16* WT = kind == 0 ? WIN : kind == 1 ? WVT : kind == 2 ? WOUT : WQ;
            const int c8 = lane & 7;
#pragma unroll
            for (int j = 0; j < 4; ++j) { const int n = (lane >> 3) + 8 * j; const float* sp = scr + (8 * c8) * 33 + n;
                *(f16x8*)(WT + (size_t)(p0 + n) * ND + k0 + 8 * c8) = (f16x8){(f16)sp[0], (f16)sp[33], (f16)sp[66], (f16)sp[99], (f16)sp[132], (f16)sp[165], (f16)sp[198], (f16)sp[231]}; }
        }
    }
    {
        __syncthreads();
        float ssu = 0.f, ssv = 0.f;
        for (int i = tid; i < 64 * 1024 / 4; i += NTHR) { const f32x4 u = ((const f32x4*)pu)[i], v = ((const f32x4*)pv)[i];
            ssu += u.x * u.x + u.y * u.y + u.z * u.z + u.w * u.w; ssv += v.x * v.x + v.y * v.y + v.z * v.z + v.w * v.w; }
        ssu = wave_sum(ssu); ssv = wave_sum(ssv);
        float* red = (float*)lds;
        if ((tid & 63) == 0) { red[tid >> 6] = ssu; red[8 + (tid >> 6)] = ssv; }
        __syncthreads();
        float tu = 0.f, tv = 0.f;
#pragma unroll
        for (int w = 0; w < 8; ++w) { tu += red[w]; tv += red[8 + w]; }
        const float du = PEER_QSTEP * sqrtf(tu * (1.f / 65536.f)), dv = PEER_QSTEP * sqrtf(tv * (1.f / 65536.f));
        if (bid == 0 && tid == 0) { float* qs = (float*)(a.ws + WS_QS); qs[0] = du; qs[1] = dv; }
        const float idu = 1.f / du, idv = 1.f / dv;
        const int lane = tid & 63, wv_ = tid >> 6;
        for (int row0 = bid * NWAVE + wv_; row0 < 2 * 16384; row0 += 4 * nb * NWAVE) {
            f32x4 x4[4][4];
#pragma unroll
            for (int rr = 0; rr < 4; ++rr) { int row = row0 + rr * nb * NWAVE; row = row < 2 * 16384 ? row : row0; const bool isv = row >= 16384; const int e = row & 16383;
                const float* src = (isv ? pv : pu) + (size_t)e * ND + 4 * lane;
#pragma unroll
                for (int j = 0; j < 4; ++j) x4[rr][j] = *(const f32x4*)(src + 256 * j); }
#pragma unroll
            for (int rr = 0; rr < 4; ++rr) { int row = row0 + rr * nb * NWAVE; row = row < 2 * 16384 ? row : row0; const bool isv = row >= 16384; const int e = row & 16383;
                u16* dstq = (u16*)((isv ? VP : UT) + (size_t)e * 512) + lane;
                const float inv = isv ? idv : idu; const int off = isv ? 8 : 0;
#pragma unroll
                for (int j = 0; j < 4; ++j) { unsigned pk = 0u;
#pragma unroll
                    for (int k = 0; k < 4; ++k) { int q = (int)floorf(x4[rr][j][k] * inv); q = q < -8 ? -8 : q > 7 ? 7 : q; pk |= (unsigned)((q + off) & 15) << (4 * k); }
                    dstq[64 * j] = (u16)pk; } }
        }
    }
}

__device__ void row_norm_mod(const float* src, const float* g, const float* mod, int sh_off, int sc_off, f16* dst, int bid, int nb) {
    int tid_ = threadIdx.x; asm volatile("" : "+v"(tid_)); const int lane = tid_ & 63, wave = tid_ >> 6;
    const int rstep = nb * NWAVE, r0 = bid * NWAVE + wave;
    const bool fast = (NS % rstep) == 0 && ((NS / rstep) % 4) == 0;
    if (fast) {
        for (int b = 0; b < NB; ++b) {
            f32x4 gs[4], sh[4];
#pragma unroll
            for (int j = 0; j < 4; ++j) { const int col = lane * 4 + 256 * j; const f32x4 gg = *(const f32x4*)(g + col), sc = *(const f32x4*)(mod + b * 6144 + sc_off + col);
                sh[j] = *(const f32x4*)(mod + b * 6144 + sh_off + col); gs[j] = gg * (1.f + sc); }
            for (int row = b * NS + r0; row < (b + 1) * NS; row += 4 * rstep) {
                f32x4 v[4][4]; float ss[4];
#pragma unroll
                for (int rr = 0; rr < 4; ++rr)
#pragma unroll
                    for (int j = 0; j < 4; ++j) v[rr][j] = ((const f32x4*)(src + (size_t)(row + rr * rstep) * ND) + lane)[64 * j];
#pragma unroll
                for (int rr = 0; rr < 4; ++rr) { float s_ = 0.f;
#pragma unroll
                    for (int j = 0; j < 4; ++j) s_ += v[rr][j].x * v[rr][j].x + v[rr][j].y * v[rr][j].y + v[rr][j].z * v[rr][j].z + v[rr][j].w * v[rr][j].w;
                    ss[rr] = rsqrtf(wave_sum(s_) * (1.f / ND) + EPS); }
#pragma unroll
                for (int rr = 0; rr < 4; ++rr)
#pragma unroll
                    for (int j = 0; j < 4; ++j) { const int col = lane * 4 + 256 * j; const f32x4 o = v[rr][j] * ss[rr] * gs[j] + sh[j];
                        *(f16x4*)(dst + (size_t)(row + rr * rstep) * ND + col) = (f16x4){(f16)o.x, (f16)o.y, (f16)o.z, (f16)o.w}; }
            }
        }
        return;
    }
    for (int row = r0; row < NT; row += rstep) {
        const int b = row / NS;
        const f32x4* xr = (const f32x4*)(src + (size_t)row * ND) + lane;
        f32x4 v[4]; float s = 0.f;
#pragma unroll
        for (int j = 0; j < 4; ++j) { v[j] = xr[64 * j]; s += v[j].x * v[j].x + v[j].y * v[j].y + v[j].z * v[j].z + v[j].w * v[j].w; }
        const float rstd = rsqrtf(wave_sum(s) * (1.f / ND) + EPS);
#pragma unroll
        for (int j = 0; j < 4; ++j) {
            const int col = lane * 4 + 256 * j;
            const f32x4 gg = *(const f32x4*)(g + col), sc = *(const f32x4*)(mod + b * 6144 + sc_off + col), sh = *(const f32x4*)(mod + b * 6144 + sh_off + col);
            f16x4 o;
            o.x = (f16)(v[j].x * rstd * gg.x * (1.f + sc.x) + sh.x); o.y = (f16)(v[j].y * rstd * gg.y * (1.f + sc.y) + sh.y);
            o.z = (f16)(v[j].z * rstd * gg.z * (1.f + sc.z) + sh.z); o.w = (f16)(v[j].w * rstd * gg.w * (1.f + sc.w) + sh.w);
            *(f16x4*)(dst + (size_t)row * ND + col) = o;
        }
    }
}
__device__ void row_norm_mod_q(const f16* src, const float* g, const float* mod, int sh_off, int sc_off, unsigned char* hq, unsigned* hp, float* hsc, int bid, int nb) {
    int tid_ = threadIdx.x; asm volatile("" : "+v"(tid_)); const int lane = tid_ & 63, wave = tid_ >> 6;
    const int rstep = nb * NWAVE, r0 = bid * NWAVE + wave;
    const bool hoist = (NS % rstep) == 0 && ((NS / rstep) % 2) == 0;
    const int nouter = hoist ? NB : 1, ninner = hoist ? NS : NT;
    for (int bo = 0; bo < nouter; ++bo) {
        f32x4 gs[4], sh[4];
        if (hoist) {
#pragma unroll
            for (int j = 0; j < 4; ++j) { const int col = 8 * lane + 512 * (j >> 1) + 4 * (j & 1); const f32x4 gg = *(const f32x4*)(g + col), sc = *(const f32x4*)(mod + bo * 6144 + sc_off + col);
                sh[j] = *(const f32x4*)(mod + bo * 6144 + sh_off + col); gs[j] = gg * (1.f + sc); }
        }
        for (int rowa = bo * ninner + r0; rowa < (bo + 1) * ninner; rowa += 2 * rstep) {
            const int rowb = rowa + rstep < NT ? rowa + rstep : rowa;
            f16x8 hx[2][2];
#pragma unroll
            for (int j = 0; j < 2; ++j) { hx[0][j] = *(const f16x8*)(src + (size_t)rowa * ND + 8 * lane + 512 * j); hx[1][j] = *(const f16x8*)(src + (size_t)rowb * ND + 8 * lane + 512 * j); }
#pragma unroll
            for (int rr = 0; rr < 2; ++rr) {
                const int row = rr ? rowb : rowa; const int b = row / NS;
                if (!hoist) {
#pragma unroll
                    for (int j = 0; j < 4; ++j) { const int col = 8 * lane + 512 * (j >> 1) + 4 * (j & 1); const f32x4 gg = *(const f32x4*)(g + col), sc = *(const f32x4*)(mod + b * 6144 + sc_off + col);
                        sh[j] = *(const f32x4*)(mod + b * 6144 + sh_off + col); gs[j] = gg * (1.f + sc); }
                }
                f32x4 v[4]; float s = 0.f;
#pragma unroll
                for (int j = 0; j < 2; ++j) { const f16x8 h8 = hx[rr][j];
                    v[2 * j] = (f32x4){(float)h8[0], (float)h8[1], (float)h8[2], (float)h8[3]}; v[2 * j + 1] = (f32x4){(float)h8[4], (float)h8[5], (float)h8[6], (float)h8[7]}; }
#pragma unroll
                for (int j = 0; j < 4; ++j) s += v[j].x * v[j].x + v[j].y * v[j].y + v[j].z * v[j].z + v[j].w * v[j].w;
                const float rstd = rsqrtf(wave_sum(s) * (1.f / ND) + EPS);
                float o[16]; float am = 0.f;
#pragma unroll
                for (int j = 0; j < 4; ++j)
#pragma unroll
                    for (int k = 0; k < 4; ++k) { const float y = v[j][k] * rstd * gs[j][k] + sh[j][k]; o[4 * j + k] = y; am = fmaxf(am, fabsf(y)); }
                am = wave_max(am);
                const float inv = am > 0.f ? 119.f / am : 0.f;
#pragma unroll
                for (int j = 0; j < 2; ++j) {
                    unsigned p0 = 0u, p1 = 0u, ph = 0u, pl = 0u;
#pragma unroll
                    for (int k = 0; k < 8; ++k) { const int q = (int)rintf(o[8 * j + k] * inv); const int l = ((q + 8) & 15) - 8; const int h = (q - l) >> 4;
                        if (k < 4) p0 |= (unsigned)(q & 255) << (8 * k); else p1 |= (unsigned)(q & 255) << (8 * (k - 4));
                        ph |= (unsigned)(h & 15) << (4 * k); pl |= (unsigned)(l & 15) << (4 * k); }
                    *(u64*)(hq + (size_t)row * ND + 8 * lane + 512 * j) = (u64)p0 | ((u64)p1 << 32);
                    hp[(size_t)row * 256 + lane + 64 * j] = ph; hp[(size_t)row * 256 + 128 + lane + 64 * j] = pl;
                }
                if (lane == 0) hsc[row] = am * (1.f / 119.f);
            }
        }
    }
}
__device__ void wq_to_int8(const f16* WQ, unsigned char* WQ8, float* WSC, int bid, int nb) {
    int tid_ = threadIdx.x; asm volatile("" : "+v"(tid_)); const int lane = tid_ & 63, wave = tid_ >> 6;
    for (int row = bid * NWAVE + wave; row < 2048; row += nb * NWAVE) {
        const f16x8 a0 = *(const f16x8*)(WQ + (size_t)row * ND + 8 * lane), a1 = *(const f16x8*)(WQ + (size_t)row * ND + 8 * lane + 512);
        float am = 0.f;
#pragma unroll
        for (int k = 0; k < 8; ++k) am = fmaxf(am, fmaxf(fabsf((float)a0[k]), fabsf((float)a1[k])));
        am = wave_max(am);
        const float inv = am > 0.f ? 127.f / am : 0.f;
        unsigned p[4] = {0u, 0u, 0u, 0u};
#pragma unroll
        for (int k = 0; k < 4; ++k) { p[0] |= (unsigned)((int)rintf((float)a0[k] * inv) & 255) << (8 * k); p[1] |= (unsigned)((int)rintf((float)a0[4 + k] * inv) & 255) << (8 * k);
                                      p[2] |= (unsigned)((int)rintf((float)a1[k] * inv) & 255) << (8 * k); p[3] |= (unsigned)((int)rintf((float)a1[4 + k] * inv) & 255) << (8 * k); }
        *(u64*)(WQ8 + (size_t)row * ND + 8 * lane) = (u64)p[0] | ((u64)p[1] << 32);
        *(u64*)(WQ8 + (size_t)row * ND + 8 * lane + 512) = (u64)p[2] | ((u64)p[3] << 32);
        if (lane == 0) WSC[row] = am * (1.f / 127.f);
    }
}

namespace pg8 {
#define PG8_LAS __attribute__((address_space(3)))
constexpr int BM = 256, BK = 64, HALF = 128, HTB = HALF * BK * 2, STAGE_BYTES = 8 * HTB, NXCD = 8, WGM = 8;
__host__ __device__ __forceinline__ int lds_byte(int r, int c) { const int st = (r >> 4) * 2 + (c >> 5), rr = r & 15, cc = c & 31, ob = rr * 64 + cc * 2; return st * 1024 + (ob ^ (((ob >> 9) & 1) << 5)); }
__host__ __device__ __forceinline__ void stage_rc(int b, int& R, int& C) { const int st = b / 1024, sb = b % 1024, swz = sb ^ (((sb >> 9) & 1) << 5); R = (st >> 1) * 16 + swz / 64; C = (st & 1) * 32 + (swz % 64) / 2; }
struct Unit { int pm, pn; };
struct Gemm { const f16* A; const f16* Bt; int M, N, K; };
struct StaticOrder {
    int nM, nN, nwg, G, c;
    __host__ __device__ void init(int M, int N, int G_, int c_) { nM = M / BM; nN = N / BM; nwg = nM * nN; G = G_; c = c_; }
    __host__ __device__ bool next(int i, Unit& u) const {
        const long L = (long)i * G + c; if (L >= nwg) return false;
        int wgid = (int)L; { const int q = nwg / NXCD, r = nwg % NXCD, xcd = wgid % NXCD, off = wgid / NXCD; wgid = (xcd < r ? xcd * (q + 1) : r * (q + 1) + (xcd - r) * q) + off; }
        const int nig = WGM * nN, gid = wgid / nig, fm = gid * WGM, gsz = (nM - fm) < WGM ? (nM - fm) : WGM;
        u.pm = fm + ((wgid % nig) % gsz); u.pn = (wgid % nig) / gsz; return true;
    }
};
template <class Epi, bool I8 = false>
__device__ __forceinline__ void gemm_phase(PG8_LAS unsigned char* lds, const Gemm g, const StaticOrder& S, const Epi& E) {
    int tid = threadIdx.x; asm volatile("" : "+v"(tid));
    const int wid = __builtin_amdgcn_readfirstlane(tid >> 6), lane = tid & 63, wr = wid >> 2, wc = wid & 3, fr = lane & 15, fq = lane >> 4;
    const int K = g.K, nt = K / BK;
    unsigned voffA[2];
#pragma unroll
    for (int i = 0; i < 2; ++i) { int R, C; stage_rc(tid * 16 + i * 8192, R, C); voffA[i] = (unsigned)(R * K + C) * 2u; }
    const size_t kstep = (size_t)(BK * 2);
    const size_t hstep = (size_t)HALF * K * 2;
    const size_t tstep = 2 * hstep;
    const unsigned ldsw = (unsigned)wid * 1024u;
    const int aoff = lds_byte(wr * 64 + fr, fq * 8), boff = lds_byte(wc * 32 + fr, fq * 8);
#define PG8_SA(b, h) (((b) * 2 + (h)) * HTB)
#define PG8_SB(b, h) ((4 + (b) * 2 + (h)) * HTB)
#define PG8_STAGE(bufoff, gbase, voff) do { _Pragma("unroll") for (int _i = 0; _i < 2; ++_i) \
        __builtin_amdgcn_global_load_lds((const unsigned*)((const char*)(gbase) + (voff)[_i]), (PG8_LAS unsigned*)(lds + (bufoff) + ldsw + _i * 8192), 16, 0, 0); } while (0)
#define PG8_LDA(dst, b, h) do { _Pragma("unroll") for (int m = 0; m < 4; ++m) _Pragma("unroll") for (int k = 0; k < 2; ++k) dst[m][k] = *(const PG8_LAS f16x8*)(lds + PG8_SA(b, h) + aoff + m * 2048 + k * 1024); } while (0)
#define PG8_LDB(dst, b, h) do { _Pragma("unroll") for (int n = 0; n < 2; ++n) _Pragma("unroll") for (int k = 0; k < 2; ++k) dst[n][k] = *(const PG8_LAS f16x8*)(lds + PG8_SB(b, h) + boff + n * 2048 + k * 1024); } while (0)
#define PG8_MMA(ai, bj, At, Bt) do { __builtin_amdgcn_s_setprio(1); _Pragma("unroll") for (int m = 0; m < 4; ++m) _Pragma("unroll") for (int n = 0; n < 2; ++n) _Pragma("unroll") for (int k = 0; k < 2; ++k) \
        acc[ai][bj][m][n] = I8 ? __builtin_bit_cast(f32x4, __builtin_amdgcn_mfma_i32_16x16x64_i8(__builtin_bit_cast(i32x4, Bt[n][k]), __builtin_bit_cast(i32x4, At[m][k]), __builtin_bit_cast(i32x4, acc[ai][bj][m][n]), 0, 0, 0)) \
                                 : __builtin_amdgcn_mfma_f32_16x16x32_f16(Bt[n][k], At[m][k], acc[ai][bj][m][n], 0, 0, 0); __builtin_amdgcn_s_setprio(0); } while (0)
#define PG8_WAIT_V(n) asm volatile("s_waitcnt vmcnt(" #n ")" ::: "memory")
#define PG8_WAIT_L(n) asm volatile("s_waitcnt lgkmcnt(" #n ")" ::: "memory")
#define PG8_BAR __builtin_amdgcn_s_barrier()
#define PG8_SCHED __builtin_amdgcn_sched_barrier(0)
    Unit cur, nxt; int ui = 0;
    if (!S.next(0, cur)) return;
    f32x4 acc[2][2][4][2];
#pragma unroll
    for (int a = 0; a < 2; ++a)
#pragma unroll
        for (int b = 0; b < 2; ++b)
#pragma unroll
            for (int m = 0; m < 4; ++m)
#pragma unroll
                for (int n = 0; n < 2; ++n) acc[a][b][m][n] = (f32x4){0.f, 0.f, 0.f, 0.f};
    f16x8 At[4][2], B0[2][2], B1[2][2];
    const char* cA = (const char*)g.A + (size_t)cur.pm * tstep; const char* cB = (const char*)g.Bt + (size_t)cur.pn * tstep;
    PG8_STAGE(PG8_SB(0, 0), cB, voffA); PG8_STAGE(PG8_SB(0, 1), cB + hstep, voffA); PG8_STAGE(PG8_SA(0, 0), cA, voffA); PG8_STAGE(PG8_SA(0, 1), cA + hstep, voffA);
    if (wr == 1) PG8_BAR;
    PG8_WAIT_V(2); PG8_BAR;
    PG8_STAGE(PG8_SB(1, 0), cB + kstep, voffA); PG8_STAGE(PG8_SA(1, 0), cA + kstep, voffA); PG8_STAGE(PG8_SB(1, 1), cB + hstep + kstep, voffA);
    PG8_WAIT_V(6); PG8_BAR;
    for (;;) {
        const bool has_next = S.next(ui + 1, nxt);
        const char* nA = has_next ? (const char*)g.A + (size_t)nxt.pm * tstep : cA; const char* nB = has_next ? (const char*)g.Bt + (size_t)nxt.pn * tstep : cB;
        for (int t = 0; t < nt; t += 2) {
            const bool last = (t == nt - 2);
            const char* a1 = cA + (size_t)(t + 1) * kstep;
            const char* a2 = last ? nA : cA + (size_t)(t + 2) * kstep; const char* b2 = last ? nB : cB + (size_t)(t + 2) * kstep;
            const char* a3 = a2 + kstep; const char* b3 = b2 + kstep;
            PG8_LDB(B0, 0, 0); PG8_LDB(B1, 0, 1); PG8_SCHED; PG8_LDA(At, 0, 0); PG8_STAGE(PG8_SA(1, 1), a1 + hstep, voffA);
            PG8_WAIT_V(8); PG8_WAIT_L(0); PG8_BAR; PG8_MMA(0, 0, At, B0); PG8_MMA(0, 1, At, B1); PG8_BAR; PG8_SCHED;
            PG8_LDA(At, 0, 1); PG8_STAGE(PG8_SB(0, 0), b2, voffA); PG8_STAGE(PG8_SB(0, 1), b2 + hstep, voffA); PG8_STAGE(PG8_SA(0, 0), a2, voffA);
            PG8_WAIT_V(8); PG8_WAIT_L(0); PG8_BAR; PG8_MMA(1, 0, At, B0); PG8_MMA(1, 1, At, B1); PG8_BAR; PG8_SCHED;
            PG8_LDB(B0, 1, 0); PG8_LDB(B1, 1, 1); PG8_SCHED; PG8_LDA(At, 1, 0); PG8_STAGE(PG8_SA(0, 1), a2 + hstep, voffA);
            PG8_WAIT_V(8); PG8_WAIT_L(0); PG8_BAR; PG8_MMA(0, 0, At, B0); PG8_MMA(0, 1, At, B1); PG8_BAR; PG8_SCHED;
            PG8_LDA(At, 1, 1); PG8_STAGE(PG8_SB(1, 0), b3, voffA); PG8_STAGE(PG8_SB(1, 1), b3 + hstep, voffA); PG8_STAGE(PG8_SA(1, 0), a3, voffA);
            PG8_WAIT_V(8); PG8_WAIT_L(0); PG8_BAR; PG8_MMA(1, 0, At, B0); PG8_MMA(1, 1, At, B1); PG8_BAR; PG8_SCHED;
        }
        if (wr == 0) PG8_BAR;
        E(acc, cur, wr, wc, fr, fq);
        if (!has_next) break;
#pragma unroll
        for (int a = 0; a < 2; ++a)
#pragma unroll
            for (int b = 0; b < 2; ++b)
#pragma unroll
                for (int m = 0; m < 4; ++m)
#pragma unroll
                    for (int n = 0; n < 2; ++n) acc[a][b][m][n] = (f32x4){0.f, 0.f, 0.f, 0.f};
        cur = nxt; cA = nA; cB = nB; ++ui;
        if (wr == 1) PG8_BAR;
    }
    PG8_WAIT_V(0);
    PG8_BAR;
#undef PG8_SA
#undef PG8_SB
#undef PG8_STAGE
#undef PG8_LDA
#undef PG8_LDB
#undef PG8_MMA
#undef PG8_WAIT_V
#undef PG8_WAIT_L
#undef PG8_BAR
#undef PG8_SCHED
}

typedef f32x4 Acc[2][2][4][2];
struct EpiMain {
    unsigned char* ws; const float *qg, *kg;
    __device__ __forceinline__ void operator()(const Acc& acc, const Unit& u, int wr, int wc, int fr, int fq) const {
        const int row0 = u.pm * BM + wr * 64 + fr, pn = u.pn;
        if (pn == 8) {
            if (wc == 0) {
#pragma unroll
                for (int ai = 0; ai < 2; ++ai)
#pragma unroll
                    for (int m = 0; m < 4; ++m) { const size_t row = row0 + ai * HALF + m * 16;
#pragma unroll
                        for (int bj = 0; bj < 2; ++bj) { const f32x4 v0 = acc[ai][bj][m][0], v1 = acc[ai][bj][m][1];
                            *(f16x8*)((f16*)(ws + WS_KI) + (((row >> 5) * 8 + 4 * bj + fq) * 32 + (row & 31)) * 8) = (f16x8){(f16)v0[0], (f16)v0[1], (f16)v0[2], (f16)v0[3], (f16)v1[0], (f16)v1[1], (f16)v1[2], (f16)v1[3]}; } }
            } else if (wc == 1 && fq == 0) {
#pragma unroll
                for (int ai = 0; ai < 2; ++ai)
#pragma unroll
                    for (int m = 0; m < 4; ++m) { const size_t row = row0 + ai * HALF + m * 16;
                        *(f32x4*)((float*)(ws + WS_WI) + row * 8) = acc[ai][0][m][0] * 0.35355339059327373f; *(f32x4*)((float*)(ws + WS_WI) + row * 8 + 4) = acc[ai][0][m][1] * 0.35355339059327373f; }
            }
            return;
        }
        const int kind = pn >> 1;
        f16* base = (f16*)(ws + (kind == 0 ? WS_U : kind == 1 ? WS_Q : kind == 2 ? WS_K : WS_QI));
        const int col0 = (pn & 1) * 256 + 64 * wc + 8 * fq;
        if (kind == 1 || kind == 2) {
            const float* gp = (kind == 1 ? qg : kg) + 8 * fq;
#pragma unroll
            for (int ai = 0; ai < 2; ++ai)
#pragma unroll
                for (int m = 0; m < 4; ++m) { const size_t row = row0 + ai * HALF + m * 16;
                    float ss = 0.f;
#pragma unroll
                    for (int bj = 0; bj < 2; ++bj)
#pragma unroll
                        for (int n = 0; n < 2; ++n) { const f32x4 v = acc[ai][bj][m][n]; ss += v[0] * v[0] + v[1] * v[1] + v[2] * v[2] + v[3] * v[3]; }
                    ss += __shfl_xor(ss, 16); ss += __shfl_xor(ss, 32);
                    const float rstd = rsqrtf(ss * (1.f / 64.f) + EPS);
#pragma unroll
                    for (int bj = 0; bj < 2; ++bj) { const f32x4 v0 = acc[ai][bj][m][0] * rstd * *(const f32x4*)(gp + 32 * bj), v1 = acc[ai][bj][m][1] * rstd * *(const f32x4*)(gp + 32 * bj + 4);
                        *(f16x8*)(base + row * 512 + col0 + 32 * bj) = (f16x8){(f16)v0[0], (f16)v0[1], (f16)v0[2], (f16)v0[3], (f16)v1[0], (f16)v1[1], (f16)v1[2], (f16)v1[3]}; }
                    asm volatile("" ::: "memory"); }
        } else if (kind == 3) {
            const int hd = (pn & 1) * 4 + wc;
#pragma unroll
            for (int ai = 0; ai < 2; ++ai)
#pragma unroll
                for (int m = 0; m < 4; ++m) { const size_t row = row0 + ai * HALF + m * 16; const int ql = (int)(row & 7);
                    const int rr = (hd & 3) | (((ql >> 1) & 1) << 2) | ((hd >> 2) << 3) | ((ql & 1) << 4);
#pragma unroll
                    for (int bj = 0; bj < 2; ++bj) { const f32x4 v0 = acc[ai][bj][m][0], v1 = acc[ai][bj][m][1]; const int chunk = fq + 4 * bj;
                        *(f16x8*)(base + ((((((row >> 3) * 2 + (ql >> 2)) * 4 + (chunk >> 1)) * 2 + (chunk & 1)) * 32 + rr) << 3)) = (f16x8){(f16)v0[0], (f16)v0[1], (f16)v0[2], (f16)v0[3], (f16)v1[0], (f16)v1[1], (f16)v1[2], (f16)v1[3]}; } }
        } else {
#pragma unroll
            for (int ai = 0; ai < 2; ++ai)
#pragma unroll
                for (int m = 0; m < 4; ++m) { const size_t row = row0 + ai * HALF + m * 16;
#pragma unroll
                    for (int bj = 0; bj < 2; ++bj) { const f32x4 v0 = acc[ai][bj][m][0], v1 = acc[ai][bj][m][1];
                        *(f16x8*)(base + row * 512 + col0 + 32 * bj) = (f16x8){(f16)v0[0], (f16)v0[1], (f16)v0[2], (f16)v0[3], (f16)v1[0], (f16)v1[1], (f16)v1[2], (f16)v1[3]}; } }
        }
    }
};
struct EpiVT {
    f16* VT;
    __device__ __forceinline__ void operator()(const Acc& acc, const Unit& u, int wr, int wc, int fr, int fq) const {
        const int row0 = u.pm * BM + wr * 64 + fr, col0 = u.pn * BM + 32 * wc + 4 * fq;
#pragma unroll
        for (int ai = 0; ai < 2; ++ai)
#pragma unroll
            for (int m = 0; m < 4; ++m) { const size_t row = row0 + ai * HALF + m * 16;
#pragma unroll
                for (int bj = 0; bj < 2; ++bj)
#pragma unroll
                    for (int n = 0; n < 2; ++n) { const f32x4 v = acc[ai][bj][m][n];
                        *(f16x4*)(VT + row * NT + col0 + 128 * bj + 16 * n) = (f16x4){(f16)v[0], (f16)v[1], (f16)v[2], (f16)v[3]}; } }
    }
};
struct EpiOut {
    const float* x; const float* mod; f16* x1;
    __device__ __forceinline__ void operator()(const Acc& acc, const Unit& u, int wr, int wc, int fr, int fq) const {
        const int row0 = u.pm * BM + wr * 64 + fr, col0 = u.pn * BM + 64 * wc + 8 * fq;
        const float* g1 = mod + ((u.pm * BM) / NS) * 6144 + 2048 + col0;
        f32x4 g4[2][2];
#pragma unroll
        for (int bj = 0; bj < 2; ++bj)
#pragma unroll
            for (int n = 0; n < 2; ++n) g4[bj][n] = *(const f32x4*)(g1 + 32 * bj + 4 * n);
#pragma unroll
        for (int ai = 0; ai < 2; ++ai)
#pragma unroll
            for (int m = 0; m < 4; ++m) { const size_t off = (size_t)(row0 + ai * HALF + m * 16) * ND + col0;
#pragma unroll
                for (int bj = 0; bj < 2; ++bj) { const f32x4 v0 = *(const f32x4*)(x + off + 32 * bj) + g4[bj][0] * acc[ai][bj][m][0], v1 = *(const f32x4*)(x + off + 32 * bj + 4) + g4[bj][1] * acc[ai][bj][m][1];
                    *(f16x8*)(x1 + off + 32 * bj) = (f16x8){(f16)v0[0], (f16)v0[1], (f16)v0[2], (f16)v0[3], (f16)v1[0], (f16)v1[1], (f16)v1[2], (f16)v1[3]}; } }
    }
};
struct EpiPQ {
    f16* PQ; const float* hsc; const float* wsc;
    __device__ __forceinline__ void operator()(const Acc& acc, const Unit& u, int wr, int wc, int fr, int fq) const {
        const int row0 = u.pm * BM + wr * 64 + fr, col0 = u.pn * BM + 64 * wc + 8 * fq;
        f32x4 ws4[2][2];
#pragma unroll
        for (int bj = 0; bj < 2; ++bj)
#pragma unroll
            for (int n = 0; n < 2; ++n) ws4[bj][n] = *(const f32x4*)(wsc + u.pn * BM + 128 * bj + 32 * wc + 16 * n + 4 * fq);
#pragma unroll
        for (int ai = 0; ai < 2; ++ai)
#pragma unroll
            for (int m = 0; m < 4; ++m) { const size_t row = row0 + ai * HALF + m * 16; const float hs = hsc[row];
#pragma unroll
                for (int bj = 0; bj < 2; ++bj) { const i32x4 i0 = __builtin_bit_cast(i32x4, acc[ai][bj][m][0]), i1 = __builtin_bit_cast(i32x4, acc[ai][bj][m][1]);
                    const f32x4 v0 = (f32x4){(float)i0[0], (float)i0[1], (float)i0[2], (float)i0[3]} * ws4[bj][0] * hs, v1 = (f32x4){(float)i1[0], (float)i1[1], (float)i1[2], (float)i1[3]} * ws4[bj][1] * hs;
                    *(f16x8*)(PQ + ((((row >> 5) * 256 + ((col0 + 32 * bj) >> 3)) * 32 + (row & 31)) << 3)) = (f16x8){(f16)v0[0], (f16)v0[1], (f16)v0[2], (f16)v0[3], (f16)v1[0], (f16)v1[1], (f16)v1[2], (f16)v1[3]}; } }
    }
};
}

__device__ __forceinline__ void ph2_inproj(const Args& a, int bid, int nb, unsigned char* lds) {
    const f16* H = (const f16*)(a.ws + WS_H); const f16* WIN = (const f16*)(a.ws + WS_WIN); const f16* WVT = (const f16*)(a.ws + WS_WVT);
    PG8_LAS unsigned char* l3 = (PG8_LAS unsigned char*)lds;
    { pg8::Gemm g{H, WIN, NT, NMAIN, ND}; pg8::StaticOrder S; S.init(NT, NMAIN, nb, bid);
      pg8::EpiMain E{a.ws, a.in[9], a.in[10]};
      pg8::gemm_phase(l3, g, S, E); }
    { pg8::Gemm g{WVT, H, 512, NT, ND}; pg8::StaticOrder S; S.init(512, NT, nb, bid);
      pg8::EpiVT E{(f16*)(a.ws + WS_VT)};
      pg8::gemm_phase(l3, g, S, E); }
}


constexpr int PPITCH = 1040;
__device__ __forceinline__ void ph3_pool_fast(const Args& a, int bid, int nb, unsigned char* lds) {
    int tid = threadIdx.x; asm volatile("" : "+v"(tid));
    const int cg8 = tid & 63, tq = tid >> 6, gch = cg8 >> 4, win = 2 << gch;
    const f16* Z = (const f16*)(a.ws + WS_U); f16* MIX = (f16*)(a.ws + WS_H);
    const f32x4 ps0 = *(const f32x4*)(a.in[7] + 8 * cg8), ps1 = *(const f32x4*)(a.in[7] + 8 * cg8 + 4), pg0 = *(const f32x4*)(a.in[8] + 8 * cg8), pg1 = *(const f32x4*)(a.in[8] + 8 * cg8 + 4);
    const float psc[8] = {ps0[0], ps0[1], ps0[2], ps0[3], ps1[0], ps1[1], ps1[2], ps1[3]}, pgn[8] = {pg0[0], pg0[1], pg0[2], pg0[3], pg1[0], pg1[1], pg1[2], pg1[3]};
    for (int item = bid; item < NT / 32; item += nb) {
        const int tb = item * 32 + 4 * tq, tl0 = tb % NS;
        const f16* up = Z + (size_t)(tb - tl0) * 512 + 8 * cg8;
        float sm[8];
#pragma unroll
        for (int j = 0; j < 8; ++j) sm[j] = 0.f;
        f16x8 hist_[15];
#pragma unroll
        for (int q = 0; q < 15; ++q) { const int rr = tl0 - 15 + q; hist_[q] = (q >= 16 - win && rr >= 0) ? *(const f16x8*)(up + (size_t)rr * 512) : (f16x8){0, 0, 0, 0, 0, 0, 0, 0}; }
        f16x8 cur_[4];
#pragma unroll
        for (int k = 0; k < 4; ++k) cur_[k] = *(const f16x8*)(up + (size_t)(tl0 + k) * 512);
#pragma unroll
        for (int q = 0; q < 15; ++q)
#pragma unroll
            for (int j = 0; j < 8; ++j) sm[j] += (float)hist_[q][j];
#pragma unroll
        for (int k = 0; k < 4; ++k) {
            const int tl = tl0 + k;
            const float ic = 1.f / (float)((tl + 1 < win) ? tl + 1 : win);
            float v[8]; float ss = 0.f;
#pragma unroll
            for (int j = 0; j < 8; ++j) { sm[j] += (float)cur_[k][j]; v[j] = (sm[j] * ic - (float)cur_[k][j]) * psc[j]; ss += v[j] * v[j]; }
            const float rstd = rsqrtf(wave_sum(ss) * (1.f / 512.f) + EPS);
            f16x8 o;
#pragma unroll
            for (int j = 0; j < 8; ++j) o[j] = (f16)(v[j] * rstd * pgn[j]);
            *(f16x8*)(MIX + (size_t)(tb + k) * ND + 8 * cg8) = o;
            if (k < 3) {
#pragma unroll
                for (int j = 0; j < 8; ++j) {
                    const int q = 16 - win + k;
                    float dv = 0.f;
#pragma unroll
                    for (int qq = 0; qq < 15; ++qq) if (qq == q) dv = (float)hist_[qq][j];
#pragma unroll
                    for (int kk = 0; kk < 3; ++kk) if (q == 15 + kk) dv = (float)cur_[kk][j];
                    sm[j] -= dv;
                }
            }
        }
    }
}


typedef float f32x2 __attribute__((ext_vector_type(2)));
typedef unsigned u32x4 __attribute__((ext_vector_type(4)));

constexpr int IDX_KPITCH = 16384 + 16;
constexpr int IDX_HPITCH = 516;
template <int NBL>
__device__ __forceinline__ int wave_pick(const unsigned (&cc)[NBL], unsigned target, int lane, unsigned& rem_out) {
    unsigned tot = 0u;
#pragma unroll
    for (int j = 0; j < NBL; ++j) tot += cc[j];
    unsigned S = tot;
#pragma unroll
    for (int o = 1; o < 64; o <<= 1) { const unsigned v = __shfl_down(S, o); if (lane + o < 64) S += v; }
    const unsigned above = S - tot;
    const bool hit = (above < target) && (S >= target);
    const u64 bal = __ballot(hit);
    const int L = bal ? __builtin_ctzll(bal) : 0;
    int bin = 0; unsigned rem = target;
    { unsigned run = above; bool done = false;
#pragma unroll
      for (int j = NBL - 1; j >= 0; --j) { if (!done) { if (run + cc[j] >= target) { bin = NBL * lane + j; rem = target - run; done = true; } else run += cc[j]; } } }
    bin = __shfl(bin, L); rem_out = __shfl(rem, L);
    return bin;
}
template <int MODE>
__device__ __forceinline__ void ph3_index_fast(const Args& a, int bid, int nb, unsigned char* lds) {
    int tid = threadIdx.x; asm volatile("" : "+v"(tid));
    const int lane = tid & 63, wave = __builtin_amdgcn_readfirstlane(tid >> 6), r = lane & 31, hh = lane >> 5;
    const f16* QI = (const f16*)(a.ws + WS_QI); const f16* KI = (const f16*)(a.ws + WS_KI); const float* WI = (const float*)(a.ws + WS_WI);
    u64* MASK = (u64*)(a.ws + WS_MASK);
    unsigned* hist = (unsigned*)(lds + 8 * IDX_KPITCH);
    f16x8 af[2][4]; f32x2 wv2[2][8];
#define IDX_LOAD_FRAGS(t0_) do { \
        _Pragma("unroll") for (int rt = 0; rt < 2; ++rt) { \
            _Pragma("unroll") for (int ks = 0; ks < 4; ++ks) af[rt][ks] = *(const f16x8*)(QI + ((((((size_t)((t0_) >> 3) * 2 + rt) * 4 + ks) * 2 + hh) * 32 + r) << 3)); \
            _Pragma("unroll") for (int qq = 0; qq < 2; ++qq) { const float* wp = WI + (size_t)((t0_) + 4 * rt + 2 * hh + qq) * 8; const f32x4 w0 = *(const f32x4*)wp * 0.125f, w1 = *(const f32x4*)(wp + 4) * 0.125f; \
                wv2[rt][4 * qq + 0] = (f32x2){w0[0], w0[1]}; wv2[rt][4 * qq + 1] = (f32x2){w0[2], w0[3]}; wv2[rt][4 * qq + 2] = (f32x2){w1[0], w1[1]}; wv2[rt][4 * qq + 3] = (f32x2){w1[2], w1[3]}; } \
        } } while (0)
    for (int round = 0; round * nb < 256; ++round) {
        const int p = round * nb + ((round & 1) ? (nb - 1 - bid) : bid);
        if (p < 256) { const int tg = p >> 3, b_ = p & 7, t0l = tg * 8, ch_ = t0l >> 6, t0_ = b_ * NS + t0l;
            if (tid < 8 * (ch_ + 1)) { const int q = tid / (ch_ + 1), w = tid % (ch_ + 1); MASK[((size_t)b_ * 128 + w) * NS + t0l + q] = ~0ull; } }
    }
#define IDX_P(round_) ((round_) * nb + (((round_) & 1) ? (nb - 1 - bid) : bid))
    int round = 0;
    while (round * nb < 8192 && !(IDX_P(round) >= 256 && IDX_P(round) < 8192)) ++round;
    if (round * nb < 8192) { const int p0 = IDX_P(round); IDX_LOAD_FRAGS((p0 & 7) * NS + (p0 >> 3) * 8); }
    for (; round * nb < 8192; ) {
        const int p = IDX_P(round);
        int rnext = round + 1;
        while (rnext * nb < 8192 && !(IDX_P(rnext) >= 256 && IDX_P(rnext) < 8192)) ++rnext;
        const bool has_next = rnext * nb < 8192;
        const int pn = has_next ? IDX_P(rnext) : p;
        const int tg = p >> 3, b = p & 7, t0l = tg * 8, ch = t0l >> 6, nadm = 64 * (ch + 1), t0 = b * NS + t0l;
        const int t0n = (pn & 7) * NS + (pn >> 3) * 8;
        round = has_next ? rnext : 8192;
        __syncthreads();
#pragma unroll
        for (int i = 0; i < 9; ++i) if (tid + i * NTHR < 8 * IDX_HPITCH) hist[tid + i * NTHR] = 0u;
        __syncthreads();
        const int nkb = nadm >> 5;
        const f16* kbase = KI + ((size_t)(b * (NS / 32)) * 8 + hh) * 256 + r * 8;
#define IDX_LOADB(dst, kb_) do { _Pragma("unroll") for (int ks = 0; ks < 4; ++ks) dst[ks] = *(const f16x8*)(kbase + ((size_t)(kb_) * 8 + 2 * ks) * 256); } while (0)
#define IDX_BLOCK(bfrag, kb_) do { \
            f32x16 acc[2]; \
            _Pragma("unroll") for (int rt = 0; rt < 2; ++rt) { acc[rt] = (f32x16){0.f, 0.f, 0.f, 0.f, 0.f, 0.f, 0.f, 0.f, 0.f, 0.f, 0.f, 0.f, 0.f, 0.f, 0.f, 0.f}; \
                _Pragma("unroll") for (int ks = 0; ks < 4; ++ks) acc[rt] = __builtin_amdgcn_mfma_f32_32x32x16_f16(af[rt][ks], bfrag[ks], acc[rt], 0, 0, 0); } \
            _Pragma("unroll") for (int rt = 0; rt < 2; ++rt) \
                _Pragma("unroll") for (int qq = 0; qq < 2; ++qq) { \
                    f32x2 t2 = (f32x2){0.f, 0.f}; \
                    _Pragma("unroll") for (int hp = 0; hp < 4; ++hp) { const f32x2 r2 = (f32x2){__int_as_float(max(__float_as_int(acc[rt][8 * qq + 2 * hp]), 0)), __int_as_float(max(__float_as_int(acc[rt][8 * qq + 2 * hp + 1]), 0))}; \
                        t2 = __builtin_elementwise_fma(wv2[rt][4 * qq + hp], r2, t2); } \
                    const float sc = t2[0] + t2[1]; \
                    const f16 sh = (f16)sc; const unsigned bits = (unsigned)__builtin_bit_cast(unsigned short, sh); \
                    const unsigned key = (bits & 0x8000u) ? (~bits & 0xFFFFu) : (bits | 0x8000u); \
                    const int q = 4 * rt + 2 * hh + qq; \
                    if (MODE != 2) *(u16*)(lds + q * IDX_KPITCH + ((kb_) * 32 + r) * 2) = (u16)key; \
                    if (MODE != 2 && MODE != 4) atomicAdd(&hist[q * IDX_HPITCH + (key >> 7)], (key & 64u) ? 0x10000u : 1u); \
                    if (MODE == 2) sink += key; \
                } } while (0)
        f16x8 bf0[4], bf1[4], bf2[4]; unsigned sink = 0u;
        if (wave >= 4) __builtin_amdgcn_s_sleep(5);
        if (wave < nkb) IDX_LOADB(bf0, wave);
        if (wave + 8 < nkb) IDX_LOADB(bf1, wave + 8);
        if (wave + 16 < nkb) IDX_LOADB(bf2, wave + 16);
        if (MODE != 3) for (int kb = wave; kb < nkb; kb += 24) {
            IDX_BLOCK(bf0, kb);
            if (kb + 24 < nkb) IDX_LOADB(bf0, kb + 24);
            if (kb + 8 < nkb) { IDX_BLOCK(bf1, kb + 8); if (kb + 32 < nkb) IDX_LOADB(bf1, kb + 32); }
            if (kb + 16 < nkb) { IDX_BLOCK(bf2, kb + 16); if (kb + 40 < nkb) IDX_LOADB(bf2, kb + 40); }
        }
#undef IDX_LOADB
#undef IDX_BLOCK
        if (MODE == 2 && sink == 0xdeadbeefu) hist[tid] = sink;
        IDX_LOAD_FRAGS(t0n);
        __syncthreads();
        if (MODE != 1) {
            unsigned* hw = hist + wave * IDX_HPITCH;
            const unsigned char* krow = lds + wave * IDX_KPITCH;
            unsigned rem1 = 0u, rem2 = 0u;
            int b1;
            {   const u32x4 d0 = *(const u32x4*)(hw + 8 * lane), d1 = *(const u32x4*)(hw + 8 * lane + 4);
                const unsigned dd[8] = {d0.x, d0.y, d0.z, d0.w, d1.x, d1.y, d1.z, d1.w};
                unsigned cc[16];
#pragma unroll
                for (int j = 0; j < 8; ++j) { cc[2 * j] = dd[j] & 0xFFFFu; cc[2 * j + 1] = dd[j] >> 16; }
                b1 = wave_pick<16>(cc, 256u, lane, rem1); }
            hw[lane] = 0u;
            const int nit = (nadm + 511) >> 9;
            for (int it = 0; it < nit; ++it) {
                const int idx = (it * 64 + lane) * 8;
                if (idx < nadm) { const u32x4 k4 = *(const u32x4*)(krow + idx * 2);
                    const unsigned kk[4] = {k4.x, k4.y, k4.z, k4.w};
                    unsigned hit = 0u;
#pragma unroll
                    for (int j = 0; j < 4; ++j) { hit |= (((kk[j] & 0xFFFFu) >> 6) == (unsigned)b1 ? 1u : 0u) << (2 * j); hit |= ((kk[j] >> 22) == (unsigned)b1 ? 1u : 0u) << (2 * j + 1); }
                    if (hit) {
#pragma unroll
                        for (int j = 0; j < 4; ++j) { const unsigned k0 = kk[j] & 0xFFFFu, k1 = kk[j] >> 16;
                            if (hit & (1u << (2 * j))) atomicAdd(&hw[k0 & 63u], 1u);
                            if (hit & (2u << (2 * j))) atomicAdd(&hw[k1 & 63u], 1u); }
                    } }
            }
            int b2;
            { const unsigned c1[1] = {hw[lane]}; b2 = wave_pick<1>(c1, rem1, lane, rem2); }
            const unsigned tau = ((unsigned)b1 << 6) | (unsigned)b2;
            const size_t mrow = (size_t)(t0 + wave) * 128;
            for (int it = 0; it < nit; ++it) {
                const int idx = (it * 64 + lane) * 8;
                unsigned byte = 0u;
                if (idx < nadm) { const u32x4 k4 = *(const u32x4*)(krow + idx * 2);
                    const unsigned kk[4] = {k4.x, k4.y, k4.z, k4.w};
#pragma unroll
                    for (int j = 0; j < 4; ++j) { byte |= ((kk[j] & 0xFFFFu) >= tau ? 1u : 0u) << (2 * j); byte |= ((kk[j] >> 16) >= tau ? 1u : 0u) << (2 * j + 1); } }
                unsigned lo = (lane & 4) ? 0u : (byte << (8 * (lane & 3))), hi = (lane & 4) ? (byte << (8 * (lane & 3))) : 0u;
                lo |= __shfl_xor(lo, 1); hi |= __shfl_xor(hi, 1); lo |= __shfl_xor(lo, 2); hi |= __shfl_xor(hi, 2); lo |= __shfl_xor(lo, 4); hi |= __shfl_xor(hi, 4);
                if ((lane & 7) == 0 && idx < nadm) { hw[64 + 2 * (it * 8 + (lane >> 3))] = lo; hw[64 + 2 * (it * 8 + (lane >> 3)) + 1] = hi; }
            }
        }
        __syncthreads();
        if (MODE != 1) { const int w = tid >> 2, qp = tid & 3;
            if (w <= ch) { const unsigned* ha = hist + (2 * qp) * IDX_HPITCH + 64 + 2 * w; const unsigned* hb = ha + IDX_HPITCH;
                *(u32x4*)(MASK + ((size_t)b * 128 + w) * NS + t0l + 2 * qp) = (u32x4){ha[0], ha[1], hb[0], hb[1]}; } }
    }
    __syncthreads();
}

constexpr int ATP = 144;
constexpr int ATT_QWORD = 3584 + 32 * 64;
template <int AMODE>
__device__ __forceinline__ void ph4_attn_fast(const Args& a, int bid, int nb, unsigned char* lds) {
    int tid = threadIdx.x; asm volatile("" : "+v"(tid));
    const int lane = tid & 63, wave = __builtin_amdgcn_readfirstlane(tid >> 6), r = lane & 31, hh = lane >> 5;
    const f16* Q = (const f16*)(a.ws + WS_Q); const f16* Kk = (const f16*)(a.ws + WS_K); const f16* VT = (const f16*)(a.ws + WS_VT);
    const u64* MASK = (const u64*)(a.ws + WS_MASK); f16* MIX = (f16*)(a.ws + WS_H); const float* og = a.in[11];
    unsigned char* Kl = lds; unsigned char* Vl = lds + 2 * 64 * ATP;
    const float LOG2E = 1.4426950408889634f, OFF = 8192.f;
    const int pir = 16 * (r >> 4) + 8 * ((r >> 2) & 1) + 4 * ((r >> 3) & 1) + (r & 3);
    const int srow = tid >> 3, schk = tid & 7;
    unsigned* aq = (unsigned*)(a.ws + WS_CTL) + ATT_QWORD;
    volatile unsigned* ucell = (volatile unsigned*)(lds + 6 * 64 * ATP);
    volatile unsigned* dflag = ucell + 8;
    const float kmax = __int_as_float(__builtin_amdgcn_readfirstlane(__float_as_int(1.01f * 8.f * wave_max(fabsf(a.in[10][lane])))));
    int upar = 0;
    for (;;) {
        if (tid == 0) ucell[upar] = __hip_atomic_fetch_add(aq, 1u, __ATOMIC_RELAXED, __HIP_MEMORY_SCOPE_AGENT);
        if (tid < 8) dflag[tid] = 0u;
        __syncthreads();
        const unsigned u = ucell[upar]; upar ^= 1;
        if (u >= 2048u) break;
        const int h = 7 - (int)(u >> 8), qb = 31 - (int)((u & 255u) >> 3), b = (int)(u & 7u);
        const int q0l = qb * 256, tq = q0l + 32 * wave + r, cw = 4 * qb + (wave >> 1), top = 4 * qb + 3;
        const size_t t = (size_t)b * NS + tq;
        const float slope = exp2f(-(float)(h + 1)) * LOG2E;
        f16x8 qf[4];
#pragma unroll
        for (int ks = 0; ks < 4; ++ks) { const f16x8 qv = *(const f16x8*)(Q + t * 512 + h * 64 + 16 * ks + 8 * hh);
#pragma unroll
            for (int j = 0; j < 8; ++j) qf[ks][j] = (f16)((float)qv[j] * (0.125f * LOG2E)); }
        float qss = 0.f;
#pragma unroll
        for (int ks = 0; ks < 4; ++ks)
#pragma unroll
            for (int j = 0; j < 8; ++j) qss += (float)qf[ks][j] * (float)qf[ks][j];
        qss += __shfl_xor(qss, 32);
        const float Sb = __int_as_float(__builtin_amdgcn_readfirstlane(__float_as_int(wave_max(sqrtf(qss)) * kmax)));
        const float rowc = OFF + slope * (float)(tq - q0l);
        float m = 1000.f, l = 0.f;
        f32x16 O[2];
#pragma unroll
        for (int dt = 0; dt < 2; ++dt) O[dt] = (f32x16){0.f, 0.f, 0.f, 0.f, 0.f, 0.f, 0.f, 0.f, 0.f, 0.f, 0.f, 0.f, 0.f, 0.f, 0.f, 0.f};
        const f16* kg = Kk + ((size_t)b * NS + srow) * 512 + h * 64 + schk * 8;
        const f16* vg = VT + (size_t)(h * 64 + srow) * NT + (size_t)b * NS + schk * 8;
        f16x8 kr0, kr1, vr0, vr1; u64 mw0 = 0ull, mw1 = 0ull;
#define ATT_LOAD(kr, vr, mwv, jj) do { if ((jj) >= 0) { kr = *(const f16x8*)(kg + (size_t)(jj) * 64 * 512); vr = *(const f16x8*)(vg + (jj) * 64); mwv = ((jj) <= cw) ? MASK[((size_t)b * 128 + (jj)) * NS + tq] : 0ull; } } while (0)
        ATT_LOAD(kr0, vr0, mw0, top); ATT_LOAD(kr1, vr1, mw1, top - 1);
        int buf = 0; bool wdone = false, stop = false;
        auto step = [&](f16x8& kreg, f16x8& vreg, u64& mwr, const int j) {
            *(f16x8*)(Kl + buf * 64 * ATP + srow * ATP + schk * 16) = kreg;
            *(f16x8*)(Vl + buf * 64 * ATP + srow * ATP + schk * 16) = vreg;
            const u64 mw = mwr;
            asm volatile("s_waitcnt lgkmcnt(0)" ::: "memory"); __builtin_amdgcn_s_barrier(); asm volatile("" ::: "memory");
            {
                const unsigned jp = (unsigned)(j + 1);
                if ((dflag[0] > jp) & (dflag[1] > jp) & (dflag[2] > jp) & (dflag[3] > jp) & (dflag[4] > jp) & (dflag[5] > jp) & (dflag[6] > jp) & (dflag[7] > jp)) { stop = true; return; }
            }
            ATT_LOAD(kreg, vreg, mwr, j - 2);
            if (!wdone && j < cw) { const float lmax = Sb + OFF + slope * (float)(64 * j + 63 - q0l); if (__all(lmax - m < -28.f)) { wdone = true; if (lane == 0) dflag[wave] = (unsigned)(j + 1); } }
            if (j <= cw && !wdone) {
                const unsigned char* kb_ = Kl + buf * 64 * ATP + pir * ATP + 16 * hh;
                f16x8 fr8[8];
#pragma unroll
                for (int kt = 0; kt < 2; ++kt)
#pragma unroll
                    for (int ks = 0; ks < 4; ++ks) fr8[kt * 4 + ks] = *(const f16x8*)(kb_ + kt * 32 * ATP + ks * 32);
                f32x16 sa[2];
                if (j == cw) {
#pragma unroll
                    for (int kt = 0; kt < 2; ++kt)
#pragma unroll
                        for (int rg = 0; rg < 16; ++rg) { const float x = (float)(64 * j + 32 * kt + 16 * (rg >> 3) + 8 * hh + (rg & 7) - tq); sa[kt][rg] = rowc - slope * fabsf(x); }
                } else {
                    const float base = OFF + slope * (float)(64 * j + 8 * hh - q0l);
#pragma unroll
                    for (int kt = 0; kt < 2; ++kt)
#pragma unroll
                        for (int rg = 0; rg < 16; ++rg) sa[kt][rg] = __builtin_fmaf(slope, (float)(32 * kt + 16 * (rg >> 3) + (rg & 7)), base);
                }
                __builtin_amdgcn_sched_barrier(0);
                __builtin_amdgcn_s_setprio(1);
#pragma unroll
                for (int kt = 0; kt < 2; ++kt)
#pragma unroll
                    for (int ks = 0; ks < 4; ++ks) sa[kt] = __builtin_amdgcn_mfma_f32_32x32x16_f16(fr8[kt * 4 + ks], qf[ks], sa[kt], 0, 0, 0);
                __builtin_amdgcn_s_setprio(0);
                __builtin_amdgcn_sched_barrier(0);
                const unsigned char* vb_ = Vl + buf * 64 * ATP + r * ATP + 16 * hh;
#pragma unroll
                for (int dt = 0; dt < 2; ++dt)
#pragma unroll
                    for (int kt = 0; kt < 2; ++kt)
#pragma unroll
                        for (int s2 = 0; s2 < 2; ++s2) fr8[dt * 4 + kt * 2 + s2] = *(const f16x8*)(vb_ + dt * 32 * ATP + kt * 64 + s2 * 32);
                __builtin_amdgcn_sched_barrier(0);
                float rm = 0.f;
#pragma unroll
                for (int kt = 0; kt < 2; ++kt) { const unsigned w32 = (unsigned)(kt ? (mw >> 32) : mw) >> (8 * hh);
#pragma unroll
                    for (int rg = 0; rg < 16; ++rg) { const int tm = __builtin_amdgcn_sbfe((int)w32, 16 * (rg >> 3) + (rg & 7), 1);
                        const float L = __int_as_float(__float_as_int(sa[kt][rg]) & tm); sa[kt][rg] = L; rm = fmaxf(rm, L); } }
                rm = fmaxf(rm, __shfl_xor(rm, 32));
                const float mn = fmaxf(m, rm);
                if (__any(mn > m)) { const float al = __builtin_amdgcn_exp2f(m - mn); l *= al;
#pragma unroll
                    for (int dt = 0; dt < 2; ++dt)
#pragma unroll
                        for (int rg = 0; rg < 16; ++rg) O[dt][rg] *= al; }
                m = mn;
                f16x8 pf[2][2];
                float l0 = 0.f, l1 = 0.f;
#pragma unroll
                for (int kt = 0; kt < 2; ++kt)
#pragma unroll
                    for (int rg = 0; rg < 16; ++rg) { const float pp = __builtin_amdgcn_exp2f(sa[kt][rg] - m); if (rg & 1) l1 += pp; else l0 += pp; pf[kt][rg >> 3][rg & 7] = (f16)pp; }
                l += l0 + l1;
                __builtin_amdgcn_sched_barrier(0);
                __builtin_amdgcn_s_setprio(1);
#pragma unroll
                for (int dt = 0; dt < 2; ++dt)
#pragma unroll
                    for (int kt = 0; kt < 2; ++kt)
#pragma unroll
                        for (int s2 = 0; s2 < 2; ++s2) O[dt] = __builtin_amdgcn_mfma_f32_32x32x16_f16(fr8[dt * 4 + kt * 2 + s2], pf[kt][s2], O[dt], 0, 0, 0);
                __builtin_amdgcn_s_setprio(0);
            }
            buf ^= 1;
        };
        for (int j = top; j >= 0; j -= 2) {
            step(kr0, vr0, mw0, j); if (stop) break;
            if (j - 1 >= 0) { step(kr1, vr1, mw1, j - 1); if (stop) break; }
        }
#undef ATT_LOAD
        l += __shfl_xor(l, 32);
        const float inv = 1.f / l;
        float ss = 0.f;
#pragma unroll
        for (int dt = 0; dt < 2; ++dt)
#pragma unroll
            for (int rg = 0; rg < 16; ++rg) { O[dt][rg] *= inv; ss += O[dt][rg] * O[dt][rg]; }
        ss += __shfl_xor(ss, 32);
        const float rstd = rsqrtf(ss * (1.f / 64.f) + EPS);
#pragma unroll
        for (int dt = 0; dt < 2; ++dt)
#pragma unroll
            for (int g4 = 0; g4 < 4; ++g4) { const int d = 32 * dt + 8 * g4 + 4 * hh; const f32x4 gg = *(const f32x4*)(og + h * 64 + d);
                f16x4 o4; o4.x = (f16)(O[dt][4 * g4 + 0] * rstd * gg.x); o4.y = (f16)(O[dt][4 * g4 + 1] * rstd * gg.y); o4.z = (f16)(O[dt][4 * g4 + 2] * rstd * gg.z); o4.w = (f16)(O[dt][4 * g4 + 3] * rstd * gg.w);
                *(f16x4*)(MIX + t * ND + 512 + h * 64 + d) = o4; }
        __syncthreads();
    }
}

__device__ __forceinline__ void ph5_outproj(const Args& a, int bid, int nb, unsigned char* lds) {
    pg8::Gemm g{(const f16*)(a.ws + WS_H), (const f16*)(a.ws + WS_WOUT), NT, 1024, ND}; pg8::StaticOrder S; S.init(NT, 1024, nb, bid);
    pg8::EpiOut E{a.in[0], (const float*)(a.ws + WS_MOD), (f16*)(a.ws + WS_X1)};
    pg8::gemm_phase((PG8_LAS unsigned char*)lds, g, S, E);
}

__device__ __forceinline__ void ph7_peerq(const Args& a, int bid, int nb, unsigned char* lds) {
    pg8::Gemm g{(const f16*)(a.ws + WS_HQ), (const f16*)(a.ws + WS_WQ8), NT, 2048, ND / 2}; pg8::StaticOrder S; S.init(NT, 2048, nb, bid);
    pg8::EpiPQ E{(f16*)(a.ws + WS_PQ), (const float*)(a.ws + WS_HSC), (const float*)(a.ws + WS_WSC)};
    pg8::gemm_phase<pg8::EpiPQ, true>((PG8_LAS unsigned char*)lds, g, S, E);
}


__device__ __forceinline__ unsigned f2skey(float f) { const unsigned u = __float_as_uint(f); return (u & 0x80000000u) ? ~u : (u | 0x80000000u); }
__device__ __forceinline__ float skey2f(unsigned k) { return __uint_as_float((k & 0x80000000u) ? (k & 0x7FFFFFFFu) : ~k); }
#define CE_(a_, b_) do { const unsigned t__ = max(a_, b_); b_ = min(a_, b_); a_ = t__; } while (0)
#define SORT16_DESC(v) do { CE_(v[0], v[1]); CE_(v[2], v[3]); CE_(v[0], v[2]); CE_(v[1], v[3]); CE_(v[1], v[2]); CE_(v[4], v[5]); CE_(v[6], v[7]); CE_(v[4], v[6]); CE_(v[5], v[7]); CE_(v[5], v[6]); CE_(v[0], v[4]); CE_(v[2], v[6]); CE_(v[2], v[4]); CE_(v[1], v[5]); CE_(v[3], v[7]); CE_(v[3], v[5]); CE_(v[1], v[2]); CE_(v[3], v[4]); CE_(v[5], v[6]); CE_(v[8], v[9]); CE_(v[10], v[11]); CE_(v[8], v[10]); CE_(v[9], v[11]); CE_(v[9], v[10]); CE_(v[12], v[13]); CE_(v[14], v[15]); CE_(v[12], v[14]); CE_(v[13], v[15]); CE_(v[13], v[14]); CE_(v[8], v[12]); CE_(v[10], v[14]); CE_(v[10], v[12]); CE_(v[9], v[13]); CE_(v[11], v[15]); CE_(v[11], v[13]); CE_(v[9], v[10]); CE_(v[11], v[12]); CE_(v[13], v[14]); CE_(v[0], v[8]); CE_(v[4], v[12]); CE_(v[4], v[8]); CE_(v[2], v[10]); CE_(v[6], v[14]); CE_(v[6], v[10]); CE_(v[2], v[4]); CE_(v[6], v[8]); CE_(v[10], v[12]); CE_(v[1], v[9]); CE_(v[5], v[13]); CE_(v[5], v[9]); CE_(v[3], v[11]); CE_(v[7], v[15]); CE_(v[7], v[11]); CE_(v[3], v[5]); CE_(v[7], v[9]); CE_(v[11], v[13]); CE_(v[1], v[2]); CE_(v[3], v[4]); CE_(v[5], v[6]); CE_(v[7], v[8]); CE_(v[9], v[10]); CE_(v[11], v[12]); CE_(v[13], v[14]); } while (0)
#define BITONIC16_DESC(v) do { CE_(v[0], v[8]); CE_(v[1], v[9]); CE_(v[2], v[10]); CE_(v[3], v[11]); CE_(v[4], v[12]); CE_(v[5], v[13]); CE_(v[6], v[14]); CE_(v[7], v[15]); CE_(v[0], v[4]); CE_(v[1], v[5]); CE_(v[2], v[6]); CE_(v[3], v[7]); CE_(v[8], v[12]); CE_(v[9], v[13]); CE_(v[10], v[14]); CE_(v[11], v[15]); CE_(v[0], v[2]); CE_(v[1], v[3]); CE_(v[4], v[6]); CE_(v[5], v[7]); CE_(v[8], v[10]); CE_(v[9], v[11]); CE_(v[12], v[14]); CE_(v[13], v[15]); CE_(v[0], v[1]); CE_(v[2], v[3]); CE_(v[4], v[5]); CE_(v[6], v[7]); CE_(v[8], v[9]); CE_(v[10], v[11]); CE_(v[12], v[13]); CE_(v[14], v[15]); } while (0)
#define MERGE16_DESC(dst, other) do { unsigned c__[16]; _Pragma("unroll") for (int i__ = 0; i__ < 16; ++i__) c__[i__] = max(dst[i__], other[15 - i__]); BITONIC16_DESC(c__); _Pragma("unroll") for (int i__ = 0; i__ < 16; ++i__) dst[i__] = c__[i__]; } while (0)
#define TOP16_INSERT(v, x_) do { unsigned x__ = (x_); _Pragma("unroll") for (int k_ = 0; k_ < 16; ++k_) { const unsigned t__ = max(v[k_], x__); x__ = min(v[k_], x__); v[k_] = t__; } } while (0)
__device__ __forceinline__ void ph8_peersel_fast(const Args& a, int bid, int nb, unsigned char* lds) {
    int tid = threadIdx.x; asm volatile("" : "+v"(tid));
    const int lane = tid & 63, wave = __builtin_amdgcn_readfirstlane(tid >> 6), r = lane & 31, hh = lane >> 5;
    const f16* PQ = (const f16*)(a.ws + WS_PQ);
    u16* EID = (u16*)(a.ws + WS_EID); float* GW = (float*)(a.ws + WS_GW);
    unsigned char* wl = lds + wave * 2048 + lane * 32;
    for (int item = bid * NWAVE + wave; item < (NT / 32) * 8; item += nb * NWAVE) {
        const int tt = item >> 3, h = item & 7, t0 = tt * 32;
        unsigned top[2][16];
#pragma unroll
        for (int p = 0; p < 2; ++p) {
            f16x8 sq[8];
#pragma unroll
            for (int c = 0; c < 8; ++c) sq[c] = *(const f16x8*)(PQ + ((((size_t)tt * 256 + h * 32 + p * 16 + 8 * hh + c) * 32 + r) << 3));
#pragma unroll
            for (int k = 0; k < 16; ++k) top[p][k] = 0u;
#pragma unroll
            for (int g = 0; g < 4; ++g) {
                unsigned ky[16];
#pragma unroll
                for (int i = 0; i < 16; ++i) { const unsigned n = 64u * hh + 16u * g + i; ky[i] = (f2skey((float)sq[2 * g + (i >> 3)][i & 7]) & ~127u) | n; }
                SORT16_DESC(ky); MERGE16_DESC(top[p], ky);
            }
            unsigned oth[16];
#pragma unroll
            for (int k = 0; k < 16; ++k) oth[k] = __shfl_xor(top[p][k], 32);
            MERGE16_DESC(top[p], oth);
            asm volatile("" ::: "memory");
        }
#pragma unroll
        for (int k = 0; k < 16; k += 4) {
            *(unsigned*)(wl + k) = (top[0][k] & 127u) | ((top[0][k + 1] & 127u) << 8) | ((top[0][k + 2] & 127u) << 16) | ((top[0][k + 3] & 127u) << 24);
            *(unsigned*)(wl + 16 + k) = (top[1][k] & 127u) | ((top[1][k + 1] & 127u) << 8) | ((top[1][k + 2] & 127u) << 16) | ((top[1][k + 3] & 127u) << 24);
        }
        float fa[16], fb[16];
#pragma unroll
        for (int k = 0; k < 16; ++k) { fa[k] = skey2f(top[0][k] & ~127u); fb[k] = skey2f(top[1][k] & ~127u); }
        unsigned cg[4][16];
        cg[0][0] = (f2skey(fa[0] + fb[0]) & ~255u) | 0u;
        cg[0][1] = (f2skey(fa[0] + fb[1]) & ~255u) | 1u;
        cg[0][2] = (f2skey(fa[0] + fb[2]) & ~255u) | 2u;
        cg[0][3] = (f2skey(fa[0] + fb[3]) & ~255u) | 3u;
        cg[0][4] = (f2skey(fa[0] + fb[4]) & ~255u) | 4u;
        cg[0][5] = (f2skey(fa[0] + fb[5]) & ~255u) | 5u;
        cg[0][6] = (f2skey(fa[0] + fb[6]) & ~255u) | 6u;
        cg[0][7] = (f2skey(fa[0] + fb[7]) & ~255u) | 7u;
        cg[0][8] = (f2skey(fa[0] + fb[8]) & ~255u) | 8u;
        cg[0][9] = (f2skey(fa[0] + fb[9]) & ~255u) | 9u;
        cg[0][10] = (f2skey(fa[0] + fb[10]) & ~255u) | 10u;
        cg[0][11] = (f2skey(fa[0] + fb[11]) & ~255u) | 11u;
        cg[0][12] = (f2skey(fa[0] + fb[12]) & ~255u) | 12u;
        cg[0][13] = (f2skey(fa[0] + fb[13]) & ~255u) | 13u;
        cg[0][14] = (f2skey(fa[0] + fb[14]) & ~255u) | 14u;
        cg[0][15] = (f2skey(fa[0] + fb[15]) & ~255u) | 15u;
        cg[1][0] = (f2skey(fa[1] + fb[0]) & ~255u) | 16u;
        cg[1][1] = (f2skey(fa[1] + fb[1]) & ~255u) | 17u;
        cg[1][2] = (f2skey(fa[1] + fb[2]) & ~255u) | 18u;
        cg[1][3] = (f2skey(fa[1] + fb[3]) & ~255u) | 19u;
        cg[1][4] = (f2skey(fa[1] + fb[4]) & ~255u) | 20u;
        cg[1][5] = (f2skey(fa[1] + fb[5]) & ~255u) | 21u;
        cg[1][6] = (f2skey(fa[1] + fb[6]) & ~255u) | 22u;
        cg[1][7] = (f2skey(fa[1] + fb[7]) & ~255u) | 23u;
        cg[1][8] = (f2skey(fa[2] + fb[0]) & ~255u) | 32u;
        cg[1][9] = (f2skey(fa[2] + fb[1]) & ~255u) | 33u;
        cg[1][10] = (f2skey(fa[2] + fb[2]) & ~255u) | 34u;
        cg[1][11] = (f2skey(fa[2] + fb[3]) & ~255u) | 35u;
        cg[1][12] = (f2skey(fa[2] + fb[4]) & ~255u) | 36u;
        cg[1][13] = (f2skey(fa[3] + fb[0]) & ~255u) | 48u;
        cg[1][14] = (f2skey(fa[3] + fb[1]) & ~255u) | 49u;
        cg[1][15] = (f2skey(fa[3] + fb[2]) & ~255u) | 50u;
        cg[2][0] = (f2skey(fa[3] + fb[3]) & ~255u) | 51u;
        cg[2][1] = (f2skey(fa[4] + fb[0]) & ~255u) | 64u;
        cg[2][2] = (f2skey(fa[4] + fb[1]) & ~255u) | 65u;
        cg[2][3] = (f2skey(fa[4] + fb[2]) & ~255u) | 66u;
        cg[2][4] = (f2skey(fa[5] + fb[0]) & ~255u) | 80u;
        cg[2][5] = (f2skey(fa[5] + fb[1]) & ~255u) | 81u;
        cg[2][6] = (f2skey(fa[6] + fb[0]) & ~255u) | 96u;
        cg[2][7] = (f2skey(fa[6] + fb[1]) & ~255u) | 97u;
        cg[2][8] = (f2skey(fa[7] + fb[0]) & ~255u) | 112u;
        cg[2][9] = (f2skey(fa[7] + fb[1]) & ~255u) | 113u;
        cg[2][10] = (f2skey(fa[8] + fb[0]) & ~255u) | 128u;
        cg[2][11] = (f2skey(fa[9] + fb[0]) & ~255u) | 144u;
        cg[2][12] = (f2skey(fa[10] + fb[0]) & ~255u) | 160u;
        cg[2][13] = (f2skey(fa[11] + fb[0]) & ~255u) | 176u;
        cg[2][14] = (f2skey(fa[12] + fb[0]) & ~255u) | 192u;
        cg[2][15] = (f2skey(fa[13] + fb[0]) & ~255u) | 208u;
        cg[3][0] = (f2skey(fa[14] + fb[0]) & ~255u) | 224u;
        cg[3][1] = (f2skey(fa[15] + fb[0]) & ~255u) | 240u;
        cg[3][2] = 0u;
        cg[3][3] = 0u;
        cg[3][4] = 0u;
        cg[3][5] = 0u;
        cg[3][6] = 0u;
        cg[3][7] = 0u;
        cg[3][8] = 0u;
        cg[3][9] = 0u;
        cg[3][10] = 0u;
        cg[3][11] = 0u;
        cg[3][12] = 0u;
        cg[3][13] = 0u;
        cg[3][14] = 0u;
        cg[3][15] = 0u;
        SORT16_DESC(cg[0]); SORT16_DESC(cg[1]); SORT16_DESC(cg[2]); SORT16_DESC(cg[3]);
        MERGE16_DESC(cg[0], cg[1]); MERGE16_DESC(cg[2], cg[3]); MERGE16_DESC(cg[0], cg[2]);
        unsigned ct[16];
#pragma unroll
        for (int k = 0; k < 16; ++k) ct[k] = cg[0][k];
        float sc[16]; float den = 0.f; const float s0 = skey2f(ct[0] & ~255u);
#pragma unroll
        for (int k = 0; k < 16; ++k) { sc[k] = __expf(skey2f(ct[k] & ~255u) - s0); den += sc[k]; }
        const float inv = 1.f / den;
        if (hh == 0) {
            u16 ev[16];
#pragma unroll
            for (int k = 0; k < 16; ++k) { const unsigned ij = ct[k] & 255u; const unsigned i1 = wl[ij >> 4], i2 = wl[16 + (ij & 15u)]; ev[k] = (u16)(i1 * 128u + i2); }
            const size_t o = (size_t)(t0 + r) * 128 + h * 16;
#pragma unroll
            for (int k = 0; k < 16; k += 8) {
                *(u32x4*)(EID + o + k) = (u32x4){(unsigned)ev[k] | ((unsigned)ev[k + 1] << 16), (unsigned)ev[k + 2] | ((unsigned)ev[k + 3] << 16), (unsigned)ev[k + 4] | ((unsigned)ev[k + 5] << 16), (unsigned)ev[k + 6] | ((unsigned)ev[k + 7] << 16)};
            }
#pragma unroll
            for (int k = 0; k < 16; k += 4) *(f32x4*)(GW + o + k) = (f32x4){sc[k] * inv, sc[k + 1] * inv, sc[k + 2] * inv, sc[k + 3] * inv};
        }
    }
}

typedef _Float16 f16x2 __attribute__((ext_vector_type(2)));
__device__ __forceinline__ float gelu_erf(float d) { return 0.5f * d * (1.f + erff(d * 0.70710678118654752f)); }
constexpr int PQ_WORD0 = 3584, PQ_CHUNK = 64, PQ_NCHUNK = NT / PQ_CHUNK, PQ_HALF = PQ_NCHUNK / 2;
constexpr size_t WS_PART = 208 * MiB;
__device__ __forceinline__ unsigned xcc_id_() { return (unsigned)__builtin_amdgcn_s_getreg((3 << 11) | 20) & 7u; }
template <int VPHASE>
__device__ __forceinline__ void ph9_sliced(const Args& a, unsigned char* lds) {
    int tid_ = threadIdx.x; asm volatile("" : "+v"(tid_)); const int lane = tid_ & 63, wave = __builtin_amdgcn_readfirstlane(tid_ >> 6);
    const int g8 = lane >> 3, c8 = lane & 7;
    const unsigned char* HP = a.ws + WS_HP; const float* HSC = (const float*)(a.ws + WS_HSC); const unsigned char* TAB = a.ws + (VPHASE ? WS_VP : WS_UT);
    const u16* EID = (const u16*)(a.ws + WS_EID); const unsigned* GW = (const unsigned*)(a.ws + WS_GW); float* PART = (float*)(a.ws + WS_PART); const float* WSUM = (const float*)(a.ws + WS_WSUM);
    const float* mod = (const float*)(a.ws + WS_MOD); float* out = a.out; const f16* X1 = (const f16*)(a.ws + WS_X1);
    unsigned* qw = (unsigned*)(a.ws + WS_CTL) + PQ_WORD0 + (VPHASE ? 8 * 64 : 0);
    volatile unsigned* cslot = (volatile unsigned*)lds;
    const bool b5 = (lane & 32) != 0, b4 = (lane & 16) != 0, b3 = (lane & 8) != 0, b2 = (lane & 4) != 0, b1 = (lane & 2) != 0, b0 = (lane & 1) != 0;
    const unsigned x0 = xcc_id_();
    int par = 0;
    for (int k = 0; k < 8; ++k) {
        const unsigned qi_ = (x0 + (unsigned)k) & 7u, sl = qi_ & 3u, half = qi_ >> 2;
        unsigned cur = 0u;
        if (tid_ == 0) cur = __hip_atomic_fetch_add(qw + 64 * qi_, 1u, __ATOMIC_RELAXED, __HIP_MEMORY_SCOPE_AGENT);
        for (;;) {
            if (tid_ == 0) cslot[par] = cur;
            __syncthreads();
            const unsigned c = cslot[par]; par ^= 1;
            if (c >= (unsigned)PQ_HALF) break;
            if (tid_ == 0) cur = __hip_atomic_fetch_add(qw + 64 * qi_, 1u, __ATOMIC_RELAXED, __HIP_MEMORY_SCOPE_AGENT);
            const int tb = (int)(half * PQ_HALF + c) * PQ_CHUNK + wave * (PQ_CHUNK / NWAVE);
            const unsigned char* tsl = TAB + 128 * sl + 16 * c8;
#pragma unroll 1
            for (int i8 = 0; i8 < PQ_CHUNK / NWAVE; ++i8) {
                const int t = tb + i8;
                const u32x4 e0 = *(const u32x4*)(EID + (size_t)t * 128 + 16 * g8), e1 = *(const u32x4*)(EID + (size_t)t * 128 + 16 * g8 + 8);
                const unsigned ew[8] = {e0.x, e0.y, e0.z, e0.w, e1.x, e1.y, e1.z, e1.w};
                u32x4 r8[16];
#pragma unroll
                for (int i = 0; i < 16; ++i) { const unsigned eid = (i & 1) ? (ew[i >> 1] >> 16) : (ew[i >> 1] & 0xFFFFu); r8[i] = *(const u32x4*)(tsl + (size_t)eid * 512); }
                if (!VPHASE) {
                    const u32x4 hh4 = *(const u32x4*)(HP + (size_t)t * 1024 + 128 * sl + 16 * c8), hl4 = *(const u32x4*)(HP + (size_t)t * 1024 + 512 + 128 * sl + 16 * c8);
                    const float hsc = 0.5f * HSC[t];
                    int hs1 = 0, hs0 = 0;
#pragma unroll
                    for (int j = 0; j < 4; ++j) { hs1 = __builtin_amdgcn_sdot8((int)hh4[j], 0x11111111, hs1, false); hs0 = __builtin_amdgcn_sdot8((int)hl4[j], 0x11111111, hs0, false); }
                    const int hsum = 16 * hs1 + hs0;
                    float p[16];
#pragma unroll
                    for (int i = 0; i < 16; ++i) { int d1 = 0, d0 = 0;
#pragma unroll
                        for (int j = 0; j < 4; ++j) { d1 = __builtin_amdgcn_sdot8((int)hh4[j], (int)r8[i][j], d1, false); d0 = __builtin_amdgcn_sdot8((int)hl4[j], (int)r8[i][j], d0, false); }
                        p[i] = (float)(2 * (16 * d1 + d0) + hsum); }
                    float q8[8], q4[4], r2[2];
#pragma unroll
                    for (int ii = 0; ii < 8; ++ii) { const float keep = b2 ? p[8 + ii] : p[ii], send = b2 ? p[ii] : p[8 + ii]; q8[ii] = keep + __shfl_xor(send, 4); }
#pragma unroll
                    for (int ii = 0; ii < 4; ++ii) { const float keep = b1 ? q8[4 + ii] : q8[ii], send = b1 ? q8[ii] : q8[4 + ii]; q4[ii] = keep + __shfl_xor(send, 2); }
#pragma unroll
                    for (int ii = 0; ii < 2; ++ii) { const float keep = b0 ? q4[2 + ii] : q4[ii], send = b0 ? q4[ii] : q4[2 + ii]; r2[ii] = keep + __shfl_xor(send, 1); }
                    *(f32x2*)(PART + ((size_t)sl * NT + t) * 128 + 16 * g8 + 2 * c8) = (f32x2){r2[0] * hsc, r2[1] * hsc};
                } else {
                    const u32x4* wp = (const u32x4*)(GW + (size_t)t * 128 + 16 * g8);
                    const u32x4 wq0 = wp[0], wq1 = wp[1], wq2 = wp[2], wq3 = wp[3];
                    const unsigned wv[16] = {wq0[0], wq0[1], wq0[2], wq0[3], wq1[0], wq1[1], wq1[2], wq1[3], wq2[0], wq2[1], wq2[2], wq2[3], wq3[0], wq3[1], wq3[2], wq3[3]};
                    const f16 off = (f16)(-7.5f * 5.9604644775390625e-08f * WSUM[(size_t)t * 8 + g8]);
                    f16x2 acc2[16];
#pragma unroll
                    for (int j = 0; j < 16; ++j) acc2[j] = (f16x2){off, off};
#pragma unroll
                    for (int i = 0; i < 16; ++i) { const f16x2 wa = __builtin_bit_cast(f16x2, wv[i]); const f16x2 wb = wa * (f16x2){(f16)0.0625f, (f16)0.0625f};
#pragma unroll
                        for (int j = 0; j < 4; ++j) { const unsigned x = r8[i][j], y = x >> 8;
                            acc2[4 * j]     = __builtin_elementwise_fma(wa, __builtin_bit_cast(f16x2, x & 0x000F000Fu), acc2[4 * j]);
                            acc2[4 * j + 1] = __builtin_elementwise_fma(wb, __builtin_bit_cast(f16x2, x & 0x00F000F0u), acc2[4 * j + 1]);
                            acc2[4 * j + 2] = __builtin_elementwise_fma(wa, __builtin_bit_cast(f16x2, y & 0x000F000Fu), acc2[4 * j + 2]);
                            acc2[4 * j + 3] = __builtin_elementwise_fma(wb, __builtin_bit_cast(f16x2, y & 0x00F000F0u), acc2[4 * j + 3]); } }
                    unsigned q8[8], q4[4], r2[2];
#pragma unroll
                    for (int ii = 0; ii < 8; ++ii) { const unsigned lo_ = __builtin_bit_cast(unsigned, acc2[ii]), hi_ = __builtin_bit_cast(unsigned, acc2[8 + ii]); const unsigned keep = b5 ? hi_ : lo_, send = b5 ? lo_ : hi_;
                        q8[ii] = __builtin_bit_cast(unsigned, __builtin_bit_cast(f16x2, keep) + __builtin_bit_cast(f16x2, (unsigned)__shfl_xor((int)send, 32))); }
#pragma unroll
                    for (int ii = 0; ii < 4; ++ii) { const unsigned keep = b4 ? q8[4 + ii] : q8[ii], send = b4 ? q8[ii] : q8[4 + ii];
                        q4[ii] = __builtin_bit_cast(unsigned, __builtin_bit_cast(f16x2, keep) + __builtin_bit_cast(f16x2, (unsigned)__shfl_xor((int)send, 16))); }
#pragma unroll
                    for (int ii = 0; ii < 2; ++ii) { const unsigned keep = b3 ? q4[2 + ii] : q4[ii], send = b3 ? q4[ii] : q4[2 + ii];
                        r2[ii] = __builtin_bit_cast(unsigned, __builtin_bit_cast(f16x2, keep) + __builtin_bit_cast(f16x2, (unsigned)__shfl_xor((int)send, 8))); }
                    const f16x2 ra = __builtin_bit_cast(f16x2, r2[0]), rb = __builtin_bit_cast(f16x2, r2[1]);
                    const int ch = 256 * sl + 32 * c8 + (b5 ? 16 : 0) + (b4 ? 8 : 0) + (b3 ? 2 : 0);
                    float* op = out + (size_t)t * ND + ch; const float* g2 = mod + (t / NS) * 6144 + 5120 + ch; const f16* xp = X1 + (size_t)t * ND + ch;
                    const f16x2 xa = *(const f16x2*)xp, xb = *(const f16x2*)(xp + 4); const f32x2 ga = *(const f32x2*)g2, gb = *(const f32x2*)(g2 + 4);
                    const float sc_ = 16777216.f / PEER_WSCALE;
                    *(f32x2*)op = (f32x2){(float)xa[0] + ga[0] * ((float)ra[0] * sc_), (float)xa[1] + ga[1] * ((float)rb[0] * sc_)};
                    *(f32x2*)(op + 4) = (f32x2){(float)xb[0] + gb[0] * ((float)ra[1] * sc_), (float)xb[1] + gb[1] * ((float)rb[1] * sc_)};
                }
            }
        }
    }
}
__device__ __forceinline__ void ph9b_combine(const Args& a, int bid, int nb) {
    int tid_ = threadIdx.x; asm volatile("" : "+v"(tid_));
    float* GW = (float*)(a.ws + WS_GW); const float* PART = (const float*)(a.ws + WS_PART);
    const float du = ((const float*)(a.ws + WS_QS))[0], dv = ((const float*)(a.ws + WS_QS))[1] * PEER_WSCALE;
    const size_t istep = (size_t)nb * NTHR, itot = (size_t)NT * 128 / 4;
    size_t i = (size_t)bid * NTHR + tid_;
#define PQ9B_ONE(sum_, g_, ii_) do { f32x4 w; \
        _Pragma("unroll") for (int j = 0; j < 4; ++j) w[j] = fminf(fmaxf(g_[j] * gelu_erf(sum_[j] * du) * dv, -60000.f), 60000.f);        \
          \
        float ws_ = 0.f; u32x4 pk; \
        _Pragma("unroll") for (int j = 0; j < 4; ++j) { const f16 hw_ = (f16)w[j]; ws_ += (float)hw_; pk[j] = (unsigned)__builtin_bit_cast(unsigned short, hw_) * 0x10001u; } \
        ((u32x4*)GW)[ii_] = pk; \
        ws_ += __shfl_xor(ws_, 1); ws_ += __shfl_xor(ws_, 2); \
        if ((tid_ & 3) == 0) ((float*)(a.ws + WS_WSUM))[(ii_) >> 2] = ws_; } while (0)
    for (; i + istep < itot; i += 2 * istep) {
        f32x4 s0 = ((const f32x4*)PART)[i], s1 = ((const f32x4*)PART)[i + istep];
#pragma unroll
        for (int sidx = 1; sidx < 4; ++sidx) { s0 += ((const f32x4*)(PART + (size_t)sidx * NT * 128))[i]; s1 += ((const f32x4*)(PART + (size_t)sidx * NT * 128))[i + istep]; }
        const f32x4 g0 = ((const f32x4*)GW)[i], g1 = ((const f32x4*)GW)[i + istep];
        PQ9B_ONE(s0, g0, i); PQ9B_ONE(s1, g1, i + istep);
    }
    for (; i < itot; i += istep) {
        f32x4 s0 = ((const f32x4*)PART)[i];
#pragma unroll
        for (int sidx = 1; sidx < 4; ++sidx) s0 += ((const f32x4*)(PART + (size_t)sidx * NT * 128))[i];
        const f32x4 g0 = ((const f32x4*)GW)[i];
        PQ9B_ONE(s0, g0, i);
    }
#undef PQ9B_ONE
}

#define LAS __attribute__((address_space(3)))
#define XB_TMO      128
#define XB_XCNT(j)  (256  + 64 * (j))
#define XB_XSUB(j)  (1280 + 64 * (j))
#define XB_XGEN(j)  (2304 + 64 * (j))
#define XB_TOP      3328
#define XB_TOPGEN   3392
#define XCD_BAR_WORDS 3456
#define XB_SPIN_CAP (1u << 18)
__device__ __forceinline__ unsigned xb_ld(unsigned* p)              { return __hip_atomic_load(p, __ATOMIC_RELAXED, __HIP_MEMORY_SCOPE_AGENT); }
__device__ __forceinline__ unsigned xb_add(unsigned* p, unsigned v) { return __hip_atomic_fetch_add(p, v, __ATOMIC_RELAXED, __HIP_MEMORY_SCOPE_AGENT); }
__device__ __forceinline__ unsigned xb_xcc_id() { return (unsigned)__builtin_amdgcn_s_getreg((3 << 11) | 20) & 0xFu; }
#define XB_SPIN(cond, bar) do { unsigned _sp = 0; while (cond) { __builtin_amdgcn_s_sleep(1); \
    if ((++_sp & 255u) == 0u) { if (xb_ld(&(bar)[XB_TMO])) break; if (_sp > XB_SPIN_CAP) { atomicAdd(&(bar)[XB_TMO], 1u); break; } } } } while (0)
struct XcdBarrier { unsigned* bar; unsigned x; volatile LAS unsigned* st; };
__device__ __forceinline__ XcdBarrier xcd_barrier_post(unsigned* bar, volatile LAS unsigned* st) {
    XcdBarrier b; b.bar = bar; b.x = xb_xcc_id(); b.st = st;
    if (threadIdx.x == 0) (void)xb_add(&bar[XB_XCNT(b.x)], 1u);
    return b;
}
__device__ __forceinline__ void xcd_barrier_complete(unsigned* bar, unsigned x, unsigned& nloc, unsigned& nx) {
    const unsigned G = gridDim.x * gridDim.y * gridDim.z;
    unsigned sum, cnt, mine, sp = 0u;
    for (;;) {
        sum = 0u; cnt = 0u; mine = 0u;
#pragma unroll
        for (unsigned j = 0; j < 16; ++j) { const unsigned c = xb_ld(&bar[XB_XCNT(j)]); sum += c; cnt += (c > 0u) ? 1u : 0u; mine = (j == x) ? c : mine; }
        if (sum == G) break;
        __builtin_amdgcn_s_sleep(1);
        if ((++sp & 255u) == 0u) { if (xb_ld(&bar[XB_TMO])) break; if (sp > XB_SPIN_CAP) { atomicAdd(&bar[XB_TMO], 1u); break; } }
    }
    nloc = mine > 0u ? mine : 1u; nx = cnt > 0u ? cnt : 1u;
}
__device__ __forceinline__ void xcd_barrier(const XcdBarrier& b) {
    asm volatile("s_waitcnt vmcnt(0)" ::: "memory");
    __syncthreads();
    if (threadIdx.x == 0) {
        unsigned* bar = b.bar;
        __builtin_amdgcn_s_waitcnt(0);
        unsigned nloc = b.st[0], nx = b.st[1];
        if (nloc == 0u) { xcd_barrier_complete(bar, b.x, nloc, nx); b.st[0] = nloc; b.st[1] = nx; }
        const unsigned old = xb_add(&bar[XB_XSUB(b.x)], 1u);
        const unsigned gen = old / nloc;
        if (old + 1u == (gen + 1u) * nloc) {
            __builtin_amdgcn_fence(__ATOMIC_RELEASE, "agent");
            asm volatile("s_waitcnt vmcnt(0)" ::: "memory");
            const unsigned og = xb_add(&bar[XB_TOP], 1u);
            const unsigned tg = og / nx;
            if (og + 1u == (tg + 1u) * nx) xb_add(&bar[XB_TOPGEN], 1u);
            else XB_SPIN(xb_ld(&bar[XB_TOPGEN]) == tg, bar);
            __builtin_amdgcn_fence(__ATOMIC_ACQUIRE, "agent");
            xb_add(&bar[XB_XGEN(b.x)], 1u);
            asm volatile("s_waitcnt vmcnt(0)" ::: "memory");
        } else {
            XB_SPIN(xb_ld(&bar[XB_XGEN(b.x)]) == gen, bar);
            __builtin_amdgcn_fence(__ATOMIC_ACQUIRE, "agent");
            asm volatile("s_waitcnt vmcnt(0)" ::: "memory");
        }
    }
    __syncthreads();
}

constexpr int N_PHASES = 12;
__global__ void __launch_bounds__(NTHR, 2) mk_fwd(Args a) {
    extern __shared__ __attribute__((aligned(16))) unsigned char lds[];
    cg::grid_group grid = cg::this_grid();
    const int bid = blockIdx.x, nb = gridDim.x;
    const int lo = a.ph_lo, hi = a.ph_hi;
    volatile LAS unsigned* bst = (volatile LAS unsigned*)((LAS unsigned char*)lds + (LDS_BYTES - 16));
    if (threadIdx.x < 4) bst[threadIdx.x] = 0u;
    __syncthreads();
    XcdBarrier xbar = xcd_barrier_post((unsigned*)(a.ws + WS_CTL), bst);
#define SEAM(k) do { if ((k) == 0) grid.sync(); else xcd_barrier(xbar); } while (0)
#define PHASE(k, body) if (lo <= (k) && (k) < hi) { body; if ((k) + 1 < hi) SEAM(k); }
    PHASE(0, ph0_prologue(a, bid, nb, lds))
    PHASE(1, row_norm_mod(a.in[0], a.in[4], (const float*)(a.ws + WS_MOD), 0, 1024, (f16*)(a.ws + WS_H), bid, nb); wq_to_int8((const f16*)(a.ws + WS_WQ), a.ws + WS_WQ8, (float*)(a.ws + WS_WSC), bid, nb))
    PHASE(2, ph2_inproj(a, bid, nb, lds))
    PHASE(3, ph3_pool_fast(a, bid, nb, lds); ph3_index_fast<0>(a, bid, nb, lds))
    PHASE(4, ph4_attn_fast<0>(a, bid, nb, lds))
    PHASE(5, ph5_outproj(a, bid, nb, lds))
    PHASE(6, row_norm_mod_q((const f16*)(a.ws + WS_X1), a.in[13], (const float*)(a.ws + WS_MOD), 3072, 4096, a.ws + WS_HQ, (unsigned*)(a.ws + WS_HP), (float*)(a.ws + WS_HSC), bid, nb))
    PHASE(7, ph7_peerq(a, bid, nb, lds))
    PHASE(8, ph8_peersel_fast(a, bid, nb, lds))
    PHASE(9, ph9_sliced<0>(a, lds))
    PHASE(10, ph9b_combine(a, bid, nb))
    PHASE(11, ph9_sliced<1>(a, lds))
#undef PHASE
}

extern "C" void kernel_launch(void* const* d_in, const int* in_sizes, int n_in, void* d_out, int out_size, void* d_ws, size_t ws_size, hipStream_t stream) {
    static int grid = 0;
    if (grid == 0) {
        if (n_in != 18 || out_size != NT * ND || ws_size < WS_END) { fprintf(stderr, "kernel_launch: unexpected shapes (n_in %d out %d ws %zu)\n", n_in, out_size, ws_size); grid = -1; return; }
        int dev = 0, cus = 0, per_cu = 0;
        hipGetDevice(&dev); hipDeviceGetAttribute(&cus, hipDeviceAttributeMultiprocessorCount, dev);
        hipFuncSetAttribute((const void*)mk_fwd, hipFuncAttributeMaxDynamicSharedMemorySize, LDS_BYTES);
        hipOccupancyMaxActiveBlocksPerMultiprocessor(&per_cu, (const void*)mk_fwd, NTHR, LDS_BYTES);
        if (per_cu < 1) { fprintf(stderr, "kernel_launch: occupancy query says %d blocks/CU\n", per_cu); per_cu = 1; }
        grid = cus * 1;
        (void)hipGetLastError();
    }
    if (grid < 0) return;
    if (hipMemsetAsync((char*)d_ws + WS_CTL, 0, 32768, stream) != hipSuccess) { fprintf(stderr, "kernel_launch: memset of the barrier words failed\n"); return; }
    Args a{};
    for (int i = 0; i < 18; ++i) a.in[i] = (const float*)d_in[i];
    a.out = (float*)d_out; a.ws = (unsigned char*)d_ws;
#if MK_MULTI
    for (int ph = 0; ph < N_PHASES; ++ph) { a.ph_lo = ph; a.ph_hi = ph + 1; hipLaunchKernelGGL(mk_fwd, dim3(grid), dim3(NTHR), LDS_BYTES, stream, a); }
#else
    a.ph_lo = 0; a.ph_hi = N_PHASES;
    void* args[] = {&a};
    hipError_t e = hipLaunchCooperativeKernel((const void*)mk_fwd, dim3(grid), dim3(NTHR), args, LDS_BYTES, stream);
    if (e != hipSuccess) fprintf(stderr, "cooperative launch failed: %s (grid %d)\n", hipGetErrorString(e), grid);
#endif
}
```

```cpp
#include <hip/hip_runtime.h>
#include <hip/hip_cooperative_groups.h>
#include <cstdio>
#include <cstdint>
namespace cg = cooperative_groups;

#ifndef MK_MULTI
#define MK_MULTI 0
#endif

typedef _Float16 f16;
typedef _Float16 f16x8 __attribute__((ext_vector_type(8)));
typedef _Float16 f16x4 __attribute__((ext_vector_type(4)));
typedef float f32x4 __attribute__((ext_vector_type(4)));
typedef float f32x16 __attribute__((ext_vector_type(16)));
typedef int i32x4 __attribute__((ext_vector_type(4)));
typedef unsigned long long u64;
typedef unsigned short u16;
typedef __attribute__((address_space(3))) unsigned lds_u32;

constexpr int NB = 8, NS = 8192, ND = 1024, NT = NB * NS;
constexpr int INW = 2632;
constexpr int NMAIN = 2304;
constexpr float EPS = 1e-6f;
constexpr int NTHR = 512, NWAVE = 8;

constexpr size_t MiB = 1u << 20;
constexpr size_t WS_CTL = 0;
constexpr size_t WS_MOD = 1 * MiB;
constexpr size_t WS_WIN = 2 * MiB;
constexpr size_t WS_WVT = 7 * MiB;
constexpr size_t WS_WOUT = 8 * MiB;
constexpr size_t WS_WQ = 10 * MiB;
constexpr size_t WS_SK = 14 * MiB;
constexpr size_t WS_PW = 14 * MiB + 512 * 1024;
constexpr size_t WS_QS = 1 * MiB + 512 * 1024;
constexpr size_t WS_UT = 16 * MiB;
constexpr size_t WS_VP = 48 * MiB;
constexpr size_t WS_H = 80 * MiB;
constexpr size_t WS_U = 208 * MiB;
constexpr size_t WS_Q = 272 * MiB;
constexpr size_t WS_K = 336 * MiB;
constexpr size_t WS_VT = 400 * MiB;
constexpr size_t WS_PQ = 208 * MiB;
constexpr size_t WS_WQ8 = 24 * MiB;
constexpr size_t WS_WSC = 26 * MiB;
constexpr size_t WS_HQ = 464 * MiB;
constexpr size_t WS_HP = 784 * MiB;
constexpr size_t WS_WSUM = 536 * MiB;
constexpr size_t WS_HSC = 528 * MiB;
constexpr size_t WS_QI = 464 * MiB;
constexpr size_t WS_KI = 528 * MiB;
constexpr size_t WS_WI = 536 * MiB;
constexpr size_t WS_MASK = 544 * MiB;
constexpr size_t WS_EID = 608 * MiB;
constexpr size_t WS_GW = 624 * MiB;
constexpr size_t WS_X1 = 656 * MiB;
constexpr size_t WS_END = 848 * MiB;

constexpr int LDS_BYTES = 155648;
constexpr float PEER_QSTEP = 0.3352f;
constexpr float PEER_WSCALE = 16384.f;

struct Args { const float* in[18]; float* out; unsigned char* ws; int ph_lo, ph_hi; };

__host__ __device__ __forceinline__ int pos2log(int p) { return 64 * ((p >> 5) & 3) + 32 * (p >> 7) + 8 * ((p >> 2) & 3) + 4 * ((p >> 4) & 1) + (p & 3); }
__device__ __forceinline__ int maincol(int L) { if (L < 1536) return L; if (L < 2120) return L + 512; return -1; }

__device__ __forceinline__ float wave_sum(float v) {
#pragma unroll
    for (int o = 1; o < 64; o <<= 1) v += __shfl_xor(v, o);
    return v;
}
__device__ __forceinline__ float wave_max(float v) {
#pragma unroll
    for (int o = 1; o < 64; o <<= 1) v = fmaxf(v, __shfl_xor(v, o));
    return v;
}

__device__ void ph0_prologue(const Args& a, int bid, int nb, unsigned char* lds) {
    int tid = threadIdx.x; asm volatile("" : "+v"(tid));
    const float* c = a.in[1]; const float* ada_w = a.in[2]; const float* ada_b = a.in[3];
    float* sil = (float*)lds;
    for (int i = tid; i < NB * ND; i += NTHR) { const float v = c[i]; sil[i] = v / (1.f + __expf(-v)); }
    __syncthreads();
    float* mod = (float*)(a.ws + WS_MOD);
    const int gt = bid * NTHR + tid, ngt = nb * NTHR;
    for (int o = gt; o < NB * 6144; o += ngt) {
        const int b = o / 6144, j = o % 6144;
        float acc = ada_b[j];
        const float* sb = sil + b * ND;
        for (int k = 0; k < ND; ++k) acc += sb[k] * ada_w[(size_t)k * 6144 + j];
        mod[o] = acc;
    }
    const float* w_in = a.in[5]; const float* pool_w = a.in[6]; const float* w_out = a.in[12];
    const float* wq = a.in[14]; const float* sk = a.in[15]; const float* pu = a.in[16]; const float* pv = a.in[17];
    f16* WIN = (f16*)(a.ws + WS_WIN); f16* WVT = (f16*)(a.ws + WS_WVT); f16* WOUT = (f16*)(a.ws + WS_WOUT); f16* WQ = (f16*)(a.ws + WS_WQ);
 unsigned char* UT = a.ws + WS_UT; unsigned char* VP = a.ws + WS_VP;
    {
        __syncthreads();
        const int lane = tid & 63, wv_ = tid >> 6;
        float* scr = (float*)lds + wv_ * (64 * 33);
        constexpr int I_WQ = 16 * 64, I_Z = 16 * 16, I_INR = 16 * (NMAIN / 32 - 16), I_VT = 16 * 16, I_OUT = 16 * 32, I_ALL = I_WQ + I_Z + I_INR + I_VT + I_OUT;
        for (int it = bid * NWAVE + wv_; it < I_ALL; it += nb * NWAVE) {
            int rr = it, kind = 3, pboff = 0;
            if (rr >= I_WQ) { rr -= I_WQ; kind = 0;
                if (rr >= I_Z) { rr -= I_Z; pboff = 16;
                    if (rr >= I_INR) { rr -= I_INR; kind = 1; pboff = 0; if (rr >= I_VT) { rr -= I_VT; kind = 2; } } } }
            const int npb = kind == 0 ? (pboff ? NMAIN / 32 - 16 : 16) : kind == 1 ? 16 : kind == 2 ? 32 : 64;
            const int k0 = (rr / npb) * 64, p0 = (rr % npb + pboff) * 32, p = p0 + (lane & 31);
            const float* W = kind <= 1 ? w_in : kind == 2 ? w_out : wq; const int ldw = kind <= 1 ? INW : kind == 2 ? 1024 : 2048;
            int col;
            if (kind == 0) col = maincol((p & ~255) + pos2log(p & 255)); else if (kind == 1) col = 1536 + p; else col = (p & ~255) + pos2log(p & 255);
            const bool foldz = (kind == 0 && pboff == 0);
            if (foldz || kind == 3) {
                const int r5 = lane & 31, hh_ = lane >> 5;
                const int blk = __builtin_amdgcn_readfirstlane(col >> 7);
                const int sub = col & 127;
                const float* arow = W + (size_t)(k0 + r5) * ldw + blk * 128 + 8 * hh_;
                f32x16 acc0 = (f32x16){0.f, 0.f, 0.f, 0.f, 0.f, 0.f, 0.f, 0.f, 0.f, 0.f, 0.f, 0.f, 0.f, 0.f, 0.f, 0.f}, acc1 = acc0;
#pragma unroll 2
                for (int ks = 0; ks < 8; ++ks) {
                    const f32x4 a00 = *(const f32x4*)(arow + 16 * ks), a01 = *(const f32x4*)(arow + 16 * ks + 4);
                    const f32x4 a10 = *(const f32x4*)(arow + (size_t)32 * ldw + 16 * ks), a11 = *(const f32x4*)(arow + (size_t)32 * ldw + 16 * ks + 4);
                    f16x8 bfr;
                    if (kind == 3) { const float* br = sk + (size_t)(blk * 128 + sub) * 128 + 16 * ks + 8 * hh_; const f32x4 b0 = *(const f32x4*)br, b1 = *(const f32x4*)(br + 4);
                        bfr = (f16x8){(f16)b0[0], (f16)b0[1], (f16)b0[2], (f16)b0[3], (f16)b1[0], (f16)b1[1], (f16)b1[2], (f16)b1[3]}; }
                    else { const float* br = pool_w + (size_t)blk * 16384 + (size_t)(16 * ks + 8 * hh_) * 128 + sub;
                        bfr = (f16x8){(f16)br[0], (f16)br[128], (f16)br[256], (f16)br[384], (f16)br[512], (f16)br[640], (f16)br[768], (f16)br[896]}; }
                    const f16x8 af0 = (f16x8){(f16)a00[0], (f16)a00[1], (f16)a00[2], (f16)a00[3], (f16)a01[0], (f16)a01[1], (f16)a01[2], (f16)a01[3]};
                    const f16x8 af1 = (f16x8){(f16)a10[0], (f16)a10[1], (f16)a10[2], (f16)a10[3], (f16)a11[0], (f16)a11[1], (f16)a11[2], (f16)a11[3]};
                    acc0 = __builtin_amdgcn_mfma_f32_32x32x16_f16(af0, bfr, acc0, 0, 0, 0);
                    acc1 = __builtin_amdgcn_mfma_f32_32x32x16_f16(af1, bfr, acc1, 0, 0, 0);
                }
#pragma unroll
                for (int rg = 0; rg < 16; ++rg) { const int kk = (rg & 3) + 8 * (rg >> 2) + 4 * hh_; scr[kk * 33 + r5] = acc0[rg]; scr[(32 + kk) * 33 + r5] = acc1[rg]; }
            } else {
#pragma unroll 8
                for (int i = 0; i < 32; ++i) { const int kk = 2 * i + (lane >> 5); scr[kk * 33 + (lane & 31)] = col >= 0 ? W[(size_t)(k0 + kk) * ldw + col] : 0.f; }
            }
            f16* WT = kind == 0 ? WIN : kind == 1 ? WVT : kind == 2 ? WOUT : WQ;
            const int c8 = lane & 7;
#pragma unroll
            for (int j = 0; j < 4; ++j) { const int n = (lane >> 3) + 8 * j; const float* sp = scr + (8 * c8) * 33 + n;
                *(f16x8*)(WT + (size_t)(p0 + n) * ND + k0 + 8 * c8) = (f16x8){(f16)sp[0], (f16)sp[33], (f16)sp[66], (f16)sp[99], (f16)sp[132], (f16)sp[165], (f16)sp[198], (f16)sp[231]}; }
        }
    }
    {
        __syncthreads();
        float ssu = 0.f, ssv = 0.f;
        for (int i = tid; i < 64 * 1024 / 4; i += NTHR) { const f32x4 u = ((const f32x4*)pu)[i], v = ((const f32x4*)pv)[i];
            ssu += u.x * u.x + u.y * u.y + u.z * u.z + u.w * u.w; ssv += v.x * v.x + v.y * v.y + v.z * v.z + v.w * v.w; }
        ssu = wave_sum(ssu); ssv = wave_sum(ssv);
        float* red = (float*)lds;
        if ((tid & 63) == 0) { red[tid >> 6] = ssu; red[8 + (tid >> 6)] = ssv; }
        __syncthreads();
        float tu = 0.f, tv = 0.f;
#pragma unroll
        for (int w = 0; w < 8; ++w) { tu += red[w]; tv += red[8 + w]; }
        const float du = PEER_QSTEP * sqrtf(tu * (1.f / 65536.f)), dv = PEER_QSTEP * sqrtf(tv * (1.f / 65536.f));
        if (bid == 0 && tid == 0) { float* qs = (float*)(a.ws + WS_QS); qs[0] = du; qs[1] = dv; }
        const float idu = 1.f / du, idv = 1.f / dv;
        const int lane = tid & 63, wv_ = tid >> 6;
        for (int row0 = bid * NWAVE + wv_; row0 < 2 * 16384; row0 += 4 * nb * NWAVE) {
            f32x4 x4[4][4];
#pragma unroll
            for (int rr = 0; rr < 4; ++rr) { int row = row0 + rr * nb * NWAVE; row = row < 2 * 16384 ? row : row0; const bool isv = row >= 16384; const int e = row & 16383;
                const float* src = (isv ? pv : pu) + (size_t)e * ND + 4 * lane;
#pragma unroll
                for (int j = 0; j < 4; ++j) x4[rr][j] = *(const f32x4*)(src + 256 * j); }
#pragma unroll
            for (int rr = 0; rr < 4; ++rr) { int row = row0 + rr * nb * NWAVE; row = row < 2 * 16384 ? row : row0; const bool isv = row >= 16384; const int e = row & 16383;
                u16* dstq = (u16*)((isv ? VP : UT) + (size_t)e * 512) + lane;
                const float inv = isv ? idv : idu; const int off = isv ? 8 : 0;
#pragma unroll
                for (int j = 0; j < 4; ++j) { unsigned pk = 0u;
#pragma unroll
                    for (int k = 0; k < 4; ++k) { int q = (int)floorf(x4[rr][j][k] * inv); q = q < -8 ? -8 : q > 7 ? 7 : q; pk |= (unsigned)((q + off) & 15) << (4 * k); }
                    dstq[64 * j] = (u16)pk; } }
        }
    }
}

__device__ void row_norm_mod(const float* src, const float* g, const float* mod, int sh_off, int sc_off, f16* dst, int bid, int nb) {
    int tid_ = threadIdx.x; asm volatile("" : "+v"(tid_)); const int lane = tid_ & 63, wave = tid_ >> 6;
    const int rstep = nb * NWAVE, r0 = bid * NWAVE + wave;
    const bool fast = (NS % rstep) == 0 && ((NS / rstep) % 4) == 0;
    if (fast) {
        for (int b = 0; b < NB; ++b) {
            f32x4 gs[4], sh[4];
#pragma unroll
            for (int j = 0; j < 4; ++j) { const int col = lane * 4 + 256 * j; const f32x4 gg = *(const f32x4*)(g + col), sc = *(const f32x4*)(mod + b * 6144 + sc_off + col);
                sh[j] = *(const f32x4*)(mod + b * 6144 + sh_off + col); gs[j] = gg * (1.f + sc); }
            for (int row = b * NS + r0; row < (b + 1) * NS; row += 4 * rstep) {
                f32x4 v[4][4]; float ss[4];
#pragma unroll
                for (int rr = 0; rr < 4; ++rr)
#pragma unroll
                    for (int j = 0; j < 4; ++j) v[rr][j] = ((const f32x4*)(src + (size_t)(row + rr * rstep) * ND) + lane)[64 * j];
#pragma unroll
                for (int rr = 0; rr < 4; ++rr) { float s_ = 0.f;
#pragma unroll
                    for (int j = 0; j < 4; ++j) s_ += v[rr][j].x * v[rr][j].x + v[rr][j].y * v[rr][j].y + v[rr][j].z * v[rr][j].z + v[rr][j].w * v[rr][j].w;
                    ss[rr] = rsqrtf(wave_sum(s_) * (1.f / ND) + EPS); }
#pragma unroll
                for (int rr = 0; rr < 4; ++rr)
#pragma unroll
                    for (int j = 0; j < 4; ++j) { const int col = lane * 4 + 256 * j; const f32x4 o = v[rr][j] * ss[rr] * gs[j] + sh[j];
                        *(f16x4*)(dst + (size_t)(row + rr * rstep) * ND + col) = (f16x4){(f16)o.x, (f16)o.y, (f16)o.z, (f16)o.w}; }
            }
        }
        return;
    }
    for (int row = r0; row < NT; row += rstep) {
        const int b = row / NS;
        const f32x4* xr = (const f32x4*)(src + (size_t)row * ND) + lane;
        f32x4 v[4]; float s = 0.f;
#pragma unroll
        for (int j = 0; j < 4; ++j) { v[j] = xr[64 * j]; s += v[j].x * v[j].x + v[j].y * v[j].y + v[j].z * v[j].z + v[j].w * v[j].w; }
        const float rstd = rsqrtf(wave_sum(s) * (1.f / ND) + EPS);
#pragma unroll
        for (int j = 0; j < 4; ++j) {
            const int col = lane * 4 + 256 * j;
            const f32x4 gg = *(const f32x4*)(g + col), sc = *(const f32x4*)(mod + b * 6144 + sc_off + col), sh = *(const f32x4*)(mod + b * 6144 + sh_off + col);
            f16x4 o;
            o.x = (f16)(v[j].x * rstd * gg.x * (1.f + sc.x) + sh.x); o.y = (f16)(v[j].y * rstd * gg.y * (1.f + sc.y) + sh.y);
            o.z = (f16)(v[j].z * rstd * gg.z * (1.f + sc.z) + sh.z); o.w = (f16)(v[j].w * rstd * gg.w * (1.f + sc.w) + sh.w);
            *(f16x4*)(dst + (size_t)row * ND + col) = o;
        }
    }
}
__device__ void row_norm_mod_q(const f16* src, const float* g, const float* mod, int sh_off, int sc_off, unsigned char* hq, unsigned* hp, float* hsc, int bid, int nb) {
    int tid_ = threadIdx.x; asm volatile("" : "+v"(tid_)); const int lane = tid_ & 63, wave = tid_ >> 6;
    const int rstep = nb * NWAVE, r0 = bid * NWAVE + wave;
    const bool hoist = (NS % rstep) == 0 && ((NS / rstep) % 2) == 0;
    const int nouter = hoist ? NB : 1, ninner = hoist ? NS : NT;
    for (int bo = 0; bo < nouter; ++bo) {
        f32x4 gs[4], sh[4];
        if (hoist) {
#pragma unroll
            for (int j = 0; j < 4; ++j) { const int col = 8 * lane + 512 * (j >> 1) + 4 * (j & 1); const f32x4 gg = *(const f32x4*)(g + col), sc = *(const f32x4*)(mod + bo * 6144 + sc_off + col);
                sh[j] = *(const f32x4*)(mod + bo * 6144 + sh_off + col); gs[j] = gg * (1.f + sc); }
        }
        for (int rowa = bo * ninner + r0; rowa < (bo + 1) * ninner; rowa += 2 * rstep) {
            const int rowb = rowa + rstep < NT ? rowa + rstep : rowa;
            f16x8 hx[2][2];
#pragma unroll
            for (int j = 0; j < 2; ++j) { hx[0][j] = *(const f16x8*)(src + (size_t)rowa * ND + 8 * lane + 512 * j); hx[1][j] = *(const f16x8*)(src + (size_t)rowb * ND + 8 * lane + 512 * j); }
#pragma unroll
            for (int rr = 0; rr < 2; ++rr) {
                const int row = rr ? rowb : rowa; const int b = row / NS;
                if (!hoist) {
#pragma unroll
                    for (int j = 0; j < 4; ++j) { const int col = 8 * lane + 512 * (j >> 1) + 4 * (j & 1); const f32x4 gg = *(const f32x4*)(g + col), sc = *(const f32x4*)(mod + b * 6144 + sc_off + col);
                        sh[j] = *(const f32x4*)(mod + b * 6144 + sh_off + col); gs[j] = gg * (1.f + sc); }
                }
                f32x4 v[4]; float s = 0.f;
#pragma unroll
                for (int j = 0; j < 2; ++j) { const f16x8 h8 = hx[rr][j];
                    v[2 * j] = (f32x4){(float)h8[0], (float)h8[1], (float)h8[2], (float)h8[3]}; v[2 * j + 1] = (f32x4){(float)h8[4], (float)h8[5], (float)h8[6], (float)h8[7]}; }
#pragma unroll
                for (int j = 0; j < 4; ++j) s += v[j].x * v[j].x + v[j].y * v[j].y + v[j].z * v[j].z + v[j].w * v[j].w;
                const float rstd = rsqrtf(wave_sum(s) * (1.f / ND) + EPS);
                float o[16]; float am = 0.f;
#pragma unroll
                for (int j = 0; j < 4; ++j)
#pragma unroll
                    for (int k = 0; k < 4; ++k) { const float y = v[j][k] * rstd * gs[j][k] + sh[j][k]; o[4 * j + k] = y; am = fmaxf(am, fabsf(y)); }
                am = wave_max(am);
                const float inv = am > 0.f ? 119.f / am : 0.f;
#pragma unroll
                for (int j = 0; j < 2; ++j) {
                    unsigned p0 = 0u, p1 = 0u, ph = 0u, pl = 0u;
#pragma unroll
                    for (int k = 0; k < 8; ++k) { const int q = (int)rintf(o[8 * j + k] * inv); const int l = ((q + 8) & 15) - 8; const int h = (q - l) >> 4;
                        if (k < 4) p0 |= (unsigned)(q & 255) << (8 * k); else p1 |= (unsigned)(q & 255) << (8 * (k - 4));
                        ph |= (unsigned)(h & 15) << (4 * k); pl |= (unsigned)(l & 15) << (4 * k); }
                    *(u64*)(hq + (size_t)row * ND + 8 * lane + 512 * j) = (u64)p0 | ((u64)p1 << 32);
                    hp[(size_t)row * 256 + lane + 64 * j] = ph; hp[(size_t)row * 256 + 128 + lane + 64 * j] = pl;
                }
                if (lane == 0) hsc[row] = am * (1.f / 119.f);
            }
        }
    }
}
__device__ void wq_to_int8(const f16* WQ, unsigned char* WQ8, float* WSC, int bid, int nb) {
    int tid_ = threadIdx.x; asm volatile("" : "+v"(tid_)); const int lane = tid_ & 63, wave = tid_ >> 6;
    for (int row = bid * NWAVE + wave; row < 2048; row += nb * NWAVE) {
        const f16x8 a0 = *(const f16x8*)(WQ + (size_t)row * ND + 8 * lane), a1 = *(const f16x8*)(WQ + (size_t)row * ND + 8 * lane + 512);
        float am = 0.f;
#pragma unroll
        for (int k = 0; k < 8; ++k) am = fmaxf(am, fmaxf(fabsf((float)a0[k]), fabsf((float)a1[k])));
        am = wave_max(am);
        const float inv = am > 0.f ? 127.f / am : 0.f;
        unsigned p[4] = {0u, 0u, 0u, 0u};
#pragma unroll
        for (int k = 0; k < 4; ++k) { p[0] |= (unsigned)((int)rintf((float)a0[k] * inv) & 255) << (8 * k); p[1] |= (unsigned)((int)rintf((float)a0[4 + k] * inv) & 255) << (8 * k);
                                      p[2] |= (unsigned)((int)rintf((float)a1[k] * inv) & 255) << (8 * k); p[3] |= (unsigned)((int)rintf((float)a1[4 + k] * inv) & 255) << (8 * k); }
        *(u64*)(WQ8 + (size_t)row * ND + 8 * lane) = (u64)p[0] | ((u64)p[1] << 32);
        *(u64*)(WQ8 + (size_t)row * ND + 8 * lane + 512) = (u64)p[2] | ((u64)p[3] << 32);
        if (lane == 0) WSC[row] = am * (1.f / 127.f);
    }
}

namespace pg8 {
#define PG8_LAS __attribute__((address_space(3)))
constexpr int BM = 256, BK = 64, HALF = 128, HTB = HALF * BK * 2, STAGE_BYTES = 8 * HTB, NXCD = 8, WGM = 8;
__host__ __device__ __forceinline__ int lds_byte(int r, int c) { const int st = (r >> 4) * 2 + (c >> 5), rr = r & 15, cc = c & 31, ob = rr * 64 + cc * 2; return st * 1024 + (ob ^ (((ob >> 9) & 1) << 5)); }
__host__ __device__ __forceinline__ void stage_rc(int b, int& R, int& C) { const int st = b / 1024, sb = b % 1024, swz = sb ^ (((sb >> 9) & 1) << 5); R = (st >> 1) * 16 + swz / 64; C = (st & 1) * 32 + (swz % 64) / 2; }
struct Unit { int pm, pn; };
struct Gemm { const f16* A; const f16* Bt; int M, N, K; };
struct StaticOrder {
    int nM, nN, nwg, G, c;
    __host__ __device__ void init(int M, int N, int G_, int c_) { nM = M / BM; nN = N / BM; nwg = nM * nN; G = G_; c = c_; }
    __host__ __device__ bool next(int i, Unit& u) const {
        const long L = (long)i * G + c; if (L >= nwg) return false;
        int wgid = (int)L; { const int q = nwg / NXCD, r = nwg % NXCD, xcd = wgid % NXCD, off = wgid / NXCD; wgid = (xcd < r ? xcd * (q + 1) : r * (q + 1) + (xcd - r) * q) + off; }
        const int nig = WGM * nN, gid = wgid / nig, fm = gid * WGM, gsz = (nM - fm) < WGM ? (nM - fm) : WGM;
        u.pm = fm + ((wgid % nig) % gsz); u.pn = (wgid % nig) / gsz; return true;
    }
};
template <class Epi, bool I8 = false>
__device__ __forceinline__ void gemm_phase(PG8_LAS unsigned char* lds, const Gemm g, const StaticOrder& S, const Epi& E) {
    int tid = threadIdx.x; asm volatile("" : "+v"(tid));
    const int wid = __builtin_amdgcn_readfirstlane(tid >> 6), lane = tid & 63, wr = wid >> 2, wc = wid & 3, fr = lane & 15, fq = lane >> 4;
    const int K = g.K, nt = K / BK;
    unsigned voffA[2];
#pragma unroll
    for (int i = 0; i < 2; ++i) { int R, C; stage_rc(tid * 16 + i * 8192, R, C); voffA[i] = (unsigned)(R * K + C) * 2u; }
    const size_t kstep = (size_t)(BK * 2);
    const size_t hstep = (size_t)HALF * K * 2;
    const size_t tstep = 2 * hstep;
    const unsigned ldsw = (unsigned)wid * 1024u;
    const int aoff = lds_byte(wr * 64 + fr, fq * 8), boff = lds_byte(wc * 32 + fr, fq * 8);
#define PG8_SA(b, h) (((b) * 2 + (h)) * HTB)
#define PG8_SB(b, h) ((4 + (b) * 2 + (h)) * HTB)
#define PG8_STAGE(bufoff, gbase, voff) do { _Pragma("unroll") for (int _i = 0; _i < 2; ++_i) \
        __builtin_amdgcn_global_load_lds((const unsigned*)((const char*)(gbase) + (voff)[_i]), (PG8_LAS unsigned*)(lds + (bufoff) + ldsw + _i * 8192), 16, 0, 0); } while (0)
#define PG8_LDA(dst, b, h) do { _Pragma("unroll") for (int m = 0; m < 4; ++m) _Pragma("unroll") for (int k = 0; k < 2; ++k) dst[m][k] = *(const PG8_LAS f16x8*)(lds + PG8_SA(b, h) + aoff + m * 2048 + k * 1024); } while (0)
#define PG8_LDB(dst, b, h) do { _Pragma("unroll") for (int n = 0; n < 2; ++n) _Pragma("unroll") for (int k = 0; k < 2; ++k) dst[n][k] = *(const PG8_LAS f16x8*)(lds + PG8_SB(b, h) + boff + n * 2048 + k * 1024); } while (0)
#define PG8_MMA(ai, bj, At, Bt) do { __builtin_amdgcn_s_setprio(1); _Pragma("unroll") for (int m = 0; m < 4; ++m) _Pragma("unroll") for (int n = 0; n < 2; ++n) _Pragma("unroll") for (int k = 0; k < 2; ++k) \
        acc[ai][bj][m][n] = I8 ? __builtin_bit_cast(f32x4, __builtin_amdgcn_mfma_i32_16x16x64_i8(__builtin_bit_cast(i32x4, Bt[n][k]), __builtin_bit_cast(i32x4, At[m][k]), __builtin_bit_cast(i32x4, acc[ai][bj][m][n]), 0, 0, 0)) \
                                 : __builtin_amdgcn_mfma_f32_16x16x32_f16(Bt[n][k], At[m][k], acc[ai][bj][m][n], 0, 0, 0); __builtin_amdgcn_s_setprio(0); } while (0)
#define PG8_WAIT_V(n) asm volatile("s_waitcnt vmcnt(" #n ")" ::: "memory")
#define PG8_WAIT_L(n) asm volatile("s_waitcnt lgkmcnt(" #n ")" ::: "memory")
#define PG8_BAR __builtin_amdgcn_s_barrier()
#define PG8_SCHED __builtin_amdgcn_sched_barrier(0)
    Unit cur, nxt; int ui = 0;
    if (!S.next(0, cur)) return;
    f32x4 acc[2][2][4][2];
#pragma unroll
    for (int a = 0; a < 2; ++a)
#pragma unroll
        for (int b = 0; b < 2; ++b)
#pragma unroll
            for (int m = 0; m < 4; ++m)
#pragma unroll
                for (int n = 0; n < 2; ++n) acc[a][b][m][n] = (f32x4){0.f, 0.f, 0.f, 0.f};
    f16x8 At[4][2], B0[2][2], B1[2][2];
    const char* cA = (const char*)g.A + (size_t)cur.pm * tstep; const char* cB = (const char*)g.Bt + (size_t)cur.pn * tstep;
    PG8_STAGE(PG8_SB(0, 0), cB, voffA); PG8_STAGE(PG8_SB(0, 1), cB + hstep, voffA); PG8_STAGE(PG8_SA(0, 0), cA, voffA); PG8_STAGE(PG8_SA(0, 1), cA + hstep, voffA);
    if (wr == 1) PG8_BAR;
    PG8_WAIT_V(2); PG8_BAR;
    PG8_STAGE(PG8_SB(1, 0), cB + kstep, voffA); PG8_STAGE(PG8_SA(1, 0), cA + kstep, voffA); PG8_STAGE(PG8_SB(1, 1), cB + hstep + kstep, voffA);
    PG8_WAIT_V(6); PG8_BAR;
    for (;;) {
        const bool has_next = S.next(ui + 1, nxt);
        const char* nA = has_next ? (const char*)g.A + (size_t)nxt.pm * tstep : cA; const char* nB = has_next ? (const char*)g.Bt + (size_t)nxt.pn * tstep : cB;
        for (int t = 0; t < nt; t += 2) {
            const bool last = (t == nt - 2);
            const char* a1 = cA + (size_t)(t + 1) * kstep;
            const char* a2 = last ? nA : cA + (size_t)(t + 2) * kstep; const char* b2 = last ? nB : cB + (size_t)(t + 2) * kstep;
            const char* a3 = a2 + kstep; const char* b3 = b2 + kstep;
            PG8_LDB(B0, 0, 0); PG8_LDB(B1, 0, 1); PG8_SCHED; PG8_LDA(At, 0, 0); PG8_STAGE(PG8_SA(1, 1), a1 + hstep, voffA);
            PG8_WAIT_V(8); PG8_WAIT_L(0); PG8_BAR; PG8_MMA(0, 0, At, B0); PG8_MMA(0, 1, At, B1); PG8_BAR; PG8_SCHED;
            PG8_LDA(At, 0, 1); PG8_STAGE(PG8_SB(0, 0), b2, voffA); PG8_STAGE(PG8_SB(0, 1), b2 + hstep, voffA); PG8_STAGE(PG8_SA(0, 0), a2, voffA);
            PG8_WAIT_V(8); PG8_WAIT_L(0); PG8_BAR; PG8_MMA(1, 0, At, B0); PG8_MMA(1, 1, At, B1); PG8_BAR; PG8_SCHED;
            PG8_LDB(B0, 1, 0); PG8_LDB(B1, 1, 1); PG8_SCHED; PG8_LDA(At, 1, 0); PG8_STAGE(PG8_SA(0, 1), a2 + hstep, voffA);
            PG8_WAIT_V(8); PG8_WAIT_L(0); PG8_BAR; PG8_MMA(0, 0, At, B0); PG8_MMA(0, 1, At, B1); PG8_BAR; PG8_SCHED;
            PG8_LDA(At, 1, 1); PG8_STAGE(PG8_SB(1, 0), b3, voffA); PG8_STAGE(PG8_SB(1, 1), b3 + hstep, voffA); PG8_STAGE(PG8_SA(1, 0), a3, voffA);
            PG8_WAIT_V(8); PG8_WAIT_L(0); PG8_BAR; PG8_MMA(1, 0, At, B0); PG8_MMA(1, 1, At, B1); PG8_BAR; PG8_SCHED;
        }
        if (wr == 0) PG8_BAR;
        E(acc, cur, wr, wc, fr, fq);
        if (!has_next) break;
#pragma unroll
        for (int a = 0; a < 2; ++a)
#pragma unroll
            for (int b = 0; b < 2; ++b)
#pragma unroll
                for (int m = 0; m < 4; ++m)
#pragma unroll
                    for (int n = 0; n < 2; ++n) acc[a][b][m][n] = (f32x4){0.f, 0.f, 0.f, 0.f};
        cur = nxt; cA = nA; cB = nB; ++ui;
        if (wr == 1) PG8_BAR;
    }
    PG8_WAIT_V(0);
    PG8_BAR;
#undef PG8_SA
#undef PG8_SB
#undef PG8_STAGE
#undef PG8_LDA
#undef PG8_LDB
#undef PG8_MMA
#undef PG8_WAIT_V
#undef PG8_WAIT_L
#undef PG8_BAR
#undef PG8_SCHED
}

typedef f32x4 Acc[2][2][4][2];
struct EpiMain {
    unsigned char* ws; const float *qg, *kg;
    __device__ __forceinline__ void operator()(const Acc& acc, const Unit& u, int wr, int wc, int fr, int fq) const {
        const int row0 = u.pm * BM + wr * 64 + fr, pn = u.pn;
        if (pn == 8) {
            if (wc == 0) {
#pragma unroll
                for (int ai = 0; ai < 2; ++ai)
#pragma unroll
                    for (int m = 0; m < 4; ++m) { const size_t row = row0 + ai * HALF + m * 16;
#pragma unroll
                        for (int bj = 0; bj < 2; ++bj) { const f32x4 v0 = acc[ai][bj][m][0], v1 = acc[ai][bj][m][1];
                            *(f16x8*)((f16*)(ws + WS_KI) + (((row >> 5) * 8 + 4 * bj + fq) * 32 + (row & 31)) * 8) = (f16x8){(f16)v0[0], (f16)v0[1], (f16)v0[2], (f16)v0[3], (f16)v1[0], (f16)v1[1], (f16)v1[2], (f16)v1[3]}; } }
            } else if (wc == 1 && fq == 0) {
#pragma unroll
                for (int ai = 0; ai < 2; ++ai)
#pragma unroll
                    for (int m = 0; m < 4; ++m) { const size_t row = row0 + ai * HALF + m * 16;
                        *(f32x4*)((float*)(ws + WS_WI) + row * 8) = acc[ai][0][m][0] * 0.35355339059327373f; *(f32x4*)((float*)(ws + WS_WI) + row * 8 + 4) = acc[ai][0][m][1] * 0.35355339059327373f; }
            }
            return;
        }
        const int kind = pn >> 1;
        f16* base = (f16*)(ws + (kind == 0 ? WS_U : kind == 1 ? WS_Q : kind == 2 ? WS_K : WS_QI));
        const int col0 = (pn & 1) * 256 + 64 * wc + 8 * fq;
        if (kind == 1 || kind == 2) {
            const float* gp = (kind == 1 ? qg : kg) + 8 * fq;
#pragma unroll
            for (int ai = 0; ai < 2; ++ai)
#pragma unroll
                for (int m = 0; m < 4; ++m) { const size_t row = row0 + ai * HALF + m * 16;
                    float ss = 0.f;
#pragma unroll
                    for (int bj = 0; bj < 2; ++bj)
#pragma unroll
                        for (int n = 0; n < 2; ++n) { const f32x4 v = acc[ai][bj][m][n]; ss += v[0] * v[0] + v[1] * v[1] + v[2] * v[2] + v[3] * v[3]; }
                    ss += __shfl_xor(ss, 16); ss += __shfl_xor(ss, 32);
                    const float rstd = rsqrtf(ss * (1.f / 64.f) + EPS);
#pragma unroll
                    for (int bj = 0; bj < 2; ++bj) { const f32x4 v0 = acc[ai][bj][m][0] * rstd * *(const f32x4*)(gp + 32 * bj), v1 = acc[ai][bj][m][1] * rstd * *(const f32x4*)(gp + 32 * bj + 4);
                        *(f16x8*)(base + row * 512 + col0 + 32 * bj) = (f16x8){(f16)v0[0], (f16)v0[1], (f16)v0[2], (f16)v0[3], (f16)v1[0], (f16)v1[1], (f16)v1[2], (f16)v1[3]}; }
                    asm volatile("" ::: "memory"); }
        } else if (kind == 3) {
            const int hd = (pn & 1) * 4 + wc;
#pragma unroll
            for (int ai = 0; ai < 2; ++ai)
#pragma unroll
                for (int m = 0; m < 4; ++m) { const size_t row = row0 + ai * HALF + m * 16; const int ql = (int)(row & 7);
                    const int rr = (hd & 3) | (((ql >> 1) & 1) << 2) | ((hd >> 2) << 3) | ((ql & 1) << 4);
#pragma unroll
                    for (int bj = 0; bj < 2; ++bj) { const f32x4 v0 = acc[ai][bj][m][0], v1 = acc[ai][bj][m][1]; const int chunk = fq + 4 * bj;
                        *(f16x8*)(base + ((((((row >> 3) * 2 + (ql >> 2)) * 4 + (chunk >> 1)) * 2 + (chunk & 1)) * 32 + rr) << 3)) = (f16x8){(f16)v0[0], (f16)v0[1], (f16)v0[2], (f16)v0[3], (f16)v1[0], (f16)v1[1], (f16)v1[2], (f16)v1[3]}; } }
        } else {
#pragma unroll
            for (int ai = 0; ai < 2; ++ai)
#pragma unroll
                for (int m = 0; m < 4; ++m) { const size_t row = row0 + ai * HALF + m * 16;
#pragma unroll
                    for (int bj = 0; bj < 2; ++bj) { const f32x4 v0 = acc[ai][bj][m][0], v1 = acc[ai][bj][m][1];
                        *(f16x8*)(base + row * 512 + col0 + 32 * bj) = (f16x8){(f16)v0[0], (f16)v0[1], (f16)v0[2], (f16)v0[3], (f16)v1[0], (f16)v1[1], (f16)v1[2], (f16)v1[3]}; } }
        }
    }
};
struct EpiVT {
    f16* VT;
    __device__ __forceinline__ void operator()(const Acc& acc, const Unit& u, int wr, int wc, int fr, int fq) const {
        const int row0 = u.pm * BM + wr * 64 + fr, col0 = u.pn * BM + 32 * wc + 4 * fq;
#pragma unroll
        for (int ai = 0; ai < 2; ++ai)
#pragma unroll
            for (int m = 0; m < 4; ++m) { const size_t row = row0 + ai * HALF + m * 16;
#pragma unroll
                for (int bj = 0; bj < 2; ++bj)
#pragma unroll
                    for (int n = 0; n < 2; ++n) { const f32x4 v = acc[ai][bj][m][n];
                        *(f16x4*)(VT + row * NT + col0 + 128 * bj + 16 * n) = (f16x4){(f16)v[0], (f16)v[1], (f16)v[2], (f16)v[3]}; } }
    }
};
struct EpiOut {
    const float* x; const float* mod; f16* x1;
    __device__ __forceinline__ void operator()(const Acc& acc, const Unit& u, int wr, int wc, int fr, int fq) const {
        const int row0 = u.pm * BM + wr * 64 + fr, col0 = u.pn * BM + 64 * wc + 8 * fq;
        const float* g1 = mod + ((u.pm * BM) / NS) * 6144 + 2048 + col0;
        f32x4 g4[2][2];
#pragma unroll
        for (int bj = 0; bj < 2; ++bj)
#pragma unroll
            for (int n = 0; n < 2; ++n) g4[bj][n] = *(const f32x4*)(g1 + 32 * bj + 4 * n);
#pragma unroll
        for (int ai = 0; ai < 2; ++ai)
#pragma unroll
            for (int m = 0; m < 4; ++m) { const size_t off = (size_t)(row0 + ai * HALF + m * 16) * ND + col0;
#pragma unroll
                for (int bj = 0; bj < 2; ++bj) { const f32x4 v0 = *(const f32x4*)(x + off + 32 * bj) + g4[bj][0] * acc[ai][bj][m][0], v1 = *(const f32x4*)(x + off + 32 * bj + 4) + g4[bj][1] * acc[ai][bj][m][1];
                    *(f16x8*)(x1 + off + 32 * bj) = (f16x8){(f16)v0[0], (f16)v0[1], (f16)v0[2], (f16)v0[3], (f16)v1[0], (f16)v1[1], (f16)v1[2], (f16)v1[3]}; } }
    }
};
struct EpiPQ {
    f16* PQ; const float* hsc; const float* wsc;
    __device__ __forceinline__ void operator()(const Acc& acc, const Unit& u, int wr, int wc, int fr, int fq) const {
        const int row0 = u.pm * BM + wr * 64 + fr, col0 = u.pn * BM + 64 * wc + 8 * fq;
        f32x4 ws4[2][2];
#pragma unroll
        for (int bj = 0; bj < 2; ++bj)
#pragma unroll
            for (int n = 0; n < 2; ++n) ws4[bj][n] = *(const f32x4*)(wsc + u.pn * BM + 128 * bj + 32 * wc + 16 * n + 4 * fq);
#pragma unroll
        for (int ai = 0; ai < 2; ++ai)
#pragma unroll
            for (int m = 0; m < 4; ++m) { const size_t row = row0 + ai * HALF + m * 16; const float hs = hsc[row];
#pragma unroll
                for (int bj = 0; bj < 2; ++bj) { const i32x4 i0 = __builtin_bit_cast(i32x4, acc[ai][bj][m][0]), i1 = __builtin_bit_cast(i32x4, acc[ai][bj][m][1]);
                    const f32x4 v0 = (f32x4){(float)i0[0], (float)i0[1], (float)i0[2], (float)i0[3]} * ws4[bj][0] * hs, v1 = (f32x4){(float)i1[0], (float)i1[1], (float)i1[2], (float)i1[3]} * ws4[bj][1] * hs;
                    *(f16x8*)(PQ + ((((row >> 5) * 256 + ((col0 + 32 * bj) >> 3)) * 32 + (row & 31)) << 3)) = (f16x8){(f16)v0[0], (f16)v0[1], (f16)v0[2], (f16)v0[3], (f16)v1[0], (f16)v1[1], (f16)v1[2], (f16)v1[3]}; } }
    }
};
}

__device__ __forceinline__ void ph2_inproj(const Args& a, int bid, int nb, unsigned char* lds) {
    const f16* H = (const f16*)(a.ws + WS_H); const f16* WIN = (const f16*)(a.ws + WS_WIN); const f16* WVT = (const f16*)(a.ws + WS_WVT);
    PG8_LAS unsigned char* l3 = (PG8_LAS unsigned char*)lds;
    { pg8::Gemm g{H, WIN, NT, NMAIN, ND}; pg8::StaticOrder S; S.init(NT, NMAIN, nb, bid);
      pg8::EpiMain E{a.ws, a.in[9], a.in[10]};
      pg8::gemm_phase(l3, g, S, E); }
    { pg8::Gemm g{WVT, H, 512, NT, ND}; pg8::StaticOrder S; S.init(512, NT, nb, bid);
      pg8::EpiVT E{(f16*)(a.ws + WS_VT)};
      pg8::gemm_phase(l3, g, S, E); }
}


constexpr int PPITCH = 1040;
__device__ __forceinline__ void ph3_pool_fast(const Args& a, int bid, int nb, unsigned char* lds) {
    int tid = threadIdx.x; asm volatile("" : "+v"(tid));
    const int cg8 = tid & 63, tq = tid >> 6, gch = cg8 >> 4, win = 2 << gch;
    const f16* Z = (const f16*)(a.ws + WS_U); f16* MIX = (f16*)(a.ws + WS_H);
    const f32x4 ps0 = *(const f32x4*)(a.in[7] + 8 * cg8), ps1 = *(const f32x4*)(a.in[7] + 8 * cg8 + 4), pg0 = *(const f32x4*)(a.in[8] + 8 * cg8), pg1 = *(const f32x4*)(a.in[8] + 8 * cg8 + 4);
    const float psc[8] = {ps0[0], ps0[1], ps0[2], ps0[3], ps1[0], ps1[1], ps1[2], ps1[3]}, pgn[8] = {pg0[0], pg0[1], pg0[2], pg0[3], pg1[0], pg1[1], pg1[2], pg1[3]};
    for (int item = bid; item < NT / 32; item += nb) {
        const int tb = item * 32 + 4 * tq, tl0 = tb % NS;
        const f16* up = Z + (size_t)(tb - tl0) * 512 + 8 * cg8;
        float sm[8];
#pragma unroll
        for (int j = 0; j < 8; ++j) sm[j] = 0.f;
        f16x8 hist_[15];
#pragma unroll
        for (int q = 0; q < 15; ++q) { const int rr = tl0 - 15 + q; hist_[q] = (q >= 16 - win && rr >= 0) ? *(const f16x8*)(up + (size_t)rr * 512) : (f16x8){0, 0, 0, 0, 0, 0, 0, 0}; }
        f16x8 cur_[4];
#pragma unroll
        for (int k = 0; k < 4; ++k) cur_[k] = *(const f16x8*)(up + (size_t)(tl0 + k) * 512);
#pragma unroll
        for (int q = 0; q < 15; ++q)
#pragma unroll
            for (int j = 0; j < 8; ++j) sm[j] += (float)hist_[q][j];
#pragma unroll
        for (int k = 0; k < 4; ++k) {
            const int tl = tl0 + k;
            const float ic = 1.f / (float)((tl + 1 < win) ? tl + 1 : win);
            float v[8]; float ss = 0.f;
#pragma unroll
            for (int j = 0; j < 8; ++j) { sm[j] += (float)cur_[k][j]; v[j] = (sm[j] * ic - (float)cur_[k][j]) * psc[j]; ss += v[j] * v[j]; }
            const float rstd = rsqrtf(wave_sum(ss) * (1.f / 512.f) + EPS);
            f16x8 o;
#pragma unroll
            for (int j = 0; j < 8; ++j) o[j] = (f16)(v[j] * rstd * pgn[j]);
            *(f16x8*)(MIX + (size_t)(tb + k) * ND + 8 * cg8) = o;
            if (k < 3) {
#pragma unroll
                for (int j = 0; j < 8; ++j) {
                    const int q = 16 - win + k;
                    float dv = 0.f;
#pragma unroll
                    for (int qq = 0; qq < 15; ++qq) if (qq == q) dv = (float)hist_[qq][j];
#pragma unroll
                    for (int kk = 0; kk < 3; ++kk) if (q == 15 + kk) dv = (float)cur_[kk][j];
                    sm[j] -= dv;
                }
            }
        }
    }
}


typedef float f32x2 __attribute__((ext_vector_type(2)));
typedef unsigned u32x4 __attribute__((ext_vector_type(4)));

constexpr int IDX_KPITCH = 16384 + 16;
constexpr int IDX_HPITCH = 516;
template <int NBL>
__device__ __forceinline__ int wave_pick(const unsigned (&cc)[NBL], unsigned target, int lane, unsigned& rem_out) {
    unsigned tot = 0u;
#pragma unroll
    for (int j = 0; j < NBL; ++j) tot += cc[j];
    unsigned S = tot;
#pragma unroll
    for (int o = 1; o < 64; o <<= 1) { const unsigned v = __shfl_down(S, o); if (lane + o < 64) S += v; }
    const unsigned above = S - tot;
    const bool hit = (above < target) && (S >= target);
    const u64 bal = __ballot(hit);
    const int L = bal ? __builtin_ctzll(bal) : 0;
    int bin = 0; unsigned rem = target;
    { unsigned run = above; bool done = false;
#pragma unroll
      for (int j = NBL - 1; j >= 0; --j) { if (!done) { if (run + cc[j] >= target) { bin = NBL * lane + j; rem = target - run; done = true; } else run += cc[j]; } } }
    bin = __shfl(bin, L); rem_out = __shfl(rem, L);
    return bin;
}
template <int MODE>
__device__ __forceinline__ void ph3_index_fast(const Args& a, int bid, int nb, unsigned char* lds) {
    int tid = threadIdx.x; asm volatile("" : "+v"(tid));
    const int lane = tid & 63, wave = __builtin_amdgcn_readfirstlane(tid >> 6), r = lane & 31, hh = lane >> 5;
    const f16* QI = (const f16*)(a.ws + WS_QI); const f16* KI = (const f16*)(a.ws + WS_KI); const float* WI = (const float*)(a.ws + WS_WI);
    u64* MASK = (u64*)(a.ws + WS_MASK);
    unsigned* hist = (unsigned*)(lds + 8 * IDX_KPITCH);
    f16x8 af[2][4]; f32x2 wv2[2][8];
#define IDX_LOAD_FRAGS(t0_) do { \
        _Pragma("unroll") for (int rt = 0; rt < 2; ++rt) { \
            _Pragma("unroll") for (int ks = 0; ks < 4; ++ks) af[rt][ks] = *(const f16x8*)(QI + ((((((size_t)((t0_) >> 3) * 2 + rt) * 4 + ks) * 2 + hh) * 32 + r) << 3)); \
            _Pragma("unroll") for (int qq = 0; qq < 2; ++qq) { const float* wp = WI + (size_t)((t0_) + 4 * rt + 2 * hh + qq) * 8; const f32x4 w0 = *(const f32x4*)wp * 0.125f, w1 = *(const f32x4*)(wp + 4) * 0.125f; \
                wv2[rt][4 * qq + 0] = (f32x2){w0[0], w0[1]}; wv2[rt][4 * qq + 1] = (f32x2){w0[2], w0[3]}; wv2[rt][4 * qq + 2] = (f32x2){w1[0], w1[1]}; wv2[rt][4 * qq + 3] = (f32x2){w1[2], w1[3]}; } \
        } } while (0)
    for (int round = 0; round * nb < 256; ++round) {
        const int p = round * nb + ((round & 1) ? (nb - 1 - bid) : bid);
        if (p < 256) { const int tg = p >> 3, b_ = p & 7, t0l = tg * 8, ch_ = t0l >> 6, t0_ = b_ * NS + t0l;
            if (tid < 8 * (ch_ + 1)) { const int q = tid / (ch_ + 1), w = tid % (ch_ + 1); MASK[((size_t)b_ * 128 + w) * NS + t0l + q] = ~0ull; } }
    }
#define IDX_P(round_) ((round_) * nb + (((round_) & 1) ? (nb - 1 - bid) : bid))
    int round = 0;
    while (round * nb < 8192 && !(IDX_P(round) >= 256 && IDX_P(round) < 8192)) ++round;
    if (round * nb < 8192) { const int p0 = IDX_P(round); IDX_LOAD_FRAGS((p0 & 7) * NS + (p0 >> 3) * 8); }
    for (; round * nb < 8192; ) {
        const int p = IDX_P(round);
        int rnext = round + 1;
        while (rnext * nb < 8192 && !(IDX_P(rnext) >= 256 && IDX_P(rnext) < 8192)) ++rnext;
        const bool has_next = rnext * nb < 8192;
        const int pn = has_next ? IDX_P(rnext) : p;
        const int tg = p >> 3, b = p & 7, t0l = tg * 8, ch = t0l >> 6, nadm = 64 * (ch + 1), t0 = b * NS + t0l;
        const int t0n = (pn & 7) * NS + (pn >> 3) * 8;
        round = has_next ? rnext : 8192;
        __syncthreads();
#pragma unroll
        for (int i = 0; i < 9; ++i) if (tid + i * NTHR < 8 * IDX_HPITCH) hist[tid + i * NTHR] = 0u;
        __syncthreads();
        const int nkb = nadm >> 5;
        const f16* kbase = KI + ((size_t)(b * (NS / 32)) * 8 + hh) * 256 + r * 8;
#define IDX_LOADB(dst, kb_) do { _Pragma("unroll") for (int ks = 0; ks < 4; ++ks) dst[ks] = *(const f16x8*)(kbase + ((size_t)(kb_) * 8 + 2 * ks) * 256); } while (0)
#define IDX_BLOCK(bfrag, kb_) do { \
            f32x16 acc[2]; \
            _Pragma("unroll") for (int rt = 0; rt < 2; ++rt) { acc[rt] = (f32x16){0.f, 0.f, 0.f, 0.f, 0.f, 0.f, 0.f, 0.f, 0.f, 0.f, 0.f, 0.f, 0.f, 0.f, 0.f, 0.f}; \
                _Pragma("unroll") for (int ks = 0; ks < 4; ++ks) acc[rt] = __builtin_amdgcn_mfma_f32_32x32x16_f16(af[rt][ks], bfrag[ks], acc[rt], 0, 0, 0); } \
            _Pragma("unroll") for (int rt = 0; rt < 2; ++rt) \
                _Pragma("unroll") for (int qq = 0; qq < 2; ++qq) { \
                    f32x2 t2 = (f32x2){0.f, 0.f}; \
                    _Pragma("unroll") for (int hp = 0; hp < 4; ++hp) { const f32x2 r2 = (f32x2){__int_as_float(max(__float_as_int(acc[rt][8 * qq + 2 * hp]), 0)), __int_as_float(max(__float_as_int(acc[rt][8 * qq + 2 * hp + 1]), 0))}; \
                        t2 = __builtin_elementwise_fma(wv2[rt][4 * qq + hp], r2, t2); } \
                    const float sc = t2[0] + t2[1]; \
                    const f16 sh = (f16)sc; const unsigned bits = (unsigned)__builtin_bit_cast(unsigned short, sh); \
                    const unsigned key = (bits & 0x8000u) ? (~bits & 0xFFFFu) : (bits | 0x8000u); \
                    const int q = 4 * rt + 2 * hh + qq; \
                    if (MODE != 2) *(u16*)(lds + q * IDX_KPITCH + ((kb_) * 32 + r) * 2) = (u16)key; \
                    if (MODE != 2 && MODE != 4) atomicAdd(&hist[q * IDX_HPITCH + (key >> 7)], (key & 64u) ? 0x10000u : 1u); \
                    if (MODE == 2) sink += key; \
                } } while (0)
        f16x8 bf0[4], bf1[4], bf2[4]; unsigned sink = 0u;
        if (wave >= 4) __builtin_amdgcn_s_sleep(5);
        if (wave < nkb) IDX_LOADB(bf0, wave);
        if (wave + 8 < nkb) IDX_LOADB(bf1, wave + 8);
        if (wave + 16 < nkb) IDX_LOADB(bf2, wave + 16);
        if (MODE != 3) for (int kb = wave; kb < nkb; kb += 24) {
            IDX_BLOCK(bf0, kb);
            if (kb + 24 < nkb) IDX_LOADB(bf0, kb + 24);
            if (kb + 8 < nkb) { IDX_BLOCK(bf1, kb + 8); if (kb + 32 < nkb) IDX_LOADB(bf1, kb + 32); }
            if (kb + 16 < nkb) { IDX_BLOCK(bf2, kb + 16); if (kb + 40 < nkb) IDX_LOADB(bf2, kb + 40); }
        }
#undef IDX_LOADB
#undef IDX_BLOCK
        if (MODE == 2 && sink == 0xdeadbeefu) hist[tid] = sink;
        IDX_LOAD_FRAGS(t0n);
        __syncthreads();
        if (MODE != 1) {
            unsigned* hw = hist + wave * IDX_HPITCH;
            const unsigned char* krow = lds + wave * IDX_KPITCH;
            unsigned rem1 = 0u, rem2 = 0u;
            int b1;
            {   const u32x4 d0 = *(const u32x4*)(hw + 8 * lane), d1 = *(const u32x4*)(hw + 8 * lane + 4);
                const unsigned dd[8] = {d0.x, d0.y, d0.z, d0.w, d1.x, d1.y, d1.z, d1.w};
                unsigned cc[16];
#pragma unroll
                for (int j = 0; j < 8; ++j) { cc[2 * j] = dd[j] & 0xFFFFu; cc[2 * j + 1] = dd[j] >> 16; }
                b1 = wave_pick<16>(cc, 256u, lane, rem1); }
            hw[lane] = 0u;
            const int nit = (nadm + 511) >> 9;
            for (int it = 0; it < nit; ++it) {
                const int idx = (it * 64 + lane) * 8;
                if (idx < nadm) { const u32x4 k4 = *(const u32x4*)(krow + idx * 2);
                    const unsigned kk[4] = {k4.x, k4.y, k4.z, k4.w};
                    unsigned hit = 0u;
#pragma unroll
                    for (int j = 0; j < 4; ++j) { hit |= (((kk[j] & 0xFFFFu) >> 6) == (unsigned)b1 ? 1u : 0u) << (2 * j); hit |= ((kk[j] >> 22) == (unsigned)b1 ? 1u : 0u) << (2 * j + 1); }
                    if (hit) {
#pragma unroll
                        for (int j = 0; j < 4; ++j) { const unsigned k0 = kk[j] & 0xFFFFu, k1 = kk[j] >> 16;
                            if (hit & (1u << (2 * j))) atomicAdd(&hw[k0 & 63u], 1u);
                            if (hit & (2u << (2 * j))) atomicAdd(&hw[k1 & 63u], 1u); }
                    } }
            }
            int b2;
            { const unsigned c1[1] = {hw[lane]}; b2 = wave_pick<1>(c1, rem1, lane, rem2); }
            const unsigned tau = ((unsigned)b1 << 6) | (unsigned)b2;
            const size_t mrow = (size_t)(t0 + wave) * 128;
            for (int it = 0; it < nit; ++it) {
                const int idx = (it * 64 + lane) * 8;
                unsigned byte = 0u;
                if (idx < nadm) { const u32x4 k4 = *(const u32x4*)(krow + idx * 2);
                    const unsigned kk[4] = {k4.x, k4.y, k4.z, k4.w};
#pragma unroll
                    for (int j = 0; j < 4; ++j) { byte |= ((kk[j] & 0xFFFFu) >= tau ? 1u : 0u) << (2 * j); byte |= ((kk[j] >> 16) >= tau ? 1u : 0u) << (2 * j + 1); } }
                unsigned lo = (lane & 4) ? 0u : (byte << (8 * (lane & 3))), hi = (lane & 4) ? (byte << (8 * (lane & 3))) : 0u;
                lo |= __shfl_xor(lo, 1); hi |= __shfl_xor(hi, 1); lo |= __shfl_xor(lo, 2); hi |= __shfl_xor(hi, 2); lo |= __shfl_xor(lo, 4); hi |= __shfl_xor(hi, 4);
                if ((lane & 7) == 0 && idx < nadm) { hw[64 + 2 * (it * 8 + (lane >> 3))] = lo; hw[64 + 2 * (it * 8 + (lane >> 3)) + 1] = hi; }
            }
        }
        __syncthreads();
        if (MODE != 1) { const int w = tid >> 2, qp = tid & 3;
            if (w <= ch) { const unsigned* ha = hist + (2 * qp) * IDX_HPITCH + 64 + 2 * w; const unsigned* hb = ha + IDX_HPITCH;
                *(u32x4*)(MASK + ((size_t)b * 128 + w) * NS + t0l + 2 * qp) = (u32x4){ha[0], ha[1], hb[0], hb[1]}; } }
    }
    __syncthreads();
}

constexpr int ATP = 144;
constexpr int ATT_QWORD = 3584 + 32 * 64;
template <int AMODE>
__device__ __forceinline__ void ph4_attn_fast(const Args& a, int bid, int nb, unsigned char* lds) {
    int tid = threadIdx.x; asm volatile("" : "+v"(tid));
    const int lane = tid & 63, wave = __builtin_amdgcn_readfirstlane(tid >> 6), r = lane & 31, hh = lane >> 5;
    const f16* Q = (const f16*)(a.ws + WS_Q); const f16* Kk = (const f16*)(a.ws + WS_K); const f16* VT = (const f16*)(a.ws + WS_VT);
    const u64* MASK = (const u64*)(a.ws + WS_MASK); f16* MIX = (f16*)(a.ws + WS_H); const float* og = a.in[11];
    unsigned char* Kl = lds; unsigned char* Vl = lds + 2 * 64 * ATP;
    const float LOG2E = 1.4426950408889634f, OFF = 8192.f;
    const int pir = 16 * (r >> 4) + 8 * ((r >> 2) & 1) + 4 * ((r >> 3) & 1) + (r & 3);
    const int srow = tid >> 3, schk = tid & 7;
    unsigned* aq = (unsigned*)(a.ws + WS_CTL) + ATT_QWORD;
    lds_u32* ucell = (lds_u32*)(lds + 6 * 64 * ATP);
    lds_u32* dflag = ucell + 8;
    const float kmax = __int_as_float(__builtin_amdgcn_readfirstlane(__float_as_int(1.01f * 8.f * wave_max(fabsf(a.in[10][lane])))));
    int upar = 0;
    for (;;) {
        if (tid == 0) ucell[upar] = __hip_atomic_fetch_add(aq, 1u, __ATOMIC_RELAXED, __HIP_MEMORY_SCOPE_AGENT);
        if (tid < 8) dflag[tid] = 0u;
        __syncthreads();
        const unsigned u = ucell[upar]; upar ^= 1;
        if (u >= 2048u) break;
        const int h = 7 - (int)(u >> 8), qb = 31 - (int)((u & 255u) >> 3), b = (int)(u & 7u);
        const int q0l = qb * 256, tq = q0l + 32 * wave + r, cw = 4 * qb + (wave >> 1), top = 4 * qb + 3;
        const size_t t = (size_t)b * NS + tq;
        const float slope = exp2f(-(float)(h + 1)) * LOG2E;
        f16x8 qf[4];
#pragma unroll
        for (int ks = 0; ks < 4; ++ks) { const f16x8 qv = *(const f16x8*)(Q + t * 512 + h * 64 + 16 * ks + 8 * hh);
#pragma unroll
            for (int j = 0; j < 8; ++j) qf[ks][j] = (f16)((float)qv[j] * (0.125f * LOG2E)); }
        float qss = 0.f;
#pragma unroll
        for (int ks = 0; ks < 4; ++ks)
#pragma unroll
            for (int j = 0; j < 8; ++j) qss += (float)qf[ks][j] * (float)qf[ks][j];
        qss += __shfl_xor(qss, 32);
        const float Sb = __int_as_float(__builtin_amdgcn_readfirstlane(__float_as_int(wave_max(sqrtf(qss)) * kmax)));
        const float rowc = OFF + slope * (float)(tq - q0l);
        float m = 1000.f, l = 0.f;
        f32x16 O[2];
#pragma unroll
        for (int dt = 0; dt < 2; ++dt) O[dt] = (f32x16){0.f, 0.f, 0.f, 0.f, 0.f, 0.f, 0.f, 0.f, 0.f, 0.f, 0.f, 0.f, 0.f, 0.f, 0.f, 0.f};
        const f16* kg = Kk + ((size_t)b * NS + srow) * 512 + h * 64 + schk * 8;
        const f16* vg = VT + (size_t)(h * 64 + srow) * NT + (size_t)b * NS + schk * 8;
        f16x8 kr0, kr1, vr0, vr1; u64 mw0 = 0ull, mw1 = 0ull;
#define ATT_LOAD(kr, vr, mwv, jj) do { const int jc_ = (jj) > 0 ? (jj) : 0; kr = *(const f16x8*)(kg + (size_t)jc_ * 64 * 512); vr = *(const f16x8*)(vg + jc_ * 64); \
            mwv = MASK[((size_t)b * 128 + jc_) * NS + tq]; } while (0)
        asm volatile("" ::: "memory"); ATT_LOAD(kr0, vr0, mw0, top); asm volatile("" ::: "memory"); ATT_LOAD(kr1, vr1, mw1, top - 1); asm volatile("" ::: "memory");
        int buf = 0; bool wdone = false, stop = false;
        auto step = [&](f16x8& kreg, f16x8& vreg, u64& mwr, const int j) {
            *(f16x8*)(Kl + buf * 64 * ATP + srow * ATP + schk * 16) = kreg;
            *(f16x8*)(Vl + buf * 64 * ATP + srow * ATP + schk * 16) = vreg;
            const u64 mw = (j <= cw) ? mwr : 0ull;
            asm volatile("s_waitcnt lgkmcnt(0)" ::: "memory"); __builtin_amdgcn_s_barrier(); asm volatile("" ::: "memory");
            {
                const unsigned jp = (unsigned)(j + 1);
                const unsigned d0 = dflag[0], d1 = dflag[1], d2 = dflag[2], d3 = dflag[3], d4 = dflag[4], d5 = dflag[5], d6 = dflag[6], d7 = dflag[7];
                if ((d0 > jp) & (d1 > jp) & (d2 > jp) & (d3 > jp) & (d4 > jp) & (d5 > jp) & (d6 > jp) & (d7 > jp)) { stop = true; return; }
            }
            asm volatile("" ::: "memory"); ATT_LOAD(kreg, vreg, mwr, j - 2); asm volatile("" ::: "memory");
            if (!wdone && j < cw) { const float lmax = Sb + OFF + slope * (float)(64 * j + 63 - q0l); if (__all(lmax - m < -28.f)) { wdone = true; if (lane == 0) dflag[wave] = (unsigned)(j + 1); } }
            if (j <= cw && !wdone) {
                const unsigned char* kb_ = Kl + buf * 64 * ATP + pir * ATP + 16 * hh;
                f16x8 fr8[8];
#pragma unroll
                for (int kt = 0; kt < 2; ++kt)
#pragma unroll
                    for (int ks = 0; ks < 4; ++ks) fr8[kt * 4 + ks] = *(const f16x8*)(kb_ + kt * 32 * ATP + ks * 32);
                f32x16 sa[2];
                if (j == cw) {
#pragma unroll
                    for (int kt = 0; kt < 2; ++kt)
#pragma unroll
                        for (int rg = 0; rg < 16; ++rg) { const float x = (float)(64 * j + 32 * kt + 16 * (rg >> 3) + 8 * hh + (rg & 7) - tq); sa[kt][rg] = rowc - slope * fabsf(x); }
                } else {
                    const float base = OFF + slope * (float)(64 * j + 8 * hh - q0l);
#pragma unroll
                    for (int kt = 0; kt < 2; ++kt)
#pragma unroll
                        for (int rg = 0; rg < 16; ++rg) sa[kt][rg] = __builtin_fmaf(slope, (float)(32 * kt + 16 * (rg >> 3) + (rg & 7)), base);
                }
                __builtin_amdgcn_sched_barrier(0);
                __builtin_amdgcn_s_setprio(1);
#pragma unroll
                for (int kt = 0; kt < 2; ++kt)
#pragma unroll
                    for (int ks = 0; ks < 4; ++ks) sa[kt] = __builtin_amdgcn_mfma_f32_32x32x16_f16(fr8[kt * 4 + ks], qf[ks], sa[kt], 0, 0, 0);
                __builtin_amdgcn_s_setprio(0);
                __builtin_amdgcn_sched_barrier(0);
                const unsigned char* vb_ = Vl + buf * 64 * ATP + r * ATP + 16 * hh;
#pragma unroll
                for (int dt = 0; dt < 2; ++dt)
#pragma unroll
                    for (int kt = 0; kt < 2; ++kt)
#pragma unroll
                        for (int s2 = 0; s2 < 2; ++s2) fr8[dt * 4 + kt * 2 + s2] = *(const f16x8*)(vb_ + dt * 32 * ATP + kt * 64 + s2 * 32);
                __builtin_amdgcn_sched_barrier(0);
                float rm = 0.f;
#pragma unroll
                for (int kt = 0; kt < 2; ++kt) { const unsigned w32 = (unsigned)(kt ? (mw >> 32) : mw) >> (8 * hh);
#pragma unroll
                    for (int rg = 0; rg < 16; ++rg) { const int tm = __builtin_amdgcn_sbfe((int)w32, 16 * (rg >> 3) + (rg & 7), 1);
                        const float L = __int_as_float(__float_as_int(sa[kt][rg]) & tm); sa[kt][rg] = L; rm = fmaxf(rm, L); } }
                rm = fmaxf(rm, __shfl_xor(rm, 32));
                const float mn = fmaxf(m, rm);
                if (__any(mn > m)) { const float al = __builtin_amdgcn_exp2f(m - mn); l *= al;
#pragma unroll
                    for (int dt = 0; dt < 2; ++dt)
#pragma unroll
                        for (int rg = 0; rg < 16; ++rg) O[dt][rg] *= al; }
                m = mn;
                f16x8 pf[2][2];
                float l0 = 0.f, l1 = 0.f;
#pragma unroll
                for (int kt = 0; kt < 2; ++kt)
#pragma unroll
                    for (int rg = 0; rg < 16; ++rg) { const float pp = __builtin_amdgcn_exp2f(sa[kt][rg] - m); if (rg & 1) l1 += pp; else l0 += pp; pf[kt][rg >> 3][rg & 7] = (f16)pp; }
                l += l0 + l1;
                __builtin_amdgcn_sched_barrier(0);
                __builtin_amdgcn_s_setprio(1);
#pragma unroll
                for (int dt = 0; dt < 2; ++dt)
#pragma unroll
                    for (int kt = 0; kt < 2; ++kt)
#pragma unroll
                        for (int s2 = 0; s2 < 2; ++s2) O[dt] = __builtin_amdgcn_mfma_f32_32x32x16_f16(fr8[dt * 4 + kt * 2 + s2], pf[kt][s2], O[dt], 0, 0, 0);
                __builtin_amdgcn_s_setprio(0);
            }
            buf ^= 1;
        };
        for (int j = top; j >= 0; j -= 2) {
            step(kr0, vr0, mw0, j); if (stop) break;
            step(kr1, vr1, mw1, j - 1); if (stop) break;
        }
#undef ATT_LOAD
        l += __shfl_xor(l, 32);
        const float inv = 1.f / l;
        float ss = 0.f;
#pragma unroll
        for (int dt = 0; dt < 2; ++dt)
#pragma unroll
            for (int rg = 0; rg < 16; ++rg) { O[dt][rg] *= inv; ss += O[dt][rg] * O[dt][rg]; }
        ss += __shfl_xor(ss, 32);
        const float rstd = rsqrtf(ss * (1.f / 64.f) + EPS);
#pragma unroll
        for (int dt = 0; dt < 2; ++dt)
#pragma unroll
            for (int g4 = 0; g4 < 4; ++g4) { const int d = 32 * dt + 8 * g4 + 4 * hh; const f32x4 gg = *(const f32x4*)(og + h * 64 + d);
                f16x4 o4; o4.x = (f16)(O[dt][4 * g4 + 0] * rstd * gg.x); o4.y = (f16)(O[dt][4 * g4 + 1] * rstd * gg.y); o4.z = (f16)(O[dt][4 * g4 + 2] * rstd * gg.z); o4.w = (f16)(O[dt][4 * g4 + 3] * rstd * gg.w);
                *(f16x4*)(MIX + t * ND + 512 + h * 64 + d) = o4; }
        __syncthreads();
    }
}

__device__ __forceinline__ void ph5_outproj(const Args& a, int bid, int nb, unsigned char* lds) {
    pg8::Gemm g{(const f16*)(a.ws + WS_H), (const f16*)(a.ws + WS_WOUT), NT, 1024, ND}; pg8::StaticOrder S; S.init(NT, 1024, nb, bid);
    pg8::EpiOut E{a.in[0], (const float*)(a.ws + WS_MOD), (f16*)(a.ws + WS_X1)};
    pg8::gemm_phase((PG8_LAS unsigned char*)lds, g, S, E);
}

__device__ __forceinline__ void ph7_peerq(const Args& a, int bid, int nb, unsigned char* lds) {
    pg8::Gemm g{(const f16*)(a.ws + WS_HQ), (const f16*)(a.ws + WS_WQ8), NT, 2048, ND / 2}; pg8::StaticOrder S; S.init(NT, 2048, nb, bid);
    pg8::EpiPQ E{(f16*)(a.ws + WS_PQ), (const float*)(a.ws + WS_HSC), (const float*)(a.ws + WS_WSC)};
    pg8::gemm_phase<pg8::EpiPQ, true>((PG8_LAS unsigned char*)lds, g, S, E);
}


__device__ __forceinline__ unsigned f2skey(float f) { const unsigned u = __float_as_uint(f); return (u & 0x80000000u) ? ~u : (u | 0x80000000u); }
__device__ __forceinline__ float skey2f(unsigned k) { return __uint_as_float((k & 0x80000000u) ? (k & 0x7FFFFFFFu) : ~k); }
#define CE_(a_, b_) do { const unsigned t__ = max(a_, b_); b_ = min(a_, b_); a_ = t__; } while (0)
#define SORT16_DESC(v) do { CE_(v[0], v[1]); CE_(v[2], v[3]); CE_(v[0], v[2]); CE_(v[1], v[3]); CE_(v[1], v[2]); CE_(v[4], v[5]); CE_(v[6], v[7]); CE_(v[4], v[6]); CE_(v[5], v[7]); CE_(v[5], v[6]); CE_(v[0], v[4]); CE_(v[2], v[6]); CE_(v[2], v[4]); CE_(v[1], v[5]); CE_(v[3], v[7]); CE_(v[3], v[5]); CE_(v[1], v[2]); CE_(v[3], v[4]); CE_(v[5], v[6]); CE_(v[8], v[9]); CE_(v[10], v[11]); CE_(v[8], v[10]); CE_(v[9], v[11]); CE_(v[9], v[10]); CE_(v[12], v[13]); CE_(v[14], v[15]); CE_(v[12], v[14]); CE_(v[13], v[15]); CE_(v[13], v[14]); CE_(v[8], v[12]); CE_(v[10], v[14]); CE_(v[10], v[12]); CE_(v[9], v[13]); CE_(v[11], v[15]); CE_(v[11], v[13]); CE_(v[9], v[10]); CE_(v[11], v[12]); CE_(v[13], v[14]); CE_(v[0], v[8]); CE_(v[4], v[12]); CE_(v[4], v[8]); CE_(v[2], v[10]); CE_(v[6], v[14]); CE_(v[6], v[10]); CE_(v[2], v[4]); CE_(v[6], v[8]); CE_(v[10], v[12]); CE_(v[1], v[9]); CE_(v[5], v[13]); CE_(v[5], v[9]); CE_(v[3], v[11]); CE_(v[7], v[15]); CE_(v[7], v[11]); CE_(v[3], v[5]); CE_(v[7], v[9]); CE_(v[11], v[13]); CE_(v[1], v[2]); CE_(v[3], v[4]); CE_(v[5], v[6]); CE_(v[7], v[8]); CE_(v[9], v[10]); CE_(v[11], v[12]); CE_(v[13], v[14]); } while (0)
#define BITONIC16_DESC(v) do { CE_(v[0], v[8]); CE_(v[1], v[9]); CE_(v[2], v[10]); CE_(v[3], v[11]); CE_(v[4], v[12]); CE_(v[5], v[13]); CE_(v[6], v[14]); CE_(v[7], v[15]); CE_(v[0], v[4]); CE_(v[1], v[5]); CE_(v[2], v[6]); CE_(v[3], v[7]); CE_(v[8], v[12]); CE_(v[9], v[13]); CE_(v[10], v[14]); CE_(v[11], v[15]); CE_(v[0], v[2]); CE_(v[1], v[3]); CE_(v[4], v[6]); CE_(v[5], v[7]); CE_(v[8], v[10]); CE_(v[9], v[11]); CE_(v[12], v[14]); CE_(v[13], v[15]); CE_(v[0], v[1]); CE_(v[2], v[3]); CE_(v[4], v[5]); CE_(v[6], v[7]); CE_(v[8], v[9]); CE_(v[10], v[11]); CE_(v[12], v[13]); CE_(v[14], v[15]); } while (0)
#define MERGE16_DESC(dst, other) do { unsigned c__[16]; _Pragma("unroll") for (int i__ = 0; i__ < 16; ++i__) c__[i__] = max(dst[i__], other[15 - i__]); BITONIC16_DESC(c__); _Pragma("unroll") for (int i__ = 0; i__ < 16; ++i__) dst[i__] = c__[i__]; } while (0)
#define TOP16_INSERT(v, x_) do { unsigned x__ = (x_); _Pragma("unroll") for (int k_ = 0; k_ < 16; ++k_) { const unsigned t__ = max(v[k_], x__); x__ = min(v[k_], x__); v[k_] = t__; } } while (0)
__device__ __forceinline__ void ph8_peersel_fast(const Args& a, int bid, int nb, unsigned char* lds) {
    int tid = threadIdx.x; asm volatile("" : "+v"(tid));
    const int lane = tid & 63, wave = __builtin_amdgcn_readfirstlane(tid >> 6), r = lane & 31, hh = lane >> 5;
    const f16* PQ = (const f16*)(a.ws + WS_PQ);
    u16* EID = (u16*)(a.ws + WS_EID); float* GW = (float*)(a.ws + WS_GW);
    unsigned char* wl = lds + wave * 2048 + lane * 32;
    for (int item = bid * NWAVE + wave; item < (NT / 32) * 8; item += nb * NWAVE) {
        const int tt = item >> 3, h = item & 7, t0 = tt * 32;
        unsigned top[2][16];
#pragma unroll
        for (int p = 0; p < 2; ++p) {
            f16x8 sq[8];
#pragma unroll
            for (int c = 0; c < 8; ++c) sq[c] = *(const f16x8*)(PQ + ((((size_t)tt * 256 + h * 32 + p * 16 + 8 * hh + c) * 32 + r) << 3));
#pragma unroll
            for (int k = 0; k < 16; ++k) top[p][k] = 0u;
#pragma unroll
            for (int g = 0; g < 4; ++g) {
                unsigned ky[16];
#pragma unroll
                for (int i = 0; i < 16; ++i) { const unsigned n = 64u * hh + 16u * g + i; ky[i] = (f2skey((float)sq[2 * g + (i >> 3)][i & 7]) & ~127u) | n; }
                SORT16_DESC(ky); MERGE16_DESC(top[p], ky);
            }
            unsigned oth[16];
#pragma unroll
            for (int k = 0; k < 16; ++k) oth[k] = __shfl_xor(top[p][k], 32);
            MERGE16_DESC(top[p], oth);
            asm volatile("" ::: "memory");
        }
#pragma unroll
        for (int k = 0; k < 16; k += 4) {
            *(unsigned*)(wl + k) = (top[0][k] & 127u) | ((top[0][k + 1] & 127u) << 8) | ((top[0][k + 2] & 127u) << 16) | ((top[0][k + 3] & 127u) << 24);
            *(unsigned*)(wl + 16 + k) = (top[1][k] & 127u) | ((top[1][k + 1] & 127u) << 8) | ((top[1][k + 2] & 127u) << 16) | ((top[1][k + 3] & 127u) << 24);
        }
        float fa[16], fb[16];
#pragma unroll
        for (int k = 0; k < 16; ++k) { fa[k] = skey2f(top[0][k] & ~127u); fb[k] = skey2f(top[1][k] & ~127u); }
        unsigned cg[4][16];
        cg[0][0] = (f2skey(fa[0] + fb[0]) & ~255u) | 0u;
        cg[0][1] = (f2skey(fa[0] + fb[1]) & ~255u) | 1u;
        cg[0][2] = (f2skey(fa[0] + fb[2]) & ~255u) | 2u;
        cg[0][3] = (f2skey(fa[0] + fb[3]) & ~255u) | 3u;
        cg[0][4] = (f2skey(fa[0] + fb[4]) & ~255u) | 4u;
        cg[0][5] = (f2skey(fa[0] + fb[5]) & ~255u) | 5u;
        cg[0][6] = (f2skey(fa[0] + fb[6]) & ~255u) | 6u;
        cg[0][7] = (f2skey(fa[0] + fb[7]) & ~255u) | 7u;
        cg[0][8] = (f2skey(fa[0] + fb[8]) & ~255u) | 8u;
        cg[0][9] = (f2skey(fa[0] + fb[9]) & ~255u) | 9u;
        cg[0][10] = (f2skey(fa[0] + fb[10]) & ~255u) | 10u;
        cg[0][11] = (f2skey(fa[0] + fb[11]) & ~255u) | 11u;
        cg[0][12] = (f2skey(fa[0] + fb[12]) & ~255u) | 12u;
        cg[0][13] = (f2skey(fa[0] + fb[13]) & ~255u) | 13u;
        cg[0][14] = (f2skey(fa[0] + fb[14]) & ~255u) | 14u;
        cg[0][15] = (f2skey(fa[0] + fb[15]) & ~255u) | 15u;
        cg[1][0] = (f2skey(fa[1] + fb[0]) & ~255u) | 16u;
        cg[1][1] = (f2skey(fa[1] + fb[1]) & ~255u) | 17u;
        cg[1][2] = (f2skey(fa[1] + fb[2]) & ~255u) | 18u;
        cg[1][3] = (f2skey(fa[1] + fb[3]) & ~255u) | 19u;
        cg[1][4] = (f2skey(fa[1] + fb[4]) & ~255u) | 20u;
        cg[1][5] = (f2skey(fa[1] + fb[5]) & ~255u) | 21u;
        cg[1][6] = (f2skey(fa[1] + fb[6]) & ~255u) | 22u;
        cg[1][7] = (f2skey(fa[1] + fb[7]) & ~255u) | 23u;
        cg[1][8] = (f2skey(fa[2] + fb[0]) & ~255u) | 32u;
        cg[1][9] = (f2skey(fa[2] + fb[1]) & ~255u) | 33u;
        cg[1][10] = (f2skey(fa[2] + fb[2]) & ~255u) | 34u;
        cg[1][11] = (f2skey(fa[2] + fb[3]) & ~255u) | 35u;
        cg[1][12] = (f2skey(fa[2] + fb[4]) & ~255u) | 36u;
        cg[1][13] = (f2skey(fa[3] + fb[0]) & ~255u) | 48u;
        cg[1][14] = (f2skey(fa[3] + fb[1]) & ~255u) | 49u;
        cg[1][15] = (f2skey(fa[3] + fb[2]) & ~255u) | 50u;
        cg[2][0] = (f2skey(fa[3] + fb[3]) & ~255u) | 51u;
        cg[2][1] = (f2skey(fa[4] + fb[0]) & ~255u) | 64u;
        cg[2][2] = (f2skey(fa[4] + fb[1]) & ~255u) | 65u;
        cg[2][3] = (f2skey(fa[4] + fb[2]) & ~255u) | 66u;
        cg[2][4] = (f2skey(fa[5] + fb[0]) & ~255u) | 80u;
        cg[2][5] = (f2skey(fa[5] + fb[1]) & ~255u) | 81u;
        cg[2][6] = (f2skey(fa[6] + fb[0]) & ~255u) | 96u;
        cg[2][7] = (f2skey(fa[6] + fb[1]) & ~255u) | 97u;
        cg[2][8] = (f2skey(fa[7] + fb[0]) & ~255u) | 112u;
        cg[2][9] = (f2skey(fa[7] + fb[1]) & ~255u) | 113u;
        cg[2][10] = (f2skey(fa[8] + fb[0]) & ~255u) | 128u;
        cg[2][11] = (f2skey(fa[9] + fb[0]) & ~255u) | 144u;
        cg[2][12] = (f2skey(fa[10] + fb[0]) & ~255u) | 160u;
        cg[2][13] = (f2skey(fa[11] + fb[0]) & ~255u) | 176u;
        cg[2][14] = (f2skey(fa[12] + fb[0]) & ~255u) | 192u;
        cg[2][15] = (f2skey(fa[13] + fb[0]) & ~255u) | 208u;
        cg[3][0] = (f2skey(fa[14] + fb[0]) & ~255u) | 224u;
        cg[3][1] = (f2skey(fa[15] + fb[0]) & ~255u) | 240u;
        cg[3][2] = 0u;
        cg[3][3] = 0u;
        cg[3][4] = 0u;
        cg[3][5] = 0u;
        cg[3][6] = 0u;
        cg[3][7] = 0u;
        cg[3][8] = 0u;
        cg[3][9] = 0u;
        cg[3][10] = 0u;
        cg[3][11] = 0u;
        cg[3][12] = 0u;
        cg[3][13] = 0u;
        cg[3][14] = 0u;
        cg[3][15] = 0u;
        SORT16_DESC(cg[0]); SORT16_DESC(cg[1]); SORT16_DESC(cg[2]); SORT16_DESC(cg[3]);
        MERGE16_DESC(cg[0], cg[1]); MERGE16_DESC(cg[2], cg[3]); MERGE16_DESC(cg[0], cg[2]);
        unsigned ct[16];
#pragma unroll
        for (int k = 0; k < 16; ++k) ct[k] = cg[0][k];
        float sc[16]; float den = 0.f; const float s0 = skey2f(ct[0] & ~255u);
#pragma unroll
        for (int k = 0; k < 16; ++k) { sc[k] = __expf(skey2f(ct[k] & ~255u) - s0); den += sc[k]; }
        const float inv = 1.f / den;
        if (hh == 0) {
            u16 ev[16];
#pragma unroll
            for (int k = 0; k < 16; ++k) { const unsigned ij = ct[k] & 255u; const unsigned i1 = wl[ij >> 4], i2 = wl[16 + (ij & 15u)]; ev[k] = (u16)(i1 * 128u + i2); }
            const size_t o = (size_t)(t0 + r) * 128 + h * 16;
#pragma unroll
            for (int k = 0; k < 16; k += 8) {
                *(u32x4*)(EID + o + k) = (u32x4){(unsigned)ev[k] | ((unsigned)ev[k + 1] << 16), (unsigned)ev[k + 2] | ((unsigned)ev[k + 3] << 16), (unsigned)ev[k + 4] | ((unsigned)ev[k + 5] << 16), (unsigned)ev[k + 6] | ((unsigned)ev[k + 7] << 16)};
            }
#pragma unroll
            for (int k = 0; k < 16; k += 4) *(f32x4*)(GW + o + k) = (f32x4){sc[k] * inv, sc[k + 1] * inv, sc[k + 2] * inv, sc[k + 3] * inv};
        }
    }
}

typedef _Float16 f16x2 __attribute__((ext_vector_type(2)));
__device__ __forceinline__ float gelu_erf(float d) { return 0.5f * d * (1.f + erff(d * 0.70710678118654752f)); }
constexpr int PQ_WORD0 = 3584, PQ_CHUNK = 64, PQ_NCHUNK = NT / PQ_CHUNK, PQ_HALF = PQ_NCHUNK / 2;
constexpr size_t WS_PART = 208 * MiB;
__device__ __forceinline__ unsigned xcc_id_() { return (unsigned)__builtin_amdgcn_s_getreg((3 << 11) | 20) & 7u; }
template <int VPHASE>
__device__ __forceinline__ void ph9_sliced(const Args& a, unsigned char* lds) {
    int tid_ = threadIdx.x; asm volatile("" : "+v"(tid_)); const int lane = tid_ & 63, wave = __builtin_amdgcn_readfirstlane(tid_ >> 6);
    const int g8 = lane >> 3, c8 = lane & 7;
    const unsigned char* HP = a.ws + WS_HP; const float* HSC = (const float*)(a.ws + WS_HSC); const unsigned char* TAB = a.ws + (VPHASE ? WS_VP : WS_UT);
    const u16* EID = (const u16*)(a.ws + WS_EID); const unsigned* GW = (const unsigned*)(a.ws + WS_GW); float* PART = (float*)(a.ws + WS_PART); const float* WSUM = (const float*)(a.ws + WS_WSUM);
    const float* mod = (const float*)(a.ws + WS_MOD); float* out = a.out; const f16* X1 = (const f16*)(a.ws + WS_X1);
    unsigned* qw = (unsigned*)(a.ws + WS_CTL) + PQ_WORD0 + (VPHASE ? 8 * 64 : 0);
    volatile unsigned* cslot = (volatile unsigned*)lds;
    const bool b5 = (lane & 32) != 0, b4 = (lane & 16) != 0, b3 = (lane & 8) != 0, b2 = (lane & 4) != 0, b1 = (lane & 2) != 0, b0 = (lane & 1) != 0;
    const unsigned x0 = xcc_id_();
    int par = 0;
    for (int k = 0; k < 8; ++k) {
        const unsigned qi_ = (x0 + (unsigned)k) & 7u, sl = qi_ & 3u, half = qi_ >> 2;
        unsigned cur = 0u;
        if (tid_ == 0) cur = __hip_atomic_fetch_add(qw + 64 * qi_, 1u, __ATOMIC_RELAXED, __HIP_MEMORY_SCOPE_AGENT);
        for (;;) {
            if (tid_ == 0) cslot[par] = cur;
            __syncthreads();
            const unsigned c = cslot[par]; par ^= 1;
            if (c >= (unsigned)PQ_HALF) break;
            if (tid_ == 0) cur = __hip_atomic_fetch_add(qw + 64 * qi_, 1u, __ATOMIC_RELAXED, __HIP_MEMORY_SCOPE_AGENT);
            const int tb = (int)(half * PQ_HALF + c) * PQ_CHUNK + wave * (PQ_CHUNK / NWAVE);
            const unsigned char* tsl = TAB + 128 * sl + 16 * c8;
#pragma unroll 1
            for (int i8 = 0; i8 < PQ_CHUNK / NWAVE; ++i8) {
                const int t = tb + i8;
                const u32x4 e0 = *(const u32x4*)(EID + (size_t)t * 128 + 16 * g8), e1 = *(const u32x4*)(EID + (size_t)t * 128 + 16 * g8 + 8);
                const unsigned ew[8] = {e0.x, e0.y, e0.z, e0.w, e1.x, e1.y, e1.z, e1.w};
                u32x4 r8[16];
#pragma unroll
                for (int i = 0; i < 16; ++i) { const unsigned eid = (i & 1) ? (ew[i >> 1] >> 16) : (ew[i >> 1] & 0xFFFFu); r8[i] = *(const u32x4*)(tsl + (size_t)eid * 512); }
                if (!VPHASE) {
                    const u32x4 hh4 = *(const u32x4*)(HP + (size_t)t * 1024 + 128 * sl + 16 * c8), hl4 = *(const u32x4*)(HP + (size_t)t * 1024 + 512 + 128 * sl + 16 * c8);
                    const float hsc = 0.5f * HSC[t];
                    int hs1 = 0, hs0 = 0;
#pragma unroll
                    for (int j = 0; j < 4; ++j) { hs1 = __builtin_amdgcn_sdot8((int)hh4[j], 0x11111111, hs1, false); hs0 = __builtin_amdgcn_sdot8((int)hl4[j], 0x11111111, hs0, false); }
                    const int hsum = 16 * hs1 + hs0;
                    float p[16];
#pragma unroll
                    for (int i = 0; i < 16; ++i) { int d1 = 0, d0 = 0;
#pragma unroll
                        for (int j = 0; j < 4; ++j) { d1 = __builtin_amdgcn_sdot8((int)hh4[j], (int)r8[i][j], d1, false); d0 = __builtin_amdgcn_sdot8((int)hl4[j], (int)r8[i][j], d0, false); }
                        p[i] = (float)(2 * (16 * d1 + d0) + hsum); }
                    float q8[8], q4[4], r2[2];
#pragma unroll
                    for (int ii = 0; ii < 8; ++ii) { const float keep = b2 ? p[8 + ii] : p[ii], send = b2 ? p[ii] : p[8 + ii]; q8[ii] = keep + __shfl_xor(send, 4); }
#pragma unroll
                    for (int ii = 0; ii < 4; ++ii) { const float keep = b1 ? q8[4 + ii] : q8[ii], send = b1 ? q8[ii] : q8[4 + ii]; q4[ii] = keep + __shfl_xor(send, 2); }
#pragma unroll
                    for (int ii = 0; ii < 2; ++ii) { const float keep = b0 ? q4[2 + ii] : q4[ii], send = b0 ? q4[ii] : q4[2 + ii]; r2[ii] = keep + __shfl_xor(send, 1); }
                    *(f32x2*)(PART + ((size_t)sl * NT + t) * 128 + 16 * g8 + 2 * c8) = (f32x2){r2[0] * hsc, r2[1] * hsc};
                } else {
                    const u32x4* wp = (const u32x4*)(GW + (size_t)t * 128 + 16 * g8);
                    const u32x4 wq0 = wp[0], wq1 = wp[1], wq2 = wp[2], wq3 = wp[3];
                    const unsigned wv[16] = {wq0[0], wq0[1], wq0[2], wq0[3], wq1[0], wq1[1], wq1[2], wq1[3], wq2[0], wq2[1], wq2[2], wq2[3], wq3[0], wq3[1], wq3[2], wq3[3]};
                    const f16 off = (f16)(-7.5f * 5.9604644775390625e-08f * WSUM[(size_t)t * 8 + g8]);
                    f16x2 acc2[16];
#pragma unroll
                    for (int j = 0; j < 16; ++j) acc2[j] = (f16x2){off, off};
#pragma unroll
                    for (int i = 0; i < 16; ++i) { const f16x2 wa = __builtin_bit_cast(f16x2, wv[i]); const f16x2 wb = wa * (f16x2){(f16)0.0625f, (f16)0.0625f};
#pragma unroll
                        for (int j = 0; j < 4; ++j) { const unsigned x = r8[i][j], y = x >> 8;
                            acc2[4 * j]     = __builtin_elementwise_fma(wa, __builtin_bit_cast(f16x2, x & 0x000F000Fu), acc2[4 * j]);
                            acc2[4 * j + 1] = __builtin_elementwise_fma(wb, __builtin_bit_cast(f16x2, x & 0x00F000F0u), acc2[4 * j + 1]);
                            acc2[4 * j + 2] = __builtin_elementwise_fma(wa, __builtin_bit_cast(f16x2, y & 0x000F000Fu), acc2[4 * j + 2]);
                            acc2[4 * j + 3] = __builtin_elementwise_fma(wb, __builtin_bit_cast(f16x2, y & 0x00F000F0u), acc2[4 * j + 3]); } }
                    unsigned q8[8], q4[4], r2[2];
#pragma unroll
                    for (int ii = 0; ii < 8; ++ii) { const unsigned lo_ = __builtin_bit_cast(unsigned, acc2[ii]), hi_ = __builtin_bit_cast(unsigned, acc2[8 + ii]); const unsigned keep = b5 ? hi_ : lo_, send = b5 ? lo_ : hi_;
                        q8[ii] = __builtin_bit_cast(unsigned, __builtin_bit_cast(f16x2, keep) + __builtin_bit_cast(f16x2, (unsigned)__shfl_xor((int)send, 32))); }
#pragma unroll
                    for (int ii = 0; ii < 4; ++ii) { const unsigned keep = b4 ? q8[4 + ii] : q8[ii], send = b4 ? q8[ii] : q8[4 + ii];
                        q4[ii] = __builtin_bit_cast(unsigned, __builtin_bit_cast(f16x2, keep) + __builtin_bit_cast(f16x2, (unsigned)__shfl_xor((int)send, 16))); }
#pragma unroll
                    for (int ii = 0; ii < 2; ++ii) { const unsigned keep = b3 ? q4[2 + ii] : q4[ii], send = b3 ? q4[ii] : q4[2 + ii];
                        r2[ii] = __builtin_bit_cast(unsigned, __builtin_bit_cast(f16x2, keep) + __builtin_bit_cast(f16x2, (unsigned)__shfl_xor((int)send, 8))); }
                    const f16x2 ra = __builtin_bit_cast(f16x2, r2[0]), rb = __builtin_bit_cast(f16x2, r2[1]);
                    const int ch = 256 * sl + 32 * c8 + (b5 ? 16 : 0) + (b4 ? 8 : 0) + (b3 ? 2 : 0);
                    float* op = out + (size_t)t * ND + ch; const float* g2 = mod + (t / NS) * 6144 + 5120 + ch; const f16* xp = X1 + (size_t)t * ND + ch;
                    const f16x2 xa = *(const f16x2*)xp, xb = *(const f16x2*)(xp + 4); const f32x2 ga = *(const f32x2*)g2, gb = *(const f32x2*)(g2 + 4);
                    const float sc_ = 16777216.f / PEER_WSCALE;
                    *(f32x2*)op = (f32x2){(float)xa[0] + ga[0] * ((float)ra[0] * sc_), (float)xa[1] + ga[1] * ((float)rb[0] * sc_)};
                    *(f32x2*)(op + 4) = (f32x2){(float)xb[0] + gb[0] * ((float)ra[1] * sc_), (float)xb[1] + gb[1] * ((float)rb[1] * sc_)};
                }
            }
        }
    }
}
__device__ __forceinline__ void ph9b_combine(const Args& a, int bid, int nb) {
    int tid_ = threadIdx.x; asm volatile("" : "+v"(tid_));
    float* GW = (float*)(a.ws + WS_GW); const float* PART = (const float*)(a.ws + WS_PART);
    const float du = ((const float*)(a.ws + WS_QS))[0], dv = ((const float*)(a.ws + WS_QS))[1] * PEER_WSCALE;
    const size_t istep = (size_t)nb * NTHR, itot = (size_t)NT * 128 / 4;
    size_t i = (size_t)bid * NTHR + tid_;
#define PQ9B_ONE(sum_, g_, ii_) do { f32x4 w; \
        _Pragma("unroll") for (int j = 0; j < 4; ++j) w[j] = fminf(fmaxf(g_[j] * gelu_erf(sum_[j] * du) * dv, -60000.f), 60000.f);        \
          \
        float ws_ = 0.f; u32x4 pk; \
        _Pragma("unroll") for (int j = 0; j < 4; ++j) { const f16 hw_ = (f16)w[j]; ws_ += (float)hw_; pk[j] = (unsigned)__builtin_bit_cast(unsigned short, hw_) * 0x10001u; } \
        ((u32x4*)GW)[ii_] = pk; \
        ws_ += __shfl_xor(ws_, 1); ws_ += __shfl_xor(ws_, 2); \
        if ((tid_ & 3) == 0) ((float*)(a.ws + WS_WSUM))[(ii_) >> 2] = ws_; } while (0)
    for (; i + istep < itot; i += 2 * istep) {
        f32x4 s0 = ((const f32x4*)PART)[i], s1 = ((const f32x4*)PART)[i + istep];
#pragma unroll
        for (int sidx = 1; sidx < 4; ++sidx) { s0 += ((const f32x4*)(PART + (size_t)sidx * NT * 128))[i]; s1 += ((const f32x4*)(PART + (size_t)sidx * NT * 128))[i + istep]; }
        const f32x4 g0 = ((const f32x4*)GW)[i], g1 = ((const f32x4*)GW)[i + istep];
        PQ9B_ONE(s0, g0, i); PQ9B_ONE(s1, g1, i + istep);
    }
    for (; i < itot; i += istep) {
        f32x4 s0 = ((const f32x4*)PART)[i];
#pragma unroll
        for (int sidx = 1; sidx < 4; ++sidx) s0 += ((const f32x4*)(PART + (size_t)sidx * NT * 128))[i];
        const f32x4 g0 = ((const f32x4*)GW)[i];
        PQ9B_ONE(s0, g0, i);
    }
#undef PQ9B_ONE
}

#define LAS __attribute__((address_space(3)))
#define XB_TMO      128
#define XB_XCNT(j)  (256  + 64 * (j))
#define XB_XSUB(j)  (1280 + 64 * (j))
#define XB_XGEN(j)  (2304 + 64 * (j))
#define XB_TOP      3328
#define XB_TOPGEN   3392
#define XCD_BAR_WORDS 3456
#define XB_SPIN_CAP (1u << 18)
__device__ __forceinline__ unsigned xb_ld(unsigned* p)              { return __hip_atomic_load(p, __ATOMIC_RELAXED, __HIP_MEMORY_SCOPE_AGENT); }
__device__ __forceinline__ unsigned xb_add(unsigned* p, unsigned v) { return __hip_atomic_fetch_add(p, v, __ATOMIC_RELAXED, __HIP_MEMORY_SCOPE_AGENT); }
__device__ __forceinline__ unsigned xb_xcc_id() { return (unsigned)__builtin_amdgcn_s_getreg((3 << 11) | 20) & 0xFu; }
#define XB_SPIN(cond, bar) do { unsigned _sp = 0; while (cond) { __builtin_amdgcn_s_sleep(1); \
    if ((++_sp & 255u) == 0u) { if (xb_ld(&(bar)[XB_TMO])) break; if (_sp > XB_SPIN_CAP) { atomicAdd(&(bar)[XB_TMO], 1u); break; } } } } while (0)
struct XcdBarrier { unsigned* bar; unsigned x; volatile LAS unsigned* st; };
__device__ __forceinline__ XcdBarrier xcd_barrier_post(unsigned* bar, volatile LAS unsigned* st) {
    XcdBarrier b; b.bar = bar; b.x = xb_xcc_id(); b.st = st;
    if (threadIdx.x == 0) (void)xb_add(&bar[XB_XCNT(b.x)], 1u);
    return b;
}
__device__ __forceinline__ void xcd_barrier_complete(unsigned* bar, unsigned x, unsigned& nloc, unsigned& nx) {
    const unsigned G = gridDim.x * gridDim.y * gridDim.z;
    unsigned sum, cnt, mine, sp = 0u;
    for (;;) {
        sum = 0u; cnt = 0u; mine = 0u;
#pragma unroll
        for (unsigned j = 0; j < 16; ++j) { const unsigned c = xb_ld(&bar[XB_XCNT(j)]); sum += c; cnt += (c > 0u) ? 1u : 0u; mine = (j == x) ? c : mine; }
        if (sum == G) break;
        __builtin_amdgcn_s_sleep(1);
        if ((++sp & 255u) == 0u) { if (xb_ld(&bar[XB_TMO])) break; if (sp > XB_SPIN_CAP) { atomicAdd(&bar[XB_TMO], 1u); break; } }
    }
    nloc = mine > 0u ? mine : 1u; nx = cnt > 0u ? cnt : 1u;
}
__device__ __forceinline__ void xcd_barrier(const XcdBarrier& b) {
    asm volatile("s_waitcnt vmcnt(0)" ::: "memory");
    __syncthreads();
    if (threadIdx.x == 0) {
        unsigned* bar = b.bar;
        __builtin_amdgcn_s_waitcnt(0);
        unsigned nloc = b.st[0], nx = b.st[1];
        if (nloc == 0u) { xcd_barrier_complete(bar, b.x, nloc, nx); b.st[0] = nloc; b.st[1] = nx; }
        const unsigned old = xb_add(&bar[XB_XSUB(b.x)], 1u);
        const unsigned gen = old / nloc;
        if (old + 1u == (gen + 1u) * nloc) {
            __builtin_amdgcn_fence(__ATOMIC_RELEASE, "agent");
            asm volatile("s_waitcnt vmcnt(0)" ::: "memory");
            const unsigned og = xb_add(&bar[XB_TOP], 1u);
            const unsigned tg = og / nx;
            if (og + 1u == (tg + 1u) * nx) xb_add(&bar[XB_TOPGEN], 1u);
            else XB_SPIN(xb_ld(&bar[XB_TOPGEN]) == tg, bar);
            __builtin_amdgcn_fence(__ATOMIC_ACQUIRE, "agent");
            xb_add(&bar[XB_XGEN(b.x)], 1u);
            asm volatile("s_waitcnt vmcnt(0)" ::: "memory");
        } else {
            XB_SPIN(xb_ld(&bar[XB_XGEN(b.x)]) == gen, bar);
            __builtin_amdgcn_fence(__ATOMIC_ACQUIRE, "agent");
            asm volatile("s_waitcnt vmcnt(0)" ::: "memory");
        }
    }
    __syncthreads();
}

constexpr int N_PHASES = 12;
__global__ void __launch_bounds__(NTHR, 2) mk_fwd(Args a) {
    extern __shared__ __attribute__((aligned(16))) unsigned char lds[];
    cg::grid_group grid = cg::this_grid();
    const int bid = blockIdx.x, nb = gridDim.x;
    const int lo = a.ph_lo, hi = a.ph_hi;
    volatile LAS unsigned* bst = (volatile LAS unsigned*)((LAS unsigned char*)lds + (LDS_BYTES - 16));
    if (threadIdx.x < 4) bst[threadIdx.x] = 0u;
    __syncthreads();
    XcdBarrier xbar = xcd_barrier_post((unsigned*)(a.ws + WS_CTL), bst);
#define SEAM(k) do { if ((k) == 0) grid.sync(); else xcd_barrier(xbar); } while (0)
#define PHASE(k, body) if (lo <= (k) && (k) < hi) { body; if ((k) + 1 < hi) SEAM(k); }
    PHASE(0, ph0_prologue(a, bid, nb, lds))
    PHASE(1, row_norm_mod(a.in[0], a.in[4], (const float*)(a.ws + WS_MOD), 0, 1024, (f16*)(a.ws + WS_H), bid, nb); wq_to_int8((const f16*)(a.ws + WS_WQ), a.ws + WS_WQ8, (float*)(a.ws + WS_WSC), bid, nb))
    PHASE(2, ph2_inproj(a, bid, nb, lds))
    PHASE(3, ph3_pool_fast(a, bid, nb, lds); ph3_index_fast<0>(a, bid, nb, lds))
    PHASE(4, ph4_attn_fast<0>(a, bid, nb, lds))
    PHASE(5, ph5_outproj(a, bid, nb, lds))
    PHASE(6, row_norm_mod_q((const f16*)(a.ws + WS_X1), a.in[13], (const float*)(a.ws + WS_MOD), 3072, 4096, a.ws + WS_HQ, (unsigned*)(a.ws + WS_HP), (float*)(a.ws + WS_HSC), bid, nb))
    PHASE(7, ph7_peerq(a, bid, nb, lds))
    PHASE(8, ph8_peersel_fast(a, bid, nb, lds))
    PHASE(9, ph9_sliced<0>(a, lds))
    PHASE(10, ph9b_combine(a, bid, nb))
    PHASE(11, ph9_sliced<1>(a, lds))
#undef PHASE
}

extern "C" void kernel_launch(void* const* d_in, const int* in_sizes, int n_in, void* d_out, int out_size, void* d_ws, size_t ws_size, hipStream_t stream) {
    static int grid = 0;
    if (grid == 0) {
        if (n_in != 18 || out_size != NT * ND || ws_size < WS_END) { fprintf(stderr, "kernel_launch: unexpected shapes (n_in %d out %d ws %zu)\n", n_in, out_size, ws_size); grid = -1; return; }
        int dev = 0, cus = 0, per_cu = 0;
        hipGetDevice(&dev); hipDeviceGetAttribute(&cus, hipDeviceAttributeMultiprocessorCount, dev);
        hipFuncSetAttribute((const void*)mk_fwd, hipFuncAttributeMaxDynamicSharedMemorySize, LDS_BYTES);
        hipOccupancyMaxActiveBlocksPerMultiprocessor(&per_cu, (const void*)mk_fwd, NTHR, LDS_BYTES);
        if (per_cu < 1) { fprintf(stderr, "kernel_launch: occupancy query says %d blocks/CU\n", per_cu); per_cu = 1; }
        grid = cus * 1;
        (void)hipGetLastError();
    }
    if (grid < 0) return;
    if (hipMemsetAsync((char*)d_ws + WS_CTL, 0, 32768, stream) != hipSuccess) { fprintf(stderr, "kernel_launch: memset of the barrier words failed\n"); return; }
    Args a{};
    for (int i = 0; i < 18; ++i) a.in[i] = (const float*)d_in[i];
    a.out = (float*)d_out; a.ws = (unsigned char*)d_ws;
#if MK_MULTI
    for (int ph = 0; ph < N_PHASES; ++ph) { a.ph_lo = ph; a.ph_hi = ph + 1; hipLaunchKernelGGL(mk_fwd, dim3(grid), dim3(NTHR), LDS_BYTES, stream, a); }
#else
    a.ph_lo = 0; a.ph_hi = N_PHASES;
    void* args[] = {&a};
    hipError_t e = hipLaunchCooperativeKernel((const void*)mk_fwd, dim3(grid), dim3(NTHR), args, LDS_BYTES, stream);
    if (e != hipSuccess) fprintf(stderr, "cooperative launch failed: %s (grid %d)\n", hipGetErrorString(e), grid);
#endif
}
```

```cpp
#include <hip/hip_runtime.h>
#include <hip/hip_cooperative_groups.h>
#include <cstdio>
#include <cstdint>
namespace cg = cooperative_groups;

#ifndef MK_MULTI
#define MK_MULTI 0
#endif

typedef _Float16 f16;
typedef _Float16 f16x8 __attribute__((ext_vector_type(8)));
typedef _Float16 f16x4 __attribute__((ext_vector_type(4)));
typedef float f32x4 __attribute__((ext_vector_type(4)));
typedef float f32x16 __attribute__((ext_vector_type(16)));
typedef int i32x4 __attribute__((ext_vector_type(4)));
typedef unsigned long long u64;
typedef unsigned short u16;
typedef __attribute__((address_space(3))) unsigned lds_u32;

constexpr int NB = 8, NS = 8192, ND = 1024, NT = NB * NS;
constexpr int INW = 2632;
constexpr int NMAIN = 2304;
constexpr float EPS = 1e-6f;
constexpr int NTHR = 512, NWAVE = 8;

constexpr size_t MiB = 1u << 20;
constexpr size_t WS_CTL = 0;
constexpr size_t WS_MOD = 1 * MiB;
constexpr size_t WS_WIN = 2 * MiB;
constexpr size_t WS_WVT = 7 * MiB;
constexpr size_t WS_WOUT = 8 * MiB;
constexpr size_t WS_WQ = 10 * MiB;
constexpr size_t WS_SK = 14 * MiB;
constexpr size_t WS_PW = 14 * MiB + 512 * 1024;
constexpr size_t WS_QS = 1 * MiB + 512 * 1024;
constexpr size_t WS_UT = 16 * MiB;
constexpr size_t WS_VP = 48 * MiB;
constexpr size_t WS_H = 80 * MiB;
constexpr size_t WS_U = 208 * MiB;
constexpr size_t WS_Q = 272 * MiB;
constexpr size_t WS_K = 336 * MiB;
constexpr size_t WS_VT = 400 * MiB;
constexpr size_t WS_PQ = 208 * MiB;
constexpr size_t WS_WIN8 = 28 * MiB;
constexpr size_t WS_WVT8 = 30 * MiB;
constexpr size_t WS_WSCIN = 31 * MiB;
constexpr size_t WS_H8 = 656 * MiB;
constexpr size_t WS_WQ8 = 24 * MiB;
constexpr size_t WS_WSC = 26 * MiB;
constexpr size_t WS_HQ = 464 * MiB;
constexpr size_t WS_HP = 784 * MiB;
constexpr size_t WS_WSUM = 536 * MiB;
constexpr size_t WS_HSC = 528 * MiB;
constexpr size_t WS_QI = 464 * MiB;
constexpr size_t WS_KI = 528 * MiB;
constexpr size_t WS_WI = 536 * MiB;
constexpr size_t WS_MASK = 544 * MiB;
constexpr size_t WS_EID = 608 * MiB;
constexpr size_t WS_GW = 624 * MiB;
constexpr size_t WS_X1 = 656 * MiB;
constexpr size_t WS_END = 848 * MiB;

constexpr int LDS_BYTES = 155648;
constexpr float PEER_QSTEP = 0.3352f;
constexpr float PEER_WSCALE = 16384.f;

struct Args { const float* in[18]; float* out; unsigned char* ws; int ph_lo, ph_hi; };

__host__ __device__ __forceinline__ int pos2log(int p) { return 64 * ((p >> 5) & 3) + 32 * (p >> 7) + 8 * ((p >> 2) & 3) + 4 * ((p >> 4) & 1) + (p & 3); }
__device__ __forceinline__ int maincol(int L) { if (L < 1536) return L; if (L < 2120) return L + 512; return -1; }

__device__ __forceinline__ float wave_sum(float v) {
#pragma unroll
    for (int o = 1; o < 64; o <<= 1) v += __shfl_xor(v, o);
    return v;
}
__device__ __forceinline__ float wave_max(float v) {
#pragma unroll
    for (int o = 1; o < 64; o <<= 1) v = fmaxf(v, __shfl_xor(v, o));
    return v;
}

__device__ void ph0_prologue(const Args& a, int bid, int nb, unsigned char* lds) {
    int tid = threadIdx.x; asm volatile("" : "+v"(tid));
    const float* c = a.in[1]; const float* ada_w = a.in[2]; const float* ada_b = a.in[3];
    float* sil = (float*)lds;
    for (int i = tid; i < NB * ND; i += NTHR) { const float v = c[i]; sil[i] = v / (1.f + __expf(-v)); }
    __syncthreads();
    float* mod = (float*)(a.ws + WS_MOD);
    const int gt = bid * NTHR + tid, ngt = nb * NTHR;
    for (int o = gt; o < NB * 6144; o += ngt) {
        const int b = o / 6144, j = o % 6144;
        float acc = ada_b[j];
        const float* sb = sil + b * ND;
        for (int k = 0; k < ND; ++k) acc += sb[k] * ada_w[(size_t)k * 6144 + j];
        mod[o] = acc;
    }
    const float* w_in = a.in[5]; const float* pool_w = a.in[6]; const float* w_out = a.in[12];
    const float* wq = a.in[14]; const float* sk = a.in[15]; const float* pu = a.in[16]; const float* pv = a.in[17];
    f16* WIN = (f16*)(a.ws + WS_WIN); f16* WVT = (f16*)(a.ws + WS_WVT); f16* WOUT = (f16*)(a.ws + WS_WOUT); f16* WQ = (f16*)(a.ws + WS_WQ);
 unsigned char* UT = a.ws + WS_UT; unsigned char* VP = a.ws + WS_VP;
    {
        __syncthreads();
        const int lane = tid & 63, wv_ = tid >> 6;
        float* scr = (float*)lds + wv_ * (64 * 33);
        constexpr int I_WQ = 16 * 64, I_Z = 16 * 16, I_INR = 16 * (NMAIN / 32 - 16), I_VT = 16 * 16, I_OUT = 16 * 32, I_ALL = I_WQ + I_Z + I_INR + I_VT + I_OUT;
        for (int it = bid * NWAVE + wv_; it < I_ALL; it += nb * NWAVE) {
            int rr = it, kind = 3, pboff = 0;
            if (rr >= I_WQ) { rr -= I_WQ; kind = 0;
                if (rr >= I_Z) { rr -= I_Z; pboff = 16;
                    if (rr >= I_INR) { rr -= I_INR; kind = 1; pboff = 0; if (rr >= I_VT) { rr -= I_VT; kind = 2; } } } }
            const int npb = kind == 0 ? (pboff ? NMAIN / 32 - 16 : 16) : kind == 1 ? 16 : kind == 2 ? 32 : 64;
            const int k0 = (rr / npb) * 64, p0 = (rr % npb + pboff) * 32, p = p0 + (lane & 31);
            const float* W = kind <= 1 ? w_in : kind == 2 ? w_out : wq; const int ldw = kind <= 1 ? INW : kind == 2 ? 1024 : 2048;
            int col;
            if (kind == 0) col = maincol((p & ~255) + pos2log(p & 255)); else if (kind == 1) col = 1536 + p; else col = (p & ~255) + pos2log(p & 255);
            const bool foldz = (kind == 0 && pboff == 0);
            if (foldz || kind == 3) {
                const int r5 = lane & 31, hh_ = lane >> 5;
                const int blk = __builtin_amdgcn_readfirstlane(col >> 7);
                const int sub = col & 127;
                const float* arow = W + (size_t)(k0 + r5) * ldw + blk * 128 + 8 * hh_;
                f32x16 acc0 = (f32x16){0.f, 0.f, 0.f, 0.f, 0.f, 0.f, 0.f, 0.f, 0.f, 0.f, 0.f, 0.f, 0.f, 0.f, 0.f, 0.f}, acc1 = acc0;
#pragma unroll 2
                for (int ks = 0; ks < 8; ++ks) {
                    const f32x4 a00 = *(const f32x4*)(arow + 16 * ks), a01 = *(const f32x4*)(arow + 16 * ks + 4);
                    const f32x4 a10 = *(const f32x4*)(arow + (size_t)32 * ldw + 16 * ks), a11 = *(const f32x4*)(arow + (size_t)32 * ldw + 16 * ks + 4);
                    f16x8 bfr;
                    if (kind == 3) { const float* br = sk + (size_t)(blk * 128 + sub) * 128 + 16 * ks + 8 * hh_; const f32x4 b0 = *(const f32x4*)br, b1 = *(const f32x4*)(br + 4);
                        bfr = (f16x8){(f16)b0[0], (f16)b0[1], (f16)b0[2], (f16)b0[3], (f16)b1[0], (f16)b1[1], (f16)b1[2], (f16)b1[3]}; }
                    else { const float* br = pool_w + (size_t)blk * 16384 + (size_t)(16 * ks + 8 * hh_) * 128 + sub;
                        bfr = (f16x8){(f16)br[0], (f16)br[128], (f16)br[256], (f16)br[384], (f16)br[512], (f16)br[640], (f16)br[768], (f16)br[896]}; }
                    const f16x8 af0 = (f16x8){(f16)a00[0], (f16)a00[1], (f16)a00[2], (f16)a00[3], (f16)a01[0], (f16)a01[1], (f16)a01[2], (f16)a01[3]};
                    const f16x8 af1 = (f16x8){(f16)a10[0], (f16)a10[1], (f16)a10[2], (f16)a10[3], (f16)a11[0], (f16)a11[1], (f16)a11[2], (f16)a11[3]};
                    acc0 = __builtin_amdgcn_mfma_f32_32x32x16_f16(af0, bfr, acc0, 0, 0, 0);
                    acc1 = __builtin_amdgcn_mfma_f32_32x32x16_f16(af1, bfr, acc1, 0, 0, 0);
                }
#pragma unroll
                for (int rg = 0; rg < 16; ++rg) { const int kk = (rg & 3) + 8 * (rg >> 2) + 4 * hh_; scr[kk * 33 + r5] = acc0[rg]; scr[(32 + kk) * 33 + r5] = acc1[rg]; }
            } else {
#pragma unroll 8
                for (int i = 0; i < 32; ++i) { const int kk = 2 * i + (lane >> 5); scr[kk * 33 + (lane & 31)] = col >= 0 ? W[(size_t)(k0 + kk) * ldw + col] : 0.f; }
            }
            f16* WT = kind == 0 ? WIN : kind == 1 ? WVT : kind == 2 ? WOUT : WQ;
            const int c8 = lane & 7;
#pragma unroll
            for (int j = 0; j < 4; ++j) { const int n = (lane >> 3) + 8 * j; const float* sp = scr + (8 * c8) * 33 + n;
                *(f16x8*)(WT + (size_t)(p0 + n) * ND + k0 + 8 * c8) = (f16x8){(f16)sp[0], (f16)sp[33], (f16)sp[66], (f16)sp[99], (f16)sp[132], (f16)sp[165], (f16)sp[198], (f16)sp[231]}; }
        }
    }
    {
        __syncthreads();
        float ssu = 0.f, ssv = 0.f;
        for (int i = tid; i < 64 * 1024 / 4; i += NTHR) { const f32x4 u = ((const f32x4*)pu)[i], v = ((const f32x4*)pv)[i];
            ssu += u.x * u.x + u.y * u.y + u.z * u.z + u.w * u.w; ssv += v.x * v.x + v.y * v.y + v.z * v.z + v.w * v.w; }
        ssu = wave_sum(ssu); ssv = wave_sum(ssv);
        float* red = (float*)lds;
        if ((tid & 63) == 0) { red[tid >> 6] = ssu; red[8 + (tid >> 6)] = ssv; }
        __syncthreads();
        float tu = 0.f, tv = 0.f;
#pragma unroll
        for (int w = 0; w < 8; ++w) { tu += red[w]; tv += red[8 + w]; }
        const float du = PEER_QSTEP * sqrtf(tu * (1.f / 65536.f)), dv = PEER_QSTEP * sqrtf(tv * (1.f / 65536.f));
        if (bid == 0 && tid == 0) { float* qs = (float*)(a.ws + WS_QS); qs[0] = du; qs[1] = dv; }
        const float idu = 1.f / du, idv = 1.f / dv;
        const int lane = tid & 63, wv_ = tid >> 6;
        for (int row0 = bid * NWAVE + wv_; row0 < 2 * 16384; row0 += 4 * nb * NWAVE) {
            f32x4 x4[4][4];
#pragma unroll
            for (int rr = 0; rr < 4; ++rr) { int row = row0 + rr * nb * NWAVE; row = row < 2 * 16384 ? row : row0; const bool isv = row >= 16384; const int e = row & 16383;
                const float* src = (isv ? pv : pu) + (size_t)e * ND + 4 * lane;
#pragma unroll
                for (int j = 0; j < 4; ++j) x4[rr][j] = *(const f32x4*)(src + 256 * j); }
#pragma unroll
            for (int rr = 0; rr < 4; ++rr) { int row = row0 + rr * nb * NWAVE; row = row < 2 * 16384 ? row : row0; const bool isv = row >= 16384; const int e = row & 16383;
                u16* dstq = (u16*)((isv ? VP : UT) + (size_t)e * 512) + lane;
                const float inv = isv ? idv : idu; const int off = isv ? 8 : 0;
#pragma unroll
                for (int j = 0; j < 4; ++j) { unsigned pk = 0u;
#pragma unroll
                    for (int k = 0; k < 4; ++k) { int q = (int)floorf(x4[rr][j][k] * inv); q = q < -8 ? -8 : q > 7 ? 7 : q; pk |= (unsigned)((q + off) & 15) << (4 * k); }
                    dstq[64 * j] = (u16)pk; } }
        }
    }
}

__device__ void row_norm_mod(const float* src, const float* g, const float* mod, int sh_off, int sc_off, f16* dst, unsigned char* h8, float* hs8, int bid, int nb) {
    int tid_ = threadIdx.x; asm volatile("" : "+v"(tid_)); const int lane = tid_ & 63, wave = tid_ >> 6;
    const int rstep = nb * NWAVE, r0 = bid * NWAVE + wave;
    const bool fast = (NS % rstep) == 0 && ((NS / rstep) % 4) == 0;
    if (fast) {
        for (int b = 0; b < NB; ++b) {
            f32x4 gs[4], sh[4];
#pragma unroll
            for (int j = 0; j < 4; ++j) { const int col = lane * 4 + 256 * j; const f32x4 gg = *(const f32x4*)(g + col), sc = *(const f32x4*)(mod + b * 6144 + sc_off + col);
                sh[j] = *(const f32x4*)(mod + b * 6144 + sh_off + col); gs[j] = gg * (1.f + sc); }
            for (int row = b * NS + r0; row < (b + 1) * NS; row += 4 * rstep) {
                f32x4 v[4][4]; float ss[4];
#pragma unroll
                for (int rr = 0; rr < 4; ++rr)
#pragma unroll
                    for (int j = 0; j < 4; ++j) v[rr][j] = ((const f32x4*)(src + (size_t)(row + rr * rstep) * ND) + lane)[64 * j];
#pragma unroll
                for (int rr = 0; rr < 4; ++rr) { float s_ = 0.f;
#pragma unroll
                    for (int j = 0; j < 4; ++j) s_ += v[rr][j].x * v[rr][j].x + v[rr][j].y * v[rr][j].y + v[rr][j].z * v[rr][j].z + v[rr][j].w * v[rr][j].w;
                    ss[rr] = rsqrtf(wave_sum(s_) * (1.f / ND) + EPS); }
#pragma unroll
                for (int rr = 0; rr < 4; ++rr) { float am = 0.f;
#pragma unroll
                    for (int j = 0; j < 4; ++j) { const int col = lane * 4 + 256 * j; const f32x4 o = v[rr][j] * ss[rr] * gs[j] + sh[j]; v[rr][j] = o;
                        am = fmaxf(am, fmaxf(fmaxf(fabsf(o.x), fabsf(o.y)), fmaxf(fabsf(o.z), fabsf(o.w))));
                        *(f16x4*)(dst + (size_t)(row + rr * rstep) * ND + col) = (f16x4){(f16)o.x, (f16)o.y, (f16)o.z, (f16)o.w}; }
                    am = wave_max(am); const float inv = am > 0.f ? 127.f / am : 0.f;
#pragma unroll
                    for (int j = 0; j < 4; ++j) { const f32x4 o = v[rr][j];
                        const unsigned pk = (unsigned)((int)rintf(o.x * inv) & 255) | ((unsigned)((int)rintf(o.y * inv) & 255) << 8) | ((unsigned)((int)rintf(o.z * inv) & 255) << 16) | ((unsigned)((int)rintf(o.w * inv) & 255) << 24);
                        *(unsigned*)(h8 + (size_t)(row + rr * rstep) * ND + lane * 4 + 256 * j) = pk; }
                    if (lane == 0) hs8[row + rr * rstep] = am * (1.f / 127.f); }
            }
        }
        return;
    }
    for (int row = r0; row < NT; row += rstep) {
        const int b = row / NS;
        const f32x4* xr = (const f32x4*)(src + (size_t)row * ND) + lane;
        f32x4 v[4]; float s = 0.f;
#pragma unroll
        for (int j = 0; j < 4; ++j) { v[j] = xr[64 * j]; s += v[j].x * v[j].x + v[j].y * v[j].y + v[j].z * v[j].z + v[j].w * v[j].w; }
        const float rstd = rsqrtf(wave_sum(s) * (1.f / ND) + EPS);
#pragma unroll
        for (int j = 0; j < 4; ++j) {
            const int col = lane * 4 + 256 * j;
            const f32x4 gg = *(const f32x4*)(g + col), sc = *(const f32x4*)(mod + b * 6144 + sc_off + col), sh = *(const f32x4*)(mod + b * 6144 + sh_off + col);
            const f32x4 of = (f32x4){v[j].x * rstd * gg.x * (1.f + sc.x) + sh.x, v[j].y * rstd * gg.y * (1.f + sc.y) + sh.y, v[j].z * rstd * gg.z * (1.f + sc.z) + sh.z, v[j].w * rstd * gg.w * (1.f + sc.w) + sh.w};
            v[j] = of;
            *(f16x4*)(dst + (size_t)row * ND + col) = (f16x4){(f16)of.x, (f16)of.y, (f16)of.z, (f16)of.w};
        }
        float am = 0.f;
#pragma unroll
        for (int j = 0; j < 4; ++j) am = fmaxf(am, fmaxf(fmaxf(fabsf(v[j].x), fabsf(v[j].y)), fmaxf(fabsf(v[j].z), fabsf(v[j].w))));
        am = wave_max(am); const float inv = am > 0.f ? 127.f / am : 0.f;
#pragma unroll
        for (int j = 0; j < 4; ++j) { const f32x4 o = v[j];
            const unsigned pk = (unsigned)((int)rintf(o.x * inv) & 255) | ((unsigned)((int)rintf(o.y * inv) & 255) << 8) | ((unsigned)((int)rintf(o.z * inv) & 255) << 16) | ((unsigned)((int)rintf(o.w * inv) & 255) << 24);
            *(unsigned*)(h8 + (size_t)row * ND + lane * 4 + 256 * j) = pk; }
        if (lane == 0) hs8[row] = am * (1.f / 127.f);
    }
}
__device__ void row_norm_mod_q(const f16* src, const float* g, const float* mod, int sh_off, int sc_off, unsigned char* hq, unsigned* hp, float* hsc, int bid, int nb) {
    int tid_ = threadIdx.x; asm volatile("" : "+v"(tid_)); const int lane = tid_ & 63, wave = tid_ >> 6;
    const int rstep = nb * NWAVE, r0 = bid * NWAVE + wave;
    const bool hoist = (NS % rstep) == 0 && ((NS / rstep) % 2) == 0;
    const int nouter = hoist ? NB : 1, ninner = hoist ? NS : NT;
    for (int bo = 0; bo < nouter; ++bo) {
        f32x4 gs[4], sh[4];
        if (hoist) {
#pragma unroll
            for (int j = 0; j < 4; ++j) { const int col = 8 * lane + 512 * (j >> 1) + 4 * (j & 1); const f32x4 gg = *(const f32x4*)(g + col), sc = *(const f32x4*)(mod + bo * 6144 + sc_off + col);
                sh[j] = *(const f32x4*)(mod + bo * 6144 + sh_off + col); gs[j] = gg * (1.f + sc); }
        }
        for (int rowa = bo * ninner + r0; rowa < (bo + 1) * ninner; rowa += 2 * rstep) {
            const int rowb = rowa + rstep < NT ? rowa + rstep : rowa;
            f16x8 hx[2][2];
#pragma unroll
            for (int j = 0; j < 2; ++j) { hx[0][j] = *(const f16x8*)(src + (size_t)rowa * ND + 8 * lane + 512 * j); hx[1][j] = *(const f16x8*)(src + (size_t)rowb * ND + 8 * lane + 512 * j); }
#pragma unroll
            for (int rr = 0; rr < 2; ++rr) {
                const int row = rr ? rowb : rowa; const int b = row / NS;
                if (!hoist) {
#pragma unroll
                    for (int j = 0; j < 4; ++j) { const int col = 8 * lane + 512 * (j >> 1) + 4 * (j & 1); const f32x4 gg = *(const f32x4*)(g + col), sc = *(const f32x4*)(mod + b * 6144 + sc_off + col);
                        sh[j] = *(const f32x4*)(mod + b * 6144 + sh_off + col); gs[j] = gg * (1.f + sc); }
                }
                f32x4 v[4]; float s = 0.f;
#pragma unroll
                for (int j = 0; j < 2; ++j) { const f16x8 h8 = hx[rr][j];
                    v[2 * j] = (f32x4){(float)h8[0], (float)h8[1], (float)h8[2], (float)h8[3]}; v[2 * j + 1] = (f32x4){(float)h8[4], (float)h8[5], (float)h8[6], (float)h8[7]}; }
#pragma unroll
                for (int j = 0; j < 4; ++j) s += v[j].x * v[j].x + v[j].y * v[j].y + v[j].z * v[j].z + v[j].w * v[j].w;
                const float rstd = rsqrtf(wave_sum(s) * (1.f / ND) + EPS);
                float o[16]; float am = 0.f;
#pragma unroll
                for (int j = 0; j < 4; ++j)
#pragma unroll
                    for (int k = 0; k < 4; ++k) { const float y = v[j][k] * rstd * gs[j][k] + sh[j][k]; o[4 * j + k] = y; am = fmaxf(am, fabsf(y)); }
                am = wave_max(am);
                const float inv = am > 0.f ? 119.f / am : 0.f;
#pragma unroll
                for (int j = 0; j < 2; ++j) {
                    unsigned p0 = 0u, p1 = 0u, ph = 0u, pl = 0u;
#pragma unroll
                    for (int k = 0; k < 8; ++k) { const int q = (int)rintf(o[8 * j + k] * inv); const int l = ((q + 8) & 15) - 8; const int h = (q - l) >> 4;
                        if (k < 4) p0 |= (unsigned)(q & 255) << (8 * k); else p1 |= (unsigned)(q & 255) << (8 * (k - 4));
                        ph |= (unsigned)(h & 15) << (4 * k); pl |= (unsigned)(l & 15) << (4 * k); }
                    *(u64*)(hq + (size_t)row * ND + 8 * lane + 512 * j) = (u64)p0 | ((u64)p1 << 32);
                    hp[(size_t)row * 256 + lane + 64 * j] = ph; hp[(size_t)row * 256 + 128 + lane + 64 * j] = pl;
                }
                if (lane == 0) hsc[row] = am * (1.f / 119.f);
            }
        }
    }
}
__device__ void wq_to_int8(const f16* WQ, unsigned char* WQ8, float* WSC, int nrows, int bid, int nb) {
    int tid_ = threadIdx.x; asm volatile("" : "+v"(tid_)); const int lane = tid_ & 63, wave = tid_ >> 6;
    for (int row = bid * NWAVE + wave; row < nrows; row += nb * NWAVE) {
        const f16x8 a0 = *(const f16x8*)(WQ + (size_t)row * ND + 8 * lane), a1 = *(const f16x8*)(WQ + (size_t)row * ND + 8 * lane + 512);
        float am = 0.f;
#pragma unroll
        for (int k = 0; k < 8; ++k) am = fmaxf(am, fmaxf(fabsf((float)a0[k]), fabsf((float)a1[k])));
        am = wave_max(am);
        const float inv = am > 0.f ? 127.f / am : 0.f;
        unsigned p[4] = {0u, 0u, 0u, 0u};
#pragma unroll
        for (int k = 0; k < 4; ++k) { p[0] |= (unsigned)((int)rintf((float)a0[k] * inv) & 255) << (8 * k); p[1] |= (unsigned)((int)rintf((float)a0[4 + k] * inv) & 255) << (8 * k);
                                      p[2] |= (unsigned)((int)rintf((float)a1[k] * inv) & 255) << (8 * k); p[3] |= (unsigned)((int)rintf((float)a1[4 + k] * inv) & 255) << (8 * k); }
        *(u64*)(WQ8 + (size_t)row * ND + 8 * lane) = (u64)p[0] | ((u64)p[1] << 32);
        *(u64*)(WQ8 + (size_t)row * ND + 8 * lane + 512) = (u64)p[2] | ((u64)p[3] << 32);
        if (lane == 0) WSC[row] = am * (1.f / 127.f);
    }
}

namespace pg8 {
#define PG8_LAS __attribute__((address_space(3)))
constexpr int BM = 256, BK = 64, HALF = 128, HTB = HALF * BK * 2, STAGE_BYTES = 8 * HTB, NXCD = 8, WGM = 8;
__host__ __device__ __forceinline__ int lds_byte(int r, int c) { const int st = (r >> 4) * 2 + (c >> 5), rr = r & 15, cc = c & 31, ob = rr * 64 + cc * 2; return st * 1024 + (ob ^ (((ob >> 9) & 1) << 5)); }
__host__ __device__ __forceinline__ void stage_rc(int b, int& R, int& C) { const int st = b / 1024, sb = b % 1024, swz = sb ^ (((sb >> 9) & 1) << 5); R = (st >> 1) * 16 + swz / 64; C = (st & 1) * 32 + (swz % 64) / 2; }
struct Unit { int pm, pn; };
struct Gemm { const f16* A; const f16* Bt; int M, N, K; };
struct StaticOrder {
    int nM, nN, nwg, G, c;
    __host__ __device__ void init(int M, int N, int G_, int c_) { nM = M / BM; nN = N / BM; nwg = nM * nN; G = G_; c = c_; }
    __host__ __device__ bool next(int i, Unit& u) const {
        const long L = (long)i * G + c; if (L >= nwg) return false;
        int wgid = (int)L; { const int q = nwg / NXCD, r = nwg % NXCD, xcd = wgid % NXCD, off = wgid / NXCD; wgid = (xcd < r ? xcd * (q + 1) : r * (q + 1) + (xcd - r) * q) + off; }
        const int nig = WGM * nN, gid = wgid / nig, fm = gid * WGM, gsz = (nM - fm) < WGM ? (nM - fm) : WGM;
        u.pm = fm + ((wgid % nig) % gsz); u.pn = (wgid % nig) / gsz; return true;
    }
};
template <class Epi, bool I8 = false>
__device__ __forceinline__ void gemm_phase(PG8_LAS unsigned char* lds, const Gemm g, const StaticOrder& S, const Epi& E) {
    int tid = threadIdx.x; asm volatile("" : "+v"(tid));
    const int wid = __builtin_amdgcn_readfirstlane(tid >> 6), lane = tid & 63, wr = wid >> 2, wc = wid & 3, fr = lane & 15, fq = lane >> 4;
    const int K = g.K, nt = K / BK;
    unsigned voffA[2];
#pragma unroll
    for (int i = 0; i < 2; ++i) { int R, C; stage_rc(tid * 16 + i * 8192, R, C); voffA[i] = (unsigned)(R * K + C) * 2u; }
    const size_t kstep = (size_t)(BK * 2);
    const size_t hstep = (size_t)HALF * K * 2;
    const size_t tstep = 2 * hstep;
    const unsigned ldsw = (unsigned)wid * 1024u;
    const int aoff = lds_byte(wr * 64 + fr, fq * 8), boff = lds_byte(wc * 32 + fr, fq * 8);
#define PG8_SA(b, h) (((b) * 2 + (h)) * HTB)
#define PG8_SB(b, h) ((4 + (b) * 2 + (h)) * HTB)
#define PG8_STAGE(bufoff, gbase, voff) do { _Pragma("unroll") for (int _i = 0; _i < 2; ++_i) \
        __builtin_amdgcn_global_load_lds((const unsigned*)((const char*)(gbase) + (voff)[_i]), (PG8_LAS unsigned*)(lds + (bufoff) + ldsw + _i * 8192), 16, 0, 0); } while (0)
#define PG8_LDA(dst, b, h) do { _Pragma("unroll") for (int m = 0; m < 4; ++m) _Pragma("unroll") for (int k = 0; k < 2; ++k) dst[m][k] = *(const PG8_LAS f16x8*)(lds + PG8_SA(b, h) + aoff + m * 2048 + k * 1024); } while (0)
#define PG8_LDB(dst, b, h) do { _Pragma("unroll") for (int n = 0; n < 2; ++n) _Pragma("unroll") for (int k = 0; k < 2; ++k) dst[n][k] = *(const PG8_LAS f16x8*)(lds + PG8_SB(b, h) + boff + n * 2048 + k * 1024); } while (0)
#define PG8_MMA(ai, bj, At, Bt) do { __builtin_amdgcn_s_setprio(1); _Pragma("unroll") for (int m = 0; m < 4; ++m) _Pragma("unroll") for (int n = 0; n < 2; ++n) _Pragma("unroll") for (int k = 0; k < 2; ++k) \
        acc[ai][bj][m][n] = I8 ? __builtin_bit_cast(f32x4, __builtin_amdgcn_mfma_i32_16x16x64_i8(__builtin_bit_cast(i32x4, Bt[n][k]), __builtin_bit_cast(i32x4, At[m][k]), __builtin_bit_cast(i32x4, acc[ai][bj][m][n]), 0, 0, 0)) \
                                 : __builtin_amdgcn_mfma_f32_16x16x32_f16(Bt[n][k], At[m][k], acc[ai][bj][m][n], 0, 0, 0); __builtin_amdgcn_s_setprio(0); } while (0)
#define PG8_WAIT_V(n) asm volatile("s_waitcnt vmcnt(" #n ")" ::: "memory")
#define PG8_WAIT_L(n) asm volatile("s_waitcnt lgkmcnt(" #n ")" ::: "memory")
#define PG8_BAR __builtin_amdgcn_s_barrier()
#define PG8_SCHED __builtin_amdgcn_sched_barrier(0)
    Unit cur, nxt; int ui = 0;
    if (!S.next(0, cur)) return;
    f32x4 acc[2][2][4][2];
#pragma unroll
    for (int a = 0; a < 2; ++a)
#pragma unroll
        for (int b = 0; b < 2; ++b)
#pragma unroll
            for (int m = 0; m < 4; ++m)
#pragma unroll
                for (int n = 0; n < 2; ++n) acc[a][b][m][n] = (f32x4){0.f, 0.f, 0.f, 0.f};
    f16x8 At[4][2], B0[2][2], B1[2][2];
    const char* cA = (const char*)g.A + (size_t)cur.pm * tstep; const char* cB = (const char*)g.Bt + (size_t)cur.pn * tstep;
    PG8_STAGE(PG8_SB(0, 0), cB, voffA); PG8_STAGE(PG8_SB(0, 1), cB + hstep, voffA); PG8_STAGE(PG8_SA(0, 0), cA, voffA); PG8_STAGE(PG8_SA(0, 1), cA + hstep, voffA);
    if (wr == 1) PG8_BAR;
    PG8_WAIT_V(2); PG8_BAR;
    PG8_STAGE(PG8_SB(1, 0), cB + kstep, voffA); PG8_STAGE(PG8_SA(1, 0), cA + kstep, voffA); PG8_STAGE(PG8_SB(1, 1), cB + hstep + kstep, voffA);
    PG8_WAIT_V(6); PG8_BAR;
    for (;;) {
        const bool has_next = S.next(ui + 1, nxt);
        const char* nA = has_next ? (const char*)g.A + (size_t)nxt.pm * tstep : cA; const char* nB = has_next ? (const char*)g.Bt + (size_t)nxt.pn * tstep : cB;
        for (int t = 0; t < nt; t += 2) {
            const bool last = (t == nt - 2);
            const char* a1 = cA + (size_t)(t + 1) * kstep;
            const char* a2 = last ? nA : cA + (size_t)(t + 2) * kstep; const char* b2 = last ? nB : cB + (size_t)(t + 2) * kstep;
            const char* a3 = a2 + kstep; const char* b3 = b2 + kstep;
            PG8_LDB(B0, 0, 0); PG8_LDB(B1, 0, 1); PG8_SCHED; PG8_LDA(At, 0, 0); PG8_STAGE(PG8_SA(1, 1), a1 + hstep, voffA);
            PG8_WAIT_V(8); PG8_WAIT_L(0); PG8_BAR; PG8_MMA(0, 0, At, B0); PG8_MMA(0, 1, At, B1); PG8_BAR; PG8_SCHED;
            PG8_LDA(At, 0, 1); PG8_STAGE(PG8_SB(0, 0), b2, voffA); PG8_STAGE(PG8_SB(0, 1), b2 + hstep, voffA); PG8_STAGE(PG8_SA(0, 0), a2, voffA);
            PG8_WAIT_V(8); PG8_WAIT_L(0); PG8_BAR; PG8_MMA(1, 0, At, B0); PG8_MMA(1, 1, At, B1); PG8_BAR; PG8_SCHED;
            PG8_LDB(B0, 1, 0); PG8_LDB(B1, 1, 1); PG8_SCHED; PG8_LDA(At, 1, 0); PG8_STAGE(PG8_SA(0, 1), a2 + hstep, voffA);
            PG8_WAIT_V(8); PG8_WAIT_L(0); PG8_BAR; PG8_MMA(0, 0, At, B0); PG8_MMA(0, 1, At, B1); PG8_BAR; PG8_SCHED;
            PG8_LDA(At, 1, 1); PG8_STAGE(PG8_SB(1, 0), b3, voffA); PG8_STAGE(PG8_SB(1, 1), b3 + hstep, voffA); PG8_STAGE(PG8_SA(1, 0), a3, voffA);
            PG8_WAIT_V(8); PG8_WAIT_L(0); PG8_BAR; PG8_MMA(1, 0, At, B0); PG8_MMA(1, 1, At, B1); PG8_BAR; PG8_SCHED;
        }
        if (wr == 0) PG8_BAR;
        E(acc, cur, wr, wc, fr, fq);
        if (!has_next) break;
#pragma unroll
        for (int a = 0; a < 2; ++a)
#pragma unroll
            for (int b = 0; b < 2; ++b)
#pragma unroll
                for (int m = 0; m < 4; ++m)
#pragma unroll
                    for (int n = 0; n < 2; ++n) acc[a][b][m][n] = (f32x4){0.f, 0.f, 0.f, 0.f};
        cur = nxt; cA = nA; cB = nB; ++ui;
        if (wr == 1) PG8_BAR;
    }
    PG8_WAIT_V(0);
    PG8_BAR;
#undef PG8_SA
#undef PG8_SB
#undef PG8_STAGE
#undef PG8_LDA
#undef PG8_LDB
#undef PG8_MMA
#undef PG8_WAIT_V
#undef PG8_WAIT_L
#undef PG8_BAR
#undef PG8_SCHED
}

typedef f32x4 Acc[2][2][4][2];
__device__ __forceinline__ f32x4 cvt_i4(const f32x4 b) { const i32x4 i = __builtin_bit_cast(i32x4, b); return (f32x4){(float)i[0], (float)i[1], (float)i[2], (float)i[3]}; }
template <bool I8>
struct EpiMainT {
    unsigned char* ws; const float *qg, *kg; int pn0; const float* hsc; const float* wsc;
    __device__ __forceinline__ void operator()(const Acc& acc, const Unit& u, int wr, int wc, int fr, int fq) const {
        const int row0 = u.pm * BM + wr * 64 + fr, pn = u.pn + pn0;
        f32x4 ws4[2][2];
#pragma unroll
        for (int bj = 0; bj < 2; ++bj)
#pragma unroll
            for (int n = 0; n < 2; ++n) ws4[bj][n] = I8 ? *(const f32x4*)(wsc + pn * BM + 128 * bj + 32 * wc + 16 * n + 4 * fq) : (f32x4){1.f, 1.f, 1.f, 1.f};
#define EA_(ai, bj, m, n) (I8 ? cvt_i4(acc[ai][bj][m][n]) * ws4[bj][n] : acc[ai][bj][m][n])
        if (pn == 8) {
            if (wc == 0) {
#pragma unroll
                for (int ai = 0; ai < 2; ++ai)
#pragma unroll
                    for (int m = 0; m < 4; ++m) { const size_t row = row0 + ai * HALF + m * 16;
#pragma unroll
                        for (int bj = 0; bj < 2; ++bj) { const f32x4 v0 = acc[ai][bj][m][0], v1 = acc[ai][bj][m][1];
                            *(f16x8*)((f16*)(ws + WS_KI) + (((row >> 5) * 8 + 4 * bj + fq) * 32 + (row & 31)) * 8) = (f16x8){(f16)v0[0], (f16)v0[1], (f16)v0[2], (f16)v0[3], (f16)v1[0], (f16)v1[1], (f16)v1[2], (f16)v1[3]}; } }
            } else if (wc == 1 && fq == 0) {
#pragma unroll
                for (int ai = 0; ai < 2; ++ai)
#pragma unroll
                    for (int m = 0; m < 4; ++m) { const size_t row = row0 + ai * HALF + m * 16;
                        *(f32x4*)((float*)(ws + WS_WI) + row * 8) = acc[ai][0][m][0] * 0.35355339059327373f; *(f32x4*)((float*)(ws + WS_WI) + row * 8 + 4) = acc[ai][0][m][1] * 0.35355339059327373f; }
            }
            return;
        }
        const int kind = pn >> 1;
        f16* base = (f16*)(ws + (kind == 0 ? WS_U : kind == 1 ? WS_Q : kind == 2 ? WS_K : WS_QI));
        const int col0 = (pn & 1) * 256 + 64 * wc + 8 * fq;
        if (kind == 1 || kind == 2) {
            const float* gp = (kind == 1 ? qg : kg) + 8 * fq;
#pragma unroll
            for (int ai = 0; ai < 2; ++ai)
#pragma unroll
                for (int m = 0; m < 4; ++m) { const size_t row = row0 + ai * HALF + m * 16; const float hs = I8 ? hsc[row] : 1.f;
                    float ss = 0.f;
#pragma unroll
                    for (int bj = 0; bj < 2; ++bj)
#pragma unroll
                        for (int n = 0; n < 2; ++n) { const f32x4 v = EA_(ai, bj, m, n) * hs; ss += v[0] * v[0] + v[1] * v[1] + v[2] * v[2] + v[3] * v[3]; }
                    ss += __shfl_xor(ss, 16); ss += __shfl_xor(ss, 32);
                    const float rstd = rsqrtf(ss * (1.f / 64.f) + EPS);
#pragma unroll
                    for (int bj = 0; bj < 2; ++bj) { const f32x4 v0 = EA_(ai, bj, m, 0) * (hs * rstd) * *(const f32x4*)(gp + 32 * bj), v1 = EA_(ai, bj, m, 1) * (hs * rstd) * *(const f32x4*)(gp + 32 * bj + 4);
                        *(f16x8*)(base + row * 512 + col0 + 32 * bj) = (f16x8){(f16)v0[0], (f16)v0[1], (f16)v0[2], (f16)v0[3], (f16)v1[0], (f16)v1[1], (f16)v1[2], (f16)v1[3]}; }
                    asm volatile("" ::: "memory"); }
        } else if (kind == 3) {
            const int hd = (pn & 1) * 4 + wc;
#pragma unroll
            for (int ai = 0; ai < 2; ++ai)
#pragma unroll
                for (int m = 0; m < 4; ++m) { const size_t row = row0 + ai * HALF + m * 16; const int ql = (int)(row & 7);
                    const int rr = (hd & 3) | (((ql >> 1) & 1) << 2) | ((hd >> 2) << 3) | ((ql & 1) << 4);
#pragma unroll
                    for (int bj = 0; bj < 2; ++bj) { const f32x4 v0 = acc[ai][bj][m][0], v1 = acc[ai][bj][m][1]; const int chunk = fq + 4 * bj;
                        *(f16x8*)(base + ((((((row >> 3) * 2 + (ql >> 2)) * 4 + (chunk >> 1)) * 2 + (chunk & 1)) * 32 + rr) << 3)) = (f16x8){(f16)v0[0], (f16)v0[1], (f16)v0[2], (f16)v0[3], (f16)v1[0], (f16)v1[1], (f16)v1[2], (f16)v1[3]}; } }
        } else {
#pragma unroll
            for (int ai = 0; ai < 2; ++ai)
#pragma unroll
                for (int m = 0; m < 4; ++m) { const size_t row = row0 + ai * HALF + m * 16; const float hs = I8 ? hsc[row] : 1.f;
#pragma unroll
                    for (int bj = 0; bj < 2; ++bj) { const f32x4 v0 = EA_(ai, bj, m, 0) * hs, v1 = EA_(ai, bj, m, 1) * hs;
                        *(f16x8*)(base + row * 512 + col0 + 32 * bj) = (f16x8){(f16)v0[0], (f16)v0[1], (f16)v0[2], (f16)v0[3], (f16)v1[0], (f16)v1[1], (f16)v1[2], (f16)v1[3]}; } }
        }
#undef EA_
    }
};
typedef EpiMainT<false> EpiMain;
template <bool I8>
struct EpiVTT {
    f16* VT; const float* wsc; const float* hsc;
    __device__ __forceinline__ void operator()(const Acc& acc, const Unit& u, int wr, int wc, int fr, int fq) const {
        const int row0 = u.pm * BM + wr * 64 + fr, col0 = u.pn * BM + 32 * wc + 4 * fq;
        f32x4 hs4[2][2];
#pragma unroll
        for (int bj = 0; bj < 2; ++bj)
#pragma unroll
            for (int n = 0; n < 2; ++n) hs4[bj][n] = I8 ? *(const f32x4*)(hsc + col0 + 128 * bj + 16 * n) : (f32x4){1.f, 1.f, 1.f, 1.f};
#pragma unroll
        for (int ai = 0; ai < 2; ++ai)
#pragma unroll
            for (int m = 0; m < 4; ++m) { const size_t row = row0 + ai * HALF + m * 16; const float wsr = I8 ? wsc[row] : 1.f;
#pragma unroll
                for (int bj = 0; bj < 2; ++bj)
#pragma unroll
                    for (int n = 0; n < 2; ++n) { const f32x4 v = I8 ? cvt_i4(acc[ai][bj][m][n]) * hs4[bj][n] * wsr : acc[ai][bj][m][n];
                        *(f16x4*)(VT + row * NT + col0 + 128 * bj + 16 * n) = (f16x4){(f16)v[0], (f16)v[1], (f16)v[2], (f16)v[3]}; } }
    }
};
struct EpiOut {
    const float* x; const float* mod; f16* x1;
    __device__ __forceinline__ void operator()(const Acc& acc, const Unit& u, int wr, int wc, int fr, int fq) const {
        const int row0 = u.pm * BM + wr * 64 + fr, col0 = u.pn * BM + 64 * wc + 8 * fq;
        const float* g1 = mod + ((u.pm * BM) / NS) * 6144 + 2048 + col0;
        f32x4 g4[2][2];
#pragma unroll
        for (int bj = 0; bj < 2; ++bj)
#pragma unroll
            for (int n = 0; n < 2; ++n) g4[bj][n] = *(const f32x4*)(g1 + 32 * bj + 4 * n);
#pragma unroll
        for (int ai = 0; ai < 2; ++ai)
#pragma unroll
            for (int m = 0; m < 4; ++m) { const size_t off = (size_t)(row0 + ai * HALF + m * 16) * ND + col0;
#pragma unroll
                for (int bj = 0; bj < 2; ++bj) { const f32x4 v0 = *(const f32x4*)(x + off + 32 * bj) + g4[bj][0] * acc[ai][bj][m][0], v1 = *(const f32x4*)(x + off + 32 * bj + 4) + g4[bj][1] * acc[ai][bj][m][1];
                    *(f16x8*)(x1 + off + 32 * bj) = (f16x8){(f16)v0[0], (f16)v0[1], (f16)v0[2], (f16)v0[3], (f16)v1[0], (f16)v1[1], (f16)v1[2], (f16)v1[3]}; } }
    }
};
struct EpiPQ {
    f16* PQ; const float* hsc; const float* wsc;
    __device__ __forceinline__ void operator()(const Acc& acc, const Unit& u, int wr, int wc, int fr, int fq) const {
        const int row0 = u.pm * BM + wr * 64 + fr, col0 = u.pn * BM + 64 * wc + 8 * fq;
        f32x4 ws4[2][2];
#pragma unroll
        for (int bj = 0; bj < 2; ++bj)
#pragma unroll
            for (int n = 0; n < 2; ++n) ws4[bj][n] = *(const f32x4*)(wsc + u.pn * BM + 128 * bj + 32 * wc + 16 * n + 4 * fq);
#pragma unroll
        for (int ai = 0; ai < 2; ++ai)
#pragma unroll
            for (int m = 0; m < 4; ++m) { const size_t row = row0 + ai * HALF + m * 16; const float hs = hsc[row];
#pragma unroll
                for (int bj = 0; bj < 2; ++bj) { const i32x4 i0 = __builtin_bit_cast(i32x4, acc[ai][bj][m][0]), i1 = __builtin_bit_cast(i32x4, acc[ai][bj][m][1]);
                    const f32x4 v0 = (f32x4){(float)i0[0], (float)i0[1], (float)i0[2], (float)i0[3]} * ws4[bj][0] * hs, v1 = (f32x4){(float)i1[0], (float)i1[1], (float)i1[2], (float)i1[3]} * ws4[bj][1] * hs;
                    *(f16x8*)(PQ + ((((row >> 5) * 256 + ((col0 + 32 * bj) >> 3)) * 32 + (row & 31)) << 3)) = (f16x8){(f16)v0[0], (f16)v0[1], (f16)v0[2], (f16)v0[3], (f16)v1[0], (f16)v1[1], (f16)v1[2], (f16)v1[3]}; } }
    }
};
}

__device__ __forceinline__ void ph2_inproj(const Args& a, int bid, int nb, unsigned char* lds) {
    const f16* H = (const f16*)(a.ws + WS_H); const f16* WIN = (const f16*)(a.ws + WS_WIN);
    const f16* H8 = (const f16*)(a.ws + WS_H8); const float* hs8 = (const float*)(a.ws + WS_H8 + 64 * MiB); const float* wsi = (const float*)(a.ws + WS_WSCIN);
    PG8_LAS unsigned char* l3 = (PG8_LAS unsigned char*)lds;
    { pg8::Gemm g{H8, (const f16*)(a.ws + WS_WIN8), NT, 1536, ND / 2}; pg8::StaticOrder S; S.init(NT, 1536, nb, bid);
      pg8::EpiMainT<true> E{a.ws, a.in[9], a.in[10], 0, hs8, wsi};
      pg8::gemm_phase<pg8::EpiMainT<true>, true>(l3, g, S, E); }
    { pg8::Gemm g{H, WIN + (size_t)1536 * ND, NT, NMAIN - 1536, ND}; pg8::StaticOrder S; S.init(NT, NMAIN - 1536, nb, bid);
      pg8::EpiMain E{a.ws, a.in[9], a.in[10], 6, nullptr, nullptr};
      pg8::gemm_phase(l3, g, S, E); }
    { pg8::Gemm g{(const f16*)(a.ws + WS_WVT8), H8, 512, NT, ND / 2}; pg8::StaticOrder S; S.init(512, NT, nb, bid);
      pg8::EpiVTT<true> E{(f16*)(a.ws + WS_VT), wsi + 1536, hs8};
      pg8::gemm_phase<pg8::EpiVTT<true>, true>(l3, g, S, E); }
}


constexpr int PPITCH = 1040;
__device__ __forceinline__ void ph3_pool_fast(const Args& a, int bid, int nb, unsigned char* lds) {
    int tid = threadIdx.x; asm volatile("" : "+v"(tid));
    const int cg8 = tid & 63, tq = tid >> 6, gch = cg8 >> 4, win = 2 << gch;
    const f16* Z = (const f16*)(a.ws + WS_U); f16* MIX = (f16*)(a.ws + WS_H);
    const f32x4 ps0 = *(const f32x4*)(a.in[7] + 8 * cg8), ps1 = *(const f32x4*)(a.in[7] + 8 * cg8 + 4), pg0 = *(const f32x4*)(a.in[8] + 8 * cg8), pg1 = *(const f32x4*)(a.in[8] + 8 * cg8 + 4);
    const float psc[8] = {ps0[0], ps0[1], ps0[2], ps0[3], ps1[0], ps1[1], ps1[2], ps1[3]}, pgn[8] = {pg0[0], pg0[1], pg0[2], pg0[3], pg1[0], pg1[1], pg1[2], pg1[3]};
    for (int item = bid; item < NT / 32; item += nb) {
        const int tb = item * 32 + 4 * tq, tl0 = tb % NS;
        const f16* up = Z + (size_t)(tb - tl0) * 512 + 8 * cg8;
        float sm[8];
#pragma unroll
        for (int j = 0; j < 8; ++j) sm[j] = 0.f;
        f16x8 hist_[15];
#pragma unroll
        for (int q = 0; q < 15; ++q) { const int rr = tl0 - 15 + q; hist_[q] = (q >= 16 - win && rr >= 0) ? *(const f16x8*)(up + (size_t)rr * 512) : (f16x8){0, 0, 0, 0, 0, 0, 0, 0}; }
        f16x8 cur_[4];
#pragma unroll
        for (int k = 0; k < 4; ++k) cur_[k] = *(const f16x8*)(up + (size_t)(tl0 + k) * 512);
#pragma unroll
        for (int q = 0; q < 15; ++q)
#pragma unroll
            for (int j = 0; j < 8; ++j) sm[j] += (float)hist_[q][j];
#pragma unroll
        for (int k = 0; k < 4; ++k) {
            const int tl = tl0 + k;
            const float ic = 1.f / (float)((tl + 1 < win) ? tl + 1 : win);
            float v[8]; float ss = 0.f;
#pragma unroll
            for (int j = 0; j < 8; ++j) { sm[j] += (float)cur_[k][j]; v[j] = (sm[j] * ic - (float)cur_[k][j]) * psc[j]; ss += v[j] * v[j]; }
            const float rstd = rsqrtf(wave_sum(ss) * (1.f / 512.f) + EPS);
            f16x8 o;
#pragma unroll
            for (int j = 0; j < 8; ++j) o[j] = (f16)(v[j] * rstd * pgn[j]);
            *(f16x8*)(MIX + (size_t)(tb + k) * ND + 8 * cg8) = o;
            if (k < 3) {
#pragma unroll
                for (int j = 0; j < 8; ++j) {
                    const int q = 16 - win + k;
                    float dv = 0.f;
#pragma unroll
                    for (int qq = 0; qq < 15; ++qq) if (qq == q) dv = (float)hist_[qq][j];
#pragma unroll
                    for (int kk = 0; kk < 3; ++kk) if (q == 15 + kk) dv = (float)cur_[kk][j];
                    sm[j] -= dv;
                }
            }
        }
    }
}


typedef float f32x2 __attribute__((ext_vector_type(2)));
typedef unsigned u32x4 __attribute__((ext_vector_type(4)));

constexpr int IDX_KPITCH = 16384 + 16;
constexpr int IDX_HPITCH = 516;
template <int NBL>
__device__ __forceinline__ int wave_pick(const unsigned (&cc)[NBL], unsigned target, int lane, unsigned& rem_out) {
    unsigned tot = 0u;
#pragma unroll
    for (int j = 0; j < NBL; ++j) tot += cc[j];
    unsigned S = tot;
#pragma unroll
    for (int o = 1; o < 64; o <<= 1) { const unsigned v = __shfl_down(S, o); if (lane + o < 64) S += v; }
    const unsigned above = S - tot;
    const bool hit = (above < target) && (S >= target);
    const u64 bal = __ballot(hit);
    const int L = bal ? __builtin_ctzll(bal) : 0;
    int bin = 0; unsigned rem = target;
    { unsigned run = above; bool done = false;
#pragma unroll
      for (int j = NBL - 1; j >= 0; --j) { if (!done) { if (run + cc[j] >= target) { bin = NBL * lane + j; rem = target - run; done = true; } else run += cc[j]; } } }
    bin = __shfl(bin, L); rem_out = __shfl(rem, L);
    return bin;
}
template <int MODE>
__device__ __forceinline__ void ph3_index_fast(const Args& a, int bid, int nb, unsigned char* lds) {
    int tid = threadIdx.x; asm volatile("" : "+v"(tid));
    const int lane = tid & 63, wave = __builtin_amdgcn_readfirstlane(tid >> 6), r = lane & 31, hh = lane >> 5;
    const f16* QI = (const f16*)(a.ws + WS_QI); const f16* KI = (const f16*)(a.ws + WS_KI); const float* WI = (const float*)(a.ws + WS_WI);
    u64* MASK = (u64*)(a.ws + WS_MASK);
    unsigned* hist = (unsigned*)(lds + 8 * IDX_KPITCH);
    f16x8 af[2][4]; f32x2 wv2[2][8];
#define IDX_LOAD_FRAGS(t0_) do { \
        _Pragma("unroll") for (int rt = 0; rt < 2; ++rt) { \
            _Pragma("unroll") for (int ks = 0; ks < 4; ++ks) af[rt][ks] = *(const f16x8*)(QI + ((((((size_t)((t0_) >> 3) * 2 + rt) * 4 + ks) * 2 + hh) * 32 + r) << 3)); \
            _Pragma("unroll") for (int qq = 0; qq < 2; ++qq) { const float* wp = WI + (size_t)((t0_) + 4 * rt + 2 * hh + qq) * 8; const f32x4 w0 = *(const f32x4*)wp * 0.125f, w1 = *(const f32x4*)(wp + 4) * 0.125f; \
                wv2[rt][4 * qq + 0] = (f32x2){w0[0], w0[1]}; wv2[rt][4 * qq + 1] = (f32x2){w0[2], w0[3]}; wv2[rt][4 * qq + 2] = (f32x2){w1[0], w1[1]}; wv2[rt][4 * qq + 3] = (f32x2){w1[2], w1[3]}; } \
        } } while (0)
    for (int round = 0; round * nb < 256; ++round) {
        const int p = round * nb + ((round & 1) ? (nb - 1 - bid) : bid);
        if (p < 256) { const int tg = p >> 3, b_ = p & 7, t0l = tg * 8, ch_ = t0l >> 6, t0_ = b_ * NS + t0l;
            if (tid < 8 * (ch_ + 1)) { const int q = tid / (ch_ + 1), w = tid % (ch_ + 1); MASK[((size_t)b_ * 128 + w) * NS + t0l + q] = ~0ull; } }
    }
#define IDX_P(round_) ((round_) * nb + (((round_) & 1) ? (nb - 1 - bid) : bid))
    int round = 0;
    while (round * nb < 8192 && !(IDX_P(round) >= 256 && IDX_P(round) < 8192)) ++round;
    if (round * nb < 8192) { const int p0 = IDX_P(round); IDX_LOAD_FRAGS((p0 & 7) * NS + (p0 >> 3) * 8); }
    for (; round * nb < 8192; ) {
        const int p = IDX_P(round);
        int rnext = round + 1;
        while (rnext * nb < 8192 && !(IDX_P(rnext) >= 256 && IDX_P(rnext) < 8192)) ++rnext;
        const bool has_next = rnext * nb < 8192;
        const int pn = has_next ? IDX_P(rnext) : p;
        const int tg = p >> 3, b = p & 7, t0l = tg * 8, ch = t0l >> 6, nadm = 64 * (ch + 1), t0 = b * NS + t0l;
        const int t0n = (pn & 7) * NS + (pn >> 3) * 8;
        round = has_next ? rnext : 8192;
        __syncthreads();
#pragma unroll
        for (int i = 0; i < 9; ++i) if (tid + i * NTHR < 8 * IDX_HPITCH) hist[tid + i * NTHR] = 0u;
        __syncthreads();
        const int nkb = nadm >> 5;
        const f16* kbase = KI + ((size_t)(b * (NS / 32)) * 8 + hh) * 256 + r * 8;
#define IDX_LOADB(dst, kb_) do { _Pragma("unroll") for (int ks = 0; ks < 4; ++ks) dst[ks] = *(const f16x8*)(kbase + ((size_t)(kb_) * 8 + 2 * ks) * 256); } while (0)
#define IDX_BLOCK(bfrag, kb_) do { \
            f32x16 acc[2]; \
            _Pragma("unroll") for (int rt = 0; rt < 2; ++rt) { acc[rt] = (f32x16){0.f, 0.f, 0.f, 0.f, 0.f, 0.f, 0.f, 0.f, 0.f, 0.f, 0.f, 0.f, 0.f, 0.f, 0.f, 0.f}; \
                _Pragma("unroll") for (int ks = 0; ks < 4; ++ks) acc[rt] = __builtin_amdgcn_mfma_f32_32x32x16_f16(af[rt][ks], bfrag[ks], acc[rt], 0, 0, 0); } \
            _Pragma("unroll") for (int rt = 0; rt < 2; ++rt) \
                _Pragma("unroll") for (int qq = 0; qq < 2; ++qq) { \
                    f32x2 t2 = (f32x2){0.f, 0.f}; \
                    _Pragma("unroll") for (int hp = 0; hp < 4; ++hp) { const f32x2 r2 = (f32x2){__int_as_float(max(__float_as_int(acc[rt][8 * qq + 2 * hp]), 0)), __int_as_float(max(__float_as_int(acc[rt][8 * qq + 2 * hp + 1]), 0))}; \
                        t2 = __builtin_elementwise_fma(wv2[rt][4 * qq + hp], r2, t2); } \
                    const float sc = t2[0] + t2[1]; \
                    const f16 sh = (f16)sc; const unsigned bits = (unsigned)__builtin_bit_cast(unsigned short, sh); \
                    const unsigned key = (bits & 0x8000u) ? (~bits & 0xFFFFu) : (bits | 0x8000u); \
                    const int q = 4 * rt + 2 * hh + qq; \
                    if (MODE != 2) *(u16*)(lds + q * IDX_KPITCH + ((kb_) * 32 + r) * 2) = (u16)key; \
                    if (MODE != 2 && MODE != 4) atomicAdd(&hist[q * IDX_HPITCH + (key >> 7)], (key & 64u) ? 0x10000u : 1u); \
                    if (MODE == 2) sink += key; \
                } } while (0)
        f16x8 bf0[4], bf1[4], bf2[4]; unsigned sink = 0u;
        if (wave >= 4) __builtin_amdgcn_s_sleep(5);
        if (wave < nkb) IDX_LOADB(bf0, wave);
        if (wave + 8 < nkb) IDX_LOADB(bf1, wave + 8);
        if (wave + 16 < nkb) IDX_LOADB(bf2, wave + 16);
        if (MODE != 3) for (int kb = wave; kb < nkb; kb += 24) {
            IDX_BLOCK(bf0, kb);
            if (kb + 24 < nkb) IDX_LOADB(bf0, kb + 24);
            if (kb + 8 < nkb) { IDX_BLOCK(bf1, kb + 8); if (kb + 32 < nkb) IDX_LOADB(bf1, kb + 32); }
            if (kb + 16 < nkb) { IDX_BLOCK(bf2, kb + 16); if (kb + 40 < nkb) IDX_LOADB(bf2, kb + 40); }
        }
#undef IDX_LOADB
#undef IDX_BLOCK
        if (MODE == 2 && sink == 0xdeadbeefu) hist[tid] = sink;
        IDX_LOAD_FRAGS(t0n);
        __syncthreads();
        if (MODE != 1) {
            unsigned* hw = hist + wave * IDX_HPITCH;
            const unsigned char* krow = lds + wave * IDX_KPITCH;
            unsigned rem1 = 0u, rem2 = 0u;
            int b1;
            {   const u32x4 d0 = *(const u32x4*)(hw + 8 * lane), d1 = *(const u32x4*)(hw + 8 * lane + 4);
                const unsigned dd[8] = {d0.x, d0.y, d0.z, d0.w, d1.x, d1.y, d1.z, d1.w};
                unsigned cc[16];
#pragma unroll
                for (int j = 0; j < 8; ++j) { cc[2 * j] = dd[j] & 0xFFFFu; cc[2 * j + 1] = dd[j] >> 16; }
                b1 = wave_pick<16>(cc, 256u, lane, rem1); }
            hw[lane] = 0u;
            const int nit = (nadm + 511) >> 9;
            for (int it = 0; it < nit; ++it) {
                const int idx = (it * 64 + lane) * 8;
                if (idx < nadm) { const u32x4 k4 = *(const u32x4*)(krow + idx * 2);
                    const unsigned kk[4] = {k4.x, k4.y, k4.z, k4.w};
                    unsigned hit = 0u;
#pragma unroll
                    for (int j = 0; j < 4; ++j) { hit |= (((kk[j] & 0xFFFFu) >> 6) == (unsigned)b1 ? 1u : 0u) << (2 * j); hit |= ((kk[j] >> 22) == (unsigned)b1 ? 1u : 0u) << (2 * j + 1); }
                    if (hit) {
#pragma unroll
                        for (int j = 0; j < 4; ++j) { const unsigned k0 = kk[j] & 0xFFFFu, k1 = kk[j] >> 16;
                            if (hit & (1u << (2 * j))) atomicAdd(&hw[k0 & 63u], 1u);
                            if (hit & (2u << (2 * j))) atomicAdd(&hw[k1 & 63u], 1u); }
                    } }
            }
            int b2;
            { const unsigned c1[1] = {hw[lane]}; b2 = wave_pick<1>(c1, rem1, lane, rem2); }
            const unsigned tau = ((unsigned)b1 << 6) | (unsigned)b2;
            const size_t mrow = (size_t)(t0 + wave) * 128;
            for (int it = 0; it < nit; ++it) {
                const int idx = (it * 64 + lane) * 8;
                unsigned byte = 0u;
                if (idx < nadm) { const u32x4 k4 = *(const u32x4*)(krow + idx * 2);
                    const unsigned kk[4] = {k4.x, k4.y, k4.z, k4.w};
#pragma unroll
                    for (int j = 0; j < 4; ++j) { byte |= ((kk[j] & 0xFFFFu) >= tau ? 1u : 0u) << (2 * j); byte |= ((kk[j] >> 16) >= tau ? 1u : 0u) << (2 * j + 1); } }
                unsigned lo = (lane & 4) ? 0u : (byte << (8 * (lane & 3))), hi = (lane & 4) ? (byte << (8 * (lane & 3))) : 0u;
                lo |= __shfl_xor(lo, 1); hi |= __shfl_xor(hi, 1); lo |= __shfl_xor(lo, 2); hi |= __shfl_xor(hi, 2); lo |= __shfl_xor(lo, 4); hi |= __shfl_xor(hi, 4);
                if ((lane & 7) == 0 && idx < nadm) { hw[64 + 2 * (it * 8 + (lane >> 3))] = lo; hw[64 + 2 * (it * 8 + (lane >> 3)) + 1] = hi; }
            }
        }
        __syncthreads();
        if (MODE != 1) { const int w = tid >> 2, qp = tid & 3;
            if (w <= ch) { const unsigned* ha = hist + (2 * qp) * IDX_HPITCH + 64 + 2 * w; const unsigned* hb = ha + IDX_HPITCH;
                *(u32x4*)(MASK + ((size_t)b * 128 + w) * NS + t0l + 2 * qp) = (u32x4){ha[0], ha[1], hb[0], hb[1]}; } }
    }
    __syncthreads();
}

constexpr int ATP = 144;
constexpr int ATT_QWORD = 3584 + 32 * 64;
template <int AMODE>
__device__ __forceinline__ void ph4_attn_fast(const Args& a, int bid, int nb, unsigned char* lds) {
    int tid = threadIdx.x; asm volatile("" : "+v"(tid));
    const int lane = tid & 63, wave = __builtin_amdgcn_readfirstlane(tid >> 6), r = lane & 31, hh = lane >> 5;
    const f16* Q = (const f16*)(a.ws + WS_Q); const f16* Kk = (const f16*)(a.ws + WS_K); const f16* VT = (const f16*)(a.ws + WS_VT);
    const u64* MASK = (const u64*)(a.ws + WS_MASK); f16* MIX = (f16*)(a.ws + WS_H); const float* og = a.in[11];
    unsigned char* Kl = lds; unsigned char* Vl = lds + 2 * 64 * ATP;
    const float LOG2E = 1.4426950408889634f, OFF = 8192.f;
    const int pir = 16 * (r >> 4) + 8 * ((r >> 2) & 1) + 4 * ((r >> 3) & 1) + (r & 3);
    const int srow = tid >> 3, schk = tid & 7;
    unsigned* aq = (unsigned*)(a.ws + WS_CTL) + ATT_QWORD;
    lds_u32* ucell = (lds_u32*)(lds + 6 * 64 * ATP);
    lds_u32* dflag = ucell + 8;
    const float kmax = __int_as_float(__builtin_amdgcn_readfirstlane(__float_as_int(1.01f * 8.f * wave_max(fabsf(a.in[10][lane])))));
    int upar = 0;
    for (;;) {
        if (tid == 0) ucell[upar] = __hip_atomic_fetch_add(aq, 1u, __ATOMIC_RELAXED, __HIP_MEMORY_SCOPE_AGENT);
        if (tid < 8) dflag[tid] = 0u;
        __syncthreads();
        const unsigned u = ucell[upar]; upar ^= 1;
        if (u >= 2048u) break;
        const int h = 7 - (int)(u >> 8), qb = 31 - (int)((u & 255u) >> 3), b = (int)(u & 7u);
        const int q0l = qb * 256, tq = q0l + 32 * wave + r, cw = 4 * qb + (wave >> 1), top = 4 * qb + 3;
        const size_t t = (size_t)b * NS + tq;
        const float slope = exp2f(-(float)(h + 1)) * LOG2E;
        f16x8 qf[4];
#pragma unroll
        for (int ks = 0; ks < 4; ++ks) { const f16x8 qv = *(const f16x8*)(Q + t * 512 + h * 64 + 16 * ks + 8 * hh);
#pragma unroll
            for (int j = 0; j < 8; ++j) qf[ks][j] = (f16)((float)qv[j] * (0.125f * LOG2E)); }
        float qss = 0.f;
#pragma unroll
        for (int ks = 0; ks < 4; ++ks)
#pragma unroll
            for (int j = 0; j < 8; ++j) qss += (float)qf[ks][j] * (float)qf[ks][j];
        qss += __shfl_xor(qss, 32);
        const float Sb = __int_as_float(__builtin_amdgcn_readfirstlane(__float_as_int(wave_max(sqrtf(qss)) * kmax)));
        const float rowc = OFF + slope * (float)(tq - q0l);
        float m = 1000.f, l = 0.f;
        f32x16 O[2];
#pragma unroll
        for (int dt = 0; dt < 2; ++dt) O[dt] = (f32x16){0.f, 0.f, 0.f, 0.f, 0.f, 0.f, 0.f, 0.f, 0.f, 0.f, 0.f, 0.f, 0.f, 0.f, 0.f, 0.f};
        const f16* kg = Kk + ((size_t)b * NS + srow) * 512 + h * 64 + schk * 8;
        const f16* vg = VT + (size_t)(h * 64 + srow) * NT + (size_t)b * NS + schk * 8;
        f16x8 kr0, kr1, vr0, vr1; u64 mw0 = 0ull, mw1 = 0ull;
#define ATT_LOAD(kr, vr, mwv, jj) do { const int jc_ = (jj) > 0 ? (jj) : 0; kr = *(const f16x8*)(kg + (size_t)jc_ * 64 * 512); vr = *(const f16x8*)(vg + jc_ * 64); \
            mwv = MASK[((size_t)b * 128 + jc_) * NS + tq]; } while (0)
        asm volatile("" ::: "memory"); ATT_LOAD(kr0, vr0, mw0, top); asm volatile("" ::: "memory"); ATT_LOAD(kr1, vr1, mw1, top - 1); asm volatile("" ::: "memory");
        int buf = 0; bool wdone = false, stop = false;
        auto step = [&](f16x8& kreg, f16x8& vreg, u64& mwr, const int j) {
            *(f16x8*)(Kl + buf * 64 * ATP + srow * ATP + schk * 16) = kreg;
            *(f16x8*)(Vl + buf * 64 * ATP + srow * ATP + schk * 16) = vreg;
            const u64 mw = (j <= cw) ? mwr : 0ull;
            asm volatile("s_waitcnt lgkmcnt(0)" ::: "memory"); __builtin_amdgcn_s_barrier(); asm volatile("" ::: "memory");
            {
                const unsigned jp = (unsigned)(j + 1);
                const unsigned d0 = dflag[0], d1 = dflag[1], d2 = dflag[2], d3 = dflag[3], d4 = dflag[4], d5 = dflag[5], d6 = dflag[6], d7 = dflag[7];
                if ((d0 > jp) & (d1 > jp) & (d2 > jp) & (d3 > jp) & (d4 > jp) & (d5 > jp) & (d6 > jp) & (d7 > jp)) { stop = true; return; }
            }
            asm volatile("" ::: "memory"); ATT_LOAD(kreg, vreg, mwr, j - 2); asm volatile("" ::: "memory");
            if (!wdone && j < cw) { const float lmax = Sb + OFF + slope * (float)(64 * j + 63 - q0l); if (__all(lmax - m < -28.f)) { wdone = true; if (lane == 0) dflag[wave] = (unsigned)(j + 1); } }
            if (j <= cw && !wdone) {
                const unsigned char* kb_ = Kl + buf * 64 * ATP + pir * ATP + 16 * hh;
                f16x8 fr8[8];
#pragma unroll
                for (int kt = 0; kt < 2; ++kt)
#pragma unroll
                    for (int ks = 0; ks < 4; ++ks) fr8[kt * 4 + ks] = *(const f16x8*)(kb_ + kt * 32 * ATP + ks * 32);
                f32x16 sa[2];
                if (j == cw) {
#pragma unroll
                    for (int kt = 0; kt < 2; ++kt)
#pragma unroll
                        for (int rg = 0; rg < 16; ++rg) { const float x = (float)(64 * j + 32 * kt + 16 * (rg >> 3) + 8 * hh + (rg & 7) - tq); sa[kt][rg] = rowc - slope * fabsf(x); }
                } else {
                    const float base = OFF + slope * (float)(64 * j + 8 * hh - q0l);
#pragma unroll
                    for (int kt = 0; kt < 2; ++kt)
#pragma unroll
                        for (int rg = 0; rg < 16; ++rg) sa[kt][rg] = __builtin_fmaf(slope, (float)(32 * kt + 16 * (rg >> 3) + (rg & 7)), base);
                }
                __builtin_amdgcn_sched_barrier(0);
                __builtin_amdgcn_s_setprio(1);
#pragma unroll
                for (int kt = 0; kt < 2; ++kt)
#pragma unroll
                    for (int ks = 0; ks < 4; ++ks) sa[kt] = __builtin_amdgcn_mfma_f32_32x32x16_f16(fr8[kt * 4 + ks], qf[ks], sa[kt], 0, 0, 0);
                __builtin_amdgcn_s_setprio(0);
                __builtin_amdgcn_sched_barrier(0);
                const unsigned char* vb_ = Vl + buf * 64 * ATP + r * ATP + 16 * hh;
#pragma unroll
                for (int dt = 0; dt < 2; ++dt)
#pragma unroll
                    for (int kt = 0; kt < 2; ++kt)
#pragma unroll
                        for (int s2 = 0; s2 < 2; ++s2) fr8[dt * 4 + kt * 2 + s2] = *(const f16x8*)(vb_ + dt * 32 * ATP + kt * 64 + s2 * 32);
                __builtin_amdgcn_sched_barrier(0);
                float rm = 0.f;
#pragma unroll
                for (int kt = 0; kt < 2; ++kt) { const unsigned w32 = (unsigned)(kt ? (mw >> 32) : mw) >> (8 * hh);
#pragma unroll
                    for (int rg = 0; rg < 16; ++rg) { const int tm = __builtin_amdgcn_sbfe((int)w32, 16 * (rg >> 3) + (rg & 7), 1);
                        const float L = __int_as_float(__float_as_int(sa[kt][rg]) & tm); sa[kt][rg] = L; rm = fmaxf(rm, L); } }
                rm = fmaxf(rm, __shfl_xor(rm, 32));
                const float mn = fmaxf(m, rm);
                if (__any(mn > m)) { const float al = __builtin_amdgcn_exp2f(m - mn); l *= al;
#pragma unroll
                    for (int dt = 0; dt < 2; ++dt)
#pragma unroll
                        for (int rg = 0; rg < 16; ++rg) O[dt][rg] *= al; }
                m = mn;
                f16x8 pf[2][2];
                float l0 = 0.f, l1 = 0.f;
#pragma unroll
                for (int kt = 0; kt < 2; ++kt)
#pragma unroll
                    for (int rg = 0; rg < 16; ++rg) { const float pp = __builtin_amdgcn_exp2f(sa[kt][rg] - m); if (rg & 1) l1 += pp; else l0 += pp; pf[kt][rg >> 3][rg & 7] = (f16)pp; }
                l += l0 + l1;
                __builtin_amdgcn_sched_barrier(0);
                __builtin_amdgcn_s_setprio(1);
#pragma unroll
                for (int dt = 0; dt < 2; ++dt)
#pragma unroll
                    for (int kt = 0; kt < 2; ++kt)
#pragma unroll
                        for (int s2 = 0; s2 < 2; ++s2) O[dt] = __builtin_amdgcn_mfma_f32_32x32x16_f16(fr8[dt * 4 + kt * 2 + s2], pf[kt][s2], O[dt], 0, 0, 0);
                __builtin_amdgcn_s_setprio(0);
            }
            buf ^= 1;
        };
        for (int j = top; j >= 0; j -= 2) {
            step(kr0, vr0, mw0, j); if (stop) break;
            step(kr1, vr1, mw1, j - 1); if (stop) break;
        }
#undef ATT_LOAD
        l += __shfl_xor(l, 32);
        const float inv = 1.f / l;
        float ss = 0.f;
#pragma unroll
        for (int dt = 0; dt < 2; ++dt)
#pragma unroll
            for (int rg = 0; rg < 16; ++rg) { O[dt][rg] *= inv; ss += O[dt][rg] * O[dt][rg]; }
        ss += __shfl_xor(ss, 32);
        const float rstd = rsqrtf(ss * (1.f / 64.f) + EPS);
#pragma unroll
        for (int dt = 0; dt < 2; ++dt)
#pragma unroll
            for (int g4 = 0; g4 < 4; ++g4) { const int d = 32 * dt + 8 * g4 + 4 * hh; const f32x4 gg = *(const f32x4*)(og + h * 64 + d);
                f16x4 o4; o4.x = (f16)(O[dt][4 * g4 + 0] * rstd * gg.x); o4.y = (f16)(O[dt][4 * g4 + 1] * rstd * gg.y); o4.z = (f16)(O[dt][4 * g4 + 2] * rstd * gg.z); o4.w = (f16)(O[dt][4 * g4 + 3] * rstd * gg.w);
                *(f16x4*)(MIX + t * ND + 512 + h * 64 + d) = o4; }
        __syncthreads();
    }
}

__device__ __forceinline__ void ph5_outproj(const Args& a, int bid, int nb, unsigned char* lds) {
    pg8::Gemm g{(const f16*)(a.ws + WS_H), (const f16*)(a.ws + WS_WOUT), NT, 1024, ND}; pg8::StaticOrder S; S.init(NT, 1024, nb, bid);
    pg8::EpiOut E{a.in[0], (const float*)(a.ws + WS_MOD), (f16*)(a.ws + WS_X1)};
    pg8::gemm_phase((PG8_LAS unsigned char*)lds, g, S, E);
}

__device__ __forceinline__ void ph7_peerq(const Args& a, int bid, int nb, unsigned char* lds) {
    pg8::Gemm g{(const f16*)(a.ws + WS_HQ), (const f16*)(a.ws + WS_WQ8), NT, 2048, ND / 2}; pg8::StaticOrder S; S.init(NT, 2048, nb, bid);
    pg8::EpiPQ E{(f16*)(a.ws + WS_PQ), (const float*)(a.ws + WS_HSC), (const float*)(a.ws + WS_WSC)};
    pg8::gemm_phase<pg8::EpiPQ, true>((PG8_LAS unsigned char*)lds, g, S, E);
}


__device__ __forceinline__ unsigned f2skey(float f) { const unsigned u = __float_as_uint(f); return (u & 0x80000000u) ? ~u : (u | 0x80000000u); }
__device__ __forceinline__ float skey2f(unsigned k) { return __uint_as_float((k & 0x80000000u) ? (k & 0x7FFFFFFFu) : ~k); }
#define CE_(a_, b_) do { const unsigned t__ = max(a_, b_); b_ = min(a_, b_); a_ = t__; } while (0)
#define SORT16_DESC(v) do { CE_(v[0], v[1]); CE_(v[2], v[3]); CE_(v[0], v[2]); CE_(v[1], v[3]); CE_(v[1], v[2]); CE_(v[4], v[5]); CE_(v[6], v[7]); CE_(v[4], v[6]); CE_(v[5], v[7]); CE_(v[5], v[6]); CE_(v[0], v[4]); CE_(v[2], v[6]); CE_(v[2], v[4]); CE_(v[1], v[5]); CE_(v[3], v[7]); CE_(v[3], v[5]); CE_(v[1], v[2]); CE_(v[3], v[4]); CE_(v[5], v[6]); CE_(v[8], v[9]); CE_(v[10], v[11]); CE_(v[8], v[10]); CE_(v[9], v[11]); CE_(v[9], v[10]); CE_(v[12], v[13]); CE_(v[14], v[15]); CE_(v[12], v[14]); CE_(v[13], v[15]); CE_(v[13], v[14]); CE_(v[8], v[12]); CE_(v[10], v[14]); CE_(v[10], v[12]); CE_(v[9], v[13]); CE_(v[11], v[15]); CE_(v[11], v[13]); CE_(v[9], v[10]); CE_(v[11], v[12]); CE_(v[13], v[14]); CE_(v[0], v[8]); CE_(v[4], v[12]); CE_(v[4], v[8]); CE_(v[2], v[10]); CE_(v[6], v[14]); CE_(v[6], v[10]); CE_(v[2], v[4]); CE_(v[6], v[8]); CE_(v[10], v[12]); CE_(v[1], v[9]); CE_(v[5], v[13]); CE_(v[5], v[9]); CE_(v[3], v[11]); CE_(v[7], v[15]); CE_(v[7], v[11]); CE_(v[3], v[5]); CE_(v[7], v[9]); CE_(v[11], v[13]); CE_(v[1], v[2]); CE_(v[3], v[4]); CE_(v[5], v[6]); CE_(v[7], v[8]); CE_(v[9], v[10]); CE_(v[11], v[12]); CE_(v[13], v[14]); } while (0)
#define BITONIC16_DESC(v) do { CE_(v[0], v[8]); CE_(v[1], v[9]); CE_(v[2], v[10]); CE_(v[3], v[11]); CE_(v[4], v[12]); CE_(v[5], v[13]); CE_(v[6], v[14]); CE_(v[7], v[15]); CE_(v[0], v[4]); CE_(v[1], v[5]); CE_(v[2], v[6]); CE_(v[3], v[7]); CE_(v[8], v[12]); CE_(v[9], v[13]); CE_(v[10], v[14]); CE_(v[11], v[15]); CE_(v[0], v[2]); CE_(v[1], v[3]); CE_(v[4], v[6]); CE_(v[5], v[7]); CE_(v[8], v[10]); CE_(v[9], v[11]); CE_(v[12], v[14]); CE_(v[13], v[15]); CE_(v[0], v[1]); CE_(v[2], v[3]); CE_(v[4], v[5]); CE_(v[6], v[7]); CE_(v[8], v[9]); CE_(v[10], v[11]); CE_(v[12], v[13]); CE_(v[14], v[15]); } while (0)
#define MERGE16_DESC(dst, other) do { unsigned c__[16]; _Pragma("unroll") for (int i__ = 0; i__ < 16; ++i__) c__[i__] = max(dst[i__], other[15 - i__]); BITONIC16_DESC(c__); _Pragma("unroll") for (int i__ = 0; i__ < 16; ++i__) dst[i__] = c__[i__]; } while (0)
#define TOP16_INSERT(v, x_) do { unsigned x__ = (x_); _Pragma("unroll") for (int k_ = 0; k_ < 16; ++k_) { const unsigned t__ = max(v[k_], x__); x__ = min(v[k_], x__); v[k_] = t__; } } while (0)
__device__ __forceinline__ void ph8_peersel_fast(const Args& a, int bid, int nb, unsigned char* lds) {
    int tid = threadIdx.x; asm volatile("" : "+v"(tid));
    const int lane = tid & 63, wave = __builtin_amdgcn_readfirstlane(tid >> 6), r = lane & 31, hh = lane >> 5;
    const f16* PQ = (const f16*)(a.ws + WS_PQ);
    u16* EID = (u16*)(a.ws + WS_EID); float* GW = (float*)(a.ws + WS_GW);
    unsigned char* wl = lds + wave * 2048 + lane * 32;
    for (int item = bid * NWAVE + wave; item < (NT / 32) * 8; item += nb * NWAVE) {
        const int tt = item >> 3, h = item & 7, t0 = tt * 32;
        unsigned top[2][16];
#pragma unroll
        for (int p = 0; p < 2; ++p) {
            f16x8 sq[8];
#pragma unroll
            for (int c = 0; c < 8; ++c) sq[c] = *(const f16x8*)(PQ + ((((size_t)tt * 256 + h * 32 + p * 16 + 8 * hh + c) * 32 + r) << 3));
#pragma unroll
            for (int k = 0; k < 16; ++k) top[p][k] = 0u;
#pragma unroll
            for (int g = 0; g < 4; ++g) {
                unsigned ky[16];
#pragma unroll
                for (int i = 0; i < 16; ++i) { const unsigned n = 64u * hh + 16u * g + i; ky[i] = (f2skey((float)sq[2 * g + (i >> 3)][i & 7]) & ~127u) | n; }
                SORT16_DESC(ky); MERGE16_DESC(top[p], ky);
            }
            unsigned oth[16];
#pragma unroll
            for (int k = 0; k < 16; ++k) oth[k] = __shfl_xor(top[p][k], 32);
            MERGE16_DESC(top[p], oth);
            asm volatile("" ::: "memory");
        }
#pragma unroll
        for (int k = 0; k < 16; k += 4) {
            *(unsigned*)(wl + k) = (top[0][k] & 127u) | ((top[0][k + 1] & 127u) << 8) | ((top[0][k + 2] & 127u) << 16) | ((top[0][k + 3] & 127u) << 24);
            *(unsigned*)(wl + 16 + k) = (top[1][k] & 127u) | ((top[1][k + 1] & 127u) << 8) | ((top[1][k + 2] & 127u) << 16) | ((top[1][k + 3] & 127u) << 24);
        }
        float fa[16], fb[16];
#pragma unroll
        for (int k = 0; k < 16; ++k) { fa[k] = skey2f(top[0][k] & ~127u); fb[k] = skey2f(top[1][k] & ~127u); }
        unsigned cg[4][16];
        cg[0][0] = (f2skey(fa[0] + fb[0]) & ~255u) | 0u;
        cg[0][1] = (f2skey(fa[0] + fb[1]) & ~255u) | 1u;
        cg[0][2] = (f2skey(fa[0] + fb[2]) & ~255u) | 2u;
        cg[0][3] = (f2skey(fa[0] + fb[3]) & ~255u) | 3u;
        cg[0][4] = (f2skey(fa[0] + fb[4]) & ~255u) | 4u;
        cg[0][5] = (f2skey(fa[0] + fb[5]) & ~255u) | 5u;
        cg[0][6] = (f2skey(fa[0] + fb[6]) & ~255u) | 6u;
        cg[0][7] = (f2skey(fa[0] + fb[7]) & ~255u) | 7u;
        cg[0][8] = (f2skey(fa[0] + fb[8]) & ~255u) | 8u;
        cg[0][9] = (f2skey(fa[0] + fb[9]) & ~255u) | 9u;
        cg[0][10] = (f2skey(fa[0] + fb[10]) & ~255u) | 10u;
        cg[0][11] = (f2skey(fa[0] + fb[11]) & ~255u) | 11u;
        cg[0][12] = (f2skey(fa[0] + fb[12]) & ~255u) | 12u;
        cg[0][13] = (f2skey(fa[0] + fb[13]) & ~255u) | 13u;
        cg[0][14] = (f2skey(fa[0] + fb[14]) & ~255u) | 14u;
        cg[0][15] = (f2skey(fa[0] + fb[15]) & ~255u) | 15u;
        cg[1][0] = (f2skey(fa[1] + fb[0]) & ~255u) | 16u;
        cg[1][1] = (f2skey(fa[1] + fb[1]) & ~255u) | 17u;
        cg[1][2] = (f2skey(fa[1] + fb[2]) & ~255u) | 18u;
        cg[1][3] = (f2skey(fa[1] + fb[3]) & ~255u) | 19u;
        cg[1][4] = (f2skey(fa[1] + fb[4]) & ~255u) | 20u;
        cg[1][5] = (f2skey(fa[1] + fb[5]) & ~255u) | 21u;
        cg[1][6] = (f2skey(fa[1] + fb[6]) & ~255u) | 22u;
        cg[1][7] = (f2skey(fa[1] + fb[7]) & ~255u) | 23u;
        cg[1][8] = (f2skey(fa[2] + fb[0]) & ~255u) | 32u;
        cg[1][9] = (f2skey(fa[2] + fb[1]) & ~255u) | 33u;
        cg[1][10] = (f2skey(fa[2] + fb[2]) & ~255u) | 34u;
        cg[1][11] = (f2skey(fa[2] + fb[3]) & ~255u) | 35u;
        cg[1][12] = (f2skey(fa[2] + fb[4]) & ~255u) | 36u;
        cg[1][13] = (f2skey(fa[3] + fb[0]) & ~255u) | 48u;
        cg[1][14] = (f2skey(fa[3] + fb[1]) & ~255u) | 49u;
        cg[1][15] = (f2skey(fa[3] + fb[2]) & ~255u) | 50u;
        cg[2][0] = (f2skey(fa[3] + fb[3]) & ~255u) | 51u;
        cg[2][1] = (f2skey(fa[4] + fb[0]) & ~255u) | 64u;
        cg[2][2] = (f2skey(fa[4] + fb[1]) & ~255u) | 65u;
        cg[2][3] = (f2skey(fa[4] + fb[2]) & ~255u) | 66u;
        cg[2][4] = (f2skey(fa[5] + fb[0]) & ~255u) | 80u;
        cg[2][5] = (f2skey(fa[5] + fb[1]) & ~255u) | 81u;
        cg[2][6] = (f2skey(fa[6] + fb[0]) & ~255u) | 96u;
        cg[2][7] = (f2skey(fa[6] + fb[1]) & ~255u) | 97u;
        cg[2][8] = (f2skey(fa[7] + fb[0]) & ~255u) | 112u;
        cg[2][9] = (f2skey(fa[7] + fb[1]) & ~255u) | 113u;
        cg[2][10] = (f2skey(fa[8] + fb[0]) & ~255u) | 128u;
        cg[2][11] = (f2skey(fa[9] + fb[0]) & ~255u) | 144u;
        cg[2][12] = (f2skey(fa[10] + fb[0]) & ~255u) | 160u;
        cg[2][13] = (f2skey(fa[11] + fb[0]) & ~255u) | 176u;
        cg[2][14] = (f2skey(fa[12] + fb[0]) & ~255u) | 192u;
        cg[2][15] = (f2skey(fa[13] + fb[0]) & ~255u) | 208u;
        cg[3][0] = (f2skey(fa[14] + fb[0]) & ~255u) | 224u;
        cg[3][1] = (f2skey(fa[15] + fb[0]) & ~255u) | 240u;
        cg[3][2] = 0u;
        cg[3][3] = 0u;
        cg[3][4] = 0u;
        cg[3][5] = 0u;
        cg[3][6] = 0u;
        cg[3][7] = 0u;
        cg[3][8] = 0u;
        cg[3][9] = 0u;
        cg[3][10] = 0u;
        cg[3][11] = 0u;
        cg[3][12] = 0u;
        cg[3][13] = 0u;
        cg[3][14] = 0u;
        cg[3][15] = 0u;
        SORT16_DESC(cg[0]); SORT16_DESC(cg[1]); SORT16_DESC(cg[2]); SORT16_DESC(cg[3]);
        MERGE16_DESC(cg[0], cg[1]); MERGE16_DESC(cg[2], cg[3]); MERGE16_DESC(cg[0], cg[2]);
        unsigned ct[16];
#pragma unroll
        for (int k = 0; k < 16; ++k) ct[k] = cg[0][k];
        float sc[16]; float den = 0.f; const float s0 = skey2f(ct[0] & ~255u);
#pragma unroll
        for (int k = 0; k < 16; ++k) { sc[k] = __expf(skey2f(ct[k] & ~255u) - s0); den += sc[k]; }
        const float inv = 1.f / den;
        if (hh == 0) {
            u16 ev[16];
#pragma unroll
            for (int k = 0; k < 16; ++k) { const unsigned ij = ct[k] & 255u; const unsigned i1 = wl[ij >> 4], i2 = wl[16 + (ij & 15u)]; ev[k] = (u16)(i1 * 128u + i2); }
            const size_t o = (size_t)(t0 + r) * 128 + h * 16;
#pragma unroll
            for (int k = 0; k < 16; k += 8) {
                *(u32x4*)(EID + o + k) = (u32x4){(unsigned)ev[k] | ((unsigned)ev[k + 1] << 16), (unsigned)ev[k + 2] | ((unsigned)ev[k + 3] << 16), (unsigned)ev[k + 4] | ((unsigned)ev[k + 5] << 16), (unsigned)ev[k + 6] | ((unsigned)ev[k + 7] << 16)};
            }
#pragma unroll
            for (int k = 0; k < 16; k += 4) *(f32x4*)(GW + o + k) = (f32x4){sc[k] * inv, sc[k + 1] * inv, sc[k + 2] * inv, sc[k + 3] * inv};
        }
    }
}

typedef _Float16 f16x2 __attribute__((ext_vector_type(2)));
__device__ __forceinline__ float gelu_erf(float d) { return 0.5f * d * (1.f + erff(d * 0.70710678118654752f)); }
constexpr int PQ_WORD0 = 3584, PQ_CHUNK = 64, PQ_NCHUNK = NT / PQ_CHUNK, PQ_HALF = PQ_NCHUNK / 2;
constexpr size_t WS_PART = 208 * MiB;
__device__ __forceinline__ unsigned xcc_id_() { return (unsigned)__builtin_amdgcn_s_getreg((3 << 11) | 20) & 7u; }
template <int VPHASE>
__device__ __forceinline__ void ph9_sliced(const Args& a, unsigned char* lds) {
    int tid_ = threadIdx.x; asm volatile("" : "+v"(tid_)); const int lane = tid_ & 63, wave = __builtin_amdgcn_readfirstlane(tid_ >> 6);
    const int g8 = lane >> 3, c8 = lane & 7;
    const unsigned char* HP = a.ws + WS_HP; const float* HSC = (const float*)(a.ws + WS_HSC); const unsigned char* TAB = a.ws + (VPHASE ? WS_VP : WS_UT);
    const u16* EID = (const u16*)(a.ws + WS_EID); const unsigned* GW = (const unsigned*)(a.ws + WS_GW); float* PART = (float*)(a.ws + WS_PART); const float* WSUM = (const float*)(a.ws + WS_WSUM);
    const float* mod = (const float*)(a.ws + WS_MOD); float* out = a.out; const f16* X1 = (const f16*)(a.ws + WS_X1);
    unsigned* qw = (unsigned*)(a.ws + WS_CTL) + PQ_WORD0 + (VPHASE ? 8 * 64 : 0);
    volatile unsigned* cslot = (volatile unsigned*)lds;
    const bool b5 = (lane & 32) != 0, b4 = (lane & 16) != 0, b3 = (lane & 8) != 0, b2 = (lane & 4) != 0, b1 = (lane & 2) != 0, b0 = (lane & 1) != 0;
    const unsigned x0 = xcc_id_();
    int par = 0;
    for (int k = 0; k < 8; ++k) {
        const unsigned qi_ = (x0 + (unsigned)k) & 7u, sl = qi_ & 3u, half = qi_ >> 2;
        unsigned cur = 0u;
        if (tid_ == 0) cur = __hip_atomic_fetch_add(qw + 64 * qi_, 1u, __ATOMIC_RELAXED, __HIP_MEMORY_SCOPE_AGENT);
        for (;;) {
            if (tid_ == 0) cslot[par] = cur;
            __syncthreads();
            const unsigned c = cslot[par]; par ^= 1;
            if (c >= (unsigned)PQ_HALF) break;
            if (tid_ == 0) cur = __hip_atomic_fetch_add(qw + 64 * qi_, 1u, __ATOMIC_RELAXED, __HIP_MEMORY_SCOPE_AGENT);
            const int tb = (int)(half * PQ_HALF + c) * PQ_CHUNK + wave * (PQ_CHUNK / NWAVE);
            const unsigned char* tsl = TAB + 128 * sl + 16 * c8;
#pragma unroll 1
            for (int i8 = 0; i8 < PQ_CHUNK / NWAVE; ++i8) {
                const int t = tb + i8;
                const u32x4 e0 = *(const u32x4*)(EID + (size_t)t * 128 + 16 * g8), e1 = *(const u32x4*)(EID + (size_t)t * 128 + 16 * g8 + 8);
                const unsigned ew[8] = {e0.x, e0.y, e0.z, e0.w, e1.x, e1.y, e1.z, e1.w};
                u32x4 r8[16];
#pragma unroll
                for (int i = 0; i < 16; ++i) { const unsigned eid = (i & 1) ? (ew[i >> 1] >> 16) : (ew[i >> 1] & 0xFFFFu); r8[i] = *(const u32x4*)(tsl + (size_t)eid * 512); }
                if (!VPHASE) {
                    const u32x4 hh4 = *(const u32x4*)(HP + (size_t)t * 1024 + 128 * sl + 16 * c8), hl4 = *(const u32x4*)(HP + (size_t)t * 1024 + 512 + 128 * sl + 16 * c8);
                    const float hsc = 0.5f * HSC[t];
                    int hs1 = 0, hs0 = 0;
#pragma unroll
                    for (int j = 0; j < 4; ++j) { hs1 = __builtin_amdgcn_sdot8((int)hh4[j], 0x11111111, hs1, false); hs0 = __builtin_amdgcn_sdot8((int)hl4[j], 0x11111111, hs0, false); }
                    const int hsum = 16 * hs1 + hs0;
                    float p[16];
#pragma unroll
                    for (int i = 0; i < 16; ++i) { int d1 = 0, d0 = 0;
#pragma unroll
                        for (int j = 0; j < 4; ++j) { d1 = __builtin_amdgcn_sdot8((int)hh4[j], (int)r8[i][j], d1, false); d0 = __builtin_amdgcn_sdot8((int)hl4[j], (int)r8[i][j], d0, false); }
                        p[i] = (float)(2 * (16 * d1 + d0) + hsum); }
                    float q8[8], q4[4], r2[2];
#pragma unroll
                    for (int ii = 0; ii < 8; ++ii) { const float keep = b2 ? p[8 + ii] : p[ii], send = b2 ? p[ii] : p[8 + ii]; q8[ii] = keep + __shfl_xor(send, 4); }
#pragma unroll
                    for (int ii = 0; ii < 4; ++ii) { const float keep = b1 ? q8[4 + ii] : q8[ii], send = b1 ? q8[ii] : q8[4 + ii]; q4[ii] = keep + __shfl_xor(send, 2); }
#pragma unroll
                    for (int ii = 0; ii < 2; ++ii) { const float keep = b0 ? q4[2 + ii] : q4[ii], send = b0 ? q4[ii] : q4[2 + ii]; r2[ii] = keep + __shfl_xor(send, 1); }
                    *(f32x2*)(PART + ((size_t)sl * NT + t) * 128 + 16 * g8 + 2 * c8) = (f32x2){r2[0] * hsc, r2[1] * hsc};
                } else {
                    const u32x4* wp = (const u32x4*)(GW + (size_t)t * 128 + 16 * g8);
                    const u32x4 wq0 = wp[0], wq1 = wp[1], wq2 = wp[2], wq3 = wp[3];
                    const unsigned wv[16] = {wq0[0], wq0[1], wq0[2], wq0[3], wq1[0], wq1[1], wq1[2], wq1[3], wq2[0], wq2[1], wq2[2], wq2[3], wq3[0], wq3[1], wq3[2], wq3[3]};
                    const f16 off = (f16)(-7.5f * 5.9604644775390625e-08f * WSUM[(size_t)t * 8 + g8]);
                    f16x2 acc2[16];
#pragma unroll
                    for (int j = 0; j < 16; ++j) acc2[j] = (f16x2){off, off};
#pragma unroll
                    for (int i = 0; i < 16; ++i) { const f16x2 wa = __builtin_bit_cast(f16x2, wv[i]); const f16x2 wb = wa * (f16x2){(f16)0.0625f, (f16)0.0625f};
#pragma unroll
                        for (int j = 0; j < 4; ++j) { const unsigned x = r8[i][j], y = x >> 8;
                            acc2[4 * j]     = __builtin_elementwise_fma(wa, __builtin_bit_cast(f16x2, x & 0x000F000Fu), acc2[4 * j]);
                            acc2[4 * j + 1] = __builtin_elementwise_fma(wb, __builtin_bit_cast(f16x2, x & 0x00F000F0u), acc2[4 * j + 1]);
                            acc2[4 * j + 2] = __builtin_elementwise_fma(wa, __builtin_bit_cast(f16x2, y & 0x000F000Fu), acc2[4 * j + 2]);
                            acc2[4 * j + 3] = __builtin_elementwise_fma(wb, __builtin_bit_cast(f16x2, y & 0x00F000F0u), acc2[4 * j + 3]); } }
                    unsigned q8[8], q4[4], r2[2];
#pragma unroll
                    for (int ii = 0; ii < 8; ++ii) { const unsigned lo_ = __builtin_bit_cast(unsigned, acc2[ii]), hi_ = __builtin_bit_cast(unsigned, acc2[8 + ii]); const unsigned keep = b5 ? hi_ : lo_, send = b5 ? lo_ : hi_;
                        q8[ii] = __builtin_bit_cast(unsigned, __builtin_bit_cast(f16x2, keep) + __builtin_bit_cast(f16x2, (unsigned)__shfl_xor((int)send, 32))); }
#pragma unroll
                    for (int ii = 0; ii < 4; ++ii) { const unsigned keep = b4 ? q8[4 + ii] : q8[ii], send = b4 ? q8[ii] : q8[4 + ii];
                        q4[ii] = __builtin_bit_cast(unsigned, __builtin_bit_cast(f16x2, keep) + __builtin_bit_cast(f16x2, (unsigned)__shfl_xor((int)send, 16))); }
#pragma unroll
                    for (int ii = 0; ii < 2; ++ii) { const unsigned keep = b3 ? q4[2 + ii] : q4[ii], send = b3 ? q4[ii] : q4[2 + ii];
                        r2[ii] = __builtin_bit_cast(unsigned, __builtin_bit_cast(f16x2, keep) + __builtin_bit_cast(f16x2, (unsigned)__shfl_xor((int)send, 8))); }
                    const f16x2 ra = __builtin_bit_cast(f16x2, r2[0]), rb = __builtin_bit_cast(f16x2, r2[1]);
                    const int ch = 256 * sl + 32 * c8 + (b5 ? 16 : 0) + (b4 ? 8 : 0) + (b3 ? 2 : 0);
                    float* op = out + (size_t)t * ND + ch; const float* g2 = mod + (t / NS) * 6144 + 5120 + ch; const f16* xp = X1 + (size_t)t * ND + ch;
                    const f16x2 xa = *(const f16x2*)xp, xb = *(const f16x2*)(xp + 4); const f32x2 ga = *(const f32x2*)g2, gb = *(const f32x2*)(g2 + 4);
                    const float sc_ = 16777216.f / PEER_WSCALE;
                    *(f32x2*)op = (f32x2){(float)xa[0] + ga[0] * ((float)ra[0] * sc_), (float)xa[1] + ga[1] * ((float)rb[0] * sc_)};
                    *(f32x2*)(op + 4) = (f32x2){(float)xb[0] + gb[0] * ((float)ra[1] * sc_), (float)xb[1] + gb[1] * ((float)rb[1] * sc_)};
                }
            }
        }
    }
}
__device__ __forceinline__ void ph9b_combine(const Args& a, int bid, int nb) {
    int tid_ = threadIdx.x; asm volatile("" : "+v"(tid_));
    float* GW = (float*)(a.ws + WS_GW); const float* PART = (const float*)(a.ws + WS_PART);
    const float du = ((const float*)(a.ws + WS_QS))[0], dv = ((const float*)(a.ws + WS_QS))[1] * PEER_WSCALE;
    const size_t istep = (size_t)nb * NTHR, itot = (size_t)NT * 128 / 4;
    size_t i = (size_t)bid * NTHR + tid_;
#define PQ9B_ONE(sum_, g_, ii_) do { f32x4 w; \
        _Pragma("unroll") for (int j = 0; j < 4; ++j) w[j] = fminf(fmaxf(g_[j] * gelu_erf(sum_[j] * du) * dv, -60000.f), 60000.f);        \
          \
        float ws_ = 0.f; u32x4 pk; \
        _Pragma("unroll") for (int j = 0; j < 4; ++j) { const f16 hw_ = (f16)w[j]; ws_ += (float)hw_; pk[j] = (unsigned)__builtin_bit_cast(unsigned short, hw_) * 0x10001u; } \
        ((u32x4*)GW)[ii_] = pk; \
        ws_ += __shfl_xor(ws_, 1); ws_ += __shfl_xor(ws_, 2); \
        if ((tid_ & 3) == 0) ((float*)(a.ws + WS_WSUM))[(ii_) >> 2] = ws_; } while (0)
    for (; i + istep < itot; i += 2 * istep) {
        f32x4 s0 = ((const f32x4*)PART)[i], s1 = ((const f32x4*)PART)[i + istep];
#pragma unroll
        for (int sidx = 1; sidx < 4; ++sidx) { s0 += ((const f32x4*)(PART + (size_t)sidx * NT * 128))[i]; s1 += ((const f32x4*)(PART + (size_t)sidx * NT * 128))[i + istep]; }
        const f32x4 g0 = ((const f32x4*)GW)[i], g1 = ((const f32x4*)GW)[i + istep];
        PQ9B_ONE(s0, g0, i); PQ9B_ONE(s1, g1, i + istep);
    }
    for (; i < itot; i += istep) {
        f32x4 s0 = ((const f32x4*)PART)[i];
#pragma unroll
        for (int sidx = 1; sidx < 4; ++sidx) s0 += ((const f32x4*)(PART + (size_t)sidx * NT * 128))[i];
        const f32x4 g0 = ((const f32x4*)GW)[i];
        PQ9B_ONE(s0, g0, i);
    }
#undef PQ9B_ONE
}

#define LAS __attribute__((address_space(3)))
#define XB_TMO      128
#define XB_XCNT(j)  (256  + 64 * (j))
#define XB_XSUB(j)  (1280 + 64 * (j))
#define XB_XGEN(j)  (2304 + 64 * (j))
#define XB_TOP      3328
#define XB_TOPGEN   3392
#define XCD_BAR_WORDS 3456
#define XB_SPIN_CAP (1u << 18)
__device__ __forceinline__ unsigned xb_ld(unsigned* p)              { return __hip_atomic_load(p, __ATOMIC_RELAXED, __HIP_MEMORY_SCOPE_AGENT); }
__device__ __forceinline__ unsigned xb_add(unsigned* p, unsigned v) { return __hip_atomic_fetch_add(p, v, __ATOMIC_RELAXED, __HIP_MEMORY_SCOPE_AGENT); }
__device__ __forceinline__ unsigned xb_xcc_id() { return (unsigned)__builtin_amdgcn_s_getreg((3 << 11) | 20) & 0xFu; }
#define XB_SPIN(cond, bar) do { unsigned _sp = 0; while (cond) { __builtin_amdgcn_s_sleep(1); \
    if ((++_sp & 255u) == 0u) { if (xb_ld(&(bar)[XB_TMO])) break; if (_sp > XB_SPIN_CAP) { atomicAdd(&(bar)[XB_TMO], 1u); break; } } } } while (0)
struct XcdBarrier { unsigned* bar; unsigned x; volatile LAS unsigned* st; };
__device__ __forceinline__ XcdBarrier xcd_barrier_post(unsigned* bar, volatile LAS unsigned* st) {
    XcdBarrier b; b.bar = bar; b.x = xb_xcc_id(); b.st = st;
    if (threadIdx.x == 0) (void)xb_add(&bar[XB_XCNT(b.x)], 1u);
    return b;
}
__device__ __forceinline__ void xcd_barrier_complete(unsigned* bar, unsigned x, unsigned& nloc, unsigned& nx) {
    const unsigned G = gridDim.x * gridDim.y * gridDim.z;
    unsigned sum, cnt, mine, sp = 0u;
    for (;;) {
        sum = 0u; cnt = 0u; mine = 0u;
#pragma unroll
        for (unsigned j = 0; j < 16; ++j) { const unsigned c = xb_ld(&bar[XB_XCNT(j)]); sum += c; cnt += (c > 0u) ? 1u : 0u; mine = (j == x) ? c : mine; }
        if (sum == G) break;
        __builtin_amdgcn_s_sleep(1);
        if ((++sp & 255u) == 0u) { if (xb_ld(&bar[XB_TMO])) break; if (sp > XB_SPIN_CAP) { atomicAdd(&bar[XB_TMO], 1u); break; } }
    }
    nloc = mine > 0u ? mine : 1u; nx = cnt > 0u ? cnt : 1u;
}
__device__ __forceinline__ void xcd_barrier(const XcdBarrier& b) {
    asm volatile("s_waitcnt vmcnt(0)" ::: "memory");
    __syncthreads();
    if (threadIdx.x == 0) {
        unsigned* bar = b.bar;
        __builtin_amdgcn_s_waitcnt(0);
        unsigned nloc = b.st[0], nx = b.st[1];
        if (nloc == 0u) { xcd_barrier_complete(bar, b.x, nloc, nx); b.st[0] = nloc; b.st[1] = nx; }
        const unsigned old = xb_add(&bar[XB_XSUB(b.x)], 1u);
        const unsigned gen = old / nloc;
        if (old + 1u == (gen + 1u) * nloc) {
            __builtin_amdgcn_fence(__ATOMIC_RELEASE, "agent");
            asm volatile("s_waitcnt vmcnt(0)" ::: "memory");
            const unsigned og = xb_add(&bar[XB_TOP], 1u);
            const unsigned tg = og / nx;
            if (og + 1u == (tg + 1u) * nx) xb_add(&bar[XB_TOPGEN], 1u);
            else XB_SPIN(xb_ld(&bar[XB_TOPGEN]) == tg, bar);
            __builtin_amdgcn_fence(__ATOMIC_ACQUIRE, "agent");
            xb_add(&bar[XB_XGEN(b.x)], 1u);
            asm volatile("s_waitcnt vmcnt(0)" ::: "memory");
        } else {
            XB_SPIN(xb_ld(&bar[XB_XGEN(b.x)]) == gen, bar);
            __builtin_amdgcn_fence(__ATOMIC_ACQUIRE, "agent");
            asm volatile("s_waitcnt vmcnt(0)" ::: "memory");
        }
    }
    __syncthreads();
}

constexpr int N_PHASES = 12;
__global__ void __launch_bounds__(NTHR, 2) mk_fwd(Args a) {
    extern __shared__ __attribute__((aligned(16))) unsigned char lds[];
    cg::grid_group grid = cg::this_grid();
    const int bid = blockIdx.x, nb = gridDim.x;
    const int lo = a.ph_lo, hi = a.ph_hi;
    volatile LAS unsigned* bst = (volatile LAS unsigned*)((LAS unsigned char*)lds + (LDS_BYTES - 16));
    if (threadIdx.x < 4) bst[threadIdx.x] = 0u;
    __syncthreads();
    XcdBarrier xbar = xcd_barrier_post((unsigned*)(a.ws + WS_CTL), bst);
#define SEAM(k) do { if ((k) == 0) grid.sync(); else xcd_barrier(xbar); } while (0)
#define PHASE(k, body) if (lo <= (k) && (k) < hi) { body; if ((k) + 1 < hi) SEAM(k); }
    PHASE(0, ph0_prologue(a, bid, nb, lds))
    PHASE(1, row_norm_mod(a.in[0], a.in[4], (const float*)(a.ws + WS_MOD), 0, 1024, (f16*)(a.ws + WS_H), a.ws + WS_H8, (float*)(a.ws + WS_H8 + 64 * MiB), bid, nb); wq_to_int8((const f16*)(a.ws + WS_WQ), a.ws + WS_WQ8, (float*)(a.ws + WS_WSC), 2048, bid, nb); wq_to_int8((const f16*)(a.ws + WS_WIN), a.ws + WS_WIN8, (float*)(a.ws + WS_WSCIN), 1536, bid, nb); wq_to_int8((const f16*)(a.ws + WS_WVT), a.ws + WS_WVT8, (float*)(a.ws + WS_WSCIN) + 1536, 512, bid, nb))
    PHASE(2, ph2_inproj(a, bid, nb, lds))
    PHASE(3, ph3_pool_fast(a, bid, nb, lds); ph3_index_fast<0>(a, bid, nb, lds))
    PHASE(4, ph4_attn_fast<0>(a, bid, nb, lds))
    PHASE(5, ph5_outproj(a, bid, nb, lds))
    PHASE(6, row_norm_mod_q((const f16*)(a.ws + WS_X1), a.in[13], (const float*)(a.ws + WS_MOD), 3072, 4096, a.ws + WS_HQ, (unsigned*)(a.ws + WS_HP), (float*)(a.ws + WS_HSC), bid, nb))
    PHASE(7, ph7_peerq(a, bid, nb, lds))
    PHASE(8, ph8_peersel_fast(a, bid, nb, lds))
    PHASE(9, ph9_sliced<0>(a, lds))
    PHASE(10, ph9b_combine(a, bid, nb))
    PHASE(11, ph9_sliced<1>(a, lds))
#undef PHASE
}

extern "C" void kernel_launch(void* const* d_in, const int* in_sizes, int n_in, void* d_out, int out_size, void* d_ws, size_t ws_size, hipStream_t stream) {
    static int grid = 0;
    if (grid == 0) {
        if (n_in != 18 || out_size != NT * ND || ws_size < WS_END) { fprintf(stderr, "kernel_launch: unexpected shapes (n_in %d out %d ws %zu)\n", n_in, out_size, ws_size); grid = -1; return; }
        int dev = 0, cus = 0, per_cu = 0;
        hipGetDevice(&dev); hipDeviceGetAttribute(&cus, hipDeviceAttributeMultiprocessorCount, dev);
        hipFuncSetAttribute((const void*)mk_fwd, hipFuncAttributeMaxDynamicSharedMemorySize, LDS_BYTES);
        hipOccupancyMaxActiveBlocksPerMultiprocessor(&per_cu, (const void*)mk_fwd, NTHR, LDS_BYTES);
        if (per_cu < 1) { fprintf(stderr, "kernel_launch: occupancy query says %d blocks/CU\n", per_cu); per_cu = 1; }
        grid = cus * 1;
        (void)hipGetLastError();
    }
    if (grid < 0) return;
    if (hipMemsetAsync((char*)d_ws + WS_CTL, 0, 32768, stream) != hipSuccess) { fprintf(stderr, "kernel_launch: memset of the barrier words failed\n"); return; }
    Args a{};
    for (int i = 0; i < 18; ++i) a.in[i] = (const float*)d_in[i];
    a.out = (float*)d_out; a.ws = (unsigned char*)d_ws;
#if MK_MULTI
    for (int ph = 0; ph < N_PHASES; ++ph) { a.ph_lo = ph; a.ph_hi = ph + 1; hipLaunchKernelGGL(mk_fwd, dim3(grid), dim3(NTHR), LDS_BYTES, stream, a); }
#else
    a.ph_lo = 0; a.ph_hi = N_PHASES;
    void* args[] = {&a};
    hipError_t e = hipLaunchCooperativeKernel((const void*)mk_fwd, dim3(grid), dim3(NTHR), args, LDS_BYTES, stream);
    if (e != hipSuccess) fprintf(stderr, "cooperative launch failed: %s (grid %d)\n", hipGetErrorString(e), grid);
#endif
}
```

```cpp
#include <hip/hip_runtime.h>
#include <hip/hip_cooperative_groups.h>
#include <cstdio>
#include <cstdint>
namespace cg = cooperative_groups;

#ifndef MK_MULTI
#define MK_MULTI 0
#endif

typedef _Float16 f16;
typedef _Float16 f16x8 __attribute__((ext_vector_type(8)));
typedef _Float16 f16x4 __attribute__((ext_vector_type(4)));
typedef float f32x4 __attribute__((ext_vector_type(4)));
typedef float f32x16 __attribute__((ext_vector_type(16)));
typedef int i32x4 __attribute__((ext_vector_type(4)));
typedef unsigned long long u64;
typedef unsigned short u16;
typedef __attribute__((address_space(3))) unsigned lds_u32;

constexpr int NB = 8, NS = 8192, ND = 1024, NT = NB * NS;
constexpr int INW = 2632;
constexpr int NMAIN = 2304;
constexpr float EPS = 1e-6f;
constexpr int NTHR = 512, NWAVE = 8;

constexpr size_t MiB = 1u << 20;
constexpr size_t WS_CTL = 0;
constexpr size_t WS_MOD = 1 * MiB;
constexpr size_t WS_WIN = 2 * MiB;
constexpr size_t WS_WVT = 7 * MiB;
constexpr size_t WS_WOUT = 8 * MiB;
constexpr size_t WS_WQ = 10 * MiB;
constexpr size_t WS_SK = 14 * MiB;
constexpr size_t WS_PW = 14 * MiB + 512 * 1024;
constexpr size_t WS_QS = 1 * MiB + 512 * 1024;
constexpr size_t WS_UT = 16 * MiB;
constexpr size_t WS_VP = 48 * MiB;
constexpr size_t WS_H = 80 * MiB;
constexpr size_t WS_U = 208 * MiB;
constexpr size_t WS_Q = 272 * MiB;
constexpr size_t WS_K = 336 * MiB;
constexpr size_t WS_VT = 400 * MiB;
constexpr size_t WS_PQ = 208 * MiB;
constexpr size_t WS_WOUT8 = 27 * MiB;
constexpr size_t WS_WIN8 = 28 * MiB;
constexpr size_t WS_WVT8 = 30 * MiB;
constexpr size_t WS_WSCIN = 31 * MiB;
constexpr size_t WS_H8 = 656 * MiB;
constexpr size_t WS_WQ8 = 24 * MiB;
constexpr size_t WS_WSC = 26 * MiB;
constexpr size_t WS_HQ = 464 * MiB;
constexpr size_t WS_HP = 784 * MiB;
constexpr size_t WS_WSUM = 536 * MiB;
constexpr size_t WS_HSC = 528 * MiB;
constexpr size_t WS_QI = 464 * MiB;
constexpr size_t WS_KI = 528 * MiB;
constexpr size_t WS_WI = 536 * MiB;
constexpr size_t WS_MASK = 544 * MiB;
constexpr size_t WS_EID = 608 * MiB;
constexpr size_t WS_GW = 624 * MiB;
constexpr size_t WS_X1 = 656 * MiB;
constexpr size_t WS_END = 848 * MiB;

constexpr int LDS_BYTES = 155648;
constexpr float MIXQ = 127.f / 8.f;
constexpr float PEER_QSTEP = 0.3352f;
constexpr float PEER_WSCALE = 16384.f;

struct Args { const float* in[18]; float* out; unsigned char* ws; int ph_lo, ph_hi; };

__host__ __device__ __forceinline__ int pos2log(int p) { return 64 * ((p >> 5) & 3) + 32 * (p >> 7) + 8 * ((p >> 2) & 3) + 4 * ((p >> 4) & 1) + (p & 3); }
__device__ __forceinline__ int maincol(int L) { if (L < 1536) return L; if (L < 2120) return L + 512; return -1; }

__device__ __forceinline__ float wave_sum(float v) {
#pragma unroll
    for (int o = 1; o < 64; o <<= 1) v += __shfl_xor(v, o);
    return v;
}
__device__ __forceinline__ float wave_max(float v) {
#pragma unroll
    for (int o = 1; o < 64; o <<= 1) v = fmaxf(v, __shfl_xor(v, o));
    return v;
}

__device__ void ph0_prologue(const Args& a, int bid, int nb, unsigned char* lds) {
    int tid = threadIdx.x; asm volatile("" : "+v"(tid));
    const float* c = a.in[1]; const float* ada_w = a.in[2]; const float* ada_b = a.in[3];
    float* sil = (float*)lds;
    for (int i = tid; i < NB * ND; i += NTHR) { const float v = c[i]; sil[i] = v / (1.f + __expf(-v)); }
    __syncthreads();
    float* mod = (float*)(a.ws + WS_MOD);
    const int gt = bid * NTHR + tid, ngt = nb * NTHR;
    for (int o = gt; o < NB * 6144; o += ngt) {
        const int b = o / 6144, j = o % 6144;
        float acc = ada_b[j];
        const float* sb = sil + b * ND;
        for (int k = 0; k < ND; ++k) acc += sb[k] * ada_w[(size_t)k * 6144 + j];
        mod[o] = acc;
    }
    const float* w_in = a.in[5]; const float* pool_w = a.in[6]; const float* w_out = a.in[12];
    const float* wq = a.in[14]; const float* sk = a.in[15]; const float* pu = a.in[16]; const float* pv = a.in[17];
    f16* WIN = (f16*)(a.ws + WS_WIN); f16* WVT = (f16*)(a.ws + WS_WVT); f16* WOUT = (f16*)(a.ws + WS_WOUT); f16* WQ = (f16*)(a.ws + WS_WQ);
 unsigned char* UT = a.ws + WS_UT; unsigned char* VP = a.ws + WS_VP;
    {
        __syncthreads();
        const int lane = tid & 63, wv_ = tid >> 6;
        float* scr = (float*)lds + wv_ * (64 * 33);
        constexpr int I_WQ = 16 * 64, I_Z = 16 * 16, I_INR = 16 * (NMAIN / 32 - 16), I_VT = 16 * 16, I_OUT = 16 * 32, I_ALL = I_WQ + I_Z + I_INR + I_VT + I_OUT;
        for (int it = bid * NWAVE + wv_; it < I_ALL; it += nb * NWAVE) {
            int rr = it, kind = 3, pboff = 0;
            if (rr >= I_WQ) { rr -= I_WQ; kind = 0;
                if (rr >= I_Z) { rr -= I_Z; pboff = 16;
                    if (rr >= I_INR) { rr -= I_INR; kind = 1; pboff = 0; if (rr >= I_VT) { rr -= I_VT; kind = 2; } } } }
            const int npb = kind == 0 ? (pboff ? NMAIN / 32 - 16 : 16) : kind == 1 ? 16 : kind == 2 ? 32 : 64;
            const int k0 = (rr / npb) * 64, p0 = (rr % npb + pboff) * 32, p = p0 + (lane & 31);
            const float* W = kind <= 1 ? w_in : kind == 2 ? w_out : wq; const int ldw = kind <= 1 ? INW : kind == 2 ? 1024 : 2048;
            int col;
            if (kind == 0) col = maincol((p & ~255) + pos2log(p & 255)); else if (kind == 1) col = 1536 + p; else col = (p & ~255) + pos2log(p & 255);
            const bool foldz = (kind == 0 && pboff == 0);
            if (foldz || kind == 3) {
                const int r5 = lane & 31, hh_ = lane >> 5;
                const int blk = __builtin_amdgcn_readfirstlane(col >> 7);
                const int sub = col & 127;
                const float* arow = W + (size_t)(k0 + r5) * ldw + blk * 128 + 8 * hh_;
                f32x16 acc0 = (f32x16){0.f, 0.f, 0.f, 0.f, 0.f, 0.f, 0.f, 0.f, 0.f, 0.f, 0.f, 0.f, 0.f, 0.f, 0.f, 0.f}, acc1 = acc0;
#pragma unroll 2
                for (int ks = 0; ks < 8; ++ks) {
                    const f32x4 a00 = *(const f32x4*)(arow + 16 * ks), a01 = *(const f32x4*)(arow + 16 * ks + 4);
                    const f32x4 a10 = *(const f32x4*)(arow + (size_t)32 * ldw + 16 * ks), a11 = *(const f32x4*)(arow + (size_t)32 * ldw + 16 * ks + 4);
                    f16x8 bfr;
                    if (kind == 3) { const float* br = sk + (size_t)(blk * 128 + sub) * 128 + 16 * ks + 8 * hh_; const f32x4 b0 = *(const f32x4*)br, b1 = *(const f32x4*)(br + 4);
                        bfr = (f16x8){(f16)b0[0], (f16)b0[1], (f16)b0[2], (f16)b0[3], (f16)b1[0], (f16)b1[1], (f16)b1[2], (f16)b1[3]}; }
                    else { const float* br = pool_w + (size_t)blk * 16384 + (size_t)(16 * ks + 8 * hh_) * 128 + sub;
                        bfr = (f16x8){(f16)br[0], (f16)br[128], (f16)br[256], (f16)br[384], (f16)br[512], (f16)br[640], (f16)br[768], (f16)br[896]}; }
                    const f16x8 af0 = (f16x8){(f16)a00[0], (f16)a00[1], (f16)a00[2], (f16)a00[3], (f16)a01[0], (f16)a01[1], (f16)a01[2], (f16)a01[3]};
                    const f16x8 af1 = (f16x8){(f16)a10[0], (f16)a10[1], (f16)a10[2], (f16)a10[3], (f16)a11[0], (f16)a11[1], (f16)a11[2], (f16)a11[3]};
                    acc0 = __builtin_amdgcn_mfma_f32_32x32x16_f16(af0, bfr, acc0, 0, 0, 0);
                    acc1 = __builtin_amdgcn_mfma_f32_32x32x16_f16(af1, bfr, acc1, 0, 0, 0);
                }
#pragma unroll
                for (int rg = 0; rg < 16; ++rg) { const int kk = (rg & 3) + 8 * (rg >> 2) + 4 * hh_; scr[kk * 33 + r5] = acc0[rg]; scr[(32 + kk) * 33 + r5] = acc1[rg]; }
            } else {
#pragma unroll 8
                for (int i = 0; i < 32; ++i) { const int kk = 2 * i + (lane >> 5); scr[kk * 33 + (lane & 31)] = col >= 0 ? W[(size_t)(k0 + kk) * ldw + col] : 0.f; }
            }
            f16* WT = kind == 0 ? WIN : kind == 1 ? WVT : kind == 2 ? WOUT : WQ;
            const int c8 = lane & 7;
#pragma unroll
            for (int j = 0; j < 4; ++j) { const int n = (lane >> 3) + 8 * j; const float* sp = scr + (8 * c8) * 33 + n;
                *(f16x8*)(WT + (size_t)(p0 + n) * ND + k0 + 8 * c8) = (f16x8){(f16)sp[0], (f16)sp[33], (f16)sp[66], (f16)sp[99], (f16)sp[132], (f16)sp[165], (f16)sp[198], (f16)sp[231]}; }
        }
    }
    {
        __syncthreads();
        float ssu = 0.f, ssv = 0.f;
        for (int i = tid; i < 64 * 1024 / 4; i += NTHR) { const f32x4 u = ((const f32x4*)pu)[i], v = ((const f32x4*)pv)[i];
            ssu += u.x * u.x + u.y * u.y + u.z * u.z + u.w * u.w; ssv += v.x * v.x + v.y * v.y + v.z * v.z + v.w * v.w; }
        ssu = wave_sum(ssu); ssv = wave_sum(ssv);
        float* red = (float*)lds;
        if ((tid & 63) == 0) { red[tid >> 6] = ssu; red[8 + (tid >> 6)] = ssv; }
        __syncthreads();
        float tu = 0.f, tv = 0.f;
#pragma unroll
        for (int w = 0; w < 8; ++w) { tu += red[w]; tv += red[8 + w]; }
        const float du = PEER_QSTEP * sqrtf(tu * (1.f / 65536.f)), dv = PEER_QSTEP * sqrtf(tv * (1.f / 65536.f));
        if (bid == 0 && tid == 0) { float* qs = (float*)(a.ws + WS_QS); qs[0] = du; qs[1] = dv; }
        const float idu = 1.f / du, idv = 1.f / dv;
        const int lane = tid & 63, wv_ = tid >> 6;
        for (int row0 = bid * NWAVE + wv_; row0 < 2 * 16384; row0 += 4 * nb * NWAVE) {
            f32x4 x4[4][4];
#pragma unroll
            for (int rr = 0; rr < 4; ++rr) { int row = row0 + rr * nb * NWAVE; row = row < 2 * 16384 ? row : row0; const bool isv = row >= 16384; const int e = row & 16383;
                const float* src = (isv ? pv : pu) + (size_t)e * ND + 4 * lane;
#pragma unroll
                for (int j = 0; j < 4; ++j) x4[rr][j] = *(const f32x4*)(src + 256 * j); }
#pragma unroll
            for (int rr = 0; rr < 4; ++rr) { int row = row0 + rr * nb * NWAVE; row = row < 2 * 16384 ? row : row0; const bool isv = row >= 16384; const int e = row & 16383;
                u16* dstq = (u16*)((isv ? VP : UT) + (size_t)e * 512) + lane;
                const float inv = isv ? idv : idu; const int off = isv ? 8 : 0;
#pragma unroll
                for (int j = 0; j < 4; ++j) { unsigned pk = 0u;
#pragma unroll
                    for (int k = 0; k < 4; ++k) { int q = (int)floorf(x4[rr][j][k] * inv); q = q < -8 ? -8 : q > 7 ? 7 : q; pk |= (unsigned)((q + off) & 15) << (4 * k); }
                    dstq[64 * j] = (u16)pk; } }
        }
    }
}

__device__ void row_norm_mod(const float* src, const float* g, const float* mod, int sh_off, int sc_off, f16* dst, unsigned char* h8, float* hs8, int bid, int nb) {
    int tid_ = threadIdx.x; asm volatile("" : "+v"(tid_)); const int lane = tid_ & 63, wave = tid_ >> 6;
    const int rstep = nb * NWAVE, r0 = bid * NWAVE + wave;
    const bool fast = (NS % rstep) == 0 && ((NS / rstep) % 4) == 0;
    if (fast) {
        for (int b = 0; b < NB; ++b) {
            f32x4 gs[4], sh[4];
#pragma unroll
            for (int j = 0; j < 4; ++j) { const int col = lane * 4 + 256 * j; const f32x4 gg = *(const f32x4*)(g + col), sc = *(const f32x4*)(mod + b * 6144 + sc_off + col);
                sh[j] = *(const f32x4*)(mod + b * 6144 + sh_off + col); gs[j] = gg * (1.f + sc); }
            for (int row = b * NS + r0; row < (b + 1) * NS; row += 4 * rstep) {
                f32x4 v[4][4]; float ss[4];
#pragma unroll
                for (int rr = 0; rr < 4; ++rr)
#pragma unroll
                    for (int j = 0; j < 4; ++j) v[rr][j] = ((const f32x4*)(src + (size_t)(row + rr * rstep) * ND) + lane)[64 * j];
#pragma unroll
                for (int rr = 0; rr < 4; ++rr) { float s_ = 0.f;
#pragma unroll
                    for (int j = 0; j < 4; ++j) s_ += v[rr][j].x * v[rr][j].x + v[rr][j].y * v[rr][j].y + v[rr][j].z * v[rr][j].z + v[rr][j].w * v[rr][j].w;
                    ss[rr] = rsqrtf(wave_sum(s_) * (1.f / ND) + EPS); }
#pragma unroll
                for (int rr = 0; rr < 4; ++rr) { float am = 0.f;
#pragma unroll
                    for (int j = 0; j < 4; ++j) { const int col = lane * 4 + 256 * j; const f32x4 o = v[rr][j] * ss[rr] * gs[j] + sh[j]; v[rr][j] = o;
                        am = fmaxf(am, fmaxf(fmaxf(fabsf(o.x), fabsf(o.y)), fmaxf(fabsf(o.z), fabsf(o.w))));
                        *(f16x4*)(dst + (size_t)(row + rr * rstep) * ND + col) = (f16x4){(f16)o.x, (f16)o.y, (f16)o.z, (f16)o.w}; }
                    am = wave_max(am); const float inv = am > 0.f ? 127.f / am : 0.f;
#pragma unroll
                    for (int j = 0; j < 4; ++j) { const f32x4 o = v[rr][j];
                        const unsigned pk = (unsigned)((int)rintf(o.x * inv) & 255) | ((unsigned)((int)rintf(o.y * inv) & 255) << 8) | ((unsigned)((int)rintf(o.z * inv) & 255) << 16) | ((unsigned)((int)rintf(o.w * inv) & 255) << 24);
                        *(unsigned*)(h8 + (size_t)(row + rr * rstep) * ND + lane * 4 + 256 * j) = pk; }
                    if (lane == 0) hs8[row + rr * rstep] = am * (1.f / 127.f); }
            }
        }
        return;
    }
    for (int row = r0; row < NT; row += rstep) {
        const int b = row / NS;
        const f32x4* xr = (const f32x4*)(src + (size_t)row * ND) + lane;
        f32x4 v[4]; float s = 0.f;
#pragma unroll
        for (int j = 0; j < 4; ++j) { v[j] = xr[64 * j]; s += v[j].x * v[j].x + v[j].y * v[j].y + v[j].z * v[j].z + v[j].w * v[j].w; }
        const float rstd = rsqrtf(wave_sum(s) * (1.f / ND) + EPS);
#pragma unroll
        for (int j = 0; j < 4; ++j) {
            const int col = lane * 4 + 256 * j;
            const f32x4 gg = *(const f32x4*)(g + col), sc = *(const f32x4*)(mod + b * 6144 + sc_off + col), sh = *(const f32x4*)(mod + b * 6144 + sh_off + col);
            const f32x4 of = (f32x4){v[j].x * rstd * gg.x * (1.f + sc.x) + sh.x, v[j].y * rstd * gg.y * (1.f + sc.y) + sh.y, v[j].z * rstd * gg.z * (1.f + sc.z) + sh.z, v[j].w * rstd * gg.w * (1.f + sc.w) + sh.w};
            v[j] = of;
            *(f16x4*)(dst + (size_t)row * ND + col) = (f16x4){(f16)of.x, (f16)of.y, (f16)of.z, (f16)of.w};
        }
        float am = 0.f;
#pragma unroll
        for (int j = 0; j < 4; ++j) am = fmaxf(am, fmaxf(fmaxf(fabsf(v[j].x), fabsf(v[j].y)), fmaxf(fabsf(v[j].z), fabsf(v[j].w))));
        am = wave_max(am); const float inv = am > 0.f ? 127.f / am : 0.f;
#pragma unroll
        for (int j = 0; j < 4; ++j) { const f32x4 o = v[j];
            const unsigned pk = (unsigned)((int)rintf(o.x * inv) & 255) | ((unsigned)((int)rintf(o.y * inv) & 255) << 8) | ((unsigned)((int)rintf(o.z * inv) & 255) << 16) | ((unsigned)((int)rintf(o.w * inv) & 255) << 24);
            *(unsigned*)(h8 + (size_t)row * ND + lane * 4 + 256 * j) = pk; }
        if (lane == 0) hs8[row] = am * (1.f / 127.f);
    }
}
__device__ void row_norm_mod_q(const f16* src, const float* g, const float* mod, int sh_off, int sc_off, unsigned char* hq, unsigned* hp, float* hsc, int bid, int nb) {
    int tid_ = threadIdx.x; asm volatile("" : "+v"(tid_)); const int lane = tid_ & 63, wave = tid_ >> 6;
    const int rstep = nb * NWAVE, r0 = bid * NWAVE + wave;
    const bool hoist = (NS % rstep) == 0 && ((NS / rstep) % 2) == 0;
    const int nouter = hoist ? NB : 1, ninner = hoist ? NS : NT;
    for (int bo = 0; bo < nouter; ++bo) {
        f32x4 gs[4], sh[4];
        if (hoist) {
#pragma unroll
            for (int j = 0; j < 4; ++j) { const int col = 8 * lane + 512 * (j >> 1) + 4 * (j & 1); const f32x4 gg = *(const f32x4*)(g + col), sc = *(const f32x4*)(mod + bo * 6144 + sc_off + col);
                sh[j] = *(const f32x4*)(mod + bo * 6144 + sh_off + col); gs[j] = gg * (1.f + sc); }
        }
        for (int rowa = bo * ninner + r0; rowa < (bo + 1) * ninner; rowa += 2 * rstep) {
            const int rowb = rowa + rstep < NT ? rowa + rstep : rowa;
            f16x8 hx[2][2];
#pragma unroll
            for (int j = 0; j < 2; ++j) { hx[0][j] = *(const f16x8*)(src + (size_t)rowa * ND + 8 * lane + 512 * j); hx[1][j] = *(const f16x8*)(src + (size_t)rowb * ND + 8 * lane + 512 * j); }
#pragma unroll
            for (int rr = 0; rr < 2; ++rr) {
                const int row = rr ? rowb : rowa; const int b = row / NS;
                if (!hoist) {
#pragma unroll
                    for (int j = 0; j < 4; ++j) { const int col = 8 * lane + 512 * (j >> 1) + 4 * (j & 1); const f32x4 gg = *(const f32x4*)(g + col), sc = *(const f32x4*)(mod + b * 6144 + sc_off + col);
                        sh[j] = *(const f32x4*)(mod + b * 6144 + sh_off + col); gs[j] = gg * (1.f + sc); }
                }
                f32x4 v[4]; float s = 0.f;
#pragma unroll
                for (int j = 0; j < 2; ++j) { const f16x8 h8 = hx[rr][j];
                    v[2 * j] = (f32x4){(float)h8[0], (float)h8[1], (float)h8[2], (float)h8[3]}; v[2 * j + 1] = (f32x4){(float)h8[4], (float)h8[5], (float)h8[6], (float)h8[7]}; }
#pragma unroll
                for (int j = 0; j < 4; ++j) s += v[j].x * v[j].x + v[j].y * v[j].y + v[j].z * v[j].z + v[j].w * v[j].w;
                const float rstd = rsqrtf(wave_sum(s) * (1.f / ND) + EPS);
                float o[16]; float am = 0.f;
#pragma unroll
                for (int j = 0; j < 4; ++j)
#pragma unroll
                    for (int k = 0; k < 4; ++k) { const float y = v[j][k] * rstd * gs[j][k] + sh[j][k]; o[4 * j + k] = y; am = fmaxf(am, fabsf(y)); }
                am = wave_max(am);
                const float inv = am > 0.f ? 119.f / am : 0.f;
#pragma unroll
                for (int j = 0; j < 2; ++j) {
                    unsigned p0 = 0u, p1 = 0u, ph = 0u, pl = 0u;
#pragma unroll
                    for (int k = 0; k < 8; ++k) { const int q = (int)rintf(o[8 * j + k] * inv); const int l = ((q + 8) & 15) - 8; const int h = (q - l) >> 4;
                        if (k < 4) p0 |= (unsigned)(q & 255) << (8 * k); else p1 |= (unsigned)(q & 255) << (8 * (k - 4));
                        ph |= (unsigned)(h & 15) << (4 * k); pl |= (unsigned)(l & 15) << (4 * k); }
                    *(u64*)(hq + (size_t)row * ND + 8 * lane + 512 * j) = (u64)p0 | ((u64)p1 << 32);
                    hp[(size_t)row * 256 + lane + 64 * j] = ph; hp[(size_t)row * 256 + 128 + lane + 64 * j] = pl;
                }
                if (lane == 0) hsc[row] = am * (1.f / 119.f);
            }
        }
    }
}
__device__ void wq_to_int8(const f16* WQ, unsigned char* WQ8, float* WSC, int nrows, int bid, int nb, const float* kg0 = nullptr, const float* kg1 = nullptr) {
    int tid_ = threadIdx.x; asm volatile("" : "+v"(tid_)); const int lane = tid_ & 63, wave = tid_ >> 6;
    for (int row = bid * NWAVE + wave; row < nrows; row += nb * NWAVE) {
        f16x8 a0 = *(const f16x8*)(WQ + (size_t)row * ND + 8 * lane), a1 = *(const f16x8*)(WQ + (size_t)row * ND + 8 * lane + 512);
        if (kg0) {
#pragma unroll
            for (int k = 0; k < 8; ++k) { a0[k] = (f16)((float)a0[k] * (fabsf(kg0[8 * lane + k]) * (1.f / MIXQ))); a1[k] = (f16)((float)a1[k] * (fabsf(kg1[8 * lane + k]) * (1.f / MIXQ))); }
        }
        float am = 0.f;
#pragma unroll
        for (int k = 0; k < 8; ++k) am = fmaxf(am, fmaxf(fabsf((float)a0[k]), fabsf((float)a1[k])));
        am = wave_max(am);
        const float inv = am > 0.f ? 127.f / am : 0.f;
        unsigned p[4] = {0u, 0u, 0u, 0u};
#pragma unroll
        for (int k = 0; k < 4; ++k) { p[0] |= (unsigned)((int)rintf((float)a0[k] * inv) & 255) << (8 * k); p[1] |= (unsigned)((int)rintf((float)a0[4 + k] * inv) & 255) << (8 * k);
                                      p[2] |= (unsigned)((int)rintf((float)a1[k] * inv) & 255) << (8 * k); p[3] |= (unsigned)((int)rintf((float)a1[4 + k] * inv) & 255) << (8 * k); }
        *(u64*)(WQ8 + (size_t)row * ND + 8 * lane) = (u64)p[0] | ((u64)p[1] << 32);
        *(u64*)(WQ8 + (size_t)row * ND + 8 * lane + 512) = (u64)p[2] | ((u64)p[3] << 32);
        if (lane == 0) WSC[row] = am * (1.f / 127.f);
    }
}

namespace pg8 {
#define PG8_LAS __attribute__((address_space(3)))
constexpr int BM = 256, BK = 64, HALF = 128, HTB = HALF * BK * 2, STAGE_BYTES = 8 * HTB, NXCD = 8, WGM = 8;
__host__ __device__ __forceinline__ int lds_byte(int r, int c) { const int st = (r >> 4) * 2 + (c >> 5), rr = r & 15, cc = c & 31, ob = rr * 64 + cc * 2; return st * 1024 + (ob ^ (((ob >> 9) & 1) << 5)); }
__host__ __device__ __forceinline__ void stage_rc(int b, int& R, int& C) { const int st = b / 1024, sb = b % 1024, swz = sb ^ (((sb >> 9) & 1) << 5); R = (st >> 1) * 16 + swz / 64; C = (st & 1) * 32 + (swz % 64) / 2; }
struct Unit { int pm, pn; };
struct Gemm { const f16* A; const f16* Bt; int M, N, K; };
struct StaticOrder {
    int nM, nN, nwg, G, c;
    __host__ __device__ void init(int M, int N, int G_, int c_) { nM = M / BM; nN = N / BM; nwg = nM * nN; G = G_; c = c_; }
    __host__ __device__ bool next(int i, Unit& u) const {
        const long L = (long)i * G + c; if (L >= nwg) return false;
        int wgid = (int)L; { const int q = nwg / NXCD, r = nwg % NXCD, xcd = wgid % NXCD, off = wgid / NXCD; wgid = (xcd < r ? xcd * (q + 1) : r * (q + 1) + (xcd - r) * q) + off; }
        const int nig = WGM * nN, gid = wgid / nig, fm = gid * WGM, gsz = (nM - fm) < WGM ? (nM - fm) : WGM;
        u.pm = fm + ((wgid % nig) % gsz); u.pn = (wgid % nig) / gsz; return true;
    }
};
template <class Epi, bool I8 = false>
__device__ __forceinline__ void gemm_phase(PG8_LAS unsigned char* lds, const Gemm g, const StaticOrder& S, const Epi& E) {
    int tid = threadIdx.x; asm volatile("" : "+v"(tid));
    const int wid = __builtin_amdgcn_readfirstlane(tid >> 6), lane = tid & 63, wr = wid >> 2, wc = wid & 3, fr = lane & 15, fq = lane >> 4;
    const int K = g.K, nt = K / BK;
    unsigned voffA[2];
#pragma unroll
    for (int i = 0; i < 2; ++i) { int R, C; stage_rc(tid * 16 + i * 8192, R, C); voffA[i] = (unsigned)(R * K + C) * 2u; }
    const size_t kstep = (size_t)(BK * 2);
    const size_t hstep = (size_t)HALF * K * 2;
    const size_t tstep = 2 * hstep;
    const unsigned ldsw = (unsigned)wid * 1024u;
    const int aoff = lds_byte(wr * 64 + fr, fq * 8), boff = lds_byte(wc * 32 + fr, fq * 8);
#define PG8_SA(b, h) (((b) * 2 + (h)) * HTB)
#define PG8_SB(b, h) ((4 + (b) * 2 + (h)) * HTB)
#define PG8_STAGE(bufoff, gbase, voff) do { _Pragma("unroll") for (int _i = 0; _i < 2; ++_i) \
        __builtin_amdgcn_global_load_lds((const unsigned*)((const char*)(gbase) + (voff)[_i]), (PG8_LAS unsigned*)(lds + (bufoff) + ldsw + _i * 8192), 16, 0, 0); } while (0)
#define PG8_LDA(dst, b, h) do { _Pragma("unroll") for (int m = 0; m < 4; ++m) _Pragma("unroll") for (int k = 0; k < 2; ++k) dst[m][k] = *(const PG8_LAS f16x8*)(lds + PG8_SA(b, h) + aoff + m * 2048 + k * 1024); } while (0)
#define PG8_LDB(dst, b, h) do { _Pragma("unroll") for (int n = 0; n < 2; ++n) _Pragma("unroll") for (int k = 0; k < 2; ++k) dst[n][k] = *(const PG8_LAS f16x8*)(lds + PG8_SB(b, h) + boff + n * 2048 + k * 1024); } while (0)
#define PG8_MMA(ai, bj, At, Bt) do { __builtin_amdgcn_s_setprio(1); _Pragma("unroll") for (int m = 0; m < 4; ++m) _Pragma("unroll") for (int n = 0; n < 2; ++n) _Pragma("unroll") for (int k = 0; k < 2; ++k) \
        acc[ai][bj][m][n] = I8 ? __builtin_bit_cast(f32x4, __builtin_amdgcn_mfma_i32_16x16x64_i8(__builtin_bit_cast(i32x4, Bt[n][k]), __builtin_bit_cast(i32x4, At[m][k]), __builtin_bit_cast(i32x4, acc[ai][bj][m][n]), 0, 0, 0)) \
                                 : __builtin_amdgcn_mfma_f32_16x16x32_f16(Bt[n][k], At[m][k], acc[ai][bj][m][n], 0, 0, 0); __builtin_amdgcn_s_setprio(0); } while (0)
#define PG8_WAIT_V(n) asm volatile("s_waitcnt vmcnt(" #n ")" ::: "memory")
#define PG8_WAIT_L(n) asm volatile("s_waitcnt lgkmcnt(" #n ")" ::: "memory")
#define PG8_BAR __builtin_amdgcn_s_barrier()
#define PG8_SCHED __builtin_amdgcn_sched_barrier(0)
    Unit cur, nxt; int ui = 0;
    if (!S.next(0, cur)) return;
    f32x4 acc[2][2][4][2];
#pragma unroll
    for (int a = 0; a < 2; ++a)
#pragma unroll
        for (int b = 0; b < 2; ++b)
#pragma unroll
            for (int m = 0; m < 4; ++m)
#pragma unroll
                for (int n = 0; n < 2; ++n) acc[a][b][m][n] = (f32x4){0.f, 0.f, 0.f, 0.f};
    f16x8 At[4][2], B0[2][2], B1[2][2];
    const char* cA = (const char*)g.A + (size_t)cur.pm * tstep; const char* cB = (const char*)g.Bt + (size_t)cur.pn * tstep;
    PG8_STAGE(PG8_SB(0, 0), cB, voffA); PG8_STAGE(PG8_SB(0, 1), cB + hstep, voffA); PG8_STAGE(PG8_SA(0, 0), cA, voffA); PG8_STAGE(PG8_SA(0, 1), cA + hstep, voffA);
    if (wr == 1) PG8_BAR;
    PG8_WAIT_V(2); PG8_BAR;
    PG8_STAGE(PG8_SB(1, 0), cB + kstep, voffA); PG8_STAGE(PG8_SA(1, 0), cA + kstep, voffA); PG8_STAGE(PG8_SB(1, 1), cB + hstep + kstep, voffA);
    PG8_WAIT_V(6); PG8_BAR;
    for (;;) {
        const bool has_next = S.next(ui + 1, nxt);
        const char* nA = has_next ? (const char*)g.A + (size_t)nxt.pm * tstep : cA; const char* nB = has_next ? (const char*)g.Bt + (size_t)nxt.pn * tstep : cB;
        for (int t = 0; t < nt; t += 2) {
            const bool last = (t == nt - 2);
            const char* a1 = cA + (size_t)(t + 1) * kstep;
            const char* a2 = last ? nA : cA + (size_t)(t + 2) * kstep; const char* b2 = last ? nB : cB + (size_t)(t + 2) * kstep;
            const char* a3 = a2 + kstep; const char* b3 = b2 + kstep;
            PG8_LDB(B0, 0, 0); PG8_LDB(B1, 0, 1); PG8_SCHED; PG8_LDA(At, 0, 0); PG8_STAGE(PG8_SA(1, 1), a1 + hstep, voffA);
            PG8_WAIT_V(8); PG8_WAIT_L(0); PG8_BAR; PG8_MMA(0, 0, At, B0); PG8_MMA(0, 1, At, B1); PG8_BAR; PG8_SCHED;
            PG8_LDA(At, 0, 1); PG8_STAGE(PG8_SB(0, 0), b2, voffA); PG8_STAGE(PG8_SB(0, 1), b2 + hstep, voffA); PG8_STAGE(PG8_SA(0, 0), a2, voffA);
            PG8_WAIT_V(8); PG8_WAIT_L(0); PG8_BAR; PG8_MMA(1, 0, At, B0); PG8_MMA(1, 1, At, B1); PG8_BAR; PG8_SCHED;
            PG8_LDB(B0, 1, 0); PG8_LDB(B1, 1, 1); PG8_SCHED; PG8_LDA(At, 1, 0); PG8_STAGE(PG8_SA(0, 1), a2 + hstep, voffA);
            PG8_WAIT_V(8); PG8_WAIT_L(0); PG8_BAR; PG8_MMA(0, 0, At, B0); PG8_MMA(0, 1, At, B1); PG8_BAR; PG8_SCHED;
            PG8_LDA(At, 1, 1); PG8_STAGE(PG8_SB(1, 0), b3, voffA); PG8_STAGE(PG8_SB(1, 1), b3 + hstep, voffA); PG8_STAGE(PG8_SA(1, 0), a3, voffA);
            PG8_WAIT_V(8); PG8_WAIT_L(0); PG8_BAR; PG8_MMA(1, 0, At, B0); PG8_MMA(1, 1, At, B1); PG8_BAR; PG8_SCHED;
        }
        if (wr == 0) PG8_BAR;
        E(acc, cur, wr, wc, fr, fq);
        if (!has_next) break;
#pragma unroll
        for (int a = 0; a < 2; ++a)
#pragma unroll
            for (int b = 0; b < 2; ++b)
#pragma unroll
                for (int m = 0; m < 4; ++m)
#pragma unroll
                    for (int n = 0; n < 2; ++n) acc[a][b][m][n] = (f32x4){0.f, 0.f, 0.f, 0.f};
        cur = nxt; cA = nA; cB = nB; ++ui;
        if (wr == 1) PG8_BAR;
    }
    PG8_WAIT_V(0);
    PG8_BAR;
#undef PG8_SA
#undef PG8_SB
#undef PG8_STAGE
#undef PG8_LDA
#undef PG8_LDB
#undef PG8_MMA
#undef PG8_WAIT_V
#undef PG8_WAIT_L
#undef PG8_BAR
#undef PG8_SCHED
}

typedef f32x4 Acc[2][2][4][2];
__device__ __forceinline__ f32x4 cvt_i4(const f32x4 b) { const i32x4 i = __builtin_bit_cast(i32x4, b); return (f32x4){(float)i[0], (float)i[1], (float)i[2], (float)i[3]}; }
template <bool I8>
struct EpiMainT {
    unsigned char* ws; const float *qg, *kg; int pn0; const float* hsc; const float* wsc;
    __device__ __forceinline__ void operator()(const Acc& acc, const Unit& u, int wr, int wc, int fr, int fq) const {
        const int row0 = u.pm * BM + wr * 64 + fr, pn = u.pn + pn0;
        f32x4 ws4[2][2];
#pragma unroll
        for (int bj = 0; bj < 2; ++bj)
#pragma unroll
            for (int n = 0; n < 2; ++n) ws4[bj][n] = I8 ? *(const f32x4*)(wsc + pn * BM + 128 * bj + 32 * wc + 16 * n + 4 * fq) : (f32x4){1.f, 1.f, 1.f, 1.f};
#define EA_(ai, bj, m, n) (I8 ? cvt_i4(acc[ai][bj][m][n]) * ws4[bj][n] : acc[ai][bj][m][n])
        if (pn == 8) {
            if (wc == 0) {
#pragma unroll
                for (int ai = 0; ai < 2; ++ai)
#pragma unroll
                    for (int m = 0; m < 4; ++m) { const size_t row = row0 + ai * HALF + m * 16;
#pragma unroll
                        for (int bj = 0; bj < 2; ++bj) { const f32x4 v0 = acc[ai][bj][m][0], v1 = acc[ai][bj][m][1];
                            *(f16x8*)((f16*)(ws + WS_KI) + (((row >> 5) * 8 + 4 * bj + fq) * 32 + (row & 31)) * 8) = (f16x8){(f16)v0[0], (f16)v0[1], (f16)v0[2], (f16)v0[3], (f16)v1[0], (f16)v1[1], (f16)v1[2], (f16)v1[3]}; } }
            } else if (wc == 1 && fq == 0) {
#pragma unroll
                for (int ai = 0; ai < 2; ++ai)
#pragma unroll
                    for (int m = 0; m < 4; ++m) { const size_t row = row0 + ai * HALF + m * 16;
                        *(f32x4*)((float*)(ws + WS_WI) + row * 8) = acc[ai][0][m][0] * 0.35355339059327373f; *(f32x4*)((float*)(ws + WS_WI) + row * 8 + 4) = acc[ai][0][m][1] * 0.35355339059327373f; }
            }
            return;
        }
        const int kind = pn >> 1;
        f16* base = (f16*)(ws + (kind == 0 ? WS_U : kind == 1 ? WS_Q : kind == 2 ? WS_K : WS_QI));
        const int col0 = (pn & 1) * 256 + 64 * wc + 8 * fq;
        if (kind == 1 || kind == 2) {
            const float* gp = (kind == 1 ? qg : kg) + 8 * fq;
#pragma unroll
            for (int ai = 0; ai < 2; ++ai)
#pragma unroll
                for (int m = 0; m < 4; ++m) { const size_t row = row0 + ai * HALF + m * 16; const float hs = I8 ? hsc[row] : 1.f;
                    float ss = 0.f;
#pragma unroll
                    for (int bj = 0; bj < 2; ++bj)
#pragma unroll
                        for (int n = 0; n < 2; ++n) { const f32x4 v = EA_(ai, bj, m, n) * hs; ss += v[0] * v[0] + v[1] * v[1] + v[2] * v[2] + v[3] * v[3]; }
                    ss += __shfl_xor(ss, 16); ss += __shfl_xor(ss, 32);
                    const float rstd = rsqrtf(ss * (1.f / 64.f) + EPS);
#pragma unroll
                    for (int bj = 0; bj < 2; ++bj) { const f32x4 v0 = EA_(ai, bj, m, 0) * (hs * rstd) * *(const f32x4*)(gp + 32 * bj), v1 = EA_(ai, bj, m, 1) * (hs * rstd) * *(const f32x4*)(gp + 32 * bj + 4);
                        *(f16x8*)(base + row * 512 + col0 + 32 * bj) = (f16x8){(f16)v0[0], (f16)v0[1], (f16)v0[2], (f16)v0[3], (f16)v1[0], (f16)v1[1], (f16)v1[2], (f16)v1[3]}; }
                    asm volatile("" ::: "memory"); }
        } else if (kind == 3) {
            const int hd = (pn & 1) * 4 + wc;
#pragma unroll
            for (int ai = 0; ai < 2; ++ai)
#pragma unroll
                for (int m = 0; m < 4; ++m) { const size_t row = row0 + ai * HALF + m * 16; const int ql = (int)(row & 7);
                    const int rr = (hd & 3) | (((ql >> 1) & 1) << 2) | ((hd >> 2) << 3) | ((ql & 1) << 4);
#pragma unroll
                    for (int bj = 0; bj < 2; ++bj) { const f32x4 v0 = acc[ai][bj][m][0], v1 = acc[ai][bj][m][1]; const int chunk = fq + 4 * bj;
                        *(f16x8*)(base + ((((((row >> 3) * 2 + (ql >> 2)) * 4 + (chunk >> 1)) * 2 + (chunk & 1)) * 32 + rr) << 3)) = (f16x8){(f16)v0[0], (f16)v0[1], (f16)v0[2], (f16)v0[3], (f16)v1[0], (f16)v1[1], (f16)v1[2], (f16)v1[3]}; } }
        } else {
#pragma unroll
            for (int ai = 0; ai < 2; ++ai)
#pragma unroll
                for (int m = 0; m < 4; ++m) { const size_t row = row0 + ai * HALF + m * 16; const float hs = I8 ? hsc[row] : 1.f;
#pragma unroll
                    for (int bj = 0; bj < 2; ++bj) { const f32x4 v0 = EA_(ai, bj, m, 0) * hs, v1 = EA_(ai, bj, m, 1) * hs;
                        *(f16x8*)(base + row * 512 + col0 + 32 * bj) = (f16x8){(f16)v0[0], (f16)v0[1], (f16)v0[2], (f16)v0[3], (f16)v1[0], (f16)v1[1], (f16)v1[2], (f16)v1[3]}; } }
        }
#undef EA_
    }
};
typedef EpiMainT<false> EpiMain;
template <bool I8>
struct EpiVTT {
    f16* VT; const float* wsc; const float* hsc;
    __device__ __forceinline__ void operator()(const Acc& acc, const Unit& u, int wr, int wc, int fr, int fq) const {
        const int row0 = u.pm * BM + wr * 64 + fr, col0 = u.pn * BM + 32 * wc + 4 * fq;
        f32x4 hs4[2][2];
#pragma unroll
        for (int bj = 0; bj < 2; ++bj)
#pragma unroll
            for (int n = 0; n < 2; ++n) hs4[bj][n] = I8 ? *(const f32x4*)(hsc + col0 + 128 * bj + 16 * n) : (f32x4){1.f, 1.f, 1.f, 1.f};
#pragma unroll
        for (int ai = 0; ai < 2; ++ai)
#pragma unroll
            for (int m = 0; m < 4; ++m) { const size_t row = row0 + ai * HALF + m * 16; const float wsr = I8 ? wsc[row] : 1.f;
#pragma unroll
                for (int bj = 0; bj < 2; ++bj)
#pragma unroll
                    for (int n = 0; n < 2; ++n) { const f32x4 v = I8 ? cvt_i4(acc[ai][bj][m][n]) * hs4[bj][n] * wsr : acc[ai][bj][m][n];
                        *(f16x4*)(VT + row * NT + col0 + 128 * bj + 16 * n) = (f16x4){(f16)v[0], (f16)v[1], (f16)v[2], (f16)v[3]}; } }
    }
};
struct EpiOut {
    const float* x; const float* mod; f16* x1; const float* wsc;
    __device__ __forceinline__ void operator()(const Acc& acc, const Unit& u, int wr, int wc, int fr, int fq) const {
        const int row0 = u.pm * BM + wr * 64 + fr, col0 = u.pn * BM + 64 * wc + 8 * fq;
        const float* g1 = mod + ((u.pm * BM) / NS) * 6144 + 2048 + col0;
        f32x4 g4[2][2];
#pragma unroll
        for (int bj = 0; bj < 2; ++bj)
#pragma unroll
            for (int n = 0; n < 2; ++n) g4[bj][n] = *(const f32x4*)(g1 + 32 * bj + 4 * n) * *(const f32x4*)(wsc + u.pn * BM + 128 * bj + 32 * wc + 16 * n + 4 * fq);
#pragma unroll
        for (int ai = 0; ai < 2; ++ai)
#pragma unroll
            for (int m = 0; m < 4; ++m) { const size_t off = (size_t)(row0 + ai * HALF + m * 16) * ND + col0;
#pragma unroll
                for (int bj = 0; bj < 2; ++bj) { const f32x4 v0 = *(const f32x4*)(x + off + 32 * bj) + g4[bj][0] * cvt_i4(acc[ai][bj][m][0]), v1 = *(const f32x4*)(x + off + 32 * bj + 4) + g4[bj][1] * cvt_i4(acc[ai][bj][m][1]);
                    *(f16x8*)(x1 + off + 32 * bj) = (f16x8){(f16)v0[0], (f16)v0[1], (f16)v0[2], (f16)v0[3], (f16)v1[0], (f16)v1[1], (f16)v1[2], (f16)v1[3]}; } }
    }
};
struct EpiPQ {
    f16* PQ; const float* hsc; const float* wsc;
    __device__ __forceinline__ void operator()(const Acc& acc, const Unit& u, int wr, int wc, int fr, int fq) const {
        const int row0 = u.pm * BM + wr * 64 + fr, col0 = u.pn * BM + 64 * wc + 8 * fq;
        f32x4 ws4[2][2];
#pragma unroll
        for (int bj = 0; bj < 2; ++bj)
#pragma unroll
            for (int n = 0; n < 2; ++n) ws4[bj][n] = *(const f32x4*)(wsc + u.pn * BM + 128 * bj + 32 * wc + 16 * n + 4 * fq);
#pragma unroll
        for (int ai = 0; ai < 2; ++ai)
#pragma unroll
            for (int m = 0; m < 4; ++m) { const size_t row = row0 + ai * HALF + m * 16; const float hs = hsc[row];
#pragma unroll
                for (int bj = 0; bj < 2; ++bj) { const i32x4 i0 = __builtin_bit_cast(i32x4, acc[ai][bj][m][0]), i1 = __builtin_bit_cast(i32x4, acc[ai][bj][m][1]);
                    const f32x4 v0 = (f32x4){(float)i0[0], (float)i0[1], (float)i0[2], (float)i0[3]} * ws4[bj][0] * hs, v1 = (f32x4){(float)i1[0], (float)i1[1], (float)i1[2], (float)i1[3]} * ws4[bj][1] * hs;
                    *(f16x8*)(PQ + ((((row >> 5) * 256 + ((col0 + 32 * bj) >> 3)) * 32 + (row & 31)) << 3)) = (f16x8){(f16)v0[0], (f16)v0[1], (f16)v0[2], (f16)v0[3], (f16)v1[0], (f16)v1[1], (f16)v1[2], (f16)v1[3]}; } }
    }
};
}

__device__ __forceinline__ void ph2_inproj(const Args& a, int bid, int nb, unsigned char* lds) {
    const f16* H = (const f16*)(a.ws + WS_H); const f16* WIN = (const f16*)(a.ws + WS_WIN);
    const f16* H8 = (const f16*)(a.ws + WS_H8); const float* hs8 = (const float*)(a.ws + WS_H8 + 64 * MiB); const float* wsi = (const float*)(a.ws + WS_WSCIN);
    PG8_LAS unsigned char* l3 = (PG8_LAS unsigned char*)lds;
    { pg8::Gemm g{H8, (const f16*)(a.ws + WS_WIN8), NT, 1536, ND / 2}; pg8::StaticOrder S; S.init(NT, 1536, nb, bid);
      pg8::EpiMainT<true> E{a.ws, a.in[9], a.in[10], 0, hs8, wsi};
      pg8::gemm_phase<pg8::EpiMainT<true>, true>(l3, g, S, E); }
    { pg8::Gemm g{H, WIN + (size_t)1536 * ND, NT, NMAIN - 1536, ND}; pg8::StaticOrder S; S.init(NT, NMAIN - 1536, nb, bid);
      pg8::EpiMain E{a.ws, a.in[9], a.in[10], 6, nullptr, nullptr};
      pg8::gemm_phase(l3, g, S, E); }
    { pg8::Gemm g{(const f16*)(a.ws + WS_WVT8), H8, 512, NT, ND / 2}; pg8::StaticOrder S; S.init(512, NT, nb, bid);
      pg8::EpiVTT<true> E{(f16*)(a.ws + WS_VT), wsi + 1536, hs8};
      pg8::gemm_phase<pg8::EpiVTT<true>, true>(l3, g, S, E); }
}


constexpr int PPITCH = 1040;
__device__ __forceinline__ void ph3_pool_fast(const Args& a, int bid, int nb, unsigned char* lds) {
    int tid = threadIdx.x; asm volatile("" : "+v"(tid));
    const int cg8 = tid & 63, tq = tid >> 6, gch = cg8 >> 4, win = 2 << gch;
    const f16* Z = (const f16*)(a.ws + WS_U); unsigned char* MIX8 = a.ws + WS_H;
    const f32x4 ps0 = *(const f32x4*)(a.in[7] + 8 * cg8), ps1 = *(const f32x4*)(a.in[7] + 8 * cg8 + 4), pg0 = *(const f32x4*)(a.in[8] + 8 * cg8), pg1 = *(const f32x4*)(a.in[8] + 8 * cg8 + 4);
    const float psc[8] = {ps0[0], ps0[1], ps0[2], ps0[3], ps1[0], ps1[1], ps1[2], ps1[3]}, pgn[8] = {pg0[0], pg0[1], pg0[2], pg0[3], pg1[0], pg1[1], pg1[2], pg1[3]};
    float psg[8];
#pragma unroll
    for (int j = 0; j < 8; ++j) psg[j] = pgn[j] > 0.f ? MIXQ : (pgn[j] < 0.f ? -MIXQ : 0.f);
    for (int item = bid; item < NT / 32; item += nb) {
        const int tb = item * 32 + 4 * tq, tl0 = tb % NS;
        const f16* up = Z + (size_t)(tb - tl0) * 512 + 8 * cg8;
        float sm[8];
#pragma unroll
        for (int j = 0; j < 8; ++j) sm[j] = 0.f;
        f16x8 hist_[15];
#pragma unroll
        for (int q = 0; q < 15; ++q) { const int rr = tl0 - 15 + q; hist_[q] = (q >= 16 - win && rr >= 0) ? *(const f16x8*)(up + (size_t)rr * 512) : (f16x8){0, 0, 0, 0, 0, 0, 0, 0}; }
        f16x8 cur_[4];
#pragma unroll
        for (int k = 0; k < 4; ++k) cur_[k] = *(const f16x8*)(up + (size_t)(tl0 + k) * 512);
#pragma unroll
        for (int q = 0; q < 15; ++q)
#pragma unroll
            for (int j = 0; j < 8; ++j) sm[j] += (float)hist_[q][j];
#pragma unroll
        for (int k = 0; k < 4; ++k) {
            const int tl = tl0 + k;
            const float ic = 1.f / (float)((tl + 1 < win) ? tl + 1 : win);
            float v[8]; float ss = 0.f;
#pragma unroll
            for (int j = 0; j < 8; ++j) { sm[j] += (float)cur_[k][j]; v[j] = (sm[j] * ic - (float)cur_[k][j]) * psc[j]; ss += v[j] * v[j]; }
            const float rstd = rsqrtf(wave_sum(ss) * (1.f / 512.f) + EPS);
            unsigned q0 = 0u, q1 = 0u;
#pragma unroll
            for (int j = 0; j < 8; ++j) { const float qf_ = fminf(fmaxf(v[j] * rstd * psg[j], -127.f), 127.f); const unsigned qb = (unsigned)((int)rintf(qf_) & 255);
                if (j < 4) q0 |= qb << (8 * j); else q1 |= qb << (8 * (j - 4)); }
            *(u64*)(MIX8 + (size_t)(tb + k) * ND + 8 * cg8) = (u64)q0 | ((u64)q1 << 32);
            if (k < 3) {
#pragma unroll
                for (int j = 0; j < 8; ++j) {
                    const int q = 16 - win + k;
                    float dv = 0.f;
#pragma unroll
                    for (int qq = 0; qq < 15; ++qq) if (qq == q) dv = (float)hist_[qq][j];
#pragma unroll
                    for (int kk = 0; kk < 3; ++kk) if (q == 15 + kk) dv = (float)cur_[kk][j];
                    sm[j] -= dv;
                }
            }
        }
    }
}


typedef float f32x2 __attribute__((ext_vector_type(2)));
typedef unsigned u32x4 __attribute__((ext_vector_type(4)));

constexpr int IDX_KPITCH = 16384 + 16;
constexpr int IDX_HPITCH = 516;
template <int NBL>
__device__ __forceinline__ int wave_pick(const unsigned (&cc)[NBL], unsigned target, int lane, unsigned& rem_out) {
    unsigned tot = 0u;
#pragma unroll
    for (int j = 0; j < NBL; ++j) tot += cc[j];
    unsigned S = tot;
#pragma unroll
    for (int o = 1; o < 64; o <<= 1) { const unsigned v = __shfl_down(S, o); if (lane + o < 64) S += v; }
    const unsigned above = S - tot;
    const bool hit = (above < target) && (S >= target);
    const u64 bal = __ballot(hit);
    const int L = bal ? __builtin_ctzll(bal) : 0;
    int bin = 0; unsigned rem = target;
    { unsigned run = above; bool done = false;
#pragma unroll
      for (int j = NBL - 1; j >= 0; --j) { if (!done) { if (run + cc[j] >= target) { bin = NBL * lane + j; rem = target - run; done = true; } else run += cc[j]; } } }
    bin = __shfl(bin, L); rem_out = __shfl(rem, L);
    return bin;
}
template <int MODE>
__device__ __forceinline__ void ph3_index_fast(const Args& a, int bid, int nb, unsigned char* lds) {
    int tid = threadIdx.x; asm volatile("" : "+v"(tid));
    const int lane = tid & 63, wave = __builtin_amdgcn_readfirstlane(tid >> 6), r = lane & 31, hh = lane >> 5;
    const f16* QI = (const f16*)(a.ws + WS_QI); const f16* KI = (const f16*)(a.ws + WS_KI); const float* WI = (const float*)(a.ws + WS_WI);
    u64* MASK = (u64*)(a.ws + WS_MASK);
    unsigned* hist = (unsigned*)(lds + 8 * IDX_KPITCH);
    f16x8 af[2][4]; f32x2 wv2[2][8];
#define IDX_LOAD_FRAGS(t0_) do { \
        _Pragma("unroll") for (int rt = 0; rt < 2; ++rt) { \
            _Pragma("unroll") for (int ks = 0; ks < 4; ++ks) af[rt][ks] = *(const f16x8*)(QI + ((((((size_t)((t0_) >> 3) * 2 + rt) * 4 + ks) * 2 + hh) * 32 + r) << 3)); \
            _Pragma("unroll") for (int qq = 0; qq < 2; ++qq) { const float* wp = WI + (size_t)((t0_) + 4 * rt + 2 * hh + qq) * 8; const f32x4 w0 = *(const f32x4*)wp * 0.125f, w1 = *(const f32x4*)(wp + 4) * 0.125f; \
                wv2[rt][4 * qq + 0] = (f32x2){w0[0], w0[1]}; wv2[rt][4 * qq + 1] = (f32x2){w0[2], w0[3]}; wv2[rt][4 * qq + 2] = (f32x2){w1[0], w1[1]}; wv2[rt][4 * qq + 3] = (f32x2){w1[2], w1[3]}; } \
        } } while (0)
    for (int round = 0; round * nb < 256; ++round) {
        const int p = round * nb + ((round & 1) ? (nb - 1 - bid) : bid);
        if (p < 256) { const int tg = p >> 3, b_ = p & 7, t0l = tg * 8, ch_ = t0l >> 6, t0_ = b_ * NS + t0l;
            if (tid < 8 * (ch_ + 1)) { const int q = tid / (ch_ + 1), w = tid % (ch_ + 1); MASK[((size_t)b_ * 128 + w) * NS + t0l + q] = ~0ull; } }
    }
#define IDX_P(round_) ((round_) * nb + (((round_) & 1) ? (nb - 1 - bid) : bid))
    int round = 0;
    while (round * nb < 8192 && !(IDX_P(round) >= 256 && IDX_P(round) < 8192)) ++round;
    if (round * nb < 8192) { const int p0 = IDX_P(round); IDX_LOAD_FRAGS((p0 & 7) * NS + (p0 >> 3) * 8); }
    for (; round * nb < 8192; ) {
        const int p = IDX_P(round);
        int rnext = round + 1;
        while (rnext * nb < 8192 && !(IDX_P(rnext) >= 256 && IDX_P(rnext) < 8192)) ++rnext;
        const bool has_next = rnext * nb < 8192;
        const int pn = has_next ? IDX_P(rnext) : p;
        const int tg = p >> 3, b = p & 7, t0l = tg * 8, ch = t0l >> 6, nadm = 64 * (ch + 1), t0 = b * NS + t0l;
        const int t0n = (pn & 7) * NS + (pn >> 3) * 8;
        round = has_next ? rnext : 8192;
        __syncthreads();
#pragma unroll
        for (int i = 0; i < 9; ++i) if (tid + i * NTHR < 8 * IDX_HPITCH) hist[tid + i * NTHR] = 0u;
        __syncthreads();
        const int nkb = nadm >> 5;
        const f16* kbase = KI + ((size_t)(b * (NS / 32)) * 8 + hh) * 256 + r * 8;
#define IDX_LOADB(dst, kb_) do { _Pragma("unroll") for (int ks = 0; ks < 4; ++ks) dst[ks] = *(const f16x8*)(kbase + ((size_t)(kb_) * 8 + 2 * ks) * 256); } while (0)
#define IDX_BLOCK(bfrag, kb_) do { \
            f32x16 acc[2]; \
            _Pragma("unroll") for (int rt = 0; rt < 2; ++rt) { acc[rt] = (f32x16){0.f, 0.f, 0.f, 0.f, 0.f, 0.f, 0.f, 0.f, 0.f, 0.f, 0.f, 0.f, 0.f, 0.f, 0.f, 0.f}; \
                _Pragma("unroll") for (int ks = 0; ks < 4; ++ks) acc[rt] = __builtin_amdgcn_mfma_f32_32x32x16_f16(af[rt][ks], bfrag[ks], acc[rt], 0, 0, 0); } \
            _Pragma("unroll") for (int rt = 0; rt < 2; ++rt) \
                _Pragma("unroll") for (int qq = 0; qq < 2; ++qq) { \
                    f32x2 t2 = (f32x2){0.f, 0.f}; \
                    _Pragma("unroll") for (int hp = 0; hp < 4; ++hp) { const f32x2 r2 = (f32x2){__int_as_float(max(__float_as_int(acc[rt][8 * qq + 2 * hp]), 0)), __int_as_float(max(__float_as_int(acc[rt][8 * qq + 2 * hp + 1]), 0))}; \
                        t2 = __builtin_elementwise_fma(wv2[rt][4 * qq + hp], r2, t2); } \
                    const float sc = t2[0] + t2[1]; \
                    const f16 sh = (f16)sc; const unsigned bits = (unsigned)__builtin_bit_cast(unsigned short, sh); \
                    const unsigned key = (bits & 0x8000u) ? (~bits & 0xFFFFu) : (bits | 0x8000u); \
                    const int q = 4 * rt + 2 * hh + qq; \
                    if (MODE != 2) *(u16*)(lds + q * IDX_KPITCH + ((kb_) * 32 + r) * 2) = (u16)key; \
                    if (MODE != 2 && MODE != 4) atomicAdd(&hist[q * IDX_HPITCH + (key >> 7)], (key & 64u) ? 0x10000u : 1u); \
                    if (MODE == 2) sink += key; \
                } } while (0)
        f16x8 bf0[4], bf1[4], bf2[4]; unsigned sink = 0u;
        if (wave >= 4) __builtin_amdgcn_s_sleep(5);
        if (wave < nkb) IDX_LOADB(bf0, wave);
        if (wave + 8 < nkb) IDX_LOADB(bf1, wave + 8);
        if (wave + 16 < nkb) IDX_LOADB(bf2, wave + 16);
        if (MODE != 3) for (int kb = wave; kb < nkb; kb += 24) {
            IDX_BLOCK(bf0, kb);
            if (kb + 24 < nkb) IDX_LOADB(bf0, kb + 24);
            if (kb + 8 < nkb) { IDX_BLOCK(bf1, kb + 8); if (kb + 32 < nkb) IDX_LOADB(bf1, kb + 32); }
            if (kb + 16 < nkb) { IDX_BLOCK(bf2, kb + 16); if (kb + 40 < nkb) IDX_LOADB(bf2, kb + 40); }
        }
#undef IDX_LOADB
#undef IDX_BLOCK
        if (MODE == 2 && sink == 0xdeadbeefu) hist[tid] = sink;
        IDX_LOAD_FRAGS(t0n);
        __syncthreads();
        if (MODE != 1) {
            unsigned* hw = hist + wave * IDX_HPITCH;
            const unsigned char* krow = lds + wave * IDX_KPITCH;
            unsigned rem1 = 0u, rem2 = 0u;
            int b1;
            {   const u32x4 d0 = *(const u32x4*)(hw + 8 * lane), d1 = *(const u32x4*)(hw + 8 * lane + 4);
                const unsigned dd[8] = {d0.x, d0.y, d0.z, d0.w, d1.x, d1.y, d1.z, d1.w};
                unsigned cc[16];
#pragma unroll
                for (int j = 0; j < 8; ++j) { cc[2 * j] = dd[j] & 0xFFFFu; cc[2 * j + 1] = dd[j] >> 16; }
                b1 = wave_pick<16>(cc, 256u, lane, rem1); }
            hw[lane] = 0u;
            const int nit = (nadm + 511) >> 9;
            for (int it = 0; it < nit; ++it) {
                const int idx = (it * 64 + lane) * 8;
                if (idx < nadm) { const u32x4 k4 = *(const u32x4*)(krow + idx * 2);
                    const unsigned kk[4] = {k4.x, k4.y, k4.z, k4.w};
                    unsigned hit = 0u;
#pragma unroll
                    for (int j = 0; j < 4; ++j) { hit |= (((kk[j] & 0xFFFFu) >> 6) == (unsigned)b1 ? 1u : 0u) << (2 * j); hit |= ((kk[j] >> 22) == (unsigned)b1 ? 1u : 0u) << (2 * j + 1); }
                    if (hit) {
#pragma unroll
                        for (int j = 0; j < 4; ++j) { const unsigned k0 = kk[j] & 0xFFFFu, k1 = kk[j] >> 16;
                            if (hit & (1u << (2 * j))) atomicAdd(&hw[k0 & 63u], 1u);
                            if (hit & (2u << (2 * j))) atomicAdd(&hw[k1 & 63u], 1u); }
                    } }
            }
            int b2;
            { const unsigned c1[1] = {hw[lane]}; b2 = wave_pick<1>(c1, rem1, lane, rem2); }
            const unsigned tau = ((unsigned)b1 << 6) | (unsigned)b2;
            const size_t mrow = (size_t)(t0 + wave) * 128;
            for (int it = 0; it < nit; ++it) {
                const int idx = (it * 64 + lane) * 8;
                unsigned byte = 0u;
                if (idx < nadm) { const u32x4 k4 = *(const u32x4*)(krow + idx * 2);
                    const unsigned kk[4] = {k4.x, k4.y, k4.z, k4.w};
#pragma unroll
                    for (int j = 0; j < 4; ++j) { byte |= ((kk[j] & 0xFFFFu) >= tau ? 1u : 0u) << (2 * j); byte |= ((kk[j] >> 16) >= tau ? 1u : 0u) << (2 * j + 1); } }
                unsigned lo = (lane & 4) ? 0u : (byte << (8 * (lane & 3))), hi = (lane & 4) ? (byte << (8 * (lane & 3))) : 0u;
                lo |= __shfl_xor(lo, 1); hi |= __shfl_xor(hi, 1); lo |= __shfl_xor(lo, 2); hi |= __shfl_xor(hi, 2); lo |= __shfl_xor(lo, 4); hi |= __shfl_xor(hi, 4);
                if ((lane & 7) == 0 && idx < nadm) { hw[64 + 2 * (it * 8 + (lane >> 3))] = lo; hw[64 + 2 * (it * 8 + (lane >> 3)) + 1] = hi; }
            }
        }
        __syncthreads();
        if (MODE != 1) { const int w = tid >> 2, qp = tid & 3;
            if (w <= ch) { const unsigned* ha = hist + (2 * qp) * IDX_HPITCH + 64 + 2 * w; const unsigned* hb = ha + IDX_HPITCH;
                *(u32x4*)(MASK + ((size_t)b * 128 + w) * NS + t0l + 2 * qp) = (u32x4){ha[0], ha[1], hb[0], hb[1]}; } }
    }
    __syncthreads();
}

constexpr int ATP = 144;
constexpr int ATT_QWORD = 3584 + 32 * 64;
template <int AMODE>
__device__ __forceinline__ void ph4_attn_fast(const Args& a, int bid, int nb, unsigned char* lds) {
    int tid = threadIdx.x; asm volatile("" : "+v"(tid));
    const int lane = tid & 63, wave = __builtin_amdgcn_readfirstlane(tid >> 6), r = lane & 31, hh = lane >> 5;
    const f16* Q = (const f16*)(a.ws + WS_Q); const f16* Kk = (const f16*)(a.ws + WS_K); const f16* VT = (const f16*)(a.ws + WS_VT);
    const u64* MASK = (const u64*)(a.ws + WS_MASK); unsigned char* MIX8 = a.ws + WS_H; const float* og = a.in[11];
    unsigned char* Kl = lds; unsigned char* Vl = lds + 2 * 64 * ATP;
    const float LOG2E = 1.4426950408889634f, OFF = 8192.f;
    const int pir = 16 * (r >> 4) + 8 * ((r >> 2) & 1) + 4 * ((r >> 3) & 1) + (r & 3);
    const int srow = tid >> 3, schk = tid & 7;
    unsigned* aq = (unsigned*)(a.ws + WS_CTL) + ATT_QWORD;
    lds_u32* ucell = (lds_u32*)(lds + 6 * 64 * ATP);
    lds_u32* dflag = ucell + 8;
    const float kmax = __int_as_float(__builtin_amdgcn_readfirstlane(__float_as_int(1.01f * 8.f * wave_max(fabsf(a.in[10][lane])))));
    int upar = 0;
    for (;;) {
        if (tid == 0) ucell[upar] = __hip_atomic_fetch_add(aq, 1u, __ATOMIC_RELAXED, __HIP_MEMORY_SCOPE_AGENT);
        if (tid < 8) dflag[tid] = 0u;
        __syncthreads();
        const unsigned u = ucell[upar]; upar ^= 1;
        if (u >= 2048u) break;
        const int h = 7 - (int)(u >> 8), qb = 31 - (int)((u & 255u) >> 3), b = (int)(u & 7u);
        const int q0l = qb * 256, tq = q0l + 32 * wave + r, cw = 4 * qb + (wave >> 1), top = 4 * qb + 3;
        const size_t t = (size_t)b * NS + tq;
        const float slope = exp2f(-(float)(h + 1)) * LOG2E;
        f16x8 qf[4];
#pragma unroll
        for (int ks = 0; ks < 4; ++ks) { const f16x8 qv = *(const f16x8*)(Q + t * 512 + h * 64 + 16 * ks + 8 * hh);
#pragma unroll
            for (int j = 0; j < 8; ++j) qf[ks][j] = (f16)((float)qv[j] * (0.125f * LOG2E)); }
        float qss = 0.f;
#pragma unroll
        for (int ks = 0; ks < 4; ++ks)
#pragma unroll
            for (int j = 0; j < 8; ++j) qss += (float)qf[ks][j] * (float)qf[ks][j];
        qss += __shfl_xor(qss, 32);
        const float Sb = __int_as_float(__builtin_amdgcn_readfirstlane(__float_as_int(wave_max(sqrtf(qss)) * kmax)));
        const float rowc = OFF + slope * (float)(tq - q0l);
        float m = 1000.f, l = 0.f;
        f32x16 O[2];
#pragma unroll
        for (int dt = 0; dt < 2; ++dt) O[dt] = (f32x16){0.f, 0.f, 0.f, 0.f, 0.f, 0.f, 0.f, 0.f, 0.f, 0.f, 0.f, 0.f, 0.f, 0.f, 0.f, 0.f};
        const f16* kg = Kk + ((size_t)b * NS + srow) * 512 + h * 64 + schk * 8;
        const f16* vg = VT + (size_t)(h * 64 + srow) * NT + (size_t)b * NS + schk * 8;
        f16x8 kr0, kr1, vr0, vr1; u64 mw0 = 0ull, mw1 = 0ull;
#define ATT_LOAD(kr, vr, mwv, jj) do { const int jc_ = (jj) > 0 ? (jj) : 0; kr = *(const f16x8*)(kg + (size_t)jc_ * 64 * 512); vr = *(const f16x8*)(vg + jc_ * 64); \
            mwv = MASK[((size_t)b * 128 + jc_) * NS + tq]; } while (0)
        asm volatile("" ::: "memory"); ATT_LOAD(kr0, vr0, mw0, top); asm volatile("" ::: "memory"); ATT_LOAD(kr1, vr1, mw1, top - 1); asm volatile("" ::: "memory");
        int buf = 0; bool wdone = false, stop = false;
        auto step = [&](f16x8& kreg, f16x8& vreg, u64& mwr, const int j) {
            *(f16x8*)(Kl + buf * 64 * ATP + srow * ATP + schk * 16) = kreg;
            *(f16x8*)(Vl + buf * 64 * ATP + srow * ATP + schk * 16) = vreg;
            const u64 mw = (j <= cw) ? mwr : 0ull;
            asm volatile("s_waitcnt lgkmcnt(0)" ::: "memory"); __builtin_amdgcn_s_barrier(); asm volatile("" ::: "memory");
            {
                const unsigned jp = (unsigned)(j + 1);
                const unsigned d0 = dflag[0], d1 = dflag[1], d2 = dflag[2], d3 = dflag[3], d4 = dflag[4], d5 = dflag[5], d6 = dflag[6], d7 = dflag[7];
                if ((d0 > jp) & (d1 > jp) & (d2 > jp) & (d3 > jp) & (d4 > jp) & (d5 > jp) & (d6 > jp) & (d7 > jp)) { stop = true; return; }
            }
            asm volatile("" ::: "memory"); ATT_LOAD(kreg, vreg, mwr, j - 2); asm volatile("" ::: "memory");
            if (!wdone && j < cw) { const float lmax = Sb + OFF + slope * (float)(64 * j + 63 - q0l); if (__all(lmax - m < -28.f)) { wdone = true; if (lane == 0) dflag[wave] = (unsigned)(j + 1); } }
            if (j <= cw && !wdone) {
                const unsigned char* kb_ = Kl + buf * 64 * ATP + pir * ATP + 16 * hh;
                f16x8 fr8[8];
#pragma unroll
                for (int kt = 0; kt < 2; ++kt)
#pragma unroll
                    for (int ks = 0; ks < 4; ++ks) fr8[kt * 4 + ks] = *(const f16x8*)(kb_ + kt * 32 * ATP + ks * 32);
                f32x16 sa[2];
                if (j == cw) {
#pragma unroll
                    for (int kt = 0; kt < 2; ++kt)
#pragma unroll
                        for (int rg = 0; rg < 16; ++rg) { const float x = (float)(64 * j + 32 * kt + 16 * (rg >> 3) + 8 * hh + (rg & 7) - tq); sa[kt][rg] = rowc - slope * fabsf(x); }
                } else {
                    const float base = OFF + slope * (float)(64 * j + 8 * hh - q0l);
#pragma unroll
                    for (int kt = 0; kt < 2; ++kt)
#pragma unroll
                        for (int rg = 0; rg < 16; ++rg) sa[kt][rg] = __builtin_fmaf(slope, (float)(32 * kt + 16 * (rg >> 3) + (rg & 7)), base);
                }
                __builtin_amdgcn_sched_barrier(0);
                __builtin_amdgcn_s_setprio(1);
#pragma unroll
                for (int kt = 0; kt < 2; ++kt)
#pragma unroll
                    for (int ks = 0; ks < 4; ++ks) sa[kt] = __builtin_amdgcn_mfma_f32_32x32x16_f16(fr8[kt * 4 + ks], qf[ks], sa[kt], 0, 0, 0);
                __builtin_amdgcn_s_setprio(0);
                __builtin_amdgcn_sched_barrier(0);
                const unsigned char* vb_ = Vl + buf * 64 * ATP + r * ATP + 16 * hh;
#pragma unroll
                for (int dt = 0; dt < 2; ++dt)
#pragma unroll
                    for (int kt = 0; kt < 2; ++kt)
#pragma unroll
                        for (int s2 = 0; s2 < 2; ++s2) fr8[dt * 4 + kt * 2 + s2] = *(const f16x8*)(vb_ + dt * 32 * ATP + kt * 64 + s2 * 32);
                __builtin_amdgcn_sched_barrier(0);
                float rm = 0.f;
#pragma unroll
                for (int kt = 0; kt < 2; ++kt) { const unsigned w32 = (unsigned)(kt ? (mw >> 32) : mw) >> (8 * hh);
#pragma unroll
                    for (int rg = 0; rg < 16; ++rg) { const int tm = __builtin_amdgcn_sbfe((int)w32, 16 * (rg >> 3) + (rg & 7), 1);
                        const float L = __int_as_float(__float_as_int(sa[kt][rg]) & tm); sa[kt][rg] = L; rm = fmaxf(rm, L); } }
                rm = fmaxf(rm, __shfl_xor(rm, 32));
                const float mn = fmaxf(m, rm);
                if (__any(mn > m)) { const float al = __builtin_amdgcn_exp2f(m - mn); l *= al;
#pragma unroll
                    for (int dt = 0; dt < 2; ++dt)
#pragma unroll
                        for (int rg = 0; rg < 16; ++rg) O[dt][rg] *= al; }
                m = mn;
                f16x8 pf[2][2];
                float l0 = 0.f, l1 = 0.f;
#pragma unroll
                for (int kt = 0; kt < 2; ++kt)
#pragma unroll
                    for (int rg = 0; rg < 16; ++rg) { const float pp = __builtin_amdgcn_exp2f(sa[kt][rg] - m); if (rg & 1) l1 += pp; else l0 += pp; pf[kt][rg >> 3][rg & 7] = (f16)pp; }
                l += l0 + l1;
                __builtin_amdgcn_sched_barrier(0);
                __builtin_amdgcn_s_setprio(1);
#pragma unroll
                for (int dt = 0; dt < 2; ++dt)
#pragma unroll
                    for (int kt = 0; kt < 2; ++kt)
#pragma unroll
                        for (int s2 = 0; s2 < 2; ++s2) O[dt] = __builtin_amdgcn_mfma_f32_32x32x16_f16(fr8[dt * 4 + kt * 2 + s2], pf[kt][s2], O[dt], 0, 0, 0);
                __builtin_amdgcn_s_setprio(0);
            }
            buf ^= 1;
        };
        for (int j = top; j >= 0; j -= 2) {
            step(kr0, vr0, mw0, j); if (stop) break;
            step(kr1, vr1, mw1, j - 1); if (stop) break;
        }
#undef ATT_LOAD
        l += __shfl_xor(l, 32);
        const float inv = 1.f / l;
        float ss = 0.f;
#pragma unroll
        for (int dt = 0; dt < 2; ++dt)
#pragma unroll
            for (int rg = 0; rg < 16; ++rg) { O[dt][rg] *= inv; ss += O[dt][rg] * O[dt][rg]; }
        ss += __shfl_xor(ss, 32);
        const float rstd = rsqrtf(ss * (1.f / 64.f) + EPS);
#pragma unroll
        for (int dt = 0; dt < 2; ++dt)
#pragma unroll
            for (int g4 = 0; g4 < 4; ++g4) { const int d = 32 * dt + 8 * g4 + 4 * hh; const f32x4 gg = *(const f32x4*)(og + h * 64 + d);
                unsigned pk = 0u;
#pragma unroll
                for (int e = 0; e < 4; ++e) { const float sg = gg[e] > 0.f ? MIXQ : (gg[e] < 0.f ? -MIXQ : 0.f); const float qf_ = fminf(fmaxf(O[dt][4 * g4 + e] * rstd * sg, -127.f), 127.f);
                    pk |= (unsigned)((int)rintf(qf_) & 255) << (8 * e); }
                *(unsigned*)(MIX8 + t * ND + 512 + h * 64 + d) = pk; }
        __syncthreads();
    }
}

__device__ __forceinline__ void ph5_outproj(const Args& a, int bid, int nb, unsigned char* lds) {
    pg8::Gemm g{(const f16*)(a.ws + WS_H), (const f16*)(a.ws + WS_WOUT8), NT, 1024, ND / 2}; pg8::StaticOrder S; S.init(NT, 1024, nb, bid);
    pg8::EpiOut E{a.in[0], (const float*)(a.ws + WS_MOD), (f16*)(a.ws + WS_X1), (const float*)(a.ws + WS_WSCIN) + 4096};
    pg8::gemm_phase<pg8::EpiOut, true>((PG8_LAS unsigned char*)lds, g, S, E);
}

__device__ __forceinline__ void ph7_peerq(const Args& a, int bid, int nb, unsigned char* lds) {
    pg8::Gemm g{(const f16*)(a.ws + WS_HQ), (const f16*)(a.ws + WS_WQ8), NT, 2048, ND / 2}; pg8::StaticOrder S; S.init(NT, 2048, nb, bid);
    pg8::EpiPQ E{(f16*)(a.ws + WS_PQ), (const float*)(a.ws + WS_HSC), (const float*)(a.ws + WS_WSC)};
    pg8::gemm_phase<pg8::EpiPQ, true>((PG8_LAS unsigned char*)lds, g, S, E);
}


__device__ __forceinline__ unsigned f2skey(float f) { const unsigned u = __float_as_uint(f); return (u & 0x80000000u) ? ~u : (u | 0x80000000u); }
__device__ __forceinline__ float skey2f(unsigned k) { return __uint_as_float((k & 0x80000000u) ? (k & 0x7FFFFFFFu) : ~k); }
#define CE_(a_, b_) do { const unsigned t__ = max(a_, b_); b_ = min(a_, b_); a_ = t__; } while (0)
#define SORT16_DESC(v) do { CE_(v[0], v[1]); CE_(v[2], v[3]); CE_(v[0], v[2]); CE_(v[1], v[3]); CE_(v[1], v[2]); CE_(v[4], v[5]); CE_(v[6], v[7]); CE_(v[4], v[6]); CE_(v[5], v[7]); CE_(v[5], v[6]); CE_(v[0], v[4]); CE_(v[2], v[6]); CE_(v[2], v[4]); CE_(v[1], v[5]); CE_(v[3], v[7]); CE_(v[3], v[5]); CE_(v[1], v[2]); CE_(v[3], v[4]); CE_(v[5], v[6]); CE_(v[8], v[9]); CE_(v[10], v[11]); CE_(v[8], v[10]); CE_(v[9], v[11]); CE_(v[9], v[10]); CE_(v[12], v[13]); CE_(v[14], v[15]); CE_(v[12], v[14]); CE_(v[13], v[15]); CE_(v[13], v[14]); CE_(v[8], v[12]); CE_(v[10], v[14]); CE_(v[10], v[12]); CE_(v[9], v[13]); CE_(v[11], v[15]); CE_(v[11], v[13]); CE_(v[9], v[10]); CE_(v[11], v[12]); CE_(v[13], v[14]); CE_(v[0], v[8]); CE_(v[4], v[12]); CE_(v[4], v[8]); CE_(v[2], v[10]); CE_(v[6], v[14]); CE_(v[6], v[10]); CE_(v[2], v[4]); CE_(v[6], v[8]); CE_(v[10], v[12]); CE_(v[1], v[9]); CE_(v[5], v[13]); CE_(v[5], v[9]); CE_(v[3], v[11]); CE_(v[7], v[15]); CE_(v[7], v[11]); CE_(v[3], v[5]); CE_(v[7], v[9]); CE_(v[11], v[13]); CE_(v[1], v[2]); CE_(v[3], v[4]); CE_(v[5], v[6]); CE_(v[7], v[8]); CE_(v[9], v[10]); CE_(v[11], v[12]); CE_(v[13], v[14]); } while (0)
#define BITONIC16_DESC(v) do { CE_(v[0], v[8]); CE_(v[1], v[9]); CE_(v[2], v[10]); CE_(v[3], v[11]); CE_(v[4], v[12]); CE_(v[5], v[13]); CE_(v[6], v[14]); CE_(v[7], v[15]); CE_(v[0], v[4]); CE_(v[1], v[5]); CE_(v[2], v[6]); CE_(v[3], v[7]); CE_(v[8], v[12]); CE_(v[9], v[13]); CE_(v[10], v[14]); CE_(v[11], v[15]); CE_(v[0], v[2]); CE_(v[1], v[3]); CE_(v[4], v[6]); CE_(v[5], v[7]); CE_(v[8], v[10]); CE_(v[9], v[11]); CE_(v[12], v[14]); CE_(v[13], v[15]); CE_(v[0], v[1]); CE_(v[2], v[3]); CE_(v[4], v[5]); CE_(v[6], v[7]); CE_(v[8], v[9]); CE_(v[10], v[11]); CE_(v[12], v[13]); CE_(v[14], v[15]); } while (0)
#define MERGE16_DESC(dst, other) do { unsigned c__[16]; _Pragma("unroll") for (int i__ = 0; i__ < 16; ++i__) c__[i__] = max(dst[i__], other[15 - i__]); BITONIC16_DESC(c__); _Pragma("unroll") for (int i__ = 0; i__ < 16; ++i__) dst[i__] = c__[i__]; } while (0)
#define TOP16_INSERT(v, x_) do { unsigned x__ = (x_); _Pragma("unroll") for (int k_ = 0; k_ < 16; ++k_) { const unsigned t__ = max(v[k_], x__); x__ = min(v[k_], x__); v[k_] = t__; } } while (0)
__device__ __forceinline__ void ph8_peersel_fast(const Args& a, int bid, int nb, unsigned char* lds) {
    int tid = threadIdx.x; asm volatile("" : "+v"(tid));
    const int lane = tid & 63, wave = __builtin_amdgcn_readfirstlane(tid >> 6), r = lane & 31, hh = lane >> 5;
    const f16* PQ = (const f16*)(a.ws + WS_PQ);
    u16* EID = (u16*)(a.ws + WS_EID); float* GW = (float*)(a.ws + WS_GW);
    unsigned char* wl = lds + wave * 2048 + lane * 32;
    for (int item = bid * NWAVE + wave; item < (NT / 32) * 8; item += nb * NWAVE) {
        const int tt = item >> 3, h = item & 7, t0 = tt * 32;
        unsigned top[2][16];
#pragma unroll
        for (int p = 0; p < 2; ++p) {
            f16x8 sq[8];
#pragma unroll
            for (int c = 0; c < 8; ++c) sq[c] = *(const f16x8*)(PQ + ((((size_t)tt * 256 + h * 32 + p * 16 + 8 * hh + c) * 32 + r) << 3));
#pragma unroll
            for (int k = 0; k < 16; ++k) top[p][k] = 0u;
#pragma unroll
            for (int g = 0; g < 4; ++g) {
                unsigned ky[16];
#pragma unroll
                for (int i = 0; i < 16; ++i) { const unsigned n = 64u * hh + 16u * g + i; ky[i] = (f2skey((float)sq[2 * g + (i >> 3)][i & 7]) & ~127u) | n; }
                SORT16_DESC(ky); MERGE16_DESC(top[p], ky);
            }
            unsigned oth[16];
#pragma unroll
            for (int k = 0; k < 16; ++k) oth[k] = __shfl_xor(top[p][k], 32);
            MERGE16_DESC(top[p], oth);
            asm volatile("" ::: "memory");
        }
#pragma unroll
        for (int k = 0; k < 16; k += 4) {
            *(unsigned*)(wl + k) = (top[0][k] & 127u) | ((top[0][k + 1] & 127u) << 8) | ((top[0][k + 2] & 127u) << 16) | ((top[0][k + 3] & 127u) << 24);
            *(unsigned*)(wl + 16 + k) = (top[1][k] & 127u) | ((top[1][k + 1] & 127u) << 8) | ((top[1][k + 2] & 127u) << 16) | ((top[1][k + 3] & 127u) << 24);
        }
        float fa[16], fb[16];
#pragma unroll
        for (int k = 0; k < 16; ++k) { fa[k] = skey2f(top[0][k] & ~127u); fb[k] = skey2f(top[1][k] & ~127u); }
        unsigned cg[4][16];
        cg[0][0] = (f2skey(fa[0] + fb[0]) & ~255u) | 0u;
        cg[0][1] = (f2skey(fa[0] + fb[1]) & ~255u) | 1u;
        cg[0][2] = (f2skey(fa[0] + fb[2]) & ~255u) | 2u;
        cg[0][3] = (f2skey(fa[0] + fb[3]) & ~255u) | 3u;
        cg[0][4] = (f2skey(fa[0] + fb[4]) & ~255u) | 4u;
        cg[0][5] = (f2skey(fa[0] + fb[5]) & ~255u) | 5u;
        cg[0][6] = (f2skey(fa[0] + fb[6]) & ~255u) | 6u;
        cg[0][7] = (f2skey(fa[0] + fb[7]) & ~255u) | 7u;
        cg[0][8] = (f2skey(fa[0] + fb[8]) & ~255u) | 8u;
        cg[0][9] = (f2skey(fa[0] + fb[9]) & ~255u) | 9u;
        cg[0][10] = (f2skey(fa[0] + fb[10]) & ~255u) | 10u;
        cg[0][11] = (f2skey(fa[0] + fb[11]) & ~255u) | 11u;
        cg[0][12] = (f2skey(fa[0] + fb[12]) & ~255u) | 12u;
        cg[0][13] = (f2skey(fa[0] + fb[13]) & ~255u) | 13u;
        cg[0][14] = (f2skey(fa[0] + fb[14]) & ~255u) | 14u;
        cg[0][15] = (f2skey(fa[0] + fb[15]) & ~255u) | 15u;
        cg[1][0] = (f2skey(fa[1] + fb[0]) & ~255u) | 16u;
        cg[1][1] = (f2skey(fa[1] + fb[1]) & ~255u) | 17u;
        cg[1][2] = (f2skey(fa[1] + fb[2]) & ~255u) | 18u;
        cg[1][3] = (f2skey(fa[1] + fb[3]) & ~255u) | 19u;
        cg[1][4] = (f2skey(fa[1] + fb[4]) & ~255u) | 20u;
        cg[1][5] = (f2skey(fa[1] + fb[5]) & ~255u) | 21u;
        cg[1][6] = (f2skey(fa[1] + fb[6]) & ~255u) | 22u;
        cg[1][7] = (f2skey(fa[1] + fb[7]) & ~255u) | 23u;
        cg[1][8] = (f2skey(fa[2] + fb[0]) & ~255u) | 32u;
        cg[1][9] = (f2skey(fa[2] + fb[1]) & ~255u) | 33u;
        cg[1][10] = (f2skey(fa[2] + fb[2]) & ~255u) | 34u;
        cg[1][11] = (f2skey(fa[2] + fb[3]) & ~255u) | 35u;
        cg[1][12] = (f2skey(fa[2] + fb[4]) & ~255u) | 36u;
        cg[1][13] = (f2skey(fa[3] + fb[0]) & ~255u) | 48u;
        cg[1][14] = (f2skey(fa[3] + fb[1]) & ~255u) | 49u;
        cg[1][15] = (f2skey(fa[3] + fb[2]) & ~255u) | 50u;
        cg[2][0] = (f2skey(fa[3] + fb[3]) & ~255u) | 51u;
        cg[2][1] = (f2skey(fa[4] + fb[0]) & ~255u) | 64u;
        cg[2][2] = (f2skey(fa[4] + fb[1]) & ~255u) | 65u;
        cg[2][3] = (f2skey(fa[4] + fb[2]) & ~255u) | 66u;
        cg[2][4] = (f2skey(fa[5] + fb[0]) & ~255u) | 80u;
        cg[2][5] = (f2skey(fa[5] + fb[1]) & ~255u) | 81u;
        cg[2][6] = (f2skey(fa[6] + fb[0]) & ~255u) | 96u;
        cg[2][7] = (f2skey(fa[6] + fb[1]) & ~255u) | 97u;
        cg[2][8] = (f2skey(fa[7] + fb[0]) & ~255u) | 112u;
        cg[2][9] = (f2skey(fa[7] + fb[1]) & ~255u) | 113u;
        cg[2][10] = (f2skey(fa[8] + fb[0]) & ~255u) | 128u;
        cg[2][11] = (f2skey(fa[9] + fb[0]) & ~255u) | 144u;
        cg[2][12] = (f2skey(fa[10] + fb[0]) & ~255u) | 160u;
        cg[2][13] = (f2skey(fa[11] + fb[0]) & ~255u) | 176u;
        cg[2][14] = (f2skey(fa[12] + fb[0]) & ~255u) | 192u;
        cg[2][15] = (f2skey(fa[13] + fb[0]) & ~255u) | 208u;
        cg[3][0] = (f2skey(fa[14] + fb[0]) & ~255u) | 224u;
        cg[3][1] = (f2skey(fa[15] + fb[0]) & ~255u) | 240u;
        cg[3][2] = 0u;
        cg[3][3] = 0u;
        cg[3][4] = 0u;
        cg[3][5] = 0u;
        cg[3][6] = 0u;
        cg[3][7] = 0u;
        cg[3][8] = 0u;
        cg[3][9] = 0u;
        cg[3][10] = 0u;
        cg[3][11] = 0u;
        cg[3][12] = 0u;
        cg[3][13] = 0u;
        cg[3][14] = 0u;
        cg[3][15] = 0u;
        SORT16_DESC(cg[0]); SORT16_DESC(cg[1]); SORT16_DESC(cg[2]); SORT16_DESC(cg[3]);
        MERGE16_DESC(cg[0], cg[1]); MERGE16_DESC(cg[2], cg[3]); MERGE16_DESC(cg[0], cg[2]);
        unsigned ct[16];
#pragma unroll
        for (int k = 0; k < 16; ++k) ct[k] = cg[0][k];
        float sc[16]; float den = 0.f; const float s0 = skey2f(ct[0] & ~255u);
#pragma unroll
        for (int k = 0; k < 16; ++k) { sc[k] = __expf(skey2f(ct[k] & ~255u) - s0); den += sc[k]; }
        const float inv = 1.f / den;
        if (hh == 0) {
            u16 ev[16];
#pragma unroll
            for (int k = 0; k < 16; ++k) { const unsigned ij = ct[k] & 255u; const unsigned i1 = wl[ij >> 4], i2 = wl[16 + (ij & 15u)]; ev[k] = (u16)(i1 * 128u + i2); }
            const size_t o = (size_t)(t0 + r) * 128 + h * 16;
#pragma unroll
            for (int k = 0; k < 16; k += 8) {
                *(u32x4*)(EID + o + k) = (u32x4){(unsigned)ev[k] | ((unsigned)ev[k + 1] << 16), (unsigned)ev[k + 2] | ((unsigned)ev[k + 3] << 16), (unsigned)ev[k + 4] | ((unsigned)ev[k + 5] << 16), (unsigned)ev[k + 6] | ((unsigned)ev[k + 7] << 16)};
            }
#pragma unroll
            for (int k = 0; k < 16; k += 4) *(f32x4*)(GW + o + k) = (f32x4){sc[k] * inv, sc[k + 1] * inv, sc[k + 2] * inv, sc[k + 3] * inv};
        }
    }
}

typedef _Float16 f16x2 __attribute__((ext_vector_type(2)));
__device__ __forceinline__ float gelu_erf(float d) { return 0.5f * d * (1.f + erff(d * 0.70710678118654752f)); }
constexpr int PQ_WORD0 = 3584, PQ_CHUNK = 64, PQ_NCHUNK = NT / PQ_CHUNK, PQ_HALF = PQ_NCHUNK / 2;
constexpr size_t WS_PART = 208 * MiB;
__device__ __forceinline__ unsigned xcc_id_() { return (unsigned)__builtin_amdgcn_s_getreg((3 << 11) | 20) & 7u; }
template <int VPHASE>
__device__ __forceinline__ void ph9_sliced(const Args& a, unsigned char* lds) {
    int tid_ = threadIdx.x; asm volatile("" : "+v"(tid_)); const int lane = tid_ & 63, wave = __builtin_amdgcn_readfirstlane(tid_ >> 6);
    const int g8 = lane >> 3, c8 = lane & 7;
    const unsigned char* HP = a.ws + WS_HP; const float* HSC = (const float*)(a.ws + WS_HSC); const unsigned char* TAB = a.ws + (VPHASE ? WS_VP : WS_UT);
    const u16* EID = (const u16*)(a.ws + WS_EID); const unsigned* GW = (const unsigned*)(a.ws + WS_GW); float* PART = (float*)(a.ws + WS_PART); const float* WSUM = (const float*)(a.ws + WS_WSUM);
    const float* mod = (const float*)(a.ws + WS_MOD); float* out = a.out; const f16* X1 = (const f16*)(a.ws + WS_X1);
    unsigned* qw = (unsigned*)(a.ws + WS_CTL) + PQ_WORD0 + (VPHASE ? 8 * 64 : 0);
    volatile unsigned* cslot = (volatile unsigned*)lds;
    const bool b5 = (lane & 32) != 0, b4 = (lane & 16) != 0, b3 = (lane & 8) != 0, b2 = (lane & 4) != 0, b1 = (lane & 2) != 0, b0 = (lane & 1) != 0;
    const unsigned x0 = xcc_id_();
    int par = 0;
    for (int k = 0; k < 8; ++k) {
        const unsigned qi_ = (x0 + (unsigned)k) & 7u, sl = qi_ & 3u, half = qi_ >> 2;
        unsigned cur = 0u;
        if (tid_ == 0) cur = __hip_atomic_fetch_add(qw + 64 * qi_, 1u, __ATOMIC_RELAXED, __HIP_MEMORY_SCOPE_AGENT);
        for (;;) {
            if (tid_ == 0) cslot[par] = cur;
            __syncthreads();
            const unsigned c = cslot[par]; par ^= 1;
            if (c >= (unsigned)PQ_HALF) break;
            if (tid_ == 0) cur = __hip_atomic_fetch_add(qw + 64 * qi_, 1u, __ATOMIC_RELAXED, __HIP_MEMORY_SCOPE_AGENT);
            const int tb = (int)(half * PQ_HALF + c) * PQ_CHUNK + wave * (PQ_CHUNK / NWAVE);
            const unsigned char* tsl = TAB + 128 * sl + 16 * c8;
#pragma unroll 1
            for (int i8 = 0; i8 < PQ_CHUNK / NWAVE; ++i8) {
                const int t = tb + i8;
                const u32x4 e0 = *(const u32x4*)(EID + (size_t)t * 128 + 16 * g8), e1 = *(const u32x4*)(EID + (size_t)t * 128 + 16 * g8 + 8);
                const unsigned ew[8] = {e0.x, e0.y, e0.z, e0.w, e1.x, e1.y, e1.z, e1.w};
                u32x4 r8[16];
#pragma unroll
                for (int i = 0; i < 16; ++i) { const unsigned eid = (i & 1) ? (ew[i >> 1] >> 16) : (ew[i >> 1] & 0xFFFFu); r8[i] = *(const u32x4*)(tsl + (size_t)eid * 512); }
                if (!VPHASE) {
                    const u32x4 hh4 = *(const u32x4*)(HP + (size_t)t * 1024 + 128 * sl + 16 * c8), hl4 = *(const u32x4*)(HP + (size_t)t * 1024 + 512 + 128 * sl + 16 * c8);
                    const float hsc = 0.5f * HSC[t];
                    int hs1 = 0, hs0 = 0;
#pragma unroll
                    for (int j = 0; j < 4; ++j) { hs1 = __builtin_amdgcn_sdot8((int)hh4[j], 0x11111111, hs1, false); hs0 = __builtin_amdgcn_sdot8((int)hl4[j], 0x11111111, hs0, false); }
                    const int hsum = 16 * hs1 + hs0;
                    float p[16];
#pragma unroll
                    for (int i = 0; i < 16; ++i) { int d1 = 0, d0 = 0;
#pragma unroll
                        for (int j = 0; j < 4; ++j) { d1 = __builtin_amdgcn_sdot8((int)hh4[j], (int)r8[i][j], d1, false); d0 = __builtin_amdgcn_sdot8((int)hl4[j], (int)r8[i][j], d0, false); }
                        p[i] = (float)(2 * (16 * d1 + d0) + hsum); }
                    float q8[8], q4[4], r2[2];
#pragma unroll
                    for (int ii = 0; ii < 8; ++ii) { const float keep = b2 ? p[8 + ii] : p[ii], send = b2 ? p[ii] : p[8 + ii]; q8[ii] = keep + __shfl_xor(send, 4); }
#pragma unroll
                    for (int ii = 0; ii < 4; ++ii) { const float keep = b1 ? q8[4 + ii] : q8[ii], send = b1 ? q8[ii] : q8[4 + ii]; q4[ii] = keep + __shfl_xor(send, 2); }
#pragma unroll
                    for (int ii = 0; ii < 2; ++ii) { const float keep = b0 ? q4[2 + ii] : q4[ii], send = b0 ? q4[ii] : q4[2 + ii]; r2[ii] = keep + __shfl_xor(send, 1); }
                    *(f32x2*)(PART + ((size_t)sl * NT + t) * 128 + 16 * g8 + 2 * c8) = (f32x2){r2[0] * hsc, r2[1] * hsc};
                } else {
                    const u32x4* wp = (const u32x4*)(GW + (size_t)t * 128 + 16 * g8);
                    const u32x4 wq0 = wp[0], wq1 = wp[1], wq2 = wp[2], wq3 = wp[3];
                    const unsigned wv[16] = {wq0[0], wq0[1], wq0[2], wq0[3], wq1[0], wq1[1], wq1[2], wq1[3], wq2[0], wq2[1], wq2[2], wq2[3], wq3[0], wq3[1], wq3[2], wq3[3]};
                    const f16 off = (f16)(-7.5f * 5.9604644775390625e-08f * WSUM[(size_t)t * 8 + g8]);
                    f16x2 acc2[16];
#pragma unroll
                    for (int j = 0; j < 16; ++j) acc2[j] = (f16x2){off, off};
#pragma unroll
                    for (int i = 0; i < 16; ++i) { const f16x2 wa = __builtin_bit_cast(f16x2, wv[i]); const f16x2 wb = wa * (f16x2){(f16)0.0625f, (f16)0.0625f};
#pragma unroll
                        for (int j = 0; j < 4; ++j) { const unsigned x = r8[i][j], y = x >> 8;
                            acc2[4 * j]     = __builtin_elementwise_fma(wa, __builtin_bit_cast(f16x2, x & 0x000F000Fu), acc2[4 * j]);
                            acc2[4 * j + 1] = __builtin_elementwise_fma(wb, __builtin_bit_cast(f16x2, x & 0x00F000F0u), acc2[4 * j + 1]);
                            acc2[4 * j + 2] = __builtin_elementwise_fma(wa, __builtin_bit_cast(f16x2, y & 0x000F000Fu), acc2[4 * j + 2]);
                            acc2[4 * j + 3] = __builtin_elementwise_fma(wb, __builtin_bit_cast(f16x2, y & 0x00F000F0u), acc2[4 * j + 3]); } }
                    unsigned q8[8], q4[4], r2[2];
#pragma unroll
                    for (int ii = 0; ii < 8; ++ii) { const unsigned lo_ = __builtin_bit_cast(unsigned, acc2[ii]), hi_ = __builtin_bit_cast(unsigned, acc2[8 + ii]); const unsigned keep = b5 ? hi_ : lo_, send = b5 ? lo_ : hi_;
                        q8[ii] = __builtin_bit_cast(unsigned, __builtin_bit_cast(f16x2, keep) + __builtin_bit_cast(f16x2, (unsigned)__shfl_xor((int)send, 32))); }
#pragma unroll
                    for (int ii = 0; ii < 4; ++ii) { const unsigned keep = b4 ? q8[4 + ii] : q8[ii], send = b4 ? q8[ii] : q8[4 + ii];
                        q4[ii] = __builtin_bit_cast(unsigned, __builtin_bit_cast(f16x2, keep) + __builtin_bit_cast(f16x2, (unsigned)__shfl_xor((int)send, 16))); }
#pragma unroll
                    for (int ii = 0; ii < 2; ++ii) { const unsigned keep = b3 ? q4[2 + ii] : q4[ii], send = b3 ? q4[ii] : q4[2 + ii];
                        r2[ii] = __builtin_bit_cast(unsigned, __builtin_bit_cast(f16x2, keep) + __builtin_bit_cast(f16x2, (unsigned)__shfl_xor((int)send, 8))); }
                    const f16x2 ra = __builtin_bit_cast(f16x2, r2[0]), rb = __builtin_bit_cast(f16x2, r2[1]);
                    const int ch = 256 * sl + 32 * c8 + (b5 ? 16 : 0) + (b4 ? 8 : 0) + (b3 ? 2 : 0);
                    float* op = out + (size_t)t * ND + ch; const float* g2 = mod + (t / NS) * 6144 + 5120 + ch; const f16* xp = X1 + (size_t)t * ND + ch;
                    const f16x2 xa = *(const f16x2*)xp, xb = *(const f16x2*)(xp + 4); const f32x2 ga = *(const f32x2*)g2, gb = *(const f32x2*)(g2 + 4);
                    const float sc_ = 16777216.f / PEER_WSCALE;
                    *(f32x2*)op = (f32x2){(float)xa[0] + ga[0] * ((float)ra[0] * sc_), (float)xa[1] + ga[1] * ((float)rb[0] * sc_)};
                    *(f32x2*)(op + 4) = (f32x2){(float)xb[0] + gb[0] * ((float)ra[1] * sc_), (float)xb[1] + gb[1] * ((float)rb[1] * sc_)};
                }
            }
        }
    }
}
__device__ __forceinline__ void ph9b_combine(const Args& a, int bid, int nb) {
    int tid_ = threadIdx.x; asm volatile("" : "+v"(tid_));
    float* GW = (float*)(a.ws + WS_GW); const float* PART = (const float*)(a.ws + WS_PART);
    const float du = ((const float*)(a.ws + WS_QS))[0], dv = ((const float*)(a.ws + WS_QS))[1] * PEER_WSCALE;
    const size_t istep = (size_t)nb * NTHR, itot = (size_t)NT * 128 / 4;
    size_t i = (size_t)bid * NTHR + tid_;
#define PQ9B_ONE(sum_, g_, ii_) do { f32x4 w; \
        _Pragma("unroll") for (int j = 0; j < 4; ++j) w[j] = fminf(fmaxf(g_[j] * gelu_erf(sum_[j] * du) * dv, -60000.f), 60000.f);        \
          \
        float ws_ = 0.f; u32x4 pk; \
        _Pragma("unroll") for (int j = 0; j < 4; ++j) { const f16 hw_ = (f16)w[j]; ws_ += (float)hw_; pk[j] = (unsigned)__builtin_bit_cast(unsigned short, hw_) * 0x10001u; } \
        ((u32x4*)GW)[ii_] = pk; \
        ws_ += __shfl_xor(ws_, 1); ws_ += __shfl_xor(ws_, 2); \
        if ((tid_ & 3) == 0) ((float*)(a.ws + WS_WSUM))[(ii_) >> 2] = ws_; } while (0)
    for (; i + istep < itot; i += 2 * istep) {
        f32x4 s0 = ((const f32x4*)PART)[i], s1 = ((const f32x4*)PART)[i + istep];
#pragma unroll
        for (int sidx = 1; sidx < 4; ++sidx) { s0 += ((const f32x4*)(PART + (size_t)sidx * NT * 128))[i]; s1 += ((const f32x4*)(PART + (size_t)sidx * NT * 128))[i + istep]; }
        const f32x4 g0 = ((const f32x4*)GW)[i], g1 = ((const f32x4*)GW)[i + istep];
        PQ9B_ONE(s0, g0, i); PQ9B_ONE(s1, g1, i + istep);
    }
    for (; i < itot; i += istep) {
        f32x4 s0 = ((const f32x4*)PART)[i];
#pragma unroll
        for (int sidx = 1; sidx < 4; ++sidx) s0 += ((const f32x4*)(PART + (size_t)sidx * NT * 128))[i];
        const f32x4 g0 = ((const f32x4*)GW)[i];
        PQ9B_ONE(s0, g0, i);
    }
#undef PQ9B_ONE
}

#define LAS __attribute__((address_space(3)))
#define XB_TMO      128
#define XB_XCNT(j)  (256  + 64 * (j))
#define XB_XSUB(j)  (1280 + 64 * (j))
#define XB_XGEN(j)  (2304 + 64 * (j))
#define XB_TOP      3328
#define XB_TOPGEN   3392
#define XCD_BAR_WORDS 3456
#define XB_SPIN_CAP (1u << 18)
__device__ __forceinline__ unsigned xb_ld(unsigned* p)              { return __hip_atomic_load(p, __ATOMIC_RELAXED, __HIP_MEMORY_SCOPE_AGENT); }
__device__ __forceinline__ unsigned xb_add(unsigned* p, unsigned v) { return __hip_atomic_fetch_add(p, v, __ATOMIC_RELAXED, __HIP_MEMORY_SCOPE_AGENT); }
__device__ __forceinline__ unsigned xb_xcc_id() { return (unsigned)__builtin_amdgcn_s_getreg((3 << 11) | 20) & 0xFu; }
#define XB_SPIN(cond, bar) do { unsigned _sp = 0; while (cond) { __builtin_amdgcn_s_sleep(1); \
    if ((++_sp & 255u) == 0u) { if (xb_ld(&(bar)[XB_TMO])) break; if (_sp > XB_SPIN_CAP) { atomicAdd(&(bar)[XB_TMO], 1u); break; } } } } while (0)
struct XcdBarrier { unsigned* bar; unsigned x; volatile LAS unsigned* st; };
__device__ __forceinline__ XcdBarrier xcd_barrier_post(unsigned* bar, volatile LAS unsigned* st) {
    XcdBarrier b; b.bar = bar; b.x = xb_xcc_id(); b.st = st;
    if (threadIdx.x == 0) (void)xb_add(&bar[XB_XCNT(b.x)], 1u);
    return b;
}
__device__ __forceinline__ void xcd_barrier_complete(unsigned* bar, unsigned x, unsigned& nloc, unsigned& nx) {
    const unsigned G = gridDim.x * gridDim.y * gridDim.z;
    unsigned sum, cnt, mine, sp = 0u;
    for (;;) {
        sum = 0u; cnt = 0u; mine = 0u;
#pragma unroll
        for (unsigned j = 0; j < 16; ++j) { const unsigned c = xb_ld(&bar[XB_XCNT(j)]); sum += c; cnt += (c > 0u) ? 1u : 0u; mine = (j == x) ? c : mine; }
        if (sum == G) break;
        __builtin_amdgcn_s_sleep(1);
        if ((++sp & 255u) == 0u) { if (xb_ld(&bar[XB_TMO])) break; if (sp > XB_SPIN_CAP) { atomicAdd(&bar[XB_TMO], 1u); break; } }
    }
    nloc = mine > 0u ? mine : 1u; nx = cnt > 0u ? cnt : 1u;
}
__device__ __forceinline__ void xcd_barrier(const XcdBarrier& b) {
    asm volatile("s_waitcnt vmcnt(0)" ::: "memory");
    __syncthreads();
    if (threadIdx.x == 0) {
        unsigned* bar = b.bar;
        __builtin_amdgcn_s_waitcnt(0);
        unsigned nloc = b.st[0], nx = b.st[1];
        if (nloc == 0u) { xcd_barrier_complete(bar, b.x, nloc, nx); b.st[0] = nloc; b.st[1] = nx; }
        const unsigned old = xb_add(&bar[XB_XSUB(b.x)], 1u);
        const unsigned gen = old / nloc;
        if (old + 1u == (gen + 1u) * nloc) {
            __builtin_amdgcn_fence(__ATOMIC_RELEASE, "agent");
            asm volatile("s_waitcnt vmcnt(0)" ::: "memory");
            const unsigned og = xb_add(&bar[XB_TOP], 1u);
            const unsigned tg = og / nx;
            if (og + 1u == (tg + 1u) * nx) xb_add(&bar[XB_TOPGEN], 1u);
            else XB_SPIN(xb_ld(&bar[XB_TOPGEN]) == tg, bar);
            __builtin_amdgcn_fence(__ATOMIC_ACQUIRE, "agent");
            xb_add(&bar[XB_XGEN(b.x)], 1u);
            asm volatile("s_waitcnt vmcnt(0)" ::: "memory");
        } else {
            XB_SPIN(xb_ld(&bar[XB_XGEN(b.x)]) == gen, bar);
            __builtin_amdgcn_fence(__ATOMIC_ACQUIRE, "agent");
            asm volatile("s_waitcnt vmcnt(0)" ::: "memory");
        }
    }
    __syncthreads();
}

constexpr int N_PHASES = 12;
__global__ void __launch_bounds__(NTHR, 2) mk_fwd(Args a) {
    extern __shared__ __attribute__((aligned(16))) unsigned char lds[];
    cg::grid_group grid = cg::this_grid();
    const int bid = blockIdx.x, nb = gridDim.x;
    const int lo = a.ph_lo, hi = a.ph_hi;
    volatile LAS unsigned* bst = (volatile LAS unsigned*)((LAS unsigned char*)lds + (LDS_BYTES - 16));
    if (threadIdx.x < 4) bst[threadIdx.x] = 0u;
    __syncthreads();
    XcdBarrier xbar = xcd_barrier_post((unsigned*)(a.ws + WS_CTL), bst);
#define SEAM(k) do { if ((k) == 0) grid.sync(); else xcd_barrier(xbar); } while (0)
#define PHASE(k, body) if (lo <= (k) && (k) < hi) { body; if ((k) + 1 < hi) SEAM(k); }
    PHASE(0, ph0_prologue(a, bid, nb, lds))
    PHASE(1, row_norm_mod(a.in[0], a.in[4], (const float*)(a.ws + WS_MOD), 0, 1024, (f16*)(a.ws + WS_H), a.ws + WS_H8, (float*)(a.ws + WS_H8 + 64 * MiB), bid, nb); wq_to_int8((const f16*)(a.ws + WS_WQ), a.ws + WS_WQ8, (float*)(a.ws + WS_WSC), 2048, bid, nb); wq_to_int8((const f16*)(a.ws + WS_WIN), a.ws + WS_WIN8, (float*)(a.ws + WS_WSCIN), 1536, bid, nb); wq_to_int8((const f16*)(a.ws + WS_WVT), a.ws + WS_WVT8, (float*)(a.ws + WS_WSCIN) + 1536, 512, bid, nb); wq_to_int8((const f16*)(a.ws + WS_WOUT), a.ws + WS_WOUT8, (float*)(a.ws + WS_WSCIN) + 4096, 1024, bid, nb, a.in[8], a.in[11]))
    PHASE(2, ph2_inproj(a, bid, nb, lds))
    PHASE(3, ph3_pool_fast(a, bid, nb, lds); ph3_index_fast<0>(a, bid, nb, lds))
    PHASE(4, ph4_attn_fast<0>(a, bid, nb, lds))
    PHASE(5, ph5_outproj(a, bid, nb, lds))
    PHASE(6, row_norm_mod_q((const f16*)(a.ws + WS_X1), a.in[13], (const float*)(a.ws + WS_MOD), 3072, 4096, a.ws + WS_HQ, (unsigned*)(a.ws + WS_HP), (float*)(a.ws + WS_HSC), bid, nb))
    PHASE(7, ph7_peerq(a, bid, nb, lds))
    PHASE(8, ph8_peersel_fast(a, bid, nb, lds))
    PHASE(9, ph9_sliced<0>(a, lds))
    PHASE(10, ph9b_combine(a, bid, nb))
    PHASE(11, ph9_sliced<1>(a, lds))
#undef PHASE
}

extern "C" void kernel_launch(void* const* d_in, const int* in_sizes, int n_in, void* d_out, int out_size, void* d_ws, size_t ws_size, hipStream_t stream) {
    static int grid = 0;
    if (grid == 0) {
        if (n_in != 18 || out_size != NT * ND || ws_size < WS_END) { fprintf(stderr, "kernel_launch: unexpected shapes (n_in %d out %d ws %zu)\n", n_in, out_size, ws_size); grid = -1; return; }
        int dev = 0, cus = 0, per_cu = 0;
        hipGetDevice(&dev); hipDeviceGetAttribute(&cus, hipDeviceAttributeMultiprocessorCount, dev);
        hipFuncSetAttribute((const void*)mk_fwd, hipFuncAttributeMaxDynamicSharedMemorySize, LDS_BYTES);
        hipOccupancyMaxActiveBlocksPerMultiprocessor(&per_cu, (const void*)mk_fwd, NTHR, LDS_BYTES);
        if (per_cu < 1) { fprintf(stderr, "kernel_launch: occupancy query says %d blocks/CU\n", per_cu); per_cu = 1; }
        grid = cus * 1;
        (void)hipGetLastError();
    }
    if (grid < 0) return;
    if (hipMemsetAsync((char*)d_ws + WS_CTL, 0, 32768, stream) != hipSuccess) { fprintf(stderr, "kernel_launch: memset of the barrier words failed\n"); return; }
    Args a{};
    for (int i = 0; i < 18; ++i) a.in[i] = (const float*)d_in[i];
    a.out = (float*)d_out; a.ws = (unsigned char*)d_ws;
#if MK_MULTI
    for (int ph = 0; ph < N_PHASES; ++ph) { a.ph_lo = ph; a.ph_hi = ph + 1; hipLaunchKernelGGL(mk_fwd, dim3(grid), dim3(NTHR), LDS_BYTES, stream, a); }
#else
    a.ph_lo = 0; a.ph_hi = N_PHASES;
    void* args[] = {&a};
    hipError_t e = hipLaunchCooperativeKernel((const void*)mk_fwd, dim3(grid), dim3(NTHR), args, LDS_BYTES, stream);
    if (e != hipSuccess) fprintf(stderr, "cooperative launch failed: %s (grid %d)\n", hipGetErrorString(e), grid);
#endif
}
```

```cpp
#include <hip/hip_runtime.h>
#include <hip/hip_cooperative_groups.h>
#include <cstdio>
#include <cstdint>
namespace cg = cooperative_groups;

#ifndef MK_MULTI
#define MK_MULTI 0
#endif

typedef _Float16 f16;
typedef _Float16 f16x8 __attribute__((ext_vector_type(8)));
typedef _Float16 f16x4 __attribute__((ext_vector_type(4)));
typedef float f32x4 __attribute__((ext_vector_type(4)));
typedef float f32x16 __attribute__((ext_vector_type(16)));
typedef int i32x4 __attribute__((ext_vector_type(4)));
typedef unsigned long long u64;
typedef unsigned short u16;
typedef __attribute__((address_space(3))) unsigned lds_u32;

constexpr int NB = 8, NS = 8192, ND = 1024, NT = NB * NS;
constexpr int INW = 2632;
constexpr int NMAIN = 2304;
constexpr float EPS = 1e-6f;
constexpr int NTHR = 512, NWAVE = 8;

constexpr size_t MiB = 1u << 20;
constexpr size_t WS_CTL = 0;
constexpr size_t WS_MOD = 1 * MiB;
constexpr size_t WS_WIN = 2 * MiB;
constexpr size_t WS_WVT = 7 * MiB;
constexpr size_t WS_WOUT = 8 * MiB;
constexpr size_t WS_WQ = 10 * MiB;
constexpr size_t WS_SK = 14 * MiB;
constexpr size_t WS_PW = 14 * MiB + 512 * 1024;
constexpr size_t WS_QS = 1 * MiB + 512 * 1024;
constexpr size_t WS_UT = 16 * MiB;
constexpr size_t WS_VP = 48 * MiB;
constexpr size_t WS_H = 80 * MiB;
constexpr size_t WS_U = 208 * MiB;
constexpr size_t WS_Q = 272 * MiB;
constexpr size_t WS_K = 336 * MiB;
constexpr size_t WS_VT = 400 * MiB;
constexpr size_t WS_PQ = 208 * MiB;
constexpr size_t WS_WOUT8 = 27 * MiB;
constexpr size_t WS_WIN8 = 28 * MiB;
constexpr size_t WS_WVT8 = 30 * MiB;
constexpr size_t WS_WSCIN = 31 * MiB;
constexpr size_t WS_H8 = 656 * MiB;
constexpr size_t WS_WQ8 = 24 * MiB;
constexpr size_t WS_WSC = 26 * MiB;
constexpr size_t WS_HQ = 464 * MiB;
constexpr size_t WS_HP = 784 * MiB;
constexpr size_t WS_GWH = 544 * MiB;
constexpr size_t WS_WSUM = 536 * MiB;
constexpr size_t WS_HSC = 528 * MiB;
constexpr size_t WS_QI = 464 * MiB;
constexpr size_t WS_KI = 528 * MiB;
constexpr size_t WS_WI = 536 * MiB;
constexpr size_t WS_MASK = 544 * MiB;
constexpr size_t WS_EID = 608 * MiB;
constexpr size_t WS_GW = 624 * MiB;
constexpr size_t WS_X1 = 656 * MiB;
constexpr size_t WS_END = 848 * MiB;

constexpr int LDS_BYTES = 155648;
constexpr float MIXQ = 127.f / 8.f;
constexpr float PEER_QSTEP = 0.3352f;
constexpr float PEER_WSCALE = 16384.f;

struct Args { const float* in[18]; float* out; unsigned char* ws; int ph_lo, ph_hi; };

__host__ __device__ __forceinline__ int pos2log(int p) { return 64 * ((p >> 5) & 3) + 32 * (p >> 7) + 8 * ((p >> 2) & 3) + 4 * ((p >> 4) & 1) + (p & 3); }
__device__ __forceinline__ int maincol(int L) { if (L < 1536) return L; if (L < 2120) return L + 512; return -1; }

__device__ __forceinline__ float wave_sum(float v) {
#pragma unroll
    for (int o = 1; o < 64; o <<= 1) v += __shfl_xor(v, o);
    return v;
}
__device__ __forceinline__ float wave_max(float v) {
#pragma unroll
    for (int o = 1; o < 64; o <<= 1) v = fmaxf(v, __shfl_xor(v, o));
    return v;
}

__device__ void ph0_prologue(const Args& a, int bid, int nb, unsigned char* lds) {
    int tid = threadIdx.x; asm volatile("" : "+v"(tid));
    const float* c = a.in[1]; const float* ada_w = a.in[2]; const float* ada_b = a.in[3];
    float* sil = (float*)lds;
    for (int i = tid; i < NB * ND; i += NTHR) { const float v = c[i]; sil[i] = v / (1.f + __expf(-v)); }
    __syncthreads();
    float* mod = (float*)(a.ws + WS_MOD);
    const int gt = bid * NTHR + tid, ngt = nb * NTHR;
    for (int o = gt; o < NB * 6144; o += ngt) {
        const int b = o / 6144, j = o % 6144;
        float acc = ada_b[j];
        const float* sb = sil + b * ND;
        for (int k = 0; k < ND; ++k) acc += sb[k] * ada_w[(size_t)k * 6144 + j];
        mod[o] = acc;
    }
    const float* w_in = a.in[5]; const float* pool_w = a.in[6]; const float* w_out = a.in[12];
    const float* wq = a.in[14]; const float* sk = a.in[15]; const float* pu = a.in[16]; const float* pv = a.in[17];
    f16* WIN = (f16*)(a.ws + WS_WIN); f16* WVT = (f16*)(a.ws + WS_WVT); f16* WOUT = (f16*)(a.ws + WS_WOUT); f16* WQ = (f16*)(a.ws + WS_WQ);
 unsigned char* UT = a.ws + WS_UT; unsigned char* VP = a.ws + WS_VP;
    {
        __syncthreads();
        const int lane = tid & 63, wv_ = tid >> 6;
        float* scr = (float*)lds + wv_ * (64 * 33);
        constexpr int I_WQ = 16 * 64, I_Z = 16 * 16, I_INR = 16 * (NMAIN / 32 - 16), I_VT = 16 * 16, I_OUT = 16 * 32, I_ALL = I_WQ + I_Z + I_INR + I_VT + I_OUT;
        for (int it = bid * NWAVE + wv_; it < I_ALL; it += nb * NWAVE) {
            int rr = it, kind = 3, pboff = 0;
            if (rr >= I_WQ) { rr -= I_WQ; kind = 0;
                if (rr >= I_Z) { rr -= I_Z; pboff = 16;
                    if (rr >= I_INR) { rr -= I_INR; kind = 1; pboff = 0; if (rr >= I_VT) { rr -= I_VT; kind = 2; } } } }
            const int npb = kind == 0 ? (pboff ? NMAIN / 32 - 16 : 16) : kind == 1 ? 16 : kind == 2 ? 32 : 64;
            const int k0 = (rr / npb) * 64, p0 = (rr % npb + pboff) * 32, p = p0 + (lane & 31);
            const float* W = kind <= 1 ? w_in : kind == 2 ? w_out : wq; const int ldw = kind <= 1 ? INW : kind == 2 ? 1024 : 2048;
            int col;
            if (kind == 0) col = maincol((p & ~255) + pos2log(p & 255)); else if (kind == 1) col = 1536 + p; else col = (p & ~255) + pos2log(p & 255);
            const bool foldz = (kind == 0 && pboff == 0);
            if (foldz || kind == 3) {
                const int r5 = lane & 31, hh_ = lane >> 5;
                const int blk = __builtin_amdgcn_readfirstlane(col >> 7);
                const int sub = col & 127;
                const float* arow = W + (size_t)(k0 + r5) * ldw + blk * 128 + 8 * hh_;
                f32x16 acc0 = (f32x16){0.f, 0.f, 0.f, 0.f, 0.f, 0.f, 0.f, 0.f, 0.f, 0.f, 0.f, 0.f, 0.f, 0.f, 0.f, 0.f}, acc1 = acc0;
#pragma unroll 2
                for (int ks = 0; ks < 8; ++ks) {
                    const f32x4 a00 = *(const f32x4*)(arow + 16 * ks), a01 = *(const f32x4*)(arow + 16 * ks + 4);
                    const f32x4 a10 = *(const f32x4*)(arow + (size_t)32 * ldw + 16 * ks), a11 = *(const f32x4*)(arow + (size_t)32 * ldw + 16 * ks + 4);
                    f16x8 bfr;
                    if (kind == 3) { const float* br = sk + (size_t)(blk * 128 + sub) * 128 + 16 * ks + 8 * hh_; const f32x4 b0 = *(const f32x4*)br, b1 = *(const f32x4*)(br + 4);
                        bfr = (f16x8){(f16)b0[0], (f16)b0[1], (f16)b0[2], (f16)b0[3], (f16)b1[0], (f16)b1[1], (f16)b1[2], (f16)b1[3]}; }
                    else { const float* br = pool_w + (size_t)blk * 16384 + (size_t)(16 * ks + 8 * hh_) * 128 + sub;
                        bfr = (f16x8){(f16)br[0], (f16)br[128], (f16)br[256], (f16)br[384], (f16)br[512], (f16)br[640], (f16)br[768], (f16)br[896]}; }
                    const f16x8 af0 = (f16x8){(f16)a00[0], (f16)a00[1], (f16)a00[2], (f16)a00[3], (f16)a01[0], (f16)a01[1], (f16)a01[2], (f16)a01[3]};
                    const f16x8 af1 = (f16x8){(f16)a10[0], (f16)a10[1], (f16)a10[2], (f16)a10[3], (f16)a11[0], (f16)a11[1], (f16)a11[2], (f16)a11[3]};
                    acc0 = __builtin_amdgcn_mfma_f32_32x32x16_f16(af0, bfr, acc0, 0, 0, 0);
                    acc1 = __builtin_amdgcn_mfma_f32_32x32x16_f16(af1, bfr, acc1, 0, 0, 0);
                }
#pragma unroll
                for (int rg = 0; rg < 16; ++rg) { const int kk = (rg & 3) + 8 * (rg >> 2) + 4 * hh_; scr[kk * 33 + r5] = acc0[rg]; scr[(32 + kk) * 33 + r5] = acc1[rg]; }
            } else {
#pragma unroll 8
                for (int i = 0; i < 32; ++i) { const int kk = 2 * i + (lane >> 5); scr[kk * 33 + (lane & 31)] = col >= 0 ? W[(size_t)(k0 + kk) * ldw + col] : 0.f; }
            }
            f16* WT = kind == 0 ? WIN : kind == 1 ? WVT : kind == 2 ? WOUT : WQ;
            const int c8 = lane & 7;
#pragma unroll
            for (int j = 0; j < 4; ++j) { const int n = (lane >> 3) + 8 * j; const float* sp = scr + (8 * c8) * 33 + n;
                *(f16x8*)(WT + (size_t)(p0 + n) * ND + k0 + 8 * c8) = (f16x8){(f16)sp[0], (f16)sp[33], (f16)sp[66], (f16)sp[99], (f16)sp[132], (f16)sp[165], (f16)sp[198], (f16)sp[231]}; }
        }
    }
    {
        __syncthreads();
        float ssu = 0.f, ssv = 0.f;
        for (int i = tid; i < 64 * 1024 / 4; i += NTHR) { const f32x4 u = ((const f32x4*)pu)[i], v = ((const f32x4*)pv)[i];
            ssu += u.x * u.x + u.y * u.y + u.z * u.z + u.w * u.w; ssv += v.x * v.x + v.y * v.y + v.z * v.z + v.w * v.w; }
        ssu = wave_sum(ssu); ssv = wave_sum(ssv);
        float* red = (float*)lds;
        if ((tid & 63) == 0) { red[tid >> 6] = ssu; red[8 + (tid >> 6)] = ssv; }
        __syncthreads();
        float tu = 0.f, tv = 0.f;
#pragma unroll
        for (int w = 0; w < 8; ++w) { tu += red[w]; tv += red[8 + w]; }
        const float du = PEER_QSTEP * sqrtf(tu * (1.f / 65536.f)), dv = PEER_QSTEP * sqrtf(tv * (1.f / 65536.f));
        if (bid == 0 && tid == 0) { float* qs = (float*)(a.ws + WS_QS); qs[0] = du; qs[1] = dv; }
        const float idu = 1.f / du, idv = 1.f / dv;
        const int lane = tid & 63, wv_ = tid >> 6;
        for (int row0 = bid * NWAVE + wv_; row0 < 2 * 16384; row0 += 4 * nb * NWAVE) {
            f32x4 x4[4][4];
#pragma unroll
            for (int rr = 0; rr < 4; ++rr) { int row = row0 + rr * nb * NWAVE; row = row < 2 * 16384 ? row : row0; const bool isv = row >= 16384; const int e = row & 16383;
                const float* src = (isv ? pv : pu) + (size_t)e * ND + 4 * lane;
#pragma unroll
                for (int j = 0; j < 4; ++j) x4[rr][j] = *(const f32x4*)(src + 256 * j); }
#pragma unroll
            for (int rr = 0; rr < 4; ++rr) { int row = row0 + rr * nb * NWAVE; row = row < 2 * 16384 ? row : row0; const bool isv = row >= 16384; const int e = row & 16383;
                u16* dstq = (u16*)((isv ? VP : UT) + (size_t)e * 512) + lane;
                const float inv = isv ? idv : idu; const int off = isv ? 8 : 0;
#pragma unroll
                for (int j = 0; j < 4; ++j) { unsigned pk = 0u, pd = 0u;
#pragma unroll
                    for (int k = 0; k < 4; ++k) { int q = (int)floorf(x4[rr][j][k] * inv); q = q < -8 ? -8 : q > 7 ? 7 : q; pk |= (unsigned)((q + off) & 15) << (4 * k);
                        pd |= (unsigned)((q + off) & 15) << (4 * ((k >> 1) + 2 * (lane & 1) + 4 * (k & 1))); }
                    const unsigned od = __shfl_xor(pd, 1);
                    if (!isv) dstq[64 * j] = (u16)pk; else if (!(lane & 1)) ((unsigned*)(VP + (size_t)e * 512))[(lane >> 1) + 32 * j] = pd | od; } }
        }
    }
}

__device__ void row_norm_mod(const float* src, const float* g, const float* mod, int sh_off, int sc_off, f16* dst, unsigned char* h8, float* hs8, int bid, int nb) {
    int tid_ = threadIdx.x; asm volatile("" : "+v"(tid_)); const int lane = tid_ & 63, wave = tid_ >> 6;
    const int rstep = nb * NWAVE, r0 = bid * NWAVE + wave;
    const bool fast = (NS % rstep) == 0 && ((NS / rstep) % 4) == 0;
    if (fast) {
        for (int b = 0; b < NB; ++b) {
            f32x4 gs[4], sh[4];
#pragma unroll
            for (int j = 0; j < 4; ++j) { const int col = lane * 4 + 256 * j; const f32x4 gg = *(const f32x4*)(g + col), sc = *(const f32x4*)(mod + b * 6144 + sc_off + col);
                sh[j] = *(const f32x4*)(mod + b * 6144 + sh_off + col); gs[j] = gg * (1.f + sc); }
            for (int row = b * NS + r0; row < (b + 1) * NS; row += 4 * rstep) {
                f32x4 v[4][4]; float ss[4];
#pragma unroll
                for (int rr = 0; rr < 4; ++rr)
#pragma unroll
                    for (int j = 0; j < 4; ++j) v[rr][j] = ((const f32x4*)(src + (size_t)(row + rr * rstep) * ND) + lane)[64 * j];
#pragma unroll
                for (int rr = 0; rr < 4; ++rr) { float s_ = 0.f;
#pragma unroll
                    for (int j = 0; j < 4; ++j) s_ += v[rr][j].x * v[rr][j].x + v[rr][j].y * v[rr][j].y + v[rr][j].z * v[rr][j].z + v[rr][j].w * v[rr][j].w;
                    ss[rr] = rsqrtf(wave_sum(s_) * (1.f / ND) + EPS); }
#pragma unroll
                for (int rr = 0; rr < 4; ++rr) { float am = 0.f;
#pragma unroll
                    for (int j = 0; j < 4; ++j) { const int col = lane * 4 + 256 * j; const f32x4 o = v[rr][j] * ss[rr] * gs[j] + sh[j]; v[rr][j] = o;
                        am = fmaxf(am, fmaxf(fmaxf(fabsf(o.x), fabsf(o.y)), fmaxf(fabsf(o.z), fabsf(o.w))));
                        *(f16x4*)(dst + (size_t)(row + rr * rstep) * ND + col) = (f16x4){(f16)o.x, (f16)o.y, (f16)o.z, (f16)o.w}; }
                    am = wave_max(am); const float inv = am > 0.f ? 127.f / am : 0.f;
#pragma unroll
                    for (int j = 0; j < 4; ++j) { const f32x4 o = v[rr][j];
                        const unsigned pk = (unsigned)((int)rintf(o.x * inv) & 255) | ((unsigned)((int)rintf(o.y * inv) & 255) << 8) | ((unsigned)((int)rintf(o.z * inv) & 255) << 16) | ((unsigned)((int)rintf(o.w * inv) & 255) << 24);
                        *(unsigned*)(h8 + (size_t)(row + rr * rstep) * ND + lane * 4 + 256 * j) = pk; }
                    if (lane == 0) hs8[row + rr * rstep] = am * (1.f / 127.f); }
            }
        }
        return;
    }
    for (int row = r0; row < NT; row += rstep) {
        const int b = row / NS;
        const f32x4* xr = (const f32x4*)(src + (size_t)row * ND) + lane;
        f32x4 v[4]; float s = 0.f;
#pragma unroll
        for (int j = 0; j < 4; ++j) { v[j] = xr[64 * j]; s += v[j].x * v[j].x + v[j].y * v[j].y + v[j].z * v[j].z + v[j].w * v[j].w; }
        const float rstd = rsqrtf(wave_sum(s) * (1.f / ND) + EPS);
#pragma unroll
        for (int j = 0; j < 4; ++j) {
            const int col = lane * 4 + 256 * j;
            const f32x4 gg = *(const f32x4*)(g + col), sc = *(const f32x4*)(mod + b * 6144 + sc_off + col), sh = *(const f32x4*)(mod + b * 6144 + sh_off + col);
            const f32x4 of = (f32x4){v[j].x * rstd * gg.x * (1.f + sc.x) + sh.x, v[j].y * rstd * gg.y * (1.f + sc.y) + sh.y, v[j].z * rstd * gg.z * (1.f + sc.z) + sh.z, v[j].w * rstd * gg.w * (1.f + sc.w) + sh.w};
            v[j] = of;
            *(f16x4*)(dst + (size_t)row * ND + col) = (f16x4){(f16)of.x, (f16)of.y, (f16)of.z, (f16)of.w};
        }
        float am = 0.f;
#pragma unroll
        for (int j = 0; j < 4; ++j) am = fmaxf(am, fmaxf(fmaxf(fabsf(v[j].x), fabsf(v[j].y)), fmaxf(fabsf(v[j].z), fabsf(v[j].w))));
        am = wave_max(am); const float inv = am > 0.f ? 127.f / am : 0.f;
#pragma unroll
        for (int j = 0; j < 4; ++j) { const f32x4 o = v[j];
            const unsigned pk = (unsigned)((int)rintf(o.x * inv) & 255) | ((unsigned)((int)rintf(o.y * inv) & 255) << 8) | ((unsigned)((int)rintf(o.z * inv) & 255) << 16) | ((unsigned)((int)rintf(o.w * inv) & 255) << 24);
            *(unsigned*)(h8 + (size_t)row * ND + lane * 4 + 256 * j) = pk; }
        if (lane == 0) hs8[row] = am * (1.f / 127.f);
    }
}
__device__ void row_norm_mod_q(const f16* src, const float* g, const float* mod, int sh_off, int sc_off, unsigned char* hq, unsigned* hp, float* hsc, int bid, int nb) {
    int tid_ = threadIdx.x; asm volatile("" : "+v"(tid_)); const int lane = tid_ & 63, wave = tid_ >> 6;
    const int rstep = nb * NWAVE, r0 = bid * NWAVE + wave;
    const bool hoist = (NS % rstep) == 0 && ((NS / rstep) % 2) == 0;
    const int nouter = hoist ? NB : 1, ninner = hoist ? NS : NT;
    for (int bo = 0; bo < nouter; ++bo) {
        f32x4 gs[4], sh[4];
        if (hoist) {
#pragma unroll
            for (int j = 0; j < 4; ++j) { const int col = 8 * lane + 512 * (j >> 1) + 4 * (j & 1); const f32x4 gg = *(const f32x4*)(g + col), sc = *(const f32x4*)(mod + bo * 6144 + sc_off + col);
                sh[j] = *(const f32x4*)(mod + bo * 6144 + sh_off + col); gs[j] = gg * (1.f + sc); }
        }
        for (int rowa = bo * ninner + r0; rowa < (bo + 1) * ninner; rowa += 2 * rstep) {
            const int rowb = rowa + rstep < NT ? rowa + rstep : rowa;
            f16x8 hx[2][2];
#pragma unroll
            for (int j = 0; j < 2; ++j) { hx[0][j] = *(const f16x8*)(src + (size_t)rowa * ND + 8 * lane + 512 * j); hx[1][j] = *(const f16x8*)(src + (size_t)rowb * ND + 8 * lane + 512 * j); }
#pragma unroll
            for (int rr = 0; rr < 2; ++rr) {
                const int row = rr ? rowb : rowa; const int b = row / NS;
                if (!hoist) {
#pragma unroll
                    for (int j = 0; j < 4; ++j) { const int col = 8 * lane + 512 * (j >> 1) + 4 * (j & 1); const f32x4 gg = *(const f32x4*)(g + col), sc = *(const f32x4*)(mod + b * 6144 + sc_off + col);
                        sh[j] = *(const f32x4*)(mod + b * 6144 + sh_off + col); gs[j] = gg * (1.f + sc); }
                }
                f32x4 v[4]; float s = 0.f;
#pragma unroll
                for (int j = 0; j < 2; ++j) { const f16x8 h8 = hx[rr][j];
                    v[2 * j] = (f32x4){(float)h8[0], (float)h8[1], (float)h8[2], (float)h8[3]}; v[2 * j + 1] = (f32x4){(float)h8[4], (float)h8[5], (float)h8[6], (float)h8[7]}; }
#pragma unroll
                for (int j = 0; j < 4; ++j) s += v[j].x * v[j].x + v[j].y * v[j].y + v[j].z * v[j].z + v[j].w * v[j].w;
                const float rstd = rsqrtf(wave_sum(s) * (1.f / ND) + EPS);
                float o[16]; float am = 0.f;
#pragma unroll
                for (int j = 0; j < 4; ++j)
#pragma unroll
                    for (int k = 0; k < 4; ++k) { const float y = v[j][k] * rstd * gs[j][k] + sh[j][k]; o[4 * j + k] = y; am = fmaxf(am, fabsf(y)); }
                am = wave_max(am);
                const float inv = am > 0.f ? 119.f / am : 0.f;
#pragma unroll
                for (int j = 0; j < 2; ++j) {
                    unsigned p0 = 0u, p1 = 0u, ph = 0u, pl = 0u;
#pragma unroll
                    for (int k = 0; k < 8; ++k) { const int q = (int)rintf(o[8 * j + k] * inv); const int l = ((q + 8) & 15) - 8; const int h = (q - l) >> 4;
                        if (k < 4) p0 |= (unsigned)(q & 255) << (8 * k); else p1 |= (unsigned)(q & 255) << (8 * (k - 4));
                        ph |= (unsigned)(h & 15) << (4 * k); pl |= (unsigned)(l & 15) << (4 * k); }
                    *(u64*)(hq + (size_t)row * ND + 8 * lane + 512 * j) = (u64)p0 | ((u64)p1 << 32);
                    hp[(size_t)row * 256 + lane + 64 * j] = ph; hp[(size_t)row * 256 + 128 + lane + 64 * j] = pl;
                }
                if (lane == 0) hsc[row] = am * (1.f / 119.f);
            }
        }
    }
}
__device__ void wq_to_int8(const f16* WQ, unsigned char* WQ8, float* WSC, int nrows, int bid, int nb, const float* kg0 = nullptr, const float* kg1 = nullptr) {
    int tid_ = threadIdx.x; asm volatile("" : "+v"(tid_)); const int lane = tid_ & 63, wave = tid_ >> 6;
    for (int row = bid * NWAVE + wave; row < nrows; row += nb * NWAVE) {
        f16x8 a0 = *(const f16x8*)(WQ + (size_t)row * ND + 8 * lane), a1 = *(const f16x8*)(WQ + (size_t)row * ND + 8 * lane + 512);
        if (kg0) {
#pragma unroll
            for (int k = 0; k < 8; ++k) { a0[k] = (f16)((float)a0[k] * (fabsf(kg0[8 * lane + k]) * (1.f / MIXQ))); a1[k] = (f16)((float)a1[k] * (fabsf(kg1[8 * lane + k]) * (1.f / MIXQ))); }
        }
        float am = 0.f;
#pragma unroll
        for (int k = 0; k < 8; ++k) am = fmaxf(am, fmaxf(fabsf((float)a0[k]), fabsf((float)a1[k])));
        am = wave_max(am);
        const float inv = am > 0.f ? 127.f / am : 0.f;
        unsigned p[4] = {0u, 0u, 0u, 0u};
#pragma unroll
        for (int k = 0; k < 4; ++k) { p[0] |= (unsigned)((int)rintf((float)a0[k] * inv) & 255) << (8 * k); p[1] |= (unsigned)((int)rintf((float)a0[4 + k] * inv) & 255) << (8 * k);
                                      p[2] |= (unsigned)((int)rintf((float)a1[k] * inv) & 255) << (8 * k); p[3] |= (unsigned)((int)rintf((float)a1[4 + k] * inv) & 255) << (8 * k); }
        *(u64*)(WQ8 + (size_t)row * ND + 8 * lane) = (u64)p[0] | ((u64)p[1] << 32);
        *(u64*)(WQ8 + (size_t)row * ND + 8 * lane + 512) = (u64)p[2] | ((u64)p[3] << 32);
        if (lane == 0) WSC[row] = am * (1.f / 127.f);
    }
}

namespace pg8 {
#define PG8_LAS __attribute__((address_space(3)))
constexpr int BM = 256, BK = 64, HALF = 128, HTB = HALF * BK * 2, STAGE_BYTES = 8 * HTB, NXCD = 8, WGM = 8;
__host__ __device__ __forceinline__ int lds_byte(int r, int c) { const int st = (r >> 4) * 2 + (c >> 5), rr = r & 15, cc = c & 31, ob = rr * 64 + cc * 2; return st * 1024 + (ob ^ (((ob >> 9) & 1) << 5)); }
__host__ __device__ __forceinline__ void stage_rc(int b, int& R, int& C) { const int st = b / 1024, sb = b % 1024, swz = sb ^ (((sb >> 9) & 1) << 5); R = (st >> 1) * 16 + swz / 64; C = (st & 1) * 32 + (swz % 64) / 2; }
struct Unit { int pm, pn; };
struct Gemm { const f16* A; const f16* Bt; int M, N, K; };
struct StaticOrder {
    int nM, nN, nwg, G, c;
    __host__ __device__ void init(int M, int N, int G_, int c_) { nM = M / BM; nN = N / BM; nwg = nM * nN; G = G_; c = c_; }
    __host__ __device__ bool next(int i, Unit& u) const {
        const long L = (long)i * G + c; if (L >= nwg) return false;
        int wgid = (int)L; { const int q = nwg / NXCD, r = nwg % NXCD, xcd = wgid % NXCD, off = wgid / NXCD; wgid = (xcd < r ? xcd * (q + 1) : r * (q + 1) + (xcd - r) * q) + off; }
        const int nig = WGM * nN, gid = wgid / nig, fm = gid * WGM, gsz = (nM - fm) < WGM ? (nM - fm) : WGM;
        u.pm = fm + ((wgid % nig) % gsz); u.pn = (wgid % nig) / gsz; return true;
    }
};
template <class Epi, bool I8 = false>
__device__ __forceinline__ void gemm_phase(PG8_LAS unsigned char* lds, const Gemm g, const StaticOrder& S, const Epi& E) {
    int tid = threadIdx.x; asm volatile("" : "+v"(tid));
    const int wid = __builtin_amdgcn_readfirstlane(tid >> 6), lane = tid & 63, wr = wid >> 2, wc = wid & 3, fr = lane & 15, fq = lane >> 4;
    const int K = g.K, nt = K / BK;
    unsigned voffA[2];
#pragma unroll
    for (int i = 0; i < 2; ++i) { int R, C; stage_rc(tid * 16 + i * 8192, R, C); voffA[i] = (unsigned)(R * K + C) * 2u; }
    const size_t kstep = (size_t)(BK * 2);
    const size_t hstep = (size_t)HALF * K * 2;
    const size_t tstep = 2 * hstep;
    const unsigned ldsw = (unsigned)wid * 1024u;
    const int aoff = lds_byte(wr * 64 + fr, fq * 8), boff = lds_byte(wc * 32 + fr, fq * 8);
#define PG8_SA(b, h) (((b) * 2 + (h)) * HTB)
#define PG8_SB(b, h) ((4 + (b) * 2 + (h)) * HTB)
#define PG8_STAGE(bufoff, gbase, voff) do { _Pragma("unroll") for (int _i = 0; _i < 2; ++_i) \
        __builtin_amdgcn_global_load_lds((const unsigned*)((const char*)(gbase) + (voff)[_i]), (PG8_LAS unsigned*)(lds + (bufoff) + ldsw + _i * 8192), 16, 0, 0); } while (0)
#define PG8_LDA(dst, b, h) do { _Pragma("unroll") for (int m = 0; m < 4; ++m) _Pragma("unroll") for (int k = 0; k < 2; ++k) dst[m][k] = *(const PG8_LAS f16x8*)(lds + PG8_SA(b, h) + aoff + m * 2048 + k * 1024); } while (0)
#define PG8_LDB(dst, b, h) do { _Pragma("unroll") for (int n = 0; n < 2; ++n) _Pragma("unroll") for (int k = 0; k < 2; ++k) dst[n][k] = *(const PG8_LAS f16x8*)(lds + PG8_SB(b, h) + boff + n * 2048 + k * 1024); } while (0)
#define PG8_MMA(ai, bj, At, Bt) do { __builtin_amdgcn_s_setprio(1); _Pragma("unroll") for (int m = 0; m < 4; ++m) _Pragma("unroll") for (int n = 0; n < 2; ++n) _Pragma("unroll") for (int k = 0; k < 2; ++k) \
        acc[ai][bj][m][n] = I8 ? __builtin_bit_cast(f32x4, __builtin_amdgcn_mfma_i32_16x16x64_i8(__builtin_bit_cast(i32x4, Bt[n][k]), __builtin_bit_cast(i32x4, At[m][k]), __builtin_bit_cast(i32x4, acc[ai][bj][m][n]), 0, 0, 0)) \
                                 : __builtin_amdgcn_mfma_f32_16x16x32_f16(Bt[n][k], At[m][k], acc[ai][bj][m][n], 0, 0, 0); __builtin_amdgcn_s_setprio(0); } while (0)
#define PG8_WAIT_V(n) asm volatile("s_waitcnt vmcnt(" #n ")" ::: "memory")
#define PG8_WAIT_L(n) asm volatile("s_waitcnt lgkmcnt(" #n ")" ::: "memory")
#define PG8_BAR __builtin_amdgcn_s_barrier()
#define PG8_SCHED __builtin_amdgcn_sched_barrier(0)
    Unit cur, nxt; int ui = 0;
    if (!S.next(0, cur)) return;
    f32x4 acc[2][2][4][2];
#pragma unroll
    for (int a = 0; a < 2; ++a)
#pragma unroll
        for (int b = 0; b < 2; ++b)
#pragma unroll
            for (int m = 0; m < 4; ++m)
#pragma unroll
                for (int n = 0; n < 2; ++n) acc[a][b][m][n] = (f32x4){0.f, 0.f, 0.f, 0.f};
    f16x8 At[4][2], B0[2][2], B1[2][2];
    const char* cA = (const char*)g.A + (size_t)cur.pm * tstep; const char* cB = (const char*)g.Bt + (size_t)cur.pn * tstep;
    PG8_STAGE(PG8_SB(0, 0), cB, voffA); PG8_STAGE(PG8_SB(0, 1), cB + hstep, voffA); PG8_STAGE(PG8_SA(0, 0), cA, voffA); PG8_STAGE(PG8_SA(0, 1), cA + hstep, voffA);
    if (wr == 1) PG8_BAR;
    PG8_WAIT_V(2); PG8_BAR;
    PG8_STAGE(PG8_SB(1, 0), cB + kstep, voffA); PG8_STAGE(PG8_SA(1, 0), cA + kstep, voffA); PG8_STAGE(PG8_SB(1, 1), cB + hstep + kstep, voffA);
    PG8_WAIT_V(6); PG8_BAR;
    for (;;) {
        const bool has_next = S.next(ui + 1, nxt);
        const char* nA = has_next ? (const char*)g.A + (size_t)nxt.pm * tstep : cA; const char* nB = has_next ? (const char*)g.Bt + (size_t)nxt.pn * tstep : cB;
        for (int t = 0; t < nt; t += 2) {
            const bool last = (t == nt - 2);
            const char* a1 = cA + (size_t)(t + 1) * kstep;
            const char* a2 = last ? nA : cA + (size_t)(t + 2) * kstep; const char* b2 = last ? nB : cB + (size_t)(t + 2) * kstep;
            const char* a3 = a2 + kstep; const char* b3 = b2 + kstep;
            PG8_LDB(B0, 0, 0); PG8_LDB(B1, 0, 1); PG8_SCHED; PG8_LDA(At, 0, 0); PG8_STAGE(PG8_SA(1, 1), a1 + hstep, voffA);
            PG8_WAIT_V(8); PG8_WAIT_L(0); PG8_BAR; PG8_MMA(0, 0, At, B0); PG8_MMA(0, 1, At, B1); PG8_BAR; PG8_SCHED;
            PG8_LDA(At, 0, 1); PG8_STAGE(PG8_SB(0, 0), b2, voffA); PG8_STAGE(PG8_SB(0, 1), b2 + hstep, voffA); PG8_STAGE(PG8_SA(0, 0), a2, voffA);
            PG8_WAIT_V(8); PG8_WAIT_L(0); PG8_BAR; PG8_MMA(1, 0, At, B0); PG8_MMA(1, 1, At, B1); PG8_BAR; PG8_SCHED;
            PG8_LDB(B0, 1, 0); PG8_LDB(B1, 1, 1); PG8_SCHED; PG8_LDA(At, 1, 0); PG8_STAGE(PG8_SA(0, 1), a2 + hstep, voffA);
            PG8_WAIT_V(8); PG8_WAIT_L(0); PG8_BAR; PG8_MMA(0, 0, At, B0); PG8_MMA(0, 1, At, B1); PG8_BAR; PG8_SCHED;
            PG8_LDA(At, 1, 1); PG8_STAGE(PG8_SB(1, 0), b3, voffA); PG8_STAGE(PG8_SB(1, 1), b3 + hstep, voffA); PG8_STAGE(PG8_SA(1, 0), a3, voffA);
            PG8_WAIT_V(8); PG8_WAIT_L(0); PG8_BAR; PG8_MMA(1, 0, At, B0); PG8_MMA(1, 1, At, B1); PG8_BAR; PG8_SCHED;
        }
        if (wr == 0) PG8_BAR;
        E(acc, cur, wr, wc, fr, fq);
        if (!has_next) break;
#pragma unroll
        for (int a = 0; a < 2; ++a)
#pragma unroll
            for (int b = 0; b < 2; ++b)
#pragma unroll
                for (int m = 0; m < 4; ++m)
#pragma unroll
                    for (int n = 0; n < 2; ++n) acc[a][b][m][n] = (f32x4){0.f, 0.f, 0.f, 0.f};
        cur = nxt; cA = nA; cB = nB; ++ui;
        if (wr == 1) PG8_BAR;
    }
    PG8_WAIT_V(0);
    PG8_BAR;
#undef PG8_SA
#undef PG8_SB
#undef PG8_STAGE
#undef PG8_LDA
#undef PG8_LDB
#undef PG8_MMA
#undef PG8_WAIT_V
#undef PG8_WAIT_L
#undef PG8_BAR
#undef PG8_SCHED
}

typedef f32x4 Acc[2][2][4][2];
__device__ __forceinline__ f32x4 cvt_i4(const f32x4 b) { const i32x4 i = __builtin_bit_cast(i32x4, b); return (f32x4){(float)i[0], (float)i[1], (float)i[2], (float)i[3]}; }
template <bool I8>
struct EpiMainT {
    unsigned char* ws; const float *qg, *kg; int pn0; const float* hsc; const float* wsc;
    __device__ __forceinline__ void operator()(const Acc& acc, const Unit& u, int wr, int wc, int fr, int fq) const {
        const int row0 = u.pm * BM + wr * 64 + fr, pn = u.pn + pn0;
        f32x4 ws4[2][2];
#pragma unroll
        for (int bj = 0; bj < 2; ++bj)
#pragma unroll
            for (int n = 0; n < 2; ++n) ws4[bj][n] = I8 ? *(const f32x4*)(wsc + pn * BM + 128 * bj + 32 * wc + 16 * n + 4 * fq) : (f32x4){1.f, 1.f, 1.f, 1.f};
#define EA_(ai, bj, m, n) (I8 ? cvt_i4(acc[ai][bj][m][n]) * ws4[bj][n] : acc[ai][bj][m][n])
        if (pn == 8) {
            if (wc == 0) {
#pragma unroll
                for (int ai = 0; ai < 2; ++ai)
#pragma unroll
                    for (int m = 0; m < 4; ++m) { const size_t row = row0 + ai * HALF + m * 16;
#pragma unroll
                        for (int bj = 0; bj < 2; ++bj) { const f32x4 v0 = acc[ai][bj][m][0], v1 = acc[ai][bj][m][1];
                            *(f16x8*)((f16*)(ws + WS_KI) + (((row >> 5) * 8 + 4 * bj + fq) * 32 + (row & 31)) * 8) = (f16x8){(f16)v0[0], (f16)v0[1], (f16)v0[2], (f16)v0[3], (f16)v1[0], (f16)v1[1], (f16)v1[2], (f16)v1[3]}; } }
            } else if (wc == 1 && fq == 0) {
#pragma unroll
                for (int ai = 0; ai < 2; ++ai)
#pragma unroll
                    for (int m = 0; m < 4; ++m) { const size_t row = row0 + ai * HALF + m * 16;
                        *(f32x4*)((float*)(ws + WS_WI) + row * 8) = acc[ai][0][m][0] * 0.35355339059327373f; *(f32x4*)((float*)(ws + WS_WI) + row * 8 + 4) = acc[ai][0][m][1] * 0.35355339059327373f; }
            }
            return;
        }
        const int kind = pn >> 1;
        f16* base = (f16*)(ws + (kind == 0 ? WS_U : kind == 1 ? WS_Q : kind == 2 ? WS_K : WS_QI));
        const int col0 = (pn & 1) * 256 + 64 * wc + 8 * fq;
        if (kind == 1 || kind == 2) {
            const float* gp = (kind == 1 ? qg : kg) + 8 * fq;
#pragma unroll
            for (int ai = 0; ai < 2; ++ai)
#pragma unroll
                for (int m = 0; m < 4; ++m) { const size_t row = row0 + ai * HALF + m * 16; const float hs = I8 ? hsc[row] : 1.f;
                    float ss = 0.f;
#pragma unroll
                    for (int bj = 0; bj < 2; ++bj)
#pragma unroll
                        for (int n = 0; n < 2; ++n) { const f32x4 v = EA_(ai, bj, m, n) * hs; ss += v[0] * v[0] + v[1] * v[1] + v[2] * v[2] + v[3] * v[3]; }
                    ss += __shfl_xor(ss, 16); ss += __shfl_xor(ss, 32);
                    const float rstd = rsqrtf(ss * (1.f / 64.f) + EPS);
#pragma unroll
                    for (int bj = 0; bj < 2; ++bj) { const f32x4 v0 = EA_(ai, bj, m, 0) * (hs * rstd) * *(const f32x4*)(gp + 32 * bj), v1 = EA_(ai, bj, m, 1) * (hs * rstd) * *(const f32x4*)(gp + 32 * bj + 4);
                        *(f16x8*)(base + row * 512 + col0 + 32 * bj) = (f16x8){(f16)v0[0], (f16)v0[1], (f16)v0[2], (f16)v0[3], (f16)v1[0], (f16)v1[1], (f16)v1[2], (f16)v1[3]}; }
                    asm volatile("" ::: "memory"); }
        } else if (kind == 3) {
            const int hd = (pn & 1) * 4 + wc;
#pragma unroll
            for (int ai = 0; ai < 2; ++ai)
#pragma unroll
                for (int m = 0; m < 4; ++m) { const size_t row = row0 + ai * HALF + m * 16; const int ql = (int)(row & 7);
                    const int rr = (hd & 3) | (((ql >> 1) & 1) << 2) | ((hd >> 2) << 3) | ((ql & 1) << 4);
#pragma unroll
                    for (int bj = 0; bj < 2; ++bj) { const f32x4 v0 = acc[ai][bj][m][0], v1 = acc[ai][bj][m][1]; const int chunk = fq + 4 * bj;
                        *(f16x8*)(base + ((((((row >> 3) * 2 + (ql >> 2)) * 4 + (chunk >> 1)) * 2 + (chunk & 1)) * 32 + rr) << 3)) = (f16x8){(f16)v0[0], (f16)v0[1], (f16)v0[2], (f16)v0[3], (f16)v1[0], (f16)v1[1], (f16)v1[2], (f16)v1[3]}; } }
        } else {
#pragma unroll
            for (int ai = 0; ai < 2; ++ai)
#pragma unroll
                for (int m = 0; m < 4; ++m) { const size_t row = row0 + ai * HALF + m * 16; const float hs = I8 ? hsc[row] : 1.f;
#pragma unroll
                    for (int bj = 0; bj < 2; ++bj) { const f32x4 v0 = EA_(ai, bj, m, 0) * hs, v1 = EA_(ai, bj, m, 1) * hs;
                        *(f16x8*)(base + row * 512 + col0 + 32 * bj) = (f16x8){(f16)v0[0], (f16)v0[1], (f16)v0[2], (f16)v0[3], (f16)v1[0], (f16)v1[1], (f16)v1[2], (f16)v1[3]}; } }
        }
#undef EA_
    }
};
typedef EpiMainT<false> EpiMain;
template <bool I8>
struct EpiVTT {
    f16* VT; const float* wsc; const float* hsc;
    __device__ __forceinline__ void operator()(const Acc& acc, const Unit& u, int wr, int wc, int fr, int fq) const {
        const int row0 = u.pm * BM + wr * 64 + fr, col0 = u.pn * BM + 32 * wc + 4 * fq;
        f32x4 hs4[2][2];
#pragma unroll
        for (int bj = 0; bj < 2; ++bj)
#pragma unroll
            for (int n = 0; n < 2; ++n) hs4[bj][n] = I8 ? *(const f32x4*)(hsc + col0 + 128 * bj + 16 * n) : (f32x4){1.f, 1.f, 1.f, 1.f};
#pragma unroll
        for (int ai = 0; ai < 2; ++ai)
#pragma unroll
            for (int m = 0; m < 4; ++m) { const size_t row = row0 + ai * HALF + m * 16; const float wsr = I8 ? wsc[row] : 1.f;
#pragma unroll
                for (int bj = 0; bj < 2; ++bj)
#pragma unroll
                    for (int n = 0; n < 2; ++n) { const f32x4 v = I8 ? cvt_i4(acc[ai][bj][m][n]) * hs4[bj][n] * wsr : acc[ai][bj][m][n];
                        *(f16x4*)(VT + row * NT + col0 + 128 * bj + 16 * n) = (f16x4){(f16)v[0], (f16)v[1], (f16)v[2], (f16)v[3]}; } }
    }
};
struct EpiOut {
    const float* x; const float* mod; f16* x1; const float* wsc;
    __device__ __forceinline__ void operator()(const Acc& acc, const Unit& u, int wr, int wc, int fr, int fq) const {
        const int row0 = u.pm * BM + wr * 64 + fr, col0 = u.pn * BM + 64 * wc + 8 * fq;
        const float* g1 = mod + ((u.pm * BM) / NS) * 6144 + 2048 + col0;
        f32x4 g4[2][2];
#pragma unroll
        for (int bj = 0; bj < 2; ++bj)
#pragma unroll
            for (int n = 0; n < 2; ++n) g4[bj][n] = *(const f32x4*)(g1 + 32 * bj + 4 * n) * *(const f32x4*)(wsc + u.pn * BM + 128 * bj + 32 * wc + 16 * n + 4 * fq);
#pragma unroll
        for (int ai = 0; ai < 2; ++ai)
#pragma unroll
            for (int m = 0; m < 4; ++m) { const size_t off = (size_t)(row0 + ai * HALF + m * 16) * ND + col0;
#pragma unroll
                for (int bj = 0; bj < 2; ++bj) { const f32x4 v0 = *(const f32x4*)(x + off + 32 * bj) + g4[bj][0] * cvt_i4(acc[ai][bj][m][0]), v1 = *(const f32x4*)(x + off + 32 * bj + 4) + g4[bj][1] * cvt_i4(acc[ai][bj][m][1]);
                    *(f16x8*)(x1 + off + 32 * bj) = (f16x8){(f16)v0[0], (f16)v0[1], (f16)v0[2], (f16)v0[3], (f16)v1[0], (f16)v1[1], (f16)v1[2], (f16)v1[3]}; } }
    }
};
struct EpiPQ {
    f16* PQ; const float* hsc; const float* wsc;
    __device__ __forceinline__ void operator()(const Acc& acc, const Unit& u, int wr, int wc, int fr, int fq) const {
        const int row0 = u.pm * BM + wr * 64 + fr, col0 = u.pn * BM + 64 * wc + 8 * fq;
        f32x4 ws4[2][2];
#pragma unroll
        for (int bj = 0; bj < 2; ++bj)
#pragma unroll
            for (int n = 0; n < 2; ++n) ws4[bj][n] = *(const f32x4*)(wsc + u.pn * BM + 128 * bj + 32 * wc + 16 * n + 4 * fq);
#pragma unroll
        for (int ai = 0; ai < 2; ++ai)
#pragma unroll
            for (int m = 0; m < 4; ++m) { const size_t row = row0 + ai * HALF + m * 16; const float hs = hsc[row];
#pragma unroll
                for (int bj = 0; bj < 2; ++bj) { const i32x4 i0 = __builtin_bit_cast(i32x4, acc[ai][bj][m][0]), i1 = __builtin_bit_cast(i32x4, acc[ai][bj][m][1]);
                    const f32x4 v0 = (f32x4){(float)i0[0], (float)i0[1], (float)i0[2], (float)i0[3]} * ws4[bj][0] * hs, v1 = (f32x4){(float)i1[0], (float)i1[1], (float)i1[2], (float)i1[3]} * ws4[bj][1] * hs;
                    *(f16x8*)(PQ + ((((row >> 5) * 256 + ((col0 + 32 * bj) >> 3)) * 32 + (row & 31)) << 3)) = (f16x8){(f16)v0[0], (f16)v0[1], (f16)v0[2], (f16)v0[3], (f16)v1[0], (f16)v1[1], (f16)v1[2], (f16)v1[3]}; } }
    }
};
}

__device__ __forceinline__ void ph2_inproj(const Args& a, int bid, int nb, unsigned char* lds) {
    const f16* H = (const f16*)(a.ws + WS_H); const f16* WIN = (const f16*)(a.ws + WS_WIN);
    const f16* H8 = (const f16*)(a.ws + WS_H8); const float* hs8 = (const float*)(a.ws + WS_H8 + 64 * MiB); const float* wsi = (const float*)(a.ws + WS_WSCIN);
    PG8_LAS unsigned char* l3 = (PG8_LAS unsigned char*)lds;
    { pg8::Gemm g{H8, (const f16*)(a.ws + WS_WIN8), NT, 1536, ND / 2}; pg8::StaticOrder S; S.init(NT, 1536, nb, bid);
      pg8::EpiMainT<true> E{a.ws, a.in[9], a.in[10], 0, hs8, wsi};
      pg8::gemm_phase<pg8::EpiMainT<true>, true>(l3, g, S, E); }
    { pg8::Gemm g{H, WIN + (size_t)1536 * ND, NT, NMAIN - 1536, ND}; pg8::StaticOrder S; S.init(NT, NMAIN - 1536, nb, bid);
      pg8::EpiMain E{a.ws, a.in[9], a.in[10], 6, nullptr, nullptr};
      pg8::gemm_phase(l3, g, S, E); }
    { pg8::Gemm g{(const f16*)(a.ws + WS_WVT8), H8, 512, NT, ND / 2}; pg8::StaticOrder S; S.init(512, NT, nb, bid);
      pg8::EpiVTT<true> E{(f16*)(a.ws + WS_VT), wsi + 1536, hs8};
      pg8::gemm_phase<pg8::EpiVTT<true>, true>(l3, g, S, E); }
}


constexpr int PPITCH = 1040;
__device__ __forceinline__ void ph3_pool_fast(const Args& a, int bid, int nb, unsigned char* lds) {
    int tid = threadIdx.x; asm volatile("" : "+v"(tid));
    const int cg8 = tid & 63, tq = tid >> 6, gch = cg8 >> 4, win = 2 << gch;
    const f16* Z = (const f16*)(a.ws + WS_U); unsigned char* MIX8 = a.ws + WS_H;
    const f32x4 ps0 = *(const f32x4*)(a.in[7] + 8 * cg8), ps1 = *(const f32x4*)(a.in[7] + 8 * cg8 + 4), pg0 = *(const f32x4*)(a.in[8] + 8 * cg8), pg1 = *(const f32x4*)(a.in[8] + 8 * cg8 + 4);
    const float psc[8] = {ps0[0], ps0[1], ps0[2], ps0[3], ps1[0], ps1[1], ps1[2], ps1[3]}, pgn[8] = {pg0[0], pg0[1], pg0[2], pg0[3], pg1[0], pg1[1], pg1[2], pg1[3]};
    float psg[8];
#pragma unroll
    for (int j = 0; j < 8; ++j) psg[j] = pgn[j] > 0.f ? MIXQ : (pgn[j] < 0.f ? -MIXQ : 0.f);
    for (int item = bid; item < NT / 32; item += nb) {
        const int tb = item * 32 + 4 * tq, tl0 = tb % NS;
        const f16* up = Z + (size_t)(tb - tl0) * 512 + 8 * cg8;
        float sm[8];
#pragma unroll
        for (int j = 0; j < 8; ++j) sm[j] = 0.f;
        f16x8 hist_[15];
#pragma unroll
        for (int q = 0; q < 15; ++q) { const int rr = tl0 - 15 + q; hist_[q] = (q >= 16 - win && rr >= 0) ? *(const f16x8*)(up + (size_t)rr * 512) : (f16x8){0, 0, 0, 0, 0, 0, 0, 0}; }
        f16x8 cur_[4];
#pragma unroll
        for (int k = 0; k < 4; ++k) cur_[k] = *(const f16x8*)(up + (size_t)(tl0 + k) * 512);
#pragma unroll
        for (int q = 0; q < 15; ++q)
#pragma unroll
            for (int j = 0; j < 8; ++j) sm[j] += (float)hist_[q][j];
#pragma unroll
        for (int k = 0; k < 4; ++k) {
            const int tl = tl0 + k;
            const float ic = 1.f / (float)((tl + 1 < win) ? tl + 1 : win);
            float v[8]; float ss = 0.f;
#pragma unroll
            for (int j = 0; j < 8; ++j) { sm[j] += (float)cur_[k][j]; v[j] = (sm[j] * ic - (float)cur_[k][j]) * psc[j]; ss += v[j] * v[j]; }
            const float rstd = rsqrtf(wave_sum(ss) * (1.f / 512.f) + EPS);
            unsigned q0 = 0u, q1 = 0u;
#pragma unroll
            for (int j = 0; j < 8; ++j) { const float qf_ = fminf(fmaxf(v[j] * rstd * psg[j], -127.f), 127.f); const unsigned qb = (unsigned)((int)rintf(qf_) & 255);
                if (j < 4) q0 |= qb << (8 * j); else q1 |= qb << (8 * (j - 4)); }
            *(u64*)(MIX8 + (size_t)(tb + k) * ND + 8 * cg8) = (u64)q0 | ((u64)q1 << 32);
            if (k < 3) {
#pragma unroll
                for (int j = 0; j < 8; ++j) {
                    const int q = 16 - win + k;
                    float dv = 0.f;
#pragma unroll
                    for (int qq = 0; qq < 15; ++qq) if (qq == q) dv = (float)hist_[qq][j];
#pragma unroll
                    for (int kk = 0; kk < 3; ++kk) if (q == 15 + kk) dv = (float)cur_[kk][j];
                    sm[j] -= dv;
                }
            }
        }
    }
}


typedef float f32x2 __attribute__((ext_vector_type(2)));
typedef unsigned u32x4 __attribute__((ext_vector_type(4)));

constexpr int IDX_KPITCH = 16384 + 16;
constexpr int IDX_HPITCH = 516;
template <int NBL>
__device__ __forceinline__ int wave_pick(const unsigned (&cc)[NBL], unsigned target, int lane, unsigned& rem_out) {
    unsigned tot = 0u;
#pragma unroll
    for (int j = 0; j < NBL; ++j) tot += cc[j];
    unsigned S = tot;
#pragma unroll
    for (int o = 1; o < 64; o <<= 1) { const unsigned v = __shfl_down(S, o); if (lane + o < 64) S += v; }
    const unsigned above = S - tot;
    const bool hit = (above < target) && (S >= target);
    const u64 bal = __ballot(hit);
    const int L = bal ? __builtin_ctzll(bal) : 0;
    int bin = 0; unsigned rem = target;
    { unsigned run = above; bool done = false;
#pragma unroll
      for (int j = NBL - 1; j >= 0; --j) { if (!done) { if (run + cc[j] >= target) { bin = NBL * lane + j; rem = target - run; done = true; } else run += cc[j]; } } }
    bin = __shfl(bin, L); rem_out = __shfl(rem, L);
    return bin;
}
template <int MODE>
__device__ __forceinline__ void ph3_index_fast(const Args& a, int bid, int nb, unsigned char* lds) {
    int tid = threadIdx.x; asm volatile("" : "+v"(tid));
    const int lane = tid & 63, wave = __builtin_amdgcn_readfirstlane(tid >> 6), r = lane & 31, hh = lane >> 5;
    const f16* QI = (const f16*)(a.ws + WS_QI); const f16* KI = (const f16*)(a.ws + WS_KI); const float* WI = (const float*)(a.ws + WS_WI);
    u64* MASK = (u64*)(a.ws + WS_MASK);
    unsigned* hist = (unsigned*)(lds + 8 * IDX_KPITCH);
    f16x8 af[2][4]; f32x2 wv2[2][8];
#define IDX_LOAD_FRAGS(t0_) do { \
        _Pragma("unroll") for (int rt = 0; rt < 2; ++rt) { \
            _Pragma("unroll") for (int ks = 0; ks < 4; ++ks) af[rt][ks] = *(const f16x8*)(QI + ((((((size_t)((t0_) >> 3) * 2 + rt) * 4 + ks) * 2 + hh) * 32 + r) << 3)); \
            _Pragma("unroll") for (int qq = 0; qq < 2; ++qq) { const float* wp = WI + (size_t)((t0_) + 4 * rt + 2 * hh + qq) * 8; const f32x4 w0 = *(const f32x4*)wp * 0.125f, w1 = *(const f32x4*)(wp + 4) * 0.125f; \
                wv2[rt][4 * qq + 0] = (f32x2){w0[0], w0[1]}; wv2[rt][4 * qq + 1] = (f32x2){w0[2], w0[3]}; wv2[rt][4 * qq + 2] = (f32x2){w1[0], w1[1]}; wv2[rt][4 * qq + 3] = (f32x2){w1[2], w1[3]}; } \
        } } while (0)
    for (int round = 0; round * nb < 256; ++round) {
        const int p = round * nb + ((round & 1) ? (nb - 1 - bid) : bid);
        if (p < 256) { const int tg = p >> 3, b_ = p & 7, t0l = tg * 8, ch_ = t0l >> 6, t0_ = b_ * NS + t0l;
            if (tid < 8 * (ch_ + 1)) { const int q = tid / (ch_ + 1), w = tid % (ch_ + 1); MASK[((size_t)b_ * 128 + w) * NS + t0l + q] = ~0ull; } }
    }
#define IDX_P(round_) ((round_) * nb + (((round_) & 1) ? (nb - 1 - bid) : bid))
    int round = 0;
    while (round * nb < 8192 && !(IDX_P(round) >= 256 && IDX_P(round) < 8192)) ++round;
    if (round * nb < 8192) { const int p0 = IDX_P(round); IDX_LOAD_FRAGS((p0 & 7) * NS + (p0 >> 3) * 8); }
    for (; round * nb < 8192; ) {
        const int p = IDX_P(round);
        int rnext = round + 1;
        while (rnext * nb < 8192 && !(IDX_P(rnext) >= 256 && IDX_P(rnext) < 8192)) ++rnext;
        const bool has_next = rnext * nb < 8192;
        const int pn = has_next ? IDX_P(rnext) : p;
        const int tg = p >> 3, b = p & 7, t0l = tg * 8, ch = t0l >> 6, nadm = 64 * (ch + 1), t0 = b * NS + t0l;
        const int t0n = (pn & 7) * NS + (pn >> 3) * 8;
        round = has_next ? rnext : 8192;
        __syncthreads();
#pragma unroll
        for (int i = 0; i < 9; ++i) if (tid + i * NTHR < 8 * IDX_HPITCH) hist[tid + i * NTHR] = 0u;
        __syncthreads();
        const int nkb = nadm >> 5;
        const f16* kbase = KI + ((size_t)(b * (NS / 32)) * 8 + hh) * 256 + r * 8;
#define IDX_LOADB(dst, kb_) do { _Pragma("unroll") for (int ks = 0; ks < 4; ++ks) dst[ks] = *(const f16x8*)(kbase + ((size_t)(kb_) * 8 + 2 * ks) * 256); } while (0)
#define IDX_BLOCK(bfrag, kb_) do { \
            f32x16 acc[2]; \
            _Pragma("unroll") for (int rt = 0; rt < 2; ++rt) { acc[rt] = (f32x16){0.f, 0.f, 0.f, 0.f, 0.f, 0.f, 0.f, 0.f, 0.f, 0.f, 0.f, 0.f, 0.f, 0.f, 0.f, 0.f}; \
                _Pragma("unroll") for (int ks = 0; ks < 4; ++ks) acc[rt] = __builtin_amdgcn_mfma_f32_32x32x16_f16(af[rt][ks], bfrag[ks], acc[rt], 0, 0, 0); } \
            _Pragma("unroll") for (int rt = 0; rt < 2; ++rt) \
                _Pragma("unroll") for (int qq = 0; qq < 2; ++qq) { \
                    f32x2 t2 = (f32x2){0.f, 0.f}; \
                    _Pragma("unroll") for (int hp = 0; hp < 4; ++hp) { const f32x2 r2 = (f32x2){__int_as_float(max(__float_as_int(acc[rt][8 * qq + 2 * hp]), 0)), __int_as_float(max(__float_as_int(acc[rt][8 * qq + 2 * hp + 1]), 0))}; \
                        t2 = __builtin_elementwise_fma(wv2[rt][4 * qq + hp], r2, t2); } \
                    const float sc = t2[0] + t2[1]; \
                    const f16 sh = (f16)sc; const unsigned bits = (unsigned)__builtin_bit_cast(unsigned short, sh); \
                    const unsigned key = (bits & 0x8000u) ? (~bits & 0xFFFFu) : (bits | 0x8000u); \
                    const int q = 4 * rt + 2 * hh + qq; \
                    if (MODE != 2) *(u16*)(lds + q * IDX_KPITCH + ((kb_) * 32 + r) * 2) = (u16)key; \
                    if (MODE != 2 && MODE != 4) atomicAdd(&hist[q * IDX_HPITCH + (key >> 7)], (key & 64u) ? 0x10000u : 1u); \
                    if (MODE == 2) sink += key; \
                } } while (0)
        f16x8 bf0[4], bf1[4], bf2[4]; unsigned sink = 0u;
        if (wave >= 4) __builtin_amdgcn_s_sleep(5);
        if (wave < nkb) IDX_LOADB(bf0, wave);
        if (wave + 8 < nkb) IDX_LOADB(bf1, wave + 8);
        if (wave + 16 < nkb) IDX_LOADB(bf2, wave + 16);
        if (MODE != 3) for (int kb = wave; kb < nkb; kb += 24) {
            IDX_BLOCK(bf0, kb);
            if (kb + 24 < nkb) IDX_LOADB(bf0, kb + 24);
            if (kb + 8 < nkb) { IDX_BLOCK(bf1, kb + 8); if (kb + 32 < nkb) IDX_LOADB(bf1, kb + 32); }
            if (kb + 16 < nkb) { IDX_BLOCK(bf2, kb + 16); if (kb + 40 < nkb) IDX_LOADB(bf2, kb + 40); }
        }
#undef IDX_LOADB
#undef IDX_BLOCK
        if (MODE == 2 && sink == 0xdeadbeefu) hist[tid] = sink;
        IDX_LOAD_FRAGS(t0n);
        __syncthreads();
        if (MODE != 1) {
            unsigned* hw = hist + wave * IDX_HPITCH;
            const unsigned char* krow = lds + wave * IDX_KPITCH;
            unsigned rem1 = 0u, rem2 = 0u;
            int b1;
            {   const u32x4 d0 = *(const u32x4*)(hw + 8 * lane), d1 = *(const u32x4*)(hw + 8 * lane + 4);
                const unsigned dd[8] = {d0.x, d0.y, d0.z, d0.w, d1.x, d1.y, d1.z, d1.w};
                unsigned cc[16];
#pragma unroll
                for (int j = 0; j < 8; ++j) { cc[2 * j] = dd[j] & 0xFFFFu; cc[2 * j + 1] = dd[j] >> 16; }
                b1 = wave_pick<16>(cc, 256u, lane, rem1); }
            hw[lane] = 0u;
            const int nit = (nadm + 511) >> 9;
            for (int it = 0; it < nit; ++it) {
                const int idx = (it * 64 + lane) * 8;
                if (idx < nadm) { const u32x4 k4 = *(const u32x4*)(krow + idx * 2);
                    const unsigned kk[4] = {k4.x, k4.y, k4.z, k4.w};
                    unsigned hit = 0u;
#pragma unroll
                    for (int j = 0; j < 4; ++j) { hit |= (((kk[j] & 0xFFFFu) >> 6) == (unsigned)b1 ? 1u : 0u) << (2 * j); hit |= ((kk[j] >> 22) == (unsigned)b1 ? 1u : 0u) << (2 * j + 1); }
                    if (hit) {
#pragma unroll
                        for (int j = 0; j < 4; ++j) { const unsigned k0 = kk[j] & 0xFFFFu, k1 = kk[j] >> 16;
                            if (hit & (1u << (2 * j))) atomicAdd(&hw[k0 & 63u], 1u);
                            if (hit & (2u << (2 * j))) atomicAdd(&hw[k1 & 63u], 1u); }
                    } }
            }
            int b2;
            { const unsigned c1[1] = {hw[lane]}; b2 = wave_pick<1>(c1, rem1, lane, rem2); }
            const unsigned tau = ((unsigned)b1 << 6) | (unsigned)b2;
            const size_t mrow = (size_t)(t0 + wave) * 128;
            for (int it = 0; it < nit; ++it) {
                const int idx = (it * 64 + lane) * 8;
                unsigned byte = 0u;
                if (idx < nadm) { const u32x4 k4 = *(const u32x4*)(krow + idx * 2);
                    const unsigned kk[4] = {k4.x, k4.y, k4.z, k4.w};
#pragma unroll
                    for (int j = 0; j < 4; ++j) { byte |= ((kk[j] & 0xFFFFu) >= tau ? 1u : 0u) << (2 * j); byte |= ((kk[j] >> 16) >= tau ? 1u : 0u) << (2 * j + 1); } }
                unsigned lo = (lane & 4) ? 0u : (byte << (8 * (lane & 3))), hi = (lane & 4) ? (byte << (8 * (lane & 3))) : 0u;
                lo |= __shfl_xor(lo, 1); hi |= __shfl_xor(hi, 1); lo |= __shfl_xor(lo, 2); hi |= __shfl_xor(hi, 2); lo |= __shfl_xor(lo, 4); hi |= __shfl_xor(hi, 4);
                if ((lane & 7) == 0 && idx < nadm) { hw[64 + 2 * (it * 8 + (lane >> 3))] = lo; hw[64 + 2 * (it * 8 + (lane >> 3)) + 1] = hi; }
            }
        }
        __syncthreads();
        if (MODE != 1) { const int w = tid >> 2, qp = tid & 3;
            if (w <= ch) { const unsigned* ha = hist + (2 * qp) * IDX_HPITCH + 64 + 2 * w; const unsigned* hb = ha + IDX_HPITCH;
                *(u32x4*)(MASK + ((size_t)b * 128 + w) * NS + t0l + 2 * qp) = (u32x4){ha[0], ha[1], hb[0], hb[1]}; } }
    }
    __syncthreads();
}

constexpr int ATP = 144;
constexpr int ATT_QWORD = 3584 + 32 * 64;
template <int AMODE>
__device__ __forceinline__ void ph4_attn_fast(const Args& a, int bid, int nb, unsigned char* lds) {
    int tid = threadIdx.x; asm volatile("" : "+v"(tid));
    const int lane = tid & 63, wave = __builtin_amdgcn_readfirstlane(tid >> 6), r = lane & 31, hh = lane >> 5;
    const f16* Q = (const f16*)(a.ws + WS_Q); const f16* Kk = (const f16*)(a.ws + WS_K); const f16* VT = (const f16*)(a.ws + WS_VT);
    const u64* MASK = (const u64*)(a.ws + WS_MASK); unsigned char* MIX8 = a.ws + WS_H; const float* og = a.in[11];
    unsigned char* Kl = lds; unsigned char* Vl = lds + 2 * 64 * ATP;
    const float LOG2E = 1.4426950408889634f, OFF = 8192.f;
    const int pir = 16 * (r >> 4) + 8 * ((r >> 2) & 1) + 4 * ((r >> 3) & 1) + (r & 3);
    const int srow = tid >> 3, schk = tid & 7;
    unsigned* aq = (unsigned*)(a.ws + WS_CTL) + ATT_QWORD;
    lds_u32* ucell = (lds_u32*)(lds + 6 * 64 * ATP);
    lds_u32* dflag = ucell + 8;
    const float kmax = __int_as_float(__builtin_amdgcn_readfirstlane(__float_as_int(1.01f * 8.f * wave_max(fabsf(a.in[10][lane])))));
    int upar = 0;
    for (;;) {
        if (tid == 0) ucell[upar] = __hip_atomic_fetch_add(aq, 1u, __ATOMIC_RELAXED, __HIP_MEMORY_SCOPE_AGENT);
        if (tid < 8) dflag[tid] = 0u;
        __syncthreads();
        const unsigned u = ucell[upar]; upar ^= 1;
        if (u >= 2048u) break;
        const int h = 7 - (int)(u >> 8), qb = 31 - (int)((u & 255u) >> 3), b = (int)(u & 7u);
        const int q0l = qb * 256, tq = q0l + 32 * wave + r, cw = 4 * qb + (wave >> 1), top = 4 * qb + 3;
        const size_t t = (size_t)b * NS + tq;
        const float slope = exp2f(-(float)(h + 1)) * LOG2E;
        f16x8 qf[4];
#pragma unroll
        for (int ks = 0; ks < 4; ++ks) { const f16x8 qv = *(const f16x8*)(Q + t * 512 + h * 64 + 16 * ks + 8 * hh);
#pragma unroll
            for (int j = 0; j < 8; ++j) qf[ks][j] = (f16)((float)qv[j] * (0.125f * LOG2E)); }
        float qss = 0.f;
#pragma unroll
        for (int ks = 0; ks < 4; ++ks)
#pragma unroll
            for (int j = 0; j < 8; ++j) qss += (float)qf[ks][j] * (float)qf[ks][j];
        qss += __shfl_xor(qss, 32);
        const float Sb = __int_as_float(__builtin_amdgcn_readfirstlane(__float_as_int(wave_max(sqrtf(qss)) * kmax)));
        const float rowc = OFF + slope * (float)(tq - q0l);
        float m = 1000.f, l = 0.f;
        f32x16 O[2];
#pragma unroll
        for (int dt = 0; dt < 2; ++dt) O[dt] = (f32x16){0.f, 0.f, 0.f, 0.f, 0.f, 0.f, 0.f, 0.f, 0.f, 0.f, 0.f, 0.f, 0.f, 0.f, 0.f, 0.f};
        const f16* kg = Kk + ((size_t)b * NS + srow) * 512 + h * 64 + schk * 8;
        const f16* vg = VT + (size_t)(h * 64 + srow) * NT + (size_t)b * NS + schk * 8;
        f16x8 kr0, kr1, vr0, vr1; u64 mw0 = 0ull, mw1 = 0ull;
#define ATT_LOAD(kr, vr, mwv, jj) do { const int jc_ = (jj) > 0 ? (jj) : 0; kr = *(const f16x8*)(kg + (size_t)jc_ * 64 * 512); vr = *(const f16x8*)(vg + jc_ * 64); \
            mwv = MASK[((size_t)b * 128 + jc_) * NS + tq]; } while (0)
        asm volatile("" ::: "memory"); ATT_LOAD(kr0, vr0, mw0, top); asm volatile("" ::: "memory"); ATT_LOAD(kr1, vr1, mw1, top - 1); asm volatile("" ::: "memory");
        int buf = 0; bool wdone = false, stop = false;
        auto step = [&](f16x8& kreg, f16x8& vreg, u64& mwr, const int j) {
            *(f16x8*)(Kl + buf * 64 * ATP + srow * ATP + schk * 16) = kreg;
            *(f16x8*)(Vl + buf * 64 * ATP + srow * ATP + schk * 16) = vreg;
            const u64 mw = (j <= cw) ? mwr : 0ull;
            asm volatile("s_waitcnt lgkmcnt(0)" ::: "memory"); __builtin_amdgcn_s_barrier(); asm volatile("" ::: "memory");
            {
                const unsigned jp = (unsigned)(j + 1);
                const unsigned d0 = dflag[0], d1 = dflag[1], d2 = dflag[2], d3 = dflag[3], d4 = dflag[4], d5 = dflag[5], d6 = dflag[6], d7 = dflag[7];
                if ((d0 > jp) & (d1 > jp) & (d2 > jp) & (d3 > jp) & (d4 > jp) & (d5 > jp) & (d6 > jp) & (d7 > jp)) { stop = true; return; }
            }
            asm volatile("" ::: "memory"); ATT_LOAD(kreg, vreg, mwr, j - 2); asm volatile("" ::: "memory");
            if (!wdone && j < cw) { const float lmax = Sb + OFF + slope * (float)(64 * j + 63 - q0l); if (__all(lmax - m < -28.f)) { wdone = true; if (lane == 0) dflag[wave] = (unsigned)(j + 1); } }
            if (j <= cw && !wdone) {
                const unsigned char* kb_ = Kl + buf * 64 * ATP + pir * ATP + 16 * hh;
                f16x8 fr8[8];
#pragma unroll
                for (int kt = 0; kt < 2; ++kt)
#pragma unroll
                    for (int ks = 0; ks < 4; ++ks) fr8[kt * 4 + ks] = *(const f16x8*)(kb_ + kt * 32 * ATP + ks * 32);
                f32x16 sa[2];
                if (j == cw) {
#pragma unroll
                    for (int kt = 0; kt < 2; ++kt)
#pragma unroll
                        for (int rg = 0; rg < 16; ++rg) { const float x = (float)(64 * j + 32 * kt + 16 * (rg >> 3) + 8 * hh + (rg & 7) - tq); sa[kt][rg] = rowc - slope * fabsf(x); }
                } else {
                    const float base = OFF + slope * (float)(64 * j + 8 * hh - q0l);
#pragma unroll
                    for (int kt = 0; kt < 2; ++kt)
#pragma unroll
                        for (int rg = 0; rg < 16; ++rg) sa[kt][rg] = __builtin_fmaf(slope, (float)(32 * kt + 16 * (rg >> 3) + (rg & 7)), base);
                }
                __builtin_amdgcn_sched_barrier(0);
                __builtin_amdgcn_s_setprio(1);
#pragma unroll
                for (int kt = 0; kt < 2; ++kt)
#pragma unroll
                    for (int ks = 0; ks < 4; ++ks) sa[kt] = __builtin_amdgcn_mfma_f32_32x32x16_f16(fr8[kt * 4 + ks], qf[ks], sa[kt], 0, 0, 0);
                __builtin_amdgcn_s_setprio(0);
                __builtin_amdgcn_sched_barrier(0);
                const unsigned char* vb_ = Vl + buf * 64 * ATP + r * ATP + 16 * hh;
#pragma unroll
                for (int dt = 0; dt < 2; ++dt)
#pragma unroll
                    for (int kt = 0; kt < 2; ++kt)
#pragma unroll
                        for (int s2 = 0; s2 < 2; ++s2) fr8[dt * 4 + kt * 2 + s2] = *(const f16x8*)(vb_ + dt * 32 * ATP + kt * 64 + s2 * 32);
                __builtin_amdgcn_sched_barrier(0);
                float rm = 0.f;
#pragma unroll
                for (int kt = 0; kt < 2; ++kt) { const unsigned w32 = (unsigned)(kt ? (mw >> 32) : mw) >> (8 * hh);
#pragma unroll
                    for (int rg = 0; rg < 16; ++rg) { const int tm = __builtin_amdgcn_sbfe((int)w32, 16 * (rg >> 3) + (rg & 7), 1);
                        const float L = __int_as_float(__float_as_int(sa[kt][rg]) & tm); sa[kt][rg] = L; rm = fmaxf(rm, L); } }
                rm = fmaxf(rm, __shfl_xor(rm, 32));
                const float mn = fmaxf(m, rm);
                if (__any(mn > m)) { const float al = __builtin_amdgcn_exp2f(m - mn); l *= al;
#pragma unroll
                    for (int dt = 0; dt < 2; ++dt)
#pragma unroll
                        for (int rg = 0; rg < 16; ++rg) O[dt][rg] *= al; }
                m = mn;
                f16x8 pf[2][2];
                float l0 = 0.f, l1 = 0.f;
#pragma unroll
                for (int kt = 0; kt < 2; ++kt)
#pragma unroll
                    for (int rg = 0; rg < 16; ++rg) { const float pp = __builtin_amdgcn_exp2f(sa[kt][rg] - m); if (rg & 1) l1 += pp; else l0 += pp; pf[kt][rg >> 3][rg & 7] = (f16)pp; }
                l += l0 + l1;
                __builtin_amdgcn_sched_barrier(0);
                __builtin_amdgcn_s_setprio(1);
#pragma unroll
                for (int dt = 0; dt < 2; ++dt)
#pragma unroll
                    for (int kt = 0; kt < 2; ++kt)
#pragma unroll
                        for (int s2 = 0; s2 < 2; ++s2) O[dt] = __builtin_amdgcn_mfma_f32_32x32x16_f16(fr8[dt * 4 + kt * 2 + s2], pf[kt][s2], O[dt], 0, 0, 0);
                __builtin_amdgcn_s_setprio(0);
            }
            buf ^= 1;
        };
        for (int j = top; j >= 0; j -= 2) {
            step(kr0, vr0, mw0, j); if (stop) break;
            step(kr1, vr1, mw1, j - 1); if (stop) break;
        }
#undef ATT_LOAD
        l += __shfl_xor(l, 32);
        const float inv = 1.f / l;
        float ss = 0.f;
#pragma unroll
        for (int dt = 0; dt < 2; ++dt)
#pragma unroll
            for (int rg = 0; rg < 16; ++rg) { O[dt][rg] *= inv; ss += O[dt][rg] * O[dt][rg]; }
        ss += __shfl_xor(ss, 32);
        const float rstd = rsqrtf(ss * (1.f / 64.f) + EPS);
#pragma unroll
        for (int dt = 0; dt < 2; ++dt)
#pragma unroll
            for (int g4 = 0; g4 < 4; ++g4) { const int d = 32 * dt + 8 * g4 + 4 * hh; const f32x4 gg = *(const f32x4*)(og + h * 64 + d);
                unsigned pk = 0u;
#pragma unroll
                for (int e = 0; e < 4; ++e) { const float sg = gg[e] > 0.f ? MIXQ : (gg[e] < 0.f ? -MIXQ : 0.f); const float qf_ = fminf(fmaxf(O[dt][4 * g4 + e] * rstd * sg, -127.f), 127.f);
                    pk |= (unsigned)((int)rintf(qf_) & 255) << (8 * e); }
                *(unsigned*)(MIX8 + t * ND + 512 + h * 64 + d) = pk; }
        __syncthreads();
    }
}

__device__ __forceinline__ void ph5_outproj(const Args& a, int bid, int nb, unsigned char* lds) {
    pg8::Gemm g{(const f16*)(a.ws + WS_H), (const f16*)(a.ws + WS_WOUT8), NT, 1024, ND / 2}; pg8::StaticOrder S; S.init(NT, 1024, nb, bid);
    pg8::EpiOut E{a.in[0], (const float*)(a.ws + WS_MOD), (f16*)(a.ws + WS_X1), (const float*)(a.ws + WS_WSCIN) + 4096};
    pg8::gemm_phase<pg8::EpiOut, true>((PG8_LAS unsigned char*)lds, g, S, E);
}

__device__ __forceinline__ void ph7_peerq(const Args& a, int bid, int nb, unsigned char* lds) {
    pg8::Gemm g{(const f16*)(a.ws + WS_HQ), (const f16*)(a.ws + WS_WQ8), NT, 2048, ND / 2}; pg8::StaticOrder S; S.init(NT, 2048, nb, bid);
    pg8::EpiPQ E{(f16*)(a.ws + WS_PQ), (const float*)(a.ws + WS_HSC), (const float*)(a.ws + WS_WSC)};
    pg8::gemm_phase<pg8::EpiPQ, true>((PG8_LAS unsigned char*)lds, g, S, E);
}


__device__ __forceinline__ unsigned f2skey(float f) { const unsigned u = __float_as_uint(f); return (u & 0x80000000u) ? ~u : (u | 0x80000000u); }
__device__ __forceinline__ float skey2f(unsigned k) { return __uint_as_float((k & 0x80000000u) ? (k & 0x7FFFFFFFu) : ~k); }
#define CE_(a_, b_) do { const unsigned t__ = max(a_, b_); b_ = min(a_, b_); a_ = t__; } while (0)
#define SORT16_DESC(v) do { CE_(v[0], v[1]); CE_(v[2], v[3]); CE_(v[0], v[2]); CE_(v[1], v[3]); CE_(v[1], v[2]); CE_(v[4], v[5]); CE_(v[6], v[7]); CE_(v[4], v[6]); CE_(v[5], v[7]); CE_(v[5], v[6]); CE_(v[0], v[4]); CE_(v[2], v[6]); CE_(v[2], v[4]); CE_(v[1], v[5]); CE_(v[3], v[7]); CE_(v[3], v[5]); CE_(v[1], v[2]); CE_(v[3], v[4]); CE_(v[5], v[6]); CE_(v[8], v[9]); CE_(v[10], v[11]); CE_(v[8], v[10]); CE_(v[9], v[11]); CE_(v[9], v[10]); CE_(v[12], v[13]); CE_(v[14], v[15]); CE_(v[12], v[14]); CE_(v[13], v[15]); CE_(v[13], v[14]); CE_(v[8], v[12]); CE_(v[10], v[14]); CE_(v[10], v[12]); CE_(v[9], v[13]); CE_(v[11], v[15]); CE_(v[11], v[13]); CE_(v[9], v[10]); CE_(v[11], v[12]); CE_(v[13], v[14]); CE_(v[0], v[8]); CE_(v[4], v[12]); CE_(v[4], v[8]); CE_(v[2], v[10]); CE_(v[6], v[14]); CE_(v[6], v[10]); CE_(v[2], v[4]); CE_(v[6], v[8]); CE_(v[10], v[12]); CE_(v[1], v[9]); CE_(v[5], v[13]); CE_(v[5], v[9]); CE_(v[3], v[11]); CE_(v[7], v[15]); CE_(v[7], v[11]); CE_(v[3], v[5]); CE_(v[7], v[9]); CE_(v[11], v[13]); CE_(v[1], v[2]); CE_(v[3], v[4]); CE_(v[5], v[6]); CE_(v[7], v[8]); CE_(v[9], v[10]); CE_(v[11], v[12]); CE_(v[13], v[14]); } while (0)
#define BITONIC16_DESC(v) do { CE_(v[0], v[8]); CE_(v[1], v[9]); CE_(v[2], v[10]); CE_(v[3], v[11]); CE_(v[4], v[12]); CE_(v[5], v[13]); CE_(v[6], v[14]); CE_(v[7], v[15]); CE_(v[0], v[4]); CE_(v[1], v[5]); CE_(v[2], v[6]); CE_(v[3], v[7]); CE_(v[8], v[12]); CE_(v[9], v[13]); CE_(v[10], v[14]); CE_(v[11], v[15]); CE_(v[0], v[2]); CE_(v[1], v[3]); CE_(v[4], v[6]); CE_(v[5], v[7]); CE_(v[8], v[10]); CE_(v[9], v[11]); CE_(v[12], v[14]); CE_(v[13], v[15]); CE_(v[0], v[1]); CE_(v[2], v[3]); CE_(v[4], v[5]); CE_(v[6], v[7]); CE_(v[8], v[9]); CE_(v[10], v[11]); CE_(v[12], v[13]); CE_(v[14], v[15]); } while (0)
#define MERGE16_DESC(dst, other) do { unsigned c__[16]; _Pragma("unroll") for (int i__ = 0; i__ < 16; ++i__) c__[i__] = max(dst[i__], other[15 - i__]); BITONIC16_DESC(c__); _Pragma("unroll") for (int i__ = 0; i__ < 16; ++i__) dst[i__] = c__[i__]; } while (0)
#define TOP16_INSERT(v, x_) do { unsigned x__ = (x_); _Pragma("unroll") for (int k_ = 0; k_ < 16; ++k_) { const unsigned t__ = max(v[k_], x__); x__ = min(v[k_], x__); v[k_] = t__; } } while (0)
__device__ __forceinline__ void ph8_peersel_fast(const Args& a, int bid, int nb, unsigned char* lds) {
    int tid = threadIdx.x; asm volatile("" : "+v"(tid));
    const int lane = tid & 63, wave = __builtin_amdgcn_readfirstlane(tid >> 6), r = lane & 31, hh = lane >> 5;
    const f16* PQ = (const f16*)(a.ws + WS_PQ);
    u16* EID = (u16*)(a.ws + WS_EID); float* GW = (float*)(a.ws + WS_GW);
    unsigned char* wl = lds + wave * 2048 + lane * 32;
    for (int item = bid * NWAVE + wave; item < (NT / 32) * 8; item += nb * NWAVE) {
        const int tt = item >> 3, h = item & 7, t0 = tt * 32;
        unsigned top[2][16];
#pragma unroll
        for (int p = 0; p < 2; ++p) {
            f16x8 sq[8];
#pragma unroll
            for (int c = 0; c < 8; ++c) sq[c] = *(const f16x8*)(PQ + ((((size_t)tt * 256 + h * 32 + p * 16 + 8 * hh + c) * 32 + r) << 3));
#pragma unroll
            for (int k = 0; k < 16; ++k) top[p][k] = 0u;
#pragma unroll
            for (int g = 0; g < 4; ++g) {
                unsigned ky[16];
#pragma unroll
                for (int i = 0; i < 16; ++i) { const unsigned n = 64u * hh + 16u * g + i; ky[i] = (f2skey((float)sq[2 * g + (i >> 3)][i & 7]) & ~127u) | n; }
                SORT16_DESC(ky); MERGE16_DESC(top[p], ky);
            }
            unsigned oth[16];
#pragma unroll
            for (int k = 0; k < 16; ++k) oth[k] = __shfl_xor(top[p][k], 32);
            MERGE16_DESC(top[p], oth);
            asm volatile("" ::: "memory");
        }
#pragma unroll
        for (int k = 0; k < 16; k += 4) {
            *(unsigned*)(wl + k) = (top[0][k] & 127u) | ((top[0][k + 1] & 127u) << 8) | ((top[0][k + 2] & 127u) << 16) | ((top[0][k + 3] & 127u) << 24);
            *(unsigned*)(wl + 16 + k) = (top[1][k] & 127u) | ((top[1][k + 1] & 127u) << 8) | ((top[1][k + 2] & 127u) << 16) | ((top[1][k + 3] & 127u) << 24);
        }
        float fa[16], fb[16];
#pragma unroll
        for (int k = 0; k < 16; ++k) { fa[k] = skey2f(top[0][k] & ~127u); fb[k] = skey2f(top[1][k] & ~127u); }
        unsigned cg[4][16];
        cg[0][0] = (f2skey(fa[0] + fb[0]) & ~255u) | 0u;
        cg[0][1] = (f2skey(fa[0] + fb[1]) & ~255u) | 1u;
        cg[0][2] = (f2skey(fa[0] + fb[2]) & ~255u) | 2u;
        cg[0][3] = (f2skey(fa[0] + fb[3]) & ~255u) | 3u;
        cg[0][4] = (f2skey(fa[0] + fb[4]) & ~255u) | 4u;
        cg[0][5] = (f2skey(fa[0] + fb[5]) & ~255u) | 5u;
        cg[0][6] = (f2skey(fa[0] + fb[6]) & ~255u) | 6u;
        cg[0][7] = (f2skey(fa[0] + fb[7]) & ~255u) | 7u;
        cg[0][8] = (f2skey(fa[0] + fb[8]) & ~255u) | 8u;
        cg[0][9] = (f2skey(fa[0] + fb[9]) & ~255u) | 9u;
        cg[0][10] = (f2skey(fa[0] + fb[10]) & ~255u) | 10u;
        cg[0][11] = (f2skey(fa[0] + fb[11]) & ~255u) | 11u;
        cg[0][12] = (f2skey(fa[0] + fb[12]) & ~255u) | 12u;
        cg[0][13] = (f2skey(fa[0] + fb[13]) & ~255u) | 13u;
        cg[0][14] = (f2skey(fa[0] + fb[14]) & ~255u) | 14u;
        cg[0][15] = (f2skey(fa[0] + fb[15]) & ~255u) | 15u;
        cg[1][0] = (f2skey(fa[1] + fb[0]) & ~255u) | 16u;
        cg[1][1] = (f2skey(fa[1] + fb[1]) & ~255u) | 17u;
        cg[1][2] = (f2skey(fa[1] + fb[2]) & ~255u) | 18u;
        cg[1][3] = (f2skey(fa[1] + fb[3]) & ~255u) | 19u;
        cg[1][4] = (f2skey(fa[1] + fb[4]) & ~255u) | 20u;
        cg[1][5] = (f2skey(fa[1] + fb[5]) & ~255u) | 21u;
        cg[1][6] = (f2skey(fa[1] + fb[6]) & ~255u) | 22u;
        cg[1][7] = (f2skey(fa[1] + fb[7]) & ~255u) | 23u;
        cg[1][8] = (f2skey(fa[2] + fb[0]) & ~255u) | 32u;
        cg[1][9] = (f2skey(fa[2] + fb[1]) & ~255u) | 33u;
        cg[1][10] = (f2skey(fa[2] + fb[2]) & ~255u) | 34u;
        cg[1][11] = (f2skey(fa[2] + fb[3]) & ~255u) | 35u;
        cg[1][12] = (f2skey(fa[2] + fb[4]) & ~255u) | 36u;
        cg[1][13] = (f2skey(fa[3] + fb[0]) & ~255u) | 48u;
        cg[1][14] = (f2skey(fa[3] + fb[1]) & ~255u) | 49u;
        cg[1][15] = (f2skey(fa[3] + fb[2]) & ~255u) | 50u;
        cg[2][0] = (f2skey(fa[3] + fb[3]) & ~255u) | 51u;
        cg[2][1] = (f2skey(fa[4] + fb[0]) & ~255u) | 64u;
        cg[2][2] = (f2skey(fa[4] + fb[1]) & ~255u) | 65u;
        cg[2][3] = (f2skey(fa[4] + fb[2]) & ~255u) | 66u;
        cg[2][4] = (f2skey(fa[5] + fb[0]) & ~255u) | 80u;
        cg[2][5] = (f2skey(fa[5] + fb[1]) & ~255u) | 81u;
        cg[2][6] = (f2skey(fa[6] + fb[0]) & ~255u) | 96u;
        cg[2][7] = (f2skey(fa[6] + fb[1]) & ~255u) | 97u;
        cg[2][8] = (f2skey(fa[7] + fb[0]) & ~255u) | 112u;
        cg[2][9] = (f2skey(fa[7] + fb[1]) & ~255u) | 113u;
        cg[2][10] = (f2skey(fa[8] + fb[0]) & ~255u) | 128u;
        cg[2][11] = (f2skey(fa[9] + fb[0]) & ~255u) | 144u;
        cg[2][12] = (f2skey(fa[10] + fb[0]) & ~255u) | 160u;
        cg[2][13] = (f2skey(fa[11] + fb[0]) & ~255u) | 176u;
        cg[2][14] = (f2skey(fa[12] + fb[0]) & ~255u) | 192u;
        cg[2][15] = (f2skey(fa[13] + fb[0]) & ~255u) | 208u;
        cg[3][0] = (f2skey(fa[14] + fb[0]) & ~255u) | 224u;
        cg[3][1] = (f2skey(fa[15] + fb[0]) & ~255u) | 240u;
        cg[3][2] = 0u;
        cg[3][3] = 0u;
        cg[3][4] = 0u;
        cg[3][5] = 0u;
        cg[3][6] = 0u;
        cg[3][7] = 0u;
        cg[3][8] = 0u;
        cg[3][9] = 0u;
        cg[3][10] = 0u;
        cg[3][11] = 0u;
        cg[3][12] = 0u;
        cg[3][13] = 0u;
        cg[3][14] = 0u;
        cg[3][15] = 0u;
        SORT16_DESC(cg[0]); SORT16_DESC(cg[1]); SORT16_DESC(cg[2]); SORT16_DESC(cg[3]);
        MERGE16_DESC(cg[0], cg[1]); MERGE16_DESC(cg[2], cg[3]); MERGE16_DESC(cg[0], cg[2]);
        unsigned ct[16];
#pragma unroll
        for (int k = 0; k < 16; ++k) ct[k] = cg[0][k];
        float sc[16]; float den = 0.f; const float s0 = skey2f(ct[0] & ~255u);
#pragma unroll
        for (int k = 0; k < 16; ++k) { sc[k] = __expf(skey2f(ct[k] & ~255u) - s0); den += sc[k]; }
        const float inv = 1.f / den;
        if (hh == 0) {
            u16 ev[16];
#pragma unroll
            for (int k = 0; k < 16; ++k) { const unsigned ij = ct[k] & 255u; const unsigned i1 = wl[ij >> 4], i2 = wl[16 + (ij & 15u)]; ev[k] = (u16)(i1 * 128u + i2); }
            const size_t o = (size_t)(t0 + r) * 128 + h * 16;
#pragma unroll
            for (int k = 0; k < 16; k += 8) {
                *(u32x4*)(EID + o + k) = (u32x4){(unsigned)ev[k] | ((unsigned)ev[k + 1] << 16), (unsigned)ev[k + 2] | ((unsigned)ev[k + 3] << 16), (unsigned)ev[k + 4] | ((unsigned)ev[k + 5] << 16), (unsigned)ev[k + 6] | ((unsigned)ev[k + 7] << 16)};
            }
#pragma unroll
            for (int k = 0; k < 16; k += 4) *(f32x4*)(GW + o + k) = (f32x4){sc[k] * inv, sc[k + 1] * inv, sc[k + 2] * inv, sc[k + 3] * inv};
        }
    }
}

typedef _Float16 f16x2 __attribute__((ext_vector_type(2)));
__device__ __forceinline__ float gelu_erf(float d) { return 0.5f * d * (1.f + erff(d * 0.70710678118654752f)); }
constexpr int PQ_WORD0 = 3584, PQ_CHUNK = 64, PQ_NCHUNK = NT / PQ_CHUNK, PQ_HALF = PQ_NCHUNK / 2;
constexpr size_t WS_PART = 208 * MiB;
__device__ __forceinline__ unsigned xcc_id_() { return (unsigned)__builtin_amdgcn_s_getreg((3 << 11) | 20) & 7u; }
template <int VPHASE>
__device__ __forceinline__ void ph9_sliced(const Args& a, unsigned char* lds) {
    int tid_ = threadIdx.x; asm volatile("" : "+v"(tid_)); const int lane = tid_ & 63, wave = __builtin_amdgcn_readfirstlane(tid_ >> 6);
    const int g8 = lane >> 3, c8 = lane & 7;
    const unsigned char* HP = a.ws + WS_HP; const float* HSC = (const float*)(a.ws + WS_HSC); const unsigned char* TAB = a.ws + (VPHASE ? WS_VP : WS_UT);
    const u16* EID = (const u16*)(a.ws + WS_EID); const f16* GWH = (const f16*)(a.ws + WS_GWH); float* PART = (float*)(a.ws + WS_PART); const float* WSUM = (const float*)(a.ws + WS_WSUM);
    const float* mod = (const float*)(a.ws + WS_MOD); float* out = a.out; const f16* X1 = (const f16*)(a.ws + WS_X1);
    unsigned* qw = (unsigned*)(a.ws + WS_CTL) + PQ_WORD0 + (VPHASE ? 8 * 64 : 0);
    volatile unsigned* cslot = (volatile unsigned*)lds;
    const bool b5 = (lane & 32) != 0, b4 = (lane & 16) != 0, b3 = (lane & 8) != 0, b2 = (lane & 4) != 0, b1 = (lane & 2) != 0, b0 = (lane & 1) != 0;
    const unsigned x0 = xcc_id_();
    int par = 0;
    for (int k = 0; k < 8; ++k) {
        const unsigned qi_ = (x0 + (unsigned)k) & 7u, sl = qi_ & 3u, half = qi_ >> 2;
        unsigned cur = 0u;
        if (tid_ == 0) cur = __hip_atomic_fetch_add(qw + 64 * qi_, 1u, __ATOMIC_RELAXED, __HIP_MEMORY_SCOPE_AGENT);
        for (;;) {
            if (tid_ == 0) cslot[par] = cur;
            __syncthreads();
            const unsigned c = cslot[par]; par ^= 1;
            if (c >= (unsigned)PQ_HALF) break;
            if (tid_ == 0) cur = __hip_atomic_fetch_add(qw + 64 * qi_, 1u, __ATOMIC_RELAXED, __HIP_MEMORY_SCOPE_AGENT);
            const int tb = (int)(half * PQ_HALF + c) * PQ_CHUNK + wave * (PQ_CHUNK / NWAVE);
            const unsigned char* tsl = TAB + 128 * sl + 16 * c8;
#pragma unroll 1
            for (int i8 = 0; i8 < PQ_CHUNK / NWAVE; ++i8) {
                const int t = tb + i8;
                const u32x4 e0 = *(const u32x4*)(EID + (size_t)t * 128 + 16 * g8), e1 = *(const u32x4*)(EID + (size_t)t * 128 + 16 * g8 + 8);
                const unsigned ew[8] = {e0.x, e0.y, e0.z, e0.w, e1.x, e1.y, e1.z, e1.w};
                u32x4 r8[16];
#pragma unroll
                for (int i = 0; i < 16; ++i) { const unsigned eid = (i & 1) ? (ew[i >> 1] >> 16) : (ew[i >> 1] & 0xFFFFu); r8[i] = *(const u32x4*)(tsl + (size_t)eid * 512); }
                if (!VPHASE) {
                    const u32x4 hh4 = *(const u32x4*)(HP + (size_t)t * 1024 + 128 * sl + 16 * c8), hl4 = *(const u32x4*)(HP + (size_t)t * 1024 + 512 + 128 * sl + 16 * c8);
                    const float hsc = 0.5f * HSC[t];
                    int hs1 = 0, hs0 = 0;
#pragma unroll
                    for (int j = 0; j < 4; ++j) { hs1 = __builtin_amdgcn_sdot8((int)hh4[j], 0x11111111, hs1, false); hs0 = __builtin_amdgcn_sdot8((int)hl4[j], 0x11111111, hs0, false); }
                    const int hsum = 16 * hs1 + hs0;
                    float p[16];
#pragma unroll
                    for (int i = 0; i < 16; ++i) { int d1 = 0, d0 = 0;
#pragma unroll
                        for (int j = 0; j < 4; ++j) { d1 = __builtin_amdgcn_sdot8((int)hh4[j], (int)r8[i][j], d1, false); d0 = __builtin_amdgcn_sdot8((int)hl4[j], (int)r8[i][j], d0, false); }
                        p[i] = (float)(2 * (16 * d1 + d0) + hsum); }
                    float q8[8], q4[4], r2[2];
#pragma unroll
                    for (int ii = 0; ii < 8; ++ii) { const float keep = b2 ? p[8 + ii] : p[ii], send = b2 ? p[ii] : p[8 + ii]; q8[ii] = keep + __shfl_xor(send, 4); }
#pragma unroll
                    for (int ii = 0; ii < 4; ++ii) { const float keep = b1 ? q8[4 + ii] : q8[ii], send = b1 ? q8[ii] : q8[4 + ii]; q4[ii] = keep + __shfl_xor(send, 2); }
#pragma unroll
                    for (int ii = 0; ii < 2; ++ii) { const float keep = b0 ? q4[2 + ii] : q4[ii], send = b0 ? q4[ii] : q4[2 + ii]; r2[ii] = keep + __shfl_xor(send, 1); }
                    *(f32x2*)(PART + ((size_t)sl * NT + t) * 128 + 16 * g8 + 2 * c8) = (f32x2){r2[0] * hsc, r2[1] * hsc};
                } else {
                    const u32x4* wp = (const u32x4*)(GWH + (size_t)t * 128 + 16 * g8);
                    const u32x4 wq0 = wp[0], wq1 = wp[1];
                    const unsigned wv[8] = {wq0[0], wq0[1], wq0[2], wq0[3], wq1[0], wq1[1], wq1[2], wq1[3]};
                    const f16 off = (f16)(-7.5f * 5.9604644775390625e-08f * WSUM[(size_t)t * 8 + g8]);
                    f16x2 acc2[16];
#pragma unroll
                    for (int j = 0; j < 16; ++j) acc2[j] = (f16x2){off, off};
#pragma unroll
                    for (int i = 0; i < 16; ++i) { const f16x2 wp2 = __builtin_bit_cast(f16x2, wv[i >> 1]); const f16x2 wp2b = wp2 * (f16x2){(f16)0.0625f, (f16)0.0625f};
                        const f16x2 wa = (i & 1) ? (f16x2){wp2[1], wp2[1]} : (f16x2){wp2[0], wp2[0]}, wb = (i & 1) ? (f16x2){wp2b[1], wp2b[1]} : (f16x2){wp2b[0], wp2b[0]};
#pragma unroll
                        for (int j = 0; j < 4; ++j) { const unsigned x = r8[i][j], y = x >> 8;
                            acc2[4 * j]     = __builtin_elementwise_fma(wa, __builtin_bit_cast(f16x2, x & 0x000F000Fu), acc2[4 * j]);
                            acc2[4 * j + 1] = __builtin_elementwise_fma(wb, __builtin_bit_cast(f16x2, x & 0x00F000F0u), acc2[4 * j + 1]);
                            acc2[4 * j + 2] = __builtin_elementwise_fma(wa, __builtin_bit_cast(f16x2, y & 0x000F000Fu), acc2[4 * j + 2]);
                            acc2[4 * j + 3] = __builtin_elementwise_fma(wb, __builtin_bit_cast(f16x2, y & 0x00F000F0u), acc2[4 * j + 3]); } }
                    unsigned q8[8], q4[4], r2[2];
#pragma unroll
                    for (int ii = 0; ii < 8; ++ii) { const unsigned lo_ = __builtin_bit_cast(unsigned, acc2[ii]), hi_ = __builtin_bit_cast(unsigned, acc2[8 + ii]); const unsigned keep = b5 ? hi_ : lo_, send = b5 ? lo_ : hi_;
                        q8[ii] = __builtin_bit_cast(unsigned, __builtin_bit_cast(f16x2, keep) + __builtin_bit_cast(f16x2, (unsigned)__shfl_xor((int)send, 32))); }
#pragma unroll
                    for (int ii = 0; ii < 4; ++ii) { const unsigned keep = b4 ? q8[4 + ii] : q8[ii], send = b4 ? q8[ii] : q8[4 + ii];
                        q4[ii] = __builtin_bit_cast(unsigned, __builtin_bit_cast(f16x2, keep) + __builtin_bit_cast(f16x2, (unsigned)__shfl_xor((int)send, 16))); }
#pragma unroll
                    for (int ii = 0; ii < 2; ++ii) { const unsigned keep = b3 ? q4[2 + ii] : q4[ii], send = b3 ? q4[ii] : q4[2 + ii];
                        r2[ii] = __builtin_bit_cast(unsigned, __builtin_bit_cast(f16x2, keep) + __builtin_bit_cast(f16x2, (unsigned)__shfl_xor((int)send, 8))); }
                    const f16x2 ra = __builtin_bit_cast(f16x2, r2[0]), rb = __builtin_bit_cast(f16x2, r2[1]);
                    const int ch = 256 * sl + 32 * c8 + (b5 ? 16 : 0) + (b4 ? 8 : 0) + (b3 ? 4 : 0);
                    float* op = out + (size_t)t * ND + ch; const float* g2 = mod + (t / NS) * 6144 + 5120 + ch;
                    const f16x4 x4 = *(const f16x4*)(X1 + (size_t)t * ND + ch); const f32x4 gg = *(const f32x4*)g2;
                    const float sc_ = 16777216.f / PEER_WSCALE;
                    *(f32x4*)op = (f32x4){(float)x4[0], (float)x4[1], (float)x4[2], (float)x4[3]} + gg * ((f32x4){(float)ra[0], (float)ra[1], (float)rb[0], (float)rb[1]} * sc_);
                }
            }
        }
    }
}
__device__ __forceinline__ void ph9b_combine(const Args& a, int bid, int nb) {
    int tid_ = threadIdx.x; asm volatile("" : "+v"(tid_));
    float* GW = (float*)(a.ws + WS_GW); const float* PART = (const float*)(a.ws + WS_PART); f16* GWH = (f16*)(a.ws + WS_GWH);
    const float du = ((const float*)(a.ws + WS_QS))[0], dv = ((const float*)(a.ws + WS_QS))[1] * PEER_WSCALE;
    const size_t istep = (size_t)nb * NTHR, itot = (size_t)NT * 128 / 4;
    size_t i = (size_t)bid * NTHR + tid_;
#define PQ9B_ONE(sum_, g_, ii_) do { f32x4 w; \
        _Pragma("unroll") for (int j = 0; j < 4; ++j) w[j] = fminf(fmaxf(g_[j] * gelu_erf(sum_[j] * du) * dv, -60000.f), 60000.f);        \
          \
        float ws_ = 0.f; f16x4 pk; \
        _Pragma("unroll") for (int j = 0; j < 4; ++j) { const f16 hw_ = (f16)w[j]; ws_ += (float)hw_; pk[j] = hw_; } \
        ((f16x4*)GWH)[ii_] = pk; \
        ws_ += __shfl_xor(ws_, 1); ws_ += __shfl_xor(ws_, 2); \
        if ((tid_ & 3) == 0) ((float*)(a.ws + WS_WSUM))[(ii_) >> 2] = ws_; } while (0)
    for (; i + istep < itot; i += 2 * istep) {
        f32x4 s0 = ((const f32x4*)PART)[i], s1 = ((const f32x4*)PART)[i + istep];
#pragma unroll
        for (int sidx = 1; sidx < 4; ++sidx) { s0 += ((const f32x4*)(PART + (size_t)sidx * NT * 128))[i]; s1 += ((const f32x4*)(PART + (size_t)sidx * NT * 128))[i + istep]; }
        const f32x4 g0 = ((const f32x4*)GW)[i], g1 = ((const f32x4*)GW)[i + istep];
        PQ9B_ONE(s0, g0, i); PQ9B_ONE(s1, g1, i + istep);
    }
    for (; i < itot; i += istep) {
        f32x4 s0 = ((const f32x4*)PART)[i];
#pragma unroll
        for (int sidx = 1; sidx < 4; ++sidx) s0 += ((const f32x4*)(PART + (size_t)sidx * NT * 128))[i];
        const f32x4 g0 = ((const f32x4*)GW)[i];
        PQ9B_ONE(s0, g0, i);
    }
#undef PQ9B_ONE
}

#define LAS __attribute__((address_space(3)))
#define XB_TMO      128
#define XB_XCNT(j)  (256  + 64 * (j))
#define XB_XSUB(j)  (1280 + 64 * (j))
#define XB_XGEN(j)  (2304 + 64 * (j))
#define XB_TOP      3328
#define XB_TOPGEN   3392
#define XCD_BAR_WORDS 3456
#define XB_SPIN_CAP (1u << 18)
__device__ __forceinline__ unsigned xb_ld(unsigned* p)              { return __hip_atomic_load(p, __ATOMIC_RELAXED, __HIP_MEMORY_SCOPE_AGENT); }
__device__ __forceinline__ unsigned xb_add(unsigned* p, unsigned v) { return __hip_atomic_fetch_add(p, v, __ATOMIC_RELAXED, __HIP_MEMORY_SCOPE_AGENT); }
__device__ __forceinline__ unsigned xb_xcc_id() { return (unsigned)__builtin_amdgcn_s_getreg((3 << 11) | 20) & 0xFu; }
#define XB_SPIN(cond, bar) do { unsigned _sp = 0; while (cond) { __builtin_amdgcn_s_sleep(1); \
    if ((++_sp & 255u) == 0u) { if (xb_ld(&(bar)[XB_TMO])) break; if (_sp > XB_SPIN_CAP) { atomicAdd(&(bar)[XB_TMO], 1u); break; } } } } while (0)
struct XcdBarrier { unsigned* bar; unsigned x; volatile LAS unsigned* st; };
__device__ __forceinline__ XcdBarrier xcd_barrier_post(unsigned* bar, volatile LAS unsigned* st) {
    XcdBarrier b; b.bar = bar; b.x = xb_xcc_id(); b.st = st;
    if (threadIdx.x == 0) (void)xb_add(&bar[XB_XCNT(b.x)], 1u);
    return b;
}
__device__ __forceinline__ void xcd_barrier_complete(unsigned* bar, unsigned x, unsigned& nloc, unsigned& nx) {
    const unsigned G = gridDim.x * gridDim.y * gridDim.z;
    unsigned sum, cnt, mine, sp = 0u;
    for (;;) {
        sum = 0u; cnt = 0u; mine = 0u;
#pragma unroll
        for (unsigned j = 0; j < 16; ++j) { const unsigned c = xb_ld(&bar[XB_XCNT(j)]); sum += c; cnt += (c > 0u) ? 1u : 0u; mine = (j == x) ? c : mine; }
        if (sum == G) break;
        __builtin_amdgcn_s_sleep(1);
        if ((++sp & 255u) == 0u) { if (xb_ld(&bar[XB_TMO])) break; if (sp > XB_SPIN_CAP) { atomicAdd(&bar[XB_TMO], 1u); break; } }
    }
    nloc = mine > 0u ? mine : 1u; nx = cnt > 0u ? cnt : 1u;
}
__device__ __forceinline__ void xcd_barrier(const XcdBarrier& b) {
    asm volatile("s_waitcnt vmcnt(0)" ::: "memory");
    __syncthreads();
    if (threadIdx.x == 0) {
        unsigned* bar = b.bar;
        __builtin_amdgcn_s_waitcnt(0);
        unsigned nloc = b.st[0], nx = b.st[1];
        if (nloc == 0u) { xcd_barrier_complete(bar, b.x, nloc, nx); b.st[0] = nloc; b.st[1] = nx; }
        const unsigned old = xb_add(&bar[XB_XSUB(b.x)], 1u);
        const unsigned gen = old / nloc;
        if (old + 1u == (gen + 1u) * nloc) {
            __builtin_amdgcn_fence(__ATOMIC_RELEASE, "agent");
            asm volatile("s_waitcnt vmcnt(0)" ::: "memory");
            const unsigned og = xb_add(&bar[XB_TOP], 1u);
            const unsigned tg = og / nx;
            if (og + 1u == (tg + 1u) * nx) xb_add(&bar[XB_TOPGEN], 1u);
            else XB_SPIN(xb_ld(&bar[XB_TOPGEN]) == tg, bar);
            __builtin_amdgcn_fence(__ATOMIC_ACQUIRE, "agent");
            xb_add(&bar[XB_XGEN(b.x)], 1u);
            asm volatile("s_waitcnt vmcnt(0)" ::: "memory");
        } else {
            XB_SPIN(xb_ld(&bar[XB_XGEN(b.x)]) == gen, bar);
            __builtin_amdgcn_fence(__ATOMIC_ACQUIRE, "agent");
            asm volatile("s_waitcnt vmcnt(0)" ::: "memory");
        }
    }
    __syncthreads();
}

constexpr int N_PHASES = 12;
__global__ void __launch_bounds__(NTHR, 2) mk_fwd(Args a) {
    extern __shared__ __attribute__((aligned(16))) unsigned char lds[];
    cg::grid_group grid = cg::this_grid();
    const int bid = blockIdx.x, nb = gridDim.x;
    const int lo = a.ph_lo, hi = a.ph_hi;
    volatile LAS unsigned* bst = (volatile LAS unsigned*)((LAS unsigned char*)lds + (LDS_BYTES - 16));
    if (threadIdx.x < 4) bst[threadIdx.x] = 0u;
    __syncthreads();
    XcdBarrier xbar = xcd_barrier_post((unsigned*)(a.ws + WS_CTL), bst);
#define SEAM(k) do { if ((k) == 0) grid.sync(); else xcd_barrier(xbar); } while (0)
#define PHASE(k, body) if (lo <= (k) && (k) < hi) { body; if ((k) + 1 < hi) SEAM(k); }
    PHASE(0, ph0_prologue(a, bid, nb, lds))
    PHASE(1, row_norm_mod(a.in[0], a.in[4], (const float*)(a.ws + WS_MOD), 0, 1024, (f16*)(a.ws + WS_H), a.ws + WS_H8, (float*)(a.ws + WS_H8 + 64 * MiB), bid, nb); wq_to_int8((const f16*)(a.ws + WS_WQ), a.ws + WS_WQ8, (float*)(a.ws + WS_WSC), 2048, bid, nb); wq_to_int8((const f16*)(a.ws + WS_WIN), a.ws + WS_WIN8, (float*)(a.ws + WS_WSCIN), 1536, bid, nb); wq_to_int8((const f16*)(a.ws + WS_WVT), a.ws + WS_WVT8, (float*)(a.ws + WS_WSCIN) + 1536, 512, bid, nb); wq_to_int8((const f16*)(a.ws + WS_WOUT), a.ws + WS_WOUT8, (float*)(a.ws + WS_WSCIN) + 4096, 1024, bid, nb, a.in[8], a.in[11]))
    PHASE(2, ph2_inproj(a, bid, nb, lds))
    PHASE(3, ph3_pool_fast(a, bid, nb, lds); ph3_index_fast<0>(a, bid, nb, lds))
    PHASE(4, ph4_attn_fast<0>(a, bid, nb, lds))
    PHASE(5, ph5_outproj(a, bid, nb, lds))
    PHASE(6, row_norm_mod_q((const f16*)(a.ws + WS_X1), a.in[13], (const float*)(a.ws + WS_MOD), 3072, 4096, a.ws + WS_HQ, (unsigned*)(a.ws + WS_HP), (float*)(a.ws + WS_HSC), bid, nb))
    PHASE(7, ph7_peerq(a, bid, nb, lds))
    PHASE(8, ph8_peersel_fast(a, bid, nb, lds))
    PHASE(9, ph9_sliced<0>(a, lds))
    PHASE(10, ph9b_combine(a, bid, nb))
    PHASE(11, ph9_sliced<1>(a, lds))
#undef PHASE
}

extern "C" void kernel_launch(void* const* d_in, const int* in_sizes, int n_in, void* d_out, int out_size, void* d_ws, size_t ws_size, hipStream_t stream) {
    static int grid = 0;
    if (grid == 0) {
        if (n_in != 18 || out_size != NT * ND || ws_size < WS_END) { fprintf(stderr, "kernel_launch: unexpected shapes (n_in %d out %d ws %zu)\n", n_in, out_size, ws_size); grid = -1; return; }
        int dev = 0, cus = 0, per_cu = 0;
        hipGetDevice(&dev); hipDeviceGetAttribute(&cus, hipDeviceAttributeMultiprocessorCount, dev);
        hipFuncSetAttribute((const void*)mk_fwd, hipFuncAttributeMaxDynamicSharedMemorySize, LDS_BYTES);
        hipOccupancyMaxActiveBlocksPerMultiprocessor(&per_cu, (const void*)mk_fwd, NTHR, LDS_BYTES);
        if (per_cu < 1) { fprintf(stderr, "kernel_launch: occupancy query says %d blocks/CU\n", per_cu); per_cu = 1; }
        grid = cus * 1;
        (void)hipGetLastError();
    }
    if (grid < 0) return;
    if (hipMemsetAsync((char*)d_ws + WS_CTL, 0, 32768, stream) != hipSuccess) { fprintf(stderr, "kernel_launch: memset of the barrier words failed\n"); return; }
    Args a{};
    for (int i = 0; i < 18; ++i) a.in[i] = (const float*)d_in[i];
    a.out = (float*)d_out; a.ws = (unsigned char*)d_ws;
#if MK_MULTI
    for (int ph = 0; ph < N_PHASES; ++ph) { a.ph_lo = ph; a.ph_hi = ph + 1; hipLaunchKernelGGL(mk_fwd, dim3(grid), dim3(NTHR), LDS_BYTES, stream, a); }
#else
    a.ph_lo = 0; a.ph_hi = N_PHASES;
    void* args[] = {&a};
    hipError_t e = hipLaunchCooperativeKernel((const void*)mk_fwd, dim3(grid), dim3(NTHR), args, LDS_BYTES, stream);
    if (e != hipSuccess) fprintf(stderr, "cooperative launch failed: %s (grid %d)\n", hipGetErrorString(e), grid);
#endif
}
```

```cpp
#if defined(__HIP_DEVICE_COMPILE__)
#pragma clang attribute push(__attribute__((target("no-packed-fp32-ops"))), apply_to = function)
#endif
#include <hip/hip_runtime.h>
#include <hip/hip_cooperative_groups.h>
#include <cstdio>
#include <cstdint>
namespace cg = cooperative_groups;

#ifndef MK_MULTI
#define MK_MULTI 0
#endif

typedef _Float16 f16;
typedef _Float16 f16x8 __attribute__((ext_vector_type(8)));
typedef _Float16 f16x4 __attribute__((ext_vector_type(4)));
typedef float f32x4 __attribute__((ext_vector_type(4)));
typedef float f32x16 __attribute__((ext_vector_type(16)));
typedef int i32x4 __attribute__((ext_vector_type(4)));
typedef unsigned long long u64;
typedef unsigned short u16;
typedef __attribute__((address_space(3))) unsigned lds_u32;

constexpr int NB = 8, NS = 8192, ND = 1024, NT = NB * NS;
constexpr int INW = 2632;
constexpr int NMAIN = 2304;
constexpr float EPS = 1e-6f;
constexpr int NTHR = 512, NWAVE = 8;

constexpr size_t MiB = 1u << 20;
constexpr size_t WS_CTL = 0;
constexpr size_t WS_MOD = 1 * MiB;
constexpr size_t WS_WIN = 2 * MiB;
constexpr size_t WS_WVT = 7 * MiB;
constexpr size_t WS_WOUT = 8 * MiB;
constexpr size_t WS_WQ = 10 * MiB;
constexpr size_t WS_SK = 14 * MiB;
constexpr size_t WS_PW = 14 * MiB + 512 * 1024;
constexpr size_t WS_QS = 1 * MiB + 512 * 1024;
constexpr size_t WS_UT = 16 * MiB;
constexpr size_t WS_VP = 48 * MiB;
constexpr size_t WS_H = 80 * MiB;
constexpr size_t WS_U = 208 * MiB;
constexpr size_t WS_Q = 272 * MiB;
constexpr size_t WS_K = 336 * MiB;
constexpr size_t WS_VT = 400 * MiB;
constexpr size_t WS_PQ = 208 * MiB;
constexpr size_t WS_WOUT8 = 27 * MiB;
constexpr size_t WS_WIN8 = 28 * MiB;
constexpr size_t WS_WVT8 = 30 * MiB;
constexpr size_t WS_WSCIN = 31 * MiB;
constexpr size_t WS_H8 = 656 * MiB;
constexpr size_t WS_WQ8 = 24 * MiB;
constexpr size_t WS_WSC = 26 * MiB;
constexpr size_t WS_HQ = 464 * MiB;
constexpr size_t WS_HP = 784 * MiB;
constexpr size_t WS_GWH = 544 * MiB;
constexpr size_t WS_WSUM = 536 * MiB;
constexpr size_t WS_HSC = 528 * MiB;
constexpr size_t WS_QI = 464 * MiB;
constexpr size_t WS_KI = 528 * MiB;
constexpr size_t WS_WI = 536 * MiB;
constexpr size_t WS_MASK = 544 * MiB;
constexpr size_t WS_EID = 608 * MiB;
constexpr size_t WS_GW = 624 * MiB;
constexpr size_t WS_X1 = 656 * MiB;
constexpr size_t WS_END = 848 * MiB;

constexpr int LDS_BYTES = 155648;
constexpr float MIXQ = 127.f / 8.f;
constexpr float PEER_QSTEP = 0.3352f;
constexpr float PEER_WSCALE = 16384.f;

struct Args { const float* in[18]; float* out; unsigned char* ws; int ph_lo, ph_hi; };

__host__ __device__ __forceinline__ int pos2log(int p) { return 64 * ((p >> 5) & 3) + 32 * (p >> 7) + 8 * ((p >> 2) & 3) + 4 * ((p >> 4) & 1) + (p & 3); }
__device__ __forceinline__ int maincol(int L) { if (L < 1536) return L; if (L < 2120) return L + 512; return -1; }

__device__ __forceinline__ float wave_sum(float v) {
#pragma unroll
    for (int o = 1; o < 64; o <<= 1) v += __shfl_xor(v, o);
    return v;
}
__device__ __forceinline__ float wave_max(float v) {
#pragma unroll
    for (int o = 1; o < 64; o <<= 1) v = fmaxf(v, __shfl_xor(v, o));
    return v;
}

__device__ void ph0_prologue(const Args& a, int bid, int nb, unsigned char* lds) {
    int tid = __builtin_amdgcn_workitem_id_x(); asm volatile("" : "+v"(tid));
    const float* c = a.in[1]; const float* ada_w = a.in[2]; const float* ada_b = a.in[3];
    float* sil = (float*)lds;
    for (int i = tid; i < NB * ND; i += NTHR) { const float v = c[i]; sil[(i % ND) * 8 + i / ND] = v / (1.f + __expf(-v)); }
    __syncthreads();
    float* mod = (float*)(a.ws + WS_MOD);
    const int gt = bid * NTHR + tid, ngt = nb * NTHR;
    {   const int lane = tid & 63, wv_ = tid >> 6;
        float* red = (float*)lds + NB * ND;
        for (int jg = bid; jg < 6144 / 64; jg += nb) {
            const float* wp = ada_w + (size_t)(128 * wv_) * 6144 + jg * 64 + lane;
            float acc[8] = {0.f, 0.f, 0.f, 0.f, 0.f, 0.f, 0.f, 0.f};
#pragma unroll 8
            for (int k = 0; k < 128; ++k) { const float wv = wp[(size_t)k * 6144]; const f32x4 s0 = *(const f32x4*)(sil + (128 * wv_ + k) * 8), s1 = *(const f32x4*)(sil + (128 * wv_ + k) * 8 + 4);
                acc[0] += s0[0] * wv; acc[1] += s0[1] * wv; acc[2] += s0[2] * wv; acc[3] += s0[3] * wv; acc[4] += s1[0] * wv; acc[5] += s1[1] * wv; acc[6] += s1[2] * wv; acc[7] += s1[3] * wv; }
#pragma unroll
            for (int b = 0; b < 8; ++b) red[(wv_ * 8 + b) * 64 + lane] = acc[b];
            __syncthreads();
            float sum = ada_b[jg * 64 + lane];
#pragma unroll
            for (int w = 0; w < 8; ++w) sum += red[(w * 8 + wv_) * 64 + lane];
            mod[wv_ * 6144 + jg * 64 + lane] = sum;
            __syncthreads();
        }
    }
    const float* w_in = a.in[5]; const float* pool_w = a.in[6]; const float* w_out = a.in[12];
    const float* wq = a.in[14]; const float* sk = a.in[15]; const float* pu = a.in[16]; const float* pv = a.in[17];
    f16* WIN = (f16*)(a.ws + WS_WIN); f16* WVT = (f16*)(a.ws + WS_WVT); f16* WOUT = (f16*)(a.ws + WS_WOUT); f16* WQ = (f16*)(a.ws + WS_WQ);
 unsigned char* UT = a.ws + WS_UT; unsigned char* VP = a.ws + WS_VP;
    {
        __syncthreads();
        const int lane = tid & 63, wv_ = tid >> 6;
        float* scr = (float*)lds + wv_ * (64 * 33);
        constexpr int I_WQ = 16 * 64, I_Z = 16 * 16, I_INR = 16 * (NMAIN / 32 - 16), I_VT = 16 * 16, I_OUT = 16 * 32, I_ALL = I_WQ + I_Z + I_INR + I_VT + I_OUT;
        for (int it = bid * NWAVE + wv_; it < I_ALL; it += nb * NWAVE) {
            int rr = it, kind = 3, pboff = 0;
            if (rr >= I_WQ) { rr -= I_WQ; kind = 0;
                if (rr >= I_Z) { rr -= I_Z; pboff = 16;
                    if (rr >= I_INR) { rr -= I_INR; kind = 1; pboff = 0; if (rr >= I_VT) { rr -= I_VT; kind = 2; } } } }
            const int npb = kind == 0 ? (pboff ? NMAIN / 32 - 16 : 16) : kind == 1 ? 16 : kind == 2 ? 32 : 64;
            const int k0 = (rr / npb) * 64, p0 = (rr % npb + pboff) * 32, p = p0 + (lane & 31);
            const float* W = kind <= 1 ? w_in : kind == 2 ? w_out : wq; const int ldw = kind <= 1 ? INW : kind == 2 ? 1024 : 2048;
            int col;
            if (kind == 0) col = maincol((p & ~255) + pos2log(p & 255)); else if (kind == 1) col = 1536 + p; else col = (p & ~255) + pos2log(p & 255);
            const bool foldz = (kind == 0 && pboff == 0);
            if (foldz || kind == 3) {
                const int r5 = lane & 31, hh_ = lane >> 5;
                const int blk = __builtin_amdgcn_readfirstlane(col >> 7);
                const int sub = col & 127;
                const float* arow = W + (size_t)(k0 + r5) * ldw + blk * 128 + 8 * hh_;
                f32x16 acc0 = (f32x16){0.f, 0.f, 0.f, 0.f, 0.f, 0.f, 0.f, 0.f, 0.f, 0.f, 0.f, 0.f, 0.f, 0.f, 0.f, 0.f}, acc1 = acc0;
#pragma unroll 2
                for (int ks = 0; ks < 8; ++ks) {
                    const f32x4 a00 = *(const f32x4*)(arow + 16 * ks), a01 = *(const f32x4*)(arow + 16 * ks + 4);
                    const f32x4 a10 = *(const f32x4*)(arow + (size_t)32 * ldw + 16 * ks), a11 = *(const f32x4*)(arow + (size_t)32 * ldw + 16 * ks + 4);
                    f16x8 bfr;
                    if (kind == 3) { const float* br = sk + (size_t)(blk * 128 + sub) * 128 + 16 * ks + 8 * hh_; const f32x4 b0 = *(const f32x4*)br, b1 = *(const f32x4*)(br + 4);
                        bfr = (f16x8){(f16)b0[0], (f16)b0[1], (f16)b0[2], (f16)b0[3], (f16)b1[0], (f16)b1[1], (f16)b1[2], (f16)b1[3]}; }
                    else { const float* br = pool_w + (size_t)blk * 16384 + (size_t)(16 * ks + 8 * hh_) * 128 + sub;
                        bfr = (f16x8){(f16)br[0], (f16)br[128], (f16)br[256], (f16)br[384], (f16)br[512], (f16)br[640], (f16)br[768], (f16)br[896]}; }
                    const f16x8 af0 = (f16x8){(f16)a00[0], (f16)a00[1], (f16)a00[2], (f16)a00[3], (f16)a01[0], (f16)a01[1], (f16)a01[2], (f16)a01[3]};
                    const f16x8 af1 = (f16x8){(f16)a10[0], (f16)a10[1], (f16)a10[2], (f16)a10[3], (f16)a11[0], (f16)a11[1], (f16)a11[2], (f16)a11[3]};
                    acc0 = __builtin_amdgcn_mfma_f32_32x32x16_f16(af0, bfr, acc0, 0, 0, 0);
                    acc1 = __builtin_amdgcn_mfma_f32_32x32x16_f16(af1, bfr, acc1, 0, 0, 0);
                }
#pragma unroll
                for (int rg = 0; rg < 16; ++rg) { const int kk = (rg & 3) + 8 * (rg >> 2) + 4 * hh_; scr[kk * 33 + r5] = acc0[rg]; scr[(32 + kk) * 33 + r5] = acc1[rg]; }
            } else {
#pragma unroll 8
                for (int i = 0; i < 32; ++i) { const int kk = 2 * i + (lane >> 5); scr[kk * 33 + (lane & 31)] = col >= 0 ? W[(size_t)(k0 + kk) * ldw + col] : 0.f; }
            }
            f16* WT = kind == 0 ? WIN : kind == 1 ? WVT : kind == 2 ? WOUT : WQ;
            const int c8 = lane & 7;
#pragma unroll
            for (int j = 0; j < 4; ++j) { const int n = (lane >> 3) + 8 * j; const float* sp = scr + (8 * c8) * 33 + n;
                *(f16x8*)(WT + (size_t)(p0 + n) * ND + k0 + 8 * c8) = (f16x8){(f16)sp[0], (f16)sp[33], (f16)sp[66], (f16)sp[99], (f16)sp[132], (f16)sp[165], (f16)sp[198], (f16)sp[231]}; }
        }
    }
    {
        __syncthreads();
        float ssu = 0.f, ssv = 0.f;
        for (int i = tid; i < 64 * 1024 / 4; i += NTHR) { const f32x4 u = ((const f32x4*)pu)[i], v = ((const f32x4*)pv)[i];
            ssu += u.x * u.x + u.y * u.y + u.z * u.z + u.w * u.w; ssv += v.x * v.x + v.y * v.y + v.z * v.z + v.w * v.w; }
        ssu = wave_sum(ssu); ssv = wave_sum(ssv);
        float* red = (float*)lds;
        if ((tid & 63) == 0) { red[tid >> 6] = ssu; red[8 + (tid >> 6)] = ssv; }
        __syncthreads();
        float tu = 0.f, tv = 0.f;
#pragma unroll
        for (int w = 0; w < 8; ++w) { tu += red[w]; tv += red[8 + w]; }
        const float du = PEER_QSTEP * sqrtf(tu * (1.f / 65536.f)), dv = PEER_QSTEP * sqrtf(tv * (1.f / 65536.f));
        if (bid == 0 && tid == 0) { float* qs = (float*)(a.ws + WS_QS); qs[0] = du; qs[1] = dv; }
        const float idu = 1.f / du, idv = 1.f / dv;
        const int lane = tid & 63, wv_ = tid >> 6;
        for (int row0 = bid * NWAVE + wv_; row0 < 2 * 16384; row0 += 4 * nb * NWAVE) {
            f32x4 x4[4][4];
#pragma unroll
            for (int rr = 0; rr < 4; ++rr) { int row = row0 + rr * nb * NWAVE; row = row < 2 * 16384 ? row : row0; const bool isv = row >= 16384; const int e = row & 16383;
                const float* src = (isv ? pv : pu) + (size_t)e * ND + 4 * lane;
#pragma unroll
                for (int j = 0; j < 4; ++j) x4[rr][j] = *(const f32x4*)(src + 256 * j); }
#pragma unroll
            for (int rr = 0; rr < 4; ++rr) { int row = row0 + rr * nb * NWAVE; row = row < 2 * 16384 ? row : row0; const bool isv = row >= 16384; const int e = row & 16383;
                u16* dstq = (u16*)((isv ? VP : UT) + (size_t)e * 512) + lane;
                const float inv = isv ? idv : idu; const int off = isv ? 8 : 0;
#pragma unroll
                for (int j = 0; j < 4; ++j) { unsigned pk = 0u, pd = 0u;
#pragma unroll
                    for (int k = 0; k < 4; ++k) { int q = (int)floorf(x4[rr][j][k] * inv); q = q < -8 ? -8 : q > 7 ? 7 : q; pk |= (unsigned)((q + off) & 15) << (4 * k);
                        pd |= (unsigned)((q + off) & 15) << (4 * ((k >> 1) + 2 * (lane & 1) + 4 * (k & 1))); }
                    const unsigned od = __shfl_xor(pd, 1);
                    if (!isv) dstq[64 * j] = (u16)pk; else if (!(lane & 1)) ((unsigned*)(VP + (size_t)e * 512))[(lane >> 1) + 32 * j] = pd | od; } }
        }
    }
}

__device__ void row_norm_mod(const float* src, const float* g, const float* mod, int sh_off, int sc_off, f16* dst, unsigned char* h8, float* hs8, int bid, int nb) {
    int tid_ = __builtin_amdgcn_workitem_id_x(); asm volatile("" : "+v"(tid_)); const int lane = tid_ & 63, wave = tid_ >> 6;
    const int rstep = nb * NWAVE, r0 = bid * NWAVE + wave;
    const bool fast = (NS % rstep) == 0 && ((NS / rstep) % 4) == 0;
    if (fast) {
        for (int b = 0; b < NB; ++b) {
            f32x4 gs[4], sh[4];
#pragma unroll
            for (int j = 0; j < 4; ++j) { const int col = lane * 4 + 256 * j; const f32x4 gg = *(const f32x4*)(g + col), sc = *(const f32x4*)(mod + b * 6144 + sc_off + col);
                sh[j] = *(const f32x4*)(mod + b * 6144 + sh_off + col); gs[j] = gg * (1.f + sc); }
            for (int row = b * NS + r0; row < (b + 1) * NS; row += 4 * rstep) {
                f32x4 v[4][4]; float ss[4];
#pragma unroll
                for (int rr = 0; rr < 4; ++rr)
#pragma unroll
                    for (int j = 0; j < 4; ++j) v[rr][j] = ((const f32x4*)(src + (size_t)(row + rr * rstep) * ND) + lane)[64 * j];
#pragma unroll
                for (int rr = 0; rr < 4; ++rr) { float s_ = 0.f;
#pragma unroll
                    for (int j = 0; j < 4; ++j) s_ += v[rr][j].x * v[rr][j].x + v[rr][j].y * v[rr][j].y + v[rr][j].z * v[rr][j].z + v[rr][j].w * v[rr][j].w;
                    ss[rr] = rsqrtf(wave_sum(s_) * (1.f / ND) + EPS); }
#pragma unroll
                for (int rr = 0; rr < 4; ++rr) { float am = 0.f;
#pragma unroll
                    for (int j = 0; j < 4; ++j) { const int col = lane * 4 + 256 * j; const f32x4 o = v[rr][j] * ss[rr] * gs[j] + sh[j]; v[rr][j] = o;
                        am = fmaxf(am, fmaxf(fmaxf(fabsf(o.x), fabsf(o.y)), fmaxf(fabsf(o.z), fabsf(o.w))));
                        *(f16x4*)(dst + (size_t)(row + rr * rstep) * ND + col) = (f16x4){(f16)o.x, (f16)o.y, (f16)o.z, (f16)o.w}; }
                    am = wave_max(am); const float inv = am > 0.f ? 127.f / am : 0.f;
#pragma unroll
                    for (int j = 0; j < 4; ++j) { const f32x4 o = v[rr][j];
                        const unsigned pk = (unsigned)((int)rintf(o.x * inv) & 255) | ((unsigned)((int)rintf(o.y * inv) & 255) << 8) | ((unsigned)((int)rintf(o.z * inv) & 255) << 16) | ((unsigned)((int)rintf(o.w * inv) & 255) << 24);
                        *(unsigned*)(h8 + (size_t)(row + rr * rstep) * ND + lane * 4 + 256 * j) = pk; }
                    if (lane == 0) hs8[row + rr * rstep] = am * (1.f / 127.f); }
            }
        }
        return;
    }
    for (int row = r0; row < NT; row += rstep) {
        const int b = row / NS;
        const f32x4* xr = (const f32x4*)(src + (size_t)row * ND) + lane;
        f32x4 v[4]; float s = 0.f;
#pragma unroll
        for (int j = 0; j < 4; ++j) { v[j] = xr[64 * j]; s += v[j].x * v[j].x + v[j].y * v[j].y + v[j].z * v[j].z + v[j].w * v[j].w; }
        const float rstd = rsqrtf(wave_sum(s) * (1.f / ND) + EPS);
#pragma unroll
        for (int j = 0; j < 4; ++j) {
            const int col = lane * 4 + 256 * j;
            const f32x4 gg = *(const f32x4*)(g + col), sc = *(const f32x4*)(mod + b * 6144 + sc_off + col), sh = *(const f32x4*)(mod + b * 6144 + sh_off + col);
            const f32x4 of = (f32x4){v[j].x * rstd * gg.x * (1.f + sc.x) + sh.x, v[j].y * rstd * gg.y * (1.f + sc.y) + sh.y, v[j].z * rstd * gg.z * (1.f + sc.z) + sh.z, v[j].w * rstd * gg.w * (1.f + sc.w) + sh.w};
            v[j] = of;
            *(f16x4*)(dst + (size_t)row * ND + col) = (f16x4){(f16)of.x, (f16)of.y, (f16)of.z, (f16)of.w};
        }
        float am = 0.f;
#pragma unroll
        for (int j = 0; j < 4; ++j) am = fmaxf(am, fmaxf(fmaxf(fabsf(v[j].x), fabsf(v[j].y)), fmaxf(fabsf(v[j].z), fabsf(v[j].w))));
        am = wave_max(am); const float inv = am > 0.f ? 127.f / am : 0.f;
#pragma unroll
        for (int j = 0; j < 4; ++j) { const f32x4 o = v[j];
            const unsigned pk = (unsigned)((int)rintf(o.x * inv) & 255) | ((unsigned)((int)rintf(o.y * inv) & 255) << 8) | ((unsigned)((int)rintf(o.z * inv) & 255) << 16) | ((unsigned)((int)rintf(o.w * inv) & 255) << 24);
            *(unsigned*)(h8 + (size_t)row * ND + lane * 4 + 256 * j) = pk; }
        if (lane == 0) hs8[row] = am * (1.f / 127.f);
    }
}
__device__ void row_norm_mod_q(const f16* src, const float* g, const float* mod, int sh_off, int sc_off, unsigned char* hq, unsigned* hp, float* hsc, int bid, int nb) {
    int tid_ = __builtin_amdgcn_workitem_id_x(); asm volatile("" : "+v"(tid_)); const int lane = tid_ & 63, wave = tid_ >> 6;
    const int rstep = nb * NWAVE, r0 = bid * NWAVE + wave;
    const bool hoist = (NS % rstep) == 0 && ((NS / rstep) % 2) == 0;
    const int nouter = hoist ? NB : 1, ninner = hoist ? NS : NT;
    for (int bo = 0; bo < nouter; ++bo) {
        f32x4 gs[4], sh[4];
        if (hoist) {
#pragma unroll
            for (int j = 0; j < 4; ++j) { const int col = 8 * lane + 512 * (j >> 1) + 4 * (j & 1); const f32x4 gg = *(const f32x4*)(g + col), sc = *(const f32x4*)(mod + bo * 6144 + sc_off + col);
                sh[j] = *(const f32x4*)(mod + bo * 6144 + sh_off + col); gs[j] = gg * (1.f + sc); }
        }
        for (int rowa = bo * ninner + r0; rowa < (bo + 1) * ninner; rowa += 2 * rstep) {
            const int rowb = rowa + rstep < NT ? rowa + rstep : rowa;
            f16x8 hx[2][2];
#pragma unroll
            for (int j = 0; j < 2; ++j) { hx[0][j] = *(const f16x8*)(src + (size_t)rowa * ND + 8 * lane + 512 * j); hx[1][j] = *(const f16x8*)(src + (size_t)rowb * ND + 8 * lane + 512 * j); }
#pragma unroll
            for (int rr = 0; rr < 2; ++rr) {
                const int row = rr ? rowb : rowa; const int b = row / NS;
                if (!hoist) {
#pragma unroll
                    for (int j = 0; j < 4; ++j) { const int col = 8 * lane + 512 * (j >> 1) + 4 * (j & 1); const f32x4 gg = *(const f32x4*)(g + col), sc = *(const f32x4*)(mod + b * 6144 + sc_off + col);
                        sh[j] = *(const f32x4*)(mod + b * 6144 + sh_off + col); gs[j] = gg * (1.f + sc); }
                }
                f32x4 v[4]; float s = 0.f;
#pragma unroll
                for (int j = 0; j < 2; ++j) { const f16x8 h8 = hx[rr][j];
                    v[2 * j] = (f32x4){(float)h8[0], (float)h8[1], (float)h8[2], (float)h8[3]}; v[2 * j + 1] = (f32x4){(float)h8[4], (float)h8[5], (float)h8[6], (float)h8[7]}; }
#pragma unroll
                for (int j = 0; j < 4; ++j) s += v[j].x * v[j].x + v[j].y * v[j].y + v[j].z * v[j].z + v[j].w * v[j].w;
                const float rstd = rsqrtf(wave_sum(s) * (1.f / ND) + EPS);
                float o[16]; float am = 0.f;
#pragma unroll
                for (int j = 0; j < 4; ++j)
#pragma unroll
                    for (int k = 0; k < 4; ++k) { const float y = v[j][k] * rstd * gs[j][k] + sh[j][k]; o[4 * j + k] = y; am = fmaxf(am, fabsf(y)); }
                am = wave_max(am);
                const float inv = am > 0.f ? 119.f / am : 0.f;
#pragma unroll
                for (int j = 0; j < 2; ++j) {
                    unsigned p0 = 0u, p1 = 0u, ph = 0u, pl = 0u;
#pragma unroll
                    for (int k = 0; k < 8; ++k) { const int q = (int)rintf(o[8 * j + k] * inv); const int l = ((q + 8) & 15) - 8; const int h = (q - l) >> 4;
                        if (k < 4) p0 |= (unsigned)(q & 255) << (8 * k); else p1 |= (unsigned)(q & 255) << (8 * (k - 4));
                        ph |= (unsigned)(h & 15) << (4 * k); pl |= (unsigned)(l & 15) << (4 * k); }
                    *(u64*)(hq + (size_t)row * ND + 8 * lane + 512 * j) = (u64)p0 | ((u64)p1 << 32);
                    hp[(size_t)row * 256 + lane + 64 * j] = ph; hp[(size_t)row * 256 + 128 + lane + 64 * j] = pl;
                }
                if (lane == 0) hsc[row] = am * (1.f / 119.f);
            }
        }
    }
}
__device__ void wq_to_int8(const f16* WQ, unsigned char* WQ8, float* WSC, int nrows, int bid, int nb, const float* kg0 = nullptr, const float* kg1 = nullptr) {
    int tid_ = __builtin_amdgcn_workitem_id_x(); asm volatile("" : "+v"(tid_)); const int lane = tid_ & 63, wave = tid_ >> 6;
    for (int row = bid * NWAVE + wave; row < nrows; row += nb * NWAVE) {
        f16x8 a0 = *(const f16x8*)(WQ + (size_t)row * ND + 8 * lane), a1 = *(const f16x8*)(WQ + (size_t)row * ND + 8 * lane + 512);
        if (kg0) {
#pragma unroll
            for (int k = 0; k < 8; ++k) { a0[k] = (f16)((float)a0[k] * (fabsf(kg0[8 * lane + k]) * (1.f / MIXQ))); a1[k] = (f16)((float)a1[k] * (fabsf(kg1[8 * lane + k]) * (1.f / MIXQ))); }
        }
        float am = 0.f;
#pragma unroll
        for (int k = 0; k < 8; ++k) am = fmaxf(am, fmaxf(fabsf((float)a0[k]), fabsf((float)a1[k])));
        am = wave_max(am);
        const float inv = am > 0.f ? 127.f / am : 0.f;
        unsigned p[4] = {0u, 0u, 0u, 0u};
#pragma unroll
        for (int k = 0; k < 4; ++k) { p[0] |= (unsigned)((int)rintf((float)a0[k] * inv) & 255) << (8 * k); p[1] |= (unsigned)((int)rintf((float)a0[4 + k] * inv) & 255) << (8 * k);
                                      p[2] |= (unsigned)((int)rintf((float)a1[k] * inv) & 255) << (8 * k); p[3] |= (unsigned)((int)rintf((float)a1[4 + k] * inv) & 255) << (8 * k); }
        *(u64*)(WQ8 + (size_t)row * ND + 8 * lane) = (u64)p[0] | ((u64)p[1] << 32);
        *(u64*)(WQ8 + (size_t)row * ND + 8 * lane + 512) = (u64)p[2] | ((u64)p[3] << 32);
        if (lane == 0) WSC[row] = am * (1.f / 127.f);
    }
}

__device__ __forceinline__ void ph8_item(const Args& a, unsigned char* lds, const int item);
namespace pg8 {
#define PG8_LAS __attribute__((address_space(3)))
constexpr int BM = 256, BK = 64, HALF = 128, HTB = HALF * BK * 2, STAGE_BYTES = 8 * HTB, NXCD = 8, WGM = 8;
__host__ __device__ __forceinline__ int lds_byte(int r, int c) { const int st = (r >> 4) * 2 + (c >> 5), rr = r & 15, cc = c & 31, ob = rr * 64 + cc * 2; return st * 1024 + (ob ^ (((ob >> 9) & 1) << 5)); }
__host__ __device__ __forceinline__ void stage_rc(int b, int& R, int& C) { const int st = b / 1024, sb = b % 1024, swz = sb ^ (((sb >> 9) & 1) << 5); R = (st >> 1) * 16 + swz / 64; C = (st & 1) * 32 + (swz % 64) / 2; }
struct Unit { int pm, pn; };
struct Gemm { const f16* A; const f16* Bt; int M, N, K; };
struct StaticOrder {
    int nM, nN, nwg, G, c;
    __host__ __device__ void init(int M, int N, int G_, int c_) { nM = M / BM; nN = N / BM; nwg = nM * nN; G = G_; c = c_; }
    __host__ __device__ bool next(int i, Unit& u) const {
        const long L = (long)i * G + c; if (L >= nwg) return false;
        int wgid = (int)L; { const int q = nwg / NXCD, r = nwg % NXCD, xcd = wgid % NXCD, off = wgid / NXCD; wgid = (xcd < r ? xcd * (q + 1) : r * (q + 1) + (xcd - r) * q) + off; }
        const int nig = WGM * nN, gid = wgid / nig, fm = gid * WGM, gsz = (nM - fm) < WGM ? (nM - fm) : WGM;
        u.pm = fm + ((wgid % nig) % gsz); u.pn = (wgid % nig) / gsz; return true;
    }
};
template <class Epi, bool I8 = false, bool HOOK = false>
__device__ __forceinline__ void gemm_phase(PG8_LAS unsigned char* lds, const Gemm g, const StaticOrder& S, const Epi& E, const Args* hargs = nullptr) {
    int tid = __builtin_amdgcn_workitem_id_x(); asm volatile("" : "+v"(tid));
    const int wid = __builtin_amdgcn_readfirstlane(tid >> 6), lane = tid & 63, wr = wid >> 2, wc = wid & 3, fr = lane & 15, fq = lane >> 4;
    const int K = g.K, nt = K / BK;
    unsigned voffA[2];
#pragma unroll
    for (int i = 0; i < 2; ++i) { int R, C; stage_rc(tid * 16 + i * 8192, R, C); voffA[i] = (unsigned)(R * K + C) * 2u; }
    const size_t kstep = (size_t)(BK * 2);
    const size_t hstep = (size_t)HALF * K * 2;
    const size_t tstep = 2 * hstep;
    const unsigned ldsw = (unsigned)wid * 1024u;
    const int aoff = lds_byte(wr * 64 + fr, fq * 8), boff = lds_byte(wc * 32 + fr, fq * 8);
#define PG8_SA(b, h) (((b) * 2 + (h)) * HTB)
#define PG8_SB(b, h) ((4 + (b) * 2 + (h)) * HTB)
#define PG8_STAGE(bufoff, gbase, voff) do { _Pragma("unroll") for (int _i = 0; _i < 2; ++_i) \
        __builtin_amdgcn_global_load_lds((const unsigned*)((const char*)(gbase) + (voff)[_i]), (PG8_LAS unsigned*)(lds + (bufoff) + ldsw + _i * 8192), 16, 0, 0); } while (0)
#define PG8_LDA(dst, b, h) do { _Pragma("unroll") for (int m = 0; m < 4; ++m) _Pragma("unroll") for (int k = 0; k < 2; ++k) dst[m][k] = *(const PG8_LAS f16x8*)(lds + PG8_SA(b, h) + aoff + m * 2048 + k * 1024); } while (0)
#define PG8_LDB(dst, b, h) do { _Pragma("unroll") for (int n = 0; n < 2; ++n) _Pragma("unroll") for (int k = 0; k < 2; ++k) dst[n][k] = *(const PG8_LAS f16x8*)(lds + PG8_SB(b, h) + boff + n * 2048 + k * 1024); } while (0)
#define PG8_MMA(ai, bj, At, Bt) do { __builtin_amdgcn_s_setprio(1); _Pragma("unroll") for (int m = 0; m < 4; ++m) _Pragma("unroll") for (int n = 0; n < 2; ++n) _Pragma("unroll") for (int k = 0; k < 2; ++k) \
        acc[ai][bj][m][n] = I8 ? __builtin_bit_cast(f32x4, __builtin_amdgcn_mfma_i32_16x16x64_i8(__builtin_bit_cast(i32x4, Bt[n][k]), __builtin_bit_cast(i32x4, At[m][k]), __builtin_bit_cast(i32x4, acc[ai][bj][m][n]), 0, 0, 0)) \
                                 : __builtin_amdgcn_mfma_f32_16x16x32_f16(Bt[n][k], At[m][k], acc[ai][bj][m][n], 0, 0, 0); __builtin_amdgcn_s_setprio(0); } while (0)
#define PG8_WAIT_V(n) asm volatile("s_waitcnt vmcnt(" #n ")" ::: "memory")
#define PG8_WAIT_L(n) asm volatile("s_waitcnt lgkmcnt(" #n ")" ::: "memory")
#define PG8_BAR __builtin_amdgcn_s_barrier()
#define PG8_SCHED __builtin_amdgcn_sched_barrier(0)
    Unit cur, nxt; int ui = 0;
    if (!S.next(0, cur)) return;
    f32x4 acc[2][2][4][2];
#pragma unroll
    for (int a = 0; a < 2; ++a)
#pragma unroll
        for (int b = 0; b < 2; ++b)
#pragma unroll
            for (int m = 0; m < 4; ++m)
#pragma unroll
                for (int n = 0; n < 2; ++n) acc[a][b][m][n] = (f32x4){0.f, 0.f, 0.f, 0.f};
    f16x8 At[4][2], B0[2][2], B1[2][2];
    const char* cA = (const char*)g.A + (size_t)cur.pm * tstep; const char* cB = (const char*)g.Bt + (size_t)cur.pn * tstep;
    PG8_STAGE(PG8_SB(0, 0), cB, voffA); PG8_STAGE(PG8_SB(0, 1), cB + hstep, voffA); PG8_STAGE(PG8_SA(0, 0), cA, voffA); PG8_STAGE(PG8_SA(0, 1), cA + hstep, voffA);
    if (wr == 1) PG8_BAR;
    PG8_WAIT_V(2); PG8_BAR;
    PG8_STAGE(PG8_SB(1, 0), cB + kstep, voffA); PG8_STAGE(PG8_SA(1, 0), cA + kstep, voffA); PG8_STAGE(PG8_SB(1, 1), cB + hstep + kstep, voffA);
    PG8_WAIT_V(6); PG8_BAR;
    for (;;) {
        const bool has_next = S.next(ui + 1, nxt);
        const char* nA = has_next ? (const char*)g.A + (size_t)nxt.pm * tstep : cA; const char* nB = has_next ? (const char*)g.Bt + (size_t)nxt.pn * tstep : cB;
        for (int t = 0; t < nt; t += 2) {
            const bool last = (t == nt - 2);
            const char* a1 = cA + (size_t)(t + 1) * kstep;
            const char* a2 = last ? nA : cA + (size_t)(t + 2) * kstep; const char* b2 = last ? nB : cB + (size_t)(t + 2) * kstep;
            const char* a3 = a2 + kstep; const char* b3 = b2 + kstep;
            PG8_LDB(B0, 0, 0); PG8_LDB(B1, 0, 1); PG8_SCHED; PG8_LDA(At, 0, 0); PG8_STAGE(PG8_SA(1, 1), a1 + hstep, voffA);
            PG8_WAIT_V(8); PG8_WAIT_L(0); PG8_BAR; PG8_MMA(0, 0, At, B0); PG8_MMA(0, 1, At, B1); PG8_BAR; PG8_SCHED;
            PG8_LDA(At, 0, 1); PG8_STAGE(PG8_SB(0, 0), b2, voffA); PG8_STAGE(PG8_SB(0, 1), b2 + hstep, voffA); PG8_STAGE(PG8_SA(0, 0), a2, voffA);
            PG8_WAIT_V(8); PG8_WAIT_L(0); PG8_BAR; PG8_MMA(1, 0, At, B0); PG8_MMA(1, 1, At, B1); PG8_BAR; PG8_SCHED;
            PG8_LDB(B0, 1, 0); PG8_LDB(B1, 1, 1); PG8_SCHED; PG8_LDA(At, 1, 0); PG8_STAGE(PG8_SA(0, 1), a2 + hstep, voffA);
            PG8_WAIT_V(8); PG8_WAIT_L(0); PG8_BAR; PG8_MMA(0, 0, At, B0); PG8_MMA(0, 1, At, B1); PG8_BAR; PG8_SCHED;
            PG8_LDA(At, 1, 1); PG8_STAGE(PG8_SB(1, 0), b3, voffA); PG8_STAGE(PG8_SB(1, 1), b3 + hstep, voffA); PG8_STAGE(PG8_SA(1, 0), a3, voffA);
            PG8_WAIT_V(8); PG8_WAIT_L(0); PG8_BAR; PG8_MMA(1, 0, At, B0); PG8_MMA(1, 1, At, B1); PG8_BAR; PG8_SCHED;
        }
        if (wr == 0) PG8_BAR;
        E(acc, cur, wr, wc, fr, fq);
        if (HOOK) {
            PG8_WAIT_V(0); PG8_BAR;
            ph8_item(*hargs, (unsigned char*)lds + STAGE_BYTES, (cur.pm * 8 + wid) * 8 + cur.pn);
        }
        if (!has_next) break;
#pragma unroll
        for (int a = 0; a < 2; ++a)
#pragma unroll
            for (int b = 0; b < 2; ++b)
#pragma unroll
                for (int m = 0; m < 4; ++m)
#pragma unroll
                    for (int n = 0; n < 2; ++n) acc[a][b][m][n] = (f32x4){0.f, 0.f, 0.f, 0.f};
        cur = nxt; cA = nA; cB = nB; ++ui;
        if (wr == 1) PG8_BAR;
    }
    PG8_WAIT_V(0);
    PG8_BAR;
#undef PG8_SA
#undef PG8_SB
#undef PG8_STAGE
#undef PG8_LDA
#undef PG8_LDB
#undef PG8_MMA
#undef PG8_WAIT_V
#undef PG8_WAIT_L
#undef PG8_BAR
#undef PG8_SCHED
}

typedef f32x4 Acc[2][2][4][2];
__device__ __forceinline__ f32x4 cvt_i4(const f32x4 b) { const i32x4 i = __builtin_bit_cast(i32x4, b); return (f32x4){(float)i[0], (float)i[1], (float)i[2], (float)i[3]}; }
template <bool I8>
struct EpiMainT {
    unsigned char* ws; const float *qg, *kg; int pn0; const float* hsc; const float* wsc; const PG8_LAS float* lg;
    __device__ __forceinline__ void operator()(const Acc& acc, const Unit& u, int wr, int wc, int fr, int fq) const {
        const int row0 = u.pm * BM + wr * 64 + fr, pn = u.pn + pn0;
        f32x4 ws4[2][2];
#pragma unroll
        for (int bj = 0; bj < 2; ++bj)
#pragma unroll
            for (int n = 0; n < 2; ++n) ws4[bj][n] = I8 ? *(const f32x4*)(wsc + pn * BM + 128 * bj + 32 * wc + 16 * n + 4 * fq) : (f32x4){1.f, 1.f, 1.f, 1.f};
#define EA_(ai, bj, m, n) (I8 ? cvt_i4(acc[ai][bj][m][n]) * ws4[bj][n] : acc[ai][bj][m][n])
        float hs8[2][4];
#pragma unroll
        for (int ai = 0; ai < 2; ++ai)
#pragma unroll
            for (int m = 0; m < 4; ++m) hs8[ai][m] = I8 ? hsc[row0 + ai * HALF + m * 16] : 1.f;
        if (pn == 8) {
            if (wc == 0) {
#pragma unroll
                for (int ai = 0; ai < 2; ++ai)
#pragma unroll
                    for (int m = 0; m < 4; ++m) { const size_t row = row0 + ai * HALF + m * 16;
#pragma unroll
                        for (int bj = 0; bj < 2; ++bj) { const f32x4 v0 = acc[ai][bj][m][0], v1 = acc[ai][bj][m][1];
                            *(f16x8*)((f16*)(ws + WS_KI) + (((row >> 5) * 8 + 4 * bj + fq) * 32 + (row & 31)) * 8) = (f16x8){(f16)v0[0], (f16)v0[1], (f16)v0[2], (f16)v0[3], (f16)v1[0], (f16)v1[1], (f16)v1[2], (f16)v1[3]}; } }
            } else if (wc == 1 && fq == 0) {
#pragma unroll
                for (int ai = 0; ai < 2; ++ai)
#pragma unroll
                    for (int m = 0; m < 4; ++m) { const size_t row = row0 + ai * HALF + m * 16;
                        *(f32x4*)((float*)(ws + WS_WI) + row * 8) = acc[ai][0][m][0] * 0.35355339059327373f; *(f32x4*)((float*)(ws + WS_WI) + row * 8 + 4) = acc[ai][0][m][1] * 0.35355339059327373f; }
            }
            return;
        }
        const int kind = pn >> 1;
        f16* base = (f16*)(ws + (kind == 0 ? WS_U : kind == 1 ? WS_Q : kind == 2 ? WS_K : WS_QI));
        const int col0 = (pn & 1) * 256 + 64 * wc + 8 * fq;
        if (kind == 1 || kind == 2) {
            const PG8_LAS float* gp = lg + (kind == 1 ? 0 : 64) + 8 * fq;
#pragma unroll
            for (int ai = 0; ai < 2; ++ai)
#pragma unroll
                for (int m = 0; m < 4; ++m) { const size_t row = row0 + ai * HALF + m * 16; const float hs = hs8[ai][m];
                    float ss = 0.f;
#pragma unroll
                    for (int bj = 0; bj < 2; ++bj)
#pragma unroll
                        for (int n = 0; n < 2; ++n) { const f32x4 v = EA_(ai, bj, m, n) * hs; ss += v[0] * v[0] + v[1] * v[1] + v[2] * v[2] + v[3] * v[3]; }
                    ss += __shfl_xor(ss, 16); ss += __shfl_xor(ss, 32);
                    const float rstd = rsqrtf(ss * (1.f / 64.f) + EPS);
#pragma unroll
                    for (int bj = 0; bj < 2; ++bj) { const f32x4 v0 = EA_(ai, bj, m, 0) * (hs * rstd) * *(const PG8_LAS f32x4*)(gp + 32 * bj), v1 = EA_(ai, bj, m, 1) * (hs * rstd) * *(const PG8_LAS f32x4*)(gp + 32 * bj + 4);
                        *(f16x8*)(base + row * 512 + col0 + 32 * bj) = (f16x8){(f16)v0[0], (f16)v0[1], (f16)v0[2], (f16)v0[3], (f16)v1[0], (f16)v1[1], (f16)v1[2], (f16)v1[3]}; }
                    asm volatile("" ::: "memory"); }
        } else if (kind == 3) {
            const int hd = (pn & 1) * 4 + wc;
#pragma unroll
            for (int ai = 0; ai < 2; ++ai)
#pragma unroll
                for (int m = 0; m < 4; ++m) { const size_t row = row0 + ai * HALF + m * 16; const int ql = (int)(row & 7);
                    const int rr = (hd & 3) | (((ql >> 1) & 1) << 2) | ((hd >> 2) << 3) | ((ql & 1) << 4);
#pragma unroll
                    for (int bj = 0; bj < 2; ++bj) { const f32x4 v0 = acc[ai][bj][m][0], v1 = acc[ai][bj][m][1]; const int chunk = fq + 4 * bj;
                        *(f16x8*)(base + ((((((row >> 3) * 2 + (ql >> 2)) * 4 + (chunk >> 1)) * 2 + (chunk & 1)) * 32 + rr) << 3)) = (f16x8){(f16)v0[0], (f16)v0[1], (f16)v0[2], (f16)v0[3], (f16)v1[0], (f16)v1[1], (f16)v1[2], (f16)v1[3]}; } }
        } else {
#pragma unroll
            for (int ai = 0; ai < 2; ++ai)
#pragma unroll
                for (int m = 0; m < 4; ++m) { const size_t row = row0 + ai * HALF + m * 16; const float hs = hs8[ai][m];
#pragma unroll
                    for (int bj = 0; bj < 2; ++bj) { const f32x4 v0 = EA_(ai, bj, m, 0) * hs, v1 = EA_(ai, bj, m, 1) * hs;
                        *(f16x8*)(base + row * 512 + col0 + 32 * bj) = (f16x8){(f16)v0[0], (f16)v0[1], (f16)v0[2], (f16)v0[3], (f16)v1[0], (f16)v1[1], (f16)v1[2], (f16)v1[3]}; } }
        }
#undef EA_
    }
};
typedef EpiMainT<false> EpiMain;
template <bool I8>
struct EpiVTT {
    f16* VT; const float* wsc; const float* hsc;
    __device__ __forceinline__ void operator()(const Acc& acc, const Unit& u, int wr, int wc, int fr, int fq) const {
        const int row0 = u.pm * BM + wr * 64 + fr, col0 = u.pn * BM + 32 * wc + 4 * fq;
        f32x4 hs4[2][2];
#pragma unroll
        for (int bj = 0; bj < 2; ++bj)
#pragma unroll
            for (int n = 0; n < 2; ++n) hs4[bj][n] = I8 ? *(const f32x4*)(hsc + col0 + 128 * bj + 16 * n) : (f32x4){1.f, 1.f, 1.f, 1.f};
        float wr8[2][4];
#pragma unroll
        for (int ai = 0; ai < 2; ++ai)
#pragma unroll
            for (int m = 0; m < 4; ++m) wr8[ai][m] = I8 ? wsc[row0 + ai * HALF + m * 16] : 1.f;
#pragma unroll
        for (int ai = 0; ai < 2; ++ai)
#pragma unroll
            for (int m = 0; m < 4; ++m) { const size_t row = row0 + ai * HALF + m * 16; const float wsr = wr8[ai][m];
#pragma unroll
                for (int bj = 0; bj < 2; ++bj) {
                    typedef unsigned u2_ __attribute__((ext_vector_type(2))); typedef unsigned u4_ __attribute__((ext_vector_type(4)));
                    const f32x4 v0 = I8 ? cvt_i4(acc[ai][bj][m][0]) * hs4[bj][0] * wsr : acc[ai][bj][m][0], v1 = I8 ? cvt_i4(acc[ai][bj][m][1]) * hs4[bj][1] * wsr : acc[ai][bj][m][1];
                    const u2_ a = __builtin_bit_cast(u2_, (f16x4){(f16)v0[0], (f16)v0[1], (f16)v0[2], (f16)v0[3]}), b = __builtin_bit_cast(u2_, (f16x4){(f16)v1[0], (f16)v1[1], (f16)v1[2], (f16)v1[3]});
                    const auto s0 = __builtin_amdgcn_permlane16_swap(a.x, b.x, false, false), s1 = __builtin_amdgcn_permlane16_swap(a.y, b.y, false, false);
                    *(u4_*)(VT + row * NT + col0 - 4 * (fq & 1) + 128 * bj + 16 * (fq & 1)) = (u4_){s0[0], s1[0], s0[1], s1[1]}; } }
    }
};
struct EpiOut {
    const float* x; const float* mod; f16* x1; const float* wsc;
    __device__ __forceinline__ void operator()(const Acc& acc, const Unit& u, int wr, int wc, int fr, int fq) const {
        const int row0 = u.pm * BM + wr * 64 + fr, col0 = u.pn * BM + 64 * wc + 8 * fq;
        const float* g1 = mod + ((u.pm * BM) / NS) * 6144 + 2048 + col0;
        f32x4 g4[2][2];
#pragma unroll
        for (int bj = 0; bj < 2; ++bj)
#pragma unroll
            for (int n = 0; n < 2; ++n) g4[bj][n] = *(const f32x4*)(g1 + 32 * bj + 4 * n) * *(const f32x4*)(wsc + u.pn * BM + 128 * bj + 32 * wc + 16 * n + 4 * fq);
#pragma unroll
        for (int ai = 0; ai < 2; ++ai) {
            f32x4 xv[4][2][2];
#pragma unroll
            for (int m = 0; m < 4; ++m)
#pragma unroll
                for (int bj = 0; bj < 2; ++bj) { const size_t off = (size_t)(row0 + ai * HALF + m * 16) * ND + col0; xv[m][bj][0] = *(const f32x4*)(x + off + 32 * bj); xv[m][bj][1] = *(const f32x4*)(x + off + 32 * bj + 4); }
#pragma unroll
            for (int m = 0; m < 4; ++m) { const size_t off = (size_t)(row0 + ai * HALF + m * 16) * ND + col0;
#pragma unroll
                for (int bj = 0; bj < 2; ++bj) { const f32x4 v0 = xv[m][bj][0] + g4[bj][0] * cvt_i4(acc[ai][bj][m][0]), v1 = xv[m][bj][1] + g4[bj][1] * cvt_i4(acc[ai][bj][m][1]);
                    *(f16x8*)(x1 + off + 32 * bj) = (f16x8){(f16)v0[0], (f16)v0[1], (f16)v0[2], (f16)v0[3], (f16)v1[0], (f16)v1[1], (f16)v1[2], (f16)v1[3]}; } }
        }
    }
};
struct EpiPQ {
    f16* PQ; const float* hsc; const float* wsc;
    __device__ __forceinline__ void operator()(const Acc& acc, const Unit& u, int wr, int wc, int fr, int fq) const {
        const int row0 = u.pm * BM + wr * 64 + fr, col0 = u.pn * BM + 64 * wc + 8 * fq;
        f32x4 ws4[2][2];
#pragma unroll
        for (int bj = 0; bj < 2; ++bj)
#pragma unroll
            for (int n = 0; n < 2; ++n) ws4[bj][n] = *(const f32x4*)(wsc + u.pn * BM + 128 * bj + 32 * wc + 16 * n + 4 * fq);
        float hs8[2][4];
#pragma unroll
        for (int ai = 0; ai < 2; ++ai)
#pragma unroll
            for (int m = 0; m < 4; ++m) hs8[ai][m] = hsc[row0 + ai * HALF + m * 16];
#pragma unroll
        for (int ai = 0; ai < 2; ++ai)
#pragma unroll
            for (int m = 0; m < 4; ++m) { const size_t row = row0 + ai * HALF + m * 16; const float hs = hs8[ai][m];
#pragma unroll
                for (int bj = 0; bj < 2; ++bj) { const i32x4 i0 = __builtin_bit_cast(i32x4, acc[ai][bj][m][0]), i1 = __builtin_bit_cast(i32x4, acc[ai][bj][m][1]);
                    const f32x4 v0 = (f32x4){(float)i0[0], (float)i0[1], (float)i0[2], (float)i0[3]} * ws4[bj][0] * hs, v1 = (f32x4){(float)i1[0], (float)i1[1], (float)i1[2], (float)i1[3]} * ws4[bj][1] * hs;
                    *(f16x8*)(PQ + (((((row & 255) >> 5) * 32 + ((64 * wc + 8 * fq + 32 * bj) >> 3)) * 32 + (row & 31)) << 3)) = (f16x8){(f16)v0[0], (f16)v0[1], (f16)v0[2], (f16)v0[3], (f16)v1[0], (f16)v1[1], (f16)v1[2], (f16)v1[3]}; } }
    }
};
}

__device__ __forceinline__ void ph2_inproj(const Args& a, int bid, int nb, unsigned char* lds) {
    const f16* H = (const f16*)(a.ws + WS_H); const f16* WIN = (const f16*)(a.ws + WS_WIN);
    const f16* H8 = (const f16*)(a.ws + WS_H8); const float* hs8 = (const float*)(a.ws + WS_H8 + 64 * MiB); const float* wsi = (const float*)(a.ws + WS_WSCIN);
    PG8_LAS unsigned char* l3 = (PG8_LAS unsigned char*)lds;
    PG8_LAS float* lg = (PG8_LAS float*)(l3 + pg8::STAGE_BYTES);
    if (__builtin_amdgcn_workitem_id_x() < 128) lg[__builtin_amdgcn_workitem_id_x()] = __builtin_amdgcn_workitem_id_x() < 64 ? a.in[9][__builtin_amdgcn_workitem_id_x()] : a.in[10][__builtin_amdgcn_workitem_id_x() - 64];
    __syncthreads();
    { pg8::Gemm g{H8, (const f16*)(a.ws + WS_WIN8), NT, 1536, ND / 2}; pg8::StaticOrder S; S.init(NT, 1536, nb, bid);
      pg8::EpiMainT<true> E{a.ws, a.in[9], a.in[10], 0, hs8, wsi, lg};
      pg8::gemm_phase<pg8::EpiMainT<true>, true>(l3, g, S, E); }
    { pg8::Gemm g{H, WIN + (size_t)1536 * ND, NT, NMAIN - 1536, ND}; pg8::StaticOrder S; S.init(NT, NMAIN - 1536, nb, bid);
      pg8::EpiMain E{a.ws, a.in[9], a.in[10], 6, nullptr, nullptr, lg};
      pg8::gemm_phase(l3, g, S, E); }
    { pg8::Gemm g{(const f16*)(a.ws + WS_WVT8), H8, 512, NT, ND / 2}; pg8::StaticOrder S; S.init(512, NT, nb, bid);
      pg8::EpiVTT<true> E{(f16*)(a.ws + WS_VT), wsi + 1536, hs8};
      pg8::gemm_phase<pg8::EpiVTT<true>, true>(l3, g, S, E); }
}


constexpr int PPITCH = 1040;
__device__ __forceinline__ void ph3_pool_fast(const Args& a, int bid, int nb, unsigned char* lds) {
    int tid = __builtin_amdgcn_workitem_id_x(); asm volatile("" : "+v"(tid));
    const int cg8 = tid & 63, tq = tid >> 6, gch = cg8 >> 4, win = 2 << gch;
    const f16* Z = (const f16*)(a.ws + WS_U); unsigned char* MIX8 = a.ws + WS_H;
    const f32x4 ps0 = *(const f32x4*)(a.in[7] + 8 * cg8), ps1 = *(const f32x4*)(a.in[7] + 8 * cg8 + 4), pg0 = *(const f32x4*)(a.in[8] + 8 * cg8), pg1 = *(const f32x4*)(a.in[8] + 8 * cg8 + 4);
    const float psc[8] = {ps0[0], ps0[1], ps0[2], ps0[3], ps1[0], ps1[1], ps1[2], ps1[3]}, pgn[8] = {pg0[0], pg0[1], pg0[2], pg0[3], pg1[0], pg1[1], pg1[2], pg1[3]};
    float psg[8];
#pragma unroll
    for (int j = 0; j < 8; ++j) psg[j] = pgn[j] > 0.f ? MIXQ : (pgn[j] < 0.f ? -MIXQ : 0.f);
    for (int item = bid; item < NT / 32; item += nb) {
        const int tb = item * 32 + 4 * tq, tl0 = tb % NS;
        const f16* up = Z + (size_t)(tb - tl0) * 512 + 8 * cg8;
        float sm[8];
#pragma unroll
        for (int j = 0; j < 8; ++j) sm[j] = 0.f;
        f16x8 hist_[15];
#pragma unroll
        for (int q = 0; q < 15; ++q) { const int rr = tl0 - 15 + q; hist_[q] = (q >= 16 - win && rr >= 0) ? *(const f16x8*)(up + (size_t)rr * 512) : (f16x8){0, 0, 0, 0, 0, 0, 0, 0}; }
        f16x8 cur_[4];
#pragma unroll
        for (int k = 0; k < 4; ++k) cur_[k] = *(const f16x8*)(up + (size_t)(tl0 + k) * 512);
#pragma unroll
        for (int q = 0; q < 15; ++q)
#pragma unroll
            for (int j = 0; j < 8; ++j) sm[j] += (float)hist_[q][j];
#pragma unroll
        for (int k = 0; k < 4; ++k) {
            const int tl = tl0 + k;
            const float ic = 1.f / (float)((tl + 1 < win) ? tl + 1 : win);
            float v[8]; float ss = 0.f;
#pragma unroll
            for (int j = 0; j < 8; ++j) { sm[j] += (float)cur_[k][j]; v[j] = (sm[j] * ic - (float)cur_[k][j]) * psc[j]; ss += v[j] * v[j]; }
            const float rstd = rsqrtf(wave_sum(ss) * (1.f / 512.f) + EPS);
            unsigned q0 = 0u, q1 = 0u;
#pragma unroll
            for (int j = 0; j < 8; ++j) { const float qf_ = fminf(fmaxf(v[j] * rstd * psg[j], -127.f), 127.f); const unsigned qb = (unsigned)((int)rintf(qf_) & 255);
                if (j < 4) q0 |= qb << (8 * j); else q1 |= qb << (8 * (j - 4)); }
            *(u64*)(MIX8 + (size_t)(tb + k) * ND + 8 * cg8) = (u64)q0 | ((u64)q1 << 32);
            if (k < 3) {
#pragma unroll
                for (int j = 0; j < 8; ++j) {
                    const int q = 16 - win + k;
                    float dv = 0.f;
#pragma unroll
                    for (int qq = 0; qq < 15; ++qq) if (qq == q) dv = (float)hist_[qq][j];
#pragma unroll
                    for (int kk = 0; kk < 3; ++kk) if (q == 15 + kk) dv = (float)cur_[kk][j];
                    sm[j] -= dv;
                }
            }
        }
    }
}


typedef float f32x2 __attribute__((ext_vector_type(2)));
typedef unsigned u32x4 __attribute__((ext_vector_type(4)));

constexpr int IDX_KPITCH = 16384 + 16;
constexpr int IDX_HPITCH = 516;
template <int NBL>
__device__ __forceinline__ int wave_pick(const unsigned (&cc)[NBL], unsigned target, int lane, unsigned& rem_out) {
    unsigned tot = 0u;
#pragma unroll
    for (int j = 0; j < NBL; ++j) tot += cc[j];
    unsigned S = tot;
    S += (unsigned)__builtin_amdgcn_update_dpp(0, (int)S, 0x101, 0xF, 0xF, true);
    S += (unsigned)__builtin_amdgcn_update_dpp(0, (int)S, 0x102, 0xF, 0xF, true);
    S += (unsigned)__builtin_amdgcn_update_dpp(0, (int)S, 0x104, 0xF, 0xF, true);
    S += (unsigned)__builtin_amdgcn_update_dpp(0, (int)S, 0x108, 0xF, 0xF, true);
    { const unsigned t1 = (unsigned)__builtin_amdgcn_readlane((int)S, 16), t2 = (unsigned)__builtin_amdgcn_readlane((int)S, 32), t3 = (unsigned)__builtin_amdgcn_readlane((int)S, 48);
      S += lane < 16 ? t1 + t2 + t3 : lane < 32 ? t2 + t3 : lane < 48 ? t3 : 0u; }
    const unsigned above = S - tot;
    const bool hit = (above < target) && (S >= target);
    const u64 bal = __ballot(hit);
    const int L = bal ? __builtin_ctzll(bal) : 0;
    int bin = 0; unsigned rem = target;
    { unsigned run = above; bool done = false;
#pragma unroll
      for (int j = NBL - 1; j >= 0; --j) { if (!done) { if (run + cc[j] >= target) { bin = NBL * lane + j; rem = target - run; done = true; } else run += cc[j]; } } }
    { const int Ls = __builtin_amdgcn_readfirstlane(L); bin = __builtin_amdgcn_readlane(bin, Ls); rem_out = (unsigned)__builtin_amdgcn_readlane((int)rem, Ls); }
    return bin;
}
template <int MODE>
__device__ __forceinline__ void ph3_index_fast(const Args& a, int bid, int nb, unsigned char* lds) {
    int tid = __builtin_amdgcn_workitem_id_x(); asm volatile("" : "+v"(tid));
    const int lane = tid & 63, wave = __builtin_amdgcn_readfirstlane(tid >> 6), r = lane & 31, hh = lane >> 5;
    const f16* QI = (const f16*)(a.ws + WS_QI); const f16* KI = (const f16*)(a.ws + WS_KI); const float* WI = (const float*)(a.ws + WS_WI);
    u64* MASK = (u64*)(a.ws + WS_MASK);
    unsigned* hist = (unsigned*)(lds + 8 * IDX_KPITCH);
    f16x8 af[2][4]; f32x2 wv2[2][8];
#define IDX_LOAD_FRAGS(t0_) do { \
        _Pragma("unroll") for (int rt = 0; rt < 2; ++rt) { \
            _Pragma("unroll") for (int ks = 0; ks < 4; ++ks) af[rt][ks] = *(const f16x8*)(QI + ((((((size_t)((t0_) >> 3) * 2 + rt) * 4 + ks) * 2 + hh) * 32 + r) << 3)); \
            _Pragma("unroll") for (int qq = 0; qq < 2; ++qq) { const float* wp = WI + (size_t)((t0_) + 4 * rt + 2 * hh + qq) * 8; const f32x4 w0 = *(const f32x4*)wp * 0.125f, w1 = *(const f32x4*)(wp + 4) * 0.125f; \
                wv2[rt][4 * qq + 0] = (f32x2){w0[0], w0[1]}; wv2[rt][4 * qq + 1] = (f32x2){w0[2], w0[3]}; wv2[rt][4 * qq + 2] = (f32x2){w1[0], w1[1]}; wv2[rt][4 * qq + 3] = (f32x2){w1[2], w1[3]}; } \
        } } while (0)
    for (int round = 0; round * nb < 256; ++round) {
        const int p = round * nb + ((round & 1) ? (nb - 1 - bid) : bid);
        if (p < 256) { const int tg = p >> 3, b_ = p & 7, t0l = tg * 8, ch_ = t0l >> 6, t0_ = b_ * NS + t0l;
            if (tid < 8 * (ch_ + 1)) { const int q = tid / (ch_ + 1), w = tid % (ch_ + 1); MASK[((size_t)b_ * 128 + w) * NS + t0l + q] = ~0ull; } }
    }
#define IDX_P(round_) ((round_) * nb + (((round_) & 1) ? (nb - 1 - bid) : bid))
    int round = 0;
    while (round * nb < 8192 && !(IDX_P(round) >= 256 && IDX_P(round) < 8192)) ++round;
    if (round * nb < 8192) { const int p0 = IDX_P(round); IDX_LOAD_FRAGS((p0 & 7) * NS + (p0 >> 3) * 8); }
    for (; round * nb < 8192; ) {
        const int p = IDX_P(round);
        int rnext = round + 1;
        while (rnext * nb < 8192 && !(IDX_P(rnext) >= 256 && IDX_P(rnext) < 8192)) ++rnext;
        const bool has_next = rnext * nb < 8192;
        const int pn = has_next ? IDX_P(rnext) : p;
        const int tg = p >> 3, b = p & 7, t0l = tg * 8, ch = t0l >> 6, nadm = 64 * (ch + 1), t0 = b * NS + t0l;
        const int t0n = (pn & 7) * NS + (pn >> 3) * 8;
        round = has_next ? rnext : 8192;
        __syncthreads();
#pragma unroll
        for (int i = 0; i < 9; ++i) if (tid + i * NTHR < 8 * IDX_HPITCH) hist[tid + i * NTHR] = 0u;
        __syncthreads();
        const int nkb = nadm >> 5;
        const f16* kbase = KI + ((size_t)(b * (NS / 32)) * 8 + hh) * 256 + r * 8;
#define IDX_LOADB(dst, kb_) do { _Pragma("unroll") for (int ks = 0; ks < 4; ++ks) dst[ks] = *(const f16x8*)(kbase + ((size_t)(kb_) * 8 + 2 * ks) * 256); } while (0)
#define IDX_BLOCK(bfrag, kb_) do { \
            f32x16 acc[2]; \
            _Pragma("unroll") for (int rt = 0; rt < 2; ++rt) { acc[rt] = (f32x16){0.f, 0.f, 0.f, 0.f, 0.f, 0.f, 0.f, 0.f, 0.f, 0.f, 0.f, 0.f, 0.f, 0.f, 0.f, 0.f}; \
                _Pragma("unroll") for (int ks = 0; ks < 4; ++ks) acc[rt] = __builtin_amdgcn_mfma_f32_32x32x16_f16(af[rt][ks], bfrag[ks], acc[rt], 0, 0, 0); } \
            _Pragma("unroll") for (int rt = 0; rt < 2; ++rt) \
                _Pragma("unroll") for (int qq = 0; qq < 2; ++qq) { \
                    f32x2 t2 = (f32x2){0.f, 0.f}; \
                    _Pragma("unroll") for (int hp = 0; hp < 4; ++hp) { const f32x2 r2 = (f32x2){__int_as_float(max(__float_as_int(acc[rt][8 * qq + 2 * hp]), 0)), __int_as_float(max(__float_as_int(acc[rt][8 * qq + 2 * hp + 1]), 0))}; \
                        t2 = __builtin_elementwise_fma(wv2[rt][4 * qq + hp], r2, t2); } \
                    const float sc = t2[0] + t2[1]; \
                    const f16 sh = (f16)sc; const unsigned bits = (unsigned)__builtin_bit_cast(unsigned short, sh); \
                    unsigned sg_; asm("v_bfe_i32 %0, %1, 15, 1" : "=v"(sg_) : "v"(bits)); \
                    const unsigned key = bits ^ (sg_ | 0x8000u);     \
                    const int q = 4 * rt + 2 * hh + qq; \
                    if (MODE != 2) *(u16*)(lds + q * IDX_KPITCH + ((kb_) * 32 + r) * 2) = (u16)key; \
                    if (MODE != 2 && MODE != 4) { unsigned hi_, hb_, hv_; asm("v_bfe_u32 %0, %1, 7, 9" : "=v"(hi_) : "v"(key)); asm("v_bfe_u32 %0, %1, 6, 1" : "=v"(hb_) : "v"(key)); asm("v_mad_u32_u24 %0, %1, %2, 1" : "=v"(hv_) : "v"(hb_), "s"(0xFFFFu)); atomicAdd(&hist[q * IDX_HPITCH + hi_], hv_); } \
                    if (MODE == 2) sink += key; \
                } } while (0)
        f16x8 bf0[4], bf1[4], bf2[4]; unsigned sink = 0u;
        if (wave >= 4) __builtin_amdgcn_s_sleep(5);
        if (wave < nkb) IDX_LOADB(bf0, wave);
        if (wave + 8 < nkb) IDX_LOADB(bf1, wave + 8);
        if (wave + 16 < nkb) IDX_LOADB(bf2, wave + 16);
        if (MODE != 3) for (int kb = wave; kb < nkb; kb += 24) {
            IDX_BLOCK(bf0, kb);
            if (kb + 24 < nkb) IDX_LOADB(bf0, kb + 24);
            if (kb + 8 < nkb) { IDX_BLOCK(bf1, kb + 8); if (kb + 32 < nkb) IDX_LOADB(bf1, kb + 32); }
            if (kb + 16 < nkb) { IDX_BLOCK(bf2, kb + 16); if (kb + 40 < nkb) IDX_LOADB(bf2, kb + 40); }
        }
#undef IDX_LOADB
#undef IDX_BLOCK
        if (MODE == 2 && sink == 0xdeadbeefu) hist[tid] = sink;
        IDX_LOAD_FRAGS(t0n);
        __syncthreads();
        if (MODE != 1) {
            unsigned* hw = hist + wave * IDX_HPITCH;
            const unsigned char* krow = lds + wave * IDX_KPITCH;
            unsigned rem1 = 0u, rem2 = 0u;
            int b1;
            {   const u32x4 d0 = *(const u32x4*)(hw + 8 * lane), d1 = *(const u32x4*)(hw + 8 * lane + 4);
                const unsigned dd[8] = {d0.x, d0.y, d0.z, d0.w, d1.x, d1.y, d1.z, d1.w};
                unsigned cc[16];
#pragma unroll
                for (int j = 0; j < 8; ++j) { cc[2 * j] = dd[j] & 0xFFFFu; cc[2 * j + 1] = dd[j] >> 16; }
                b1 = wave_pick<16>(cc, 256u, lane, rem1); }
            hw[lane] = 0u;
            const int nit = (nadm + 511) >> 9;
            for (int it = 0; it < nit; ++it) {
                const int idx = (it * 64 + lane) * 8;
                if (idx < nadm) { const u32x4 k4 = *(const u32x4*)(krow + idx * 2);
                    const unsigned kk[4] = {k4.x, k4.y, k4.z, k4.w};
                    unsigned hit = 0u;
#pragma unroll
                    for (int j = 0; j < 4; ++j) { hit |= (((kk[j] & 0xFFFFu) >> 6) == (unsigned)b1 ? 1u : 0u) << (2 * j); hit |= ((kk[j] >> 22) == (unsigned)b1 ? 1u : 0u) << (2 * j + 1); }
                    if (hit) {
#pragma unroll
                        for (int j = 0; j < 4; ++j) { const unsigned k0 = kk[j] & 0xFFFFu, k1 = kk[j] >> 16;
                            if (hit & (1u << (2 * j))) atomicAdd(&hw[k0 & 63u], 1u);
                            if (hit & (2u << (2 * j))) atomicAdd(&hw[k1 & 63u], 1u); }
                    } }
            }
            int b2;
            { const unsigned c1[1] = {hw[lane]}; b2 = wave_pick<1>(c1, rem1, lane, rem2); }
            const unsigned tau = ((unsigned)b1 << 6) | (unsigned)b2;
            const size_t mrow = (size_t)(t0 + wave) * 128;
            for (int it = 0; it < nit; ++it) {
                const int idx = (it * 64 + lane) * 8;
                unsigned byte = 0u;
                if (idx < nadm) { const u32x4 k4 = *(const u32x4*)(krow + idx * 2);
                    const unsigned kk[4] = {k4.x, k4.y, k4.z, k4.w};
#pragma unroll
                    for (int j = 0; j < 4; ++j) { byte |= ((kk[j] & 0xFFFFu) >= tau ? 1u : 0u) << (2 * j); byte |= ((kk[j] >> 16) >= tau ? 1u : 0u) << (2 * j + 1); } }
                if (idx < nadm) ((unsigned char*)(hw + 64))[it * 64 + lane] = (unsigned char)byte;
            }
        }
        __syncthreads();
        if (MODE != 1) { const int w = tid >> 2, qp = tid & 3;
            if (w <= ch) { const unsigned* ha = hist + (2 * qp) * IDX_HPITCH + 64 + 2 * w; const unsigned* hb = ha + IDX_HPITCH;
                *(u32x4*)(MASK + ((size_t)b * 128 + w) * NS + t0l + 2 * qp) = (u32x4){ha[0], ha[1], hb[0], hb[1]}; } }
    }
    __syncthreads();
}

constexpr int ATP = 144;
constexpr int ATT_QWORD = 3584 + 32 * 64;
template <int AMODE>
__device__ __forceinline__ void ph4_attn_fast(const Args& a, int bid, int nb, unsigned char* lds) {
    int tid = __builtin_amdgcn_workitem_id_x(); asm volatile("" : "+v"(tid));
    const int lane = tid & 63, wave = __builtin_amdgcn_readfirstlane(tid >> 6), r = lane & 31, hh = lane >> 5;
    const f16* Q = (const f16*)(a.ws + WS_Q); const f16* Kk = (const f16*)(a.ws + WS_K); const f16* VT = (const f16*)(a.ws + WS_VT);
    const u64* MASK = (const u64*)(a.ws + WS_MASK); unsigned char* MIX8 = a.ws + WS_H; const float* og = a.in[11];
    unsigned char* Kl = lds; unsigned char* Vl = lds + 2 * 64 * ATP;
    const float LOG2E = 1.4426950408889634f, OFF = 8192.f;
    const int pir = 16 * (r >> 4) + 8 * ((r >> 2) & 1) + 4 * ((r >> 3) & 1) + (r & 3);
    const int srow = tid >> 3, schk = tid & 7;
    unsigned* aq = (unsigned*)(a.ws + WS_CTL) + ATT_QWORD;
    lds_u32* ucell = (lds_u32*)(lds + 6 * 64 * ATP);
    lds_u32* dflag = ucell + 8;
    const float kmax = __int_as_float(__builtin_amdgcn_readfirstlane(__float_as_int(1.01f * 8.f * wave_max(fabsf(a.in[10][lane])))));
    int upar = 0;
    for (;;) {
        if (tid == 0) ucell[upar] = __hip_atomic_fetch_add(aq, 1u, __ATOMIC_RELAXED, __HIP_MEMORY_SCOPE_AGENT);
        if (tid < 8) dflag[tid] = 0u;
        __syncthreads();
        const unsigned u = ucell[upar]; upar ^= 1;
        if (u >= 2048u) break;
        const int h = 7 - (int)(u >> 8), qb = 31 - (int)((u & 255u) >> 3), b = (int)(u & 7u);
        const int q0l = qb * 256, tq = q0l + 32 * wave + r, cw = 4 * qb + (wave >> 1), top = 4 * qb + 3;
        const size_t t = (size_t)b * NS + tq;
        const float slope = exp2f(-(float)(h + 1)) * LOG2E;
        f16x8 qf[4];
#pragma unroll
        for (int ks = 0; ks < 4; ++ks) { const f16x8 qv = *(const f16x8*)(Q + t * 512 + h * 64 + 16 * ks + 8 * hh);
#pragma unroll
            for (int j = 0; j < 8; ++j) qf[ks][j] = (f16)((float)qv[j] * (0.125f * LOG2E)); }
        float qss = 0.f;
#pragma unroll
        for (int ks = 0; ks < 4; ++ks)
#pragma unroll
            for (int j = 0; j < 8; ++j) qss += (float)qf[ks][j] * (float)qf[ks][j];
        qss += __shfl_xor(qss, 32);
        const float Sb = __int_as_float(__builtin_amdgcn_readfirstlane(__float_as_int(wave_max(sqrtf(qss)) * kmax)));
        const float rowc = OFF + slope * (float)(tq - q0l);
        float m = 0.f, l = 0.f; bool mset = false;
        f32x16 O[2];
#pragma unroll
        for (int dt = 0; dt < 2; ++dt) O[dt] = (f32x16){0.f, 0.f, 0.f, 0.f, 0.f, 0.f, 0.f, 0.f, 0.f, 0.f, 0.f, 0.f, 0.f, 0.f, 0.f, 0.f};
        const f16* kg = Kk + ((size_t)b * NS + srow) * 512 + h * 64 + schk * 8;
        const f16* vg = VT + (size_t)(h * 64 + srow) * NT + (size_t)b * NS + schk * 8;
        f16x8 kr0, kr1, vr0, vr1; u64 mw0 = 0ull, mw1 = 0ull;
#define ATT_LOAD(kr, vr, mwv, jj) do { const int jc_ = (jj) > 0 ? (jj) : 0; mwv = MASK[((size_t)b * 128 + jc_) * NS + tq]; asm volatile("" ::: "memory"); \
            kr = *(const f16x8*)(kg + (size_t)jc_ * 64 * 512); vr = *(const f16x8*)(vg + jc_ * 64); } while (0)
        asm volatile("" ::: "memory"); ATT_LOAD(kr0, vr0, mw0, top); asm volatile("" ::: "memory"); ATT_LOAD(kr1, vr1, mw1, top - 1); asm volatile("" ::: "memory");
        int buf = 0; bool wdone = false, stop = false;
        auto step = [&](f16x8& kreg, f16x8& vreg, u64& mwr, const int j) {
            *(f16x8*)(Kl + buf * 64 * ATP + srow * ATP + schk * 16) = kreg;
            *(f16x8*)(Vl + buf * 64 * ATP + srow * ATP + schk * 16) = vreg;
            const u64 mw = (j <= cw) ? mwr : 0ull;
            asm volatile("s_waitcnt lgkmcnt(0)" ::: "memory"); __builtin_amdgcn_s_barrier(); asm volatile("" ::: "memory");
            asm volatile("" ::: "memory"); ATT_LOAD(kreg, vreg, mwr, j - 2); asm volatile("" ::: "memory");
            {
                const unsigned jp = (unsigned)(j + 1);
                typedef __attribute__((address_space(3))) u32x4 lds_u32x4;
                const u32x4 da = *(const lds_u32x4*)dflag, db = *(const lds_u32x4*)(dflag + 4);
                const unsigned dmin = min(min(min(da.x, da.y), min(da.z, da.w)), min(min(db.x, db.y), min(db.z, db.w)));
                if (dmin > jp) { stop = true; return; }
            }
            if (!wdone && j < cw) { const float lmax = Sb + slope * (float)(64 * j + 63 - tq); if (__all(mset && (lmax - m < -28.f))) { wdone = true; if (lane == 0) dflag[wave] = (unsigned)(j + 1); } }
            if (j <= cw && !wdone) {
                const unsigned char* kb_ = Kl + buf * 64 * ATP + pir * ATP + 16 * hh;
                f16x8 fr8[8];
#pragma unroll
                for (int kt = 0; kt < 2; ++kt)
#pragma unroll
                    for (int ks = 0; ks < 4; ++ks) fr8[kt * 4 + ks] = *(const f16x8*)(kb_ + kt * 32 * ATP + ks * 32);
                f32x16 sa[2];
                {
                    const float base = slope * (float)(64 * j + 8 * hh - tq) - m;
#pragma unroll
                    for (int kt = 0; kt < 2; ++kt)
#pragma unroll
                        for (int rg = 0; rg < 16; ++rg) sa[kt][rg] = __builtin_fmaf(slope, (float)(32 * kt + 16 * (rg >> 3) + (rg & 7)), base);
                    if (j == cw) {
#pragma unroll
                        for (int kt = 0; kt < 2; ++kt)
#pragma unroll
                            for (int rg = 0; rg < 16; ++rg) { const float x = (float)(64 * j + 32 * kt + 16 * (rg >> 3) + 8 * hh + (rg & 7) - tq); sa[kt][rg] = __builtin_fmaf(-2.f * slope, fmaxf(x, 0.f), sa[kt][rg]); }
                    }
                }
                __builtin_amdgcn_sched_barrier(0);
                __builtin_amdgcn_s_setprio(1);
#pragma unroll
                for (int kt = 0; kt < 2; ++kt)
#pragma unroll
                    for (int ks = 0; ks < 4; ++ks) sa[kt] = __builtin_amdgcn_mfma_f32_32x32x16_f16(fr8[kt * 4 + ks], qf[ks], sa[kt], 0, 0, 0);
                __builtin_amdgcn_s_setprio(0);
                const unsigned char* vb_ = Vl + buf * 64 * ATP + r * ATP + 16 * hh;
#pragma unroll
                for (int dt = 0; dt < 2; ++dt)
#pragma unroll
                    for (int kt = 0; kt < 2; ++kt)
#pragma unroll
                        for (int s2 = 0; s2 < 2; ++s2) fr8[dt * 4 + kt * 2 + s2] = *(const f16x8*)(vb_ + dt * 32 * ATP + kt * 64 + s2 * 32);
                const float NEGB = -1.0e30f;
                float rm = NEGB;
#pragma unroll
                for (int kt = 0; kt < 2; ++kt) { const unsigned w32 = (unsigned)(kt ? (mw >> 32) : mw) >> (8 * hh);
#pragma unroll
                    for (int rg = 0; rg < 16; ++rg) { const int tm = __builtin_amdgcn_sbfe((int)w32, 16 * (rg >> 3) + (rg & 7), 1);
                        const float L = __int_as_float((__float_as_int(sa[kt][rg]) & tm) | (~tm & __float_as_int(NEGB))); sa[kt][rg] = L; rm = fmaxf(rm, L); } }
                rm = fmaxf(rm, __shfl_xor(rm, 32));
                const bool first = !mset && rm > -1.0e29f;
                if (__any(first || rm > 8.f)) {
                    const bool mv = first || rm > 8.f;
                    const float dl = mv ? rm : 0.f;
                    const float al = first ? 0.f : __builtin_amdgcn_exp2f(-dl);
                    m += dl; l *= al;
#pragma unroll
                    for (int dt = 0; dt < 2; ++dt)
#pragma unroll
                        for (int rg = 0; rg < 16; ++rg) O[dt][rg] *= al;
#pragma unroll
                    for (int kt = 0; kt < 2; ++kt)
#pragma unroll
                        for (int rg = 0; rg < 16; ++rg) sa[kt][rg] -= dl;
                    mset = mset || first;
                }
                f16x8 pf[2][2];
                float l0 = 0.f, l1 = 0.f;
#pragma unroll
                for (int kt = 0; kt < 2; ++kt)
#pragma unroll
                    for (int rg = 0; rg < 16; ++rg) { const float pp = __builtin_amdgcn_exp2f(sa[kt][rg]); if (rg & 1) l1 += pp; else l0 += pp; pf[kt][rg >> 3][rg & 7] = (f16)pp; }
                l += l0 + l1;
                __builtin_amdgcn_sched_barrier(0);
                __builtin_amdgcn_s_setprio(1);
#pragma unroll
                for (int dt = 0; dt < 2; ++dt)
#pragma unroll
                    for (int kt = 0; kt < 2; ++kt)
#pragma unroll
                        for (int s2 = 0; s2 < 2; ++s2) O[dt] = __builtin_amdgcn_mfma_f32_32x32x16_f16(fr8[dt * 4 + kt * 2 + s2], pf[kt][s2], O[dt], 0, 0, 0);
                __builtin_amdgcn_s_setprio(0);
            }
            buf ^= 1;
        };
        for (int j = top; j >= 0; j -= 2) {
            step(kr0, vr0, mw0, j); if (stop) break;
            step(kr1, vr1, mw1, j - 1); if (stop) break;
        }
#undef ATT_LOAD
        l += __shfl_xor(l, 32);
        const float inv = 1.f / l;
        float ss = 0.f;
#pragma unroll
        for (int dt = 0; dt < 2; ++dt)
#pragma unroll
            for (int rg = 0; rg < 16; ++rg) { O[dt][rg] *= inv; ss += O[dt][rg] * O[dt][rg]; }
        ss += __shfl_xor(ss, 32);
        const float rstd = rsqrtf(ss * (1.f / 64.f) + EPS);
#pragma unroll
        for (int dt = 0; dt < 2; ++dt)
#pragma unroll
            for (int g4 = 0; g4 < 4; ++g4) { const int d = 32 * dt + 8 * g4 + 4 * hh; const f32x4 gg = *(const f32x4*)(og + h * 64 + d);
                unsigned pk = 0u;
#pragma unroll
                for (int e = 0; e < 4; ++e) { const float sg = gg[e] > 0.f ? MIXQ : (gg[e] < 0.f ? -MIXQ : 0.f); const float qf_ = fminf(fmaxf(O[dt][4 * g4 + e] * rstd * sg, -127.f), 127.f);
                    pk |= (unsigned)((int)rintf(qf_) & 255) << (8 * e); }
                *(unsigned*)(MIX8 + t * ND + 512 + h * 64 + d) = pk; }
        __syncthreads();
    }
}

__device__ __forceinline__ void ph5_outproj(const Args& a, int bid, int nb, unsigned char* lds) {
    pg8::Gemm g{(const f16*)(a.ws + WS_H), (const f16*)(a.ws + WS_WOUT8), NT, 1024, ND / 2}; pg8::StaticOrder S; S.init(NT, 1024, nb, bid);
    pg8::EpiOut E{a.in[0], (const float*)(a.ws + WS_MOD), (f16*)(a.ws + WS_X1), (const float*)(a.ws + WS_WSCIN) + 4096};
    pg8::gemm_phase<pg8::EpiOut, true>((PG8_LAS unsigned char*)lds, g, S, E);
}

__device__ __forceinline__ void ph7_peerq(const Args& a, int bid, int nb, unsigned char* lds) {
    pg8::Gemm g{(const f16*)(a.ws + WS_HQ), (const f16*)(a.ws + WS_WQ8), NT, 2048, ND / 2}; pg8::StaticOrder S; S.init(NT, 2048, nb, bid);
    pg8::EpiPQ E{(f16*)(a.ws + WS_PQ) + (size_t)bid * 65536, (const float*)(a.ws + WS_HSC), (const float*)(a.ws + WS_WSC)};
    pg8::gemm_phase<pg8::EpiPQ, true, true>((PG8_LAS unsigned char*)lds, g, S, E, &a);
}


__device__ __forceinline__ unsigned f2skey(float f) { const unsigned u = __float_as_uint(f); return (u & 0x80000000u) ? ~u : (u | 0x80000000u); }
__device__ __forceinline__ float skey2f(unsigned k) { return __uint_as_float((k & 0x80000000u) ? (k & 0x7FFFFFFFu) : ~k); }
#define CE_(a_, b_) do { const unsigned t__ = max(a_, b_); b_ = min(a_, b_); a_ = t__; } while (0)
#define SORT16_DESC(v) do { CE_(v[0], v[1]); CE_(v[2], v[3]); CE_(v[0], v[2]); CE_(v[1], v[3]); CE_(v[1], v[2]); CE_(v[4], v[5]); CE_(v[6], v[7]); CE_(v[4], v[6]); CE_(v[5], v[7]); CE_(v[5], v[6]); CE_(v[0], v[4]); CE_(v[2], v[6]); CE_(v[2], v[4]); CE_(v[1], v[5]); CE_(v[3], v[7]); CE_(v[3], v[5]); CE_(v[1], v[2]); CE_(v[3], v[4]); CE_(v[5], v[6]); CE_(v[8], v[9]); CE_(v[10], v[11]); CE_(v[8], v[10]); CE_(v[9], v[11]); CE_(v[9], v[10]); CE_(v[12], v[13]); CE_(v[14], v[15]); CE_(v[12], v[14]); CE_(v[13], v[15]); CE_(v[13], v[14]); CE_(v[8], v[12]); CE_(v[10], v[14]); CE_(v[10], v[12]); CE_(v[9], v[13]); CE_(v[11], v[15]); CE_(v[11], v[13]); CE_(v[9], v[10]); CE_(v[11], v[12]); CE_(v[13], v[14]); CE_(v[0], v[8]); CE_(v[4], v[12]); CE_(v[4], v[8]); CE_(v[2], v[10]); CE_(v[6], v[14]); CE_(v[6], v[10]); CE_(v[2], v[4]); CE_(v[6], v[8]); CE_(v[10], v[12]); CE_(v[1], v[9]); CE_(v[5], v[13]); CE_(v[5], v[9]); CE_(v[3], v[11]); CE_(v[7], v[15]); CE_(v[7], v[11]); CE_(v[3], v[5]); CE_(v[7], v[9]); CE_(v[11], v[13]); CE_(v[1], v[2]); CE_(v[3], v[4]); CE_(v[5], v[6]); CE_(v[7], v[8]); CE_(v[9], v[10]); CE_(v[11], v[12]); CE_(v[13], v[14]); } while (0)
#define BITONIC16_DESC(v) do { CE_(v[0], v[8]); CE_(v[1], v[9]); CE_(v[2], v[10]); CE_(v[3], v[11]); CE_(v[4], v[12]); CE_(v[5], v[13]); CE_(v[6], v[14]); CE_(v[7], v[15]); CE_(v[0], v[4]); CE_(v[1], v[5]); CE_(v[2], v[6]); CE_(v[3], v[7]); CE_(v[8], v[12]); CE_(v[9], v[13]); CE_(v[10], v[14]); CE_(v[11], v[15]); CE_(v[0], v[2]); CE_(v[1], v[3]); CE_(v[4], v[6]); CE_(v[5], v[7]); CE_(v[8], v[10]); CE_(v[9], v[11]); CE_(v[12], v[14]); CE_(v[13], v[15]); CE_(v[0], v[1]); CE_(v[2], v[3]); CE_(v[4], v[5]); CE_(v[6], v[7]); CE_(v[8], v[9]); CE_(v[10], v[11]); CE_(v[12], v[13]); CE_(v[14], v[15]); } while (0)
#define MERGE16_DESC(dst, other) do { unsigned c__[16]; _Pragma("unroll") for (int i__ = 0; i__ < 16; ++i__) c__[i__] = max(dst[i__], other[15 - i__]); BITONIC16_DESC(c__); _Pragma("unroll") for (int i__ = 0; i__ < 16; ++i__) dst[i__] = c__[i__]; } while (0)
#define TOP16_INSERT(v, x_) do { unsigned x__ = (x_); _Pragma("unroll") for (int k_ = 0; k_ < 16; ++k_) { const unsigned t__ = max(v[k_], x__); x__ = min(v[k_], x__); v[k_] = t__; } } while (0)
__device__ __forceinline__ void ph8_item(const Args& a, unsigned char* lds, const int item) {
    int tid = __builtin_amdgcn_workitem_id_x(); asm volatile("" : "+v"(tid));
    const int lane = tid & 63, wave = __builtin_amdgcn_readfirstlane(tid >> 6), r = lane & 31, hh = lane >> 5;
    const f16* PQ = (const f16*)(a.ws + WS_PQ) + (size_t)__builtin_amdgcn_workgroup_id_x() * 65536;
    u16* EID = (u16*)(a.ws + WS_EID); float* GW = (float*)(a.ws + WS_GW);
    unsigned char* wl = lds + wave * 2048 + lane * 32;
    {
        const int tt = item >> 3, h = item & 7, t0 = tt * 32;
        unsigned top[2][16];
#pragma unroll
        for (int p = 0; p < 2; ++p) {
            f16x8 sq[8];
#pragma unroll
            for (int c = 0; c < 8; ++c) sq[c] = *(const f16x8*)(PQ + ((((size_t)(tt & 7) * 32 + p * 16 + 8 * hh + c) * 32 + r) << 3));
#pragma unroll
            for (int g = 0; g < 4; ++g) {
                unsigned ky[16];
#pragma unroll
                for (int i = 0; i < 16; ++i) { const unsigned n = 64u * hh + 16u * g + i; ky[i] = (f2skey((float)sq[2 * g + (i >> 3)][i & 7]) & ~127u) | n; }
                SORT16_DESC(ky);
                if (g == 0) {
#pragma unroll
                    for (int k = 0; k < 16; ++k) top[p][k] = ky[k];
                } else MERGE16_DESC(top[p], ky);
            }
            unsigned oth[16];
#pragma unroll
            for (int k = 0; k < 16; ++k) oth[k] = __shfl_xor(top[p][k], 32);
            MERGE16_DESC(top[p], oth);
            asm volatile("" ::: "memory");
        }
#pragma unroll
        for (int k = 0; k < 16; k += 4) {
            *(unsigned*)(wl + k) = (top[0][k] & 127u) | ((top[0][k + 1] & 127u) << 8) | ((top[0][k + 2] & 127u) << 16) | ((top[0][k + 3] & 127u) << 24);
            *(unsigned*)(wl + 16 + k) = (top[1][k] & 127u) | ((top[1][k + 1] & 127u) << 8) | ((top[1][k + 2] & 127u) << 16) | ((top[1][k + 3] & 127u) << 24);
        }
        float fa[16], fb[16];
#pragma unroll
        for (int k = 0; k < 16; ++k) { fa[k] = skey2f(top[0][k] & ~127u); fb[k] = skey2f(top[1][k] & ~127u); }
        unsigned cg[4][16];
        cg[0][0] = (f2skey(fa[0] + fb[0]) & ~255u) | 0u;
        cg[0][1] = (f2skey(fa[0] + fb[1]) & ~255u) | 1u;
        cg[0][2] = (f2skey(fa[0] + fb[2]) & ~255u) | 2u;
        cg[0][3] = (f2skey(fa[0] + fb[3]) & ~255u) | 3u;
        cg[0][4] = (f2skey(fa[0] + fb[4]) & ~255u) | 4u;
        cg[0][5] = (f2skey(fa[0] + fb[5]) & ~255u) | 5u;
        cg[0][6] = (f2skey(fa[0] + fb[6]) & ~255u) | 6u;
        cg[0][7] = (f2skey(fa[0] + fb[7]) & ~255u) | 7u;
        cg[0][8] = (f2skey(fa[0] + fb[8]) & ~255u) | 8u;
        cg[0][9] = (f2skey(fa[0] + fb[9]) & ~255u) | 9u;
        cg[0][10] = (f2skey(fa[0] + fb[10]) & ~255u) | 10u;
        cg[0][11] = (f2skey(fa[0] + fb[11]) & ~255u) | 11u;
        cg[0][12] = (f2skey(fa[0] + fb[12]) & ~255u) | 12u;
        cg[0][13] = (f2skey(fa[0] + fb[13]) & ~255u) | 13u;
        cg[0][14] = (f2skey(fa[0] + fb[14]) & ~255u) | 14u;
        cg[0][15] = (f2skey(fa[0] + fb[15]) & ~255u) | 15u;
        cg[1][0] = (f2skey(fa[1] + fb[0]) & ~255u) | 16u;
        cg[1][1] = (f2skey(fa[1] + fb[1]) & ~255u) | 17u;
        cg[1][2] = (f2skey(fa[1] + fb[2]) & ~255u) | 18u;
        cg[1][3] = (f2skey(fa[1] + fb[3]) & ~255u) | 19u;
        cg[1][4] = (f2skey(fa[1] + fb[4]) & ~255u) | 20u;
        cg[1][5] = (f2skey(fa[1] + fb[5]) & ~255u) | 21u;
        cg[1][6] = (f2skey(fa[1] + fb[6]) & ~255u) | 22u;
        cg[1][7] = (f2skey(fa[1] + fb[7]) & ~255u) | 23u;
        cg[1][8] = (f2skey(fa[2] + fb[0]) & ~255u) | 32u;
        cg[1][9] = (f2skey(fa[2] + fb[1]) & ~255u) | 33u;
        cg[1][10] = (f2skey(fa[2] + fb[2]) & ~255u) | 34u;
        cg[1][11] = (f2skey(fa[2] + fb[3]) & ~255u) | 35u;
        cg[1][12] = (f2skey(fa[2] + fb[4]) & ~255u) | 36u;
        cg[1][13] = (f2skey(fa[3] + fb[0]) & ~255u) | 48u;
        cg[1][14] = (f2skey(fa[3] + fb[1]) & ~255u) | 49u;
        cg[1][15] = (f2skey(fa[3] + fb[2]) & ~255u) | 50u;
        cg[2][0] = (f2skey(fa[3] + fb[3]) & ~255u) | 51u;
        cg[2][1] = (f2skey(fa[4] + fb[0]) & ~255u) | 64u;
        cg[2][2] = (f2skey(fa[4] + fb[1]) & ~255u) | 65u;
        cg[2][3] = (f2skey(fa[4] + fb[2]) & ~255u) | 66u;
        cg[2][4] = (f2skey(fa[5] + fb[0]) & ~255u) | 80u;
        cg[2][5] = (f2skey(fa[5] + fb[1]) & ~255u) | 81u;
        cg[2][6] = (f2skey(fa[6] + fb[0]) & ~255u) | 96u;
        cg[2][7] = (f2skey(fa[6] + fb[1]) & ~255u) | 97u;
        cg[2][8] = (f2skey(fa[7] + fb[0]) & ~255u) | 112u;
        cg[2][9] = (f2skey(fa[7] + fb[1]) & ~255u) | 113u;
        cg[2][10] = (f2skey(fa[8] + fb[0]) & ~255u) | 128u;
        cg[2][11] = (f2skey(fa[9] + fb[0]) & ~255u) | 144u;
        cg[2][12] = (f2skey(fa[10] + fb[0]) & ~255u) | 160u;
        cg[2][13] = (f2skey(fa[11] + fb[0]) & ~255u) | 176u;
        cg[2][14] = (f2skey(fa[12] + fb[0]) & ~255u) | 192u;
        cg[2][15] = (f2skey(fa[13] + fb[0]) & ~255u) | 208u;
        cg[3][0] = (f2skey(fa[14] + fb[0]) & ~255u) | 224u;
        cg[3][1] = (f2skey(fa[15] + fb[0]) & ~255u) | 240u;
        cg[3][2] = 0u;
        cg[3][3] = 0u;
        cg[3][4] = 0u;
        cg[3][5] = 0u;
        cg[3][6] = 0u;
        cg[3][7] = 0u;
        cg[3][8] = 0u;
        cg[3][9] = 0u;
        cg[3][10] = 0u;
        cg[3][11] = 0u;
        cg[3][12] = 0u;
        cg[3][13] = 0u;
        cg[3][14] = 0u;
        cg[3][15] = 0u;
        SORT16_DESC(cg[0]); SORT16_DESC(cg[1]); SORT16_DESC(cg[2]); SORT16_DESC(cg[3]);
        MERGE16_DESC(cg[0], cg[1]); MERGE16_DESC(cg[2], cg[3]); MERGE16_DESC(cg[0], cg[2]);
        unsigned ct[16];
#pragma unroll
        for (int k = 0; k < 16; ++k) ct[k] = cg[0][k];
        float sc[16]; float den = 0.f; const float s0 = skey2f(ct[0] & ~255u);
#pragma unroll
        for (int k = 0; k < 16; ++k) { sc[k] = __expf(skey2f(ct[k] & ~255u) - s0); den += sc[k]; }
        const float inv = 1.f / den;
        if (hh == 0) {
            u16 ev[16];
#pragma unroll
            for (int k = 0; k < 16; ++k) { const unsigned ij = ct[k] & 255u; const unsigned i1 = wl[ij >> 4], i2 = wl[16 + (ij & 15u)]; ev[k] = (u16)(i1 * 128u + i2); }
            const size_t o = (size_t)(t0 + r) * 128 + h * 16;
#pragma unroll
            for (int k = 0; k < 16; k += 8) {
                *(u32x4*)(EID + o + k) = (u32x4){(unsigned)ev[k] | ((unsigned)ev[k + 1] << 16), (unsigned)ev[k + 2] | ((unsigned)ev[k + 3] << 16), (unsigned)ev[k + 4] | ((unsigned)ev[k + 5] << 16), (unsigned)ev[k + 6] | ((unsigned)ev[k + 7] << 16)};
            }
#pragma unroll
            for (int k = 0; k < 16; k += 4) *(f32x4*)(GW + o + k) = (f32x4){sc[k] * inv, sc[k + 1] * inv, sc[k + 2] * inv, sc[k + 3] * inv};
        }
    }
}

typedef _Float16 f16x2 __attribute__((ext_vector_type(2)));
__device__ __forceinline__ float gelu_erf(float d) { return 0.5f * d * (1.f + erff(d * 0.70710678118654752f)); }
constexpr int PQ_WORD0 = 3584, PQ_CHUNK = 64, PQ_NCHUNK = NT / PQ_CHUNK, PQ_HALF = PQ_NCHUNK / 2;
constexpr size_t WS_PART = 208 * MiB;
__device__ __forceinline__ unsigned xcc_id_() { return (unsigned)__builtin_amdgcn_s_getreg((3 << 11) | 20) & 7u; }
template <int VPHASE>
__device__ __forceinline__ void ph9_sliced(const Args& a, unsigned char* lds) {
    int tid_ = __builtin_amdgcn_workitem_id_x(); asm volatile("" : "+v"(tid_)); const int lane = tid_ & 63, wave = __builtin_amdgcn_readfirstlane(tid_ >> 6);
    const int g8 = lane >> 3, c8 = lane & 7;
    const unsigned char* HP = a.ws + WS_HP; const float* HSC = (const float*)(a.ws + WS_HSC); const unsigned char* TAB = a.ws + (VPHASE ? WS_VP : WS_UT);
    const u16* EID = (const u16*)(a.ws + WS_EID); const f16* GWH = (const f16*)(a.ws + WS_GWH); f16* PART = (f16*)(a.ws + WS_PART); const float* WSUM = (const float*)(a.ws + WS_WSUM);
    const float* mod = (const float*)(a.ws + WS_MOD); float* out = a.out; const f16* X1 = (const f16*)(a.ws + WS_X1);
    unsigned* qw = (unsigned*)(a.ws + WS_CTL) + PQ_WORD0 + (VPHASE ? 8 * 64 : 0);
    const bool b5 = (lane & 32) != 0, b4 = (lane & 16) != 0, b3 = (lane & 8) != 0, b2 = (lane & 4) != 0, b1 = (lane & 2) != 0, b0 = (lane & 1) != 0;
    const unsigned x0 = xcc_id_();
    for (int k = 0; k < 8; ++k) {
        const unsigned qi_ = (x0 + (unsigned)k) & 7u, sl = qi_ & 3u, half = qi_ >> 2;
        unsigned cur = 0u;
        if (lane == 0) cur = __hip_atomic_fetch_add(qw + 64 * qi_, 1u, __ATOMIC_RELAXED, __HIP_MEMORY_SCOPE_AGENT);
        for (;;) {
            const unsigned c = (unsigned)__builtin_amdgcn_readfirstlane((int)cur);
            if (c >= (unsigned)(PQ_HALF * NWAVE)) break;
            if (lane == 0) cur = __hip_atomic_fetch_add(qw + 64 * qi_, 1u, __ATOMIC_RELAXED, __HIP_MEMORY_SCOPE_AGENT);
            const int tb = ((int)(half * PQ_HALF) * NWAVE + (int)c) * (PQ_CHUNK / NWAVE);
            const unsigned char* tsl = TAB + 128 * sl + 16 * c8;
#pragma unroll 1
            for (int i8 = 0; i8 < PQ_CHUNK / NWAVE; ++i8) {
                const int t = tb + i8;
                const u32x4 e0 = *(const u32x4*)(EID + (size_t)t * 128 + 16 * g8), e1 = *(const u32x4*)(EID + (size_t)t * 128 + 16 * g8 + 8);
                const unsigned ew[8] = {e0.x, e0.y, e0.z, e0.w, e1.x, e1.y, e1.z, e1.w};
                u32x4 r8[16];
#pragma unroll
                for (int i = 0; i < 16; ++i) { const unsigned eid = (i & 1) ? (ew[i >> 1] >> 16) : (ew[i >> 1] & 0xFFFFu); r8[i] = *(const u32x4*)(tsl + (size_t)eid * 512); }
                if (!VPHASE) {
                    const u32x4 hh4 = *(const u32x4*)(HP + (size_t)t * 1024 + 128 * sl + 16 * c8), hl4 = *(const u32x4*)(HP + (size_t)t * 1024 + 512 + 128 * sl + 16 * c8);
                    const float hsc = 0.5f * HSC[t];
                    int hs1 = 0, hs0 = 0;
#pragma unroll
                    for (int j = 0; j < 4; ++j) { hs1 = __builtin_amdgcn_sdot8((int)hh4[j], 0x11111111, hs1, false); hs0 = __builtin_amdgcn_sdot8((int)hl4[j], 0x11111111, hs0, false); }
                    const int hsum = 16 * hs1 + hs0;
                    float p[16];
#pragma unroll
                    for (int i = 0; i < 16; ++i) { int d1 = 0, d0 = 0;
#pragma unroll
                        for (int j = 0; j < 4; ++j) { d1 = __builtin_amdgcn_sdot8((int)hh4[j], (int)r8[i][j], d1, false); d0 = __builtin_amdgcn_sdot8((int)hl4[j], (int)r8[i][j], d0, false); }
                        p[i] = (float)(2 * (16 * d1 + d0) + hsum); }
                    float q8[8], q4[4], r2[2];
#define DPPF(x_, ctrl_) __int_as_float(__builtin_amdgcn_update_dpp(0, __float_as_int(x_), ctrl_, 0xF, 0xF, true))
#pragma unroll
                    for (int ii = 0; ii < 8; ++ii) { const float keep = b2 ? p[8 + ii] : p[ii], send = b2 ? p[ii] : p[8 + ii]; q8[ii] = keep + DPPF(send, 0x141); }
#pragma unroll
                    for (int ii = 0; ii < 4; ++ii) { const float keep = b1 ? q8[4 + ii] : q8[ii], send = b1 ? q8[ii] : q8[4 + ii]; q4[ii] = keep + DPPF(send, 0x4E); }
#pragma unroll
                    for (int ii = 0; ii < 2; ++ii) { const float keep = b0 ? q4[2 + ii] : q4[ii], send = b0 ? q4[ii] : q4[2 + ii]; r2[ii] = keep + DPPF(send, 0xB1); }
#undef DPPF
                    *(f16x2*)(PART + ((size_t)sl * NT + t) * 128 + 16 * g8 + 2 * c8) = (f16x2){(f16)(r2[0] * hsc), (f16)(r2[1] * hsc)};
                } else {
                    const u32x4* wp = (const u32x4*)(GWH + (size_t)t * 128 + 16 * g8);
                    const u32x4 wq0 = wp[0], wq1 = wp[1];
                    const unsigned wv[8] = {wq0[0], wq0[1], wq0[2], wq0[3], wq1[0], wq1[1], wq1[2], wq1[3]};
                    const f16 off = (f16)(-7.5f * 5.9604644775390625e-08f * WSUM[(size_t)t * 8 + g8]);
                    f16x2 acc2[16];
#pragma unroll
                    for (int j = 0; j < 16; ++j) acc2[j] = (f16x2){off, off};
#pragma unroll
                    for (int i = 0; i < 16; ++i) { const f16x2 wp2 = __builtin_bit_cast(f16x2, wv[i >> 1]); const f16x2 wp2b = wp2 * (f16x2){(f16)0.0625f, (f16)0.0625f};
                        const f16x2 wa = (i & 1) ? (f16x2){wp2[1], wp2[1]} : (f16x2){wp2[0], wp2[0]}, wb = (i & 1) ? (f16x2){wp2b[1], wp2b[1]} : (f16x2){wp2b[0], wp2b[0]};
#pragma unroll
                        for (int j = 0; j < 4; ++j) { const unsigned x = r8[i][j], y = x >> 8;
                            acc2[4 * j]     = __builtin_elementwise_fma(wa, __builtin_bit_cast(f16x2, x & 0x000F000Fu), acc2[4 * j]);
                            acc2[4 * j + 1] = __builtin_elementwise_fma(wb, __builtin_bit_cast(f16x2, x & 0x00F000F0u), acc2[4 * j + 1]);
                            acc2[4 * j + 2] = __builtin_elementwise_fma(wa, __builtin_bit_cast(f16x2, y & 0x000F000Fu), acc2[4 * j + 2]);
                            acc2[4 * j + 3] = __builtin_elementwise_fma(wb, __builtin_bit_cast(f16x2, y & 0x00F000F0u), acc2[4 * j + 3]); } }
                    unsigned q8[8], q4[4], r2[2];
#pragma unroll
                    for (int ii = 0; ii < 8; ++ii) { const auto sw = __builtin_amdgcn_permlane32_swap(__builtin_bit_cast(unsigned, acc2[ii]), __builtin_bit_cast(unsigned, acc2[8 + ii]), false, false);
                        q8[ii] = __builtin_bit_cast(unsigned, __builtin_bit_cast(f16x2, (unsigned)sw[0]) + __builtin_bit_cast(f16x2, (unsigned)sw[1])); }
#pragma unroll
                    for (int ii = 0; ii < 4; ++ii) { const auto sw = __builtin_amdgcn_permlane16_swap(q8[ii], q8[4 + ii], false, false);
                        q4[ii] = __builtin_bit_cast(unsigned, __builtin_bit_cast(f16x2, (unsigned)sw[0]) + __builtin_bit_cast(f16x2, (unsigned)sw[1])); }
#pragma unroll
                    for (int ii = 0; ii < 2; ++ii) { const unsigned keep = b3 ? q4[2 + ii] : q4[ii], send = b3 ? q4[ii] : q4[2 + ii];
                        r2[ii] = __builtin_bit_cast(unsigned, __builtin_bit_cast(f16x2, keep) + __builtin_bit_cast(f16x2, (unsigned)__builtin_amdgcn_update_dpp(0, (int)send, 0x128, 0xF, 0xF, true))); }
                    const f16x2 ra = __builtin_bit_cast(f16x2, r2[0]), rb = __builtin_bit_cast(f16x2, r2[1]);
                    const int ch = 256 * sl + 32 * c8 + (b5 ? 16 : 0) + (b4 ? 8 : 0) + (b3 ? 4 : 0);
                    float* op = out + (size_t)t * ND + ch; const float* g2 = mod + (t / NS) * 6144 + 5120 + ch;
                    const f16x4 x4 = *(const f16x4*)(X1 + (size_t)t * ND + ch); const f32x4 gg = *(const f32x4*)g2;
                    const float sc_ = 16777216.f / PEER_WSCALE;
                    *(f32x4*)op = (f32x4){(float)x4[0], (float)x4[1], (float)x4[2], (float)x4[3]} + gg * ((f32x4){(float)ra[0], (float)ra[1], (float)rb[0], (float)rb[1]} * sc_);
                }
            }
        }
    }
}
__device__ __forceinline__ void ph9b_combine(const Args& a, int bid, int nb) {
    int tid_ = __builtin_amdgcn_workitem_id_x(); asm volatile("" : "+v"(tid_));
    float* GW = (float*)(a.ws + WS_GW); const f16* PART = (const f16*)(a.ws + WS_PART); f16* GWH = (f16*)(a.ws + WS_GWH);
    const float du = ((const float*)(a.ws + WS_QS))[0], dv = ((const float*)(a.ws + WS_QS))[1] * PEER_WSCALE;
    const size_t istep = (size_t)nb * NTHR, itot = (size_t)NT * 128 / 4;
    size_t i = (size_t)bid * NTHR + tid_;
#define PQ9B_ONE(sum_, g_, ii_) do { f32x4 w; \
        _Pragma("unroll") for (int j = 0; j < 4; ++j) w[j] = fminf(fmaxf(g_[j] * gelu_erf(sum_[j] * du) * dv, -60000.f), 60000.f);        \
          \
        float ws_ = 0.f; f16x4 pk; \
        _Pragma("unroll") for (int j = 0; j < 4; ++j) { const f16 hw_ = (f16)w[j]; ws_ += (float)hw_; pk[j] = hw_; } \
        ((f16x4*)GWH)[ii_] = pk; \
        ws_ += __shfl_xor(ws_, 1); ws_ += __shfl_xor(ws_, 2); \
        if ((tid_ & 3) == 0) ((float*)(a.ws + WS_WSUM))[(ii_) >> 2] = ws_; } while (0)
    for (; i + istep < itot; i += 2 * istep) {
#define PQ9B_LD(idx_, sidx_) ({ const f16x4 h4_ = ((const f16x4*)(PART + (size_t)(sidx_) * NT * 128))[idx_]; (f32x4){(float)h4_[0], (float)h4_[1], (float)h4_[2], (float)h4_[3]}; })
        f32x4 s0 = PQ9B_LD(i, 0), s1 = PQ9B_LD(i + istep, 0);
#pragma unroll
        for (int sidx = 1; sidx < 4; ++sidx) { s0 += PQ9B_LD(i, sidx); s1 += PQ9B_LD(i + istep, sidx); }
        const f32x4 g0 = ((const f32x4*)GW)[i], g1 = ((const f32x4*)GW)[i + istep];
        PQ9B_ONE(s0, g0, i); PQ9B_ONE(s1, g1, i + istep);
    }
    for (; i < itot; i += istep) {
        f32x4 s0 = PQ9B_LD(i, 0);
#pragma unroll
        for (int sidx = 1; sidx < 4; ++sidx) s0 += PQ9B_LD(i, sidx);
        const f32x4 g0 = ((const f32x4*)GW)[i];
        PQ9B_ONE(s0, g0, i);
    }
#undef PQ9B_ONE
#undef PQ9B_LD
}

#define LAS __attribute__((address_space(3)))
#define XB_TMO      128
#define XB_XCNT(j)  (256  + 64 * (j))
#define XB_XSUB(j)  (1280 + 64 * (j))
#define XB_XGEN(j)  (2304 + 64 * (j))
#define XB_TOP      3328
#define XB_TOPGEN   3392
#define XCD_BAR_WORDS 3456
#define XB_SPIN_CAP (1u << 18)
__device__ __forceinline__ unsigned xb_ld(unsigned* p)              { return __hip_atomic_load(p, __ATOMIC_RELAXED, __HIP_MEMORY_SCOPE_AGENT); }
__device__ __forceinline__ unsigned xb_add(unsigned* p, unsigned v) { return __hip_atomic_fetch_add(p, v, __ATOMIC_RELAXED, __HIP_MEMORY_SCOPE_AGENT); }
__device__ __forceinline__ unsigned xb_xcc_id() { return (unsigned)__builtin_amdgcn_s_getreg((3 << 11) | 20) & 0xFu; }
#define XB_SPIN(cond, bar) do { unsigned _sp = 0; while (cond) { __builtin_amdgcn_s_sleep(1); \
    if ((++_sp & 255u) == 0u) { if (xb_ld(&(bar)[XB_TMO])) break; if (_sp > XB_SPIN_CAP) { atomicAdd(&(bar)[XB_TMO], 1u); break; } } } } while (0)
struct XcdBarrier { unsigned* bar; unsigned x; volatile LAS unsigned* st; };
__device__ __forceinline__ XcdBarrier xcd_barrier_post(unsigned* bar, volatile LAS unsigned* st) {
    XcdBarrier b; b.bar = bar; b.x = xb_xcc_id(); b.st = st;
    if (__builtin_amdgcn_workitem_id_x() == 0) (void)xb_add(&bar[XB_XCNT(b.x)], 1u);
    return b;
}
__device__ __forceinline__ void xcd_barrier_complete(unsigned* bar, unsigned x, unsigned& nloc, unsigned& nx) {
    const unsigned G = (__builtin_amdgcn_grid_size_x() / NTHR);
    unsigned sum, cnt, mine, sp = 0u;
    for (;;) {
        sum = 0u; cnt = 0u; mine = 0u;
#pragma unroll
        for (unsigned j = 0; j < 16; ++j) { const unsigned c = xb_ld(&bar[XB_XCNT(j)]); sum += c; cnt += (c > 0u) ? 1u : 0u; mine = (j == x) ? c : mine; }
        if (sum == G) break;
        __builtin_amdgcn_s_sleep(1);
        if ((++sp & 255u) == 0u) { if (xb_ld(&bar[XB_TMO])) break; if (sp > XB_SPIN_CAP) { atomicAdd(&bar[XB_TMO], 1u); break; } }
    }
    nloc = mine > 0u ? mine : 1u; nx = cnt > 0u ? cnt : 1u;
}
__device__ __forceinline__ void xcd_barrier(const XcdBarrier& b) {
    asm volatile("s_waitcnt vmcnt(0)" ::: "memory");
    __syncthreads();
    if (__builtin_amdgcn_workitem_id_x() == 0) {
        unsigned* bar = b.bar;
        __builtin_amdgcn_s_waitcnt(0);
        unsigned nloc = b.st[0], nx = b.st[1];
        if (nloc == 0u) { xcd_barrier_complete(bar, b.x, nloc, nx); b.st[0] = nloc; b.st[1] = nx; }
        const unsigned old = xb_add(&bar[XB_XSUB(b.x)], 1u);
        const unsigned gen = old / nloc;
        if (old + 1u == (gen + 1u) * nloc) {
            __builtin_amdgcn_fence(__ATOMIC_RELEASE, "agent");
            asm volatile("s_waitcnt vmcnt(0)" ::: "memory");
            const unsigned og = xb_add(&bar[XB_TOP], 1u);
            const unsigned tg = og / nx;
            if (og + 1u == (tg + 1u) * nx) xb_add(&bar[XB_TOPGEN], 1u);
            else XB_SPIN(xb_ld(&bar[XB_TOPGEN]) == tg, bar);
            __builtin_amdgcn_fence(__ATOMIC_ACQUIRE, "agent");
            xb_add(&bar[XB_XGEN(b.x)], 1u);
            asm volatile("s_waitcnt vmcnt(0)" ::: "memory");
        } else {
            XB_SPIN(xb_ld(&bar[XB_XGEN(b.x)]) == gen, bar);
            __builtin_amdgcn_fence(__ATOMIC_ACQUIRE, "agent");
            asm volatile("s_waitcnt vmcnt(0)" ::: "memory");
        }
    }
    __syncthreads();
}

constexpr int N_PHASES = 11;
__global__ void __launch_bounds__(NTHR, 2) mk_fwd(Args a) {
    extern __shared__ __attribute__((aligned(16))) unsigned char lds[];
    const int bid = __builtin_amdgcn_workgroup_id_x(), nb = (__builtin_amdgcn_grid_size_x() / NTHR);
    const int lo = a.ph_lo, hi = a.ph_hi;
    volatile LAS unsigned* bst = (volatile LAS unsigned*)((LAS unsigned char*)lds + (LDS_BYTES - 16));
    if (__builtin_amdgcn_workitem_id_x() < 4) bst[__builtin_amdgcn_workitem_id_x()] = 0u;
    __syncthreads();
    XcdBarrier xbar = xcd_barrier_post((unsigned*)(a.ws + WS_CTL), bst);
#define SEAM(k) xcd_barrier(xbar)
#define PHASE(k, body) if (lo <= (k) && (k) < hi) { body; if ((k) + 1 < hi) SEAM(k); }
    PHASE(0, ph0_prologue(a, bid, nb, lds))
    PHASE(1, row_norm_mod(a.in[0], a.in[4], (const float*)(a.ws + WS_MOD), 0, 1024, (f16*)(a.ws + WS_H), a.ws + WS_H8, (float*)(a.ws + WS_H8 + 64 * MiB), bid, nb); wq_to_int8((const f16*)(a.ws + WS_WQ), a.ws + WS_WQ8, (float*)(a.ws + WS_WSC), 2048, bid, nb); wq_to_int8((const f16*)(a.ws + WS_WIN), a.ws + WS_WIN8, (float*)(a.ws + WS_WSCIN), 1536, bid, nb); wq_to_int8((const f16*)(a.ws + WS_WVT), a.ws + WS_WVT8, (float*)(a.ws + WS_WSCIN) + 1536, 512, bid, nb); wq_to_int8((const f16*)(a.ws + WS_WOUT), a.ws + WS_WOUT8, (float*)(a.ws + WS_WSCIN) + 4096, 1024, bid, nb, a.in[8], a.in[11]))
    PHASE(2, ph2_inproj(a, bid, nb, lds))
    PHASE(3, ph3_pool_fast(a, bid, nb, lds); ph3_index_fast<0>(a, bid, nb, lds))
    PHASE(4, ph4_attn_fast<0>(a, bid, nb, lds))
    PHASE(5, ph5_outproj(a, bid, nb, lds))
    PHASE(6, row_norm_mod_q((const f16*)(a.ws + WS_X1), a.in[13], (const float*)(a.ws + WS_MOD), 3072, 4096, a.ws + WS_HQ, (unsigned*)(a.ws + WS_HP), (float*)(a.ws + WS_HSC), bid, nb))
    PHASE(7, ph7_peerq(a, bid, nb, lds))
    PHASE(8, ph9_sliced<0>(a, lds))
    PHASE(9, ph9b_combine(a, bid, nb))
    PHASE(10, ph9_sliced<1>(a, lds))
#undef PHASE
}

extern "C" void kernel_launch(void* const* d_in, const int* in_sizes, int n_in, void* d_out, int out_size, void* d_ws, size_t ws_size, hipStream_t stream) {
    static int grid = 0;
    if (grid == 0) {
        if (n_in != 18 || out_size != NT * ND || ws_size < WS_END) { fprintf(stderr, "kernel_launch: unexpected shapes (n_in %d out %d ws %zu)\n", n_in, out_size, ws_size); grid = -1; return; }
        int dev = 0, cus = 0, per_cu = 0;
        hipGetDevice(&dev); hipDeviceGetAttribute(&cus, hipDeviceAttributeMultiprocessorCount, dev);
        hipFuncSetAttribute((const void*)mk_fwd, hipFuncAttributeMaxDynamicSharedMemorySize, LDS_BYTES);
        hipOccupancyMaxActiveBlocksPerMultiprocessor(&per_cu, (const void*)mk_fwd, NTHR, LDS_BYTES);
        if (per_cu < 1) { fprintf(stderr, "kernel_launch: occupancy query says %d blocks/CU\n", per_cu); per_cu = 1; }
        grid = cus * 1;
        (void)hipGetLastError();
    }
    if (grid < 0) return;
    if (hipMemsetAsync((char*)d_ws + WS_CTL, 0, 32768, stream) != hipSuccess) { fprintf(stderr, "kernel_launch: memset of the barrier words failed\n"); return; }
    Args a{};
    for (int i = 0; i < 18; ++i) a.in[i] = (const float*)d_in[i];
    a.out = (float*)d_out; a.ws = (unsigned char*)d_ws;
#if MK_MULTI
    for (int ph = 0; ph < N_PHASES; ++ph) { a.ph_lo = ph; a.ph_hi = ph + 1; hipLaunchKernelGGL(mk_fwd, dim3(grid), dim3(NTHR), LDS_BYTES, stream, a); }
#else
    a.ph_lo = 0; a.ph_hi = N_PHASES;
    void* args[] = {&a};
    hipError_t e = hipLaunchCooperativeKernel((const void*)mk_fwd, dim3(grid), dim3(NTHR), args, LDS_BYTES, stream);
    if (e != hipSuccess) fprintf(stderr, "cooperative launch failed: %s (grid %d)\n", hipGetErrorString(e), grid);
#endif
}
#if defined(__HIP_DEVICE_COMPILE__)
#pragma clang attribute pop
#endif
```
